# Optimizing an MI355X kernel written in HIP

```python
import jax
import jax.numpy as jnp
from jax import lax
import numpy as np

D_MODEL = 2048
BATCH = 2
SEQ = 4096
DEPTH = 4

GRID_W = 64
CTX_LEN = 256
N_EVEN = (DEPTH + 1) // 2
N_ODD = DEPTH // 2
EPS = 1e-6
ROPE_THETA = 10000.0
Q_BLOCK = 128
N_MOD = 6

MLA_HEADS = 8
MLA_NOPE = 128
MLA_ROPE = 64
MLA_QK = MLA_NOPE + MLA_ROPE
MLA_V = 128
Q_LORA = 512
KV_LORA = 256

CONV_WIDTH = 1024
CONV_K = 3

EVEN_IN = Q_LORA + KV_LORA + MLA_ROPE + 3 * CONV_WIDTH
MIX_WIDTH = MLA_HEADS * MLA_V + CONV_WIDTH

GQA_HEADS = 16
GQA_KV_HEADS = 4
GQA_GROUP = GQA_HEADS // GQA_KV_HEADS
GQA_HD = 128
GQA_Q_DIM = GQA_HEADS * GQA_HD
GQA_KV_DIM = GQA_KV_HEADS * GQA_HD
ODD_IN = GQA_Q_DIM + 2 * GQA_KV_DIM

PEER_HEADS = 8
N_KEYS = 128
N_EXPERTS = N_KEYS * N_KEYS
PEER_TOPK = 16
PEER_DKEY = 256
PEER_DHALF = PEER_DKEY // 2
PEER_CHUNK = 128

kernel_name = 'hybrid_mla_conv_gqa_peer_dit'


def rmsnorm(x, g):
    xf = x.astype(jnp.float32)
    y = xf * lax.rsqrt(jnp.mean(xf * xf, axis=-1, keepdims=True) + EPS)
    return y.astype(x.dtype) * g


def axial_rope_tables(n_tokens, rope_dim):
    rows = n_tokens // GRID_W
    row = jnp.repeat(jnp.arange(rows, dtype=jnp.float32), GRID_W)
    col = jnp.tile(jnp.arange(GRID_W, dtype=jnp.float32), rows)
    quarter = rope_dim // 4
    freqs = ROPE_THETA ** (-jnp.arange(quarter, dtype=jnp.float32) / quarter)
    ang = jnp.concatenate([row[:, None] * freqs, col[:, None] * freqs], axis=-1)
    return jnp.cos(ang), jnp.sin(ang)


def apply_rope(x, cos, sin):
    shp = (cos.shape[0],) + (1,) * (x.ndim - 3) + (cos.shape[1],)
    cos = cos.reshape(shp).astype(x.dtype)
    sin = sin.reshape(shp).astype(x.dtype)
    x1, x2 = jnp.split(x, 2, axis=-1)
    return jnp.concatenate([x1 * cos - x2 * sin, x2 * cos + x1 * sin], axis=-1)


def softmax_attend(q, k, v):
    s = jnp.einsum('bqhgd,bkhd->bhgqk', q, k).astype(jnp.float32) * (q.shape[-1] ** -0.5)
    p = jax.nn.softmax(s, axis=-1).astype(v.dtype)
    return jnp.einsum('bhgqk,bkhd->bqhgd', p, v)


def latent_attend(q, k_lat, v_lat, k_ctx, v_ctx):
    b, s = q.shape[:2]
    k = jnp.concatenate([k_ctx, k_lat], axis=1)
    v = jnp.concatenate([v_ctx, v_lat], axis=1)
    qb = q.reshape((b, s // Q_BLOCK, Q_BLOCK) + q.shape[2:]).swapaxes(0, 1)
    out = lax.map(lambda qi: softmax_attend(qi, k, v), qb).swapaxes(0, 1)
    return out.reshape((b, s) + out.shape[3:])


def short_conv(u, w, bias):
    n = u.shape[1]
    up = jnp.pad(u, ((0, 0), (1, 1), (0, 0)))
    return up[:, :n] * w[0] + up[:, 1:n + 1] * w[1] + up[:, 2:] * w[2] + bias


def gated_conv(z, w, bias):
    b_gate, c_gate, hz = jnp.split(z, 3, axis=-1)
    return b_gate * short_conv(c_gate * hz, w, bias)


def even_mixer(h_ctx, h_lat, w_in, q_lora_g, kv_lora_g, w_uq, w_ukv, q_g, k_g, conv_w, conv_b, w_o,
               cos, sin, need_ctx):
    cuts = [Q_LORA, Q_LORA + KV_LORA, Q_LORA + KV_LORA + MLA_ROPE]

    def mla_q(cq, rope):
        b, n = cq.shape[:2]
        q = rmsnorm((rmsnorm(cq, q_lora_g) @ w_uq).reshape(b, n, MLA_HEADS, MLA_QK), q_g)
        if rope:
            q = jnp.concatenate([q[..., :MLA_NOPE], apply_rope(q[..., MLA_NOPE:], cos, sin)], axis=-1)
        return q[:, :, :, None, :]

    def mla_kv(ckv, kr, rope):
        b, n = ckv.shape[:2]
        kv = (rmsnorm(ckv, kv_lora_g) @ w_ukv).reshape(b, n, MLA_HEADS, MLA_NOPE + MLA_V)
        k_nope, v = jnp.split(kv, [MLA_NOPE], axis=-1)
        k_rope = jnp.broadcast_to(kr[:, :, None, :], (b, n, MLA_HEADS, MLA_ROPE))
        k = rmsnorm(jnp.concatenate([k_nope, k_rope], axis=-1), k_g)
        if rope:
            k = jnp.concatenate([k[..., :MLA_NOPE], apply_rope(k[..., MLA_NOPE:], cos, sin)], axis=-1)
        return k, v

    b, s = h_lat.shape[:2]
    cq, ckv, kr, z = jnp.split(h_lat @ w_in, cuts, axis=-1)
    k_lat, v_lat = mla_kv(ckv, kr, True)
    if need_ctx:
        cq_c, ckv_c, kr_c, z_c = jnp.split(h_ctx @ w_in, cuts, axis=-1)
    else:
        ckv_c, kr_c = jnp.split(h_ctx @ w_in[:, cuts[0]:cuts[2]], [KV_LORA], axis=-1)
    k_ctx, v_ctx = mla_kv(ckv_c, kr_c, False)
    a_lat = latent_attend(mla_q(cq, True), k_lat, v_lat, k_ctx, v_ctx).reshape(b, s, MLA_HEADS * MLA_V)
    y_lat = jnp.concatenate([a_lat, gated_conv(z, conv_w, conv_b)], axis=-1) @ w_o
    y_ctx = None
    if need_ctx:
        a_ctx = softmax_attend(mla_q(cq_c, False), k_ctx, v_ctx).reshape(b, h_ctx.shape[1], MLA_HEADS * MLA_V)
        y_ctx = jnp.concatenate([a_ctx, gated_conv(z_c, conv_w, conv_b)], axis=-1) @ w_o
    return y_ctx, y_lat


def odd_mixer(h_ctx, h_lat, w_qkv, q_g, k_g, w_o, cos, sin, need_ctx):
    cuts = [GQA_Q_DIM, GQA_Q_DIM + GQA_KV_DIM]

    def heads_q(pq, rope):
        b, n = pq.shape[:2]
        q = rmsnorm(pq.reshape(b, n, GQA_KV_HEADS, GQA_GROUP, GQA_HD), q_g)
        return apply_rope(q, cos, sin) if rope else q

    def heads_kv(pk, pv, rope):
        b, n = pk.shape[:2]
        k = rmsnorm(pk.reshape(b, n, GQA_KV_HEADS, GQA_HD), k_g)
        v = pv.reshape(b, n, GQA_KV_HEADS, GQA_HD)
        return (apply_rope(k, cos, sin) if rope else k), v

    b, s = h_lat.shape[:2]
    pq, pk, pv = jnp.split(h_lat @ w_qkv, cuts, axis=-1)
    k_lat, v_lat = heads_kv(pk, pv, True)
    if need_ctx:
        pq_c, pk_c, pv_c = jnp.split(h_ctx @ w_qkv, cuts, axis=-1)
    else:
        pk_c, pv_c = jnp.split(h_ctx @ w_qkv[:, GQA_Q_DIM:], [GQA_KV_DIM], axis=-1)
    k_ctx, v_ctx = heads_kv(pk_c, pv_c, False)
    y_lat = latent_attend(heads_q(pq, True), k_lat, v_lat, k_ctx, v_ctx).reshape(b, s, GQA_Q_DIM) @ w_o
    y_ctx = None
    if need_ctx:
        y_ctx = softmax_attend(heads_q(pq_c, False), k_ctx, v_ctx).reshape(b, h_ctx.shape[1], GQA_Q_DIM) @ w_o
    return y_ctx, y_lat


def peer_ffn(h, w_q, sub_keys, u_tab, v_tab):
    shape = h.shape
    chunks = h.reshape(-1, PEER_CHUNK, shape[-1])
    kk = PEER_TOPK * PEER_TOPK

    def one(xi):
        q = (xi @ w_q).reshape(PEER_CHUNK, PEER_HEADS, 2, PEER_DHALF)
        s = jnp.einsum('thpd,hpnd->thpn', q, sub_keys).astype(jnp.float32)
        s_top, i_top = lax.top_k(s, PEER_TOPK)
        cand_s = (s_top[:, :, 0, :, None] + s_top[:, :, 1, None, :]).reshape(PEER_CHUNK, PEER_HEADS, kk)
        cand_i = (i_top[:, :, 0, :, None] * N_KEYS + i_top[:, :, 1, None, :]).reshape(PEER_CHUNK, PEER_HEADS, kk)
        best_s, best_j = lax.top_k(cand_s, PEER_TOPK)
        idx = jnp.take_along_axis(cand_i, best_j, axis=-1)
        g = jax.nn.softmax(best_s, axis=-1).astype(xi.dtype)
        a = jax.nn.gelu(jnp.einsum('thkd,td->thk', u_tab[idx], xi), approximate=False)
        return jnp.einsum('thk,thkd->td', g * a, v_tab[idx])

    return lax.map(one, chunks).reshape(shape)


def setup_inputs(seed: int = 0) -> dict:
    key = jax.random.key(seed)
    ks = iter(jax.random.split(key, 32))

    def nrm(shape, std):
        return jax.random.normal(next(ks), shape, jnp.float32) * std

    def gain(shape):
        return 1.0 + nrm(shape, 0.01)

    d = D_MODEL
    return {
        'x': nrm((BATCH, SEQ, d), 1.0),
        'c': nrm((BATCH, d), 1.0),
        'ctx': nrm((BATCH, CTX_LEN, d), 1.0),
        'c_ctx': nrm((d,), 1.0),
        'ada_w': nrm((DEPTH, d, N_MOD * d), d ** -0.5),
        'ada_b': nrm((DEPTH, N_MOD * d), 0.01),
        'norm1_g': gain((DEPTH, d)),
        'norm2_g': gain((DEPTH, d)),
        'a_w_in': nrm((N_EVEN, d, EVEN_IN), d ** -0.5),
        'a_q_lora_g': gain((N_EVEN, Q_LORA)),
        'a_kv_lora_g': gain((N_EVEN, KV_LORA)),
        'a_w_uq': nrm((N_EVEN, Q_LORA, MLA_HEADS * MLA_QK), Q_LORA ** -0.5),
        'a_w_ukv': nrm((N_EVEN, KV_LORA, MLA_HEADS * (MLA_NOPE + MLA_V)), KV_LORA ** -0.5),
        'a_q_g': gain((N_EVEN, MLA_QK)),
        'a_k_g': gain((N_EVEN, MLA_QK)),
        'b_conv_w': nrm((N_EVEN, CONV_K, CONV_WIDTH), CONV_K ** -0.5),
        'b_conv_b': nrm((N_EVEN, CONV_WIDTH), 0.01),
        'e_w_o': nrm((N_EVEN, MIX_WIDTH, d), MIX_WIDTH ** -0.5),
        'c_w_qkv': nrm((N_ODD, d, ODD_IN), d ** -0.5),
        'c_q_g': gain((N_ODD, GQA_HD)),
        'c_k_g': gain((N_ODD, GQA_HD)),
        'c_w_o': nrm((N_ODD, GQA_Q_DIM, d), GQA_Q_DIM ** -0.5),
        'p_w_q': nrm((DEPTH, d, PEER_HEADS * PEER_DKEY), d ** -0.5),
        'p_sub_keys': nrm((DEPTH, PEER_HEADS, 2, N_KEYS, PEER_DHALF), PEER_DHALF ** -0.5),
        'p_u': nrm((DEPTH, N_EXPERTS, d), d ** -0.5),
        'p_v': nrm((DEPTH, N_EXPERTS, d), PEER_HEADS ** -0.5),
    }


def reference(x, c, ctx, c_ctx, ada_w, ada_b, norm1_g, norm2_g, a_w_in, a_q_lora_g, a_kv_lora_g, a_w_uq,
              a_w_ukv, a_q_g, a_k_g, b_conv_w, b_conv_b, e_w_o, c_w_qkv, c_q_g, c_k_g, c_w_o, p_w_q,
              p_sub_keys, p_u, p_v):
    s = x.shape[1]
    cos_a, sin_a = axial_rope_tables(s, MLA_ROPE)
    cos_c, sin_c = axial_rope_tables(s, GQA_HD)
    silu_lat = jax.nn.silu(c)
    silu_ctx = jax.nn.silu(c_ctx)
    xc = ctx
    for l in range(DEPTH):
        need_ctx = l < DEPTH - 1
        sh1, sc1, g1, sh2, sc2, g2 = jnp.split((silu_lat @ ada_w[l] + ada_b[l])[:, None, :], N_MOD, axis=-1)
        csh1, csc1, cg1, csh2, csc2, cg2 = jnp.split((silu_ctx @ ada_w[l] + ada_b[l])[None, None, :], N_MOD, axis=-1)
        h_lat = rmsnorm(x, norm1_g[l]) * (1 + sc1) + sh1
        h_ctx = rmsnorm(xc, norm1_g[l]) * (1 + csc1) + csh1
        i = l // 2
        if l % 2 == 0:
            y_ctx, y_lat = even_mixer(h_ctx, h_lat, a_w_in[i], a_q_lora_g[i], a_kv_lora_g[i], a_w_uq[i],
                                      a_w_ukv[i], a_q_g[i], a_k_g[i], b_conv_w[i], b_conv_b[i], e_w_o[i],
                                      cos_a, sin_a, need_ctx)
        else:
            y_ctx, y_lat = odd_mixer(h_ctx, h_lat, c_w_qkv[i], c_q_g[i], c_k_g[i], c_w_o[i],
                                     cos_c, sin_c, need_ctx)
        x = x + g1 * y_lat
        h_lat = rmsnorm(x, norm2_g[l]) * (1 + sc2) + sh2
        x = x + g2 * peer_ffn(h_lat, p_w_q[l], p_sub_keys[l], p_u[l], p_v[l])
        if need_ctx:
            xc = xc + cg1 * y_ctx
            h_ctx = rmsnorm(xc, norm2_g[l]) * (1 + csc2) + csh2
            xc = xc + cg2 * peer_ffn(h_ctx, p_w_q[l], p_sub_keys[l], p_u[l], p_v[l])
    return x
```

```cpp
#include <hip/hip_runtime.h>
#include <cstdio>
#include <cstdint>
namespace pg8 {
#define PG8_LAS __attribute__((address_space(3)))
typedef unsigned short bf16_t;
typedef short bf16x8 __attribute__((ext_vector_type(8)));
typedef float f32x4 __attribute__((ext_vector_type(4)));
typedef unsigned u32x4 __attribute__((ext_vector_type(4)));
constexpr int BM = 256, BK = 64, HALF = 128, HTB = HALF * BK * 2  , STAGE_BYTES = 8 * HTB, NXCD = 8, WGM = 8;

__host__ __device__ __forceinline__ int lds_byte(int r, int c) { const int st = (r >> 4) * 2 + (c >> 5), rr = r & 15, cc = c & 31, ob = rr * 64 + cc * 2; return st * 1024 + (ob ^ (((ob >> 9) & 1) << 5)); }
__host__ __device__ __forceinline__ void stage_rc(int b, int& R, int& C) { const int st = b / 1024, sb = b % 1024, swz = sb ^ (((sb >> 9) & 1) << 5); R = (st >> 1) * 16 + swz / 64; C = (st & 1) * 32 + (swz % 64) / 2; }
__host__ __device__ __forceinline__ int perm32(int rho) { const int n = rho >> 4, i = rho & 15; return 8 * (i >> 2) + 4 * n + (i & 3); }

struct Unit { int pm, pn; };
struct Gemm { const bf16_t* A; const bf16_t* Bt; int M, N, K, lda, ldb; };

struct StaticOrder {
    int nM, nN, nwg, G, c;
    __host__ __device__ void init(int M, int N, int G_, int c_) { nM = M / BM; nN = N / BM; nwg = nM * nN; G = G_; c = c_; }
    __host__ __device__ bool next(int i, Unit& u) const {
        const long L = (long)i * G + c; if (L >= nwg) return false;
        int wgid = (int)L; { const int q = nwg / NXCD, r = nwg % NXCD, xcd = wgid % NXCD, off = wgid / NXCD; wgid = (xcd < r ? xcd * (q + 1) : r * (q + 1) + (xcd - r) * q) + off; }
        const int nig = WGM * nN, gid = wgid / nig, fm = gid * WGM, gsz = (nM - fm) < WGM ? (nM - fm) : WGM;
        u.pm = fm + ((wgid % nig) % gsz); u.pn = (wgid % nig) / gsz; return true;
    }
    __device__ __forceinline__ void a_ready(const Unit&) const {}
    __device__ __forceinline__ void done(const Unit&) const {}
};
__device__ __forceinline__ unsigned cvt_pk_bf16(float lo, float hi) { unsigned r; asm volatile("v_cvt_pk_bf16_f32 %0, %1, %2" : "=v"(r) : "v"(lo), "v"(hi)); return r; }
typedef float f32x2 __attribute__((ext_vector_type(2)));
struct EpiBf16 {
    static constexpr bool PERM = true, AFTER_DRAIN = false;
    bf16_t* O; int ldc;
    __device__ __forceinline__ void operator()(const f32x4 (&acc)[2][2][4][2], const Unit& u, int wr, int wc, int fr, int fq) const {
        const int row0 = u.pm * BM + wr * 64 + fr, col0 = u.pn * BM + wc * 32 + 8 * fq;
#pragma unroll
        for (int ai = 0; ai < 2; ++ai)
#pragma unroll
            for (int m = 0; m < 4; ++m) { bf16_t* rowp = O + (size_t)(row0 + ai * HALF + m * 16) * ldc + col0;
#pragma unroll
                for (int bj = 0; bj < 2; ++bj) { const f32x4 v0 = acc[ai][bj][m][0], v1 = acc[ai][bj][m][1];
                    u32x4 w; w.x = cvt_pk_bf16(v0[0], v0[1]); w.y = cvt_pk_bf16(v0[2], v0[3]); w.z = cvt_pk_bf16(v1[0], v1[1]); w.w = cvt_pk_bf16(v1[2], v1[3]);
                    *(u32x4*)(rowp + bj * HALF) = w; } }
    }
};
struct EpiResid {
    static constexpr bool PERM = false, AFTER_DRAIN = false;
    float* X; int ldc; const float* gate;
    __device__ __forceinline__ void operator()(const f32x4 (&acc)[2][2][4][2], const Unit& u, int wr, int wc, int fr, int fq) const {
        const int row0 = u.pm * BM + wr * 64 + fr, col0 = u.pn * BM + wc * 32 + 4 * fq;
        const int cls = (u.pm % 17 == 0) ? 2 : (u.pm / 17);
        const float* gp = gate + (size_t)cls * 12288 + col0;
        f32x4 gv[2][2];
#pragma unroll
        for (int bj = 0; bj < 2; ++bj)
#pragma unroll
            for (int n = 0; n < 2; ++n) gv[bj][n] = *(const f32x4*)(gp + bj * HALF + n * 16);
#pragma unroll
        for (int ai = 0; ai < 2; ++ai)
#pragma unroll
            for (int m = 0; m < 4; ++m) { float* rowp = X + (size_t)(row0 + ai * HALF + m * 16) * ldc + col0;
#pragma unroll
                for (int bj = 0; bj < 2; ++bj)
#pragma unroll
                    for (int n = 0; n < 2; ++n) { f32x4* p = (f32x4*)(rowp + bj * HALF + n * 16); *p = *p + gv[bj][n] * acc[ai][bj][m][n]; } }
    }
};
template <class Epi, class Sched, bool ALIGN_EPI = false, bool SP2 = false>
__device__ __forceinline__ void gemm_phase(PG8_LAS unsigned char* lds, const Gemm g, const Sched& S, const Epi& E) {
    int tid_ = threadIdx.x; asm volatile("" : "+v"(tid_));
    const int tid = tid_, wid = __builtin_amdgcn_readfirstlane(tid >> 6), lane = tid & 63, wr = wid >> 2, wc = wid & 3, fr = lane & 15, fq = lane >> 4;
    const int K = g.K, nt = K / BK;
    unsigned voffA[2], voffB[2];
#pragma unroll
    for (int i = 0; i < 2; ++i) { int R, C; stage_rc(tid * 16 + i * 8192, R, C); const int Rb = Epi::PERM ? ((R & ~31) + perm32(R & 31)) : R;
        voffA[i] = (unsigned)(R * g.lda + C) * 2u; voffB[i] = (unsigned)(Rb * g.ldb + C) * 2u; }
    const size_t kstep = (size_t)(BK * 2);
    const size_t hstepA = (size_t)HALF * g.lda * 2, hstepB = (size_t)HALF * g.ldb * 2;
    const size_t tstepA = 2 * hstepA, tstepB = 2 * hstepB;
    const unsigned ldsw = (unsigned)wid * 1024u;
    const int aoff = lds_byte(wr * 64 + fr, fq * 8), boff = lds_byte(wc * 32 + fr, fq * 8);
#define PG8_SA(b, h) (((b) * 2 + (h)) * HTB)
#define PG8_SB(b, h) ((4 + (b) * 2 + (h)) * HTB)
#define PG8_STAGE(bufoff, gbase, voff) do { _Pragma("unroll") for (int _i = 0; _i < 2; ++_i) \
        __builtin_amdgcn_global_load_lds((const unsigned*)((const char*)(gbase) + (voff)[_i]), (PG8_LAS unsigned*)(lds + (bufoff) + ldsw + _i * 8192), 16, 0, 0); } while (0)
#define PG8_LDA(dst, b, h) do { _Pragma("unroll") for (int m = 0; m < 4; ++m) _Pragma("unroll") for (int k = 0; k < 2; ++k) dst[m][k] = *(const PG8_LAS bf16x8*)(lds + PG8_SA(b, h) + aoff + m * 2048 + k * 1024); } while (0)
#define PG8_LDB(dst, b, h) do { _Pragma("unroll") for (int n = 0; n < 2; ++n) _Pragma("unroll") for (int k = 0; k < 2; ++k) dst[n][k] = *(const PG8_LAS bf16x8*)(lds + PG8_SB(b, h) + boff + n * 2048 + k * 1024); } while (0)
#define PG8_MMA(ai, bj, At, Bt) do { __builtin_amdgcn_s_setprio(1); _Pragma("unroll") for (int m = 0; m < 4; ++m) _Pragma("unroll") for (int n = 0; n < 2; ++n) _Pragma("unroll") for (int k = 0; k < 2; ++k) \
        acc[ai][bj][m][n] = __builtin_amdgcn_mfma_f32_16x16x32_bf16(Bt[n][k], At[m][k], acc[ai][bj][m][n], 0, 0, 0); __builtin_amdgcn_s_setprio(0); } while (0)
#define PG8_WAIT_V(n) asm volatile("s_waitcnt vmcnt(" #n ")" ::: "memory")
#define PG8_WAIT_L(n) asm volatile("s_waitcnt lgkmcnt(" #n ")" ::: "memory")
#define PG8_BAR __builtin_amdgcn_s_barrier()
#define PG8_SCHED __builtin_amdgcn_sched_barrier(0)
    Unit cur, nxt; int ui = 0;
    if (!S.next(0, cur)) return;
    f32x4 acc[2][2][4][2];
#pragma unroll
    for (int a = 0; a < 2; ++a)
#pragma unroll
        for (int b = 0; b < 2; ++b)
#pragma unroll
            for (int m = 0; m < 4; ++m)
#pragma unroll
                for (int n = 0; n < 2; ++n) acc[a][b][m][n] = (f32x4){0.f, 0.f, 0.f, 0.f};
    bf16x8 At[4][2], B0[2][2], B1[2][2];
    const char* cA = (const char*)g.A + (size_t)cur.pm * tstepA; const char* cB = (const char*)g.Bt + (size_t)cur.pn * tstepB;
    S.a_ready(cur);
    if constexpr (SP2) {
        PG8_STAGE(PG8_SB(0, 0), cB, voffB); PG8_STAGE(PG8_SB(0, 1), cB + hstepB, voffB); PG8_STAGE(PG8_SA(0, 0), cA, voffA); PG8_STAGE(PG8_SA(0, 1), cA + hstepA, voffA);
        if (wr == 1) PG8_BAR;
        PG8_WAIT_V(2); PG8_BAR;
        PG8_STAGE(PG8_SB(1, 0), cB + kstep, voffB); PG8_STAGE(PG8_SA(1, 0), cA + kstep, voffA); PG8_STAGE(PG8_SB(1, 1), cB + hstepB + kstep, voffB);
        PG8_WAIT_V(6); PG8_BAR;
    } else {
        PG8_STAGE(PG8_SB(0, 0), cB, voffB); PG8_STAGE(PG8_SA(0, 0), cA, voffA); PG8_STAGE(PG8_SB(0, 1), cB + hstepB, voffB); PG8_STAGE(PG8_SA(0, 1), cA + hstepA, voffA);
        if (wr == 1) PG8_BAR;
        PG8_WAIT_V(4); PG8_BAR;
        PG8_STAGE(PG8_SB(1, 0), cB + kstep, voffB); PG8_STAGE(PG8_SA(1, 0), cA + kstep, voffA); PG8_STAGE(PG8_SB(1, 1), cB + hstepB + kstep, voffB);
        PG8_WAIT_V(6); PG8_BAR;
    }
    for (;;) {
        const bool has_next = S.next(ui + 1, nxt);
        const char* nA = has_next ? (const char*)g.A + (size_t)nxt.pm * tstepA : cA; const char* nB = has_next ? (const char*)g.Bt + (size_t)nxt.pn * tstepB : cB;
        for (int t = 0; t < nt; t += 2) {
            const bool last = (t == nt - 2);
            const char* a1 = cA + (size_t)(t + 1) * kstep;
            const char* a2 = last ? nA : cA + (size_t)(t + 2) * kstep; const char* b2 = last ? nB : cB + (size_t)(t + 2) * kstep;
            const char* a3 = a2 + kstep; const char* b3 = b2 + kstep;
            if (last && has_next) S.a_ready(nxt);
            if constexpr (SP2) {
            PG8_LDB(B0, 0, 0); PG8_LDB(B1, 0, 1); PG8_SCHED; PG8_LDA(At, 0, 0); PG8_STAGE(PG8_SA(1, 1), a1 + hstepA, voffA);
            PG8_WAIT_V(8); PG8_WAIT_L(0); PG8_BAR; PG8_MMA(0, 0, At, B0); PG8_MMA(0, 1, At, B1); PG8_BAR; PG8_SCHED;
            PG8_LDA(At, 0, 1); PG8_STAGE(PG8_SB(0, 0), b2, voffB); PG8_STAGE(PG8_SB(0, 1), b2 + hstepB, voffB); PG8_STAGE(PG8_SA(0, 0), a2, voffA);
            PG8_WAIT_V(8); PG8_WAIT_L(0); PG8_BAR; PG8_MMA(1, 0, At, B0); PG8_MMA(1, 1, At, B1); PG8_BAR; PG8_SCHED;
            PG8_LDB(B0, 1, 0); PG8_LDB(B1, 1, 1); PG8_SCHED; PG8_LDA(At, 1, 0); PG8_STAGE(PG8_SA(0, 1), a2 + hstepA, voffA);
            PG8_WAIT_V(8); PG8_WAIT_L(0); PG8_BAR; PG8_MMA(0, 0, At, B0); PG8_MMA(0, 1, At, B1); PG8_BAR; PG8_SCHED;
            PG8_LDA(At, 1, 1); PG8_STAGE(PG8_SB(1, 0), b3, voffB); PG8_STAGE(PG8_SB(1, 1), b3 + hstepB, voffB); PG8_STAGE(PG8_SA(1, 0), a3, voffA);
            PG8_WAIT_V(8); PG8_WAIT_L(0); PG8_BAR; PG8_MMA(1, 0, At, B0); PG8_MMA(1, 1, At, B1); PG8_BAR; PG8_SCHED;
            } else {
            PG8_LDB(B0, 0, 0); PG8_SCHED; PG8_LDA(At, 0, 0); PG8_STAGE(PG8_SA(1, 1), a1 + hstepA, voffA);
            PG8_WAIT_L(8); PG8_BAR; PG8_WAIT_L(0); PG8_MMA(0, 0, At, B0); PG8_BAR; PG8_SCHED;
            PG8_LDB(B1, 0, 1); PG8_STAGE(PG8_SB(0, 0), b2, voffB);
            PG8_BAR; PG8_WAIT_L(0); PG8_MMA(0, 1, At, B1); PG8_BAR;
            PG8_LDA(At, 0, 1); PG8_STAGE(PG8_SA(0, 0), a2, voffA);
            PG8_BAR; PG8_WAIT_L(0); PG8_MMA(1, 0, At, B0); PG8_BAR; PG8_SCHED;
            PG8_STAGE(PG8_SB(0, 1), b2 + hstepB, voffB);
            PG8_WAIT_V(6); PG8_BAR; PG8_MMA(1, 1, At, B1); PG8_BAR;
            PG8_LDB(B0, 1, 0); PG8_SCHED; PG8_LDA(At, 1, 0); PG8_STAGE(PG8_SA(0, 1), a2 + hstepA, voffA);
            PG8_WAIT_L(8); PG8_BAR; PG8_WAIT_L(0); PG8_MMA(0, 0, At, B0); PG8_BAR; PG8_SCHED;
            PG8_LDB(B1, 1, 1); PG8_STAGE(PG8_SB(1, 0), b3, voffB);
            PG8_BAR; PG8_WAIT_L(0); PG8_MMA(0, 1, At, B1); PG8_BAR;
            PG8_LDA(At, 1, 1); PG8_STAGE(PG8_SA(1, 0), a3, voffA);
            PG8_BAR; PG8_WAIT_L(0); PG8_MMA(1, 0, At, B0); PG8_BAR; PG8_SCHED;
            PG8_STAGE(PG8_SB(1, 1), b3 + hstepB, voffB);
            PG8_WAIT_V(6); PG8_BAR; PG8_MMA(1, 1, At, B1); PG8_BAR;
            }
        }
        if constexpr (ALIGN_EPI) { if (wr == 0) PG8_BAR; }
        if constexpr (!Epi::AFTER_DRAIN) { E(acc, cur, wr, wc, fr, fq); S.done(cur); }
        if (!has_next) break;
#pragma unroll
        for (int a = 0; a < 2; ++a)
#pragma unroll
            for (int b = 0; b < 2; ++b)
#pragma unroll
                for (int m = 0; m < 4; ++m)
#pragma unroll
                    for (int n = 0; n < 2; ++n) acc[a][b][m][n] = (f32x4){0.f, 0.f, 0.f, 0.f};
        cur = nxt; cA = nA; cB = nB; ++ui;
        if constexpr (ALIGN_EPI) { if (wr == 1) PG8_BAR; }
    }
    PG8_WAIT_V(0);
    if constexpr (!ALIGN_EPI) { if (wr == 0) PG8_BAR; }
    PG8_BAR;
    if constexpr (Epi::AFTER_DRAIN) { E.fused(acc, cur, wr, wc, fr, fq, lds, wid, lane); S.done(cur); }
#undef PG8_SA
#undef PG8_SB
#undef PG8_STAGE
#undef PG8_LDA
#undef PG8_LDB
#undef PG8_MMA
#undef PG8_WAIT_V
#undef PG8_WAIT_L
#undef PG8_BAR
#undef PG8_SCHED
}
}
namespace att {
typedef unsigned short bf16_t;
using bf16x8 = __attribute__((ext_vector_type(8))) short;
using s16x4  = __attribute__((ext_vector_type(4))) short;
using f32x16 = __attribute__((ext_vector_type(16))) float;
using u32x4  = __attribute__((ext_vector_type(4))) unsigned;
constexpr int DV = 128, NW = 8, QBLK = 32, KVBLK = 64;
constexpr float THR = 8.f;
constexpr int SHM_V = KVBLK * DV * 2;
template <int DQK> struct Cfg {
    static constexpr int SHM_K = KVBLK * DQK * 2, KROWB = DQK * 2, NCK = DQK / 64, C8 = DQK / 8, ND0 = DQK / 16;
    static constexpr float SCALE = (DQK == 128) ? 0.088388347648318440f : 0.072168783648703220f;
    static constexpr int LDS_BYTES = 2 * SHM_V + 2 * SHM_K + NW * 64 * 4;
};
#define ATT_SBAR() __builtin_amdgcn_sched_barrier(0)
__device__ __forceinline__ int crow(int r, int hi) { return (r & 3) + 8 * (r >> 2) + 4 * hi; }
__device__ __forceinline__ unsigned cvtpk(float lo, float hi) { unsigned r; asm volatile("v_cvt_pk_bf16_f32 %0, %1, %2" : "=v"(r) : "v"(lo), "v"(hi)); return r; }
template <int DQK> __device__ __forceinline__ int kswz(int row, int colB) {
    const int key = (DQK == 128) ? (row & 7) : ((row >> 1) & 7);
    return row * (DQK * 2) + (colB ^ (key << 4));
}
template <int DQK> __device__ __forceinline__ void partialSM(f32x16& p0, f32x16& p1, float& m_reg, float& mn, float& alpha) {
    constexpr float SCALE = Cfg<DQK>::SCALE, C = SCALE * 1.4426950408889634f;
    float pmax = p0[0];
#pragma unroll
    for (int r = 1; r < 16; ++r) pmax = fmaxf(pmax, p0[r]);
#pragma unroll
    for (int r = 0; r < 16; ++r) pmax = fmaxf(pmax, p1[r]);
    { auto rr = __builtin_amdgcn_permlane32_swap(__float_as_uint(pmax), __float_as_uint(pmax), false, false);
      pmax = fmaxf(__uint_as_float(rr[0]), __uint_as_float(rr[1])); }
    if (__builtin_expect(__all(pmax - m_reg <= THR / SCALE), 1)) { mn = m_reg; alpha = 1.f; }
    else { mn = fmaxf(m_reg, pmax); alpha = __builtin_amdgcn_exp2f((m_reg - mn) * C); m_reg = mn; }
    const float mnC = -mn * C;
#pragma unroll
    for (int r = 0; r < 16; ++r) p0[r] = fmaf(p0[r], C, mnC);
#pragma unroll
    for (int r = 0; r < 16; ++r) p1[r] = fmaf(p1[r], C, mnC);
#pragma unroll
    for (int r = 0; r < 16; ++r) p0[r] = __builtin_amdgcn_exp2f(p0[r]);
}
__device__ __forceinline__ void finishSM(f32x16& p0, f32x16& p1, float alpha, float& l_reg, bf16x8& pa0, bf16x8& pa1, bf16x8& pa2, bf16x8& pa3) {
#pragma unroll
    for (int r = 0; r < 16; ++r) p1[r] = __builtin_amdgcn_exp2f(p1[r]);
    float ps = 0;
#pragma unroll
    for (int r = 0; r < 16; ++r) ps += p0[r];
#pragma unroll
    for (int r = 0; r < 16; ++r) ps += p1[r];
    { auto rr = __builtin_amdgcn_permlane32_swap(__float_as_uint(ps), __float_as_uint(ps), false, false);
      ps = __uint_as_float(rr[0]) + __uint_as_float(rr[1]); }
    l_reg = l_reg * alpha + ps;
#define ATT_PK4(P, BASE, OUT) do { unsigned a0 = cvtpk(P[BASE + 0], P[BASE + 1]), a1 = cvtpk(P[BASE + 2], P[BASE + 3]);   \
    unsigned b0 = cvtpk(P[BASE + 4], P[BASE + 5]), b1 = cvtpk(P[BASE + 6], P[BASE + 7]);                              \
    auto r0 = __builtin_amdgcn_permlane32_swap(a0, b0, false, false); auto r1 = __builtin_amdgcn_permlane32_swap(a1, b1, false, false); \
    u32x4 w = {r0[0], r1[0], r0[1], r1[1]}; OUT = *reinterpret_cast<bf16x8*>(&w); } while (0)
    ATT_PK4(p0, 0, pa0); ATT_PK4(p0, 8, pa1); ATT_PK4(p1, 0, pa2); ATT_PK4(p1, 8, pa3);
#undef ATT_PK4
}
template <int DQK> __device__ __forceinline__ void qkt(f32x16& p0, f32x16& p1, const char* Ks, const bf16x8* qr, int r32, int hi) {
    p0 = f32x16{}; p1 = f32x16{};
#pragma unroll
    for (int d0 = 0; d0 < Cfg<DQK>::ND0; ++d0) { const int cb = (d0 * 16 + hi * 8) * 2;
        bf16x8 b0 = *reinterpret_cast<const bf16x8*>(Ks + kswz<DQK>(r32, cb));
        bf16x8 b1 = *reinterpret_cast<const bf16x8*>(Ks + kswz<DQK>(32 + r32, cb));
        p0 = __builtin_amdgcn_mfma_f32_32x32x16_bf16(b0, qr[d0], p0, 0, 0, 0);
        p1 = __builtin_amdgcn_mfma_f32_32x32x16_bf16(b1, qr[d0], p1, 0, 0, 0); }
}
__device__ __forceinline__ int v_st(int k, int c) { const int kk = (k & ~0xC) | ((k & 4) << 1) | ((k & 8) >> 1); return ((kk >> 3) * 4 + (c >> 5)) * 512 + ((kk & 7) * 32 + (c & 31)) * 2; }
__device__ __forceinline__ int v_rd_base(int lane) { return ((lane & 3) << 3) | (((lane >> 2) & 3) << 6) | (((lane >> 4) & 1) << 5) | (((lane >> 5) & 1) << 8); }
constexpr int v_rd_off(int d0, int ks, int half) { return d0 * 512 + ks * 4096 + half * 2048; }
template <int OFF> __device__ __forceinline__ s16x4 tr_read(int vb) {
    s16x4 r; asm volatile("ds_read_b64_tr_b16 %0, %1 offset:%2" : "=&v"(r) : "v"(vb), "i"(OFF) : "memory"); return r;
}
template <int D0> __device__ __forceinline__ void pv_one(f32x16& od, int vb, bf16x8 pa0, bf16x8 pa1, bf16x8 pa2, bf16x8 pa3) {
    const s16x4 l0 = tr_read<v_rd_off(D0, 0, 0)>(vb), h0 = tr_read<v_rd_off(D0, 0, 1)>(vb), l1 = tr_read<v_rd_off(D0, 1, 0)>(vb), h1 = tr_read<v_rd_off(D0, 1, 1)>(vb);
    const s16x4 l2 = tr_read<v_rd_off(D0, 2, 0)>(vb), h2 = tr_read<v_rd_off(D0, 2, 1)>(vb), l3 = tr_read<v_rd_off(D0, 3, 0)>(vb), h3 = tr_read<v_rd_off(D0, 3, 1)>(vb);
    asm volatile("s_waitcnt lgkmcnt(0)" ::: "memory"); ATT_SBAR();
#define ATT_PK(L, H) (bf16x8){L[0], L[1], L[2], L[3], H[0], H[1], H[2], H[3]}
    od = __builtin_amdgcn_mfma_f32_32x32x16_bf16(pa0, ATT_PK(l0, h0), od, 0, 0, 0);
    od = __builtin_amdgcn_mfma_f32_32x32x16_bf16(pa1, ATT_PK(l1, h1), od, 0, 0, 0);
    od = __builtin_amdgcn_mfma_f32_32x32x16_bf16(pa2, ATT_PK(l2, h2), od, 0, 0, 0);
    od = __builtin_amdgcn_mfma_f32_32x32x16_bf16(pa3, ATT_PK(l3, h3), od, 0, 0, 0);
#undef ATT_PK
}
__device__ __forceinline__ void pv_d0(f32x16* o, int vb, bf16x8 pa0, bf16x8 pa1, bf16x8 pa2, bf16x8 pa3) {
    pv_one<0>(o[0], vb, pa0, pa1, pa2, pa3); pv_one<1>(o[1], vb, pa0, pa1, pa2, pa3); pv_one<2>(o[2], vb, pa0, pa1, pa2, pa3); pv_one<3>(o[3], vb, pa0, pa1, pa2, pa3);
}
template <int DQK, int LDQ, int LDK, int LDV, int LDO, int SDEPTH>
__device__ __forceinline__ void attn_body(const bf16_t* __restrict__ Qb, const bf16_t* __restrict__ Kh, const bf16_t* __restrict__ Vh, bf16_t* __restrict__ Ob, int seq, char* lds) {
    using C_ = Cfg<DQK>;
    constexpr int SHM_K = C_::SHM_K, NCK = C_::NCK, C8 = C_::C8, ND0 = C_::ND0;
    int tid_ = threadIdx.x; asm volatile("" : "+v"(tid_));
    const int tid = tid_, wid = tid >> 6, lane = tid & 63, r32 = lane & 31, hi = lane >> 5;
    char* V_lds = lds; char* K_lds = lds + 2 * SHM_V;
    float* ws = (float*)(lds + 2 * SHM_V + 2 * SHM_K) + wid * 64; float* li_l = ws; float* al_l = ws + 32;
    float m_reg = -1e30f, l_reg = 0; f32x16 o[4] = {}; bf16x8 qr[ND0];
    const bf16_t* Qw = Qb + (long)(wid * QBLK + r32) * LDQ + hi * 8;
#pragma unroll
    for (int d0 = 0; d0 < ND0; ++d0) qr[d0] = *reinterpret_cast<const bf16x8*>(Qw + d0 * 16);
    const int sr = tid >> 4, sc = (tid & 15) * 8, vst0 = v_st(sr, sc), vst1 = v_st(32 + sr, sc);
    int krow[NCK], kcol[NCK];
#pragma unroll
    for (int i = 0; i < NCK; ++i) { const int ci = tid + 512 * i; krow[i] = ci / C8; kcol[i] = (ci % C8) * 8; }
    const int vb0 = (int)(uintptr_t)V_lds + v_rd_base(lane);
    struct { bf16x8 vs0, vs1, ks[NCK]; } sr_[SDEPTH];
#define ATT_SLOAD(i, k0) do { sr_[i].vs0 = *reinterpret_cast<const bf16x8*>(&Vh[(long)((k0) + sr) * LDV + sc]); sr_[i].vs1 = *reinterpret_cast<const bf16x8*>(&Vh[(long)((k0) + 32 + sr) * LDV + sc]); \
    _Pragma("unroll") for (int c_ = 0; c_ < NCK; ++c_) sr_[i].ks[c_] = *reinterpret_cast<const bf16x8*>(&Kh[(long)((k0) + krow[c_]) * LDK + kcol[c_]]); } while (0)
#define ATT_SWRITE(b, i) do { *(bf16x8*)(V_lds + (b) * SHM_V + vst0) = sr_[i].vs0; *(bf16x8*)(V_lds + (b) * SHM_V + vst1) = sr_[i].vs1; \
    _Pragma("unroll") for (int c_ = 0; c_ < NCK; ++c_) *(bf16x8*)(K_lds + (b) * SHM_K + kswz<DQK>(krow[c_], kcol[c_] * 2)) = sr_[i].ks[c_]; } while (0)
#define ATT_SWAIT() do { if constexpr (SDEPTH == 2) { if constexpr (NCK == 2) asm volatile("s_waitcnt vmcnt(4)" ::: "memory"); else asm volatile("s_waitcnt vmcnt(5)" ::: "memory"); } else asm volatile("s_waitcnt vmcnt(0)" ::: "memory"); } while (0)
#define ATT_RESC(a) do { if (__any((a) < 1.f)) { if (hi == 0) al_l[r32] = (a); asm volatile("s_waitcnt lgkmcnt(0)" ::: "memory"); \
    _Pragma("unroll") for (int d = 0; d < 4; ++d) _Pragma("unroll") for (int r = 0; r < 16; ++r) o[d][r] *= al_l[crow(r, hi)]; } } while (0)
    f32x16 pA0, pA1, pB0, pB1; float mnA, mnB, alA, alB; bf16x8 pa0, pa1, pa2, pa3; const int NT = seq / KVBLK;
    constexpr int SE = 0, SO = SDEPTH - 1;
    ATT_SLOAD(SE, 0); asm volatile("s_waitcnt vmcnt(0)" ::: "memory"); ATT_SWRITE(0, SE); __syncthreads();
    qkt<DQK>(pA0, pA1, K_lds, qr, r32, hi); partialSM<DQK>(pA0, pA1, m_reg, mnA, alA);
    ATT_SLOAD(SO, KVBLK); if constexpr (SDEPTH == 2) { if (2 < NT) ATT_SLOAD(SE, 2 * KVBLK); }
    ATT_SWAIT(); ATT_SWRITE(1, SO); __syncthreads();
    for (int j = 1; j + 1 < NT; j += 2) {
        ATT_SBAR(); qkt<DQK>(pB0, pB1, K_lds + SHM_K, qr, r32, hi);
        finishSM(pA0, pA1, alA, l_reg, pa0, pa1, pa2, pa3); ATT_SBAR();
        ATT_SLOAD(SO, (j + SDEPTH) * KVBLK); ATT_SBAR();
        pv_d0(o, vb0, pa0, pa1, pa2, pa3); partialSM<DQK>(pB0, pB1, m_reg, mnB, alB);
        __syncthreads(); ATT_SWAIT(); ATT_SWRITE(0, SE);
        ATT_RESC(alB); __syncthreads();
        ATT_SBAR(); qkt<DQK>(pA0, pA1, K_lds, qr, r32, hi);
        finishSM(pB0, pB1, alB, l_reg, pa0, pa1, pa2, pa3); ATT_SBAR();
        if (SDEPTH == 1 || j + 3 < NT) ATT_SLOAD(SE, (j + 1 + SDEPTH) * KVBLK); ATT_SBAR();
        pv_d0(o, vb0 + (int)SHM_V, pa0, pa1, pa2, pa3); partialSM<DQK>(pA0, pA1, m_reg, mnA, alA);
        __syncthreads(); ATT_SWAIT(); ATT_SWRITE(1, SO);
        ATT_RESC(alA); __syncthreads();
    }
    ATT_SBAR(); qkt<DQK>(pB0, pB1, K_lds + SHM_K, qr, r32, hi);
    finishSM(pA0, pA1, alA, l_reg, pa0, pa1, pa2, pa3); ATT_SBAR();
    pv_d0(o, vb0, pa0, pa1, pa2, pa3); partialSM<DQK>(pB0, pB1, m_reg, mnB, alB);
    __syncthreads(); ATT_RESC(alB);
    finishSM(pB0, pB1, alB, l_reg, pa0, pa1, pa2, pa3); ATT_SBAR();
    pv_d0(o, vb0 + (int)SHM_V, pa0, pa1, pa2, pa3);
    if (hi == 0) li_l[r32] = l_reg;
    asm volatile("s_waitcnt lgkmcnt(0)" ::: "memory");
    __syncthreads();
    float rli[16];
#pragma unroll
    for (int r = 0; r < 16; ++r) rli[r] = __builtin_amdgcn_rcpf(li_l[crow(r, hi)]);
    unsigned short* stg = (unsigned short*)(lds + wid * 8192);
#pragma unroll
    for (int r = 0; r < 16; ++r) { const int orow = crow(r, hi);
#pragma unroll
        for (int d0 = 0; d0 < 4; ++d0) { const unsigned w = cvtpk(o[d0][r] * rli[r], 0.f); stg[orow * 128 + d0 * 32 + r32] = (unsigned short)(w & 0xffffu); } }
    asm volatile("s_waitcnt lgkmcnt(0)" ::: "memory");
    bf16_t* Ow = Ob + (long)(wid * QBLK) * LDO;
#pragma unroll
    for (int i = 0; i < 8; ++i) { const int id = lane + 64 * i, row = id >> 4, c16 = id & 15;
        const u32x4 v = *(const u32x4*)((const char*)stg + row * 256 + c16 * 16);
        *(u32x4*)(Ow + (long)row * LDO + c16 * 8) = v; }
    asm volatile("s_waitcnt lgkmcnt(0)" ::: "memory");
    __syncthreads();
#undef ATT_SLOAD
#undef ATT_SWRITE
#undef ATT_SWAIT
#undef ATT_RESC
}

template <int DQK, int LDQ, int LDK, int LDV, int LDO>
__device__ __forceinline__ void attn_body1(const bf16_t* __restrict__ Qb, const bf16_t* __restrict__ Kh, const bf16_t* __restrict__ Vh, bf16_t* __restrict__ Ob, int seq, char* lds) {
    using C_ = Cfg<DQK>;
    constexpr int SHM_K = C_::SHM_K, NCK = C_::NCK, C8 = C_::C8, ND0 = C_::ND0;
    int tid_ = threadIdx.x; asm volatile("" : "+v"(tid_));
    const int tid = tid_, wid = tid >> 6, lane = tid & 63, r32 = lane & 31, hi = lane >> 5;
    char* V_lds = lds; char* K_lds = lds + 2 * SHM_V;
    float* ws = (float*)(lds + 2 * SHM_V + 2 * SHM_K) + wid * 64; float* li_l = ws; float* al_l = ws + 32;
    float m_reg = -1e30f, l_reg = 0; f32x16 o[4] = {}; bf16x8 qr[ND0];
    const bf16_t* Qw = Qb + (long)(wid * QBLK + r32) * LDQ + hi * 8;
#pragma unroll
    for (int d0 = 0; d0 < ND0; ++d0) qr[d0] = *reinterpret_cast<const bf16x8*>(Qw + d0 * 16);
    const int sr = tid >> 4, sc = (tid & 15) * 8, vst0 = v_st(sr, sc), vst1 = v_st(32 + sr, sc);
    int krow[NCK], kcol[NCK];
#pragma unroll
    for (int i = 0; i < NCK; ++i) { const int ci = tid + 512 * i; krow[i] = ci / C8; kcol[i] = (ci % C8) * 8; }
    const int vb0 = (int)(uintptr_t)V_lds + v_rd_base(lane);
    bf16x8 vs0, vs1, ks[NCK];
#define ATT1_SLOAD(k0) do { vs0 = *reinterpret_cast<const bf16x8*>(&Vh[(long)((k0) + sr) * LDV + sc]); vs1 = *reinterpret_cast<const bf16x8*>(&Vh[(long)((k0) + 32 + sr) * LDV + sc]); \
    _Pragma("unroll") for (int c_ = 0; c_ < NCK; ++c_) ks[c_] = *reinterpret_cast<const bf16x8*>(&Kh[(long)((k0) + krow[c_]) * LDK + kcol[c_]]); } while (0)
#define ATT1_SWRITE(b) do { *(bf16x8*)(V_lds + (b) * SHM_V + vst0) = vs0; *(bf16x8*)(V_lds + (b) * SHM_V + vst1) = vs1; \
    _Pragma("unroll") for (int c_ = 0; c_ < NCK; ++c_) *(bf16x8*)(K_lds + (b) * SHM_K + kswz<DQK>(krow[c_], kcol[c_] * 2)) = ks[c_]; } while (0)
    const int NT = seq / KVBLK;
    ATT1_SLOAD(0); asm volatile("s_waitcnt vmcnt(0)" ::: "memory"); ATT1_SWRITE(0); __syncthreads();
    for (int j = 0; j < NT; ++j) {
        const int b = j & 1;
        if (j + 1 < NT) ATT1_SLOAD((j + 1) * KVBLK);
        ATT_SBAR();
        f32x16 p0, p1; float mn, alpha; bf16x8 pa0, pa1, pa2, pa3;
        qkt<DQK>(p0, p1, K_lds + b * SHM_K, qr, r32, hi);
        partialSM<DQK>(p0, p1, m_reg, mn, alpha);
        if (__any(alpha < 1.f)) { if (hi == 0) al_l[r32] = alpha; asm volatile("s_waitcnt lgkmcnt(0)" ::: "memory");
#pragma unroll
            for (int d = 0; d < 4; ++d)
#pragma unroll
                for (int r = 0; r < 16; ++r) o[d][r] *= al_l[crow(r, hi)]; }
        finishSM(p0, p1, alpha, l_reg, pa0, pa1, pa2, pa3); ATT_SBAR();
        pv_d0(o, vb0 + b * (int)SHM_V, pa0, pa1, pa2, pa3);
        if (j + 1 < NT) { ATT1_SWRITE(b ^ 1); }
        __syncthreads();
    }
    if (hi == 0) li_l[r32] = l_reg;
    asm volatile("s_waitcnt lgkmcnt(0)" ::: "memory");
    __syncthreads();
    float rli[16];
#pragma unroll
    for (int r = 0; r < 16; ++r) rli[r] = __builtin_amdgcn_rcpf(li_l[crow(r, hi)]);
    unsigned short* stg = (unsigned short*)(lds + wid * 8192);
#pragma unroll
    for (int r = 0; r < 16; ++r) { const int orow = crow(r, hi);
#pragma unroll
        for (int d0 = 0; d0 < 4; ++d0) { const unsigned w = cvtpk(o[d0][r] * rli[r], 0.f); stg[orow * 128 + d0 * 32 + r32] = (unsigned short)(w & 0xffffu); } }
    asm volatile("s_waitcnt lgkmcnt(0)" ::: "memory");
    bf16_t* Ow = Ob + (long)(wid * QBLK) * LDO;
#pragma unroll
    for (int i = 0; i < 8; ++i) { const int id = lane + 64 * i, row = id >> 4, c16 = id & 15;
        const u32x4 v = *(const u32x4*)((const char*)stg + row * 256 + c16 * 16);
        *(u32x4*)(Ow + (long)row * LDO + c16 * 8) = v; }
    asm volatile("s_waitcnt lgkmcnt(0)" ::: "memory");
    __syncthreads();
#undef ATT1_SLOAD
#undef ATT1_SWRITE
}
}
constexpr int DM = 2048, NBATCH = 2, SEQ = 4096, CTX = 256, RB = SEQ + CTX  , MROWS = NBATCH * RB  ;
constexpr int NMOD = 6 * DM, NEXP = 16384;
constexpr float EPS = 1e-6f;
constexpr int NWAVES = 8, NTHREADS = 512;
constexpr size_t MiB = 1u << 20;
constexpr size_t WS_CTL = 0, CTL_ZERO_BYTES = 64 * 1024;
constexpr size_t WS_MOD = 1 * MiB;
constexpr size_t WS_ROPE = 2 * MiB;
constexpr size_t WS_SMALL = 3 * MiB;
constexpr int SM_N1G = 0, SM_N2G = 8192, SM_AQG = 16384, SM_AKG = 16384 + 384, SM_CW = 16384 + 768, SM_CB = SM_CW + 6144, SM_CQG = SM_CB + 2048, SM_CKG = SM_CQG + 256, SM_END = SM_CKG + 256;
constexpr size_t WS_XW = 4 * MiB;
constexpr size_t WS_H = 72 * MiB;
constexpr size_t WS_P = 106 * MiB;
constexpr size_t WS_QRAW = 174 * MiB;
constexpr size_t WS_KVRAW = 200 * MiB;
constexpr size_t WS_Q = 234 * MiB;
constexpr size_t WS_K = 268 * MiB;
constexpr size_t WS_V = 294 * MiB;
constexpr size_t WS_CAT = 311 * MiB;
constexpr size_t WS_PQ = 345 * MiB;
constexpr size_t WS_IDX = 379 * MiB;
constexpr size_t WS_GATE = 384 * MiB;
constexpr size_t WS_WIN = 389 * MiB;
constexpr size_t WS_WUQ = 421 * MiB;
constexpr size_t WS_WUKV = 424 * MiB;
constexpr size_t WS_WEO = 426 * MiB;
constexpr size_t WS_WQKV = 442 * MiB;
constexpr size_t WS_WCO = 466 * MiB;
constexpr size_t WS_WPQ = 482 * MiB;
constexpr size_t WS_SUBK = 514 * MiB;
constexpr size_t WS_U = 516 * MiB;
constexpr size_t WS_VT = 772 * MiB;
constexpr size_t WS_END = 1028 * MiB;
constexpr int CW_BAR = 4096;
constexpr int LDS_MISC = 131072 + 8192;
constexpr int LDS_BYTES = 147456;

#define LAS __attribute__((address_space(3)))
typedef unsigned short bf16_t;
typedef float f32x4 __attribute__((ext_vector_type(4)));
typedef unsigned u32x4 __attribute__((ext_vector_type(4)));
typedef unsigned u32x2 __attribute__((ext_vector_type(2)));
typedef short bf16x8 __attribute__((ext_vector_type(8)));
typedef float f32x16 __attribute__((ext_vector_type(16)));
typedef __bf16 bf16x2_t __attribute__((ext_vector_type(2)));

__device__ __forceinline__ unsigned f2bf(float f) { unsigned u = __builtin_bit_cast(unsigned, f); return (u + 0x7fffu + ((u >> 16) & 1u)) >> 16; }
__device__ __forceinline__ unsigned pk2(float lo, float hi) { return f2bf(lo) | (f2bf(hi) << 16); }
__device__ __forceinline__ float bf_lo(unsigned w) { return __builtin_bit_cast(float, w << 16); }
__device__ __forceinline__ float bf_hi(unsigned w) { return __builtin_bit_cast(float, w & 0xffff0000u); }
__device__ __forceinline__ float bf2f(bf16_t h) { return __builtin_bit_cast(float, (unsigned)h << 16); }
__device__ __forceinline__ float wave_sum(float v) {
#pragma unroll
    for (int o = 1; o < 64; o <<= 1) v += __shfl_xor(v, o);
    return v;
}
__device__ __forceinline__ float dot2_bf16(unsigned w, unsigned x, float acc) { return __builtin_amdgcn_fdot2_f32_bf16(__builtin_bit_cast(bf16x2_t, w), __builtin_bit_cast(bf16x2_t, x), acc, false); }
__device__ __forceinline__ float gelu_erf(float v) {
    const float av = fabsf(v), t = __builtin_amdgcn_rcpf(av * 0.2316418882f + 1.0f);
    float q = t * 0.5307027145f + (-0.7265760135f); q = q * t + 0.7107068705f; q = q * t + (-0.142248368f); q = q * t + 0.127414796f; q = q * t;
    const float e = __builtin_amdgcn_exp2f((v * v) * (-0.72134752044f));
    const float m = v * (q * e);
    return v < 0.f ? m : v - m;
}
#define XB_TMO      128
#define XB_XCNT(j)  (256  + 64 * (j))
#define XB_XSUB(j)  (1280 + 64 * (j))
#define XB_XGEN(j)  (2304 + 64 * (j))
#define XB_TOP      3328
#define XB_TOPGEN   3392
#define XCD_BAR_WORDS 3456
#define XB_SPIN_CAP (1u << 18)

__device__ __forceinline__ unsigned xb_ld(unsigned* p)              { return __hip_atomic_load(p, __ATOMIC_RELAXED, __HIP_MEMORY_SCOPE_AGENT); }
__device__ __forceinline__ unsigned xb_add(unsigned* p, unsigned v) { return __hip_atomic_fetch_add(p, v, __ATOMIC_RELAXED, __HIP_MEMORY_SCOPE_AGENT); }
__device__ __forceinline__ unsigned xb_xcc_id() { return (unsigned)__builtin_amdgcn_s_getreg((3 << 11) | 20) & 0xFu; }
#define XB_SPIN(cond, bar) do { unsigned _sp = 0; while (cond) { __builtin_amdgcn_s_sleep(1); \
    if ((++_sp & 255u) == 0u) { if (xb_ld(&(bar)[XB_TMO])) break; if (_sp > XB_SPIN_CAP) { atomicAdd(&(bar)[XB_TMO], 1u); break; } } } } while (0)

struct XcdBarrier {
    unsigned* bar; unsigned x;
    volatile LAS unsigned* st;
};

__device__ __forceinline__ XcdBarrier xcd_barrier_post(unsigned* bar, volatile LAS unsigned* st) {
    XcdBarrier b; b.bar = bar; b.x = xb_xcc_id(); b.st = st;
    if (threadIdx.x == 0) (void)xb_add(&bar[XB_XCNT(b.x)], 1u);
    return b;
}
__device__ __forceinline__ void xcd_barrier_complete(unsigned* bar, unsigned x, unsigned& nloc, unsigned& nx) {
    const unsigned G = gridDim.x * gridDim.y * gridDim.z;
    unsigned sum, cnt, mine, sp = 0u;
    for (;;) {
        sum = 0u; cnt = 0u; mine = 0u;
#pragma unroll
        for (unsigned j = 0; j < 16; ++j) { const unsigned c = xb_ld(&bar[XB_XCNT(j)]); sum += c; cnt += (c > 0u) ? 1u : 0u; mine = (j == x) ? c : mine; }
        if (sum == G) break;
        __builtin_amdgcn_s_sleep(1);
        if ((++sp & 255u) == 0u) { if (xb_ld(&bar[XB_TMO])) break; if (sp > XB_SPIN_CAP) { atomicAdd(&bar[XB_TMO], 1u); break; } }
    }
    nloc = mine > 0u ? mine : 1u; nx = cnt > 0u ? cnt : 1u;
}

__device__ __forceinline__ void xcd_barrier(const XcdBarrier& b) {
    asm volatile("s_waitcnt vmcnt(0)" ::: "memory");
    __syncthreads();
    if (threadIdx.x == 0) {
        unsigned* bar = b.bar; unsigned bx = b.x;
        asm volatile("" : "+s"(bar), "+s"(bx));
        __builtin_amdgcn_s_waitcnt(0);
        unsigned nloc = b.st[0], nx = b.st[1];
        if (nloc == 0u) { xcd_barrier_complete(bar, bx, nloc, nx); b.st[0] = nloc; b.st[1] = nx; }
        const unsigned old = xb_add(&bar[XB_XSUB(bx)], 1u);
        const unsigned gen = old / nloc;
        if (old + 1u == (gen + 1u) * nloc) {
            __builtin_amdgcn_fence(__ATOMIC_RELEASE, "agent");
            asm volatile("s_waitcnt vmcnt(0)" ::: "memory");
            const unsigned og = xb_add(&bar[XB_TOP], 1u);
            const unsigned tg = og / nx;
            if (og + 1u == (tg + 1u) * nx) xb_add(&bar[XB_TOPGEN], 1u);
            else XB_SPIN(xb_ld(&bar[XB_TOPGEN]) == tg, bar);
            __builtin_amdgcn_fence(__ATOMIC_ACQUIRE, "agent");
            xb_add(&bar[XB_XGEN(bx)], 1u);
            asm volatile("s_waitcnt vmcnt(0)" ::: "memory");
        } else {
            XB_SPIN(xb_ld(&bar[XB_XGEN(bx)]) == gen, bar);
            __builtin_amdgcn_fence(__ATOMIC_ACQUIRE, "agent");
            asm volatile("s_waitcnt vmcnt(0)" ::: "memory");
        }
    }
    __syncthreads();
}
struct Frame {
    LAS unsigned char* lds;
    int tid, lane, wave, vcu, G, gw, NGW;
    unsigned char* ws;
};
__device__ __forceinline__ int opaque_v(int v) { asm volatile("" : "+v"(v)); return v; }
__device__ __forceinline__ Frame phase_frame(const Frame& F0) { Frame F = F0; F.tid = opaque_v(F0.tid); F.lane = F.tid & 63; return F; }
__device__ __forceinline__ int row_cls(int row) { const int b = row / RB, i = row - b * RB; return i < CTX ? 2 : b; }

__device__ __forceinline__ void p0_transpose_item(const float* W, int K, int N, bf16_t* WT, const float* gain, LAS float* scr, int item, int lane) {
    const int nblk = N / 32, kb = item / nblk, nb = item % nblk, k0 = 64 * kb, n0 = 32 * nb;
#pragma unroll 8
    for (int i = 0; i < 32; ++i) { const int kk = 2 * i + (lane >> 5); float v = W[(size_t)(k0 + kk) * N + n0 + (lane & 31)]; if (gain) v *= gain[k0 + kk]; scr[kk * 33 + (lane & 31)] = v; }
    asm volatile("s_waitcnt lgkmcnt(0)" ::: "memory");
    const int c = lane & 7;
#pragma unroll
    for (int j = 0; j < 4; ++j) { const int n = (lane >> 3) + 8 * j; const LAS float* s = scr + (8 * c) * 33 + n;
        u32x4 o; o.x = pk2(s[0 * 33], s[1 * 33]); o.y = pk2(s[2 * 33], s[3 * 33]); o.z = pk2(s[4 * 33], s[5 * 33]); o.w = pk2(s[6 * 33], s[7 * 33]);
        *(u32x4*)(WT + (size_t)(n0 + n) * K + k0 + 8 * c) = o; }
    asm volatile("s_waitcnt lgkmcnt(0)" ::: "memory");
}
struct TrDesc { const float* W; const float* gain; bf16_t* WT; int K, N, items; };

__device__ __forceinline__ void p0_gemv_task(Frame& F, int task, const float* ada_w, const float* ada_b, float* mod) {
    LAS float* sv = (LAS float*)F.lds; LAS float* part = (LAS float*)(F.lds + 32768);
    const int l = task / 48, n0 = (task % 48) * 256;
    const float* Wp = ada_w + (size_t)l * DM * NMOD + n0 + F.lane * 4 + (size_t)(F.wave * 256) * NMOD;
    f32x4 a0 = {0, 0, 0, 0}, a1 = a0, a2 = a0;
    for (int k = 0; k < 256; k += 8) {
        f32x4 w[8];
#pragma unroll
        for (int u = 0; u < 8; ++u) w[u] = *(const f32x4*)(Wp + (size_t)(k + u) * NMOD);
#pragma unroll
        for (int u = 0; u < 8; ++u) { const int kk = F.wave * 256 + k + u; const float s0 = sv[kk], s1 = sv[2048 + kk], s2 = sv[4096 + kk];
            a0 += w[u] * s0; a1 += w[u] * s1; a2 += w[u] * s2; }
    }
    *(LAS f32x4*)(part + (F.wave * 3 + 0) * 256 + F.lane * 4) = a0;
    *(LAS f32x4*)(part + (F.wave * 3 + 1) * 256 + F.lane * 4) = a1;
    *(LAS f32x4*)(part + (F.wave * 3 + 2) * 256 + F.lane * 4) = a2;
    __syncthreads();
    for (int o = F.tid; o < 768; o += NTHREADS) { const int r = o >> 8, c = o & 255; float s = 0.f;
#pragma unroll
        for (int w = 0; w < 8; ++w) s += part[(w * 3 + r) * 256 + c];
        mod[(size_t)(l * 3 + r) * NMOD + n0 + c] = s + ada_b[(size_t)l * NMOD + n0 + c]; }
    __syncthreads();
}

__device__ __forceinline__ void p0_prologue(Frame& F, const float* const* in) {
    unsigned char* ws = F.ws;
    {
        LAS float* sv = (LAS float*)F.lds;
        for (int i = F.tid; i < 3 * DM; i += NTHREADS) { const int r = i / DM, k = i - r * DM; const float x = (r < 2) ? in[1][r * DM + k] : in[3][k]; sv[i] = x / (1.f + __expf(-x)); }
        __syncthreads();
        for (int task = F.vcu; task < 192; task += F.G) p0_gemv_task(F, task, in[4], in[5], (float*)(ws + WS_MOD));
        __syncthreads();
    }
    {
        float* xw = (float*)(ws + WS_XW);
        for (int row = F.gw; row < MROWS; row += F.NGW) { const int b = row / RB, i = row - b * RB;
            const float* src = (i < CTX) ? in[2] + (size_t)(b * CTX + i) * DM : in[0] + (size_t)(b * SEQ + i - CTX) * DM;
            const f32x4* s4 = (const f32x4*)src + F.lane; f32x4* d4 = (f32x4*)(xw + (size_t)row * DM) + F.lane;
#pragma unroll
            for (int j = 0; j < 8; ++j) d4[64 * j] = s4[64 * j]; }
    }
    {
        float* sm = (float*)(ws + WS_SMALL); const int g = F.vcu * NTHREADS + F.tid;
        if (g < 8192) { sm[SM_N1G + g] = in[6][g]; sm[SM_N2G + g] = in[7][g]; }
        if (g < 384) { sm[SM_AQG + g] = in[13][g]; sm[SM_AKG + g] = in[14][g]; }
        if (g < 6144) sm[SM_CW + g] = in[15][g];
        if (g < 2048) sm[SM_CB + g] = in[16][g];
        if (g < 256) { sm[SM_CQG + g] = in[19][g]; sm[SM_CKG + g] = in[20][g]; }
    }
    {
        float* rc = (float*)(ws + WS_ROPE); float* ra = rc + 64 * 32 * 2;
        const int g = F.vcu * NTHREADS + F.tid;
        if (g < 64 * 32) { const int pos = g >> 5, f = g & 31; const float fr = exp2f(-(float)f * (13.287712379549449f / 32.f)); const float ang = (float)pos * fr;
            rc[2 * g] = cosf(ang); rc[2 * g + 1] = sinf(ang); }
        else if (g < 64 * 32 + 64 * 16) { const int e = g - 64 * 32, pos = e >> 4, f = e & 15; const float fr = exp2f(-(float)f * (13.287712379549449f / 16.f)); const float ang = (float)pos * fr;
            ra[2 * e] = cosf(ang); ra[2 * e + 1] = sinf(ang); }
    }
    {
        LAS float* scr = (LAS float*)(F.lds + F.wave * 16384);
        TrDesc d[16]; int nd = 0;
#pragma unroll
        for (int i = 0; i < 2; ++i) {
            d[nd++] = TrDesc{in[8] + (size_t)i * DM * 3904, nullptr, (bf16_t*)(ws + WS_WIN) + (size_t)i * 4096 * DM, DM, 3904, 32 * 122};
            d[nd++] = TrDesc{in[11] + (size_t)i * 512 * 1536, in[9] + i * 512, (bf16_t*)(ws + WS_WUQ) + (size_t)i * 1536 * 512, 512, 1536, 8 * 48};
            d[nd++] = TrDesc{in[12] + (size_t)i * 256 * 2048, in[10] + i * 256, (bf16_t*)(ws + WS_WUKV) + (size_t)i * 2048 * 256, 256, 2048, 4 * 64};
            d[nd++] = TrDesc{in[17] + (size_t)i * DM * DM, nullptr, (bf16_t*)(ws + WS_WEO) + (size_t)i * DM * DM, DM, DM, 32 * 64};
            d[nd++] = TrDesc{in[18] + (size_t)i * DM * 3072, nullptr, (bf16_t*)(ws + WS_WQKV) + (size_t)i * 3072 * DM, DM, 3072, 32 * 96};
            d[nd++] = TrDesc{in[21] + (size_t)i * DM * DM, nullptr, (bf16_t*)(ws + WS_WCO) + (size_t)i * DM * DM, DM, DM, 32 * 64};
        }
#pragma unroll
        for (int l = 0; l < 4; ++l) d[nd++] = TrDesc{in[22] + (size_t)l * DM * DM, nullptr, (bf16_t*)(ws + WS_WPQ) + (size_t)l * DM * DM, DM, DM, 32 * 64};
#pragma unroll
        for (int m = 0; m < 16; ++m) {
            for (int it = F.gw; it < d[m].items; it += F.NGW) p0_transpose_item(d[m].W, d[m].K, d[m].N, d[m].WT, d[m].gain, scr, it, F.lane);
        }
        for (int i = F.gw * 64 + F.lane; i < 2 * 192 * DM / 8; i += F.NGW * 64) { const int li = i / (192 * DM / 8), r = i % (192 * DM / 8);
            *(u32x4*)((bf16_t*)(ws + WS_WIN) + (size_t)li * 4096 * DM + (size_t)3904 * DM + (size_t)r * 8) = (u32x4){0u, 0u, 0u, 0u}; }
    }
    {
        const size_t n_sk = (size_t)4 * 16 * 128 * 128 / 8, n_tab = (size_t)4 * NEXP * DM / 8;
        const size_t gt = (size_t)F.vcu * NTHREADS + F.tid, GT = (size_t)F.G * NTHREADS;
        for (size_t i = gt; i < n_sk + 2 * n_tab; i += GT) {
            const float* src; bf16_t* dst; size_t j;
            if (i < n_sk) { src = in[23]; dst = (bf16_t*)(ws + WS_SUBK); j = i; }
            else if (i < n_sk + n_tab) { src = in[24]; dst = (bf16_t*)(ws + WS_U); j = i - n_sk; }
            else { src = in[25]; dst = (bf16_t*)(ws + WS_VT); j = i - n_sk - n_tab; }
            const f32x4 a = *(const f32x4*)(src + j * 8), b = *(const f32x4*)(src + j * 8 + 4);
            u32x4 o; o.x = pk2(a.x, a.y); o.y = pk2(a.z, a.w); o.z = pk2(b.x, b.y); o.w = pk2(b.z, b.w);
            *(u32x4*)(dst + j * 8) = o;
        }
    }
}

__device__ __forceinline__ void norm_phase(const Frame& F0, const float* xw, const float* g, const float* modl  , int off_sh, int off_sc, bf16_t* H) {
    const Frame F = phase_frame(F0);
    for (int row = F.gw; row < MROWS; row += F.NGW) {
        const int cls = row_cls(row);
        const f32x4* x4 = (const f32x4*)(xw + (size_t)row * DM) + F.lane;
        f32x4 v[8]; float ss = 0.f;
#pragma unroll
        for (int j = 0; j < 8; ++j) { v[j] = x4[64 * j]; ss += (v[j].x * v[j].x + v[j].y * v[j].y) + (v[j].z * v[j].z + v[j].w * v[j].w); }
        const float rstd = 1.0f / sqrtf(wave_sum(ss) * (1.f / DM) + EPS);
        const f32x4* g4 = (const f32x4*)g + F.lane; const f32x4* sc4 = (const f32x4*)(modl + (size_t)cls * NMOD + off_sc) + F.lane; const f32x4* sh4 = (const f32x4*)(modl + (size_t)cls * NMOD + off_sh) + F.lane;
        u32x2* o2 = (u32x2*)(H + (size_t)row * DM) + F.lane;
#pragma unroll
        for (int j = 0; j < 8; ++j) { const f32x4 gg = g4[64 * j], sc = sc4[64 * j], sh = sh4[64 * j];
            const f32x4 y = (v[j] * rstd) * gg * (sc + 1.0f) + sh;
            u32x2 o; o.x = pk2(y.x, y.y); o.y = pk2(y.z, y.w); o2[64 * j] = o; }
    }
}

__device__ __forceinline__ void prep_odd_phase(const Frame& F0, const bf16_t* P, const float* qg, const float* kg, const float* rope_c, bf16_t* Q, bf16_t* Kb) {
    const Frame F = phase_frame(F0);
    const float g_q1 = qg[F.lane], g_q2 = qg[F.lane + 64], g_k1 = kg[F.lane], g_k2 = kg[F.lane + 64];
    for (int row = F.gw; row < MROWS; row += F.NGW) {
        const int b = row / RB, i = row - b * RB; const bool lat = i >= CTX; const int t = i - CTX;
        float cs = 1.f, sn = 0.f;
        if (lat) { const int pos = (F.lane < 32) ? (t >> 6) : (t & 63); const float* e = rope_c + ((pos << 5) + (F.lane & 31)) * 2; cs = e[0]; sn = e[1]; }
        const bf16_t* pr = P + (size_t)row * 3072;
#pragma unroll 4
        for (int hh = 0; hh < 20; ++hh) {
            const bool isq = hh < 16; const bf16_t* src = pr + hh * 128;
            const float x1 = bf2f(src[F.lane]), x2 = bf2f(src[F.lane + 64]);
            const float rstd = 1.0f / sqrtf(wave_sum(x1 * x1 + x2 * x2) * (1.f / 128.f) + EPS);
            const float y1 = x1 * rstd * (isq ? g_q1 : g_k1), y2 = x2 * rstd * (isq ? g_q2 : g_k2);
            const float o1 = y1 * cs - y2 * sn, o2 = y2 * cs + y1 * sn;
            bf16_t* dst = isq ? (Q + (size_t)row * 2048 + hh * 128) : (Kb + (size_t)row * 512 + (hh - 16) * 128);
            dst[F.lane] = (bf16_t)f2bf(o1); dst[F.lane + 64] = (bf16_t)f2bf(o2);
        }
    }
}

__device__ __forceinline__ void prep_even_phase(const Frame& F0, const bf16_t* P, const bf16_t* QR, const bf16_t* KVR, const float* qg, const float* kg, const float* rope_a, bf16_t* Q, bf16_t* Kb, bf16_t* Vb) {
    const Frame F = phase_frame(F0);
    const float gq0 = qg[F.lane], gq1 = qg[F.lane + 64], gq2 = qg[F.lane + 128], gk0 = kg[F.lane], gk1 = kg[F.lane + 64], gk2 = kg[F.lane + 128];
    for (int row = F.gw; row < MROWS; row += F.NGW) {
        const int b = row / RB, i = row - b * RB; const bool lat = i >= CTX; const int t = i - CTX;
        float cs = 1.f, sn = 0.f;
        if (lat) { const int j = F.lane & 31; const int pos = (j < 16) ? (t >> 6) : (t & 63); const float* e = rope_a + ((pos << 4) + (j & 15)) * 2; cs = e[0]; sn = e[1]; }
        const float sgn = (F.lane < 32) ? -1.f : 1.f;
        const bf16_t* pr = P + (size_t)row * 4096;
        float ssq = 0.f, sskv = 0.f;
        { const u32x4 w = *(const u32x4*)(pr + F.lane * 8); const unsigned ww[4] = {w.x, w.y, w.z, w.w};
#pragma unroll
          for (int q = 0; q < 4; ++q) { const float a = bf_lo(ww[q]), c = bf_hi(ww[q]); ssq += a * a + c * c; } }
        { const u32x2 w = *(const u32x2*)(pr + 512 + F.lane * 4); const float a = bf_lo(w.x), c = bf_hi(w.x), d = bf_lo(w.y), e = bf_hi(w.y); sskv = (a * a + c * c) + (d * d + e * e); }
        const float rstd_q = 1.0f / sqrtf(wave_sum(ssq) * (1.f / 512.f) + EPS), rstd_kv = 1.0f / sqrtf(wave_sum(sskv) * (1.f / 256.f) + EPS);
        const float kr = bf2f(pr[768 + F.lane]);
        const bf16_t* qr = QR + (size_t)row * 1536; const bf16_t* kvr = KVR + (size_t)row * 2048;
        bf16_t* qo = Q + (size_t)row * 1536; bf16_t* ko = Kb + (size_t)row * 1536; bf16_t* vo = Vb + (size_t)row * 1024;
#pragma unroll 2
        for (int h = 0; h < 8; ++h) {
            {
                const float x0 = bf2f(qr[h * 192 + F.lane]) * rstd_q, x1 = bf2f(qr[h * 192 + 64 + F.lane]) * rstd_q, x2 = bf2f(qr[h * 192 + 128 + F.lane]) * rstd_q;
                const float r2 = 1.0f / sqrtf(wave_sum(x0 * x0 + x1 * x1 + x2 * x2) * (1.f / 192.f) + EPS);
                const float y0 = x0 * r2 * gq0, y1 = x1 * r2 * gq1, y2 = x2 * r2 * gq2;
                const float yp = __shfl_xor(y2, 32);
                const float o2 = y2 * cs + sgn * yp * sn;
                qo[h * 192 + F.lane] = (bf16_t)f2bf(y0); qo[h * 192 + 64 + F.lane] = (bf16_t)f2bf(y1); qo[h * 192 + 128 + F.lane] = (bf16_t)f2bf(o2);
            }
            {
                const float x0 = bf2f(kvr[h * 256 + F.lane]) * rstd_kv, x1 = bf2f(kvr[h * 256 + 64 + F.lane]) * rstd_kv;
                const float r2 = 1.0f / sqrtf(wave_sum(x0 * x0 + x1 * x1 + kr * kr) * (1.f / 192.f) + EPS);
                const float y0 = x0 * r2 * gk0, y1 = x1 * r2 * gk1, y2 = kr * r2 * gk2;
                const float yp = __shfl_xor(y2, 32);
                const float o2 = y2 * cs + sgn * yp * sn;
                ko[h * 192 + F.lane] = (bf16_t)f2bf(y0); ko[h * 192 + 64 + F.lane] = (bf16_t)f2bf(y1); ko[h * 192 + 128 + F.lane] = (bf16_t)f2bf(o2);
                const float v0 = bf2f(kvr[h * 256 + 128 + F.lane]) * rstd_kv, v1 = bf2f(kvr[h * 256 + 192 + F.lane]) * rstd_kv;
                vo[h * 128 + F.lane] = (bf16_t)f2bf(v0); vo[h * 128 + 64 + F.lane] = (bf16_t)f2bf(v1);
            }
        }
    }
}

__device__ __forceinline__ void conv_phase(const Frame& F0, const bf16_t* P, const float* cw  , const float* cb  , bf16_t* CAT) {
    const Frame F = phase_frame(F0);
    const int gt = F.vcu * NTHREADS + F.tid, GT = F.G * NTHREADS;
    for (int it = gt; it < MROWS * 128; it += GT) {
        const int row = it >> 7, c0 = (it & 127) * 8; const int b = row / RB, i = row - b * RB;
        const bool first = (i == 0) || (i == CTX), last = (i == CTX - 1) || (i == RB - 1);
        const bf16_t* pr = P + (size_t)row * 4096 + 832 + c0;
        const u32x4 bg = *(const u32x4*)pr, cg = *(const u32x4*)(pr + 1024), hz = *(const u32x4*)(pr + 2048);
        u32x4 cgm = {0u, 0u, 0u, 0u}, hzm = cgm, cgp = cgm, hzp = cgm;
        if (!first) { cgm = *(const u32x4*)(pr - 4096 + 1024); hzm = *(const u32x4*)(pr - 4096 + 2048); }
        if (!last) { cgp = *(const u32x4*)(pr + 4096 + 1024); hzp = *(const u32x4*)(pr + 4096 + 2048); }
        const unsigned bgw[4] = {bg.x, bg.y, bg.z, bg.w}, cgw[4] = {cg.x, cg.y, cg.z, cg.w}, hzw[4] = {hz.x, hz.y, hz.z, hz.w};
        const unsigned cmw[4] = {cgm.x, cgm.y, cgm.z, cgm.w}, hmw[4] = {hzm.x, hzm.y, hzm.z, hzm.w}, cpw[4] = {cgp.x, cgp.y, cgp.z, cgp.w}, hpw[4] = {hzp.x, hzp.y, hzp.z, hzp.w};
        unsigned ow[4];
#pragma unroll
        for (int q = 0; q < 4; ++q) {
            const int c = c0 + 2 * q;
            const float u0a = bf_lo(cgw[q]) * bf_lo(hzw[q]), u0b = bf_hi(cgw[q]) * bf_hi(hzw[q]);
            const float uma = bf_lo(cmw[q]) * bf_lo(hmw[q]), umb = bf_hi(cmw[q]) * bf_hi(hmw[q]);
            const float upa = bf_lo(cpw[q]) * bf_lo(hpw[q]), upb = bf_hi(cpw[q]) * bf_hi(hpw[q]);
            const float ra = bf_lo(bgw[q]) * (uma * cw[c] + u0a * cw[1024 + c] + upa * cw[2048 + c] + cb[c]);
            const float rb = bf_hi(bgw[q]) * (umb * cw[c + 1] + u0b * cw[1024 + c + 1] + upb * cw[2048 + c + 1] + cb[c + 1]);
            ow[q] = pk2(ra, rb);
        }
        *(u32x4*)(CAT + (size_t)row * DM + 1024 + c0) = (u32x4){ow[0], ow[1], ow[2], ow[3]};
    }
}
__device__ __forceinline__ void attn_even_phase(const Frame& F0, const bf16_t* Q, const bf16_t* Kb, const bf16_t* Vb, bf16_t* CAT) {
    const Frame F = phase_frame(F0);
    for (int u = F.vcu; u < 272; u += F.G) {
        int b, h, qt, nk;
        if (u < 256) { b = u >> 7; h = (u >> 4) & 7; qt = 1 + (u & 15); nk = RB; } else { const int v = u - 256; b = v >> 3; h = v & 7; qt = 0; nk = CTX; }
        const size_t r0 = (size_t)b * RB;
        att::attn_body1<192, 1536, 1536, 1024, 2048>(Q + (r0 + qt * 256) * 1536 + h * 192, Kb + r0 * 1536 + h * 192, Vb + r0 * 1024 + h * 128, CAT + (r0 + qt * 256) * 2048 + h * 128, nk, (char*)F.lds);
    }
}
__device__ __forceinline__ void attn_odd_phase(const Frame& F0, const bf16_t* Q, const bf16_t* Kb, const bf16_t* P, bf16_t* CAT) {
    const Frame F = phase_frame(F0);
    for (int u = F.vcu; u < 544; u += F.G) {
        int b, hq, qt, nk;
        if (u < 512) { b = u >> 8; hq = (u >> 4) & 15; qt = 1 + (u & 15); nk = RB; } else { const int v = u - 512; b = v >> 4; hq = v & 15; qt = 0; nk = CTX; }
        const int kvh = hq >> 2; const size_t r0 = (size_t)b * RB;
        att::attn_body1<128, 2048, 512, 3072, 2048>(Q + (r0 + qt * 256) * 2048 + hq * 128, Kb + r0 * 512 + kvh * 128, P + r0 * 3072 + 2560 + kvh * 128, CAT + (r0 + qt * 256) * 2048 + hq * 128, nk, (char*)F.lds);
    }
}

__device__ __forceinline__ int crow32(int r, int hi) { return (r & 3) + 8 * (r >> 2) + 4 * hi; }
__device__ __forceinline__ float swapmax(float m) { auto rr = __builtin_amdgcn_permlane32_swap(__float_as_uint(m), __float_as_uint(m), false, false); return fmaxf(__uint_as_float(rr[0]), __uint_as_float(rr[1])); }
__device__ __forceinline__ void peer_topk_phase(const Frame& F0, const bf16_t* PQ, const bf16_t* subk  , int* IDX, float* GATE) {
    const Frame F = phase_frame(F0);
    const float NEG = -3.0e38f;
    for (int task = F.gw; task < (MROWS / 32) * 8; task += F.NGW) {
        int lane_ = F.lane; asm volatile("" : "+v"(lane_));
        const int r32 = lane_ & 31, hi = lane_ >> 5;
        const int tg = task >> 3, h = task & 7; const int token = tg * 32 + r32;
        float top[2][16];
#pragma unroll
        for (int j = 0; j < 16; ++j) { top[0][j] = NEG; top[1][j] = NEG; }
#pragma unroll
        for (int p = 0; p < 2; ++p) {
            bf16x8 bq[8];
            const bf16_t* qp = PQ + (size_t)token * DM + h * 256 + p * 128 + hi * 8;
#pragma unroll
            for (int ks = 0; ks < 8; ++ks) bq[ks] = *(const bf16x8*)(qp + ks * 16);
            const bf16_t* kp = subk + (size_t)(h * 2 + p) * 128 * 128 + (size_t)r32 * 128 + hi * 8;
            float s[64];
#pragma unroll
            for (int nb = 0; nb < 4; ++nb) {
                f32x16 acc = {};
#pragma unroll
                for (int ks = 0; ks < 8; ++ks) { const bf16x8 a = *(const bf16x8*)(kp + (size_t)nb * 32 * 128 + ks * 16); acc = __builtin_amdgcn_mfma_f32_32x32x16_bf16(a, bq[ks], acc, 0, 0, 0); }
#pragma unroll
                for (int r = 0; r < 16; ++r) { const int key = nb * 32 + crow32(r, hi); s[nb * 16 + r] = __uint_as_float((__float_as_uint(acc[r]) & ~127u) | (unsigned)(127 - key)); }
                asm volatile("" ::: "memory");
            }
#pragma unroll 1
            for (int it = 0; it < 16; ++it) {
                float m = s[0];
#pragma unroll
                for (int i = 1; i < 64; ++i) m = fmaxf(m, s[i]);
                m = swapmax(m);
#pragma unroll
                for (int i = 0; i < 64; ++i) s[i] = (s[i] == m) ? NEG : s[i];
#pragma unroll
                for (int j = 0; j < 16; ++j) top[p][j] = (j == it) ? m : top[p][j];
            }
        }
        float cand[25];
        {
            int n = 0;
#pragma unroll
            for (int a = 0; a < 16; ++a)
#pragma unroll
                for (int b = 0; b < 16; ++b) if ((a + 1) * (b + 1) <= 16) {
                    const int slot = n >> 1, which = n & 1; ++n;
                    const float v = top[0][a] + top[1][b];
                    const float pv = __uint_as_float((__float_as_uint(v) & ~255u) | (unsigned)(255 - (a * 16 + b)));
                    if (which == 0) cand[slot] = pv; else cand[slot] = hi ? pv : cand[slot];
                }
        }
        float win[16];
#pragma unroll
        for (int j = 0; j < 16; ++j) win[j] = NEG;
#pragma unroll 1
        for (int it = 0; it < 16; ++it) {
            float m = cand[0];
#pragma unroll
            for (int i = 1; i < 25; ++i) m = fmaxf(m, cand[i]);
            m = swapmax(m);
#pragma unroll
            for (int i = 0; i < 25; ++i) cand[i] = (cand[i] == m) ? NEG : cand[i];
#pragma unroll
            for (int j = 0; j < 16; ++j) win[j] = (j == it) ? m : win[j];
        }
        float ev[16]; float esum = 0.f; const float v0 = __uint_as_float(__float_as_uint(win[0]) & ~255u);
#pragma unroll
        for (int j = 0; j < 16; ++j) { const float v = __uint_as_float(__float_as_uint(win[j]) & ~255u); ev[j] = __expf(v - v0); esum += ev[j]; }
        const float rs = 1.0f / esum;
        int oi[8]; float og[8];
#pragma unroll
        for (int j = 0; j < 8; ++j) {
            const float w = hi ? win[8 + j] : win[j]; const float e = hi ? ev[8 + j] : ev[j];
            const int id = 255 - (int)(__float_as_uint(w) & 255u), a = id >> 4, b = id & 15;
            float ta = top[0][0], tb = top[1][0];
#pragma unroll
            for (int q = 1; q < 16; ++q) { ta = (a == q) ? top[0][q] : ta; tb = (b == q) ? top[1][q] : tb; }
            const int ka = 127 - (int)(__float_as_uint(ta) & 127u), kb = 127 - (int)(__float_as_uint(tb) & 127u);
            oi[j] = ka * 128 + kb; og[j] = e * rs;
        }
        int* ip = IDX + (size_t)token * 128 + h * 16 + hi * 8; float* gp = GATE + (size_t)token * 128 + h * 16 + hi * 8;
        *(int4*)ip = make_int4(oi[0], oi[1], oi[2], oi[3]); *(int4*)(ip + 4) = make_int4(oi[4], oi[5], oi[6], oi[7]);
        *(f32x4*)gp = (f32x4){og[0], og[1], og[2], og[3]}; *(f32x4*)(gp + 4) = (f32x4){og[4], og[5], og[6], og[7]};
    }
}

__device__ __forceinline__ void peer_expert_phase(const Frame& F0, const bf16_t* H2, const int* IDX, const float* GATE, const bf16_t* U, size_t v_minus_u_bytes, const float* g2  , float* XW, float* OUT) {
    const Frame F = phase_frame(F0);
    LAS float* red = (LAS float*)F.lds;
    const unsigned voff_tab = (unsigned)v_minus_u_bytes;
    const __amdgpu_buffer_rsrc_t rs = __builtin_amdgcn_make_buffer_rsrc((void*)U, 0, (int)(voff_tab + (unsigned)NEXP * DM * 2u), 0x00020000);
    const int lane = F.lane; const int voff = lane * 16;
#define PX_LOAD(buf, s) do { const int e0_ = ((s) & 7) * 2; const unsigned tb_ = ((s) >= 8) ? voff_tab : 0u; \
        const unsigned o0_ = (unsigned)__builtin_amdgcn_readlane(iv, e0_) * 4096u + tb_, o1_ = (unsigned)__builtin_amdgcn_readlane(iv, e0_ + 1) * 4096u + tb_; \
        _Pragma("unroll") for (int j_ = 0; j_ < 4; ++j_) { buf[0][j_] = __builtin_amdgcn_raw_buffer_load_b128(rs, voff + j_ * 1024, o0_, 0); buf[1][j_] = __builtin_amdgcn_raw_buffer_load_b128(rs, voff + j_ * 1024, o1_, 0); } } while (0)
#define PX_COMP(buf, s) do { const int e0_ = ((s) & 7) * 2; \
        if ((s) < 8) { \
            _Pragma("unroll") for (int ee_ = 0; ee_ < 2; ++ee_) { float a0_ = 0.f, a1_ = 0.f; \
                _Pragma("unroll") for (int j_ = 0; j_ < 4; ++j_) { const u32x4 w_ = buf[ee_][j_]; \
                    a0_ = dot2_bf16(w_.x, xr[4 * j_], a0_); a1_ = dot2_bf16(w_.y, xr[4 * j_ + 1], a1_); a0_ = dot2_bf16(w_.z, xr[4 * j_ + 2], a0_); a1_ = dot2_bf16(w_.w, xr[4 * j_ + 3], a1_); } \
                const float t_ = wave_sum(a0_ + a1_); sv = (lane == e0_ + ee_) ? t_ : sv; } \
            if ((s) == 7) wv = gelu_erf(sv) * gv; \
        } else { \
            _Pragma("unroll") for (int ee_ = 0; ee_ < 2; ++ee_) { const float wg_ = __uint_as_float(__builtin_amdgcn_readlane(__float_as_uint(wv), e0_ + ee_)); \
                _Pragma("unroll") for (int j_ = 0; j_ < 4; ++j_) { const unsigned ww_[4] = {buf[ee_][j_].x, buf[ee_][j_].y, buf[ee_][j_].z, buf[ee_][j_].w}; \
                    _Pragma("unroll") for (int q_ = 0; q_ < 4; ++q_) { acc[j_ * 8 + 2 * q_] += wg_ * bf_lo(ww_[q_]); acc[j_ * 8 + 2 * q_ + 1] += wg_ * bf_hi(ww_[q_]); } } } \
        } } while (0)
    for (int row = F.vcu; row < MROWS; row += F.G) {
        unsigned xr[16];
        { const u32x4* xp = (const u32x4*)(H2 + (size_t)row * DM) + lane;
#pragma unroll
          for (int j = 0; j < 4; ++j) { const u32x4 w = xp[64 * j]; xr[4 * j] = w.x; xr[4 * j + 1] = w.y; xr[4 * j + 2] = w.z; xr[4 * j + 3] = w.w; } }
        int iv = 0; float gv = 0.f;
        if (lane < 16) { iv = IDX[(size_t)row * 128 + F.wave * 16 + lane]; gv = GATE[(size_t)row * 128 + F.wave * 16 + lane]; }
        float sv = 0.f, wv = 0.f;
        float acc[32];
#pragma unroll
        for (int q = 0; q < 32; ++q) acc[q] = 0.f;
        u32x4 bA[2][4], bB[2][4];
        PX_LOAD(bA, 0);
#pragma unroll 1
        for (int s = 0; s < 16; s += 2) {
            PX_LOAD(bB, s + 1);
            PX_COMP(bA, s);
            if (s + 2 < 16) PX_LOAD(bA, s + 2);
            PX_COMP(bB, s + 1);
        }
#pragma unroll
        for (int j = 0; j < 4; ++j) { LAS f32x4* rp = (LAS f32x4*)(red + F.wave * DM + j * 512 + lane * 8);
            rp[0] = (f32x4){acc[j * 8], acc[j * 8 + 1], acc[j * 8 + 2], acc[j * 8 + 3]}; rp[1] = (f32x4){acc[j * 8 + 4], acc[j * 8 + 5], acc[j * 8 + 6], acc[j * 8 + 7]}; }
        __syncthreads();
        {
            f32x4 sm = {0.f, 0.f, 0.f, 0.f};
#pragma unroll
            for (int w = 0; w < 8; ++w) sm += *(const LAS f32x4*)(red + w * DM + F.tid * 4);
            const int cls = row_cls(row);
            const f32x4 g = *(const f32x4*)(g2 + (size_t)cls * NMOD + F.tid * 4);
            f32x4* xp = (f32x4*)(XW + (size_t)row * DM) + F.tid;
            const f32x4 xn = *xp + g * sm;
            *xp = xn;
            if (OUT) { const int b = row / RB, i = row - b * RB; if (i >= CTX) *((f32x4*)(OUT + ((size_t)b * SEQ + (i - CTX)) * DM) + F.tid) = xn; }
        }
        __syncthreads();
    }
#undef PX_LOAD
#undef PX_COMP
}
#ifndef N_LAUNCHES
#define N_LAUNCHES 1
#endif
struct Args { const float* in[26]; float* out; unsigned char* ws; int ph_lo, ph_hi; };
constexpr int NPHASES = 39;
__global__ void __launch_bounds__(NTHREADS, 2) fwd_kernel(Args args) {
    extern __shared__ __attribute__((aligned(16))) unsigned char lds_raw[];
    Frame F_;
    F_.lds = (LAS unsigned char*)lds_raw;
    F_.tid = threadIdx.x; F_.lane = F_.tid & 63; F_.wave = __builtin_amdgcn_readfirstlane(F_.tid >> 6);
    F_.G = gridDim.x; { const int bx = blockIdx.x; F_.vcu = (F_.G % 8 == 0) ? (bx % 8) * (F_.G / 8) + bx / 8 : bx; }
    F_.gw = F_.vcu * NWAVES + F_.wave; F_.NGW = F_.G * NWAVES;
    F_.ws = args.ws;
    volatile LAS unsigned* MISC = (volatile LAS unsigned*)(F_.lds + LDS_MISC);
    if (F_.tid < 32) MISC[F_.tid] = 0u;
    __syncthreads();
    const int lo = args.ph_lo, hi = args.ph_hi;
    XcdBarrier bar; bar.bar = (unsigned*)(args.ws + WS_CTL) + CW_BAR; bar.x = 0; bar.st = nullptr;
    if (N_LAUNCHES == 1 || hi - lo > 1) bar = xcd_barrier_post((unsigned*)(args.ws + WS_CTL) + CW_BAR, MISC + 8);
#if N_LAUNCHES == 1
#define IN(k) true
#define SEAM(k) xcd_barrier(bar)
#else
#define IN(k) (lo <= (k) && (k) < hi)
#define SEAM(k) do { if (IN(k) && IN((k) + 1)) xcd_barrier(bar); } while (0)
#endif
    PG8_LAS unsigned char* glds = (PG8_LAS unsigned char*)lds_raw;

    if (IN(0)) { p0_prologue(F_, args.in); } SEAM(0);

#pragma unroll 1
    for (int lp = 0; lp < 2; ++lp) {
        const int pb = 1 + lp * 19;
        unsigned char* ws = args.ws; asm volatile("" : "+s"(ws));
        Frame F = F_; { int w_ = F_.wave, v_ = F_.vcu, g_ = F_.G; asm volatile("" : "+s"(w_), "+s"(v_), "+s"(g_)); F.wave = w_; F.vcu = v_; F.G = g_; F.gw = v_ * NWAVES + w_; F.NGW = g_ * NWAVES; F.ws = ws; }
        float* mod = (float*)(ws + WS_MOD); float* XW = (float*)(ws + WS_XW);
        bf16_t* H = (bf16_t*)(ws + WS_H); bf16_t* P = (bf16_t*)(ws + WS_P); bf16_t* QRAW = (bf16_t*)(ws + WS_QRAW); bf16_t* KVRAW = (bf16_t*)(ws + WS_KVRAW);
        bf16_t* Q = (bf16_t*)(ws + WS_Q); bf16_t* KB = (bf16_t*)(ws + WS_K); bf16_t* VB = (bf16_t*)(ws + WS_V); bf16_t* CAT = (bf16_t*)(ws + WS_CAT); bf16_t* PQ = (bf16_t*)(ws + WS_PQ);
        int* IDX = (int*)(ws + WS_IDX); float* GATE = (float*)(ws + WS_GATE);
        const float* rope_c = (const float*)(ws + WS_ROPE); const float* rope_a = rope_c + 64 * 32 * 2;
        const float* SMv = (const float*)(ws + WS_SMALL);
        {
            const int l = 2 * lp, i = lp;
            const float* modl = mod + (size_t)l * 3 * NMOD;
            if (IN(pb + 0)) { norm_phase(F, XW, SMv + SM_N1G + l * DM, modl, 0, 2048, H); } SEAM(pb + 0);
            if (IN(pb + 1)) {
                pg8::Gemm g{H, (const bf16_t*)(ws + WS_WIN) + (size_t)i * 4096 * DM, MROWS, 4096, DM, DM, DM}; pg8::StaticOrder S; S.init(MROWS, 4096, F.G, (int)blockIdx.x);
                pg8::EpiBf16 E{P, 4096};
                pg8::gemm_phase<pg8::EpiBf16, pg8::StaticOrder, true, true>(glds, g, S, E);
            } SEAM(pb + 1);
            if (IN(pb + 2)) {
                { pg8::Gemm g{P, (const bf16_t*)(ws + WS_WUQ) + (size_t)i * 1536 * 512, MROWS, 1536, 512, 4096, 512}; pg8::StaticOrder S; S.init(MROWS, 1536, F.G, (int)blockIdx.x);
                  pg8::EpiBf16 E{QRAW, 1536};
                  pg8::gemm_phase<pg8::EpiBf16, pg8::StaticOrder, true, true>(glds, g, S, E); }
                __syncthreads();
                { pg8::Gemm g{P + 512, (const bf16_t*)(ws + WS_WUKV) + (size_t)i * 2048 * 256, MROWS, 2048, 256, 4096, 256}; pg8::StaticOrder S; S.init(MROWS, 2048, F.G, (int)blockIdx.x);
                  pg8::EpiBf16 E{KVRAW, 2048};
                  pg8::gemm_phase<pg8::EpiBf16, pg8::StaticOrder, true, true>(glds, g, S, E); }
                __syncthreads();
                conv_phase(F, P, SMv + SM_CW + i * 3072, SMv + SM_CB + i * 1024, CAT);
            } SEAM(pb + 2);
            if (IN(pb + 3)) { prep_even_phase(F, P, QRAW, KVRAW, SMv + SM_AQG + i * 192, SMv + SM_AKG + i * 192, rope_a, Q, KB, VB); } SEAM(pb + 3);
            if (IN(pb + 4)) { attn_even_phase(F, Q, KB, VB, CAT); } SEAM(pb + 4);
            if (IN(pb + 5)) {
                pg8::Gemm g{CAT, (const bf16_t*)(ws + WS_WEO) + (size_t)i * DM * DM, MROWS, DM, DM, DM, DM}; pg8::StaticOrder S; S.init(MROWS, DM, F.G, (int)blockIdx.x);
                pg8::EpiResid E{XW, DM, modl + 4096};
                pg8::gemm_phase<pg8::EpiResid, pg8::StaticOrder, true, true>(glds, g, S, E);
            } SEAM(pb + 5);
            if (IN(pb + 6)) { norm_phase(F, XW, SMv + SM_N2G + l * DM, modl, 6144, 8192, H); } SEAM(pb + 6);
            if (IN(pb + 7)) {
                pg8::Gemm g{H, (const bf16_t*)(ws + WS_WPQ) + (size_t)l * DM * DM, MROWS, DM, DM, DM, DM}; pg8::StaticOrder S; S.init(MROWS, DM, F.G, (int)blockIdx.x);
                pg8::EpiBf16 E{PQ, DM};
                pg8::gemm_phase<pg8::EpiBf16, pg8::StaticOrder, true, true>(glds, g, S, E);
            } SEAM(pb + 7);
            if (IN(pb + 8)) { peer_topk_phase(F, PQ, (const bf16_t*)(ws + WS_SUBK) + (size_t)l * 16 * 128 * 128, IDX, GATE); } SEAM(pb + 8);
            if (IN(pb + 9)) { peer_expert_phase(F, H, IDX, GATE, (const bf16_t*)(ws + WS_U) + (size_t)l * NEXP * DM, (size_t)(WS_VT - WS_U), modl + 10240, XW, nullptr); } SEAM(pb + 9);
        }
        {
            const int l = 2 * lp + 1, i = lp, qb = pb + 10;
            const float* modl = mod + (size_t)l * 3 * NMOD;
            if (IN(qb + 0)) { norm_phase(F, XW, SMv + SM_N1G + l * DM, modl, 0, 2048, H); } SEAM(qb + 0);
            if (IN(qb + 1)) {
                pg8::Gemm g{H, (const bf16_t*)(ws + WS_WQKV) + (size_t)i * 3072 * DM, MROWS, 3072, DM, DM, DM}; pg8::StaticOrder S; S.init(MROWS, 3072, F.G, (int)blockIdx.x);
                pg8::EpiBf16 E{P, 3072};
                pg8::gemm_phase<pg8::EpiBf16, pg8::StaticOrder, true, true>(glds, g, S, E);
            } SEAM(qb + 1);
            if (IN(qb + 2)) { prep_odd_phase(F, P, SMv + SM_CQG + i * 128, SMv + SM_CKG + i * 128, rope_c, Q, KB); } SEAM(qb + 2);
            if (IN(qb + 3)) { attn_odd_phase(F, Q, KB, P, CAT); } SEAM(qb + 3);
            if (IN(qb + 4)) {
                pg8::Gemm g{CAT, (const bf16_t*)(ws + WS_WCO) + (size_t)i * DM * DM, MROWS, DM, DM, DM, DM}; pg8::StaticOrder S; S.init(MROWS, DM, F.G, (int)blockIdx.x);
                pg8::EpiResid E{XW, DM, modl + 4096};
                pg8::gemm_phase<pg8::EpiResid, pg8::StaticOrder, true, true>(glds, g, S, E);
            } SEAM(qb + 4);
            if (IN(qb + 5)) { norm_phase(F, XW, SMv + SM_N2G + l * DM, modl, 6144, 8192, H); } SEAM(qb + 5);
            if (IN(qb + 6)) {
                pg8::Gemm g{H, (const bf16_t*)(ws + WS_WPQ) + (size_t)l * DM * DM, MROWS, DM, DM, DM, DM}; pg8::StaticOrder S; S.init(MROWS, DM, F.G, (int)blockIdx.x);
                pg8::EpiBf16 E{PQ, DM};
                pg8::gemm_phase<pg8::EpiBf16, pg8::StaticOrder, true, true>(glds, g, S, E);
            } SEAM(qb + 6);
            if (IN(qb + 7)) { peer_topk_phase(F, PQ, (const bf16_t*)(ws + WS_SUBK) + (size_t)l * 16 * 128 * 128, IDX, GATE); } SEAM(qb + 7);
            if (IN(qb + 8)) { peer_expert_phase(F, H, IDX, GATE, (const bf16_t*)(ws + WS_U) + (size_t)l * NEXP * DM, (size_t)(WS_VT - WS_U), modl + 10240, XW, (l == 3) ? args.out : nullptr); } if (lp == 0) SEAM(qb + 8);
        }
    }
#undef IN
#undef SEAM
}

extern "C" void kernel_launch(void* const* d_in, const int* in_sizes, int n_in, void* d_out, int out_size, void* d_ws, size_t ws_size, hipStream_t stream) {
    static int grid = 0;
    if (grid == 0) {
        if (n_in != 26 || out_size != NBATCH * SEQ * DM || ws_size < WS_END) { fprintf(stderr, "kernel_launch: unexpected shapes: n_in %d out %d ws %zu (need %zu)\n", n_in, out_size, ws_size, (size_t)WS_END); grid = -1; return; }
        int dev = 0, cus = 0, per_cu = 0;
        if (hipGetDevice(&dev) != hipSuccess || hipDeviceGetAttribute(&cus, hipDeviceAttributeMultiprocessorCount, dev) != hipSuccess) { fprintf(stderr, "kernel_launch: device query failed\n"); grid = -1; return; }
        if (hipFuncSetAttribute((const void*)fwd_kernel, hipFuncAttributeMaxDynamicSharedMemorySize, LDS_BYTES) != hipSuccess) { fprintf(stderr, "kernel_launch: hipFuncSetAttribute failed\n"); grid = -1; return; }
        if (hipOccupancyMaxActiveBlocksPerMultiprocessor(&per_cu, (const void*)fwd_kernel, NTHREADS, LDS_BYTES) != hipSuccess || per_cu < 1) { fprintf(stderr, "kernel_launch: occupancy query says %d blocks per CU\n", per_cu); (void)hipGetLastError(); grid = -1; return; }
        grid = cus;
    }
    if (grid < 0) return;
    (void)hipMemsetAsync((char*)d_ws + WS_CTL, 0, CTL_ZERO_BYTES, stream);
    Args a{};
    for (int i = 0; i < 26; ++i) a.in[i] = (const float*)d_in[i];
    a.out = (float*)d_out; a.ws = (unsigned char*)d_ws;
    for (int li = 0; li < N_LAUNCHES; ++li) {
        a.ph_lo = (N_LAUNCHES == 1) ? 0 : li; a.ph_hi = (N_LAUNCHES == 1) ? NPHASES : li + 1;
        hipLaunchKernelGGL(fwd_kernel, dim3(grid), dim3(NTHREADS), LDS_BYTES, stream, a);
        const hipError_t le = hipPeekAtLastError();
        if (le != hipSuccess) { fprintf(stderr, "kernel_launch: launch %d failed: %s\n", li, hipGetErrorName(le)); break; }
    }
}
```

```cpp
#include <hip/hip_runtime.h>
#include <cstdio>
#include <cstdint>
namespace pg8 {
#define PG8_LAS __attribute__((address_space(3)))
typedef unsigned short bf16_t;
typedef short bf16x8 __attribute__((ext_vector_type(8)));
typedef float f32x4 __attribute__((ext_vector_type(4)));
typedef unsigned u32x4 __attribute__((ext_vector_type(4)));
constexpr int BM = 256, BK = 64, HALF = 128, HTB = HALF * BK * 2  , STAGE_BYTES = 8 * HTB, NXCD = 8, WGM = 8;

__host__ __device__ __forceinline__ int lds_byte(int r, int c) { const int st = (r >> 4) * 2 + (c >> 5), rr = r & 15, cc = c & 31, ob = rr * 64 + cc * 2; return st * 1024 + (ob ^ (((ob >> 9) & 1) << 5)); }
__host__ __device__ __forceinline__ void stage_rc(int b, int& R, int& C) { const int st = b / 1024, sb = b % 1024, swz = sb ^ (((sb >> 9) & 1) << 5); R = (st >> 1) * 16 + swz / 64; C = (st & 1) * 32 + (swz % 64) / 2; }
__host__ __device__ __forceinline__ int perm32(int rho) { const int n = rho >> 4, i = rho & 15; return 8 * (i >> 2) + 4 * n + (i & 3); }

struct Unit { int pm, pn; };
struct Gemm { const bf16_t* A; const bf16_t* Bt; int M, N, K, lda, ldb; };

struct StaticOrder {
    int nM, nN, nwg, G, c;
    __host__ __device__ void init(int M, int N, int G_, int c_) { nM = M / BM; nN = N / BM; nwg = nM * nN; G = G_; c = c_; }
    __host__ __device__ bool next(int i, Unit& u) const {
        const long L = (long)i * G + c; if (L >= nwg) return false;
        int wgid = (int)L; { const int q = nwg / NXCD, r = nwg % NXCD, xcd = wgid % NXCD, off = wgid / NXCD; wgid = (xcd < r ? xcd * (q + 1) : r * (q + 1) + (xcd - r) * q) + off; }
        const int nig = WGM * nN, gid = wgid / nig, fm = gid * WGM, gsz = (nM - fm) < WGM ? (nM - fm) : WGM;
        u.pm = fm + ((wgid % nig) % gsz); u.pn = (wgid % nig) / gsz; return true;
    }
    __device__ __forceinline__ void a_ready(const Unit&) const {}
    __device__ __forceinline__ void done(const Unit&) const {}
};
__device__ __forceinline__ unsigned cvt_pk_bf16(float lo, float hi) { unsigned r; asm volatile("v_cvt_pk_bf16_f32 %0, %1, %2" : "=v"(r) : "v"(lo), "v"(hi)); return r; }
typedef float f32x2 __attribute__((ext_vector_type(2)));
struct EpiBf16 {
    static constexpr bool PERM = true, AFTER_DRAIN = false;
    bf16_t* O; int ldc;
    __device__ __forceinline__ void operator()(const f32x4 (&acc)[2][2][4][2], const Unit& u, int wr, int wc, int fr, int fq) const {
        const int row0 = u.pm * BM + wr * 64 + fr, col0 = u.pn * BM + wc * 32 + 8 * fq;
#pragma unroll
        for (int ai = 0; ai < 2; ++ai)
#pragma unroll
            for (int m = 0; m < 4; ++m) { bf16_t* rowp = O + (size_t)(row0 + ai * HALF + m * 16) * ldc + col0;
#pragma unroll
                for (int bj = 0; bj < 2; ++bj) { const f32x4 v0 = acc[ai][bj][m][0], v1 = acc[ai][bj][m][1];
                    u32x4 w; w.x = cvt_pk_bf16(v0[0], v0[1]); w.y = cvt_pk_bf16(v0[2], v0[3]); w.z = cvt_pk_bf16(v1[0], v1[1]); w.w = cvt_pk_bf16(v1[2], v1[3]);
                    *(u32x4*)(rowp + bj * HALF) = w; } }
    }
};
struct EpiResid {
    static constexpr bool PERM = false, AFTER_DRAIN = false;
    float* X; int ldc; const float* gate;
    __device__ __forceinline__ void operator()(const f32x4 (&acc)[2][2][4][2], const Unit& u, int wr, int wc, int fr, int fq) const {
        const int row0 = u.pm * BM + wr * 64 + fr, col0 = u.pn * BM + wc * 32 + 4 * fq;
        const int cls = (u.pm % 17 == 0) ? 2 : (u.pm / 17);
        const float* gp = gate + (size_t)cls * 12288 + col0;
        f32x4 gv[2][2];
#pragma unroll
        for (int bj = 0; bj < 2; ++bj)
#pragma unroll
            for (int n = 0; n < 2; ++n) gv[bj][n] = *(const f32x4*)(gp + bj * HALF + n * 16);
#pragma unroll
        for (int ai = 0; ai < 2; ++ai)
#pragma unroll
            for (int m = 0; m < 4; ++m) { float* rowp = X + (size_t)(row0 + ai * HALF + m * 16) * ldc + col0;
#pragma unroll
                for (int bj = 0; bj < 2; ++bj)
#pragma unroll
                    for (int n = 0; n < 2; ++n) { f32x4* p = (f32x4*)(rowp + bj * HALF + n * 16); *p = *p + gv[bj][n] * acc[ai][bj][m][n]; } }
    }
};
template <class Epi, class Sched, bool ALIGN_EPI = false, bool SP2 = false>
__device__ __forceinline__ void gemm_phase(PG8_LAS unsigned char* lds, const Gemm g, const Sched& S, const Epi& E, int tid_in) {
    int tid_ = tid_in; asm volatile("" : "+v"(tid_));
    const int tid = tid_, wid = __builtin_amdgcn_readfirstlane(tid >> 6), lane = tid & 63, wr = wid >> 2, wc = wid & 3, fr = lane & 15, fq = lane >> 4;
    const int K = g.K, nt = K / BK;
    unsigned voffA[2], voffB[2];
#pragma unroll
    for (int i = 0; i < 2; ++i) { int R, C; stage_rc(tid * 16 + i * 8192, R, C); const int Rb = Epi::PERM ? ((R & ~31) + perm32(R & 31)) : R;
        voffA[i] = (unsigned)(R * g.lda + C) * 2u; voffB[i] = (unsigned)(Rb * g.ldb + C) * 2u; }
    const size_t kstep = (size_t)(BK * 2);
    const size_t hstepA = (size_t)HALF * g.lda * 2, hstepB = (size_t)HALF * g.ldb * 2;
    const size_t tstepA = 2 * hstepA, tstepB = 2 * hstepB;
    const unsigned ldsw = (unsigned)wid * 1024u;
    const int aoff = lds_byte(wr * 64 + fr, fq * 8), boff = lds_byte(wc * 32 + fr, fq * 8);
#define PG8_SA(b, h) (((b) * 2 + (h)) * HTB)
#define PG8_SB(b, h) ((4 + (b) * 2 + (h)) * HTB)
#define PG8_STAGE(bufoff, gbase, voff) do { _Pragma("unroll") for (int _i = 0; _i < 2; ++_i) \
        __builtin_amdgcn_global_load_lds((const unsigned*)((const char*)(gbase) + (voff)[_i]), (PG8_LAS unsigned*)(lds + (bufoff) + ldsw + _i * 8192), 16, 0, 0); } while (0)
#define PG8_LDA(dst, b, h) do { _Pragma("unroll") for (int m = 0; m < 4; ++m) _Pragma("unroll") for (int k = 0; k < 2; ++k) dst[m][k] = *(const PG8_LAS bf16x8*)(lds + PG8_SA(b, h) + aoff + m * 2048 + k * 1024); } while (0)
#define PG8_LDB(dst, b, h) do { _Pragma("unroll") for (int n = 0; n < 2; ++n) _Pragma("unroll") for (int k = 0; k < 2; ++k) dst[n][k] = *(const PG8_LAS bf16x8*)(lds + PG8_SB(b, h) + boff + n * 2048 + k * 1024); } while (0)
#define PG8_MMA(ai, bj, At, Bt) do { __builtin_amdgcn_s_setprio(1); _Pragma("unroll") for (int m = 0; m < 4; ++m) _Pragma("unroll") for (int n = 0; n < 2; ++n) _Pragma("unroll") for (int k = 0; k < 2; ++k) \
        acc[ai][bj][m][n] = __builtin_amdgcn_mfma_f32_16x16x32_bf16(Bt[n][k], At[m][k], acc[ai][bj][m][n], 0, 0, 0); __builtin_amdgcn_s_setprio(0); } while (0)
#define PG8_WAIT_V(n) asm volatile("s_waitcnt vmcnt(" #n ")" ::: "memory")
#define PG8_WAIT_L(n) asm volatile("s_waitcnt lgkmcnt(" #n ")" ::: "memory")
#define PG8_BAR __builtin_amdgcn_s_barrier()
#define PG8_SCHED __builtin_amdgcn_sched_barrier(0)
    Unit cur, nxt; int ui = 0;
    if (!S.next(0, cur)) return;
    f32x4 acc[2][2][4][2];
#pragma unroll
    for (int a = 0; a < 2; ++a)
#pragma unroll
        for (int b = 0; b < 2; ++b)
#pragma unroll
            for (int m = 0; m < 4; ++m)
#pragma unroll
                for (int n = 0; n < 2; ++n) acc[a][b][m][n] = (f32x4){0.f, 0.f, 0.f, 0.f};
    bf16x8 At[4][2], B0[2][2], B1[2][2];
    const char* cA = (const char*)g.A + (size_t)cur.pm * tstepA; const char* cB = (const char*)g.Bt + (size_t)cur.pn * tstepB;
    S.a_ready(cur);
    if constexpr (SP2) {
        PG8_STAGE(PG8_SB(0, 0), cB, voffB); PG8_STAGE(PG8_SB(0, 1), cB + hstepB, voffB); PG8_STAGE(PG8_SA(0, 0), cA, voffA); PG8_STAGE(PG8_SA(0, 1), cA + hstepA, voffA);
        if (wr == 1) PG8_BAR;
        PG8_WAIT_V(2); PG8_BAR;
        PG8_STAGE(PG8_SB(1, 0), cB + kstep, voffB); PG8_STAGE(PG8_SA(1, 0), cA + kstep, voffA); PG8_STAGE(PG8_SB(1, 1), cB + hstepB + kstep, voffB);
        PG8_WAIT_V(6); PG8_BAR;
    } else {
        PG8_STAGE(PG8_SB(0, 0), cB, voffB); PG8_STAGE(PG8_SA(0, 0), cA, voffA); PG8_STAGE(PG8_SB(0, 1), cB + hstepB, voffB); PG8_STAGE(PG8_SA(0, 1), cA + hstepA, voffA);
        if (wr == 1) PG8_BAR;
        PG8_WAIT_V(4); PG8_BAR;
        PG8_STAGE(PG8_SB(1, 0), cB + kstep, voffB); PG8_STAGE(PG8_SA(1, 0), cA + kstep, voffA); PG8_STAGE(PG8_SB(1, 1), cB + hstepB + kstep, voffB);
        PG8_WAIT_V(6); PG8_BAR;
    }
    for (;;) {
        const bool has_next = S.next(ui + 1, nxt);
        const char* nA = has_next ? (const char*)g.A + (size_t)nxt.pm * tstepA : cA; const char* nB = has_next ? (const char*)g.Bt + (size_t)nxt.pn * tstepB : cB;
        for (int t = 0; t < nt; t += 2) {
            const bool last = (t == nt - 2);
            const char* a1 = cA + (size_t)(t + 1) * kstep;
            const char* a2 = last ? nA : cA + (size_t)(t + 2) * kstep; const char* b2 = last ? nB : cB + (size_t)(t + 2) * kstep;
            const char* a3 = a2 + kstep; const char* b3 = b2 + kstep;
            if (last && has_next) S.a_ready(nxt);
            if constexpr (SP2) {
            PG8_LDB(B0, 0, 0); PG8_LDB(B1, 0, 1); PG8_SCHED; PG8_LDA(At, 0, 0); PG8_STAGE(PG8_SA(1, 1), a1 + hstepA, voffA);
            PG8_WAIT_V(8); PG8_WAIT_L(0); PG8_BAR; PG8_MMA(0, 0, At, B0); PG8_MMA(0, 1, At, B1); PG8_BAR; PG8_SCHED;
            PG8_LDA(At, 0, 1); PG8_STAGE(PG8_SB(0, 0), b2, voffB); PG8_STAGE(PG8_SB(0, 1), b2 + hstepB, voffB); PG8_STAGE(PG8_SA(0, 0), a2, voffA);
            PG8_WAIT_V(8); PG8_WAIT_L(0); PG8_BAR; PG8_MMA(1, 0, At, B0); PG8_MMA(1, 1, At, B1); PG8_BAR; PG8_SCHED;
            PG8_LDB(B0, 1, 0); PG8_LDB(B1, 1, 1); PG8_SCHED; PG8_LDA(At, 1, 0); PG8_STAGE(PG8_SA(0, 1), a2 + hstepA, voffA);
            PG8_WAIT_V(8); PG8_WAIT_L(0); PG8_BAR; PG8_MMA(0, 0, At, B0); PG8_MMA(0, 1, At, B1); PG8_BAR; PG8_SCHED;
            PG8_LDA(At, 1, 1); PG8_STAGE(PG8_SB(1, 0), b3, voffB); PG8_STAGE(PG8_SB(1, 1), b3 + hstepB, voffB); PG8_STAGE(PG8_SA(1, 0), a3, voffA);
            PG8_WAIT_V(8); PG8_WAIT_L(0); PG8_BAR; PG8_MMA(1, 0, At, B0); PG8_MMA(1, 1, At, B1); PG8_BAR; PG8_SCHED;
            } else {
            PG8_LDB(B0, 0, 0); PG8_SCHED; PG8_LDA(At, 0, 0); PG8_STAGE(PG8_SA(1, 1), a1 + hstepA, voffA);
            PG8_WAIT_L(8); PG8_BAR; PG8_WAIT_L(0); PG8_MMA(0, 0, At, B0); PG8_BAR; PG8_SCHED;
            PG8_LDB(B1, 0, 1); PG8_STAGE(PG8_SB(0, 0), b2, voffB);
            PG8_BAR; PG8_WAIT_L(0); PG8_MMA(0, 1, At, B1); PG8_BAR;
            PG8_LDA(At, 0, 1); PG8_STAGE(PG8_SA(0, 0), a2, voffA);
            PG8_BAR; PG8_WAIT_L(0); PG8_MMA(1, 0, At, B0); PG8_BAR; PG8_SCHED;
            PG8_STAGE(PG8_SB(0, 1), b2 + hstepB, voffB);
            PG8_WAIT_V(6); PG8_BAR; PG8_MMA(1, 1, At, B1); PG8_BAR;
            PG8_LDB(B0, 1, 0); PG8_SCHED; PG8_LDA(At, 1, 0); PG8_STAGE(PG8_SA(0, 1), a2 + hstepA, voffA);
            PG8_WAIT_L(8); PG8_BAR; PG8_WAIT_L(0); PG8_MMA(0, 0, At, B0); PG8_BAR; PG8_SCHED;
            PG8_LDB(B1, 1, 1); PG8_STAGE(PG8_SB(1, 0), b3, voffB);
            PG8_BAR; PG8_WAIT_L(0); PG8_MMA(0, 1, At, B1); PG8_BAR;
            PG8_LDA(At, 1, 1); PG8_STAGE(PG8_SA(1, 0), a3, voffA);
            PG8_BAR; PG8_WAIT_L(0); PG8_MMA(1, 0, At, B0); PG8_BAR; PG8_SCHED;
            PG8_STAGE(PG8_SB(1, 1), b3 + hstepB, voffB);
            PG8_WAIT_V(6); PG8_BAR; PG8_MMA(1, 1, At, B1); PG8_BAR;
            }
        }
        if constexpr (ALIGN_EPI) { if (wr == 0) PG8_BAR; }
        if constexpr (!Epi::AFTER_DRAIN) { E(acc, cur, wr, wc, fr, fq); S.done(cur); }
        if (!has_next) break;
#pragma unroll
        for (int a = 0; a < 2; ++a)
#pragma unroll
            for (int b = 0; b < 2; ++b)
#pragma unroll
                for (int m = 0; m < 4; ++m)
#pragma unroll
                    for (int n = 0; n < 2; ++n) acc[a][b][m][n] = (f32x4){0.f, 0.f, 0.f, 0.f};
        cur = nxt; cA = nA; cB = nB; ++ui;
        if constexpr (ALIGN_EPI) { if (wr == 1) PG8_BAR; }
    }
    PG8_WAIT_V(0);
    if constexpr (!ALIGN_EPI) { if (wr == 0) PG8_BAR; }
    PG8_BAR;
    if constexpr (Epi::AFTER_DRAIN) { E.fused(acc, cur, wr, wc, fr, fq, lds, wid, lane); S.done(cur); }
#undef PG8_SA
#undef PG8_SB
#undef PG8_STAGE
#undef PG8_LDA
#undef PG8_LDB
#undef PG8_MMA
#undef PG8_WAIT_V
#undef PG8_WAIT_L
#undef PG8_BAR
#undef PG8_SCHED
}
}
namespace att {
typedef unsigned short bf16_t;
using bf16x8 = __attribute__((ext_vector_type(8))) short;
using s16x4  = __attribute__((ext_vector_type(4))) short;
using f32x16 = __attribute__((ext_vector_type(16))) float;
using u32x4  = __attribute__((ext_vector_type(4))) unsigned;
constexpr int DV = 128, NW = 8, QBLK = 32, KVBLK = 64;
constexpr float THR = 8.f;
constexpr int SHM_V = KVBLK * DV * 2;
template <int DQK> struct Cfg {
    static constexpr int SHM_K = KVBLK * DQK * 2, KROWB = DQK * 2, NCK = DQK / 64, C8 = DQK / 8, ND0 = DQK / 16;
    static constexpr float SCALE = (DQK == 128) ? 0.088388347648318440f : 0.072168783648703220f;
    static constexpr int LDS_BYTES = 2 * SHM_V + 2 * SHM_K + NW * 64 * 4;
};
#define ATT_SBAR() __builtin_amdgcn_sched_barrier(0)
__device__ __forceinline__ int crow(int r, int hi) { return (r & 3) + 8 * (r >> 2) + 4 * hi; }
__device__ __forceinline__ unsigned cvtpk(float lo, float hi) { unsigned r; asm volatile("v_cvt_pk_bf16_f32 %0, %1, %2" : "=v"(r) : "v"(lo), "v"(hi)); return r; }
template <int DQK> __device__ __forceinline__ int kswz(int row, int colB) {
    const int key = (DQK == 128) ? (row & 7) : ((row >> 1) & 7);
    return row * (DQK * 2) + (colB ^ (key << 4));
}
template <int DQK> __device__ __forceinline__ void partialSM(f32x16& p0, f32x16& p1, float& m_reg, float& mn, float& alpha) {
    constexpr float SCALE = Cfg<DQK>::SCALE, C = SCALE * 1.4426950408889634f;
    float pmax = p0[0];
#pragma unroll
    for (int r = 1; r < 16; ++r) pmax = fmaxf(pmax, p0[r]);
#pragma unroll
    for (int r = 0; r < 16; ++r) pmax = fmaxf(pmax, p1[r]);
    { auto rr = __builtin_amdgcn_permlane32_swap(__float_as_uint(pmax), __float_as_uint(pmax), false, false);
      pmax = fmaxf(__uint_as_float(rr[0]), __uint_as_float(rr[1])); }
    if (__builtin_expect(__all(pmax - m_reg <= THR / SCALE), 1)) { mn = m_reg; alpha = 1.f; }
    else { mn = fmaxf(m_reg, pmax); alpha = __builtin_amdgcn_exp2f((m_reg - mn) * C); m_reg = mn; }
    const float mnC = -mn * C;
#pragma unroll
    for (int r = 0; r < 16; ++r) p0[r] = fmaf(p0[r], C, mnC);
#pragma unroll
    for (int r = 0; r < 16; ++r) p1[r] = fmaf(p1[r], C, mnC);
#pragma unroll
    for (int r = 0; r < 16; ++r) p0[r] = __builtin_amdgcn_exp2f(p0[r]);
}
__device__ __forceinline__ void finishSM(f32x16& p0, f32x16& p1, float alpha, float& l_reg, bf16x8& pa0, bf16x8& pa1, bf16x8& pa2, bf16x8& pa3) {
#pragma unroll
    for (int r = 0; r < 16; ++r) p1[r] = __builtin_amdgcn_exp2f(p1[r]);
    float ps = 0;
#pragma unroll
    for (int r = 0; r < 16; ++r) ps += p0[r];
#pragma unroll
    for (int r = 0; r < 16; ++r) ps += p1[r];
    { auto rr = __builtin_amdgcn_permlane32_swap(__float_as_uint(ps), __float_as_uint(ps), false, false);
      ps = __uint_as_float(rr[0]) + __uint_as_float(rr[1]); }
    l_reg = l_reg * alpha + ps;
#define ATT_PK4(P, BASE, OUT) do { unsigned a0 = cvtpk(P[BASE + 0], P[BASE + 1]), a1 = cvtpk(P[BASE + 2], P[BASE + 3]);   \
    unsigned b0 = cvtpk(P[BASE + 4], P[BASE + 5]), b1 = cvtpk(P[BASE + 6], P[BASE + 7]);                              \
    auto r0 = __builtin_amdgcn_permlane32_swap(a0, b0, false, false); auto r1 = __builtin_amdgcn_permlane32_swap(a1, b1, false, false); \
    u32x4 w = {r0[0], r1[0], r0[1], r1[1]}; OUT = *reinterpret_cast<bf16x8*>(&w); } while (0)
    ATT_PK4(p0, 0, pa0); ATT_PK4(p0, 8, pa1); ATT_PK4(p1, 0, pa2); ATT_PK4(p1, 8, pa3);
#undef ATT_PK4
}
template <int DQK> __device__ __forceinline__ void qkt(f32x16& p0, f32x16& p1, const char* Ks, const bf16x8* qr, int r32, int hi) {
    p0 = f32x16{}; p1 = f32x16{};
#pragma unroll
    for (int d0 = 0; d0 < Cfg<DQK>::ND0; ++d0) { const int cb = (d0 * 16 + hi * 8) * 2;
        bf16x8 b0 = *reinterpret_cast<const bf16x8*>(Ks + kswz<DQK>(r32, cb));
        bf16x8 b1 = *reinterpret_cast<const bf16x8*>(Ks + kswz<DQK>(32 + r32, cb));
        p0 = __builtin_amdgcn_mfma_f32_32x32x16_bf16(b0, qr[d0], p0, 0, 0, 0);
        p1 = __builtin_amdgcn_mfma_f32_32x32x16_bf16(b1, qr[d0], p1, 0, 0, 0); }
}
__device__ __forceinline__ int v_st(int k, int c) { const int kk = (k & ~0xC) | ((k & 4) << 1) | ((k & 8) >> 1); return ((kk >> 3) * 4 + (c >> 5)) * 512 + ((kk & 7) * 32 + (c & 31)) * 2; }
__device__ __forceinline__ int v_rd_base(int lane) { return ((lane & 3) << 3) | (((lane >> 2) & 3) << 6) | (((lane >> 4) & 1) << 5) | (((lane >> 5) & 1) << 8); }
constexpr int v_rd_off(int d0, int ks, int half) { return d0 * 512 + ks * 4096 + half * 2048; }
template <int OFF> __device__ __forceinline__ s16x4 tr_read(int vb) {
    s16x4 r; asm volatile("ds_read_b64_tr_b16 %0, %1 offset:%2" : "=&v"(r) : "v"(vb), "i"(OFF) : "memory"); return r;
}
template <int D0> __device__ __forceinline__ void pv_one(f32x16& od, int vb, bf16x8 pa0, bf16x8 pa1, bf16x8 pa2, bf16x8 pa3) {
    const s16x4 l0 = tr_read<v_rd_off(D0, 0, 0)>(vb), h0 = tr_read<v_rd_off(D0, 0, 1)>(vb), l1 = tr_read<v_rd_off(D0, 1, 0)>(vb), h1 = tr_read<v_rd_off(D0, 1, 1)>(vb);
    const s16x4 l2 = tr_read<v_rd_off(D0, 2, 0)>(vb), h2 = tr_read<v_rd_off(D0, 2, 1)>(vb), l3 = tr_read<v_rd_off(D0, 3, 0)>(vb), h3 = tr_read<v_rd_off(D0, 3, 1)>(vb);
    asm volatile("s_waitcnt lgkmcnt(0)" ::: "memory"); ATT_SBAR();
#define ATT_PK(L, H) (bf16x8){L[0], L[1], L[2], L[3], H[0], H[1], H[2], H[3]}
    od = __builtin_amdgcn_mfma_f32_32x32x16_bf16(pa0, ATT_PK(l0, h0), od, 0, 0, 0);
    od = __builtin_amdgcn_mfma_f32_32x32x16_bf16(pa1, ATT_PK(l1, h1), od, 0, 0, 0);
    od = __builtin_amdgcn_mfma_f32_32x32x16_bf16(pa2, ATT_PK(l2, h2), od, 0, 0, 0);
    od = __builtin_amdgcn_mfma_f32_32x32x16_bf16(pa3, ATT_PK(l3, h3), od, 0, 0, 0);
#undef ATT_PK
}
__device__ __forceinline__ void pv_d0(f32x16* o, int vb, bf16x8 pa0, bf16x8 pa1, bf16x8 pa2, bf16x8 pa3) {
    pv_one<0>(o[0], vb, pa0, pa1, pa2, pa3); pv_one<1>(o[1], vb, pa0, pa1, pa2, pa3); pv_one<2>(o[2], vb, pa0, pa1, pa2, pa3); pv_one<3>(o[3], vb, pa0, pa1, pa2, pa3);
}
template <int DQK, int LDQ, int LDK, int LDV, int LDO, int SDEPTH>
__device__ __forceinline__ void attn_body(const bf16_t* __restrict__ Qb, const bf16_t* __restrict__ Kh, const bf16_t* __restrict__ Vh, bf16_t* __restrict__ Ob, int seq, char* lds, int tid_in) {
    using C_ = Cfg<DQK>;
    constexpr int SHM_K = C_::SHM_K, NCK = C_::NCK, C8 = C_::C8, ND0 = C_::ND0;
    int tid_ = tid_in; asm volatile("" : "+v"(tid_));
    const int tid = tid_, wid = tid >> 6, lane = tid & 63, r32 = lane & 31, hi = lane >> 5;
    char* V_lds = lds; char* K_lds = lds + 2 * SHM_V;
    float* ws = (float*)(lds + 2 * SHM_V + 2 * SHM_K) + wid * 64; float* li_l = ws; float* al_l = ws + 32;
    float m_reg = -1e30f, l_reg = 0; f32x16 o[4] = {}; bf16x8 qr[ND0];
    const bf16_t* Qw = Qb + (long)(wid * QBLK + r32) * LDQ + hi * 8;
#pragma unroll
    for (int d0 = 0; d0 < ND0; ++d0) qr[d0] = *reinterpret_cast<const bf16x8*>(Qw + d0 * 16);
    const int sr = tid >> 4, sc = (tid & 15) * 8, vst0 = v_st(sr, sc), vst1 = v_st(32 + sr, sc);
    int krow[NCK], kcol[NCK];
#pragma unroll
    for (int i = 0; i < NCK; ++i) { const int ci = tid + 512 * i; krow[i] = ci / C8; kcol[i] = (ci % C8) * 8; }
    const int vb0 = (int)(uintptr_t)V_lds + v_rd_base(lane);
    struct { bf16x8 vs0, vs1, ks[NCK]; } sr_[SDEPTH];
#define ATT_SLOAD(i, k0) do { sr_[i].vs0 = *reinterpret_cast<const bf16x8*>(&Vh[(long)((k0) + sr) * LDV + sc]); sr_[i].vs1 = *reinterpret_cast<const bf16x8*>(&Vh[(long)((k0) + 32 + sr) * LDV + sc]); \
    _Pragma("unroll") for (int c_ = 0; c_ < NCK; ++c_) sr_[i].ks[c_] = *reinterpret_cast<const bf16x8*>(&Kh[(long)((k0) + krow[c_]) * LDK + kcol[c_]]); } while (0)
#define ATT_SWRITE(b, i) do { *(bf16x8*)(V_lds + (b) * SHM_V + vst0) = sr_[i].vs0; *(bf16x8*)(V_lds + (b) * SHM_V + vst1) = sr_[i].vs1; \
    _Pragma("unroll") for (int c_ = 0; c_ < NCK; ++c_) *(bf16x8*)(K_lds + (b) * SHM_K + kswz<DQK>(krow[c_], kcol[c_] * 2)) = sr_[i].ks[c_]; } while (0)
#define ATT_SWAIT() do { if constexpr (SDEPTH == 2) { if constexpr (NCK == 2) asm volatile("s_waitcnt vmcnt(4)" ::: "memory"); else asm volatile("s_waitcnt vmcnt(5)" ::: "memory"); } else asm volatile("s_waitcnt vmcnt(0)" ::: "memory"); } while (0)
#define ATT_RESC(a) do { if (__any((a) < 1.f)) { if (hi == 0) al_l[r32] = (a); asm volatile("s_waitcnt lgkmcnt(0)" ::: "memory"); \
    _Pragma("unroll") for (int d = 0; d < 4; ++d) _Pragma("unroll") for (int r = 0; r < 16; ++r) o[d][r] *= al_l[crow(r, hi)]; } } while (0)
    f32x16 pA0, pA1, pB0, pB1; float mnA, mnB, alA, alB; bf16x8 pa0, pa1, pa2, pa3; const int NT = seq / KVBLK;
    constexpr int SE = 0, SO = SDEPTH - 1;
    ATT_SLOAD(SE, 0); asm volatile("s_waitcnt vmcnt(0)" ::: "memory"); ATT_SWRITE(0, SE); __syncthreads();
    qkt<DQK>(pA0, pA1, K_lds, qr, r32, hi); partialSM<DQK>(pA0, pA1, m_reg, mnA, alA);
    ATT_SLOAD(SO, KVBLK); if constexpr (SDEPTH == 2) { if (2 < NT) ATT_SLOAD(SE, 2 * KVBLK); }
    ATT_SWAIT(); ATT_SWRITE(1, SO); __syncthreads();
    for (int j = 1; j + 1 < NT; j += 2) {
        ATT_SBAR(); qkt<DQK>(pB0, pB1, K_lds + SHM_K, qr, r32, hi);
        finishSM(pA0, pA1, alA, l_reg, pa0, pa1, pa2, pa3); ATT_SBAR();
        ATT_SLOAD(SO, (j + SDEPTH) * KVBLK); ATT_SBAR();
        pv_d0(o, vb0, pa0, pa1, pa2, pa3); partialSM<DQK>(pB0, pB1, m_reg, mnB, alB);
        __syncthreads(); ATT_SWAIT(); ATT_SWRITE(0, SE);
        ATT_RESC(alB); __syncthreads();
        ATT_SBAR(); qkt<DQK>(pA0, pA1, K_lds, qr, r32, hi);
        finishSM(pB0, pB1, alB, l_reg, pa0, pa1, pa2, pa3); ATT_SBAR();
        if (SDEPTH == 1 || j + 3 < NT) ATT_SLOAD(SE, (j + 1 + SDEPTH) * KVBLK); ATT_SBAR();
        pv_d0(o, vb0 + (int)SHM_V, pa0, pa1, pa2, pa3); partialSM<DQK>(pA0, pA1, m_reg, mnA, alA);
        __syncthreads(); ATT_SWAIT(); ATT_SWRITE(1, SO);
        ATT_RESC(alA); __syncthreads();
    }
    ATT_SBAR(); qkt<DQK>(pB0, pB1, K_lds + SHM_K, qr, r32, hi);
    finishSM(pA0, pA1, alA, l_reg, pa0, pa1, pa2, pa3); ATT_SBAR();
    pv_d0(o, vb0, pa0, pa1, pa2, pa3); partialSM<DQK>(pB0, pB1, m_reg, mnB, alB);
    __syncthreads(); ATT_RESC(alB);
    finishSM(pB0, pB1, alB, l_reg, pa0, pa1, pa2, pa3); ATT_SBAR();
    pv_d0(o, vb0 + (int)SHM_V, pa0, pa1, pa2, pa3);
    if (hi == 0) li_l[r32] = l_reg;
    asm volatile("s_waitcnt lgkmcnt(0)" ::: "memory");
    __syncthreads();
    float rli[16];
#pragma unroll
    for (int r = 0; r < 16; ++r) rli[r] = __builtin_amdgcn_rcpf(li_l[crow(r, hi)]);
    unsigned short* stg = (unsigned short*)(lds + wid * 8192);
#pragma unroll
    for (int r = 0; r < 16; ++r) { const int orow = crow(r, hi);
#pragma unroll
        for (int d0 = 0; d0 < 4; ++d0) { const unsigned w = cvtpk(o[d0][r] * rli[r], 0.f); stg[orow * 128 + d0 * 32 + r32] = (unsigned short)(w & 0xffffu); } }
    asm volatile("s_waitcnt lgkmcnt(0)" ::: "memory");
    bf16_t* Ow = Ob + (long)(wid * QBLK) * LDO;
#pragma unroll
    for (int i = 0; i < 8; ++i) { const int id = lane + 64 * i, row = id >> 4, c16 = id & 15;
        const u32x4 v = *(const u32x4*)((const char*)stg + row * 256 + c16 * 16);
        *(u32x4*)(Ow + (long)row * LDO + c16 * 8) = v; }
    asm volatile("s_waitcnt lgkmcnt(0)" ::: "memory");
    __syncthreads();
#undef ATT_SLOAD
#undef ATT_SWRITE
#undef ATT_SWAIT
#undef ATT_RESC
}

template <int DQK, int LDQ, int LDK, int LDV, int LDO>
__device__ __forceinline__ void attn_body1(const bf16_t* __restrict__ Qb, const bf16_t* __restrict__ Kh, const bf16_t* __restrict__ Vh, bf16_t* __restrict__ Ob, int seq, char* lds, int tid_in) {
    using C_ = Cfg<DQK>;
    constexpr int SHM_K = C_::SHM_K, NCK = C_::NCK, C8 = C_::C8, ND0 = C_::ND0;
    int tid_ = tid_in; asm volatile("" : "+v"(tid_));
    const int tid = tid_, wid = tid >> 6, lane = tid & 63, r32 = lane & 31, hi = lane >> 5;
    char* V_lds = lds; char* K_lds = lds + 2 * SHM_V;
    float* ws = (float*)(lds + 2 * SHM_V + 2 * SHM_K) + wid * 64; float* li_l = ws; float* al_l = ws + 32;
    float m_reg = -1e30f, l_reg = 0; f32x16 o[4] = {}; bf16x8 qr[ND0];
    const bf16_t* Qw = Qb + (long)(wid * QBLK + r32) * LDQ + hi * 8;
#pragma unroll
    for (int d0 = 0; d0 < ND0; ++d0) qr[d0] = *reinterpret_cast<const bf16x8*>(Qw + d0 * 16);
    const int sr = tid >> 4, sc = (tid & 15) * 8, vst0 = v_st(sr, sc), vst1 = v_st(32 + sr, sc);
    int krow[NCK], kcol[NCK];
#pragma unroll
    for (int i = 0; i < NCK; ++i) { const int ci = tid + 512 * i; krow[i] = ci / C8; kcol[i] = (ci % C8) * 8; }
    const int vb0 = (int)(uintptr_t)V_lds + v_rd_base(lane);
    bf16x8 vs0, vs1, ks[NCK];
#define ATT1_SLOAD(k0) do { vs0 = *reinterpret_cast<const bf16x8*>(&Vh[(long)((k0) + sr) * LDV + sc]); vs1 = *reinterpret_cast<const bf16x8*>(&Vh[(long)((k0) + 32 + sr) * LDV + sc]); \
    _Pragma("unroll") for (int c_ = 0; c_ < NCK; ++c_) ks[c_] = *reinterpret_cast<const bf16x8*>(&Kh[(long)((k0) + krow[c_]) * LDK + kcol[c_]]); } while (0)
#define ATT1_SWRITE(b) do { *(bf16x8*)(V_lds + (b) * SHM_V + vst0) = vs0; *(bf16x8*)(V_lds + (b) * SHM_V + vst1) = vs1; \
    _Pragma("unroll") for (int c_ = 0; c_ < NCK; ++c_) *(bf16x8*)(K_lds + (b) * SHM_K + kswz<DQK>(krow[c_], kcol[c_] * 2)) = ks[c_]; } while (0)
    const int NT = seq / KVBLK;
    ATT1_SLOAD(0); asm volatile("s_waitcnt vmcnt(0)" ::: "memory"); ATT1_SWRITE(0); __syncthreads();
    for (int j = 0; j < NT; ++j) {
        const int b = j & 1;
        if (j + 1 < NT) ATT1_SLOAD((j + 1) * KVBLK);
        ATT_SBAR();
        f32x16 p0, p1; float mn, alpha; bf16x8 pa0, pa1, pa2, pa3;
        qkt<DQK>(p0, p1, K_lds + b * SHM_K, qr, r32, hi);
        partialSM<DQK>(p0, p1, m_reg, mn, alpha);
        if (__any(alpha < 1.f)) { if (hi == 0) al_l[r32] = alpha; asm volatile("s_waitcnt lgkmcnt(0)" ::: "memory");
#pragma unroll
            for (int d = 0; d < 4; ++d)
#pragma unroll
                for (int r = 0; r < 16; ++r) o[d][r] *= al_l[crow(r, hi)]; }
        finishSM(p0, p1, alpha, l_reg, pa0, pa1, pa2, pa3); ATT_SBAR();
        pv_d0(o, vb0 + b * (int)SHM_V, pa0, pa1, pa2, pa3);
        if (j + 1 < NT) { ATT1_SWRITE(b ^ 1); }
        __syncthreads();
    }
    if (hi == 0) li_l[r32] = l_reg;
    asm volatile("s_waitcnt lgkmcnt(0)" ::: "memory");
    __syncthreads();
    float rli[16];
#pragma unroll
    for (int r = 0; r < 16; ++r) rli[r] = __builtin_amdgcn_rcpf(li_l[crow(r, hi)]);
    unsigned short* stg = (unsigned short*)(lds + wid * 8192);
#pragma unroll
    for (int r = 0; r < 16; ++r) { const int orow = crow(r, hi);
#pragma unroll
        for (int d0 = 0; d0 < 4; ++d0) { const unsigned w = cvtpk(o[d0][r] * rli[r], 0.f); stg[orow * 128 + d0 * 32 + r32] = (unsigned short)(w & 0xffffu); } }
    asm volatile("s_waitcnt lgkmcnt(0)" ::: "memory");
    bf16_t* Ow = Ob + (long)(wid * QBLK) * LDO;
#pragma unroll
    for (int i = 0; i < 8; ++i) { const int id = lane + 64 * i, row = id >> 4, c16 = id & 15;
        const u32x4 v = *(const u32x4*)((const char*)stg + row * 256 + c16 * 16);
        *(u32x4*)(Ow + (long)row * LDO + c16 * 8) = v; }
    asm volatile("s_waitcnt lgkmcnt(0)" ::: "memory");
    __syncthreads();
#undef ATT1_SLOAD
#undef ATT1_SWRITE
}
}
constexpr int DM = 2048, NBATCH = 2, SEQ = 4096, CTX = 256, RB = SEQ + CTX  , MROWS = NBATCH * RB  ;
constexpr int NMOD = 6 * DM, NEXP = 16384;
constexpr float EPS = 1e-6f;
constexpr int NWAVES = 8, NTHREADS = 512;
constexpr size_t MiB = 1u << 20;
constexpr size_t WS_CTL = 0, CTL_ZERO_BYTES = 64 * 1024;
constexpr size_t WS_MOD = 1 * MiB;
constexpr size_t WS_ROPE = 2 * MiB;
constexpr size_t WS_SMALL = 3 * MiB;
constexpr int SM_N1G = 0, SM_N2G = 8192, SM_AQG = 16384, SM_AKG = 16384 + 384, SM_CW = 16384 + 768, SM_CB = SM_CW + 6144, SM_CQG = SM_CB + 2048, SM_CKG = SM_CQG + 256, SM_END = SM_CKG + 256;
constexpr size_t WS_XW = 4 * MiB;
constexpr size_t WS_H = 72 * MiB;
constexpr size_t WS_P = 106 * MiB;
constexpr size_t WS_QRAW = 174 * MiB;
constexpr size_t WS_KVRAW = 200 * MiB;
constexpr size_t WS_Q = 234 * MiB;
constexpr size_t WS_K = 268 * MiB;
constexpr size_t WS_V = 294 * MiB;
constexpr size_t WS_CAT = 311 * MiB;
constexpr size_t WS_PQ = 345 * MiB;
constexpr size_t WS_IDX = 379 * MiB;
constexpr size_t WS_GATE = 384 * MiB;
constexpr size_t WS_WIN = 389 * MiB;
constexpr size_t WS_WUQ = 421 * MiB;
constexpr size_t WS_WUKV = 424 * MiB;
constexpr size_t WS_WEO = 426 * MiB;
constexpr size_t WS_WQKV = 442 * MiB;
constexpr size_t WS_WCO = 466 * MiB;
constexpr size_t WS_WPQ = 482 * MiB;
constexpr size_t WS_SUBK = 514 * MiB;
constexpr size_t WS_U = 516 * MiB;
constexpr size_t WS_VT = 644 * MiB;
constexpr size_t WS_USC = 772 * MiB;
constexpr size_t WS_VSC = 773 * MiB;
constexpr size_t WS_END = 774 * MiB;
constexpr int CW_BAR = 4096;
constexpr int LDS_MISC = 131072 + 8192;
constexpr int LDS_BYTES = 147456;

#define LAS __attribute__((address_space(3)))
typedef unsigned short bf16_t;
typedef float f32x4 __attribute__((ext_vector_type(4)));
typedef unsigned u32x4 __attribute__((ext_vector_type(4)));
typedef unsigned u32x2 __attribute__((ext_vector_type(2)));
typedef short bf16x8 __attribute__((ext_vector_type(8)));
typedef float f32x16 __attribute__((ext_vector_type(16)));
typedef __bf16 bf16x2_t __attribute__((ext_vector_type(2)));
typedef float f32x2 __attribute__((ext_vector_type(2)));

__device__ __forceinline__ unsigned f2bf(float f) { unsigned u = __builtin_bit_cast(unsigned, f); return (u + 0x7fffu + ((u >> 16) & 1u)) >> 16; }
__device__ __forceinline__ unsigned pk2(float lo, float hi) { return f2bf(lo) | (f2bf(hi) << 16); }
__device__ __forceinline__ float bf_lo(unsigned w) { return __builtin_bit_cast(float, w << 16); }
__device__ __forceinline__ float bf_hi(unsigned w) { return __builtin_bit_cast(float, w & 0xffff0000u); }
__device__ __forceinline__ float bf2f(bf16_t h) { return __builtin_bit_cast(float, (unsigned)h << 16); }
__device__ __forceinline__ float wave_sum(float v) {
#pragma unroll
    for (int o = 1; o < 64; o <<= 1) v += __shfl_xor(v, o);
    return v;
}
#define DPP_ADD(v, ctrl) ((v) + __builtin_bit_cast(float, __builtin_amdgcn_update_dpp(0, __builtin_bit_cast(int, (v)), (ctrl), 0xf, 0xf, true)))
__device__ __forceinline__ float wave_sum_dpp(float v) {
    v = DPP_ADD(v, 0xB1);
    v = DPP_ADD(v, 0x4E);
    v = DPP_ADD(v, 0x141);
    v = DPP_ADD(v, 0x140);
    const int vi = __builtin_bit_cast(int, v);
    const float s0 = __builtin_bit_cast(float, __builtin_amdgcn_readlane(vi, 0)), s1 = __builtin_bit_cast(float, __builtin_amdgcn_readlane(vi, 16));
    const float s2 = __builtin_bit_cast(float, __builtin_amdgcn_readlane(vi, 32)), s3 = __builtin_bit_cast(float, __builtin_amdgcn_readlane(vi, 48));
    return (s0 + s1) + (s2 + s3);
}
__device__ __forceinline__ float dot2_bf16(unsigned w, unsigned x, float acc) { return __builtin_amdgcn_fdot2_f32_bf16(__builtin_bit_cast(bf16x2_t, w), __builtin_bit_cast(bf16x2_t, x), acc, false); }
__device__ __forceinline__ float gelu_erf(float v) {
    const float av = fabsf(v), t = __builtin_amdgcn_rcpf(av * 0.2316418882f + 1.0f);
    float q = t * 0.5307027145f + (-0.7265760135f); q = q * t + 0.7107068705f; q = q * t + (-0.142248368f); q = q * t + 0.127414796f; q = q * t;
    const float e = __builtin_amdgcn_exp2f((v * v) * (-0.72134752044f));
    const float m = v * (q * e);
    return v < 0.f ? m : v - m;
}
#define XB_TMO      128
#define XB_XCNT(j)  (256  + 64 * (j))
#define XB_XSUB(j)  (1280 + 64 * (j))
#define XB_XGEN(j)  (2304 + 64 * (j))
#define XB_TOP      3328
#define XB_TOPGEN   3392
#define XCD_BAR_WORDS 3456
#define XB_SPIN_CAP (1u << 18)

__device__ __forceinline__ unsigned xb_ld(unsigned* p)              { return __hip_atomic_load(p, __ATOMIC_RELAXED, __HIP_MEMORY_SCOPE_AGENT); }
__device__ __forceinline__ unsigned xb_add(unsigned* p, unsigned v) { return __hip_atomic_fetch_add(p, v, __ATOMIC_RELAXED, __HIP_MEMORY_SCOPE_AGENT); }
__device__ __forceinline__ unsigned xb_xcc_id() { return (unsigned)__builtin_amdgcn_s_getreg((3 << 11) | 20) & 0xFu; }
#define XB_SPIN(cond, bar) do { unsigned _sp = 0; while (cond) { __builtin_amdgcn_s_sleep(1); \
    if ((++_sp & 255u) == 0u) { if (xb_ld(&(bar)[XB_TMO])) break; if (_sp > XB_SPIN_CAP) { atomicAdd(&(bar)[XB_TMO], 1u); break; } } } } while (0)

struct XcdBarrier {
    unsigned* bar; unsigned x;
    volatile LAS unsigned* st;
};

__device__ __forceinline__ XcdBarrier xcd_barrier_post(unsigned* bar, volatile LAS unsigned* st) {
    XcdBarrier b; b.bar = bar; b.x = xb_xcc_id(); b.st = st;
    if (threadIdx.x == 0) (void)xb_add(&bar[XB_XCNT(b.x)], 1u);
    return b;
}
__device__ __forceinline__ void xcd_barrier_complete(unsigned* bar, unsigned x, unsigned& nloc, unsigned& nx) {
    const unsigned G = gridDim.x * gridDim.y * gridDim.z;
    unsigned sum, cnt, mine, sp = 0u;
    for (;;) {
        sum = 0u; cnt = 0u; mine = 0u;
#pragma unroll
        for (unsigned j = 0; j < 16; ++j) { const unsigned c = xb_ld(&bar[XB_XCNT(j)]); sum += c; cnt += (c > 0u) ? 1u : 0u; mine = (j == x) ? c : mine; }
        if (sum == G) break;
        __builtin_amdgcn_s_sleep(1);
        if ((++sp & 255u) == 0u) { if (xb_ld(&bar[XB_TMO])) break; if (sp > XB_SPIN_CAP) { atomicAdd(&bar[XB_TMO], 1u); break; } }
    }
    nloc = mine > 0u ? mine : 1u; nx = cnt > 0u ? cnt : 1u;
}

__device__ __forceinline__ void xcd_barrier(const XcdBarrier& b) {
    asm volatile("s_waitcnt vmcnt(0)" ::: "memory");
    __syncthreads();
    if (threadIdx.x == 0) {
        unsigned* bar = b.bar; unsigned bx = b.x;
        asm volatile("" : "+s"(bar), "+s"(bx));
        __builtin_amdgcn_s_waitcnt(0);
        unsigned nloc = b.st[0], nx = b.st[1];
        if (nloc == 0u) { xcd_barrier_complete(bar, bx, nloc, nx); b.st[0] = nloc; b.st[1] = nx; }
        const unsigned old = xb_add(&bar[XB_XSUB(bx)], 1u);
        const unsigned gen = old / nloc;
        if (old + 1u == (gen + 1u) * nloc) {
            __builtin_amdgcn_fence(__ATOMIC_RELEASE, "agent");
            asm volatile("s_waitcnt vmcnt(0)" ::: "memory");
            const unsigned og = xb_add(&bar[XB_TOP], 1u);
            const unsigned tg = og / nx;
            if (og + 1u == (tg + 1u) * nx) xb_add(&bar[XB_TOPGEN], 1u);
            else XB_SPIN(xb_ld(&bar[XB_TOPGEN]) == tg, bar);
            __builtin_amdgcn_fence(__ATOMIC_ACQUIRE, "agent");
            xb_add(&bar[XB_XGEN(bx)], 1u);
            asm volatile("s_waitcnt vmcnt(0)" ::: "memory");
        } else {
            XB_SPIN(xb_ld(&bar[XB_XGEN(bx)]) == gen, bar);
            __builtin_amdgcn_fence(__ATOMIC_ACQUIRE, "agent");
            asm volatile("s_waitcnt vmcnt(0)" ::: "memory");
        }
    }
    __syncthreads();
}
struct Frame {
    LAS unsigned char* lds;
    int tid, lane, wave, vcu, G, gw, NGW;
    unsigned char* ws;
};
__device__ __forceinline__ int opaque_v(int v) { asm volatile("" : "+v"(v)); return v; }
__device__ __forceinline__ int phase_tid(int wave) { int lane; asm volatile("v_mbcnt_lo_u32_b32 %0, -1, 0\n\tv_mbcnt_hi_u32_b32 %0, -1, %0" : "=v"(lane)); return wave * 64 + lane; }
__device__ __forceinline__ Frame phase_frame(const Frame& F0) { Frame F = F0; F.tid = phase_tid(F0.wave); F.lane = F.tid & 63; return F; }
__device__ __forceinline__ float swap32(float v, int lane) { auto rr = __builtin_amdgcn_permlane32_swap(__float_as_uint(v), __float_as_uint(v), false, false); return __uint_as_float(lane < 32 ? rr[1] : rr[0]); }
__device__ __forceinline__ int row_cls(int row) { const int b = row / RB, i = row - b * RB; return i < CTX ? 2 : b; }

__device__ __forceinline__ void p0_transpose_item(const float* W, int K, int N, bf16_t* WT, const float* gain, LAS float* scr, int item, int lane) {
    const int nblk = N / 32, kb = item / nblk, nb = item % nblk, k0 = 64 * kb, n0 = 32 * nb;
#pragma unroll 8
    for (int i = 0; i < 32; ++i) { const int kk = 2 * i + (lane >> 5); float v = W[(size_t)(k0 + kk) * N + n0 + (lane & 31)]; if (gain) v *= gain[k0 + kk]; scr[kk * 33 + (lane & 31)] = v; }
    asm volatile("s_waitcnt lgkmcnt(0)" ::: "memory");
    const int c = lane & 7;
#pragma unroll
    for (int j = 0; j < 4; ++j) { const int n = (lane >> 3) + 8 * j; const LAS float* s = scr + (8 * c) * 33 + n;
        u32x4 o; o.x = pk2(s[0 * 33], s[1 * 33]); o.y = pk2(s[2 * 33], s[3 * 33]); o.z = pk2(s[4 * 33], s[5 * 33]); o.w = pk2(s[6 * 33], s[7 * 33]);
        *(u32x4*)(WT + (size_t)(n0 + n) * K + k0 + 8 * c) = o; }
    asm volatile("s_waitcnt lgkmcnt(0)" ::: "memory");
}
struct TrDesc { const float* W; const float* gain; bf16_t* WT; int K, N, items; };

__device__ __forceinline__ void p0_gemv_task(Frame& F, int task, const float* ada_w, const float* ada_b, float* mod) {
    LAS float* sv = (LAS float*)F.lds; LAS float* part = (LAS float*)(F.lds + 32768);
    const int l = task / 48, n0 = (task % 48) * 256;
    const float* Wp = ada_w + (size_t)l * DM * NMOD + n0 + F.lane * 4 + (size_t)(F.wave * 256) * NMOD;
    f32x4 a0 = {0, 0, 0, 0}, a1 = a0, a2 = a0;
    for (int k = 0; k < 256; k += 8) {
        f32x4 w[8];
#pragma unroll
        for (int u = 0; u < 8; ++u) w[u] = *(const f32x4*)(Wp + (size_t)(k + u) * NMOD);
#pragma unroll
        for (int u = 0; u < 8; ++u) { const int kk = F.wave * 256 + k + u; const float s0 = sv[kk], s1 = sv[2048 + kk], s2 = sv[4096 + kk];
            a0 += w[u] * s0; a1 += w[u] * s1; a2 += w[u] * s2; }
    }
    *(LAS f32x4*)(part + (F.wave * 3 + 0) * 256 + F.lane * 4) = a0;
    *(LAS f32x4*)(part + (F.wave * 3 + 1) * 256 + F.lane * 4) = a1;
    *(LAS f32x4*)(part + (F.wave * 3 + 2) * 256 + F.lane * 4) = a2;
    __syncthreads();
    for (int o = F.tid; o < 768; o += NTHREADS) { const int r = o >> 8, c = o & 255; float s = 0.f;
#pragma unroll
        for (int w = 0; w < 8; ++w) s += part[(w * 3 + r) * 256 + c];
        mod[(size_t)(l * 3 + r) * NMOD + n0 + c] = s + ada_b[(size_t)l * NMOD + n0 + c]; }
    __syncthreads();
}

__device__ __forceinline__ void p0_prologue(Frame& F, const float* const* in) {
    unsigned char* ws = F.ws;
    {
        LAS float* sv = (LAS float*)F.lds;
        for (int i = F.tid; i < 3 * DM; i += NTHREADS) { const int r = i / DM, k = i - r * DM; const float x = (r < 2) ? in[1][r * DM + k] : in[3][k]; sv[i] = x / (1.f + __expf(-x)); }
        __syncthreads();
        for (int task = F.vcu; task < 192; task += F.G) p0_gemv_task(F, task, in[4], in[5], (float*)(ws + WS_MOD));
        __syncthreads();
    }
    {
        float* xw = (float*)(ws + WS_XW);
        for (int row = F.gw; row < MROWS; row += F.NGW) { const int b = row / RB, i = row - b * RB;
            const float* src = (i < CTX) ? in[2] + (size_t)(b * CTX + i) * DM : in[0] + (size_t)(b * SEQ + i - CTX) * DM;
            const f32x4* s4 = (const f32x4*)src + F.lane; f32x4* d4 = (f32x4*)(xw + (size_t)row * DM) + F.lane;
#pragma unroll
            for (int j = 0; j < 8; ++j) d4[64 * j] = s4[64 * j]; }
    }
    {
        float* sm = (float*)(ws + WS_SMALL); const int g = F.vcu * NTHREADS + F.tid;
        if (g < 8192) { sm[SM_N1G + g] = in[6][g]; sm[SM_N2G + g] = in[7][g]; }
        if (g < 384) { sm[SM_AQG + g] = in[13][g]; sm[SM_AKG + g] = in[14][g]; }
        if (g < 6144) sm[SM_CW + g] = in[15][g];
        if (g < 2048) sm[SM_CB + g] = in[16][g];
        if (g < 256) { sm[SM_CQG + g] = in[19][g]; sm[SM_CKG + g] = in[20][g]; }
    }
    {
        float* rc = (float*)(ws + WS_ROPE); float* ra = rc + 64 * 32 * 2;
        const int g = F.vcu * NTHREADS + F.tid;
        if (g < 64 * 32) { const int pos = g >> 5, f = g & 31; const float fr = exp2f(-(float)f * (13.287712379549449f / 32.f)); const float ang = (float)pos * fr;
            rc[2 * g] = cosf(ang); rc[2 * g + 1] = sinf(ang); }
        else if (g < 64 * 32 + 64 * 16) { const int e = g - 64 * 32, pos = e >> 4, f = e & 15; const float fr = exp2f(-(float)f * (13.287712379549449f / 16.f)); const float ang = (float)pos * fr;
            ra[2 * e] = cosf(ang); ra[2 * e + 1] = sinf(ang); }
    }
    {
        LAS float* scr = (LAS float*)(F.lds + F.wave * 16384);
        TrDesc d[16]; int nd = 0;
#pragma unroll
        for (int i = 0; i < 2; ++i) {
            d[nd++] = TrDesc{in[8] + (size_t)i * DM * 3904, nullptr, (bf16_t*)(ws + WS_WIN) + (size_t)i * 4096 * DM, DM, 3904, 32 * 122};
            d[nd++] = TrDesc{in[11] + (size_t)i * 512 * 1536, in[9] + i * 512, (bf16_t*)(ws + WS_WUQ) + (size_t)i * 1536 * 512, 512, 1536, 8 * 48};
            d[nd++] = TrDesc{in[12] + (size_t)i * 256 * 2048, in[10] + i * 256, (bf16_t*)(ws + WS_WUKV) + (size_t)i * 2048 * 256, 256, 2048, 4 * 64};
            d[nd++] = TrDesc{in[17] + (size_t)i * DM * DM, nullptr, (bf16_t*)(ws + WS_WEO) + (size_t)i * DM * DM, DM, DM, 32 * 64};
            d[nd++] = TrDesc{in[18] + (size_t)i * DM * 3072, nullptr, (bf16_t*)(ws + WS_WQKV) + (size_t)i * 3072 * DM, DM, 3072, 32 * 96};
            d[nd++] = TrDesc{in[21] + (size_t)i * DM * DM, nullptr, (bf16_t*)(ws + WS_WCO) + (size_t)i * DM * DM, DM, DM, 32 * 64};
        }
#pragma unroll
        for (int l = 0; l < 4; ++l) d[nd++] = TrDesc{in[22] + (size_t)l * DM * DM, nullptr, (bf16_t*)(ws + WS_WPQ) + (size_t)l * DM * DM, DM, DM, 32 * 64};
#pragma unroll
        for (int m = 0; m < 16; ++m) {
            for (int it = F.gw; it < d[m].items; it += F.NGW) p0_transpose_item(d[m].W, d[m].K, d[m].N, d[m].WT, d[m].gain, scr, it, F.lane);
        }
        for (int i = F.gw * 64 + F.lane; i < 2 * 192 * DM / 8; i += F.NGW * 64) { const int li = i / (192 * DM / 8), r = i % (192 * DM / 8);
            *(u32x4*)((bf16_t*)(ws + WS_WIN) + (size_t)li * 4096 * DM + (size_t)3904 * DM + (size_t)r * 8) = (u32x4){0u, 0u, 0u, 0u}; }
    }
    {
        const size_t n_sk = (size_t)4 * 16 * 128 * 128 / 8;
        const size_t gt = (size_t)F.vcu * NTHREADS + F.tid, GT = (size_t)F.G * NTHREADS;
        for (size_t j = gt; j < n_sk; j += GT) {
            const f32x4 a = *(const f32x4*)(in[23] + j * 8), b = *(const f32x4*)(in[23] + j * 8 + 4);
            u32x4 o; o.x = pk2(a.x, a.y); o.y = pk2(a.z, a.w); o.z = pk2(b.x, b.y); o.w = pk2(b.z, b.w);
            *(u32x4*)((bf16_t*)(ws + WS_SUBK) + j * 8) = o;
        }
    }
    {
        for (int r = F.gw; r < 2 * 4 * NEXP; r += F.NGW) {
            const int tab = r / (4 * NEXP), rr = r - tab * (4 * NEXP);
            const float* src = (tab ? in[25] : in[24]) + (size_t)rr * DM + F.lane * 16;
            f32x4 v[8];
#pragma unroll
            for (int j = 0; j < 2; ++j)
#pragma unroll
                for (int q = 0; q < 4; ++q) v[j * 4 + q] = *(const f32x4*)(src + j * 1024 + q * 4);
            float am = 0.f;
#pragma unroll
            for (int q = 0; q < 8; ++q) am = fmaxf(fmaxf(am, fmaxf(fabsf(v[q].x), fabsf(v[q].y))), fmaxf(fabsf(v[q].z), fabsf(v[q].w)));
#pragma unroll
            for (int o = 1; o < 64; o <<= 1) am = fmaxf(am, __shfl_xor(am, o));
            am = fmaxf(am, 1e-30f);
            const float sc = 448.0f / am;
            unsigned char* dst = ws + (tab ? WS_VT : WS_U) + (size_t)rr * DM + F.lane * 16;
#pragma unroll
            for (int j = 0; j < 2; ++j) { u32x4 o; unsigned w[4];
#pragma unroll
                for (int q = 0; q < 4; ++q) { const f32x4 x = v[j * 4 + q] * sc; int t = 0; t = __builtin_amdgcn_cvt_pk_fp8_f32(x.x, x.y, t, false); t = __builtin_amdgcn_cvt_pk_fp8_f32(x.z, x.w, t, true); w[q] = (unsigned)t; }
                o.x = w[0]; o.y = w[1]; o.z = w[2]; o.w = w[3]; *(u32x4*)(dst + j * 1024) = o; }
            if (F.lane == 0) ((float*)(ws + (tab ? WS_VSC : WS_USC)))[rr] = am * (1.0f / 448.0f);
        }
    }
}

__device__ __forceinline__ void norm_phase(const Frame& F0, const float* xw, const float* g, const float* modl  , int off_sh, int off_sc, bf16_t* H) {
    const Frame F = phase_frame(F0);
    for (int row = F.gw; row < MROWS; row += F.NGW) {
        const int cls = row_cls(row);
        const f32x4* x4 = (const f32x4*)(xw + (size_t)row * DM) + F.lane;
        f32x4 v[8]; float ss = 0.f;
#pragma unroll
        for (int j = 0; j < 8; ++j) { v[j] = x4[64 * j]; ss += (v[j].x * v[j].x + v[j].y * v[j].y) + (v[j].z * v[j].z + v[j].w * v[j].w); }
        const float rstd = 1.0f / sqrtf(wave_sum_dpp(ss) * (1.f / DM) + EPS);
        const f32x4* g4 = (const f32x4*)g + F.lane; const f32x4* sc4 = (const f32x4*)(modl + (size_t)cls * NMOD + off_sc) + F.lane; const f32x4* sh4 = (const f32x4*)(modl + (size_t)cls * NMOD + off_sh) + F.lane;
        u32x2* o2 = (u32x2*)(H + (size_t)row * DM) + F.lane;
#pragma unroll
        for (int j = 0; j < 8; ++j) { const f32x4 gg = g4[64 * j], sc = sc4[64 * j], sh = sh4[64 * j];
            const f32x4 y = (v[j] * rstd) * gg * (sc + 1.0f) + sh;
            u32x2 o; o.x = pk2(y.x, y.y); o.y = pk2(y.z, y.w); o2[64 * j] = o; }
    }
}

__device__ __forceinline__ void prep_odd_phase(const Frame& F0, const bf16_t* P, const float* qg, const float* kg, const float* rope_c, bf16_t* Q, bf16_t* Kb) {
    const Frame F = phase_frame(F0);
    const float g_q1 = qg[F.lane], g_q2 = qg[F.lane + 64], g_k1 = kg[F.lane], g_k2 = kg[F.lane + 64];
    for (int row = F.gw; row < MROWS; row += F.NGW) {
        const int b = row / RB, i = row - b * RB; const bool lat = i >= CTX; const int t = i - CTX;
        float cs = 1.f, sn = 0.f;
        if (lat) { const int pos = (F.lane < 32) ? (t >> 6) : (t & 63); const float* e = rope_c + ((pos << 5) + (F.lane & 31)) * 2; cs = e[0]; sn = e[1]; }
        const bf16_t* pr = P + (size_t)row * 3072;
#pragma unroll 4
        for (int hh = 0; hh < 20; ++hh) {
            const bool isq = hh < 16; const bf16_t* src = pr + hh * 128;
            const float x1 = bf2f(src[F.lane]), x2 = bf2f(src[F.lane + 64]);
            const float rstd = 1.0f / sqrtf(wave_sum_dpp(x1 * x1 + x2 * x2) * (1.f / 128.f) + EPS);
            const float y1 = x1 * rstd * (isq ? g_q1 : g_k1), y2 = x2 * rstd * (isq ? g_q2 : g_k2);
            const float o1 = y1 * cs - y2 * sn, o2 = y2 * cs + y1 * sn;
            bf16_t* dst = isq ? (Q + (size_t)row * 2048 + hh * 128) : (Kb + (size_t)row * 512 + (hh - 16) * 128);
            dst[F.lane] = (bf16_t)f2bf(o1); dst[F.lane + 64] = (bf16_t)f2bf(o2);
        }
    }
}

__device__ __forceinline__ void prep_even_phase(const Frame& F0, const bf16_t* P, const bf16_t* QR, const bf16_t* KVR, const float* qg, const float* kg, const float* rope_a, bf16_t* Q, bf16_t* Kb, bf16_t* Vb) {
    const Frame F = phase_frame(F0);
    const float gq0 = qg[F.lane], gq1 = qg[F.lane + 64], gq2 = qg[F.lane + 128], gk0 = kg[F.lane], gk1 = kg[F.lane + 64], gk2 = kg[F.lane + 128];
    for (int row = F.gw; row < MROWS; row += F.NGW) {
        const int b = row / RB, i = row - b * RB; const bool lat = i >= CTX; const int t = i - CTX;
        float cs = 1.f, sn = 0.f;
        if (lat) { const int j = F.lane & 31; const int pos = (j < 16) ? (t >> 6) : (t & 63); const float* e = rope_a + ((pos << 4) + (j & 15)) * 2; cs = e[0]; sn = e[1]; }
        const float sgn = (F.lane < 32) ? -1.f : 1.f;
        const bf16_t* pr = P + (size_t)row * 4096;
        float ssq = 0.f, sskv = 0.f;
        { const u32x4 w = *(const u32x4*)(pr + F.lane * 8); const unsigned ww[4] = {w.x, w.y, w.z, w.w};
#pragma unroll
          for (int q = 0; q < 4; ++q) { const float a = bf_lo(ww[q]), c = bf_hi(ww[q]); ssq += a * a + c * c; } }
        { const u32x2 w = *(const u32x2*)(pr + 512 + F.lane * 4); const float a = bf_lo(w.x), c = bf_hi(w.x), d = bf_lo(w.y), e = bf_hi(w.y); sskv = (a * a + c * c) + (d * d + e * e); }
        const float rstd_q = 1.0f / sqrtf(wave_sum_dpp(ssq) * (1.f / 512.f) + EPS), rstd_kv = 1.0f / sqrtf(wave_sum_dpp(sskv) * (1.f / 256.f) + EPS);
        const float kr = bf2f(pr[768 + F.lane]);
        const bf16_t* qr = QR + (size_t)row * 1536; const bf16_t* kvr = KVR + (size_t)row * 2048;
        bf16_t* qo = Q + (size_t)row * 1536; bf16_t* ko = Kb + (size_t)row * 1536; bf16_t* vo = Vb + (size_t)row * 1024;
#pragma unroll 2
        for (int h = 0; h < 8; ++h) {
            {
                const float x0 = bf2f(qr[h * 192 + F.lane]) * rstd_q, x1 = bf2f(qr[h * 192 + 64 + F.lane]) * rstd_q, x2 = bf2f(qr[h * 192 + 128 + F.lane]) * rstd_q;
                const float r2 = 1.0f / sqrtf(wave_sum_dpp(x0 * x0 + x1 * x1 + x2 * x2) * (1.f / 192.f) + EPS);
                const float y0 = x0 * r2 * gq0, y1 = x1 * r2 * gq1, y2 = x2 * r2 * gq2;
                const float yp = swap32(y2, F.lane);
                const float o2 = y2 * cs + sgn * yp * sn;
                qo[h * 192 + F.lane] = (bf16_t)f2bf(y0); qo[h * 192 + 64 + F.lane] = (bf16_t)f2bf(y1); qo[h * 192 + 128 + F.lane] = (bf16_t)f2bf(o2);
            }
            {
                const float x0 = bf2f(kvr[h * 256 + F.lane]) * rstd_kv, x1 = bf2f(kvr[h * 256 + 64 + F.lane]) * rstd_kv;
                const float r2 = 1.0f / sqrtf(wave_sum_dpp(x0 * x0 + x1 * x1 + kr * kr) * (1.f / 192.f) + EPS);
                const float y0 = x0 * r2 * gk0, y1 = x1 * r2 * gk1, y2 = kr * r2 * gk2;
                const float yp = swap32(y2, F.lane);
                const float o2 = y2 * cs + sgn * yp * sn;
                ko[h * 192 + F.lane] = (bf16_t)f2bf(y0); ko[h * 192 + 64 + F.lane] = (bf16_t)f2bf(y1); ko[h * 192 + 128 + F.lane] = (bf16_t)f2bf(o2);
                const float v0 = bf2f(kvr[h * 256 + 128 + F.lane]) * rstd_kv, v1 = bf2f(kvr[h * 256 + 192 + F.lane]) * rstd_kv;
                vo[h * 128 + F.lane] = (bf16_t)f2bf(v0); vo[h * 128 + 64 + F.lane] = (bf16_t)f2bf(v1);
            }
        }
    }
}

__device__ __forceinline__ void conv_phase(const Frame& F0, const bf16_t* P, const float* cw  , const float* cb  , bf16_t* CAT) {
    const Frame F = phase_frame(F0);
    const int gt = F.vcu * NTHREADS + F.tid, GT = F.G * NTHREADS;
    for (int it = gt; it < MROWS * 128; it += GT) {
        const int row = it >> 7, c0 = (it & 127) * 8; const int b = row / RB, i = row - b * RB;
        const bool first = (i == 0) || (i == CTX), last = (i == CTX - 1) || (i == RB - 1);
        const bf16_t* pr = P + (size_t)row * 4096 + 832 + c0;
        const u32x4 bg = *(const u32x4*)pr, cg = *(const u32x4*)(pr + 1024), hz = *(const u32x4*)(pr + 2048);
        u32x4 cgm = {0u, 0u, 0u, 0u}, hzm = cgm, cgp = cgm, hzp = cgm;
        if (!first) { cgm = *(const u32x4*)(pr - 4096 + 1024); hzm = *(const u32x4*)(pr - 4096 + 2048); }
        if (!last) { cgp = *(const u32x4*)(pr + 4096 + 1024); hzp = *(const u32x4*)(pr + 4096 + 2048); }
        const unsigned bgw[4] = {bg.x, bg.y, bg.z, bg.w}, cgw[4] = {cg.x, cg.y, cg.z, cg.w}, hzw[4] = {hz.x, hz.y, hz.z, hz.w};
        const unsigned cmw[4] = {cgm.x, cgm.y, cgm.z, cgm.w}, hmw[4] = {hzm.x, hzm.y, hzm.z, hzm.w}, cpw[4] = {cgp.x, cgp.y, cgp.z, cgp.w}, hpw[4] = {hzp.x, hzp.y, hzp.z, hzp.w};
        unsigned ow[4];
#pragma unroll
        for (int q = 0; q < 4; ++q) {
            const int c = c0 + 2 * q;
            const float u0a = bf_lo(cgw[q]) * bf_lo(hzw[q]), u0b = bf_hi(cgw[q]) * bf_hi(hzw[q]);
            const float uma = bf_lo(cmw[q]) * bf_lo(hmw[q]), umb = bf_hi(cmw[q]) * bf_hi(hmw[q]);
            const float upa = bf_lo(cpw[q]) * bf_lo(hpw[q]), upb = bf_hi(cpw[q]) * bf_hi(hpw[q]);
            const float ra = bf_lo(bgw[q]) * (uma * cw[c] + u0a * cw[1024 + c] + upa * cw[2048 + c] + cb[c]);
            const float rb = bf_hi(bgw[q]) * (umb * cw[c + 1] + u0b * cw[1024 + c + 1] + upb * cw[2048 + c + 1] + cb[c + 1]);
            ow[q] = pk2(ra, rb);
        }
        *(u32x4*)(CAT + (size_t)row * DM + 1024 + c0) = (u32x4){ow[0], ow[1], ow[2], ow[3]};
    }
}
__device__ __forceinline__ void attn_even_phase(const Frame& F0, const bf16_t* Q, const bf16_t* Kb, const bf16_t* Vb, bf16_t* CAT) {
    const Frame F = phase_frame(F0);
    for (int u = F.vcu; u < 272; u += F.G) {
        int b, h, qt, nk;
        if (u < 256) { b = u >> 7; h = (u >> 4) & 7; qt = 1 + (u & 15); nk = RB; } else { const int v = u - 256; b = v >> 3; h = v & 7; qt = 0; nk = CTX; }
        const size_t r0 = (size_t)b * RB;
        att::attn_body1<192, 1536, 1536, 1024, 2048>(Q + (r0 + qt * 256) * 1536 + h * 192, Kb + r0 * 1536 + h * 192, Vb + r0 * 1024 + h * 128, CAT + (r0 + qt * 256) * 2048 + h * 128, nk, (char*)F.lds, phase_tid(F.wave));
    }
}
__device__ __forceinline__ void attn_odd_phase(const Frame& F0, const bf16_t* Q, const bf16_t* Kb, const bf16_t* P, bf16_t* CAT) {
    const Frame F = phase_frame(F0);
    for (int u = F.vcu; u < 544; u += F.G) {
        int b, hq, qt, nk;
        if (u < 512) { b = u >> 8; hq = (u >> 4) & 15; qt = 1 + (u & 15); nk = RB; } else { const int v = u - 512; b = v >> 4; hq = v & 15; qt = 0; nk = CTX; }
        const int kvh = hq >> 2; const size_t r0 = (size_t)b * RB;
        att::attn_body1<128, 2048, 512, 3072, 2048>(Q + (r0 + qt * 256) * 2048 + hq * 128, Kb + r0 * 512 + kvh * 128, P + r0 * 3072 + 2560 + kvh * 128, CAT + (r0 + qt * 256) * 2048 + hq * 128, nk, (char*)F.lds, phase_tid(F.wave));
    }
}

__device__ __forceinline__ int crow32(int r, int hi) { return (r & 3) + 8 * (r >> 2) + 4 * hi; }
__device__ __forceinline__ float swapmax(float m) { auto rr = __builtin_amdgcn_permlane32_swap(__float_as_uint(m), __float_as_uint(m), false, false); return fmaxf(__uint_as_float(rr[0]), __uint_as_float(rr[1])); }
__device__ __forceinline__ void peer_topk_phase(const Frame& F0, const bf16_t* PQ, const bf16_t* subk  , int* IDX, float* GATE) {
    const Frame F = phase_frame(F0);
    const float NEG = -3.0e38f;
    for (int task = F.gw; task < (MROWS / 32) * 8; task += F.NGW) {
        int lane_ = F.lane; asm volatile("" : "+v"(lane_));
        const int r32 = lane_ & 31, hi = lane_ >> 5;
        const int tg = task >> 3, h = task & 7; const int token = tg * 32 + r32;
        float top[2][16];
#pragma unroll
        for (int j = 0; j < 16; ++j) { top[0][j] = NEG; top[1][j] = NEG; }
#pragma unroll
        for (int p = 0; p < 2; ++p) {
            bf16x8 bq[8];
            const bf16_t* qp = PQ + (size_t)token * DM + h * 256 + p * 128 + hi * 8;
#pragma unroll
            for (int ks = 0; ks < 8; ++ks) bq[ks] = *(const bf16x8*)(qp + ks * 16);
            const bf16_t* kp = subk + (size_t)(h * 2 + p) * 128 * 128 + (size_t)r32 * 128 + hi * 8;
            float s[64];
#pragma unroll
            for (int nb = 0; nb < 4; ++nb) {
                f32x16 acc = {};
#pragma unroll
                for (int ks = 0; ks < 8; ++ks) { const bf16x8 a = *(const bf16x8*)(kp + (size_t)nb * 32 * 128 + ks * 16); acc = __builtin_amdgcn_mfma_f32_32x32x16_bf16(a, bq[ks], acc, 0, 0, 0); }
#pragma unroll
                for (int r = 0; r < 16; ++r) { const int key = nb * 32 + crow32(r, hi); s[nb * 16 + r] = __uint_as_float((__float_as_uint(acc[r]) & ~127u) | (unsigned)(127 - key)); }
                asm volatile("" ::: "memory");
            }
#pragma unroll 1
            for (int it = 0; it < 16; ++it) {
                float m = s[0];
#pragma unroll
                for (int i = 1; i < 64; ++i) m = fmaxf(m, s[i]);
                m = swapmax(m);
#pragma unroll
                for (int i = 0; i < 64; ++i) s[i] = (s[i] == m) ? NEG : s[i];
#pragma unroll
                for (int j = 0; j < 16; ++j) top[p][j] = (j == it) ? m : top[p][j];
            }
        }
        float cand[25];
        {
            int n = 0;
#pragma unroll
            for (int a = 0; a < 16; ++a)
#pragma unroll
                for (int b = 0; b < 16; ++b) if ((a + 1) * (b + 1) <= 16) {
                    const int slot = n >> 1, which = n & 1; ++n;
                    const float v = top[0][a] + top[1][b];
                    const float pv = __uint_as_float((__float_as_uint(v) & ~255u) | (unsigned)(255 - (a * 16 + b)));
                    if (which == 0) cand[slot] = pv; else cand[slot] = hi ? pv : cand[slot];
                }
        }
        float win[16];
#pragma unroll
        for (int j = 0; j < 16; ++j) win[j] = NEG;
#pragma unroll 1
        for (int it = 0; it < 16; ++it) {
            float m = cand[0];
#pragma unroll
            for (int i = 1; i < 25; ++i) m = fmaxf(m, cand[i]);
            m = swapmax(m);
#pragma unroll
            for (int i = 0; i < 25; ++i) cand[i] = (cand[i] == m) ? NEG : cand[i];
#pragma unroll
            for (int j = 0; j < 16; ++j) win[j] = (j == it) ? m : win[j];
        }
        float ev[16]; float esum = 0.f; const float v0 = __uint_as_float(__float_as_uint(win[0]) & ~255u);
#pragma unroll
        for (int j = 0; j < 16; ++j) { const float v = __uint_as_float(__float_as_uint(win[j]) & ~255u); ev[j] = __expf(v - v0); esum += ev[j]; }
        const float rs = 1.0f / esum;
        int oi[8]; float og[8];
#pragma unroll
        for (int j = 0; j < 8; ++j) {
            const float w = hi ? win[8 + j] : win[j]; const float e = hi ? ev[8 + j] : ev[j];
            const int id = 255 - (int)(__float_as_uint(w) & 255u), a = id >> 4, b = id & 15;
            float ta = top[0][0], tb = top[1][0];
#pragma unroll
            for (int q = 1; q < 16; ++q) { ta = (a == q) ? top[0][q] : ta; tb = (b == q) ? top[1][q] : tb; }
            const int ka = 127 - (int)(__float_as_uint(ta) & 127u), kb = 127 - (int)(__float_as_uint(tb) & 127u);
            oi[j] = ka * 128 + kb; og[j] = e * rs;
        }
        int* ip = IDX + (size_t)token * 128 + h * 16 + hi * 8; float* gp = GATE + (size_t)token * 128 + h * 16 + hi * 8;
        *(int4*)ip = make_int4(oi[0], oi[1], oi[2], oi[3]); *(int4*)(ip + 4) = make_int4(oi[4], oi[5], oi[6], oi[7]);
        *(f32x4*)gp = (f32x4){og[0], og[1], og[2], og[3]}; *(f32x4*)(gp + 4) = (f32x4){og[4], og[5], og[6], og[7]};
    }
}

__device__ __forceinline__ void peer_expert_phase(const Frame& F0, const bf16_t* H2, const int* IDX, const float* GATE, const unsigned char* U, size_t v_minus_u_bytes, const float* USC, const float* VSC,
                                                  const float* g2  , float* XW, float* OUT) {
    const Frame F = phase_frame(F0);
    LAS float* red = (LAS float*)F.lds;
    const unsigned voff_tab = (unsigned)v_minus_u_bytes;
    const __amdgpu_buffer_rsrc_t rs = __builtin_amdgcn_make_buffer_rsrc((void*)U, 0, (int)(voff_tab + (unsigned)NEXP * DM), 0x00020000);
    const int lane = F.lane; const int voff = lane * 16;
#define PX_SB() __builtin_amdgcn_sched_barrier(0)
#define PX_LOAD(buf, s, ivv) do { constexpr int e0_ = ((s) & 3) * 4; const unsigned tb_ = ((s) >= 4) ? voff_tab : 0u; \
        _Pragma("unroll") for (int ee_ = 0; ee_ < 4; ++ee_) { const unsigned o_ = (unsigned)__builtin_amdgcn_readlane(ivv, e0_ + ee_) * 2048u + tb_; \
            buf[ee_][0] = __builtin_amdgcn_raw_buffer_load_b128(rs, voff, o_, 0); buf[ee_][1] = __builtin_amdgcn_raw_buffer_load_b128(rs, voff + 1024, o_, 0); } } while (0)
#define PX_COMP_U(buf, s) do { constexpr int e0_ = ((s) & 3) * 4; \
            _Pragma("unroll") for (int ee_ = 0; ee_ < 4; ++ee_) { f32x2 a_ = {0.f, 0.f}; \
                _Pragma("unroll") for (int j_ = 0; j_ < 2; ++j_) { unsigned ww_[4] = {buf[ee_][j_].x, buf[ee_][j_].y, buf[ee_][j_].z, buf[ee_][j_].w}; \
                    _Pragma("unroll") for (int q_ = 0; q_ < 4; ++q_) { asm volatile("" : "+v"(ww_[q_]) : "v"(a_.x));     \
                        const f32x2 lo_ = __builtin_amdgcn_cvt_pk_f32_fp8((int)ww_[q_], false), hi_ = __builtin_amdgcn_cvt_pk_f32_fp8((int)ww_[q_], true); \
                        a_ += lo_ * (f32x2){xf[j_ * 16 + q_ * 4], xf[j_ * 16 + q_ * 4 + 1]}; a_ += hi_ * (f32x2){xf[j_ * 16 + q_ * 4 + 2], xf[j_ * 16 + q_ * 4 + 3]}; } } \
                const float t_ = wave_sum_dpp(a_.x + a_.y); sv = (lane == e0_ + ee_) ? t_ : sv; } } while (0)
#define PX_COMP_V(buf, s) do { constexpr int e0_ = ((s) & 3) * 4; \
            _Pragma("unroll") for (int ee_ = 0; ee_ < 4; ++ee_) { const float wg_ = __uint_as_float(__builtin_amdgcn_readlane(__float_as_uint(wv), e0_ + ee_)); \
                _Pragma("unroll") for (int j_ = 0; j_ < 2; ++j_) { unsigned ww_[4] = {buf[ee_][j_].x, buf[ee_][j_].y, buf[ee_][j_].z, buf[ee_][j_].w}; \
                    _Pragma("unroll") for (int q_ = 0; q_ < 4; ++q_) { asm volatile("" : "+v"(ww_[q_]) : "v"(acc[(j_ * 16 + q_ * 4 + 28) & 31])); \
                        const f32x2 lo_ = __builtin_amdgcn_cvt_pk_f32_fp8((int)ww_[q_], false), hi_ = __builtin_amdgcn_cvt_pk_f32_fp8((int)ww_[q_], true); \
                        acc[j_ * 16 + q_ * 4] += wg_ * lo_.x; acc[j_ * 16 + q_ * 4 + 1] += wg_ * lo_.y; acc[j_ * 16 + q_ * 4 + 2] += wg_ * hi_.x; acc[j_ * 16 + q_ * 4 + 3] += wg_ * hi_.y; } } } } while (0)
#define PX_FETCH_TOKEN(r, XP, IV, GV) do { const u32x4* xp_ = (const u32x4*)(H2 + (size_t)(r) * DM + lane * 16); XP[0] = xp_[0]; XP[1] = xp_[1]; XP[2] = xp_[128]; XP[3] = xp_[129]; \
        IV = 0; GV = 0.f; if (lane < 16) { IV = IDX[(size_t)(r) * 128 + F.wave * 16 + lane]; GV = GATE[(size_t)(r) * 128 + F.wave * 16 + lane]; } } while (0)
    const bool skip_ctx = (OUT != nullptr);
    int row = F.vcu; if (skip_ctx && row < MROWS && row_cls(row) == 2) row += F.G;
    u32x4 xp[4]; int iv; float gv;
    u32x4 bA[4][2], bB[4][2];
    if (row < MROWS) { PX_FETCH_TOKEN(row, xp, iv, gv); PX_LOAD(bA, 0, iv); }
    int par = 0;
    while (row < MROWS) {
        int nrow = row + F.G; if (skip_ctx && nrow < MROWS && row_cls(nrow) == 2) nrow += F.G;
        float xf[32];
#pragma unroll
        for (int q = 0; q < 4; ++q) { const unsigned ww[4] = {xp[q].x, xp[q].y, xp[q].z, xp[q].w};
#pragma unroll
            for (int k = 0; k < 4; ++k) { xf[q * 8 + 2 * k] = bf_lo(ww[k]); xf[q * 8 + 2 * k + 1] = bf_hi(ww[k]); } }
        float usc = 0.f, vsc = 0.f;
        if (lane < 16) { usc = USC[iv]; vsc = VSC[iv]; }
        u32x4 xpn[4]; int ivn = 0; float gvn = 0.f;
        if (nrow < MROWS) PX_FETCH_TOKEN(nrow, xpn, ivn, gvn);
        float sv = 0.f, wv = 0.f;
        PX_LOAD(bB, 1, iv); PX_SB(); PX_COMP_U(bA, 0); PX_SB();
        PX_LOAD(bA, 2, iv); PX_SB(); PX_COMP_U(bB, 1); PX_SB();
        PX_LOAD(bB, 3, iv); PX_SB(); PX_COMP_U(bA, 2); PX_SB();
        PX_LOAD(bA, 4, iv); PX_SB(); PX_COMP_U(bB, 3); PX_SB();
        wv = gelu_erf(sv * usc) * gv * vsc;
        float acc[32];
#pragma unroll
        for (int q = 0; q < 32; ++q) acc[q] = 0.f;
        PX_LOAD(bB, 5, iv); PX_SB(); PX_COMP_V(bA, 4); PX_SB();
        PX_LOAD(bA, 6, iv); PX_SB(); PX_COMP_V(bB, 5); PX_SB();
        PX_LOAD(bB, 7, iv); PX_SB(); PX_COMP_V(bA, 6); PX_SB();
        if (nrow < MROWS) PX_LOAD(bA, 0, ivn);
        PX_SB(); PX_COMP_V(bB, 7); PX_SB();
        LAS float* rb = red + par * (NWAVES * DM);
#pragma unroll
        for (int j = 0; j < 2; ++j)
#pragma unroll
            for (int q = 0; q < 4; ++q) *(LAS f32x4*)(rb + F.wave * DM + j * 1024 + lane * 16 + q * 4) = (f32x4){acc[j * 16 + q * 4], acc[j * 16 + q * 4 + 1], acc[j * 16 + q * 4 + 2], acc[j * 16 + q * 4 + 3]};
        __syncthreads();
        {
            f32x4 sm = {0.f, 0.f, 0.f, 0.f};
#pragma unroll
            for (int w = 0; w < 8; ++w) sm += *(const LAS f32x4*)(rb + w * DM + F.tid * 4);
            const int cls = row_cls(row);
            const f32x4 g = *(const f32x4*)(g2 + (size_t)cls * NMOD + F.tid * 4);
            f32x4* xq = (f32x4*)(XW + (size_t)row * DM) + F.tid;
            const f32x4 xn = *xq + g * sm;
            *xq = xn;
            if (OUT) { const int b = row / RB, i = row - b * RB; if (i >= CTX) *((f32x4*)(OUT + ((size_t)b * SEQ + (i - CTX)) * DM) + F.tid) = xn; }
        }
        par ^= 1; row = nrow;
#pragma unroll
        for (int q = 0; q < 4; ++q) xp[q] = xpn[q];
        iv = ivn; gv = gvn;
    }
#undef PX_LOAD
#undef PX_COMP_U
#undef PX_COMP_V
#undef PX_SB
#undef PX_FETCH_TOKEN
}
#ifndef N_LAUNCHES
#define N_LAUNCHES 1
#endif
struct Args { const float* in[26]; float* out; unsigned char* ws; int ph_lo, ph_hi; };
constexpr int NPHASES = 39;
__global__ void __launch_bounds__(NTHREADS, 2) fwd_kernel(Args args) {
    extern __shared__ __attribute__((aligned(16))) unsigned char lds_raw[];
    Frame F_;
    F_.lds = (LAS unsigned char*)lds_raw;
    F_.tid = threadIdx.x; F_.lane = F_.tid & 63; F_.wave = __builtin_amdgcn_readfirstlane(F_.tid >> 6);
    F_.G = gridDim.x; { const int bx = blockIdx.x; F_.vcu = (F_.G % 8 == 0) ? (bx % 8) * (F_.G / 8) + bx / 8 : bx; }
    F_.gw = F_.vcu * NWAVES + F_.wave; F_.NGW = F_.G * NWAVES;
    F_.ws = args.ws;
    volatile LAS unsigned* MISC = (volatile LAS unsigned*)(F_.lds + LDS_MISC);
    if (F_.tid < 32) MISC[F_.tid] = 0u;
    __syncthreads();
    const int lo = args.ph_lo, hi = args.ph_hi;
    XcdBarrier bar; bar.bar = (unsigned*)(args.ws + WS_CTL) + CW_BAR; bar.x = 0; bar.st = nullptr;
    if (N_LAUNCHES == 1 || hi - lo > 1) bar = xcd_barrier_post((unsigned*)(args.ws + WS_CTL) + CW_BAR, MISC + 8);
#if N_LAUNCHES == 1
#define IN(k) true
#define SEAM(k) xcd_barrier(bar)
#else
#define IN(k) (lo <= (k) && (k) < hi)
#define SEAM(k) do { if (IN(k) && IN((k) + 1)) xcd_barrier(bar); } while (0)
#endif
    PG8_LAS unsigned char* glds = (PG8_LAS unsigned char*)lds_raw;

    if (IN(0)) { p0_prologue(F_, args.in); } SEAM(0);

#pragma unroll 1
    for (int lp = 0; lp < 2; ++lp) {
        const int pb = 1 + lp * 19;
        unsigned char* ws = args.ws; asm volatile("" : "+s"(ws));
        Frame F = F_; { int w_ = F_.wave, v_ = F_.vcu, g_ = F_.G; asm volatile("" : "+s"(w_), "+s"(v_), "+s"(g_)); F.wave = w_; F.vcu = v_; F.G = g_; F.gw = v_ * NWAVES + w_; F.NGW = g_ * NWAVES; F.ws = ws; }
        float* mod = (float*)(ws + WS_MOD); float* XW = (float*)(ws + WS_XW);
        bf16_t* H = (bf16_t*)(ws + WS_H); bf16_t* P = (bf16_t*)(ws + WS_P); bf16_t* QRAW = (bf16_t*)(ws + WS_QRAW); bf16_t* KVRAW = (bf16_t*)(ws + WS_KVRAW);
        bf16_t* Q = (bf16_t*)(ws + WS_Q); bf16_t* KB = (bf16_t*)(ws + WS_K); bf16_t* VB = (bf16_t*)(ws + WS_V); bf16_t* CAT = (bf16_t*)(ws + WS_CAT); bf16_t* PQ = (bf16_t*)(ws + WS_PQ);
        int* IDX = (int*)(ws + WS_IDX); float* GATE = (float*)(ws + WS_GATE);
        const float* rope_c = (const float*)(ws + WS_ROPE); const float* rope_a = rope_c + 64 * 32 * 2;
        const float* SMv = (const float*)(ws + WS_SMALL);
        {
            const int l = 2 * lp, i = lp;
            const float* modl = mod + (size_t)l * 3 * NMOD;
            if (IN(pb + 0)) { norm_phase(F, XW, SMv + SM_N1G + l * DM, modl, 0, 2048, H); } SEAM(pb + 0);
            if (IN(pb + 1)) {
                pg8::Gemm g{H, (const bf16_t*)(ws + WS_WIN) + (size_t)i * 4096 * DM, MROWS, 4096, DM, DM, DM}; pg8::StaticOrder S; S.init(MROWS, 4096, F.G, (int)blockIdx.x);
                pg8::EpiBf16 E{P, 4096};
                pg8::gemm_phase<pg8::EpiBf16, pg8::StaticOrder, true, true>(glds, g, S, E, phase_tid(F.wave));
            } SEAM(pb + 1);
            if (IN(pb + 2)) {
                { pg8::Gemm g{P, (const bf16_t*)(ws + WS_WUQ) + (size_t)i * 1536 * 512, MROWS, 1536, 512, 4096, 512}; pg8::StaticOrder S; S.init(MROWS, 1536, F.G, (int)blockIdx.x);
                  pg8::EpiBf16 E{QRAW, 1536};
                  pg8::gemm_phase<pg8::EpiBf16, pg8::StaticOrder, true, true>(glds, g, S, E, phase_tid(F.wave)); }
                __syncthreads();
                { pg8::Gemm g{P + 512, (const bf16_t*)(ws + WS_WUKV) + (size_t)i * 2048 * 256, MROWS, 2048, 256, 4096, 256}; pg8::StaticOrder S; S.init(MROWS, 2048, F.G, (int)blockIdx.x);
                  pg8::EpiBf16 E{KVRAW, 2048};
                  pg8::gemm_phase<pg8::EpiBf16, pg8::StaticOrder, true, true>(glds, g, S, E, phase_tid(F.wave)); }
                __syncthreads();
                conv_phase(F, P, SMv + SM_CW + i * 3072, SMv + SM_CB + i * 1024, CAT);
            } SEAM(pb + 2);
            if (IN(pb + 3)) { prep_even_phase(F, P, QRAW, KVRAW, SMv + SM_AQG + i * 192, SMv + SM_AKG + i * 192, rope_a, Q, KB, VB); } SEAM(pb + 3);
            if (IN(pb + 4)) { attn_even_phase(F, Q, KB, VB, CAT); } SEAM(pb + 4);
            if (IN(pb + 5)) {
                pg8::Gemm g{CAT, (const bf16_t*)(ws + WS_WEO) + (size_t)i * DM * DM, MROWS, DM, DM, DM, DM}; pg8::StaticOrder S; S.init(MROWS, DM, F.G, (int)blockIdx.x);
                pg8::EpiResid E{XW, DM, modl + 4096};
                pg8::gemm_phase<pg8::EpiResid, pg8::StaticOrder, true, true>(glds, g, S, E, phase_tid(F.wave));
            } SEAM(pb + 5);
            if (IN(pb + 6)) { norm_phase(F, XW, SMv + SM_N2G + l * DM, modl, 6144, 8192, H); } SEAM(pb + 6);
            if (IN(pb + 7)) {
                pg8::Gemm g{H, (const bf16_t*)(ws + WS_WPQ) + (size_t)l * DM * DM, MROWS, DM, DM, DM, DM}; pg8::StaticOrder S; S.init(MROWS, DM, F.G, (int)blockIdx.x);
                pg8::EpiBf16 E{PQ, DM};
                pg8::gemm_phase<pg8::EpiBf16, pg8::StaticOrder, true, true>(glds, g, S, E, phase_tid(F.wave));
            } SEAM(pb + 7);
            if (IN(pb + 8)) { peer_topk_phase(F, PQ, (const bf16_t*)(ws + WS_SUBK) + (size_t)l * 16 * 128 * 128, IDX, GATE); } SEAM(pb + 8);
            if (IN(pb + 9)) { peer_expert_phase(F, H, IDX, GATE, ws + WS_U + (size_t)l * NEXP * DM, (size_t)(WS_VT - WS_U), (const float*)(ws + WS_USC) + l * NEXP, (const float*)(ws + WS_VSC) + l * NEXP, modl + 10240, XW, nullptr); } SEAM(pb + 9);
        }
        {
            const int l = 2 * lp + 1, i = lp, qb = pb + 10;
            const float* modl = mod + (size_t)l * 3 * NMOD;
            if (IN(qb + 0)) { norm_phase(F, XW, SMv + SM_N1G + l * DM, modl, 0, 2048, H); } SEAM(qb + 0);
            if (IN(qb + 1)) {
                pg8::Gemm g{H, (const bf16_t*)(ws + WS_WQKV) + (size_t)i * 3072 * DM, MROWS, 3072, DM, DM, DM}; pg8::StaticOrder S; S.init(MROWS, 3072, F.G, (int)blockIdx.x);
                pg8::EpiBf16 E{P, 3072};
                pg8::gemm_phase<pg8::EpiBf16, pg8::StaticOrder, true, true>(glds, g, S, E, phase_tid(F.wave));
            } SEAM(qb + 1);
            if (IN(qb + 2)) { prep_odd_phase(F, P, SMv + SM_CQG + i * 128, SMv + SM_CKG + i * 128, rope_c, Q, KB); } SEAM(qb + 2);
            if (IN(qb + 3)) { attn_odd_phase(F, Q, KB, P, CAT); } SEAM(qb + 3);
            if (IN(qb + 4)) {
                pg8::Gemm g{CAT, (const bf16_t*)(ws + WS_WCO) + (size_t)i * DM * DM, MROWS, DM, DM, DM, DM}; pg8::StaticOrder S; S.init(MROWS, DM, F.G, (int)blockIdx.x);
                pg8::EpiResid E{XW, DM, modl + 4096};
                pg8::gemm_phase<pg8::EpiResid, pg8::StaticOrder, true, true>(glds, g, S, E, phase_tid(F.wave));
            } SEAM(qb + 4);
            if (IN(qb + 5)) { norm_phase(F, XW, SMv + SM_N2G + l * DM, modl, 6144, 8192, H); } SEAM(qb + 5);
            if (IN(qb + 6)) {
                pg8::Gemm g{H, (const bf16_t*)(ws + WS_WPQ) + (size_t)l * DM * DM, MROWS, DM, DM, DM, DM}; pg8::StaticOrder S; S.init(MROWS, DM, F.G, (int)blockIdx.x);
                pg8::EpiBf16 E{PQ, DM};
                pg8::gemm_phase<pg8::EpiBf16, pg8::StaticOrder, true, true>(glds, g, S, E, phase_tid(F.wave));
            } SEAM(qb + 6);
            if (IN(qb + 7)) { peer_topk_phase(F, PQ, (const bf16_t*)(ws + WS_SUBK) + (size_t)l * 16 * 128 * 128, IDX, GATE); } SEAM(qb + 7);
            if (IN(qb + 8)) { peer_expert_phase(F, H, IDX, GATE, ws + WS_U + (size_t)l * NEXP * DM, (size_t)(WS_VT - WS_U), (const float*)(ws + WS_USC) + l * NEXP, (const float*)(ws + WS_VSC) + l * NEXP, modl + 10240, XW, (l == 3) ? args.out : nullptr); } if (lp == 0) SEAM(qb + 8);
        }
    }
#undef IN
#undef SEAM
}

extern "C" void kernel_launch(void* const* d_in, const int* in_sizes, int n_in, void* d_out, int out_size, void* d_ws, size_t ws_size, hipStream_t stream) {
    static int grid = 0;
    if (grid == 0) {
        if (n_in != 26 || out_size != NBATCH * SEQ * DM || ws_size < WS_END) { fprintf(stderr, "kernel_launch: unexpected shapes: n_in %d out %d ws %zu (need %zu)\n", n_in, out_size, ws_size, (size_t)WS_END); grid = -1; return; }
        int dev = 0, cus = 0, per_cu = 0;
        if (hipGetDevice(&dev) != hipSuccess || hipDeviceGetAttribute(&cus, hipDeviceAttributeMultiprocessorCount, dev) != hipSuccess) { fprintf(stderr, "kernel_launch: device query failed\n"); grid = -1; return; }
        if (hipFuncSetAttribute((const void*)fwd_kernel, hipFuncAttributeMaxDynamicSharedMemorySize, LDS_BYTES) != hipSuccess) { fprintf(stderr, "kernel_launch: hipFuncSetAttribute failed\n"); grid = -1; return; }
        if (hipOccupancyMaxActiveBlocksPerMultiprocessor(&per_cu, (const void*)fwd_kernel, NTHREADS, LDS_BYTES) != hipSuccess || per_cu < 1) { fprintf(stderr, "kernel_launch: occupancy query says %d blocks per CU\n", per_cu); (void)hipGetLastError(); grid = -1; return; }
        grid = cus;
    }
    if (grid < 0) return;
    (void)hipMemsetAsync((char*)d_ws + WS_CTL, 0, CTL_ZERO_BYTES, stream);
    Args a{};
    for (int i = 0; i < 26; ++i) a.in[i] = (const float*)d_in[i];
    a.out = (float*)d_out; a.ws = (unsigned char*)d_ws;
    for (int li = 0; li < N_LAUNCHES; ++li) {
        a.ph_lo = (N_LAUNCHES == 1) ? 0 : li; a.ph_hi = (N_LAUNCHES == 1) ? NPHASES : li + 1;
        hipLaunchKernelGGL(fwd_kernel, dim3(grid), dim3(NTHREADS), LDS_BYTES, stream, a);
        const hipError_t le = hipPeekAtLastError();
        if (le != hipSuccess) { fprintf(stderr, "kernel_launch: launch %d failed: %s\n", li, hipGetErrorName(le)); break; }
    }
}
```

```cpp
#include <hip/hip_runtime.h>
#include <cstdio>
#include <cstdint>
namespace pg8 {
#define PG8_LAS __attribute__((address_space(3)))
typedef unsigned short bf16_t;
typedef short bf16x8 __attribute__((ext_vector_type(8)));
typedef float f32x4 __attribute__((ext_vector_type(4)));
typedef unsigned u32x4 __attribute__((ext_vector_type(4)));
constexpr int BM = 256, BK = 64, HALF = 128, HTB = HALF * BK * 2  , STAGE_BYTES = 8 * HTB, NXCD = 8, WGM = 8;

__host__ __device__ __forceinline__ int lds_byte(int r, int c) { const int st = (r >> 4) * 2 + (c >> 5), rr = r & 15, cc = c & 31, ob = rr * 64 + cc * 2; return st * 1024 + (ob ^ (((ob >> 9) & 1) << 5)); }
__host__ __device__ __forceinline__ void stage_rc(int b, int& R, int& C) { const int st = b / 1024, sb = b % 1024, swz = sb ^ (((sb >> 9) & 1) << 5); R = (st >> 1) * 16 + swz / 64; C = (st & 1) * 32 + (swz % 64) / 2; }
__host__ __device__ __forceinline__ int perm32(int rho) { const int n = rho >> 4, i = rho & 15; return 8 * (i >> 2) + 4 * n + (i & 3); }

struct Unit { int pm, pn; };
struct Gemm { const bf16_t* A; const bf16_t* Bt; int M, N, K, lda, ldb; };

struct StaticOrder {
    int nM, nN, nwg, G, c;
    __host__ __device__ void init(int M, int N, int G_, int c_) { nM = M / BM; nN = N / BM; nwg = nM * nN; G = G_; c = c_; }
    __host__ __device__ bool next(int i, Unit& u) const {
        const long L = (long)i * G + c; if (L >= nwg) return false;
        int wgid = (int)L; { const int q = nwg / NXCD, r = nwg % NXCD, xcd = wgid % NXCD, off = wgid / NXCD; wgid = (xcd < r ? xcd * (q + 1) : r * (q + 1) + (xcd - r) * q) + off; }
        const int nig = WGM * nN, gid = wgid / nig, fm = gid * WGM, gsz = (nM - fm) < WGM ? (nM - fm) : WGM;
        u.pm = fm + ((wgid % nig) % gsz); u.pn = (wgid % nig) / gsz; return true;
    }
    __device__ __forceinline__ void a_ready(const Unit&) const {}
    __device__ __forceinline__ void done(const Unit&) const {}
};
__device__ __forceinline__ unsigned cvt_pk_bf16(float lo, float hi) { unsigned r; asm volatile("v_cvt_pk_bf16_f32 %0, %1, %2" : "=v"(r) : "v"(lo), "v"(hi)); return r; }
typedef float f32x2 __attribute__((ext_vector_type(2)));
struct EpiBf16 {
    static constexpr bool PERM = true, AFTER_DRAIN = false;
    bf16_t* O; int ldc;
    __device__ __forceinline__ void operator()(const f32x4 (&acc)[2][2][4][2], const Unit& u, int wr, int wc, int fr, int fq) const {
        const int row0 = u.pm * BM + wr * 64 + fr, col0 = u.pn * BM + wc * 32 + 8 * fq;
#pragma unroll
        for (int ai = 0; ai < 2; ++ai)
#pragma unroll
            for (int m = 0; m < 4; ++m) { bf16_t* rowp = O + (size_t)(row0 + ai * HALF + m * 16) * ldc + col0;
#pragma unroll
                for (int bj = 0; bj < 2; ++bj) { const f32x4 v0 = acc[ai][bj][m][0], v1 = acc[ai][bj][m][1];
                    u32x4 w; w.x = cvt_pk_bf16(v0[0], v0[1]); w.y = cvt_pk_bf16(v0[2], v0[3]); w.z = cvt_pk_bf16(v1[0], v1[1]); w.w = cvt_pk_bf16(v1[2], v1[3]);
                    *(u32x4*)(rowp + bj * HALF) = w; } }
    }
};
struct EpiResid {
    static constexpr bool PERM = false, AFTER_DRAIN = false;
    float* X; int ldc; const float* gate;
    __device__ __forceinline__ void operator()(const f32x4 (&acc)[2][2][4][2], const Unit& u, int wr, int wc, int fr, int fq) const {
        const int row0 = u.pm * BM + wr * 64 + fr, col0 = u.pn * BM + wc * 32 + 4 * fq;
        const int cls = (u.pm % 17 == 0) ? 2 : (u.pm / 17);
        const float* gp = gate + (size_t)cls * 12288 + col0;
        f32x4 gv[2][2];
#pragma unroll
        for (int bj = 0; bj < 2; ++bj)
#pragma unroll
            for (int n = 0; n < 2; ++n) gv[bj][n] = *(const f32x4*)(gp + bj * HALF + n * 16);
#pragma unroll
        for (int ai = 0; ai < 2; ++ai)
#pragma unroll
            for (int m = 0; m < 4; ++m) { float* rowp = X + (size_t)(row0 + ai * HALF + m * 16) * ldc + col0;
#pragma unroll
                for (int bj = 0; bj < 2; ++bj)
#pragma unroll
                    for (int n = 0; n < 2; ++n) { f32x4* p = (f32x4*)(rowp + bj * HALF + n * 16); *p = *p + gv[bj][n] * acc[ai][bj][m][n]; } }
    }
};
template <class Epi, class Sched, bool ALIGN_EPI = false, bool SP2 = false>
__device__ __forceinline__ void gemm_phase(PG8_LAS unsigned char* lds, const Gemm g, const Sched& S, const Epi& E, int tid_in) {
    int tid_ = tid_in; asm volatile("" : "+v"(tid_));
    const int tid = tid_, wid = __builtin_amdgcn_readfirstlane(tid >> 6), lane = tid & 63, wr = wid >> 2, wc = wid & 3, fr = lane & 15, fq = lane >> 4;
    const int K = g.K, nt = K / BK;
    unsigned voffA[2], voffB[2];
#pragma unroll
    for (int i = 0; i < 2; ++i) { int R, C; stage_rc(tid * 16 + i * 8192, R, C); const int Rb = Epi::PERM ? ((R & ~31) + perm32(R & 31)) : R;
        voffA[i] = (unsigned)(R * g.lda + C) * 2u; voffB[i] = (unsigned)(Rb * g.ldb + C) * 2u; }
    const size_t kstep = (size_t)(BK * 2);
    const size_t hstepA = (size_t)HALF * g.lda * 2, hstepB = (size_t)HALF * g.ldb * 2;
    const size_t tstepA = 2 * hstepA, tstepB = 2 * hstepB;
    const unsigned ldsw = (unsigned)wid * 1024u;
    const int aoff = lds_byte(wr * 64 + fr, fq * 8), boff = lds_byte(wc * 32 + fr, fq * 8);
#define PG8_SA(b, h) (((b) * 2 + (h)) * HTB)
#define PG8_SB(b, h) ((4 + (b) * 2 + (h)) * HTB)
#define PG8_STAGE(bufoff, gbase, voff) do { _Pragma("unroll") for (int _i = 0; _i < 2; ++_i) \
        __builtin_amdgcn_global_load_lds((const unsigned*)((const char*)(gbase) + (voff)[_i]), (PG8_LAS unsigned*)(lds + (bufoff) + ldsw + _i * 8192), 16, 0, 0); } while (0)
#define PG8_LDA(dst, b, h) do { _Pragma("unroll") for (int m = 0; m < 4; ++m) _Pragma("unroll") for (int k = 0; k < 2; ++k) dst[m][k] = *(const PG8_LAS bf16x8*)(lds + PG8_SA(b, h) + aoff + m * 2048 + k * 1024); } while (0)
#define PG8_LDB(dst, b, h) do { _Pragma("unroll") for (int n = 0; n < 2; ++n) _Pragma("unroll") for (int k = 0; k < 2; ++k) dst[n][k] = *(const PG8_LAS bf16x8*)(lds + PG8_SB(b, h) + boff + n * 2048 + k * 1024); } while (0)
#define PG8_MMA(ai, bj, At, Bt) do { __builtin_amdgcn_s_setprio(1); _Pragma("unroll") for (int m = 0; m < 4; ++m) _Pragma("unroll") for (int n = 0; n < 2; ++n) _Pragma("unroll") for (int k = 0; k < 2; ++k) \
        acc[ai][bj][m][n] = __builtin_amdgcn_mfma_f32_16x16x32_bf16(Bt[n][k], At[m][k], acc[ai][bj][m][n], 0, 0, 0); __builtin_amdgcn_s_setprio(0); } while (0)
#define PG8_WAIT_V(n) asm volatile("s_waitcnt vmcnt(" #n ")" ::: "memory")
#define PG8_WAIT_L(n) asm volatile("s_waitcnt lgkmcnt(" #n ")" ::: "memory")
#define PG8_BAR __builtin_amdgcn_s_barrier()
#define PG8_SCHED __builtin_amdgcn_sched_barrier(0)
    Unit cur, nxt; int ui = 0;
    if (!S.next(0, cur)) return;
    f32x4 acc[2][2][4][2];
#pragma unroll
    for (int a = 0; a < 2; ++a)
#pragma unroll
        for (int b = 0; b < 2; ++b)
#pragma unroll
            for (int m = 0; m < 4; ++m)
#pragma unroll
                for (int n = 0; n < 2; ++n) acc[a][b][m][n] = (f32x4){0.f, 0.f, 0.f, 0.f};
    bf16x8 At[4][2], B0[2][2], B1[2][2];
    const char* cA = (const char*)g.A + (size_t)cur.pm * tstepA; const char* cB = (const char*)g.Bt + (size_t)cur.pn * tstepB;
    S.a_ready(cur);
    if constexpr (SP2) {
        PG8_STAGE(PG8_SB(0, 0), cB, voffB); PG8_STAGE(PG8_SB(0, 1), cB + hstepB, voffB); PG8_STAGE(PG8_SA(0, 0), cA, voffA); PG8_STAGE(PG8_SA(0, 1), cA + hstepA, voffA);
        if (wr == 1) PG8_BAR;
        PG8_WAIT_V(2); PG8_BAR;
        PG8_STAGE(PG8_SB(1, 0), cB + kstep, voffB); PG8_STAGE(PG8_SA(1, 0), cA + kstep, voffA); PG8_STAGE(PG8_SB(1, 1), cB + hstepB + kstep, voffB);
        PG8_WAIT_V(6); PG8_BAR;
    } else {
        PG8_STAGE(PG8_SB(0, 0), cB, voffB); PG8_STAGE(PG8_SA(0, 0), cA, voffA); PG8_STAGE(PG8_SB(0, 1), cB + hstepB, voffB); PG8_STAGE(PG8_SA(0, 1), cA + hstepA, voffA);
        if (wr == 1) PG8_BAR;
        PG8_WAIT_V(4); PG8_BAR;
        PG8_STAGE(PG8_SB(1, 0), cB + kstep, voffB); PG8_STAGE(PG8_SA(1, 0), cA + kstep, voffA); PG8_STAGE(PG8_SB(1, 1), cB + hstepB + kstep, voffB);
        PG8_WAIT_V(6); PG8_BAR;
    }
    for (;;) {
        const bool has_next = S.next(ui + 1, nxt);
        const char* nA = has_next ? (const char*)g.A + (size_t)nxt.pm * tstepA : cA; const char* nB = has_next ? (const char*)g.Bt + (size_t)nxt.pn * tstepB : cB;
        for (int t = 0; t < nt; t += 2) {
            const bool last = (t == nt - 2);
            const char* a1 = cA + (size_t)(t + 1) * kstep;
            const char* a2 = last ? nA : cA + (size_t)(t + 2) * kstep; const char* b2 = last ? nB : cB + (size_t)(t + 2) * kstep;
            const char* a3 = a2 + kstep; const char* b3 = b2 + kstep;
            if (last && has_next) S.a_ready(nxt);
            if constexpr (SP2) {
            PG8_LDB(B0, 0, 0); PG8_LDB(B1, 0, 1); PG8_SCHED; PG8_LDA(At, 0, 0); PG8_STAGE(PG8_SA(1, 1), a1 + hstepA, voffA);
            PG8_WAIT_V(8); PG8_WAIT_L(0); PG8_BAR; PG8_MMA(0, 0, At, B0); PG8_MMA(0, 1, At, B1); PG8_BAR; PG8_SCHED;
            PG8_LDA(At, 0, 1); PG8_STAGE(PG8_SB(0, 0), b2, voffB); PG8_STAGE(PG8_SB(0, 1), b2 + hstepB, voffB); PG8_STAGE(PG8_SA(0, 0), a2, voffA);
            PG8_WAIT_V(8); PG8_WAIT_L(0); PG8_BAR; PG8_MMA(1, 0, At, B0); PG8_MMA(1, 1, At, B1); PG8_BAR; PG8_SCHED;
            PG8_LDB(B0, 1, 0); PG8_LDB(B1, 1, 1); PG8_SCHED; PG8_LDA(At, 1, 0); PG8_STAGE(PG8_SA(0, 1), a2 + hstepA, voffA);
            PG8_WAIT_V(8); PG8_WAIT_L(0); PG8_BAR; PG8_MMA(0, 0, At, B0); PG8_MMA(0, 1, At, B1); PG8_BAR; PG8_SCHED;
            PG8_LDA(At, 1, 1); PG8_STAGE(PG8_SB(1, 0), b3, voffB); PG8_STAGE(PG8_SB(1, 1), b3 + hstepB, voffB); PG8_STAGE(PG8_SA(1, 0), a3, voffA);
            PG8_WAIT_V(8); PG8_WAIT_L(0); PG8_BAR; PG8_MMA(1, 0, At, B0); PG8_MMA(1, 1, At, B1); PG8_BAR; PG8_SCHED;
            } else {
            PG8_LDB(B0, 0, 0); PG8_SCHED; PG8_LDA(At, 0, 0); PG8_STAGE(PG8_SA(1, 1), a1 + hstepA, voffA);
            PG8_WAIT_L(8); PG8_BAR; PG8_WAIT_L(0); PG8_MMA(0, 0, At, B0); PG8_BAR; PG8_SCHED;
            PG8_LDB(B1, 0, 1); PG8_STAGE(PG8_SB(0, 0), b2, voffB);
            PG8_BAR; PG8_WAIT_L(0); PG8_MMA(0, 1, At, B1); PG8_BAR;
            PG8_LDA(At, 0, 1); PG8_STAGE(PG8_SA(0, 0), a2, voffA);
            PG8_BAR; PG8_WAIT_L(0); PG8_MMA(1, 0, At, B0); PG8_BAR; PG8_SCHED;
            PG8_STAGE(PG8_SB(0, 1), b2 + hstepB, voffB);
            PG8_WAIT_V(6); PG8_BAR; PG8_MMA(1, 1, At, B1); PG8_BAR;
            PG8_LDB(B0, 1, 0); PG8_SCHED; PG8_LDA(At, 1, 0); PG8_STAGE(PG8_SA(0, 1), a2 + hstepA, voffA);
            PG8_WAIT_L(8); PG8_BAR; PG8_WAIT_L(0); PG8_MMA(0, 0, At, B0); PG8_BAR; PG8_SCHED;
            PG8_LDB(B1, 1, 1); PG8_STAGE(PG8_SB(1, 0), b3, voffB);
            PG8_BAR; PG8_WAIT_L(0); PG8_MMA(0, 1, At, B1); PG8_BAR;
            PG8_LDA(At, 1, 1); PG8_STAGE(PG8_SA(1, 0), a3, voffA);
            PG8_BAR; PG8_WAIT_L(0); PG8_MMA(1, 0, At, B0); PG8_BAR; PG8_SCHED;
            PG8_STAGE(PG8_SB(1, 1), b3 + hstepB, voffB);
            PG8_WAIT_V(6); PG8_BAR; PG8_MMA(1, 1, At, B1); PG8_BAR;
            }
        }
        if constexpr (ALIGN_EPI) { if (wr == 0) PG8_BAR; }
        if constexpr (!Epi::AFTER_DRAIN) { E(acc, cur, wr, wc, fr, fq); S.done(cur); }
        if (!has_next) break;
#pragma unroll
        for (int a = 0; a < 2; ++a)
#pragma unroll
            for (int b = 0; b < 2; ++b)
#pragma unroll
                for (int m = 0; m < 4; ++m)
#pragma unroll
                    for (int n = 0; n < 2; ++n) acc[a][b][m][n] = (f32x4){0.f, 0.f, 0.f, 0.f};
        cur = nxt; cA = nA; cB = nB; ++ui;
        if constexpr (ALIGN_EPI) { if (wr == 1) PG8_BAR; }
    }
    PG8_WAIT_V(0);
    if constexpr (!ALIGN_EPI) { if (wr == 0) PG8_BAR; }
    PG8_BAR;
    if constexpr (Epi::AFTER_DRAIN) { E.fused(acc, cur, wr, wc, fr, fq, lds, wid, lane); S.done(cur); }
#undef PG8_SA
#undef PG8_SB
#undef PG8_STAGE
#undef PG8_LDA
#undef PG8_LDB
#undef PG8_MMA
#undef PG8_WAIT_V
#undef PG8_WAIT_L
#undef PG8_BAR
#undef PG8_SCHED
}
}
namespace att {
typedef unsigned short bf16_t;
using bf16x8 = __attribute__((ext_vector_type(8))) short;
using s16x4  = __attribute__((ext_vector_type(4))) short;
using f32x16 = __attribute__((ext_vector_type(16))) float;
using u32x4  = __attribute__((ext_vector_type(4))) unsigned;
constexpr int DV = 128, NW = 8, QBLK = 32, KVBLK = 64;
constexpr float THR = 8.f;
constexpr int SHM_V = KVBLK * DV * 2;
template <int DQK> struct Cfg {
    static constexpr int SHM_K = KVBLK * DQK * 2, KROWB = DQK * 2, NCK = DQK / 64, C8 = DQK / 8, ND0 = DQK / 16;
    static constexpr float SCALE = (DQK == 128) ? 0.088388347648318440f : 0.072168783648703220f;
    static constexpr int LDS_BYTES = 2 * SHM_V + 2 * SHM_K + NW * 64 * 4;
};
#define ATT_SBAR() __builtin_amdgcn_sched_barrier(0)
__device__ __forceinline__ int crow(int r, int hi) { return (r & 3) + 8 * (r >> 2) + 4 * hi; }
__device__ __forceinline__ unsigned cvtpk(float lo, float hi) { unsigned r; asm volatile("v_cvt_pk_bf16_f32 %0, %1, %2" : "=v"(r) : "v"(lo), "v"(hi)); return r; }
template <int DQK> __device__ __forceinline__ int kswz(int row, int colB) {
    const int key = (DQK == 128) ? (row & 7) : ((row >> 1) & 7);
    return row * (DQK * 2) + (colB ^ (key << 4));
}
template <int DQK> __device__ __forceinline__ void partialSM(f32x16& p0, f32x16& p1, float& m_reg, float& mn, float& alpha) {
    constexpr float SCALE = Cfg<DQK>::SCALE, C = SCALE * 1.4426950408889634f;
    float pmax = p0[0];
#pragma unroll
    for (int r = 1; r < 16; ++r) pmax = fmaxf(pmax, p0[r]);
#pragma unroll
    for (int r = 0; r < 16; ++r) pmax = fmaxf(pmax, p1[r]);
    { auto rr = __builtin_amdgcn_permlane32_swap(__float_as_uint(pmax), __float_as_uint(pmax), false, false);
      pmax = fmaxf(__uint_as_float(rr[0]), __uint_as_float(rr[1])); }
    if (__builtin_expect(__all(pmax - m_reg <= THR / SCALE), 1)) { mn = m_reg; alpha = 1.f; }
    else { mn = fmaxf(m_reg, pmax); alpha = __builtin_amdgcn_exp2f((m_reg - mn) * C); m_reg = mn; }
    const float mnC = -mn * C;
#pragma unroll
    for (int r = 0; r < 16; ++r) p0[r] = fmaf(p0[r], C, mnC);
#pragma unroll
    for (int r = 0; r < 16; ++r) p1[r] = fmaf(p1[r], C, mnC);
#pragma unroll
    for (int r = 0; r < 16; ++r) p0[r] = __builtin_amdgcn_exp2f(p0[r]);
}
__device__ __forceinline__ void finishSM(f32x16& p0, f32x16& p1, float alpha, float& l_reg, bf16x8& pa0, bf16x8& pa1, bf16x8& pa2, bf16x8& pa3) {
#pragma unroll
    for (int r = 0; r < 16; ++r) p1[r] = __builtin_amdgcn_exp2f(p1[r]);
    float ps = 0;
#pragma unroll
    for (int r = 0; r < 16; ++r) ps += p0[r];
#pragma unroll
    for (int r = 0; r < 16; ++r) ps += p1[r];
    { auto rr = __builtin_amdgcn_permlane32_swap(__float_as_uint(ps), __float_as_uint(ps), false, false);
      ps = __uint_as_float(rr[0]) + __uint_as_float(rr[1]); }
    l_reg = l_reg * alpha + ps;
#define ATT_PK4(P, BASE, OUT) do { unsigned a0 = cvtpk(P[BASE + 0], P[BASE + 1]), a1 = cvtpk(P[BASE + 2], P[BASE + 3]);   \
    unsigned b0 = cvtpk(P[BASE + 4], P[BASE + 5]), b1 = cvtpk(P[BASE + 6], P[BASE + 7]);                              \
    auto r0 = __builtin_amdgcn_permlane32_swap(a0, b0, false, false); auto r1 = __builtin_amdgcn_permlane32_swap(a1, b1, false, false); \
    u32x4 w = {r0[0], r1[0], r0[1], r1[1]}; OUT = *reinterpret_cast<bf16x8*>(&w); } while (0)
    ATT_PK4(p0, 0, pa0); ATT_PK4(p0, 8, pa1); ATT_PK4(p1, 0, pa2); ATT_PK4(p1, 8, pa3);
#undef ATT_PK4
}
template <int DQK> __device__ __forceinline__ void qkt(f32x16& p0, f32x16& p1, const char* Ks, const bf16x8* qr, int r32, int hi) {
    p0 = f32x16{}; p1 = f32x16{};
#pragma unroll
    for (int d0 = 0; d0 < Cfg<DQK>::ND0; ++d0) { const int cb = (d0 * 16 + hi * 8) * 2;
        bf16x8 b0 = *reinterpret_cast<const bf16x8*>(Ks + kswz<DQK>(r32, cb));
        bf16x8 b1 = *reinterpret_cast<const bf16x8*>(Ks + kswz<DQK>(32 + r32, cb));
        p0 = __builtin_amdgcn_mfma_f32_32x32x16_bf16(b0, qr[d0], p0, 0, 0, 0);
        p1 = __builtin_amdgcn_mfma_f32_32x32x16_bf16(b1, qr[d0], p1, 0, 0, 0); }
}
__device__ __forceinline__ int v_st(int k, int c) { const int kk = (k & ~0xC) | ((k & 4) << 1) | ((k & 8) >> 1); return ((kk >> 3) * 4 + (c >> 5)) * 512 + ((kk & 7) * 32 + (c & 31)) * 2; }
__device__ __forceinline__ int v_rd_base(int lane) { return ((lane & 3) << 3) | (((lane >> 2) & 3) << 6) | (((lane >> 4) & 1) << 5) | (((lane >> 5) & 1) << 8); }
constexpr int v_rd_off(int d0, int ks, int half) { return d0 * 512 + ks * 4096 + half * 2048; }
template <int OFF> __device__ __forceinline__ s16x4 tr_read(int vb) {
    s16x4 r; asm volatile("ds_read_b64_tr_b16 %0, %1 offset:%2" : "=&v"(r) : "v"(vb), "i"(OFF) : "memory"); return r;
}
template <int D0> __device__ __forceinline__ void pv_one(f32x16& od, int vb, bf16x8 pa0, bf16x8 pa1, bf16x8 pa2, bf16x8 pa3) {
    const s16x4 l0 = tr_read<v_rd_off(D0, 0, 0)>(vb), h0 = tr_read<v_rd_off(D0, 0, 1)>(vb), l1 = tr_read<v_rd_off(D0, 1, 0)>(vb), h1 = tr_read<v_rd_off(D0, 1, 1)>(vb);
    const s16x4 l2 = tr_read<v_rd_off(D0, 2, 0)>(vb), h2 = tr_read<v_rd_off(D0, 2, 1)>(vb), l3 = tr_read<v_rd_off(D0, 3, 0)>(vb), h3 = tr_read<v_rd_off(D0, 3, 1)>(vb);
    asm volatile("s_waitcnt lgkmcnt(0)" ::: "memory"); ATT_SBAR();
#define ATT_PK(L, H) (bf16x8){L[0], L[1], L[2], L[3], H[0], H[1], H[2], H[3]}
    od = __builtin_amdgcn_mfma_f32_32x32x16_bf16(pa0, ATT_PK(l0, h0), od, 0, 0, 0);
    od = __builtin_amdgcn_mfma_f32_32x32x16_bf16(pa1, ATT_PK(l1, h1), od, 0, 0, 0);
    od = __builtin_amdgcn_mfma_f32_32x32x16_bf16(pa2, ATT_PK(l2, h2), od, 0, 0, 0);
    od = __builtin_amdgcn_mfma_f32_32x32x16_bf16(pa3, ATT_PK(l3, h3), od, 0, 0, 0);
#undef ATT_PK
}
__device__ __forceinline__ void pv_d0(f32x16* o, int vb, bf16x8 pa0, bf16x8 pa1, bf16x8 pa2, bf16x8 pa3) {
    pv_one<0>(o[0], vb, pa0, pa1, pa2, pa3); pv_one<1>(o[1], vb, pa0, pa1, pa2, pa3); pv_one<2>(o[2], vb, pa0, pa1, pa2, pa3); pv_one<3>(o[3], vb, pa0, pa1, pa2, pa3);
}
template <int DQK, int LDQ, int LDK, int LDV, int LDO, int SDEPTH>
__device__ __forceinline__ void attn_body(const bf16_t* __restrict__ Qb, const bf16_t* __restrict__ Kh, const bf16_t* __restrict__ Vh, bf16_t* __restrict__ Ob, int seq, char* lds, int tid_in) {
    using C_ = Cfg<DQK>;
    constexpr int SHM_K = C_::SHM_K, NCK = C_::NCK, C8 = C_::C8, ND0 = C_::ND0;
    int tid_ = tid_in; asm volatile("" : "+v"(tid_));
    const int tid = tid_, wid = tid >> 6, lane = tid & 63, r32 = lane & 31, hi = lane >> 5;
    char* V_lds = lds; char* K_lds = lds + 2 * SHM_V;
    float* ws = (float*)(lds + 2 * SHM_V + 2 * SHM_K) + wid * 64; float* li_l = ws; float* al_l = ws + 32;
    float m_reg = -1e30f, l_reg = 0; f32x16 o[4] = {}; bf16x8 qr[ND0];
    const bf16_t* Qw = Qb + (long)(wid * QBLK + r32) * LDQ + hi * 8;
#pragma unroll
    for (int d0 = 0; d0 < ND0; ++d0) qr[d0] = *reinterpret_cast<const bf16x8*>(Qw + d0 * 16);
    const int sr = tid >> 4, sc = (tid & 15) * 8, vst0 = v_st(sr, sc), vst1 = v_st(32 + sr, sc);
    int krow[NCK], kcol[NCK];
#pragma unroll
    for (int i = 0; i < NCK; ++i) { const int ci = tid + 512 * i; krow[i] = ci / C8; kcol[i] = (ci % C8) * 8; }
    const int vb0 = (int)(uintptr_t)V_lds + v_rd_base(lane);
    struct { bf16x8 vs0, vs1, ks[NCK]; } sr_[SDEPTH];
#define ATT_SLOAD(i, k0) do { sr_[i].vs0 = *reinterpret_cast<const bf16x8*>(&Vh[(long)((k0) + sr) * LDV + sc]); sr_[i].vs1 = *reinterpret_cast<const bf16x8*>(&Vh[(long)((k0) + 32 + sr) * LDV + sc]); \
    _Pragma("unroll") for (int c_ = 0; c_ < NCK; ++c_) sr_[i].ks[c_] = *reinterpret_cast<const bf16x8*>(&Kh[(long)((k0) + krow[c_]) * LDK + kcol[c_]]); } while (0)
#define ATT_SWRITE(b, i) do { *(bf16x8*)(V_lds + (b) * SHM_V + vst0) = sr_[i].vs0; *(bf16x8*)(V_lds + (b) * SHM_V + vst1) = sr_[i].vs1; \
    _Pragma("unroll") for (int c_ = 0; c_ < NCK; ++c_) *(bf16x8*)(K_lds + (b) * SHM_K + kswz<DQK>(krow[c_], kcol[c_] * 2)) = sr_[i].ks[c_]; } while (0)
#define ATT_SWAIT() do { if constexpr (SDEPTH == 2) { if constexpr (NCK == 2) asm volatile("s_waitcnt vmcnt(4)" ::: "memory"); else asm volatile("s_waitcnt vmcnt(5)" ::: "memory"); } else asm volatile("s_waitcnt vmcnt(0)" ::: "memory"); } while (0)
#define ATT_RESC(a) do { if (__any((a) < 1.f)) { if (hi == 0) al_l[r32] = (a); asm volatile("s_waitcnt lgkmcnt(0)" ::: "memory"); \
    _Pragma("unroll") for (int d = 0; d < 4; ++d) _Pragma("unroll") for (int r = 0; r < 16; ++r) o[d][r] *= al_l[crow(r, hi)]; } } while (0)
    f32x16 pA0, pA1, pB0, pB1; float mnA, mnB, alA, alB; bf16x8 pa0, pa1, pa2, pa3; const int NT = seq / KVBLK;
    constexpr int SE = 0, SO = SDEPTH - 1;
    ATT_SLOAD(SE, 0); asm volatile("s_waitcnt vmcnt(0)" ::: "memory"); ATT_SWRITE(0, SE); __syncthreads();
    qkt<DQK>(pA0, pA1, K_lds, qr, r32, hi); partialSM<DQK>(pA0, pA1, m_reg, mnA, alA);
    ATT_SLOAD(SO, KVBLK); if constexpr (SDEPTH == 2) { if (2 < NT) ATT_SLOAD(SE, 2 * KVBLK); }
    ATT_SWAIT(); ATT_SWRITE(1, SO); __syncthreads();
    for (int j = 1; j + 1 < NT; j += 2) {
        ATT_SBAR(); qkt<DQK>(pB0, pB1, K_lds + SHM_K, qr, r32, hi);
        finishSM(pA0, pA1, alA, l_reg, pa0, pa1, pa2, pa3); ATT_SBAR();
        ATT_SLOAD(SO, (j + SDEPTH) * KVBLK); ATT_SBAR();
        pv_d0(o, vb0, pa0, pa1, pa2, pa3); partialSM<DQK>(pB0, pB1, m_reg, mnB, alB);
        __syncthreads(); ATT_SWAIT(); ATT_SWRITE(0, SE);
        ATT_RESC(alB); __syncthreads();
        ATT_SBAR(); qkt<DQK>(pA0, pA1, K_lds, qr, r32, hi);
        finishSM(pB0, pB1, alB, l_reg, pa0, pa1, pa2, pa3); ATT_SBAR();
        if (SDEPTH == 1 || j + 3 < NT) ATT_SLOAD(SE, (j + 1 + SDEPTH) * KVBLK); ATT_SBAR();
        pv_d0(o, vb0 + (int)SHM_V, pa0, pa1, pa2, pa3); partialSM<DQK>(pA0, pA1, m_reg, mnA, alA);
        __syncthreads(); ATT_SWAIT(); ATT_SWRITE(1, SO);
        ATT_RESC(alA); __syncthreads();
    }
    ATT_SBAR(); qkt<DQK>(pB0, pB1, K_lds + SHM_K, qr, r32, hi);
    finishSM(pA0, pA1, alA, l_reg, pa0, pa1, pa2, pa3); ATT_SBAR();
    pv_d0(o, vb0, pa0, pa1, pa2, pa3); partialSM<DQK>(pB0, pB1, m_reg, mnB, alB);
    __syncthreads(); ATT_RESC(alB);
    finishSM(pB0, pB1, alB, l_reg, pa0, pa1, pa2, pa3); ATT_SBAR();
    pv_d0(o, vb0 + (int)SHM_V, pa0, pa1, pa2, pa3);
    if (hi == 0) li_l[r32] = l_reg;
    asm volatile("s_waitcnt lgkmcnt(0)" ::: "memory");
    __syncthreads();
    float rli[16];
#pragma unroll
    for (int r = 0; r < 16; ++r) rli[r] = __builtin_amdgcn_rcpf(li_l[crow(r, hi)]);
    unsigned short* stg = (unsigned short*)(lds + wid * 8192);
#pragma unroll
    for (int r = 0; r < 16; ++r) { const int orow = crow(r, hi);
#pragma unroll
        for (int d0 = 0; d0 < 4; ++d0) { const unsigned w = cvtpk(o[d0][r] * rli[r], 0.f); stg[orow * 128 + d0 * 32 + r32] = (unsigned short)(w & 0xffffu); } }
    asm volatile("s_waitcnt lgkmcnt(0)" ::: "memory");
    bf16_t* Ow = Ob + (long)(wid * QBLK) * LDO;
#pragma unroll
    for (int i = 0; i < 8; ++i) { const int id = lane + 64 * i, row = id >> 4, c16 = id & 15;
        const u32x4 v = *(const u32x4*)((const char*)stg + row * 256 + c16 * 16);
        *(u32x4*)(Ow + (long)row * LDO + c16 * 8) = v; }
    asm volatile("s_waitcnt lgkmcnt(0)" ::: "memory");
    __syncthreads();
#undef ATT_SLOAD
#undef ATT_SWRITE
#undef ATT_SWAIT
#undef ATT_RESC
}

template <int DQK, int LDQ, int LDK, int LDV, int LDO>
__device__ __forceinline__ void attn_body1(const bf16_t* __restrict__ Qb, const bf16_t* __restrict__ Kh, const bf16_t* __restrict__ Vh, bf16_t* __restrict__ Ob, int seq, char* lds, int tid_in) {
    using C_ = Cfg<DQK>;
    constexpr int SHM_K = C_::SHM_K, NCK = C_::NCK, C8 = C_::C8, ND0 = C_::ND0;
    int tid_ = tid_in; asm volatile("" : "+v"(tid_));
    const int tid = tid_, wid = tid >> 6, lane = tid & 63, r32 = lane & 31, hi = lane >> 5;
    char* V_lds = lds; char* K_lds = lds + 2 * SHM_V;
    float* ws = (float*)(lds + 2 * SHM_V + 2 * SHM_K) + wid * 64; float* li_l = ws; float* al_l = ws + 32;
    float m_reg = -1e30f, l_reg = 0; f32x16 o[4] = {}; bf16x8 qr[ND0];
    const bf16_t* Qw = Qb + (long)(wid * QBLK + r32) * LDQ + hi * 8;
#pragma unroll
    for (int d0 = 0; d0 < ND0; ++d0) qr[d0] = *reinterpret_cast<const bf16x8*>(Qw + d0 * 16);
    const int sr = tid >> 4, sc = (tid & 15) * 8, vst0 = v_st(sr, sc), vst1 = v_st(32 + sr, sc);
    int krow[NCK], kcol[NCK];
#pragma unroll
    for (int i = 0; i < NCK; ++i) { const int ci = tid + 512 * i; krow[i] = ci / C8; kcol[i] = (ci % C8) * 8; }
    const int vb0 = (int)(uintptr_t)V_lds + v_rd_base(lane);
    bf16x8 vs0, vs1, ks[NCK];
#define ATT1_SLOAD(k0) do { vs0 = *reinterpret_cast<const bf16x8*>(&Vh[(long)((k0) + sr) * LDV + sc]); vs1 = *reinterpret_cast<const bf16x8*>(&Vh[(long)((k0) + 32 + sr) * LDV + sc]); \
    _Pragma("unroll") for (int c_ = 0; c_ < NCK; ++c_) ks[c_] = *reinterpret_cast<const bf16x8*>(&Kh[(long)((k0) + krow[c_]) * LDK + kcol[c_]]); } while (0)
#define ATT1_SWRITE(b) do { *(bf16x8*)(V_lds + (b) * SHM_V + vst0) = vs0; *(bf16x8*)(V_lds + (b) * SHM_V + vst1) = vs1; \
    _Pragma("unroll") for (int c_ = 0; c_ < NCK; ++c_) *(bf16x8*)(K_lds + (b) * SHM_K + kswz<DQK>(krow[c_], kcol[c_] * 2)) = ks[c_]; } while (0)
    const int NT = seq / KVBLK;
    ATT1_SLOAD(0); asm volatile("s_waitcnt vmcnt(0)" ::: "memory"); ATT1_SWRITE(0); __syncthreads();
    for (int j = 0; j < NT; ++j) {
        const int b = j & 1;
        if (j + 1 < NT) ATT1_SLOAD((j + 1) * KVBLK);
        ATT_SBAR();
        f32x16 p0, p1; float mn, alpha; bf16x8 pa0, pa1, pa2, pa3;
        qkt<DQK>(p0, p1, K_lds + b * SHM_K, qr, r32, hi);
        partialSM<DQK>(p0, p1, m_reg, mn, alpha);
        if (__any(alpha < 1.f)) { if (hi == 0) al_l[r32] = alpha; asm volatile("s_waitcnt lgkmcnt(0)" ::: "memory");
#pragma unroll
            for (int d = 0; d < 4; ++d)
#pragma unroll
                for (int r = 0; r < 16; ++r) o[d][r] *= al_l[crow(r, hi)]; }
        finishSM(p0, p1, alpha, l_reg, pa0, pa1, pa2, pa3); ATT_SBAR();
        pv_d0(o, vb0 + b * (int)SHM_V, pa0, pa1, pa2, pa3);
        if (j + 1 < NT) { ATT1_SWRITE(b ^ 1); }
        __syncthreads();
    }
    if (hi == 0) li_l[r32] = l_reg;
    asm volatile("s_waitcnt lgkmcnt(0)" ::: "memory");
    __syncthreads();
    float rli[16];
#pragma unroll
    for (int r = 0; r < 16; ++r) rli[r] = __builtin_amdgcn_rcpf(li_l[crow(r, hi)]);
    unsigned short* stg = (unsigned short*)(lds + wid * 8192);
#pragma unroll
    for (int r = 0; r < 16; ++r) { const int orow = crow(r, hi);
#pragma unroll
        for (int d0 = 0; d0 < 4; ++d0) { const unsigned w = cvtpk(o[d0][r] * rli[r], 0.f); stg[orow * 128 + d0 * 32 + r32] = (unsigned short)(w & 0xffffu); } }
    asm volatile("s_waitcnt lgkmcnt(0)" ::: "memory");
    bf16_t* Ow = Ob + (long)(wid * QBLK) * LDO;
#pragma unroll
    for (int i = 0; i < 8; ++i) { const int id = lane + 64 * i, row = id >> 4, c16 = id & 15;
        const u32x4 v = *(const u32x4*)((const char*)stg + row * 256 + c16 * 16);
        *(u32x4*)(Ow + (long)row * LDO + c16 * 8) = v; }
    asm volatile("s_waitcnt lgkmcnt(0)" ::: "memory");
    __syncthreads();
#undef ATT1_SLOAD
#undef ATT1_SWRITE
}
}
constexpr int DM = 2048, NBATCH = 2, SEQ = 4096, CTX = 256, RB = SEQ + CTX  , MROWS = NBATCH * RB  ;
constexpr int NMOD = 6 * DM, NEXP = 16384;
constexpr float EPS = 1e-6f;
constexpr int NWAVES = 8, NTHREADS = 512;
constexpr size_t MiB = 1u << 20;
constexpr size_t WS_CTL = 0, CTL_ZERO_BYTES = 64 * 1024;
constexpr size_t WS_MOD = 1 * MiB;
constexpr size_t WS_ROPE = 2 * MiB;
constexpr size_t WS_SMALL = 3 * MiB;
constexpr int SM_N1G = 0, SM_N2G = 8192, SM_AQG = 16384, SM_AKG = 16384 + 384, SM_CW = 16384 + 768, SM_CB = SM_CW + 6144, SM_CQG = SM_CB + 2048, SM_CKG = SM_CQG + 256, SM_END = SM_CKG + 256;
constexpr size_t WS_XW = 4 * MiB;
constexpr size_t WS_H = 72 * MiB;
constexpr size_t WS_P = 106 * MiB;
constexpr size_t WS_QRAW = 174 * MiB;
constexpr size_t WS_KVRAW = 200 * MiB;
constexpr size_t WS_Q = 234 * MiB;
constexpr size_t WS_K = 268 * MiB;
constexpr size_t WS_V = 294 * MiB;
constexpr size_t WS_CAT = 311 * MiB;
constexpr size_t WS_PQ = 345 * MiB;
constexpr size_t WS_IDX = 379 * MiB;
constexpr size_t WS_GATE = 384 * MiB;
constexpr size_t WS_WIN = 389 * MiB;
constexpr size_t WS_WUQ = 421 * MiB;
constexpr size_t WS_WUKV = 424 * MiB;
constexpr size_t WS_WEO = 426 * MiB;
constexpr size_t WS_WQKV = 442 * MiB;
constexpr size_t WS_WCO = 466 * MiB;
constexpr size_t WS_WPQ = 482 * MiB;
constexpr size_t WS_SUBK = 514 * MiB;
constexpr int ROWB = 1536;
constexpr size_t WS_U = 516 * MiB;
constexpr size_t WS_VT = 644 * MiB;
constexpr size_t WS_USC = 772 * MiB;
constexpr size_t WS_VSC = 773 * MiB;
constexpr size_t WS_END = 774 * MiB;
constexpr int CW_BAR = 4096;
constexpr int LDS_MISC = 131072 + 8192;
constexpr int LDS_BYTES = 147456;

#define LAS __attribute__((address_space(3)))
typedef unsigned short bf16_t;
typedef float f32x4 __attribute__((ext_vector_type(4)));
typedef unsigned u32x4 __attribute__((ext_vector_type(4)));
typedef unsigned u32x2 __attribute__((ext_vector_type(2)));
typedef short bf16x8 __attribute__((ext_vector_type(8)));
typedef float f32x16 __attribute__((ext_vector_type(16)));
typedef __bf16 bf16x2_t __attribute__((ext_vector_type(2)));
typedef float f32x2 __attribute__((ext_vector_type(2)));
typedef float f32x32 __attribute__((ext_vector_type(32)));
typedef unsigned u32x6 __attribute__((ext_vector_type(6)));

__device__ __forceinline__ unsigned f2bf(float f) { unsigned u = __builtin_bit_cast(unsigned, f); return (u + 0x7fffu + ((u >> 16) & 1u)) >> 16; }
__device__ __forceinline__ unsigned pk2(float lo, float hi) { return f2bf(lo) | (f2bf(hi) << 16); }
__device__ __forceinline__ float bf_lo(unsigned w) { return __builtin_bit_cast(float, w << 16); }
__device__ __forceinline__ float bf_hi(unsigned w) { return __builtin_bit_cast(float, w & 0xffff0000u); }
__device__ __forceinline__ float bf2f(bf16_t h) { return __builtin_bit_cast(float, (unsigned)h << 16); }
__device__ __forceinline__ float wave_sum(float v) {
#pragma unroll
    for (int o = 1; o < 64; o <<= 1) v += __shfl_xor(v, o);
    return v;
}
#define DPP_ADD(v, ctrl) ((v) + __builtin_bit_cast(float, __builtin_amdgcn_update_dpp(0, __builtin_bit_cast(int, (v)), (ctrl), 0xf, 0xf, true)))
__device__ __forceinline__ float wave_sum_dpp(float v) {
    v = DPP_ADD(v, 0xB1);
    v = DPP_ADD(v, 0x4E);
    v = DPP_ADD(v, 0x141);
    v = DPP_ADD(v, 0x140);
    const int vi = __builtin_bit_cast(int, v);
    const float s0 = __builtin_bit_cast(float, __builtin_amdgcn_readlane(vi, 0)), s1 = __builtin_bit_cast(float, __builtin_amdgcn_readlane(vi, 16));
    const float s2 = __builtin_bit_cast(float, __builtin_amdgcn_readlane(vi, 32)), s3 = __builtin_bit_cast(float, __builtin_amdgcn_readlane(vi, 48));
    return (s0 + s1) + (s2 + s3);
}
__device__ __forceinline__ float dot2_bf16(unsigned w, unsigned x, float acc) { return __builtin_amdgcn_fdot2_f32_bf16(__builtin_bit_cast(bf16x2_t, w), __builtin_bit_cast(bf16x2_t, x), acc, false); }
__device__ __forceinline__ float gelu_erf(float v) {
    const float av = fabsf(v), t = __builtin_amdgcn_rcpf(av * 0.2316418882f + 1.0f);
    float q = t * 0.5307027145f + (-0.7265760135f); q = q * t + 0.7107068705f; q = q * t + (-0.142248368f); q = q * t + 0.127414796f; q = q * t;
    const float e = __builtin_amdgcn_exp2f((v * v) * (-0.72134752044f));
    const float m = v * (q * e);
    return v < 0.f ? m : v - m;
}
#define XB_TMO      128
#define XB_XCNT(j)  (256  + 64 * (j))
#define XB_XSUB(j)  (1280 + 64 * (j))
#define XB_XGEN(j)  (2304 + 64 * (j))
#define XB_TOP      3328
#define XB_TOPGEN   3392
#define XCD_BAR_WORDS 3456
#define XB_SPIN_CAP (1u << 18)

__device__ __forceinline__ unsigned xb_ld(unsigned* p)              { return __hip_atomic_load(p, __ATOMIC_RELAXED, __HIP_MEMORY_SCOPE_AGENT); }
__device__ __forceinline__ unsigned xb_add(unsigned* p, unsigned v) { return __hip_atomic_fetch_add(p, v, __ATOMIC_RELAXED, __HIP_MEMORY_SCOPE_AGENT); }
__device__ __forceinline__ unsigned xb_xcc_id() { return (unsigned)__builtin_amdgcn_s_getreg((3 << 11) | 20) & 0xFu; }
#define XB_SPIN(cond, bar) do { unsigned _sp = 0; while (cond) { __builtin_amdgcn_s_sleep(1); \
    if ((++_sp & 255u) == 0u) { if (xb_ld(&(bar)[XB_TMO])) break; if (_sp > XB_SPIN_CAP) { atomicAdd(&(bar)[XB_TMO], 1u); break; } } } } while (0)

struct XcdBarrier {
    unsigned* bar; unsigned x;
    volatile LAS unsigned* st;
};

__device__ __forceinline__ XcdBarrier xcd_barrier_post(unsigned* bar, volatile LAS unsigned* st) {
    XcdBarrier b; b.bar = bar; b.x = xb_xcc_id(); b.st = st;
    if (threadIdx.x == 0) (void)xb_add(&bar[XB_XCNT(b.x)], 1u);
    return b;
}
__device__ __forceinline__ void xcd_barrier_complete(unsigned* bar, unsigned x, unsigned& nloc, unsigned& nx) {
    const unsigned G = gridDim.x * gridDim.y * gridDim.z;
    unsigned sum, cnt, mine, sp = 0u;
    for (;;) {
        sum = 0u; cnt = 0u; mine = 0u;
#pragma unroll
        for (unsigned j = 0; j < 16; ++j) { const unsigned c = xb_ld(&bar[XB_XCNT(j)]); sum += c; cnt += (c > 0u) ? 1u : 0u; mine = (j == x) ? c : mine; }
        if (sum == G) break;
        __builtin_amdgcn_s_sleep(1);
        if ((++sp & 255u) == 0u) { if (xb_ld(&bar[XB_TMO])) break; if (sp > XB_SPIN_CAP) { atomicAdd(&bar[XB_TMO], 1u); break; } }
    }
    nloc = mine > 0u ? mine : 1u; nx = cnt > 0u ? cnt : 1u;
}

__device__ __forceinline__ void xcd_barrier(const XcdBarrier& b) {
    asm volatile("s_waitcnt vmcnt(0)" ::: "memory");
    __syncthreads();
    if (threadIdx.x == 0) {
        unsigned* bar = b.bar; unsigned bx = b.x;
        asm volatile("" : "+s"(bar), "+s"(bx));
        __builtin_amdgcn_s_waitcnt(0);
        unsigned nloc = b.st[0], nx = b.st[1];
        if (nloc == 0u) { xcd_barrier_complete(bar, bx, nloc, nx); b.st[0] = nloc; b.st[1] = nx; }
        const unsigned old = xb_add(&bar[XB_XSUB(bx)], 1u);
        const unsigned gen = old / nloc;
        if (old + 1u == (gen + 1u) * nloc) {
            __builtin_amdgcn_fence(__ATOMIC_RELEASE, "agent");
            asm volatile("s_waitcnt vmcnt(0)" ::: "memory");
            const unsigned og = xb_add(&bar[XB_TOP], 1u);
            const unsigned tg = og / nx;
            if (og + 1u == (tg + 1u) * nx) xb_add(&bar[XB_TOPGEN], 1u);
            else XB_SPIN(xb_ld(&bar[XB_TOPGEN]) == tg, bar);
            __builtin_amdgcn_fence(__ATOMIC_ACQUIRE, "agent");
            xb_add(&bar[XB_XGEN(bx)], 1u);
            asm volatile("s_waitcnt vmcnt(0)" ::: "memory");
        } else {
            XB_SPIN(xb_ld(&bar[XB_XGEN(bx)]) == gen, bar);
            __builtin_amdgcn_fence(__ATOMIC_ACQUIRE, "agent");
            asm volatile("s_waitcnt vmcnt(0)" ::: "memory");
        }
    }
    __syncthreads();
}
struct Frame {
    LAS unsigned char* lds;
    int tid, lane, wave, vcu, G, gw, NGW;
    unsigned char* ws;
};
__device__ __forceinline__ int opaque_v(int v) { asm volatile("" : "+v"(v)); return v; }
__device__ __forceinline__ int phase_tid(int wave) { int lane; asm volatile("v_mbcnt_lo_u32_b32 %0, -1, 0\n\tv_mbcnt_hi_u32_b32 %0, -1, %0" : "=v"(lane)); return wave * 64 + lane; }
__device__ __forceinline__ Frame phase_frame(const Frame& F0) { Frame F = F0; F.tid = phase_tid(F0.wave); F.lane = F.tid & 63; return F; }
__device__ __forceinline__ float swap32(float v, int lane) { auto rr = __builtin_amdgcn_permlane32_swap(__float_as_uint(v), __float_as_uint(v), false, false); return __uint_as_float(lane < 32 ? rr[1] : rr[0]); }
__device__ __forceinline__ int row_cls(int row) { const int b = row / RB, i = row - b * RB; return i < CTX ? 2 : b; }

__device__ __forceinline__ void p0_transpose_item(const float* W, int K, int N, bf16_t* WT, const float* gain, LAS float* scr, int item, int lane) {
    const int nblk = N / 32, kb = item / nblk, nb = item % nblk, k0 = 64 * kb, n0 = 32 * nb;
#pragma unroll 8
    for (int i = 0; i < 32; ++i) { const int kk = 2 * i + (lane >> 5); float v = W[(size_t)(k0 + kk) * N + n0 + (lane & 31)]; if (gain) v *= gain[k0 + kk]; scr[kk * 33 + (lane & 31)] = v; }
    asm volatile("s_waitcnt lgkmcnt(0)" ::: "memory");
    const int c = lane & 7;
#pragma unroll
    for (int j = 0; j < 4; ++j) { const int n = (lane >> 3) + 8 * j; const LAS float* s = scr + (8 * c) * 33 + n;
        u32x4 o; o.x = pk2(s[0 * 33], s[1 * 33]); o.y = pk2(s[2 * 33], s[3 * 33]); o.z = pk2(s[4 * 33], s[5 * 33]); o.w = pk2(s[6 * 33], s[7 * 33]);
        *(u32x4*)(WT + (size_t)(n0 + n) * K + k0 + 8 * c) = o; }
    asm volatile("s_waitcnt lgkmcnt(0)" ::: "memory");
}
struct TrDesc { const float* W; const float* gain; bf16_t* WT; int K, N, items; };

__device__ __forceinline__ void p0_gemv_task(Frame& F, int task, const float* ada_w, const float* ada_b, float* mod) {
    LAS float* sv = (LAS float*)F.lds; LAS float* part = (LAS float*)(F.lds + 32768);
    const int l = task / 48, n0 = (task % 48) * 256;
    const float* Wp = ada_w + (size_t)l * DM * NMOD + n0 + F.lane * 4 + (size_t)(F.wave * 256) * NMOD;
    f32x4 a0 = {0, 0, 0, 0}, a1 = a0, a2 = a0;
    for (int k = 0; k < 256; k += 8) {
        f32x4 w[8];
#pragma unroll
        for (int u = 0; u < 8; ++u) w[u] = *(const f32x4*)(Wp + (size_t)(k + u) * NMOD);
#pragma unroll
        for (int u = 0; u < 8; ++u) { const int kk = F.wave * 256 + k + u; const float s0 = sv[kk], s1 = sv[2048 + kk], s2 = sv[4096 + kk];
            a0 += w[u] * s0; a1 += w[u] * s1; a2 += w[u] * s2; }
    }
    *(LAS f32x4*)(part + (F.wave * 3 + 0) * 256 + F.lane * 4) = a0;
    *(LAS f32x4*)(part + (F.wave * 3 + 1) * 256 + F.lane * 4) = a1;
    *(LAS f32x4*)(part + (F.wave * 3 + 2) * 256 + F.lane * 4) = a2;
    __syncthreads();
    for (int o = F.tid; o < 768; o += NTHREADS) { const int r = o >> 8, c = o & 255; float s = 0.f;
#pragma unroll
        for (int w = 0; w < 8; ++w) s += part[(w * 3 + r) * 256 + c];
        mod[(size_t)(l * 3 + r) * NMOD + n0 + c] = s + ada_b[(size_t)l * NMOD + n0 + c]; }
    __syncthreads();
}

__device__ __forceinline__ void p0_prologue(Frame& F, const float* const* in) {
    unsigned char* ws = F.ws;
    {
        LAS float* sv = (LAS float*)F.lds;
        for (int i = F.tid; i < 3 * DM; i += NTHREADS) { const int r = i / DM, k = i - r * DM; const float x = (r < 2) ? in[1][r * DM + k] : in[3][k]; sv[i] = x / (1.f + __expf(-x)); }
        __syncthreads();
        for (int task = F.vcu; task < 192; task += F.G) p0_gemv_task(F, task, in[4], in[5], (float*)(ws + WS_MOD));
        __syncthreads();
    }
    {
        float* xw = (float*)(ws + WS_XW);
        for (int row = F.gw; row < MROWS; row += F.NGW) { const int b = row / RB, i = row - b * RB;
            const float* src = (i < CTX) ? in[2] + (size_t)(b * CTX + i) * DM : in[0] + (size_t)(b * SEQ + i - CTX) * DM;
            const f32x4* s4 = (const f32x4*)src + F.lane; f32x4* d4 = (f32x4*)(xw + (size_t)row * DM) + F.lane;
#pragma unroll
            for (int j = 0; j < 8; ++j) d4[64 * j] = s4[64 * j]; }
    }
    {
        float* sm = (float*)(ws + WS_SMALL); const int g = F.vcu * NTHREADS + F.tid;
        if (g < 8192) { sm[SM_N1G + g] = in[6][g]; sm[SM_N2G + g] = in[7][g]; }
        if (g < 384) { sm[SM_AQG + g] = in[13][g]; sm[SM_AKG + g] = in[14][g]; }
        if (g < 6144) sm[SM_CW + g] = in[15][g];
        if (g < 2048) sm[SM_CB + g] = in[16][g];
        if (g < 256) { sm[SM_CQG + g] = in[19][g]; sm[SM_CKG + g] = in[20][g]; }
    }
    {
        float* rc = (float*)(ws + WS_ROPE); float* ra = rc + 64 * 32 * 2;
        const int g = F.vcu * NTHREADS + F.tid;
        if (g < 64 * 32) { const int pos = g >> 5, f = g & 31; const float fr = exp2f(-(float)f * (13.287712379549449f / 32.f)); const float ang = (float)pos * fr;
            rc[2 * g] = cosf(ang); rc[2 * g + 1] = sinf(ang); }
        else if (g < 64 * 32 + 64 * 16) { const int e = g - 64 * 32, pos = e >> 4, f = e & 15; const float fr = exp2f(-(float)f * (13.287712379549449f / 16.f)); const float ang = (float)pos * fr;
            ra[2 * e] = cosf(ang); ra[2 * e + 1] = sinf(ang); }
    }
    {
        LAS float* scr = (LAS float*)(F.lds + F.wave * 16384);
        TrDesc d[16]; int nd = 0;
#pragma unroll
        for (int i = 0; i < 2; ++i) {
            d[nd++] = TrDesc{in[8] + (size_t)i * DM * 3904, nullptr, (bf16_t*)(ws + WS_WIN) + (size_t)i * 4096 * DM, DM, 3904, 32 * 122};
            d[nd++] = TrDesc{in[11] + (size_t)i * 512 * 1536, in[9] + i * 512, (bf16_t*)(ws + WS_WUQ) + (size_t)i * 1536 * 512, 512, 1536, 8 * 48};
            d[nd++] = TrDesc{in[12] + (size_t)i * 256 * 2048, in[10] + i * 256, (bf16_t*)(ws + WS_WUKV) + (size_t)i * 2048 * 256, 256, 2048, 4 * 64};
            d[nd++] = TrDesc{in[17] + (size_t)i * DM * DM, nullptr, (bf16_t*)(ws + WS_WEO) + (size_t)i * DM * DM, DM, DM, 32 * 64};
            d[nd++] = TrDesc{in[18] + (size_t)i * DM * 3072, nullptr, (bf16_t*)(ws + WS_WQKV) + (size_t)i * 3072 * DM, DM, 3072, 32 * 96};
            d[nd++] = TrDesc{in[21] + (size_t)i * DM * DM, nullptr, (bf16_t*)(ws + WS_WCO) + (size_t)i * DM * DM, DM, DM, 32 * 64};
        }
#pragma unroll
        for (int l = 0; l < 4; ++l) d[nd++] = TrDesc{in[22] + (size_t)l * DM * DM, nullptr, (bf16_t*)(ws + WS_WPQ) + (size_t)l * DM * DM, DM, DM, 32 * 64};
#pragma unroll
        for (int m = 0; m < 16; ++m) {
            for (int it = F.gw; it < d[m].items; it += F.NGW) p0_transpose_item(d[m].W, d[m].K, d[m].N, d[m].WT, d[m].gain, scr, it, F.lane);
        }
        for (int i = F.gw * 64 + F.lane; i < 2 * 192 * DM / 8; i += F.NGW * 64) { const int li = i / (192 * DM / 8), r = i % (192 * DM / 8);
            *(u32x4*)((bf16_t*)(ws + WS_WIN) + (size_t)li * 4096 * DM + (size_t)3904 * DM + (size_t)r * 8) = (u32x4){0u, 0u, 0u, 0u}; }
    }
    {
        const size_t n_sk = (size_t)4 * 16 * 128 * 128 / 8;
        const size_t gt = (size_t)F.vcu * NTHREADS + F.tid, GT = (size_t)F.G * NTHREADS;
        for (size_t j = gt; j < n_sk; j += GT) {
            const f32x4 a = *(const f32x4*)(in[23] + j * 8), b = *(const f32x4*)(in[23] + j * 8 + 4);
            u32x4 o; o.x = pk2(a.x, a.y); o.y = pk2(a.z, a.w); o.z = pk2(b.x, b.y); o.w = pk2(b.z, b.w);
            *(u32x4*)((bf16_t*)(ws + WS_SUBK) + j * 8) = o;
        }
    }
    {
        for (int r = F.gw; r < 2 * 4 * NEXP; r += F.NGW) {
            const int tab = r / (4 * NEXP), rr = r - tab * (4 * NEXP);
            const float* src = (tab ? in[25] : in[24]) + (size_t)rr * DM + F.lane * 16;
            f32x4 v[8];
#pragma unroll
            for (int j = 0; j < 2; ++j)
#pragma unroll
                for (int q = 0; q < 4; ++q) v[j * 4 + q] = *(const f32x4*)(src + j * 1024 + q * 4);
            float am = 0.f;
#pragma unroll
            for (int q = 0; q < 8; ++q) am = fmaxf(fmaxf(am, fmaxf(fabsf(v[q].x), fabsf(v[q].y))), fmaxf(fabsf(v[q].z), fabsf(v[q].w)));
#pragma unroll
            for (int o = 1; o < 64; o <<= 1) am = fmaxf(am, __shfl_xor(am, o));
            am = fmaxf(am, 1e-30f);
            const float sc = 7.5f / am;
            f32x16 a, b;
#pragma unroll
            for (int q = 0; q < 8; ++q) { const f32x4 x = v[q] * sc; a[2 * q] = x.x; b[2 * q] = x.y; a[2 * q + 1] = x.z; b[2 * q + 1] = x.w; }
            const u32x6 w = __builtin_amdgcn_cvt_scalef32_2xpk16_fp6_f32(a, b, 1.0f);
            unsigned char* dst = ws + (tab ? WS_VT : WS_U) + (size_t)rr * ROWB;
            *(u32x4*)(dst + F.lane * 16) = (u32x4){w[0], w[1], w[2], w[3]};
            *(u32x2*)(dst + 1024 + F.lane * 8) = (u32x2){w[4], w[5]};
            if (F.lane == 0) ((float*)(ws + (tab ? WS_VSC : WS_USC)))[rr] = am * (1.0f / 7.5f);
        }
    }
}

__device__ __forceinline__ void norm_phase(const Frame& F0, const float* xw, const float* g, const float* modl  , int off_sh, int off_sc, bf16_t* H) {
    const Frame F = phase_frame(F0);
    for (int row = F.gw; row < MROWS; row += F.NGW) {
        const int cls = row_cls(row);
        const f32x4* x4 = (const f32x4*)(xw + (size_t)row * DM) + F.lane;
        f32x4 v[8]; float ss = 0.f;
#pragma unroll
        for (int j = 0; j < 8; ++j) { v[j] = x4[64 * j]; ss += (v[j].x * v[j].x + v[j].y * v[j].y) + (v[j].z * v[j].z + v[j].w * v[j].w); }
        const float rstd = 1.0f / sqrtf(wave_sum_dpp(ss) * (1.f / DM) + EPS);
        const f32x4* g4 = (const f32x4*)g + F.lane; const f32x4* sc4 = (const f32x4*)(modl + (size_t)cls * NMOD + off_sc) + F.lane; const f32x4* sh4 = (const f32x4*)(modl + (size_t)cls * NMOD + off_sh) + F.lane;
        u32x2* o2 = (u32x2*)(H + (size_t)row * DM) + F.lane;
#pragma unroll
        for (int j = 0; j < 8; ++j) { const f32x4 gg = g4[64 * j], sc = sc4[64 * j], sh = sh4[64 * j];
            const f32x4 y = (v[j] * rstd) * gg * (sc + 1.0f) + sh;
            u32x2 o; o.x = pk2(y.x, y.y); o.y = pk2(y.z, y.w); o2[64 * j] = o; }
    }
}

__device__ __forceinline__ void prep_odd_phase(const Frame& F0, const bf16_t* P, const float* qg, const float* kg, const float* rope_c, bf16_t* Q, bf16_t* Kb) {
    const Frame F = phase_frame(F0);
    const float g_q1 = qg[F.lane], g_q2 = qg[F.lane + 64], g_k1 = kg[F.lane], g_k2 = kg[F.lane + 64];
    for (int row = F.gw; row < MROWS; row += F.NGW) {
        const int b = row / RB, i = row - b * RB; const bool lat = i >= CTX; const int t = i - CTX;
        float cs = 1.f, sn = 0.f;
        if (lat) { const int pos = (F.lane < 32) ? (t >> 6) : (t & 63); const float* e = rope_c + ((pos << 5) + (F.lane & 31)) * 2; cs = e[0]; sn = e[1]; }
        const bf16_t* pr = P + (size_t)row * 3072;
#pragma unroll 4
        for (int hh = 0; hh < 20; ++hh) {
            const bool isq = hh < 16; const bf16_t* src = pr + hh * 128;
            const float x1 = bf2f(src[F.lane]), x2 = bf2f(src[F.lane + 64]);
            const float rstd = 1.0f / sqrtf(wave_sum_dpp(x1 * x1 + x2 * x2) * (1.f / 128.f) + EPS);
            const float y1 = x1 * rstd * (isq ? g_q1 : g_k1), y2 = x2 * rstd * (isq ? g_q2 : g_k2);
            const float o1 = y1 * cs - y2 * sn, o2 = y2 * cs + y1 * sn;
            bf16_t* dst = isq ? (Q + (size_t)row * 2048 + hh * 128) : (Kb + (size_t)row * 512 + (hh - 16) * 128);
            dst[F.lane] = (bf16_t)f2bf(o1); dst[F.lane + 64] = (bf16_t)f2bf(o2);
        }
    }
}

__device__ __forceinline__ void prep_even_phase(const Frame& F0, const bf16_t* P, const bf16_t* QR, const bf16_t* KVR, const float* qg, const float* kg, const float* rope_a, bf16_t* Q, bf16_t* Kb, bf16_t* Vb) {
    const Frame F = phase_frame(F0);
    const float gq0 = qg[F.lane], gq1 = qg[F.lane + 64], gq2 = qg[F.lane + 128], gk0 = kg[F.lane], gk1 = kg[F.lane + 64], gk2 = kg[F.lane + 128];
    for (int row = F.gw; row < MROWS; row += F.NGW) {
        const int b = row / RB, i = row - b * RB; const bool lat = i >= CTX; const int t = i - CTX;
        float cs = 1.f, sn = 0.f;
        if (lat) { const int j = F.lane & 31; const int pos = (j < 16) ? (t >> 6) : (t & 63); const float* e = rope_a + ((pos << 4) + (j & 15)) * 2; cs = e[0]; sn = e[1]; }
        const float sgn = (F.lane < 32) ? -1.f : 1.f;
        const bf16_t* pr = P + (size_t)row * 4096;
        float ssq = 0.f, sskv = 0.f;
        { const u32x4 w = *(const u32x4*)(pr + F.lane * 8); const unsigned ww[4] = {w.x, w.y, w.z, w.w};
#pragma unroll
          for (int q = 0; q < 4; ++q) { const float a = bf_lo(ww[q]), c = bf_hi(ww[q]); ssq += a * a + c * c; } }
        { const u32x2 w = *(const u32x2*)(pr + 512 + F.lane * 4); const float a = bf_lo(w.x), c = bf_hi(w.x), d = bf_lo(w.y), e = bf_hi(w.y); sskv = (a * a + c * c) + (d * d + e * e); }
        const float rstd_q = 1.0f / sqrtf(wave_sum_dpp(ssq) * (1.f / 512.f) + EPS), rstd_kv = 1.0f / sqrtf(wave_sum_dpp(sskv) * (1.f / 256.f) + EPS);
        const float kr = bf2f(pr[768 + F.lane]);
        const bf16_t* qr = QR + (size_t)row * 1536; const bf16_t* kvr = KVR + (size_t)row * 2048;
        bf16_t* qo = Q + (size_t)row * 1536; bf16_t* ko = Kb + (size_t)row * 1536; bf16_t* vo = Vb + (size_t)row * 1024;
#pragma unroll 2
        for (int h = 0; h < 8; ++h) {
            {
                const float x0 = bf2f(qr[h * 192 + F.lane]) * rstd_q, x1 = bf2f(qr[h * 192 + 64 + F.lane]) * rstd_q, x2 = bf2f(qr[h * 192 + 128 + F.lane]) * rstd_q;
                const float r2 = 1.0f / sqrtf(wave_sum_dpp(x0 * x0 + x1 * x1 + x2 * x2) * (1.f / 192.f) + EPS);
                const float y0 = x0 * r2 * gq0, y1 = x1 * r2 * gq1, y2 = x2 * r2 * gq2;
                const float yp = swap32(y2, F.lane);
                const float o2 = y2 * cs + sgn * yp * sn;
                qo[h * 192 + F.lane] = (bf16_t)f2bf(y0); qo[h * 192 + 64 + F.lane] = (bf16_t)f2bf(y1); qo[h * 192 + 128 + F.lane] = (bf16_t)f2bf(o2);
            }
            {
                const float x0 = bf2f(kvr[h * 256 + F.lane]) * rstd_kv, x1 = bf2f(kvr[h * 256 + 64 + F.lane]) * rstd_kv;
                const float r2 = 1.0f / sqrtf(wave_sum_dpp(x0 * x0 + x1 * x1 + kr * kr) * (1.f / 192.f) + EPS);
                const float y0 = x0 * r2 * gk0, y1 = x1 * r2 * gk1, y2 = kr * r2 * gk2;
                const float yp = swap32(y2, F.lane);
                const float o2 = y2 * cs + sgn * yp * sn;
                ko[h * 192 + F.lane] = (bf16_t)f2bf(y0); ko[h * 192 + 64 + F.lane] = (bf16_t)f2bf(y1); ko[h * 192 + 128 + F.lane] = (bf16_t)f2bf(o2);
                const float v0 = bf2f(kvr[h * 256 + 128 + F.lane]) * rstd_kv, v1 = bf2f(kvr[h * 256 + 192 + F.lane]) * rstd_kv;
                vo[h * 128 + F.lane] = (bf16_t)f2bf(v0); vo[h * 128 + 64 + F.lane] = (bf16_t)f2bf(v1);
            }
        }
    }
}

__device__ __forceinline__ void conv_phase(const Frame& F0, const bf16_t* P, const float* cw  , const float* cb  , bf16_t* CAT) {
    const Frame F = phase_frame(F0);
    const int gt = F.vcu * NTHREADS + F.tid, GT = F.G * NTHREADS;
    for (int it = gt; it < MROWS * 128; it += GT) {
        const int row = it >> 7, c0 = (it & 127) * 8; const int b = row / RB, i = row - b * RB;
        const bool first = (i == 0) || (i == CTX), last = (i == CTX - 1) || (i == RB - 1);
        const bf16_t* pr = P + (size_t)row * 4096 + 832 + c0;
        const u32x4 bg = *(const u32x4*)pr, cg = *(const u32x4*)(pr + 1024), hz = *(const u32x4*)(pr + 2048);
        u32x4 cgm = {0u, 0u, 0u, 0u}, hzm = cgm, cgp = cgm, hzp = cgm;
        if (!first) { cgm = *(const u32x4*)(pr - 4096 + 1024); hzm = *(const u32x4*)(pr - 4096 + 2048); }
        if (!last) { cgp = *(const u32x4*)(pr + 4096 + 1024); hzp = *(const u32x4*)(pr + 4096 + 2048); }
        const unsigned bgw[4] = {bg.x, bg.y, bg.z, bg.w}, cgw[4] = {cg.x, cg.y, cg.z, cg.w}, hzw[4] = {hz.x, hz.y, hz.z, hz.w};
        const unsigned cmw[4] = {cgm.x, cgm.y, cgm.z, cgm.w}, hmw[4] = {hzm.x, hzm.y, hzm.z, hzm.w}, cpw[4] = {cgp.x, cgp.y, cgp.z, cgp.w}, hpw[4] = {hzp.x, hzp.y, hzp.z, hzp.w};
        unsigned ow[4];
#pragma unroll
        for (int q = 0; q < 4; ++q) {
            const int c = c0 + 2 * q;
            const float u0a = bf_lo(cgw[q]) * bf_lo(hzw[q]), u0b = bf_hi(cgw[q]) * bf_hi(hzw[q]);
            const float uma = bf_lo(cmw[q]) * bf_lo(hmw[q]), umb = bf_hi(cmw[q]) * bf_hi(hmw[q]);
            const float upa = bf_lo(cpw[q]) * bf_lo(hpw[q]), upb = bf_hi(cpw[q]) * bf_hi(hpw[q]);
            const float ra = bf_lo(bgw[q]) * (uma * cw[c] + u0a * cw[1024 + c] + upa * cw[2048 + c] + cb[c]);
            const float rb = bf_hi(bgw[q]) * (umb * cw[c + 1] + u0b * cw[1024 + c + 1] + upb * cw[2048 + c + 1] + cb[c + 1]);
            ow[q] = pk2(ra, rb);
        }
        *(u32x4*)(CAT + (size_t)row * DM + 1024 + c0) = (u32x4){ow[0], ow[1], ow[2], ow[3]};
    }
}
__device__ __forceinline__ void attn_even_phase(const Frame& F0, const bf16_t* Q, const bf16_t* Kb, const bf16_t* Vb, bf16_t* CAT) {
    const Frame F = phase_frame(F0);
    for (int u = F.vcu; u < 272; u += F.G) {
        int b, h, qt, nk;
        if (u < 256) { b = u >> 7; h = (u >> 4) & 7; qt = 1 + (u & 15); nk = RB; } else { const int v = u - 256; b = v >> 3; h = v & 7; qt = 0; nk = CTX; }
        const size_t r0 = (size_t)b * RB;
        att::attn_body1<192, 1536, 1536, 1024, 2048>(Q + (r0 + qt * 256) * 1536 + h * 192, Kb + r0 * 1536 + h * 192, Vb + r0 * 1024 + h * 128, CAT + (r0 + qt * 256) * 2048 + h * 128, nk, (char*)F.lds, phase_tid(F.wave));
    }
}
__device__ __forceinline__ void attn_odd_phase(const Frame& F0, const bf16_t* Q, const bf16_t* Kb, const bf16_t* P, bf16_t* CAT) {
    const Frame F = phase_frame(F0);
    for (int u = F.vcu; u < 544; u += F.G) {
        int b, hq, qt, nk;
        if (u < 512) { b = u >> 8; hq = (u >> 4) & 15; qt = 1 + (u & 15); nk = RB; } else { const int v = u - 512; b = v >> 4; hq = v & 15; qt = 0; nk = CTX; }
        const int kvh = hq >> 2; const size_t r0 = (size_t)b * RB;
        att::attn_body1<128, 2048, 512, 3072, 2048>(Q + (r0 + qt * 256) * 2048 + hq * 128, Kb + r0 * 512 + kvh * 128, P + r0 * 3072 + 2560 + kvh * 128, CAT + (r0 + qt * 256) * 2048 + hq * 128, nk, (char*)F.lds, phase_tid(F.wave));
    }
}

__device__ __forceinline__ int crow32(int r, int hi) { return (r & 3) + 8 * (r >> 2) + 4 * hi; }
__device__ __forceinline__ float swapmax(float m) { auto rr = __builtin_amdgcn_permlane32_swap(__float_as_uint(m), __float_as_uint(m), false, false); return fmaxf(__uint_as_float(rr[0]), __uint_as_float(rr[1])); }
__device__ __forceinline__ void peer_topk_phase(const Frame& F0, const bf16_t* PQ, const bf16_t* subk  , int* IDX, float* GATE) {
    const Frame F = phase_frame(F0);
    const float NEG = -3.0e38f;
    for (int task = F.gw; task < (MROWS / 32) * 8; task += F.NGW) {
        int lane_ = F.lane; asm volatile("" : "+v"(lane_));
        const int r32 = lane_ & 31, hi = lane_ >> 5;
        const int tg = task >> 3, h = task & 7; const int token = tg * 32 + r32;
        float top[2][16];
#pragma unroll
        for (int j = 0; j < 16; ++j) { top[0][j] = NEG; top[1][j] = NEG; }
#pragma unroll
        for (int p = 0; p < 2; ++p) {
            bf16x8 bq[8];
            const bf16_t* qp = PQ + (size_t)token * DM + h * 256 + p * 128 + hi * 8;
#pragma unroll
            for (int ks = 0; ks < 8; ++ks) bq[ks] = *(const bf16x8*)(qp + ks * 16);
            const bf16_t* kp = subk + (size_t)(h * 2 + p) * 128 * 128 + (size_t)r32 * 128 + hi * 8;
            float s[64];
#pragma unroll
            for (int nb = 0; nb < 4; ++nb) {
                f32x16 acc = {};
#pragma unroll
                for (int ks = 0; ks < 8; ++ks) { const bf16x8 a = *(const bf16x8*)(kp + (size_t)nb * 32 * 128 + ks * 16); acc = __builtin_amdgcn_mfma_f32_32x32x16_bf16(a, bq[ks], acc, 0, 0, 0); }
#pragma unroll
                for (int r = 0; r < 16; ++r) { const int key = nb * 32 + crow32(r, hi); s[nb * 16 + r] = __uint_as_float((__float_as_uint(acc[r]) & ~127u) | (unsigned)(127 - key)); }
                asm volatile("" ::: "memory");
            }
#pragma unroll 1
            for (int it = 0; it < 16; ++it) {
                float m = s[0];
#pragma unroll
                for (int i = 1; i < 64; ++i) m = fmaxf(m, s[i]);
                m = swapmax(m);
#pragma unroll
                for (int i = 0; i < 64; ++i) s[i] = (s[i] == m) ? NEG : s[i];
#pragma unroll
                for (int j = 0; j < 16; ++j) top[p][j] = (j == it) ? m : top[p][j];
            }
        }
        float cand[25];
        {
            int n = 0;
#pragma unroll
            for (int a = 0; a < 16; ++a)
#pragma unroll
                for (int b = 0; b < 16; ++b) if ((a + 1) * (b + 1) <= 16) {
                    const int slot = n >> 1, which = n & 1; ++n;
                    const float v = top[0][a] + top[1][b];
                    const float pv = __uint_as_float((__float_as_uint(v) & ~255u) | (unsigned)(255 - (a * 16 + b)));
                    if (which == 0) cand[slot] = pv; else cand[slot] = hi ? pv : cand[slot];
                }
        }
        float win[16];
#pragma unroll
        for (int j = 0; j < 16; ++j) win[j] = NEG;
#pragma unroll 1
        for (int it = 0; it < 16; ++it) {
            float m = cand[0];
#pragma unroll
            for (int i = 1; i < 25; ++i) m = fmaxf(m, cand[i]);
            m = swapmax(m);
#pragma unroll
            for (int i = 0; i < 25; ++i) cand[i] = (cand[i] == m) ? NEG : cand[i];
#pragma unroll
            for (int j = 0; j < 16; ++j) win[j] = (j == it) ? m : win[j];
        }
        float ev[16]; float esum = 0.f; const float v0 = __uint_as_float(__float_as_uint(win[0]) & ~255u);
#pragma unroll
        for (int j = 0; j < 16; ++j) { const float v = __uint_as_float(__float_as_uint(win[j]) & ~255u); ev[j] = __expf(v - v0); esum += ev[j]; }
        const float rs = 1.0f / esum;
        int oi[8]; float og[8];
#pragma unroll
        for (int j = 0; j < 8; ++j) {
            const float w = hi ? win[8 + j] : win[j]; const float e = hi ? ev[8 + j] : ev[j];
            const int id = 255 - (int)(__float_as_uint(w) & 255u), a = id >> 4, b = id & 15;
            float ta = top[0][0], tb = top[1][0];
#pragma unroll
            for (int q = 1; q < 16; ++q) { ta = (a == q) ? top[0][q] : ta; tb = (b == q) ? top[1][q] : tb; }
            const int ka = 127 - (int)(__float_as_uint(ta) & 127u), kb = 127 - (int)(__float_as_uint(tb) & 127u);
            oi[j] = ka * 128 + kb; og[j] = e * rs;
        }
        int* ip = IDX + (size_t)token * 128 + h * 16 + hi * 8; float* gp = GATE + (size_t)token * 128 + h * 16 + hi * 8;
        *(int4*)ip = make_int4(oi[0], oi[1], oi[2], oi[3]); *(int4*)(ip + 4) = make_int4(oi[4], oi[5], oi[6], oi[7]);
        *(f32x4*)gp = (f32x4){og[0], og[1], og[2], og[3]}; *(f32x4*)(gp + 4) = (f32x4){og[4], og[5], og[6], og[7]};
    }
}

__device__ __forceinline__ void peer_expert_phase(const Frame& F0, const bf16_t* H2, const int* IDX, const float* GATE, const unsigned char* U, size_t v_minus_u_bytes, const float* USC, const float* VSC,
                                                  const float* g2  , float* XW, float* OUT) {
    const Frame F = phase_frame(F0);
    LAS float* red = (LAS float*)F.lds;
    const unsigned voff_tab = (unsigned)v_minus_u_bytes;
    const __amdgpu_buffer_rsrc_t rs = __builtin_amdgcn_make_buffer_rsrc((void*)U, 0, (int)(voff_tab + (unsigned)NEXP * ROWB), 0x00020000);
    const int lane = F.lane; const int voff = lane * 16, voff2 = 1024 + lane * 8;
#define PX_SB() __builtin_amdgcn_sched_barrier(0)
#define PX_LOAD(buf, s, ivv) do { constexpr int e0_ = ((s) & 3) * 4; const unsigned tb_ = ((s) >= 4) ? voff_tab : 0u; \
        _Pragma("unroll") for (int ee_ = 0; ee_ < 4; ++ee_) { const unsigned o_ = (unsigned)__builtin_amdgcn_readlane(ivv, e0_ + ee_) * (unsigned)ROWB + tb_; \
            buf##h[ee_] = __builtin_amdgcn_raw_buffer_load_b128(rs, voff, o_, 0); buf##l[ee_] = __builtin_amdgcn_raw_buffer_load_b64(rs, voff2, o_, 0); } } while (0)
#define PX_DECODE(buf, ee_, dep) u32x6 w6_ = {buf##h[ee_].x, buf##h[ee_].y, buf##h[ee_].z, buf##h[ee_].w, buf##l[ee_].x, buf##l[ee_].y}; \
        asm volatile("" : "+v"(w6_) : "v"(dep));     \
        const f32x32 r_ = __builtin_amdgcn_cvt_scalef32_pk32_f32_fp6(w6_, 1.0f);
#define PX_COMP_U(buf, s) do { constexpr int e0_ = ((s) & 3) * 4; \
            _Pragma("unroll") for (int ee_ = 0; ee_ < 4; ++ee_) { PX_DECODE(buf, ee_, sv) \
                const f32x32 p_ = r_ * xf; float a0_ = 0.f, a1_ = 0.f; \
                _Pragma("unroll") for (int k_ = 0; k_ < 32; k_ += 2) { a0_ += p_[k_]; a1_ += p_[k_ + 1]; } \
                const float t_ = wave_sum_dpp(a0_ + a1_); sv = (lane == e0_ + ee_) ? t_ : sv; } } while (0)
#define PX_COMP_V(buf, s) do { constexpr int e0_ = ((s) & 3) * 4; \
            _Pragma("unroll") for (int ee_ = 0; ee_ < 4; ++ee_) { const float wg_ = __uint_as_float(__builtin_amdgcn_readlane(__float_as_uint(wv), e0_ + ee_)); \
                PX_DECODE(buf, ee_, acc) \
                acc += r_ * wg_; } } while (0)
#define PX_FETCH_TOKEN(r, XP, IV, GV) do { const u32x4* xp_ = (const u32x4*)(H2 + (size_t)(r) * DM + lane * 16); XP[0] = xp_[0]; XP[1] = xp_[1]; XP[2] = xp_[128]; XP[3] = xp_[129]; \
        IV = 0; GV = 0.f; if (lane < 16) { IV = IDX[(size_t)(r) * 128 + F.wave * 16 + lane]; GV = GATE[(size_t)(r) * 128 + F.wave * 16 + lane]; } } while (0)
    const bool skip_ctx = (OUT != nullptr);
    int row = F.vcu; if (skip_ctx && row < MROWS && row_cls(row) == 2) row += F.G;
    u32x4 xp[4]; int iv; float gv;
    u32x4 bAh[4], bBh[4]; u32x2 bAl[4], bBl[4];
    if (row < MROWS) { PX_FETCH_TOKEN(row, xp, iv, gv); PX_LOAD(bA, 0, iv); }
    int par = 0;
    while (row < MROWS) {
        int nrow = row + F.G; if (skip_ctx && nrow < MROWS && row_cls(nrow) == 2) nrow += F.G;
        f32x32 xf;
#pragma unroll
        for (int q = 0; q < 4; ++q) { const unsigned ww[4] = {xp[q].x, xp[q].y, xp[q].z, xp[q].w};
#pragma unroll
            for (int k = 0; k < 4; ++k) { xf[q * 8 + 2 * k] = bf_lo(ww[k]); xf[q * 8 + 2 * k + 1] = bf_hi(ww[k]); } }
        float usc = 0.f, vsc = 0.f;
        if (lane < 16) { usc = USC[iv]; vsc = VSC[iv]; }
        u32x4 xpn[4]; int ivn = 0; float gvn = 0.f;
        if (nrow < MROWS) PX_FETCH_TOKEN(nrow, xpn, ivn, gvn);
        float sv = 0.f, wv = 0.f;
        PX_LOAD(bB, 1, iv); PX_SB(); PX_COMP_U(bA, 0); PX_SB();
        PX_LOAD(bA, 2, iv); PX_SB(); PX_COMP_U(bB, 1); PX_SB();
        PX_LOAD(bB, 3, iv); PX_SB(); PX_COMP_U(bA, 2); PX_SB();
        PX_LOAD(bA, 4, iv); PX_SB(); PX_COMP_U(bB, 3); PX_SB();
        wv = gelu_erf(sv * usc) * gv * vsc;
        f32x32 acc = {};
        PX_LOAD(bB, 5, iv); PX_SB(); PX_COMP_V(bA, 4); PX_SB();
        PX_LOAD(bA, 6, iv); PX_SB(); PX_COMP_V(bB, 5); PX_SB();
        PX_LOAD(bB, 7, iv); PX_SB(); PX_COMP_V(bA, 6); PX_SB();
        if (nrow < MROWS) PX_LOAD(bA, 0, ivn);
        PX_SB(); PX_COMP_V(bB, 7); PX_SB();
        LAS float* rb = red + par * (NWAVES * DM);
#pragma unroll
        for (int j = 0; j < 2; ++j)
#pragma unroll
            for (int q = 0; q < 4; ++q) *(LAS f32x4*)(rb + F.wave * DM + j * 1024 + lane * 16 + q * 4) = (f32x4){acc[j * 16 + q * 4], acc[j * 16 + q * 4 + 1], acc[j * 16 + q * 4 + 2], acc[j * 16 + q * 4 + 3]};
        __syncthreads();
        {
            f32x4 sm = {0.f, 0.f, 0.f, 0.f};
#pragma unroll
            for (int w = 0; w < 8; ++w) sm += *(const LAS f32x4*)(rb + w * DM + F.tid * 4);
            const int cls = row_cls(row);
            const f32x4 g = *(const f32x4*)(g2 + (size_t)cls * NMOD + F.tid * 4);
            f32x4* xq = (f32x4*)(XW + (size_t)row * DM) + F.tid;
            const f32x4 xn = *xq + g * sm;
            *xq = xn;
            if (OUT) { const int b = row / RB, i = row - b * RB; if (i >= CTX) *((f32x4*)(OUT + ((size_t)b * SEQ + (i - CTX)) * DM) + F.tid) = xn; }
        }
        par ^= 1; row = nrow;
#pragma unroll
        for (int q = 0; q < 4; ++q) xp[q] = xpn[q];
        iv = ivn; gv = gvn;
    }
#undef PX_LOAD
#undef PX_COMP_U
#undef PX_COMP_V
#undef PX_SB
#undef PX_FETCH_TOKEN
}
#ifndef N_LAUNCHES
#define N_LAUNCHES 1
#endif
struct Args { const float* in[26]; float* out; unsigned char* ws; int ph_lo, ph_hi; };
constexpr int NPHASES = 39;
__global__ void __launch_bounds__(NTHREADS, 2) fwd_kernel(Args args) {
    extern __shared__ __attribute__((aligned(16))) unsigned char lds_raw[];
    Frame F_;
    F_.lds = (LAS unsigned char*)lds_raw;
    F_.tid = threadIdx.x; F_.lane = F_.tid & 63; F_.wave = __builtin_amdgcn_readfirstlane(F_.tid >> 6);
    F_.G = gridDim.x; { const int bx = blockIdx.x; F_.vcu = (F_.G % 8 == 0) ? (bx % 8) * (F_.G / 8) + bx / 8 : bx; }
    F_.gw = F_.vcu * NWAVES + F_.wave; F_.NGW = F_.G * NWAVES;
    F_.ws = args.ws;
    volatile LAS unsigned* MISC = (volatile LAS unsigned*)(F_.lds + LDS_MISC);
    if (F_.tid < 32) MISC[F_.tid] = 0u;
    __syncthreads();
    const int lo = args.ph_lo, hi = args.ph_hi;
    XcdBarrier bar; bar.bar = (unsigned*)(args.ws + WS_CTL) + CW_BAR; bar.x = 0; bar.st = nullptr;
    if (N_LAUNCHES == 1 || hi - lo > 1) bar = xcd_barrier_post((unsigned*)(args.ws + WS_CTL) + CW_BAR, MISC + 8);
#if N_LAUNCHES == 1
#define IN(k) true
#define SEAM(k) xcd_barrier(bar)
#else
#define IN(k) (lo <= (k) && (k) < hi)
#define SEAM(k) do { if (IN(k) && IN((k) + 1)) xcd_barrier(bar); } while (0)
#endif
    PG8_LAS unsigned char* glds = (PG8_LAS unsigned char*)lds_raw;

    if (IN(0)) { p0_prologue(F_, args.in); } SEAM(0);

#pragma unroll 1
    for (int lp = 0; lp < 2; ++lp) {
        const int pb = 1 + lp * 19;
        unsigned char* ws = args.ws; asm volatile("" : "+s"(ws));
        Frame F = F_; { int w_ = F_.wave, v_ = F_.vcu, g_ = F_.G; asm volatile("" : "+s"(w_), "+s"(v_), "+s"(g_)); F.wave = w_; F.vcu = v_; F.G = g_; F.gw = v_ * NWAVES + w_; F.NGW = g_ * NWAVES; F.ws = ws; }
        float* mod = (float*)(ws + WS_MOD); float* XW = (float*)(ws + WS_XW);
        bf16_t* H = (bf16_t*)(ws + WS_H); bf16_t* P = (bf16_t*)(ws + WS_P); bf16_t* QRAW = (bf16_t*)(ws + WS_QRAW); bf16_t* KVRAW = (bf16_t*)(ws + WS_KVRAW);
        bf16_t* Q = (bf16_t*)(ws + WS_Q); bf16_t* KB = (bf16_t*)(ws + WS_K); bf16_t* VB = (bf16_t*)(ws + WS_V); bf16_t* CAT = (bf16_t*)(ws + WS_CAT); bf16_t* PQ = (bf16_t*)(ws + WS_PQ);
        int* IDX = (int*)(ws + WS_IDX); float* GATE = (float*)(ws + WS_GATE);
        const float* rope_c = (const float*)(ws + WS_ROPE); const float* rope_a = rope_c + 64 * 32 * 2;
        const float* SMv = (const float*)(ws + WS_SMALL);
        {
            const int l = 2 * lp, i = lp;
            const float* modl = mod + (size_t)l * 3 * NMOD;
            if (IN(pb + 0)) { norm_phase(F, XW, SMv + SM_N1G + l * DM, modl, 0, 2048, H); } SEAM(pb + 0);
            if (IN(pb + 1)) {
                pg8::Gemm g{H, (const bf16_t*)(ws + WS_WIN) + (size_t)i * 4096 * DM, MROWS, 4096, DM, DM, DM}; pg8::StaticOrder S; S.init(MROWS, 4096, F.G, (int)blockIdx.x);
                pg8::EpiBf16 E{P, 4096};
                pg8::gemm_phase<pg8::EpiBf16, pg8::StaticOrder, true, true>(glds, g, S, E, phase_tid(F.wave));
            } SEAM(pb + 1);
            if (IN(pb + 2)) {
                { pg8::Gemm g{P, (const bf16_t*)(ws + WS_WUQ) + (size_t)i * 1536 * 512, MROWS, 1536, 512, 4096, 512}; pg8::StaticOrder S; S.init(MROWS, 1536, F.G, (int)blockIdx.x);
                  pg8::EpiBf16 E{QRAW, 1536};
                  pg8::gemm_phase<pg8::EpiBf16, pg8::StaticOrder, true, true>(glds, g, S, E, phase_tid(F.wave)); }
                __syncthreads();
                { pg8::Gemm g{P + 512, (const bf16_t*)(ws + WS_WUKV) + (size_t)i * 2048 * 256, MROWS, 2048, 256, 4096, 256}; pg8::StaticOrder S; S.init(MROWS, 2048, F.G, (int)blockIdx.x);
                  pg8::EpiBf16 E{KVRAW, 2048};
                  pg8::gemm_phase<pg8::EpiBf16, pg8::StaticOrder, true, true>(glds, g, S, E, phase_tid(F.wave)); }
                __syncthreads();
                conv_phase(F, P, SMv + SM_CW + i * 3072, SMv + SM_CB + i * 1024, CAT);
            } SEAM(pb + 2);
            if (IN(pb + 3)) { prep_even_phase(F, P, QRAW, KVRAW, SMv + SM_AQG + i * 192, SMv + SM_AKG + i * 192, rope_a, Q, KB, VB); } SEAM(pb + 3);
            if (IN(pb + 4)) { attn_even_phase(F, Q, KB, VB, CAT); } SEAM(pb + 4);
            if (IN(pb + 5)) {
                pg8::Gemm g{CAT, (const bf16_t*)(ws + WS_WEO) + (size_t)i * DM * DM, MROWS, DM, DM, DM, DM}; pg8::StaticOrder S; S.init(MROWS, DM, F.G, (int)blockIdx.x);
                pg8::EpiResid E{XW, DM, modl + 4096};
                pg8::gemm_phase<pg8::EpiResid, pg8::StaticOrder, true, true>(glds, g, S, E, phase_tid(F.wave));
            } SEAM(pb + 5);
            if (IN(pb + 6)) { norm_phase(F, XW, SMv + SM_N2G + l * DM, modl, 6144, 8192, H); } SEAM(pb + 6);
            if (IN(pb + 7)) {
                pg8::Gemm g{H, (const bf16_t*)(ws + WS_WPQ) + (size_t)l * DM * DM, MROWS, DM, DM, DM, DM}; pg8::StaticOrder S; S.init(MROWS, DM, F.G, (int)blockIdx.x);
                pg8::EpiBf16 E{PQ, DM};
                pg8::gemm_phase<pg8::EpiBf16, pg8::StaticOrder, true, true>(glds, g, S, E, phase_tid(F.wave));
            } SEAM(pb + 7);
            if (IN(pb + 8)) { peer_topk_phase(F, PQ, (const bf16_t*)(ws + WS_SUBK) + (size_t)l * 16 * 128 * 128, IDX, GATE); } SEAM(pb + 8);
            if (IN(pb + 9)) { peer_expert_phase(F, H, IDX, GATE, ws + WS_U + (size_t)l * NEXP * ROWB, (size_t)(WS_VT - WS_U), (const float*)(ws + WS_USC) + l * NEXP, (const float*)(ws + WS_VSC) + l * NEXP, modl + 10240, XW, nullptr); } SEAM(pb + 9);
        }
        {
            const int l = 2 * lp + 1, i = lp, qb = pb + 10;
            const float* modl = mod + (size_t)l * 3 * NMOD;
            if (IN(qb + 0)) { norm_phase(F, XW, SMv + SM_N1G + l * DM, modl, 0, 2048, H); } SEAM(qb + 0);
            if (IN(qb + 1)) {
                pg8::Gemm g{H, (const bf16_t*)(ws + WS_WQKV) + (size_t)i * 3072 * DM, MROWS, 3072, DM, DM, DM}; pg8::StaticOrder S; S.init(MROWS, 3072, F.G, (int)blockIdx.x);
                pg8::EpiBf16 E{P, 3072};
                pg8::gemm_phase<pg8::EpiBf16, pg8::StaticOrder, true, true>(glds, g, S, E, phase_tid(F.wave));
            } SEAM(qb + 1);
            if (IN(qb + 2)) { prep_odd_phase(F, P, SMv + SM_CQG + i * 128, SMv + SM_CKG + i * 128, rope_c, Q, KB); } SEAM(qb + 2);
            if (IN(qb + 3)) { attn_odd_phase(F, Q, KB, P, CAT); } SEAM(qb + 3);
            if (IN(qb + 4)) {
                pg8::Gemm g{CAT, (const bf16_t*)(ws + WS_WCO) + (size_t)i * DM * DM, MROWS, DM, DM, DM, DM}; pg8::StaticOrder S; S.init(MROWS, DM, F.G, (int)blockIdx.x);
                pg8::EpiResid E{XW, DM, modl + 4096};
                pg8::gemm_phase<pg8::EpiResid, pg8::StaticOrder, true, true>(glds, g, S, E, phase_tid(F.wave));
            } SEAM(qb + 4);
            if (IN(qb + 5)) { norm_phase(F, XW, SMv + SM_N2G + l * DM, modl, 6144, 8192, H); } SEAM(qb + 5);
            if (IN(qb + 6)) {
                pg8::Gemm g{H, (const bf16_t*)(ws + WS_WPQ) + (size_t)l * DM * DM, MROWS, DM, DM, DM, DM}; pg8::StaticOrder S; S.init(MROWS, DM, F.G, (int)blockIdx.x);
                pg8::EpiBf16 E{PQ, DM};
                pg8::gemm_phase<pg8::EpiBf16, pg8::StaticOrder, true, true>(glds, g, S, E, phase_tid(F.wave));
            } SEAM(qb + 6);
            if (IN(qb + 7)) { peer_topk_phase(F, PQ, (const bf16_t*)(ws + WS_SUBK) + (size_t)l * 16 * 128 * 128, IDX, GATE); } SEAM(qb + 7);
            if (IN(qb + 8)) { peer_expert_phase(F, H, IDX, GATE, ws + WS_U + (size_t)l * NEXP * ROWB, (size_t)(WS_VT - WS_U), (const float*)(ws + WS_USC) + l * NEXP, (const float*)(ws + WS_VSC) + l * NEXP, modl + 10240, XW, (l == 3) ? args.out : nullptr); } if (lp == 0) SEAM(qb + 8);
        }
    }
#undef IN
#undef SEAM
}

extern "C" void kernel_launch(void* const* d_in, const int* in_sizes, int n_in, void* d_out, int out_size, void* d_ws, size_t ws_size, hipStream_t stream) {
    static int grid = 0;
    if (grid == 0) {
        if (n_in != 26 || out_size != NBATCH * SEQ * DM || ws_size < WS_END) { fprintf(stderr, "kernel_launch: unexpected shapes: n_in %d out %d ws %zu (need %zu)\n", n_in, out_size, ws_size, (size_t)WS_END); grid = -1; return; }
        int dev = 0, cus = 0, per_cu = 0;
        if (hipGetDevice(&dev) != hipSuccess || hipDeviceGetAttribute(&cus, hipDeviceAttributeMultiprocessorCount, dev) != hipSuccess) { fprintf(stderr, "kernel_launch: device query failed\n"); grid = -1; return; }
        if (hipFuncSetAttribute((const void*)fwd_kernel, hipFuncAttributeMaxDynamicSharedMemorySize, LDS_BYTES) != hipSuccess) { fprintf(stderr, "kernel_launch: hipFuncSetAttribute failed\n"); grid = -1; return; }
        if (hipOccupancyMaxActiveBlocksPerMultiprocessor(&per_cu, (const void*)fwd_kernel, NTHREADS, LDS_BYTES) != hipSuccess || per_cu < 1) { fprintf(stderr, "kernel_launch: occupancy query says %d blocks per CU\n", per_cu); (void)hipGetLastError(); grid = -1; return; }
        grid = cus;
    }
    if (grid < 0) return;
    (void)hipMemsetAsync((char*)d_ws + WS_CTL, 0, CTL_ZERO_BYTES, stream);
    Args a{};
    for (int i = 0; i < 26; ++i) a.in[i] = (const float*)d_in[i];
    a.out = (float*)d_out; a.ws = (unsigned char*)d_ws;
    for (int li = 0; li < N_LAUNCHES; ++li) {
        a.ph_lo = (N_LAUNCHES == 1) ? 0 : li; a.ph_hi = (N_LAUNCHES == 1) ? NPHASES : li + 1;
        hipLaunchKernelGGL(fwd_kernel, dim3(grid), dim3(NTHREADS), LDS_BYTES, stream, a);
        const hipError_t le = hipPeekAtLastError();
        if (le != hipSuccess) { fprintf(stderr, "kernel_launch: launch %d failed: %s\n", li, hipGetErrorName(le)); break; }
    }
}
```

```cpp
#include <hip/hip_runtime.h>
#include <cstdio>
#include <cstdint>
namespace pg8 {
#define PG8_LAS __attribute__((address_space(3)))
typedef unsigned short bf16_t;
typedef short bf16x8 __attribute__((ext_vector_type(8)));
typedef float f32x4 __attribute__((ext_vector_type(4)));
typedef unsigned u32x4 __attribute__((ext_vector_type(4)));
constexpr int BM = 256, BK = 64, HALF = 128, HTB = HALF * BK * 2  , STAGE_BYTES = 8 * HTB, NXCD = 8, WGM = 8;

__host__ __device__ __forceinline__ int lds_byte(int r, int c) { const int st = (r >> 4) * 2 + (c >> 5), rr = r & 15, cc = c & 31, ob = rr * 64 + cc * 2; return st * 1024 + (ob ^ (((ob >> 9) & 1) << 5)); }
__host__ __device__ __forceinline__ void stage_rc(int b, int& R, int& C) { const int st = b / 1024, sb = b % 1024, swz = sb ^ (((sb >> 9) & 1) << 5); R = (st >> 1) * 16 + swz / 64; C = (st & 1) * 32 + (swz % 64) / 2; }
__host__ __device__ __forceinline__ int perm32(int rho) { const int n = rho >> 4, i = rho & 15; return 8 * (i >> 2) + 4 * n + (i & 3); }

struct Unit { int pm, pn; };
struct Gemm { const bf16_t* A; const bf16_t* Bt; int M, N, K, lda, ldb; };

struct StaticOrder {
    int nM, nN, nwg, G, c; bool lat_only;
    __host__ __device__ void init(int M, int N, int G_, int c_, bool lat_only_ = false) { lat_only = lat_only_; nM = lat_only_ ? 32 : M / BM; nN = N / BM; nwg = nM * nN; G = G_; c = c_; }
    __host__ __device__ bool next(int i, Unit& u) const {
        const long L = (long)i * G + c; if (L >= nwg) return false;
        int wgid = (int)L; { const int q = nwg / NXCD, r = nwg % NXCD, xcd = wgid % NXCD, off = wgid / NXCD; wgid = (xcd < r ? xcd * (q + 1) : r * (q + 1) + (xcd - r) * q) + off; }
        const int nig = WGM * nN, gid = wgid / nig, fm = gid * WGM, gsz = (nM - fm) < WGM ? (nM - fm) : WGM;
        u.pm = fm + ((wgid % nig) % gsz); u.pn = (wgid % nig) / gsz; if (lat_only) u.pm += 1 + (u.pm >= 16 ? 1 : 0); return true;
    }
    __device__ __forceinline__ void a_ready(const Unit&) const {}
    __device__ __forceinline__ void done(const Unit&) const {}
};
__device__ __forceinline__ unsigned cvt_pk_bf16(float lo, float hi) { unsigned r; asm volatile("v_cvt_pk_bf16_f32 %0, %1, %2" : "=v"(r) : "v"(lo), "v"(hi)); return r; }
typedef float f32x2 __attribute__((ext_vector_type(2)));
struct EpiBf16 {
    static constexpr bool PERM = true, AFTER_DRAIN = false;
    bf16_t* O; int ldc;
    __device__ __forceinline__ void operator()(const f32x4 (&acc)[2][2][4][2], const Unit& u, int wr, int wc, int fr, int fq) const {
        const int row0 = u.pm * BM + wr * 64 + fr, col0 = u.pn * BM + wc * 32 + 8 * fq;
#pragma unroll
        for (int ai = 0; ai < 2; ++ai)
#pragma unroll
            for (int m = 0; m < 4; ++m) { bf16_t* rowp = O + (size_t)(row0 + ai * HALF + m * 16) * ldc + col0;
#pragma unroll
                for (int bj = 0; bj < 2; ++bj) { const f32x4 v0 = acc[ai][bj][m][0], v1 = acc[ai][bj][m][1];
                    u32x4 w; w.x = cvt_pk_bf16(v0[0], v0[1]); w.y = cvt_pk_bf16(v0[2], v0[3]); w.z = cvt_pk_bf16(v1[0], v1[1]); w.w = cvt_pk_bf16(v1[2], v1[3]);
                    *(u32x4*)(rowp + bj * HALF) = w; } }
    }
};
struct EpiResid {
    static constexpr bool PERM = false, AFTER_DRAIN = false;
    float* X; int ldc; const float* gate;
    __device__ __forceinline__ void operator()(const f32x4 (&acc)[2][2][4][2], const Unit& u, int wr, int wc, int fr, int fq) const {
        const int row0 = u.pm * BM + wr * 64 + fr, col0 = u.pn * BM + wc * 32 + 4 * fq;
        const int cls = (u.pm % 17 == 0) ? 2 : (u.pm / 17);
        const float* gp = gate + (size_t)cls * 12288 + col0;
        f32x4 gv[2][2];
#pragma unroll
        for (int bj = 0; bj < 2; ++bj)
#pragma unroll
            for (int n = 0; n < 2; ++n) gv[bj][n] = *(const f32x4*)(gp + bj * HALF + n * 16);
#pragma unroll
        for (int ai = 0; ai < 2; ++ai)
#pragma unroll
            for (int m = 0; m < 4; ++m) { float* rowp = X + (size_t)(row0 + ai * HALF + m * 16) * ldc + col0;
#pragma unroll
                for (int bj = 0; bj < 2; ++bj)
#pragma unroll
                    for (int n = 0; n < 2; ++n) { f32x4* p = (f32x4*)(rowp + bj * HALF + n * 16); *p = *p + gv[bj][n] * acc[ai][bj][m][n]; } }
    }
};
template <class Epi, class Sched, bool ALIGN_EPI = false, bool SP2 = false>
__device__ __forceinline__ void gemm_phase(PG8_LAS unsigned char* lds, const Gemm g, const Sched& S, const Epi& E, int tid_in) {
    int tid_ = tid_in; asm volatile("" : "+v"(tid_));
    const int tid = tid_, wid = __builtin_amdgcn_readfirstlane(tid >> 6), lane = tid & 63, wr = wid >> 2, wc = wid & 3, fr = lane & 15, fq = lane >> 4;
    const int K = g.K, nt = K / BK;
    unsigned voffA[2], voffB[2];
#pragma unroll
    for (int i = 0; i < 2; ++i) { int R, C; stage_rc(tid * 16 + i * 8192, R, C); const int Rb = Epi::PERM ? ((R & ~31) + perm32(R & 31)) : R;
        voffA[i] = (unsigned)(R * g.lda + C) * 2u; voffB[i] = (unsigned)(Rb * g.ldb + C) * 2u; }
    const size_t kstep = (size_t)(BK * 2);
    const size_t hstepA = (size_t)HALF * g.lda * 2, hstepB = (size_t)HALF * g.ldb * 2;
    const size_t tstepA = 2 * hstepA, tstepB = 2 * hstepB;
    const unsigned ldsw = (unsigned)wid * 1024u;
    const int aoff = lds_byte(wr * 64 + fr, fq * 8), boff = lds_byte(wc * 32 + fr, fq * 8);
#define PG8_SA(b, h) (((b) * 2 + (h)) * HTB)
#define PG8_SB(b, h) ((4 + (b) * 2 + (h)) * HTB)
#define PG8_STAGE(bufoff, gbase, voff) do { _Pragma("unroll") for (int _i = 0; _i < 2; ++_i) \
        __builtin_amdgcn_global_load_lds((const unsigned*)((const char*)(gbase) + (voff)[_i]), (PG8_LAS unsigned*)(lds + (bufoff) + ldsw + _i * 8192), 16, 0, 0); } while (0)
#define PG8_LDA(dst, b, h) do { _Pragma("unroll") for (int m = 0; m < 4; ++m) _Pragma("unroll") for (int k = 0; k < 2; ++k) dst[m][k] = *(const PG8_LAS bf16x8*)(lds + PG8_SA(b, h) + aoff + m * 2048 + k * 1024); } while (0)
#define PG8_LDB(dst, b, h) do { _Pragma("unroll") for (int n = 0; n < 2; ++n) _Pragma("unroll") for (int k = 0; k < 2; ++k) dst[n][k] = *(const PG8_LAS bf16x8*)(lds + PG8_SB(b, h) + boff + n * 2048 + k * 1024); } while (0)
#define PG8_MMA(ai, bj, At, Bt) do { __builtin_amdgcn_s_setprio(1); _Pragma("unroll") for (int m = 0; m < 4; ++m) _Pragma("unroll") for (int n = 0; n < 2; ++n) _Pragma("unroll") for (int k = 0; k < 2; ++k) \
        acc[ai][bj][m][n] = __builtin_amdgcn_mfma_f32_16x16x32_bf16(Bt[n][k], At[m][k], acc[ai][bj][m][n], 0, 0, 0); __builtin_amdgcn_s_setprio(0); } while (0)
#define PG8_WAIT_V(n) asm volatile("s_waitcnt vmcnt(" #n ")" ::: "memory")
#define PG8_WAIT_L(n) asm volatile("s_waitcnt lgkmcnt(" #n ")" ::: "memory")
#define PG8_BAR __builtin_amdgcn_s_barrier()
#define PG8_SCHED __builtin_amdgcn_sched_barrier(0)
    Unit cur, nxt; int ui = 0;
    if (!S.next(0, cur)) return;
    f32x4 acc[2][2][4][2];
#pragma unroll
    for (int a = 0; a < 2; ++a)
#pragma unroll
        for (int b = 0; b < 2; ++b)
#pragma unroll
            for (int m = 0; m < 4; ++m)
#pragma unroll
                for (int n = 0; n < 2; ++n) acc[a][b][m][n] = (f32x4){0.f, 0.f, 0.f, 0.f};
    bf16x8 At[4][2], B0[2][2], B1[2][2];
    const char* cA = (const char*)g.A + (size_t)cur.pm * tstepA; const char* cB = (const char*)g.Bt + (size_t)cur.pn * tstepB;
    S.a_ready(cur);
    if constexpr (SP2) {
        PG8_STAGE(PG8_SB(0, 0), cB, voffB); PG8_STAGE(PG8_SB(0, 1), cB + hstepB, voffB); PG8_STAGE(PG8_SA(0, 0), cA, voffA); PG8_STAGE(PG8_SA(0, 1), cA + hstepA, voffA);
        if (wr == 1) PG8_BAR;
        PG8_WAIT_V(2); PG8_BAR;
        PG8_STAGE(PG8_SB(1, 0), cB + kstep, voffB); PG8_STAGE(PG8_SA(1, 0), cA + kstep, voffA); PG8_STAGE(PG8_SB(1, 1), cB + hstepB + kstep, voffB);
        PG8_WAIT_V(6); PG8_BAR;
    } else {
        PG8_STAGE(PG8_SB(0, 0), cB, voffB); PG8_STAGE(PG8_SA(0, 0), cA, voffA); PG8_STAGE(PG8_SB(0, 1), cB + hstepB, voffB); PG8_STAGE(PG8_SA(0, 1), cA + hstepA, voffA);
        if (wr == 1) PG8_BAR;
        PG8_WAIT_V(4); PG8_BAR;
        PG8_STAGE(PG8_SB(1, 0), cB + kstep, voffB); PG8_STAGE(PG8_SA(1, 0), cA + kstep, voffA); PG8_STAGE(PG8_SB(1, 1), cB + hstepB + kstep, voffB);
        PG8_WAIT_V(6); PG8_BAR;
    }
    for (;;) {
        const bool has_next = S.next(ui + 1, nxt);
        const char* nA = has_next ? (const char*)g.A + (size_t)nxt.pm * tstepA : cA; const char* nB = has_next ? (const char*)g.Bt + (size_t)nxt.pn * tstepB : cB;
        for (int t = 0; t < nt; t += 2) {
            const bool last = (t == nt - 2);
            const char* a1 = cA + (size_t)(t + 1) * kstep;
            const char* a2 = last ? nA : cA + (size_t)(t + 2) * kstep; const char* b2 = last ? nB : cB + (size_t)(t + 2) * kstep;
            const char* a3 = a2 + kstep; const char* b3 = b2 + kstep;
            if (last && has_next) S.a_ready(nxt);
            if constexpr (SP2) {
            PG8_LDB(B0, 0, 0); PG8_LDB(B1, 0, 1); PG8_SCHED; PG8_LDA(At, 0, 0); PG8_STAGE(PG8_SA(1, 1), a1 + hstepA, voffA);
            PG8_WAIT_V(8); PG8_WAIT_L(0); PG8_BAR; PG8_MMA(0, 0, At, B0); PG8_MMA(0, 1, At, B1); PG8_BAR; PG8_SCHED;
            PG8_LDA(At, 0, 1); PG8_STAGE(PG8_SB(0, 0), b2, voffB); PG8_STAGE(PG8_SB(0, 1), b2 + hstepB, voffB); PG8_STAGE(PG8_SA(0, 0), a2, voffA);
            PG8_WAIT_V(8); PG8_WAIT_L(0); PG8_BAR; PG8_MMA(1, 0, At, B0); PG8_MMA(1, 1, At, B1); PG8_BAR; PG8_SCHED;
            PG8_LDB(B0, 1, 0); PG8_LDB(B1, 1, 1); PG8_SCHED; PG8_LDA(At, 1, 0); PG8_STAGE(PG8_SA(0, 1), a2 + hstepA, voffA);
            PG8_WAIT_V(8); PG8_WAIT_L(0); PG8_BAR; PG8_MMA(0, 0, At, B0); PG8_MMA(0, 1, At, B1); PG8_BAR; PG8_SCHED;
            PG8_LDA(At, 1, 1); PG8_STAGE(PG8_SB(1, 0), b3, voffB); PG8_STAGE(PG8_SB(1, 1), b3 + hstepB, voffB); PG8_STAGE(PG8_SA(1, 0), a3, voffA);
            PG8_WAIT_V(8); PG8_WAIT_L(0); PG8_BAR; PG8_MMA(1, 0, At, B0); PG8_MMA(1, 1, At, B1); PG8_BAR; PG8_SCHED;
            } else {
            PG8_LDB(B0, 0, 0); PG8_SCHED; PG8_LDA(At, 0, 0); PG8_STAGE(PG8_SA(1, 1), a1 + hstepA, voffA);
            PG8_WAIT_L(8); PG8_BAR; PG8_WAIT_L(0); PG8_MMA(0, 0, At, B0); PG8_BAR; PG8_SCHED;
            PG8_LDB(B1, 0, 1); PG8_STAGE(PG8_SB(0, 0), b2, voffB);
            PG8_BAR; PG8_WAIT_L(0); PG8_MMA(0, 1, At, B1); PG8_BAR;
            PG8_LDA(At, 0, 1); PG8_STAGE(PG8_SA(0, 0), a2, voffA);
            PG8_BAR; PG8_WAIT_L(0); PG8_MMA(1, 0, At, B0); PG8_BAR; PG8_SCHED;
            PG8_STAGE(PG8_SB(0, 1), b2 + hstepB, voffB);
            PG8_WAIT_V(6); PG8_BAR; PG8_MMA(1, 1, At, B1); PG8_BAR;
            PG8_LDB(B0, 1, 0); PG8_SCHED; PG8_LDA(At, 1, 0); PG8_STAGE(PG8_SA(0, 1), a2 + hstepA, voffA);
            PG8_WAIT_L(8); PG8_BAR; PG8_WAIT_L(0); PG8_MMA(0, 0, At, B0); PG8_BAR; PG8_SCHED;
            PG8_LDB(B1, 1, 1); PG8_STAGE(PG8_SB(1, 0), b3, voffB);
            PG8_BAR; PG8_WAIT_L(0); PG8_MMA(0, 1, At, B1); PG8_BAR;
            PG8_LDA(At, 1, 1); PG8_STAGE(PG8_SA(1, 0), a3, voffA);
            PG8_BAR; PG8_WAIT_L(0); PG8_MMA(1, 0, At, B0); PG8_BAR; PG8_SCHED;
            PG8_STAGE(PG8_SB(1, 1), b3 + hstepB, voffB);
            PG8_WAIT_V(6); PG8_BAR; PG8_MMA(1, 1, At, B1); PG8_BAR;
            }
        }
        if constexpr (ALIGN_EPI) { if (wr == 0) PG8_BAR; }
        if constexpr (!Epi::AFTER_DRAIN) { E(acc, cur, wr, wc, fr, fq); S.done(cur); }
        if (!has_next) break;
#pragma unroll
        for (int a = 0; a < 2; ++a)
#pragma unroll
            for (int b = 0; b < 2; ++b)
#pragma unroll
                for (int m = 0; m < 4; ++m)
#pragma unroll
                    for (int n = 0; n < 2; ++n) acc[a][b][m][n] = (f32x4){0.f, 0.f, 0.f, 0.f};
        cur = nxt; cA = nA; cB = nB; ++ui;
        if constexpr (ALIGN_EPI) { if (wr == 1) PG8_BAR; }
    }
    PG8_WAIT_V(0);
    if constexpr (!ALIGN_EPI) { if (wr == 0) PG8_BAR; }
    PG8_BAR;
    if constexpr (Epi::AFTER_DRAIN) { E.fused(acc, cur, wr, wc, fr, fq, lds, wid, lane); S.done(cur); }
#undef PG8_SA
#undef PG8_SB
#undef PG8_STAGE
#undef PG8_LDA
#undef PG8_LDB
#undef PG8_MMA
#undef PG8_WAIT_V
#undef PG8_WAIT_L
#undef PG8_BAR
#undef PG8_SCHED
}
}
namespace att {
typedef unsigned short bf16_t;
using bf16x8 = __attribute__((ext_vector_type(8))) short;
using s16x4  = __attribute__((ext_vector_type(4))) short;
using f32x16 = __attribute__((ext_vector_type(16))) float;
using u32x4  = __attribute__((ext_vector_type(4))) unsigned;
constexpr int DV = 128, NW = 8, QBLK = 32, KVBLK = 64;
constexpr float THR = 8.f;
constexpr int SHM_V = KVBLK * DV * 2;
template <int DQK> struct Cfg {
    static constexpr int SHM_K = KVBLK * DQK * 2, KROWB = DQK * 2, NCK = DQK / 64, C8 = DQK / 8, ND0 = DQK / 16;
    static constexpr float SCALE = (DQK == 128) ? 0.088388347648318440f : 0.072168783648703220f;
    static constexpr int LDS_BYTES = 2 * SHM_V + 2 * SHM_K + NW * 64 * 4;
};
#define ATT_SBAR() __builtin_amdgcn_sched_barrier(0)
__device__ __forceinline__ int crow(int r, int hi) { return (r & 3) + 8 * (r >> 2) + 4 * hi; }
__device__ __forceinline__ unsigned cvtpk(float lo, float hi) { unsigned r; asm volatile("v_cvt_pk_bf16_f32 %0, %1, %2" : "=v"(r) : "v"(lo), "v"(hi)); return r; }
template <int DQK> __device__ __forceinline__ int kswz(int row, int colB) {
    const int key = (DQK == 128) ? (row & 7) : ((row >> 1) & 7);
    return row * (DQK * 2) + (colB ^ (key << 4));
}
template <int DQK> __device__ __forceinline__ void partialSM(f32x16& p0, f32x16& p1, float& m_reg, float& mn, float& alpha) {
    constexpr float SCALE = Cfg<DQK>::SCALE, C = SCALE * 1.4426950408889634f;
    float pmax = p0[0];
#pragma unroll
    for (int r = 1; r < 16; ++r) pmax = fmaxf(pmax, p0[r]);
#pragma unroll
    for (int r = 0; r < 16; ++r) pmax = fmaxf(pmax, p1[r]);
    { auto rr = __builtin_amdgcn_permlane32_swap(__float_as_uint(pmax), __float_as_uint(pmax), false, false);
      pmax = fmaxf(__uint_as_float(rr[0]), __uint_as_float(rr[1])); }
    if (__builtin_expect(__all(pmax - m_reg <= THR / SCALE), 1)) { mn = m_reg; alpha = 1.f; }
    else { mn = fmaxf(m_reg, pmax); alpha = __builtin_amdgcn_exp2f((m_reg - mn) * C); m_reg = mn; }
    const float mnC = -mn * C;
#pragma unroll
    for (int r = 0; r < 16; ++r) p0[r] = fmaf(p0[r], C, mnC);
#pragma unroll
    for (int r = 0; r < 16; ++r) p1[r] = fmaf(p1[r], C, mnC);
#pragma unroll
    for (int r = 0; r < 16; ++r) p0[r] = __builtin_amdgcn_exp2f(p0[r]);
}
__device__ __forceinline__ void finishSM(f32x16& p0, f32x16& p1, float alpha, float& l_reg, bf16x8& pa0, bf16x8& pa1, bf16x8& pa2, bf16x8& pa3) {
#pragma unroll
    for (int r = 0; r < 16; ++r) p1[r] = __builtin_amdgcn_exp2f(p1[r]);
    float ps = 0;
#pragma unroll
    for (int r = 0; r < 16; ++r) ps += p0[r];
#pragma unroll
    for (int r = 0; r < 16; ++r) ps += p1[r];
    { auto rr = __builtin_amdgcn_permlane32_swap(__float_as_uint(ps), __float_as_uint(ps), false, false);
      ps = __uint_as_float(rr[0]) + __uint_as_float(rr[1]); }
    l_reg = l_reg * alpha + ps;
#define ATT_PK4(P, BASE, OUT) do { unsigned a0 = cvtpk(P[BASE + 0], P[BASE + 1]), a1 = cvtpk(P[BASE + 2], P[BASE + 3]);   \
    unsigned b0 = cvtpk(P[BASE + 4], P[BASE + 5]), b1 = cvtpk(P[BASE + 6], P[BASE + 7]);                              \
    auto r0 = __builtin_amdgcn_permlane32_swap(a0, b0, false, false); auto r1 = __builtin_amdgcn_permlane32_swap(a1, b1, false, false); \
    u32x4 w = {r0[0], r1[0], r0[1], r1[1]}; OUT = *reinterpret_cast<bf16x8*>(&w); } while (0)
    ATT_PK4(p0, 0, pa0); ATT_PK4(p0, 8, pa1); ATT_PK4(p1, 0, pa2); ATT_PK4(p1, 8, pa3);
#undef ATT_PK4
}
template <int DQK> __device__ __forceinline__ void qkt(f32x16& p0, f32x16& p1, const char* Ks, const bf16x8* qr, int r32, int hi) {
    p0 = f32x16{}; p1 = f32x16{};
#pragma unroll
    for (int d0 = 0; d0 < Cfg<DQK>::ND0; ++d0) { const int cb = (d0 * 16 + hi * 8) * 2;
        bf16x8 b0 = *reinterpret_cast<const bf16x8*>(Ks + kswz<DQK>(r32, cb));
        bf16x8 b1 = *reinterpret_cast<const bf16x8*>(Ks + kswz<DQK>(32 + r32, cb));
        p0 = __builtin_amdgcn_mfma_f32_32x32x16_bf16(b0, qr[d0], p0, 0, 0, 0);
        p1 = __builtin_amdgcn_mfma_f32_32x32x16_bf16(b1, qr[d0], p1, 0, 0, 0); }
}
__device__ __forceinline__ int v_st(int k, int c) { const int kk = (k & ~0xC) | ((k & 4) << 1) | ((k & 8) >> 1); return ((kk >> 3) * 4 + (c >> 5)) * 512 + ((kk & 7) * 32 + (c & 31)) * 2; }
__device__ __forceinline__ int v_rd_base(int lane) { return ((lane & 3) << 3) | (((lane >> 2) & 3) << 6) | (((lane >> 4) & 1) << 5) | (((lane >> 5) & 1) << 8); }
constexpr int v_rd_off(int d0, int ks, int half) { return d0 * 512 + ks * 4096 + half * 2048; }
template <int OFF> __device__ __forceinline__ s16x4 tr_read(int vb) {
    s16x4 r; asm volatile("ds_read_b64_tr_b16 %0, %1 offset:%2" : "=&v"(r) : "v"(vb), "i"(OFF) : "memory"); return r;
}
template <int D0> __device__ __forceinline__ void pv_one(f32x16& od, int vb, bf16x8 pa0, bf16x8 pa1, bf16x8 pa2, bf16x8 pa3) {
    const s16x4 l0 = tr_read<v_rd_off(D0, 0, 0)>(vb), h0 = tr_read<v_rd_off(D0, 0, 1)>(vb), l1 = tr_read<v_rd_off(D0, 1, 0)>(vb), h1 = tr_read<v_rd_off(D0, 1, 1)>(vb);
    const s16x4 l2 = tr_read<v_rd_off(D0, 2, 0)>(vb), h2 = tr_read<v_rd_off(D0, 2, 1)>(vb), l3 = tr_read<v_rd_off(D0, 3, 0)>(vb), h3 = tr_read<v_rd_off(D0, 3, 1)>(vb);
    asm volatile("s_waitcnt lgkmcnt(0)" ::: "memory"); ATT_SBAR();
#define ATT_PK(L, H) (bf16x8){L[0], L[1], L[2], L[3], H[0], H[1], H[2], H[3]}
    od = __builtin_amdgcn_mfma_f32_32x32x16_bf16(pa0, ATT_PK(l0, h0), od, 0, 0, 0);
    od = __builtin_amdgcn_mfma_f32_32x32x16_bf16(pa1, ATT_PK(l1, h1), od, 0, 0, 0);
    od = __builtin_amdgcn_mfma_f32_32x32x16_bf16(pa2, ATT_PK(l2, h2), od, 0, 0, 0);
    od = __builtin_amdgcn_mfma_f32_32x32x16_bf16(pa3, ATT_PK(l3, h3), od, 0, 0, 0);
#undef ATT_PK
}
__device__ __forceinline__ void pv_d0(f32x16* o, int vb, bf16x8 pa0, bf16x8 pa1, bf16x8 pa2, bf16x8 pa3) {
    pv_one<0>(o[0], vb, pa0, pa1, pa2, pa3); pv_one<1>(o[1], vb, pa0, pa1, pa2, pa3); pv_one<2>(o[2], vb, pa0, pa1, pa2, pa3); pv_one<3>(o[3], vb, pa0, pa1, pa2, pa3);
}
template <int DQK, int LDQ, int LDK, int LDV, int LDO, int SDEPTH>
__device__ __forceinline__ void attn_body(const bf16_t* __restrict__ Qb, const bf16_t* __restrict__ Kh, const bf16_t* __restrict__ Vh, bf16_t* __restrict__ Ob, int seq, char* lds, int tid_in) {
    using C_ = Cfg<DQK>;
    constexpr int SHM_K = C_::SHM_K, NCK = C_::NCK, C8 = C_::C8, ND0 = C_::ND0;
    int tid_ = tid_in; asm volatile("" : "+v"(tid_));
    const int tid = tid_, wid = tid >> 6, lane = tid & 63, r32 = lane & 31, hi = lane >> 5;
    char* V_lds = lds; char* K_lds = lds + 2 * SHM_V;
    float* ws = (float*)(lds + 2 * SHM_V + 2 * SHM_K) + wid * 64; float* li_l = ws; float* al_l = ws + 32;
    float m_reg = -1e30f, l_reg = 0; f32x16 o[4] = {}; bf16x8 qr[ND0];
    const bf16_t* Qw = Qb + (long)(wid * QBLK + r32) * LDQ + hi * 8;
#pragma unroll
    for (int d0 = 0; d0 < ND0; ++d0) qr[d0] = *reinterpret_cast<const bf16x8*>(Qw + d0 * 16);
    const int sr = tid >> 4, sc = (tid & 15) * 8, vst0 = v_st(sr, sc), vst1 = v_st(32 + sr, sc);
    int krow[NCK], kcol[NCK];
#pragma unroll
    for (int i = 0; i < NCK; ++i) { const int ci = tid + 512 * i; krow[i] = ci / C8; kcol[i] = (ci % C8) * 8; }
    const int vb0 = (int)(uintptr_t)V_lds + v_rd_base(lane);
    struct { bf16x8 vs0, vs1, ks[NCK]; } sr_[SDEPTH];
#define ATT_SLOAD(i, k0) do { sr_[i].vs0 = *reinterpret_cast<const bf16x8*>(&Vh[(long)((k0) + sr) * LDV + sc]); sr_[i].vs1 = *reinterpret_cast<const bf16x8*>(&Vh[(long)((k0) + 32 + sr) * LDV + sc]); \
    _Pragma("unroll") for (int c_ = 0; c_ < NCK; ++c_) sr_[i].ks[c_] = *reinterpret_cast<const bf16x8*>(&Kh[(long)((k0) + krow[c_]) * LDK + kcol[c_]]); } while (0)
#define ATT_SWRITE(b, i) do { *(bf16x8*)(V_lds + (b) * SHM_V + vst0) = sr_[i].vs0; *(bf16x8*)(V_lds + (b) * SHM_V + vst1) = sr_[i].vs1; \
    _Pragma("unroll") for (int c_ = 0; c_ < NCK; ++c_) *(bf16x8*)(K_lds + (b) * SHM_K + kswz<DQK>(krow[c_], kcol[c_] * 2)) = sr_[i].ks[c_]; } while (0)
#define ATT_SWAIT() do { if constexpr (SDEPTH == 2) { if constexpr (NCK == 2) asm volatile("s_waitcnt vmcnt(4)" ::: "memory"); else asm volatile("s_waitcnt vmcnt(5)" ::: "memory"); } else asm volatile("s_waitcnt vmcnt(0)" ::: "memory"); } while (0)
#define ATT_RESC(a) do { if (__any((a) < 1.f)) { if (hi == 0) al_l[r32] = (a); asm volatile("s_waitcnt lgkmcnt(0)" ::: "memory"); \
    _Pragma("unroll") for (int d = 0; d < 4; ++d) _Pragma("unroll") for (int r = 0; r < 16; ++r) o[d][r] *= al_l[crow(r, hi)]; } } while (0)
    f32x16 pA0, pA1, pB0, pB1; float mnA, mnB, alA, alB; bf16x8 pa0, pa1, pa2, pa3; const int NT = seq / KVBLK;
    constexpr int SE = 0, SO = SDEPTH - 1;
    ATT_SLOAD(SE, 0); asm volatile("s_waitcnt vmcnt(0)" ::: "memory"); ATT_SWRITE(0, SE); __syncthreads();
    qkt<DQK>(pA0, pA1, K_lds, qr, r32, hi); partialSM<DQK>(pA0, pA1, m_reg, mnA, alA);
    ATT_SLOAD(SO, KVBLK); if constexpr (SDEPTH == 2) { if (2 < NT) ATT_SLOAD(SE, 2 * KVBLK); }
    ATT_SWAIT(); ATT_SWRITE(1, SO); __syncthreads();
    for (int j = 1; j + 1 < NT; j += 2) {
        ATT_SBAR(); qkt<DQK>(pB0, pB1, K_lds + SHM_K, qr, r32, hi);
        finishSM(pA0, pA1, alA, l_reg, pa0, pa1, pa2, pa3); ATT_SBAR();
        ATT_SLOAD(SO, (j + SDEPTH) * KVBLK); ATT_SBAR();
        pv_d0(o, vb0, pa0, pa1, pa2, pa3); partialSM<DQK>(pB0, pB1, m_reg, mnB, alB);
        __syncthreads(); ATT_SWAIT(); ATT_SWRITE(0, SE);
        ATT_RESC(alB); __syncthreads();
        ATT_SBAR(); qkt<DQK>(pA0, pA1, K_lds, qr, r32, hi);
        finishSM(pB0, pB1, alB, l_reg, pa0, pa1, pa2, pa3); ATT_SBAR();
        if (SDEPTH == 1 || j + 3 < NT) ATT_SLOAD(SE, (j + 1 + SDEPTH) * KVBLK); ATT_SBAR();
        pv_d0(o, vb0 + (int)SHM_V, pa0, pa1, pa2, pa3); partialSM<DQK>(pA0, pA1, m_reg, mnA, alA);
        __syncthreads(); ATT_SWAIT(); ATT_SWRITE(1, SO);
        ATT_RESC(alA); __syncthreads();
    }
    ATT_SBAR(); qkt<DQK>(pB0, pB1, K_lds + SHM_K, qr, r32, hi);
    finishSM(pA0, pA1, alA, l_reg, pa0, pa1, pa2, pa3); ATT_SBAR();
    pv_d0(o, vb0, pa0, pa1, pa2, pa3); partialSM<DQK>(pB0, pB1, m_reg, mnB, alB);
    __syncthreads(); ATT_RESC(alB);
    finishSM(pB0, pB1, alB, l_reg, pa0, pa1, pa2, pa3); ATT_SBAR();
    pv_d0(o, vb0 + (int)SHM_V, pa0, pa1, pa2, pa3);
    if (hi == 0) li_l[r32] = l_reg;
    asm volatile("s_waitcnt lgkmcnt(0)" ::: "memory");
    __syncthreads();
    float rli[16];
#pragma unroll
    for (int r = 0; r < 16; ++r) rli[r] = __builtin_amdgcn_rcpf(li_l[crow(r, hi)]);
    unsigned short* stg = (unsigned short*)(lds + wid * 8192);
#pragma unroll
    for (int r = 0; r < 16; ++r) { const int orow = crow(r, hi);
#pragma unroll
        for (int d0 = 0; d0 < 4; ++d0) { const unsigned w = cvtpk(o[d0][r] * rli[r], 0.f); stg[orow * 128 + d0 * 32 + r32] = (unsigned short)(w & 0xffffu); } }
    asm volatile("s_waitcnt lgkmcnt(0)" ::: "memory");
    bf16_t* Ow = Ob + (long)(wid * QBLK) * LDO;
#pragma unroll
    for (int i = 0; i < 8; ++i) { const int id = lane + 64 * i, row = id >> 4, c16 = id & 15;
        const u32x4 v = *(const u32x4*)((const char*)stg + row * 256 + c16 * 16);
        *(u32x4*)(Ow + (long)row * LDO + c16 * 8) = v; }
    asm volatile("s_waitcnt lgkmcnt(0)" ::: "memory");
    __syncthreads();
#undef ATT_SLOAD
#undef ATT_SWRITE
#undef ATT_SWAIT
#undef ATT_RESC
}

template <int DQK, int LDQ, int LDK, int LDV, int LDO>
__device__ __forceinline__ void attn_body1(const bf16_t* __restrict__ Qb, const bf16_t* __restrict__ Kh, const bf16_t* __restrict__ Vh, bf16_t* __restrict__ Ob, int seq, char* lds, int tid_in) {
    using C_ = Cfg<DQK>;
    constexpr int SHM_K = C_::SHM_K, NCK = C_::NCK, C8 = C_::C8, ND0 = C_::ND0;
    int tid_ = tid_in; asm volatile("" : "+v"(tid_));
    const int tid = tid_, wid = tid >> 6, lane = tid & 63, r32 = lane & 31, hi = lane >> 5;
    char* V_lds = lds; char* K_lds = lds + 2 * SHM_V;
    float* ws = (float*)(lds + 2 * SHM_V + 2 * SHM_K) + wid * 64; float* li_l = ws; float* al_l = ws + 32;
    float m_reg = -1e30f, l_reg = 0; f32x16 o[4] = {}; bf16x8 qr[ND0];
    const bf16_t* Qw = Qb + (long)(wid * QBLK + r32) * LDQ + hi * 8;
#pragma unroll
    for (int d0 = 0; d0 < ND0; ++d0) qr[d0] = *reinterpret_cast<const bf16x8*>(Qw + d0 * 16);
    const int sr = tid >> 4, sc = (tid & 15) * 8, vst0 = v_st(sr, sc), vst1 = v_st(32 + sr, sc);
    int krow[NCK], kcol[NCK];
#pragma unroll
    for (int i = 0; i < NCK; ++i) { const int ci = tid + 512 * i; krow[i] = ci / C8; kcol[i] = (ci % C8) * 8; }
    const int vb0 = (int)(uintptr_t)V_lds + v_rd_base(lane);
    bf16x8 vs0, vs1, ks[NCK];
#define ATT1_SLOAD(k0) do { vs0 = *reinterpret_cast<const bf16x8*>(&Vh[(long)((k0) + sr) * LDV + sc]); vs1 = *reinterpret_cast<const bf16x8*>(&Vh[(long)((k0) + 32 + sr) * LDV + sc]); \
    _Pragma("unroll") for (int c_ = 0; c_ < NCK; ++c_) ks[c_] = *reinterpret_cast<const bf16x8*>(&Kh[(long)((k0) + krow[c_]) * LDK + kcol[c_]]); } while (0)
#define ATT1_SWRITE(b) do { *(bf16x8*)(V_lds + (b) * SHM_V + vst0) = vs0; *(bf16x8*)(V_lds + (b) * SHM_V + vst1) = vs1; \
    _Pragma("unroll") for (int c_ = 0; c_ < NCK; ++c_) *(bf16x8*)(K_lds + (b) * SHM_K + kswz<DQK>(krow[c_], kcol[c_] * 2)) = ks[c_]; } while (0)
    const int NT = seq / KVBLK;
    ATT1_SLOAD(0); asm volatile("s_waitcnt vmcnt(0)" ::: "memory"); ATT1_SWRITE(0); __syncthreads();
    for (int j = 0; j < NT; ++j) {
        const int b = j & 1;
        if (j + 1 < NT) ATT1_SLOAD((j + 1) * KVBLK);
        ATT_SBAR();
        f32x16 p0, p1; float mn, alpha; bf16x8 pa0, pa1, pa2, pa3;
        qkt<DQK>(p0, p1, K_lds + b * SHM_K, qr, r32, hi);
        partialSM<DQK>(p0, p1, m_reg, mn, alpha);
        if (__any(alpha < 1.f)) { if (hi == 0) al_l[r32] = alpha; asm volatile("s_waitcnt lgkmcnt(0)" ::: "memory");
#pragma unroll
            for (int d = 0; d < 4; ++d)
#pragma unroll
                for (int r = 0; r < 16; ++r) o[d][r] *= al_l[crow(r, hi)]; }
        finishSM(p0, p1, alpha, l_reg, pa0, pa1, pa2, pa3); ATT_SBAR();
        pv_d0(o, vb0 + b * (int)SHM_V, pa0, pa1, pa2, pa3);
        if (j + 1 < NT) { ATT1_SWRITE(b ^ 1); }
        __syncthreads();
    }
    if (hi == 0) li_l[r32] = l_reg;
    asm volatile("s_waitcnt lgkmcnt(0)" ::: "memory");
    __syncthreads();
    float rli[16];
#pragma unroll
    for (int r = 0; r < 16; ++r) rli[r] = __builtin_amdgcn_rcpf(li_l[crow(r, hi)]);
    unsigned short* stg = (unsigned short*)(lds + wid * 8192);
#pragma unroll
    for (int r = 0; r < 16; ++r) { const int orow = crow(r, hi);
#pragma unroll
        for (int d0 = 0; d0 < 4; ++d0) { const unsigned w = cvtpk(o[d0][r] * rli[r], 0.f); stg[orow * 128 + d0 * 32 + r32] = (unsigned short)(w & 0xffffu); } }
    asm volatile("s_waitcnt lgkmcnt(0)" ::: "memory");
    bf16_t* Ow = Ob + (long)(wid * QBLK) * LDO;
#pragma unroll
    for (int i = 0; i < 8; ++i) { const int id = lane + 64 * i, row = id >> 4, c16 = id & 15;
        const u32x4 v = *(const u32x4*)((const char*)stg + row * 256 + c16 * 16);
        *(u32x4*)(Ow + (long)row * LDO + c16 * 8) = v; }
    asm volatile("s_waitcnt lgkmcnt(0)" ::: "memory");
    __syncthreads();
#undef ATT1_SLOAD
#undef ATT1_SWRITE
}
}
constexpr int DM = 2048, NBATCH = 2, SEQ = 4096, CTX = 256, RB = SEQ + CTX  , MROWS = NBATCH * RB  ;
constexpr int NMOD = 6 * DM, NEXP = 16384;
constexpr float EPS = 1e-6f;
constexpr int NWAVES = 8, NTHREADS = 512;
constexpr size_t MiB = 1u << 20;
constexpr size_t WS_CTL = 0, CTL_ZERO_BYTES = 64 * 1024;
constexpr size_t WS_MOD = 1 * MiB;
constexpr size_t WS_ROPE = 2 * MiB;
constexpr size_t WS_SMALL = 3 * MiB;
constexpr int SM_N1G = 0, SM_N2G = 8192, SM_AQG = 16384, SM_AKG = 16384 + 384, SM_CW = 16384 + 768, SM_CB = SM_CW + 6144, SM_CQG = SM_CB + 2048, SM_CKG = SM_CQG + 256, SM_END = SM_CKG + 256;
constexpr size_t WS_XW = 4 * MiB;
constexpr size_t WS_H = 72 * MiB;
constexpr size_t WS_P = 106 * MiB;
constexpr size_t WS_QRAW = 174 * MiB;
constexpr size_t WS_KVRAW = 200 * MiB;
constexpr size_t WS_Q = 234 * MiB;
constexpr size_t WS_K = 268 * MiB;
constexpr size_t WS_V = 294 * MiB;
constexpr size_t WS_CAT = 311 * MiB;
constexpr size_t WS_PQ = 345 * MiB;
constexpr size_t WS_IDX = 379 * MiB;
constexpr size_t WS_GATE = 384 * MiB;
constexpr size_t WS_WIN = 389 * MiB;
constexpr size_t WS_WUQ = 421 * MiB;
constexpr size_t WS_WUKV = 424 * MiB;
constexpr size_t WS_WEO = 426 * MiB;
constexpr size_t WS_WQKV = 442 * MiB;
constexpr size_t WS_WCO = 466 * MiB;
constexpr size_t WS_WPQ = 482 * MiB;
constexpr size_t WS_SUBK = 514 * MiB;
constexpr int ROWB = 1536;
constexpr size_t WS_U = 516 * MiB;
constexpr size_t WS_VT = 644 * MiB;
constexpr size_t WS_USC = 772 * MiB;
constexpr size_t WS_VSC = 773 * MiB;
constexpr size_t WS_END = 774 * MiB;
constexpr int CW_BAR = 4096;
constexpr int LDS_MISC = 131072 + 8192;
constexpr int LDS_BYTES = 147456;

#define LAS __attribute__((address_space(3)))
typedef unsigned short bf16_t;
typedef float f32x4 __attribute__((ext_vector_type(4)));
typedef unsigned u32x4 __attribute__((ext_vector_type(4)));
typedef unsigned u32x2 __attribute__((ext_vector_type(2)));
typedef short bf16x8 __attribute__((ext_vector_type(8)));
typedef float f32x16 __attribute__((ext_vector_type(16)));
typedef __bf16 bf16x2_t __attribute__((ext_vector_type(2)));
typedef float f32x2 __attribute__((ext_vector_type(2)));
typedef float f32x32 __attribute__((ext_vector_type(32)));
typedef unsigned u32x6 __attribute__((ext_vector_type(6)));

__device__ __forceinline__ unsigned f2bf(float f) { unsigned u = __builtin_bit_cast(unsigned, f); return (u + 0x7fffu + ((u >> 16) & 1u)) >> 16; }
__device__ __forceinline__ unsigned pk2(float lo, float hi) { return f2bf(lo) | (f2bf(hi) << 16); }
__device__ __forceinline__ float bf_lo(unsigned w) { return __builtin_bit_cast(float, w << 16); }
__device__ __forceinline__ float bf_hi(unsigned w) { return __builtin_bit_cast(float, w & 0xffff0000u); }
__device__ __forceinline__ float bf2f(bf16_t h) { return __builtin_bit_cast(float, (unsigned)h << 16); }
__device__ __forceinline__ float wave_sum(float v) {
#pragma unroll
    for (int o = 1; o < 64; o <<= 1) v += __shfl_xor(v, o);
    return v;
}
#define DPP_ADD(v, ctrl) ((v) + __builtin_bit_cast(float, __builtin_amdgcn_update_dpp(0, __builtin_bit_cast(int, (v)), (ctrl), 0xf, 0xf, true)))
__device__ __forceinline__ float wave_sum_dpp(float v) {
    v = DPP_ADD(v, 0xB1);
    v = DPP_ADD(v, 0x4E);
    v = DPP_ADD(v, 0x141);
    v = DPP_ADD(v, 0x140);
    const int vi = __builtin_bit_cast(int, v);
    const float s0 = __builtin_bit_cast(float, __builtin_amdgcn_readlane(vi, 0)), s1 = __builtin_bit_cast(float, __builtin_amdgcn_readlane(vi, 16));
    const float s2 = __builtin_bit_cast(float, __builtin_amdgcn_readlane(vi, 32)), s3 = __builtin_bit_cast(float, __builtin_amdgcn_readlane(vi, 48));
    return (s0 + s1) + (s2 + s3);
}
__device__ __forceinline__ float dot2_bf16(unsigned w, unsigned x, float acc) { return __builtin_amdgcn_fdot2_f32_bf16(__builtin_bit_cast(bf16x2_t, w), __builtin_bit_cast(bf16x2_t, x), acc, false); }
__device__ __forceinline__ float gelu_erf(float v) {
    const float av = fabsf(v), t = __builtin_amdgcn_rcpf(av * 0.2316418882f + 1.0f);
    float q = t * 0.5307027145f + (-0.7265760135f); q = q * t + 0.7107068705f; q = q * t + (-0.142248368f); q = q * t + 0.127414796f; q = q * t;
    const float e = __builtin_amdgcn_exp2f((v * v) * (-0.72134752044f));
    const float m = v * (q * e);
    return v < 0.f ? m : v - m;
}
#define XB_TMO      128
#define XB_XCNT(j)  (256  + 64 * (j))
#define XB_XSUB(j)  (1280 + 64 * (j))
#define XB_XGEN(j)  (2304 + 64 * (j))
#define XB_TOP      3328
#define XB_TOPGEN   3392
#define XCD_BAR_WORDS 3456
#define XB_SPIN_CAP (1u << 18)

__device__ __forceinline__ unsigned xb_ld(unsigned* p)              { return __hip_atomic_load(p, __ATOMIC_RELAXED, __HIP_MEMORY_SCOPE_AGENT); }
__device__ __forceinline__ unsigned xb_add(unsigned* p, unsigned v) { return __hip_atomic_fetch_add(p, v, __ATOMIC_RELAXED, __HIP_MEMORY_SCOPE_AGENT); }
__device__ __forceinline__ unsigned xb_xcc_id() { return (unsigned)__builtin_amdgcn_s_getreg((3 << 11) | 20) & 0xFu; }
#define XB_SPIN(cond, bar) do { unsigned _sp = 0; while (cond) { __builtin_amdgcn_s_sleep(1); \
    if ((++_sp & 255u) == 0u) { if (xb_ld(&(bar)[XB_TMO])) break; if (_sp > XB_SPIN_CAP) { atomicAdd(&(bar)[XB_TMO], 1u); break; } } } } while (0)

struct XcdBarrier {
    unsigned* bar; unsigned x;
    volatile LAS unsigned* st;
};

__device__ __forceinline__ XcdBarrier xcd_barrier_post(unsigned* bar, volatile LAS unsigned* st) {
    XcdBarrier b; b.bar = bar; b.x = xb_xcc_id(); b.st = st;
    if (threadIdx.x == 0) (void)xb_add(&bar[XB_XCNT(b.x)], 1u);
    return b;
}
__device__ __forceinline__ void xcd_barrier_complete(unsigned* bar, unsigned x, unsigned& nloc, unsigned& nx) {
    const unsigned G = gridDim.x * gridDim.y * gridDim.z;
    unsigned sum, cnt, mine, sp = 0u;
    for (;;) {
        sum = 0u; cnt = 0u; mine = 0u;
#pragma unroll
        for (unsigned j = 0; j < 16; ++j) { const unsigned c = xb_ld(&bar[XB_XCNT(j)]); sum += c; cnt += (c > 0u) ? 1u : 0u; mine = (j == x) ? c : mine; }
        if (sum == G) break;
        __builtin_amdgcn_s_sleep(1);
        if ((++sp & 255u) == 0u) { if (xb_ld(&bar[XB_TMO])) break; if (sp > XB_SPIN_CAP) { atomicAdd(&bar[XB_TMO], 1u); break; } }
    }
    nloc = mine > 0u ? mine : 1u; nx = cnt > 0u ? cnt : 1u;
}

__device__ __forceinline__ void xcd_barrier(const XcdBarrier& b) {
    asm volatile("s_waitcnt vmcnt(0)" ::: "memory");
    __syncthreads();
    if (threadIdx.x == 0) {
        unsigned* bar = b.bar; unsigned bx = b.x;
        asm volatile("" : "+s"(bar), "+s"(bx));
        __builtin_amdgcn_s_waitcnt(0);
        unsigned nloc = b.st[0], nx = b.st[1];
        if (nloc == 0u) { xcd_barrier_complete(bar, bx, nloc, nx); b.st[0] = nloc; b.st[1] = nx; }
        const unsigned old = xb_add(&bar[XB_XSUB(bx)], 1u);
        const unsigned gen = old / nloc;
        if (old + 1u == (gen + 1u) * nloc) {
            __builtin_amdgcn_fence(__ATOMIC_RELEASE, "agent");
            asm volatile("s_waitcnt vmcnt(0)" ::: "memory");
            const unsigned og = xb_add(&bar[XB_TOP], 1u);
            const unsigned tg = og / nx;
            if (og + 1u == (tg + 1u) * nx) xb_add(&bar[XB_TOPGEN], 1u);
            else XB_SPIN(xb_ld(&bar[XB_TOPGEN]) == tg, bar);
            __builtin_amdgcn_fence(__ATOMIC_ACQUIRE, "agent");
            xb_add(&bar[XB_XGEN(bx)], 1u);
            asm volatile("s_waitcnt vmcnt(0)" ::: "memory");
        } else {
            XB_SPIN(xb_ld(&bar[XB_XGEN(bx)]) == gen, bar);
            __builtin_amdgcn_fence(__ATOMIC_ACQUIRE, "agent");
            asm volatile("s_waitcnt vmcnt(0)" ::: "memory");
        }
    }
    __syncthreads();
}
struct Frame {
    LAS unsigned char* lds;
    int tid, lane, wave, vcu, G, gw, NGW;
    unsigned char* ws;
};
__device__ __forceinline__ int opaque_v(int v) { asm volatile("" : "+v"(v)); return v; }
__device__ __forceinline__ int phase_tid(int wave) { int lane; asm volatile("v_mbcnt_lo_u32_b32 %0, -1, 0\n\tv_mbcnt_hi_u32_b32 %0, -1, %0" : "=v"(lane)); return wave * 64 + lane; }
__device__ __forceinline__ Frame phase_frame(const Frame& F0) { Frame F = F0; F.tid = phase_tid(F0.wave); F.lane = F.tid & 63; return F; }
__device__ __forceinline__ float swap32(float v, int lane) { auto rr = __builtin_amdgcn_permlane32_swap(__float_as_uint(v), __float_as_uint(v), false, false); return __uint_as_float(lane < 32 ? rr[1] : rr[0]); }
__device__ __forceinline__ int row_cls(int row) { const int b = row / RB, i = row - b * RB; return i < CTX ? 2 : b; }

__device__ __forceinline__ void p0_transpose_item(const float* W, int K, int N, bf16_t* WT, const float* gain, LAS float* scr, int item, int lane) {
    const int nblk = N / 32, kb = item / nblk, nb = item % nblk, k0 = 64 * kb, n0 = 32 * nb;
#pragma unroll 8
    for (int i = 0; i < 32; ++i) { const int kk = 2 * i + (lane >> 5); float v = W[(size_t)(k0 + kk) * N + n0 + (lane & 31)]; if (gain) v *= gain[k0 + kk]; scr[kk * 33 + (lane & 31)] = v; }
    asm volatile("s_waitcnt lgkmcnt(0)" ::: "memory");
    const int c = lane & 7;
#pragma unroll
    for (int j = 0; j < 4; ++j) { const int n = (lane >> 3) + 8 * j; const LAS float* s = scr + (8 * c) * 33 + n;
        u32x4 o; o.x = pk2(s[0 * 33], s[1 * 33]); o.y = pk2(s[2 * 33], s[3 * 33]); o.z = pk2(s[4 * 33], s[5 * 33]); o.w = pk2(s[6 * 33], s[7 * 33]);
        *(u32x4*)(WT + (size_t)(n0 + n) * K + k0 + 8 * c) = o; }
    asm volatile("s_waitcnt lgkmcnt(0)" ::: "memory");
}
struct TrDesc { const float* W; const float* gain; bf16_t* WT; int K, N, items; };

__device__ __forceinline__ void p0_gemv_task(Frame& F, int task, const float* ada_w, const float* ada_b, float* mod) {
    LAS float* sv = (LAS float*)F.lds; LAS float* part = (LAS float*)(F.lds + 32768);
    const int l = task / 48, n0 = (task % 48) * 256;
    const float* Wp = ada_w + (size_t)l * DM * NMOD + n0 + F.lane * 4 + (size_t)(F.wave * 256) * NMOD;
    f32x4 a0 = {0, 0, 0, 0}, a1 = a0, a2 = a0;
    for (int k = 0; k < 256; k += 8) {
        f32x4 w[8];
#pragma unroll
        for (int u = 0; u < 8; ++u) w[u] = *(const f32x4*)(Wp + (size_t)(k + u) * NMOD);
#pragma unroll
        for (int u = 0; u < 8; ++u) { const int kk = F.wave * 256 + k + u; const float s0 = sv[kk], s1 = sv[2048 + kk], s2 = sv[4096 + kk];
            a0 += w[u] * s0; a1 += w[u] * s1; a2 += w[u] * s2; }
    }
    *(LAS f32x4*)(part + (F.wave * 3 + 0) * 256 + F.lane * 4) = a0;
    *(LAS f32x4*)(part + (F.wave * 3 + 1) * 256 + F.lane * 4) = a1;
    *(LAS f32x4*)(part + (F.wave * 3 + 2) * 256 + F.lane * 4) = a2;
    __syncthreads();
    for (int o = F.tid; o < 768; o += NTHREADS) { const int r = o >> 8, c = o & 255; float s = 0.f;
#pragma unroll
        for (int w = 0; w < 8; ++w) s += part[(w * 3 + r) * 256 + c];
        mod[(size_t)(l * 3 + r) * NMOD + n0 + c] = s + ada_b[(size_t)l * NMOD + n0 + c]; }
    __syncthreads();
}

__device__ __forceinline__ void p0_prologue(Frame& F, const float* const* in) {
    unsigned char* ws = F.ws;
    {
        LAS float* sv = (LAS float*)F.lds;
        for (int i = F.tid; i < 3 * DM; i += NTHREADS) { const int r = i / DM, k = i - r * DM; const float x = (r < 2) ? in[1][r * DM + k] : in[3][k]; sv[i] = x / (1.f + __expf(-x)); }
        __syncthreads();
        for (int task = F.vcu; task < 192; task += F.G) p0_gemv_task(F, task, in[4], in[5], (float*)(ws + WS_MOD));
        __syncthreads();
    }
    {
        float* xw = (float*)(ws + WS_XW);
        for (int row = F.gw; row < MROWS; row += F.NGW) { const int b = row / RB, i = row - b * RB;
            const float* src = (i < CTX) ? in[2] + (size_t)(b * CTX + i) * DM : in[0] + (size_t)(b * SEQ + i - CTX) * DM;
            const f32x4* s4 = (const f32x4*)src + F.lane; f32x4* d4 = (f32x4*)(xw + (size_t)row * DM) + F.lane;
#pragma unroll
            for (int j = 0; j < 8; ++j) d4[64 * j] = s4[64 * j]; }
    }
    {
        float* sm = (float*)(ws + WS_SMALL); const int g = F.vcu * NTHREADS + F.tid;
        if (g < 8192) { sm[SM_N1G + g] = in[6][g]; sm[SM_N2G + g] = in[7][g]; }
        if (g < 384) { sm[SM_AQG + g] = in[13][g]; sm[SM_AKG + g] = in[14][g]; }
        if (g < 6144) sm[SM_CW + g] = in[15][g];
        if (g < 2048) sm[SM_CB + g] = in[16][g];
        if (g < 256) { sm[SM_CQG + g] = in[19][g]; sm[SM_CKG + g] = in[20][g]; }
    }
    {
        float* rc = (float*)(ws + WS_ROPE); float* ra = rc + 64 * 32 * 2;
        const int g = F.vcu * NTHREADS + F.tid;
        if (g < 64 * 32) { const int pos = g >> 5, f = g & 31; const float fr = exp2f(-(float)f * (13.287712379549449f / 32.f)); const float ang = (float)pos * fr;
            rc[2 * g] = cosf(ang); rc[2 * g + 1] = sinf(ang); }
        else if (g < 64 * 32 + 64 * 16) { const int e = g - 64 * 32, pos = e >> 4, f = e & 15; const float fr = exp2f(-(float)f * (13.287712379549449f / 16.f)); const float ang = (float)pos * fr;
            ra[2 * e] = cosf(ang); ra[2 * e + 1] = sinf(ang); }
    }
    {
        LAS float* scr = (LAS float*)(F.lds + F.wave * 16384);
        TrDesc d[16]; int nd = 0;
#pragma unroll
        for (int i = 0; i < 2; ++i) {
            d[nd++] = TrDesc{in[8] + (size_t)i * DM * 3904, nullptr, (bf16_t*)(ws + WS_WIN) + (size_t)i * 4096 * DM, DM, 3904, 32 * 122};
            d[nd++] = TrDesc{in[11] + (size_t)i * 512 * 1536, in[9] + i * 512, (bf16_t*)(ws + WS_WUQ) + (size_t)i * 1536 * 512, 512, 1536, 8 * 48};
            d[nd++] = TrDesc{in[12] + (size_t)i * 256 * 2048, in[10] + i * 256, (bf16_t*)(ws + WS_WUKV) + (size_t)i * 2048 * 256, 256, 2048, 4 * 64};
            d[nd++] = TrDesc{in[17] + (size_t)i * DM * DM, nullptr, (bf16_t*)(ws + WS_WEO) + (size_t)i * DM * DM, DM, DM, 32 * 64};
            d[nd++] = TrDesc{in[18] + (size_t)i * DM * 3072, nullptr, (bf16_t*)(ws + WS_WQKV) + (size_t)i * 3072 * DM, DM, 3072, 32 * 96};
            d[nd++] = TrDesc{in[21] + (size_t)i * DM * DM, nullptr, (bf16_t*)(ws + WS_WCO) + (size_t)i * DM * DM, DM, DM, 32 * 64};
        }
#pragma unroll
        for (int l = 0; l < 4; ++l) d[nd++] = TrDesc{in[22] + (size_t)l * DM * DM, nullptr, (bf16_t*)(ws + WS_WPQ) + (size_t)l * DM * DM, DM, DM, 32 * 64};
#pragma unroll
        for (int m = 0; m < 16; ++m) {
            for (int it = F.gw; it < d[m].items; it += F.NGW) p0_transpose_item(d[m].W, d[m].K, d[m].N, d[m].WT, d[m].gain, scr, it, F.lane);
        }
        for (int i = F.gw * 64 + F.lane; i < 2 * 192 * DM / 8; i += F.NGW * 64) { const int li = i / (192 * DM / 8), r = i % (192 * DM / 8);
            *(u32x4*)((bf16_t*)(ws + WS_WIN) + (size_t)li * 4096 * DM + (size_t)3904 * DM + (size_t)r * 8) = (u32x4){0u, 0u, 0u, 0u}; }
    }
    {
        const size_t n_sk = (size_t)4 * 16 * 128 * 128 / 8;
        const size_t gt = (size_t)F.vcu * NTHREADS + F.tid, GT = (size_t)F.G * NTHREADS;
        for (size_t j = gt; j < n_sk; j += GT) {
            const f32x4 a = *(const f32x4*)(in[23] + j * 8), b = *(const f32x4*)(in[23] + j * 8 + 4);
            u32x4 o; o.x = pk2(a.x, a.y); o.y = pk2(a.z, a.w); o.z = pk2(b.x, b.y); o.w = pk2(b.z, b.w);
            *(u32x4*)((bf16_t*)(ws + WS_SUBK) + j * 8) = o;
        }
    }
    {
        for (int r = F.gw; r < 2 * 4 * NEXP; r += F.NGW) {
            const int tab = r / (4 * NEXP), rr = r - tab * (4 * NEXP);
            const float* src = (tab ? in[25] : in[24]) + (size_t)rr * DM + F.lane * 16;
            f32x4 v[8];
#pragma unroll
            for (int j = 0; j < 2; ++j)
#pragma unroll
                for (int q = 0; q < 4; ++q) v[j * 4 + q] = *(const f32x4*)(src + j * 1024 + q * 4);
            float am = 0.f;
#pragma unroll
            for (int q = 0; q < 8; ++q) am = fmaxf(fmaxf(am, fmaxf(fabsf(v[q].x), fabsf(v[q].y))), fmaxf(fabsf(v[q].z), fabsf(v[q].w)));
#pragma unroll
            for (int o = 1; o < 64; o <<= 1) am = fmaxf(am, __shfl_xor(am, o));
            am = fmaxf(am, 1e-30f);
            const float sc = 7.5f / am;
            f32x16 a, b;
#pragma unroll
            for (int q = 0; q < 8; ++q) { const f32x4 x = v[q] * sc; a[2 * q] = x.x; b[2 * q] = x.y; a[2 * q + 1] = x.z; b[2 * q + 1] = x.w; }
            const u32x6 w = __builtin_amdgcn_cvt_scalef32_2xpk16_fp6_f32(a, b, 1.0f);
            unsigned char* dst = ws + (tab ? WS_VT : WS_U) + (size_t)rr * ROWB;
            *(u32x4*)(dst + F.lane * 16) = (u32x4){w[0], w[1], w[2], w[3]};
            *(u32x2*)(dst + 1024 + F.lane * 8) = (u32x2){w[4], w[5]};
            if (F.lane == 0) ((float*)(ws + (tab ? WS_VSC : WS_USC)))[rr] = am * (1.0f / 7.5f);
        }
    }
}

__device__ __forceinline__ void norm_phase(const Frame& F0, const float* xw, const float* g, const float* modl  , int off_sh, int off_sc, bf16_t* H, bool lat_only) {
    const Frame F = phase_frame(F0);
    for (int row = F.gw; row < MROWS; row += F.NGW) {
        const int cls = row_cls(row);
        if (lat_only && cls == 2) continue;
        const f32x4* x4 = (const f32x4*)(xw + (size_t)row * DM) + F.lane;
        f32x4 v[8]; float ss = 0.f;
#pragma unroll
        for (int j = 0; j < 8; ++j) { v[j] = x4[64 * j]; ss += (v[j].x * v[j].x + v[j].y * v[j].y) + (v[j].z * v[j].z + v[j].w * v[j].w); }
        const float rstd = 1.0f / sqrtf(wave_sum_dpp(ss) * (1.f / DM) + EPS);
        const f32x4* g4 = (const f32x4*)g + F.lane; const f32x4* sc4 = (const f32x4*)(modl + (size_t)cls * NMOD + off_sc) + F.lane; const f32x4* sh4 = (const f32x4*)(modl + (size_t)cls * NMOD + off_sh) + F.lane;
        u32x2* o2 = (u32x2*)(H + (size_t)row * DM) + F.lane;
#pragma unroll
        for (int j = 0; j < 8; ++j) { const f32x4 gg = g4[64 * j], sc = sc4[64 * j], sh = sh4[64 * j];
            const f32x4 y = (v[j] * rstd) * gg * (sc + 1.0f) + sh;
            u32x2 o; o.x = pk2(y.x, y.y); o.y = pk2(y.z, y.w); o2[64 * j] = o; }
    }
}

__device__ __forceinline__ void prep_odd_phase(const Frame& F0, const bf16_t* P, const float* qg, const float* kg, const float* rope_c, bf16_t* Q, bf16_t* Kb) {
    const Frame F = phase_frame(F0);
    const float g_q1 = qg[F.lane], g_q2 = qg[F.lane + 64], g_k1 = kg[F.lane], g_k2 = kg[F.lane + 64];
    for (int row = F.gw; row < MROWS; row += F.NGW) {
        const int b = row / RB, i = row - b * RB; const bool lat = i >= CTX; const int t = i - CTX;
        float cs = 1.f, sn = 0.f;
        if (lat) { const int pos = (F.lane < 32) ? (t >> 6) : (t & 63); const float* e = rope_c + ((pos << 5) + (F.lane & 31)) * 2; cs = e[0]; sn = e[1]; }
        const bf16_t* pr = P + (size_t)row * 3072;
#pragma unroll 4
        for (int hh = 0; hh < 20; ++hh) {
            const bool isq = hh < 16; const bf16_t* src = pr + hh * 128;
            const float x1 = bf2f(src[F.lane]), x2 = bf2f(src[F.lane + 64]);
            const float rstd = 1.0f / sqrtf(wave_sum_dpp(x1 * x1 + x2 * x2) * (1.f / 128.f) + EPS);
            const float y1 = x1 * rstd * (isq ? g_q1 : g_k1), y2 = x2 * rstd * (isq ? g_q2 : g_k2);
            const float o1 = y1 * cs - y2 * sn, o2 = y2 * cs + y1 * sn;
            bf16_t* dst = isq ? (Q + (size_t)row * 2048 + hh * 128) : (Kb + (size_t)row * 512 + (hh - 16) * 128);
            dst[F.lane] = (bf16_t)f2bf(o1); dst[F.lane + 64] = (bf16_t)f2bf(o2);
        }
    }
}

__device__ __forceinline__ void prep_even_phase(const Frame& F0, const bf16_t* P, const bf16_t* QR, const bf16_t* KVR, const float* qg, const float* kg, const float* rope_a, bf16_t* Q, bf16_t* Kb, bf16_t* Vb) {
    const Frame F = phase_frame(F0);
    const float gq0 = qg[F.lane], gq1 = qg[F.lane + 64], gq2 = qg[F.lane + 128], gk0 = kg[F.lane], gk1 = kg[F.lane + 64], gk2 = kg[F.lane + 128];
    for (int row = F.gw; row < MROWS; row += F.NGW) {
        const int b = row / RB, i = row - b * RB; const bool lat = i >= CTX; const int t = i - CTX;
        float cs = 1.f, sn = 0.f;
        if (lat) { const int j = F.lane & 31; const int pos = (j < 16) ? (t >> 6) : (t & 63); const float* e = rope_a + ((pos << 4) + (j & 15)) * 2; cs = e[0]; sn = e[1]; }
        const float sgn = (F.lane < 32) ? -1.f : 1.f;
        const bf16_t* pr = P + (size_t)row * 4096;
        float ssq = 0.f, sskv = 0.f;
        { const u32x4 w = *(const u32x4*)(pr + F.lane * 8); const unsigned ww[4] = {w.x, w.y, w.z, w.w};
#pragma unroll
          for (int q = 0; q < 4; ++q) { const float a = bf_lo(ww[q]), c = bf_hi(ww[q]); ssq += a * a + c * c; } }
        { const u32x2 w = *(const u32x2*)(pr + 512 + F.lane * 4); const float a = bf_lo(w.x), c = bf_hi(w.x), d = bf_lo(w.y), e = bf_hi(w.y); sskv = (a * a + c * c) + (d * d + e * e); }
        const float rstd_q = 1.0f / sqrtf(wave_sum_dpp(ssq) * (1.f / 512.f) + EPS), rstd_kv = 1.0f / sqrtf(wave_sum_dpp(sskv) * (1.f / 256.f) + EPS);
        const float kr = bf2f(pr[768 + F.lane]);
        const bf16_t* qr = QR + (size_t)row * 1536; const bf16_t* kvr = KVR + (size_t)row * 2048;
        bf16_t* qo = Q + (size_t)row * 1536; bf16_t* ko = Kb + (size_t)row * 1536; bf16_t* vo = Vb + (size_t)row * 1024;
#pragma unroll 2
        for (int h = 0; h < 8; ++h) {
            {
                const float x0 = bf2f(qr[h * 192 + F.lane]) * rstd_q, x1 = bf2f(qr[h * 192 + 64 + F.lane]) * rstd_q, x2 = bf2f(qr[h * 192 + 128 + F.lane]) * rstd_q;
                const float r2 = 1.0f / sqrtf(wave_sum_dpp(x0 * x0 + x1 * x1 + x2 * x2) * (1.f / 192.f) + EPS);
                const float y0 = x0 * r2 * gq0, y1 = x1 * r2 * gq1, y2 = x2 * r2 * gq2;
                const float yp = swap32(y2, F.lane);
                const float o2 = y2 * cs + sgn * yp * sn;
                qo[h * 192 + F.lane] = (bf16_t)f2bf(y0); qo[h * 192 + 64 + F.lane] = (bf16_t)f2bf(y1); qo[h * 192 + 128 + F.lane] = (bf16_t)f2bf(o2);
            }
            {
                const float x0 = bf2f(kvr[h * 256 + F.lane]) * rstd_kv, x1 = bf2f(kvr[h * 256 + 64 + F.lane]) * rstd_kv;
                const float r2 = 1.0f / sqrtf(wave_sum_dpp(x0 * x0 + x1 * x1 + kr * kr) * (1.f / 192.f) + EPS);
                const float y0 = x0 * r2 * gk0, y1 = x1 * r2 * gk1, y2 = kr * r2 * gk2;
                const float yp = swap32(y2, F.lane);
                const float o2 = y2 * cs + sgn * yp * sn;
                ko[h * 192 + F.lane] = (bf16_t)f2bf(y0); ko[h * 192 + 64 + F.lane] = (bf16_t)f2bf(y1); ko[h * 192 + 128 + F.lane] = (bf16_t)f2bf(o2);
                const float v0 = bf2f(kvr[h * 256 + 128 + F.lane]) * rstd_kv, v1 = bf2f(kvr[h * 256 + 192 + F.lane]) * rstd_kv;
                vo[h * 128 + F.lane] = (bf16_t)f2bf(v0); vo[h * 128 + 64 + F.lane] = (bf16_t)f2bf(v1);
            }
        }
    }
}

__device__ __forceinline__ void conv_phase(const Frame& F0, const bf16_t* P, const float* cw  , const float* cb  , bf16_t* CAT) {
    const Frame F = phase_frame(F0);
    const int gt = F.vcu * NTHREADS + F.tid, GT = F.G * NTHREADS;
    for (int it = gt; it < MROWS * 128; it += GT) {
        const int row = it >> 7, c0 = (it & 127) * 8; const int b = row / RB, i = row - b * RB;
        const bool first = (i == 0) || (i == CTX), last = (i == CTX - 1) || (i == RB - 1);
        const bf16_t* pr = P + (size_t)row * 4096 + 832 + c0;
        const u32x4 bg = *(const u32x4*)pr, cg = *(const u32x4*)(pr + 1024), hz = *(const u32x4*)(pr + 2048);
        u32x4 cgm = {0u, 0u, 0u, 0u}, hzm = cgm, cgp = cgm, hzp = cgm;
        if (!first) { cgm = *(const u32x4*)(pr - 4096 + 1024); hzm = *(const u32x4*)(pr - 4096 + 2048); }
        if (!last) { cgp = *(const u32x4*)(pr + 4096 + 1024); hzp = *(const u32x4*)(pr + 4096 + 2048); }
        const unsigned bgw[4] = {bg.x, bg.y, bg.z, bg.w}, cgw[4] = {cg.x, cg.y, cg.z, cg.w}, hzw[4] = {hz.x, hz.y, hz.z, hz.w};
        const unsigned cmw[4] = {cgm.x, cgm.y, cgm.z, cgm.w}, hmw[4] = {hzm.x, hzm.y, hzm.z, hzm.w}, cpw[4] = {cgp.x, cgp.y, cgp.z, cgp.w}, hpw[4] = {hzp.x, hzp.y, hzp.z, hzp.w};
        unsigned ow[4];
#pragma unroll
        for (int q = 0; q < 4; ++q) {
            const int c = c0 + 2 * q;
            const float u0a = bf_lo(cgw[q]) * bf_lo(hzw[q]), u0b = bf_hi(cgw[q]) * bf_hi(hzw[q]);
            const float uma = bf_lo(cmw[q]) * bf_lo(hmw[q]), umb = bf_hi(cmw[q]) * bf_hi(hmw[q]);
            const float upa = bf_lo(cpw[q]) * bf_lo(hpw[q]), upb = bf_hi(cpw[q]) * bf_hi(hpw[q]);
            const float ra = bf_lo(bgw[q]) * (uma * cw[c] + u0a * cw[1024 + c] + upa * cw[2048 + c] + cb[c]);
            const float rb = bf_hi(bgw[q]) * (umb * cw[c + 1] + u0b * cw[1024 + c + 1] + upb * cw[2048 + c + 1] + cb[c + 1]);
            ow[q] = pk2(ra, rb);
        }
        *(u32x4*)(CAT + (size_t)row * DM + 1024 + c0) = (u32x4){ow[0], ow[1], ow[2], ow[3]};
    }
}
__device__ __forceinline__ void attn_even_phase(const Frame& F0, const bf16_t* Q, const bf16_t* Kb, const bf16_t* Vb, bf16_t* CAT) {
    const Frame F = phase_frame(F0);
    for (int u = F.vcu; u < 272; u += F.G) {
        int b, h, qt, nk;
        if (u < 256) { b = u >> 7; h = (u >> 4) & 7; qt = 1 + (u & 15); nk = RB; } else { const int v = u - 256; b = v >> 3; h = v & 7; qt = 0; nk = CTX; }
        const size_t r0 = (size_t)b * RB;
        att::attn_body1<192, 1536, 1536, 1024, 2048>(Q + (r0 + qt * 256) * 1536 + h * 192, Kb + r0 * 1536 + h * 192, Vb + r0 * 1024 + h * 128, CAT + (r0 + qt * 256) * 2048 + h * 128, nk, (char*)F.lds, phase_tid(F.wave));
    }
}
__device__ __forceinline__ void attn_odd_phase(const Frame& F0, const bf16_t* Q, const bf16_t* Kb, const bf16_t* P, bf16_t* CAT, bool lat_only) {
    const Frame F = phase_frame(F0);
    const int nunits = lat_only ? 512 : 544;
    for (int u = F.vcu; u < nunits; u += F.G) {
        int b, hq, qt, nk;
        if (u < 512) { b = u >> 8; hq = (u >> 4) & 15; qt = 1 + (u & 15); nk = RB; } else { const int v = u - 512; b = v >> 4; hq = v & 15; qt = 0; nk = CTX; }
        const int kvh = hq >> 2; const size_t r0 = (size_t)b * RB;
        att::attn_body<128, 2048, 512, 3072, 2048, 2>(Q + (r0 + qt * 256) * 2048 + hq * 128, Kb + r0 * 512 + kvh * 128, P + r0 * 3072 + 2560 + kvh * 128, CAT + (r0 + qt * 256) * 2048 + hq * 128, nk, (char*)F.lds, phase_tid(F.wave));
    }
}

__device__ __forceinline__ int crow32(int r, int hi) { return (r & 3) + 8 * (r >> 2) + 4 * hi; }
__device__ __forceinline__ float swapmax(float m) { auto rr = __builtin_amdgcn_permlane32_swap(__float_as_uint(m), __float_as_uint(m), false, false); return fmaxf(__uint_as_float(rr[0]), __uint_as_float(rr[1])); }
__device__ __forceinline__ void peer_topk_phase(const Frame& F0, const bf16_t* PQ, const bf16_t* subk  , int* IDX, float* GATE, bool lat_only) {
    const Frame F = phase_frame(F0);
    const float NEG = -3.0e38f;
    const int ntask = (lat_only ? 256 : MROWS / 32) * 8;
    for (int task = F.gw; task < ntask; task += F.NGW) {
        int lane_ = F.lane; asm volatile("" : "+v"(lane_));
        const int r32 = lane_ & 31, hi = lane_ >> 5;
        int tg = task >> 3; const int h = task & 7; if (lat_only) tg += 8 + (tg >= 128 ? 8 : 0);
        const int token = tg * 32 + r32;
        float top[2][16];
#pragma unroll
        for (int j = 0; j < 16; ++j) { top[0][j] = NEG; top[1][j] = NEG; }
#pragma unroll
        for (int p = 0; p < 2; ++p) {
            bf16x8 bq[8];
            const bf16_t* qp = PQ + (size_t)token * DM + h * 256 + p * 128 + hi * 8;
#pragma unroll
            for (int ks = 0; ks < 8; ++ks) bq[ks] = *(const bf16x8*)(qp + ks * 16);
            const bf16_t* kp = subk + (size_t)(h * 2 + p) * 128 * 128 + (size_t)r32 * 128 + hi * 8;
            float s[64];
#pragma unroll
            for (int nb = 0; nb < 4; ++nb) {
                f32x16 acc = {};
#pragma unroll
                for (int ks = 0; ks < 8; ++ks) { const bf16x8 a = *(const bf16x8*)(kp + (size_t)nb * 32 * 128 + ks * 16); acc = __builtin_amdgcn_mfma_f32_32x32x16_bf16(a, bq[ks], acc, 0, 0, 0); }
#pragma unroll
                for (int r = 0; r < 16; ++r) { const int key = nb * 32 + crow32(r, hi); s[nb * 16 + r] = __uint_as_float((__float_as_uint(acc[r]) & ~127u) | (unsigned)(127 - key)); }
                asm volatile("" ::: "memory");
            }
#pragma unroll 1
            for (int it = 0; it < 16; ++it) {
                float m = s[0];
#pragma unroll
                for (int i = 1; i < 64; ++i) m = fmaxf(m, s[i]);
                m = swapmax(m);
#pragma unroll
                for (int i = 0; i < 64; ++i) s[i] = (s[i] == m) ? NEG : s[i];
#pragma unroll
                for (int j = 0; j < 16; ++j) top[p][j] = (j == it) ? m : top[p][j];
            }
        }
        float cand[25];
        {
            int n = 0;
#pragma unroll
            for (int a = 0; a < 16; ++a)
#pragma unroll
                for (int b = 0; b < 16; ++b) if ((a + 1) * (b + 1) <= 16) {
                    const int slot = n >> 1, which = n & 1; ++n;
                    const float v = top[0][a] + top[1][b];
                    const float pv = __uint_as_float((__float_as_uint(v) & ~255u) | (unsigned)(255 - (a * 16 + b)));
                    if (which == 0) cand[slot] = pv; else cand[slot] = hi ? pv : cand[slot];
                }
        }
        float win[16];
#pragma unroll
        for (int j = 0; j < 16; ++j) win[j] = NEG;
#pragma unroll 1
        for (int it = 0; it < 16; ++it) {
            float m = cand[0];
#pragma unroll
            for (int i = 1; i < 25; ++i) m = fmaxf(m, cand[i]);
            m = swapmax(m);
#pragma unroll
            for (int i = 0; i < 25; ++i) cand[i] = (cand[i] == m) ? NEG : cand[i];
#pragma unroll
            for (int j = 0; j < 16; ++j) win[j] = (j == it) ? m : win[j];
        }
        float ev[16]; float esum = 0.f; const float v0 = __uint_as_float(__float_as_uint(win[0]) & ~255u);
#pragma unroll
        for (int j = 0; j < 16; ++j) { const float v = __uint_as_float(__float_as_uint(win[j]) & ~255u); ev[j] = __expf(v - v0); esum += ev[j]; }
        const float rs = 1.0f / esum;
        int oi[8]; float og[8];
#pragma unroll
        for (int j = 0; j < 8; ++j) {
            const float w = hi ? win[8 + j] : win[j]; const float e = hi ? ev[8 + j] : ev[j];
            const int id = 255 - (int)(__float_as_uint(w) & 255u), a = id >> 4, b = id & 15;
            float ta = top[0][0], tb = top[1][0];
#pragma unroll
            for (int q = 1; q < 16; ++q) { ta = (a == q) ? top[0][q] : ta; tb = (b == q) ? top[1][q] : tb; }
            const int ka = 127 - (int)(__float_as_uint(ta) & 127u), kb = 127 - (int)(__float_as_uint(tb) & 127u);
            oi[j] = ka * 128 + kb; og[j] = e * rs;
        }
        int* ip = IDX + (size_t)token * 128 + h * 16 + hi * 8; float* gp = GATE + (size_t)token * 128 + h * 16 + hi * 8;
        *(int4*)ip = make_int4(oi[0], oi[1], oi[2], oi[3]); *(int4*)(ip + 4) = make_int4(oi[4], oi[5], oi[6], oi[7]);
        *(f32x4*)gp = (f32x4){og[0], og[1], og[2], og[3]}; *(f32x4*)(gp + 4) = (f32x4){og[4], og[5], og[6], og[7]};
    }
}

__device__ __forceinline__ void peer_expert_phase(const Frame& F0, const bf16_t* H2, const int* IDX, const float* GATE, const unsigned char* U, size_t v_minus_u_bytes, const float* USC, const float* VSC,
                                                  const float* g2  , float* XW, float* OUT) {
    const Frame F = phase_frame(F0);
    LAS float* red = (LAS float*)F.lds;
    const unsigned voff_tab = (unsigned)v_minus_u_bytes;
    const __amdgpu_buffer_rsrc_t rs = __builtin_amdgcn_make_buffer_rsrc((void*)U, 0, (int)(voff_tab + (unsigned)NEXP * ROWB), 0x00020000);
    const int lane = F.lane; const int voff = lane * 16, voff2 = 1024 + lane * 8;
#define PX_SB() __builtin_amdgcn_sched_barrier(0)
#define PX_LOAD(buf, s, ivv) do { constexpr int e0_ = ((s) & 3) * 4; const unsigned tb_ = ((s) >= 4) ? voff_tab : 0u; \
        _Pragma("unroll") for (int ee_ = 0; ee_ < 4; ++ee_) { const unsigned o_ = (unsigned)__builtin_amdgcn_readlane(ivv, e0_ + ee_) * (unsigned)ROWB + tb_; \
            buf##h[ee_] = __builtin_amdgcn_raw_buffer_load_b128(rs, voff, o_, 0); buf##l[ee_] = __builtin_amdgcn_raw_buffer_load_b64(rs, voff2, o_, 0); } } while (0)
#define PX_DECODE(buf, ee_, dep) u32x6 w6_ = {buf##h[ee_].x, buf##h[ee_].y, buf##h[ee_].z, buf##h[ee_].w, buf##l[ee_].x, buf##l[ee_].y}; \
        asm volatile("" : "+v"(w6_) : "v"(dep));     \
        const f32x32 r_ = __builtin_amdgcn_cvt_scalef32_pk32_f32_fp6(w6_, 1.0f);
#define PX_COMP_U(buf, s) do { constexpr int e0_ = ((s) & 3) * 4; \
            _Pragma("unroll") for (int ee_ = 0; ee_ < 4; ++ee_) { PX_DECODE(buf, ee_, sv) \
                const f32x32 p_ = r_ * xf; float a0_ = 0.f, a1_ = 0.f; \
                _Pragma("unroll") for (int k_ = 0; k_ < 32; k_ += 2) { a0_ += p_[k_]; a1_ += p_[k_ + 1]; } \
                const float t_ = wave_sum_dpp(a0_ + a1_); sv = (lane == e0_ + ee_) ? t_ : sv; } } while (0)
#define PX_COMP_V(buf, s) do { constexpr int e0_ = ((s) & 3) * 4; \
            _Pragma("unroll") for (int ee_ = 0; ee_ < 4; ++ee_) { const float wg_ = __uint_as_float(__builtin_amdgcn_readlane(__float_as_uint(wv), e0_ + ee_)); \
                PX_DECODE(buf, ee_, acc) \
                acc += r_ * wg_; } } while (0)
#define PX_FETCH_TOKEN(r, XP, IV, GV) do { const u32x4* xp_ = (const u32x4*)(H2 + (size_t)(r) * DM + lane * 16); XP[0] = xp_[0]; XP[1] = xp_[1]; XP[2] = xp_[128]; XP[3] = xp_[129]; \
        IV = 0; GV = 0.f; if (lane < 16) { IV = IDX[(size_t)(r) * 128 + F.wave * 16 + lane]; GV = GATE[(size_t)(r) * 128 + F.wave * 16 + lane]; } } while (0)
    const bool skip_ctx = (OUT != nullptr);
    int row = F.vcu; if (skip_ctx && row < MROWS && row_cls(row) == 2) row += F.G;
    u32x4 xp[4]; int iv; float gv;
    u32x4 bAh[4], bBh[4]; u32x2 bAl[4], bBl[4];
    if (row < MROWS) { PX_FETCH_TOKEN(row, xp, iv, gv); PX_LOAD(bA, 0, iv); }
    int par = 0;
    while (row < MROWS) {
        int nrow = row + F.G; if (skip_ctx && nrow < MROWS && row_cls(nrow) == 2) nrow += F.G;
        f32x32 xf;
#pragma unroll
        for (int q = 0; q < 4; ++q) { const unsigned ww[4] = {xp[q].x, xp[q].y, xp[q].z, xp[q].w};
#pragma unroll
            for (int k = 0; k < 4; ++k) { xf[q * 8 + 2 * k] = bf_lo(ww[k]); xf[q * 8 + 2 * k + 1] = bf_hi(ww[k]); } }
        float usc = 0.f, vsc = 0.f;
        if (lane < 16) { usc = USC[iv]; vsc = VSC[iv]; }
        u32x4 xpn[4]; int ivn = 0; float gvn = 0.f;
        if (nrow < MROWS) PX_FETCH_TOKEN(nrow, xpn, ivn, gvn);
        float sv = 0.f, wv = 0.f;
        PX_LOAD(bB, 1, iv); PX_SB(); PX_COMP_U(bA, 0); PX_SB();
        PX_LOAD(bA, 2, iv); PX_SB(); PX_COMP_U(bB, 1); PX_SB();
        PX_LOAD(bB, 3, iv); PX_SB(); PX_COMP_U(bA, 2); PX_SB();
        PX_LOAD(bA, 4, iv); PX_SB(); PX_COMP_U(bB, 3); PX_SB();
        wv = gelu_erf(sv * usc) * gv * vsc;
        f32x32 acc = {};
        PX_LOAD(bB, 5, iv); PX_SB(); PX_COMP_V(bA, 4); PX_SB();
        PX_LOAD(bA, 6, iv); PX_SB(); PX_COMP_V(bB, 5); PX_SB();
        PX_LOAD(bB, 7, iv); PX_SB(); PX_COMP_V(bA, 6); PX_SB();
        if (nrow < MROWS) PX_LOAD(bA, 0, ivn);
        PX_SB(); PX_COMP_V(bB, 7); PX_SB();
        LAS float* rb = red + par * (NWAVES * DM);
#pragma unroll
        for (int j = 0; j < 2; ++j)
#pragma unroll
            for (int q = 0; q < 4; ++q) *(LAS f32x4*)(rb + F.wave * DM + j * 1024 + lane * 16 + q * 4) = (f32x4){acc[j * 16 + q * 4], acc[j * 16 + q * 4 + 1], acc[j * 16 + q * 4 + 2], acc[j * 16 + q * 4 + 3]};
        __syncthreads();
        {
            f32x4 sm = {0.f, 0.f, 0.f, 0.f};
#pragma unroll
            for (int w = 0; w < 8; ++w) sm += *(const LAS f32x4*)(rb + w * DM + F.tid * 4);
            const int cls = row_cls(row);
            const f32x4 g = *(const f32x4*)(g2 + (size_t)cls * NMOD + F.tid * 4);
            f32x4* xq = (f32x4*)(XW + (size_t)row * DM) + F.tid;
            const f32x4 xn = *xq + g * sm;
            *xq = xn;
            if (OUT) { const int b = row / RB, i = row - b * RB; if (i >= CTX) *((f32x4*)(OUT + ((size_t)b * SEQ + (i - CTX)) * DM) + F.tid) = xn; }
        }
        par ^= 1; row = nrow;
#pragma unroll
        for (int q = 0; q < 4; ++q) xp[q] = xpn[q];
        iv = ivn; gv = gvn;
    }
#undef PX_LOAD
#undef PX_COMP_U
#undef PX_COMP_V
#undef PX_SB
#undef PX_FETCH_TOKEN
}
#ifndef N_LAUNCHES
#define N_LAUNCHES 1
#endif
struct Args { const float* in[26]; float* out; unsigned char* ws; int ph_lo, ph_hi; };
constexpr int NPHASES = 39;
__global__ void __launch_bounds__(NTHREADS, 2) fwd_kernel(Args args) {
    extern __shared__ __attribute__((aligned(16))) unsigned char lds_raw[];
    Frame F_;
    F_.lds = (LAS unsigned char*)lds_raw;
    F_.tid = threadIdx.x; F_.lane = F_.tid & 63; F_.wave = __builtin_amdgcn_readfirstlane(F_.tid >> 6);
    F_.G = gridDim.x; { const int bx = blockIdx.x; F_.vcu = (F_.G % 8 == 0) ? (bx % 8) * (F_.G / 8) + bx / 8 : bx; }
    F_.gw = F_.vcu * NWAVES + F_.wave; F_.NGW = F_.G * NWAVES;
    F_.ws = args.ws;
    volatile LAS unsigned* MISC = (volatile LAS unsigned*)(F_.lds + LDS_MISC);
    if (F_.tid < 32) MISC[F_.tid] = 0u;
    __syncthreads();
    const int lo = args.ph_lo, hi = args.ph_hi;
    XcdBarrier bar; bar.bar = (unsigned*)(args.ws + WS_CTL) + CW_BAR; bar.x = 0; bar.st = nullptr;
    if (N_LAUNCHES == 1 || hi - lo > 1) bar = xcd_barrier_post((unsigned*)(args.ws + WS_CTL) + CW_BAR, MISC + 8);
#if N_LAUNCHES == 1
#define IN(k) true
#define SEAM(k) xcd_barrier(bar)
#else
#define IN(k) (lo <= (k) && (k) < hi)
#define SEAM(k) do { if (IN(k) && IN((k) + 1)) xcd_barrier(bar); } while (0)
#endif
    PG8_LAS unsigned char* glds = (PG8_LAS unsigned char*)lds_raw;

    if (IN(0)) { p0_prologue(F_, args.in); } SEAM(0);

#pragma unroll 1
    for (int lp = 0; lp < 2; ++lp) {
        const int pb = 1 + lp * 19;
        unsigned char* ws = args.ws; asm volatile("" : "+s"(ws));
        Frame F = F_; { int w_ = F_.wave, v_ = F_.vcu, g_ = F_.G; asm volatile("" : "+s"(w_), "+s"(v_), "+s"(g_)); F.wave = w_; F.vcu = v_; F.G = g_; F.gw = v_ * NWAVES + w_; F.NGW = g_ * NWAVES; F.ws = ws; }
        float* mod = (float*)(ws + WS_MOD); float* XW = (float*)(ws + WS_XW);
        bf16_t* H = (bf16_t*)(ws + WS_H); bf16_t* P = (bf16_t*)(ws + WS_P); bf16_t* QRAW = (bf16_t*)(ws + WS_QRAW); bf16_t* KVRAW = (bf16_t*)(ws + WS_KVRAW);
        bf16_t* Q = (bf16_t*)(ws + WS_Q); bf16_t* KB = (bf16_t*)(ws + WS_K); bf16_t* VB = (bf16_t*)(ws + WS_V); bf16_t* CAT = (bf16_t*)(ws + WS_CAT); bf16_t* PQ = (bf16_t*)(ws + WS_PQ);
        int* IDX = (int*)(ws + WS_IDX); float* GATE = (float*)(ws + WS_GATE);
        const float* rope_c = (const float*)(ws + WS_ROPE); const float* rope_a = rope_c + 64 * 32 * 2;
        const float* SMv = (const float*)(ws + WS_SMALL);
        {
            const int l = 2 * lp, i = lp;
            const float* modl = mod + (size_t)l * 3 * NMOD;
            if (IN(pb + 0)) { norm_phase(F, XW, SMv + SM_N1G + l * DM, modl, 0, 2048, H, false); } SEAM(pb + 0);
            if (IN(pb + 1)) {
                pg8::Gemm g{H, (const bf16_t*)(ws + WS_WIN) + (size_t)i * 4096 * DM, MROWS, 4096, DM, DM, DM}; pg8::StaticOrder S; S.init(MROWS, 4096, F.G, (int)blockIdx.x);
                pg8::EpiBf16 E{P, 4096};
                pg8::gemm_phase<pg8::EpiBf16, pg8::StaticOrder, true, true>(glds, g, S, E, phase_tid(F.wave));
            } SEAM(pb + 1);
            if (IN(pb + 2)) {
                { pg8::Gemm g{P, (const bf16_t*)(ws + WS_WUQ) + (size_t)i * 1536 * 512, MROWS, 1536, 512, 4096, 512}; pg8::StaticOrder S; S.init(MROWS, 1536, F.G, (int)blockIdx.x);
                  pg8::EpiBf16 E{QRAW, 1536};
                  pg8::gemm_phase<pg8::EpiBf16, pg8::StaticOrder, true, true>(glds, g, S, E, phase_tid(F.wave)); }
                __syncthreads();
                { pg8::Gemm g{P + 512, (const bf16_t*)(ws + WS_WUKV) + (size_t)i * 2048 * 256, MROWS, 2048, 256, 4096, 256}; pg8::StaticOrder S; S.init(MROWS, 2048, F.G, (int)blockIdx.x);
                  pg8::EpiBf16 E{KVRAW, 2048};
                  pg8::gemm_phase<pg8::EpiBf16, pg8::StaticOrder, true, true>(glds, g, S, E, phase_tid(F.wave)); }
                __syncthreads();
                conv_phase(F, P, SMv + SM_CW + i * 3072, SMv + SM_CB + i * 1024, CAT);
            } SEAM(pb + 2);
            if (IN(pb + 3)) { prep_even_phase(F, P, QRAW, KVRAW, SMv + SM_AQG + i * 192, SMv + SM_AKG + i * 192, rope_a, Q, KB, VB); } SEAM(pb + 3);
            if (IN(pb + 4)) { attn_even_phase(F, Q, KB, VB, CAT); } SEAM(pb + 4);
            if (IN(pb + 5)) {
                pg8::Gemm g{CAT, (const bf16_t*)(ws + WS_WEO) + (size_t)i * DM * DM, MROWS, DM, DM, DM, DM}; pg8::StaticOrder S; S.init(MROWS, DM, F.G, (int)blockIdx.x);
                pg8::EpiResid E{XW, DM, modl + 4096};
                pg8::gemm_phase<pg8::EpiResid, pg8::StaticOrder, true, true>(glds, g, S, E, phase_tid(F.wave));
            } SEAM(pb + 5);
            if (IN(pb + 6)) { norm_phase(F, XW, SMv + SM_N2G + l * DM, modl, 6144, 8192, H, l == 3); } SEAM(pb + 6);
            if (IN(pb + 7)) {
                pg8::Gemm g{H, (const bf16_t*)(ws + WS_WPQ) + (size_t)l * DM * DM, MROWS, DM, DM, DM, DM}; pg8::StaticOrder S; S.init(MROWS, DM, F.G, (int)blockIdx.x);
                pg8::EpiBf16 E{PQ, DM};
                pg8::gemm_phase<pg8::EpiBf16, pg8::StaticOrder, true, true>(glds, g, S, E, phase_tid(F.wave));
            } SEAM(pb + 7);
            if (IN(pb + 8)) { peer_topk_phase(F, PQ, (const bf16_t*)(ws + WS_SUBK) + (size_t)l * 16 * 128 * 128, IDX, GATE, l == 3); } SEAM(pb + 8);
            if (IN(pb + 9)) { peer_expert_phase(F, H, IDX, GATE, ws + WS_U + (size_t)l * NEXP * ROWB, (size_t)(WS_VT - WS_U), (const float*)(ws + WS_USC) + l * NEXP, (const float*)(ws + WS_VSC) + l * NEXP, modl + 10240, XW, nullptr); } SEAM(pb + 9);
        }
        {
            const int l = 2 * lp + 1, i = lp, qb = pb + 10;
            const float* modl = mod + (size_t)l * 3 * NMOD;
            if (IN(qb + 0)) { norm_phase(F, XW, SMv + SM_N1G + l * DM, modl, 0, 2048, H, false); } SEAM(qb + 0);
            if (IN(qb + 1)) {
                pg8::Gemm g{H, (const bf16_t*)(ws + WS_WQKV) + (size_t)i * 3072 * DM, MROWS, 3072, DM, DM, DM}; pg8::StaticOrder S; S.init(MROWS, 3072, F.G, (int)blockIdx.x);
                pg8::EpiBf16 E{P, 3072};
                pg8::gemm_phase<pg8::EpiBf16, pg8::StaticOrder, true, true>(glds, g, S, E, phase_tid(F.wave));
            } SEAM(qb + 1);
            if (IN(qb + 2)) { prep_odd_phase(F, P, SMv + SM_CQG + i * 128, SMv + SM_CKG + i * 128, rope_c, Q, KB); } SEAM(qb + 2);
            if (IN(qb + 3)) { attn_odd_phase(F, Q, KB, P, CAT, l == 3); } SEAM(qb + 3);
            if (IN(qb + 4)) {
                pg8::Gemm g{CAT, (const bf16_t*)(ws + WS_WCO) + (size_t)i * DM * DM, MROWS, DM, DM, DM, DM}; pg8::StaticOrder S; S.init(MROWS, DM, F.G, (int)blockIdx.x, l == 3);
                pg8::EpiResid E{XW, DM, modl + 4096};
                pg8::gemm_phase<pg8::EpiResid, pg8::StaticOrder, true, true>(glds, g, S, E, phase_tid(F.wave));
            } SEAM(qb + 4);
            if (IN(qb + 5)) { norm_phase(F, XW, SMv + SM_N2G + l * DM, modl, 6144, 8192, H, l == 3); } SEAM(qb + 5);
            if (IN(qb + 6)) {
                pg8::Gemm g{H, (const bf16_t*)(ws + WS_WPQ) + (size_t)l * DM * DM, MROWS, DM, DM, DM, DM}; pg8::StaticOrder S; S.init(MROWS, DM, F.G, (int)blockIdx.x, l == 3);
                pg8::EpiBf16 E{PQ, DM};
                pg8::gemm_phase<pg8::EpiBf16, pg8::StaticOrder, true, true>(glds, g, S, E, phase_tid(F.wave));
            } SEAM(qb + 6);
            if (IN(qb + 7)) { peer_topk_phase(F, PQ, (const bf16_t*)(ws + WS_SUBK) + (size_t)l * 16 * 128 * 128, IDX, GATE, l == 3); } SEAM(qb + 7);
            if (IN(qb + 8)) { peer_expert_phase(F, H, IDX, GATE, ws + WS_U + (size_t)l * NEXP * ROWB, (size_t)(WS_VT - WS_U), (const float*)(ws + WS_USC) + l * NEXP, (const float*)(ws + WS_VSC) + l * NEXP, modl + 10240, XW, (l == 3) ? args.out : nullptr); } if (lp == 0) SEAM(qb + 8);
        }
    }
#undef IN
#undef SEAM
}

extern "C" void kernel_launch(void* const* d_in, const int* in_sizes, int n_in, void* d_out, int out_size, void* d_ws, size_t ws_size, hipStream_t stream) {
    static int grid = 0;
    if (grid == 0) {
        if (n_in != 26 || out_size != NBATCH * SEQ * DM || ws_size < WS_END) { fprintf(stderr, "kernel_launch: unexpected shapes: n_in %d out %d ws %zu (need %zu)\n", n_in, out_size, ws_size, (size_t)WS_END); grid = -1; return; }
        int dev = 0, cus = 0, per_cu = 0;
        if (hipGetDevice(&dev) != hipSuccess || hipDeviceGetAttribute(&cus, hipDeviceAttributeMultiprocessorCount, dev) != hipSuccess) { fprintf(stderr, "kernel_launch: device query failed\n"); grid = -1; return; }
        if (hipFuncSetAttribute((const void*)fwd_kernel, hipFuncAttributeMaxDynamicSharedMemorySize, LDS_BYTES) != hipSuccess) { fprintf(stderr, "kernel_launch: hipFuncSetAttribute failed\n"); grid = -1; return; }
        if (hipOccupancyMaxActiveBlocksPerMultiprocessor(&per_cu, (const void*)fwd_kernel, NTHREADS, LDS_BYTES) != hipSuccess || per_cu < 1) { fprintf(stderr, "kernel_launch: occupancy query says %d blocks per CU\n", per_cu); (void)hipGetLastError(); grid = -1; return; }
        grid = cus;
    }
    if (grid < 0) return;
    (void)hipMemsetAsync((char*)d_ws + WS_CTL, 0, CTL_ZERO_BYTES, stream);
    Args a{};
    for (int i = 0; i < 26; ++i) a.in[i] = (const float*)d_in[i];
    a.out = (float*)d_out; a.ws = (unsigned char*)d_ws;
    for (int li = 0; li < N_LAUNCHES; ++li) {
        a.ph_lo = (N_LAUNCHES == 1) ? 0 : li; a.ph_hi = (N_LAUNCHES == 1) ? NPHASES : li + 1;
        hipLaunchKernelGGL(fwd_kernel, dim3(grid), dim3(NTHREADS), LDS_BYTES, stream, a);
        const hipError_t le = hipPeekAtLastError();
        if (le != hipSuccess) { fprintf(stderr, "kernel_launch: launch %d failed: %s\n", li, hipGetErrorName(le)); break; }
    }
}
```

```cpp
#include <hip/hip_runtime.h>
#include <cstdio>
#include <cstdint>
namespace pg8 {
#define PG8_LAS __attribute__((address_space(3)))
typedef unsigned short bf16_t;
typedef short bf16x8 __attribute__((ext_vector_type(8)));
typedef float f32x4 __attribute__((ext_vector_type(4)));
typedef unsigned u32x4 __attribute__((ext_vector_type(4)));
constexpr int BM = 256, BK = 64, HALF = 128, HTB = HALF * BK * 2  , STAGE_BYTES = 8 * HTB, NXCD = 8, WGM = 8;

__host__ __device__ __forceinline__ int lds_byte(int r, int c) { const int st = (r >> 4) * 2 + (c >> 5), rr = r & 15, cc = c & 31, ob = rr * 64 + cc * 2; return st * 1024 + (ob ^ (((ob >> 9) & 1) << 5)); }
__host__ __device__ __forceinline__ void stage_rc(int b, int& R, int& C) { const int st = b / 1024, sb = b % 1024, swz = sb ^ (((sb >> 9) & 1) << 5); R = (st >> 1) * 16 + swz / 64; C = (st & 1) * 32 + (swz % 64) / 2; }
__host__ __device__ __forceinline__ int perm32(int rho) { const int n = rho >> 4, i = rho & 15; return 8 * (i >> 2) + 4 * n + (i & 3); }

struct Unit { int pm, pn; };
struct Gemm { const bf16_t* A; const bf16_t* Bt; int M, N, K, lda, ldb; };

struct StaticOrder {
    int nM, nN, nwg, G, c; bool lat_only;
    __host__ __device__ void init(int M, int N, int G_, int c_, bool lat_only_ = false) { lat_only = lat_only_; nM = lat_only_ ? 32 : M / BM; nN = N / BM; nwg = nM * nN; G = G_; c = c_; }
    __host__ __device__ bool next(int i, Unit& u) const {
        const long L = (long)i * G + c; if (L >= nwg) return false;
        int wgid = (int)L; { const int q = nwg / NXCD, r = nwg % NXCD, xcd = wgid % NXCD, off = wgid / NXCD; wgid = (xcd < r ? xcd * (q + 1) : r * (q + 1) + (xcd - r) * q) + off; }
        const int nig = WGM * nN, gid = wgid / nig, fm = gid * WGM, gsz = (nM - fm) < WGM ? (nM - fm) : WGM;
        u.pm = fm + ((wgid % nig) % gsz); u.pn = (wgid % nig) / gsz; if (lat_only) u.pm += 1 + (u.pm >= 16 ? 1 : 0); return true;
    }
    __device__ __forceinline__ void a_ready(const Unit&) const {}
    __device__ __forceinline__ void done(const Unit&) const {}
};
__device__ __forceinline__ unsigned cvt_pk_bf16(float lo, float hi) { unsigned r; asm volatile("v_cvt_pk_bf16_f32 %0, %1, %2" : "=v"(r) : "v"(lo), "v"(hi)); return r; }
typedef float f32x2 __attribute__((ext_vector_type(2)));
struct EpiBf16 {
    static constexpr bool PERM = true, AFTER_DRAIN = false;
    bf16_t* O; int ldc;
    __device__ __forceinline__ void operator()(const f32x4 (&acc)[2][2][4][2], const Unit& u, int wr, int wc, int fr, int fq) const {
        const int row0 = u.pm * BM + wr * 64 + fr, col0 = u.pn * BM + wc * 32 + 8 * fq;
#pragma unroll
        for (int ai = 0; ai < 2; ++ai)
#pragma unroll
            for (int m = 0; m < 4; ++m) { bf16_t* rowp = O + (size_t)(row0 + ai * HALF + m * 16) * ldc + col0;
#pragma unroll
                for (int bj = 0; bj < 2; ++bj) { const f32x4 v0 = acc[ai][bj][m][0], v1 = acc[ai][bj][m][1];
                    u32x4 w; w.x = cvt_pk_bf16(v0[0], v0[1]); w.y = cvt_pk_bf16(v0[2], v0[3]); w.z = cvt_pk_bf16(v1[0], v1[1]); w.w = cvt_pk_bf16(v1[2], v1[3]);
                    *(u32x4*)(rowp + bj * HALF) = w; } }
    }
};
struct EpiResid {
    static constexpr bool PERM = false, AFTER_DRAIN = false;
    float* X; int ldc; const float* gate;
    __device__ __forceinline__ void operator()(const f32x4 (&acc)[2][2][4][2], const Unit& u, int wr, int wc, int fr, int fq) const {
        const int row0 = u.pm * BM + wr * 64 + fr, col0 = u.pn * BM + wc * 32 + 4 * fq;
        const int cls = (u.pm % 17 == 0) ? 2 : (u.pm / 17);
        const float* gp = gate + (size_t)cls * 12288 + col0;
        f32x4 gv[2][2];
#pragma unroll
        for (int bj = 0; bj < 2; ++bj)
#pragma unroll
            for (int n = 0; n < 2; ++n) gv[bj][n] = *(const f32x4*)(gp + bj * HALF + n * 16);
#pragma unroll
        for (int ai = 0; ai < 2; ++ai)
#pragma unroll
            for (int m = 0; m < 4; ++m) { float* rowp = X + (size_t)(row0 + ai * HALF + m * 16) * ldc + col0;
#pragma unroll
                for (int bj = 0; bj < 2; ++bj)
#pragma unroll
                    for (int n = 0; n < 2; ++n) { f32x4* p = (f32x4*)(rowp + bj * HALF + n * 16); *p = *p + gv[bj][n] * acc[ai][bj][m][n]; } }
    }
};
template <class Epi, class Sched, bool ALIGN_EPI = false, bool SP2 = false>
__device__ __forceinline__ void gemm_phase(PG8_LAS unsigned char* lds, const Gemm g, const Sched& S, const Epi& E, int tid_in) {
    int tid_ = tid_in; asm volatile("" : "+v"(tid_));
    const int tid = tid_, wid = __builtin_amdgcn_readfirstlane(tid >> 6), lane = tid & 63, wr = wid >> 2, wc = wid & 3, fr = lane & 15, fq = lane >> 4;
    const int K = g.K, nt = K / BK;
    unsigned voffA[2], voffB[2];
#pragma unroll
    for (int i = 0; i < 2; ++i) { int R, C; stage_rc(tid * 16 + i * 8192, R, C); const int Rb = Epi::PERM ? ((R & ~31) + perm32(R & 31)) : R;
        voffA[i] = (unsigned)(R * g.lda + C) * 2u; voffB[i] = (unsigned)(Rb * g.ldb + C) * 2u; }
    const size_t kstep = (size_t)(BK * 2);
    const size_t hstepA = (size_t)HALF * g.lda * 2, hstepB = (size_t)HALF * g.ldb * 2;
    const size_t tstepA = 2 * hstepA, tstepB = 2 * hstepB;
    const unsigned ldsw = (unsigned)wid * 1024u;
    const int aoff = lds_byte(wr * 64 + fr, fq * 8), boff = lds_byte(wc * 32 + fr, fq * 8);
#define PG8_SA(b, h) (((b) * 2 + (h)) * HTB)
#define PG8_SB(b, h) ((4 + (b) * 2 + (h)) * HTB)
#define PG8_STAGE(bufoff, gbase, voff) do { _Pragma("unroll") for (int _i = 0; _i < 2; ++_i) \
        __builtin_amdgcn_global_load_lds((const unsigned*)((const char*)(gbase) + (voff)[_i]), (PG8_LAS unsigned*)(lds + (bufoff) + ldsw + _i * 8192), 16, 0, 0); } while (0)
#define PG8_LDA(dst, b, h) do { _Pragma("unroll") for (int m = 0; m < 4; ++m) _Pragma("unroll") for (int k = 0; k < 2; ++k) dst[m][k] = *(const PG8_LAS bf16x8*)(lds + PG8_SA(b, h) + aoff + m * 2048 + k * 1024); } while (0)
#define PG8_LDB(dst, b, h) do { _Pragma("unroll") for (int n = 0; n < 2; ++n) _Pragma("unroll") for (int k = 0; k < 2; ++k) dst[n][k] = *(const PG8_LAS bf16x8*)(lds + PG8_SB(b, h) + boff + n * 2048 + k * 1024); } while (0)
#define PG8_MMA(ai, bj, At, Bt) do { __builtin_amdgcn_s_setprio(1); _Pragma("unroll") for (int m = 0; m < 4; ++m) _Pragma("unroll") for (int n = 0; n < 2; ++n) _Pragma("unroll") for (int k = 0; k < 2; ++k) \
        acc[ai][bj][m][n] = __builtin_amdgcn_mfma_f32_16x16x32_bf16(Bt[n][k], At[m][k], acc[ai][bj][m][n], 0, 0, 0); __builtin_amdgcn_s_setprio(0); } while (0)
#define PG8_WAIT_V(n) asm volatile("s_waitcnt vmcnt(" #n ")" ::: "memory")
#define PG8_WAIT_L(n) asm volatile("s_waitcnt lgkmcnt(" #n ")" ::: "memory")
#define PG8_BAR __builtin_amdgcn_s_barrier()
#define PG8_SCHED __builtin_amdgcn_sched_barrier(0)
    Unit cur, nxt; int ui = 0;
    if (!S.next(0, cur)) return;
    f32x4 acc[2][2][4][2];
#pragma unroll
    for (int a = 0; a < 2; ++a)
#pragma unroll
        for (int b = 0; b < 2; ++b)
#pragma unroll
            for (int m = 0; m < 4; ++m)
#pragma unroll
                for (int n = 0; n < 2; ++n) acc[a][b][m][n] = (f32x4){0.f, 0.f, 0.f, 0.f};
    bf16x8 At[4][2], B0[2][2], B1[2][2];
    const char* cA = (const char*)g.A + (size_t)cur.pm * tstepA; const char* cB = (const char*)g.Bt + (size_t)cur.pn * tstepB;
    S.a_ready(cur);
    if constexpr (SP2) {
        PG8_STAGE(PG8_SB(0, 0), cB, voffB); PG8_STAGE(PG8_SB(0, 1), cB + hstepB, voffB); PG8_STAGE(PG8_SA(0, 0), cA, voffA); PG8_STAGE(PG8_SA(0, 1), cA + hstepA, voffA);
        if (wr == 1) PG8_BAR;
        PG8_WAIT_V(2); PG8_BAR;
        PG8_STAGE(PG8_SB(1, 0), cB + kstep, voffB); PG8_STAGE(PG8_SA(1, 0), cA + kstep, voffA); PG8_STAGE(PG8_SB(1, 1), cB + hstepB + kstep, voffB);
        PG8_WAIT_V(6); PG8_BAR;
    } else {
        PG8_STAGE(PG8_SB(0, 0), cB, voffB); PG8_STAGE(PG8_SA(0, 0), cA, voffA); PG8_STAGE(PG8_SB(0, 1), cB + hstepB, voffB); PG8_STAGE(PG8_SA(0, 1), cA + hstepA, voffA);
        if (wr == 1) PG8_BAR;
        PG8_WAIT_V(4); PG8_BAR;
        PG8_STAGE(PG8_SB(1, 0), cB + kstep, voffB); PG8_STAGE(PG8_SA(1, 0), cA + kstep, voffA); PG8_STAGE(PG8_SB(1, 1), cB + hstepB + kstep, voffB);
        PG8_WAIT_V(6); PG8_BAR;
    }
    for (;;) {
        const bool has_next = S.next(ui + 1, nxt);
        const char* nA = has_next ? (const char*)g.A + (size_t)nxt.pm * tstepA : cA; const char* nB = has_next ? (const char*)g.Bt + (size_t)nxt.pn * tstepB : cB;
        for (int t = 0; t < nt; t += 2) {
            const bool last = (t == nt - 2);
            const char* a1 = cA + (size_t)(t + 1) * kstep;
            const char* a2 = last ? nA : cA + (size_t)(t + 2) * kstep; const char* b2 = last ? nB : cB + (size_t)(t + 2) * kstep;
            const char* a3 = a2 + kstep; const char* b3 = b2 + kstep;
            if (last && has_next) S.a_ready(nxt);
            if constexpr (SP2) {
            PG8_LDB(B0, 0, 0); PG8_LDB(B1, 0, 1); PG8_SCHED; PG8_LDA(At, 0, 0); PG8_STAGE(PG8_SA(1, 1), a1 + hstepA, voffA);
            PG8_WAIT_V(8); PG8_WAIT_L(0); PG8_BAR; PG8_MMA(0, 0, At, B0); PG8_MMA(0, 1, At, B1); PG8_BAR; PG8_SCHED;
            PG8_LDA(At, 0, 1); PG8_STAGE(PG8_SB(0, 0), b2, voffB); PG8_STAGE(PG8_SB(0, 1), b2 + hstepB, voffB); PG8_STAGE(PG8_SA(0, 0), a2, voffA);
            PG8_WAIT_V(8); PG8_WAIT_L(0); PG8_BAR; PG8_MMA(1, 0, At, B0); PG8_MMA(1, 1, At, B1); PG8_BAR; PG8_SCHED;
            PG8_LDB(B0, 1, 0); PG8_LDB(B1, 1, 1); PG8_SCHED; PG8_LDA(At, 1, 0); PG8_STAGE(PG8_SA(0, 1), a2 + hstepA, voffA);
            PG8_WAIT_V(8); PG8_WAIT_L(0); PG8_BAR; PG8_MMA(0, 0, At, B0); PG8_MMA(0, 1, At, B1); PG8_BAR; PG8_SCHED;
            PG8_LDA(At, 1, 1); PG8_STAGE(PG8_SB(1, 0), b3, voffB); PG8_STAGE(PG8_SB(1, 1), b3 + hstepB, voffB); PG8_STAGE(PG8_SA(1, 0), a3, voffA);
            PG8_WAIT_V(8); PG8_WAIT_L(0); PG8_BAR; PG8_MMA(1, 0, At, B0); PG8_MMA(1, 1, At, B1); PG8_BAR; PG8_SCHED;
            } else {
            PG8_LDB(B0, 0, 0); PG8_SCHED; PG8_LDA(At, 0, 0); PG8_STAGE(PG8_SA(1, 1), a1 + hstepA, voffA);
            PG8_WAIT_L(8); PG8_BAR; PG8_WAIT_L(0); PG8_MMA(0, 0, At, B0); PG8_BAR; PG8_SCHED;
            PG8_LDB(B1, 0, 1); PG8_STAGE(PG8_SB(0, 0), b2, voffB);
            PG8_BAR; PG8_WAIT_L(0); PG8_MMA(0, 1, At, B1); PG8_BAR;
            PG8_LDA(At, 0, 1); PG8_STAGE(PG8_SA(0, 0), a2, voffA);
            PG8_BAR; PG8_WAIT_L(0); PG8_MMA(1, 0, At, B0); PG8_BAR; PG8_SCHED;
            PG8_STAGE(PG8_SB(0, 1), b2 + hstepB, voffB);
            PG8_WAIT_V(6); PG8_BAR; PG8_MMA(1, 1, At, B1); PG8_BAR;
            PG8_LDB(B0, 1, 0); PG8_SCHED; PG8_LDA(At, 1, 0); PG8_STAGE(PG8_SA(0, 1), a2 + hstepA, voffA);
            PG8_WAIT_L(8); PG8_BAR; PG8_WAIT_L(0); PG8_MMA(0, 0, At, B0); PG8_BAR; PG8_SCHED;
            PG8_LDB(B1, 1, 1); PG8_STAGE(PG8_SB(1, 0), b3, voffB);
            PG8_BAR; PG8_WAIT_L(0); PG8_MMA(0, 1, At, B1); PG8_BAR;
            PG8_LDA(At, 1, 1); PG8_STAGE(PG8_SA(1, 0), a3, voffA);
            PG8_BAR; PG8_WAIT_L(0); PG8_MMA(1, 0, At, B0); PG8_BAR; PG8_SCHED;
            PG8_STAGE(PG8_SB(1, 1), b3 + hstepB, voffB);
            PG8_WAIT_V(6); PG8_BAR; PG8_MMA(1, 1, At, B1); PG8_BAR;
            }
        }
        if constexpr (ALIGN_EPI) { if (wr == 0) PG8_BAR; }
        if constexpr (!Epi::AFTER_DRAIN) { E(acc, cur, wr, wc, fr, fq); S.done(cur); }
        if (!has_next) break;
#pragma unroll
        for (int a = 0; a < 2; ++a)
#pragma unroll
            for (int b = 0; b < 2; ++b)
#pragma unroll
                for (int m = 0; m < 4; ++m)
#pragma unroll
                    for (int n = 0; n < 2; ++n) acc[a][b][m][n] = (f32x4){0.f, 0.f, 0.f, 0.f};
        cur = nxt; cA = nA; cB = nB; ++ui;
        if constexpr (ALIGN_EPI) { if (wr == 1) PG8_BAR; }
    }
    PG8_WAIT_V(0);
    if constexpr (!ALIGN_EPI) { if (wr == 0) PG8_BAR; }
    PG8_BAR;
    if constexpr (Epi::AFTER_DRAIN) { E.fused(acc, cur, wr, wc, fr, fq, lds, wid, lane); S.done(cur); }
#undef PG8_SA
#undef PG8_SB
#undef PG8_STAGE
#undef PG8_LDA
#undef PG8_LDB
#undef PG8_MMA
#undef PG8_WAIT_V
#undef PG8_WAIT_L
#undef PG8_BAR
#undef PG8_SCHED
}
}
namespace att {
typedef unsigned short bf16_t;
using bf16x8 = __attribute__((ext_vector_type(8))) short;
using s16x4  = __attribute__((ext_vector_type(4))) short;
using f32x16 = __attribute__((ext_vector_type(16))) float;
using u32x4  = __attribute__((ext_vector_type(4))) unsigned;
constexpr int DV = 128, NW = 8, QBLK = 32, KVBLK = 64;
constexpr float THR = 8.f;
constexpr int SHM_V = KVBLK * DV * 2;
template <int DQK> struct Cfg {
    static constexpr int SHM_K = KVBLK * DQK * 2, KROWB = DQK * 2, NCK = DQK / 64, C8 = DQK / 8, ND0 = DQK / 16;
    static constexpr float SCALE = (DQK == 128) ? 0.088388347648318440f : 0.072168783648703220f;
    static constexpr int LDS_BYTES = 2 * SHM_V + 2 * SHM_K + NW * 64 * 4;
};
#define ATT_SBAR() __builtin_amdgcn_sched_barrier(0)
__device__ __forceinline__ int crow(int r, int hi) { return (r & 3) + 8 * (r >> 2) + 4 * hi; }
__device__ __forceinline__ unsigned cvtpk(float lo, float hi) { unsigned r; asm volatile("v_cvt_pk_bf16_f32 %0, %1, %2" : "=v"(r) : "v"(lo), "v"(hi)); return r; }
template <int DQK> __device__ __forceinline__ int kswz(int row, int colB) {
    const int key = (DQK == 128) ? (row & 7) : ((row >> 1) & 7);
    return row * (DQK * 2) + (colB ^ (key << 4));
}
template <int DQK> __device__ __forceinline__ void partialSM(f32x16& p0, f32x16& p1, float& m_reg, float& mn, float& alpha) {
    constexpr float SCALE = Cfg<DQK>::SCALE, C = SCALE * 1.4426950408889634f;
    float pmax = p0[0];
#pragma unroll
    for (int r = 1; r < 16; ++r) pmax = fmaxf(pmax, p0[r]);
#pragma unroll
    for (int r = 0; r < 16; ++r) pmax = fmaxf(pmax, p1[r]);
    { auto rr = __builtin_amdgcn_permlane32_swap(__float_as_uint(pmax), __float_as_uint(pmax), false, false);
      pmax = fmaxf(__uint_as_float(rr[0]), __uint_as_float(rr[1])); }
    if (__builtin_expect(__all(pmax - m_reg <= THR / SCALE), 1)) { mn = m_reg; alpha = 1.f; }
    else { mn = fmaxf(m_reg, pmax); alpha = __builtin_amdgcn_exp2f((m_reg - mn) * C); m_reg = mn; }
    const float mnC = -mn * C;
#pragma unroll
    for (int r = 0; r < 16; ++r) p0[r] = fmaf(p0[r], C, mnC);
#pragma unroll
    for (int r = 0; r < 16; ++r) p1[r] = fmaf(p1[r], C, mnC);
#pragma unroll
    for (int r = 0; r < 16; ++r) p0[r] = __builtin_amdgcn_exp2f(p0[r]);
}
__device__ __forceinline__ void finishSM(f32x16& p0, f32x16& p1, float alpha, float& l_reg, bf16x8& pa0, bf16x8& pa1, bf16x8& pa2, bf16x8& pa3) {
#pragma unroll
    for (int r = 0; r < 16; ++r) p1[r] = __builtin_amdgcn_exp2f(p1[r]);
    float ps = 0;
#pragma unroll
    for (int r = 0; r < 16; ++r) ps += p0[r];
#pragma unroll
    for (int r = 0; r < 16; ++r) ps += p1[r];
    { auto rr = __builtin_amdgcn_permlane32_swap(__float_as_uint(ps), __float_as_uint(ps), false, false);
      ps = __uint_as_float(rr[0]) + __uint_as_float(rr[1]); }
    l_reg = l_reg * alpha + ps;
#define ATT_PK4(P, BASE, OUT) do { unsigned a0 = cvtpk(P[BASE + 0], P[BASE + 1]), a1 = cvtpk(P[BASE + 2], P[BASE + 3]);   \
    unsigned b0 = cvtpk(P[BASE + 4], P[BASE + 5]), b1 = cvtpk(P[BASE + 6], P[BASE + 7]);                              \
    auto r0 = __builtin_amdgcn_permlane32_swap(a0, b0, false, false); auto r1 = __builtin_amdgcn_permlane32_swap(a1, b1, false, false); \
    u32x4 w = {r0[0], r1[0], r0[1], r1[1]}; OUT = *reinterpret_cast<bf16x8*>(&w); } while (0)
    ATT_PK4(p0, 0, pa0); ATT_PK4(p0, 8, pa1); ATT_PK4(p1, 0, pa2); ATT_PK4(p1, 8, pa3);
#undef ATT_PK4
}
template <int DQK> __device__ __forceinline__ void qkt(f32x16& p0, f32x16& p1, const char* Ks, const bf16x8* qr, int r32, int hi) {
    p0 = f32x16{}; p1 = f32x16{};
#pragma unroll
    for (int d0 = 0; d0 < Cfg<DQK>::ND0; ++d0) { const int cb = (d0 * 16 + hi * 8) * 2;
        bf16x8 b0 = *reinterpret_cast<const bf16x8*>(Ks + kswz<DQK>(r32, cb));
        bf16x8 b1 = *reinterpret_cast<const bf16x8*>(Ks + kswz<DQK>(32 + r32, cb));
        p0 = __builtin_amdgcn_mfma_f32_32x32x16_bf16(b0, qr[d0], p0, 0, 0, 0);
        p1 = __builtin_amdgcn_mfma_f32_32x32x16_bf16(b1, qr[d0], p1, 0, 0, 0); }
}
__device__ __forceinline__ int v_st(int k, int c) { const int kk = (k & ~0xC) | ((k & 4) << 1) | ((k & 8) >> 1); return ((kk >> 3) * 4 + (c >> 5)) * 512 + ((kk & 7) * 32 + (c & 31)) * 2; }
__device__ __forceinline__ int v_rd_base(int lane) { return ((lane & 3) << 3) | (((lane >> 2) & 3) << 6) | (((lane >> 4) & 1) << 5) | (((lane >> 5) & 1) << 8); }
constexpr int v_rd_off(int d0, int ks, int half) { return d0 * 512 + ks * 4096 + half * 2048; }
template <int OFF> __device__ __forceinline__ s16x4 tr_read(int vb) {
    s16x4 r; asm volatile("ds_read_b64_tr_b16 %0, %1 offset:%2" : "=&v"(r) : "v"(vb), "i"(OFF) : "memory"); return r;
}
template <int D0> __device__ __forceinline__ void pv_one(f32x16& od, int vb, bf16x8 pa0, bf16x8 pa1, bf16x8 pa2, bf16x8 pa3) {
    const s16x4 l0 = tr_read<v_rd_off(D0, 0, 0)>(vb), h0 = tr_read<v_rd_off(D0, 0, 1)>(vb), l1 = tr_read<v_rd_off(D0, 1, 0)>(vb), h1 = tr_read<v_rd_off(D0, 1, 1)>(vb);
    const s16x4 l2 = tr_read<v_rd_off(D0, 2, 0)>(vb), h2 = tr_read<v_rd_off(D0, 2, 1)>(vb), l3 = tr_read<v_rd_off(D0, 3, 0)>(vb), h3 = tr_read<v_rd_off(D0, 3, 1)>(vb);
    asm volatile("s_waitcnt lgkmcnt(0)" ::: "memory"); ATT_SBAR();
#define ATT_PK(L, H) (bf16x8){L[0], L[1], L[2], L[3], H[0], H[1], H[2], H[3]}
    od = __builtin_amdgcn_mfma_f32_32x32x16_bf16(pa0, ATT_PK(l0, h0), od, 0, 0, 0);
    od = __builtin_amdgcn_mfma_f32_32x32x16_bf16(pa1, ATT_PK(l1, h1), od, 0, 0, 0);
    od = __builtin_amdgcn_mfma_f32_32x32x16_bf16(pa2, ATT_PK(l2, h2), od, 0, 0, 0);
    od = __builtin_amdgcn_mfma_f32_32x32x16_bf16(pa3, ATT_PK(l3, h3), od, 0, 0, 0);
#undef ATT_PK
}
__device__ __forceinline__ void pv_d0(f32x16* o, int vb, bf16x8 pa0, bf16x8 pa1, bf16x8 pa2, bf16x8 pa3) {
    pv_one<0>(o[0], vb, pa0, pa1, pa2, pa3); pv_one<1>(o[1], vb, pa0, pa1, pa2, pa3); pv_one<2>(o[2], vb, pa0, pa1, pa2, pa3); pv_one<3>(o[3], vb, pa0, pa1, pa2, pa3);
}
template <int DQK, int LDQ, int LDK, int LDV, int LDO, int SDEPTH>
__device__ __forceinline__ void attn_body(const bf16_t* __restrict__ Qb, const bf16_t* __restrict__ Kh, const bf16_t* __restrict__ Vh, bf16_t* __restrict__ Ob, int seq, char* lds, int tid_in) {
    using C_ = Cfg<DQK>;
    constexpr int SHM_K = C_::SHM_K, NCK = C_::NCK, C8 = C_::C8, ND0 = C_::ND0;
    int tid_ = tid_in; asm volatile("" : "+v"(tid_));
    const int tid = tid_, wid = tid >> 6, lane = tid & 63, r32 = lane & 31, hi = lane >> 5;
    char* V_lds = lds; char* K_lds = lds + 2 * SHM_V;
    float* ws = (float*)(lds + 2 * SHM_V + 2 * SHM_K) + wid * 64; float* li_l = ws; float* al_l = ws + 32;
    float m_reg = -1e30f, l_reg = 0; f32x16 o[4] = {}; bf16x8 qr[ND0];
    const bf16_t* Qw = Qb + (long)(wid * QBLK + r32) * LDQ + hi * 8;
#pragma unroll
    for (int d0 = 0; d0 < ND0; ++d0) qr[d0] = *reinterpret_cast<const bf16x8*>(Qw + d0 * 16);
    const int sr = tid >> 4, sc = (tid & 15) * 8, vst0 = v_st(sr, sc), vst1 = v_st(32 + sr, sc);
    int krow[NCK], kcol[NCK];
#pragma unroll
    for (int i = 0; i < NCK; ++i) { const int ci = tid + 512 * i; krow[i] = ci / C8; kcol[i] = (ci % C8) * 8; }
    const int vb0 = (int)(uintptr_t)V_lds + v_rd_base(lane);
    struct { bf16x8 vs0, vs1, ks[NCK]; } sr_[SDEPTH];
#define ATT_SLOAD(i, k0) do { sr_[i].vs0 = *reinterpret_cast<const bf16x8*>(&Vh[(long)((k0) + sr) * LDV + sc]); sr_[i].vs1 = *reinterpret_cast<const bf16x8*>(&Vh[(long)((k0) + 32 + sr) * LDV + sc]); \
    _Pragma("unroll") for (int c_ = 0; c_ < NCK; ++c_) sr_[i].ks[c_] = *reinterpret_cast<const bf16x8*>(&Kh[(long)((k0) + krow[c_]) * LDK + kcol[c_]]); } while (0)
#define ATT_SWRITE(b, i) do { *(bf16x8*)(V_lds + (b) * SHM_V + vst0) = sr_[i].vs0; *(bf16x8*)(V_lds + (b) * SHM_V + vst1) = sr_[i].vs1; \
    _Pragma("unroll") for (int c_ = 0; c_ < NCK; ++c_) *(bf16x8*)(K_lds + (b) * SHM_K + kswz<DQK>(krow[c_], kcol[c_] * 2)) = sr_[i].ks[c_]; } while (0)
#define ATT_SWAIT() do { if constexpr (SDEPTH == 2) { if constexpr (NCK == 2) asm volatile("s_waitcnt vmcnt(4)" ::: "memory"); else asm volatile("s_waitcnt vmcnt(5)" ::: "memory"); } else asm volatile("s_waitcnt vmcnt(0)" ::: "memory"); } while (0)
#define ATT_RESC(a) do { if (__any((a) < 1.f)) { if (hi == 0) al_l[r32] = (a); asm volatile("s_waitcnt lgkmcnt(0)" ::: "memory"); \
    _Pragma("unroll") for (int d = 0; d < 4; ++d) _Pragma("unroll") for (int r = 0; r < 16; ++r) o[d][r] *= al_l[crow(r, hi)]; } } while (0)
    f32x16 pA0, pA1, pB0, pB1; float mnA, mnB, alA, alB; bf16x8 pa0, pa1, pa2, pa3; const int NT = seq / KVBLK;
    constexpr int SE = 0, SO = SDEPTH - 1;
    ATT_SLOAD(SE, 0); asm volatile("s_waitcnt vmcnt(0)" ::: "memory"); ATT_SWRITE(0, SE); __syncthreads();
    qkt<DQK>(pA0, pA1, K_lds, qr, r32, hi); partialSM<DQK>(pA0, pA1, m_reg, mnA, alA);
    ATT_SLOAD(SO, KVBLK); if constexpr (SDEPTH == 2) { if (2 < NT) ATT_SLOAD(SE, 2 * KVBLK); }
    ATT_SWAIT(); ATT_SWRITE(1, SO); __syncthreads();
    for (int j = 1; j + 1 < NT; j += 2) {
        ATT_SBAR(); qkt<DQK>(pB0, pB1, K_lds + SHM_K, qr, r32, hi);
        finishSM(pA0, pA1, alA, l_reg, pa0, pa1, pa2, pa3); ATT_SBAR();
        ATT_SLOAD(SO, (j + SDEPTH) * KVBLK); ATT_SBAR();
        pv_d0(o, vb0, pa0, pa1, pa2, pa3); partialSM<DQK>(pB0, pB1, m_reg, mnB, alB);
        __syncthreads(); ATT_SWAIT(); ATT_SWRITE(0, SE);
        ATT_RESC(alB); __syncthreads();
        ATT_SBAR(); qkt<DQK>(pA0, pA1, K_lds, qr, r32, hi);
        finishSM(pB0, pB1, alB, l_reg, pa0, pa1, pa2, pa3); ATT_SBAR();
        if (SDEPTH == 1 || j + 3 < NT) ATT_SLOAD(SE, (j + 1 + SDEPTH) * KVBLK); ATT_SBAR();
        pv_d0(o, vb0 + (int)SHM_V, pa0, pa1, pa2, pa3); partialSM<DQK>(pA0, pA1, m_reg, mnA, alA);
        __syncthreads(); ATT_SWAIT(); ATT_SWRITE(1, SO);
        ATT_RESC(alA); __syncthreads();
    }
    ATT_SBAR(); qkt<DQK>(pB0, pB1, K_lds + SHM_K, qr, r32, hi);
    finishSM(pA0, pA1, alA, l_reg, pa0, pa1, pa2, pa3); ATT_SBAR();
    pv_d0(o, vb0, pa0, pa1, pa2, pa3); partialSM<DQK>(pB0, pB1, m_reg, mnB, alB);
    __syncthreads(); ATT_RESC(alB);
    finishSM(pB0, pB1, alB, l_reg, pa0, pa1, pa2, pa3); ATT_SBAR();
    pv_d0(o, vb0 + (int)SHM_V, pa0, pa1, pa2, pa3);
    if (hi == 0) li_l[r32] = l_reg;
    asm volatile("s_waitcnt lgkmcnt(0)" ::: "memory");
    __syncthreads();
    float rli[16];
#pragma unroll
    for (int r = 0; r < 16; ++r) rli[r] = __builtin_amdgcn_rcpf(li_l[crow(r, hi)]);
    unsigned short* stg = (unsigned short*)(lds + wid * 8192);
#pragma unroll
    for (int r = 0; r < 16; ++r) { const int orow = crow(r, hi);
#pragma unroll
        for (int d0 = 0; d0 < 4; ++d0) { const unsigned w = cvtpk(o[d0][r] * rli[r], 0.f); stg[orow * 128 + d0 * 32 + r32] = (unsigned short)(w & 0xffffu); } }
    asm volatile("s_waitcnt lgkmcnt(0)" ::: "memory");
    bf16_t* Ow = Ob + (long)(wid * QBLK) * LDO;
#pragma unroll
    for (int i = 0; i < 8; ++i) { const int id = lane + 64 * i, row = id >> 4, c16 = id & 15;
        const u32x4 v = *(const u32x4*)((const char*)stg + row * 256 + c16 * 16);
        *(u32x4*)(Ow + (long)row * LDO + c16 * 8) = v; }
    asm volatile("s_waitcnt lgkmcnt(0)" ::: "memory");
    __syncthreads();
#undef ATT_SLOAD
#undef ATT_SWRITE
#undef ATT_SWAIT
#undef ATT_RESC
}

template <int DQK, int LDQ, int LDK, int LDV, int LDO>
__device__ __forceinline__ void attn_body1(const bf16_t* __restrict__ Qb, const bf16_t* __restrict__ Kh, const bf16_t* __restrict__ Vh, bf16_t* __restrict__ Ob, int seq, char* lds, int tid_in) {
    using C_ = Cfg<DQK>;
    constexpr int SHM_K = C_::SHM_K, NCK = C_::NCK, C8 = C_::C8, ND0 = C_::ND0;
    int tid_ = tid_in; asm volatile("" : "+v"(tid_));
    const int tid = tid_, wid = tid >> 6, lane = tid & 63, r32 = lane & 31, hi = lane >> 5;
    char* V_lds = lds; char* K_lds = lds + 2 * SHM_V;
    float* ws = (float*)(lds + 2 * SHM_V + 2 * SHM_K) + wid * 64; float* li_l = ws; float* al_l = ws + 32;
    float m_reg = -1e30f, l_reg = 0; f32x16 o[4] = {}; bf16x8 qr[ND0];
    const bf16_t* Qw = Qb + (long)(wid * QBLK + r32) * LDQ + hi * 8;
#pragma unroll
    for (int d0 = 0; d0 < ND0; ++d0) qr[d0] = *reinterpret_cast<const bf16x8*>(Qw + d0 * 16);
    const int sr = tid >> 4, sc = (tid & 15) * 8, vst0 = v_st(sr, sc), vst1 = v_st(32 + sr, sc);
    int krow[NCK], kcol[NCK];
#pragma unroll
    for (int i = 0; i < NCK; ++i) { const int ci = tid + 512 * i; krow[i] = ci / C8; kcol[i] = (ci % C8) * 8; }
    const int vb0 = (int)(uintptr_t)V_lds + v_rd_base(lane);
    bf16x8 vs0, vs1, ks[NCK];
#define ATT1_SLOAD(k0) do { vs0 = *reinterpret_cast<const bf16x8*>(&Vh[(long)((k0) + sr) * LDV + sc]); vs1 = *reinterpret_cast<const bf16x8*>(&Vh[(long)((k0) + 32 + sr) * LDV + sc]); \
    _Pragma("unroll") for (int c_ = 0; c_ < NCK; ++c_) ks[c_] = *reinterpret_cast<const bf16x8*>(&Kh[(long)((k0) + krow[c_]) * LDK + kcol[c_]]); } while (0)
#define ATT1_SWRITE(b) do { *(bf16x8*)(V_lds + (b) * SHM_V + vst0) = vs0; *(bf16x8*)(V_lds + (b) * SHM_V + vst1) = vs1; \
    _Pragma("unroll") for (int c_ = 0; c_ < NCK; ++c_) *(bf16x8*)(K_lds + (b) * SHM_K + kswz<DQK>(krow[c_], kcol[c_] * 2)) = ks[c_]; } while (0)
    const int NT = seq / KVBLK;
    ATT1_SLOAD(0); asm volatile("s_waitcnt vmcnt(0)" ::: "memory"); ATT1_SWRITE(0); __syncthreads();
    for (int j = 0; j < NT; ++j) {
        const int b = j & 1;
        if (j + 1 < NT) ATT1_SLOAD((j + 1) * KVBLK);
        ATT_SBAR();
        f32x16 p0, p1; float mn, alpha; bf16x8 pa0, pa1, pa2, pa3;
        qkt<DQK>(p0, p1, K_lds + b * SHM_K, qr, r32, hi);
        partialSM<DQK>(p0, p1, m_reg, mn, alpha);
        if (__any(alpha < 1.f)) { if (hi == 0) al_l[r32] = alpha; asm volatile("s_waitcnt lgkmcnt(0)" ::: "memory");
#pragma unroll
            for (int d = 0; d < 4; ++d)
#pragma unroll
                for (int r = 0; r < 16; ++r) o[d][r] *= al_l[crow(r, hi)]; }
        finishSM(p0, p1, alpha, l_reg, pa0, pa1, pa2, pa3); ATT_SBAR();
        pv_d0(o, vb0 + b * (int)SHM_V, pa0, pa1, pa2, pa3);
        if (j + 1 < NT) { ATT1_SWRITE(b ^ 1); }
        __syncthreads();
    }
    if (hi == 0) li_l[r32] = l_reg;
    asm volatile("s_waitcnt lgkmcnt(0)" ::: "memory");
    __syncthreads();
    float rli[16];
#pragma unroll
    for (int r = 0; r < 16; ++r) rli[r] = __builtin_amdgcn_rcpf(li_l[crow(r, hi)]);
    unsigned short* stg = (unsigned short*)(lds + wid * 8192);
#pragma unroll
    for (int r = 0; r < 16; ++r) { const int orow = crow(r, hi);
#pragma unroll
        for (int d0 = 0; d0 < 4; ++d0) { const unsigned w = cvtpk(o[d0][r] * rli[r], 0.f); stg[orow * 128 + d0 * 32 + r32] = (unsigned short)(w & 0xffffu); } }
    asm volatile("s_waitcnt lgkmcnt(0)" ::: "memory");
    bf16_t* Ow = Ob + (long)(wid * QBLK) * LDO;
#pragma unroll
    for (int i = 0; i < 8; ++i) { const int id = lane + 64 * i, row = id >> 4, c16 = id & 15;
        const u32x4 v = *(const u32x4*)((const char*)stg + row * 256 + c16 * 16);
        *(u32x4*)(Ow + (long)row * LDO + c16 * 8) = v; }
    asm volatile("s_waitcnt lgkmcnt(0)" ::: "memory");
    __syncthreads();
#undef ATT1_SLOAD
#undef ATT1_SWRITE
}
}
constexpr int DM = 2048, NBATCH = 2, SEQ = 4096, CTX = 256, RB = SEQ + CTX  , MROWS = NBATCH * RB  ;
constexpr int NMOD = 6 * DM, NEXP = 16384;
constexpr float EPS = 1e-6f;
constexpr int NWAVES = 8, NTHREADS = 512;
constexpr size_t MiB = 1u << 20;
constexpr size_t WS_CTL = 0, CTL_ZERO_BYTES = 64 * 1024;
constexpr size_t WS_MOD = 1 * MiB;
constexpr size_t WS_ROPE = 2 * MiB;
constexpr size_t WS_SMALL = 3 * MiB;
constexpr int SM_N1G = 0, SM_N2G = 8192, SM_AQG = 16384, SM_AKG = 16384 + 384, SM_CW = 16384 + 768, SM_CB = SM_CW + 6144, SM_CQG = SM_CB + 2048, SM_CKG = SM_CQG + 256, SM_END = SM_CKG + 256;
constexpr size_t WS_XW = 4 * MiB;
constexpr size_t WS_H = 72 * MiB;
constexpr size_t WS_P = 106 * MiB;
constexpr size_t WS_QRAW = 174 * MiB;
constexpr size_t WS_KVRAW = 200 * MiB;
constexpr size_t WS_Q = 234 * MiB;
constexpr size_t WS_K = 268 * MiB;
constexpr size_t WS_V = 294 * MiB;
constexpr size_t WS_CAT = 311 * MiB;
constexpr size_t WS_PQ = 345 * MiB;
constexpr size_t WS_IDX = 379 * MiB;
constexpr size_t WS_GATE = 384 * MiB;
constexpr size_t WS_WIN = 389 * MiB;
constexpr size_t WS_WUQ = 421 * MiB;
constexpr size_t WS_WUKV = 424 * MiB;
constexpr size_t WS_WEO = 426 * MiB;
constexpr size_t WS_WQKV = 442 * MiB;
constexpr size_t WS_WCO = 466 * MiB;
constexpr size_t WS_WPQ = 482 * MiB;
constexpr size_t WS_SUBK = 514 * MiB;
constexpr int ROWB = 1536;
constexpr size_t WS_U = 516 * MiB;
constexpr size_t WS_VT = 644 * MiB;
constexpr size_t WS_USC = 772 * MiB;
constexpr size_t WS_VSC = 773 * MiB;
constexpr size_t WS_END = 774 * MiB;
constexpr int CW_BAR = 4096;
constexpr int LDS_MISC = 131072 + 8192;
constexpr int LDS_BYTES = 147456;

#define LAS __attribute__((address_space(3)))
typedef unsigned short bf16_t;
typedef float f32x4 __attribute__((ext_vector_type(4)));
typedef unsigned u32x4 __attribute__((ext_vector_type(4)));
typedef unsigned u32x2 __attribute__((ext_vector_type(2)));
typedef short bf16x8 __attribute__((ext_vector_type(8)));
typedef float f32x16 __attribute__((ext_vector_type(16)));
typedef __bf16 bf16x2_t __attribute__((ext_vector_type(2)));
typedef float f32x2 __attribute__((ext_vector_type(2)));
typedef float f32x32 __attribute__((ext_vector_type(32)));
typedef unsigned u32x6 __attribute__((ext_vector_type(6)));

__device__ __forceinline__ unsigned f2bf(float f) { unsigned u = __builtin_bit_cast(unsigned, f); return (u + 0x7fffu + ((u >> 16) & 1u)) >> 16; }
__device__ __forceinline__ unsigned pk2(float lo, float hi) { return f2bf(lo) | (f2bf(hi) << 16); }
__device__ __forceinline__ float bf_lo(unsigned w) { return __builtin_bit_cast(float, w << 16); }
__device__ __forceinline__ float bf_hi(unsigned w) { return __builtin_bit_cast(float, w & 0xffff0000u); }
__device__ __forceinline__ float bf2f(bf16_t h) { return __builtin_bit_cast(float, (unsigned)h << 16); }
__device__ __forceinline__ float wave_sum(float v) {
#pragma unroll
    for (int o = 1; o < 64; o <<= 1) v += __shfl_xor(v, o);
    return v;
}
#define DPP_ADD(v, ctrl) ((v) + __builtin_bit_cast(float, __builtin_amdgcn_update_dpp(0, __builtin_bit_cast(int, (v)), (ctrl), 0xf, 0xf, true)))
__device__ __forceinline__ float wave_sum_dpp(float v) {
    v = DPP_ADD(v, 0xB1);
    v = DPP_ADD(v, 0x4E);
    v = DPP_ADD(v, 0x141);
    v = DPP_ADD(v, 0x140);
    const int vi = __builtin_bit_cast(int, v);
    const float s0 = __builtin_bit_cast(float, __builtin_amdgcn_readlane(vi, 0)), s1 = __builtin_bit_cast(float, __builtin_amdgcn_readlane(vi, 16));
    const float s2 = __builtin_bit_cast(float, __builtin_amdgcn_readlane(vi, 32)), s3 = __builtin_bit_cast(float, __builtin_amdgcn_readlane(vi, 48));
    return (s0 + s1) + (s2 + s3);
}
__device__ __forceinline__ float dot2_bf16(unsigned w, unsigned x, float acc) { return __builtin_amdgcn_fdot2_f32_bf16(__builtin_bit_cast(bf16x2_t, w), __builtin_bit_cast(bf16x2_t, x), acc, false); }
__device__ __forceinline__ float gelu_erf(float v) {
    const float av = fabsf(v), t = __builtin_amdgcn_rcpf(av * 0.2316418882f + 1.0f);
    float q = t * 0.5307027145f + (-0.7265760135f); q = q * t + 0.7107068705f; q = q * t + (-0.142248368f); q = q * t + 0.127414796f; q = q * t;
    const float e = __builtin_amdgcn_exp2f((v * v) * (-0.72134752044f));
    const float m = v * (q * e);
    return v < 0.f ? m : v - m;
}
#define XB_TMO      128
#define XB_XCNT(j)  (256  + 64 * (j))
#define XB_XSUB(j)  (1280 + 64 * (j))
#define XB_XGEN(j)  (2304 + 64 * (j))
#define XB_TOP      3328
#define XB_TOPGEN   3392
#define XCD_BAR_WORDS 3456
#define XB_SPIN_CAP (1u << 18)

__device__ __forceinline__ unsigned xb_ld(unsigned* p)              { return __hip_atomic_load(p, __ATOMIC_RELAXED, __HIP_MEMORY_SCOPE_AGENT); }
__device__ __forceinline__ unsigned xb_add(unsigned* p, unsigned v) { return __hip_atomic_fetch_add(p, v, __ATOMIC_RELAXED, __HIP_MEMORY_SCOPE_AGENT); }
__device__ __forceinline__ unsigned xb_xcc_id() { return (unsigned)__builtin_amdgcn_s_getreg((3 << 11) | 20) & 0xFu; }
#define XB_SPIN(cond, bar) do { unsigned _sp = 0; while (cond) { __builtin_amdgcn_s_sleep(1); \
    if ((++_sp & 255u) == 0u) { if (xb_ld(&(bar)[XB_TMO])) break; if (_sp > XB_SPIN_CAP) { atomicAdd(&(bar)[XB_TMO], 1u); break; } } } } while (0)

struct XcdBarrier {
    unsigned* bar; unsigned x;
    volatile LAS unsigned* st;
};

__device__ __forceinline__ XcdBarrier xcd_barrier_post(unsigned* bar, volatile LAS unsigned* st) {
    XcdBarrier b; b.bar = bar; b.x = xb_xcc_id(); b.st = st;
    if (threadIdx.x == 0) (void)xb_add(&bar[XB_XCNT(b.x)], 1u);
    return b;
}
__device__ __forceinline__ void xcd_barrier_complete(unsigned* bar, unsigned x, unsigned& nloc, unsigned& nx) {
    const unsigned G = gridDim.x * gridDim.y * gridDim.z;
    unsigned sum, cnt, mine, sp = 0u;
    for (;;) {
        sum = 0u; cnt = 0u; mine = 0u;
#pragma unroll
        for (unsigned j = 0; j < 16; ++j) { const unsigned c = xb_ld(&bar[XB_XCNT(j)]); sum += c; cnt += (c > 0u) ? 1u : 0u; mine = (j == x) ? c : mine; }
        if (sum == G) break;
        __builtin_amdgcn_s_sleep(1);
        if ((++sp & 255u) == 0u) { if (xb_ld(&bar[XB_TMO])) break; if (sp > XB_SPIN_CAP) { atomicAdd(&bar[XB_TMO], 1u); break; } }
    }
    nloc = mine > 0u ? mine : 1u; nx = cnt > 0u ? cnt : 1u;
}

__device__ __forceinline__ void xcd_barrier(const XcdBarrier& b) {
    asm volatile("s_waitcnt vmcnt(0)" ::: "memory");
    __syncthreads();
    if (threadIdx.x == 0) {
        unsigned* bar = b.bar; unsigned bx = b.x;
        asm volatile("" : "+s"(bar), "+s"(bx));
        __builtin_amdgcn_s_waitcnt(0);
        unsigned nloc = b.st[0], nx = b.st[1];
        if (nloc == 0u) { xcd_barrier_complete(bar, bx, nloc, nx); b.st[0] = nloc; b.st[1] = nx; }
        const unsigned old = xb_add(&bar[XB_XSUB(bx)], 1u);
        const unsigned gen = old / nloc;
        if (old + 1u == (gen + 1u) * nloc) {
            __builtin_amdgcn_fence(__ATOMIC_RELEASE, "agent");
            asm volatile("s_waitcnt vmcnt(0)" ::: "memory");
            const unsigned og = xb_add(&bar[XB_TOP], 1u);
            const unsigned tg = og / nx;
            if (og + 1u == (tg + 1u) * nx) xb_add(&bar[XB_TOPGEN], 1u);
            else XB_SPIN(xb_ld(&bar[XB_TOPGEN]) == tg, bar);
            __builtin_amdgcn_fence(__ATOMIC_ACQUIRE, "agent");
            xb_add(&bar[XB_XGEN(bx)], 1u);
            asm volatile("s_waitcnt vmcnt(0)" ::: "memory");
        } else {
            XB_SPIN(xb_ld(&bar[XB_XGEN(bx)]) == gen, bar);
            __builtin_amdgcn_fence(__ATOMIC_ACQUIRE, "agent");
            asm volatile("s_waitcnt vmcnt(0)" ::: "memory");
        }
    }
    __syncthreads();
}
struct Frame {
    LAS unsigned char* lds;
    int tid, lane, wave, vcu, G, gw, NGW;
    unsigned char* ws;
};
__device__ __forceinline__ int opaque_v(int v) { asm volatile("" : "+v"(v)); return v; }
__device__ __forceinline__ int phase_tid(int wave) { int lane; asm volatile("v_mbcnt_lo_u32_b32 %0, -1, 0\n\tv_mbcnt_hi_u32_b32 %0, -1, %0" : "=v"(lane)); return wave * 64 + lane; }
__device__ __forceinline__ Frame phase_frame(const Frame& F0) { Frame F = F0; F.tid = phase_tid(F0.wave); F.lane = F.tid & 63; return F; }
__device__ __forceinline__ float swap32(float v, int lane) { auto rr = __builtin_amdgcn_permlane32_swap(__float_as_uint(v), __float_as_uint(v), false, false); return __uint_as_float(lane < 32 ? rr[1] : rr[0]); }
__device__ __forceinline__ int row_cls(int row) { const int b = row / RB, i = row - b * RB; return i < CTX ? 2 : b; }

__device__ __forceinline__ void p0_transpose_item(const float* W, int K, int N, bf16_t* WT, const float* gain, LAS float* scr, int item, int lane) {
    const int nblk = N / 32, kb = item / nblk, nb = item % nblk, k0 = 64 * kb, n0 = 32 * nb;
#pragma unroll 8
    for (int i = 0; i < 32; ++i) { const int kk = 2 * i + (lane >> 5); float v = W[(size_t)(k0 + kk) * N + n0 + (lane & 31)]; if (gain) v *= gain[k0 + kk]; scr[kk * 33 + (lane & 31)] = v; }
    asm volatile("s_waitcnt lgkmcnt(0)" ::: "memory");
    const int c = lane & 7;
#pragma unroll
    for (int j = 0; j < 4; ++j) { const int n = (lane >> 3) + 8 * j; const LAS float* s = scr + (8 * c) * 33 + n;
        u32x4 o; o.x = pk2(s[0 * 33], s[1 * 33]); o.y = pk2(s[2 * 33], s[3 * 33]); o.z = pk2(s[4 * 33], s[5 * 33]); o.w = pk2(s[6 * 33], s[7 * 33]);
        *(u32x4*)(WT + (size_t)(n0 + n) * K + k0 + 8 * c) = o; }
    asm volatile("s_waitcnt lgkmcnt(0)" ::: "memory");
}
struct TrDesc { const float* W; const float* gain; bf16_t* WT; int K, N, items; };

__device__ __forceinline__ void p0_gemv_task(Frame& F, int task, const float* ada_w, const float* ada_b, float* mod) {
    LAS float* sv = (LAS float*)F.lds; LAS float* part = (LAS float*)(F.lds + 32768);
    const int l = task / 48, n0 = (task % 48) * 256;
    const float* Wp = ada_w + (size_t)l * DM * NMOD + n0 + F.lane * 4 + (size_t)(F.wave * 256) * NMOD;
    f32x4 a0 = {0, 0, 0, 0}, a1 = a0, a2 = a0;
    for (int k = 0; k < 256; k += 8) {
        f32x4 w[8];
#pragma unroll
        for (int u = 0; u < 8; ++u) w[u] = *(const f32x4*)(Wp + (size_t)(k + u) * NMOD);
#pragma unroll
        for (int u = 0; u < 8; ++u) { const int kk = F.wave * 256 + k + u; const float s0 = sv[kk], s1 = sv[2048 + kk], s2 = sv[4096 + kk];
            a0 += w[u] * s0; a1 += w[u] * s1; a2 += w[u] * s2; }
    }
    *(LAS f32x4*)(part + (F.wave * 3 + 0) * 256 + F.lane * 4) = a0;
    *(LAS f32x4*)(part + (F.wave * 3 + 1) * 256 + F.lane * 4) = a1;
    *(LAS f32x4*)(part + (F.wave * 3 + 2) * 256 + F.lane * 4) = a2;
    __syncthreads();
    for (int o = F.tid; o < 768; o += NTHREADS) { const int r = o >> 8, c = o & 255; float s = 0.f;
#pragma unroll
        for (int w = 0; w < 8; ++w) s += part[(w * 3 + r) * 256 + c];
        mod[(size_t)(l * 3 + r) * NMOD + n0 + c] = s + ada_b[(size_t)l * NMOD + n0 + c]; }
    __syncthreads();
}

__device__ __forceinline__ void p0_prologue(Frame& F, const float* const* in) {
    unsigned char* ws = F.ws;
    {
        LAS float* sv = (LAS float*)F.lds;
        for (int i = F.tid; i < 3 * DM; i += NTHREADS) { const int r = i / DM, k = i - r * DM; const float x = (r < 2) ? in[1][r * DM + k] : in[3][k]; sv[i] = x / (1.f + __expf(-x)); }
        __syncthreads();
        for (int task = F.vcu; task < 192; task += F.G) p0_gemv_task(F, task, in[4], in[5], (float*)(ws + WS_MOD));
        __syncthreads();
    }
    {
        float* xw = (float*)(ws + WS_XW);
        for (int row = F.gw; row < MROWS; row += F.NGW) { const int b = row / RB, i = row - b * RB;
            const float* src = (i < CTX) ? in[2] + (size_t)(b * CTX + i) * DM : in[0] + (size_t)(b * SEQ + i - CTX) * DM;
            const f32x4* s4 = (const f32x4*)src + F.lane; f32x4* d4 = (f32x4*)(xw + (size_t)row * DM) + F.lane;
#pragma unroll
            for (int j = 0; j < 8; ++j) d4[64 * j] = s4[64 * j]; }
    }
    {
        float* sm = (float*)(ws + WS_SMALL); const int g = F.vcu * NTHREADS + F.tid;
        if (g < 8192) { sm[SM_N1G + g] = in[6][g]; sm[SM_N2G + g] = in[7][g]; }
        if (g < 384) { sm[SM_AQG + g] = in[13][g]; sm[SM_AKG + g] = in[14][g]; }
        if (g < 6144) sm[SM_CW + g] = in[15][g];
        if (g < 2048) sm[SM_CB + g] = in[16][g];
        if (g < 256) { sm[SM_CQG + g] = in[19][g]; sm[SM_CKG + g] = in[20][g]; }
    }
    {
        float* rc = (float*)(ws + WS_ROPE); float* ra = rc + 64 * 32 * 2;
        const int g = F.vcu * NTHREADS + F.tid;
        if (g < 64 * 32) { const int pos = g >> 5, f = g & 31; const float fr = exp2f(-(float)f * (13.287712379549449f / 32.f)); const float ang = (float)pos * fr;
            rc[2 * g] = cosf(ang); rc[2 * g + 1] = sinf(ang); }
        else if (g < 64 * 32 + 64 * 16) { const int e = g - 64 * 32, pos = e >> 4, f = e & 15; const float fr = exp2f(-(float)f * (13.287712379549449f / 16.f)); const float ang = (float)pos * fr;
            ra[2 * e] = cosf(ang); ra[2 * e + 1] = sinf(ang); }
    }
    {
        LAS float* scr = (LAS float*)(F.lds + F.wave * 16384);
        TrDesc d[16]; int nd = 0;
#pragma unroll
        for (int i = 0; i < 2; ++i) {
            d[nd++] = TrDesc{in[8] + (size_t)i * DM * 3904, nullptr, (bf16_t*)(ws + WS_WIN) + (size_t)i * 4096 * DM, DM, 3904, 32 * 122};
            d[nd++] = TrDesc{in[11] + (size_t)i * 512 * 1536, in[9] + i * 512, (bf16_t*)(ws + WS_WUQ) + (size_t)i * 1536 * 512, 512, 1536, 8 * 48};
            d[nd++] = TrDesc{in[12] + (size_t)i * 256 * 2048, in[10] + i * 256, (bf16_t*)(ws + WS_WUKV) + (size_t)i * 2048 * 256, 256, 2048, 4 * 64};
            d[nd++] = TrDesc{in[17] + (size_t)i * DM * DM, nullptr, (bf16_t*)(ws + WS_WEO) + (size_t)i * DM * DM, DM, DM, 32 * 64};
            d[nd++] = TrDesc{in[18] + (size_t)i * DM * 3072, nullptr, (bf16_t*)(ws + WS_WQKV) + (size_t)i * 3072 * DM, DM, 3072, 32 * 96};
            d[nd++] = TrDesc{in[21] + (size_t)i * DM * DM, nullptr, (bf16_t*)(ws + WS_WCO) + (size_t)i * DM * DM, DM, DM, 32 * 64};
        }
#pragma unroll
        for (int l = 0; l < 4; ++l) d[nd++] = TrDesc{in[22] + (size_t)l * DM * DM, nullptr, (bf16_t*)(ws + WS_WPQ) + (size_t)l * DM * DM, DM, DM, 32 * 64};
#pragma unroll
        for (int m = 0; m < 16; ++m) {
            for (int it = F.gw; it < d[m].items; it += F.NGW) p0_transpose_item(d[m].W, d[m].K, d[m].N, d[m].WT, d[m].gain, scr, it, F.lane);
        }
        for (int i = F.gw * 64 + F.lane; i < 2 * 192 * DM / 8; i += F.NGW * 64) { const int li = i / (192 * DM / 8), r = i % (192 * DM / 8);
            *(u32x4*)((bf16_t*)(ws + WS_WIN) + (size_t)li * 4096 * DM + (size_t)3904 * DM + (size_t)r * 8) = (u32x4){0u, 0u, 0u, 0u}; }
    }
    {
        const size_t n_sk = (size_t)4 * 16 * 128 * 128 / 8;
        const size_t gt = (size_t)F.vcu * NTHREADS + F.tid, GT = (size_t)F.G * NTHREADS;
        for (size_t j = gt; j < n_sk; j += GT) {
            const f32x4 a = *(const f32x4*)(in[23] + j * 8), b = *(const f32x4*)(in[23] + j * 8 + 4);
            u32x4 o; o.x = pk2(a.x, a.y); o.y = pk2(a.z, a.w); o.z = pk2(b.x, b.y); o.w = pk2(b.z, b.w);
            *(u32x4*)((bf16_t*)(ws + WS_SUBK) + j * 8) = o;
        }
    }
    {
        for (int r = F.gw; r < 2 * 4 * NEXP; r += F.NGW) {
            const int tab = r / (4 * NEXP), rr = r - tab * (4 * NEXP);
            const float* src = (tab ? in[25] : in[24]) + (size_t)rr * DM + F.lane * 16;
            f32x4 v[8];
#pragma unroll
            for (int j = 0; j < 2; ++j)
#pragma unroll
                for (int q = 0; q < 4; ++q) v[j * 4 + q] = *(const f32x4*)(src + j * 1024 + q * 4);
            float am = 0.f;
#pragma unroll
            for (int q = 0; q < 8; ++q) am = fmaxf(fmaxf(am, fmaxf(fabsf(v[q].x), fabsf(v[q].y))), fmaxf(fabsf(v[q].z), fabsf(v[q].w)));
#pragma unroll
            for (int o = 1; o < 64; o <<= 1) am = fmaxf(am, __shfl_xor(am, o));
            am = fmaxf(am, 1e-30f);
            const float sc = 7.5f / am;
            f32x16 a, b;
#pragma unroll
            for (int q = 0; q < 8; ++q) { const f32x4 x = v[q] * sc; a[2 * q] = x.x; b[2 * q] = x.y; a[2 * q + 1] = x.z; b[2 * q + 1] = x.w; }
            const u32x6 w = __builtin_amdgcn_cvt_scalef32_2xpk16_fp6_f32(a, b, 1.0f);
            unsigned char* dst = ws + (tab ? WS_VT : WS_U) + (size_t)rr * ROWB;
            *(u32x4*)(dst + F.lane * 16) = (u32x4){w[0], w[1], w[2], w[3]};
            *(u32x2*)(dst + 1024 + F.lane * 8) = (u32x2){w[4], w[5]};
            if (F.lane == 0) ((float*)(ws + (tab ? WS_VSC : WS_USC)))[rr] = am * (1.0f / 7.5f);
        }
    }
}

__device__ __forceinline__ void norm_phase(const Frame& F0, const float* xw, const float* g, const float* modl  , int off_sh, int off_sc, bf16_t* H, bool lat_only) {
    const Frame F = phase_frame(F0);
    for (int row = F.gw; row < MROWS; row += F.NGW) {
        const int cls = row_cls(row);
        if (lat_only && cls == 2) continue;
        const f32x4* x4 = (const f32x4*)(xw + (size_t)row * DM) + F.lane;
        f32x4 v[8]; float ss = 0.f;
#pragma unroll
        for (int j = 0; j < 8; ++j) { v[j] = x4[64 * j]; ss += (v[j].x * v[j].x + v[j].y * v[j].y) + (v[j].z * v[j].z + v[j].w * v[j].w); }
        const float rstd = 1.0f / sqrtf(wave_sum_dpp(ss) * (1.f / DM) + EPS);
        const f32x4* g4 = (const f32x4*)g + F.lane; const f32x4* sc4 = (const f32x4*)(modl + (size_t)cls * NMOD + off_sc) + F.lane; const f32x4* sh4 = (const f32x4*)(modl + (size_t)cls * NMOD + off_sh) + F.lane;
        u32x2* o2 = (u32x2*)(H + (size_t)row * DM) + F.lane;
#pragma unroll
        for (int j = 0; j < 8; ++j) { const f32x4 gg = g4[64 * j], sc = sc4[64 * j], sh = sh4[64 * j];
            const f32x4 y = (v[j] * rstd) * gg * (sc + 1.0f) + sh;
            u32x2 o; o.x = pk2(y.x, y.y); o.y = pk2(y.z, y.w); o2[64 * j] = o; }
    }
}

__device__ __forceinline__ void prep_odd_phase(const Frame& F0, const bf16_t* P, const float* qg, const float* kg, const float* rope_c, bf16_t* Q, bf16_t* Kb) {
    const Frame F = phase_frame(F0);
    const float g_q1 = qg[F.lane], g_q2 = qg[F.lane + 64], g_k1 = kg[F.lane], g_k2 = kg[F.lane + 64];
    for (int row = F.gw; row < MROWS; row += F.NGW) {
        const int b = row / RB, i = row - b * RB; const bool lat = i >= CTX; const int t = i - CTX;
        float cs = 1.f, sn = 0.f;
        if (lat) { const int pos = (F.lane < 32) ? (t >> 6) : (t & 63); const float* e = rope_c + ((pos << 5) + (F.lane & 31)) * 2; cs = e[0]; sn = e[1]; }
        const bf16_t* pr = P + (size_t)row * 3072;
#pragma unroll 4
        for (int hh = 0; hh < 20; ++hh) {
            const bool isq = hh < 16; const bf16_t* src = pr + hh * 128;
            const float x1 = bf2f(src[F.lane]), x2 = bf2f(src[F.lane + 64]);
            const float rstd = 1.0f / sqrtf(wave_sum_dpp(x1 * x1 + x2 * x2) * (1.f / 128.f) + EPS);
            const float y1 = x1 * rstd * (isq ? g_q1 : g_k1), y2 = x2 * rstd * (isq ? g_q2 : g_k2);
            const float o1 = y1 * cs - y2 * sn, o2 = y2 * cs + y1 * sn;
            bf16_t* dst = isq ? (Q + (size_t)row * 2048 + hh * 128) : (Kb + (size_t)row * 512 + (hh - 16) * 128);
            dst[F.lane] = (bf16_t)f2bf(o1); dst[F.lane + 64] = (bf16_t)f2bf(o2);
        }
    }
}

__device__ __forceinline__ void prep_even_phase(const Frame& F0, const bf16_t* P, const bf16_t* QR, const bf16_t* KVR, const float* qg, const float* kg, const float* rope_a, bf16_t* Q, bf16_t* Kb, bf16_t* Vb) {
    const Frame F = phase_frame(F0);
    const float gq0 = qg[F.lane], gq1 = qg[F.lane + 64], gq2 = qg[F.lane + 128], gk0 = kg[F.lane], gk1 = kg[F.lane + 64], gk2 = kg[F.lane + 128];
    for (int row = F.gw; row < MROWS; row += F.NGW) {
        const int b = row / RB, i = row - b * RB; const bool lat = i >= CTX; const int t = i - CTX;
        float cs = 1.f, sn = 0.f;
        if (lat) { const int j = F.lane & 31; const int pos = (j < 16) ? (t >> 6) : (t & 63); const float* e = rope_a + ((pos << 4) + (j & 15)) * 2; cs = e[0]; sn = e[1]; }
        const float sgn = (F.lane < 32) ? -1.f : 1.f;
        const bf16_t* pr = P + (size_t)row * 4096;
        float ssq = 0.f, sskv = 0.f;
        { const u32x4 w = *(const u32x4*)(pr + F.lane * 8); const unsigned ww[4] = {w.x, w.y, w.z, w.w};
#pragma unroll
          for (int q = 0; q < 4; ++q) { const float a = bf_lo(ww[q]), c = bf_hi(ww[q]); ssq += a * a + c * c; } }
        { const u32x2 w = *(const u32x2*)(pr + 512 + F.lane * 4); const float a = bf_lo(w.x), c = bf_hi(w.x), d = bf_lo(w.y), e = bf_hi(w.y); sskv = (a * a + c * c) + (d * d + e * e); }
        const float rstd_q = 1.0f / sqrtf(wave_sum_dpp(ssq) * (1.f / 512.f) + EPS), rstd_kv = 1.0f / sqrtf(wave_sum_dpp(sskv) * (1.f / 256.f) + EPS);
        const float kr = bf2f(pr[768 + F.lane]);
        const bf16_t* qr = QR + (size_t)row * 1536; const bf16_t* kvr = KVR + (size_t)row * 2048;
        bf16_t* qo = Q + (size_t)row * 1536; bf16_t* ko = Kb + (size_t)row * 1536; bf16_t* vo = Vb + (size_t)row * 1024;
#pragma unroll 2
        for (int h = 0; h < 8; ++h) {
            {
                const float x0 = bf2f(qr[h * 192 + F.lane]) * rstd_q, x1 = bf2f(qr[h * 192 + 64 + F.lane]) * rstd_q, x2 = bf2f(qr[h * 192 + 128 + F.lane]) * rstd_q;
                const float r2 = 1.0f / sqrtf(wave_sum_dpp(x0 * x0 + x1 * x1 + x2 * x2) * (1.f / 192.f) + EPS);
                const float y0 = x0 * r2 * gq0, y1 = x1 * r2 * gq1, y2 = x2 * r2 * gq2;
                const float yp = swap32(y2, F.lane);
                const float o2 = y2 * cs + sgn * yp * sn;
                qo[h * 192 + F.lane] = (bf16_t)f2bf(y0); qo[h * 192 + 64 + F.lane] = (bf16_t)f2bf(y1); qo[h * 192 + 128 + F.lane] = (bf16_t)f2bf(o2);
            }
            {
                const float x0 = bf2f(kvr[h * 256 + F.lane]) * rstd_kv, x1 = bf2f(kvr[h * 256 + 64 + F.lane]) * rstd_kv;
                const float r2 = 1.0f / sqrtf(wave_sum_dpp(x0 * x0 + x1 * x1 + kr * kr) * (1.f / 192.f) + EPS);
                const float y0 = x0 * r2 * gk0, y1 = x1 * r2 * gk1, y2 = kr * r2 * gk2;
                const float yp = swap32(y2, F.lane);
                const float o2 = y2 * cs + sgn * yp * sn;
                ko[h * 192 + F.lane] = (bf16_t)f2bf(y0); ko[h * 192 + 64 + F.lane] = (bf16_t)f2bf(y1); ko[h * 192 + 128 + F.lane] = (bf16_t)f2bf(o2);
                const float v0 = bf2f(kvr[h * 256 + 128 + F.lane]) * rstd_kv, v1 = bf2f(kvr[h * 256 + 192 + F.lane]) * rstd_kv;
                vo[h * 128 + F.lane] = (bf16_t)f2bf(v0); vo[h * 128 + 64 + F.lane] = (bf16_t)f2bf(v1);
            }
        }
    }
}

__device__ __forceinline__ void conv_phase(const Frame& F0, const bf16_t* P, const float* cw  , const float* cb  , bf16_t* CAT) {
    const Frame F = phase_frame(F0);
    const int gt = F.vcu * NTHREADS + F.tid, GT = F.G * NTHREADS;
    for (int it = gt; it < MROWS * 128; it += GT) {
        const int row = it >> 7, c0 = (it & 127) * 8; const int b = row / RB, i = row - b * RB;
        const bool first = (i == 0) || (i == CTX), last = (i == CTX - 1) || (i == RB - 1);
        const bf16_t* pr = P + (size_t)row * 4096 + 832 + c0;
        const u32x4 bg = *(const u32x4*)pr, cg = *(const u32x4*)(pr + 1024), hz = *(const u32x4*)(pr + 2048);
        u32x4 cgm = {0u, 0u, 0u, 0u}, hzm = cgm, cgp = cgm, hzp = cgm;
        if (!first) { cgm = *(const u32x4*)(pr - 4096 + 1024); hzm = *(const u32x4*)(pr - 4096 + 2048); }
        if (!last) { cgp = *(const u32x4*)(pr + 4096 + 1024); hzp = *(const u32x4*)(pr + 4096 + 2048); }
        const unsigned bgw[4] = {bg.x, bg.y, bg.z, bg.w}, cgw[4] = {cg.x, cg.y, cg.z, cg.w}, hzw[4] = {hz.x, hz.y, hz.z, hz.w};
        const unsigned cmw[4] = {cgm.x, cgm.y, cgm.z, cgm.w}, hmw[4] = {hzm.x, hzm.y, hzm.z, hzm.w}, cpw[4] = {cgp.x, cgp.y, cgp.z, cgp.w}, hpw[4] = {hzp.x, hzp.y, hzp.z, hzp.w};
        unsigned ow[4];
#pragma unroll
        for (int q = 0; q < 4; ++q) {
            const int c = c0 + 2 * q;
            const float u0a = bf_lo(cgw[q]) * bf_lo(hzw[q]), u0b = bf_hi(cgw[q]) * bf_hi(hzw[q]);
            const float uma = bf_lo(cmw[q]) * bf_lo(hmw[q]), umb = bf_hi(cmw[q]) * bf_hi(hmw[q]);
            const float upa = bf_lo(cpw[q]) * bf_lo(hpw[q]), upb = bf_hi(cpw[q]) * bf_hi(hpw[q]);
            const float ra = bf_lo(bgw[q]) * (uma * cw[c] + u0a * cw[1024 + c] + upa * cw[2048 + c] + cb[c]);
            const float rb = bf_hi(bgw[q]) * (umb * cw[c + 1] + u0b * cw[1024 + c + 1] + upb * cw[2048 + c + 1] + cb[c + 1]);
            ow[q] = pk2(ra, rb);
        }
        *(u32x4*)(CAT + (size_t)row * DM + 1024 + c0) = (u32x4){ow[0], ow[1], ow[2], ow[3]};
    }
}
__device__ __forceinline__ void attn_even_phase(const Frame& F0, const bf16_t* Q, const bf16_t* Kb, const bf16_t* Vb, bf16_t* CAT) {
    const Frame F = phase_frame(F0);
    for (int u = F.vcu; u < 272; u += F.G) {
        int b, h, qt, nk;
        if (u < 256) { b = u >> 7; h = (u >> 4) & 7; qt = 1 + (u & 15); nk = RB; } else { const int v = u - 256; b = v >> 3; h = v & 7; qt = 0; nk = CTX; }
        const size_t r0 = (size_t)b * RB;
        att::attn_body1<192, 1536, 1536, 1024, 2048>(Q + (r0 + qt * 256) * 1536 + h * 192, Kb + r0 * 1536 + h * 192, Vb + r0 * 1024 + h * 128, CAT + (r0 + qt * 256) * 2048 + h * 128, nk, (char*)F.lds, phase_tid(F.wave));
    }
}
__device__ __forceinline__ void attn_odd_phase(const Frame& F0, const bf16_t* Q, const bf16_t* Kb, const bf16_t* P, bf16_t* CAT, bool lat_only) {
    const Frame F = phase_frame(F0);
    const int nunits = lat_only ? 512 : 544;
    for (int u = F.vcu; u < nunits; u += F.G) {
        int b, hq, qt, nk;
        if (u < 512) { b = u >> 8; hq = (u >> 4) & 15; qt = 1 + (u & 15); nk = RB; } else { const int v = u - 512; b = v >> 4; hq = v & 15; qt = 0; nk = CTX; }
        const int kvh = hq >> 2; const size_t r0 = (size_t)b * RB;
        att::attn_body<128, 2048, 512, 3072, 2048, 2>(Q + (r0 + qt * 256) * 2048 + hq * 128, Kb + r0 * 512 + kvh * 128, P + r0 * 3072 + 2560 + kvh * 128, CAT + (r0 + qt * 256) * 2048 + hq * 128, nk, (char*)F.lds, phase_tid(F.wave));
    }
}

__device__ __forceinline__ int crow32(int r, int hi) { return (r & 3) + 8 * (r >> 2) + 4 * hi; }
__device__ __forceinline__ int fkey(int b) { return b ^ ((b >> 31) & 0x7fffffff); }
#define TK_CE(x, y) do { const int hi_ = max((x), (y)), lo_ = min((x), (y)); (x) = hi_; (y) = lo_; } while (0)
template <int N> __device__ __forceinline__ void tk_sort(int* v) {
#pragma unroll
    for (int k = 2; k <= N; k <<= 1)
#pragma unroll
        for (int j = k >> 1; j > 0; j >>= 1)
#pragma unroll
            for (int i = 0; i < N; ++i) { const int l = i ^ j; if (l > i) { if ((i & k) == 0) TK_CE(v[i], v[l]); else TK_CE(v[l], v[i]); } }
}
__device__ __forceinline__ void tk_merge16(int* a, const int* b) {
#pragma unroll
    for (int i = 0; i < 16; ++i) a[i] = max(a[i], b[15 - i]);
#pragma unroll
    for (int j = 8; j > 0; j >>= 1)
#pragma unroll
        for (int i = 0; i < 16; ++i) { const int l = i ^ j; if (l > i) TK_CE(a[i], a[l]); }
}
__device__ __forceinline__ void tk_merge_partner(int* a) {
    int lo[16], hi[16];
#pragma unroll
    for (int i = 0; i < 16; ++i) { auto rr = __builtin_amdgcn_permlane32_swap((unsigned)a[i], (unsigned)a[i], false, false); lo[i] = (int)rr[0]; hi[i] = (int)rr[1]; }
    tk_merge16(lo, hi);
#pragma unroll
    for (int i = 0; i < 16; ++i) a[i] = lo[i];
}
__device__ __forceinline__ void peer_topk_phase(const Frame& F0, const bf16_t* PQ, const bf16_t* subk  , int* IDX, float* GATE, bool lat_only) {
    const Frame F = phase_frame(F0);
    const int h = F.vcu & 7, jw = (F.vcu >> 3) * NWAVES + F.wave, nwh = (F.G >> 3) * NWAVES;
    {
        const bf16_t* src = subk + (size_t)h * 2 * 128 * 128;
        for (int c = F.tid; c < 4096; c += NTHREADS) { const int row = c >> 4, ch = c & 15;
            *(LAS u32x4*)(F.lds + row * 256 + ((ch ^ (row & 15)) << 4)) = *(const u32x4*)(src + (size_t)row * 128 + ch * 8); }
        __syncthreads();
    }
    const int ntg = lat_only ? 256 : MROWS / 32;
    for (int t = jw; t < ntg; t += nwh) {
        int lane_ = F.lane; asm volatile("" : "+v"(lane_));
        const int r32 = lane_ & 31, hi = lane_ >> 5;
        int tg = t; if (lat_only) tg += 8 + (tg >= 128 ? 8 : 0);
        const int token = tg * 32 + r32;
        int top[2][16];
        const int kk = (((r32 & 14) | (hi ^ (r32 & 1))) << 4);
#pragma unroll
        for (int p = 0; p < 2; ++p) {
            bf16x8 bq[8];
            const bf16_t* qp = PQ + (size_t)token * DM + h * 256 + p * 128 + hi * 8;
#pragma unroll
            for (int ks = 0; ks < 8; ++ks) bq[ks] = *(const bf16x8*)(qp + ks * 16);
            int s[4][16];
#pragma unroll
            for (int nb = 0; nb < 4; ++nb) {
                f32x16 acc = {};
                const LAS unsigned char* kp = F.lds + (p * 128 + nb * 32 + r32) * 256;
#pragma unroll
                for (int ks = 0; ks < 8; ++ks) { const bf16x8 a = *(const LAS bf16x8*)(kp + (kk ^ (ks << 5))); acc = __builtin_amdgcn_mfma_f32_32x32x16_bf16(a, bq[ks], acc, 0, 0, 0); }
#pragma unroll
                for (int r = 0; r < 16; ++r) { const int key = nb * 32 + crow32(r, hi); s[nb][r] = fkey((int)((__float_as_uint(acc[r]) & ~127u) | (unsigned)(127 - key))); }
                tk_sort<16>(s[nb]);
            }
            tk_merge16(s[0], s[1]); tk_merge16(s[2], s[3]); tk_merge16(s[0], s[2]);
            tk_merge_partner(s[0]);
#pragma unroll
            for (int j = 0; j < 16; ++j) top[p][j] = s[0][j];
        }
        int cand[32];
        unsigned long long kaLo = 0ull, kaHi = 0ull, kbLo = 0ull, kbHi = 0ull;
        {
            float fb[16]; const float fa0 = __uint_as_float((unsigned)fkey(top[0][0]) & ~127u), fb0 = __uint_as_float((unsigned)fkey(top[1][0]) & ~127u);
#pragma unroll
            for (int r = 0; r < 16; ++r) { const int ba = fkey(top[0][r]), bb = fkey(top[1][r]); fb[r] = __uint_as_float((unsigned)bb & ~127u) - fb0;
                const unsigned long long xa = (unsigned long long)(unsigned)(127 - (ba & 127)) << (8 * (r & 7)), xb = (unsigned long long)(unsigned)(127 - (bb & 127)) << (8 * (r & 7));
                if (r < 8) { kaLo |= xa; kbLo |= xb; } else { kaHi |= xa; kbHi |= xb; } }
            float fa[8];
#pragma unroll
            for (int i = 0; i < 8; ++i) { const int ka = hi ? top[0][2 * i + 1] : top[0][2 * i]; fa[i] = __uint_as_float((unsigned)fkey(ka) & ~127u) - fa0; }
            const int hid = 255 - (hi << 4);
            int n = 0;
#pragma unroll
            for (int i = 0; i < 8; ++i)
#pragma unroll
                for (int b = 0; b < 16; ++b) if ((2 * i + 1) * (b + 1) <= 16) {
                    const float sum = fa[i] + fb[b];
                    cand[n++] = fkey((int)((__float_as_uint(sum) & ~255u) | (unsigned)(hid - (32 * i + b))));
                }
#pragma unroll
            for (; n < 32; ++n) cand[n] = (int)0x80000000;
        }
        tk_sort<16>(cand); tk_sort<16>(cand + 16); tk_merge16(cand, cand + 16);
        tk_merge_partner(cand);
        float ev[16]; float esum = 0.f;
#pragma unroll
        for (int j = 0; j < 16; ++j) { ev[j] = __expf(__uint_as_float((unsigned)fkey(cand[j]) & ~255u)); esum += ev[j]; }
        const float rs = 1.0f / esum;
        int oi[8]; float og[8];
#pragma unroll
        for (int j = 0; j < 8; ++j) { const int w = hi ? cand[8 + j] : cand[j]; const float e = hi ? ev[8 + j] : ev[j];
            const int id8 = 255 - (fkey(w) & 255), ra = id8 >> 4, rb = id8 & 15;
            const unsigned long long wa = (ra & 8) ? kaHi : kaLo, wb = (rb & 8) ? kbHi : kbLo;
            const int ka = (int)(wa >> (8 * (ra & 7))) & 127, kb = (int)(wb >> (8 * (rb & 7))) & 127;
            oi[j] = ka * 128 + kb; og[j] = e * rs; }
        int* ip = IDX + (size_t)token * 128 + h * 16 + hi * 8; float* gp = GATE + (size_t)token * 128 + h * 16 + hi * 8;
        *(int4*)ip = make_int4(oi[0], oi[1], oi[2], oi[3]); *(int4*)(ip + 4) = make_int4(oi[4], oi[5], oi[6], oi[7]);
        *(f32x4*)gp = (f32x4){og[0], og[1], og[2], og[3]}; *(f32x4*)(gp + 4) = (f32x4){og[4], og[5], og[6], og[7]};
    }
}

__device__ __forceinline__ void peer_expert_phase(const Frame& F0, const bf16_t* H2, const int* IDX, const float* GATE, const unsigned char* U, size_t v_minus_u_bytes, const float* USC, const float* VSC,
                                                  const float* g2  , float* XW, float* OUT) {
    const Frame F = phase_frame(F0);
    LAS float* red = (LAS float*)F.lds;
    const unsigned voff_tab = (unsigned)v_minus_u_bytes;
    const __amdgpu_buffer_rsrc_t rs = __builtin_amdgcn_make_buffer_rsrc((void*)U, 0, (int)(voff_tab + (unsigned)NEXP * ROWB), 0x00020000);
    const int lane = F.lane; const int voff = lane * 16, voff2 = 1024 + lane * 8;
#define PX_SB() __builtin_amdgcn_sched_barrier(0)
#define PX_LOAD(buf, s, ivv) do { constexpr int e0_ = ((s) & 3) * 4; const unsigned tb_ = ((s) >= 4) ? voff_tab : 0u; \
        _Pragma("unroll") for (int ee_ = 0; ee_ < 4; ++ee_) { const unsigned o_ = (unsigned)__builtin_amdgcn_readlane(ivv, e0_ + ee_) * (unsigned)ROWB + tb_; \
            buf##h[ee_] = __builtin_amdgcn_raw_buffer_load_b128(rs, voff, o_, 0); buf##l[ee_] = __builtin_amdgcn_raw_buffer_load_b64(rs, voff2, o_, 0); } } while (0)
#define PX_DECODE(buf, ee_, dep) u32x6 w6_ = {buf##h[ee_].x, buf##h[ee_].y, buf##h[ee_].z, buf##h[ee_].w, buf##l[ee_].x, buf##l[ee_].y}; \
        asm volatile("" : "+v"(w6_) : "v"(dep));     \
        const f32x32 r_ = __builtin_amdgcn_cvt_scalef32_pk32_f32_fp6(w6_, 1.0f);
#define PX_COMP_U(buf, s) do { constexpr int e0_ = ((s) & 3) * 4; \
            _Pragma("unroll") for (int ee_ = 0; ee_ < 4; ++ee_) { PX_DECODE(buf, ee_, sv) \
                const f32x32 p_ = r_ * xf; float a0_ = 0.f, a1_ = 0.f; \
                _Pragma("unroll") for (int k_ = 0; k_ < 32; k_ += 2) { a0_ += p_[k_]; a1_ += p_[k_ + 1]; } \
                const float t_ = wave_sum_dpp(a0_ + a1_); sv = (lane == e0_ + ee_) ? t_ : sv; } } while (0)
#define PX_COMP_V(buf, s) do { constexpr int e0_ = ((s) & 3) * 4; \
            _Pragma("unroll") for (int ee_ = 0; ee_ < 4; ++ee_) { const float wg_ = __uint_as_float(__builtin_amdgcn_readlane(__float_as_uint(wv), e0_ + ee_)); \
                PX_DECODE(buf, ee_, acc) \
                acc += r_ * wg_; } } while (0)
#define PX_FETCH_TOKEN(r, XP, IV, GV) do { const u32x4* xp_ = (const u32x4*)(H2 + (size_t)(r) * DM + lane * 16); XP[0] = xp_[0]; XP[1] = xp_[1]; XP[2] = xp_[128]; XP[3] = xp_[129]; \
        IV = 0; GV = 0.f; if (lane < 16) { IV = IDX[(size_t)(r) * 128 + F.wave * 16 + lane]; GV = GATE[(size_t)(r) * 128 + F.wave * 16 + lane]; } } while (0)
    const bool skip_ctx = (OUT != nullptr);
    int row = F.vcu; if (skip_ctx && row < MROWS && row_cls(row) == 2) row += F.G;
    u32x4 xp[4]; int iv; float gv;
    u32x4 bAh[4], bBh[4]; u32x2 bAl[4], bBl[4];
    if (row < MROWS) { PX_FETCH_TOKEN(row, xp, iv, gv); PX_LOAD(bA, 0, iv); }
    int par = 0;
    while (row < MROWS) {
        int nrow = row + F.G; if (skip_ctx && nrow < MROWS && row_cls(nrow) == 2) nrow += F.G;
        f32x32 xf;
#pragma unroll
        for (int q = 0; q < 4; ++q) { const unsigned ww[4] = {xp[q].x, xp[q].y, xp[q].z, xp[q].w};
#pragma unroll
            for (int k = 0; k < 4; ++k) { xf[q * 8 + 2 * k] = bf_lo(ww[k]); xf[q * 8 + 2 * k + 1] = bf_hi(ww[k]); } }
        float usc = 0.f, vsc = 0.f;
        if (lane < 16) { usc = USC[iv]; vsc = VSC[iv]; }
        u32x4 xpn[4]; int ivn = 0; float gvn = 0.f;
        if (nrow < MROWS) PX_FETCH_TOKEN(nrow, xpn, ivn, gvn);
        float sv = 0.f, wv = 0.f;
        PX_LOAD(bB, 1, iv); PX_SB(); PX_COMP_U(bA, 0); PX_SB();
        PX_LOAD(bA, 2, iv); PX_SB(); PX_COMP_U(bB, 1); PX_SB();
        PX_LOAD(bB, 3, iv); PX_SB(); PX_COMP_U(bA, 2); PX_SB();
        PX_LOAD(bA, 4, iv); PX_SB(); PX_COMP_U(bB, 3); PX_SB();
        wv = gelu_erf(sv * usc) * gv * vsc;
        f32x32 acc = {};
        PX_LOAD(bB, 5, iv); PX_SB(); PX_COMP_V(bA, 4); PX_SB();
        PX_LOAD(bA, 6, iv); PX_SB(); PX_COMP_V(bB, 5); PX_SB();
        PX_LOAD(bB, 7, iv); PX_SB(); PX_COMP_V(bA, 6); PX_SB();
        if (nrow < MROWS) PX_LOAD(bA, 0, ivn);
        PX_SB(); PX_COMP_V(bB, 7); PX_SB();
        LAS float* rb = red + par * (NWAVES * DM);
#pragma unroll
        for (int j = 0; j < 2; ++j)
#pragma unroll
            for (int q = 0; q < 4; ++q) *(LAS f32x4*)(rb + F.wave * DM + j * 1024 + lane * 16 + q * 4) = (f32x4){acc[j * 16 + q * 4], acc[j * 16 + q * 4 + 1], acc[j * 16 + q * 4 + 2], acc[j * 16 + q * 4 + 3]};
        __syncthreads();
        {
            f32x4 sm = {0.f, 0.f, 0.f, 0.f};
#pragma unroll
            for (int w = 0; w < 8; ++w) sm += *(const LAS f32x4*)(rb + w * DM + F.tid * 4);
            const int cls = row_cls(row);
            const f32x4 g = *(const f32x4*)(g2 + (size_t)cls * NMOD + F.tid * 4);
            f32x4* xq = (f32x4*)(XW + (size_t)row * DM) + F.tid;
            const f32x4 xn = *xq + g * sm;
            *xq = xn;
            if (OUT) { const int b = row / RB, i = row - b * RB; if (i >= CTX) *((f32x4*)(OUT + ((size_t)b * SEQ + (i - CTX)) * DM) + F.tid) = xn; }
        }
        par ^= 1; row = nrow;
#pragma unroll
        for (int q = 0; q < 4; ++q) xp[q] = xpn[q];
        iv = ivn; gv = gvn;
    }
#undef PX_LOAD
#undef PX_COMP_U
#undef PX_COMP_V
#undef PX_SB
#undef PX_FETCH_TOKEN
}
#ifndef N_LAUNCHES
#define N_LAUNCHES 1
#endif
struct Args { const float* in[26]; float* out; unsigned char* ws; int ph_lo, ph_hi; };
constexpr int NPHASES = 39;
__global__ void __launch_bounds__(NTHREADS, 2) fwd_kernel(Args args) {
    extern __shared__ __attribute__((aligned(16))) unsigned char lds_raw[];
    Frame F_;
    F_.lds = (LAS unsigned char*)lds_raw;
    F_.tid = threadIdx.x; F_.lane = F_.tid & 63; F_.wave = __builtin_amdgcn_readfirstlane(F_.tid >> 6);
    F_.G = gridDim.x; { const int bx = blockIdx.x; F_.vcu = (F_.G % 8 == 0) ? (bx % 8) * (F_.G / 8) + bx / 8 : bx; }
    F_.gw = F_.vcu * NWAVES + F_.wave; F_.NGW = F_.G * NWAVES;
    F_.ws = args.ws;
    volatile LAS unsigned* MISC = (volatile LAS unsigned*)(F_.lds + LDS_MISC);
    if (F_.tid < 32) MISC[F_.tid] = 0u;
    __syncthreads();
    const int lo = args.ph_lo, hi = args.ph_hi;
    XcdBarrier bar; bar.bar = (unsigned*)(args.ws + WS_CTL) + CW_BAR; bar.x = 0; bar.st = nullptr;
    if (N_LAUNCHES == 1 || hi - lo > 1) bar = xcd_barrier_post((unsigned*)(args.ws + WS_CTL) + CW_BAR, MISC + 8);
#if N_LAUNCHES == 1
#define IN(k) true
#define SEAM(k) xcd_barrier(bar)
#else
#define IN(k) (lo <= (k) && (k) < hi)
#define SEAM(k) do { if (IN(k) && IN((k) + 1)) xcd_barrier(bar); } while (0)
#endif
    PG8_LAS unsigned char* glds = (PG8_LAS unsigned char*)lds_raw;

    if (IN(0)) { p0_prologue(F_, args.in); } SEAM(0);

#pragma unroll 1
    for (int lp = 0; lp < 2; ++lp) {
        const int pb = 1 + lp * 19;
        unsigned char* ws = args.ws; asm volatile("" : "+s"(ws));
        Frame F = F_; { int w_ = F_.wave, v_ = F_.vcu, g_ = F_.G; asm volatile("" : "+s"(w_), "+s"(v_), "+s"(g_)); F.wave = w_; F.vcu = v_; F.G = g_; F.gw = v_ * NWAVES + w_; F.NGW = g_ * NWAVES; F.ws = ws; }
        float* mod = (float*)(ws + WS_MOD); float* XW = (float*)(ws + WS_XW);
        bf16_t* H = (bf16_t*)(ws + WS_H); bf16_t* P = (bf16_t*)(ws + WS_P); bf16_t* QRAW = (bf16_t*)(ws + WS_QRAW); bf16_t* KVRAW = (bf16_t*)(ws + WS_KVRAW);
        bf16_t* Q = (bf16_t*)(ws + WS_Q); bf16_t* KB = (bf16_t*)(ws + WS_K); bf16_t* VB = (bf16_t*)(ws + WS_V); bf16_t* CAT = (bf16_t*)(ws + WS_CAT); bf16_t* PQ = (bf16_t*)(ws + WS_PQ);
        int* IDX = (int*)(ws + WS_IDX); float* GATE = (float*)(ws + WS_GATE);
        const float* rope_c = (const float*)(ws + WS_ROPE); const float* rope_a = rope_c + 64 * 32 * 2;
        const float* SMv = (const float*)(ws + WS_SMALL);
        {
            const int l = 2 * lp, i = lp;
            const float* modl = mod + (size_t)l * 3 * NMOD;
            if (IN(pb + 0)) { norm_phase(F, XW, SMv + SM_N1G + l * DM, modl, 0, 2048, H, false); } SEAM(pb + 0);
            if (IN(pb + 1)) {
                pg8::Gemm g{H, (const bf16_t*)(ws + WS_WIN) + (size_t)i * 4096 * DM, MROWS, 4096, DM, DM, DM}; pg8::StaticOrder S; S.init(MROWS, 4096, F.G, (int)blockIdx.x);
                pg8::EpiBf16 E{P, 4096};
                pg8::gemm_phase<pg8::EpiBf16, pg8::StaticOrder, true, true>(glds, g, S, E, phase_tid(F.wave));
            } SEAM(pb + 1);
            if (IN(pb + 2)) {
                { pg8::Gemm g{P, (const bf16_t*)(ws + WS_WUQ) + (size_t)i * 1536 * 512, MROWS, 1536, 512, 4096, 512}; pg8::StaticOrder S; S.init(MROWS, 1536, F.G, (int)blockIdx.x);
                  pg8::EpiBf16 E{QRAW, 1536};
                  pg8::gemm_phase<pg8::EpiBf16, pg8::StaticOrder, true, true>(glds, g, S, E, phase_tid(F.wave)); }
                __syncthreads();
                { pg8::Gemm g{P + 512, (const bf16_t*)(ws + WS_WUKV) + (size_t)i * 2048 * 256, MROWS, 2048, 256, 4096, 256}; pg8::StaticOrder S; S.init(MROWS, 2048, F.G, (int)blockIdx.x);
                  pg8::EpiBf16 E{KVRAW, 2048};
                  pg8::gemm_phase<pg8::EpiBf16, pg8::StaticOrder, true, true>(glds, g, S, E, phase_tid(F.wave)); }
                __syncthreads();
                conv_phase(F, P, SMv + SM_CW + i * 3072, SMv + SM_CB + i * 1024, CAT);
            } SEAM(pb + 2);
            if (IN(pb + 3)) { prep_even_phase(F, P, QRAW, KVRAW, SMv + SM_AQG + i * 192, SMv + SM_AKG + i * 192, rope_a, Q, KB, VB); } SEAM(pb + 3);
            if (IN(pb + 4)) { attn_even_phase(F, Q, KB, VB, CAT); } SEAM(pb + 4);
            if (IN(pb + 5)) {
                pg8::Gemm g{CAT, (const bf16_t*)(ws + WS_WEO) + (size_t)i * DM * DM, MROWS, DM, DM, DM, DM}; pg8::StaticOrder S; S.init(MROWS, DM, F.G, (int)blockIdx.x);
                pg8::EpiResid E{XW, DM, modl + 4096};
                pg8::gemm_phase<pg8::EpiResid, pg8::StaticOrder, true, true>(glds, g, S, E, phase_tid(F.wave));
            } SEAM(pb + 5);
            if (IN(pb + 6)) { norm_phase(F, XW, SMv + SM_N2G + l * DM, modl, 6144, 8192, H, l == 3); } SEAM(pb + 6);
            if (IN(pb + 7)) {
                pg8::Gemm g{H, (const bf16_t*)(ws + WS_WPQ) + (size_t)l * DM * DM, MROWS, DM, DM, DM, DM}; pg8::StaticOrder S; S.init(MROWS, DM, F.G, (int)blockIdx.x);
                pg8::EpiBf16 E{PQ, DM};
                pg8::gemm_phase<pg8::EpiBf16, pg8::StaticOrder, true, true>(glds, g, S, E, phase_tid(F.wave));
            } SEAM(pb + 7);
            if (IN(pb + 8)) { peer_topk_phase(F, PQ, (const bf16_t*)(ws + WS_SUBK) + (size_t)l * 16 * 128 * 128, IDX, GATE, l == 3); } SEAM(pb + 8);
            if (IN(pb + 9)) { peer_expert_phase(F, H, IDX, GATE, ws + WS_U + (size_t)l * NEXP * ROWB, (size_t)(WS_VT - WS_U), (const float*)(ws + WS_USC) + l * NEXP, (const float*)(ws + WS_VSC) + l * NEXP, modl + 10240, XW, nullptr); } SEAM(pb + 9);
        }
        {
            const int l = 2 * lp + 1, i = lp, qb = pb + 10;
            const float* modl = mod + (size_t)l * 3 * NMOD;
            if (IN(qb + 0)) { norm_phase(F, XW, SMv + SM_N1G + l * DM, modl, 0, 2048, H, false); } SEAM(qb + 0);
            if (IN(qb + 1)) {
                pg8::Gemm g{H, (const bf16_t*)(ws + WS_WQKV) + (size_t)i * 3072 * DM, MROWS, 3072, DM, DM, DM}; pg8::StaticOrder S; S.init(MROWS, 3072, F.G, (int)blockIdx.x);
                pg8::EpiBf16 E{P, 3072};
                pg8::gemm_phase<pg8::EpiBf16, pg8::StaticOrder, true, true>(glds, g, S, E, phase_tid(F.wave));
            } SEAM(qb + 1);
            if (IN(qb + 2)) { prep_odd_phase(F, P, SMv + SM_CQG + i * 128, SMv + SM_CKG + i * 128, rope_c, Q, KB); } SEAM(qb + 2);
            if (IN(qb + 3)) { attn_odd_phase(F, Q, KB, P, CAT, l == 3); } SEAM(qb + 3);
            if (IN(qb + 4)) {
                pg8::Gemm g{CAT, (const bf16_t*)(ws + WS_WCO) + (size_t)i * DM * DM, MROWS, DM, DM, DM, DM}; pg8::StaticOrder S; S.init(MROWS, DM, F.G, (int)blockIdx.x, l == 3);
                pg8::EpiResid E{XW, DM, modl + 4096};
                pg8::gemm_phase<pg8::EpiResid, pg8::StaticOrder, true, true>(glds, g, S, E, phase_tid(F.wave));
            } SEAM(qb + 4);
            if (IN(qb + 5)) { norm_phase(F, XW, SMv + SM_N2G + l * DM, modl, 6144, 8192, H, l == 3); } SEAM(qb + 5);
            if (IN(qb + 6)) {
                pg8::Gemm g{H, (const bf16_t*)(ws + WS_WPQ) + (size_t)l * DM * DM, MROWS, DM, DM, DM, DM}; pg8::StaticOrder S; S.init(MROWS, DM, F.G, (int)blockIdx.x, l == 3);
                pg8::EpiBf16 E{PQ, DM};
                pg8::gemm_phase<pg8::EpiBf16, pg8::StaticOrder, true, true>(glds, g, S, E, phase_tid(F.wave));
            } SEAM(qb + 6);
            if (IN(qb + 7)) { peer_topk_phase(F, PQ, (const bf16_t*)(ws + WS_SUBK) + (size_t)l * 16 * 128 * 128, IDX, GATE, l == 3); } SEAM(qb + 7);
            if (IN(qb + 8)) { peer_expert_phase(F, H, IDX, GATE, ws + WS_U + (size_t)l * NEXP * ROWB, (size_t)(WS_VT - WS_U), (const float*)(ws + WS_USC) + l * NEXP, (const float*)(ws + WS_VSC) + l * NEXP, modl + 10240, XW, (l == 3) ? args.out : nullptr); } if (lp == 0) SEAM(qb + 8);
        }
    }
#undef IN
#undef SEAM
}

extern "C" void kernel_launch(void* const* d_in, const int* in_sizes, int n_in, void* d_out, int out_size, void* d_ws, size_t ws_size, hipStream_t stream) {
    static int grid = 0;
    if (grid == 0) {
        if (n_in != 26 || out_size != NBATCH * SEQ * DM || ws_size < WS_END) { fprintf(stderr, "kernel_launch: unexpected shapes: n_in %d out %d ws %zu (need %zu)\n", n_in, out_size, ws_size, (size_t)WS_END); grid = -1; return; }
        int dev = 0, cus = 0, per_cu = 0;
        if (hipGetDevice(&dev) != hipSuccess || hipDeviceGetAttribute(&cus, hipDeviceAttributeMultiprocessorCount, dev) != hipSuccess) { fprintf(stderr, "kernel_launch: device query failed\n"); grid = -1; return; }
        if (hipFuncSetAttribute((const void*)fwd_kernel, hipFuncAttributeMaxDynamicSharedMemorySize, LDS_BYTES) != hipSuccess) { fprintf(stderr, "kernel_launch: hipFuncSetAttribute failed\n"); grid = -1; return; }
        if (hipOccupancyMaxActiveBlocksPerMultiprocessor(&per_cu, (const void*)fwd_kernel, NTHREADS, LDS_BYTES) != hipSuccess || per_cu < 1) { fprintf(stderr, "kernel_launch: occupancy query says %d blocks per CU\n", per_cu); (void)hipGetLastError(); grid = -1; return; }
        grid = cus;
    }
    if (grid < 0) return;
    (void)hipMemsetAsync((char*)d_ws + WS_CTL, 0, CTL_ZERO_BYTES, stream);
    Args a{};
    for (int i = 0; i < 26; ++i) a.in[i] = (const float*)d_in[i];
    a.out = (float*)d_out; a.ws = (unsigned char*)d_ws;
    for (int li = 0; li < N_LAUNCHES; ++li) {
        a.ph_lo = (N_LAUNCHES == 1) ? 0 : li; a.ph_hi = (N_LAUNCHES == 1) ? NPHASES : li + 1;
        hipLaunchKernelGGL(fwd_kernel, dim3(grid), dim3(NTHREADS), LDS_BYTES, stream, a);
        const hipError_t le = hipPeekAtLastError();
        if (le != hipSuccess) { fprintf(stderr, "kernel_launch: launch %d failed: %s\n", li, hipGetErrorName(le)); break; }
    }
}
```

```cpp
#include <hip/hip_runtime.h>
#include <cstdio>
#include <cstdint>
namespace pg8 {
#define PG8_LAS __attribute__((address_space(3)))
typedef unsigned short bf16_t;
typedef short bf16x8 __attribute__((ext_vector_type(8)));
typedef float f32x4 __attribute__((ext_vector_type(4)));
typedef unsigned u32x4 __attribute__((ext_vector_type(4)));
constexpr int BM = 256, BK = 64, HALF = 128, HTB = HALF * BK * 2  , STAGE_BYTES = 8 * HTB, NXCD = 8, WGM = 8;

__host__ __device__ __forceinline__ int lds_byte(int r, int c) { const int st = (r >> 4) * 2 + (c >> 5), rr = r & 15, cc = c & 31, ob = rr * 64 + cc * 2; return st * 1024 + (ob ^ (((ob >> 9) & 1) << 5)); }
__host__ __device__ __forceinline__ void stage_rc(int b, int& R, int& C) { const int st = b / 1024, sb = b % 1024, swz = sb ^ (((sb >> 9) & 1) << 5); R = (st >> 1) * 16 + swz / 64; C = (st & 1) * 32 + (swz % 64) / 2; }
__host__ __device__ __forceinline__ int perm32(int rho) { const int n = rho >> 4, i = rho & 15; return 8 * (i >> 2) + 4 * n + (i & 3); }

struct Unit { int pm, pn; };
struct Gemm { const bf16_t* A; const bf16_t* Bt; int M, N, K, lda, ldb; };

struct StaticOrder {
    int nM, nN, nwg, G, c; bool lat_only;
    __host__ __device__ void init(int M, int N, int G_, int c_, bool lat_only_ = false) { lat_only = lat_only_; nM = lat_only_ ? 32 : M / BM; nN = N / BM; nwg = nM * nN; G = G_; c = c_; }
    __host__ __device__ bool next(int i, Unit& u) const {
        const long L = (long)i * G + c; if (L >= nwg) return false;
        int wgid = (int)L; { const int q = nwg / NXCD, r = nwg % NXCD, xcd = wgid % NXCD, off = wgid / NXCD; wgid = (xcd < r ? xcd * (q + 1) : r * (q + 1) + (xcd - r) * q) + off; }
        const int nig = WGM * nN, gid = wgid / nig, fm = gid * WGM, gsz = (nM - fm) < WGM ? (nM - fm) : WGM;
        u.pm = fm + ((wgid % nig) % gsz); u.pn = (wgid % nig) / gsz; if (lat_only) u.pm += 1 + (u.pm >= 16 ? 1 : 0); return true;
    }
    __device__ __forceinline__ void a_ready(const Unit&) const {}
    __device__ __forceinline__ void done(const Unit&) const {}
};
__device__ __forceinline__ unsigned cvt_pk_bf16(float lo, float hi) { unsigned r; asm volatile("v_cvt_pk_bf16_f32 %0, %1, %2" : "=v"(r) : "v"(lo), "v"(hi)); return r; }
typedef float f32x2 __attribute__((ext_vector_type(2)));
struct EpiBf16 {
    static constexpr bool PERM = true, AFTER_DRAIN = false;
    bf16_t* O; int ldc;
    __device__ __forceinline__ void operator()(const f32x4 (&acc)[2][2][4][2], const Unit& u, int wr, int wc, int fr, int fq) const {
        const int row0 = u.pm * BM + wr * 64 + fr, col0 = u.pn * BM + wc * 32 + 8 * fq;
#pragma unroll
        for (int ai = 0; ai < 2; ++ai)
#pragma unroll
            for (int m = 0; m < 4; ++m) { bf16_t* rowp = O + (size_t)(row0 + ai * HALF + m * 16) * ldc + col0;
#pragma unroll
                for (int bj = 0; bj < 2; ++bj) { const f32x4 v0 = acc[ai][bj][m][0], v1 = acc[ai][bj][m][1];
                    u32x4 w; w.x = cvt_pk_bf16(v0[0], v0[1]); w.y = cvt_pk_bf16(v0[2], v0[3]); w.z = cvt_pk_bf16(v1[0], v1[1]); w.w = cvt_pk_bf16(v1[2], v1[3]);
                    *(u32x4*)(rowp + bj * HALF) = w; } }
    }
};
struct EpiResid {
    static constexpr bool PERM = false, AFTER_DRAIN = false;
    float* X; int ldc; const float* gate;
    __device__ __forceinline__ void operator()(const f32x4 (&acc)[2][2][4][2], const Unit& u, int wr, int wc, int fr, int fq) const {
        const int row0 = u.pm * BM + wr * 64 + fr, col0 = u.pn * BM + wc * 32 + 4 * fq;
        const int cls = (u.pm % 17 == 0) ? 2 : (u.pm / 17);
        const float* gp = gate + (size_t)cls * 12288 + col0;
        f32x4 gv[2][2];
#pragma unroll
        for (int bj = 0; bj < 2; ++bj)
#pragma unroll
            for (int n = 0; n < 2; ++n) gv[bj][n] = *(const f32x4*)(gp + bj * HALF + n * 16);
#pragma unroll
        for (int ai = 0; ai < 2; ++ai)
#pragma unroll
            for (int m = 0; m < 4; ++m) { float* rowp = X + (size_t)(row0 + ai * HALF + m * 16) * ldc + col0;
#pragma unroll
                for (int bj = 0; bj < 2; ++bj)
#pragma unroll
                    for (int n = 0; n < 2; ++n) { f32x4* p = (f32x4*)(rowp + bj * HALF + n * 16); *p = *p + gv[bj][n] * acc[ai][bj][m][n]; } }
    }
};
template <class Epi, class Sched, bool ALIGN_EPI = false, bool SP2 = false>
__device__ __forceinline__ void gemm_phase(PG8_LAS unsigned char* lds, const Gemm g, const Sched& S, const Epi& E, int tid_in) {
    int tid_ = tid_in; asm volatile("" : "+v"(tid_));
    const int tid = tid_, wid = __builtin_amdgcn_readfirstlane(tid >> 6), lane = tid & 63, wr = wid >> 2, wc = wid & 3, fr = lane & 15, fq = lane >> 4;
    const int K = g.K, nt = K / BK;
    unsigned voffA[2], voffB[2];
#pragma unroll
    for (int i = 0; i < 2; ++i) { int R, C; stage_rc(tid * 16 + i * 8192, R, C); const int Rb = Epi::PERM ? ((R & ~31) + perm32(R & 31)) : R;
        voffA[i] = (unsigned)(R * g.lda + C) * 2u; voffB[i] = (unsigned)(Rb * g.ldb + C) * 2u; }
    const size_t kstep = (size_t)(BK * 2);
    const size_t hstepA = (size_t)HALF * g.lda * 2, hstepB = (size_t)HALF * g.ldb * 2;
    const size_t tstepA = 2 * hstepA, tstepB = 2 * hstepB;
    const unsigned ldsw = (unsigned)wid * 1024u;
    const int aoff = lds_byte(wr * 64 + fr, fq * 8), boff = lds_byte(wc * 32 + fr, fq * 8);
#define PG8_SA(b, h) (((b) * 2 + (h)) * HTB)
#define PG8_SB(b, h) ((4 + (b) * 2 + (h)) * HTB)
#define PG8_STAGE(bufoff, gbase, voff) do { _Pragma("unroll") for (int _i = 0; _i < 2; ++_i) \
        __builtin_amdgcn_global_load_lds((const unsigned*)((const char*)(gbase) + (voff)[_i]), (PG8_LAS unsigned*)(lds + (bufoff) + ldsw + _i * 8192), 16, 0, 0); } while (0)
#define PG8_LDA(dst, b, h) do { _Pragma("unroll") for (int m = 0; m < 4; ++m) _Pragma("unroll") for (int k = 0; k < 2; ++k) dst[m][k] = *(const PG8_LAS bf16x8*)(lds + PG8_SA(b, h) + aoff + m * 2048 + k * 1024); } while (0)
#define PG8_LDB(dst, b, h) do { _Pragma("unroll") for (int n = 0; n < 2; ++n) _Pragma("unroll") for (int k = 0; k < 2; ++k) dst[n][k] = *(const PG8_LAS bf16x8*)(lds + PG8_SB(b, h) + boff + n * 2048 + k * 1024); } while (0)
#define PG8_MMA(ai, bj, At, Bt) do { __builtin_amdgcn_s_setprio(1); _Pragma("unroll") for (int m = 0; m < 4; ++m) _Pragma("unroll") for (int n = 0; n < 2; ++n) _Pragma("unroll") for (int k = 0; k < 2; ++k) \
        acc[ai][bj][m][n] = __builtin_amdgcn_mfma_f32_16x16x32_bf16(Bt[n][k], At[m][k], acc[ai][bj][m][n], 0, 0, 0); __builtin_amdgcn_s_setprio(0); } while (0)
#define PG8_WAIT_V(n) asm volatile("s_waitcnt vmcnt(" #n ")" ::: "memory")
#define PG8_WAIT_L(n) asm volatile("s_waitcnt lgkmcnt(" #n ")" ::: "memory")
#define PG8_BAR __builtin_amdgcn_s_barrier()
#define PG8_SCHED __builtin_amdgcn_sched_barrier(0)
    Unit cur, nxt; int ui = 0;
    if (!S.next(0, cur)) return;
    f32x4 acc[2][2][4][2];
#pragma unroll
    for (int a = 0; a < 2; ++a)
#pragma unroll
        for (int b = 0; b < 2; ++b)
#pragma unroll
            for (int m = 0; m < 4; ++m)
#pragma unroll
                for (int n = 0; n < 2; ++n) acc[a][b][m][n] = (f32x4){0.f, 0.f, 0.f, 0.f};
    bf16x8 At[4][2], B0[2][2], B1[2][2];
    const char* cA = (const char*)g.A + (size_t)cur.pm * tstepA; const char* cB = (const char*)g.Bt + (size_t)cur.pn * tstepB;
    S.a_ready(cur);
    if constexpr (SP2) {
        PG8_STAGE(PG8_SB(0, 0), cB, voffB); PG8_STAGE(PG8_SB(0, 1), cB + hstepB, voffB); PG8_STAGE(PG8_SA(0, 0), cA, voffA); PG8_STAGE(PG8_SA(0, 1), cA + hstepA, voffA);
        if (wr == 1) PG8_BAR;
        PG8_WAIT_V(2); PG8_BAR;
        PG8_STAGE(PG8_SB(1, 0), cB + kstep, voffB); PG8_STAGE(PG8_SA(1, 0), cA + kstep, voffA); PG8_STAGE(PG8_SB(1, 1), cB + hstepB + kstep, voffB);
        PG8_WAIT_V(6); PG8_BAR;
    } else {
        PG8_STAGE(PG8_SB(0, 0), cB, voffB); PG8_STAGE(PG8_SA(0, 0), cA, voffA); PG8_STAGE(PG8_SB(0, 1), cB + hstepB, voffB); PG8_STAGE(PG8_SA(0, 1), cA + hstepA, voffA);
        if (wr == 1) PG8_BAR;
        PG8_WAIT_V(4); PG8_BAR;
        PG8_STAGE(PG8_SB(1, 0), cB + kstep, voffB); PG8_STAGE(PG8_SA(1, 0), cA + kstep, voffA); PG8_STAGE(PG8_SB(1, 1), cB + hstepB + kstep, voffB);
        PG8_WAIT_V(6); PG8_BAR;
    }
    for (;;) {
        const bool has_next = S.next(ui + 1, nxt);
        const char* nA = has_next ? (const char*)g.A + (size_t)nxt.pm * tstepA : cA; const char* nB = has_next ? (const char*)g.Bt + (size_t)nxt.pn * tstepB : cB;
        for (int t = 0; t < nt; t += 2) {
            const bool last = (t == nt - 2);
            const char* a1 = cA + (size_t)(t + 1) * kstep;
            const char* a2 = last ? nA : cA + (size_t)(t + 2) * kstep; const char* b2 = last ? nB : cB + (size_t)(t + 2) * kstep;
            const char* a3 = a2 + kstep; const char* b3 = b2 + kstep;
            if (last && has_next) S.a_ready(nxt);
            if constexpr (SP2) {
            PG8_LDB(B0, 0, 0); PG8_LDB(B1, 0, 1); PG8_SCHED; PG8_LDA(At, 0, 0); PG8_STAGE(PG8_SA(1, 1), a1 + hstepA, voffA);
            PG8_WAIT_V(8); PG8_WAIT_L(0); PG8_BAR; PG8_MMA(0, 0, At, B0); PG8_MMA(0, 1, At, B1); PG8_BAR; PG8_SCHED;
            PG8_LDA(At, 0, 1); PG8_STAGE(PG8_SB(0, 0), b2, voffB); PG8_STAGE(PG8_SB(0, 1), b2 + hstepB, voffB); PG8_STAGE(PG8_SA(0, 0), a2, voffA);
            PG8_WAIT_V(8); PG8_WAIT_L(0); PG8_BAR; PG8_MMA(1, 0, At, B0); PG8_MMA(1, 1, At, B1); PG8_BAR; PG8_SCHED;
            PG8_LDB(B0, 1, 0); PG8_LDB(B1, 1, 1); PG8_SCHED; PG8_LDA(At, 1, 0); PG8_STAGE(PG8_SA(0, 1), a2 + hstepA, voffA);
            PG8_WAIT_V(8); PG8_WAIT_L(0); PG8_BAR; PG8_MMA(0, 0, At, B0); PG8_MMA(0, 1, At, B1); PG8_BAR; PG8_SCHED;
            PG8_LDA(At, 1, 1); PG8_STAGE(PG8_SB(1, 0), b3, voffB); PG8_STAGE(PG8_SB(1, 1), b3 + hstepB, voffB); PG8_STAGE(PG8_SA(1, 0), a3, voffA);
            PG8_WAIT_V(8); PG8_WAIT_L(0); PG8_BAR; PG8_MMA(1, 0, At, B0); PG8_MMA(1, 1, At, B1); PG8_BAR; PG8_SCHED;
            } else {
            PG8_LDB(B0, 0, 0); PG8_SCHED; PG8_LDA(At, 0, 0); PG8_STAGE(PG8_SA(1, 1), a1 + hstepA, voffA);
            PG8_WAIT_L(8); PG8_BAR; PG8_WAIT_L(0); PG8_MMA(0, 0, At, B0); PG8_BAR; PG8_SCHED;
            PG8_LDB(B1, 0, 1); PG8_STAGE(PG8_SB(0, 0), b2, voffB);
            PG8_BAR; PG8_WAIT_L(0); PG8_MMA(0, 1, At, B1); PG8_BAR;
            PG8_LDA(At, 0, 1); PG8_STAGE(PG8_SA(0, 0), a2, voffA);
            PG8_BAR; PG8_WAIT_L(0); PG8_MMA(1, 0, At, B0); PG8_BAR; PG8_SCHED;
            PG8_STAGE(PG8_SB(0, 1), b2 + hstepB, voffB);
            PG8_WAIT_V(6); PG8_BAR; PG8_MMA(1, 1, At, B1); PG8_BAR;
            PG8_LDB(B0, 1, 0); PG8_SCHED; PG8_LDA(At, 1, 0); PG8_STAGE(PG8_SA(0, 1), a2 + hstepA, voffA);
            PG8_WAIT_L(8); PG8_BAR; PG8_WAIT_L(0); PG8_MMA(0, 0, At, B0); PG8_BAR; PG8_SCHED;
            PG8_LDB(B1, 1, 1); PG8_STAGE(PG8_SB(1, 0), b3, voffB);
            PG8_BAR; PG8_WAIT_L(0); PG8_MMA(0, 1, At, B1); PG8_BAR;
            PG8_LDA(At, 1, 1); PG8_STAGE(PG8_SA(1, 0), a3, voffA);
            PG8_BAR; PG8_WAIT_L(0); PG8_MMA(1, 0, At, B0); PG8_BAR; PG8_SCHED;
            PG8_STAGE(PG8_SB(1, 1), b3 + hstepB, voffB);
            PG8_WAIT_V(6); PG8_BAR; PG8_MMA(1, 1, At, B1); PG8_BAR;
            }
        }
        if constexpr (ALIGN_EPI) { if (wr == 0) PG8_BAR; }
        if constexpr (!Epi::AFTER_DRAIN) { E(acc, cur, wr, wc, fr, fq); S.done(cur); }
        if (!has_next) break;
#pragma unroll
        for (int a = 0; a < 2; ++a)
#pragma unroll
            for (int b = 0; b < 2; ++b)
#pragma unroll
                for (int m = 0; m < 4; ++m)
#pragma unroll
                    for (int n = 0; n < 2; ++n) acc[a][b][m][n] = (f32x4){0.f, 0.f, 0.f, 0.f};
        cur = nxt; cA = nA; cB = nB; ++ui;
        if constexpr (ALIGN_EPI) { if (wr == 1) PG8_BAR; }
    }
    PG8_WAIT_V(0);
    if constexpr (!ALIGN_EPI) { if (wr == 0) PG8_BAR; }
    PG8_BAR;
    if constexpr (Epi::AFTER_DRAIN) { E.fused(acc, cur, wr, wc, fr, fq, lds, wid, lane); S.done(cur); }
#undef PG8_SA
#undef PG8_SB
#undef PG8_STAGE
#undef PG8_LDA
#undef PG8_LDB
#undef PG8_MMA
#undef PG8_WAIT_V
#undef PG8_WAIT_L
#undef PG8_BAR
#undef PG8_SCHED
}
}
namespace att {
typedef unsigned short bf16_t;
using bf16x8 = __attribute__((ext_vector_type(8))) short;
using s16x4  = __attribute__((ext_vector_type(4))) short;
using f32x16 = __attribute__((ext_vector_type(16))) float;
using u32x4  = __attribute__((ext_vector_type(4))) unsigned;
constexpr int DV = 128, NW = 8, QBLK = 32, KVBLK = 64;
constexpr float THR = 8.f;
constexpr int SHM_V = KVBLK * DV * 2;
template <int DQK> struct Cfg {
    static constexpr int SHM_K = KVBLK * DQK * 2, KROWB = DQK * 2, NCK = DQK / 64, C8 = DQK / 8, ND0 = DQK / 16;
    static constexpr float SCALE = (DQK == 128) ? 0.088388347648318440f : 0.072168783648703220f;
    static constexpr int LDS_BYTES = 2 * SHM_V + 2 * SHM_K + NW * 64 * 4;
};
#define ATT_SBAR() __builtin_amdgcn_sched_barrier(0)
__device__ __forceinline__ int crow(int r, int hi) { return (r & 3) + 8 * (r >> 2) + 4 * hi; }
__device__ __forceinline__ unsigned cvtpk(float lo, float hi) { unsigned r; asm volatile("v_cvt_pk_bf16_f32 %0, %1, %2" : "=v"(r) : "v"(lo), "v"(hi)); return r; }
template <int DQK> __device__ __forceinline__ int kswz(int row, int colB) {
    const int key = (DQK == 128) ? (row & 7) : ((row >> 1) & 7);
    return row * (DQK * 2) + (colB ^ (key << 4));
}
template <int DQK> __device__ __forceinline__ void partialSM(f32x16& p0, f32x16& p1, float& m_reg, float& mn, float& alpha) {
    constexpr float SCALE = Cfg<DQK>::SCALE, C = SCALE * 1.4426950408889634f;
    float pmax = p0[0];
#pragma unroll
    for (int r = 1; r < 16; ++r) pmax = fmaxf(pmax, p0[r]);
#pragma unroll
    for (int r = 0; r < 16; ++r) pmax = fmaxf(pmax, p1[r]);
    { auto rr = __builtin_amdgcn_permlane32_swap(__float_as_uint(pmax), __float_as_uint(pmax), false, false);
      pmax = fmaxf(__uint_as_float(rr[0]), __uint_as_float(rr[1])); }
    if (__builtin_expect(__all(pmax - m_reg <= THR / SCALE), 1)) { mn = m_reg; alpha = 1.f; }
    else { mn = fmaxf(m_reg, pmax); alpha = __builtin_amdgcn_exp2f((m_reg - mn) * C); m_reg = mn; }
    const float mnC = -mn * C;
#pragma unroll
    for (int r = 0; r < 16; ++r) p0[r] = fmaf(p0[r], C, mnC);
#pragma unroll
    for (int r = 0; r < 16; ++r) p1[r] = fmaf(p1[r], C, mnC);
#pragma unroll
    for (int r = 0; r < 16; ++r) p0[r] = __builtin_amdgcn_exp2f(p0[r]);
}
__device__ __forceinline__ void finishSM(f32x16& p0, f32x16& p1, float alpha, float& l_reg, bf16x8& pa0, bf16x8& pa1, bf16x8& pa2, bf16x8& pa3) {
#pragma unroll
    for (int r = 0; r < 16; ++r) p1[r] = __builtin_amdgcn_exp2f(p1[r]);
    float ps = 0;
#pragma unroll
    for (int r = 0; r < 16; ++r) ps += p0[r];
#pragma unroll
    for (int r = 0; r < 16; ++r) ps += p1[r];
    { auto rr = __builtin_amdgcn_permlane32_swap(__float_as_uint(ps), __float_as_uint(ps), false, false);
      ps = __uint_as_float(rr[0]) + __uint_as_float(rr[1]); }
    l_reg = l_reg * alpha + ps;
#define ATT_PK4(P, BASE, OUT) do { unsigned a0 = cvtpk(P[BASE + 0], P[BASE + 1]), a1 = cvtpk(P[BASE + 2], P[BASE + 3]);   \
    unsigned b0 = cvtpk(P[BASE + 4], P[BASE + 5]), b1 = cvtpk(P[BASE + 6], P[BASE + 7]);                              \
    auto r0 = __builtin_amdgcn_permlane32_swap(a0, b0, false, false); auto r1 = __builtin_amdgcn_permlane32_swap(a1, b1, false, false); \
    u32x4 w = {r0[0], r1[0], r0[1], r1[1]}; OUT = *reinterpret_cast<bf16x8*>(&w); } while (0)
    ATT_PK4(p0, 0, pa0); ATT_PK4(p0, 8, pa1); ATT_PK4(p1, 0, pa2); ATT_PK4(p1, 8, pa3);
#undef ATT_PK4
}
template <int DQK> __device__ __forceinline__ void qkt(f32x16& p0, f32x16& p1, const char* Ks, const bf16x8* qr, int r32, int hi) {
    p0 = f32x16{}; p1 = f32x16{};
#pragma unroll
    for (int d0 = 0; d0 < Cfg<DQK>::ND0; ++d0) { const int cb = (d0 * 16 + hi * 8) * 2;
        bf16x8 b0 = *reinterpret_cast<const bf16x8*>(Ks + kswz<DQK>(r32, cb));
        bf16x8 b1 = *reinterpret_cast<const bf16x8*>(Ks + kswz<DQK>(32 + r32, cb));
        p0 = __builtin_amdgcn_mfma_f32_32x32x16_bf16(b0, qr[d0], p0, 0, 0, 0);
        p1 = __builtin_amdgcn_mfma_f32_32x32x16_bf16(b1, qr[d0], p1, 0, 0, 0); }
}
__device__ __forceinline__ int v_st(int k, int c) { const int kk = (k & ~0xC) | ((k & 4) << 1) | ((k & 8) >> 1); return ((kk >> 3) * 4 + (c >> 5)) * 512 + ((kk & 7) * 32 + (c & 31)) * 2; }
__device__ __forceinline__ int v_rd_base(int lane) { return ((lane & 3) << 3) | (((lane >> 2) & 3) << 6) | (((lane >> 4) & 1) << 5) | (((lane >> 5) & 1) << 8); }
constexpr int v_rd_off(int d0, int ks, int half) { return d0 * 512 + ks * 4096 + half * 2048; }
template <int OFF> __device__ __forceinline__ s16x4 tr_read(int vb) {
    s16x4 r; asm volatile("ds_read_b64_tr_b16 %0, %1 offset:%2" : "=&v"(r) : "v"(vb), "i"(OFF) : "memory"); return r;
}
template <int D0> __device__ __forceinline__ void pv_one(f32x16& od, int vb, bf16x8 pa0, bf16x8 pa1, bf16x8 pa2, bf16x8 pa3) {
    const s16x4 l0 = tr_read<v_rd_off(D0, 0, 0)>(vb), h0 = tr_read<v_rd_off(D0, 0, 1)>(vb), l1 = tr_read<v_rd_off(D0, 1, 0)>(vb), h1 = tr_read<v_rd_off(D0, 1, 1)>(vb);
    const s16x4 l2 = tr_read<v_rd_off(D0, 2, 0)>(vb), h2 = tr_read<v_rd_off(D0, 2, 1)>(vb), l3 = tr_read<v_rd_off(D0, 3, 0)>(vb), h3 = tr_read<v_rd_off(D0, 3, 1)>(vb);
    asm volatile("s_waitcnt lgkmcnt(0)" ::: "memory"); ATT_SBAR();
#define ATT_PK(L, H) (bf16x8){L[0], L[1], L[2], L[3], H[0], H[1], H[2], H[3]}
    od = __builtin_amdgcn_mfma_f32_32x32x16_bf16(pa0, ATT_PK(l0, h0), od, 0, 0, 0);
    od = __builtin_amdgcn_mfma_f32_32x32x16_bf16(pa1, ATT_PK(l1, h1), od, 0, 0, 0);
    od = __builtin_amdgcn_mfma_f32_32x32x16_bf16(pa2, ATT_PK(l2, h2), od, 0, 0, 0);
    od = __builtin_amdgcn_mfma_f32_32x32x16_bf16(pa3, ATT_PK(l3, h3), od, 0, 0, 0);
#undef ATT_PK
}
__device__ __forceinline__ void pv_d0(f32x16* o, int vb, bf16x8 pa0, bf16x8 pa1, bf16x8 pa2, bf16x8 pa3) {
    pv_one<0>(o[0], vb, pa0, pa1, pa2, pa3); pv_one<1>(o[1], vb, pa0, pa1, pa2, pa3); pv_one<2>(o[2], vb, pa0, pa1, pa2, pa3); pv_one<3>(o[3], vb, pa0, pa1, pa2, pa3);
}
template <int DQK, int LDQ, int LDK, int LDV, int LDO, int SDEPTH>
__device__ __forceinline__ void attn_body(const bf16_t* __restrict__ Qb, const bf16_t* __restrict__ Kh, const bf16_t* __restrict__ Vh, bf16_t* __restrict__ Ob, int seq, char* lds, int tid_in) {
    using C_ = Cfg<DQK>;
    constexpr int SHM_K = C_::SHM_K, NCK = C_::NCK, C8 = C_::C8, ND0 = C_::ND0;
    int tid_ = tid_in; asm volatile("" : "+v"(tid_));
    const int tid = tid_, wid = tid >> 6, lane = tid & 63, r32 = lane & 31, hi = lane >> 5;
    char* V_lds = lds; char* K_lds = lds + 2 * SHM_V;
    float* ws = (float*)(lds + 2 * SHM_V + 2 * SHM_K) + wid * 64; float* li_l = ws; float* al_l = ws + 32;
    float m_reg = -1e30f, l_reg = 0; f32x16 o[4] = {}; bf16x8 qr[ND0];
    const bf16_t* Qw = Qb + (long)(wid * QBLK + r32) * LDQ + hi * 8;
#pragma unroll
    for (int d0 = 0; d0 < ND0; ++d0) qr[d0] = *reinterpret_cast<const bf16x8*>(Qw + d0 * 16);
    const int sr = tid >> 4, sc = (tid & 15) * 8, vst0 = v_st(sr, sc), vst1 = v_st(32 + sr, sc);
    int krow[NCK], kcol[NCK];
#pragma unroll
    for (int i = 0; i < NCK; ++i) { const int ci = tid + 512 * i; krow[i] = ci / C8; kcol[i] = (ci % C8) * 8; }
    const int vb0 = (int)(uintptr_t)V_lds + v_rd_base(lane);
    struct { bf16x8 vs0, vs1, ks[NCK]; } sr_[SDEPTH];
#define ATT_SLOAD(i, k0) do { sr_[i].vs0 = *reinterpret_cast<const bf16x8*>(&Vh[(long)((k0) + sr) * LDV + sc]); sr_[i].vs1 = *reinterpret_cast<const bf16x8*>(&Vh[(long)((k0) + 32 + sr) * LDV + sc]); \
    _Pragma("unroll") for (int c_ = 0; c_ < NCK; ++c_) sr_[i].ks[c_] = *reinterpret_cast<const bf16x8*>(&Kh[(long)((k0) + krow[c_]) * LDK + kcol[c_]]); } while (0)
#define ATT_SWRITE(b, i) do { *(bf16x8*)(V_lds + (b) * SHM_V + vst0) = sr_[i].vs0; *(bf16x8*)(V_lds + (b) * SHM_V + vst1) = sr_[i].vs1; \
    _Pragma("unroll") for (int c_ = 0; c_ < NCK; ++c_) *(bf16x8*)(K_lds + (b) * SHM_K + kswz<DQK>(krow[c_], kcol[c_] * 2)) = sr_[i].ks[c_]; } while (0)
#define ATT_SWAIT() do { if constexpr (SDEPTH == 2) { if constexpr (NCK == 2) asm volatile("s_waitcnt vmcnt(4)" ::: "memory"); else asm volatile("s_waitcnt vmcnt(5)" ::: "memory"); } else asm volatile("s_waitcnt vmcnt(0)" ::: "memory"); } while (0)
#define ATT_RESC(a) do { if (__any((a) < 1.f)) { if (hi == 0) al_l[r32] = (a); asm volatile("s_waitcnt lgkmcnt(0)" ::: "memory"); \
    _Pragma("unroll") for (int d = 0; d < 4; ++d) _Pragma("unroll") for (int r = 0; r < 16; ++r) o[d][r] *= al_l[crow(r, hi)]; } } while (0)
    f32x16 pA0, pA1, pB0, pB1; float mnA, mnB, alA, alB; bf16x8 pa0, pa1, pa2, pa3; const int NT = seq / KVBLK;
    constexpr int SE = 0, SO = SDEPTH - 1;
    ATT_SLOAD(SE, 0); asm volatile("s_waitcnt vmcnt(0)" ::: "memory"); ATT_SWRITE(0, SE); __syncthreads();
    qkt<DQK>(pA0, pA1, K_lds, qr, r32, hi); partialSM<DQK>(pA0, pA1, m_reg, mnA, alA);
    ATT_SLOAD(SO, KVBLK); if constexpr (SDEPTH == 2) { if (2 < NT) ATT_SLOAD(SE, 2 * KVBLK); }
    ATT_SWAIT(); ATT_SWRITE(1, SO); __syncthreads();
    for (int j = 1; j + 1 < NT; j += 2) {
        ATT_SBAR(); qkt<DQK>(pB0, pB1, K_lds + SHM_K, qr, r32, hi);
        finishSM(pA0, pA1, alA, l_reg, pa0, pa1, pa2, pa3); ATT_SBAR();
        ATT_SLOAD(SO, (j + SDEPTH) * KVBLK); ATT_SBAR();
        pv_d0(o, vb0, pa0, pa1, pa2, pa3); partialSM<DQK>(pB0, pB1, m_reg, mnB, alB);
        __syncthreads(); ATT_SWAIT(); ATT_SWRITE(0, SE);
        ATT_RESC(alB); __syncthreads();
        ATT_SBAR(); qkt<DQK>(pA0, pA1, K_lds, qr, r32, hi);
        finishSM(pB0, pB1, alB, l_reg, pa0, pa1, pa2, pa3); ATT_SBAR();
        if (SDEPTH == 1 || j + 3 < NT) ATT_SLOAD(SE, (j + 1 + SDEPTH) * KVBLK); ATT_SBAR();
        pv_d0(o, vb0 + (int)SHM_V, pa0, pa1, pa2, pa3); partialSM<DQK>(pA0, pA1, m_reg, mnA, alA);
        __syncthreads(); ATT_SWAIT(); ATT_SWRITE(1, SO);
        ATT_RESC(alA); __syncthreads();
    }
    ATT_SBAR(); qkt<DQK>(pB0, pB1, K_lds + SHM_K, qr, r32, hi);
    finishSM(pA0, pA1, alA, l_reg, pa0, pa1, pa2, pa3); ATT_SBAR();
    pv_d0(o, vb0, pa0, pa1, pa2, pa3); partialSM<DQK>(pB0, pB1, m_reg, mnB, alB);
    __syncthreads(); ATT_RESC(alB);
    finishSM(pB0, pB1, alB, l_reg, pa0, pa1, pa2, pa3); ATT_SBAR();
    pv_d0(o, vb0 + (int)SHM_V, pa0, pa1, pa2, pa3);
    if (hi == 0) li_l[r32] = l_reg;
    asm volatile("s_waitcnt lgkmcnt(0)" ::: "memory");
    __syncthreads();
    float rli[16];
#pragma unroll
    for (int r = 0; r < 16; ++r) rli[r] = __builtin_amdgcn_rcpf(li_l[crow(r, hi)]);
    unsigned short* stg = (unsigned short*)(lds + wid * 8192);
#pragma unroll
    for (int r = 0; r < 16; ++r) { const int orow = crow(r, hi);
#pragma unroll
        for (int d0 = 0; d0 < 4; ++d0) { const unsigned w = cvtpk(o[d0][r] * rli[r], 0.f); stg[orow * 128 + d0 * 32 + r32] = (unsigned short)(w & 0xffffu); } }
    asm volatile("s_waitcnt lgkmcnt(0)" ::: "memory");
    bf16_t* Ow = Ob + (long)(wid * QBLK) * LDO;
#pragma unroll
    for (int i = 0; i < 8; ++i) { const int id = lane + 64 * i, row = id >> 4, c16 = id & 15;
        const u32x4 v = *(const u32x4*)((const char*)stg + row * 256 + c16 * 16);
        *(u32x4*)(Ow + (long)row * LDO + c16 * 8) = v; }
    asm volatile("s_waitcnt lgkmcnt(0)" ::: "memory");
    __syncthreads();
#undef ATT_SLOAD
#undef ATT_SWRITE
#undef ATT_SWAIT
#undef ATT_RESC
}

template <int DQK, int LDQ, int LDK, int LDV, int LDO>
__device__ __forceinline__ void attn_body1(const bf16_t* __restrict__ Qb, const bf16_t* __restrict__ Kh, const bf16_t* __restrict__ Vh, bf16_t* __restrict__ Ob, int seq, char* lds, int tid_in) {
    using C_ = Cfg<DQK>;
    constexpr int SHM_K = C_::SHM_K, NCK = C_::NCK, C8 = C_::C8, ND0 = C_::ND0;
    int tid_ = tid_in; asm volatile("" : "+v"(tid_));
    const int tid = tid_, wid = tid >> 6, lane = tid & 63, r32 = lane & 31, hi = lane >> 5;
    char* V_lds = lds; char* K_lds = lds + 2 * SHM_V;
    float* ws = (float*)(lds + 2 * SHM_V + 2 * SHM_K) + wid * 64; float* li_l = ws; float* al_l = ws + 32;
    float m_reg = -1e30f, l_reg = 0; f32x16 o[4] = {}; bf16x8 qr[ND0];
    const bf16_t* Qw = Qb + (long)(wid * QBLK + r32) * LDQ + hi * 8;
#pragma unroll
    for (int d0 = 0; d0 < ND0; ++d0) qr[d0] = *reinterpret_cast<const bf16x8*>(Qw + d0 * 16);
    const int sr = tid >> 4, sc = (tid & 15) * 8, vst0 = v_st(sr, sc), vst1 = v_st(32 + sr, sc);
    int krow[NCK], kcol[NCK];
#pragma unroll
    for (int i = 0; i < NCK; ++i) { const int ci = tid + 512 * i; krow[i] = ci / C8; kcol[i] = (ci % C8) * 8; }
    const int vb0 = (int)(uintptr_t)V_lds + v_rd_base(lane);
    bf16x8 vs0, vs1, ks[NCK];
#define ATT1_SLOAD(k0) do { vs0 = *reinterpret_cast<const bf16x8*>(&Vh[(long)((k0) + sr) * LDV + sc]); vs1 = *reinterpret_cast<const bf16x8*>(&Vh[(long)((k0) + 32 + sr) * LDV + sc]); \
    _Pragma("unroll") for (int c_ = 0; c_ < NCK; ++c_) ks[c_] = *reinterpret_cast<const bf16x8*>(&Kh[(long)((k0) + krow[c_]) * LDK + kcol[c_]]); } while (0)
#define ATT1_SWRITE(b) do { *(bf16x8*)(V_lds + (b) * SHM_V + vst0) = vs0; *(bf16x8*)(V_lds + (b) * SHM_V + vst1) = vs1; \
    _Pragma("unroll") for (int c_ = 0; c_ < NCK; ++c_) *(bf16x8*)(K_lds + (b) * SHM_K + kswz<DQK>(krow[c_], kcol[c_] * 2)) = ks[c_]; } while (0)
    const int NT = seq / KVBLK;
    ATT1_SLOAD(0); asm volatile("s_waitcnt vmcnt(0)" ::: "memory"); ATT1_SWRITE(0); __syncthreads();
    for (int j = 0; j < NT; ++j) {
        const int b = j & 1;
        if (j + 1 < NT) ATT1_SLOAD((j + 1) * KVBLK);
        ATT_SBAR();
        f32x16 p0, p1; float mn, alpha; bf16x8 pa0, pa1, pa2, pa3;
        qkt<DQK>(p0, p1, K_lds + b * SHM_K, qr, r32, hi);
        partialSM<DQK>(p0, p1, m_reg, mn, alpha);
        if (__any(alpha < 1.f)) { if (hi == 0) al_l[r32] = alpha; asm volatile("s_waitcnt lgkmcnt(0)" ::: "memory");
#pragma unroll
            for (int d = 0; d < 4; ++d)
#pragma unroll
                for (int r = 0; r < 16; ++r) o[d][r] *= al_l[crow(r, hi)]; }
        finishSM(p0, p1, alpha, l_reg, pa0, pa1, pa2, pa3); ATT_SBAR();
        pv_d0(o, vb0 + b * (int)SHM_V, pa0, pa1, pa2, pa3);
        if (j + 1 < NT) { ATT1_SWRITE(b ^ 1); }
        __syncthreads();
    }
    if (hi == 0) li_l[r32] = l_reg;
    asm volatile("s_waitcnt lgkmcnt(0)" ::: "memory");
    __syncthreads();
    float rli[16];
#pragma unroll
    for (int r = 0; r < 16; ++r) rli[r] = __builtin_amdgcn_rcpf(li_l[crow(r, hi)]);
    unsigned short* stg = (unsigned short*)(lds + wid * 8192);
#pragma unroll
    for (int r = 0; r < 16; ++r) { const int orow = crow(r, hi);
#pragma unroll
        for (int d0 = 0; d0 < 4; ++d0) { const unsigned w = cvtpk(o[d0][r] * rli[r], 0.f); stg[orow * 128 + d0 * 32 + r32] = (unsigned short)(w & 0xffffu); } }
    asm volatile("s_waitcnt lgkmcnt(0)" ::: "memory");
    bf16_t* Ow = Ob + (long)(wid * QBLK) * LDO;
#pragma unroll
    for (int i = 0; i < 8; ++i) { const int id = lane + 64 * i, row = id >> 4, c16 = id & 15;
        const u32x4 v = *(const u32x4*)((const char*)stg + row * 256 + c16 * 16);
        *(u32x4*)(Ow + (long)row * LDO + c16 * 8) = v; }
    asm volatile("s_waitcnt lgkmcnt(0)" ::: "memory");
    __syncthreads();
#undef ATT1_SLOAD
#undef ATT1_SWRITE
}
}
constexpr int DM = 2048, NBATCH = 2, SEQ = 4096, CTX = 256, RB = SEQ + CTX  , MROWS = NBATCH * RB  ;
constexpr int NMOD = 6 * DM, NEXP = 16384;
constexpr float EPS = 1e-6f;
constexpr int NWAVES = 8, NTHREADS = 512;
constexpr size_t MiB = 1u << 20;
constexpr size_t WS_CTL = 0, CTL_ZERO_BYTES = 64 * 1024;
constexpr size_t WS_MOD = 1 * MiB;
constexpr size_t WS_ROPE = 2 * MiB;
constexpr size_t WS_SMALL = 3 * MiB;
constexpr int SM_N1G = 0, SM_N2G = 8192, SM_AQG = 16384, SM_AKG = 16384 + 384, SM_CW = 16384 + 768, SM_CB = SM_CW + 6144, SM_CQG = SM_CB + 2048, SM_CKG = SM_CQG + 256, SM_END = SM_CKG + 256;
constexpr size_t WS_XW = 4 * MiB;
constexpr size_t WS_H = 72 * MiB;
constexpr size_t WS_P = 106 * MiB;
constexpr size_t WS_QRAW = 174 * MiB;
constexpr size_t WS_KVRAW = 200 * MiB;
constexpr size_t WS_Q = 234 * MiB;
constexpr size_t WS_K = 268 * MiB;
constexpr size_t WS_V = 294 * MiB;
constexpr size_t WS_CAT = 311 * MiB;
constexpr size_t WS_PQ = 345 * MiB;
constexpr size_t WS_IDX = 379 * MiB;
constexpr size_t WS_GATE = 384 * MiB;
constexpr size_t WS_WIN = 389 * MiB;
constexpr size_t WS_WUQ = 421 * MiB;
constexpr size_t WS_WUKV = 424 * MiB;
constexpr size_t WS_WEO = 426 * MiB;
constexpr size_t WS_WQKV = 442 * MiB;
constexpr size_t WS_WCO = 466 * MiB;
constexpr size_t WS_WPQ = 482 * MiB;
constexpr size_t WS_SUBK = 514 * MiB;
constexpr int ROWB = 1536;
constexpr size_t WS_U = 516 * MiB;
constexpr size_t WS_VT = 644 * MiB;
constexpr size_t WS_USC = 772 * MiB;
constexpr size_t WS_VSC = 773 * MiB;
constexpr size_t WS_END = 774 * MiB;
constexpr int CW_BAR = 4096;
constexpr int LDS_MISC = 131072 + 8192;
constexpr int LDS_BYTES = 147456;

#define LAS __attribute__((address_space(3)))
typedef unsigned short bf16_t;
typedef float f32x4 __attribute__((ext_vector_type(4)));
typedef unsigned u32x4 __attribute__((ext_vector_type(4)));
typedef unsigned u32x2 __attribute__((ext_vector_type(2)));
typedef short bf16x8 __attribute__((ext_vector_type(8)));
typedef float f32x16 __attribute__((ext_vector_type(16)));
typedef __bf16 bf16x2_t __attribute__((ext_vector_type(2)));
typedef float f32x2 __attribute__((ext_vector_type(2)));
typedef float f32x32 __attribute__((ext_vector_type(32)));
typedef unsigned u32x6 __attribute__((ext_vector_type(6)));

__device__ __forceinline__ unsigned f2bf(float f) { unsigned u = __builtin_bit_cast(unsigned, f); return (u + 0x7fffu + ((u >> 16) & 1u)) >> 16; }
__device__ __forceinline__ unsigned pk2(float lo, float hi) { return f2bf(lo) | (f2bf(hi) << 16); }
__device__ __forceinline__ float bf_lo(unsigned w) { return __builtin_bit_cast(float, w << 16); }
__device__ __forceinline__ float bf_hi(unsigned w) { return __builtin_bit_cast(float, w & 0xffff0000u); }
__device__ __forceinline__ float bf2f(bf16_t h) { return __builtin_bit_cast(float, (unsigned)h << 16); }
__device__ __forceinline__ float wave_sum(float v) {
#pragma unroll
    for (int o = 1; o < 64; o <<= 1) v += __shfl_xor(v, o);
    return v;
}
#define DPP_ADD(v, ctrl) ((v) + __builtin_bit_cast(float, __builtin_amdgcn_update_dpp(0, __builtin_bit_cast(int, (v)), (ctrl), 0xf, 0xf, true)))
__device__ __forceinline__ float wave_sum_dpp(float v) {
    v = DPP_ADD(v, 0xB1);
    v = DPP_ADD(v, 0x4E);
    v = DPP_ADD(v, 0x141);
    v = DPP_ADD(v, 0x140);
    const int vi = __builtin_bit_cast(int, v);
    const float s0 = __builtin_bit_cast(float, __builtin_amdgcn_readlane(vi, 0)), s1 = __builtin_bit_cast(float, __builtin_amdgcn_readlane(vi, 16));
    const float s2 = __builtin_bit_cast(float, __builtin_amdgcn_readlane(vi, 32)), s3 = __builtin_bit_cast(float, __builtin_amdgcn_readlane(vi, 48));
    return (s0 + s1) + (s2 + s3);
}
__device__ __forceinline__ float dot2_bf16(unsigned w, unsigned x, float acc) { return __builtin_amdgcn_fdot2_f32_bf16(__builtin_bit_cast(bf16x2_t, w), __builtin_bit_cast(bf16x2_t, x), acc, false); }
__device__ __forceinline__ float gelu_erf(float v) {
    const float av = fabsf(v), t = __builtin_amdgcn_rcpf(av * 0.2316418882f + 1.0f);
    float q = t * 0.5307027145f + (-0.7265760135f); q = q * t + 0.7107068705f; q = q * t + (-0.142248368f); q = q * t + 0.127414796f; q = q * t;
    const float e = __builtin_amdgcn_exp2f((v * v) * (-0.72134752044f));
    const float m = v * (q * e);
    return v < 0.f ? m : v - m;
}
#define XB_TMO      128
#define XB_XCNT(j)  (256  + 64 * (j))
#define XB_XSUB(j)  (1280 + 64 * (j))
#define XB_XGEN(j)  (2304 + 64 * (j))
#define XB_TOP      3328
#define XB_TOPGEN   3392
#define XCD_BAR_WORDS 3456
#define XB_SPIN_CAP (1u << 18)

__device__ __forceinline__ unsigned xb_ld(unsigned* p)              { return __hip_atomic_load(p, __ATOMIC_RELAXED, __HIP_MEMORY_SCOPE_AGENT); }
__device__ __forceinline__ unsigned xb_add(unsigned* p, unsigned v) { return __hip_atomic_fetch_add(p, v, __ATOMIC_RELAXED, __HIP_MEMORY_SCOPE_AGENT); }
__device__ __forceinline__ unsigned xb_xcc_id() { return (unsigned)__builtin_amdgcn_s_getreg((3 << 11) | 20) & 0xFu; }
#define XB_SPIN(cond, bar) do { unsigned _sp = 0; while (cond) { __builtin_amdgcn_s_sleep(1); \
    if ((++_sp & 255u) == 0u) { if (xb_ld(&(bar)[XB_TMO])) break; if (_sp > XB_SPIN_CAP) { atomicAdd(&(bar)[XB_TMO], 1u); break; } } } } while (0)

struct XcdBarrier {
    unsigned* bar; unsigned x;
    volatile LAS unsigned* st;
};

__device__ __forceinline__ XcdBarrier xcd_barrier_post(unsigned* bar, volatile LAS unsigned* st) {
    XcdBarrier b; b.bar = bar; b.x = xb_xcc_id(); b.st = st;
    if (threadIdx.x == 0) (void)xb_add(&bar[XB_XCNT(b.x)], 1u);
    return b;
}
__device__ __forceinline__ void xcd_barrier_complete(unsigned* bar, unsigned x, unsigned& nloc, unsigned& nx) {
    const unsigned G = gridDim.x * gridDim.y * gridDim.z;
    unsigned sum, cnt, mine, sp = 0u;
    for (;;) {
        sum = 0u; cnt = 0u; mine = 0u;
#pragma unroll
        for (unsigned j = 0; j < 16; ++j) { const unsigned c = xb_ld(&bar[XB_XCNT(j)]); sum += c; cnt += (c > 0u) ? 1u : 0u; mine = (j == x) ? c : mine; }
        if (sum == G) break;
        __builtin_amdgcn_s_sleep(1);
        if ((++sp & 255u) == 0u) { if (xb_ld(&bar[XB_TMO])) break; if (sp > XB_SPIN_CAP) { atomicAdd(&bar[XB_TMO], 1u); break; } }
    }
    nloc = mine > 0u ? mine : 1u; nx = cnt > 0u ? cnt : 1u;
}

__device__ __forceinline__ void xcd_barrier(const XcdBarrier& b) {
    asm volatile("s_waitcnt vmcnt(0)" ::: "memory");
    __syncthreads();
    if (threadIdx.x == 0) {
        unsigned* bar = b.bar; unsigned bx = b.x;
        asm volatile("" : "+s"(bar), "+s"(bx));
        __builtin_amdgcn_s_waitcnt(0);
        unsigned nloc = b.st[0], nx = b.st[1];
        if (nloc == 0u) { xcd_barrier_complete(bar, bx, nloc, nx); b.st[0] = nloc; b.st[1] = nx; }
        const unsigned old = xb_add(&bar[XB_XSUB(bx)], 1u);
        const unsigned gen = old / nloc;
        if (old + 1u == (gen + 1u) * nloc) {
            __builtin_amdgcn_fence(__ATOMIC_RELEASE, "agent");
            asm volatile("s_waitcnt vmcnt(0)" ::: "memory");
            const unsigned og = xb_add(&bar[XB_TOP], 1u);
            const unsigned tg = og / nx;
            if (og + 1u == (tg + 1u) * nx) xb_add(&bar[XB_TOPGEN], 1u);
            else XB_SPIN(xb_ld(&bar[XB_TOPGEN]) == tg, bar);
            __builtin_amdgcn_fence(__ATOMIC_ACQUIRE, "agent");
            xb_add(&bar[XB_XGEN(bx)], 1u);
            asm volatile("s_waitcnt vmcnt(0)" ::: "memory");
        } else {
            XB_SPIN(xb_ld(&bar[XB_XGEN(bx)]) == gen, bar);
            __builtin_amdgcn_fence(__ATOMIC_ACQUIRE, "agent");
            asm volatile("s_waitcnt vmcnt(0)" ::: "memory");
        }
    }
    __syncthreads();
}
struct Frame {
    LAS unsigned char* lds;
    int tid, lane, wave, vcu, G, gw, NGW;
    unsigned char* ws;
};
__device__ __forceinline__ int opaque_v(int v) { asm volatile("" : "+v"(v)); return v; }
__device__ __forceinline__ int phase_tid(int wave) { int lane; asm volatile("v_mbcnt_lo_u32_b32 %0, -1, 0\n\tv_mbcnt_hi_u32_b32 %0, -1, %0" : "=v"(lane)); return wave * 64 + lane; }
__device__ __forceinline__ Frame phase_frame(const Frame& F0) { Frame F = F0; F.tid = phase_tid(F0.wave); F.lane = F.tid & 63; return F; }
__device__ __forceinline__ float swap32(float v, int lane) { auto rr = __builtin_amdgcn_permlane32_swap(__float_as_uint(v), __float_as_uint(v), false, false); return __uint_as_float(lane < 32 ? rr[1] : rr[0]); }
__device__ __forceinline__ int row_cls(int row) { const int b = row / RB, i = row - b * RB; return i < CTX ? 2 : b; }

__device__ __forceinline__ void p0_transpose_item(const float* W, int K, int N, bf16_t* WT, const float* gain, LAS float* scr, int item, int lane, bool perm_q = false) {
    const int nblk = N / 32, kb = item / nblk, nb = item % nblk, k0 = 64 * kb, n0 = 32 * nb;
#pragma unroll 8
    for (int i = 0; i < 32; ++i) { const int kk = 2 * i + (lane >> 5); float v = W[(size_t)(k0 + kk) * N + n0 + (lane & 31)]; if (gain) v *= gain[k0 + kk]; scr[kk * 33 + (lane & 31)] = v; }
    asm volatile("s_waitcnt lgkmcnt(0)" ::: "memory");
    const int c = lane & 7;
#pragma unroll
    for (int j = 0; j < 4; ++j) { const int n = (lane >> 3) + 8 * j; const LAS float* s = scr + (8 * c) * 33 + n;
        u32x4 o; o.x = pk2(s[0 * 33], s[1 * 33]); o.y = pk2(s[2 * 33], s[3 * 33]); o.z = pk2(s[4 * 33], s[5 * 33]); o.w = pk2(s[6 * 33], s[7 * 33]);
        int nn = n0 + n; if (perm_q) { const int hh = nn / 192, e = nn - hh * 192; nn = (e < 128) ? hh * 128 + e : 1024 + hh * 64 + (e - 128); }
        *(u32x4*)(WT + (size_t)nn * K + k0 + 8 * c) = o; }
    asm volatile("s_waitcnt lgkmcnt(0)" ::: "memory");
}
struct TrDesc { const float* W; const float* gain; bf16_t* WT; int K, N, items; };

__device__ __forceinline__ void p0_gemv_task(Frame& F, int task, const float* ada_w, const float* ada_b, float* mod) {
    LAS float* sv = (LAS float*)F.lds; LAS float* part = (LAS float*)(F.lds + 32768);
    const int l = task / 48, n0 = (task % 48) * 256;
    const float* Wp = ada_w + (size_t)l * DM * NMOD + n0 + F.lane * 4 + (size_t)(F.wave * 256) * NMOD;
    f32x4 a0 = {0, 0, 0, 0}, a1 = a0, a2 = a0;
    for (int k = 0; k < 256; k += 8) {
        f32x4 w[8];
#pragma unroll
        for (int u = 0; u < 8; ++u) w[u] = *(const f32x4*)(Wp + (size_t)(k + u) * NMOD);
#pragma unroll
        for (int u = 0; u < 8; ++u) { const int kk = F.wave * 256 + k + u; const float s0 = sv[kk], s1 = sv[2048 + kk], s2 = sv[4096 + kk];
            a0 += w[u] * s0; a1 += w[u] * s1; a2 += w[u] * s2; }
    }
    *(LAS f32x4*)(part + (F.wave * 3 + 0) * 256 + F.lane * 4) = a0;
    *(LAS f32x4*)(part + (F.wave * 3 + 1) * 256 + F.lane * 4) = a1;
    *(LAS f32x4*)(part + (F.wave * 3 + 2) * 256 + F.lane * 4) = a2;
    __syncthreads();
    for (int o = F.tid; o < 768; o += NTHREADS) { const int r = o >> 8, c = o & 255; float s = 0.f;
#pragma unroll
        for (int w = 0; w < 8; ++w) s += part[(w * 3 + r) * 256 + c];
        mod[(size_t)(l * 3 + r) * NMOD + n0 + c] = s + ada_b[(size_t)l * NMOD + n0 + c]; }
    __syncthreads();
}

__device__ __forceinline__ void p0_prologue(Frame& F, const float* const* in) {
    unsigned char* ws = F.ws;
    {
        LAS float* sv = (LAS float*)F.lds;
        for (int i = F.tid; i < 3 * DM; i += NTHREADS) { const int r = i / DM, k = i - r * DM; const float x = (r < 2) ? in[1][r * DM + k] : in[3][k]; sv[i] = x / (1.f + __expf(-x)); }
        __syncthreads();
        for (int task = F.vcu; task < 192; task += F.G) p0_gemv_task(F, task, in[4], in[5], (float*)(ws + WS_MOD));
        __syncthreads();
    }
    {
        float* xw = (float*)(ws + WS_XW);
        for (int row = F.gw; row < MROWS; row += F.NGW) { const int b = row / RB, i = row - b * RB;
            const float* src = (i < CTX) ? in[2] + (size_t)(b * CTX + i) * DM : in[0] + (size_t)(b * SEQ + i - CTX) * DM;
            const f32x4* s4 = (const f32x4*)src + F.lane; f32x4* d4 = (f32x4*)(xw + (size_t)row * DM) + F.lane;
#pragma unroll
            for (int j = 0; j < 8; ++j) d4[64 * j] = s4[64 * j]; }
    }
    {
        float* sm = (float*)(ws + WS_SMALL); const int g = F.vcu * NTHREADS + F.tid;
        if (g < 8192) { sm[SM_N1G + g] = in[6][g]; sm[SM_N2G + g] = in[7][g]; }
        if (g < 384) { sm[SM_AQG + g] = in[13][g]; sm[SM_AKG + g] = in[14][g]; }
        if (g < 6144) sm[SM_CW + g] = in[15][g];
        if (g < 2048) sm[SM_CB + g] = in[16][g];
        if (g < 256) { sm[SM_CQG + g] = in[19][g]; sm[SM_CKG + g] = in[20][g]; }
    }
    {
        float* rc = (float*)(ws + WS_ROPE); float* ra = rc + 64 * 32 * 2;
        const int g = F.vcu * NTHREADS + F.tid;
        if (g < 64 * 32) { const int pos = g >> 5, f = g & 31; const float fr = exp2f(-(float)f * (13.287712379549449f / 32.f)); const float ang = (float)pos * fr;
            rc[2 * g] = cosf(ang); rc[2 * g + 1] = sinf(ang); }
        else if (g < 64 * 32 + 64 * 16) { const int e = g - 64 * 32, pos = e >> 4, f = e & 15; const float fr = exp2f(-(float)f * (13.287712379549449f / 16.f)); const float ang = (float)pos * fr;
            ra[2 * e] = cosf(ang); ra[2 * e + 1] = sinf(ang); }
    }
    {
        LAS float* scr = (LAS float*)(F.lds + F.wave * 16384);
        TrDesc d[16]; int nd = 0;
#pragma unroll
        for (int i = 0; i < 2; ++i) {
            d[nd++] = TrDesc{in[8] + (size_t)i * DM * 3904, nullptr, (bf16_t*)(ws + WS_WIN) + (size_t)i * 4096 * DM, DM, 3904, 32 * 122};
            d[nd++] = TrDesc{in[11] + (size_t)i * 512 * 1536, in[9] + i * 512, (bf16_t*)(ws + WS_WUQ) + (size_t)i * 1536 * 512, 512, 1536, 8 * 48};
            d[nd++] = TrDesc{in[12] + (size_t)i * 256 * 2048, in[10] + i * 256, (bf16_t*)(ws + WS_WUKV) + (size_t)i * 2048 * 256, 256, 2048, 4 * 64};
            d[nd++] = TrDesc{in[17] + (size_t)i * DM * DM, nullptr, (bf16_t*)(ws + WS_WEO) + (size_t)i * DM * DM, DM, DM, 32 * 64};
            d[nd++] = TrDesc{in[18] + (size_t)i * DM * 3072, nullptr, (bf16_t*)(ws + WS_WQKV) + (size_t)i * 3072 * DM, DM, 3072, 32 * 96};
            d[nd++] = TrDesc{in[21] + (size_t)i * DM * DM, nullptr, (bf16_t*)(ws + WS_WCO) + (size_t)i * DM * DM, DM, DM, 32 * 64};
        }
#pragma unroll
        for (int l = 0; l < 4; ++l) d[nd++] = TrDesc{in[22] + (size_t)l * DM * DM, nullptr, (bf16_t*)(ws + WS_WPQ) + (size_t)l * DM * DM, DM, DM, 32 * 64};
#pragma unroll
        for (int m = 0; m < 16; ++m) {
            for (int it = F.gw; it < d[m].items; it += F.NGW) p0_transpose_item(d[m].W, d[m].K, d[m].N, d[m].WT, d[m].gain, scr, it, F.lane, d[m].K == 512);
        }
        for (int i = F.gw * 64 + F.lane; i < 2 * 192 * DM / 8; i += F.NGW * 64) { const int li = i / (192 * DM / 8), r = i % (192 * DM / 8);
            *(u32x4*)((bf16_t*)(ws + WS_WIN) + (size_t)li * 4096 * DM + (size_t)3904 * DM + (size_t)r * 8) = (u32x4){0u, 0u, 0u, 0u}; }
    }
    {
        const size_t n_sk = (size_t)4 * 16 * 128 * 128 / 8;
        const size_t gt = (size_t)F.vcu * NTHREADS + F.tid, GT = (size_t)F.G * NTHREADS;
        for (size_t j = gt; j < n_sk; j += GT) {
            const f32x4 a = *(const f32x4*)(in[23] + j * 8), b = *(const f32x4*)(in[23] + j * 8 + 4);
            u32x4 o; o.x = pk2(a.x, a.y); o.y = pk2(a.z, a.w); o.z = pk2(b.x, b.y); o.w = pk2(b.z, b.w);
            *(u32x4*)((bf16_t*)(ws + WS_SUBK) + j * 8) = o;
        }
    }
    {
        for (int r = F.gw; r < 2 * 4 * NEXP; r += F.NGW) {
            const int tab = r / (4 * NEXP), rr = r - tab * (4 * NEXP);
            const float* src = (tab ? in[25] : in[24]) + (size_t)rr * DM + F.lane * 16;
            f32x4 v[8];
#pragma unroll
            for (int j = 0; j < 2; ++j)
#pragma unroll
                for (int q = 0; q < 4; ++q) v[j * 4 + q] = *(const f32x4*)(src + j * 1024 + q * 4);
            float am = 0.f;
#pragma unroll
            for (int q = 0; q < 8; ++q) am = fmaxf(fmaxf(am, fmaxf(fabsf(v[q].x), fabsf(v[q].y))), fmaxf(fabsf(v[q].z), fabsf(v[q].w)));
#pragma unroll
            for (int o = 1; o < 64; o <<= 1) am = fmaxf(am, __shfl_xor(am, o));
            am = fmaxf(am, 1e-30f);
            const float sc = 7.5f / am;
            f32x16 a, b;
#pragma unroll
            for (int q = 0; q < 8; ++q) { const f32x4 x = v[q] * sc; a[2 * q] = x.x; b[2 * q] = x.y; a[2 * q + 1] = x.z; b[2 * q + 1] = x.w; }
            const u32x6 w = __builtin_amdgcn_cvt_scalef32_2xpk16_fp6_f32(a, b, 1.0f);
            unsigned char* dst = ws + (tab ? WS_VT : WS_U) + (size_t)rr * ROWB;
            *(u32x4*)(dst + F.lane * 16) = (u32x4){w[0], w[1], w[2], w[3]};
            *(u32x2*)(dst + 1024 + F.lane * 8) = (u32x2){w[4], w[5]};
            if (F.lane == 0) ((float*)(ws + (tab ? WS_VSC : WS_USC)))[rr] = am * (1.0f / 7.5f);
        }
    }
}

__device__ __forceinline__ void norm_phase(const Frame& F0, const float* xw, const float* g, const float* modl  , int off_sh, int off_sc, bf16_t* H, bool lat_only) {
    const Frame F = phase_frame(F0);
    f32x4 gm[8], shv[8]; int cur_cls = -1;
    int row = F.gw; if (lat_only) while (row < MROWS && row_cls(row) == 2) row += F.NGW;
    f32x4 v[8];
    if (row < MROWS) { const f32x4* x4 = (const f32x4*)(xw + (size_t)row * DM) + F.lane;
#pragma unroll
        for (int j = 0; j < 8; ++j) v[j] = x4[64 * j]; }
    while (row < MROWS) {
        int nrow = row + F.NGW; if (lat_only) while (nrow < MROWS && row_cls(nrow) == 2) nrow += F.NGW;
        f32x4 vn[8];
        if (nrow < MROWS) { const f32x4* x4 = (const f32x4*)(xw + (size_t)nrow * DM) + F.lane;
#pragma unroll
            for (int j = 0; j < 8; ++j) vn[j] = x4[64 * j]; }
        const int cls = row_cls(row);
        if (cls != cur_cls) {
            cur_cls = cls;
            const f32x4* g4 = (const f32x4*)g + F.lane; const f32x4* sc4 = (const f32x4*)(modl + (size_t)cls * NMOD + off_sc) + F.lane; const f32x4* sh4 = (const f32x4*)(modl + (size_t)cls * NMOD + off_sh) + F.lane;
#pragma unroll
            for (int j = 0; j < 8; ++j) { gm[j] = g4[64 * j] * (sc4[64 * j] + 1.0f); shv[j] = sh4[64 * j]; }
        }
        float ss = 0.f;
#pragma unroll
        for (int j = 0; j < 8; ++j) ss += (v[j].x * v[j].x + v[j].y * v[j].y) + (v[j].z * v[j].z + v[j].w * v[j].w);
        const float rstd = 1.0f / sqrtf(wave_sum_dpp(ss) * (1.f / DM) + EPS);
        u32x2* o2 = (u32x2*)(H + (size_t)row * DM) + F.lane;
#pragma unroll
        for (int j = 0; j < 8; ++j) { const f32x4 y = (v[j] * rstd) * gm[j] + shv[j]; u32x2 o; o.x = pk2(y.x, y.y); o.y = pk2(y.z, y.w); o2[64 * j] = o; }
        row = nrow;
#pragma unroll
        for (int j = 0; j < 8; ++j) v[j] = vn[j];
    }
}

#define DPP_MOV(v, ctrl) __builtin_bit_cast(float, __builtin_amdgcn_update_dpp(0, __builtin_bit_cast(int, (v)), (ctrl), 0xf, 0xf, true))
__device__ __forceinline__ float row16_sum(float v) { v = DPP_ADD(v, 0xB1); v = DPP_ADD(v, 0x4E); v = DPP_ADD(v, 0x141); v = DPP_ADD(v, 0x140); return v; }
__device__ __forceinline__ void prep_odd_phase(const Frame& F0, const bf16_t* P, const float* qg, const float* kg, const float* rope_c, bf16_t* Q, bf16_t* Kb) {
    const Frame F = phase_frame(F0);
    const int l16 = F.lane & 15, d0 = l16 * 8;
    float gq[8], gk[8];
#pragma unroll
    for (int e = 0; e < 8; ++e) { gq[e] = qg[d0 + e]; gk[e] = kg[d0 + e]; }
    const bool lowhalf = l16 < 8;
    const int j0 = (l16 & 7) * 8;
    int row = F.gw;
    u32x4 w[5];
    if (row < MROWS) { const u32x4* pr = (const u32x4*)(P + (size_t)row * 3072) + F.lane;
#pragma unroll
        for (int k = 0; k < 5; ++k) w[k] = pr[64 * k]; }
    while (row < MROWS) {
        const int nrow = row + F.NGW;
        u32x4 wn[5];
        if (nrow < MROWS) { const u32x4* pr = (const u32x4*)(P + (size_t)nrow * 3072) + F.lane;
#pragma unroll
            for (int k = 0; k < 5; ++k) wn[k] = pr[64 * k]; }
        const int b = row / RB, i = row - b * RB; const bool lat = i >= CTX; const int t = i - CTX;
        float cs[8], sn[8];
#pragma unroll
        for (int e = 0; e < 8; ++e) { cs[e] = 1.f; sn[e] = 0.f; }
        if (lat) { const int pos = (j0 < 32) ? (t >> 6) : (t & 63); const f32x4* tb = (const f32x4*)(rope_c + ((pos << 5) + (j0 & 31)) * 2);
#pragma unroll
            for (int q = 0; q < 4; ++q) { const f32x4 c = tb[q]; cs[2 * q] = c.x; sn[2 * q] = c.y; cs[2 * q + 1] = c.z; sn[2 * q + 1] = c.w; } }
#pragma unroll
        for (int k = 0; k < 5; ++k) {
            const unsigned ww[4] = {w[k].x, w[k].y, w[k].z, w[k].w};
            float x[8]; float ss = 0.f;
#pragma unroll
            for (int q = 0; q < 4; ++q) { x[2 * q] = bf_lo(ww[q]); x[2 * q + 1] = bf_hi(ww[q]); ss += x[2 * q] * x[2 * q] + x[2 * q + 1] * x[2 * q + 1]; }
            const float rstd = 1.0f / sqrtf(row16_sum(ss) * (1.f / 128.f) + EPS);
            unsigned ow[4]; float o[8];
#pragma unroll
            for (int e = 0; e < 8; ++e) { const float y = x[e] * rstd * (k < 4 ? gq[e] : gk[e]); const float yp = DPP_MOV(y, 0x128);
                o[e] = lowhalf ? (y * cs[e] - yp * sn[e]) : (y * cs[e] + yp * sn[e]); }
#pragma unroll
            for (int q = 0; q < 4; ++q) ow[q] = pk2(o[2 * q], o[2 * q + 1]);
            if (k < 4) *((u32x4*)(Q + (size_t)row * 2048) + 64 * k + F.lane) = (u32x4){ow[0], ow[1], ow[2], ow[3]};
            else *((u32x4*)(Kb + (size_t)row * 512) + F.lane) = (u32x4){ow[0], ow[1], ow[2], ow[3]};
        }
        row = nrow;
#pragma unroll
        for (int k = 0; k < 5; ++k) w[k] = wn[k];
    }
}

struct PrepEvenRow { u32x4 cq; u32x2 ckv, kr; u32x4 qn[2]; u32x2 qr[2]; u32x4 kn[2], vv[2]; };
__device__ __forceinline__ void prep_even_load(PrepEvenRow& R, const bf16_t* P, const bf16_t* QR, const bf16_t* KVR, int row, int lane) {
    const bf16_t* pr = P + (size_t)row * 4096; const int l16 = lane & 15, hq = lane >> 4;
    R.cq = *((const u32x4*)pr + lane); R.ckv = *((const u32x2*)(pr + 512) + lane); R.kr = *((const u32x2*)(pr + 768) + l16);
    const bf16_t* q = QR + (size_t)row * 1536; const bf16_t* kv = KVR + (size_t)row * 2048;
#pragma unroll
    for (int k = 0; k < 2; ++k) { R.qn[k] = *((const u32x4*)q + 64 * k + lane); R.qr[k] = *((const u32x2*)(q + 1024) + 64 * k + lane);
        const bf16_t* kh = kv + (4 * k + hq) * 256 + l16 * 8; R.kn[k] = *(const u32x4*)kh; R.vv[k] = *(const u32x4*)(kh + 128); }
}
__device__ __forceinline__ void prep_even_phase(const Frame& F0, const bf16_t* P, const bf16_t* QR, const bf16_t* KVR, const float* qg, const float* kg, const float* rope_a, bf16_t* Q, bf16_t* Kb, bf16_t* Vb) {
    const Frame F = phase_frame(F0);
    const int lane = F.lane, l16 = lane & 15, hq = lane >> 4, d0 = l16 * 8, r0 = l16 * 4;
    float gqn[8], gkn[8], gqr[4], gkr[4];
#pragma unroll
    for (int e = 0; e < 8; ++e) { gqn[e] = qg[d0 + e]; gkn[e] = kg[d0 + e]; }
#pragma unroll
    for (int e = 0; e < 4; ++e) { gqr[e] = qg[128 + r0 + e]; gkr[e] = kg[128 + r0 + e]; }
    const bool lowhalf = l16 < 8; const int j0 = (l16 & 7) * 4;
    int row = F.gw;
    PrepEvenRow R;
    if (row < MROWS) prep_even_load(R, P, QR, KVR, row, lane);
    while (row < MROWS) {
        const int nrow = row + F.NGW;
        PrepEvenRow Rn;
        if (nrow < MROWS) prep_even_load(Rn, P, QR, KVR, nrow, lane);
        const int b = row / RB, i = row - b * RB; const bool lat = i >= CTX; const int t = i - CTX;
        float cs[4], sn[4];
#pragma unroll
        for (int e = 0; e < 4; ++e) { cs[e] = 1.f; sn[e] = 0.f; }
        if (lat) { const int pos = (j0 < 16) ? (t >> 6) : (t & 63); const f32x4* tb = (const f32x4*)(rope_a + ((pos << 4) + (j0 & 15)) * 2);
            const f32x4 c0 = tb[0], c1 = tb[1]; cs[0] = c0.x; sn[0] = c0.y; cs[1] = c0.z; sn[1] = c0.w; cs[2] = c1.x; sn[2] = c1.y; cs[3] = c1.z; sn[3] = c1.w; }
        float ssq = 0.f, sskv = 0.f;
        { const unsigned ww[4] = {R.cq.x, R.cq.y, R.cq.z, R.cq.w};
#pragma unroll
          for (int q = 0; q < 4; ++q) { const float a = bf_lo(ww[q]), c = bf_hi(ww[q]); ssq += a * a + c * c; } }
        { const float a = bf_lo(R.ckv.x), c = bf_hi(R.ckv.x), d = bf_lo(R.ckv.y), e = bf_hi(R.ckv.y); sskv = (a * a + c * c) + (d * d + e * e); }
        const float rstd_q = 1.0f / sqrtf(wave_sum_dpp(ssq) * (1.f / 512.f) + EPS), rstd_kv = 1.0f / sqrtf(wave_sum_dpp(sskv) * (1.f / 256.f) + EPS);
        const float krv[4] = {bf_lo(R.kr.x), bf_hi(R.kr.x), bf_lo(R.kr.y), bf_hi(R.kr.y)};
        const float krss = (krv[0] * krv[0] + krv[1] * krv[1]) + (krv[2] * krv[2] + krv[3] * krv[3]);
#pragma unroll
        for (int k = 0; k < 2; ++k) {
            const int h = 4 * k + hq;
            {
                const unsigned wn[4] = {R.qn[k].x, R.qn[k].y, R.qn[k].z, R.qn[k].w};
                float xn[8], xr[4]; float ss = 0.f;
#pragma unroll
                for (int q = 0; q < 4; ++q) { xn[2 * q] = bf_lo(wn[q]) * rstd_q; xn[2 * q + 1] = bf_hi(wn[q]) * rstd_q; ss += xn[2 * q] * xn[2 * q] + xn[2 * q + 1] * xn[2 * q + 1]; }
                xr[0] = bf_lo(R.qr[k].x) * rstd_q; xr[1] = bf_hi(R.qr[k].x) * rstd_q; xr[2] = bf_lo(R.qr[k].y) * rstd_q; xr[3] = bf_hi(R.qr[k].y) * rstd_q;
                ss += (xr[0] * xr[0] + xr[1] * xr[1]) + (xr[2] * xr[2] + xr[3] * xr[3]);
                const float r2 = 1.0f / sqrtf(row16_sum(ss) * (1.f / 192.f) + EPS);
                unsigned on[4]; float o[4];
#pragma unroll
                for (int q = 0; q < 4; ++q) on[q] = pk2(xn[2 * q] * r2 * gqn[2 * q], xn[2 * q + 1] * r2 * gqn[2 * q + 1]);
#pragma unroll
                for (int e = 0; e < 4; ++e) { const float y = xr[e] * r2 * gqr[e]; const float yp = DPP_MOV(y, 0x128); o[e] = lowhalf ? (y * cs[e] - yp * sn[e]) : (y * cs[e] + yp * sn[e]); }
                bf16_t* qo = Q + (size_t)row * 1536 + h * 192;
                *(u32x4*)(qo + d0) = (u32x4){on[0], on[1], on[2], on[3]};
                *(u32x2*)(qo + 128 + r0) = (u32x2){pk2(o[0], o[1]), pk2(o[2], o[3])};
            }
            {
                const unsigned wn[4] = {R.kn[k].x, R.kn[k].y, R.kn[k].z, R.kn[k].w}, wv[4] = {R.vv[k].x, R.vv[k].y, R.vv[k].z, R.vv[k].w};
                float xn[8]; float ss = krss;
#pragma unroll
                for (int q = 0; q < 4; ++q) { xn[2 * q] = bf_lo(wn[q]) * rstd_kv; xn[2 * q + 1] = bf_hi(wn[q]) * rstd_kv; ss += xn[2 * q] * xn[2 * q] + xn[2 * q + 1] * xn[2 * q + 1]; }
                const float r2 = 1.0f / sqrtf(row16_sum(ss) * (1.f / 192.f) + EPS);
                unsigned on[4], ov[4]; float o[4];
#pragma unroll
                for (int q = 0; q < 4; ++q) { on[q] = pk2(xn[2 * q] * r2 * gkn[2 * q], xn[2 * q + 1] * r2 * gkn[2 * q + 1]); ov[q] = pk2(bf_lo(wv[q]) * rstd_kv, bf_hi(wv[q]) * rstd_kv); }
#pragma unroll
                for (int e = 0; e < 4; ++e) { const float y = krv[e] * r2 * gkr[e]; const float yp = DPP_MOV(y, 0x128); o[e] = lowhalf ? (y * cs[e] - yp * sn[e]) : (y * cs[e] + yp * sn[e]); }
                bf16_t* ko = Kb + (size_t)row * 1536 + h * 192;
                *(u32x4*)(ko + d0) = (u32x4){on[0], on[1], on[2], on[3]};
                *(u32x2*)(ko + 128 + r0) = (u32x2){pk2(o[0], o[1]), pk2(o[2], o[3])};
                *(u32x4*)(Vb + (size_t)row * 1024 + h * 128 + d0) = (u32x4){ov[0], ov[1], ov[2], ov[3]};
            }
        }
        row = nrow; R = Rn;
    }
}

__device__ __forceinline__ void conv_phase(const Frame& F0, const bf16_t* P, const float* cw  , const float* cb  , bf16_t* CAT) {
    const Frame F = phase_frame(F0);
    const int gt = F.vcu * NTHREADS + F.tid, GT = F.G * NTHREADS;
    for (int it = gt; it < MROWS * 128; it += GT) {
        const int row = it >> 7, c0 = (it & 127) * 8; const int b = row / RB, i = row - b * RB;
        const bool first = (i == 0) || (i == CTX), last = (i == CTX - 1) || (i == RB - 1);
        const bf16_t* pr = P + (size_t)row * 4096 + 832 + c0;
        const u32x4 bg = *(const u32x4*)pr, cg = *(const u32x4*)(pr + 1024), hz = *(const u32x4*)(pr + 2048);
        u32x4 cgm = {0u, 0u, 0u, 0u}, hzm = cgm, cgp = cgm, hzp = cgm;
        if (!first) { cgm = *(const u32x4*)(pr - 4096 + 1024); hzm = *(const u32x4*)(pr - 4096 + 2048); }
        if (!last) { cgp = *(const u32x4*)(pr + 4096 + 1024); hzp = *(const u32x4*)(pr + 4096 + 2048); }
        const unsigned bgw[4] = {bg.x, bg.y, bg.z, bg.w}, cgw[4] = {cg.x, cg.y, cg.z, cg.w}, hzw[4] = {hz.x, hz.y, hz.z, hz.w};
        const unsigned cmw[4] = {cgm.x, cgm.y, cgm.z, cgm.w}, hmw[4] = {hzm.x, hzm.y, hzm.z, hzm.w}, cpw[4] = {cgp.x, cgp.y, cgp.z, cgp.w}, hpw[4] = {hzp.x, hzp.y, hzp.z, hzp.w};
        unsigned ow[4];
#pragma unroll
        for (int q = 0; q < 4; ++q) {
            const int c = c0 + 2 * q;
            const float u0a = bf_lo(cgw[q]) * bf_lo(hzw[q]), u0b = bf_hi(cgw[q]) * bf_hi(hzw[q]);
            const float uma = bf_lo(cmw[q]) * bf_lo(hmw[q]), umb = bf_hi(cmw[q]) * bf_hi(hmw[q]);
            const float upa = bf_lo(cpw[q]) * bf_lo(hpw[q]), upb = bf_hi(cpw[q]) * bf_hi(hpw[q]);
            const float ra = bf_lo(bgw[q]) * (uma * cw[c] + u0a * cw[1024 + c] + upa * cw[2048 + c] + cb[c]);
            const float rb = bf_hi(bgw[q]) * (umb * cw[c + 1] + u0b * cw[1024 + c + 1] + upb * cw[2048 + c + 1] + cb[c + 1]);
            ow[q] = pk2(ra, rb);
        }
        *(u32x4*)(CAT + (size_t)row * DM + 1024 + c0) = (u32x4){ow[0], ow[1], ow[2], ow[3]};
    }
}
__device__ __forceinline__ void attn_even_phase(const Frame& F0, const bf16_t* Q, const bf16_t* Kb, const bf16_t* Vb, bf16_t* CAT) {
    const Frame F = phase_frame(F0);
    for (int u = F.vcu; u < 272; u += F.G) {
        int b, h, qt, nk;
        if (u < 256) { b = u >> 7; h = (u >> 4) & 7; qt = 1 + (u & 15); nk = RB; } else { const int v = u - 256; b = v >> 3; h = v & 7; qt = 0; nk = CTX; }
        const size_t r0 = (size_t)b * RB;
        att::attn_body1<192, 1536, 1536, 1024, 2048>(Q + (r0 + qt * 256) * 1536 + h * 192, Kb + r0 * 1536 + h * 192, Vb + r0 * 1024 + h * 128, CAT + (r0 + qt * 256) * 2048 + h * 128, nk, (char*)F.lds, phase_tid(F.wave));
    }
}
__device__ __forceinline__ void attn_odd_phase(const Frame& F0, const bf16_t* Q, const bf16_t* Kb, const bf16_t* P, bf16_t* CAT, bool lat_only) {
    const Frame F = phase_frame(F0);
    const int nunits = lat_only ? 512 : 544;
    for (int u = F.vcu; u < nunits; u += F.G) {
        int b, hq, qt, nk;
        if (u < 512) { b = u >> 8; hq = (u >> 4) & 15; qt = 1 + (u & 15); nk = RB; } else { const int v = u - 512; b = v >> 4; hq = v & 15; qt = 0; nk = CTX; }
        const int kvh = hq >> 2; const size_t r0 = (size_t)b * RB;
        att::attn_body<128, 2048, 512, 3072, 2048, 2>(Q + (r0 + qt * 256) * 2048 + hq * 128, Kb + r0 * 512 + kvh * 128, P + r0 * 3072 + 2560 + kvh * 128, CAT + (r0 + qt * 256) * 2048 + hq * 128, nk, (char*)F.lds, phase_tid(F.wave));
    }
}

__device__ __forceinline__ int crow32(int r, int hi) { return (r & 3) + 8 * (r >> 2) + 4 * hi; }
__device__ __forceinline__ int fkey(int b) { return b ^ ((b >> 31) & 0x7fffffff); }
#define TK_CE(x, y) do { const int hi_ = max((x), (y)), lo_ = min((x), (y)); (x) = hi_; (y) = lo_; } while (0)
template <int N> __device__ __forceinline__ void tk_sort(int* v) {
#pragma unroll
    for (int k = 2; k <= N; k <<= 1)
#pragma unroll
        for (int j = k >> 1; j > 0; j >>= 1)
#pragma unroll
            for (int i = 0; i < N; ++i) { const int l = i ^ j; if (l > i) { if ((i & k) == 0) TK_CE(v[i], v[l]); else TK_CE(v[l], v[i]); } }
}
__device__ __forceinline__ void tk_merge16(int* a, const int* b) {
#pragma unroll
    for (int i = 0; i < 16; ++i) a[i] = max(a[i], b[15 - i]);
#pragma unroll
    for (int j = 8; j > 0; j >>= 1)
#pragma unroll
        for (int i = 0; i < 16; ++i) { const int l = i ^ j; if (l > i) TK_CE(a[i], a[l]); }
}
__device__ __forceinline__ void tk_merge_partner(int* a) {
    int lo[16], hi[16];
#pragma unroll
    for (int i = 0; i < 16; ++i) { auto rr = __builtin_amdgcn_permlane32_swap((unsigned)a[i], (unsigned)a[i], false, false); lo[i] = (int)rr[0]; hi[i] = (int)rr[1]; }
    tk_merge16(lo, hi);
#pragma unroll
    for (int i = 0; i < 16; ++i) a[i] = lo[i];
}
__device__ __forceinline__ void peer_topk_phase(const Frame& F0, const bf16_t* PQ, const bf16_t* subk  , int* IDX, float* GATE, bool lat_only) {
    const Frame F = phase_frame(F0);
    const int h = F.vcu & 7, jw = (F.vcu >> 3) * NWAVES + F.wave, nwh = (F.G >> 3) * NWAVES;
    {
        const bf16_t* src = subk + (size_t)h * 2 * 128 * 128;
        for (int c = F.tid; c < 4096; c += NTHREADS) { const int row = c >> 4, ch = c & 15;
            *(LAS u32x4*)(F.lds + row * 256 + ((ch ^ (row & 15)) << 4)) = *(const u32x4*)(src + (size_t)row * 128 + ch * 8); }
        __syncthreads();
    }
    const int ntg = lat_only ? 256 : MROWS / 32;
    for (int t = jw; t < ntg; t += nwh) {
        int lane_ = F.lane; asm volatile("" : "+v"(lane_));
        const int r32 = lane_ & 31, hi = lane_ >> 5;
        int tg = t; if (lat_only) tg += 8 + (tg >= 128 ? 8 : 0);
        const int token = tg * 32 + r32;
        int top[2][16];
        const int kk = (((r32 & 14) | (hi ^ (r32 & 1))) << 4);
#pragma unroll
        for (int p = 0; p < 2; ++p) {
            bf16x8 bq[8];
            const bf16_t* qp = PQ + (size_t)token * DM + h * 256 + p * 128 + hi * 8;
#pragma unroll
            for (int ks = 0; ks < 8; ++ks) bq[ks] = *(const bf16x8*)(qp + ks * 16);
            int s[4][16];
#pragma unroll
            for (int nb = 0; nb < 4; ++nb) {
                f32x16 acc = {};
                const LAS unsigned char* kp = F.lds + (p * 128 + nb * 32 + r32) * 256;
#pragma unroll
                for (int ks = 0; ks < 8; ++ks) { const bf16x8 a = *(const LAS bf16x8*)(kp + (kk ^ (ks << 5))); acc = __builtin_amdgcn_mfma_f32_32x32x16_bf16(a, bq[ks], acc, 0, 0, 0); }
#pragma unroll
                for (int r = 0; r < 16; ++r) { const int key = nb * 32 + crow32(r, hi); s[nb][r] = fkey((int)((__float_as_uint(acc[r]) & ~127u) | (unsigned)(127 - key))); }
                tk_sort<16>(s[nb]);
            }
            tk_merge16(s[0], s[1]); tk_merge16(s[2], s[3]); tk_merge16(s[0], s[2]);
            tk_merge_partner(s[0]);
#pragma unroll
            for (int j = 0; j < 16; ++j) top[p][j] = s[0][j];
        }
        int cand[32];
        unsigned long long kaLo = 0ull, kaHi = 0ull, kbLo = 0ull, kbHi = 0ull;
        {
            float fb[16]; const float fa0 = __uint_as_float((unsigned)fkey(top[0][0]) & ~127u), fb0 = __uint_as_float((unsigned)fkey(top[1][0]) & ~127u);
#pragma unroll
            for (int r = 0; r < 16; ++r) { const int ba = fkey(top[0][r]), bb = fkey(top[1][r]); fb[r] = __uint_as_float((unsigned)bb & ~127u) - fb0;
                const unsigned long long xa = (unsigned long long)(unsigned)(127 - (ba & 127)) << (8 * (r & 7)), xb = (unsigned long long)(unsigned)(127 - (bb & 127)) << (8 * (r & 7));
                if (r < 8) { kaLo |= xa; kbLo |= xb; } else { kaHi |= xa; kbHi |= xb; } }
            float fa[8];
#pragma unroll
            for (int i = 0; i < 8; ++i) { const int ka = hi ? top[0][2 * i + 1] : top[0][2 * i]; fa[i] = __uint_as_float((unsigned)fkey(ka) & ~127u) - fa0; }
            const int hid = 255 - (hi << 4);
            int n = 0;
#pragma unroll
            for (int i = 0; i < 8; ++i)
#pragma unroll
                for (int b = 0; b < 16; ++b) if ((2 * i + 1) * (b + 1) <= 16) {
                    const float sum = fa[i] + fb[b];
                    cand[n++] = fkey((int)((__float_as_uint(sum) & ~255u) | (unsigned)(hid - (32 * i + b))));
                }
#pragma unroll
            for (; n < 32; ++n) cand[n] = (int)0x80000000;
        }
        tk_sort<16>(cand); tk_sort<16>(cand + 16); tk_merge16(cand, cand + 16);
        tk_merge_partner(cand);
        float ev[16]; float esum = 0.f;
#pragma unroll
        for (int j = 0; j < 16; ++j) { ev[j] = __expf(__uint_as_float((unsigned)fkey(cand[j]) & ~255u)); esum += ev[j]; }
        const float rs = 1.0f / esum;
        int oi[8]; float og[8];
#pragma unroll
        for (int j = 0; j < 8; ++j) { const int w = hi ? cand[8 + j] : cand[j]; const float e = hi ? ev[8 + j] : ev[j];
            const int id8 = 255 - (fkey(w) & 255), ra = id8 >> 4, rb = id8 & 15;
            const unsigned long long wa = (ra & 8) ? kaHi : kaLo, wb = (rb & 8) ? kbHi : kbLo;
            const int ka = (int)(wa >> (8 * (ra & 7))) & 127, kb = (int)(wb >> (8 * (rb & 7))) & 127;
            oi[j] = ka * 128 + kb; og[j] = e * rs; }
        int* ip = IDX + (size_t)token * 128 + h * 16 + hi * 8; float* gp = GATE + (size_t)token * 128 + h * 16 + hi * 8;
        *(int4*)ip = make_int4(oi[0], oi[1], oi[2], oi[3]); *(int4*)(ip + 4) = make_int4(oi[4], oi[5], oi[6], oi[7]);
        *(f32x4*)gp = (f32x4){og[0], og[1], og[2], og[3]}; *(f32x4*)(gp + 4) = (f32x4){og[4], og[5], og[6], og[7]};
    }
}

__device__ __forceinline__ void peer_expert_phase(const Frame& F0, const bf16_t* H2, const int* IDX, const float* GATE, const unsigned char* U, size_t v_minus_u_bytes, const float* USC, const float* VSC,
                                                  const float* g2  , float* XW, float* OUT,
                                                  bf16_t* HN  , const float* ng  , const float* nmod  ) {
    const Frame F = phase_frame(F0);
    LAS float* red = (LAS float*)F.lds;
    const unsigned voff_tab = (unsigned)v_minus_u_bytes;
    const __amdgpu_buffer_rsrc_t rs = __builtin_amdgcn_make_buffer_rsrc((void*)U, 0, (int)(voff_tab + (unsigned)NEXP * ROWB), 0x00020000);
    const int lane = F.lane; const int voff = lane * 16, voff2 = 1024 + lane * 8;
#define PX_SB() __builtin_amdgcn_sched_barrier(0)
#define PX_LOAD(buf, s, ivv) do { constexpr int e0_ = ((s) & 3) * 4; const unsigned tb_ = ((s) >= 4) ? voff_tab : 0u; \
        _Pragma("unroll") for (int ee_ = 0; ee_ < 4; ++ee_) { const unsigned o_ = (unsigned)__builtin_amdgcn_readlane(ivv, e0_ + ee_) * (unsigned)ROWB + tb_; \
            buf##h[ee_] = __builtin_amdgcn_raw_buffer_load_b128(rs, voff, o_, 0); buf##l[ee_] = __builtin_amdgcn_raw_buffer_load_b64(rs, voff2, o_, 0); } } while (0)
#define PX_DECODE(buf, ee_, dep) u32x6 w6_ = {buf##h[ee_].x, buf##h[ee_].y, buf##h[ee_].z, buf##h[ee_].w, buf##l[ee_].x, buf##l[ee_].y}; \
        asm volatile("" : "+v"(w6_) : "v"(dep));     \
        const f32x32 r_ = __builtin_amdgcn_cvt_scalef32_pk32_f32_fp6(w6_, 1.0f);
#define PX_COMP_U(buf, s) do { constexpr int e0_ = ((s) & 3) * 4; \
            _Pragma("unroll") for (int ee_ = 0; ee_ < 4; ++ee_) { PX_DECODE(buf, ee_, sv) \
                const f32x32 p_ = r_ * xf; float a0_ = 0.f, a1_ = 0.f; \
                _Pragma("unroll") for (int k_ = 0; k_ < 32; k_ += 2) { a0_ += p_[k_]; a1_ += p_[k_ + 1]; } \
                const float t_ = wave_sum_dpp(a0_ + a1_); sv = (lane == e0_ + ee_) ? t_ : sv; } } while (0)
#define PX_COMP_V(buf, s) do { constexpr int e0_ = ((s) & 3) * 4; \
            _Pragma("unroll") for (int ee_ = 0; ee_ < 4; ++ee_) { const float wg_ = __uint_as_float(__builtin_amdgcn_readlane(__float_as_uint(wv), e0_ + ee_)); \
                PX_DECODE(buf, ee_, acc) \
                acc += r_ * wg_; } } while (0)
#define PX_FETCH_TOKEN(r, XP, IV, GV) do { const u32x4* xp_ = (const u32x4*)(H2 + (size_t)(r) * DM + lane * 16); XP[0] = xp_[0]; XP[1] = xp_[1]; XP[2] = xp_[128]; XP[3] = xp_[129]; \
        IV = 0; GV = 0.f; if (lane < 16) { IV = IDX[(size_t)(r) * 128 + F.wave * 16 + lane]; GV = GATE[(size_t)(r) * 128 + F.wave * 16 + lane]; } } while (0)
    const bool skip_ctx = (OUT != nullptr);
    int row = F.vcu; if (skip_ctx && row < MROWS && row_cls(row) == 2) row += F.G;
    u32x4 xp[4]; int iv; float gv;
    u32x4 bAh[4], bBh[4]; u32x2 bAl[4], bBl[4];
    if (row < MROWS) { PX_FETCH_TOKEN(row, xp, iv, gv); PX_LOAD(bA, 0, iv); }
    int par = 0;
    while (row < MROWS) {
        int nrow = row + F.G; if (skip_ctx && nrow < MROWS && row_cls(nrow) == 2) nrow += F.G;
        f32x32 xf;
#pragma unroll
        for (int q = 0; q < 4; ++q) { const unsigned ww[4] = {xp[q].x, xp[q].y, xp[q].z, xp[q].w};
#pragma unroll
            for (int k = 0; k < 4; ++k) { xf[q * 8 + 2 * k] = bf_lo(ww[k]); xf[q * 8 + 2 * k + 1] = bf_hi(ww[k]); } }
        float usc = 0.f, vsc = 0.f;
        if (lane < 16) { usc = USC[iv]; vsc = VSC[iv]; }
        u32x4 xpn[4]; int ivn = 0; float gvn = 0.f;
        if (nrow < MROWS) PX_FETCH_TOKEN(nrow, xpn, ivn, gvn);
        const int cls = row_cls(row);
        const f32x4 x_old = *((const f32x4*)(XW + (size_t)row * DM) + F.tid), g_vec = *((const f32x4*)(g2 + (size_t)cls * NMOD) + F.tid);
        f32x4 n_g = {0.f, 0.f, 0.f, 0.f}, n_sc = n_g, n_sh = n_g;
        if (HN) { n_g = *((const f32x4*)ng + F.tid); n_sc = *((const f32x4*)(nmod + (size_t)cls * NMOD + 2048) + F.tid); n_sh = *((const f32x4*)(nmod + (size_t)cls * NMOD) + F.tid); }
        float sv = 0.f, wv = 0.f;
        PX_LOAD(bB, 1, iv); PX_SB(); PX_COMP_U(bA, 0); PX_SB();
        PX_LOAD(bA, 2, iv); PX_SB(); PX_COMP_U(bB, 1); PX_SB();
        PX_LOAD(bB, 3, iv); PX_SB(); PX_COMP_U(bA, 2); PX_SB();
        PX_LOAD(bA, 4, iv); PX_SB(); PX_COMP_U(bB, 3); PX_SB();
        wv = gelu_erf(sv * usc) * gv * vsc;
        f32x32 acc = {};
        PX_LOAD(bB, 5, iv); PX_SB(); PX_COMP_V(bA, 4); PX_SB();
        PX_LOAD(bA, 6, iv); PX_SB(); PX_COMP_V(bB, 5); PX_SB();
        PX_LOAD(bB, 7, iv); PX_SB(); PX_COMP_V(bA, 6); PX_SB();
        if (nrow < MROWS) PX_LOAD(bA, 0, ivn);
        PX_SB(); PX_COMP_V(bB, 7); PX_SB();
        LAS float* rb = red + par * (NWAVES * DM);
#pragma unroll
        for (int j = 0; j < 2; ++j)
#pragma unroll
            for (int q = 0; q < 4; ++q) *(LAS f32x4*)(rb + F.wave * DM + j * 1024 + lane * 16 + q * 4) = (f32x4){acc[j * 16 + q * 4], acc[j * 16 + q * 4 + 1], acc[j * 16 + q * 4 + 2], acc[j * 16 + q * 4 + 3]};
        __syncthreads();
        {
            f32x4 sm = {0.f, 0.f, 0.f, 0.f};
#pragma unroll
            for (int w = 0; w < 8; ++w) sm += *(const LAS f32x4*)(rb + w * DM + F.tid * 4);
            f32x4* xq = (f32x4*)(XW + (size_t)row * DM) + F.tid;
            const f32x4 xn = x_old + g_vec * sm;
            *xq = xn;
            if (OUT) { const int b = row / RB, i = row - b * RB; if (i >= CTX) *((f32x4*)(OUT + ((size_t)b * SEQ + (i - CTX)) * DM) + F.tid) = xn; }
            if (HN) {
                LAS float* ssp = (LAS float*)(F.lds + 131072) + par * 8;
                const float sw = wave_sum_dpp((xn.x * xn.x + xn.y * xn.y) + (xn.z * xn.z + xn.w * xn.w));
                if (lane == 0) ssp[F.wave] = sw;
                __syncthreads();
                const float tot = ((ssp[0] + ssp[1]) + (ssp[2] + ssp[3])) + ((ssp[4] + ssp[5]) + (ssp[6] + ssp[7]));
                const float rstd = 1.0f / sqrtf(tot * (1.f / DM) + EPS);
                const f32x4 y = (xn * rstd) * n_g * (n_sc + 1.0f) + n_sh;
                u32x2 o; o.x = pk2(y.x, y.y); o.y = pk2(y.z, y.w);
                *((u32x2*)(HN + (size_t)row * DM) + F.tid) = o;
            }
        }
        par ^= 1; row = nrow;
#pragma unroll
        for (int q = 0; q < 4; ++q) xp[q] = xpn[q];
        iv = ivn; gv = gvn;
    }
#undef PX_LOAD
#undef PX_COMP_U
#undef PX_COMP_V
#undef PX_SB
#undef PX_FETCH_TOKEN
}
#ifndef N_LAUNCHES
#define N_LAUNCHES 1
#endif
struct Args { const float* in[26]; float* out; unsigned char* ws; int ph_lo, ph_hi; };
constexpr int NPHASES = 39;
__global__ void __launch_bounds__(NTHREADS, 2) fwd_kernel(Args args) {
    extern __shared__ __attribute__((aligned(16))) unsigned char lds_raw[];
    Frame F_;
    F_.lds = (LAS unsigned char*)lds_raw;
    F_.tid = threadIdx.x; F_.lane = F_.tid & 63; F_.wave = __builtin_amdgcn_readfirstlane(F_.tid >> 6);
    F_.G = gridDim.x; { const int bx = blockIdx.x; F_.vcu = (F_.G % 8 == 0) ? (bx % 8) * (F_.G / 8) + bx / 8 : bx; }
    F_.gw = F_.vcu * NWAVES + F_.wave; F_.NGW = F_.G * NWAVES;
    F_.ws = args.ws;
    volatile LAS unsigned* MISC = (volatile LAS unsigned*)(F_.lds + LDS_MISC);
    if (F_.tid < 32) MISC[F_.tid] = 0u;
    __syncthreads();
    const int lo = args.ph_lo, hi = args.ph_hi;
    XcdBarrier bar; bar.bar = (unsigned*)(args.ws + WS_CTL) + CW_BAR; bar.x = 0; bar.st = nullptr;
    if (N_LAUNCHES == 1 || hi - lo > 1) bar = xcd_barrier_post((unsigned*)(args.ws + WS_CTL) + CW_BAR, MISC + 8);
#if N_LAUNCHES == 1
#define IN(k) true
#define SEAM(k) xcd_barrier(bar)
#else
#define IN(k) (lo <= (k) && (k) < hi)
#define SEAM(k) do { if (IN(k) && IN((k) + 1)) xcd_barrier(bar); } while (0)
#endif
    PG8_LAS unsigned char* glds = (PG8_LAS unsigned char*)lds_raw;

    if (IN(0)) { p0_prologue(F_, args.in); } SEAM(0);

#pragma unroll 1
    for (int lp = 0; lp < 2; ++lp) {
        const int pb = 1 + lp * 19;
        unsigned char* ws = args.ws; asm volatile("" : "+s"(ws));
        Frame F = F_; { int w_ = F_.wave, v_ = F_.vcu, g_ = F_.G; asm volatile("" : "+s"(w_), "+s"(v_), "+s"(g_)); F.wave = w_; F.vcu = v_; F.G = g_; F.gw = v_ * NWAVES + w_; F.NGW = g_ * NWAVES; F.ws = ws; }
        float* mod = (float*)(ws + WS_MOD); float* XW = (float*)(ws + WS_XW);
        bf16_t* H = (bf16_t*)(ws + WS_H); bf16_t* P = (bf16_t*)(ws + WS_P); bf16_t* QRAW = (bf16_t*)(ws + WS_QRAW); bf16_t* KVRAW = (bf16_t*)(ws + WS_KVRAW);
        bf16_t* Q = (bf16_t*)(ws + WS_Q); bf16_t* KB = (bf16_t*)(ws + WS_K); bf16_t* VB = (bf16_t*)(ws + WS_V); bf16_t* CAT = (bf16_t*)(ws + WS_CAT); bf16_t* PQ = (bf16_t*)(ws + WS_PQ);
        int* IDX = (int*)(ws + WS_IDX); float* GATE = (float*)(ws + WS_GATE);
        const float* rope_c = (const float*)(ws + WS_ROPE); const float* rope_a = rope_c + 64 * 32 * 2;
        const float* SMv = (const float*)(ws + WS_SMALL);
        {
            const int l = 2 * lp, i = lp;
            const float* modl = mod + (size_t)l * 3 * NMOD;
            if (lp == 0) { if (IN(pb + 0)) { norm_phase(F, XW, SMv + SM_N1G + l * DM, modl, 0, 2048, H, false); } SEAM(pb + 0); }
            if (IN(pb + 1)) {
                pg8::Gemm g{H, (const bf16_t*)(ws + WS_WIN) + (size_t)i * 4096 * DM, MROWS, 4096, DM, DM, DM}; pg8::StaticOrder S; S.init(MROWS, 4096, F.G, (int)blockIdx.x);
                pg8::EpiBf16 E{P, 4096};
                pg8::gemm_phase<pg8::EpiBf16, pg8::StaticOrder, true, true>(glds, g, S, E, phase_tid(F.wave));
            } SEAM(pb + 1);
            if (IN(pb + 2)) {
                { pg8::Gemm g{P, (const bf16_t*)(ws + WS_WUQ) + (size_t)i * 1536 * 512, MROWS, 1536, 512, 4096, 512}; pg8::StaticOrder S; S.init(MROWS, 1536, F.G, (int)blockIdx.x);
                  pg8::EpiBf16 E{QRAW, 1536};
                  pg8::gemm_phase<pg8::EpiBf16, pg8::StaticOrder, true, true>(glds, g, S, E, phase_tid(F.wave)); }
                __syncthreads();
                { pg8::Gemm g{P + 512, (const bf16_t*)(ws + WS_WUKV) + (size_t)i * 2048 * 256, MROWS, 2048, 256, 4096, 256}; pg8::StaticOrder S; S.init(MROWS, 2048, F.G, (int)blockIdx.x);
                  pg8::EpiBf16 E{KVRAW, 2048};
                  pg8::gemm_phase<pg8::EpiBf16, pg8::StaticOrder, true, true>(glds, g, S, E, phase_tid(F.wave)); }
                __syncthreads();
                conv_phase(F, P, SMv + SM_CW + i * 3072, SMv + SM_CB + i * 1024, CAT);
            } SEAM(pb + 2);
            if (IN(pb + 3)) { prep_even_phase(F, P, QRAW, KVRAW, SMv + SM_AQG + i * 192, SMv + SM_AKG + i * 192, rope_a, Q, KB, VB); } SEAM(pb + 3);
            if (IN(pb + 4)) { attn_even_phase(F, Q, KB, VB, CAT); } SEAM(pb + 4);
            if (IN(pb + 5)) {
                pg8::Gemm g{CAT, (const bf16_t*)(ws + WS_WEO) + (size_t)i * DM * DM, MROWS, DM, DM, DM, DM}; pg8::StaticOrder S; S.init(MROWS, DM, F.G, (int)blockIdx.x);
                pg8::EpiResid E{XW, DM, modl + 4096};
                pg8::gemm_phase<pg8::EpiResid, pg8::StaticOrder, true, true>(glds, g, S, E, phase_tid(F.wave));
            } SEAM(pb + 5);
            if (IN(pb + 6)) { norm_phase(F, XW, SMv + SM_N2G + l * DM, modl, 6144, 8192, H, l == 3); } SEAM(pb + 6);
            if (IN(pb + 7)) {
                pg8::Gemm g{H, (const bf16_t*)(ws + WS_WPQ) + (size_t)l * DM * DM, MROWS, DM, DM, DM, DM}; pg8::StaticOrder S; S.init(MROWS, DM, F.G, (int)blockIdx.x);
                pg8::EpiBf16 E{PQ, DM};
                pg8::gemm_phase<pg8::EpiBf16, pg8::StaticOrder, true, true>(glds, g, S, E, phase_tid(F.wave));
            } SEAM(pb + 7);
            if (IN(pb + 8)) { peer_topk_phase(F, PQ, (const bf16_t*)(ws + WS_SUBK) + (size_t)l * 16 * 128 * 128, IDX, GATE, l == 3); } SEAM(pb + 8);
            if (IN(pb + 9)) { peer_expert_phase(F, H, IDX, GATE, ws + WS_U + (size_t)l * NEXP * ROWB, (size_t)(WS_VT - WS_U), (const float*)(ws + WS_USC) + l * NEXP, (const float*)(ws + WS_VSC) + l * NEXP, modl + 10240, XW, nullptr, H, SMv + SM_N1G + (l + 1) * DM, mod + (size_t)(l + 1) * 3 * NMOD); } SEAM(pb + 9);
        }
        {
            const int l = 2 * lp + 1, i = lp, qb = pb + 10;
            const float* modl = mod + (size_t)l * 3 * NMOD;
            if (IN(qb + 1)) {
                pg8::Gemm g{H, (const bf16_t*)(ws + WS_WQKV) + (size_t)i * 3072 * DM, MROWS, 3072, DM, DM, DM}; pg8::StaticOrder S; S.init(MROWS, 3072, F.G, (int)blockIdx.x);
                pg8::EpiBf16 E{P, 3072};
                pg8::gemm_phase<pg8::EpiBf16, pg8::StaticOrder, true, true>(glds, g, S, E, phase_tid(F.wave));
            } SEAM(qb + 1);
            if (IN(qb + 2)) { prep_odd_phase(F, P, SMv + SM_CQG + i * 128, SMv + SM_CKG + i * 128, rope_c, Q, KB); } SEAM(qb + 2);
            if (IN(qb + 3)) { attn_odd_phase(F, Q, KB, P, CAT, l == 3); } SEAM(qb + 3);
            if (IN(qb + 4)) {
                pg8::Gemm g{CAT, (const bf16_t*)(ws + WS_WCO) + (size_t)i * DM * DM, MROWS, DM, DM, DM, DM}; pg8::StaticOrder S; S.init(MROWS, DM, F.G, (int)blockIdx.x, l == 3);
                pg8::EpiResid E{XW, DM, modl + 4096};
                pg8::gemm_phase<pg8::EpiResid, pg8::StaticOrder, true, true>(glds, g, S, E, phase_tid(F.wave));
            } SEAM(qb + 4);
            if (IN(qb + 5)) { norm_phase(F, XW, SMv + SM_N2G + l * DM, modl, 6144, 8192, H, l == 3); } SEAM(qb + 5);
            if (IN(qb + 6)) {
                pg8::Gemm g{H, (const bf16_t*)(ws + WS_WPQ) + (size_t)l * DM * DM, MROWS, DM, DM, DM, DM}; pg8::StaticOrder S; S.init(MROWS, DM, F.G, (int)blockIdx.x, l == 3);
                pg8::EpiBf16 E{PQ, DM};
                pg8::gemm_phase<pg8::EpiBf16, pg8::StaticOrder, true, true>(glds, g, S, E, phase_tid(F.wave));
            } SEAM(qb + 6);
            if (IN(qb + 7)) { peer_topk_phase(F, PQ, (const bf16_t*)(ws + WS_SUBK) + (size_t)l * 16 * 128 * 128, IDX, GATE, l == 3); } SEAM(qb + 7);
            if (IN(qb + 8)) { peer_expert_phase(F, H, IDX, GATE, ws + WS_U + (size_t)l * NEXP * ROWB, (size_t)(WS_VT - WS_U), (const float*)(ws + WS_USC) + l * NEXP, (const float*)(ws + WS_VSC) + l * NEXP, modl + 10240, XW, (l == 3) ? args.out : nullptr, (l == 3) ? nullptr : H, SMv + SM_N1G + (l + 1) * DM, mod + (size_t)(l + 1) * 3 * NMOD); } if (lp == 0) SEAM(qb + 8);
        }
    }
#undef IN
#undef SEAM
}

extern "C" void kernel_launch(void* const* d_in, const int* in_sizes, int n_in, void* d_out, int out_size, void* d_ws, size_t ws_size, hipStream_t stream) {
    static int grid = 0;
    if (grid == 0) {
        if (n_in != 26 || out_size != NBATCH * SEQ * DM || ws_size < WS_END) { fprintf(stderr, "kernel_launch: unexpected shapes: n_in %d out %d ws %zu (need %zu)\n", n_in, out_size, ws_size, (size_t)WS_END); grid = -1; return; }
        int dev = 0, cus = 0, per_cu = 0;
        if (hipGetDevice(&dev) != hipSuccess || hipDeviceGetAttribute(&cus, hipDeviceAttributeMultiprocessorCount, dev) != hipSuccess) { fprintf(stderr, "kernel_launch: device query failed\n"); grid = -1; return; }
        if (hipFuncSetAttribute((const void*)fwd_kernel, hipFuncAttributeMaxDynamicSharedMemorySize, LDS_BYTES) != hipSuccess) { fprintf(stderr, "kernel_launch: hipFuncSetAttribute failed\n"); grid = -1; return; }
        if (hipOccupancyMaxActiveBlocksPerMultiprocessor(&per_cu, (const void*)fwd_kernel, NTHREADS, LDS_BYTES) != hipSuccess || per_cu < 1) { fprintf(stderr, "kernel_launch: occupancy query says %d blocks per CU\n", per_cu); (void)hipGetLastError(); grid = -1; return; }
        grid = cus;
    }
    if (grid < 0) return;
    (void)hipMemsetAsync((char*)d_ws + WS_CTL, 0, CTL_ZERO_BYTES, stream);
    Args a{};
    for (int i = 0; i < 26; ++i) a.in[i] = (const float*)d_in[i];
    a.out = (float*)d_out; a.ws = (unsigned char*)d_ws;
    for (int li = 0; li < N_LAUNCHES; ++li) {
        a.ph_lo = (N_LAUNCHES == 1) ? 0 : li; a.ph_hi = (N_LAUNCHES == 1) ? NPHASES : li + 1;
        hipLaunchKernelGGL(fwd_kernel, dim3(grid), dim3(NTHREADS), LDS_BYTES, stream, a);
        const hipError_t le = hipPeekAtLastError();
        if (le != hipSuccess) { fprintf(stderr, "kernel_launch: launch %d failed: %s\n", li, hipGetErrorName(le)); break; }
    }
}
```

```cpp
#include <hip/hip_runtime.h>
#include <cstdio>
#include <cstdint>
namespace pg8 {
#define PG8_LAS __attribute__((address_space(3)))
typedef unsigned short bf16_t;
typedef short bf16x8 __attribute__((ext_vector_type(8)));
typedef float f32x4 __attribute__((ext_vector_type(4)));
typedef unsigned u32x4 __attribute__((ext_vector_type(4)));
constexpr int BM = 256, BK = 64, HALF = 128, HTB = HALF * BK * 2  , STAGE_BYTES = 8 * HTB, NXCD = 8, WGM = 8;

__host__ __device__ __forceinline__ int lds_byte(int r, int c) { const int st = (r >> 4) * 2 + (c >> 5), rr = r & 15, cc = c & 31, ob = rr * 64 + cc * 2; return st * 1024 + (ob ^ (((ob >> 9) & 1) << 5)); }
__host__ __device__ __forceinline__ void stage_rc(int b, int& R, int& C) { const int st = b / 1024, sb = b % 1024, swz = sb ^ (((sb >> 9) & 1) << 5); R = (st >> 1) * 16 + swz / 64; C = (st & 1) * 32 + (swz % 64) / 2; }
__host__ __device__ __forceinline__ int perm32(int rho) { const int n = rho >> 4, i = rho & 15; return 8 * (i >> 2) + 4 * n + (i & 3); }

struct Unit { int pm, pn; };
struct Gemm { const bf16_t* A; const bf16_t* Bt; int M, N, K, lda, ldb; };

struct StaticOrder {
    int nM, nN, nwg, G, c; bool lat_only;
    __host__ __device__ void init(int M, int N, int G_, int c_, bool lat_only_ = false) { lat_only = lat_only_; nM = lat_only_ ? 32 : M / BM; nN = N / BM; nwg = nM * nN; G = G_; c = c_; }
    __host__ __device__ bool next(int i, Unit& u) const {
        const long L = (long)i * G + c; if (L >= nwg) return false;
        int wgid = (int)L; { const int q = nwg / NXCD, r = nwg % NXCD, xcd = wgid % NXCD, off = wgid / NXCD; wgid = (xcd < r ? xcd * (q + 1) : r * (q + 1) + (xcd - r) * q) + off; }
        const int nig = WGM * nN, gid = wgid / nig, fm = gid * WGM, gsz = (nM - fm) < WGM ? (nM - fm) : WGM;
        u.pm = fm + ((wgid % nig) % gsz); u.pn = (wgid % nig) / gsz; if (lat_only) u.pm += 1 + (u.pm >= 16 ? 1 : 0); return true;
    }
    __device__ __forceinline__ void a_ready(const Unit&) const {}
    __device__ __forceinline__ void done(const Unit&) const {}
};
__device__ __forceinline__ unsigned cvt_pk_bf16(float lo, float hi) { unsigned r; asm volatile("v_cvt_pk_bf16_f32 %0, %1, %2" : "=v"(r) : "v"(lo), "v"(hi)); return r; }
typedef float f32x2 __attribute__((ext_vector_type(2)));
struct EpiBf16 {
    static constexpr bool PERM = true, AFTER_DRAIN = false;
    bf16_t* O; int ldc;
    __device__ __forceinline__ void operator()(const f32x4 (&acc)[2][2][4][2], const Unit& u, int wr, int wc, int fr, int fq) const {
        const int row0 = u.pm * BM + wr * 64 + fr, col0 = u.pn * BM + wc * 32 + 8 * fq;
#pragma unroll
        for (int ai = 0; ai < 2; ++ai)
#pragma unroll
            for (int m = 0; m < 4; ++m) { bf16_t* rowp = O + (size_t)(row0 + ai * HALF + m * 16) * ldc + col0;
#pragma unroll
                for (int bj = 0; bj < 2; ++bj) { const f32x4 v0 = acc[ai][bj][m][0], v1 = acc[ai][bj][m][1];
                    u32x4 w; w.x = cvt_pk_bf16(v0[0], v0[1]); w.y = cvt_pk_bf16(v0[2], v0[3]); w.z = cvt_pk_bf16(v1[0], v1[1]); w.w = cvt_pk_bf16(v1[2], v1[3]);
                    *(u32x4*)(rowp + bj * HALF) = w; } }
    }
};
struct EpiResid {
    static constexpr bool PERM = false, AFTER_DRAIN = false;
    float* X; int ldc; const float* gate;
    __device__ __forceinline__ void operator()(const f32x4 (&acc)[2][2][4][2], const Unit& u, int wr, int wc, int fr, int fq) const {
        const int row0 = u.pm * BM + wr * 64 + fr, col0 = u.pn * BM + wc * 32 + 4 * fq;
        const int cls = (u.pm % 17 == 0) ? 2 : (u.pm / 17);
        const float* gp = gate + (size_t)cls * 12288 + col0;
        f32x4 gv[2][2];
#pragma unroll
        for (int bj = 0; bj < 2; ++bj)
#pragma unroll
            for (int n = 0; n < 2; ++n) gv[bj][n] = *(const f32x4*)(gp + bj * HALF + n * 16);
#pragma unroll
        for (int ai = 0; ai < 2; ++ai)
#pragma unroll
            for (int m = 0; m < 4; ++m) { float* rowp = X + (size_t)(row0 + ai * HALF + m * 16) * ldc + col0;
#pragma unroll
                for (int bj = 0; bj < 2; ++bj)
#pragma unroll
                    for (int n = 0; n < 2; ++n) { f32x4* p = (f32x4*)(rowp + bj * HALF + n * 16); *p = *p + gv[bj][n] * acc[ai][bj][m][n]; } }
    }
};
template <class Epi, class Sched, bool ALIGN_EPI = false, bool SP2 = false>
__device__ __forceinline__ void gemm_phase(PG8_LAS unsigned char* lds, const Gemm g, const Sched& S, const Epi& E, int tid_in) {
    int tid_ = tid_in; asm volatile("" : "+v"(tid_));
    const int tid = tid_, wid = __builtin_amdgcn_readfirstlane(tid >> 6), lane = tid & 63, wr = wid >> 2, wc = wid & 3, fr = lane & 15, fq = lane >> 4;
    const int K = g.K, nt = K / BK;
    unsigned voffA[2], voffB[2];
#pragma unroll
    for (int i = 0; i < 2; ++i) { int R, C; stage_rc(tid * 16 + i * 8192, R, C); const int Rb = Epi::PERM ? ((R & ~31) + perm32(R & 31)) : R;
        voffA[i] = (unsigned)(R * g.lda + C) * 2u; voffB[i] = (unsigned)(Rb * g.ldb + C) * 2u; }
    const size_t kstep = (size_t)(BK * 2);
    const size_t hstepA = (size_t)HALF * g.lda * 2, hstepB = (size_t)HALF * g.ldb * 2;
    const size_t tstepA = 2 * hstepA, tstepB = 2 * hstepB;
    const unsigned ldsw = (unsigned)wid * 1024u;
    const int aoff = lds_byte(wr * 64 + fr, fq * 8), boff = lds_byte(wc * 32 + fr, fq * 8);
#define PG8_SA(b, h) (((b) * 2 + (h)) * HTB)
#define PG8_SB(b, h) ((4 + (b) * 2 + (h)) * HTB)
#define PG8_STAGE(bufoff, gbase, voff) do { _Pragma("unroll") for (int _i = 0; _i < 2; ++_i) \
        __builtin_amdgcn_global_load_lds((const unsigned*)((const char*)(gbase) + (voff)[_i]), (PG8_LAS unsigned*)(lds + (bufoff) + ldsw + _i * 8192), 16, 0, 0); } while (0)
#define PG8_LDA(dst, b, h) do { _Pragma("unroll") for (int m = 0; m < 4; ++m) _Pragma("unroll") for (int k = 0; k < 2; ++k) dst[m][k] = *(const PG8_LAS bf16x8*)(lds + PG8_SA(b, h) + aoff + m * 2048 + k * 1024); } while (0)
#define PG8_LDB(dst, b, h) do { _Pragma("unroll") for (int n = 0; n < 2; ++n) _Pragma("unroll") for (int k = 0; k < 2; ++k) dst[n][k] = *(const PG8_LAS bf16x8*)(lds + PG8_SB(b, h) + boff + n * 2048 + k * 1024); } while (0)
#define PG8_MMA(ai, bj, At, Bt) do { __builtin_amdgcn_s_setprio(1); _Pragma("unroll") for (int m = 0; m < 4; ++m) _Pragma("unroll") for (int n = 0; n < 2; ++n) _Pragma("unroll") for (int k = 0; k < 2; ++k) \
        acc[ai][bj][m][n] = __builtin_amdgcn_mfma_f32_16x16x32_bf16(Bt[n][k], At[m][k], acc[ai][bj][m][n], 0, 0, 0); __builtin_amdgcn_s_setprio(0); } while (0)
#define PG8_WAIT_V(n) asm volatile("s_waitcnt vmcnt(" #n ")" ::: "memory")
#define PG8_WAIT_L(n) asm volatile("s_waitcnt lgkmcnt(" #n ")" ::: "memory")
#define PG8_BAR __builtin_amdgcn_s_barrier()
#define PG8_SCHED __builtin_amdgcn_sched_barrier(0)
    Unit cur, nxt; int ui = 0;
    if (!S.next(0, cur)) return;
    f32x4 acc[2][2][4][2];
#pragma unroll
    for (int a = 0; a < 2; ++a)
#pragma unroll
        for (int b = 0; b < 2; ++b)
#pragma unroll
            for (int m = 0; m < 4; ++m)
#pragma unroll
                for (int n = 0; n < 2; ++n) acc[a][b][m][n] = (f32x4){0.f, 0.f, 0.f, 0.f};
    bf16x8 At[4][2], B0[2][2], B1[2][2];
    const char* cA = (const char*)g.A + (size_t)cur.pm * tstepA; const char* cB = (const char*)g.Bt + (size_t)cur.pn * tstepB;
    S.a_ready(cur);
    if constexpr (SP2) {
        PG8_STAGE(PG8_SB(0, 0), cB, voffB); PG8_STAGE(PG8_SB(0, 1), cB + hstepB, voffB); PG8_STAGE(PG8_SA(0, 0), cA, voffA); PG8_STAGE(PG8_SA(0, 1), cA + hstepA, voffA);
        if (wr == 1) PG8_BAR;
        PG8_WAIT_V(2); PG8_BAR;
        PG8_STAGE(PG8_SB(1, 0), cB + kstep, voffB); PG8_STAGE(PG8_SA(1, 0), cA + kstep, voffA); PG8_STAGE(PG8_SB(1, 1), cB + hstepB + kstep, voffB);
        PG8_WAIT_V(6); PG8_BAR;
    } else {
        PG8_STAGE(PG8_SB(0, 0), cB, voffB); PG8_STAGE(PG8_SA(0, 0), cA, voffA); PG8_STAGE(PG8_SB(0, 1), cB + hstepB, voffB); PG8_STAGE(PG8_SA(0, 1), cA + hstepA, voffA);
        if (wr == 1) PG8_BAR;
        PG8_WAIT_V(4); PG8_BAR;
        PG8_STAGE(PG8_SB(1, 0), cB + kstep, voffB); PG8_STAGE(PG8_SA(1, 0), cA + kstep, voffA); PG8_STAGE(PG8_SB(1, 1), cB + hstepB + kstep, voffB);
        PG8_WAIT_V(6); PG8_BAR;
    }
    for (;;) {
        const bool has_next = S.next(ui + 1, nxt);
        const char* nA = has_next ? (const char*)g.A + (size_t)nxt.pm * tstepA : cA; const char* nB = has_next ? (const char*)g.Bt + (size_t)nxt.pn * tstepB : cB;
        for (int t = 0; t < nt; t += 2) {
            const bool last = (t == nt - 2);
            const char* a1 = cA + (size_t)(t + 1) * kstep;
            const char* a2 = last ? nA : cA + (size_t)(t + 2) * kstep; const char* b2 = last ? nB : cB + (size_t)(t + 2) * kstep;
            const char* a3 = a2 + kstep; const char* b3 = b2 + kstep;
            if (last && has_next) S.a_ready(nxt);
            if constexpr (SP2) {
            PG8_LDB(B0, 0, 0); PG8_LDB(B1, 0, 1); PG8_SCHED; PG8_LDA(At, 0, 0); PG8_STAGE(PG8_SA(1, 1), a1 + hstepA, voffA);
            PG8_WAIT_V(8); PG8_WAIT_L(0); PG8_BAR; PG8_MMA(0, 0, At, B0); PG8_MMA(0, 1, At, B1); PG8_BAR; PG8_SCHED;
            PG8_LDA(At, 0, 1); PG8_STAGE(PG8_SB(0, 0), b2, voffB); PG8_STAGE(PG8_SB(0, 1), b2 + hstepB, voffB); PG8_STAGE(PG8_SA(0, 0), a2, voffA);
            PG8_WAIT_V(8); PG8_WAIT_L(0); PG8_BAR; PG8_MMA(1, 0, At, B0); PG8_MMA(1, 1, At, B1); PG8_BAR; PG8_SCHED;
            PG8_LDB(B0, 1, 0); PG8_LDB(B1, 1, 1); PG8_SCHED; PG8_LDA(At, 1, 0); PG8_STAGE(PG8_SA(0, 1), a2 + hstepA, voffA);
            PG8_WAIT_V(8); PG8_WAIT_L(0); PG8_BAR; PG8_MMA(0, 0, At, B0); PG8_MMA(0, 1, At, B1); PG8_BAR; PG8_SCHED;
            PG8_LDA(At, 1, 1); PG8_STAGE(PG8_SB(1, 0), b3, voffB); PG8_STAGE(PG8_SB(1, 1), b3 + hstepB, voffB); PG8_STAGE(PG8_SA(1, 0), a3, voffA);
            PG8_WAIT_V(8); PG8_WAIT_L(0); PG8_BAR; PG8_MMA(1, 0, At, B0); PG8_MMA(1, 1, At, B1); PG8_BAR; PG8_SCHED;
            } else {
            PG8_LDB(B0, 0, 0); PG8_SCHED; PG8_LDA(At, 0, 0); PG8_STAGE(PG8_SA(1, 1), a1 + hstepA, voffA);
            PG8_WAIT_L(8); PG8_BAR; PG8_WAIT_L(0); PG8_MMA(0, 0, At, B0); PG8_BAR; PG8_SCHED;
            PG8_LDB(B1, 0, 1); PG8_STAGE(PG8_SB(0, 0), b2, voffB);
            PG8_BAR; PG8_WAIT_L(0); PG8_MMA(0, 1, At, B1); PG8_BAR;
            PG8_LDA(At, 0, 1); PG8_STAGE(PG8_SA(0, 0), a2, voffA);
            PG8_BAR; PG8_WAIT_L(0); PG8_MMA(1, 0, At, B0); PG8_BAR; PG8_SCHED;
            PG8_STAGE(PG8_SB(0, 1), b2 + hstepB, voffB);
            PG8_WAIT_V(6); PG8_BAR; PG8_MMA(1, 1, At, B1); PG8_BAR;
            PG8_LDB(B0, 1, 0); PG8_SCHED; PG8_LDA(At, 1, 0); PG8_STAGE(PG8_SA(0, 1), a2 + hstepA, voffA);
            PG8_WAIT_L(8); PG8_BAR; PG8_WAIT_L(0); PG8_MMA(0, 0, At, B0); PG8_BAR; PG8_SCHED;
            PG8_LDB(B1, 1, 1); PG8_STAGE(PG8_SB(1, 0), b3, voffB);
            PG8_BAR; PG8_WAIT_L(0); PG8_MMA(0, 1, At, B1); PG8_BAR;
            PG8_LDA(At, 1, 1); PG8_STAGE(PG8_SA(1, 0), a3, voffA);
            PG8_BAR; PG8_WAIT_L(0); PG8_MMA(1, 0, At, B0); PG8_BAR; PG8_SCHED;
            PG8_STAGE(PG8_SB(1, 1), b3 + hstepB, voffB);
            PG8_WAIT_V(6); PG8_BAR; PG8_MMA(1, 1, At, B1); PG8_BAR;
            }
        }
        if constexpr (ALIGN_EPI) { if (wr == 0) PG8_BAR; }
        if constexpr (!Epi::AFTER_DRAIN) { E(acc, cur, wr, wc, fr, fq); S.done(cur); }
        if (!has_next) break;
#pragma unroll
        for (int a = 0; a < 2; ++a)
#pragma unroll
            for (int b = 0; b < 2; ++b)
#pragma unroll
                for (int m = 0; m < 4; ++m)
#pragma unroll
                    for (int n = 0; n < 2; ++n) acc[a][b][m][n] = (f32x4){0.f, 0.f, 0.f, 0.f};
        cur = nxt; cA = nA; cB = nB; ++ui;
        if constexpr (ALIGN_EPI) { if (wr == 1) PG8_BAR; }
    }
    PG8_WAIT_V(0);
    if constexpr (!ALIGN_EPI) { if (wr == 0) PG8_BAR; }
    PG8_BAR;
    if constexpr (Epi::AFTER_DRAIN) { E.fused(acc, cur, wr, wc, fr, fq, lds, wid, lane); S.done(cur); }
#undef PG8_SA
#undef PG8_SB
#undef PG8_STAGE
#undef PG8_LDA
#undef PG8_LDB
#undef PG8_MMA
#undef PG8_WAIT_V
#undef PG8_WAIT_L
#undef PG8_BAR
#undef PG8_SCHED
}
}
namespace att {
typedef unsigned short bf16_t;
using bf16x8 = __attribute__((ext_vector_type(8))) short;
using s16x4  = __attribute__((ext_vector_type(4))) short;
using f32x16 = __attribute__((ext_vector_type(16))) float;
using u32x4  = __attribute__((ext_vector_type(4))) unsigned;
constexpr int DV = 128, NW = 8, QBLK = 32, KVBLK = 64;
constexpr float THR = 8.f;
constexpr int SHM_V = KVBLK * DV * 2;
template <int DQK> struct Cfg {
    static constexpr int SHM_K = KVBLK * DQK * 2, KROWB = DQK * 2, NCK = DQK / 64, C8 = DQK / 8, ND0 = DQK / 16;
    static constexpr float SCALE = (DQK == 128) ? 0.088388347648318440f : 0.072168783648703220f;
    static constexpr int LDS_BYTES = 2 * SHM_V + 2 * SHM_K + NW * 64 * 4;
};
#define ATT_SBAR() __builtin_amdgcn_sched_barrier(0)
__device__ __forceinline__ int crow(int r, int hi) { return (r & 3) + 8 * (r >> 2) + 4 * hi; }
__device__ __forceinline__ unsigned cvtpk(float lo, float hi) { unsigned r; asm volatile("v_cvt_pk_bf16_f32 %0, %1, %2" : "=v"(r) : "v"(lo), "v"(hi)); return r; }
template <int DQK> __device__ __forceinline__ int kswz(int row, int colB) {
    const int key = (DQK == 128) ? (row & 7) : ((row >> 1) & 7);
    return row * (DQK * 2) + (colB ^ (key << 4));
}
template <int DQK> __device__ __forceinline__ void partialSM(f32x16& p0, f32x16& p1, float& m_reg, float& mn, float& alpha) {
    constexpr float SCALE = Cfg<DQK>::SCALE, C = SCALE * 1.4426950408889634f;
    float pmax = p0[0];
#pragma unroll
    for (int r = 1; r < 16; ++r) pmax = fmaxf(pmax, p0[r]);
#pragma unroll
    for (int r = 0; r < 16; ++r) pmax = fmaxf(pmax, p1[r]);
    { auto rr = __builtin_amdgcn_permlane32_swap(__float_as_uint(pmax), __float_as_uint(pmax), false, false);
      pmax = fmaxf(__uint_as_float(rr[0]), __uint_as_float(rr[1])); }
    if (__builtin_expect(__all(pmax - m_reg <= THR / SCALE), 1)) { mn = m_reg; alpha = 1.f; }
    else { mn = fmaxf(m_reg, pmax); alpha = __builtin_amdgcn_exp2f((m_reg - mn) * C); m_reg = mn; }
    const float mnC = -mn * C;
#pragma unroll
    for (int r = 0; r < 16; ++r) p0[r] = fmaf(p0[r], C, mnC);
#pragma unroll
    for (int r = 0; r < 16; ++r) p1[r] = fmaf(p1[r], C, mnC);
#pragma unroll
    for (int r = 0; r < 16; ++r) p0[r] = __builtin_amdgcn_exp2f(p0[r]);
}
__device__ __forceinline__ void finishSM(f32x16& p0, f32x16& p1, float alpha, float& l_reg, bf16x8& pa0, bf16x8& pa1, bf16x8& pa2, bf16x8& pa3) {
#pragma unroll
    for (int r = 0; r < 16; ++r) p1[r] = __builtin_amdgcn_exp2f(p1[r]);
    float ps = 0;
#pragma unroll
    for (int r = 0; r < 16; ++r) ps += p0[r];
#pragma unroll
    for (int r = 0; r < 16; ++r) ps += p1[r];
    { auto rr = __builtin_amdgcn_permlane32_swap(__float_as_uint(ps), __float_as_uint(ps), false, false);
      ps = __uint_as_float(rr[0]) + __uint_as_float(rr[1]); }
    l_reg = l_reg * alpha + ps;
#define ATT_PK4(P, BASE, OUT) do { unsigned a0 = cvtpk(P[BASE + 0], P[BASE + 1]), a1 = cvtpk(P[BASE + 2], P[BASE + 3]);   \
    unsigned b0 = cvtpk(P[BASE + 4], P[BASE + 5]), b1 = cvtpk(P[BASE + 6], P[BASE + 7]);                              \
    auto r0 = __builtin_amdgcn_permlane32_swap(a0, b0, false, false); auto r1 = __builtin_amdgcn_permlane32_swap(a1, b1, false, false); \
    u32x4 w = {r0[0], r1[0], r0[1], r1[1]}; OUT = *reinterpret_cast<bf16x8*>(&w); } while (0)
    ATT_PK4(p0, 0, pa0); ATT_PK4(p0, 8, pa1); ATT_PK4(p1, 0, pa2); ATT_PK4(p1, 8, pa3);
#undef ATT_PK4
}
template <int DQK> __device__ __forceinline__ void qkt(f32x16& p0, f32x16& p1, const char* Ks, const bf16x8* qr, int r32, int hi) {
    p0 = f32x16{}; p1 = f32x16{};
#pragma unroll
    for (int d0 = 0; d0 < Cfg<DQK>::ND0; ++d0) { const int cb = (d0 * 16 + hi * 8) * 2;
        bf16x8 b0 = *reinterpret_cast<const bf16x8*>(Ks + kswz<DQK>(r32, cb));
        bf16x8 b1 = *reinterpret_cast<const bf16x8*>(Ks + kswz<DQK>(32 + r32, cb));
        p0 = __builtin_amdgcn_mfma_f32_32x32x16_bf16(b0, qr[d0], p0, 0, 0, 0);
        p1 = __builtin_amdgcn_mfma_f32_32x32x16_bf16(b1, qr[d0], p1, 0, 0, 0); }
}
__device__ __forceinline__ int v_st(int k, int c) { const int kk = (k & ~0xC) | ((k & 4) << 1) | ((k & 8) >> 1); return ((kk >> 3) * 4 + (c >> 5)) * 512 + ((kk & 7) * 32 + (c & 31)) * 2; }
__device__ __forceinline__ int v_rd_base(int lane) { return ((lane & 3) << 3) | (((lane >> 2) & 3) << 6) | (((lane >> 4) & 1) << 5) | (((lane >> 5) & 1) << 8); }
constexpr int v_rd_off(int d0, int ks, int half) { return d0 * 512 + ks * 4096 + half * 2048; }
template <int OFF> __device__ __forceinline__ s16x4 tr_read(int vb) {
    s16x4 r; asm volatile("ds_read_b64_tr_b16 %0, %1 offset:%2" : "=&v"(r) : "v"(vb), "i"(OFF) : "memory"); return r;
}
template <int D0> __device__ __forceinline__ void pv_one(f32x16& od, int vb, bf16x8 pa0, bf16x8 pa1, bf16x8 pa2, bf16x8 pa3) {
    const s16x4 l0 = tr_read<v_rd_off(D0, 0, 0)>(vb), h0 = tr_read<v_rd_off(D0, 0, 1)>(vb), l1 = tr_read<v_rd_off(D0, 1, 0)>(vb), h1 = tr_read<v_rd_off(D0, 1, 1)>(vb);
    const s16x4 l2 = tr_read<v_rd_off(D0, 2, 0)>(vb), h2 = tr_read<v_rd_off(D0, 2, 1)>(vb), l3 = tr_read<v_rd_off(D0, 3, 0)>(vb), h3 = tr_read<v_rd_off(D0, 3, 1)>(vb);
    asm volatile("s_waitcnt lgkmcnt(0)" ::: "memory"); ATT_SBAR();
#define ATT_PK(L, H) (bf16x8){L[0], L[1], L[2], L[3], H[0], H[1], H[2], H[3]}
    od = __builtin_amdgcn_mfma_f32_32x32x16_bf16(pa0, ATT_PK(l0, h0), od, 0, 0, 0);
    od = __builtin_amdgcn_mfma_f32_32x32x16_bf16(pa1, ATT_PK(l1, h1), od, 0, 0, 0);
    od = __builtin_amdgcn_mfma_f32_32x32x16_bf16(pa2, ATT_PK(l2, h2), od, 0, 0, 0);
    od = __builtin_amdgcn_mfma_f32_32x32x16_bf16(pa3, ATT_PK(l3, h3), od, 0, 0, 0);
#undef ATT_PK
}
__device__ __forceinline__ void pv_d0(f32x16* o, int vb, bf16x8 pa0, bf16x8 pa1, bf16x8 pa2, bf16x8 pa3) {
    pv_one<0>(o[0], vb, pa0, pa1, pa2, pa3); pv_one<1>(o[1], vb, pa0, pa1, pa2, pa3); pv_one<2>(o[2], vb, pa0, pa1, pa2, pa3); pv_one<3>(o[3], vb, pa0, pa1, pa2, pa3);
}
template <int DQK, int LDQ, int LDK, int LDV, int LDO, int SDEPTH>
__device__ __forceinline__ void attn_body(const bf16_t* __restrict__ Qb, const bf16_t* __restrict__ Kh, const bf16_t* __restrict__ Vh, bf16_t* __restrict__ Ob, int seq, char* lds, int tid_in) {
    using C_ = Cfg<DQK>;
    constexpr int SHM_K = C_::SHM_K, NCK = C_::NCK, C8 = C_::C8, ND0 = C_::ND0;
    int tid_ = tid_in; asm volatile("" : "+v"(tid_));
    const int tid = tid_, wid = tid >> 6, lane = tid & 63, r32 = lane & 31, hi = lane >> 5;
    char* V_lds = lds; char* K_lds = lds + 2 * SHM_V;
    float* ws = (float*)(lds + 2 * SHM_V + 2 * SHM_K) + wid * 64; float* li_l = ws; float* al_l = ws + 32;
    float m_reg = -1e30f, l_reg = 0; f32x16 o[4] = {}; bf16x8 qr[ND0];
    const bf16_t* Qw = Qb + (long)(wid * QBLK + r32) * LDQ + hi * 8;
#pragma unroll
    for (int d0 = 0; d0 < ND0; ++d0) qr[d0] = *reinterpret_cast<const bf16x8*>(Qw + d0 * 16);
    const int sr = tid >> 4, sc = (tid & 15) * 8, vst0 = v_st(sr, sc), vst1 = v_st(32 + sr, sc);
    int krow[NCK], kcol[NCK];
#pragma unroll
    for (int i = 0; i < NCK; ++i) { const int ci = tid + 512 * i; krow[i] = ci / C8; kcol[i] = (ci % C8) * 8; }
    const int vb0 = (int)(uintptr_t)V_lds + v_rd_base(lane);
    struct { bf16x8 vs0, vs1, ks[NCK]; } sr_[SDEPTH];
#define ATT_SLOAD(i, k0) do { sr_[i].vs0 = *reinterpret_cast<const bf16x8*>(&Vh[(long)((k0) + sr) * LDV + sc]); sr_[i].vs1 = *reinterpret_cast<const bf16x8*>(&Vh[(long)((k0) + 32 + sr) * LDV + sc]); \
    _Pragma("unroll") for (int c_ = 0; c_ < NCK; ++c_) sr_[i].ks[c_] = *reinterpret_cast<const bf16x8*>(&Kh[(long)((k0) + krow[c_]) * LDK + kcol[c_]]); } while (0)
#define ATT_SWRITE(b, i) do { *(bf16x8*)(V_lds + (b) * SHM_V + vst0) = sr_[i].vs0; *(bf16x8*)(V_lds + (b) * SHM_V + vst1) = sr_[i].vs1; \
    _Pragma("unroll") for (int c_ = 0; c_ < NCK; ++c_) *(bf16x8*)(K_lds + (b) * SHM_K + kswz<DQK>(krow[c_], kcol[c_] * 2)) = sr_[i].ks[c_]; } while (0)
#define ATT_SWAIT() do { if constexpr (SDEPTH == 2) { if constexpr (NCK == 2) asm volatile("s_waitcnt vmcnt(4)" ::: "memory"); else asm volatile("s_waitcnt vmcnt(5)" ::: "memory"); } else asm volatile("s_waitcnt vmcnt(0)" ::: "memory"); } while (0)
#define ATT_RESC(a) do { if (__any((a) < 1.f)) { if (hi == 0) al_l[r32] = (a); asm volatile("s_waitcnt lgkmcnt(0)" ::: "memory"); \
    _Pragma("unroll") for (int d = 0; d < 4; ++d) _Pragma("unroll") for (int r = 0; r < 16; ++r) o[d][r] *= al_l[crow(r, hi)]; } } while (0)
    f32x16 pA0, pA1, pB0, pB1; float mnA, mnB, alA, alB; bf16x8 pa0, pa1, pa2, pa3; const int NT = seq / KVBLK;
    constexpr int SE = 0, SO = SDEPTH - 1;
    ATT_SLOAD(SE, 0); asm volatile("s_waitcnt vmcnt(0)" ::: "memory"); ATT_SWRITE(0, SE); __syncthreads();
    qkt<DQK>(pA0, pA1, K_lds, qr, r32, hi); partialSM<DQK>(pA0, pA1, m_reg, mnA, alA);
    ATT_SLOAD(SO, KVBLK); if constexpr (SDEPTH == 2) { if (2 < NT) ATT_SLOAD(SE, 2 * KVBLK); }
    ATT_SWAIT(); ATT_SWRITE(1, SO); __syncthreads();
    for (int j = 1; j + 1 < NT; j += 2) {
        ATT_SBAR(); qkt<DQK>(pB0, pB1, K_lds + SHM_K, qr, r32, hi);
        finishSM(pA0, pA1, alA, l_reg, pa0, pa1, pa2, pa3); ATT_SBAR();
        ATT_SLOAD(SO, (j + SDEPTH) * KVBLK); ATT_SBAR();
        pv_d0(o, vb0, pa0, pa1, pa2, pa3); partialSM<DQK>(pB0, pB1, m_reg, mnB, alB);
        __syncthreads(); ATT_SWAIT(); ATT_SWRITE(0, SE);
        ATT_RESC(alB); __syncthreads();
        ATT_SBAR(); qkt<DQK>(pA0, pA1, K_lds, qr, r32, hi);
        finishSM(pB0, pB1, alB, l_reg, pa0, pa1, pa2, pa3); ATT_SBAR();
        if (SDEPTH == 1 || j + 3 < NT) ATT_SLOAD(SE, (j + 1 + SDEPTH) * KVBLK); ATT_SBAR();
        pv_d0(o, vb0 + (int)SHM_V, pa0, pa1, pa2, pa3); partialSM<DQK>(pA0, pA1, m_reg, mnA, alA);
        __syncthreads(); ATT_SWAIT(); ATT_SWRITE(1, SO);
        ATT_RESC(alA); __syncthreads();
    }
    ATT_SBAR(); qkt<DQK>(pB0, pB1, K_lds + SHM_K, qr, r32, hi);
    finishSM(pA0, pA1, alA, l_reg, pa0, pa1, pa2, pa3); ATT_SBAR();
    pv_d0(o, vb0, pa0, pa1, pa2, pa3); partialSM<DQK>(pB0, pB1, m_reg, mnB, alB);
    __syncthreads(); ATT_RESC(alB);
    finishSM(pB0, pB1, alB, l_reg, pa0, pa1, pa2, pa3); ATT_SBAR();
    pv_d0(o, vb0 + (int)SHM_V, pa0, pa1, pa2, pa3);
    if (hi == 0) li_l[r32] = l_reg;
    asm volatile("s_waitcnt lgkmcnt(0)" ::: "memory");
    __syncthreads();
    float rli[16];
#pragma unroll
    for (int r = 0; r < 16; ++r) rli[r] = __builtin_amdgcn_rcpf(li_l[crow(r, hi)]);
    unsigned short* stg = (unsigned short*)(lds + wid * 8192);
#pragma unroll
    for (int r = 0; r < 16; ++r) { const int orow = crow(r, hi);
#pragma unroll
        for (int d0 = 0; d0 < 4; ++d0) { const unsigned w = cvtpk(o[d0][r] * rli[r], 0.f); stg[orow * 128 + d0 * 32 + r32] = (unsigned short)(w & 0xffffu); } }
    asm volatile("s_waitcnt lgkmcnt(0)" ::: "memory");
    bf16_t* Ow = Ob + (long)(wid * QBLK) * LDO;
#pragma unroll
    for (int i = 0; i < 8; ++i) { const int id = lane + 64 * i, row = id >> 4, c16 = id & 15;
        const u32x4 v = *(const u32x4*)((const char*)stg + row * 256 + c16 * 16);
        *(u32x4*)(Ow + (long)row * LDO + c16 * 8) = v; }
    asm volatile("s_waitcnt lgkmcnt(0)" ::: "memory");
    __syncthreads();
#undef ATT_SLOAD
#undef ATT_SWRITE
#undef ATT_SWAIT
#undef ATT_RESC
}

template <int DQK, int LDQ, int LDK, int LDV, int LDO>
__device__ __forceinline__ void attn_body1(const bf16_t* __restrict__ Qb, const bf16_t* __restrict__ Kh, const bf16_t* __restrict__ Vh, bf16_t* __restrict__ Ob, int seq, char* lds, int tid_in) {
    using C_ = Cfg<DQK>;
    constexpr int SHM_K = C_::SHM_K, NCK = C_::NCK, C8 = C_::C8, ND0 = C_::ND0;
    int tid_ = tid_in; asm volatile("" : "+v"(tid_));
    const int tid = tid_, wid = tid >> 6, lane = tid & 63, r32 = lane & 31, hi = lane >> 5;
    char* V_lds = lds; char* K_lds = lds + 2 * SHM_V;
    float* ws = (float*)(lds + 2 * SHM_V + 2 * SHM_K) + wid * 64; float* li_l = ws; float* al_l = ws + 32;
    float m_reg = -1e30f, l_reg = 0; f32x16 o[4] = {}; bf16x8 qr[ND0];
    const bf16_t* Qw = Qb + (long)(wid * QBLK + r32) * LDQ + hi * 8;
#pragma unroll
    for (int d0 = 0; d0 < ND0; ++d0) qr[d0] = *reinterpret_cast<const bf16x8*>(Qw + d0 * 16);
    const int sr = tid >> 4, sc = (tid & 15) * 8, vst0 = v_st(sr, sc), vst1 = v_st(32 + sr, sc);
    int krow[NCK], kcol[NCK];
#pragma unroll
    for (int i = 0; i < NCK; ++i) { const int ci = tid + 512 * i; krow[i] = ci / C8; kcol[i] = (ci % C8) * 8; }
    const int vb0 = (int)(uintptr_t)V_lds + v_rd_base(lane);
    bf16x8 vs0, vs1, ks[NCK];
#define ATT1_SLOAD(k0) do { vs0 = *reinterpret_cast<const bf16x8*>(&Vh[(long)((k0) + sr) * LDV + sc]); vs1 = *reinterpret_cast<const bf16x8*>(&Vh[(long)((k0) + 32 + sr) * LDV + sc]); \
    _Pragma("unroll") for (int c_ = 0; c_ < NCK; ++c_) ks[c_] = *reinterpret_cast<const bf16x8*>(&Kh[(long)((k0) + krow[c_]) * LDK + kcol[c_]]); } while (0)
#define ATT1_SWRITE(b) do { *(bf16x8*)(V_lds + (b) * SHM_V + vst0) = vs0; *(bf16x8*)(V_lds + (b) * SHM_V + vst1) = vs1; \
    _Pragma("unroll") for (int c_ = 0; c_ < NCK; ++c_) *(bf16x8*)(K_lds + (b) * SHM_K + kswz<DQK>(krow[c_], kcol[c_] * 2)) = ks[c_]; } while (0)
    const int NT = seq / KVBLK;
    ATT1_SLOAD(0); asm volatile("s_waitcnt vmcnt(0)" ::: "memory"); ATT1_SWRITE(0); __syncthreads();
    for (int j = 0; j < NT; ++j) {
        const int b = j & 1;
        if (j + 1 < NT) ATT1_SLOAD((j + 1) * KVBLK);
        ATT_SBAR();
        f32x16 p0, p1; float mn, alpha; bf16x8 pa0, pa1, pa2, pa3;
        qkt<DQK>(p0, p1, K_lds + b * SHM_K, qr, r32, hi);
        partialSM<DQK>(p0, p1, m_reg, mn, alpha);
        if (__any(alpha < 1.f)) { if (hi == 0) al_l[r32] = alpha; asm volatile("s_waitcnt lgkmcnt(0)" ::: "memory");
#pragma unroll
            for (int d = 0; d < 4; ++d)
#pragma unroll
                for (int r = 0; r < 16; ++r) o[d][r] *= al_l[crow(r, hi)]; }
        finishSM(p0, p1, alpha, l_reg, pa0, pa1, pa2, pa3); ATT_SBAR();
        pv_d0(o, vb0 + b * (int)SHM_V, pa0, pa1, pa2, pa3);
        if (j + 1 < NT) { ATT1_SWRITE(b ^ 1); }
        __syncthreads();
    }
    if (hi == 0) li_l[r32] = l_reg;
    asm volatile("s_waitcnt lgkmcnt(0)" ::: "memory");
    __syncthreads();
    float rli[16];
#pragma unroll
    for (int r = 0; r < 16; ++r) rli[r] = __builtin_amdgcn_rcpf(li_l[crow(r, hi)]);
    unsigned short* stg = (unsigned short*)(lds + wid * 8192);
#pragma unroll
    for (int r = 0; r < 16; ++r) { const int orow = crow(r, hi);
#pragma unroll
        for (int d0 = 0; d0 < 4; ++d0) { const unsigned w = cvtpk(o[d0][r] * rli[r], 0.f); stg[orow * 128 + d0 * 32 + r32] = (unsigned short)(w & 0xffffu); } }
    asm volatile("s_waitcnt lgkmcnt(0)" ::: "memory");
    bf16_t* Ow = Ob + (long)(wid * QBLK) * LDO;
#pragma unroll
    for (int i = 0; i < 8; ++i) { const int id = lane + 64 * i, row = id >> 4, c16 = id & 15;
        const u32x4 v = *(const u32x4*)((const char*)stg + row * 256 + c16 * 16);
        *(u32x4*)(Ow + (long)row * LDO + c16 * 8) = v; }
    asm volatile("s_waitcnt lgkmcnt(0)" ::: "memory");
    __syncthreads();
#undef ATT1_SLOAD
#undef ATT1_SWRITE
}
}
constexpr int DM = 2048, NBATCH = 2, SEQ = 4096, CTX = 256, RB = SEQ + CTX  , MROWS = NBATCH * RB  ;
constexpr int NMOD = 6 * DM, NEXP = 16384;
constexpr float EPS = 1e-6f;
constexpr int NWAVES = 8, NTHREADS = 512;
constexpr size_t MiB = 1u << 20;
constexpr size_t WS_CTL = 0, CTL_ZERO_BYTES = 64 * 1024;
constexpr size_t WS_MOD = 1 * MiB;
constexpr size_t WS_ROPE = 2 * MiB;
constexpr size_t WS_SMALL = 3 * MiB;
constexpr int SM_N1G = 0, SM_N2G = 8192, SM_AQG = 16384, SM_AKG = 16384 + 384, SM_CW = 16384 + 768, SM_CB = SM_CW + 6144, SM_CQG = SM_CB + 2048, SM_CKG = SM_CQG + 256, SM_END = SM_CKG + 256;
constexpr size_t WS_XW = 4 * MiB;
constexpr size_t WS_H = 72 * MiB;
constexpr size_t WS_P = 106 * MiB;
constexpr size_t WS_QRAW = 174 * MiB;
constexpr size_t WS_KVRAW = 200 * MiB;
constexpr size_t WS_Q = 234 * MiB;
constexpr size_t WS_K = 268 * MiB;
constexpr size_t WS_V = 294 * MiB;
constexpr size_t WS_CAT = 311 * MiB;
constexpr size_t WS_PQ = 345 * MiB;
constexpr size_t WS_IDX = 379 * MiB;
constexpr size_t WS_GATE = 384 * MiB;
constexpr size_t WS_WIN = 389 * MiB;
constexpr size_t WS_WUQ = 421 * MiB;
constexpr size_t WS_WUKV = 424 * MiB;
constexpr size_t WS_WEO = 426 * MiB;
constexpr size_t WS_WQKV = 442 * MiB;
constexpr size_t WS_WCO = 466 * MiB;
constexpr size_t WS_WPQ = 482 * MiB;
constexpr size_t WS_SUBK = 514 * MiB;
#ifndef TAB_FP4
#define TAB_FP4 1
#endif
#if TAB_FP4
constexpr int ROWB = 1024;
#else
constexpr int ROWB = 1536;
#endif
constexpr size_t WS_U = 516 * MiB;
constexpr size_t WS_VT = 644 * MiB;
constexpr size_t WS_USC = 772 * MiB;
constexpr size_t WS_VSC = 773 * MiB;
constexpr size_t WS_END = 774 * MiB;
constexpr int CW_BAR = 4096;
constexpr int LDS_MISC = 131072 + 8192;
constexpr int LDS_BYTES = 147456;

#define LAS __attribute__((address_space(3)))
typedef unsigned short bf16_t;
typedef float f32x4 __attribute__((ext_vector_type(4)));
typedef unsigned u32x4 __attribute__((ext_vector_type(4)));
typedef unsigned u32x2 __attribute__((ext_vector_type(2)));
typedef short bf16x8 __attribute__((ext_vector_type(8)));
typedef float f32x16 __attribute__((ext_vector_type(16)));
typedef __bf16 bf16x2_t __attribute__((ext_vector_type(2)));
typedef float f32x2 __attribute__((ext_vector_type(2)));
typedef float f32x32 __attribute__((ext_vector_type(32)));
typedef unsigned u32x6 __attribute__((ext_vector_type(6)));

__device__ __forceinline__ unsigned f2bf(float f) { unsigned u = __builtin_bit_cast(unsigned, f); return (u + 0x7fffu + ((u >> 16) & 1u)) >> 16; }
__device__ __forceinline__ unsigned pk2(float lo, float hi) { return f2bf(lo) | (f2bf(hi) << 16); }
__device__ __forceinline__ float bf_lo(unsigned w) { return __builtin_bit_cast(float, w << 16); }
__device__ __forceinline__ float bf_hi(unsigned w) { return __builtin_bit_cast(float, w & 0xffff0000u); }
__device__ __forceinline__ float bf2f(bf16_t h) { return __builtin_bit_cast(float, (unsigned)h << 16); }
__device__ __forceinline__ float wave_sum(float v) {
#pragma unroll
    for (int o = 1; o < 64; o <<= 1) v += __shfl_xor(v, o);
    return v;
}
#define DPP_ADD(v, ctrl) ((v) + __builtin_bit_cast(float, __builtin_amdgcn_update_dpp(0, __builtin_bit_cast(int, (v)), (ctrl), 0xf, 0xf, true)))
__device__ __forceinline__ float wave_sum_dpp(float v) {
    v = DPP_ADD(v, 0xB1);
    v = DPP_ADD(v, 0x4E);
    v = DPP_ADD(v, 0x141);
    v = DPP_ADD(v, 0x140);
    const int vi = __builtin_bit_cast(int, v);
    const float s0 = __builtin_bit_cast(float, __builtin_amdgcn_readlane(vi, 0)), s1 = __builtin_bit_cast(float, __builtin_amdgcn_readlane(vi, 16));
    const float s2 = __builtin_bit_cast(float, __builtin_amdgcn_readlane(vi, 32)), s3 = __builtin_bit_cast(float, __builtin_amdgcn_readlane(vi, 48));
    return (s0 + s1) + (s2 + s3);
}
__device__ __forceinline__ float dot2_bf16(unsigned w, unsigned x, float acc) { return __builtin_amdgcn_fdot2_f32_bf16(__builtin_bit_cast(bf16x2_t, w), __builtin_bit_cast(bf16x2_t, x), acc, false); }
__device__ __forceinline__ float gelu_erf(float v) {
    const float av = fabsf(v), t = __builtin_amdgcn_rcpf(av * 0.2316418882f + 1.0f);
    float q = t * 0.5307027145f + (-0.7265760135f); q = q * t + 0.7107068705f; q = q * t + (-0.142248368f); q = q * t + 0.127414796f; q = q * t;
    const float e = __builtin_amdgcn_exp2f((v * v) * (-0.72134752044f));
    const float m = v * (q * e);
    return v < 0.f ? m : v - m;
}
#define XB_TMO      128
#define XB_XCNT(j)  (256  + 64 * (j))
#define XB_XSUB(j)  (1280 + 64 * (j))
#define XB_XGEN(j)  (2304 + 64 * (j))
#define XB_TOP      3328
#define XB_TOPGEN   3392
#define XCD_BAR_WORDS 3456
#define XB_SPIN_CAP (1u << 18)

__device__ __forceinline__ unsigned xb_ld(unsigned* p)              { return __hip_atomic_load(p, __ATOMIC_RELAXED, __HIP_MEMORY_SCOPE_AGENT); }
__device__ __forceinline__ unsigned xb_add(unsigned* p, unsigned v) { return __hip_atomic_fetch_add(p, v, __ATOMIC_RELAXED, __HIP_MEMORY_SCOPE_AGENT); }
__device__ __forceinline__ unsigned xb_xcc_id() { return (unsigned)__builtin_amdgcn_s_getreg((3 << 11) | 20) & 0xFu; }
#define XB_SPIN(cond, bar) do { unsigned _sp = 0; while (cond) { __builtin_amdgcn_s_sleep(1); \
    if ((++_sp & 255u) == 0u) { if (xb_ld(&(bar)[XB_TMO])) break; if (_sp > XB_SPIN_CAP) { atomicAdd(&(bar)[XB_TMO], 1u); break; } } } } while (0)

struct XcdBarrier {
    unsigned* bar; unsigned x;
    volatile LAS unsigned* st;
};

__device__ __forceinline__ XcdBarrier xcd_barrier_post(unsigned* bar, volatile LAS unsigned* st) {
    XcdBarrier b; b.bar = bar; b.x = xb_xcc_id(); b.st = st;
    if (threadIdx.x == 0) (void)xb_add(&bar[XB_XCNT(b.x)], 1u);
    return b;
}
__device__ __forceinline__ void xcd_barrier_complete(unsigned* bar, unsigned x, unsigned& nloc, unsigned& nx) {
    const unsigned G = gridDim.x * gridDim.y * gridDim.z;
    unsigned sum, cnt, mine, sp = 0u;
    for (;;) {
        sum = 0u; cnt = 0u; mine = 0u;
#pragma unroll
        for (unsigned j = 0; j < 16; ++j) { const unsigned c = xb_ld(&bar[XB_XCNT(j)]); sum += c; cnt += (c > 0u) ? 1u : 0u; mine = (j == x) ? c : mine; }
        if (sum == G) break;
        __builtin_amdgcn_s_sleep(1);
        if ((++sp & 255u) == 0u) { if (xb_ld(&bar[XB_TMO])) break; if (sp > XB_SPIN_CAP) { atomicAdd(&bar[XB_TMO], 1u); break; } }
    }
    nloc = mine > 0u ? mine : 1u; nx = cnt > 0u ? cnt : 1u;
}

__device__ __forceinline__ void xcd_barrier(const XcdBarrier& b) {
    asm volatile("s_waitcnt vmcnt(0)" ::: "memory");
    __syncthreads();
    if (threadIdx.x == 0) {
        unsigned* bar = b.bar; unsigned bx = b.x;
        asm volatile("" : "+s"(bar), "+s"(bx));
        __builtin_amdgcn_s_waitcnt(0);
        unsigned nloc = b.st[0], nx = b.st[1];
        if (nloc == 0u) { xcd_barrier_complete(bar, bx, nloc, nx); b.st[0] = nloc; b.st[1] = nx; }
        const unsigned old = xb_add(&bar[XB_XSUB(bx)], 1u);
        const unsigned gen = old / nloc;
        if (old + 1u == (gen + 1u) * nloc) {
            __builtin_amdgcn_fence(__ATOMIC_RELEASE, "agent");
            asm volatile("s_waitcnt vmcnt(0)" ::: "memory");
            const unsigned og = xb_add(&bar[XB_TOP], 1u);
            const unsigned tg = og / nx;
            if (og + 1u == (tg + 1u) * nx) xb_add(&bar[XB_TOPGEN], 1u);
            else XB_SPIN(xb_ld(&bar[XB_TOPGEN]) == tg, bar);
            __builtin_amdgcn_fence(__ATOMIC_ACQUIRE, "agent");
            xb_add(&bar[XB_XGEN(bx)], 1u);
            asm volatile("s_waitcnt vmcnt(0)" ::: "memory");
        } else {
            XB_SPIN(xb_ld(&bar[XB_XGEN(bx)]) == gen, bar);
            __builtin_amdgcn_fence(__ATOMIC_ACQUIRE, "agent");
            asm volatile("s_waitcnt vmcnt(0)" ::: "memory");
        }
    }
    __syncthreads();
}
struct Frame {
    LAS unsigned char* lds;
    int tid, lane, wave, vcu, G, gw, NGW;
    unsigned char* ws;
};
__device__ __forceinline__ int opaque_v(int v) { asm volatile("" : "+v"(v)); return v; }
__device__ __forceinline__ int phase_tid(int wave) { int lane; asm volatile("v_mbcnt_lo_u32_b32 %0, -1, 0\n\tv_mbcnt_hi_u32_b32 %0, -1, %0" : "=v"(lane)); return wave * 64 + lane; }
__device__ __forceinline__ Frame phase_frame(const Frame& F0) { Frame F = F0; F.tid = phase_tid(F0.wave); F.lane = F.tid & 63; return F; }
__device__ __forceinline__ float swap32(float v, int lane) { auto rr = __builtin_amdgcn_permlane32_swap(__float_as_uint(v), __float_as_uint(v), false, false); return __uint_as_float(lane < 32 ? rr[1] : rr[0]); }
__device__ __forceinline__ int row_cls(int row) { const int b = row / RB, i = row - b * RB; return i < CTX ? 2 : b; }

__device__ __forceinline__ void p0_transpose_item(const float* W, int K, int N, bf16_t* WT, const float* gain, LAS float* scr, int item, int lane, bool perm_q = false) {
    const int nblk = N / 32, kb = item / nblk, nb = item % nblk, k0 = 64 * kb, n0 = 32 * nb;
#pragma unroll 8
    for (int i = 0; i < 32; ++i) { const int kk = 2 * i + (lane >> 5); float v = W[(size_t)(k0 + kk) * N + n0 + (lane & 31)]; if (gain) v *= gain[k0 + kk]; scr[kk * 33 + (lane & 31)] = v; }
    asm volatile("s_waitcnt lgkmcnt(0)" ::: "memory");
    const int c = lane & 7;
#pragma unroll
    for (int j = 0; j < 4; ++j) { const int n = (lane >> 3) + 8 * j; const LAS float* s = scr + (8 * c) * 33 + n;
        u32x4 o; o.x = pk2(s[0 * 33], s[1 * 33]); o.y = pk2(s[2 * 33], s[3 * 33]); o.z = pk2(s[4 * 33], s[5 * 33]); o.w = pk2(s[6 * 33], s[7 * 33]);
        int nn = n0 + n; if (perm_q) { const int hh = nn / 192, e = nn - hh * 192; nn = (e < 128) ? hh * 128 + e : 1024 + hh * 64 + (e - 128); }
        *(u32x4*)(WT + (size_t)nn * K + k0 + 8 * c) = o; }
    asm volatile("s_waitcnt lgkmcnt(0)" ::: "memory");
}
struct TrDesc { const float* W; const float* gain; bf16_t* WT; int K, N, items; };

__device__ __forceinline__ void p0_gemv_task(Frame& F, int task, const float* ada_w, const float* ada_b, float* mod) {
    LAS float* sv = (LAS float*)F.lds; LAS float* part = (LAS float*)(F.lds + 32768);
    const int l = task / 192, n0 = (task % 192) * 64, rg = F.lane >> 4, c4 = (F.lane & 15) * 4;
    const float* Wp = ada_w + (size_t)l * DM * NMOD + n0 + c4 + (size_t)(F.wave * 256 + rg) * NMOD;
    f32x4 a0 = {0, 0, 0, 0}, a1 = a0, a2 = a0;
    for (int k = 0; k < 256; k += 32) {
        f32x4 w[8];
#pragma unroll
        for (int u = 0; u < 8; ++u) w[u] = *(const f32x4*)(Wp + (size_t)(k + 4 * u) * NMOD);
#pragma unroll
        for (int u = 0; u < 8; ++u) { const int kk = F.wave * 256 + k + 4 * u + rg; const float s0 = sv[kk], s1 = sv[2048 + kk], s2 = sv[4096 + kk];
            a0 += w[u] * s0; a1 += w[u] * s1; a2 += w[u] * s2; }
    }
    LAS float* pp = part + ((F.wave * 4 + rg) * 3) * 64 + c4;
    *(LAS f32x4*)(pp) = a0; *(LAS f32x4*)(pp + 64) = a1; *(LAS f32x4*)(pp + 128) = a2;
    __syncthreads();
    if (F.tid < 192) { const int r = F.tid >> 6, c = F.tid & 63; float s = 0.f;
#pragma unroll
        for (int q = 0; q < 32; ++q) s += part[(q * 3 + r) * 64 + c];
        mod[(size_t)(l * 3 + r) * NMOD + n0 + c] = s + ada_b[(size_t)l * NMOD + n0 + c]; }
    __syncthreads();
}

__device__ __forceinline__ void p0_prologue(Frame& F, const float* const* in) {
    unsigned char* ws = F.ws;
    {
        LAS float* sv = (LAS float*)F.lds;
        for (int i = F.tid; i < 3 * DM; i += NTHREADS) { const int r = i / DM, k = i - r * DM; const float x = (r < 2) ? in[1][r * DM + k] : in[3][k]; sv[i] = x / (1.f + __expf(-x)); }
        __syncthreads();
        for (int task = F.vcu; task < 768; task += F.G) p0_gemv_task(F, task, in[4], in[5], (float*)(ws + WS_MOD));
        __syncthreads();
    }
    {
        float* xw = (float*)(ws + WS_XW);
        for (int row = F.gw; row < MROWS; row += F.NGW) { const int b = row / RB, i = row - b * RB;
            const float* src = (i < CTX) ? in[2] + (size_t)(b * CTX + i) * DM : in[0] + (size_t)(b * SEQ + i - CTX) * DM;
            const f32x4* s4 = (const f32x4*)src + F.lane; f32x4* d4 = (f32x4*)(xw + (size_t)row * DM) + F.lane;
#pragma unroll
            for (int j = 0; j < 8; ++j) d4[64 * j] = s4[64 * j]; }
    }
    {
        float* sm = (float*)(ws + WS_SMALL); const int g = F.vcu * NTHREADS + F.tid;
        if (g < 8192) { sm[SM_N1G + g] = in[6][g]; sm[SM_N2G + g] = in[7][g]; }
        if (g < 384) { sm[SM_AQG + g] = in[13][g]; sm[SM_AKG + g] = in[14][g]; }
        if (g < 6144) sm[SM_CW + g] = in[15][g];
        if (g < 2048) sm[SM_CB + g] = in[16][g];
        if (g < 256) { sm[SM_CQG + g] = in[19][g]; sm[SM_CKG + g] = in[20][g]; }
    }
    {
        float* rc = (float*)(ws + WS_ROPE); float* ra = rc + 64 * 32 * 2;
        const int g = F.vcu * NTHREADS + F.tid;
        if (g < 64 * 32) { const int pos = g >> 5, f = g & 31; const float fr = exp2f(-(float)f * (13.287712379549449f / 32.f)); const float ang = (float)pos * fr;
            rc[2 * g] = cosf(ang); rc[2 * g + 1] = sinf(ang); }
        else if (g < 64 * 32 + 64 * 16) { const int e = g - 64 * 32, pos = e >> 4, f = e & 15; const float fr = exp2f(-(float)f * (13.287712379549449f / 16.f)); const float ang = (float)pos * fr;
            ra[2 * e] = cosf(ang); ra[2 * e + 1] = sinf(ang); }
    }
    {
        LAS float* scr = (LAS float*)(F.lds + F.wave * 16384);
        TrDesc d[16]; int nd = 0;
#pragma unroll
        for (int i = 0; i < 2; ++i) {
            d[nd++] = TrDesc{in[8] + (size_t)i * DM * 3904, nullptr, (bf16_t*)(ws + WS_WIN) + (size_t)i * 4096 * DM, DM, 3904, 32 * 122};
            d[nd++] = TrDesc{in[11] + (size_t)i * 512 * 1536, in[9] + i * 512, (bf16_t*)(ws + WS_WUQ) + (size_t)i * 1536 * 512, 512, 1536, 8 * 48};
            d[nd++] = TrDesc{in[12] + (size_t)i * 256 * 2048, in[10] + i * 256, (bf16_t*)(ws + WS_WUKV) + (size_t)i * 2048 * 256, 256, 2048, 4 * 64};
            d[nd++] = TrDesc{in[17] + (size_t)i * DM * DM, nullptr, (bf16_t*)(ws + WS_WEO) + (size_t)i * DM * DM, DM, DM, 32 * 64};
            d[nd++] = TrDesc{in[18] + (size_t)i * DM * 3072, nullptr, (bf16_t*)(ws + WS_WQKV) + (size_t)i * 3072 * DM, DM, 3072, 32 * 96};
            d[nd++] = TrDesc{in[21] + (size_t)i * DM * DM, nullptr, (bf16_t*)(ws + WS_WCO) + (size_t)i * DM * DM, DM, DM, 32 * 64};
        }
#pragma unroll
        for (int l = 0; l < 4; ++l) d[nd++] = TrDesc{in[22] + (size_t)l * DM * DM, nullptr, (bf16_t*)(ws + WS_WPQ) + (size_t)l * DM * DM, DM, DM, 32 * 64};
#pragma unroll
        for (int m = 0; m < 16; ++m) {
            for (int it = F.gw; it < d[m].items; it += F.NGW) p0_transpose_item(d[m].W, d[m].K, d[m].N, d[m].WT, d[m].gain, scr, it, F.lane, d[m].K == 512);
        }
        for (int i = F.gw * 64 + F.lane; i < 2 * 192 * DM / 8; i += F.NGW * 64) { const int li = i / (192 * DM / 8), r = i % (192 * DM / 8);
            *(u32x4*)((bf16_t*)(ws + WS_WIN) + (size_t)li * 4096 * DM + (size_t)3904 * DM + (size_t)r * 8) = (u32x4){0u, 0u, 0u, 0u}; }
    }
    {
        const size_t n_sk = (size_t)4 * 16 * 128 * 128 / 8;
        const size_t gt = (size_t)F.vcu * NTHREADS + F.tid, GT = (size_t)F.G * NTHREADS;
        for (size_t j = gt; j < n_sk; j += GT) {
            const f32x4 a = *(const f32x4*)(in[23] + j * 8), b = *(const f32x4*)(in[23] + j * 8 + 4);
            u32x4 o; o.x = pk2(a.x, a.y); o.y = pk2(a.z, a.w); o.z = pk2(b.x, b.y); o.w = pk2(b.z, b.w);
            *(u32x4*)((bf16_t*)(ws + WS_SUBK) + j * 8) = o;
        }
    }
    {
        for (int r = F.gw; r < 2 * 4 * NEXP; r += F.NGW) {
            const int tab = r / (4 * NEXP), rr = r - tab * (4 * NEXP);
            const float* src = (tab ? in[25] : in[24]) + (size_t)rr * DM + F.lane * 16;
            f32x4 v[8];
#pragma unroll
            for (int j = 0; j < 2; ++j)
#pragma unroll
                for (int q = 0; q < 4; ++q) v[j * 4 + q] = *(const f32x4*)(src + j * 1024 + q * 4);
            float am = 0.f;
#pragma unroll
            for (int q = 0; q < 8; ++q) am = fmaxf(fmaxf(am, fmaxf(fabsf(v[q].x), fabsf(v[q].y))), fmaxf(fabsf(v[q].z), fabsf(v[q].w)));
#pragma unroll
            for (int o = 1; o < 64; o <<= 1) am = fmaxf(am, __shfl_xor(am, o));
            am = fmaxf(am, 1e-30f);
#if TAB_FP4
            float ssq = 0.f;
#pragma unroll
            for (int q = 0; q < 8; ++q) ssq += (v[q].x * v[q].x + v[q].y * v[q].y) + (v[q].z * v[q].z + v[q].w * v[q].w);
#pragma unroll
            for (int o = 1; o < 64; o <<= 1) ssq += __shfl_xor(ssq, o);
            const float sig = fmaxf(sqrtf(ssq * (1.f / DM)), am * (1.f / 64.f));
            const float sc = 2.0f / sig;
            unsigned w4[4];
#pragma unroll
            for (int q = 0; q < 4; ++q) { unsigned t = 0u;
                const f32x4 xa = v[2 * q] * sc, xb = v[2 * q + 1] * sc;
#define P0_C6(x) fminf(fmaxf((x), -6.f), 6.f)
                t = __builtin_amdgcn_cvt_scalef32_pk_fp4_f32(t, P0_C6(xa.x), P0_C6(xa.y), 1.0f, 0);
                t = __builtin_amdgcn_cvt_scalef32_pk_fp4_f32(t, P0_C6(xa.z), P0_C6(xa.w), 1.0f, 1);
                t = __builtin_amdgcn_cvt_scalef32_pk_fp4_f32(t, P0_C6(xb.x), P0_C6(xb.y), 1.0f, 2);
                t = __builtin_amdgcn_cvt_scalef32_pk_fp4_f32(t, P0_C6(xb.z), P0_C6(xb.w), 1.0f, 3);
#undef P0_C6
                w4[q] = t; }
            *(u32x4*)(ws + (tab ? WS_VT : WS_U) + (size_t)rr * ROWB + F.lane * 16) = (u32x4){w4[0], w4[1], w4[2], w4[3]};
            if (F.lane == 0) ((float*)(ws + (tab ? WS_VSC : WS_USC)))[rr] = sig * 0.5f;
#else
            const float sc = 7.5f / am;
            f32x16 a, b;
#pragma unroll
            for (int q = 0; q < 8; ++q) { const f32x4 x = v[q] * sc; a[2 * q] = x.x; b[2 * q] = x.y; a[2 * q + 1] = x.z; b[2 * q + 1] = x.w; }
            const u32x6 w = __builtin_amdgcn_cvt_scalef32_2xpk16_fp6_f32(a, b, 1.0f);
            unsigned char* dst = ws + (tab ? WS_VT : WS_U) + (size_t)rr * ROWB;
            *(u32x4*)(dst + F.lane * 16) = (u32x4){w[0], w[1], w[2], w[3]};
            *(u32x2*)(dst + 1024 + F.lane * 8) = (u32x2){w[4], w[5]};
            if (F.lane == 0) ((float*)(ws + (tab ? WS_VSC : WS_USC)))[rr] = am * (1.0f / 7.5f);
#endif
        }
    }
}

__device__ __forceinline__ void norm_phase(const Frame& F0, const float* xw, const float* g, const float* modl  , int off_sh, int off_sc, bf16_t* H, bool lat_only) {
    const Frame F = phase_frame(F0);
    f32x4 gm[8], shv[8]; int cur_cls = -1;
    int row = F.gw; if (lat_only) while (row < MROWS && row_cls(row) == 2) row += F.NGW;
    f32x4 v[8];
    if (row < MROWS) { const f32x4* x4 = (const f32x4*)(xw + (size_t)row * DM) + F.lane;
#pragma unroll
        for (int j = 0; j < 8; ++j) v[j] = x4[64 * j]; }
    while (row < MROWS) {
        int nrow = row + F.NGW; if (lat_only) while (nrow < MROWS && row_cls(nrow) == 2) nrow += F.NGW;
        f32x4 vn[8];
        if (nrow < MROWS) { const f32x4* x4 = (const f32x4*)(xw + (size_t)nrow * DM) + F.lane;
#pragma unroll
            for (int j = 0; j < 8; ++j) vn[j] = x4[64 * j]; }
        const int cls = row_cls(row);
        if (cls != cur_cls) {
            cur_cls = cls;
            const f32x4* g4 = (const f32x4*)g + F.lane; const f32x4* sc4 = (const f32x4*)(modl + (size_t)cls * NMOD + off_sc) + F.lane; const f32x4* sh4 = (const f32x4*)(modl + (size_t)cls * NMOD + off_sh) + F.lane;
#pragma unroll
            for (int j = 0; j < 8; ++j) { gm[j] = g4[64 * j] * (sc4[64 * j] + 1.0f); shv[j] = sh4[64 * j]; }
        }
        float ss = 0.f;
#pragma unroll
        for (int j = 0; j < 8; ++j) ss += (v[j].x * v[j].x + v[j].y * v[j].y) + (v[j].z * v[j].z + v[j].w * v[j].w);
        const float rstd = 1.0f / sqrtf(wave_sum_dpp(ss) * (1.f / DM) + EPS);
        u32x2* o2 = (u32x2*)(H + (size_t)row * DM) + F.lane;
#pragma unroll
        for (int j = 0; j < 8; ++j) { const f32x4 y = (v[j] * rstd) * gm[j] + shv[j]; u32x2 o; o.x = pk2(y.x, y.y); o.y = pk2(y.z, y.w); o2[64 * j] = o; }
        row = nrow;
#pragma unroll
        for (int j = 0; j < 8; ++j) v[j] = vn[j];
    }
}

#define DPP_MOV(v, ctrl) __builtin_bit_cast(float, __builtin_amdgcn_update_dpp(0, __builtin_bit_cast(int, (v)), (ctrl), 0xf, 0xf, true))
__device__ __forceinline__ float row16_sum(float v) { v = DPP_ADD(v, 0xB1); v = DPP_ADD(v, 0x4E); v = DPP_ADD(v, 0x141); v = DPP_ADD(v, 0x140); return v; }
__device__ __forceinline__ void prep_odd_phase(const Frame& F0, const bf16_t* P, const float* qg, const float* kg, const float* rope_c, bf16_t* Q, bf16_t* Kb) {
    const Frame F = phase_frame(F0);
    const int l16 = F.lane & 15, d0 = l16 * 8;
    float gq[8], gk[8];
#pragma unroll
    for (int e = 0; e < 8; ++e) { gq[e] = qg[d0 + e]; gk[e] = kg[d0 + e]; }
    const bool lowhalf = l16 < 8;
    const int j0 = (l16 & 7) * 8;
    int row = F.gw;
    u32x4 w[5];
    if (row < MROWS) { const u32x4* pr = (const u32x4*)(P + (size_t)row * 3072) + F.lane;
#pragma unroll
        for (int k = 0; k < 5; ++k) w[k] = pr[64 * k]; }
    while (row < MROWS) {
        const int nrow = row + F.NGW;
        u32x4 wn[5];
        if (nrow < MROWS) { const u32x4* pr = (const u32x4*)(P + (size_t)nrow * 3072) + F.lane;
#pragma unroll
            for (int k = 0; k < 5; ++k) wn[k] = pr[64 * k]; }
        const int b = row / RB, i = row - b * RB; const bool lat = i >= CTX; const int t = i - CTX;
        float cs[8], sn[8];
#pragma unroll
        for (int e = 0; e < 8; ++e) { cs[e] = 1.f; sn[e] = 0.f; }
        if (lat) { const int pos = (j0 < 32) ? (t >> 6) : (t & 63); const f32x4* tb = (const f32x4*)(rope_c + ((pos << 5) + (j0 & 31)) * 2);
#pragma unroll
            for (int q = 0; q < 4; ++q) { const f32x4 c = tb[q]; cs[2 * q] = c.x; sn[2 * q] = c.y; cs[2 * q + 1] = c.z; sn[2 * q + 1] = c.w; } }
#pragma unroll
        for (int k = 0; k < 5; ++k) {
            const unsigned ww[4] = {w[k].x, w[k].y, w[k].z, w[k].w};
            float x[8]; float ss = 0.f;
#pragma unroll
            for (int q = 0; q < 4; ++q) { x[2 * q] = bf_lo(ww[q]); x[2 * q + 1] = bf_hi(ww[q]); ss += x[2 * q] * x[2 * q] + x[2 * q + 1] * x[2 * q + 1]; }
            const float rstd = 1.0f / sqrtf(row16_sum(ss) * (1.f / 128.f) + EPS);
            unsigned ow[4]; float o[8];
#pragma unroll
            for (int e = 0; e < 8; ++e) { const float y = x[e] * rstd * (k < 4 ? gq[e] : gk[e]); const float yp = DPP_MOV(y, 0x128);
                o[e] = lowhalf ? (y * cs[e] - yp * sn[e]) : (y * cs[e] + yp * sn[e]); }
#pragma unroll
            for (int q = 0; q < 4; ++q) ow[q] = pk2(o[2 * q], o[2 * q + 1]);
            if (k < 4) *((u32x4*)(Q + (size_t)row * 2048) + 64 * k + F.lane) = (u32x4){ow[0], ow[1], ow[2], ow[3]};
            else *((u32x4*)(Kb + (size_t)row * 512) + F.lane) = (u32x4){ow[0], ow[1], ow[2], ow[3]};
        }
        row = nrow;
#pragma unroll
        for (int k = 0; k < 5; ++k) w[k] = wn[k];
    }
}

struct PrepEvenRow { u32x4 cq; u32x2 ckv, kr; u32x4 qn[2]; u32x2 qr[2]; u32x4 kn[2], vv[2]; };
__device__ __forceinline__ void prep_even_load(PrepEvenRow& R, const bf16_t* P, const bf16_t* QR, const bf16_t* KVR, int row, int lane) {
    const bf16_t* pr = P + (size_t)row * 4096; const int l16 = lane & 15, hq = lane >> 4;
    R.cq = *((const u32x4*)pr + lane); R.ckv = *((const u32x2*)(pr + 512) + lane); R.kr = *((const u32x2*)(pr + 768) + l16);
    const bf16_t* q = QR + (size_t)row * 1536; const bf16_t* kv = KVR + (size_t)row * 2048;
#pragma unroll
    for (int k = 0; k < 2; ++k) { R.qn[k] = *((const u32x4*)q + 64 * k + lane); R.qr[k] = *((const u32x2*)(q + 1024) + 64 * k + lane);
        const bf16_t* kh = kv + (4 * k + hq) * 256 + l16 * 8; R.kn[k] = *(const u32x4*)kh; R.vv[k] = *(const u32x4*)(kh + 128); }
}
__device__ __forceinline__ void prep_even_phase(const Frame& F0, const bf16_t* P, const bf16_t* QR, const bf16_t* KVR, const float* qg, const float* kg, const float* rope_a, bf16_t* Q, bf16_t* Kb, bf16_t* Vb) {
    const Frame F = phase_frame(F0);
    const int lane = F.lane, l16 = lane & 15, hq = lane >> 4, d0 = l16 * 8, r0 = l16 * 4;
    float gqn[8], gkn[8], gqr[4], gkr[4];
#pragma unroll
    for (int e = 0; e < 8; ++e) { gqn[e] = qg[d0 + e]; gkn[e] = kg[d0 + e]; }
#pragma unroll
    for (int e = 0; e < 4; ++e) { gqr[e] = qg[128 + r0 + e]; gkr[e] = kg[128 + r0 + e]; }
    const bool lowhalf = l16 < 8; const int j0 = (l16 & 7) * 4;
    int row = F.gw;
    PrepEvenRow R;
    if (row < MROWS) prep_even_load(R, P, QR, KVR, row, lane);
    while (row < MROWS) {
        const int nrow = row + F.NGW;
        PrepEvenRow Rn;
        if (nrow < MROWS) prep_even_load(Rn, P, QR, KVR, nrow, lane);
        const int b = row / RB, i = row - b * RB; const bool lat = i >= CTX; const int t = i - CTX;
        float cs[4], sn[4];
#pragma unroll
        for (int e = 0; e < 4; ++e) { cs[e] = 1.f; sn[e] = 0.f; }
        if (lat) { const int pos = (j0 < 16) ? (t >> 6) : (t & 63); const f32x4* tb = (const f32x4*)(rope_a + ((pos << 4) + (j0 & 15)) * 2);
            const f32x4 c0 = tb[0], c1 = tb[1]; cs[0] = c0.x; sn[0] = c0.y; cs[1] = c0.z; sn[1] = c0.w; cs[2] = c1.x; sn[2] = c1.y; cs[3] = c1.z; sn[3] = c1.w; }
        float ssq = 0.f, sskv = 0.f;
        { const unsigned ww[4] = {R.cq.x, R.cq.y, R.cq.z, R.cq.w};
#pragma unroll
          for (int q = 0; q < 4; ++q) { const float a = bf_lo(ww[q]), c = bf_hi(ww[q]); ssq += a * a + c * c; } }
        { const float a = bf_lo(R.ckv.x), c = bf_hi(R.ckv.x), d = bf_lo(R.ckv.y), e = bf_hi(R.ckv.y); sskv = (a * a + c * c) + (d * d + e * e); }
        const float rstd_q = 1.0f / sqrtf(wave_sum_dpp(ssq) * (1.f / 512.f) + EPS), rstd_kv = 1.0f / sqrtf(wave_sum_dpp(sskv) * (1.f / 256.f) + EPS);
        const float krv[4] = {bf_lo(R.kr.x), bf_hi(R.kr.x), bf_lo(R.kr.y), bf_hi(R.kr.y)};
        const float krss = (krv[0] * krv[0] + krv[1] * krv[1]) + (krv[2] * krv[2] + krv[3] * krv[3]);
#pragma unroll
        for (int k = 0; k < 2; ++k) {
            const int h = 4 * k + hq;
            {
                const unsigned wn[4] = {R.qn[k].x, R.qn[k].y, R.qn[k].z, R.qn[k].w};
                float xn[8], xr[4]; float ss = 0.f;
#pragma unroll
                for (int q = 0; q < 4; ++q) { xn[2 * q] = bf_lo(wn[q]) * rstd_q; xn[2 * q + 1] = bf_hi(wn[q]) * rstd_q; ss += xn[2 * q] * xn[2 * q] + xn[2 * q + 1] * xn[2 * q + 1]; }
                xr[0] = bf_lo(R.qr[k].x) * rstd_q; xr[1] = bf_hi(R.qr[k].x) * rstd_q; xr[2] = bf_lo(R.qr[k].y) * rstd_q; xr[3] = bf_hi(R.qr[k].y) * rstd_q;
                ss += (xr[0] * xr[0] + xr[1] * xr[1]) + (xr[2] * xr[2] + xr[3] * xr[3]);
                const float r2 = 1.0f / sqrtf(row16_sum(ss) * (1.f / 192.f) + EPS);
                unsigned on[4]; float o[4];
#pragma unroll
                for (int q = 0; q < 4; ++q) on[q] = pk2(xn[2 * q] * r2 * gqn[2 * q], xn[2 * q + 1] * r2 * gqn[2 * q + 1]);
#pragma unroll
                for (int e = 0; e < 4; ++e) { const float y = xr[e] * r2 * gqr[e]; const float yp = DPP_MOV(y, 0x128); o[e] = lowhalf ? (y * cs[e] - yp * sn[e]) : (y * cs[e] + yp * sn[e]); }
                bf16_t* qo = Q + (size_t)row * 1536 + h * 192;
                *(u32x4*)(qo + d0) = (u32x4){on[0], on[1], on[2], on[3]};
                *(u32x2*)(qo + 128 + r0) = (u32x2){pk2(o[0], o[1]), pk2(o[2], o[3])};
            }
            {
                const unsigned wn[4] = {R.kn[k].x, R.kn[k].y, R.kn[k].z, R.kn[k].w}, wv[4] = {R.vv[k].x, R.vv[k].y, R.vv[k].z, R.vv[k].w};
                float xn[8]; float ss = krss;
#pragma unroll
                for (int q = 0; q < 4; ++q) { xn[2 * q] = bf_lo(wn[q]) * rstd_kv; xn[2 * q + 1] = bf_hi(wn[q]) * rstd_kv; ss += xn[2 * q] * xn[2 * q] + xn[2 * q + 1] * xn[2 * q + 1]; }
                const float r2 = 1.0f / sqrtf(row16_sum(ss) * (1.f / 192.f) + EPS);
                unsigned on[4], ov[4]; float o[4];
#pragma unroll
                for (int q = 0; q < 4; ++q) { on[q] = pk2(xn[2 * q] * r2 * gkn[2 * q], xn[2 * q + 1] * r2 * gkn[2 * q + 1]); ov[q] = pk2(bf_lo(wv[q]) * rstd_kv, bf_hi(wv[q]) * rstd_kv); }
#pragma unroll
                for (int e = 0; e < 4; ++e) { const float y = krv[e] * r2 * gkr[e]; const float yp = DPP_MOV(y, 0x128); o[e] = lowhalf ? (y * cs[e] - yp * sn[e]) : (y * cs[e] + yp * sn[e]); }
                bf16_t* ko = Kb + (size_t)row * 1536 + h * 192;
                *(u32x4*)(ko + d0) = (u32x4){on[0], on[1], on[2], on[3]};
                *(u32x2*)(ko + 128 + r0) = (u32x2){pk2(o[0], o[1]), pk2(o[2], o[3])};
                *(u32x4*)(Vb + (size_t)row * 1024 + h * 128 + d0) = (u32x4){ov[0], ov[1], ov[2], ov[3]};
            }
        }
        row = nrow; R = Rn;
    }
}

__device__ __forceinline__ void conv_phase(const Frame& F0, const bf16_t* P, const float* cw  , const float* cb  , bf16_t* CAT) {
    const Frame F = phase_frame(F0);
    const int gt = F.vcu * NTHREADS + F.tid, GT = F.G * NTHREADS;
    for (int it = gt; it < MROWS * 128; it += GT) {
        const int row = it >> 7, c0 = (it & 127) * 8; const int b = row / RB, i = row - b * RB;
        const bool first = (i == 0) || (i == CTX), last = (i == CTX - 1) || (i == RB - 1);
        const bf16_t* pr = P + (size_t)row * 4096 + 832 + c0;
        const u32x4 bg = *(const u32x4*)pr, cg = *(const u32x4*)(pr + 1024), hz = *(const u32x4*)(pr + 2048);
        u32x4 cgm = {0u, 0u, 0u, 0u}, hzm = cgm, cgp = cgm, hzp = cgm;
        if (!first) { cgm = *(const u32x4*)(pr - 4096 + 1024); hzm = *(const u32x4*)(pr - 4096 + 2048); }
        if (!last) { cgp = *(const u32x4*)(pr + 4096 + 1024); hzp = *(const u32x4*)(pr + 4096 + 2048); }
        const unsigned bgw[4] = {bg.x, bg.y, bg.z, bg.w}, cgw[4] = {cg.x, cg.y, cg.z, cg.w}, hzw[4] = {hz.x, hz.y, hz.z, hz.w};
        const unsigned cmw[4] = {cgm.x, cgm.y, cgm.z, cgm.w}, hmw[4] = {hzm.x, hzm.y, hzm.z, hzm.w}, cpw[4] = {cgp.x, cgp.y, cgp.z, cgp.w}, hpw[4] = {hzp.x, hzp.y, hzp.z, hzp.w};
        unsigned ow[4];
#pragma unroll
        for (int q = 0; q < 4; ++q) {
            const int c = c0 + 2 * q;
            const float u0a = bf_lo(cgw[q]) * bf_lo(hzw[q]), u0b = bf_hi(cgw[q]) * bf_hi(hzw[q]);
            const float uma = bf_lo(cmw[q]) * bf_lo(hmw[q]), umb = bf_hi(cmw[q]) * bf_hi(hmw[q]);
            const float upa = bf_lo(cpw[q]) * bf_lo(hpw[q]), upb = bf_hi(cpw[q]) * bf_hi(hpw[q]);
            const float ra = bf_lo(bgw[q]) * (uma * cw[c] + u0a * cw[1024 + c] + upa * cw[2048 + c] + cb[c]);
            const float rb = bf_hi(bgw[q]) * (umb * cw[c + 1] + u0b * cw[1024 + c + 1] + upb * cw[2048 + c + 1] + cb[c + 1]);
            ow[q] = pk2(ra, rb);
        }
        *(u32x4*)(CAT + (size_t)row * DM + 1024 + c0) = (u32x4){ow[0], ow[1], ow[2], ow[3]};
    }
}
__device__ __forceinline__ void attn_even_phase(const Frame& F0, const bf16_t* Q, const bf16_t* Kb, const bf16_t* Vb, bf16_t* CAT) {
    const Frame F = phase_frame(F0);
    for (int u = F.vcu; u < 272; u += F.G) {
        int b, h, qt, nk;
        if (u < 256) { b = u >> 7; h = (u >> 4) & 7; qt = 1 + (u & 15); nk = RB; } else { const int v = u - 256; b = v >> 3; h = v & 7; qt = 0; nk = CTX; }
        const size_t r0 = (size_t)b * RB;
        att::attn_body1<192, 1536, 1536, 1024, 2048>(Q + (r0 + qt * 256) * 1536 + h * 192, Kb + r0 * 1536 + h * 192, Vb + r0 * 1024 + h * 128, CAT + (r0 + qt * 256) * 2048 + h * 128, nk, (char*)F.lds, phase_tid(F.wave));
    }
}
__device__ __forceinline__ void attn_odd_phase(const Frame& F0, const bf16_t* Q, const bf16_t* Kb, const bf16_t* P, bf16_t* CAT, bool lat_only) {
    const Frame F = phase_frame(F0);
    const int nunits = lat_only ? 512 : 544;
    for (int u = F.vcu; u < nunits; u += F.G) {
        int b, hq, qt, nk;
        if (u < 512) { b = u >> 8; hq = (u >> 4) & 15; qt = 1 + (u & 15); nk = RB; } else { const int v = u - 512; b = v >> 4; hq = v & 15; qt = 0; nk = CTX; }
        const int kvh = hq >> 2; const size_t r0 = (size_t)b * RB;
        att::attn_body<128, 2048, 512, 3072, 2048, 2>(Q + (r0 + qt * 256) * 2048 + hq * 128, Kb + r0 * 512 + kvh * 128, P + r0 * 3072 + 2560 + kvh * 128, CAT + (r0 + qt * 256) * 2048 + hq * 128, nk, (char*)F.lds, phase_tid(F.wave));
    }
}

__device__ __forceinline__ int crow32(int r, int hi) { return (r & 3) + 8 * (r >> 2) + 4 * hi; }
__device__ __forceinline__ int fkey(int b) { return b ^ ((b >> 31) & 0x7fffffff); }
#define TK_CE(x, y) do { const int hi_ = max((x), (y)), lo_ = min((x), (y)); (x) = hi_; (y) = lo_; } while (0)
template <int N> __device__ __forceinline__ void tk_sort(int* v) {
#pragma unroll
    for (int k = 2; k <= N; k <<= 1)
#pragma unroll
        for (int j = k >> 1; j > 0; j >>= 1)
#pragma unroll
            for (int i = 0; i < N; ++i) { const int l = i ^ j; if (l > i) { if ((i & k) == 0) TK_CE(v[i], v[l]); else TK_CE(v[l], v[i]); } }
}
__device__ __forceinline__ void tk_merge16(int* a, const int* b) {
#pragma unroll
    for (int i = 0; i < 16; ++i) a[i] = max(a[i], b[15 - i]);
#pragma unroll
    for (int j = 8; j > 0; j >>= 1)
#pragma unroll
        for (int i = 0; i < 16; ++i) { const int l = i ^ j; if (l > i) TK_CE(a[i], a[l]); }
}
__device__ __forceinline__ void tk_merge_partner(int* a) {
    int lo[16], hi[16];
#pragma unroll
    for (int i = 0; i < 16; ++i) { auto rr = __builtin_amdgcn_permlane32_swap((unsigned)a[i], (unsigned)a[i], false, false); lo[i] = (int)rr[0]; hi[i] = (int)rr[1]; }
    tk_merge16(lo, hi);
#pragma unroll
    for (int i = 0; i < 16; ++i) a[i] = lo[i];
}
__device__ __forceinline__ void peer_topk_phase(const Frame& F0, const bf16_t* PQ, const bf16_t* subk  , int* IDX, float* GATE, bool lat_only) {
    const Frame F = phase_frame(F0);
    const int h = F.vcu & 7, jw = (F.vcu >> 3) * NWAVES + F.wave, nwh = (F.G >> 3) * NWAVES;
    {
        const bf16_t* src = subk + (size_t)h * 2 * 128 * 128;
        for (int c = F.tid; c < 4096; c += NTHREADS) { const int row = c >> 4, ch = c & 15;
            *(LAS u32x4*)(F.lds + row * 256 + ((ch ^ (row & 15)) << 4)) = *(const u32x4*)(src + (size_t)row * 128 + ch * 8); }
        __syncthreads();
    }
    const int ntg = lat_only ? 256 : MROWS / 32;
    for (int t = jw; t < ntg; t += nwh) {
        int lane_ = F.lane; asm volatile("" : "+v"(lane_));
        const int r32 = lane_ & 31, hi = lane_ >> 5;
        int tg = t; if (lat_only) tg += 8 + (tg >= 128 ? 8 : 0);
        const int token = tg * 32 + r32;
        int top[2][16];
        const int kk = (((r32 & 14) | (hi ^ (r32 & 1))) << 4);
#pragma unroll
        for (int p = 0; p < 2; ++p) {
            bf16x8 bq[8];
            const bf16_t* qp = PQ + (size_t)token * DM + h * 256 + p * 128 + hi * 8;
#pragma unroll
            for (int ks = 0; ks < 8; ++ks) bq[ks] = *(const bf16x8*)(qp + ks * 16);
            int s[4][16];
#pragma unroll
            for (int nb = 0; nb < 4; ++nb) {
                f32x16 acc = {};
                const LAS unsigned char* kp = F.lds + (p * 128 + nb * 32 + r32) * 256;
#pragma unroll
                for (int ks = 0; ks < 8; ++ks) { const bf16x8 a = *(const LAS bf16x8*)(kp + (kk ^ (ks << 5))); acc = __builtin_amdgcn_mfma_f32_32x32x16_bf16(a, bq[ks], acc, 0, 0, 0); }
#pragma unroll
                for (int r = 0; r < 16; ++r) { const int key = nb * 32 + crow32(r, hi); s[nb][r] = fkey((int)((__float_as_uint(acc[r]) & ~127u) | (unsigned)(127 - key))); }
                tk_sort<16>(s[nb]);
            }
            tk_merge16(s[0], s[1]); tk_merge16(s[2], s[3]); tk_merge16(s[0], s[2]);
            tk_merge_partner(s[0]);
#pragma unroll
            for (int j = 0; j < 16; ++j) top[p][j] = s[0][j];
        }
        int cand[32];
        unsigned long long kaLo = 0ull, kaHi = 0ull, kbLo = 0ull, kbHi = 0ull;
        {
            float fb[16]; const float fa0 = __uint_as_float((unsigned)fkey(top[0][0]) & ~127u), fb0 = __uint_as_float((unsigned)fkey(top[1][0]) & ~127u);
#pragma unroll
            for (int r = 0; r < 16; ++r) { const int ba = fkey(top[0][r]), bb = fkey(top[1][r]); fb[r] = __uint_as_float((unsigned)bb & ~127u) - fb0;
                const unsigned long long xa = (unsigned long long)(unsigned)(127 - (ba & 127)) << (8 * (r & 7)), xb = (unsigned long long)(unsigned)(127 - (bb & 127)) << (8 * (r & 7));
                if (r < 8) { kaLo |= xa; kbLo |= xb; } else { kaHi |= xa; kbHi |= xb; } }
            float fa[8];
#pragma unroll
            for (int i = 0; i < 8; ++i) { const int ka = hi ? top[0][2 * i + 1] : top[0][2 * i]; fa[i] = __uint_as_float((unsigned)fkey(ka) & ~127u) - fa0; }
            const int hid = 255 - (hi << 4);
            int n = 0;
#pragma unroll
            for (int i = 0; i < 8; ++i)
#pragma unroll
                for (int b = 0; b < 16; ++b) if ((2 * i + 1) * (b + 1) <= 16) {
                    const float sum = fa[i] + fb[b];
                    cand[n++] = fkey((int)((__float_as_uint(sum) & ~255u) | (unsigned)(hid - (32 * i + b))));
                }
#pragma unroll
            for (; n < 32; ++n) cand[n] = (int)0x80000000;
        }
        tk_sort<16>(cand); tk_sort<16>(cand + 16); tk_merge16(cand, cand + 16);
        tk_merge_partner(cand);
        float ev[16]; float esum = 0.f;
#pragma unroll
        for (int j = 0; j < 16; ++j) { ev[j] = __expf(__uint_as_float((unsigned)fkey(cand[j]) & ~255u)); esum += ev[j]; }
        const float rs = 1.0f / esum;
        int oi[8]; float og[8];
#pragma unroll
        for (int j = 0; j < 8; ++j) { const int w = hi ? cand[8 + j] : cand[j]; const float e = hi ? ev[8 + j] : ev[j];
            const int id8 = 255 - (fkey(w) & 255), ra = id8 >> 4, rb = id8 & 15;
            const unsigned long long wa = (ra & 8) ? kaHi : kaLo, wb = (rb & 8) ? kbHi : kbLo;
            const int ka = (int)(wa >> (8 * (ra & 7))) & 127, kb = (int)(wb >> (8 * (rb & 7))) & 127;
            oi[j] = ka * 128 + kb; og[j] = e * rs; }
        int* ip = IDX + (size_t)token * 128 + h * 16 + hi * 8; float* gp = GATE + (size_t)token * 128 + h * 16 + hi * 8;
        *(int4*)ip = make_int4(oi[0], oi[1], oi[2], oi[3]); *(int4*)(ip + 4) = make_int4(oi[4], oi[5], oi[6], oi[7]);
        *(f32x4*)gp = (f32x4){og[0], og[1], og[2], og[3]}; *(f32x4*)(gp + 4) = (f32x4){og[4], og[5], og[6], og[7]};
    }
}

#if TAB_FP4
__device__ __forceinline__ void peer_expert_phase(const Frame& F0, const bf16_t* H2, const int* IDX, const float* GATE, const unsigned char* U, size_t v_minus_u_bytes, const float* USC, const float* VSC,
                                                  const float* g2  , float* XW, float* OUT,
                                                  bf16_t* HN  , const float* ng  , const float* nmod  ) {
    const Frame F = phase_frame(F0);
    LAS float* red = (LAS float*)F.lds;
    const unsigned voff_tab = (unsigned)v_minus_u_bytes;
    const __amdgpu_buffer_rsrc_t rs = __builtin_amdgcn_make_buffer_rsrc((void*)U, 0, (int)(voff_tab + (unsigned)NEXP * ROWB), 0x00020000);
    const int lane = F.lane; const int voff = lane * 16;
#define PX_SB() __builtin_amdgcn_sched_barrier(0)
#define PX_LOADALL(buf, ivv, tb) do { _Pragma("unroll") for (int e_ = 0; e_ < 16; ++e_) buf[e_] = __builtin_amdgcn_raw_buffer_load_b128(rs, voff, (unsigned)__builtin_amdgcn_readlane(ivv, e_) * (unsigned)ROWB + (tb), 0); } while (0)
#define PX_U1(d_, b_) { const bf16x2_t r2_ = __builtin_amdgcn_cvt_scalef32_pk_bf16_fp4(wd_[d_], 1.0f, b_); if ((b_) & 1) a1_ = __builtin_amdgcn_fdot2_f32_bf16(r2_, __builtin_bit_cast(bf16x2_t, xpk[4 * (d_) + (b_)]), a1_, false); \
                        else a0_ = __builtin_amdgcn_fdot2_f32_bf16(r2_, __builtin_bit_cast(bf16x2_t, xpk[4 * (d_) + (b_)]), a0_, false); }
#define PX_V1(d_, b_) { const f32x2 t2_ = __builtin_amdgcn_cvt_scalef32_pk_f32_fp4(wd_[d_], 1.0f, b_); acc[8 * (d_) + 2 * (b_)] += wg_ * t2_.x; acc[8 * (d_) + 2 * (b_) + 1] += wg_ * t2_.y; }
#define PX_FETCH_TOKEN(r, XP, IV, GV) do { const u32x4* xp_ = (const u32x4*)(H2 + (size_t)(r) * DM + lane * 16); XP[0] = xp_[0]; XP[1] = xp_[1]; XP[2] = xp_[128]; XP[3] = xp_[129]; \
        IV = 0; GV = 0.f; if (lane < 16) { IV = IDX[(size_t)(r) * 128 + F.wave * 16 + lane]; GV = GATE[(size_t)(r) * 128 + F.wave * 16 + lane]; } } while (0)
    const bool skip_ctx = (OUT != nullptr);
    int row = F.vcu; if (skip_ctx && row < MROWS && row_cls(row) == 2) row += F.G;
    u32x4 xp[4]; int iv; float gv;
    u32x4 ub[16], vb[16];
    if (row < MROWS) { PX_FETCH_TOKEN(row, xp, iv, gv); PX_LOADALL(ub, iv, 0u); }
    int par = 0;
    while (row < MROWS) {
        int nrow = row + F.G; if (skip_ctx && nrow < MROWS && row_cls(nrow) == 2) nrow += F.G;
        PX_LOADALL(vb, iv, voff_tab);
        float usc = 0.f, vsc = 0.f;
        if (lane < 16) { usc = USC[iv]; vsc = VSC[iv]; }
        u32x4 xpn[4]; int ivn = 0; float gvn = 0.f;
        if (nrow < MROWS) PX_FETCH_TOKEN(nrow, xpn, ivn, gvn);
        const int cls = row_cls(row);
        const f32x4 x_old = *((const f32x4*)(XW + (size_t)row * DM) + F.tid), g_vec = *((const f32x4*)(g2 + (size_t)cls * NMOD) + F.tid);
        f32x4 n_g = {0.f, 0.f, 0.f, 0.f}, n_sc = n_g, n_sh = n_g;
        if (HN) { n_g = *((const f32x4*)ng + F.tid); n_sc = *((const f32x4*)(nmod + (size_t)cls * NMOD + 2048) + F.tid); n_sh = *((const f32x4*)(nmod + (size_t)cls * NMOD) + F.tid); }
        const unsigned xpk[16] = {xp[0].x, xp[0].y, xp[0].z, xp[0].w, xp[1].x, xp[1].y, xp[1].z, xp[1].w, xp[2].x, xp[2].y, xp[2].z, xp[2].w, xp[3].x, xp[3].y, xp[3].z, xp[3].w};
        float sv = 0.f;
        PX_SB();
#pragma unroll
        for (int e = 0; e < 16; ++e) {
            u32x4 w_ = ub[e]; asm volatile("" : "+v"(w_) : "v"(sv));
            const unsigned wd_[4] = {w_.x, w_.y, w_.z, w_.w}; float a0_ = 0.f, a1_ = 0.f;
            PX_U1(0, 0) PX_U1(0, 1) PX_U1(0, 2) PX_U1(0, 3) PX_U1(1, 0) PX_U1(1, 1) PX_U1(1, 2) PX_U1(1, 3) PX_U1(2, 0) PX_U1(2, 1) PX_U1(2, 2) PX_U1(2, 3) PX_U1(3, 0) PX_U1(3, 1) PX_U1(3, 2) PX_U1(3, 3)
            const float t_ = wave_sum_dpp(a0_ + a1_); sv = (lane == e) ? t_ : sv;
        }
        const float wv = gelu_erf(sv * usc) * gv * vsc;
        PX_SB();
        if (nrow < MROWS) PX_LOADALL(ub, ivn, 0u);
        PX_SB();
        f32x32 acc = {};
#pragma unroll
        for (int e = 0; e < 16; ++e) {
            u32x4 w_ = vb[e]; asm volatile("" : "+v"(w_) : "v"(acc));
            const unsigned wd_[4] = {w_.x, w_.y, w_.z, w_.w}; const float wg_ = __uint_as_float(__builtin_amdgcn_readlane(__float_as_uint(wv), e));
            PX_V1(0, 0) PX_V1(0, 1) PX_V1(0, 2) PX_V1(0, 3) PX_V1(1, 0) PX_V1(1, 1) PX_V1(1, 2) PX_V1(1, 3) PX_V1(2, 0) PX_V1(2, 1) PX_V1(2, 2) PX_V1(2, 3) PX_V1(3, 0) PX_V1(3, 1) PX_V1(3, 2) PX_V1(3, 3)
        }
        PX_SB();
        LAS float* rb = red + par * (NWAVES * DM);
#pragma unroll
        for (int j = 0; j < 2; ++j)
#pragma unroll
            for (int q = 0; q < 4; ++q) *(LAS f32x4*)(rb + F.wave * DM + j * 1024 + lane * 16 + q * 4) = (f32x4){acc[j * 16 + q * 4], acc[j * 16 + q * 4 + 1], acc[j * 16 + q * 4 + 2], acc[j * 16 + q * 4 + 3]};
        __syncthreads();
        {
            f32x4 sm = {0.f, 0.f, 0.f, 0.f};
#pragma unroll
            for (int w = 0; w < 8; ++w) sm += *(const LAS f32x4*)(rb + w * DM + F.tid * 4);
            f32x4* xq = (f32x4*)(XW + (size_t)row * DM) + F.tid;
            const f32x4 xn = x_old + g_vec * sm;
            *xq = xn;
            if (OUT) { const int b = row / RB, i = row - b * RB; if (i >= CTX) *((f32x4*)(OUT + ((size_t)b * SEQ + (i - CTX)) * DM) + F.tid) = xn; }
            if (HN) {
                LAS float* ssp = (LAS float*)(F.lds + 131072) + par * 8;
                const float sw = wave_sum_dpp((xn.x * xn.x + xn.y * xn.y) + (xn.z * xn.z + xn.w * xn.w));
                if (lane == 0) ssp[F.wave] = sw;
                __syncthreads();
                const float tot = ((ssp[0] + ssp[1]) + (ssp[2] + ssp[3])) + ((ssp[4] + ssp[5]) + (ssp[6] + ssp[7]));
                const float rstd = 1.0f / sqrtf(tot * (1.f / DM) + EPS);
                const f32x4 y = (xn * rstd) * n_g * (n_sc + 1.0f) + n_sh;
                u32x2 o; o.x = pk2(y.x, y.y); o.y = pk2(y.z, y.w);
                *((u32x2*)(HN + (size_t)row * DM) + F.tid) = o;
            }
        }
        par ^= 1; row = nrow;
#pragma unroll
        for (int q = 0; q < 4; ++q) xp[q] = xpn[q];
        iv = ivn; gv = gvn;
    }
#undef PX_LOADALL
#undef PX_U1
#undef PX_V1
#undef PX_SB
#undef PX_FETCH_TOKEN
}
#else
__device__ __forceinline__ void peer_expert_phase(const Frame& F0, const bf16_t* H2, const int* IDX, const float* GATE, const unsigned char* U, size_t v_minus_u_bytes, const float* USC, const float* VSC,
                                                  const float* g2  , float* XW, float* OUT,
                                                  bf16_t* HN  , const float* ng  , const float* nmod  ) {
    const Frame F = phase_frame(F0);
    LAS float* red = (LAS float*)F.lds;
    const unsigned voff_tab = (unsigned)v_minus_u_bytes;
    const __amdgpu_buffer_rsrc_t rs = __builtin_amdgcn_make_buffer_rsrc((void*)U, 0, (int)(voff_tab + (unsigned)NEXP * ROWB), 0x00020000);
    const int lane = F.lane; const int voff = lane * 16, voff2 = 1024 + lane * 8;
#define PX_SB() __builtin_amdgcn_sched_barrier(0)
#define PX_LOAD(buf, s, ivv) do { constexpr int e0_ = ((s) & 3) * 4; const unsigned tb_ = ((s) >= 4) ? voff_tab : 0u; \
        _Pragma("unroll") for (int ee_ = 0; ee_ < 4; ++ee_) { const unsigned o_ = (unsigned)__builtin_amdgcn_readlane(ivv, e0_ + ee_) * (unsigned)ROWB + tb_; \
            buf##h[ee_] = __builtin_amdgcn_raw_buffer_load_b128(rs, voff, o_, 0); buf##l[ee_] = __builtin_amdgcn_raw_buffer_load_b64(rs, voff2, o_, 0); } } while (0)
#define PX_DECODE(buf, ee_, dep) u32x6 w6_ = {buf##h[ee_].x, buf##h[ee_].y, buf##h[ee_].z, buf##h[ee_].w, buf##l[ee_].x, buf##l[ee_].y}; \
        asm volatile("" : "+v"(w6_) : "v"(dep));     \
        const f32x32 r_ = __builtin_amdgcn_cvt_scalef32_pk32_f32_fp6(w6_, 1.0f);
#define PX_COMP_U(buf, s) do { constexpr int e0_ = ((s) & 3) * 4; \
            _Pragma("unroll") for (int ee_ = 0; ee_ < 4; ++ee_) { PX_DECODE(buf, ee_, sv) \
                const f32x32 p_ = r_ * xf; float a0_ = 0.f, a1_ = 0.f; \
                _Pragma("unroll") for (int k_ = 0; k_ < 32; k_ += 2) { a0_ += p_[k_]; a1_ += p_[k_ + 1]; } \
                const float t_ = wave_sum_dpp(a0_ + a1_); sv = (lane == e0_ + ee_) ? t_ : sv; } } while (0)
#define PX_COMP_V(buf, s) do { constexpr int e0_ = ((s) & 3) * 4; \
            _Pragma("unroll") for (int ee_ = 0; ee_ < 4; ++ee_) { const float wg_ = __uint_as_float(__builtin_amdgcn_readlane(__float_as_uint(wv), e0_ + ee_)); \
                PX_DECODE(buf, ee_, acc) \
                acc += r_ * wg_; } } while (0)
#define PX_FETCH_TOKEN(r, XP, IV, GV) do { const u32x4* xp_ = (const u32x4*)(H2 + (size_t)(r) * DM + lane * 16); XP[0] = xp_[0]; XP[1] = xp_[1]; XP[2] = xp_[128]; XP[3] = xp_[129]; \
        IV = 0; GV = 0.f; if (lane < 16) { IV = IDX[(size_t)(r) * 128 + F.wave * 16 + lane]; GV = GATE[(size_t)(r) * 128 + F.wave * 16 + lane]; } } while (0)
    const bool skip_ctx = (OUT != nullptr);
    int row = F.vcu; if (skip_ctx && row < MROWS && row_cls(row) == 2) row += F.G;
    u32x4 xp[4]; int iv; float gv;
    u32x4 bAh[4], bBh[4]; u32x2 bAl[4], bBl[4];
    if (row < MROWS) { PX_FETCH_TOKEN(row, xp, iv, gv); PX_LOAD(bA, 0, iv); }
    int par = 0;
    while (row < MROWS) {
        int nrow = row + F.G; if (skip_ctx && nrow < MROWS && row_cls(nrow) == 2) nrow += F.G;
        f32x32 xf;
#pragma unroll
        for (int q = 0; q < 4; ++q) { const unsigned ww[4] = {xp[q].x, xp[q].y, xp[q].z, xp[q].w};
#pragma unroll
            for (int k = 0; k < 4; ++k) { xf[q * 8 + 2 * k] = bf_lo(ww[k]); xf[q * 8 + 2 * k + 1] = bf_hi(ww[k]); } }
        float usc = 0.f, vsc = 0.f;
        if (lane < 16) { usc = USC[iv]; vsc = VSC[iv]; }
        u32x4 xpn[4]; int ivn = 0; float gvn = 0.f;
        if (nrow < MROWS) PX_FETCH_TOKEN(nrow, xpn, ivn, gvn);
        const int cls = row_cls(row);
        const f32x4 x_old = *((const f32x4*)(XW + (size_t)row * DM) + F.tid), g_vec = *((const f32x4*)(g2 + (size_t)cls * NMOD) + F.tid);
        f32x4 n_g = {0.f, 0.f, 0.f, 0.f}, n_sc = n_g, n_sh = n_g;
        if (HN) { n_g = *((const f32x4*)ng + F.tid); n_sc = *((const f32x4*)(nmod + (size_t)cls * NMOD + 2048) + F.tid); n_sh = *((const f32x4*)(nmod + (size_t)cls * NMOD) + F.tid); }
        float sv = 0.f, wv = 0.f;
        PX_LOAD(bB, 1, iv); PX_SB(); PX_COMP_U(bA, 0); PX_SB();
        PX_LOAD(bA, 2, iv); PX_SB(); PX_COMP_U(bB, 1); PX_SB();
        PX_LOAD(bB, 3, iv); PX_SB(); PX_COMP_U(bA, 2); PX_SB();
        PX_LOAD(bA, 4, iv); PX_SB(); PX_COMP_U(bB, 3); PX_SB();
        wv = gelu_erf(sv * usc) * gv * vsc;
        f32x32 acc = {};
        PX_LOAD(bB, 5, iv); PX_SB(); PX_COMP_V(bA, 4); PX_SB();
        PX_LOAD(bA, 6, iv); PX_SB(); PX_COMP_V(bB, 5); PX_SB();
        PX_LOAD(bB, 7, iv); PX_SB(); PX_COMP_V(bA, 6); PX_SB();
        if (nrow < MROWS) PX_LOAD(bA, 0, ivn);
        PX_SB(); PX_COMP_V(bB, 7); PX_SB();
        LAS float* rb = red + par * (NWAVES * DM);
#pragma unroll
        for (int j = 0; j < 2; ++j)
#pragma unroll
            for (int q = 0; q < 4; ++q) *(LAS f32x4*)(rb + F.wave * DM + j * 1024 + lane * 16 + q * 4) = (f32x4){acc[j * 16 + q * 4], acc[j * 16 + q * 4 + 1], acc[j * 16 + q * 4 + 2], acc[j * 16 + q * 4 + 3]};
        __syncthreads();
        {
            f32x4 sm = {0.f, 0.f, 0.f, 0.f};
#pragma unroll
            for (int w = 0; w < 8; ++w) sm += *(const LAS f32x4*)(rb + w * DM + F.tid * 4);
            f32x4* xq = (f32x4*)(XW + (size_t)row * DM) + F.tid;
            const f32x4 xn = x_old + g_vec * sm;
            *xq = xn;
            if (OUT) { const int b = row / RB, i = row - b * RB; if (i >= CTX) *((f32x4*)(OUT + ((size_t)b * SEQ + (i - CTX)) * DM) + F.tid) = xn; }
            if (HN) {
                LAS float* ssp = (LAS float*)(F.lds + 131072) + par * 8;
                const float sw = wave_sum_dpp((xn.x * xn.x + xn.y * xn.y) + (xn.z * xn.z + xn.w * xn.w));
                if (lane == 0) ssp[F.wave] = sw;
                __syncthreads();
                const float tot = ((ssp[0] + ssp[1]) + (ssp[2] + ssp[3])) + ((ssp[4] + ssp[5]) + (ssp[6] + ssp[7]));
                const float rstd = 1.0f / sqrtf(tot * (1.f / DM) + EPS);
                const f32x4 y = (xn * rstd) * n_g * (n_sc + 1.0f) + n_sh;
                u32x2 o; o.x = pk2(y.x, y.y); o.y = pk2(y.z, y.w);
                *((u32x2*)(HN + (size_t)row * DM) + F.tid) = o;
            }
        }
        par ^= 1; row = nrow;
#pragma unroll
        for (int q = 0; q < 4; ++q) xp[q] = xpn[q];
        iv = ivn; gv = gvn;
    }
#undef PX_LOAD
#undef PX_COMP_U
#undef PX_COMP_V
#undef PX_SB
#undef PX_FETCH_TOKEN
}
#endif
#ifndef N_LAUNCHES
#define N_LAUNCHES 1
#endif
struct Args { const float* in[26]; float* out; unsigned char* ws; int ph_lo, ph_hi; };
constexpr int NPHASES = 39;
__global__ void __launch_bounds__(NTHREADS, 2) fwd_kernel(Args args) {
    extern __shared__ __attribute__((aligned(16))) unsigned char lds_raw[];
    Frame F_;
    F_.lds = (LAS unsigned char*)lds_raw;
    F_.tid = threadIdx.x; F_.lane = F_.tid & 63; F_.wave = __builtin_amdgcn_readfirstlane(F_.tid >> 6);
    F_.G = gridDim.x; { const int bx = blockIdx.x; F_.vcu = (F_.G % 8 == 0) ? (bx % 8) * (F_.G / 8) + bx / 8 : bx; }
    F_.gw = F_.vcu * NWAVES + F_.wave; F_.NGW = F_.G * NWAVES;
    F_.ws = args.ws;
    volatile LAS unsigned* MISC = (volatile LAS unsigned*)(F_.lds + LDS_MISC);
    if (F_.tid < 32) MISC[F_.tid] = 0u;
    __syncthreads();
    const int lo = args.ph_lo, hi = args.ph_hi;
    XcdBarrier bar; bar.bar = (unsigned*)(args.ws + WS_CTL) + CW_BAR; bar.x = 0; bar.st = nullptr;
    if (N_LAUNCHES == 1 || hi - lo > 1) bar = xcd_barrier_post((unsigned*)(args.ws + WS_CTL) + CW_BAR, MISC + 8);
#if N_LAUNCHES == 1
#define IN(k) true
#define SEAM(k) xcd_barrier(bar)
#else
#define IN(k) (lo <= (k) && (k) < hi)
#define SEAM(k) do { if (IN(k) && IN((k) + 1)) xcd_barrier(bar); } while (0)
#endif
    PG8_LAS unsigned char* glds = (PG8_LAS unsigned char*)lds_raw;

    if (IN(0)) { p0_prologue(F_, args.in); } SEAM(0);

#pragma unroll 1
    for (int lp = 0; lp < 2; ++lp) {
        const int pb = 1 + lp * 19;
        unsigned char* ws = args.ws; asm volatile("" : "+s"(ws));
        Frame F = F_; { int w_ = F_.wave, v_ = F_.vcu, g_ = F_.G; asm volatile("" : "+s"(w_), "+s"(v_), "+s"(g_)); F.wave = w_; F.vcu = v_; F.G = g_; F.gw = v_ * NWAVES + w_; F.NGW = g_ * NWAVES; F.ws = ws; }
        float* mod = (float*)(ws + WS_MOD); float* XW = (float*)(ws + WS_XW);
        bf16_t* H = (bf16_t*)(ws + WS_H); bf16_t* P = (bf16_t*)(ws + WS_P); bf16_t* QRAW = (bf16_t*)(ws + WS_QRAW); bf16_t* KVRAW = (bf16_t*)(ws + WS_KVRAW);
        bf16_t* Q = (bf16_t*)(ws + WS_Q); bf16_t* KB = (bf16_t*)(ws + WS_K); bf16_t* VB = (bf16_t*)(ws + WS_V); bf16_t* CAT = (bf16_t*)(ws + WS_CAT); bf16_t* PQ = (bf16_t*)(ws + WS_PQ);
        int* IDX = (int*)(ws + WS_IDX); float* GATE = (float*)(ws + WS_GATE);
        const float* rope_c = (const float*)(ws + WS_ROPE); const float* rope_a = rope_c + 64 * 32 * 2;
        const float* SMv = (const float*)(ws + WS_SMALL);
        {
            const int l = 2 * lp, i = lp;
            const float* modl = mod + (size_t)l * 3 * NMOD;
            if (lp == 0) { if (IN(pb + 0)) { norm_phase(F, XW, SMv + SM_N1G + l * DM, modl, 0, 2048, H, false); } SEAM(pb + 0); }
            if (IN(pb + 1)) {
                pg8::Gemm g{H, (const bf16_t*)(ws + WS_WIN) + (size_t)i * 4096 * DM, MROWS, 4096, DM, DM, DM}; pg8::StaticOrder S; S.init(MROWS, 4096, F.G, (int)blockIdx.x);
                pg8::EpiBf16 E{P, 4096};
                pg8::gemm_phase<pg8::EpiBf16, pg8::StaticOrder, true, true>(glds, g, S, E, phase_tid(F.wave));
            } SEAM(pb + 1);
            if (IN(pb + 2)) {
                { pg8::Gemm g{P, (const bf16_t*)(ws + WS_WUQ) + (size_t)i * 1536 * 512, MROWS, 1536, 512, 4096, 512}; pg8::StaticOrder S; S.init(MROWS, 1536, F.G, (int)blockIdx.x);
                  pg8::EpiBf16 E{QRAW, 1536};
                  pg8::gemm_phase<pg8::EpiBf16, pg8::StaticOrder, true, true>(glds, g, S, E, phase_tid(F.wave)); }
                __syncthreads();
                { pg8::Gemm g{P + 512, (const bf16_t*)(ws + WS_WUKV) + (size_t)i * 2048 * 256, MROWS, 2048, 256, 4096, 256}; pg8::StaticOrder S; S.init(MROWS, 2048, F.G, (int)blockIdx.x);
                  pg8::EpiBf16 E{KVRAW, 2048};
                  pg8::gemm_phase<pg8::EpiBf16, pg8::StaticOrder, true, true>(glds, g, S, E, phase_tid(F.wave)); }
                __syncthreads();
                conv_phase(F, P, SMv + SM_CW + i * 3072, SMv + SM_CB + i * 1024, CAT);
            } SEAM(pb + 2);
            if (IN(pb + 3)) { prep_even_phase(F, P, QRAW, KVRAW, SMv + SM_AQG + i * 192, SMv + SM_AKG + i * 192, rope_a, Q, KB, VB); } SEAM(pb + 3);
            if (IN(pb + 4)) { attn_even_phase(F, Q, KB, VB, CAT); } SEAM(pb + 4);
            if (IN(pb + 5)) {
                pg8::Gemm g{CAT, (const bf16_t*)(ws + WS_WEO) + (size_t)i * DM * DM, MROWS, DM, DM, DM, DM}; pg8::StaticOrder S; S.init(MROWS, DM, F.G, (int)blockIdx.x);
                pg8::EpiResid E{XW, DM, modl + 4096};
                pg8::gemm_phase<pg8::EpiResid, pg8::StaticOrder, true, true>(glds, g, S, E, phase_tid(F.wave));
            } SEAM(pb + 5);
            if (IN(pb + 6)) { norm_phase(F, XW, SMv + SM_N2G + l * DM, modl, 6144, 8192, H, l == 3); } SEAM(pb + 6);
            if (IN(pb + 7)) {
                pg8::Gemm g{H, (const bf16_t*)(ws + WS_WPQ) + (size_t)l * DM * DM, MROWS, DM, DM, DM, DM}; pg8::StaticOrder S; S.init(MROWS, DM, F.G, (int)blockIdx.x);
                pg8::EpiBf16 E{PQ, DM};
                pg8::gemm_phase<pg8::EpiBf16, pg8::StaticOrder, true, true>(glds, g, S, E, phase_tid(F.wave));
            } SEAM(pb + 7);
            if (IN(pb + 8)) { peer_topk_phase(F, PQ, (const bf16_t*)(ws + WS_SUBK) + (size_t)l * 16 * 128 * 128, IDX, GATE, l == 3); } SEAM(pb + 8);
            if (IN(pb + 9)) { peer_expert_phase(F, H, IDX, GATE, ws + WS_U + (size_t)l * NEXP * ROWB, (size_t)(WS_VT - WS_U), (const float*)(ws + WS_USC) + l * NEXP, (const float*)(ws + WS_VSC) + l * NEXP, modl + 10240, XW, nullptr, H, SMv + SM_N1G + (l + 1) * DM, mod + (size_t)(l + 1) * 3 * NMOD); } SEAM(pb + 9);
        }
        {
            const int l = 2 * lp + 1, i = lp, qb = pb + 10;
            const float* modl = mod + (size_t)l * 3 * NMOD;
            if (IN(qb + 1)) {
                pg8::Gemm g{H, (const bf16_t*)(ws + WS_WQKV) + (size_t)i * 3072 * DM, MROWS, 3072, DM, DM, DM}; pg8::StaticOrder S; S.init(MROWS, 3072, F.G, (int)blockIdx.x);
                pg8::EpiBf16 E{P, 3072};
                pg8::gemm_phase<pg8::EpiBf16, pg8::StaticOrder, true, true>(glds, g, S, E, phase_tid(F.wave));
            } SEAM(qb + 1);
            if (IN(qb + 2)) { prep_odd_phase(F, P, SMv + SM_CQG + i * 128, SMv + SM_CKG + i * 128, rope_c, Q, KB); } SEAM(qb + 2);
            if (IN(qb + 3)) { attn_odd_phase(F, Q, KB, P, CAT, l == 3); } SEAM(qb + 3);
            if (IN(qb + 4)) {
                pg8::Gemm g{CAT, (const bf16_t*)(ws + WS_WCO) + (size_t)i * DM * DM, MROWS, DM, DM, DM, DM}; pg8::StaticOrder S; S.init(MROWS, DM, F.G, (int)blockIdx.x, l == 3);
                pg8::EpiResid E{XW, DM, modl + 4096};
                pg8::gemm_phase<pg8::EpiResid, pg8::StaticOrder, true, true>(glds, g, S, E, phase_tid(F.wave));
            } SEAM(qb + 4);
            if (IN(qb + 5)) { norm_phase(F, XW, SMv + SM_N2G + l * DM, modl, 6144, 8192, H, l == 3); } SEAM(qb + 5);
            if (IN(qb + 6)) {
                pg8::Gemm g{H, (const bf16_t*)(ws + WS_WPQ) + (size_t)l * DM * DM, MROWS, DM, DM, DM, DM}; pg8::StaticOrder S; S.init(MROWS, DM, F.G, (int)blockIdx.x, l == 3);
                pg8::EpiBf16 E{PQ, DM};
                pg8::gemm_phase<pg8::EpiBf16, pg8::StaticOrder, true, true>(glds, g, S, E, phase_tid(F.wave));
            } SEAM(qb + 6);
            if (IN(qb + 7)) { peer_topk_phase(F, PQ, (const bf16_t*)(ws + WS_SUBK) + (size_t)l * 16 * 128 * 128, IDX, GATE, l == 3); } SEAM(qb + 7);
            if (IN(qb + 8)) { peer_expert_phase(F, H, IDX, GATE, ws + WS_U + (size_t)l * NEXP * ROWB, (size_t)(WS_VT - WS_U), (const float*)(ws + WS_USC) + l * NEXP, (const float*)(ws + WS_VSC) + l * NEXP, modl + 10240, XW, (l == 3) ? args.out : nullptr, (l == 3) ? nullptr : H, SMv + SM_N1G + (l + 1) * DM, mod + (size_t)(l + 1) * 3 * NMOD); } if (lp == 0) SEAM(qb + 8);
        }
    }
#undef IN
#undef SEAM
}

extern "C" void kernel_launch(void* const* d_in, const int* in_sizes, int n_in, void* d_out, int out_size, void* d_ws, size_t ws_size, hipStream_t stream) {
    static int grid = 0;
    if (grid == 0) {
        if (n_in != 26 || out_size != NBATCH * SEQ * DM || ws_size < WS_END) { fprintf(stderr, "kernel_launch: unexpected shapes: n_in %d out %d ws %zu (need %zu)\n", n_in, out_size, ws_size, (size_t)WS_END); grid = -1; return; }
        int dev = 0, cus = 0, per_cu = 0;
        if (hipGetDevice(&dev) != hipSuccess || hipDeviceGetAttribute(&cus, hipDeviceAttributeMultiprocessorCount, dev) != hipSuccess) { fprintf(stderr, "kernel_launch: device query failed\n"); grid = -1; return; }
        if (hipFuncSetAttribute((const void*)fwd_kernel, hipFuncAttributeMaxDynamicSharedMemorySize, LDS_BYTES) != hipSuccess) { fprintf(stderr, "kernel_launch: hipFuncSetAttribute failed\n"); grid = -1; return; }
        if (hipOccupancyMaxActiveBlocksPerMultiprocessor(&per_cu, (const void*)fwd_kernel, NTHREADS, LDS_BYTES) != hipSuccess || per_cu < 1) { fprintf(stderr, "kernel_launch: occupancy query says %d blocks per CU\n", per_cu); (void)hipGetLastError(); grid = -1; return; }
        grid = cus;
    }
    if (grid < 0) return;
    (void)hipMemsetAsync((char*)d_ws + WS_CTL, 0, CTL_ZERO_BYTES, stream);
    Args a{};
    for (int i = 0; i < 26; ++i) a.in[i] = (const float*)d_in[i];
    a.out = (float*)d_out; a.ws = (unsigned char*)d_ws;
    for (int li = 0; li < N_LAUNCHES; ++li) {
        a.ph_lo = (N_LAUNCHES == 1) ? 0 : li; a.ph_hi = (N_LAUNCHES == 1) ? NPHASES : li + 1;
        hipLaunchKernelGGL(fwd_kernel, dim3(grid), dim3(NTHREADS), LDS_BYTES, stream, a);
        const hipError_t le = hipPeekAtLastError();
        if (le != hipSuccess) { fprintf(stderr, "kernel_launch: launch %d failed: %s\n", li, hipGetErrorName(le)); break; }
    }
}
```

```cpp
#include <hip/hip_runtime.h>
#include <cstdio>
#include <cstdint>
namespace pg8 {
#define PG8_LAS __attribute__((address_space(3)))
typedef unsigned short bf16_t;
typedef short bf16x8 __attribute__((ext_vector_type(8)));
typedef float f32x4 __attribute__((ext_vector_type(4)));
typedef unsigned u32x4 __attribute__((ext_vector_type(4)));
constexpr int BM = 256, BK = 64, HALF = 128, HTB = HALF * BK * 2  , STAGE_BYTES = 8 * HTB, NXCD = 8, WGM = 8;

__host__ __device__ __forceinline__ int lds_byte(int r, int c) { const int st = (r >> 4) * 2 + (c >> 5), rr = r & 15, cc = c & 31, ob = rr * 64 + cc * 2; return st * 1024 + (ob ^ (((ob >> 9) & 1) << 5)); }
__host__ __device__ __forceinline__ void stage_rc(int b, int& R, int& C) { const int st = b / 1024, sb = b % 1024, swz = sb ^ (((sb >> 9) & 1) << 5); R = (st >> 1) * 16 + swz / 64; C = (st & 1) * 32 + (swz % 64) / 2; }
__host__ __device__ __forceinline__ int perm32(int rho) { const int n = rho >> 4, i = rho & 15; return 8 * (i >> 2) + 4 * n + (i & 3); }

struct Unit { int pm, pn; };
struct Gemm { const bf16_t* A; const bf16_t* Bt; int M, N, K, lda, ldb; };

struct StaticOrder {
    int nM, nN, nwg, G, c; bool lat_only;
    __host__ __device__ void init(int M, int N, int G_, int c_, bool lat_only_ = false) { lat_only = lat_only_; nM = lat_only_ ? 32 : M / BM; nN = N / BM; nwg = nM * nN; G = G_; c = c_; }
    __host__ __device__ bool next(int i, Unit& u) const {
        const long L = (long)i * G + c; if (L >= nwg) return false;
        int wgid = (int)L; { const int q = nwg / NXCD, r = nwg % NXCD, xcd = wgid % NXCD, off = wgid / NXCD; wgid = (xcd < r ? xcd * (q + 1) : r * (q + 1) + (xcd - r) * q) + off; }
        const int nig = WGM * nN, gid = wgid / nig, fm = gid * WGM, gsz = (nM - fm) < WGM ? (nM - fm) : WGM;
        u.pm = fm + ((wgid % nig) % gsz); u.pn = (wgid % nig) / gsz; if (lat_only) u.pm += 1 + (u.pm >= 16 ? 1 : 0); return true;
    }
    __device__ __forceinline__ void a_ready(const Unit&) const {}
    __device__ __forceinline__ void done(const Unit&) const {}
};
__device__ __forceinline__ unsigned cvt_pk_bf16(float lo, float hi) { unsigned r; asm volatile("v_cvt_pk_bf16_f32 %0, %1, %2" : "=v"(r) : "v"(lo), "v"(hi)); return r; }
typedef float f32x2 __attribute__((ext_vector_type(2)));
struct EpiBf16 {
    static constexpr bool PERM = true, AFTER_DRAIN = false;
    bf16_t* O; int ldc;
    __device__ __forceinline__ void operator()(const f32x4 (&acc)[2][2][4][2], const Unit& u, int wr, int wc, int fr, int fq) const {
        const int row0 = u.pm * BM + wr * 64 + fr, col0 = u.pn * BM + wc * 32 + 8 * fq;
#pragma unroll
        for (int ai = 0; ai < 2; ++ai)
#pragma unroll
            for (int m = 0; m < 4; ++m) { bf16_t* rowp = O + (size_t)(row0 + ai * HALF + m * 16) * ldc + col0;
#pragma unroll
                for (int bj = 0; bj < 2; ++bj) { const f32x4 v0 = acc[ai][bj][m][0], v1 = acc[ai][bj][m][1];
                    u32x4 w; w.x = cvt_pk_bf16(v0[0], v0[1]); w.y = cvt_pk_bf16(v0[2], v0[3]); w.z = cvt_pk_bf16(v1[0], v1[1]); w.w = cvt_pk_bf16(v1[2], v1[3]);
                    *(u32x4*)(rowp + bj * HALF) = w; } }
    }
};
struct EpiResid {
    static constexpr bool PERM = false, AFTER_DRAIN = false;
    float* X; int ldc; const float* gate;
    __device__ __forceinline__ void operator()(const f32x4 (&acc)[2][2][4][2], const Unit& u, int wr, int wc, int fr, int fq) const {
        const int row0 = u.pm * BM + wr * 64 + fr, col0 = u.pn * BM + wc * 32 + 4 * fq;
        const int cls = (u.pm % 17 == 0) ? 2 : (u.pm / 17);
        const float* gp = gate + (size_t)cls * 12288 + col0;
        f32x4 gv[2][2];
#pragma unroll
        for (int bj = 0; bj < 2; ++bj)
#pragma unroll
            for (int n = 0; n < 2; ++n) gv[bj][n] = *(const f32x4*)(gp + bj * HALF + n * 16);
#pragma unroll
        for (int ai = 0; ai < 2; ++ai)
#pragma unroll
            for (int m = 0; m < 4; ++m) { float* rowp = X + (size_t)(row0 + ai * HALF + m * 16) * ldc + col0;
#pragma unroll
                for (int bj = 0; bj < 2; ++bj)
#pragma unroll
                    for (int n = 0; n < 2; ++n) { f32x4* p = (f32x4*)(rowp + bj * HALF + n * 16); *p = *p + gv[bj][n] * acc[ai][bj][m][n]; } }
    }
};
template <class Epi, class Sched, bool ALIGN_EPI = false, bool SP2 = false>
__device__ __forceinline__ void gemm_phase(PG8_LAS unsigned char* lds, const Gemm g, const Sched& S, const Epi& E, int tid_in) {
    int tid_ = tid_in; asm volatile("" : "+v"(tid_));
    const int tid = tid_, wid = __builtin_amdgcn_readfirstlane(tid >> 6), lane = tid & 63, wr = wid >> 2, wc = wid & 3, fr = lane & 15, fq = lane >> 4;
    const int K = g.K, nt = K / BK;
    unsigned voffA[2], voffB[2];
#pragma unroll
    for (int i = 0; i < 2; ++i) { int R, C; stage_rc(tid * 16 + i * 8192, R, C); const int Rb = Epi::PERM ? ((R & ~31) + perm32(R & 31)) : R;
        voffA[i] = (unsigned)(R * g.lda + C) * 2u; voffB[i] = (unsigned)(Rb * g.ldb + C) * 2u; }
    const size_t kstep = (size_t)(BK * 2);
    const size_t hstepA = (size_t)HALF * g.lda * 2, hstepB = (size_t)HALF * g.ldb * 2;
    const size_t tstepA = 2 * hstepA, tstepB = 2 * hstepB;
    const unsigned ldsw = (unsigned)wid * 1024u;
    const int aoff = lds_byte(wr * 64 + fr, fq * 8), boff = lds_byte(wc * 32 + fr, fq * 8);
#define PG8_SA(b, h) (((b) * 2 + (h)) * HTB)
#define PG8_SB(b, h) ((4 + (b) * 2 + (h)) * HTB)
#define PG8_STAGE(bufoff, gbase, voff) do { _Pragma("unroll") for (int _i = 0; _i < 2; ++_i) \
        __builtin_amdgcn_global_load_lds((const unsigned*)((const char*)(gbase) + (voff)[_i]), (PG8_LAS unsigned*)(lds + (bufoff) + ldsw + _i * 8192), 16, 0, 0); } while (0)
#define PG8_LDA(dst, b, h) do { _Pragma("unroll") for (int m = 0; m < 4; ++m) _Pragma("unroll") for (int k = 0; k < 2; ++k) dst[m][k] = *(const PG8_LAS bf16x8*)(lds + PG8_SA(b, h) + aoff + m * 2048 + k * 1024); } while (0)
#define PG8_LDB(dst, b, h) do { _Pragma("unroll") for (int n = 0; n < 2; ++n) _Pragma("unroll") for (int k = 0; k < 2; ++k) dst[n][k] = *(const PG8_LAS bf16x8*)(lds + PG8_SB(b, h) + boff + n * 2048 + k * 1024); } while (0)
#define PG8_MMA(ai, bj, At, Bt) do { __builtin_amdgcn_s_setprio(1); _Pragma("unroll") for (int m = 0; m < 4; ++m) _Pragma("unroll") for (int n = 0; n < 2; ++n) _Pragma("unroll") for (int k = 0; k < 2; ++k) \
        acc[ai][bj][m][n] = __builtin_amdgcn_mfma_f32_16x16x32_bf16(Bt[n][k], At[m][k], acc[ai][bj][m][n], 0, 0, 0); __builtin_amdgcn_s_setprio(0); } while (0)
#define PG8_WAIT_V(n) asm volatile("s_waitcnt vmcnt(" #n ")" ::: "memory")
#define PG8_WAIT_L(n) asm volatile("s_waitcnt lgkmcnt(" #n ")" ::: "memory")
#define PG8_BAR __builtin_amdgcn_s_barrier()
#define PG8_SCHED __builtin_amdgcn_sched_barrier(0)
    Unit cur, nxt; int ui = 0;
    if (!S.next(0, cur)) return;
    f32x4 acc[2][2][4][2];
#pragma unroll
    for (int a = 0; a < 2; ++a)
#pragma unroll
        for (int b = 0; b < 2; ++b)
#pragma unroll
            for (int m = 0; m < 4; ++m)
#pragma unroll
                for (int n = 0; n < 2; ++n) acc[a][b][m][n] = (f32x4){0.f, 0.f, 0.f, 0.f};
    bf16x8 At[4][2], B0[2][2], B1[2][2];
    const char* cA = (const char*)g.A + (size_t)cur.pm * tstepA; const char* cB = (const char*)g.Bt + (size_t)cur.pn * tstepB;
    S.a_ready(cur);
    if constexpr (SP2) {
        PG8_STAGE(PG8_SB(0, 0), cB, voffB); PG8_STAGE(PG8_SB(0, 1), cB + hstepB, voffB); PG8_STAGE(PG8_SA(0, 0), cA, voffA); PG8_STAGE(PG8_SA(0, 1), cA + hstepA, voffA);
        if (wr == 1) PG8_BAR;
        PG8_WAIT_V(2); PG8_BAR;
        PG8_STAGE(PG8_SB(1, 0), cB + kstep, voffB); PG8_STAGE(PG8_SA(1, 0), cA + kstep, voffA); PG8_STAGE(PG8_SB(1, 1), cB + hstepB + kstep, voffB);
        PG8_WAIT_V(6); PG8_BAR;
    } else {
        PG8_STAGE(PG8_SB(0, 0), cB, voffB); PG8_STAGE(PG8_SA(0, 0), cA, voffA); PG8_STAGE(PG8_SB(0, 1), cB + hstepB, voffB); PG8_STAGE(PG8_SA(0, 1), cA + hstepA, voffA);
        if (wr == 1) PG8_BAR;
        PG8_WAIT_V(4); PG8_BAR;
        PG8_STAGE(PG8_SB(1, 0), cB + kstep, voffB); PG8_STAGE(PG8_SA(1, 0), cA + kstep, voffA); PG8_STAGE(PG8_SB(1, 1), cB + hstepB + kstep, voffB);
        PG8_WAIT_V(6); PG8_BAR;
    }
    for (;;) {
        const bool has_next = S.next(ui + 1, nxt);
        const char* nA = has_next ? (const char*)g.A + (size_t)nxt.pm * tstepA : cA; const char* nB = has_next ? (const char*)g.Bt + (size_t)nxt.pn * tstepB : cB;
        for (int t = 0; t < nt; t += 2) {
            const bool last = (t == nt - 2);
            const char* a1 = cA + (size_t)(t + 1) * kstep;
            const char* a2 = last ? nA : cA + (size_t)(t + 2) * kstep; const char* b2 = last ? nB : cB + (size_t)(t + 2) * kstep;
            const char* a3 = a2 + kstep; const char* b3 = b2 + kstep;
            if (last && has_next) S.a_ready(nxt);
            if constexpr (SP2) {
            PG8_LDB(B0, 0, 0); PG8_LDB(B1, 0, 1); PG8_SCHED; PG8_LDA(At, 0, 0); PG8_STAGE(PG8_SA(1, 1), a1 + hstepA, voffA);
            PG8_WAIT_V(8); PG8_WAIT_L(0); PG8_BAR; PG8_MMA(0, 0, At, B0); PG8_MMA(0, 1, At, B1); PG8_BAR; PG8_SCHED;
            PG8_LDA(At, 0, 1); PG8_STAGE(PG8_SB(0, 0), b2, voffB); PG8_STAGE(PG8_SB(0, 1), b2 + hstepB, voffB); PG8_STAGE(PG8_SA(0, 0), a2, voffA);
            PG8_WAIT_V(8); PG8_WAIT_L(0); PG8_BAR; PG8_MMA(1, 0, At, B0); PG8_MMA(1, 1, At, B1); PG8_BAR; PG8_SCHED;
            PG8_LDB(B0, 1, 0); PG8_LDB(B1, 1, 1); PG8_SCHED; PG8_LDA(At, 1, 0); PG8_STAGE(PG8_SA(0, 1), a2 + hstepA, voffA);
            PG8_WAIT_V(8); PG8_WAIT_L(0); PG8_BAR; PG8_MMA(0, 0, At, B0); PG8_MMA(0, 1, At, B1); PG8_BAR; PG8_SCHED;
            PG8_LDA(At, 1, 1); PG8_STAGE(PG8_SB(1, 0), b3, voffB); PG8_STAGE(PG8_SB(1, 1), b3 + hstepB, voffB); PG8_STAGE(PG8_SA(1, 0), a3, voffA);
            PG8_WAIT_V(8); PG8_WAIT_L(0); PG8_BAR; PG8_MMA(1, 0, At, B0); PG8_MMA(1, 1, At, B1); PG8_BAR; PG8_SCHED;
            } else {
            PG8_LDB(B0, 0, 0); PG8_SCHED; PG8_LDA(At, 0, 0); PG8_STAGE(PG8_SA(1, 1), a1 + hstepA, voffA);
            PG8_WAIT_L(8); PG8_BAR; PG8_WAIT_L(0); PG8_MMA(0, 0, At, B0); PG8_BAR; PG8_SCHED;
            PG8_LDB(B1, 0, 1); PG8_STAGE(PG8_SB(0, 0), b2, voffB);
            PG8_BAR; PG8_WAIT_L(0); PG8_MMA(0, 1, At, B1); PG8_BAR;
            PG8_LDA(At, 0, 1); PG8_STAGE(PG8_SA(0, 0), a2, voffA);
            PG8_BAR; PG8_WAIT_L(0); PG8_MMA(1, 0, At, B0); PG8_BAR; PG8_SCHED;
            PG8_STAGE(PG8_SB(0, 1), b2 + hstepB, voffB);
            PG8_WAIT_V(6); PG8_BAR; PG8_MMA(1, 1, At, B1); PG8_BAR;
            PG8_LDB(B0, 1, 0); PG8_SCHED; PG8_LDA(At, 1, 0); PG8_STAGE(PG8_SA(0, 1), a2 + hstepA, voffA);
            PG8_WAIT_L(8); PG8_BAR; PG8_WAIT_L(0); PG8_MMA(0, 0, At, B0); PG8_BAR; PG8_SCHED;
            PG8_LDB(B1, 1, 1); PG8_STAGE(PG8_SB(1, 0), b3, voffB);
            PG8_BAR; PG8_WAIT_L(0); PG8_MMA(0, 1, At, B1); PG8_BAR;
            PG8_LDA(At, 1, 1); PG8_STAGE(PG8_SA(1, 0), a3, voffA);
            PG8_BAR; PG8_WAIT_L(0); PG8_MMA(1, 0, At, B0); PG8_BAR; PG8_SCHED;
            PG8_STAGE(PG8_SB(1, 1), b3 + hstepB, voffB);
            PG8_WAIT_V(6); PG8_BAR; PG8_MMA(1, 1, At, B1); PG8_BAR;
            }
        }
        if constexpr (ALIGN_EPI) { if (wr == 0) PG8_BAR; }
        if constexpr (!Epi::AFTER_DRAIN) { E(acc, cur, wr, wc, fr, fq); S.done(cur); }
        if (!has_next) break;
#pragma unroll
        for (int a = 0; a < 2; ++a)
#pragma unroll
            for (int b = 0; b < 2; ++b)
#pragma unroll
                for (int m = 0; m < 4; ++m)
#pragma unroll
                    for (int n = 0; n < 2; ++n) acc[a][b][m][n] = (f32x4){0.f, 0.f, 0.f, 0.f};
        cur = nxt; cA = nA; cB = nB; ++ui;
        if constexpr (ALIGN_EPI) { if (wr == 1) PG8_BAR; }
    }
    PG8_WAIT_V(0);
    if constexpr (!ALIGN_EPI) { if (wr == 0) PG8_BAR; }
    PG8_BAR;
    if constexpr (Epi::AFTER_DRAIN) { E.fused(acc, cur, wr, wc, fr, fq, lds, wid, lane); S.done(cur); }
#undef PG8_SA
#undef PG8_SB
#undef PG8_STAGE
#undef PG8_LDA
#undef PG8_LDB
#undef PG8_MMA
#undef PG8_WAIT_V
#undef PG8_WAIT_L
#undef PG8_BAR
#undef PG8_SCHED
}
}
namespace att {
typedef unsigned short bf16_t;
using bf16x8 = __attribute__((ext_vector_type(8))) short;
using s16x4  = __attribute__((ext_vector_type(4))) short;
using f32x16 = __attribute__((ext_vector_type(16))) float;
using u32x4  = __attribute__((ext_vector_type(4))) unsigned;
constexpr int DV = 128, NW = 8, QBLK = 32, KVBLK = 64;
constexpr float THR = 8.f;
constexpr int SHM_V = KVBLK * DV * 2;
template <int DQK> struct Cfg {
    static constexpr int SHM_K = KVBLK * DQK * 2, KROWB = DQK * 2, NCK = DQK / 64, C8 = DQK / 8, ND0 = DQK / 16;
    static constexpr float SCALE = (DQK == 128) ? 0.088388347648318440f : 0.072168783648703220f;
    static constexpr int LDS_BYTES = 2 * SHM_V + 2 * SHM_K + NW * 64 * 4;
};
#define ATT_SBAR() __builtin_amdgcn_sched_barrier(0)
__device__ __forceinline__ int crow(int r, int hi) { return (r & 3) + 8 * (r >> 2) + 4 * hi; }
__device__ __forceinline__ unsigned cvtpk(float lo, float hi) { unsigned r; asm volatile("v_cvt_pk_bf16_f32 %0, %1, %2" : "=v"(r) : "v"(lo), "v"(hi)); return r; }
template <int DQK> __device__ __forceinline__ int kswz(int row, int colB) {
    const int key = (DQK == 128) ? (row & 7) : ((row >> 1) & 7);
    return row * (DQK * 2) + (colB ^ (key << 4));
}
template <int DQK> __device__ __forceinline__ void partialSM(f32x16& p0, f32x16& p1, float& m_reg, float& mn, float& alpha) {
    constexpr float SCALE = Cfg<DQK>::SCALE, C = SCALE * 1.4426950408889634f;
    float pmax = p0[0];
#pragma unroll
    for (int r = 1; r < 16; ++r) pmax = fmaxf(pmax, p0[r]);
#pragma unroll
    for (int r = 0; r < 16; ++r) pmax = fmaxf(pmax, p1[r]);
    { auto rr = __builtin_amdgcn_permlane32_swap(__float_as_uint(pmax), __float_as_uint(pmax), false, false);
      pmax = fmaxf(__uint_as_float(rr[0]), __uint_as_float(rr[1])); }
    if (__builtin_expect(__all(pmax - m_reg <= THR / SCALE), 1)) { mn = m_reg; alpha = 1.f; }
    else { mn = fmaxf(m_reg, pmax); alpha = __builtin_amdgcn_exp2f((m_reg - mn) * C); m_reg = mn; }
    const float mnC = -mn * C;
#pragma unroll
    for (int r = 0; r < 16; ++r) p0[r] = fmaf(p0[r], C, mnC);
#pragma unroll
    for (int r = 0; r < 16; ++r) p1[r] = fmaf(p1[r], C, mnC);
#pragma unroll
    for (int r = 0; r < 16; ++r) p0[r] = __builtin_amdgcn_exp2f(p0[r]);
}
__device__ __forceinline__ void finishSM(f32x16& p0, f32x16& p1, float alpha, float& l_reg, bf16x8& pa0, bf16x8& pa1, bf16x8& pa2, bf16x8& pa3) {
#pragma unroll
    for (int r = 0; r < 16; ++r) p1[r] = __builtin_amdgcn_exp2f(p1[r]);
    float ps = 0;
#pragma unroll
    for (int r = 0; r < 16; ++r) ps += p0[r];
#pragma unroll
    for (int r = 0; r < 16; ++r) ps += p1[r];
    { auto rr = __builtin_amdgcn_permlane32_swap(__float_as_uint(ps), __float_as_uint(ps), false, false);
      ps = __uint_as_float(rr[0]) + __uint_as_float(rr[1]); }
    l_reg = l_reg * alpha + ps;
#define ATT_PK4(P, BASE, OUT) do { unsigned a0 = cvtpk(P[BASE + 0], P[BASE + 1]), a1 = cvtpk(P[BASE + 2], P[BASE + 3]);   \
    unsigned b0 = cvtpk(P[BASE + 4], P[BASE + 5]), b1 = cvtpk(P[BASE + 6], P[BASE + 7]);                              \
    auto r0 = __builtin_amdgcn_permlane32_swap(a0, b0, false, false); auto r1 = __builtin_amdgcn_permlane32_swap(a1, b1, false, false); \
    u32x4 w = {r0[0], r1[0], r0[1], r1[1]}; OUT = *reinterpret_cast<bf16x8*>(&w); } while (0)
    ATT_PK4(p0, 0, pa0); ATT_PK4(p0, 8, pa1); ATT_PK4(p1, 0, pa2); ATT_PK4(p1, 8, pa3);
#undef ATT_PK4
}
template <int DQK> __device__ __forceinline__ void qkt(f32x16& p0, f32x16& p1, const char* Ks, const bf16x8* qr, int r32, int hi) {
    p0 = f32x16{}; p1 = f32x16{};
#pragma unroll
    for (int d0 = 0; d0 < Cfg<DQK>::ND0; ++d0) { const int cb = (d0 * 16 + hi * 8) * 2;
        bf16x8 b0 = *reinterpret_cast<const bf16x8*>(Ks + kswz<DQK>(r32, cb));
        bf16x8 b1 = *reinterpret_cast<const bf16x8*>(Ks + kswz<DQK>(32 + r32, cb));
        p0 = __builtin_amdgcn_mfma_f32_32x32x16_bf16(b0, qr[d0], p0, 0, 0, 0);
        p1 = __builtin_amdgcn_mfma_f32_32x32x16_bf16(b1, qr[d0], p1, 0, 0, 0); }
}
__device__ __forceinline__ int v_st(int k, int c) { const int kk = (k & ~0xC) | ((k & 4) << 1) | ((k & 8) >> 1); return ((kk >> 3) * 4 + (c >> 5)) * 512 + ((kk & 7) * 32 + (c & 31)) * 2; }
__device__ __forceinline__ int v_rd_base(int lane) { return ((lane & 3) << 3) | (((lane >> 2) & 3) << 6) | (((lane >> 4) & 1) << 5) | (((lane >> 5) & 1) << 8); }
constexpr int v_rd_off(int d0, int ks, int half) { return d0 * 512 + ks * 4096 + half * 2048; }
template <int OFF> __device__ __forceinline__ s16x4 tr_read(int vb) {
    s16x4 r; asm volatile("ds_read_b64_tr_b16 %0, %1 offset:%2" : "=&v"(r) : "v"(vb), "i"(OFF) : "memory"); return r;
}
template <int D0> __device__ __forceinline__ void pv_one(f32x16& od, int vb, bf16x8 pa0, bf16x8 pa1, bf16x8 pa2, bf16x8 pa3) {
    const s16x4 l0 = tr_read<v_rd_off(D0, 0, 0)>(vb), h0 = tr_read<v_rd_off(D0, 0, 1)>(vb), l1 = tr_read<v_rd_off(D0, 1, 0)>(vb), h1 = tr_read<v_rd_off(D0, 1, 1)>(vb);
    const s16x4 l2 = tr_read<v_rd_off(D0, 2, 0)>(vb), h2 = tr_read<v_rd_off(D0, 2, 1)>(vb), l3 = tr_read<v_rd_off(D0, 3, 0)>(vb), h3 = tr_read<v_rd_off(D0, 3, 1)>(vb);
    asm volatile("s_waitcnt lgkmcnt(0)" ::: "memory"); ATT_SBAR();
#define ATT_PK(L, H) (bf16x8){L[0], L[1], L[2], L[3], H[0], H[1], H[2], H[3]}
    od = __builtin_amdgcn_mfma_f32_32x32x16_bf16(pa0, ATT_PK(l0, h0), od, 0, 0, 0);
    od = __builtin_amdgcn_mfma_f32_32x32x16_bf16(pa1, ATT_PK(l1, h1), od, 0, 0, 0);
    od = __builtin_amdgcn_mfma_f32_32x32x16_bf16(pa2, ATT_PK(l2, h2), od, 0, 0, 0);
    od = __builtin_amdgcn_mfma_f32_32x32x16_bf16(pa3, ATT_PK(l3, h3), od, 0, 0, 0);
#undef ATT_PK
}
__device__ __forceinline__ void pv_d0(f32x16* o, int vb, bf16x8 pa0, bf16x8 pa1, bf16x8 pa2, bf16x8 pa3) {
    pv_one<0>(o[0], vb, pa0, pa1, pa2, pa3); pv_one<1>(o[1], vb, pa0, pa1, pa2, pa3); pv_one<2>(o[2], vb, pa0, pa1, pa2, pa3); pv_one<3>(o[3], vb, pa0, pa1, pa2, pa3);
}
template <int DQK, int LDQ, int LDK, int LDV, int LDO, int SDEPTH>
__device__ __forceinline__ void attn_body(const bf16_t* __restrict__ Qb, const bf16_t* __restrict__ Kh, const bf16_t* __restrict__ Vh, bf16_t* __restrict__ Ob, int seq, char* lds, int tid_in) {
    using C_ = Cfg<DQK>;
    constexpr int SHM_K = C_::SHM_K, NCK = C_::NCK, C8 = C_::C8, ND0 = C_::ND0;
    int tid_ = tid_in; asm volatile("" : "+v"(tid_));
    const int tid = tid_, wid = tid >> 6, lane = tid & 63, r32 = lane & 31, hi = lane >> 5;
    char* V_lds = lds; char* K_lds = lds + 2 * SHM_V;
    float* ws = (float*)(lds + 2 * SHM_V + 2 * SHM_K) + wid * 64; float* li_l = ws; float* al_l = ws + 32;
    float m_reg = -1e30f, l_reg = 0; f32x16 o[4] = {}; bf16x8 qr[ND0];
    const bf16_t* Qw = Qb + (long)(wid * QBLK + r32) * LDQ + hi * 8;
#pragma unroll
    for (int d0 = 0; d0 < ND0; ++d0) qr[d0] = *reinterpret_cast<const bf16x8*>(Qw + d0 * 16);
    const int sr = tid >> 4, sc = (tid & 15) * 8, vst0 = v_st(sr, sc), vst1 = v_st(32 + sr, sc);
    int krow[NCK], kcol[NCK];
#pragma unroll
    for (int i = 0; i < NCK; ++i) { const int ci = tid + 512 * i; krow[i] = ci / C8; kcol[i] = (ci % C8) * 8; }
    const int vb0 = (int)(uintptr_t)V_lds + v_rd_base(lane);
    struct { bf16x8 vs0, vs1, ks[NCK]; } sr_[SDEPTH];
#define ATT_SLOAD(i, k0) do { sr_[i].vs0 = *reinterpret_cast<const bf16x8*>(&Vh[(long)((k0) + sr) * LDV + sc]); sr_[i].vs1 = *reinterpret_cast<const bf16x8*>(&Vh[(long)((k0) + 32 + sr) * LDV + sc]); \
    _Pragma("unroll") for (int c_ = 0; c_ < NCK; ++c_) sr_[i].ks[c_] = *reinterpret_cast<const bf16x8*>(&Kh[(long)((k0) + krow[c_]) * LDK + kcol[c_]]); } while (0)
#define ATT_SWRITE(b, i) do { *(bf16x8*)(V_lds + (b) * SHM_V + vst0) = sr_[i].vs0; *(bf16x8*)(V_lds + (b) * SHM_V + vst1) = sr_[i].vs1; \
    _Pragma("unroll") for (int c_ = 0; c_ < NCK; ++c_) *(bf16x8*)(K_lds + (b) * SHM_K + kswz<DQK>(krow[c_], kcol[c_] * 2)) = sr_[i].ks[c_]; } while (0)
#define ATT_SWAIT() do { if constexpr (SDEPTH == 2) { if constexpr (NCK == 2) asm volatile("s_waitcnt vmcnt(4)" ::: "memory"); else asm volatile("s_waitcnt vmcnt(5)" ::: "memory"); } else asm volatile("s_waitcnt vmcnt(0)" ::: "memory"); } while (0)
#define ATT_RESC(a) do { if (__any((a) < 1.f)) { if (hi == 0) al_l[r32] = (a); asm volatile("s_waitcnt lgkmcnt(0)" ::: "memory"); \
    _Pragma("unroll") for (int d = 0; d < 4; ++d) _Pragma("unroll") for (int r = 0; r < 16; ++r) o[d][r] *= al_l[crow(r, hi)]; } } while (0)
    f32x16 pA0, pA1, pB0, pB1; float mnA, mnB, alA, alB; bf16x8 pa0, pa1, pa2, pa3; const int NT = seq / KVBLK;
    constexpr int SE = 0, SO = SDEPTH - 1;
    ATT_SLOAD(SE, 0); asm volatile("s_waitcnt vmcnt(0)" ::: "memory"); ATT_SWRITE(0, SE); __syncthreads();
    qkt<DQK>(pA0, pA1, K_lds, qr, r32, hi); partialSM<DQK>(pA0, pA1, m_reg, mnA, alA);
    ATT_SLOAD(SO, KVBLK); if constexpr (SDEPTH == 2) { if (2 < NT) ATT_SLOAD(SE, 2 * KVBLK); }
    ATT_SWAIT(); ATT_SWRITE(1, SO); __syncthreads();
    for (int j = 1; j + 1 < NT; j += 2) {
        ATT_SBAR(); qkt<DQK>(pB0, pB1, K_lds + SHM_K, qr, r32, hi);
        finishSM(pA0, pA1, alA, l_reg, pa0, pa1, pa2, pa3); ATT_SBAR();
        ATT_SLOAD(SO, (j + SDEPTH) * KVBLK); ATT_SBAR();
        pv_d0(o, vb0, pa0, pa1, pa2, pa3); partialSM<DQK>(pB0, pB1, m_reg, mnB, alB);
        __syncthreads(); ATT_SWAIT(); ATT_SWRITE(0, SE);
        ATT_RESC(alB); __syncthreads();
        ATT_SBAR(); qkt<DQK>(pA0, pA1, K_lds, qr, r32, hi);
        finishSM(pB0, pB1, alB, l_reg, pa0, pa1, pa2, pa3); ATT_SBAR();
        if (SDEPTH == 1 || j + 3 < NT) ATT_SLOAD(SE, (j + 1 + SDEPTH) * KVBLK); ATT_SBAR();
        pv_d0(o, vb0 + (int)SHM_V, pa0, pa1, pa2, pa3); partialSM<DQK>(pA0, pA1, m_reg, mnA, alA);
        __syncthreads(); ATT_SWAIT(); ATT_SWRITE(1, SO);
        ATT_RESC(alA); __syncthreads();
    }
    ATT_SBAR(); qkt<DQK>(pB0, pB1, K_lds + SHM_K, qr, r32, hi);
    finishSM(pA0, pA1, alA, l_reg, pa0, pa1, pa2, pa3); ATT_SBAR();
    pv_d0(o, vb0, pa0, pa1, pa2, pa3); partialSM<DQK>(pB0, pB1, m_reg, mnB, alB);
    __syncthreads(); ATT_RESC(alB);
    finishSM(pB0, pB1, alB, l_reg, pa0, pa1, pa2, pa3); ATT_SBAR();
    pv_d0(o, vb0 + (int)SHM_V, pa0, pa1, pa2, pa3);
    if (hi == 0) li_l[r32] = l_reg;
    asm volatile("s_waitcnt lgkmcnt(0)" ::: "memory");
    __syncthreads();
    float rli[16];
#pragma unroll
    for (int r = 0; r < 16; ++r) rli[r] = __builtin_amdgcn_rcpf(li_l[crow(r, hi)]);
    unsigned short* stg = (unsigned short*)(lds + wid * 8192);
#pragma unroll
    for (int r = 0; r < 16; ++r) { const int orow = crow(r, hi);
#pragma unroll
        for (int d0 = 0; d0 < 4; ++d0) { const unsigned w = cvtpk(o[d0][r] * rli[r], 0.f); stg[orow * 128 + d0 * 32 + r32] = (unsigned short)(w & 0xffffu); } }
    asm volatile("s_waitcnt lgkmcnt(0)" ::: "memory");
    bf16_t* Ow = Ob + (long)(wid * QBLK) * LDO;
#pragma unroll
    for (int i = 0; i < 8; ++i) { const int id = lane + 64 * i, row = id >> 4, c16 = id & 15;
        const u32x4 v = *(const u32x4*)((const char*)stg + row * 256 + c16 * 16);
        *(u32x4*)(Ow + (long)row * LDO + c16 * 8) = v; }
    asm volatile("s_waitcnt lgkmcnt(0)" ::: "memory");
    __syncthreads();
#undef ATT_SLOAD
#undef ATT_SWRITE
#undef ATT_SWAIT
#undef ATT_RESC
}

template <int DQK, int LDQ, int LDK, int LDV, int LDO>
__device__ __forceinline__ void attn_body1(const bf16_t* __restrict__ Qb, const bf16_t* __restrict__ Kh, const bf16_t* __restrict__ Vh, bf16_t* __restrict__ Ob, int seq, char* lds, int tid_in) {
    using C_ = Cfg<DQK>;
    constexpr int SHM_K = C_::SHM_K, NCK = C_::NCK, C8 = C_::C8, ND0 = C_::ND0;
    int tid_ = tid_in; asm volatile("" : "+v"(tid_));
    const int tid = tid_, wid = tid >> 6, lane = tid & 63, r32 = lane & 31, hi = lane >> 5;
    char* V_lds = lds; char* K_lds = lds + 2 * SHM_V;
    float* ws = (float*)(lds + 2 * SHM_V + 2 * SHM_K) + wid * 64; float* li_l = ws; float* al_l = ws + 32;
    float m_reg = -1e30f, l_reg = 0; f32x16 o[4] = {}; bf16x8 qr[ND0];
    const bf16_t* Qw = Qb + (long)(wid * QBLK + r32) * LDQ + hi * 8;
#pragma unroll
    for (int d0 = 0; d0 < ND0; ++d0) qr[d0] = *reinterpret_cast<const bf16x8*>(Qw + d0 * 16);
    const int sr = tid >> 4, sc = (tid & 15) * 8, vst0 = v_st(sr, sc), vst1 = v_st(32 + sr, sc);
    int krow[NCK], kcol[NCK];
#pragma unroll
    for (int i = 0; i < NCK; ++i) { const int ci = tid + 512 * i; krow[i] = ci / C8; kcol[i] = (ci % C8) * 8; }
    const int vb0 = (int)(uintptr_t)V_lds + v_rd_base(lane);
    bf16x8 vs0, vs1, ks[NCK];
#define ATT1_SLOAD(k0) do { vs0 = *reinterpret_cast<const bf16x8*>(&Vh[(long)((k0) + sr) * LDV + sc]); vs1 = *reinterpret_cast<const bf16x8*>(&Vh[(long)((k0) + 32 + sr) * LDV + sc]); \
    _Pragma("unroll") for (int c_ = 0; c_ < NCK; ++c_) ks[c_] = *reinterpret_cast<const bf16x8*>(&Kh[(long)((k0) + krow[c_]) * LDK + kcol[c_]]); } while (0)
#define ATT1_SWRITE(b) do { *(bf16x8*)(V_lds + (b) * SHM_V + vst0) = vs0; *(bf16x8*)(V_lds + (b) * SHM_V + vst1) = vs1; \
    _Pragma("unroll") for (int c_ = 0; c_ < NCK; ++c_) *(bf16x8*)(K_lds + (b) * SHM_K + kswz<DQK>(krow[c_], kcol[c_] * 2)) = ks[c_]; } while (0)
    const int NT = seq / KVBLK;
    ATT1_SLOAD(0); asm volatile("s_waitcnt vmcnt(0)" ::: "memory"); ATT1_SWRITE(0); __syncthreads();
    for (int j = 0; j < NT; ++j) {
        const int b = j & 1;
        if (j + 1 < NT) ATT1_SLOAD((j + 1) * KVBLK);
        ATT_SBAR();
        f32x16 p0, p1; float mn, alpha; bf16x8 pa0, pa1, pa2, pa3;
        qkt<DQK>(p0, p1, K_lds + b * SHM_K, qr, r32, hi);
        partialSM<DQK>(p0, p1, m_reg, mn, alpha);
        if (__any(alpha < 1.f)) { if (hi == 0) al_l[r32] = alpha; asm volatile("s_waitcnt lgkmcnt(0)" ::: "memory");
#pragma unroll
            for (int d = 0; d < 4; ++d)
#pragma unroll
                for (int r = 0; r < 16; ++r) o[d][r] *= al_l[crow(r, hi)]; }
        finishSM(p0, p1, alpha, l_reg, pa0, pa1, pa2, pa3); ATT_SBAR();
        pv_d0(o, vb0 + b * (int)SHM_V, pa0, pa1, pa2, pa3);
        if (j + 1 < NT) { ATT1_SWRITE(b ^ 1); }
        __syncthreads();
    }
    if (hi == 0) li_l[r32] = l_reg;
    asm volatile("s_waitcnt lgkmcnt(0)" ::: "memory");
    __syncthreads();
    float rli[16];
#pragma unroll
    for (int r = 0; r < 16; ++r) rli[r] = __builtin_amdgcn_rcpf(li_l[crow(r, hi)]);
    unsigned short* stg = (unsigned short*)(lds + wid * 8192);
#pragma unroll
    for (int r = 0; r < 16; ++r) { const int orow = crow(r, hi);
#pragma unroll
        for (int d0 = 0; d0 < 4; ++d0) { const unsigned w = cvtpk(o[d0][r] * rli[r], 0.f); stg[orow * 128 + d0 * 32 + r32] = (unsigned short)(w & 0xffffu); } }
    asm volatile("s_waitcnt lgkmcnt(0)" ::: "memory");
    bf16_t* Ow = Ob + (long)(wid * QBLK) * LDO;
#pragma unroll
    for (int i = 0; i < 8; ++i) { const int id = lane + 64 * i, row = id >> 4, c16 = id & 15;
        const u32x4 v = *(const u32x4*)((const char*)stg + row * 256 + c16 * 16);
        *(u32x4*)(Ow + (long)row * LDO + c16 * 8) = v; }
    asm volatile("s_waitcnt lgkmcnt(0)" ::: "memory");
    __syncthreads();
#undef ATT1_SLOAD
#undef ATT1_SWRITE
}
}
constexpr int DM = 2048, NBATCH = 2, SEQ = 4096, CTX = 256, RB = SEQ + CTX  , MROWS = NBATCH * RB  ;
constexpr int NMOD = 6 * DM, NEXP = 16384;
constexpr float EPS = 1e-6f;
constexpr int NWAVES = 8, NTHREADS = 512;
constexpr size_t MiB = 1u << 20;
constexpr size_t WS_CTL = 0, CTL_ZERO_BYTES = 64 * 1024;
constexpr size_t WS_MOD = 1 * MiB;
constexpr size_t WS_ROPE = 2 * MiB;
constexpr size_t WS_SMALL = 3 * MiB;
constexpr int SM_N1G = 0, SM_N2G = 8192, SM_AQG = 16384, SM_AKG = 16384 + 384, SM_CW = 16384 + 768, SM_CB = SM_CW + 6144, SM_CQG = SM_CB + 2048, SM_CKG = SM_CQG + 256, SM_END = SM_CKG + 256;
constexpr size_t WS_PTRS = 3 * MiB + 512 * 1024;
constexpr size_t WS_XW = 4 * MiB;
constexpr size_t WS_H = 72 * MiB;
constexpr size_t WS_P = 106 * MiB;
constexpr size_t WS_QRAW = 174 * MiB;
constexpr size_t WS_KVRAW = 200 * MiB;
constexpr size_t WS_Q = 234 * MiB;
constexpr size_t WS_K = 268 * MiB;
constexpr size_t WS_V = 294 * MiB;
constexpr size_t WS_CAT = 311 * MiB;
constexpr size_t WS_PQ = 345 * MiB;
constexpr size_t WS_IDX = 379 * MiB;
constexpr size_t WS_GATE = 384 * MiB;
constexpr size_t WS_WIN = 389 * MiB;
constexpr size_t WS_WUQ = 421 * MiB;
constexpr size_t WS_WUKV = 424 * MiB;
constexpr size_t WS_WEO = 426 * MiB;
constexpr size_t WS_WQKV = 442 * MiB;
constexpr size_t WS_WCO = 466 * MiB;
constexpr size_t WS_WPQ = 482 * MiB;
constexpr size_t WS_SUBK = 514 * MiB;
#ifndef TAB_FP4
#define TAB_FP4 1
#endif
#if TAB_FP4
constexpr int ROWB = 1024;
#else
constexpr int ROWB = 1536;
#endif
constexpr size_t WS_U = 516 * MiB;
constexpr size_t WS_VT = 644 * MiB;
constexpr size_t WS_USC = 772 * MiB;
constexpr size_t WS_VSC = 773 * MiB;
constexpr size_t WS_PART = 774 * MiB;
constexpr size_t WS_END = 810 * MiB;
#ifndef EXP_SLICED
#define EXP_SLICED 1
#endif
constexpr int CW_BAR = 4096;
constexpr int LDS_MISC = 131072 + 8192;
constexpr int LDS_BYTES = 147456;

#define LAS __attribute__((address_space(3)))
typedef unsigned short bf16_t;
typedef float f32x4 __attribute__((ext_vector_type(4)));
typedef unsigned u32x4 __attribute__((ext_vector_type(4)));
typedef unsigned u32x2 __attribute__((ext_vector_type(2)));
typedef short bf16x8 __attribute__((ext_vector_type(8)));
typedef float f32x16 __attribute__((ext_vector_type(16)));
typedef __bf16 bf16x2_t __attribute__((ext_vector_type(2)));
typedef float f32x2 __attribute__((ext_vector_type(2)));
typedef _Float16 h2_t __attribute__((ext_vector_type(2)));
typedef float f32x32 __attribute__((ext_vector_type(32)));
typedef unsigned u32x6 __attribute__((ext_vector_type(6)));

__device__ __forceinline__ unsigned f2bf(float f) { unsigned u = __builtin_bit_cast(unsigned, f); return (u + 0x7fffu + ((u >> 16) & 1u)) >> 16; }
__device__ __forceinline__ unsigned pk2(float lo, float hi) { return f2bf(lo) | (f2bf(hi) << 16); }
__device__ __forceinline__ float bf_lo(unsigned w) { return __builtin_bit_cast(float, w << 16); }
__device__ __forceinline__ float bf_hi(unsigned w) { return __builtin_bit_cast(float, w & 0xffff0000u); }
__device__ __forceinline__ float bf2f(bf16_t h) { return __builtin_bit_cast(float, (unsigned)h << 16); }
__device__ __forceinline__ float wave_sum(float v) {
#pragma unroll
    for (int o = 1; o < 64; o <<= 1) v += __shfl_xor(v, o);
    return v;
}
#define DPP_ADD(v, ctrl) ((v) + __builtin_bit_cast(float, __builtin_amdgcn_update_dpp(0, __builtin_bit_cast(int, (v)), (ctrl), 0xf, 0xf, true)))
__device__ __forceinline__ float wave_sum_dpp(float v) {
    v = DPP_ADD(v, 0xB1);
    v = DPP_ADD(v, 0x4E);
    v = DPP_ADD(v, 0x141);
    v = DPP_ADD(v, 0x140);
    const int vi = __builtin_bit_cast(int, v);
    const float s0 = __builtin_bit_cast(float, __builtin_amdgcn_readlane(vi, 0)), s1 = __builtin_bit_cast(float, __builtin_amdgcn_readlane(vi, 16));
    const float s2 = __builtin_bit_cast(float, __builtin_amdgcn_readlane(vi, 32)), s3 = __builtin_bit_cast(float, __builtin_amdgcn_readlane(vi, 48));
    return (s0 + s1) + (s2 + s3);
}
__device__ __forceinline__ float dot2_bf16(unsigned w, unsigned x, float acc) { return __builtin_amdgcn_fdot2_f32_bf16(__builtin_bit_cast(bf16x2_t, w), __builtin_bit_cast(bf16x2_t, x), acc, false); }
__device__ __forceinline__ float gelu_erf(float v) {
    const float av = fabsf(v), t = __builtin_amdgcn_rcpf(av * 0.2316418882f + 1.0f);
    float q = t * 0.5307027145f + (-0.7265760135f); q = q * t + 0.7107068705f; q = q * t + (-0.142248368f); q = q * t + 0.127414796f; q = q * t;
    const float e = __builtin_amdgcn_exp2f((v * v) * (-0.72134752044f));
    const float m = v * (q * e);
    return v < 0.f ? m : v - m;
}
#define XB_TMO      128
#define XB_XCNT(j)  (256  + 64 * (j))
#define XB_XSUB(j)  (1280 + 64 * (j))
#define XB_XGEN(j)  (2304 + 64 * (j))
#define XB_TOP      3328
#define XB_TOPGEN   3392
#define XCD_BAR_WORDS 3456
#define XB_SPIN_CAP (1u << 18)

__device__ __forceinline__ unsigned xb_ld(unsigned* p)              { return __hip_atomic_load(p, __ATOMIC_RELAXED, __HIP_MEMORY_SCOPE_AGENT); }
__device__ __forceinline__ unsigned xb_add(unsigned* p, unsigned v) { return __hip_atomic_fetch_add(p, v, __ATOMIC_RELAXED, __HIP_MEMORY_SCOPE_AGENT); }
__device__ __forceinline__ unsigned xb_xcc_id() { return (unsigned)__builtin_amdgcn_s_getreg((3 << 11) | 20) & 0xFu; }
#define XB_SPIN(cond, bar) do { unsigned _sp = 0; while (cond) { __builtin_amdgcn_s_sleep(1); \
    if ((++_sp & 255u) == 0u) { if (xb_ld(&(bar)[XB_TMO])) break; if (_sp > XB_SPIN_CAP) { atomicAdd(&(bar)[XB_TMO], 1u); break; } } } } while (0)

struct XcdBarrier {
    unsigned* bar; unsigned x;
    volatile LAS unsigned* st;
};

__device__ __forceinline__ XcdBarrier xcd_barrier_post(unsigned* bar, volatile LAS unsigned* st) {
    XcdBarrier b; b.bar = bar; b.x = xb_xcc_id(); b.st = st;
    if (threadIdx.x == 0) (void)xb_add(&bar[XB_XCNT(b.x)], 1u);
    return b;
}
__device__ __forceinline__ void xcd_barrier_complete(unsigned* bar, unsigned x, unsigned& nloc, unsigned& nx) {
    const unsigned G = gridDim.x * gridDim.y * gridDim.z;
    unsigned sum, cnt, mine, sp = 0u;
    for (;;) {
        sum = 0u; cnt = 0u; mine = 0u;
#pragma unroll
        for (unsigned j = 0; j < 16; ++j) { const unsigned c = xb_ld(&bar[XB_XCNT(j)]); sum += c; cnt += (c > 0u) ? 1u : 0u; mine = (j == x) ? c : mine; }
        if (sum == G) break;
        __builtin_amdgcn_s_sleep(1);
        if ((++sp & 255u) == 0u) { if (xb_ld(&bar[XB_TMO])) break; if (sp > XB_SPIN_CAP) { atomicAdd(&bar[XB_TMO], 1u); break; } }
    }
    nloc = mine > 0u ? mine : 1u; nx = cnt > 0u ? cnt : 1u;
}

__device__ __forceinline__ void xcd_barrier(const XcdBarrier& b) {
    asm volatile("s_waitcnt vmcnt(0)" ::: "memory");
    __syncthreads();
    if (threadIdx.x == 0) {
        unsigned* bar = b.bar; unsigned bx = b.x;
        asm volatile("" : "+s"(bar), "+s"(bx));
        __builtin_amdgcn_s_waitcnt(0);
        unsigned nloc = b.st[0], nx = b.st[1];
        if (nloc == 0u) { xcd_barrier_complete(bar, bx, nloc, nx); b.st[0] = nloc; b.st[1] = nx; }
        const unsigned old = xb_add(&bar[XB_XSUB(bx)], 1u);
        const unsigned gen = old / nloc;
        if (old + 1u == (gen + 1u) * nloc) {
            __builtin_amdgcn_fence(__ATOMIC_RELEASE, "agent");
            asm volatile("s_waitcnt vmcnt(0)" ::: "memory");
            const unsigned og = xb_add(&bar[XB_TOP], 1u);
            const unsigned tg = og / nx;
            if (og + 1u == (tg + 1u) * nx) xb_add(&bar[XB_TOPGEN], 1u);
            else XB_SPIN(xb_ld(&bar[XB_TOPGEN]) == tg, bar);
            __builtin_amdgcn_fence(__ATOMIC_ACQUIRE, "agent");
            xb_add(&bar[XB_XGEN(bx)], 1u);
            asm volatile("s_waitcnt vmcnt(0)" ::: "memory");
        } else {
            XB_SPIN(xb_ld(&bar[XB_XGEN(bx)]) == gen, bar);
            __builtin_amdgcn_fence(__ATOMIC_ACQUIRE, "agent");
            asm volatile("s_waitcnt vmcnt(0)" ::: "memory");
        }
    }
    __syncthreads();
}
struct Frame {
    LAS unsigned char* lds;
    int tid, lane, wave, vcu, G, gw, NGW;
    unsigned char* ws;
};
__device__ __forceinline__ int opaque_v(int v) { asm volatile("" : "+v"(v)); return v; }
__device__ __forceinline__ int phase_tid(int wave) { int lane; asm volatile("v_mbcnt_lo_u32_b32 %0, -1, 0\n\tv_mbcnt_hi_u32_b32 %0, -1, %0" : "=v"(lane)); return wave * 64 + lane; }
__device__ __forceinline__ Frame phase_frame(const Frame& F0) { Frame F = F0; F.tid = phase_tid(F0.wave); F.lane = F.tid & 63; return F; }
__device__ __forceinline__ float swap32(float v, int lane) { auto rr = __builtin_amdgcn_permlane32_swap(__float_as_uint(v), __float_as_uint(v), false, false); return __uint_as_float(lane < 32 ? rr[1] : rr[0]); }
__device__ __forceinline__ int row_cls(int row) { const int b = row / RB, i = row - b * RB; return i < CTX ? 2 : b; }

__device__ __forceinline__ void p0_transpose_item(const float* W, int K, int N, bf16_t* WT, const float* gain, LAS float* scr, int item, int lane, bool perm_q = false) {
    const int nblk = N / 32, kb = item / nblk, nb = item % nblk, k0 = 64 * kb, n0 = 32 * nb;
    {
        const int rgp = lane >> 3, c4 = (lane & 7) * 4; f32x4 tv[8];
#pragma unroll
        for (int i = 0; i < 8; ++i) tv[i] = *(const f32x4*)(W + (size_t)(k0 + 8 * i + rgp) * N + n0 + c4);
#pragma unroll
        for (int i = 0; i < 8; ++i) { const int kk = 8 * i + rgp; f32x4 v = tv[i]; if (gain) v = v * gain[k0 + kk];
            LAS float* d = scr + kk * 33 + c4; d[0] = v.x; d[1] = v.y; d[2] = v.z; d[3] = v.w; }
    }
    asm volatile("s_waitcnt lgkmcnt(0)" ::: "memory");
    const int c = lane & 7;
#pragma unroll
    for (int j = 0; j < 4; ++j) { const int n = (lane >> 3) + 8 * j; const LAS float* s = scr + (8 * c) * 33 + n;
        u32x4 o; o.x = pk2(s[0 * 33], s[1 * 33]); o.y = pk2(s[2 * 33], s[3 * 33]); o.z = pk2(s[4 * 33], s[5 * 33]); o.w = pk2(s[6 * 33], s[7 * 33]);
        int nn = n0 + n; if (perm_q) { const int hh = nn / 192, e = nn - hh * 192; nn = (e < 128) ? hh * 128 + e : 1024 + hh * 64 + (e - 128); }
        *(u32x4*)(WT + (size_t)nn * K + k0 + 8 * c) = o; }
    asm volatile("s_waitcnt lgkmcnt(0)" ::: "memory");
}
struct TrDesc { const float* W; const float* gain; bf16_t* WT; int K, N, items; };

__device__ __forceinline__ void p0_gemv_task(Frame& F, int task, const float* ada_w, const float* ada_b, float* mod) {
    LAS float* sv = (LAS float*)F.lds; LAS float* part = (LAS float*)(F.lds + 32768);
    const int l = task / 192, n0 = (task % 192) * 64, rg = F.lane >> 4, c4 = (F.lane & 15) * 4;
    const float* Wp = ada_w + (size_t)l * DM * NMOD + n0 + c4 + (size_t)(F.wave * 256 + rg) * NMOD;
    f32x4 a0 = {0, 0, 0, 0}, a1 = a0, a2 = a0;
    for (int k = 0; k < 256; k += 32) {
        f32x4 w[8];
#pragma unroll
        for (int u = 0; u < 8; ++u) w[u] = *(const f32x4*)(Wp + (size_t)(k + 4 * u) * NMOD);
#pragma unroll
        for (int u = 0; u < 8; ++u) { const int kk = F.wave * 256 + k + 4 * u + rg; const float s0 = sv[kk], s1 = sv[2048 + kk], s2 = sv[4096 + kk];
            a0 += w[u] * s0; a1 += w[u] * s1; a2 += w[u] * s2; }
    }
    LAS float* pp = part + ((F.wave * 4 + rg) * 3) * 64 + c4;
    *(LAS f32x4*)(pp) = a0; *(LAS f32x4*)(pp + 64) = a1; *(LAS f32x4*)(pp + 128) = a2;
    __syncthreads();
    if (F.tid < 192) { const int r = F.tid >> 6, c = F.tid & 63; float s = 0.f;
#pragma unroll
        for (int q = 0; q < 32; ++q) s += part[(q * 3 + r) * 64 + c];
        mod[(size_t)(l * 3 + r) * NMOD + n0 + c] = s + ada_b[(size_t)l * NMOD + n0 + c]; }
    __syncthreads();
}

__device__ __forceinline__ void p0_prologue(Frame& F, const float* const* in) {
    unsigned char* ws = F.ws;
    {
        LAS float* sv = (LAS float*)F.lds;
        for (int i = F.tid; i < 3 * DM; i += NTHREADS) { const int r = i / DM, k = i - r * DM; const float x = (r < 2) ? in[1][r * DM + k] : in[3][k]; sv[i] = x / (1.f + __expf(-x)); }
        __syncthreads();
        for (int task = F.vcu; task < 768; task += F.G) p0_gemv_task(F, task, in[4], in[5], (float*)(ws + WS_MOD));
        __syncthreads();
    }
    {
        float* xw = (float*)(ws + WS_XW);
        for (int row = F.gw; row < MROWS; row += F.NGW) { const int b = row / RB, i = row - b * RB;
            const float* src = (i < CTX) ? in[2] + (size_t)(b * CTX + i) * DM : in[0] + (size_t)(b * SEQ + i - CTX) * DM;
            const f32x4* s4 = (const f32x4*)src + F.lane; f32x4* d4 = (f32x4*)(xw + (size_t)row * DM) + F.lane;
#pragma unroll
            for (int j = 0; j < 8; ++j) d4[64 * j] = s4[64 * j]; }
    }
    {
        float* sm = (float*)(ws + WS_SMALL); const int g = F.vcu * NTHREADS + F.tid;
        if (g < 8192) { sm[SM_N1G + g] = in[6][g]; sm[SM_N2G + g] = in[7][g]; }
        if (g < 384) { sm[SM_AQG + g] = in[13][g]; sm[SM_AKG + g] = in[14][g]; }
        if (g < 6144) sm[SM_CW + g] = in[15][g];
        if (g < 2048) sm[SM_CB + g] = in[16][g];
        if (g < 256) { sm[SM_CQG + g] = in[19][g]; sm[SM_CKG + g] = in[20][g]; }
    }
    {
        float* rc = (float*)(ws + WS_ROPE); float* ra = rc + 64 * 32 * 2;
        const int g = F.vcu * NTHREADS + F.tid;
        if (g < 64 * 32) { const int pos = g >> 5, f = g & 31; const float fr = exp2f(-(float)f * (13.287712379549449f / 32.f)); const float ang = (float)pos * fr;
            rc[2 * g] = cosf(ang); rc[2 * g + 1] = sinf(ang); }
        else if (g < 64 * 32 + 64 * 16) { const int e = g - 64 * 32, pos = e >> 4, f = e & 15; const float fr = exp2f(-(float)f * (13.287712379549449f / 16.f)); const float ang = (float)pos * fr;
            ra[2 * e] = cosf(ang); ra[2 * e + 1] = sinf(ang); }
    }
    {
        LAS float* scr = (LAS float*)(F.lds + F.wave * 16384);
        TrDesc d[16]; int nd = 0;
#pragma unroll
        for (int i = 0; i < 2; ++i) {
            d[nd++] = TrDesc{in[8] + (size_t)i * DM * 3904, nullptr, (bf16_t*)(ws + WS_WIN) + (size_t)i * 4096 * DM, DM, 3904, 32 * 122};
            d[nd++] = TrDesc{in[11] + (size_t)i * 512 * 1536, in[9] + i * 512, (bf16_t*)(ws + WS_WUQ) + (size_t)i * 1536 * 512, 512, 1536, 8 * 48};
            d[nd++] = TrDesc{in[12] + (size_t)i * 256 * 2048, in[10] + i * 256, (bf16_t*)(ws + WS_WUKV) + (size_t)i * 2048 * 256, 256, 2048, 4 * 64};
            d[nd++] = TrDesc{in[17] + (size_t)i * DM * DM, nullptr, (bf16_t*)(ws + WS_WEO) + (size_t)i * DM * DM, DM, DM, 32 * 64};
            d[nd++] = TrDesc{in[18] + (size_t)i * DM * 3072, nullptr, (bf16_t*)(ws + WS_WQKV) + (size_t)i * 3072 * DM, DM, 3072, 32 * 96};
            d[nd++] = TrDesc{in[21] + (size_t)i * DM * DM, nullptr, (bf16_t*)(ws + WS_WCO) + (size_t)i * DM * DM, DM, DM, 32 * 64};
        }
#pragma unroll
        for (int l = 0; l < 4; ++l) d[nd++] = TrDesc{in[22] + (size_t)l * DM * DM, nullptr, (bf16_t*)(ws + WS_WPQ) + (size_t)l * DM * DM, DM, DM, 32 * 64};
#pragma unroll
        for (int m = 0; m < 16; ++m) {
            for (int it = F.gw; it < d[m].items; it += F.NGW) p0_transpose_item(d[m].W, d[m].K, d[m].N, d[m].WT, d[m].gain, scr, it, F.lane, d[m].K == 512);
        }
        for (int i = F.gw * 64 + F.lane; i < 2 * 192 * DM / 8; i += F.NGW * 64) { const int li = i / (192 * DM / 8), r = i % (192 * DM / 8);
            *(u32x4*)((bf16_t*)(ws + WS_WIN) + (size_t)li * 4096 * DM + (size_t)3904 * DM + (size_t)r * 8) = (u32x4){0u, 0u, 0u, 0u}; }
    }
    {
        const size_t n_sk = (size_t)4 * 16 * 128 * 128 / 8;
        const size_t gt = (size_t)F.vcu * NTHREADS + F.tid, GT = (size_t)F.G * NTHREADS;
        for (size_t j = gt; j < n_sk; j += GT) {
            const f32x4 a = *(const f32x4*)(in[23] + j * 8), b = *(const f32x4*)(in[23] + j * 8 + 4);
            u32x4 o; o.x = pk2(a.x, a.y); o.y = pk2(a.z, a.w); o.z = pk2(b.x, b.y); o.w = pk2(b.z, b.w);
            *(u32x4*)((bf16_t*)(ws + WS_SUBK) + j * 8) = o;
        }
    }
    {
        for (int r = F.gw; r < 2 * 4 * NEXP; r += F.NGW) {
            const int tab = r / (4 * NEXP), rr = r - tab * (4 * NEXP);
#if EXP_SLICED
            const float* src = (tab ? in[25] : in[24]) + (size_t)rr * DM + F.lane * 32;
            f32x4 v[8];
#pragma unroll
            for (int q = 0; q < 8; ++q) v[q] = *(const f32x4*)(src + q * 4);
#else
            const float* src = (tab ? in[25] : in[24]) + (size_t)rr * DM + F.lane * 16;
            f32x4 v[8];
#pragma unroll
            for (int j = 0; j < 2; ++j)
#pragma unroll
                for (int q = 0; q < 4; ++q) v[j * 4 + q] = *(const f32x4*)(src + j * 1024 + q * 4);
#endif
            float am = 0.f;
#pragma unroll
            for (int q = 0; q < 8; ++q) am = fmaxf(fmaxf(am, fmaxf(fabsf(v[q].x), fabsf(v[q].y))), fmaxf(fabsf(v[q].z), fabsf(v[q].w)));
#pragma unroll
            for (int o = 1; o < 64; o <<= 1) am = fmaxf(am, __shfl_xor(am, o));
            am = fmaxf(am, 1e-30f);
#if TAB_FP4
            float ssq = 0.f;
#pragma unroll
            for (int q = 0; q < 8; ++q) ssq += (v[q].x * v[q].x + v[q].y * v[q].y) + (v[q].z * v[q].z + v[q].w * v[q].w);
#pragma unroll
            for (int o = 1; o < 64; o <<= 1) ssq += __shfl_xor(ssq, o);
            const float sig = fmaxf(sqrtf(ssq * (1.f / DM)), am * (1.f / 64.f));
            const float sc = 2.0f / sig;
            unsigned w4[4];
#pragma unroll
            for (int q = 0; q < 4; ++q) { unsigned t = 0u;
                const f32x4 xa = v[2 * q] * sc, xb = v[2 * q + 1] * sc;
#define P0_C6(x) fminf(fmaxf((x), -6.f), 6.f)
                t = __builtin_amdgcn_cvt_scalef32_pk_fp4_f32(t, P0_C6(xa.x), P0_C6(xa.y), 1.0f, 0);
                t = __builtin_amdgcn_cvt_scalef32_pk_fp4_f32(t, P0_C6(xa.z), P0_C6(xa.w), 1.0f, 1);
                t = __builtin_amdgcn_cvt_scalef32_pk_fp4_f32(t, P0_C6(xb.x), P0_C6(xb.y), 1.0f, 2);
                t = __builtin_amdgcn_cvt_scalef32_pk_fp4_f32(t, P0_C6(xb.z), P0_C6(xb.w), 1.0f, 3);
#undef P0_C6
                w4[q] = t; }
#if EXP_SLICED
            { const int ll = rr / NEXP, ee = rr - ll * NEXP;
              *(u32x4*)(ws + (tab ? WS_VT : WS_U) + (size_t)ll * NEXP * ROWB + (size_t)(F.lane >> 3) * (NEXP * 128) + (size_t)ee * 128 + (F.lane & 7) * 16) = (u32x4){w4[0], w4[1], w4[2], w4[3]}; }
#else
            *(u32x4*)(ws + (tab ? WS_VT : WS_U) + (size_t)rr * ROWB + F.lane * 16) = (u32x4){w4[0], w4[1], w4[2], w4[3]};
#endif
            if (F.lane == 0) ((float*)(ws + (tab ? WS_VSC : WS_USC)))[rr] = sig * 0.5f;
#else
            const float sc = 7.5f / am;
            f32x16 a, b;
#pragma unroll
            for (int q = 0; q < 8; ++q) { const f32x4 x = v[q] * sc; a[2 * q] = x.x; b[2 * q] = x.y; a[2 * q + 1] = x.z; b[2 * q + 1] = x.w; }
            const u32x6 w = __builtin_amdgcn_cvt_scalef32_2xpk16_fp6_f32(a, b, 1.0f);
            unsigned char* dst = ws + (tab ? WS_VT : WS_U) + (size_t)rr * ROWB;
            *(u32x4*)(dst + F.lane * 16) = (u32x4){w[0], w[1], w[2], w[3]};
            *(u32x2*)(dst + 1024 + F.lane * 8) = (u32x2){w[4], w[5]};
            if (F.lane == 0) ((float*)(ws + (tab ? WS_VSC : WS_USC)))[rr] = am * (1.0f / 7.5f);
#endif
        }
    }
}

__device__ __forceinline__ void norm_phase(const Frame& F0, const float* xw, const float* g, const float* modl  , int off_sh, int off_sc, bf16_t* H, bool lat_only) {
    const Frame F = phase_frame(F0);
    f32x4 gm[8], shv[8]; int cur_cls = -1;
    int row = F.gw; if (lat_only) while (row < MROWS && row_cls(row) == 2) row += F.NGW;
    f32x4 v[8];
    if (row < MROWS) { const f32x4* x4 = (const f32x4*)(xw + (size_t)row * DM) + F.lane;
#pragma unroll
        for (int j = 0; j < 8; ++j) v[j] = x4[64 * j]; }
    while (row < MROWS) {
        int nrow = row + F.NGW; if (lat_only) while (nrow < MROWS && row_cls(nrow) == 2) nrow += F.NGW;
        f32x4 vn[8];
        if (nrow < MROWS) { const f32x4* x4 = (const f32x4*)(xw + (size_t)nrow * DM) + F.lane;
#pragma unroll
            for (int j = 0; j < 8; ++j) vn[j] = x4[64 * j]; }
        const int cls = row_cls(row);
        if (cls != cur_cls) {
            cur_cls = cls;
            const f32x4* g4 = (const f32x4*)g + F.lane; const f32x4* sc4 = (const f32x4*)(modl + (size_t)cls * NMOD + off_sc) + F.lane; const f32x4* sh4 = (const f32x4*)(modl + (size_t)cls * NMOD + off_sh) + F.lane;
#pragma unroll
            for (int j = 0; j < 8; ++j) { gm[j] = g4[64 * j] * (sc4[64 * j] + 1.0f); shv[j] = sh4[64 * j]; }
        }
        float ss = 0.f;
#pragma unroll
        for (int j = 0; j < 8; ++j) ss += (v[j].x * v[j].x + v[j].y * v[j].y) + (v[j].z * v[j].z + v[j].w * v[j].w);
        const float rstd = 1.0f / sqrtf(wave_sum_dpp(ss) * (1.f / DM) + EPS);
        u32x2* o2 = (u32x2*)(H + (size_t)row * DM) + F.lane;
#pragma unroll
        for (int j = 0; j < 8; ++j) { const f32x4 y = (v[j] * rstd) * gm[j] + shv[j]; u32x2 o; o.x = pk2(y.x, y.y); o.y = pk2(y.z, y.w); o2[64 * j] = o; }
        row = nrow;
#pragma unroll
        for (int j = 0; j < 8; ++j) v[j] = vn[j];
    }
}

#define DPP_MOV(v, ctrl) __builtin_bit_cast(float, __builtin_amdgcn_update_dpp(0, __builtin_bit_cast(int, (v)), (ctrl), 0xf, 0xf, true))
__device__ __forceinline__ float row16_sum(float v) { v = DPP_ADD(v, 0xB1); v = DPP_ADD(v, 0x4E); v = DPP_ADD(v, 0x141); v = DPP_ADD(v, 0x140); return v; }
__device__ __forceinline__ void prep_odd_phase(const Frame& F0, const bf16_t* P, const float* qg, const float* kg, const float* rope_c, bf16_t* Q, bf16_t* Kb) {
    const Frame F = phase_frame(F0);
    const int l16 = F.lane & 15, d0 = l16 * 8;
    float gq[8], gk[8];
#pragma unroll
    for (int e = 0; e < 8; ++e) { gq[e] = qg[d0 + e]; gk[e] = kg[d0 + e]; }
    const bool lowhalf = l16 < 8;
    const int j0 = (l16 & 7) * 8;
    int row = F.gw;
    u32x4 w[5];
    if (row < MROWS) { const u32x4* pr = (const u32x4*)(P + (size_t)row * 3072) + F.lane;
#pragma unroll
        for (int k = 0; k < 5; ++k) w[k] = pr[64 * k]; }
    while (row < MROWS) {
        const int nrow = row + F.NGW;
        u32x4 wn[5];
        if (nrow < MROWS) { const u32x4* pr = (const u32x4*)(P + (size_t)nrow * 3072) + F.lane;
#pragma unroll
            for (int k = 0; k < 5; ++k) wn[k] = pr[64 * k]; }
        const int b = row / RB, i = row - b * RB; const bool lat = i >= CTX; const int t = i - CTX;
        float cs[8], sn[8];
#pragma unroll
        for (int e = 0; e < 8; ++e) { cs[e] = 1.f; sn[e] = 0.f; }
        if (lat) { const int pos = (j0 < 32) ? (t >> 6) : (t & 63); const f32x4* tb = (const f32x4*)(rope_c + ((pos << 5) + (j0 & 31)) * 2);
#pragma unroll
            for (int q = 0; q < 4; ++q) { const f32x4 c = tb[q]; cs[2 * q] = c.x; sn[2 * q] = c.y; cs[2 * q + 1] = c.z; sn[2 * q + 1] = c.w; } }
#pragma unroll
        for (int k = 0; k < 5; ++k) {
            const unsigned ww[4] = {w[k].x, w[k].y, w[k].z, w[k].w};
            float x[8]; float ss = 0.f;
#pragma unroll
            for (int q = 0; q < 4; ++q) { x[2 * q] = bf_lo(ww[q]); x[2 * q + 1] = bf_hi(ww[q]); ss += x[2 * q] * x[2 * q] + x[2 * q + 1] * x[2 * q + 1]; }
            const float rstd = 1.0f / sqrtf(row16_sum(ss) * (1.f / 128.f) + EPS);
            unsigned ow[4]; float o[8];
#pragma unroll
            for (int e = 0; e < 8; ++e) { const float y = x[e] * rstd * (k < 4 ? gq[e] : gk[e]); const float yp = DPP_MOV(y, 0x128);
                o[e] = lowhalf ? (y * cs[e] - yp * sn[e]) : (y * cs[e] + yp * sn[e]); }
#pragma unroll
            for (int q = 0; q < 4; ++q) ow[q] = pk2(o[2 * q], o[2 * q + 1]);
            if (k < 4) *((u32x4*)(Q + (size_t)row * 2048) + 64 * k + F.lane) = (u32x4){ow[0], ow[1], ow[2], ow[3]};
            else *((u32x4*)(Kb + (size_t)row * 512) + F.lane) = (u32x4){ow[0], ow[1], ow[2], ow[3]};
        }
        row = nrow;
#pragma unroll
        for (int k = 0; k < 5; ++k) w[k] = wn[k];
    }
}

struct PrepEvenRow { u32x4 cq; u32x2 ckv, kr; u32x4 qn[2]; u32x2 qr[2]; u32x4 kn[2], vv[2]; };
__device__ __forceinline__ void prep_even_load(PrepEvenRow& R, const bf16_t* P, const bf16_t* QR, const bf16_t* KVR, int row, int lane) {
    const bf16_t* pr = P + (size_t)row * 4096; const int l16 = lane & 15, hq = lane >> 4;
    R.cq = *((const u32x4*)pr + lane); R.ckv = *((const u32x2*)(pr + 512) + lane); R.kr = *((const u32x2*)(pr + 768) + l16);
    const bf16_t* q = QR + (size_t)row * 1536; const bf16_t* kv = KVR + (size_t)row * 2048;
#pragma unroll
    for (int k = 0; k < 2; ++k) { R.qn[k] = *((const u32x4*)q + 64 * k + lane); R.qr[k] = *((const u32x2*)(q + 1024) + 64 * k + lane);
        const bf16_t* kh = kv + (4 * k + hq) * 256 + l16 * 8; R.kn[k] = *(const u32x4*)kh; R.vv[k] = *(const u32x4*)(kh + 128); }
}
__device__ __forceinline__ void prep_even_phase(const Frame& F0, const bf16_t* P, const bf16_t* QR, const bf16_t* KVR, const float* qg, const float* kg, const float* rope_a, bf16_t* Q, bf16_t* Kb, bf16_t* Vb) {
    const Frame F = phase_frame(F0);
    const int lane = F.lane, l16 = lane & 15, hq = lane >> 4, d0 = l16 * 8, r0 = l16 * 4;
    float gqn[8], gkn[8], gqr[4], gkr[4];
#pragma unroll
    for (int e = 0; e < 8; ++e) { gqn[e] = qg[d0 + e]; gkn[e] = kg[d0 + e]; }
#pragma unroll
    for (int e = 0; e < 4; ++e) { gqr[e] = qg[128 + r0 + e]; gkr[e] = kg[128 + r0 + e]; }
    const bool lowhalf = l16 < 8; const int j0 = (l16 & 7) * 4;
    int row = F.gw;
    PrepEvenRow R;
    if (row < MROWS) prep_even_load(R, P, QR, KVR, row, lane);
    while (row < MROWS) {
        const int nrow = row + F.NGW;
        PrepEvenRow Rn;
        if (nrow < MROWS) prep_even_load(Rn, P, QR, KVR, nrow, lane);
        const int b = row / RB, i = row - b * RB; const bool lat = i >= CTX; const int t = i - CTX;
        float cs[4], sn[4];
#pragma unroll
        for (int e = 0; e < 4; ++e) { cs[e] = 1.f; sn[e] = 0.f; }
        if (lat) { const int pos = (j0 < 16) ? (t >> 6) : (t & 63); const f32x4* tb = (const f32x4*)(rope_a + ((pos << 4) + (j0 & 15)) * 2);
            const f32x4 c0 = tb[0], c1 = tb[1]; cs[0] = c0.x; sn[0] = c0.y; cs[1] = c0.z; sn[1] = c0.w; cs[2] = c1.x; sn[2] = c1.y; cs[3] = c1.z; sn[3] = c1.w; }
        float ssq = 0.f, sskv = 0.f;
        { const unsigned ww[4] = {R.cq.x, R.cq.y, R.cq.z, R.cq.w};
#pragma unroll
          for (int q = 0; q < 4; ++q) { const float a = bf_lo(ww[q]), c = bf_hi(ww[q]); ssq += a * a + c * c; } }
        { const float a = bf_lo(R.ckv.x), c = bf_hi(R.ckv.x), d = bf_lo(R.ckv.y), e = bf_hi(R.ckv.y); sskv = (a * a + c * c) + (d * d + e * e); }
        const float rstd_q = 1.0f / sqrtf(wave_sum_dpp(ssq) * (1.f / 512.f) + EPS), rstd_kv = 1.0f / sqrtf(wave_sum_dpp(sskv) * (1.f / 256.f) + EPS);
        const float krv[4] = {bf_lo(R.kr.x), bf_hi(R.kr.x), bf_lo(R.kr.y), bf_hi(R.kr.y)};
        const float krss = (krv[0] * krv[0] + krv[1] * krv[1]) + (krv[2] * krv[2] + krv[3] * krv[3]);
#pragma unroll
        for (int k = 0; k < 2; ++k) {
            const int h = 4 * k + hq;
            {
                const unsigned wn[4] = {R.qn[k].x, R.qn[k].y, R.qn[k].z, R.qn[k].w};
                float xn[8], xr[4]; float ss = 0.f;
#pragma unroll
                for (int q = 0; q < 4; ++q) { xn[2 * q] = bf_lo(wn[q]) * rstd_q; xn[2 * q + 1] = bf_hi(wn[q]) * rstd_q; ss += xn[2 * q] * xn[2 * q] + xn[2 * q + 1] * xn[2 * q + 1]; }
                xr[0] = bf_lo(R.qr[k].x) * rstd_q; xr[1] = bf_hi(R.qr[k].x) * rstd_q; xr[2] = bf_lo(R.qr[k].y) * rstd_q; xr[3] = bf_hi(R.qr[k].y) * rstd_q;
                ss += (xr[0] * xr[0] + xr[1] * xr[1]) + (xr[2] * xr[2] + xr[3] * xr[3]);
                const float r2 = 1.0f / sqrtf(row16_sum(ss) * (1.f / 192.f) + EPS);
                unsigned on[4]; float o[4];
#pragma unroll
                for (int q = 0; q < 4; ++q) on[q] = pk2(xn[2 * q] * r2 * gqn[2 * q], xn[2 * q + 1] * r2 * gqn[2 * q + 1]);
#pragma unroll
                for (int e = 0; e < 4; ++e) { const float y = xr[e] * r2 * gqr[e]; const float yp = DPP_MOV(y, 0x128); o[e] = lowhalf ? (y * cs[e] - yp * sn[e]) : (y * cs[e] + yp * sn[e]); }
                bf16_t* qo = Q + (size_t)row * 1536 + h * 192;
                *(u32x4*)(qo + d0) = (u32x4){on[0], on[1], on[2], on[3]};
                *(u32x2*)(qo + 128 + r0) = (u32x2){pk2(o[0], o[1]), pk2(o[2], o[3])};
            }
            {
                const unsigned wn[4] = {R.kn[k].x, R.kn[k].y, R.kn[k].z, R.kn[k].w}, wv[4] = {R.vv[k].x, R.vv[k].y, R.vv[k].z, R.vv[k].w};
                float xn[8]; float ss = krss;
#pragma unroll
                for (int q = 0; q < 4; ++q) { xn[2 * q] = bf_lo(wn[q]) * rstd_kv; xn[2 * q + 1] = bf_hi(wn[q]) * rstd_kv; ss += xn[2 * q] * xn[2 * q] + xn[2 * q + 1] * xn[2 * q + 1]; }
                const float r2 = 1.0f / sqrtf(row16_sum(ss) * (1.f / 192.f) + EPS);
                unsigned on[4], ov[4]; float o[4];
#pragma unroll
                for (int q = 0; q < 4; ++q) { on[q] = pk2(xn[2 * q] * r2 * gkn[2 * q], xn[2 * q + 1] * r2 * gkn[2 * q + 1]); ov[q] = pk2(bf_lo(wv[q]) * rstd_kv, bf_hi(wv[q]) * rstd_kv); }
#pragma unroll
                for (int e = 0; e < 4; ++e) { const float y = krv[e] * r2 * gkr[e]; const float yp = DPP_MOV(y, 0x128); o[e] = lowhalf ? (y * cs[e] - yp * sn[e]) : (y * cs[e] + yp * sn[e]); }
                bf16_t* ko = Kb + (size_t)row * 1536 + h * 192;
                *(u32x4*)(ko + d0) = (u32x4){on[0], on[1], on[2], on[3]};
                *(u32x2*)(ko + 128 + r0) = (u32x2){pk2(o[0], o[1]), pk2(o[2], o[3])};
                *(u32x4*)(Vb + (size_t)row * 1024 + h * 128 + d0) = (u32x4){ov[0], ov[1], ov[2], ov[3]};
            }
        }
        row = nrow; R = Rn;
    }
}

__device__ __forceinline__ void conv_phase(const Frame& F0, const bf16_t* P, const float* cw  , const float* cb  , bf16_t* CAT) {
    const Frame F = phase_frame(F0);
    const int gt = F.vcu * NTHREADS + F.tid, GT = F.G * NTHREADS;
    for (int it = gt; it < MROWS * 128; it += GT) {
        const int row = it >> 7, c0 = (it & 127) * 8; const int b = row / RB, i = row - b * RB;
        const bool first = (i == 0) || (i == CTX), last = (i == CTX - 1) || (i == RB - 1);
        const bf16_t* pr = P + (size_t)row * 4096 + 832 + c0;
        const u32x4 bg = *(const u32x4*)pr, cg = *(const u32x4*)(pr + 1024), hz = *(const u32x4*)(pr + 2048);
        u32x4 cgm = {0u, 0u, 0u, 0u}, hzm = cgm, cgp = cgm, hzp = cgm;
        if (!first) { cgm = *(const u32x4*)(pr - 4096 + 1024); hzm = *(const u32x4*)(pr - 4096 + 2048); }
        if (!last) { cgp = *(const u32x4*)(pr + 4096 + 1024); hzp = *(const u32x4*)(pr + 4096 + 2048); }
        const unsigned bgw[4] = {bg.x, bg.y, bg.z, bg.w}, cgw[4] = {cg.x, cg.y, cg.z, cg.w}, hzw[4] = {hz.x, hz.y, hz.z, hz.w};
        const unsigned cmw[4] = {cgm.x, cgm.y, cgm.z, cgm.w}, hmw[4] = {hzm.x, hzm.y, hzm.z, hzm.w}, cpw[4] = {cgp.x, cgp.y, cgp.z, cgp.w}, hpw[4] = {hzp.x, hzp.y, hzp.z, hzp.w};
        unsigned ow[4];
#pragma unroll
        for (int q = 0; q < 4; ++q) {
            const int c = c0 + 2 * q;
            const float u0a = bf_lo(cgw[q]) * bf_lo(hzw[q]), u0b = bf_hi(cgw[q]) * bf_hi(hzw[q]);
            const float uma = bf_lo(cmw[q]) * bf_lo(hmw[q]), umb = bf_hi(cmw[q]) * bf_hi(hmw[q]);
            const float upa = bf_lo(cpw[q]) * bf_lo(hpw[q]), upb = bf_hi(cpw[q]) * bf_hi(hpw[q]);
            const float ra = bf_lo(bgw[q]) * (uma * cw[c] + u0a * cw[1024 + c] + upa * cw[2048 + c] + cb[c]);
            const float rb = bf_hi(bgw[q]) * (umb * cw[c + 1] + u0b * cw[1024 + c + 1] + upb * cw[2048 + c + 1] + cb[c + 1]);
            ow[q] = pk2(ra, rb);
        }
        *(u32x4*)(CAT + (size_t)row * DM + 1024 + c0) = (u32x4){ow[0], ow[1], ow[2], ow[3]};
    }
}
__device__ __forceinline__ void attn_even_phase(const Frame& F0, const bf16_t* Q, const bf16_t* Kb, const bf16_t* Vb, bf16_t* CAT) {
    const Frame F = phase_frame(F0);
    for (int u = F.vcu; u < 272; u += F.G) {
        int b, h, qt, nk;
        if (u < 256) { b = u >> 7; h = (u >> 4) & 7; qt = 1 + (u & 15); nk = RB; } else { const int v = u - 256; b = v >> 3; h = v & 7; qt = 0; nk = CTX; }
        const size_t r0 = (size_t)b * RB;
        att::attn_body1<192, 1536, 1536, 1024, 2048>(Q + (r0 + qt * 256) * 1536 + h * 192, Kb + r0 * 1536 + h * 192, Vb + r0 * 1024 + h * 128, CAT + (r0 + qt * 256) * 2048 + h * 128, nk, (char*)F.lds, phase_tid(F.wave));
    }
}
__device__ __forceinline__ void attn_odd_phase(const Frame& F0, const bf16_t* Q, const bf16_t* Kb, const bf16_t* P, bf16_t* CAT, bool lat_only) {
    const Frame F = phase_frame(F0);
    const int nunits = lat_only ? 512 : 544;
    for (int u = F.vcu; u < nunits; u += F.G) {
        int b, hq, qt, nk;
        if (u < 512) { b = u >> 8; hq = (u >> 4) & 15; qt = 1 + (u & 15); nk = RB; } else { const int v = u - 512; b = v >> 4; hq = v & 15; qt = 0; nk = CTX; }
        const int kvh = hq >> 2; const size_t r0 = (size_t)b * RB;
        att::attn_body<128, 2048, 512, 3072, 2048, 2>(Q + (r0 + qt * 256) * 2048 + hq * 128, Kb + r0 * 512 + kvh * 128, P + r0 * 3072 + 2560 + kvh * 128, CAT + (r0 + qt * 256) * 2048 + hq * 128, nk, (char*)F.lds, phase_tid(F.wave));
    }
}

__device__ __forceinline__ int crow32(int r, int hi) { return (r & 3) + 8 * (r >> 2) + 4 * hi; }
__device__ __forceinline__ int fkey(int b) { return b ^ ((b >> 31) & 0x7fffffff); }
#define TK_CE(x, y) do { const int hi_ = max((x), (y)), lo_ = min((x), (y)); (x) = hi_; (y) = lo_; } while (0)
template <int N> __device__ __forceinline__ void tk_sort(int* v) {
#pragma unroll
    for (int k = 2; k <= N; k <<= 1)
#pragma unroll
        for (int j = k >> 1; j > 0; j >>= 1)
#pragma unroll
            for (int i = 0; i < N; ++i) { const int l = i ^ j; if (l > i) { if ((i & k) == 0) TK_CE(v[i], v[l]); else TK_CE(v[l], v[i]); } }
}
__device__ __forceinline__ void tk_merge16(int* a, const int* b) {
#pragma unroll
    for (int i = 0; i < 16; ++i) a[i] = max(a[i], b[15 - i]);
#pragma unroll
    for (int j = 8; j > 0; j >>= 1)
#pragma unroll
        for (int i = 0; i < 16; ++i) { const int l = i ^ j; if (l > i) TK_CE(a[i], a[l]); }
}
__device__ __forceinline__ void tk_merge_partner(int* a) {
    int lo[16], hi[16];
#pragma unroll
    for (int i = 0; i < 16; ++i) { auto rr = __builtin_amdgcn_permlane32_swap((unsigned)a[i], (unsigned)a[i], false, false); lo[i] = (int)rr[0]; hi[i] = (int)rr[1]; }
    tk_merge16(lo, hi);
#pragma unroll
    for (int i = 0; i < 16; ++i) a[i] = lo[i];
}
__device__ __forceinline__ void peer_topk_phase(const Frame& F0, const bf16_t* PQ, const bf16_t* subk  , int* IDX, float* GATE, bool lat_only) {
    const Frame F = phase_frame(F0);
    const int h = F.vcu & 7, jw = (F.vcu >> 3) * NWAVES + F.wave, nwh = (F.G >> 3) * NWAVES;
    {
        const bf16_t* src = subk + (size_t)h * 2 * 128 * 128;
        for (int c = F.tid; c < 4096; c += NTHREADS) { const int row = c >> 4, ch = c & 15;
            *(LAS u32x4*)(F.lds + row * 256 + ((ch ^ (row & 15)) << 4)) = *(const u32x4*)(src + (size_t)row * 128 + ch * 8); }
        __syncthreads();
    }
    const int ntg = lat_only ? 256 : MROWS / 32;
    for (int t = jw; t < ntg; t += nwh) {
        int lane_ = F.lane; asm volatile("" : "+v"(lane_));
        const int r32 = lane_ & 31, hi = lane_ >> 5;
        int tg = t; if (lat_only) tg += 8 + (tg >= 128 ? 8 : 0);
        const int token = tg * 32 + r32;
        int top[2][16];
        const int kk = (((r32 & 14) | (hi ^ (r32 & 1))) << 4);
#pragma unroll
        for (int p = 0; p < 2; ++p) {
            bf16x8 bq[8];
            const bf16_t* qp = PQ + (size_t)token * DM + h * 256 + p * 128 + hi * 8;
#pragma unroll
            for (int ks = 0; ks < 8; ++ks) bq[ks] = *(const bf16x8*)(qp + ks * 16);
            int s[4][16];
#pragma unroll
            for (int nb = 0; nb < 4; ++nb) {
                f32x16 acc = {};
                const LAS unsigned char* kp = F.lds + (p * 128 + nb * 32 + r32) * 256;
#pragma unroll
                for (int ks = 0; ks < 8; ++ks) { const bf16x8 a = *(const LAS bf16x8*)(kp + (kk ^ (ks << 5))); acc = __builtin_amdgcn_mfma_f32_32x32x16_bf16(a, bq[ks], acc, 0, 0, 0); }
#pragma unroll
                for (int r = 0; r < 16; ++r) { const int key = nb * 32 + crow32(r, hi); s[nb][r] = fkey((int)((__float_as_uint(acc[r]) & ~127u) | (unsigned)(127 - key))); }
                tk_sort<16>(s[nb]);
            }
            tk_merge16(s[0], s[1]); tk_merge16(s[2], s[3]); tk_merge16(s[0], s[2]);
            tk_merge_partner(s[0]);
#pragma unroll
            for (int j = 0; j < 16; ++j) top[p][j] = s[0][j];
        }
        int cand[32];
        unsigned long long kaLo = 0ull, kaHi = 0ull, kbLo = 0ull, kbHi = 0ull;
        {
            float fb[16]; const float fa0 = __uint_as_float((unsigned)fkey(top[0][0]) & ~127u), fb0 = __uint_as_float((unsigned)fkey(top[1][0]) & ~127u);
#pragma unroll
            for (int r = 0; r < 16; ++r) { const int ba = fkey(top[0][r]), bb = fkey(top[1][r]); fb[r] = __uint_as_float((unsigned)bb & ~127u) - fb0;
                const unsigned long long xa = (unsigned long long)(unsigned)(127 - (ba & 127)) << (8 * (r & 7)), xb = (unsigned long long)(unsigned)(127 - (bb & 127)) << (8 * (r & 7));
                if (r < 8) { kaLo |= xa; kbLo |= xb; } else { kaHi |= xa; kbHi |= xb; } }
            float fa[8];
#pragma unroll
            for (int i = 0; i < 8; ++i) { const int ka = hi ? top[0][2 * i + 1] : top[0][2 * i]; fa[i] = __uint_as_float((unsigned)fkey(ka) & ~127u) - fa0; }
            const int hid = 255 - (hi << 4);
            int n = 0;
#pragma unroll
            for (int i = 0; i < 8; ++i)
#pragma unroll
                for (int b = 0; b < 16; ++b) if ((2 * i + 1) * (b + 1) <= 16) {
                    const float sum = fa[i] + fb[b];
                    cand[n++] = fkey((int)((__float_as_uint(sum) & ~255u) | (unsigned)(hid - (32 * i + b))));
                }
#pragma unroll
            for (; n < 32; ++n) cand[n] = (int)0x80000000;
        }
        tk_sort<16>(cand); tk_sort<16>(cand + 16); tk_merge16(cand, cand + 16);
        tk_merge_partner(cand);
        float ev[16]; float esum = 0.f;
#pragma unroll
        for (int j = 0; j < 16; ++j) { ev[j] = __expf(__uint_as_float((unsigned)fkey(cand[j]) & ~255u)); esum += ev[j]; }
        const float rs = 1.0f / esum;
        int oi[8]; float og[8];
#pragma unroll
        for (int j = 0; j < 8; ++j) { const int w = hi ? cand[8 + j] : cand[j]; const float e = hi ? ev[8 + j] : ev[j];
            const int id8 = 255 - (fkey(w) & 255), ra = id8 >> 4, rb = id8 & 15;
            const unsigned long long wa = (ra & 8) ? kaHi : kaLo, wb = (rb & 8) ? kbHi : kbLo;
            const int ka = (int)(wa >> (8 * (ra & 7))) & 127, kb = (int)(wb >> (8 * (rb & 7))) & 127;
            oi[j] = ka * 128 + kb; og[j] = e * rs; }
        int* ip = IDX + (size_t)token * 128 + h * 16 + hi * 8; float* gp = GATE + (size_t)token * 128 + h * 16 + hi * 8;
        *(int4*)ip = make_int4(oi[0], oi[1], oi[2], oi[3]); *(int4*)(ip + 4) = make_int4(oi[4], oi[5], oi[6], oi[7]);
        *(f32x4*)gp = (f32x4){og[0], og[1], og[2], og[3]}; *(f32x4*)(gp + 4) = (f32x4){og[4], og[5], og[6], og[7]};
    }
}

#if TAB_FP4
__device__ __forceinline__ void peer_expert_phase(const Frame& F0, const bf16_t* H2, const int* IDX, const float* GATE, const unsigned char* U, size_t v_minus_u_bytes, const float* USC, const float* VSC,
                                                  const float* g2  , float* XW, float* OUT,
                                                  bf16_t* HN  , const float* ng  , const float* nmod  ) {
    const Frame F = phase_frame(F0);
    LAS float* red = (LAS float*)F.lds;
    const unsigned voff_tab = (unsigned)v_minus_u_bytes;
    const __amdgpu_buffer_rsrc_t rs = __builtin_amdgcn_make_buffer_rsrc((void*)U, 0, (int)(voff_tab + (unsigned)NEXP * ROWB), 0x00020000);
    const int lane = F.lane; const int voff = lane * 16;
#define PX_SB() __builtin_amdgcn_sched_barrier(0)
#define PX_LOADALL(buf, ivv, tb) do { _Pragma("unroll") for (int e_ = 0; e_ < 16; ++e_) buf[e_] = __builtin_amdgcn_raw_buffer_load_b128(rs, voff, (unsigned)__builtin_amdgcn_readlane(ivv, e_) * (unsigned)ROWB + (tb), 0); } while (0)
#define PX_U1(d_, b_) { const bf16x2_t r2_ = __builtin_amdgcn_cvt_scalef32_pk_bf16_fp4(wd_[d_], 1.0f, b_); if ((b_) & 1) a1_ = __builtin_amdgcn_fdot2_f32_bf16(r2_, __builtin_bit_cast(bf16x2_t, xpk[4 * (d_) + (b_)]), a1_, false); \
                        else a0_ = __builtin_amdgcn_fdot2_f32_bf16(r2_, __builtin_bit_cast(bf16x2_t, xpk[4 * (d_) + (b_)]), a0_, false); }
#define PX_V1(d_, b_) { const f32x2 t2_ = __builtin_amdgcn_cvt_scalef32_pk_f32_fp4(wd_[d_], 1.0f, b_); acc[8 * (d_) + 2 * (b_)] += wg_ * t2_.x; acc[8 * (d_) + 2 * (b_) + 1] += wg_ * t2_.y; }
#define PX_FETCH_TOKEN(r, XP, IV, GV) do { const u32x4* xp_ = (const u32x4*)(H2 + (size_t)(r) * DM + lane * 16); XP[0] = xp_[0]; XP[1] = xp_[1]; XP[2] = xp_[128]; XP[3] = xp_[129]; \
        IV = 0; GV = 0.f; if (lane < 16) { IV = IDX[(size_t)(r) * 128 + F.wave * 16 + lane]; GV = GATE[(size_t)(r) * 128 + F.wave * 16 + lane]; } } while (0)
    const bool skip_ctx = (OUT != nullptr);
    int row = F.vcu; if (skip_ctx && row < MROWS && row_cls(row) == 2) row += F.G;
    u32x4 xp[4]; int iv; float gv;
    u32x4 ub[16], vb[16];
    if (row < MROWS) { PX_FETCH_TOKEN(row, xp, iv, gv); PX_LOADALL(ub, iv, 0u); PX_LOADALL(vb, iv, voff_tab); }
    int par = 0;
    while (row < MROWS) {
        int nrow = row + F.G; if (skip_ctx && nrow < MROWS && row_cls(nrow) == 2) nrow += F.G;
        float usc = 0.f, vsc = 0.f;
        if (lane < 16) { usc = USC[iv]; vsc = VSC[iv]; }
        u32x4 xpn[4]; int ivn = 0; float gvn = 0.f;
        if (nrow < MROWS) PX_FETCH_TOKEN(nrow, xpn, ivn, gvn);
        const int cls = row_cls(row);
        const f32x4 x_old = *((const f32x4*)(XW + (size_t)row * DM) + F.tid), g_vec = *((const f32x4*)(g2 + (size_t)cls * NMOD) + F.tid);
        f32x4 n_g = {0.f, 0.f, 0.f, 0.f}, n_sc = n_g, n_sh = n_g;
        if (HN) { n_g = *((const f32x4*)ng + F.tid); n_sc = *((const f32x4*)(nmod + (size_t)cls * NMOD + 2048) + F.tid); n_sh = *((const f32x4*)(nmod + (size_t)cls * NMOD) + F.tid); }
        const unsigned xpk[16] = {xp[0].x, xp[0].y, xp[0].z, xp[0].w, xp[1].x, xp[1].y, xp[1].z, xp[1].w, xp[2].x, xp[2].y, xp[2].z, xp[2].w, xp[3].x, xp[3].y, xp[3].z, xp[3].w};
        float sv = 0.f;
        PX_SB();
#pragma unroll
        for (int e = 0; e < 16; ++e) {
            u32x4 w_ = ub[e]; asm volatile("" : "+v"(w_) : "v"(sv));
            const unsigned wd_[4] = {w_.x, w_.y, w_.z, w_.w}; float a0_ = 0.f, a1_ = 0.f;
            PX_U1(0, 0) PX_U1(0, 1) PX_U1(0, 2) PX_U1(0, 3) PX_U1(1, 0) PX_U1(1, 1) PX_U1(1, 2) PX_U1(1, 3) PX_U1(2, 0) PX_U1(2, 1) PX_U1(2, 2) PX_U1(2, 3) PX_U1(3, 0) PX_U1(3, 1) PX_U1(3, 2) PX_U1(3, 3)
            const float t_ = wave_sum_dpp(a0_ + a1_); sv = (lane == e) ? t_ : sv;
        }
        const float wv = gelu_erf(sv * usc) * gv * vsc;
        PX_SB();
        if (nrow < MROWS) PX_LOADALL(ub, ivn, 0u);
        PX_SB();
        f32x32 acc = {};
#pragma unroll
        for (int e = 0; e < 16; ++e) {
            u32x4 w_ = vb[e]; asm volatile("" : "+v"(w_) : "v"(acc));
            const unsigned wd_[4] = {w_.x, w_.y, w_.z, w_.w}; const float wg_ = __uint_as_float(__builtin_amdgcn_readlane(__float_as_uint(wv), e));
            PX_V1(0, 0) PX_V1(0, 1) PX_V1(0, 2) PX_V1(0, 3) PX_V1(1, 0) PX_V1(1, 1) PX_V1(1, 2) PX_V1(1, 3) PX_V1(2, 0) PX_V1(2, 1) PX_V1(2, 2) PX_V1(2, 3) PX_V1(3, 0) PX_V1(3, 1) PX_V1(3, 2) PX_V1(3, 3)
        }
        PX_SB();
        if (nrow < MROWS) PX_LOADALL(vb, ivn, voff_tab);
        PX_SB();
        LAS float* rb = red + par * (NWAVES * DM);
#pragma unroll
        for (int j = 0; j < 2; ++j)
#pragma unroll
            for (int q = 0; q < 4; ++q) *(LAS f32x4*)(rb + F.wave * DM + j * 1024 + lane * 16 + q * 4) = (f32x4){acc[j * 16 + q * 4], acc[j * 16 + q * 4 + 1], acc[j * 16 + q * 4 + 2], acc[j * 16 + q * 4 + 3]};
        __syncthreads();
        {
            f32x4 sm = {0.f, 0.f, 0.f, 0.f};
#pragma unroll
            for (int w = 0; w < 8; ++w) sm += *(const LAS f32x4*)(rb + w * DM + F.tid * 4);
            f32x4* xq = (f32x4*)(XW + (size_t)row * DM) + F.tid;
            const f32x4 xn = x_old + g_vec * sm;
            *xq = xn;
            if (OUT) { const int b = row / RB, i = row - b * RB; if (i >= CTX) *((f32x4*)(OUT + ((size_t)b * SEQ + (i - CTX)) * DM) + F.tid) = xn; }
            if (HN) {
                LAS float* ssp = (LAS float*)(F.lds + 131072) + par * 8;
                const float sw = wave_sum_dpp((xn.x * xn.x + xn.y * xn.y) + (xn.z * xn.z + xn.w * xn.w));
                if (lane == 0) ssp[F.wave] = sw;
                __syncthreads();
                const float tot = ((ssp[0] + ssp[1]) + (ssp[2] + ssp[3])) + ((ssp[4] + ssp[5]) + (ssp[6] + ssp[7]));
                const float rstd = 1.0f / sqrtf(tot * (1.f / DM) + EPS);
                const f32x4 y = (xn * rstd) * n_g * (n_sc + 1.0f) + n_sh;
                u32x2 o; o.x = pk2(y.x, y.y); o.y = pk2(y.z, y.w);
                *((u32x2*)(HN + (size_t)row * DM) + F.tid) = o;
            }
        }
        par ^= 1; row = nrow;
#pragma unroll
        for (int q = 0; q < 4; ++q) xp[q] = xpn[q];
        iv = ivn; gv = gvn;
    }
#undef PX_LOADALL
#undef PX_U1
#undef PX_V1
#undef PX_SB
#undef PX_FETCH_TOKEN
}
#else
__device__ __forceinline__ void peer_expert_phase(const Frame& F0, const bf16_t* H2, const int* IDX, const float* GATE, const unsigned char* U, size_t v_minus_u_bytes, const float* USC, const float* VSC,
                                                  const float* g2  , float* XW, float* OUT,
                                                  bf16_t* HN  , const float* ng  , const float* nmod  ) {
    const Frame F = phase_frame(F0);
    LAS float* red = (LAS float*)F.lds;
    const unsigned voff_tab = (unsigned)v_minus_u_bytes;
    const __amdgpu_buffer_rsrc_t rs = __builtin_amdgcn_make_buffer_rsrc((void*)U, 0, (int)(voff_tab + (unsigned)NEXP * ROWB), 0x00020000);
    const int lane = F.lane; const int voff = lane * 16, voff2 = 1024 + lane * 8;
#define PX_SB() __builtin_amdgcn_sched_barrier(0)
#define PX_LOAD(buf, s, ivv) do { constexpr int e0_ = ((s) & 3) * 4; const unsigned tb_ = ((s) >= 4) ? voff_tab : 0u; \
        _Pragma("unroll") for (int ee_ = 0; ee_ < 4; ++ee_) { const unsigned o_ = (unsigned)__builtin_amdgcn_readlane(ivv, e0_ + ee_) * (unsigned)ROWB + tb_; \
            buf##h[ee_] = __builtin_amdgcn_raw_buffer_load_b128(rs, voff, o_, 0); buf##l[ee_] = __builtin_amdgcn_raw_buffer_load_b64(rs, voff2, o_, 0); } } while (0)
#define PX_DECODE(buf, ee_, dep) u32x6 w6_ = {buf##h[ee_].x, buf##h[ee_].y, buf##h[ee_].z, buf##h[ee_].w, buf##l[ee_].x, buf##l[ee_].y}; \
        asm volatile("" : "+v"(w6_) : "v"(dep));     \
        const f32x32 r_ = __builtin_amdgcn_cvt_scalef32_pk32_f32_fp6(w6_, 1.0f);
#define PX_COMP_U(buf, s) do { constexpr int e0_ = ((s) & 3) * 4; \
            _Pragma("unroll") for (int ee_ = 0; ee_ < 4; ++ee_) { PX_DECODE(buf, ee_, sv) \
                const f32x32 p_ = r_ * xf; float a0_ = 0.f, a1_ = 0.f; \
                _Pragma("unroll") for (int k_ = 0; k_ < 32; k_ += 2) { a0_ += p_[k_]; a1_ += p_[k_ + 1]; } \
                const float t_ = wave_sum_dpp(a0_ + a1_); sv = (lane == e0_ + ee_) ? t_ : sv; } } while (0)
#define PX_COMP_V(buf, s) do { constexpr int e0_ = ((s) & 3) * 4; \
            _Pragma("unroll") for (int ee_ = 0; ee_ < 4; ++ee_) { const float wg_ = __uint_as_float(__builtin_amdgcn_readlane(__float_as_uint(wv), e0_ + ee_)); \
                PX_DECODE(buf, ee_, acc) \
                acc += r_ * wg_; } } while (0)
#define PX_FETCH_TOKEN(r, XP, IV, GV) do { const u32x4* xp_ = (const u32x4*)(H2 + (size_t)(r) * DM + lane * 16); XP[0] = xp_[0]; XP[1] = xp_[1]; XP[2] = xp_[128]; XP[3] = xp_[129]; \
        IV = 0; GV = 0.f; if (lane < 16) { IV = IDX[(size_t)(r) * 128 + F.wave * 16 + lane]; GV = GATE[(size_t)(r) * 128 + F.wave * 16 + lane]; } } while (0)
    const bool skip_ctx = (OUT != nullptr);
    int row = F.vcu; if (skip_ctx && row < MROWS && row_cls(row) == 2) row += F.G;
    u32x4 xp[4]; int iv; float gv;
    u32x4 bAh[4], bBh[4]; u32x2 bAl[4], bBl[4];
    if (row < MROWS) { PX_FETCH_TOKEN(row, xp, iv, gv); PX_LOAD(bA, 0, iv); }
    int par = 0;
    while (row < MROWS) {
        int nrow = row + F.G; if (skip_ctx && nrow < MROWS && row_cls(nrow) == 2) nrow += F.G;
        f32x32 xf;
#pragma unroll
        for (int q = 0; q < 4; ++q) { const unsigned ww[4] = {xp[q].x, xp[q].y, xp[q].z, xp[q].w};
#pragma unroll
            for (int k = 0; k < 4; ++k) { xf[q * 8 + 2 * k] = bf_lo(ww[k]); xf[q * 8 + 2 * k + 1] = bf_hi(ww[k]); } }
        float usc = 0.f, vsc = 0.f;
        if (lane < 16) { usc = USC[iv]; vsc = VSC[iv]; }
        u32x4 xpn[4]; int ivn = 0; float gvn = 0.f;
        if (nrow < MROWS) PX_FETCH_TOKEN(nrow, xpn, ivn, gvn);
        const int cls = row_cls(row);
        const f32x4 x_old = *((const f32x4*)(XW + (size_t)row * DM) + F.tid), g_vec = *((const f32x4*)(g2 + (size_t)cls * NMOD) + F.tid);
        f32x4 n_g = {0.f, 0.f, 0.f, 0.f}, n_sc = n_g, n_sh = n_g;
        if (HN) { n_g = *((const f32x4*)ng + F.tid); n_sc = *((const f32x4*)(nmod + (size_t)cls * NMOD + 2048) + F.tid); n_sh = *((const f32x4*)(nmod + (size_t)cls * NMOD) + F.tid); }
        float sv = 0.f, wv = 0.f;
        PX_LOAD(bB, 1, iv); PX_SB(); PX_COMP_U(bA, 0); PX_SB();
        PX_LOAD(bA, 2, iv); PX_SB(); PX_COMP_U(bB, 1); PX_SB();
        PX_LOAD(bB, 3, iv); PX_SB(); PX_COMP_U(bA, 2); PX_SB();
        PX_LOAD(bA, 4, iv); PX_SB(); PX_COMP_U(bB, 3); PX_SB();
        wv = gelu_erf(sv * usc) * gv * vsc;
        f32x32 acc = {};
        PX_LOAD(bB, 5, iv); PX_SB(); PX_COMP_V(bA, 4); PX_SB();
        PX_LOAD(bA, 6, iv); PX_SB(); PX_COMP_V(bB, 5); PX_SB();
        PX_LOAD(bB, 7, iv); PX_SB(); PX_COMP_V(bA, 6); PX_SB();
        if (nrow < MROWS) PX_LOAD(bA, 0, ivn);
        PX_SB(); PX_COMP_V(bB, 7); PX_SB();
        LAS float* rb = red + par * (NWAVES * DM);
#pragma unroll
        for (int j = 0; j < 2; ++j)
#pragma unroll
            for (int q = 0; q < 4; ++q) *(LAS f32x4*)(rb + F.wave * DM + j * 1024 + lane * 16 + q * 4) = (f32x4){acc[j * 16 + q * 4], acc[j * 16 + q * 4 + 1], acc[j * 16 + q * 4 + 2], acc[j * 16 + q * 4 + 3]};
        __syncthreads();
        {
            f32x4 sm = {0.f, 0.f, 0.f, 0.f};
#pragma unroll
            for (int w = 0; w < 8; ++w) sm += *(const LAS f32x4*)(rb + w * DM + F.tid * 4);
            f32x4* xq = (f32x4*)(XW + (size_t)row * DM) + F.tid;
            const f32x4 xn = x_old + g_vec * sm;
            *xq = xn;
            if (OUT) { const int b = row / RB, i = row - b * RB; if (i >= CTX) *((f32x4*)(OUT + ((size_t)b * SEQ + (i - CTX)) * DM) + F.tid) = xn; }
            if (HN) {
                LAS float* ssp = (LAS float*)(F.lds + 131072) + par * 8;
                const float sw = wave_sum_dpp((xn.x * xn.x + xn.y * xn.y) + (xn.z * xn.z + xn.w * xn.w));
                if (lane == 0) ssp[F.wave] = sw;
                __syncthreads();
                const float tot = ((ssp[0] + ssp[1]) + (ssp[2] + ssp[3])) + ((ssp[4] + ssp[5]) + (ssp[6] + ssp[7]));
                const float rstd = 1.0f / sqrtf(tot * (1.f / DM) + EPS);
                const f32x4 y = (xn * rstd) * n_g * (n_sc + 1.0f) + n_sh;
                u32x2 o; o.x = pk2(y.x, y.y); o.y = pk2(y.z, y.w);
                *((u32x2*)(HN + (size_t)row * DM) + F.tid) = o;
            }
        }
        par ^= 1; row = nrow;
#pragma unroll
        for (int q = 0; q < 4; ++q) xp[q] = xpn[q];
        iv = ivn; gv = gvn;
    }
#undef PX_LOAD
#undef PX_COMP_U
#undef PX_COMP_V
#undef PX_SB
#undef PX_FETCH_TOKEN
}
#endif

#if EXP_SLICED && TAB_FP4
__device__ __forceinline__ float oct_sum(float v) { v = DPP_ADD(v, 0xB1); v = DPP_ADD(v, 0x4E); v = DPP_ADD(v, 0x141); return v; }
__device__ __forceinline__ int sl_next_tok(int t, bool lat_only) { t += 256; if (lat_only) while (t < MROWS && row_cls(t) == 2) t += 256; return t; }
#define SL_IDS(t_, A_, B_) do { A_ = IDX[(size_t)(t_) * 128 + lane]; B_ = IDX[(size_t)(t_) * 128 + 64 + lane]; } while (0)
#define SL_ROWS(buf, A_, B_) do { _Pragma("unroll") for (int i_ = 0; i_ < 16; ++i_) { const int id_ = __builtin_amdgcn_ds_bpermute(bp + 32 * (i_ & 7), (i_ < 8) ? (A_) : (B_)); \
        buf[i_] = __builtin_amdgcn_raw_buffer_load_b128(rs, id_ * 128 + coloff, 0, 0); } } while (0)
__device__ __forceinline__ void peer_u_phase(const Frame& F0, const bf16_t* H2, const int* IDX, const unsigned char* U, float* PART, bool lat_only) {
    const Frame F = phase_frame(F0);
    const int lane = F.lane, g = lane >> 3, j = lane & 7, bp = 4 * g;
    const int x = F.vcu >> 5, wi = (F.vcu & 31) * NWAVES + F.wave;
    const __amdgpu_buffer_rsrc_t rs = __builtin_amdgcn_make_buffer_rsrc((void*)(U + (size_t)x * (NEXP * 128)), 0, NEXP * 128, 0x00020000);
    const int coloff = 16 * j;
    int t = wi - 256; t = sl_next_tok(t, lat_only);
    int idA = 0, idB = 0, idA1 = 0, idB1 = 0; u32x4 xs[4], xs1[4], w[16], wn[16];
#define SL_XS(dst, t_) do { const u32x4* xp_ = (const u32x4*)(H2 + (size_t)(t_) * DM + 256 * x + 32 * j); dst[0] = xp_[0]; dst[1] = xp_[1]; dst[2] = xp_[2]; dst[3] = xp_[3]; } while (0)
    if (t < MROWS) { SL_IDS(t, idA, idB); SL_XS(xs, t); SL_ROWS(w, idA, idB); }
    int t1 = sl_next_tok(t, lat_only);
    if (t1 < MROWS) SL_IDS(t1, idA1, idB1);
    while (t < MROWS) {
        const int t2 = sl_next_tok(t1, lat_only);
        int idA2 = 0, idB2 = 0;
        if (t1 < MROWS) { SL_ROWS(wn, idA1, idB1); SL_XS(xs1, t1); }
        if (t2 < MROWS) SL_IDS(t2, idA2, idB2);
        const unsigned xpk[16] = {xs[0].x, xs[0].y, xs[0].z, xs[0].w, xs[1].x, xs[1].y, xs[1].z, xs[1].w, xs[2].x, xs[2].y, xs[2].z, xs[2].w, xs[3].x, xs[3].y, xs[3].z, xs[3].w};
        float res_lo = 0.f, res_hi = 0.f;
#define SL_U1(d_, b_) { const bf16x2_t r2_ = __builtin_amdgcn_cvt_scalef32_pk_bf16_fp4(wd_[d_], 1.0f, b_); aq_[b_] = __builtin_amdgcn_fdot2_f32_bf16(r2_, __builtin_bit_cast(bf16x2_t, xpk[4 * (d_) + (b_)]), aq_[b_], false); }
#pragma unroll
        for (int i = 0; i < 16; ++i) {
            const unsigned wd_[4] = {w[i].x, w[i].y, w[i].z, w[i].w}; float aq_[4] = {0.f, 0.f, 0.f, 0.f};
            SL_U1(0, 0) SL_U1(0, 1) SL_U1(0, 2) SL_U1(0, 3) SL_U1(1, 0) SL_U1(1, 1) SL_U1(1, 2) SL_U1(1, 3) SL_U1(2, 0) SL_U1(2, 1) SL_U1(2, 2) SL_U1(2, 3) SL_U1(3, 0) SL_U1(3, 1) SL_U1(3, 2) SL_U1(3, 3)
            const float a_ = oct_sum((aq_[0] + aq_[1]) + (aq_[2] + aq_[3]));
            if (i < 8) res_lo = (j == i) ? a_ : res_lo; else res_hi = (j == i - 8) ? a_ : res_hi;
        }
#undef SL_U1
        float* pp = PART + ((size_t)t * 8 + x) * 128 + 8 * j + g;
        pp[0] = res_lo; pp[64] = res_hi;
        t = t1; t1 = t2; idA1 = idA2; idB1 = idB2;
#pragma unroll
        for (int q = 0; q < 4; ++q) xs[q] = xs1[q];
#pragma unroll
        for (int i = 0; i < 16; ++i) w[i] = wn[i];
    }
#undef SL_XS
}
__device__ __forceinline__ void peer_w_phase(const Frame& F0, const float* PART, const int* IDX, float* GATE, const float* USC, const float* VSC, bool lat_only) {
    const Frame F = phase_frame(F0);
    const int gt = F.vcu * NTHREADS + F.tid, GT = F.G * NTHREADS;
    for (int e = gt; e < MROWS * 128; e += GT) { const int t = e >> 7, k = e & 127;
        if (lat_only && row_cls(t) == 2) continue;
        const float* pp = PART + (size_t)t * 1024 + k; float s = 0.f;
#pragma unroll
        for (int xx = 0; xx < 8; ++xx) s += pp[xx * 128];
        const int id = IDX[e];
        GATE[e] = GATE[e] * gelu_erf(s * USC[id]) * VSC[id]; }
}
__device__ __forceinline__ void peer_v_phase(const Frame& F0, const int* IDX, const float* WK, const unsigned char* VT, const float* g2  , float* XW, float* OUT, bool lat_only) {
    const Frame F = phase_frame(F0);
    const int lane = F.lane, g = lane >> 3, j = lane & 7, bp = 4 * g;
    const int x = F.vcu >> 5, wi = (F.vcu & 31) * NWAVES + F.wave;
    const __amdgpu_buffer_rsrc_t rs = __builtin_amdgcn_make_buffer_rsrc((void*)(VT + (size_t)x * (NEXP * 128)), 0, NEXP * 128, 0x00020000);
    const int coloff = 16 * j;
    const int mycol = 256 * x + 32 * j + 4 * g;
    int t = wi - 256; t = sl_next_tok(t, lat_only);
    int idA = 0, idB = 0, idA1 = 0, idB1 = 0; float wA = 0.f, wB = 0.f, wA1 = 0.f, wB1 = 0.f; u32x4 w[16], wn[16];
#define SL_WK(t_, A_, B_) do { A_ = WK[(size_t)(t_) * 128 + lane]; B_ = WK[(size_t)(t_) * 128 + 64 + lane]; } while (0)
    if (t < MROWS) { SL_IDS(t, idA, idB); SL_WK(t, wA, wB); SL_ROWS(w, idA, idB); }
    int t1 = sl_next_tok(t, lat_only);
    if (t1 < MROWS) { SL_IDS(t1, idA1, idB1); SL_WK(t1, wA1, wB1); }
    while (t < MROWS) {
        const int t2 = sl_next_tok(t1, lat_only);
        int idA2 = 0, idB2 = 0; float wA2 = 0.f, wB2 = 0.f;
        if (t1 < MROWS) SL_ROWS(wn, idA1, idB1);
        if (t2 < MROWS) { SL_IDS(t2, idA2, idB2); SL_WK(t2, wA2, wB2); }
        const int cls = row_cls(t);
        const f32x4 x_old = *(const f32x4*)(XW + (size_t)t * DM + mycol), g_vec = *(const f32x4*)(g2 + (size_t)cls * NMOD + mycol);
        h2_t acc[16];
#pragma unroll
        for (int p = 0; p < 16; ++p) acc[p] = (h2_t){(_Float16)0.f, (_Float16)0.f};
#define SL_V1(d_, b_) { const h2_t r2_ = __builtin_amdgcn_cvt_scalef32_pk_f16_fp4(wd_[d_], 1.0f, b_); acc[4 * (d_) + (b_)] = __builtin_elementwise_fma(r2_, wg2_, acc[4 * (d_) + (b_)]); }
#pragma unroll
        for (int i = 0; i < 16; ++i) {
            const unsigned wd_[4] = {w[i].x, w[i].y, w[i].z, w[i].w};
            const float wgf_ = __int_as_float(__builtin_amdgcn_ds_bpermute(bp + 32 * (i & 7), __float_as_int((i < 8) ? wA : wB)));
            const _Float16 wgh_ = (_Float16)wgf_; const h2_t wg2_ = {wgh_, wgh_};
            SL_V1(0, 0) SL_V1(0, 1) SL_V1(0, 2) SL_V1(0, 3) SL_V1(1, 0) SL_V1(1, 1) SL_V1(1, 2) SL_V1(1, 3) SL_V1(2, 0) SL_V1(2, 1) SL_V1(2, 2) SL_V1(2, 3) SL_V1(3, 0) SL_V1(3, 1) SL_V1(3, 2) SL_V1(3, 3)
        }
#undef SL_V1
        unsigned m0 = 0u, m1 = 0u;
#pragma unroll
        for (int p = 0; p < 16; ++p) {
            h2_t v = acc[p];
            v = v + __builtin_bit_cast(h2_t, __builtin_amdgcn_update_dpp(0, __builtin_bit_cast(int, v), 0x128, 0xf, 0xf, true));
            { auto r = __builtin_amdgcn_permlane16_swap(__builtin_bit_cast(unsigned, v), __builtin_bit_cast(unsigned, v), false, false); v = __builtin_bit_cast(h2_t, (unsigned)r[0]) + __builtin_bit_cast(h2_t, (unsigned)r[1]); }
            { auto r = __builtin_amdgcn_permlane32_swap(__builtin_bit_cast(unsigned, v), __builtin_bit_cast(unsigned, v), false, false); v = __builtin_bit_cast(h2_t, (unsigned)r[0]) + __builtin_bit_cast(h2_t, (unsigned)r[1]); }
            if (g == (p >> 1)) { if (p & 1) m1 = __builtin_bit_cast(unsigned, v); else m0 = __builtin_bit_cast(unsigned, v); }
        }
        const h2_t q0 = __builtin_bit_cast(h2_t, m0), q1 = __builtin_bit_cast(h2_t, m1);
        const f32x4 mine = {(float)q0.x, (float)q0.y, (float)q1.x, (float)q1.y};
        const f32x4 xn = x_old + g_vec * mine;
        *(f32x4*)(XW + (size_t)t * DM + mycol) = xn;
        if (OUT) { const int b = t / RB, i = t - b * RB; if (i >= CTX) *(f32x4*)(OUT + ((size_t)b * SEQ + (i - CTX)) * DM + mycol) = xn; }
        t = t1; t1 = t2; idA1 = idA2; idB1 = idB2; wA = wA1; wB = wB1; wA1 = wA2; wB1 = wB2;
#pragma unroll
        for (int i = 0; i < 16; ++i) w[i] = wn[i];
    }
#undef SL_WK
}
#undef SL_IDS
#undef SL_ROWS
#endif
#ifndef N_LAUNCHES
#define N_LAUNCHES 1
#endif
struct Args { const float* in[26]; float* out; unsigned char* ws; int ph_lo, ph_hi; };
constexpr int NPHASES = 39;
__global__ void __launch_bounds__(NTHREADS, 2) fwd_kernel(Args args) {
    extern __shared__ __attribute__((aligned(16))) unsigned char lds_raw[];
    Frame F_;
    F_.lds = (LAS unsigned char*)lds_raw;
    F_.tid = threadIdx.x; F_.lane = F_.tid & 63; F_.wave = __builtin_amdgcn_readfirstlane(F_.tid >> 6);
    F_.G = gridDim.x; { const int bx = blockIdx.x; F_.vcu = (F_.G % 8 == 0) ? (bx % 8) * (F_.G / 8) + bx / 8 : bx; }
    F_.gw = F_.vcu * NWAVES + F_.wave; F_.NGW = F_.G * NWAVES;
    F_.ws = args.ws;
    volatile LAS unsigned* MISC = (volatile LAS unsigned*)(F_.lds + LDS_MISC);
    if (F_.tid < 32) MISC[F_.tid] = 0u;
    __syncthreads();
    const int lo = args.ph_lo, hi = args.ph_hi;
    XcdBarrier bar; bar.bar = (unsigned*)(args.ws + WS_CTL) + CW_BAR; bar.x = 0; bar.st = nullptr;
    if (N_LAUNCHES == 1 || hi - lo > 1) bar = xcd_barrier_post((unsigned*)(args.ws + WS_CTL) + CW_BAR, MISC + 8);
#if N_LAUNCHES == 1
#define IN(k) true
#define SEAM(k) xcd_barrier(bar)
#else
#define IN(k) (lo <= (k) && (k) < hi)
#define SEAM(k) do { if (IN(k) && IN((k) + 1)) xcd_barrier(bar); } while (0)
#endif
    PG8_LAS unsigned char* glds = (PG8_LAS unsigned char*)lds_raw;

    if (IN(0)) { p0_prologue(F_, args.in); } SEAM(0);

#pragma unroll 1
    for (int lp = 0; lp < 2; ++lp) {
        const int pb = 1 + lp * 19;
        unsigned char* ws = args.ws; asm volatile("" : "+s"(ws));
        Frame F = F_; { int w_ = F_.wave, v_ = F_.vcu, g_ = F_.G; asm volatile("" : "+s"(w_), "+s"(v_), "+s"(g_)); F.wave = w_; F.vcu = v_; F.G = g_; F.gw = v_ * NWAVES + w_; F.NGW = g_ * NWAVES; F.ws = ws; }
        float* mod = (float*)(ws + WS_MOD); float* XW = (float*)(ws + WS_XW);
        bf16_t* H = (bf16_t*)(ws + WS_H); bf16_t* P = (bf16_t*)(ws + WS_P); bf16_t* QRAW = (bf16_t*)(ws + WS_QRAW); bf16_t* KVRAW = (bf16_t*)(ws + WS_KVRAW);
        bf16_t* Q = (bf16_t*)(ws + WS_Q); bf16_t* KB = (bf16_t*)(ws + WS_K); bf16_t* VB = (bf16_t*)(ws + WS_V); bf16_t* CAT = (bf16_t*)(ws + WS_CAT); bf16_t* PQ = (bf16_t*)(ws + WS_PQ);
        int* IDX = (int*)(ws + WS_IDX); float* GATE = (float*)(ws + WS_GATE);
        const float* rope_c = (const float*)(ws + WS_ROPE); const float* rope_a = rope_c + 64 * 32 * 2;
        const float* SMv = (const float*)(ws + WS_SMALL);
        {
            const int l = 2 * lp, i = lp;
            const float* modl = mod + (size_t)l * 3 * NMOD;
            if (lp == 0) { if (IN(pb + 0)) { norm_phase(F, XW, SMv + SM_N1G + l * DM, modl, 0, 2048, H, false); } SEAM(pb + 0); }
            if (IN(pb + 1)) {
                pg8::Gemm g{H, (const bf16_t*)(ws + WS_WIN) + (size_t)i * 4096 * DM, MROWS, 4096, DM, DM, DM}; pg8::StaticOrder S; S.init(MROWS, 4096, F.G, (int)blockIdx.x);
                pg8::EpiBf16 E{P, 4096};
                pg8::gemm_phase<pg8::EpiBf16, pg8::StaticOrder, true, true>(glds, g, S, E, phase_tid(F.wave));
            } SEAM(pb + 1);
            if (IN(pb + 2)) {
                { pg8::Gemm g{P, (const bf16_t*)(ws + WS_WUQ) + (size_t)i * 1536 * 512, MROWS, 1536, 512, 4096, 512}; pg8::StaticOrder S; S.init(MROWS, 1536, F.G, (int)blockIdx.x);
                  pg8::EpiBf16 E{QRAW, 1536};
                  pg8::gemm_phase<pg8::EpiBf16, pg8::StaticOrder, true, true>(glds, g, S, E, phase_tid(F.wave)); }
                __syncthreads();
                { pg8::Gemm g{P + 512, (const bf16_t*)(ws + WS_WUKV) + (size_t)i * 2048 * 256, MROWS, 2048, 256, 4096, 256}; pg8::StaticOrder S; S.init(MROWS, 2048, F.G, (int)blockIdx.x);
                  pg8::EpiBf16 E{KVRAW, 2048};
                  pg8::gemm_phase<pg8::EpiBf16, pg8::StaticOrder, true, true>(glds, g, S, E, phase_tid(F.wave)); }
                __syncthreads();
                conv_phase(F, P, SMv + SM_CW + i * 3072, SMv + SM_CB + i * 1024, CAT);
            } SEAM(pb + 2);
            if (IN(pb + 3)) { prep_even_phase(F, P, QRAW, KVRAW, SMv + SM_AQG + i * 192, SMv + SM_AKG + i * 192, rope_a, Q, KB, VB); } SEAM(pb + 3);
            if (IN(pb + 4)) { attn_even_phase(F, Q, KB, VB, CAT); } SEAM(pb + 4);
            if (IN(pb + 5)) {
                pg8::Gemm g{CAT, (const bf16_t*)(ws + WS_WEO) + (size_t)i * DM * DM, MROWS, DM, DM, DM, DM}; pg8::StaticOrder S; S.init(MROWS, DM, F.G, (int)blockIdx.x);
                pg8::EpiResid E{XW, DM, modl + 4096};
                pg8::gemm_phase<pg8::EpiResid, pg8::StaticOrder, true, true>(glds, g, S, E, phase_tid(F.wave));
            } SEAM(pb + 5);
            if (IN(pb + 6)) { norm_phase(F, XW, SMv + SM_N2G + l * DM, modl, 6144, 8192, H, l == 3); } SEAM(pb + 6);
            if (IN(pb + 7)) {
                pg8::Gemm g{H, (const bf16_t*)(ws + WS_WPQ) + (size_t)l * DM * DM, MROWS, DM, DM, DM, DM}; pg8::StaticOrder S; S.init(MROWS, DM, F.G, (int)blockIdx.x);
                pg8::EpiBf16 E{PQ, DM};
                pg8::gemm_phase<pg8::EpiBf16, pg8::StaticOrder, true, true>(glds, g, S, E, phase_tid(F.wave));
            } SEAM(pb + 7);
            if (IN(pb + 8)) { peer_topk_phase(F, PQ, (const bf16_t*)(ws + WS_SUBK) + (size_t)l * 16 * 128 * 128, IDX, GATE, l == 3); } SEAM(pb + 8);
            {
                const unsigned char* Ut = ws + WS_U + (size_t)l * NEXP * ROWB; const unsigned char* Vt = ws + WS_VT + (size_t)l * NEXP * ROWB;
                peer_u_phase(F, H, IDX, Ut, (float*)(ws + WS_PART), false); SEAM(0);
                peer_w_phase(F, (const float*)(ws + WS_PART), IDX, GATE, (const float*)(ws + WS_USC) + l * NEXP, (const float*)(ws + WS_VSC) + l * NEXP, false); SEAM(0);
                peer_v_phase(F, IDX, GATE, Vt, modl + 10240, XW, nullptr, false); SEAM(0);
                norm_phase(F, XW, SMv + SM_N1G + (l + 1) * DM, mod + (size_t)(l + 1) * 3 * NMOD, 0, 2048, H, false); SEAM(0);
            }
        }
        {
            const int l = 2 * lp + 1, i = lp, qb = pb + 10;
            const float* modl = mod + (size_t)l * 3 * NMOD;
            if (IN(qb + 1)) {
                pg8::Gemm g{H, (const bf16_t*)(ws + WS_WQKV) + (size_t)i * 3072 * DM, MROWS, 3072, DM, DM, DM}; pg8::StaticOrder S; S.init(MROWS, 3072, F.G, (int)blockIdx.x);
                pg8::EpiBf16 E{P, 3072};
                pg8::gemm_phase<pg8::EpiBf16, pg8::StaticOrder, true, true>(glds, g, S, E, phase_tid(F.wave));
            } SEAM(qb + 1);
            if (IN(qb + 2)) { prep_odd_phase(F, P, SMv + SM_CQG + i * 128, SMv + SM_CKG + i * 128, rope_c, Q, KB); } SEAM(qb + 2);
            if (IN(qb + 3)) { attn_odd_phase(F, Q, KB, P, CAT, l == 3); } SEAM(qb + 3);
            if (IN(qb + 4)) {
                pg8::Gemm g{CAT, (const bf16_t*)(ws + WS_WCO) + (size_t)i * DM * DM, MROWS, DM, DM, DM, DM}; pg8::StaticOrder S; S.init(MROWS, DM, F.G, (int)blockIdx.x, l == 3);
                pg8::EpiResid E{XW, DM, modl + 4096};
                pg8::gemm_phase<pg8::EpiResid, pg8::StaticOrder, true, true>(glds, g, S, E, phase_tid(F.wave));
            } SEAM(qb + 4);
            if (IN(qb + 5)) { norm_phase(F, XW, SMv + SM_N2G + l * DM, modl, 6144, 8192, H, l == 3); } SEAM(qb + 5);
            if (IN(qb + 6)) {
                pg8::Gemm g{H, (const bf16_t*)(ws + WS_WPQ) + (size_t)l * DM * DM, MROWS, DM, DM, DM, DM}; pg8::StaticOrder S; S.init(MROWS, DM, F.G, (int)blockIdx.x, l == 3);
                pg8::EpiBf16 E{PQ, DM};
                pg8::gemm_phase<pg8::EpiBf16, pg8::StaticOrder, true, true>(glds, g, S, E, phase_tid(F.wave));
            } SEAM(qb + 6);
            if (IN(qb + 7)) { peer_topk_phase(F, PQ, (const bf16_t*)(ws + WS_SUBK) + (size_t)l * 16 * 128 * 128, IDX, GATE, l == 3); } SEAM(qb + 7);
            {
                const unsigned char* Ut = ws + WS_U + (size_t)l * NEXP * ROWB; const unsigned char* Vt = ws + WS_VT + (size_t)l * NEXP * ROWB;
                peer_u_phase(F, H, IDX, Ut, (float*)(ws + WS_PART), l == 3); SEAM(0);
                peer_w_phase(F, (const float*)(ws + WS_PART), IDX, GATE, (const float*)(ws + WS_USC) + l * NEXP, (const float*)(ws + WS_VSC) + l * NEXP, l == 3); SEAM(0);
                peer_v_phase(F, IDX, GATE, Vt, modl + 10240, XW, (l == 3) ? args.out : nullptr, l == 3);
                if (lp == 0) { SEAM(0); norm_phase(F, XW, SMv + SM_N1G + (l + 1) * DM, mod + (size_t)(l + 1) * 3 * NMOD, 0, 2048, H, false); SEAM(0); }
            }
        }
    }
#undef IN
#undef SEAM
}

extern "C" void kernel_launch(void* const* d_in, const int* in_sizes, int n_in, void* d_out, int out_size, void* d_ws, size_t ws_size, hipStream_t stream) {
    static int grid = 0;
    if (grid == 0) {
        if (n_in != 26 || out_size != NBATCH * SEQ * DM || ws_size < WS_END) { fprintf(stderr, "kernel_launch: unexpected shapes: n_in %d out %d ws %zu (need %zu)\n", n_in, out_size, ws_size, (size_t)WS_END); grid = -1; return; }
        int dev = 0, cus = 0, per_cu = 0;
        if (hipGetDevice(&dev) != hipSuccess || hipDeviceGetAttribute(&cus, hipDeviceAttributeMultiprocessorCount, dev) != hipSuccess) { fprintf(stderr, "kernel_launch: device query failed\n"); grid = -1; return; }
        if (hipFuncSetAttribute((const void*)fwd_kernel, hipFuncAttributeMaxDynamicSharedMemorySize, LDS_BYTES) != hipSuccess) { fprintf(stderr, "kernel_launch: hipFuncSetAttribute failed\n"); grid = -1; return; }
        if (hipOccupancyMaxActiveBlocksPerMultiprocessor(&per_cu, (const void*)fwd_kernel, NTHREADS, LDS_BYTES) != hipSuccess || per_cu < 1) { fprintf(stderr, "kernel_launch: occupancy query says %d blocks per CU\n", per_cu); (void)hipGetLastError(); grid = -1; return; }
        grid = cus;
    }
    if (grid < 0) return;
    (void)hipMemsetAsync((char*)d_ws + WS_CTL, 0, CTL_ZERO_BYTES, stream);
    Args a{};
    for (int i = 0; i < 26; ++i) a.in[i] = (const float*)d_in[i];
    a.out = (float*)d_out; a.ws = (unsigned char*)d_ws;
    for (int li = 0; li < N_LAUNCHES; ++li) {
        a.ph_lo = (N_LAUNCHES == 1) ? 0 : li; a.ph_hi = (N_LAUNCHES == 1) ? NPHASES : li + 1;
        hipLaunchKernelGGL(fwd_kernel, dim3(grid), dim3(NTHREADS), LDS_BYTES, stream, a);
        const hipError_t le = hipPeekAtLastError();
        if (le != hipSuccess) { fprintf(stderr, "kernel_launch: launch %d failed: %s\n", li, hipGetErrorName(le)); break; }
    }
}
```

```cpp
#include <hip/hip_runtime.h>
#include <cstdio>
#include <cstdint>
namespace pg8 {
#define PG8_LAS __attribute__((address_space(3)))
typedef unsigned short bf16_t;
typedef short bf16x8 __attribute__((ext_vector_type(8)));
typedef float f32x4 __attribute__((ext_vector_type(4)));
typedef unsigned u32x4 __attribute__((ext_vector_type(4)));
constexpr int BM = 256, BK = 64, HALF = 128, HTB = HALF * BK * 2  , STAGE_BYTES = 8 * HTB, NXCD = 8, WGM = 8;

__host__ __device__ __forceinline__ int lds_byte(int r, int c) { const int st = (r >> 4) * 2 + (c >> 5), rr = r & 15, cc = c & 31, ob = rr * 64 + cc * 2; return st * 1024 + (ob ^ (((ob >> 9) & 1) << 5)); }
__host__ __device__ __forceinline__ void stage_rc(int b, int& R, int& C) { const int st = b / 1024, sb = b % 1024, swz = sb ^ (((sb >> 9) & 1) << 5); R = (st >> 1) * 16 + swz / 64; C = (st & 1) * 32 + (swz % 64) / 2; }
__host__ __device__ __forceinline__ int perm32(int rho) { const int n = rho >> 4, i = rho & 15; return 8 * (i >> 2) + 4 * n + (i & 3); }

struct Unit { int pm, pn; };
struct Gemm { const bf16_t* A; const bf16_t* Bt; int M, N, K, lda, ldb; };

struct StaticOrder {
    int nM, nN, nwg, G, c; bool lat_only;
    __host__ __device__ void init(int M, int N, int G_, int c_, bool lat_only_ = false) { lat_only = lat_only_; nM = lat_only_ ? 32 : M / BM; nN = N / BM; nwg = nM * nN; G = G_; c = c_; }
    __host__ __device__ bool next(int i, Unit& u) const {
        const long L = (long)i * G + c; if (L >= nwg) return false;
        int wgid = (int)L; { const int q = nwg / NXCD, r = nwg % NXCD, xcd = wgid % NXCD, off = wgid / NXCD; wgid = (xcd < r ? xcd * (q + 1) : r * (q + 1) + (xcd - r) * q) + off; }
        const int nig = WGM * nN, gid = wgid / nig, fm = gid * WGM, gsz = (nM - fm) < WGM ? (nM - fm) : WGM;
        u.pm = fm + ((wgid % nig) % gsz); u.pn = (wgid % nig) / gsz; if (lat_only) u.pm += 1 + (u.pm >= 16 ? 1 : 0); return true;
    }
    __device__ __forceinline__ void a_ready(const Unit&) const {}
    __device__ __forceinline__ void done(const Unit&) const {}
};
__device__ __forceinline__ unsigned cvt_pk_bf16(float lo, float hi) { unsigned r; asm volatile("v_cvt_pk_bf16_f32 %0, %1, %2" : "=v"(r) : "v"(lo), "v"(hi)); return r; }
typedef float f32x2 __attribute__((ext_vector_type(2)));
struct EpiBf16 {
    static constexpr bool PERM = true, AFTER_DRAIN = false;
    bf16_t* O; int ldc;
    __device__ __forceinline__ void operator()(const f32x4 (&acc)[2][2][4][2], const Unit& u, int wr, int wc, int fr, int fq) const {
        const int row0 = u.pm * BM + wr * 64 + fr, col0 = u.pn * BM + wc * 32 + 8 * fq;
#pragma unroll
        for (int ai = 0; ai < 2; ++ai)
#pragma unroll
            for (int m = 0; m < 4; ++m) { bf16_t* rowp = O + (size_t)(row0 + ai * HALF + m * 16) * ldc + col0;
#pragma unroll
                for (int bj = 0; bj < 2; ++bj) { const f32x4 v0 = acc[ai][bj][m][0], v1 = acc[ai][bj][m][1];
                    u32x4 w; w.x = cvt_pk_bf16(v0[0], v0[1]); w.y = cvt_pk_bf16(v0[2], v0[3]); w.z = cvt_pk_bf16(v1[0], v1[1]); w.w = cvt_pk_bf16(v1[2], v1[3]);
                    *(u32x4*)(rowp + bj * HALF) = w; } }
    }
};
struct EpiResid {
    static constexpr bool PERM = false, AFTER_DRAIN = false;
    float* X; int ldc; const float* gate;
    __device__ __forceinline__ void operator()(const f32x4 (&acc)[2][2][4][2], const Unit& u, int wr, int wc, int fr, int fq) const {
        const int row0 = u.pm * BM + wr * 64 + fr, col0 = u.pn * BM + wc * 32 + 4 * fq;
        const int cls = (u.pm % 17 == 0) ? 2 : (u.pm / 17);
        const float* gp = gate + (size_t)cls * 12288 + col0;
        f32x4 gv[2][2];
#pragma unroll
        for (int bj = 0; bj < 2; ++bj)
#pragma unroll
            for (int n = 0; n < 2; ++n) gv[bj][n] = *(const f32x4*)(gp + bj * HALF + n * 16);
#pragma unroll
        for (int ai = 0; ai < 2; ++ai)
#pragma unroll
            for (int m = 0; m < 4; ++m) { float* rowp = X + (size_t)(row0 + ai * HALF + m * 16) * ldc + col0;
#pragma unroll
                for (int bj = 0; bj < 2; ++bj)
#pragma unroll
                    for (int n = 0; n < 2; ++n) { f32x4* p = (f32x4*)(rowp + bj * HALF + n * 16); *p = *p + gv[bj][n] * acc[ai][bj][m][n]; } }
    }
};
template <class Epi, class Sched, bool ALIGN_EPI = false, bool SP2 = false>
__device__ __forceinline__ void gemm_phase(PG8_LAS unsigned char* lds, const Gemm g, const Sched& S, const Epi& E, int tid_in) {
    int tid_ = tid_in; asm volatile("" : "+v"(tid_));
    const int tid = tid_, wid = __builtin_amdgcn_readfirstlane(tid >> 6), lane = tid & 63, wr = wid >> 2, wc = wid & 3, fr = lane & 15, fq = lane >> 4;
    const int K = g.K, nt = K / BK;
    unsigned voffA[2], voffB[2];
#pragma unroll
    for (int i = 0; i < 2; ++i) { int R, C; stage_rc(tid * 16 + i * 8192, R, C); const int Rb = Epi::PERM ? ((R & ~31) + perm32(R & 31)) : R;
        voffA[i] = (unsigned)(R * g.lda + C) * 2u; voffB[i] = (unsigned)(Rb * g.ldb + C) * 2u; }
    const size_t kstep = (size_t)(BK * 2);
    const size_t hstepA = (size_t)HALF * g.lda * 2, hstepB = (size_t)HALF * g.ldb * 2;
    const size_t tstepA = 2 * hstepA, tstepB = 2 * hstepB;
    const unsigned ldsw = (unsigned)wid * 1024u;
    const int aoff = lds_byte(wr * 64 + fr, fq * 8), boff = lds_byte(wc * 32 + fr, fq * 8);
#define PG8_SA(b, h) (((b) * 2 + (h)) * HTB)
#define PG8_SB(b, h) ((4 + (b) * 2 + (h)) * HTB)
#define PG8_STAGE(bufoff, gbase, voff) do { _Pragma("unroll") for (int _i = 0; _i < 2; ++_i) \
        __builtin_amdgcn_global_load_lds((const unsigned*)((const char*)(gbase) + (voff)[_i]), (PG8_LAS unsigned*)(lds + (bufoff) + ldsw + _i * 8192), 16, 0, 0); } while (0)
#define PG8_LDA(dst, b, h) do { _Pragma("unroll") for (int m = 0; m < 4; ++m) _Pragma("unroll") for (int k = 0; k < 2; ++k) dst[m][k] = *(const PG8_LAS bf16x8*)(lds + PG8_SA(b, h) + aoff + m * 2048 + k * 1024); } while (0)
#define PG8_LDB(dst, b, h) do { _Pragma("unroll") for (int n = 0; n < 2; ++n) _Pragma("unroll") for (int k = 0; k < 2; ++k) dst[n][k] = *(const PG8_LAS bf16x8*)(lds + PG8_SB(b, h) + boff + n * 2048 + k * 1024); } while (0)
#define PG8_MMA(ai, bj, At, Bt) do { __builtin_amdgcn_s_setprio(1); _Pragma("unroll") for (int m = 0; m < 4; ++m) _Pragma("unroll") for (int n = 0; n < 2; ++n) _Pragma("unroll") for (int k = 0; k < 2; ++k) \
        acc[ai][bj][m][n] = __builtin_amdgcn_mfma_f32_16x16x32_bf16(Bt[n][k], At[m][k], acc[ai][bj][m][n], 0, 0, 0); __builtin_amdgcn_s_setprio(0); } while (0)
#define PG8_WAIT_V(n) asm volatile("s_waitcnt vmcnt(" #n ")" ::: "memory")
#define PG8_WAIT_L(n) asm volatile("s_waitcnt lgkmcnt(" #n ")" ::: "memory")
#define PG8_BAR __builtin_amdgcn_s_barrier()
#define PG8_SCHED __builtin_amdgcn_sched_barrier(0)
    Unit cur, nxt; int ui = 0;
    if (!S.next(0, cur)) return;
    f32x4 acc[2][2][4][2];
#pragma unroll
    for (int a = 0; a < 2; ++a)
#pragma unroll
        for (int b = 0; b < 2; ++b)
#pragma unroll
            for (int m = 0; m < 4; ++m)
#pragma unroll
                for (int n = 0; n < 2; ++n) acc[a][b][m][n] = (f32x4){0.f, 0.f, 0.f, 0.f};
    bf16x8 At[4][2], B0[2][2], B1[2][2];
    const char* cA = (const char*)g.A + (size_t)cur.pm * tstepA; const char* cB = (const char*)g.Bt + (size_t)cur.pn * tstepB;
    S.a_ready(cur);
    if constexpr (SP2) {
        PG8_STAGE(PG8_SB(0, 0), cB, voffB); PG8_STAGE(PG8_SB(0, 1), cB + hstepB, voffB); PG8_STAGE(PG8_SA(0, 0), cA, voffA); PG8_STAGE(PG8_SA(0, 1), cA + hstepA, voffA);
        if (wr == 1) PG8_BAR;
        PG8_WAIT_V(2); PG8_BAR;
        PG8_STAGE(PG8_SB(1, 0), cB + kstep, voffB); PG8_STAGE(PG8_SA(1, 0), cA + kstep, voffA); PG8_STAGE(PG8_SB(1, 1), cB + hstepB + kstep, voffB);
        PG8_WAIT_V(6); PG8_BAR;
    } else {
        PG8_STAGE(PG8_SB(0, 0), cB, voffB); PG8_STAGE(PG8_SA(0, 0), cA, voffA); PG8_STAGE(PG8_SB(0, 1), cB + hstepB, voffB); PG8_STAGE(PG8_SA(0, 1), cA + hstepA, voffA);
        if (wr == 1) PG8_BAR;
        PG8_WAIT_V(4); PG8_BAR;
        PG8_STAGE(PG8_SB(1, 0), cB + kstep, voffB); PG8_STAGE(PG8_SA(1, 0), cA + kstep, voffA); PG8_STAGE(PG8_SB(1, 1), cB + hstepB + kstep, voffB);
        PG8_WAIT_V(6); PG8_BAR;
    }
    for (;;) {
        const bool has_next = S.next(ui + 1, nxt);
        const char* nA = has_next ? (const char*)g.A + (size_t)nxt.pm * tstepA : cA; const char* nB = has_next ? (const char*)g.Bt + (size_t)nxt.pn * tstepB : cB;
        for (int t = 0; t < nt; t += 2) {
            const bool last = (t == nt - 2);
            const char* a1 = cA + (size_t)(t + 1) * kstep;
            const char* a2 = last ? nA : cA + (size_t)(t + 2) * kstep; const char* b2 = last ? nB : cB + (size_t)(t + 2) * kstep;
            const char* a3 = a2 + kstep; const char* b3 = b2 + kstep;
            if (last && has_next) S.a_ready(nxt);
            if constexpr (SP2) {
            PG8_LDB(B0, 0, 0); PG8_LDB(B1, 0, 1); PG8_SCHED; PG8_LDA(At, 0, 0); PG8_STAGE(PG8_SA(1, 1), a1 + hstepA, voffA);
            PG8_WAIT_V(8); PG8_WAIT_L(0); PG8_BAR; PG8_MMA(0, 0, At, B0); PG8_MMA(0, 1, At, B1); PG8_BAR; PG8_SCHED;
            PG8_LDA(At, 0, 1); PG8_STAGE(PG8_SB(0, 0), b2, voffB); PG8_STAGE(PG8_SB(0, 1), b2 + hstepB, voffB); PG8_STAGE(PG8_SA(0, 0), a2, voffA);
            PG8_WAIT_V(8); PG8_WAIT_L(0); PG8_BAR; PG8_MMA(1, 0, At, B0); PG8_MMA(1, 1, At, B1); PG8_BAR; PG8_SCHED;
            PG8_LDB(B0, 1, 0); PG8_LDB(B1, 1, 1); PG8_SCHED; PG8_LDA(At, 1, 0); PG8_STAGE(PG8_SA(0, 1), a2 + hstepA, voffA);
            PG8_WAIT_V(8); PG8_WAIT_L(0); PG8_BAR; PG8_MMA(0, 0, At, B0); PG8_MMA(0, 1, At, B1); PG8_BAR; PG8_SCHED;
            PG8_LDA(At, 1, 1); PG8_STAGE(PG8_SB(1, 0), b3, voffB); PG8_STAGE(PG8_SB(1, 1), b3 + hstepB, voffB); PG8_STAGE(PG8_SA(1, 0), a3, voffA);
            PG8_WAIT_V(8); PG8_WAIT_L(0); PG8_BAR; PG8_MMA(1, 0, At, B0); PG8_MMA(1, 1, At, B1); PG8_BAR; PG8_SCHED;
            } else {
            PG8_LDB(B0, 0, 0); PG8_SCHED; PG8_LDA(At, 0, 0); PG8_STAGE(PG8_SA(1, 1), a1 + hstepA, voffA);
            PG8_WAIT_L(8); PG8_BAR; PG8_WAIT_L(0); PG8_MMA(0, 0, At, B0); PG8_BAR; PG8_SCHED;
            PG8_LDB(B1, 0, 1); PG8_STAGE(PG8_SB(0, 0), b2, voffB);
            PG8_BAR; PG8_WAIT_L(0); PG8_MMA(0, 1, At, B1); PG8_BAR;
            PG8_LDA(At, 0, 1); PG8_STAGE(PG8_SA(0, 0), a2, voffA);
            PG8_BAR; PG8_WAIT_L(0); PG8_MMA(1, 0, At, B0); PG8_BAR; PG8_SCHED;
            PG8_STAGE(PG8_SB(0, 1), b2 + hstepB, voffB);
            PG8_WAIT_V(6); PG8_BAR; PG8_MMA(1, 1, At, B1); PG8_BAR;
            PG8_LDB(B0, 1, 0); PG8_SCHED; PG8_LDA(At, 1, 0); PG8_STAGE(PG8_SA(0, 1), a2 + hstepA, voffA);
            PG8_WAIT_L(8); PG8_BAR; PG8_WAIT_L(0); PG8_MMA(0, 0, At, B0); PG8_BAR; PG8_SCHED;
            PG8_LDB(B1, 1, 1); PG8_STAGE(PG8_SB(1, 0), b3, voffB);
            PG8_BAR; PG8_WAIT_L(0); PG8_MMA(0, 1, At, B1); PG8_BAR;
            PG8_LDA(At, 1, 1); PG8_STAGE(PG8_SA(1, 0), a3, voffA);
            PG8_BAR; PG8_WAIT_L(0); PG8_MMA(1, 0, At, B0); PG8_BAR; PG8_SCHED;
            PG8_STAGE(PG8_SB(1, 1), b3 + hstepB, voffB);
            PG8_WAIT_V(6); PG8_BAR; PG8_MMA(1, 1, At, B1); PG8_BAR;
            }
        }
        if constexpr (ALIGN_EPI) { if (wr == 0) PG8_BAR; }
        if constexpr (!Epi::AFTER_DRAIN) { E(acc, cur, wr, wc, fr, fq); S.done(cur); }
        if (!has_next) break;
#pragma unroll
        for (int a = 0; a < 2; ++a)
#pragma unroll
            for (int b = 0; b < 2; ++b)
#pragma unroll
                for (int m = 0; m < 4; ++m)
#pragma unroll
                    for (int n = 0; n < 2; ++n) acc[a][b][m][n] = (f32x4){0.f, 0.f, 0.f, 0.f};
        cur = nxt; cA = nA; cB = nB; ++ui;
        if constexpr (ALIGN_EPI) { if (wr == 1) PG8_BAR; }
    }
    PG8_WAIT_V(0);
    if constexpr (!ALIGN_EPI) { if (wr == 0) PG8_BAR; }
    PG8_BAR;
    if constexpr (Epi::AFTER_DRAIN) { E.fused(acc, cur, wr, wc, fr, fq, lds, wid, lane); S.done(cur); }
#undef PG8_SA
#undef PG8_SB
#undef PG8_STAGE
#undef PG8_LDA
#undef PG8_LDB
#undef PG8_MMA
#undef PG8_WAIT_V
#undef PG8_WAIT_L
#undef PG8_BAR
#undef PG8_SCHED
}
}
namespace att {
typedef unsigned short bf16_t;
using bf16x8 = __attribute__((ext_vector_type(8))) short;
using s16x4  = __attribute__((ext_vector_type(4))) short;
using f32x16 = __attribute__((ext_vector_type(16))) float;
using u32x4  = __attribute__((ext_vector_type(4))) unsigned;
constexpr int DV = 128, NW = 8, QBLK = 32, KVBLK = 64;
constexpr float THR = 8.f;
constexpr int SHM_V = KVBLK * DV * 2;
template <int DQK> struct Cfg {
    static constexpr int SHM_K = KVBLK * DQK * 2, KROWB = DQK * 2, NCK = DQK / 64, C8 = DQK / 8, ND0 = DQK / 16;
    static constexpr float SCALE = (DQK == 128) ? 0.088388347648318440f : 0.072168783648703220f;
    static constexpr int LDS_BYTES = 2 * SHM_V + 2 * SHM_K + NW * 64 * 4;
};
#define ATT_SBAR() __builtin_amdgcn_sched_barrier(0)
__device__ __forceinline__ int crow(int r, int hi) { return (r & 3) + 8 * (r >> 2) + 4 * hi; }
__device__ __forceinline__ unsigned cvtpk(float lo, float hi) { unsigned r; asm volatile("v_cvt_pk_bf16_f32 %0, %1, %2" : "=v"(r) : "v"(lo), "v"(hi)); return r; }
template <int DQK> __device__ __forceinline__ int kswz(int row, int colB) {
    const int key = (DQK == 128) ? (row & 7) : ((row >> 1) & 7);
    return row * (DQK * 2) + (colB ^ (key << 4));
}
template <int DQK> __device__ __forceinline__ void partialSM(f32x16& p0, f32x16& p1, float& m_reg, float& mn, float& alpha) {
    constexpr float SCALE = Cfg<DQK>::SCALE, C = SCALE * 1.4426950408889634f;
    float pmax = p0[0];
#pragma unroll
    for (int r = 1; r < 16; ++r) pmax = fmaxf(pmax, p0[r]);
#pragma unroll
    for (int r = 0; r < 16; ++r) pmax = fmaxf(pmax, p1[r]);
    { auto rr = __builtin_amdgcn_permlane32_swap(__float_as_uint(pmax), __float_as_uint(pmax), false, false);
      pmax = fmaxf(__uint_as_float(rr[0]), __uint_as_float(rr[1])); }
    if (__builtin_expect(__all(pmax - m_reg <= THR / SCALE), 1)) { mn = m_reg; alpha = 1.f; }
    else { mn = fmaxf(m_reg, pmax); alpha = __builtin_amdgcn_exp2f((m_reg - mn) * C); m_reg = mn; }
    const float mnC = -mn * C;
#pragma unroll
    for (int r = 0; r < 16; ++r) p0[r] = fmaf(p0[r], C, mnC);
#pragma unroll
    for (int r = 0; r < 16; ++r) p1[r] = fmaf(p1[r], C, mnC);
#pragma unroll
    for (int r = 0; r < 16; ++r) p0[r] = __builtin_amdgcn_exp2f(p0[r]);
}
__device__ __forceinline__ void finishSM(f32x16& p0, f32x16& p1, float alpha, float& l_reg, bf16x8& pa0, bf16x8& pa1, bf16x8& pa2, bf16x8& pa3) {
#pragma unroll
    for (int r = 0; r < 16; ++r) p1[r] = __builtin_amdgcn_exp2f(p1[r]);
    float ps = 0;
#pragma unroll
    for (int r = 0; r < 16; ++r) ps += p0[r];
#pragma unroll
    for (int r = 0; r < 16; ++r) ps += p1[r];
    { auto rr = __builtin_amdgcn_permlane32_swap(__float_as_uint(ps), __float_as_uint(ps), false, false);
      ps = __uint_as_float(rr[0]) + __uint_as_float(rr[1]); }
    l_reg = l_reg * alpha + ps;
#define ATT_PK4(P, BASE, OUT) do { unsigned a0 = cvtpk(P[BASE + 0], P[BASE + 1]), a1 = cvtpk(P[BASE + 2], P[BASE + 3]);   \
    unsigned b0 = cvtpk(P[BASE + 4], P[BASE + 5]), b1 = cvtpk(P[BASE + 6], P[BASE + 7]);                              \
    auto r0 = __builtin_amdgcn_permlane32_swap(a0, b0, false, false); auto r1 = __builtin_amdgcn_permlane32_swap(a1, b1, false, false); \
    u32x4 w = {r0[0], r1[0], r0[1], r1[1]}; OUT = *reinterpret_cast<bf16x8*>(&w); } while (0)
    ATT_PK4(p0, 0, pa0); ATT_PK4(p0, 8, pa1); ATT_PK4(p1, 0, pa2); ATT_PK4(p1, 8, pa3);
#undef ATT_PK4
}
template <int DQK> __device__ __forceinline__ void qkt(f32x16& p0, f32x16& p1, const char* Ks, const bf16x8* qr, int r32, int hi) {
    p0 = f32x16{}; p1 = f32x16{};
#pragma unroll
    for (int d0 = 0; d0 < Cfg<DQK>::ND0; ++d0) { const int cb = (d0 * 16 + hi * 8) * 2;
        bf16x8 b0 = *reinterpret_cast<const bf16x8*>(Ks + kswz<DQK>(r32, cb));
        bf16x8 b1 = *reinterpret_cast<const bf16x8*>(Ks + kswz<DQK>(32 + r32, cb));
        p0 = __builtin_amdgcn_mfma_f32_32x32x16_bf16(b0, qr[d0], p0, 0, 0, 0);
        p1 = __builtin_amdgcn_mfma_f32_32x32x16_bf16(b1, qr[d0], p1, 0, 0, 0); }
}
__device__ __forceinline__ int v_st(int k, int c) { const int kk = (k & ~0xC) | ((k & 4) << 1) | ((k & 8) >> 1); return ((kk >> 3) * 4 + (c >> 5)) * 512 + ((kk & 7) * 32 + (c & 31)) * 2; }
__device__ __forceinline__ int v_rd_base(int lane) { return ((lane & 3) << 3) | (((lane >> 2) & 3) << 6) | (((lane >> 4) & 1) << 5) | (((lane >> 5) & 1) << 8); }
constexpr int v_rd_off(int d0, int ks, int half) { return d0 * 512 + ks * 4096 + half * 2048; }
template <int OFF> __device__ __forceinline__ s16x4 tr_read(int vb) {
    s16x4 r; asm volatile("ds_read_b64_tr_b16 %0, %1 offset:%2" : "=&v"(r) : "v"(vb), "i"(OFF) : "memory"); return r;
}
template <int D0> __device__ __forceinline__ void pv_one(f32x16& od, int vb, bf16x8 pa0, bf16x8 pa1, bf16x8 pa2, bf16x8 pa3) {
    const s16x4 l0 = tr_read<v_rd_off(D0, 0, 0)>(vb), h0 = tr_read<v_rd_off(D0, 0, 1)>(vb), l1 = tr_read<v_rd_off(D0, 1, 0)>(vb), h1 = tr_read<v_rd_off(D0, 1, 1)>(vb);
    const s16x4 l2 = tr_read<v_rd_off(D0, 2, 0)>(vb), h2 = tr_read<v_rd_off(D0, 2, 1)>(vb), l3 = tr_read<v_rd_off(D0, 3, 0)>(vb), h3 = tr_read<v_rd_off(D0, 3, 1)>(vb);
    asm volatile("s_waitcnt lgkmcnt(0)" ::: "memory"); ATT_SBAR();
#define ATT_PK(L, H) (bf16x8){L[0], L[1], L[2], L[3], H[0], H[1], H[2], H[3]}
    od = __builtin_amdgcn_mfma_f32_32x32x16_bf16(pa0, ATT_PK(l0, h0), od, 0, 0, 0);
    od = __builtin_amdgcn_mfma_f32_32x32x16_bf16(pa1, ATT_PK(l1, h1), od, 0, 0, 0);
    od = __builtin_amdgcn_mfma_f32_32x32x16_bf16(pa2, ATT_PK(l2, h2), od, 0, 0, 0);
    od = __builtin_amdgcn_mfma_f32_32x32x16_bf16(pa3, ATT_PK(l3, h3), od, 0, 0, 0);
#undef ATT_PK
}
__device__ __forceinline__ void pv_d0(f32x16* o, int vb, bf16x8 pa0, bf16x8 pa1, bf16x8 pa2, bf16x8 pa3) {
    pv_one<0>(o[0], vb, pa0, pa1, pa2, pa3); pv_one<1>(o[1], vb, pa0, pa1, pa2, pa3); pv_one<2>(o[2], vb, pa0, pa1, pa2, pa3); pv_one<3>(o[3], vb, pa0, pa1, pa2, pa3);
}
template <int DQK, int LDQ, int LDK, int LDV, int LDO, int SDEPTH>
__device__ __forceinline__ void attn_body(const bf16_t* __restrict__ Qb, const bf16_t* __restrict__ Kh, const bf16_t* __restrict__ Vh, bf16_t* __restrict__ Ob, int seq, char* lds, int tid_in) {
    using C_ = Cfg<DQK>;
    constexpr int SHM_K = C_::SHM_K, NCK = C_::NCK, C8 = C_::C8, ND0 = C_::ND0;
    int tid_ = tid_in; asm volatile("" : "+v"(tid_));
    const int tid = tid_, wid = tid >> 6, lane = tid & 63, r32 = lane & 31, hi = lane >> 5;
    char* V_lds = lds; char* K_lds = lds + 2 * SHM_V;
    float* ws = (float*)(lds + 2 * SHM_V + 2 * SHM_K) + wid * 64; float* li_l = ws; float* al_l = ws + 32;
    float m_reg = -1e30f, l_reg = 0; f32x16 o[4] = {}; bf16x8 qr[ND0];
    const bf16_t* Qw = Qb + (long)(wid * QBLK + r32) * LDQ + hi * 8;
#pragma unroll
    for (int d0 = 0; d0 < ND0; ++d0) qr[d0] = *reinterpret_cast<const bf16x8*>(Qw + d0 * 16);
    const int sr = tid >> 4, sc = (tid & 15) * 8, vst0 = v_st(sr, sc), vst1 = v_st(32 + sr, sc);
    int krow[NCK], kcol[NCK];
#pragma unroll
    for (int i = 0; i < NCK; ++i) { const int ci = tid + 512 * i; krow[i] = ci / C8; kcol[i] = (ci % C8) * 8; }
    const int vb0 = (int)(uintptr_t)V_lds + v_rd_base(lane);
    struct { bf16x8 vs0, vs1, ks[NCK]; } sr_[SDEPTH];
#define ATT_SLOAD(i, k0) do { sr_[i].vs0 = *reinterpret_cast<const bf16x8*>(&Vh[(long)((k0) + sr) * LDV + sc]); sr_[i].vs1 = *reinterpret_cast<const bf16x8*>(&Vh[(long)((k0) + 32 + sr) * LDV + sc]); \
    _Pragma("unroll") for (int c_ = 0; c_ < NCK; ++c_) sr_[i].ks[c_] = *reinterpret_cast<const bf16x8*>(&Kh[(long)((k0) + krow[c_]) * LDK + kcol[c_]]); } while (0)
#define ATT_SWRITE(b, i) do { *(bf16x8*)(V_lds + (b) * SHM_V + vst0) = sr_[i].vs0; *(bf16x8*)(V_lds + (b) * SHM_V + vst1) = sr_[i].vs1; \
    _Pragma("unroll") for (int c_ = 0; c_ < NCK; ++c_) *(bf16x8*)(K_lds + (b) * SHM_K + kswz<DQK>(krow[c_], kcol[c_] * 2)) = sr_[i].ks[c_]; } while (0)
#define ATT_SWAIT() do { if constexpr (SDEPTH == 2) { if constexpr (NCK == 2) asm volatile("s_waitcnt vmcnt(4)" ::: "memory"); else asm volatile("s_waitcnt vmcnt(5)" ::: "memory"); } else asm volatile("s_waitcnt vmcnt(0)" ::: "memory"); } while (0)
#define ATT_RESC(a) do { if (__any((a) < 1.f)) { if (hi == 0) al_l[r32] = (a); asm volatile("s_waitcnt lgkmcnt(0)" ::: "memory"); \
    _Pragma("unroll") for (int d = 0; d < 4; ++d) _Pragma("unroll") for (int r = 0; r < 16; ++r) o[d][r] *= al_l[crow(r, hi)]; } } while (0)
    f32x16 pA0, pA1, pB0, pB1; float mnA, mnB, alA, alB; bf16x8 pa0, pa1, pa2, pa3; const int NT = seq / KVBLK;
    constexpr int SE = 0, SO = SDEPTH - 1;
    ATT_SLOAD(SE, 0); asm volatile("s_waitcnt vmcnt(0)" ::: "memory"); ATT_SWRITE(0, SE); __syncthreads();
    qkt<DQK>(pA0, pA1, K_lds, qr, r32, hi); partialSM<DQK>(pA0, pA1, m_reg, mnA, alA);
    ATT_SLOAD(SO, KVBLK); if constexpr (SDEPTH == 2) { if (2 < NT) ATT_SLOAD(SE, 2 * KVBLK); }
    ATT_SWAIT(); ATT_SWRITE(1, SO); __syncthreads();
    for (int j = 1; j + 1 < NT; j += 2) {
        ATT_SBAR(); qkt<DQK>(pB0, pB1, K_lds + SHM_K, qr, r32, hi);
        finishSM(pA0, pA1, alA, l_reg, pa0, pa1, pa2, pa3); ATT_SBAR();
        ATT_SLOAD(SO, (j + SDEPTH) * KVBLK); ATT_SBAR();
        pv_d0(o, vb0, pa0, pa1, pa2, pa3); partialSM<DQK>(pB0, pB1, m_reg, mnB, alB);
        __syncthreads(); ATT_SWAIT(); ATT_SWRITE(0, SE);
        ATT_RESC(alB); __syncthreads();
        ATT_SBAR(); qkt<DQK>(pA0, pA1, K_lds, qr, r32, hi);
        finishSM(pB0, pB1, alB, l_reg, pa0, pa1, pa2, pa3); ATT_SBAR();
        if (SDEPTH == 1 || j + 3 < NT) ATT_SLOAD(SE, (j + 1 + SDEPTH) * KVBLK); ATT_SBAR();
        pv_d0(o, vb0 + (int)SHM_V, pa0, pa1, pa2, pa3); partialSM<DQK>(pA0, pA1, m_reg, mnA, alA);
        __syncthreads(); ATT_SWAIT(); ATT_SWRITE(1, SO);
        ATT_RESC(alA); __syncthreads();
    }
    ATT_SBAR(); qkt<DQK>(pB0, pB1, K_lds + SHM_K, qr, r32, hi);
    finishSM(pA0, pA1, alA, l_reg, pa0, pa1, pa2, pa3); ATT_SBAR();
    pv_d0(o, vb0, pa0, pa1, pa2, pa3); partialSM<DQK>(pB0, pB1, m_reg, mnB, alB);
    __syncthreads(); ATT_RESC(alB);
    finishSM(pB0, pB1, alB, l_reg, pa0, pa1, pa2, pa3); ATT_SBAR();
    pv_d0(o, vb0 + (int)SHM_V, pa0, pa1, pa2, pa3);
    if (hi == 0) li_l[r32] = l_reg;
    asm volatile("s_waitcnt lgkmcnt(0)" ::: "memory");
    __syncthreads();
    float rli[16];
#pragma unroll
    for (int r = 0; r < 16; ++r) rli[r] = __builtin_amdgcn_rcpf(li_l[crow(r, hi)]);
    unsigned short* stg = (unsigned short*)(lds + wid * 8192);
#pragma unroll
    for (int r = 0; r < 16; ++r) { const int orow = crow(r, hi);
#pragma unroll
        for (int d0 = 0; d0 < 4; ++d0) { const unsigned w = cvtpk(o[d0][r] * rli[r], 0.f); stg[orow * 128 + d0 * 32 + r32] = (unsigned short)(w & 0xffffu); } }
    asm volatile("s_waitcnt lgkmcnt(0)" ::: "memory");
    bf16_t* Ow = Ob + (long)(wid * QBLK) * LDO;
#pragma unroll
    for (int i = 0; i < 8; ++i) { const int id = lane + 64 * i, row = id >> 4, c16 = id & 15;
        const u32x4 v = *(const u32x4*)((const char*)stg + row * 256 + c16 * 16);
        *(u32x4*)(Ow + (long)row * LDO + c16 * 8) = v; }
    asm volatile("s_waitcnt lgkmcnt(0)" ::: "memory");
    __syncthreads();
#undef ATT_SLOAD
#undef ATT_SWRITE
#undef ATT_SWAIT
#undef ATT_RESC
}

template <int DQK, int LDQ, int LDK, int LDV, int LDO>
__device__ __forceinline__ void attn_body1(const bf16_t* __restrict__ Qb, const bf16_t* __restrict__ Kh, const bf16_t* __restrict__ Vh, bf16_t* __restrict__ Ob, int seq, char* lds, int tid_in) {
    using C_ = Cfg<DQK>;
    constexpr int SHM_K = C_::SHM_K, NCK = C_::NCK, C8 = C_::C8, ND0 = C_::ND0;
    int tid_ = tid_in; asm volatile("" : "+v"(tid_));
    const int tid = tid_, wid = tid >> 6, lane = tid & 63, r32 = lane & 31, hi = lane >> 5;
    char* V_lds = lds; char* K_lds = lds + 2 * SHM_V;
    float* ws = (float*)(lds + 2 * SHM_V + 2 * SHM_K) + wid * 64; float* li_l = ws; float* al_l = ws + 32;
    float m_reg = -1e30f, l_reg = 0; f32x16 o[4] = {}; bf16x8 qr[ND0];
    const bf16_t* Qw = Qb + (long)(wid * QBLK + r32) * LDQ + hi * 8;
#pragma unroll
    for (int d0 = 0; d0 < ND0; ++d0) qr[d0] = *reinterpret_cast<const bf16x8*>(Qw + d0 * 16);
    const int sr = tid >> 4, sc = (tid & 15) * 8, vst0 = v_st(sr, sc), vst1 = v_st(32 + sr, sc);
    int krow[NCK], kcol[NCK];
#pragma unroll
    for (int i = 0; i < NCK; ++i) { const int ci = tid + 512 * i; krow[i] = ci / C8; kcol[i] = (ci % C8) * 8; }
    const int vb0 = (int)(uintptr_t)V_lds + v_rd_base(lane);
    bf16x8 vs0, vs1, ks[NCK];
#define ATT1_SLOAD(k0) do { vs0 = *reinterpret_cast<const bf16x8*>(&Vh[(long)((k0) + sr) * LDV + sc]); vs1 = *reinterpret_cast<const bf16x8*>(&Vh[(long)((k0) + 32 + sr) * LDV + sc]); \
    _Pragma("unroll") for (int c_ = 0; c_ < NCK; ++c_) ks[c_] = *reinterpret_cast<const bf16x8*>(&Kh[(long)((k0) + krow[c_]) * LDK + kcol[c_]]); } while (0)
#define ATT1_SWRITE(b) do { *(bf16x8*)(V_lds + (b) * SHM_V + vst0) = vs0; *(bf16x8*)(V_lds + (b) * SHM_V + vst1) = vs1; \
    _Pragma("unroll") for (int c_ = 0; c_ < NCK; ++c_) *(bf16x8*)(K_lds + (b) * SHM_K + kswz<DQK>(krow[c_], kcol[c_] * 2)) = ks[c_]; } while (0)
    const int NT = seq / KVBLK;
    ATT1_SLOAD(0); asm volatile("s_waitcnt vmcnt(0)" ::: "memory"); ATT1_SWRITE(0); __syncthreads();
    for (int j = 0; j < NT; ++j) {
        const int b = j & 1;
        if (j + 1 < NT) ATT1_SLOAD((j + 1) * KVBLK);
        ATT_SBAR();
        f32x16 p0, p1; float mn, alpha; bf16x8 pa0, pa1, pa2, pa3;
        qkt<DQK>(p0, p1, K_lds + b * SHM_K, qr, r32, hi);
        partialSM<DQK>(p0, p1, m_reg, mn, alpha);
        if (__any(alpha < 1.f)) { if (hi == 0) al_l[r32] = alpha; asm volatile("s_waitcnt lgkmcnt(0)" ::: "memory");
#pragma unroll
            for (int d = 0; d < 4; ++d)
#pragma unroll
                for (int r = 0; r < 16; ++r) o[d][r] *= al_l[crow(r, hi)]; }
        finishSM(p0, p1, alpha, l_reg, pa0, pa1, pa2, pa3); ATT_SBAR();
        pv_d0(o, vb0 + b * (int)SHM_V, pa0, pa1, pa2, pa3);
        if (j + 1 < NT) { ATT1_SWRITE(b ^ 1); }
        __syncthreads();
    }
    if (hi == 0) li_l[r32] = l_reg;
    asm volatile("s_waitcnt lgkmcnt(0)" ::: "memory");
    __syncthreads();
    float rli[16];
#pragma unroll
    for (int r = 0; r < 16; ++r) rli[r] = __builtin_amdgcn_rcpf(li_l[crow(r, hi)]);
    unsigned short* stg = (unsigned short*)(lds + wid * 8192);
#pragma unroll
    for (int r = 0; r < 16; ++r) { const int orow = crow(r, hi);
#pragma unroll
        for (int d0 = 0; d0 < 4; ++d0) { const unsigned w = cvtpk(o[d0][r] * rli[r], 0.f); stg[orow * 128 + d0 * 32 + r32] = (unsigned short)(w & 0xffffu); } }
    asm volatile("s_waitcnt lgkmcnt(0)" ::: "memory");
    bf16_t* Ow = Ob + (long)(wid * QBLK) * LDO;
#pragma unroll
    for (int i = 0; i < 8; ++i) { const int id = lane + 64 * i, row = id >> 4, c16 = id & 15;
        const u32x4 v = *(const u32x4*)((const char*)stg + row * 256 + c16 * 16);
        *(u32x4*)(Ow + (long)row * LDO + c16 * 8) = v; }
    asm volatile("s_waitcnt lgkmcnt(0)" ::: "memory");
    __syncthreads();
#undef ATT1_SLOAD
#undef ATT1_SWRITE
}
}
constexpr int DM = 2048, NBATCH = 2, SEQ = 4096, CTX = 256, RB = SEQ + CTX  , MROWS = NBATCH * RB  ;
constexpr int NMOD = 6 * DM, NEXP = 16384;
constexpr float EPS = 1e-6f;
constexpr int NWAVES = 8, NTHREADS = 512;
constexpr size_t MiB = 1u << 20;
constexpr size_t WS_CTL = 0, CTL_ZERO_BYTES = 64 * 1024;
constexpr size_t WS_MOD = 1 * MiB;
constexpr size_t WS_ROPE = 2 * MiB;
constexpr size_t WS_SMALL = 3 * MiB;
constexpr int SM_N1G = 0, SM_N2G = 8192, SM_AQG = 16384, SM_AKG = 16384 + 384, SM_CW = 16384 + 768, SM_CB = SM_CW + 6144, SM_CQG = SM_CB + 2048, SM_CKG = SM_CQG + 256, SM_END = SM_CKG + 256;
constexpr size_t WS_PTRS = 3 * MiB + 512 * 1024;
constexpr size_t WS_XW = 4 * MiB;
constexpr size_t WS_H = 72 * MiB;
constexpr size_t WS_P = 106 * MiB;
constexpr size_t WS_QRAW = 174 * MiB;
constexpr size_t WS_KVRAW = 200 * MiB;
constexpr size_t WS_Q = 234 * MiB;
constexpr size_t WS_K = 268 * MiB;
constexpr size_t WS_V = 294 * MiB;
constexpr size_t WS_CAT = 311 * MiB;
constexpr size_t WS_PQ = 345 * MiB;
constexpr size_t WS_IDX = 379 * MiB;
constexpr size_t WS_GATE = 384 * MiB;
constexpr size_t WS_WIN = 389 * MiB;
constexpr size_t WS_WUQ = 421 * MiB;
constexpr size_t WS_WUKV = 424 * MiB;
constexpr size_t WS_WEO = 426 * MiB;
constexpr size_t WS_WQKV = 442 * MiB;
constexpr size_t WS_WCO = 466 * MiB;
constexpr size_t WS_WPQ = 482 * MiB;
constexpr size_t WS_SUBK = 514 * MiB;
#ifndef TAB_FP4
#define TAB_FP4 1
#endif
#if TAB_FP4
constexpr int ROWB = 1024;
#else
constexpr int ROWB = 1536;
#endif
constexpr size_t WS_U = 516 * MiB;
constexpr size_t WS_VT = 644 * MiB;
constexpr size_t WS_USC = 772 * MiB;
constexpr size_t WS_VSC = 773 * MiB;
constexpr size_t WS_XQ = 810 * MiB;
constexpr size_t WS_XS = 828 * MiB;
constexpr size_t WS_PART = 774 * MiB;
constexpr size_t WS_END = 834 * MiB;
#ifndef EXP_SLICED
#define EXP_SLICED 1
#endif
constexpr int CW_BAR = 4096;
constexpr int LDS_MISC = 131072 + 8192;
constexpr int LDS_BYTES = 147456;

#define LAS __attribute__((address_space(3)))
typedef unsigned short bf16_t;
typedef float f32x4 __attribute__((ext_vector_type(4)));
typedef unsigned u32x4 __attribute__((ext_vector_type(4)));
typedef unsigned u32x2 __attribute__((ext_vector_type(2)));
typedef short bf16x8 __attribute__((ext_vector_type(8)));
typedef float f32x16 __attribute__((ext_vector_type(16)));
typedef __bf16 bf16x2_t __attribute__((ext_vector_type(2)));
typedef float f32x2 __attribute__((ext_vector_type(2)));
typedef _Float16 h2_t __attribute__((ext_vector_type(2)));
typedef float f32x32 __attribute__((ext_vector_type(32)));
typedef unsigned u32x6 __attribute__((ext_vector_type(6)));

__device__ __forceinline__ unsigned f2bf(float f) { unsigned u = __builtin_bit_cast(unsigned, f); return (u + 0x7fffu + ((u >> 16) & 1u)) >> 16; }
__device__ __forceinline__ unsigned pk2(float lo, float hi) { return f2bf(lo) | (f2bf(hi) << 16); }
__device__ __forceinline__ float bf_lo(unsigned w) { return __builtin_bit_cast(float, w << 16); }
__device__ __forceinline__ float bf_hi(unsigned w) { return __builtin_bit_cast(float, w & 0xffff0000u); }
__device__ __forceinline__ float bf2f(bf16_t h) { return __builtin_bit_cast(float, (unsigned)h << 16); }
__device__ __forceinline__ float wave_sum(float v) {
#pragma unroll
    for (int o = 1; o < 64; o <<= 1) v += __shfl_xor(v, o);
    return v;
}
#define DPP_ADD(v, ctrl) ((v) + __builtin_bit_cast(float, __builtin_amdgcn_update_dpp(0, __builtin_bit_cast(int, (v)), (ctrl), 0xf, 0xf, true)))
__device__ __forceinline__ float wave_sum_dpp(float v) {
    v = DPP_ADD(v, 0xB1);
    v = DPP_ADD(v, 0x4E);
    v = DPP_ADD(v, 0x141);
    v = DPP_ADD(v, 0x140);
    const int vi = __builtin_bit_cast(int, v);
    const float s0 = __builtin_bit_cast(float, __builtin_amdgcn_readlane(vi, 0)), s1 = __builtin_bit_cast(float, __builtin_amdgcn_readlane(vi, 16));
    const float s2 = __builtin_bit_cast(float, __builtin_amdgcn_readlane(vi, 32)), s3 = __builtin_bit_cast(float, __builtin_amdgcn_readlane(vi, 48));
    return (s0 + s1) + (s2 + s3);
}
__device__ __forceinline__ float dot2_bf16(unsigned w, unsigned x, float acc) { return __builtin_amdgcn_fdot2_f32_bf16(__builtin_bit_cast(bf16x2_t, w), __builtin_bit_cast(bf16x2_t, x), acc, false); }
__device__ __forceinline__ float gelu_erf(float v) {
    const float av = fabsf(v), t = __builtin_amdgcn_rcpf(av * 0.2316418882f + 1.0f);
    float q = t * 0.5307027145f + (-0.7265760135f); q = q * t + 0.7107068705f; q = q * t + (-0.142248368f); q = q * t + 0.127414796f; q = q * t;
    const float e = __builtin_amdgcn_exp2f((v * v) * (-0.72134752044f));
    const float m = v * (q * e);
    return v < 0.f ? m : v - m;
}
#define XB_TMO      128
#define XB_XCNT(j)  (256  + 64 * (j))
#define XB_XSUB(j)  (1280 + 64 * (j))
#define XB_XGEN(j)  (2304 + 64 * (j))
#define XB_TOP      3328
#define XB_TOPGEN   3392
#define XCD_BAR_WORDS 3456
#define XB_SPIN_CAP (1u << 18)

__device__ __forceinline__ unsigned xb_ld(unsigned* p)              { return __hip_atomic_load(p, __ATOMIC_RELAXED, __HIP_MEMORY_SCOPE_AGENT); }
__device__ __forceinline__ unsigned xb_add(unsigned* p, unsigned v) { return __hip_atomic_fetch_add(p, v, __ATOMIC_RELAXED, __HIP_MEMORY_SCOPE_AGENT); }
__device__ __forceinline__ unsigned xb_xcc_id() { return (unsigned)__builtin_amdgcn_s_getreg((3 << 11) | 20) & 0xFu; }
#define XB_SPIN(cond, bar) do { unsigned _sp = 0; while (cond) { __builtin_amdgcn_s_sleep(1); \
    if ((++_sp & 255u) == 0u) { if (xb_ld(&(bar)[XB_TMO])) break; if (_sp > XB_SPIN_CAP) { atomicAdd(&(bar)[XB_TMO], 1u); break; } } } } while (0)

struct XcdBarrier {
    unsigned* bar; unsigned x;
    volatile LAS unsigned* st;
};

__device__ __forceinline__ XcdBarrier xcd_barrier_post(unsigned* bar, volatile LAS unsigned* st) {
    XcdBarrier b; b.bar = bar; b.x = xb_xcc_id(); b.st = st;
    if (threadIdx.x == 0) (void)xb_add(&bar[XB_XCNT(b.x)], 1u);
    return b;
}
__device__ __forceinline__ void xcd_barrier_complete(unsigned* bar, unsigned x, unsigned& nloc, unsigned& nx) {
    const unsigned G = gridDim.x * gridDim.y * gridDim.z;
    unsigned sum, cnt, mine, sp = 0u;
    for (;;) {
        sum = 0u; cnt = 0u; mine = 0u;
#pragma unroll
        for (unsigned j = 0; j < 16; ++j) { const unsigned c = xb_ld(&bar[XB_XCNT(j)]); sum += c; cnt += (c > 0u) ? 1u : 0u; mine = (j == x) ? c : mine; }
        if (sum == G) break;
        __builtin_amdgcn_s_sleep(1);
        if ((++sp & 255u) == 0u) { if (xb_ld(&bar[XB_TMO])) break; if (sp > XB_SPIN_CAP) { atomicAdd(&bar[XB_TMO], 1u); break; } }
    }
    nloc = mine > 0u ? mine : 1u; nx = cnt > 0u ? cnt : 1u;
}

__device__ __forceinline__ void xcd_barrier(const XcdBarrier& b) {
    asm volatile("s_waitcnt vmcnt(0)" ::: "memory");
    __syncthreads();
    if (threadIdx.x == 0) {
        unsigned* bar = b.bar; unsigned bx = b.x;
        asm volatile("" : "+s"(bar), "+s"(bx));
        __builtin_amdgcn_s_waitcnt(0);
        unsigned nloc = b.st[0], nx = b.st[1];
        if (nloc == 0u) { xcd_barrier_complete(bar, bx, nloc, nx); b.st[0] = nloc; b.st[1] = nx; }
        const unsigned old = xb_add(&bar[XB_XSUB(bx)], 1u);
        const unsigned gen = old / nloc;
        if (old + 1u == (gen + 1u) * nloc) {
            __builtin_amdgcn_fence(__ATOMIC_RELEASE, "agent");
            asm volatile("s_waitcnt vmcnt(0)" ::: "memory");
            const unsigned og = xb_add(&bar[XB_TOP], 1u);
            const unsigned tg = og / nx;
            if (og + 1u == (tg + 1u) * nx) xb_add(&bar[XB_TOPGEN], 1u);
            else XB_SPIN(xb_ld(&bar[XB_TOPGEN]) == tg, bar);
            __builtin_amdgcn_fence(__ATOMIC_ACQUIRE, "agent");
            xb_add(&bar[XB_XGEN(bx)], 1u);
            asm volatile("s_waitcnt vmcnt(0)" ::: "memory");
        } else {
            XB_SPIN(xb_ld(&bar[XB_XGEN(bx)]) == gen, bar);
            __builtin_amdgcn_fence(__ATOMIC_ACQUIRE, "agent");
            asm volatile("s_waitcnt vmcnt(0)" ::: "memory");
        }
    }
    __syncthreads();
}
struct Frame {
    LAS unsigned char* lds;
    int tid, lane, wave, vcu, G, gw, NGW;
    unsigned char* ws;
};
__device__ __forceinline__ int opaque_v(int v) { asm volatile("" : "+v"(v)); return v; }
__device__ __forceinline__ int phase_tid(int wave) { int lane; asm volatile("v_mbcnt_lo_u32_b32 %0, -1, 0\n\tv_mbcnt_hi_u32_b32 %0, -1, %0" : "=v"(lane)); return wave * 64 + lane; }
__device__ __forceinline__ Frame phase_frame(const Frame& F0) { Frame F = F0; F.tid = phase_tid(F0.wave); F.lane = F.tid & 63; return F; }
__device__ __forceinline__ float swap32(float v, int lane) { auto rr = __builtin_amdgcn_permlane32_swap(__float_as_uint(v), __float_as_uint(v), false, false); return __uint_as_float(lane < 32 ? rr[1] : rr[0]); }
__device__ __forceinline__ int row_cls(int row) { const int b = row / RB, i = row - b * RB; return i < CTX ? 2 : b; }

__device__ __forceinline__ void p0_transpose_item(const float* W, int K, int N, bf16_t* WT, const float* gain, LAS float* scr, int item, int lane, bool perm_q = false) {
    const int nblk = N / 32, kb = item / nblk, nb = item % nblk, k0 = 64 * kb, n0 = 32 * nb;
    {
        const int rgp = lane >> 3, c4 = (lane & 7) * 4; f32x4 tv[8];
#pragma unroll
        for (int i = 0; i < 8; ++i) tv[i] = *(const f32x4*)(W + (size_t)(k0 + 8 * i + rgp) * N + n0 + c4);
#pragma unroll
        for (int i = 0; i < 8; ++i) { const int kk = 8 * i + rgp; f32x4 v = tv[i]; if (gain) v = v * gain[k0 + kk];
            LAS float* d = scr + kk * 33 + c4; d[0] = v.x; d[1] = v.y; d[2] = v.z; d[3] = v.w; }
    }
    asm volatile("s_waitcnt lgkmcnt(0)" ::: "memory");
    const int c = lane & 7;
#pragma unroll
    for (int j = 0; j < 4; ++j) { const int n = (lane >> 3) + 8 * j; const LAS float* s = scr + (8 * c) * 33 + n;
        u32x4 o; o.x = pk2(s[0 * 33], s[1 * 33]); o.y = pk2(s[2 * 33], s[3 * 33]); o.z = pk2(s[4 * 33], s[5 * 33]); o.w = pk2(s[6 * 33], s[7 * 33]);
        int nn = n0 + n; if (perm_q) { const int hh = nn / 192, e = nn - hh * 192; nn = (e < 128) ? hh * 128 + e : 1024 + hh * 64 + (e - 128); }
        *(u32x4*)(WT + (size_t)nn * K + k0 + 8 * c) = o; }
    asm volatile("s_waitcnt lgkmcnt(0)" ::: "memory");
}
struct TrDesc { const float* W; const float* gain; bf16_t* WT; int K, N, items; };

__device__ __forceinline__ void p0_gemv_task(Frame& F, int task, const float* ada_w, const float* ada_b, float* mod) {
    LAS float* sv = (LAS float*)F.lds; LAS float* part = (LAS float*)(F.lds + 32768);
    const int l = task / 192, n0 = (task % 192) * 64, rg = F.lane >> 4, c4 = (F.lane & 15) * 4;
    const float* Wp = ada_w + (size_t)l * DM * NMOD + n0 + c4 + (size_t)(F.wave * 256 + rg) * NMOD;
    f32x4 a0 = {0, 0, 0, 0}, a1 = a0, a2 = a0;
    for (int k = 0; k < 256; k += 32) {
        f32x4 w[8];
#pragma unroll
        for (int u = 0; u < 8; ++u) w[u] = *(const f32x4*)(Wp + (size_t)(k + 4 * u) * NMOD);
#pragma unroll
        for (int u = 0; u < 8; ++u) { const int kk = F.wave * 256 + k + 4 * u + rg; const float s0 = sv[kk], s1 = sv[2048 + kk], s2 = sv[4096 + kk];
            a0 += w[u] * s0; a1 += w[u] * s1; a2 += w[u] * s2; }
    }
    LAS float* pp = part + ((F.wave * 4 + rg) * 3) * 64 + c4;
    *(LAS f32x4*)(pp) = a0; *(LAS f32x4*)(pp + 64) = a1; *(LAS f32x4*)(pp + 128) = a2;
    __syncthreads();
    if (F.tid < 192) { const int r = F.tid >> 6, c = F.tid & 63; float s = 0.f;
#pragma unroll
        for (int q = 0; q < 32; ++q) s += part[(q * 3 + r) * 64 + c];
        mod[(size_t)(l * 3 + r) * NMOD + n0 + c] = s + ada_b[(size_t)l * NMOD + n0 + c]; }
    __syncthreads();
}

__device__ __forceinline__ void p0_prologue(Frame& F, const float* const* in) {
    unsigned char* ws = F.ws;
    {
        LAS float* sv = (LAS float*)F.lds;
        for (int i = F.tid; i < 3 * DM; i += NTHREADS) { const int r = i / DM, k = i - r * DM; const float x = (r < 2) ? in[1][r * DM + k] : in[3][k]; sv[i] = x / (1.f + __expf(-x)); }
        __syncthreads();
        for (int task = F.vcu; task < 768; task += F.G) p0_gemv_task(F, task, in[4], in[5], (float*)(ws + WS_MOD));
        __syncthreads();
    }
    {
        float* xw = (float*)(ws + WS_XW);
        for (int row = F.gw; row < MROWS; row += F.NGW) { const int b = row / RB, i = row - b * RB;
            const float* src = (i < CTX) ? in[2] + (size_t)(b * CTX + i) * DM : in[0] + (size_t)(b * SEQ + i - CTX) * DM;
            const f32x4* s4 = (const f32x4*)src + F.lane; f32x4* d4 = (f32x4*)(xw + (size_t)row * DM) + F.lane;
#pragma unroll
            for (int j = 0; j < 8; ++j) d4[64 * j] = s4[64 * j]; }
    }
    {
        float* sm = (float*)(ws + WS_SMALL); const int g = F.vcu * NTHREADS + F.tid;
        if (g < 8192) { sm[SM_N1G + g] = in[6][g]; sm[SM_N2G + g] = in[7][g]; }
        if (g < 384) { sm[SM_AQG + g] = in[13][g]; sm[SM_AKG + g] = in[14][g]; }
        if (g < 6144) sm[SM_CW + g] = in[15][g];
        if (g < 2048) sm[SM_CB + g] = in[16][g];
        if (g < 256) { sm[SM_CQG + g] = in[19][g]; sm[SM_CKG + g] = in[20][g]; }
    }
    {
        float* rc = (float*)(ws + WS_ROPE); float* ra = rc + 64 * 32 * 2;
        const int g = F.vcu * NTHREADS + F.tid;
        if (g < 64 * 32) { const int pos = g >> 5, f = g & 31; const float fr = exp2f(-(float)f * (13.287712379549449f / 32.f)); const float ang = (float)pos * fr;
            rc[2 * g] = cosf(ang); rc[2 * g + 1] = sinf(ang); }
        else if (g < 64 * 32 + 64 * 16) { const int e = g - 64 * 32, pos = e >> 4, f = e & 15; const float fr = exp2f(-(float)f * (13.287712379549449f / 16.f)); const float ang = (float)pos * fr;
            ra[2 * e] = cosf(ang); ra[2 * e + 1] = sinf(ang); }
    }
    {
        LAS float* scr = (LAS float*)(F.lds + F.wave * 16384);
        TrDesc d[16]; int nd = 0;
#pragma unroll
        for (int i = 0; i < 2; ++i) {
            d[nd++] = TrDesc{in[8] + (size_t)i * DM * 3904, nullptr, (bf16_t*)(ws + WS_WIN) + (size_t)i * 4096 * DM, DM, 3904, 32 * 122};
            d[nd++] = TrDesc{in[11] + (size_t)i * 512 * 1536, in[9] + i * 512, (bf16_t*)(ws + WS_WUQ) + (size_t)i * 1536 * 512, 512, 1536, 8 * 48};
            d[nd++] = TrDesc{in[12] + (size_t)i * 256 * 2048, in[10] + i * 256, (bf16_t*)(ws + WS_WUKV) + (size_t)i * 2048 * 256, 256, 2048, 4 * 64};
            d[nd++] = TrDesc{in[17] + (size_t)i * DM * DM, nullptr, (bf16_t*)(ws + WS_WEO) + (size_t)i * DM * DM, DM, DM, 32 * 64};
            d[nd++] = TrDesc{in[18] + (size_t)i * DM * 3072, nullptr, (bf16_t*)(ws + WS_WQKV) + (size_t)i * 3072 * DM, DM, 3072, 32 * 96};
            d[nd++] = TrDesc{in[21] + (size_t)i * DM * DM, nullptr, (bf16_t*)(ws + WS_WCO) + (size_t)i * DM * DM, DM, DM, 32 * 64};
        }
#pragma unroll
        for (int l = 0; l < 4; ++l) d[nd++] = TrDesc{in[22] + (size_t)l * DM * DM, nullptr, (bf16_t*)(ws + WS_WPQ) + (size_t)l * DM * DM, DM, DM, 32 * 64};
#pragma unroll
        for (int m = 0; m < 16; ++m) {
            for (int it = F.gw; it < d[m].items; it += F.NGW) p0_transpose_item(d[m].W, d[m].K, d[m].N, d[m].WT, d[m].gain, scr, it, F.lane, d[m].K == 512);
        }
        for (int i = F.gw * 64 + F.lane; i < 2 * 192 * DM / 8; i += F.NGW * 64) { const int li = i / (192 * DM / 8), r = i % (192 * DM / 8);
            *(u32x4*)((bf16_t*)(ws + WS_WIN) + (size_t)li * 4096 * DM + (size_t)3904 * DM + (size_t)r * 8) = (u32x4){0u, 0u, 0u, 0u}; }
    }
    {
        const size_t n_sk = (size_t)4 * 16 * 128 * 128 / 8;
        const size_t gt = (size_t)F.vcu * NTHREADS + F.tid, GT = (size_t)F.G * NTHREADS;
        for (size_t j = gt; j < n_sk; j += GT) {
            const f32x4 a = *(const f32x4*)(in[23] + j * 8), b = *(const f32x4*)(in[23] + j * 8 + 4);
            u32x4 o; o.x = pk2(a.x, a.y); o.y = pk2(a.z, a.w); o.z = pk2(b.x, b.y); o.w = pk2(b.z, b.w);
            *(u32x4*)((bf16_t*)(ws + WS_SUBK) + j * 8) = o;
        }
    }
    {
        for (int r = F.gw; r < 2 * 4 * NEXP; r += F.NGW) {
            const int tab = r / (4 * NEXP), rr = r - tab * (4 * NEXP);
#if EXP_SLICED
            const float* src = (tab ? in[25] : in[24]) + (size_t)rr * DM + F.lane * 32;
            f32x4 v[8];
#pragma unroll
            for (int q = 0; q < 8; ++q) v[q] = *(const f32x4*)(src + q * 4);
#else
            const float* src = (tab ? in[25] : in[24]) + (size_t)rr * DM + F.lane * 16;
            f32x4 v[8];
#pragma unroll
            for (int j = 0; j < 2; ++j)
#pragma unroll
                for (int q = 0; q < 4; ++q) v[j * 4 + q] = *(const f32x4*)(src + j * 1024 + q * 4);
#endif
            float am = 0.f;
#pragma unroll
            for (int q = 0; q < 8; ++q) am = fmaxf(fmaxf(am, fmaxf(fabsf(v[q].x), fabsf(v[q].y))), fmaxf(fabsf(v[q].z), fabsf(v[q].w)));
#pragma unroll
            for (int o = 1; o < 64; o <<= 1) am = fmaxf(am, __shfl_xor(am, o));
            am = fmaxf(am, 1e-30f);
#if TAB_FP4
            float ssq = 0.f;
#pragma unroll
            for (int q = 0; q < 8; ++q) ssq += (v[q].x * v[q].x + v[q].y * v[q].y) + (v[q].z * v[q].z + v[q].w * v[q].w);
#pragma unroll
            for (int o = 1; o < 64; o <<= 1) ssq += __shfl_xor(ssq, o);
            const float sig = fmaxf(sqrtf(ssq * (1.f / DM)), am * (1.f / 64.f));
            unsigned w4[4];
#if EXP_SLICED
            if (tab == 0) {
                const float delta = 0.3352f * sig, isc = 1.0f / delta;
#pragma unroll
                for (int q = 0; q < 4; ++q) { unsigned t = 0u;
#pragma unroll
                    for (int hh = 0; hh < 2; ++hh) { const f32x4 x = v[2 * q + hh] * isc;
                        const int n0 = min(max((int)floorf(x.x), -8), 7) & 15, n1 = min(max((int)floorf(x.y), -8), 7) & 15, n2 = min(max((int)floorf(x.z), -8), 7) & 15, n3 = min(max((int)floorf(x.w), -8), 7) & 15;
                        t |= ((unsigned)n0 | ((unsigned)n1 << 4) | ((unsigned)n2 << 8) | ((unsigned)n3 << 12)) << (16 * hh); }
                    w4[q] = t; }
                { const int ll = rr / NEXP, ee = rr - ll * NEXP;
                  *(u32x4*)(ws + WS_U + (size_t)ll * NEXP * ROWB + (size_t)(F.lane >> 3) * (NEXP * 128) + (size_t)ee * 128 + (F.lane & 7) * 16) = (u32x4){w4[0], w4[1], w4[2], w4[3]}; }
                if (F.lane == 0) ((float*)(ws + WS_USC))[rr] = delta;
                continue;
            }
#endif
            const float sc = 2.0f / sig;
#pragma unroll
            for (int q = 0; q < 4; ++q) { unsigned t = 0u;
                const f32x4 xa = v[2 * q] * sc, xb = v[2 * q + 1] * sc;
#define P0_C6(x) fminf(fmaxf((x), -6.f), 6.f)
                t = __builtin_amdgcn_cvt_scalef32_pk_fp4_f32(t, P0_C6(xa.x), P0_C6(xa.y), 1.0f, 0);
                t = __builtin_amdgcn_cvt_scalef32_pk_fp4_f32(t, P0_C6(xa.z), P0_C6(xa.w), 1.0f, 1);
                t = __builtin_amdgcn_cvt_scalef32_pk_fp4_f32(t, P0_C6(xb.x), P0_C6(xb.y), 1.0f, 2);
                t = __builtin_amdgcn_cvt_scalef32_pk_fp4_f32(t, P0_C6(xb.z), P0_C6(xb.w), 1.0f, 3);
#undef P0_C6
                w4[q] = t; }
#if EXP_SLICED
            { const int ll = rr / NEXP, ee = rr - ll * NEXP;
              *(u32x4*)(ws + (tab ? WS_VT : WS_U) + (size_t)ll * NEXP * ROWB + (size_t)(F.lane >> 3) * (NEXP * 128) + (size_t)ee * 128 + (F.lane & 7) * 16) = (u32x4){w4[0], w4[1], w4[2], w4[3]}; }
#else
            *(u32x4*)(ws + (tab ? WS_VT : WS_U) + (size_t)rr * ROWB + F.lane * 16) = (u32x4){w4[0], w4[1], w4[2], w4[3]};
#endif
            if (F.lane == 0) ((float*)(ws + (tab ? WS_VSC : WS_USC)))[rr] = sig * 0.5f;
#else
            const float sc = 7.5f / am;
            f32x16 a, b;
#pragma unroll
            for (int q = 0; q < 8; ++q) { const f32x4 x = v[q] * sc; a[2 * q] = x.x; b[2 * q] = x.y; a[2 * q + 1] = x.z; b[2 * q + 1] = x.w; }
            const u32x6 w = __builtin_amdgcn_cvt_scalef32_2xpk16_fp6_f32(a, b, 1.0f);
            unsigned char* dst = ws + (tab ? WS_VT : WS_U) + (size_t)rr * ROWB;
            *(u32x4*)(dst + F.lane * 16) = (u32x4){w[0], w[1], w[2], w[3]};
            *(u32x2*)(dst + 1024 + F.lane * 8) = (u32x2){w[4], w[5]};
            if (F.lane == 0) ((float*)(ws + (tab ? WS_VSC : WS_USC)))[rr] = am * (1.0f / 7.5f);
#endif
        }
    }
}

#define DPP_MOV(v, ctrl) __builtin_bit_cast(float, __builtin_amdgcn_update_dpp(0, __builtin_bit_cast(int, (v)), (ctrl), 0xf, 0xf, true))
__device__ __forceinline__ void norm_phase(const Frame& F0, const float* xw, const float* g, const float* modl  , int off_sh, int off_sc, bf16_t* H, bool lat_only, unsigned* XQ = nullptr, float* XS = nullptr) {
    const Frame F = phase_frame(F0);
    f32x4 gm[8], shv[8]; int cur_cls = -1;
    int row = F.gw; if (lat_only) while (row < MROWS && row_cls(row) == 2) row += F.NGW;
    f32x4 v[8];
    if (row < MROWS) { const f32x4* x4 = (const f32x4*)(xw + (size_t)row * DM) + F.lane;
#pragma unroll
        for (int j = 0; j < 8; ++j) v[j] = x4[64 * j]; }
    while (row < MROWS) {
        int nrow = row + F.NGW; if (lat_only) while (nrow < MROWS && row_cls(nrow) == 2) nrow += F.NGW;
        f32x4 vn[8];
        if (nrow < MROWS) { const f32x4* x4 = (const f32x4*)(xw + (size_t)nrow * DM) + F.lane;
#pragma unroll
            for (int j = 0; j < 8; ++j) vn[j] = x4[64 * j]; }
        const int cls = row_cls(row);
        if (cls != cur_cls) {
            cur_cls = cls;
            const f32x4* g4 = (const f32x4*)g + F.lane; const f32x4* sc4 = (const f32x4*)(modl + (size_t)cls * NMOD + off_sc) + F.lane; const f32x4* sh4 = (const f32x4*)(modl + (size_t)cls * NMOD + off_sh) + F.lane;
#pragma unroll
            for (int j = 0; j < 8; ++j) { gm[j] = g4[64 * j] * (sc4[64 * j] + 1.0f); shv[j] = sh4[64 * j]; }
        }
        float ss = 0.f;
#pragma unroll
        for (int j = 0; j < 8; ++j) ss += (v[j].x * v[j].x + v[j].y * v[j].y) + (v[j].z * v[j].z + v[j].w * v[j].w);
        const float rstd = 1.0f / sqrtf(wave_sum_dpp(ss) * (1.f / DM) + EPS);
        u32x2* o2 = (u32x2*)(H + (size_t)row * DM) + F.lane;
#pragma unroll
        for (int j = 0; j < 8; ++j) { const f32x4 y = (v[j] * rstd) * gm[j] + shv[j]; u32x2 o; o.x = pk2(y.x, y.y); o.y = pk2(y.z, y.w); o2[64 * j] = o;
            if (XQ) {
                float am = fmaxf(fmaxf(fabsf(y.x), fabsf(y.y)), fmaxf(fabsf(y.z), fabsf(y.w)));
                am = fmaxf(am, DPP_MOV(am, 0xB1)); am = fmaxf(am, DPP_MOV(am, 0x4E)); am = fmaxf(am, DPP_MOV(am, 0x141)); am = fmaxf(am, 1e-20f);
                const float qs = 119.0f / am; const float yy[4] = {y.x, y.y, y.z, y.w};
                unsigned pl = 0u, ph = 0u; int sq = 0;
#pragma unroll
                for (int i = 0; i < 4; ++i) { const int qi = __float2int_rn(yy[i] * qs); const int lo = ((qi + 8) & 15) - 8; const int hi = (qi - lo) >> 4; sq += qi; pl |= (unsigned)(lo & 15) << (4 * i); ph |= (unsigned)(hi & 15) << (4 * i); }
                const unsigned pl1 = (unsigned)__builtin_amdgcn_update_dpp(0, (int)pl, 0xB1, 0xf, 0xf, true), ph1 = (unsigned)__builtin_amdgcn_update_dpp(0, (int)ph, 0xB1, 0xf, 0xf, true);
                float sqf = (float)sq; sqf = DPP_ADD(sqf, 0xB1); sqf = DPP_ADD(sqf, 0x4E); sqf = DPP_ADD(sqf, 0x141);
                const int chunk = j * 8 + (F.lane >> 3), l8 = F.lane & 7;
                if ((l8 & 1) == 0) { unsigned* q = XQ + ((size_t)row * 64 + chunk) * 8 + (l8 >> 1); q[0] = ph | (ph1 << 16); q[4] = pl | (pl1 << 16); }
                if (l8 == 0) { float* s = XS + ((size_t)row * 64 + chunk) * 2; s[0] = am * (1.0f / 119.0f); s[1] = 0.5f * sqf; }
            } }
        row = nrow;
#pragma unroll
        for (int j = 0; j < 8; ++j) v[j] = vn[j];
    }
}

__device__ __forceinline__ float row16_sum(float v) { v = DPP_ADD(v, 0xB1); v = DPP_ADD(v, 0x4E); v = DPP_ADD(v, 0x141); v = DPP_ADD(v, 0x140); return v; }
__device__ __forceinline__ void prep_odd_phase(const Frame& F0, const bf16_t* P, const float* qg, const float* kg, const float* rope_c, bf16_t* Q, bf16_t* Kb) {
    const Frame F = phase_frame(F0);
    const int l16 = F.lane & 15, d0 = l16 * 8;
    float gq[8], gk[8];
#pragma unroll
    for (int e = 0; e < 8; ++e) { gq[e] = qg[d0 + e]; gk[e] = kg[d0 + e]; }
    const bool lowhalf = l16 < 8;
    const int j0 = (l16 & 7) * 8;
    int row = F.gw;
    u32x4 w[5];
    if (row < MROWS) { const u32x4* pr = (const u32x4*)(P + (size_t)row * 3072) + F.lane;
#pragma unroll
        for (int k = 0; k < 5; ++k) w[k] = pr[64 * k]; }
    while (row < MROWS) {
        const int nrow = row + F.NGW;
        u32x4 wn[5];
        if (nrow < MROWS) { const u32x4* pr = (const u32x4*)(P + (size_t)nrow * 3072) + F.lane;
#pragma unroll
            for (int k = 0; k < 5; ++k) wn[k] = pr[64 * k]; }
        const int b = row / RB, i = row - b * RB; const bool lat = i >= CTX; const int t = i - CTX;
        float cs[8], sn[8];
#pragma unroll
        for (int e = 0; e < 8; ++e) { cs[e] = 1.f; sn[e] = 0.f; }
        if (lat) { const int pos = (j0 < 32) ? (t >> 6) : (t & 63); const f32x4* tb = (const f32x4*)(rope_c + ((pos << 5) + (j0 & 31)) * 2);
#pragma unroll
            for (int q = 0; q < 4; ++q) { const f32x4 c = tb[q]; cs[2 * q] = c.x; sn[2 * q] = c.y; cs[2 * q + 1] = c.z; sn[2 * q + 1] = c.w; } }
#pragma unroll
        for (int k = 0; k < 5; ++k) {
            const unsigned ww[4] = {w[k].x, w[k].y, w[k].z, w[k].w};
            float x[8]; float ss = 0.f;
#pragma unroll
            for (int q = 0; q < 4; ++q) { x[2 * q] = bf_lo(ww[q]); x[2 * q + 1] = bf_hi(ww[q]); ss += x[2 * q] * x[2 * q] + x[2 * q + 1] * x[2 * q + 1]; }
            const float rstd = 1.0f / sqrtf(row16_sum(ss) * (1.f / 128.f) + EPS);
            unsigned ow[4]; float o[8];
#pragma unroll
            for (int e = 0; e < 8; ++e) { const float y = x[e] * rstd * (k < 4 ? gq[e] : gk[e]); const float yp = DPP_MOV(y, 0x128);
                o[e] = lowhalf ? (y * cs[e] - yp * sn[e]) : (y * cs[e] + yp * sn[e]); }
#pragma unroll
            for (int q = 0; q < 4; ++q) ow[q] = pk2(o[2 * q], o[2 * q + 1]);
            if (k < 4) *((u32x4*)(Q + (size_t)row * 2048) + 64 * k + F.lane) = (u32x4){ow[0], ow[1], ow[2], ow[3]};
            else *((u32x4*)(Kb + (size_t)row * 512) + F.lane) = (u32x4){ow[0], ow[1], ow[2], ow[3]};
        }
        row = nrow;
#pragma unroll
        for (int k = 0; k < 5; ++k) w[k] = wn[k];
    }
}

struct PrepEvenRow { u32x4 cq; u32x2 ckv, kr; u32x4 qn[2]; u32x2 qr[2]; u32x4 kn[2], vv[2]; };
__device__ __forceinline__ void prep_even_load(PrepEvenRow& R, const bf16_t* P, const bf16_t* QR, const bf16_t* KVR, int row, int lane) {
    const bf16_t* pr = P + (size_t)row * 4096; const int l16 = lane & 15, hq = lane >> 4;
    R.cq = *((const u32x4*)pr + lane); R.ckv = *((const u32x2*)(pr + 512) + lane); R.kr = *((const u32x2*)(pr + 768) + l16);
    const bf16_t* q = QR + (size_t)row * 1536; const bf16_t* kv = KVR + (size_t)row * 2048;
#pragma unroll
    for (int k = 0; k < 2; ++k) { R.qn[k] = *((const u32x4*)q + 64 * k + lane); R.qr[k] = *((const u32x2*)(q + 1024) + 64 * k + lane);
        const bf16_t* kh = kv + (4 * k + hq) * 256 + l16 * 8; R.kn[k] = *(const u32x4*)kh; R.vv[k] = *(const u32x4*)(kh + 128); }
}
__device__ __forceinline__ void prep_even_phase(const Frame& F0, const bf16_t* P, const bf16_t* QR, const bf16_t* KVR, const float* qg, const float* kg, const float* rope_a, bf16_t* Q, bf16_t* Kb, bf16_t* Vb) {
    const Frame F = phase_frame(F0);
    const int lane = F.lane, l16 = lane & 15, hq = lane >> 4, d0 = l16 * 8, r0 = l16 * 4;
    float gqn[8], gkn[8], gqr[4], gkr[4];
#pragma unroll
    for (int e = 0; e < 8; ++e) { gqn[e] = qg[d0 + e]; gkn[e] = kg[d0 + e]; }
#pragma unroll
    for (int e = 0; e < 4; ++e) { gqr[e] = qg[128 + r0 + e]; gkr[e] = kg[128 + r0 + e]; }
    const bool lowhalf = l16 < 8; const int j0 = (l16 & 7) * 4;
    int row = F.gw;
    PrepEvenRow R;
    if (row < MROWS) prep_even_load(R, P, QR, KVR, row, lane);
    while (row < MROWS) {
        const int nrow = row + F.NGW;
        PrepEvenRow Rn;
        if (nrow < MROWS) prep_even_load(Rn, P, QR, KVR, nrow, lane);
        const int b = row / RB, i = row - b * RB; const bool lat = i >= CTX; const int t = i - CTX;
        float cs[4], sn[4];
#pragma unroll
        for (int e = 0; e < 4; ++e) { cs[e] = 1.f; sn[e] = 0.f; }
        if (lat) { const int pos = (j0 < 16) ? (t >> 6) : (t & 63); const f32x4* tb = (const f32x4*)(rope_a + ((pos << 4) + (j0 & 15)) * 2);
            const f32x4 c0 = tb[0], c1 = tb[1]; cs[0] = c0.x; sn[0] = c0.y; cs[1] = c0.z; sn[1] = c0.w; cs[2] = c1.x; sn[2] = c1.y; cs[3] = c1.z; sn[3] = c1.w; }
        float ssq = 0.f, sskv = 0.f;
        { const unsigned ww[4] = {R.cq.x, R.cq.y, R.cq.z, R.cq.w};
#pragma unroll
          for (int q = 0; q < 4; ++q) { const float a = bf_lo(ww[q]), c = bf_hi(ww[q]); ssq += a * a + c * c; } }
        { const float a = bf_lo(R.ckv.x), c = bf_hi(R.ckv.x), d = bf_lo(R.ckv.y), e = bf_hi(R.ckv.y); sskv = (a * a + c * c) + (d * d + e * e); }
        const float rstd_q = 1.0f / sqrtf(wave_sum_dpp(ssq) * (1.f / 512.f) + EPS), rstd_kv = 1.0f / sqrtf(wave_sum_dpp(sskv) * (1.f / 256.f) + EPS);
        const float krv[4] = {bf_lo(R.kr.x), bf_hi(R.kr.x), bf_lo(R.kr.y), bf_hi(R.kr.y)};
        const float krss = (krv[0] * krv[0] + krv[1] * krv[1]) + (krv[2] * krv[2] + krv[3] * krv[3]);
#pragma unroll
        for (int k = 0; k < 2; ++k) {
            const int h = 4 * k + hq;
            {
                const unsigned wn[4] = {R.qn[k].x, R.qn[k].y, R.qn[k].z, R.qn[k].w};
                float xn[8], xr[4]; float ss = 0.f;
#pragma unroll
                for (int q = 0; q < 4; ++q) { xn[2 * q] = bf_lo(wn[q]) * rstd_q; xn[2 * q + 1] = bf_hi(wn[q]) * rstd_q; ss += xn[2 * q] * xn[2 * q] + xn[2 * q + 1] * xn[2 * q + 1]; }
                xr[0] = bf_lo(R.qr[k].x) * rstd_q; xr[1] = bf_hi(R.qr[k].x) * rstd_q; xr[2] = bf_lo(R.qr[k].y) * rstd_q; xr[3] = bf_hi(R.qr[k].y) * rstd_q;
                ss += (xr[0] * xr[0] + xr[1] * xr[1]) + (xr[2] * xr[2] + xr[3] * xr[3]);
                const float r2 = 1.0f / sqrtf(row16_sum(ss) * (1.f / 192.f) + EPS);
                unsigned on[4]; float o[4];
#pragma unroll
                for (int q = 0; q < 4; ++q) on[q] = pk2(xn[2 * q] * r2 * gqn[2 * q], xn[2 * q + 1] * r2 * gqn[2 * q + 1]);
#pragma unroll
                for (int e = 0; e < 4; ++e) { const float y = xr[e] * r2 * gqr[e]; const float yp = DPP_MOV(y, 0x128); o[e] = lowhalf ? (y * cs[e] - yp * sn[e]) : (y * cs[e] + yp * sn[e]); }
                bf16_t* qo = Q + (size_t)row * 1536 + h * 192;
                *(u32x4*)(qo + d0) = (u32x4){on[0], on[1], on[2], on[3]};
                *(u32x2*)(qo + 128 + r0) = (u32x2){pk2(o[0], o[1]), pk2(o[2], o[3])};
            }
            {
                const unsigned wn[4] = {R.kn[k].x, R.kn[k].y, R.kn[k].z, R.kn[k].w}, wv[4] = {R.vv[k].x, R.vv[k].y, R.vv[k].z, R.vv[k].w};
                float xn[8]; float ss = krss;
#pragma unroll
                for (int q = 0; q < 4; ++q) { xn[2 * q] = bf_lo(wn[q]) * rstd_kv; xn[2 * q + 1] = bf_hi(wn[q]) * rstd_kv; ss += xn[2 * q] * xn[2 * q] + xn[2 * q + 1] * xn[2 * q + 1]; }
                const float r2 = 1.0f / sqrtf(row16_sum(ss) * (1.f / 192.f) + EPS);
                unsigned on[4], ov[4]; float o[4];
#pragma unroll
                for (int q = 0; q < 4; ++q) { on[q] = pk2(xn[2 * q] * r2 * gkn[2 * q], xn[2 * q + 1] * r2 * gkn[2 * q + 1]); ov[q] = pk2(bf_lo(wv[q]) * rstd_kv, bf_hi(wv[q]) * rstd_kv); }
#pragma unroll
                for (int e = 0; e < 4; ++e) { const float y = krv[e] * r2 * gkr[e]; const float yp = DPP_MOV(y, 0x128); o[e] = lowhalf ? (y * cs[e] - yp * sn[e]) : (y * cs[e] + yp * sn[e]); }
                bf16_t* ko = Kb + (size_t)row * 1536 + h * 192;
                *(u32x4*)(ko + d0) = (u32x4){on[0], on[1], on[2], on[3]};
                *(u32x2*)(ko + 128 + r0) = (u32x2){pk2(o[0], o[1]), pk2(o[2], o[3])};
                *(u32x4*)(Vb + (size_t)row * 1024 + h * 128 + d0) = (u32x4){ov[0], ov[1], ov[2], ov[3]};
            }
        }
        row = nrow; R = Rn;
    }
}

__device__ __forceinline__ void conv_phase(const Frame& F0, const bf16_t* P, const float* cw  , const float* cb  , bf16_t* CAT) {
    const Frame F = phase_frame(F0);
    const int gt = F.vcu * NTHREADS + F.tid, GT = F.G * NTHREADS;
    for (int it = gt; it < MROWS * 128; it += GT) {
        const int row = it >> 7, c0 = (it & 127) * 8; const int b = row / RB, i = row - b * RB;
        const bool first = (i == 0) || (i == CTX), last = (i == CTX - 1) || (i == RB - 1);
        const bf16_t* pr = P + (size_t)row * 4096 + 832 + c0;
        const u32x4 bg = *(const u32x4*)pr, cg = *(const u32x4*)(pr + 1024), hz = *(const u32x4*)(pr + 2048);
        u32x4 cgm = {0u, 0u, 0u, 0u}, hzm = cgm, cgp = cgm, hzp = cgm;
        if (!first) { cgm = *(const u32x4*)(pr - 4096 + 1024); hzm = *(const u32x4*)(pr - 4096 + 2048); }
        if (!last) { cgp = *(const u32x4*)(pr + 4096 + 1024); hzp = *(const u32x4*)(pr + 4096 + 2048); }
        const unsigned bgw[4] = {bg.x, bg.y, bg.z, bg.w}, cgw[4] = {cg.x, cg.y, cg.z, cg.w}, hzw[4] = {hz.x, hz.y, hz.z, hz.w};
        const unsigned cmw[4] = {cgm.x, cgm.y, cgm.z, cgm.w}, hmw[4] = {hzm.x, hzm.y, hzm.z, hzm.w}, cpw[4] = {cgp.x, cgp.y, cgp.z, cgp.w}, hpw[4] = {hzp.x, hzp.y, hzp.z, hzp.w};
        unsigned ow[4];
#pragma unroll
        for (int q = 0; q < 4; ++q) {
            const int c = c0 + 2 * q;
            const float u0a = bf_lo(cgw[q]) * bf_lo(hzw[q]), u0b = bf_hi(cgw[q]) * bf_hi(hzw[q]);
            const float uma = bf_lo(cmw[q]) * bf_lo(hmw[q]), umb = bf_hi(cmw[q]) * bf_hi(hmw[q]);
            const float upa = bf_lo(cpw[q]) * bf_lo(hpw[q]), upb = bf_hi(cpw[q]) * bf_hi(hpw[q]);
            const float ra = bf_lo(bgw[q]) * (uma * cw[c] + u0a * cw[1024 + c] + upa * cw[2048 + c] + cb[c]);
            const float rb = bf_hi(bgw[q]) * (umb * cw[c + 1] + u0b * cw[1024 + c + 1] + upb * cw[2048 + c + 1] + cb[c + 1]);
            ow[q] = pk2(ra, rb);
        }
        *(u32x4*)(CAT + (size_t)row * DM + 1024 + c0) = (u32x4){ow[0], ow[1], ow[2], ow[3]};
    }
}
__device__ __forceinline__ void attn_even_phase(const Frame& F0, const bf16_t* Q, const bf16_t* Kb, const bf16_t* Vb, bf16_t* CAT) {
    const Frame F = phase_frame(F0);
    for (int u = F.vcu; u < 272; u += F.G) {
        int b, h, qt, nk;
        if (u < 256) { b = u >> 7; h = (u >> 4) & 7; qt = 1 + (u & 15); nk = RB; } else { const int v = u - 256; b = v >> 3; h = v & 7; qt = 0; nk = CTX; }
        const size_t r0 = (size_t)b * RB;
        att::attn_body1<192, 1536, 1536, 1024, 2048>(Q + (r0 + qt * 256) * 1536 + h * 192, Kb + r0 * 1536 + h * 192, Vb + r0 * 1024 + h * 128, CAT + (r0 + qt * 256) * 2048 + h * 128, nk, (char*)F.lds, phase_tid(F.wave));
    }
}
__device__ __forceinline__ void attn_odd_phase(const Frame& F0, const bf16_t* Q, const bf16_t* Kb, const bf16_t* P, bf16_t* CAT, bool lat_only) {
    const Frame F = phase_frame(F0);
    const int nunits = lat_only ? 512 : 544;
    for (int u = F.vcu; u < nunits; u += F.G) {
        int b, hq, qt, nk;
        if (u < 512) { b = u >> 8; hq = (u >> 4) & 15; qt = 1 + (u & 15); nk = RB; } else { const int v = u - 512; b = v >> 4; hq = v & 15; qt = 0; nk = CTX; }
        const int kvh = hq >> 2; const size_t r0 = (size_t)b * RB;
        att::attn_body<128, 2048, 512, 3072, 2048, 2>(Q + (r0 + qt * 256) * 2048 + hq * 128, Kb + r0 * 512 + kvh * 128, P + r0 * 3072 + 2560 + kvh * 128, CAT + (r0 + qt * 256) * 2048 + hq * 128, nk, (char*)F.lds, phase_tid(F.wave));
    }
}

__device__ __forceinline__ int crow32(int r, int hi) { return (r & 3) + 8 * (r >> 2) + 4 * hi; }
__device__ __forceinline__ int fkey(int b) { return b ^ ((b >> 31) & 0x7fffffff); }
#define TK_CE(x, y) do { const int hi_ = max((x), (y)), lo_ = min((x), (y)); (x) = hi_; (y) = lo_; } while (0)
template <int N> __device__ __forceinline__ void tk_sort(int* v) {
#pragma unroll
    for (int k = 2; k <= N; k <<= 1)
#pragma unroll
        for (int j = k >> 1; j > 0; j >>= 1)
#pragma unroll
            for (int i = 0; i < N; ++i) { const int l = i ^ j; if (l > i) { if ((i & k) == 0) TK_CE(v[i], v[l]); else TK_CE(v[l], v[i]); } }
}
__device__ __forceinline__ void tk_merge16(int* a, const int* b) {
#pragma unroll
    for (int i = 0; i < 16; ++i) a[i] = max(a[i], b[15 - i]);
#pragma unroll
    for (int j = 8; j > 0; j >>= 1)
#pragma unroll
        for (int i = 0; i < 16; ++i) { const int l = i ^ j; if (l > i) TK_CE(a[i], a[l]); }
}
__device__ __forceinline__ void tk_merge_partner(int* a) {
    int lo[16], hi[16];
#pragma unroll
    for (int i = 0; i < 16; ++i) { auto rr = __builtin_amdgcn_permlane32_swap((unsigned)a[i], (unsigned)a[i], false, false); lo[i] = (int)rr[0]; hi[i] = (int)rr[1]; }
    tk_merge16(lo, hi);
#pragma unroll
    for (int i = 0; i < 16; ++i) a[i] = lo[i];
}
__device__ __forceinline__ void peer_topk_phase(const Frame& F0, const bf16_t* PQ, const bf16_t* subk  , int* IDX, float* GATE, bool lat_only) {
    const Frame F = phase_frame(F0);
    const int h = F.vcu & 7, jw = (F.vcu >> 3) * NWAVES + F.wave, nwh = (F.G >> 3) * NWAVES;
    {
        const bf16_t* src = subk + (size_t)h * 2 * 128 * 128;
        for (int c = F.tid; c < 4096; c += NTHREADS) { const int row = c >> 4, ch = c & 15;
            *(LAS u32x4*)(F.lds + row * 256 + ((ch ^ (row & 15)) << 4)) = *(const u32x4*)(src + (size_t)row * 128 + ch * 8); }
        __syncthreads();
    }
    const int ntg = lat_only ? 256 : MROWS / 32;
    for (int t = jw; t < ntg; t += nwh) {
        int lane_ = F.lane; asm volatile("" : "+v"(lane_));
        const int r32 = lane_ & 31, hi = lane_ >> 5;
        int tg = t; if (lat_only) tg += 8 + (tg >= 128 ? 8 : 0);
        const int token = tg * 32 + r32;
        int top[2][16];
        const int kk = (((r32 & 14) | (hi ^ (r32 & 1))) << 4);
#pragma unroll
        for (int p = 0; p < 2; ++p) {
            bf16x8 bq[8];
            const bf16_t* qp = PQ + (size_t)token * DM + h * 256 + p * 128 + hi * 8;
#pragma unroll
            for (int ks = 0; ks < 8; ++ks) bq[ks] = *(const bf16x8*)(qp + ks * 16);
            int s[4][16];
#pragma unroll
            for (int nb = 0; nb < 4; ++nb) {
                f32x16 acc = {};
                const LAS unsigned char* kp = F.lds + (p * 128 + nb * 32 + r32) * 256;
#pragma unroll
                for (int ks = 0; ks < 8; ++ks) { const bf16x8 a = *(const LAS bf16x8*)(kp + (kk ^ (ks << 5))); acc = __builtin_amdgcn_mfma_f32_32x32x16_bf16(a, bq[ks], acc, 0, 0, 0); }
#pragma unroll
                for (int r = 0; r < 16; ++r) { const int key = nb * 32 + crow32(r, hi); s[nb][r] = fkey((int)((__float_as_uint(acc[r]) & ~127u) | (unsigned)(127 - key))); }
                tk_sort<16>(s[nb]);
            }
            tk_merge16(s[0], s[1]); tk_merge16(s[2], s[3]); tk_merge16(s[0], s[2]);
            tk_merge_partner(s[0]);
#pragma unroll
            for (int j = 0; j < 16; ++j) top[p][j] = s[0][j];
        }
        int cand[32];
        unsigned long long kaLo = 0ull, kaHi = 0ull, kbLo = 0ull, kbHi = 0ull;
        {
            float fb[16]; const float fa0 = __uint_as_float((unsigned)fkey(top[0][0]) & ~127u), fb0 = __uint_as_float((unsigned)fkey(top[1][0]) & ~127u);
#pragma unroll
            for (int r = 0; r < 16; ++r) { const int ba = fkey(top[0][r]), bb = fkey(top[1][r]); fb[r] = __uint_as_float((unsigned)bb & ~127u) - fb0;
                const unsigned long long xa = (unsigned long long)(unsigned)(127 - (ba & 127)) << (8 * (r & 7)), xb = (unsigned long long)(unsigned)(127 - (bb & 127)) << (8 * (r & 7));
                if (r < 8) { kaLo |= xa; kbLo |= xb; } else { kaHi |= xa; kbHi |= xb; } }
            float fa[8];
#pragma unroll
            for (int i = 0; i < 8; ++i) { const int ka = hi ? top[0][2 * i + 1] : top[0][2 * i]; fa[i] = __uint_as_float((unsigned)fkey(ka) & ~127u) - fa0; }
            const int hid = 255 - (hi << 4);
            int n = 0;
#pragma unroll
            for (int i = 0; i < 8; ++i)
#pragma unroll
                for (int b = 0; b < 16; ++b) if ((2 * i + 1) * (b + 1) <= 16) {
                    const float sum = fa[i] + fb[b];
                    cand[n++] = fkey((int)((__float_as_uint(sum) & ~255u) | (unsigned)(hid - (32 * i + b))));
                }
#pragma unroll
            for (; n < 32; ++n) cand[n] = (int)0x80000000;
        }
        tk_sort<16>(cand); tk_sort<16>(cand + 16); tk_merge16(cand, cand + 16);
        tk_merge_partner(cand);
        float ev[16]; float esum = 0.f;
#pragma unroll
        for (int j = 0; j < 16; ++j) { ev[j] = __expf(__uint_as_float((unsigned)fkey(cand[j]) & ~255u)); esum += ev[j]; }
        const float rs = 1.0f / esum;
        int oi[8]; float og[8];
#pragma unroll
        for (int j = 0; j < 8; ++j) { const int w = hi ? cand[8 + j] : cand[j]; const float e = hi ? ev[8 + j] : ev[j];
            const int id8 = 255 - (fkey(w) & 255), ra = id8 >> 4, rb = id8 & 15;
            const unsigned long long wa = (ra & 8) ? kaHi : kaLo, wb = (rb & 8) ? kbHi : kbLo;
            const int ka = (int)(wa >> (8 * (ra & 7))) & 127, kb = (int)(wb >> (8 * (rb & 7))) & 127;
            oi[j] = ka * 128 + kb; og[j] = e * rs; }
        int* ip = IDX + (size_t)token * 128 + h * 16 + hi * 8; float* gp = GATE + (size_t)token * 128 + h * 16 + hi * 8;
        *(int4*)ip = make_int4(oi[0], oi[1], oi[2], oi[3]); *(int4*)(ip + 4) = make_int4(oi[4], oi[5], oi[6], oi[7]);
        *(f32x4*)gp = (f32x4){og[0], og[1], og[2], og[3]}; *(f32x4*)(gp + 4) = (f32x4){og[4], og[5], og[6], og[7]};
    }
}

#if TAB_FP4
__device__ __forceinline__ void peer_expert_phase(const Frame& F0, const bf16_t* H2, const int* IDX, const float* GATE, const unsigned char* U, size_t v_minus_u_bytes, const float* USC, const float* VSC,
                                                  const float* g2  , float* XW, float* OUT,
                                                  bf16_t* HN  , const float* ng  , const float* nmod  ) {
    const Frame F = phase_frame(F0);
    LAS float* red = (LAS float*)F.lds;
    const unsigned voff_tab = (unsigned)v_minus_u_bytes;
    const __amdgpu_buffer_rsrc_t rs = __builtin_amdgcn_make_buffer_rsrc((void*)U, 0, (int)(voff_tab + (unsigned)NEXP * ROWB), 0x00020000);
    const int lane = F.lane; const int voff = lane * 16;
#define PX_SB() __builtin_amdgcn_sched_barrier(0)
#define PX_LOADALL(buf, ivv, tb) do { _Pragma("unroll") for (int e_ = 0; e_ < 16; ++e_) buf[e_] = __builtin_amdgcn_raw_buffer_load_b128(rs, voff, (unsigned)__builtin_amdgcn_readlane(ivv, e_) * (unsigned)ROWB + (tb), 0); } while (0)
#define PX_U1(d_, b_) { const bf16x2_t r2_ = __builtin_amdgcn_cvt_scalef32_pk_bf16_fp4(wd_[d_], 1.0f, b_); if ((b_) & 1) a1_ = __builtin_amdgcn_fdot2_f32_bf16(r2_, __builtin_bit_cast(bf16x2_t, xpk[4 * (d_) + (b_)]), a1_, false); \
                        else a0_ = __builtin_amdgcn_fdot2_f32_bf16(r2_, __builtin_bit_cast(bf16x2_t, xpk[4 * (d_) + (b_)]), a0_, false); }
#define PX_V1(d_, b_) { const f32x2 t2_ = __builtin_amdgcn_cvt_scalef32_pk_f32_fp4(wd_[d_], 1.0f, b_); acc[8 * (d_) + 2 * (b_)] += wg_ * t2_.x; acc[8 * (d_) + 2 * (b_) + 1] += wg_ * t2_.y; }
#define PX_FETCH_TOKEN(r, XP, IV, GV) do { const u32x4* xp_ = (const u32x4*)(H2 + (size_t)(r) * DM + lane * 16); XP[0] = xp_[0]; XP[1] = xp_[1]; XP[2] = xp_[128]; XP[3] = xp_[129]; \
        IV = 0; GV = 0.f; if (lane < 16) { IV = IDX[(size_t)(r) * 128 + F.wave * 16 + lane]; GV = GATE[(size_t)(r) * 128 + F.wave * 16 + lane]; } } while (0)
    const bool skip_ctx = (OUT != nullptr);
    int row = F.vcu; if (skip_ctx && row < MROWS && row_cls(row) == 2) row += F.G;
    u32x4 xp[4]; int iv; float gv;
    u32x4 ub[16], vb[16];
    if (row < MROWS) { PX_FETCH_TOKEN(row, xp, iv, gv); PX_LOADALL(ub, iv, 0u); PX_LOADALL(vb, iv, voff_tab); }
    int par = 0;
    while (row < MROWS) {
        int nrow = row + F.G; if (skip_ctx && nrow < MROWS && row_cls(nrow) == 2) nrow += F.G;
        float usc = 0.f, vsc = 0.f;
        if (lane < 16) { usc = USC[iv]; vsc = VSC[iv]; }
        u32x4 xpn[4]; int ivn = 0; float gvn = 0.f;
        if (nrow < MROWS) PX_FETCH_TOKEN(nrow, xpn, ivn, gvn);
        const int cls = row_cls(row);
        const f32x4 x_old = *((const f32x4*)(XW + (size_t)row * DM) + F.tid), g_vec = *((const f32x4*)(g2 + (size_t)cls * NMOD) + F.tid);
        f32x4 n_g = {0.f, 0.f, 0.f, 0.f}, n_sc = n_g, n_sh = n_g;
        if (HN) { n_g = *((const f32x4*)ng + F.tid); n_sc = *((const f32x4*)(nmod + (size_t)cls * NMOD + 2048) + F.tid); n_sh = *((const f32x4*)(nmod + (size_t)cls * NMOD) + F.tid); }
        const unsigned xpk[16] = {xp[0].x, xp[0].y, xp[0].z, xp[0].w, xp[1].x, xp[1].y, xp[1].z, xp[1].w, xp[2].x, xp[2].y, xp[2].z, xp[2].w, xp[3].x, xp[3].y, xp[3].z, xp[3].w};
        float sv = 0.f;
        PX_SB();
#pragma unroll
        for (int e = 0; e < 16; ++e) {
            u32x4 w_ = ub[e]; asm volatile("" : "+v"(w_) : "v"(sv));
            const unsigned wd_[4] = {w_.x, w_.y, w_.z, w_.w}; float a0_ = 0.f, a1_ = 0.f;
            PX_U1(0, 0) PX_U1(0, 1) PX_U1(0, 2) PX_U1(0, 3) PX_U1(1, 0) PX_U1(1, 1) PX_U1(1, 2) PX_U1(1, 3) PX_U1(2, 0) PX_U1(2, 1) PX_U1(2, 2) PX_U1(2, 3) PX_U1(3, 0) PX_U1(3, 1) PX_U1(3, 2) PX_U1(3, 3)
            const float t_ = wave_sum_dpp(a0_ + a1_); sv = (lane == e) ? t_ : sv;
        }
        const float wv = gelu_erf(sv * usc) * gv * vsc;
        PX_SB();
        if (nrow < MROWS) PX_LOADALL(ub, ivn, 0u);
        PX_SB();
        f32x32 acc = {};
#pragma unroll
        for (int e = 0; e < 16; ++e) {
            u32x4 w_ = vb[e]; asm volatile("" : "+v"(w_) : "v"(acc));
            const unsigned wd_[4] = {w_.x, w_.y, w_.z, w_.w}; const float wg_ = __uint_as_float(__builtin_amdgcn_readlane(__float_as_uint(wv), e));
            PX_V1(0, 0) PX_V1(0, 1) PX_V1(0, 2) PX_V1(0, 3) PX_V1(1, 0) PX_V1(1, 1) PX_V1(1, 2) PX_V1(1, 3) PX_V1(2, 0) PX_V1(2, 1) PX_V1(2, 2) PX_V1(2, 3) PX_V1(3, 0) PX_V1(3, 1) PX_V1(3, 2) PX_V1(3, 3)
        }
        PX_SB();
        if (nrow < MROWS) PX_LOADALL(vb, ivn, voff_tab);
        PX_SB();
        LAS float* rb = red + par * (NWAVES * DM);
#pragma unroll
        for (int j = 0; j < 2; ++j)
#pragma unroll
            for (int q = 0; q < 4; ++q) *(LAS f32x4*)(rb + F.wave * DM + j * 1024 + lane * 16 + q * 4) = (f32x4){acc[j * 16 + q * 4], acc[j * 16 + q * 4 + 1], acc[j * 16 + q * 4 + 2], acc[j * 16 + q * 4 + 3]};
        __syncthreads();
        {
            f32x4 sm = {0.f, 0.f, 0.f, 0.f};
#pragma unroll
            for (int w = 0; w < 8; ++w) sm += *(const LAS f32x4*)(rb + w * DM + F.tid * 4);
            f32x4* xq = (f32x4*)(XW + (size_t)row * DM) + F.tid;
            const f32x4 xn = x_old + g_vec * sm;
            *xq = xn;
            if (OUT) { const int b = row / RB, i = row - b * RB; if (i >= CTX) *((f32x4*)(OUT + ((size_t)b * SEQ + (i - CTX)) * DM) + F.tid) = xn; }
            if (HN) {
                LAS float* ssp = (LAS float*)(F.lds + 131072) + par * 8;
                const float sw = wave_sum_dpp((xn.x * xn.x + xn.y * xn.y) + (xn.z * xn.z + xn.w * xn.w));
                if (lane == 0) ssp[F.wave] = sw;
                __syncthreads();
                const float tot = ((ssp[0] + ssp[1]) + (ssp[2] + ssp[3])) + ((ssp[4] + ssp[5]) + (ssp[6] + ssp[7]));
                const float rstd = 1.0f / sqrtf(tot * (1.f / DM) + EPS);
                const f32x4 y = (xn * rstd) * n_g * (n_sc + 1.0f) + n_sh;
                u32x2 o; o.x = pk2(y.x, y.y); o.y = pk2(y.z, y.w);
                *((u32x2*)(HN + (size_t)row * DM) + F.tid) = o;
            }
        }
        par ^= 1; row = nrow;
#pragma unroll
        for (int q = 0; q < 4; ++q) xp[q] = xpn[q];
        iv = ivn; gv = gvn;
    }
#undef PX_LOADALL
#undef PX_U1
#undef PX_V1
#undef PX_SB
#undef PX_FETCH_TOKEN
}
#else
__device__ __forceinline__ void peer_expert_phase(const Frame& F0, const bf16_t* H2, const int* IDX, const float* GATE, const unsigned char* U, size_t v_minus_u_bytes, const float* USC, const float* VSC,
                                                  const float* g2  , float* XW, float* OUT,
                                                  bf16_t* HN  , const float* ng  , const float* nmod  ) {
    const Frame F = phase_frame(F0);
    LAS float* red = (LAS float*)F.lds;
    const unsigned voff_tab = (unsigned)v_minus_u_bytes;
    const __amdgpu_buffer_rsrc_t rs = __builtin_amdgcn_make_buffer_rsrc((void*)U, 0, (int)(voff_tab + (unsigned)NEXP * ROWB), 0x00020000);
    const int lane = F.lane; const int voff = lane * 16, voff2 = 1024 + lane * 8;
#define PX_SB() __builtin_amdgcn_sched_barrier(0)
#define PX_LOAD(buf, s, ivv) do { constexpr int e0_ = ((s) & 3) * 4; const unsigned tb_ = ((s) >= 4) ? voff_tab : 0u; \
        _Pragma("unroll") for (int ee_ = 0; ee_ < 4; ++ee_) { const unsigned o_ = (unsigned)__builtin_amdgcn_readlane(ivv, e0_ + ee_) * (unsigned)ROWB + tb_; \
            buf##h[ee_] = __builtin_amdgcn_raw_buffer_load_b128(rs, voff, o_, 0); buf##l[ee_] = __builtin_amdgcn_raw_buffer_load_b64(rs, voff2, o_, 0); } } while (0)
#define PX_DECODE(buf, ee_, dep) u32x6 w6_ = {buf##h[ee_].x, buf##h[ee_].y, buf##h[ee_].z, buf##h[ee_].w, buf##l[ee_].x, buf##l[ee_].y}; \
        asm volatile("" : "+v"(w6_) : "v"(dep));     \
        const f32x32 r_ = __builtin_amdgcn_cvt_scalef32_pk32_f32_fp6(w6_, 1.0f);
#define PX_COMP_U(buf, s) do { constexpr int e0_ = ((s) & 3) * 4; \
            _Pragma("unroll") for (int ee_ = 0; ee_ < 4; ++ee_) { PX_DECODE(buf, ee_, sv) \
                const f32x32 p_ = r_ * xf; float a0_ = 0.f, a1_ = 0.f; \
                _Pragma("unroll") for (int k_ = 0; k_ < 32; k_ += 2) { a0_ += p_[k_]; a1_ += p_[k_ + 1]; } \
                const float t_ = wave_sum_dpp(a0_ + a1_); sv = (lane == e0_ + ee_) ? t_ : sv; } } while (0)
#define PX_COMP_V(buf, s) do { constexpr int e0_ = ((s) & 3) * 4; \
            _Pragma("unroll") for (int ee_ = 0; ee_ < 4; ++ee_) { const float wg_ = __uint_as_float(__builtin_amdgcn_readlane(__float_as_uint(wv), e0_ + ee_)); \
                PX_DECODE(buf, ee_, acc) \
                acc += r_ * wg_; } } while (0)
#define PX_FETCH_TOKEN(r, XP, IV, GV) do { const u32x4* xp_ = (const u32x4*)(H2 + (size_t)(r) * DM + lane * 16); XP[0] = xp_[0]; XP[1] = xp_[1]; XP[2] = xp_[128]; XP[3] = xp_[129]; \
        IV = 0; GV = 0.f; if (lane < 16) { IV = IDX[(size_t)(r) * 128 + F.wave * 16 + lane]; GV = GATE[(size_t)(r) * 128 + F.wave * 16 + lane]; } } while (0)
    const bool skip_ctx = (OUT != nullptr);
    int row = F.vcu; if (skip_ctx && row < MROWS && row_cls(row) == 2) row += F.G;
    u32x4 xp[4]; int iv; float gv;
    u32x4 bAh[4], bBh[4]; u32x2 bAl[4], bBl[4];
    if (row < MROWS) { PX_FETCH_TOKEN(row, xp, iv, gv); PX_LOAD(bA, 0, iv); }
    int par = 0;
    while (row < MROWS) {
        int nrow = row + F.G; if (skip_ctx && nrow < MROWS && row_cls(nrow) == 2) nrow += F.G;
        f32x32 xf;
#pragma unroll
        for (int q = 0; q < 4; ++q) { const unsigned ww[4] = {xp[q].x, xp[q].y, xp[q].z, xp[q].w};
#pragma unroll
            for (int k = 0; k < 4; ++k) { xf[q * 8 + 2 * k] = bf_lo(ww[k]); xf[q * 8 + 2 * k + 1] = bf_hi(ww[k]); } }
        float usc = 0.f, vsc = 0.f;
        if (lane < 16) { usc = USC[iv]; vsc = VSC[iv]; }
        u32x4 xpn[4]; int ivn = 0; float gvn = 0.f;
        if (nrow < MROWS) PX_FETCH_TOKEN(nrow, xpn, ivn, gvn);
        const int cls = row_cls(row);
        const f32x4 x_old = *((const f32x4*)(XW + (size_t)row * DM) + F.tid), g_vec = *((const f32x4*)(g2 + (size_t)cls * NMOD) + F.tid);
        f32x4 n_g = {0.f, 0.f, 0.f, 0.f}, n_sc = n_g, n_sh = n_g;
        if (HN) { n_g = *((const f32x4*)ng + F.tid); n_sc = *((const f32x4*)(nmod + (size_t)cls * NMOD + 2048) + F.tid); n_sh = *((const f32x4*)(nmod + (size_t)cls * NMOD) + F.tid); }
        float sv = 0.f, wv = 0.f;
        PX_LOAD(bB, 1, iv); PX_SB(); PX_COMP_U(bA, 0); PX_SB();
        PX_LOAD(bA, 2, iv); PX_SB(); PX_COMP_U(bB, 1); PX_SB();
        PX_LOAD(bB, 3, iv); PX_SB(); PX_COMP_U(bA, 2); PX_SB();
        PX_LOAD(bA, 4, iv); PX_SB(); PX_COMP_U(bB, 3); PX_SB();
        wv = gelu_erf(sv * usc) * gv * vsc;
        f32x32 acc = {};
        PX_LOAD(bB, 5, iv); PX_SB(); PX_COMP_V(bA, 4); PX_SB();
        PX_LOAD(bA, 6, iv); PX_SB(); PX_COMP_V(bB, 5); PX_SB();
        PX_LOAD(bB, 7, iv); PX_SB(); PX_COMP_V(bA, 6); PX_SB();
        if (nrow < MROWS) PX_LOAD(bA, 0, ivn);
        PX_SB(); PX_COMP_V(bB, 7); PX_SB();
        LAS float* rb = red + par * (NWAVES * DM);
#pragma unroll
        for (int j = 0; j < 2; ++j)
#pragma unroll
            for (int q = 0; q < 4; ++q) *(LAS f32x4*)(rb + F.wave * DM + j * 1024 + lane * 16 + q * 4) = (f32x4){acc[j * 16 + q * 4], acc[j * 16 + q * 4 + 1], acc[j * 16 + q * 4 + 2], acc[j * 16 + q * 4 + 3]};
        __syncthreads();
        {
            f32x4 sm = {0.f, 0.f, 0.f, 0.f};
#pragma unroll
            for (int w = 0; w < 8; ++w) sm += *(const LAS f32x4*)(rb + w * DM + F.tid * 4);
            f32x4* xq = (f32x4*)(XW + (size_t)row * DM) + F.tid;
            const f32x4 xn = x_old + g_vec * sm;
            *xq = xn;
            if (OUT) { const int b = row / RB, i = row - b * RB; if (i >= CTX) *((f32x4*)(OUT + ((size_t)b * SEQ + (i - CTX)) * DM) + F.tid) = xn; }
            if (HN) {
                LAS float* ssp = (LAS float*)(F.lds + 131072) + par * 8;
                const float sw = wave_sum_dpp((xn.x * xn.x + xn.y * xn.y) + (xn.z * xn.z + xn.w * xn.w));
                if (lane == 0) ssp[F.wave] = sw;
                __syncthreads();
                const float tot = ((ssp[0] + ssp[1]) + (ssp[2] + ssp[3])) + ((ssp[4] + ssp[5]) + (ssp[6] + ssp[7]));
                const float rstd = 1.0f / sqrtf(tot * (1.f / DM) + EPS);
                const f32x4 y = (xn * rstd) * n_g * (n_sc + 1.0f) + n_sh;
                u32x2 o; o.x = pk2(y.x, y.y); o.y = pk2(y.z, y.w);
                *((u32x2*)(HN + (size_t)row * DM) + F.tid) = o;
            }
        }
        par ^= 1; row = nrow;
#pragma unroll
        for (int q = 0; q < 4; ++q) xp[q] = xpn[q];
        iv = ivn; gv = gvn;
    }
#undef PX_LOAD
#undef PX_COMP_U
#undef PX_COMP_V
#undef PX_SB
#undef PX_FETCH_TOKEN
}
#endif

#if EXP_SLICED && TAB_FP4
__device__ __forceinline__ float oct_sum(float v) { v = DPP_ADD(v, 0xB1); v = DPP_ADD(v, 0x4E); v = DPP_ADD(v, 0x141); return v; }
__device__ __forceinline__ int sl_next_tok(int t, bool lat_only) { t += 256; if (lat_only) while (t < MROWS && row_cls(t) == 2) t += 256; return t; }
#ifndef PROBE_IDMASK
#define PROBE_IDMASK 0x7fffffff
#endif
#define SL_IDS(t_, A_, B_) do { A_ = IDX[(size_t)(t_) * 128 + lane] & idmask; B_ = IDX[(size_t)(t_) * 128 + 64 + lane] & idmask; } while (0)
#define SL_ROWS(buf, A_, B_) do { _Pragma("unroll") for (int i_ = 0; i_ < 16; ++i_) { const int id_ = __builtin_amdgcn_ds_bpermute(bp + 32 * (i_ & 7), (i_ < 8) ? (A_) : (B_)); \
        buf[i_] = __builtin_amdgcn_raw_buffer_load_b128(rs, id_ * 128 + coloff, 0, 0); } } while (0)
__device__ __forceinline__ void peer_u_phase(const Frame& F0, const unsigned* XQ, const float* XS, const int* IDX, const unsigned char* U, float* PART, bool lat_only, int idmask = 0x7fffffff) {
    const Frame F = phase_frame(F0);
    const int lane = F.lane, g = lane >> 3, j = lane & 7, bp = 4 * g;
    const int x = F.vcu >> 5, wi = (F.vcu & 31) * NWAVES + F.wave;
    const __amdgpu_buffer_rsrc_t rs = __builtin_amdgcn_make_buffer_rsrc((void*)(U + (size_t)x * (NEXP * 128)), 0, NEXP * 128, 0x00020000);
    const int coloff = 16 * j;
    int t = wi - 256; t = sl_next_tok(t, lat_only);
    int t1 = sl_next_tok(t, lat_only), t2 = sl_next_tok(t1, lat_only);
    int idA1 = 0, idB1 = 0, idA2 = 0, idB2 = 0, idA3 = 0, idB3 = 0; u32x4 xs[3], xs1[3], xs2[3], w[16], wn[16];
#define SL_XS(dst, t_) do { const u32x4* xp_ = (const u32x4*)(XQ + ((size_t)(t_) * 64 + 8 * x + j) * 8); dst[0] = xp_[0]; dst[1] = xp_[1]; const f32x2 s2_ = *(const f32x2*)(XS + ((size_t)(t_) * 64 + 8 * x + j) * 2); dst[2] = (u32x4){__float_as_uint(s2_.x), __float_as_uint(s2_.y), 0u, 0u}; } while (0)
    if (t < MROWS) { int idA0, idB0; SL_IDS(t, idA0, idB0); SL_XS(xs1, t); SL_ROWS(wn, idA0, idB0); }
    if (t1 < MROWS) { SL_IDS(t1, idA2, idB2); SL_XS(xs2, t1); }
    if (t2 < MROWS) SL_IDS(t2, idA3, idB3);
    while (t < MROWS) {
        const int t3 = sl_next_tok(t2, lat_only);
#pragma unroll
        for (int i = 0; i < 16; ++i) w[i] = wn[i];
#pragma unroll
        for (int q = 0; q < 3; ++q) { xs[q] = xs1[q]; xs1[q] = xs2[q]; }
        idA1 = idA2; idB1 = idB2; idA2 = idA3; idB2 = idB3;
        if (t1 < MROWS) SL_ROWS(wn, idA1, idB1);
        if (t2 < MROWS) SL_XS(xs2, t2);
        if (t3 < MROWS) SL_IDS(t3, idA3, idB3);
        const int xh[4] = {(int)xs[0].x, (int)xs[0].y, (int)xs[0].z, (int)xs[0].w}, xl[4] = {(int)xs[1].x, (int)xs[1].y, (int)xs[1].z, (int)xs[1].w};
        const float dq = __uint_as_float(xs[2].x), off = __uint_as_float(xs[2].y);
        float res_lo = 0.f, res_hi = 0.f;
#pragma unroll
        for (int i = 0; i < 16; ++i) {
            const int wd_[4] = {(int)w[i].x, (int)w[i].y, (int)w[i].z, (int)w[i].w}; int ah_ = 0, al_ = 0;
#pragma unroll
            for (int d = 0; d < 4; ++d) { ah_ = __builtin_amdgcn_sdot8(wd_[d], xh[d], ah_, false); al_ = __builtin_amdgcn_sdot8(wd_[d], xl[d], al_, false); }
            const float a_ = oct_sum(((float)(16 * ah_ + al_) + off) * dq);
            if (i < 8) res_lo = (j == i) ? a_ : res_lo; else res_hi = (j == i - 8) ? a_ : res_hi;
        }
        float* pp = PART + ((size_t)t * 8 + x) * 128 + 8 * j + g;
        pp[0] = res_lo; pp[64] = res_hi;
        t = t1; t1 = t2; t2 = t3;
    }
#undef SL_XS
}
__device__ __forceinline__ void peer_w_phase(const Frame& F0, const float* PART, const int* IDX, float* GATE, const float* USC, const float* VSC, bool lat_only) {
    const Frame F = phase_frame(F0);
    const int gt = F.vcu * NTHREADS + F.tid, GT = F.G * NTHREADS;
    for (int e = gt; e < MROWS * 128; e += GT) { const int t = e >> 7, k = e & 127;
        if (lat_only && row_cls(t) == 2) continue;
        const float* pp = PART + (size_t)t * 1024 + k; float s = 0.f;
#pragma unroll
        for (int xx = 0; xx < 8; ++xx) s += pp[xx * 128];
        const int id = IDX[e];
        GATE[e] = GATE[e] * gelu_erf(s * USC[id]) * VSC[id]; }
}
__device__ __forceinline__ void peer_v_phase(const Frame& F0, const int* IDX, const float* WK, const unsigned char* VT, const float* g2  , float* XW, float* OUT, bool lat_only) {
    const int idmask = 0x7fffffff;
    const Frame F = phase_frame(F0);
    const int lane = F.lane, g = lane >> 3, j = lane & 7, bp = 4 * g;
    const int x = F.vcu >> 5, wi = (F.vcu & 31) * NWAVES + F.wave;
    const __amdgpu_buffer_rsrc_t rs = __builtin_amdgcn_make_buffer_rsrc((void*)(VT + (size_t)x * (NEXP * 128)), 0, NEXP * 128, 0x00020000);
    const int coloff = 16 * j;
    const int mycol = 256 * x + 32 * j + 4 * g;
    int t = wi - 256; t = sl_next_tok(t, lat_only);
    int t1 = sl_next_tok(t, lat_only), t2 = sl_next_tok(t1, lat_only);
    int idA1 = 0, idB1 = 0, idA2 = 0, idB2 = 0, idA3 = 0, idB3 = 0; float wA = 0.f, wB = 0.f, wA1 = 0.f, wB1 = 0.f, wA2 = 0.f, wB2 = 0.f; u32x4 w[16], wn[16];
    f32x4 x_old = {0.f, 0.f, 0.f, 0.f}, g_vec = x_old, xo1 = x_old, gv1 = x_old, xo2 = x_old, gv2 = x_old;
#define SL_WK(t_, A_, B_) do { A_ = WK[(size_t)(t_) * 128 + lane]; B_ = WK[(size_t)(t_) * 128 + 64 + lane]; } while (0)
#define SL_XG(t_, X_, G_) do { X_ = *(const f32x4*)(XW + (size_t)(t_) * DM + mycol); G_ = *(const f32x4*)(g2 + (size_t)row_cls(t_) * NMOD + mycol); } while (0)
    if (t < MROWS) { int idA0, idB0; SL_IDS(t, idA0, idB0); SL_WK(t, wA1, wB1); SL_XG(t, xo1, gv1); SL_ROWS(wn, idA0, idB0); }
    if (t1 < MROWS) { SL_IDS(t1, idA2, idB2); SL_WK(t1, wA2, wB2); SL_XG(t1, xo2, gv2); }
    if (t2 < MROWS) SL_IDS(t2, idA3, idB3);
    while (t < MROWS) {
        const int t3 = sl_next_tok(t2, lat_only);
#pragma unroll
        for (int i = 0; i < 16; ++i) w[i] = wn[i];
        wA = wA1; wB = wB1; wA1 = wA2; wB1 = wB2; x_old = xo1; g_vec = gv1; xo1 = xo2; gv1 = gv2;
        idA1 = idA2; idB1 = idB2; idA2 = idA3; idB2 = idB3;
        if (t1 < MROWS) SL_ROWS(wn, idA1, idB1);
        if (t2 < MROWS) { SL_WK(t2, wA2, wB2); SL_XG(t2, xo2, gv2); }
        if (t3 < MROWS) SL_IDS(t3, idA3, idB3);
        h2_t acc[16];
#pragma unroll
        for (int p = 0; p < 16; ++p) acc[p] = (h2_t){(_Float16)0.f, (_Float16)0.f};
#define SL_V1(d_, b_) { const h2_t r2_ = __builtin_amdgcn_cvt_scalef32_pk_f16_fp4(wd_[d_], 1.0f, b_); acc[4 * (d_) + (b_)] = __builtin_elementwise_fma(r2_, wg2_, acc[4 * (d_) + (b_)]); }
#pragma unroll
        for (int i = 0; i < 16; ++i) {
            const unsigned wd_[4] = {w[i].x, w[i].y, w[i].z, w[i].w};
            const float wgf_ = __int_as_float(__builtin_amdgcn_ds_bpermute(bp + 32 * (i & 7), __float_as_int((i < 8) ? wA : wB)));
            const _Float16 wgh_ = (_Float16)wgf_; const h2_t wg2_ = {wgh_, wgh_};
            SL_V1(0, 0) SL_V1(0, 1) SL_V1(0, 2) SL_V1(0, 3) SL_V1(1, 0) SL_V1(1, 1) SL_V1(1, 2) SL_V1(1, 3) SL_V1(2, 0) SL_V1(2, 1) SL_V1(2, 2) SL_V1(2, 3) SL_V1(3, 0) SL_V1(3, 1) SL_V1(3, 2) SL_V1(3, 3)
        }
#undef SL_V1
        unsigned m0 = 0u, m1 = 0u;
#pragma unroll
        for (int p = 0; p < 16; ++p) {
            h2_t v = acc[p];
            v = v + __builtin_bit_cast(h2_t, __builtin_amdgcn_update_dpp(0, __builtin_bit_cast(int, v), 0x128, 0xf, 0xf, true));
            { auto r = __builtin_amdgcn_permlane16_swap(__builtin_bit_cast(unsigned, v), __builtin_bit_cast(unsigned, v), false, false); v = __builtin_bit_cast(h2_t, (unsigned)r[0]) + __builtin_bit_cast(h2_t, (unsigned)r[1]); }
            { auto r = __builtin_amdgcn_permlane32_swap(__builtin_bit_cast(unsigned, v), __builtin_bit_cast(unsigned, v), false, false); v = __builtin_bit_cast(h2_t, (unsigned)r[0]) + __builtin_bit_cast(h2_t, (unsigned)r[1]); }
            if (g == (p >> 1)) { if (p & 1) m1 = __builtin_bit_cast(unsigned, v); else m0 = __builtin_bit_cast(unsigned, v); }
        }
        const h2_t q0 = __builtin_bit_cast(h2_t, m0), q1 = __builtin_bit_cast(h2_t, m1);
        const f32x4 mine = {(float)q0.x, (float)q0.y, (float)q1.x, (float)q1.y};
        const f32x4 xn = x_old + g_vec * mine;
        *(f32x4*)(XW + (size_t)t * DM + mycol) = xn;
        if (OUT) { const int b = t / RB, i = t - b * RB; if (i >= CTX) *(f32x4*)(OUT + ((size_t)b * SEQ + (i - CTX)) * DM + mycol) = xn; }
        t = t1; t1 = t2; t2 = t3;
    }
#undef SL_WK
#undef SL_XG
}
#undef SL_IDS
#undef SL_ROWS
#endif
#ifndef N_LAUNCHES
#define N_LAUNCHES 1
#endif
struct Args { const float* in[26]; float* out; unsigned char* ws; int ph_lo, ph_hi; };
constexpr int NPHASES = 39;
__global__ void __launch_bounds__(NTHREADS, 2) fwd_kernel(Args args) {
    extern __shared__ __attribute__((aligned(16))) unsigned char lds_raw[];
    Frame F_;
    F_.lds = (LAS unsigned char*)lds_raw;
    F_.tid = threadIdx.x; F_.lane = F_.tid & 63; F_.wave = __builtin_amdgcn_readfirstlane(F_.tid >> 6);
    F_.G = gridDim.x; { const int bx = blockIdx.x; F_.vcu = (F_.G % 8 == 0) ? (bx % 8) * (F_.G / 8) + bx / 8 : bx; }
    F_.gw = F_.vcu * NWAVES + F_.wave; F_.NGW = F_.G * NWAVES;
    F_.ws = args.ws;
    volatile LAS unsigned* MISC = (volatile LAS unsigned*)(F_.lds + LDS_MISC);
    if (F_.tid < 32) MISC[F_.tid] = 0u;
    __syncthreads();
    const int lo = args.ph_lo, hi = args.ph_hi;
    XcdBarrier bar; bar.bar = (unsigned*)(args.ws + WS_CTL) + CW_BAR; bar.x = 0; bar.st = nullptr;
    if (N_LAUNCHES == 1 || hi - lo > 1) bar = xcd_barrier_post((unsigned*)(args.ws + WS_CTL) + CW_BAR, MISC + 8);
#if N_LAUNCHES == 1
#define IN(k) true
#define SEAM(k) xcd_barrier(bar)
#else
#define IN(k) (lo <= (k) && (k) < hi)
#define SEAM(k) do { if (IN(k) && IN((k) + 1)) xcd_barrier(bar); } while (0)
#endif
    PG8_LAS unsigned char* glds = (PG8_LAS unsigned char*)lds_raw;

    if (IN(0)) { p0_prologue(F_, args.in); } SEAM(0);

#pragma unroll 1
    for (int lp = 0; lp < 2; ++lp) {
        const int pb = 1 + lp * 19;
        unsigned char* ws = args.ws; asm volatile("" : "+s"(ws));
        Frame F = F_; { int w_ = F_.wave, v_ = F_.vcu, g_ = F_.G; asm volatile("" : "+s"(w_), "+s"(v_), "+s"(g_)); F.wave = w_; F.vcu = v_; F.G = g_; F.gw = v_ * NWAVES + w_; F.NGW = g_ * NWAVES; F.ws = ws; }
        float* mod = (float*)(ws + WS_MOD); float* XW = (float*)(ws + WS_XW);
        bf16_t* H = (bf16_t*)(ws + WS_H); bf16_t* P = (bf16_t*)(ws + WS_P); bf16_t* QRAW = (bf16_t*)(ws + WS_QRAW); bf16_t* KVRAW = (bf16_t*)(ws + WS_KVRAW);
        bf16_t* Q = (bf16_t*)(ws + WS_Q); bf16_t* KB = (bf16_t*)(ws + WS_K); bf16_t* VB = (bf16_t*)(ws + WS_V); bf16_t* CAT = (bf16_t*)(ws + WS_CAT); bf16_t* PQ = (bf16_t*)(ws + WS_PQ);
        int* IDX = (int*)(ws + WS_IDX); float* GATE = (float*)(ws + WS_GATE);
        const float* rope_c = (const float*)(ws + WS_ROPE); const float* rope_a = rope_c + 64 * 32 * 2;
        const float* SMv = (const float*)(ws + WS_SMALL);
        {
            const int l = 2 * lp, i = lp;
            const float* modl = mod + (size_t)l * 3 * NMOD;
            if (lp == 0) { if (IN(pb + 0)) { norm_phase(F, XW, SMv + SM_N1G + l * DM, modl, 0, 2048, H, false); } SEAM(pb + 0); }
            if (IN(pb + 1)) {
                pg8::Gemm g{H, (const bf16_t*)(ws + WS_WIN) + (size_t)i * 4096 * DM, MROWS, 4096, DM, DM, DM}; pg8::StaticOrder S; S.init(MROWS, 4096, F.G, (int)blockIdx.x);
                pg8::EpiBf16 E{P, 4096};
                pg8::gemm_phase<pg8::EpiBf16, pg8::StaticOrder, true, true>(glds, g, S, E, phase_tid(F.wave));
            } SEAM(pb + 1);
            if (IN(pb + 2)) {
                { pg8::Gemm g{P, (const bf16_t*)(ws + WS_WUQ) + (size_t)i * 1536 * 512, MROWS, 1536, 512, 4096, 512}; pg8::StaticOrder S; S.init(MROWS, 1536, F.G, (int)blockIdx.x);
                  pg8::EpiBf16 E{QRAW, 1536};
                  pg8::gemm_phase<pg8::EpiBf16, pg8::StaticOrder, true, true>(glds, g, S, E, phase_tid(F.wave)); }
                __syncthreads();
                { pg8::Gemm g{P + 512, (const bf16_t*)(ws + WS_WUKV) + (size_t)i * 2048 * 256, MROWS, 2048, 256, 4096, 256}; pg8::StaticOrder S; S.init(MROWS, 2048, F.G, (int)blockIdx.x);
                  pg8::EpiBf16 E{KVRAW, 2048};
                  pg8::gemm_phase<pg8::EpiBf16, pg8::StaticOrder, true, true>(glds, g, S, E, phase_tid(F.wave)); }
                __syncthreads();
                conv_phase(F, P, SMv + SM_CW + i * 3072, SMv + SM_CB + i * 1024, CAT);
            } SEAM(pb + 2);
            if (IN(pb + 3)) { prep_even_phase(F, P, QRAW, KVRAW, SMv + SM_AQG + i * 192, SMv + SM_AKG + i * 192, rope_a, Q, KB, VB); } SEAM(pb + 3);
            if (IN(pb + 4)) { attn_even_phase(F, Q, KB, VB, CAT); } SEAM(pb + 4);
            if (IN(pb + 5)) {
                pg8::Gemm g{CAT, (const bf16_t*)(ws + WS_WEO) + (size_t)i * DM * DM, MROWS, DM, DM, DM, DM}; pg8::StaticOrder S; S.init(MROWS, DM, F.G, (int)blockIdx.x);
                pg8::EpiResid E{XW, DM, modl + 4096};
                pg8::gemm_phase<pg8::EpiResid, pg8::StaticOrder, true, true>(glds, g, S, E, phase_tid(F.wave));
            } SEAM(pb + 5);
            if (IN(pb + 6)) { norm_phase(F, XW, SMv + SM_N2G + l * DM, modl, 6144, 8192, H, l == 3, (unsigned*)(ws + WS_XQ), (float*)(ws + WS_XS)); } SEAM(pb + 6);
            if (IN(pb + 7)) {
                pg8::Gemm g{H, (const bf16_t*)(ws + WS_WPQ) + (size_t)l * DM * DM, MROWS, DM, DM, DM, DM}; pg8::StaticOrder S; S.init(MROWS, DM, F.G, (int)blockIdx.x);
                pg8::EpiBf16 E{PQ, DM};
                pg8::gemm_phase<pg8::EpiBf16, pg8::StaticOrder, true, true>(glds, g, S, E, phase_tid(F.wave));
            } SEAM(pb + 7);
            if (IN(pb + 8)) { peer_topk_phase(F, PQ, (const bf16_t*)(ws + WS_SUBK) + (size_t)l * 16 * 128 * 128, IDX, GATE, l == 3); } SEAM(pb + 8);
            {
                const unsigned char* Ut = ws + WS_U + (size_t)l * NEXP * ROWB; const unsigned char* Vt = ws + WS_VT + (size_t)l * NEXP * ROWB;
                peer_u_phase(F, (const unsigned*)(ws + WS_XQ), (const float*)(ws + WS_XS), IDX, Ut, (float*)(ws + WS_PART), false); SEAM(0);
                peer_w_phase(F, (const float*)(ws + WS_PART), IDX, GATE, (const float*)(ws + WS_USC) + l * NEXP, (const float*)(ws + WS_VSC) + l * NEXP, false); SEAM(0);
                peer_v_phase(F, IDX, GATE, Vt, modl + 10240, XW, nullptr, false); SEAM(0);
                norm_phase(F, XW, SMv + SM_N1G + (l + 1) * DM, mod + (size_t)(l + 1) * 3 * NMOD, 0, 2048, H, false); SEAM(0);
            }
        }
        {
            const int l = 2 * lp + 1, i = lp, qb = pb + 10;
            const float* modl = mod + (size_t)l * 3 * NMOD;
            if (IN(qb + 1)) {
                pg8::Gemm g{H, (const bf16_t*)(ws + WS_WQKV) + (size_t)i * 3072 * DM, MROWS, 3072, DM, DM, DM}; pg8::StaticOrder S; S.init(MROWS, 3072, F.G, (int)blockIdx.x);
                pg8::EpiBf16 E{P, 3072};
                pg8::gemm_phase<pg8::EpiBf16, pg8::StaticOrder, true, true>(glds, g, S, E, phase_tid(F.wave));
            } SEAM(qb + 1);
            if (IN(qb + 2)) { prep_odd_phase(F, P, SMv + SM_CQG + i * 128, SMv + SM_CKG + i * 128, rope_c, Q, KB); } SEAM(qb + 2);
            if (IN(qb + 3)) { attn_odd_phase(F, Q, KB, P, CAT, l == 3); } SEAM(qb + 3);
            if (IN(qb + 4)) {
                pg8::Gemm g{CAT, (const bf16_t*)(ws + WS_WCO) + (size_t)i * DM * DM, MROWS, DM, DM, DM, DM}; pg8::StaticOrder S; S.init(MROWS, DM, F.G, (int)blockIdx.x, l == 3);
                pg8::EpiResid E{XW, DM, modl + 4096};
                pg8::gemm_phase<pg8::EpiResid, pg8::StaticOrder, true, true>(glds, g, S, E, phase_tid(F.wave));
            } SEAM(qb + 4);
            if (IN(qb + 5)) { norm_phase(F, XW, SMv + SM_N2G + l * DM, modl, 6144, 8192, H, l == 3, (unsigned*)(ws + WS_XQ), (float*)(ws + WS_XS)); } SEAM(qb + 5);
            if (IN(qb + 6)) {
                pg8::Gemm g{H, (const bf16_t*)(ws + WS_WPQ) + (size_t)l * DM * DM, MROWS, DM, DM, DM, DM}; pg8::StaticOrder S; S.init(MROWS, DM, F.G, (int)blockIdx.x, l == 3);
                pg8::EpiBf16 E{PQ, DM};
                pg8::gemm_phase<pg8::EpiBf16, pg8::StaticOrder, true, true>(glds, g, S, E, phase_tid(F.wave));
            } SEAM(qb + 6);
            if (IN(qb + 7)) { peer_topk_phase(F, PQ, (const bf16_t*)(ws + WS_SUBK) + (size_t)l * 16 * 128 * 128, IDX, GATE, l == 3); } SEAM(qb + 7);
            {
                const unsigned char* Ut = ws + WS_U + (size_t)l * NEXP * ROWB; const unsigned char* Vt = ws + WS_VT + (size_t)l * NEXP * ROWB;
                peer_u_phase(F, (const unsigned*)(ws + WS_XQ), (const float*)(ws + WS_XS), IDX, Ut, (float*)(ws + WS_PART), l == 3); SEAM(0);
                peer_w_phase(F, (const float*)(ws + WS_PART), IDX, GATE, (const float*)(ws + WS_USC) + l * NEXP, (const float*)(ws + WS_VSC) + l * NEXP, l == 3); SEAM(0);
                peer_v_phase(F, IDX, GATE, Vt, modl + 10240, XW, (l == 3) ? args.out : nullptr, l == 3);
                if (lp == 0) { SEAM(0); norm_phase(F, XW, SMv + SM_N1G + (l + 1) * DM, mod + (size_t)(l + 1) * 3 * NMOD, 0, 2048, H, false); SEAM(0); }
            }
        }
    }
#undef IN
#undef SEAM
}

extern "C" void kernel_launch(void* const* d_in, const int* in_sizes, int n_in, void* d_out, int out_size, void* d_ws, size_t ws_size, hipStream_t stream) {
    static int grid = 0;
    if (grid == 0) {
        if (n_in != 26 || out_size != NBATCH * SEQ * DM || ws_size < WS_END) { fprintf(stderr, "kernel_launch: unexpected shapes: n_in %d out %d ws %zu (need %zu)\n", n_in, out_size, ws_size, (size_t)WS_END); grid = -1; return; }
        int dev = 0, cus = 0, per_cu = 0;
        if (hipGetDevice(&dev) != hipSuccess || hipDeviceGetAttribute(&cus, hipDeviceAttributeMultiprocessorCount, dev) != hipSuccess) { fprintf(stderr, "kernel_launch: device query failed\n"); grid = -1; return; }
        if (hipFuncSetAttribute((const void*)fwd_kernel, hipFuncAttributeMaxDynamicSharedMemorySize, LDS_BYTES) != hipSuccess) { fprintf(stderr, "kernel_launch: hipFuncSetAttribute failed\n"); grid = -1; return; }
        if (hipOccupancyMaxActiveBlocksPerMultiprocessor(&per_cu, (const void*)fwd_kernel, NTHREADS, LDS_BYTES) != hipSuccess || per_cu < 1) { fprintf(stderr, "kernel_launch: occupancy query says %d blocks per CU\n", per_cu); (void)hipGetLastError(); grid = -1; return; }
        grid = cus;
    }
    if (grid < 0) return;
    (void)hipMemsetAsync((char*)d_ws + WS_CTL, 0, CTL_ZERO_BYTES, stream);
    Args a{};
    for (int i = 0; i < 26; ++i) a.in[i] = (const float*)d_in[i];
    a.out = (float*)d_out; a.ws = (unsigned char*)d_ws;
    for (int li = 0; li < N_LAUNCHES; ++li) {
        a.ph_lo = (N_LAUNCHES == 1) ? 0 : li; a.ph_hi = (N_LAUNCHES == 1) ? NPHASES : li + 1;
        hipLaunchKernelGGL(fwd_kernel, dim3(grid), dim3(NTHREADS), LDS_BYTES, stream, a);
        const hipError_t le = hipPeekAtLastError();
        if (le != hipSuccess) { fprintf(stderr, "kernel_launch: launch %d failed: %s\n", li, hipGetErrorName(le)); break; }
    }
}
```

```cpp
#include <hip/hip_runtime.h>
#include <cstdio>
#include <cstdint>
namespace pg8 {
#define PG8_LAS __attribute__((address_space(3)))
typedef unsigned short bf16_t;
typedef short bf16x8 __attribute__((ext_vector_type(8)));
typedef float f32x4 __attribute__((ext_vector_type(4)));
typedef unsigned u32x4 __attribute__((ext_vector_type(4)));
constexpr int BM = 256, BK = 64, HALF = 128, HTB = HALF * BK * 2  , STAGE_BYTES = 8 * HTB, NXCD = 8, WGM = 8;

__host__ __device__ __forceinline__ int lds_byte(int r, int c) { const int st = (r >> 4) * 2 + (c >> 5), rr = r & 15, cc = c & 31, ob = rr * 64 + cc * 2; return st * 1024 + (ob ^ (((ob >> 9) & 1) << 5)); }
__host__ __device__ __forceinline__ void stage_rc(int b, int& R, int& C) { const int st = b / 1024, sb = b % 1024, swz = sb ^ (((sb >> 9) & 1) << 5); R = (st >> 1) * 16 + swz / 64; C = (st & 1) * 32 + (swz % 64) / 2; }
__host__ __device__ __forceinline__ int perm32(int rho) { const int n = rho >> 4, i = rho & 15; return 8 * (i >> 2) + 4 * n + (i & 3); }

struct Unit { int pm, pn; };
struct Gemm { const bf16_t* A; const bf16_t* Bt; int M, N, K, lda, ldb; };

struct StaticOrder {
    int nM, nN, nwg, G, c; bool lat_only;
    __host__ __device__ void init(int M, int N, int G_, int c_, bool lat_only_ = false) { lat_only = lat_only_; nM = lat_only_ ? 32 : M / BM; nN = N / BM; nwg = nM * nN; G = G_; c = c_; }
    __host__ __device__ bool next(int i, Unit& u) const {
        const long L = (long)i * G + c; if (L >= nwg) return false;
        int wgid = (int)L; { const int q = nwg / NXCD, r = nwg % NXCD, xcd = wgid % NXCD, off = wgid / NXCD; wgid = (xcd < r ? xcd * (q + 1) : r * (q + 1) + (xcd - r) * q) + off; }
        const int nig = WGM * nN, gid = wgid / nig, fm = gid * WGM, gsz = (nM - fm) < WGM ? (nM - fm) : WGM;
        u.pm = fm + ((wgid % nig) % gsz); u.pn = (wgid % nig) / gsz; if (lat_only) u.pm += 1 + (u.pm >= 16 ? 1 : 0); return true;
    }
    __device__ __forceinline__ void a_ready(const Unit&) const {}
    __device__ __forceinline__ void done(const Unit&) const {}
};
__device__ __forceinline__ unsigned cvt_pk_bf16(float lo, float hi) { unsigned r; asm volatile("v_cvt_pk_bf16_f32 %0, %1, %2" : "=v"(r) : "v"(lo), "v"(hi)); return r; }
typedef float f32x2 __attribute__((ext_vector_type(2)));
struct EpiBf16 {
    static constexpr bool PERM = true, AFTER_DRAIN = false;
    bf16_t* O; int ldc;
    __device__ __forceinline__ void operator()(const f32x4 (&acc)[2][2][4][2], const Unit& u, int wr, int wc, int fr, int fq) const {
        const int row0 = u.pm * BM + wr * 64 + fr, col0 = u.pn * BM + wc * 32 + 8 * fq;
#pragma unroll
        for (int ai = 0; ai < 2; ++ai)
#pragma unroll
            for (int m = 0; m < 4; ++m) { bf16_t* rowp = O + (size_t)(row0 + ai * HALF + m * 16) * ldc + col0;
#pragma unroll
                for (int bj = 0; bj < 2; ++bj) { const f32x4 v0 = acc[ai][bj][m][0], v1 = acc[ai][bj][m][1];
                    u32x4 w; w.x = cvt_pk_bf16(v0[0], v0[1]); w.y = cvt_pk_bf16(v0[2], v0[3]); w.z = cvt_pk_bf16(v1[0], v1[1]); w.w = cvt_pk_bf16(v1[2], v1[3]);
                    *(u32x4*)(rowp + bj * HALF) = w; } }
    }
};
struct EpiResid {
    static constexpr bool PERM = false, AFTER_DRAIN = false;
    float* X; int ldc; const float* gate;
    __device__ __forceinline__ void operator()(const f32x4 (&acc)[2][2][4][2], const Unit& u, int wr, int wc, int fr, int fq) const {
        const int row0 = u.pm * BM + wr * 64 + fr, col0 = u.pn * BM + wc * 32 + 4 * fq;
        const int cls = (u.pm % 17 == 0) ? 2 : (u.pm / 17);
        const float* gp = gate + (size_t)cls * 12288 + col0;
        f32x4 gv[2][2];
#pragma unroll
        for (int bj = 0; bj < 2; ++bj)
#pragma unroll
            for (int n = 0; n < 2; ++n) gv[bj][n] = *(const f32x4*)(gp + bj * HALF + n * 16);
#pragma unroll
        for (int ai = 0; ai < 2; ++ai)
#pragma unroll
            for (int m = 0; m < 4; ++m) { float* rowp = X + (size_t)(row0 + ai * HALF + m * 16) * ldc + col0;
#pragma unroll
                for (int bj = 0; bj < 2; ++bj)
#pragma unroll
                    for (int n = 0; n < 2; ++n) { f32x4* p = (f32x4*)(rowp + bj * HALF + n * 16); *p = *p + gv[bj][n] * acc[ai][bj][m][n]; } }
    }
};
template <class Epi, class Sched, bool ALIGN_EPI = false, bool SP2 = false>
__device__ __forceinline__ void gemm_phase(PG8_LAS unsigned char* lds, const Gemm g, const Sched& S, const Epi& E, int tid_in) {
    int tid_ = tid_in; asm volatile("" : "+v"(tid_));
    const int tid = tid_, wid = __builtin_amdgcn_readfirstlane(tid >> 6), lane = tid & 63, wr = wid >> 2, wc = wid & 3, fr = lane & 15, fq = lane >> 4;
    const int K = g.K, nt = K / BK;
    unsigned voffA[2], voffB[2];
#pragma unroll
    for (int i = 0; i < 2; ++i) { int R, C; stage_rc(tid * 16 + i * 8192, R, C); const int Rb = Epi::PERM ? ((R & ~31) + perm32(R & 31)) : R;
        voffA[i] = (unsigned)(R * g.lda + C) * 2u; voffB[i] = (unsigned)(Rb * g.ldb + C) * 2u; }
    const size_t kstep = (size_t)(BK * 2);
    const size_t hstepA = (size_t)HALF * g.lda * 2, hstepB = (size_t)HALF * g.ldb * 2;
    const size_t tstepA = 2 * hstepA, tstepB = 2 * hstepB;
    const unsigned ldsw = (unsigned)wid * 1024u;
    const int aoff = lds_byte(wr * 64 + fr, fq * 8), boff = lds_byte(wc * 32 + fr, fq * 8);
#define PG8_SA(b, h) (((b) * 2 + (h)) * HTB)
#define PG8_SB(b, h) ((4 + (b) * 2 + (h)) * HTB)
#define PG8_STAGE(bufoff, gbase, voff) do { _Pragma("unroll") for (int _i = 0; _i < 2; ++_i) \
        __builtin_amdgcn_global_load_lds((const unsigned*)((const char*)(gbase) + (voff)[_i]), (PG8_LAS unsigned*)(lds + (bufoff) + ldsw + _i * 8192), 16, 0, 0); } while (0)
#define PG8_LDA(dst, b, h) do { _Pragma("unroll") for (int m = 0; m < 4; ++m) _Pragma("unroll") for (int k = 0; k < 2; ++k) dst[m][k] = *(const PG8_LAS bf16x8*)(lds + PG8_SA(b, h) + aoff + m * 2048 + k * 1024); } while (0)
#define PG8_LDB(dst, b, h) do { _Pragma("unroll") for (int n = 0; n < 2; ++n) _Pragma("unroll") for (int k = 0; k < 2; ++k) dst[n][k] = *(const PG8_LAS bf16x8*)(lds + PG8_SB(b, h) + boff + n * 2048 + k * 1024); } while (0)
#define PG8_MMA(ai, bj, At, Bt) do { __builtin_amdgcn_s_setprio(1); _Pragma("unroll") for (int m = 0; m < 4; ++m) _Pragma("unroll") for (int n = 0; n < 2; ++n) _Pragma("unroll") for (int k = 0; k < 2; ++k) \
        acc[ai][bj][m][n] = __builtin_amdgcn_mfma_f32_16x16x32_bf16(Bt[n][k], At[m][k], acc[ai][bj][m][n], 0, 0, 0); __builtin_amdgcn_s_setprio(0); } while (0)
#define PG8_WAIT_V(n) asm volatile("s_waitcnt vmcnt(" #n ")" ::: "memory")
#define PG8_WAIT_L(n) asm volatile("s_waitcnt lgkmcnt(" #n ")" ::: "memory")
#define PG8_BAR __builtin_amdgcn_s_barrier()
#define PG8_SCHED __builtin_amdgcn_sched_barrier(0)
    Unit cur, nxt; int ui = 0;
    if (!S.next(0, cur)) return;
    f32x4 acc[2][2][4][2];
#pragma unroll
    for (int a = 0; a < 2; ++a)
#pragma unroll
        for (int b = 0; b < 2; ++b)
#pragma unroll
            for (int m = 0; m < 4; ++m)
#pragma unroll
                for (int n = 0; n < 2; ++n) acc[a][b][m][n] = (f32x4){0.f, 0.f, 0.f, 0.f};
    bf16x8 At[4][2], B0[2][2], B1[2][2];
    const char* cA = (const char*)g.A + (size_t)cur.pm * tstepA; const char* cB = (const char*)g.Bt + (size_t)cur.pn * tstepB;
    S.a_ready(cur);
    if constexpr (SP2) {
        PG8_STAGE(PG8_SB(0, 0), cB, voffB); PG8_STAGE(PG8_SB(0, 1), cB + hstepB, voffB); PG8_STAGE(PG8_SA(0, 0), cA, voffA); PG8_STAGE(PG8_SA(0, 1), cA + hstepA, voffA);
        if (wr == 1) PG8_BAR;
        PG8_WAIT_V(2); PG8_BAR;
        PG8_STAGE(PG8_SB(1, 0), cB + kstep, voffB); PG8_STAGE(PG8_SA(1, 0), cA + kstep, voffA); PG8_STAGE(PG8_SB(1, 1), cB + hstepB + kstep, voffB);
        PG8_WAIT_V(6); PG8_BAR;
    } else {
        PG8_STAGE(PG8_SB(0, 0), cB, voffB); PG8_STAGE(PG8_SA(0, 0), cA, voffA); PG8_STAGE(PG8_SB(0, 1), cB + hstepB, voffB); PG8_STAGE(PG8_SA(0, 1), cA + hstepA, voffA);
        if (wr == 1) PG8_BAR;
        PG8_WAIT_V(4); PG8_BAR;
        PG8_STAGE(PG8_SB(1, 0), cB + kstep, voffB); PG8_STAGE(PG8_SA(1, 0), cA + kstep, voffA); PG8_STAGE(PG8_SB(1, 1), cB + hstepB + kstep, voffB);
        PG8_WAIT_V(6); PG8_BAR;
    }
    for (;;) {
        const bool has_next = S.next(ui + 1, nxt);
        const char* nA = has_next ? (const char*)g.A + (size_t)nxt.pm * tstepA : cA; const char* nB = has_next ? (const char*)g.Bt + (size_t)nxt.pn * tstepB : cB;
        for (int t = 0; t < nt; t += 2) {
            const bool last = (t == nt - 2);
            const char* a1 = cA + (size_t)(t + 1) * kstep;
            const char* a2 = last ? nA : cA + (size_t)(t + 2) * kstep; const char* b2 = last ? nB : cB + (size_t)(t + 2) * kstep;
            const char* a3 = a2 + kstep; const char* b3 = b2 + kstep;
            if (last && has_next) S.a_ready(nxt);
            if constexpr (SP2) {
            PG8_LDB(B0, 0, 0); PG8_LDB(B1, 0, 1); PG8_SCHED; PG8_LDA(At, 0, 0); PG8_STAGE(PG8_SA(1, 1), a1 + hstepA, voffA);
            PG8_WAIT_V(8); PG8_WAIT_L(0); PG8_BAR; PG8_MMA(0, 0, At, B0); PG8_MMA(0, 1, At, B1); PG8_BAR; PG8_SCHED;
            PG8_LDA(At, 0, 1); PG8_STAGE(PG8_SB(0, 0), b2, voffB); PG8_STAGE(PG8_SB(0, 1), b2 + hstepB, voffB); PG8_STAGE(PG8_SA(0, 0), a2, voffA);
            PG8_WAIT_V(8); PG8_WAIT_L(0); PG8_BAR; PG8_MMA(1, 0, At, B0); PG8_MMA(1, 1, At, B1); PG8_BAR; PG8_SCHED;
            PG8_LDB(B0, 1, 0); PG8_LDB(B1, 1, 1); PG8_SCHED; PG8_LDA(At, 1, 0); PG8_STAGE(PG8_SA(0, 1), a2 + hstepA, voffA);
            PG8_WAIT_V(8); PG8_WAIT_L(0); PG8_BAR; PG8_MMA(0, 0, At, B0); PG8_MMA(0, 1, At, B1); PG8_BAR; PG8_SCHED;
            PG8_LDA(At, 1, 1); PG8_STAGE(PG8_SB(1, 0), b3, voffB); PG8_STAGE(PG8_SB(1, 1), b3 + hstepB, voffB); PG8_STAGE(PG8_SA(1, 0), a3, voffA);
            PG8_WAIT_V(8); PG8_WAIT_L(0); PG8_BAR; PG8_MMA(1, 0, At, B0); PG8_MMA(1, 1, At, B1); PG8_BAR; PG8_SCHED;
            } else {
            PG8_LDB(B0, 0, 0); PG8_SCHED; PG8_LDA(At, 0, 0); PG8_STAGE(PG8_SA(1, 1), a1 + hstepA, voffA);
            PG8_WAIT_L(8); PG8_BAR; PG8_WAIT_L(0); PG8_MMA(0, 0, At, B0); PG8_BAR; PG8_SCHED;
            PG8_LDB(B1, 0, 1); PG8_STAGE(PG8_SB(0, 0), b2, voffB);
            PG8_BAR; PG8_WAIT_L(0); PG8_MMA(0, 1, At, B1); PG8_BAR;
            PG8_LDA(At, 0, 1); PG8_STAGE(PG8_SA(0, 0), a2, voffA);
            PG8_BAR; PG8_WAIT_L(0); PG8_MMA(1, 0, At, B0); PG8_BAR; PG8_SCHED;
            PG8_STAGE(PG8_SB(0, 1), b2 + hstepB, voffB);
            PG8_WAIT_V(6); PG8_BAR; PG8_MMA(1, 1, At, B1); PG8_BAR;
            PG8_LDB(B0, 1, 0); PG8_SCHED; PG8_LDA(At, 1, 0); PG8_STAGE(PG8_SA(0, 1), a2 + hstepA, voffA);
            PG8_WAIT_L(8); PG8_BAR; PG8_WAIT_L(0); PG8_MMA(0, 0, At, B0); PG8_BAR; PG8_SCHED;
            PG8_LDB(B1, 1, 1); PG8_STAGE(PG8_SB(1, 0), b3, voffB);
            PG8_BAR; PG8_WAIT_L(0); PG8_MMA(0, 1, At, B1); PG8_BAR;
            PG8_LDA(At, 1, 1); PG8_STAGE(PG8_SA(1, 0), a3, voffA);
            PG8_BAR; PG8_WAIT_L(0); PG8_MMA(1, 0, At, B0); PG8_BAR; PG8_SCHED;
            PG8_STAGE(PG8_SB(1, 1), b3 + hstepB, voffB);
            PG8_WAIT_V(6); PG8_BAR; PG8_MMA(1, 1, At, B1); PG8_BAR;
            }
        }
        if constexpr (ALIGN_EPI) { if (wr == 0) PG8_BAR; }
        if constexpr (!Epi::AFTER_DRAIN) { E(acc, cur, wr, wc, fr, fq); S.done(cur); }
        if (!has_next) break;
#pragma unroll
        for (int a = 0; a < 2; ++a)
#pragma unroll
            for (int b = 0; b < 2; ++b)
#pragma unroll
                for (int m = 0; m < 4; ++m)
#pragma unroll
                    for (int n = 0; n < 2; ++n) acc[a][b][m][n] = (f32x4){0.f, 0.f, 0.f, 0.f};
        cur = nxt; cA = nA; cB = nB; ++ui;
        if constexpr (ALIGN_EPI) { if (wr == 1) PG8_BAR; }
    }
    PG8_WAIT_V(0);
    if constexpr (!ALIGN_EPI) { if (wr == 0) PG8_BAR; }
    PG8_BAR;
    if constexpr (Epi::AFTER_DRAIN) { E.fused(acc, cur, wr, wc, fr, fq, lds, wid, lane); S.done(cur); }
#undef PG8_SA
#undef PG8_SB
#undef PG8_STAGE
#undef PG8_LDA
#undef PG8_LDB
#undef PG8_MMA
#undef PG8_WAIT_V
#undef PG8_WAIT_L
#undef PG8_BAR
#undef PG8_SCHED
}
}
namespace att {
typedef unsigned short bf16_t;
using bf16x8 = __attribute__((ext_vector_type(8))) short;
using s16x4  = __attribute__((ext_vector_type(4))) short;
using f32x16 = __attribute__((ext_vector_type(16))) float;
using u32x4  = __attribute__((ext_vector_type(4))) unsigned;
constexpr int DV = 128, NW = 8, QBLK = 32, KVBLK = 64;
constexpr float THR = 8.f;
constexpr int SHM_V = KVBLK * DV * 2;
template <int DQK> struct Cfg {
    static constexpr int SHM_K = KVBLK * DQK * 2, KROWB = DQK * 2, NCK = DQK / 64, C8 = DQK / 8, ND0 = DQK / 16;
    static constexpr float SCALE = (DQK == 128) ? 0.088388347648318440f : 0.072168783648703220f;
    static constexpr int LDS_BYTES = 2 * SHM_V + 2 * SHM_K + NW * 64 * 4;
};
#define ATT_SBAR() __builtin_amdgcn_sched_barrier(0)
__device__ __forceinline__ int crow(int r, int hi) { return (r & 3) + 8 * (r >> 2) + 4 * hi; }
__device__ __forceinline__ unsigned cvtpk(float lo, float hi) { unsigned r; asm volatile("v_cvt_pk_bf16_f32 %0, %1, %2" : "=v"(r) : "v"(lo), "v"(hi)); return r; }
template <int DQK> __device__ __forceinline__ int kswz(int row, int colB) {
    const int key = (DQK == 128) ? (row & 7) : ((row >> 1) & 7);
    return row * (DQK * 2) + (colB ^ (key << 4));
}
template <int DQK> __device__ __forceinline__ void partialSM(f32x16& p0, f32x16& p1, float& m_reg, float& mn, float& alpha) {
    constexpr float SCALE = Cfg<DQK>::SCALE, C = SCALE * 1.4426950408889634f;
    float pmax = p0[0];
#pragma unroll
    for (int r = 1; r < 16; ++r) pmax = fmaxf(pmax, p0[r]);
#pragma unroll
    for (int r = 0; r < 16; ++r) pmax = fmaxf(pmax, p1[r]);
    { auto rr = __builtin_amdgcn_permlane32_swap(__float_as_uint(pmax), __float_as_uint(pmax), false, false);
      pmax = fmaxf(__uint_as_float(rr[0]), __uint_as_float(rr[1])); }
    if (__builtin_expect(__all(pmax - m_reg <= THR / SCALE), 1)) { mn = m_reg; alpha = 1.f; }
    else { mn = fmaxf(m_reg, pmax); alpha = __builtin_amdgcn_exp2f((m_reg - mn) * C); m_reg = mn; }
    const float mnC = -mn * C;
#pragma unroll
    for (int r = 0; r < 16; ++r) p0[r] = fmaf(p0[r], C, mnC);
#pragma unroll
    for (int r = 0; r < 16; ++r) p1[r] = fmaf(p1[r], C, mnC);
#pragma unroll
    for (int r = 0; r < 16; ++r) p0[r] = __builtin_amdgcn_exp2f(p0[r]);
}
__device__ __forceinline__ void finishSM(f32x16& p0, f32x16& p1, float alpha, float& l_reg, bf16x8& pa0, bf16x8& pa1, bf16x8& pa2, bf16x8& pa3) {
#pragma unroll
    for (int r = 0; r < 16; ++r) p1[r] = __builtin_amdgcn_exp2f(p1[r]);
    float ps = 0;
#pragma unroll
    for (int r = 0; r < 16; ++r) ps += p0[r];
#pragma unroll
    for (int r = 0; r < 16; ++r) ps += p1[r];
    { auto rr = __builtin_amdgcn_permlane32_swap(__float_as_uint(ps), __float_as_uint(ps), false, false);
      ps = __uint_as_float(rr[0]) + __uint_as_float(rr[1]); }
    l_reg = l_reg * alpha + ps;
#define ATT_PK4(P, BASE, OUT) do { unsigned a0 = cvtpk(P[BASE + 0], P[BASE + 1]), a1 = cvtpk(P[BASE + 2], P[BASE + 3]);   \
    unsigned b0 = cvtpk(P[BASE + 4], P[BASE + 5]), b1 = cvtpk(P[BASE + 6], P[BASE + 7]);                              \
    auto r0 = __builtin_amdgcn_permlane32_swap(a0, b0, false, false); auto r1 = __builtin_amdgcn_permlane32_swap(a1, b1, false, false); \
    u32x4 w = {r0[0], r1[0], r0[1], r1[1]}; OUT = *reinterpret_cast<bf16x8*>(&w); } while (0)
    ATT_PK4(p0, 0, pa0); ATT_PK4(p0, 8, pa1); ATT_PK4(p1, 0, pa2); ATT_PK4(p1, 8, pa3);
#undef ATT_PK4
}
template <int DQK> __device__ __forceinline__ void qkt(f32x16& p0, f32x16& p1, const char* Ks, const bf16x8* qr, int r32, int hi) {
    p0 = f32x16{}; p1 = f32x16{};
#pragma unroll
    for (int d0 = 0; d0 < Cfg<DQK>::ND0; ++d0) { const int cb = (d0 * 16 + hi * 8) * 2;
        bf16x8 b0 = *reinterpret_cast<const bf16x8*>(Ks + kswz<DQK>(r32, cb));
        bf16x8 b1 = *reinterpret_cast<const bf16x8*>(Ks + kswz<DQK>(32 + r32, cb));
        p0 = __builtin_amdgcn_mfma_f32_32x32x16_bf16(b0, qr[d0], p0, 0, 0, 0);
        p1 = __builtin_amdgcn_mfma_f32_32x32x16_bf16(b1, qr[d0], p1, 0, 0, 0); }
}
__device__ __forceinline__ int v_st(int k, int c) { const int kk = (k & ~0xC) | ((k & 4) << 1) | ((k & 8) >> 1); return ((kk >> 3) * 4 + (c >> 5)) * 512 + ((kk & 7) * 32 + (c & 31)) * 2; }
__device__ __forceinline__ int v_rd_base(int lane) { return ((lane & 3) << 3) | (((lane >> 2) & 3) << 6) | (((lane >> 4) & 1) << 5) | (((lane >> 5) & 1) << 8); }
constexpr int v_rd_off(int d0, int ks, int half) { return d0 * 512 + ks * 4096 + half * 2048; }
template <int OFF> __device__ __forceinline__ s16x4 tr_read(int vb) {
    s16x4 r; asm volatile("ds_read_b64_tr_b16 %0, %1 offset:%2" : "=&v"(r) : "v"(vb), "i"(OFF) : "memory"); return r;
}
template <int D0> __device__ __forceinline__ void pv_one(f32x16& od, int vb, bf16x8 pa0, bf16x8 pa1, bf16x8 pa2, bf16x8 pa3) {
    const s16x4 l0 = tr_read<v_rd_off(D0, 0, 0)>(vb), h0 = tr_read<v_rd_off(D0, 0, 1)>(vb), l1 = tr_read<v_rd_off(D0, 1, 0)>(vb), h1 = tr_read<v_rd_off(D0, 1, 1)>(vb);
    const s16x4 l2 = tr_read<v_rd_off(D0, 2, 0)>(vb), h2 = tr_read<v_rd_off(D0, 2, 1)>(vb), l3 = tr_read<v_rd_off(D0, 3, 0)>(vb), h3 = tr_read<v_rd_off(D0, 3, 1)>(vb);
    asm volatile("s_waitcnt lgkmcnt(0)" ::: "memory"); ATT_SBAR();
#define ATT_PK(L, H) (bf16x8){L[0], L[1], L[2], L[3], H[0], H[1], H[2], H[3]}
    od = __builtin_amdgcn_mfma_f32_32x32x16_bf16(pa0, ATT_PK(l0, h0), od, 0, 0, 0);
    od = __builtin_amdgcn_mfma_f32_32x32x16_bf16(pa1, ATT_PK(l1, h1), od, 0, 0, 0);
    od = __builtin_amdgcn_mfma_f32_32x32x16_bf16(pa2, ATT_PK(l2, h2), od, 0, 0, 0);
    od = __builtin_amdgcn_mfma_f32_32x32x16_bf16(pa3, ATT_PK(l3, h3), od, 0, 0, 0);
#undef ATT_PK
}
__device__ __forceinline__ void pv_d0(f32x16* o, int vb, bf16x8 pa0, bf16x8 pa1, bf16x8 pa2, bf16x8 pa3) {
    pv_one<0>(o[0], vb, pa0, pa1, pa2, pa3); pv_one<1>(o[1], vb, pa0, pa1, pa2, pa3); pv_one<2>(o[2], vb, pa0, pa1, pa2, pa3); pv_one<3>(o[3], vb, pa0, pa1, pa2, pa3);
}
template <int DQK, int LDQ, int LDK, int LDV, int LDO, int SDEPTH>
__device__ __forceinline__ void attn_body(const bf16_t* __restrict__ Qb, const bf16_t* __restrict__ Kh, const bf16_t* __restrict__ Vh, bf16_t* __restrict__ Ob, int seq, char* lds, int tid_in) {
    using C_ = Cfg<DQK>;
    constexpr int SHM_K = C_::SHM_K, NCK = C_::NCK, C8 = C_::C8, ND0 = C_::ND0;
    int tid_ = tid_in; asm volatile("" : "+v"(tid_));
    const int tid = tid_, wid = tid >> 6, lane = tid & 63, r32 = lane & 31, hi = lane >> 5;
    char* V_lds = lds; char* K_lds = lds + 2 * SHM_V;
    float* ws = (float*)(lds + 2 * SHM_V + 2 * SHM_K) + wid * 64; float* li_l = ws; float* al_l = ws + 32;
    float m_reg = -1e30f, l_reg = 0; f32x16 o[4] = {}; bf16x8 qr[ND0];
    const bf16_t* Qw = Qb + (long)(wid * QBLK + r32) * LDQ + hi * 8;
#pragma unroll
    for (int d0 = 0; d0 < ND0; ++d0) qr[d0] = *reinterpret_cast<const bf16x8*>(Qw + d0 * 16);
    const int sr = tid >> 4, sc = (tid & 15) * 8, vst0 = v_st(sr, sc), vst1 = v_st(32 + sr, sc);
    int krow[NCK], kcol[NCK];
#pragma unroll
    for (int i = 0; i < NCK; ++i) { const int ci = tid + 512 * i; krow[i] = ci / C8; kcol[i] = (ci % C8) * 8; }
    const int vb0 = (int)(uintptr_t)V_lds + v_rd_base(lane);
    struct { bf16x8 vs0, vs1, ks[NCK]; } sr_[SDEPTH];
#define ATT_SLOAD(i, k0) do { sr_[i].vs0 = *reinterpret_cast<const bf16x8*>(&Vh[(long)((k0) + sr) * LDV + sc]); sr_[i].vs1 = *reinterpret_cast<const bf16x8*>(&Vh[(long)((k0) + 32 + sr) * LDV + sc]); \
    _Pragma("unroll") for (int c_ = 0; c_ < NCK; ++c_) sr_[i].ks[c_] = *reinterpret_cast<const bf16x8*>(&Kh[(long)((k0) + krow[c_]) * LDK + kcol[c_]]); } while (0)
#define ATT_SWRITE(b, i) do { *(bf16x8*)(V_lds + (b) * SHM_V + vst0) = sr_[i].vs0; *(bf16x8*)(V_lds + (b) * SHM_V + vst1) = sr_[i].vs1; \
    _Pragma("unroll") for (int c_ = 0; c_ < NCK; ++c_) *(bf16x8*)(K_lds + (b) * SHM_K + kswz<DQK>(krow[c_], kcol[c_] * 2)) = sr_[i].ks[c_]; } while (0)
#define ATT_SWAIT() do { if constexpr (SDEPTH == 2) { if constexpr (NCK == 2) asm volatile("s_waitcnt vmcnt(4)" ::: "memory"); else asm volatile("s_waitcnt vmcnt(5)" ::: "memory"); } else asm volatile("s_waitcnt vmcnt(0)" ::: "memory"); } while (0)
#define ATT_RESC(a) do { if (__any((a) < 1.f)) { if (hi == 0) al_l[r32] = (a); asm volatile("s_waitcnt lgkmcnt(0)" ::: "memory"); \
    _Pragma("unroll") for (int d = 0; d < 4; ++d) _Pragma("unroll") for (int r = 0; r < 16; ++r) o[d][r] *= al_l[crow(r, hi)]; } } while (0)
    f32x16 pA0, pA1, pB0, pB1; float mnA, mnB, alA, alB; bf16x8 pa0, pa1, pa2, pa3; const int NT = seq / KVBLK;
    constexpr int SE = 0, SO = SDEPTH - 1;
    ATT_SLOAD(SE, 0); asm volatile("s_waitcnt vmcnt(0)" ::: "memory"); ATT_SWRITE(0, SE); __syncthreads();
    qkt<DQK>(pA0, pA1, K_lds, qr, r32, hi); partialSM<DQK>(pA0, pA1, m_reg, mnA, alA);
    ATT_SLOAD(SO, KVBLK); if constexpr (SDEPTH == 2) { if (2 < NT) ATT_SLOAD(SE, 2 * KVBLK); }
    ATT_SWAIT(); ATT_SWRITE(1, SO); __syncthreads();
    for (int j = 1; j + 1 < NT; j += 2) {
        ATT_SBAR(); qkt<DQK>(pB0, pB1, K_lds + SHM_K, qr, r32, hi);
        finishSM(pA0, pA1, alA, l_reg, pa0, pa1, pa2, pa3); ATT_SBAR();
        ATT_SLOAD(SO, (j + SDEPTH) * KVBLK); ATT_SBAR();
        pv_d0(o, vb0, pa0, pa1, pa2, pa3); partialSM<DQK>(pB0, pB1, m_reg, mnB, alB);
        __syncthreads(); ATT_SWAIT(); ATT_SWRITE(0, SE);
        ATT_RESC(alB); __syncthreads();
        ATT_SBAR(); qkt<DQK>(pA0, pA1, K_lds, qr, r32, hi);
        finishSM(pB0, pB1, alB, l_reg, pa0, pa1, pa2, pa3); ATT_SBAR();
        if (SDEPTH == 1 || j + 3 < NT) ATT_SLOAD(SE, (j + 1 + SDEPTH) * KVBLK); ATT_SBAR();
        pv_d0(o, vb0 + (int)SHM_V, pa0, pa1, pa2, pa3); partialSM<DQK>(pA0, pA1, m_reg, mnA, alA);
        __syncthreads(); ATT_SWAIT(); ATT_SWRITE(1, SO);
        ATT_RESC(alA); __syncthreads();
    }
    ATT_SBAR(); qkt<DQK>(pB0, pB1, K_lds + SHM_K, qr, r32, hi);
    finishSM(pA0, pA1, alA, l_reg, pa0, pa1, pa2, pa3); ATT_SBAR();
    pv_d0(o, vb0, pa0, pa1, pa2, pa3); partialSM<DQK>(pB0, pB1, m_reg, mnB, alB);
    __syncthreads(); ATT_RESC(alB);
    finishSM(pB0, pB1, alB, l_reg, pa0, pa1, pa2, pa3); ATT_SBAR();
    pv_d0(o, vb0 + (int)SHM_V, pa0, pa1, pa2, pa3);
    if (hi == 0) li_l[r32] = l_reg;
    asm volatile("s_waitcnt lgkmcnt(0)" ::: "memory");
    __syncthreads();
    float rli[16];
#pragma unroll
    for (int r = 0; r < 16; ++r) rli[r] = __builtin_amdgcn_rcpf(li_l[crow(r, hi)]);
    unsigned short* stg = (unsigned short*)(lds + wid * 8192);
#pragma unroll
    for (int r = 0; r < 16; ++r) { const int orow = crow(r, hi);
#pragma unroll
        for (int d0 = 0; d0 < 4; ++d0) { const unsigned w = cvtpk(o[d0][r] * rli[r], 0.f); stg[orow * 128 + d0 * 32 + r32] = (unsigned short)(w & 0xffffu); } }
    asm volatile("s_waitcnt lgkmcnt(0)" ::: "memory");
    bf16_t* Ow = Ob + (long)(wid * QBLK) * LDO;
#pragma unroll
    for (int i = 0; i < 8; ++i) { const int id = lane + 64 * i, row = id >> 4, c16 = id & 15;
        const u32x4 v = *(const u32x4*)((const char*)stg + row * 256 + c16 * 16);
        *(u32x4*)(Ow + (long)row * LDO + c16 * 8) = v; }
    asm volatile("s_waitcnt lgkmcnt(0)" ::: "memory");
    __syncthreads();
#undef ATT_SLOAD
#undef ATT_SWRITE
#undef ATT_SWAIT
#undef ATT_RESC
}

template <int DQK, int LDQ, int LDK, int LDV, int LDO>
__device__ __forceinline__ void attn_body1(const bf16_t* __restrict__ Qb, const bf16_t* __restrict__ Kh, const bf16_t* __restrict__ Vh, bf16_t* __restrict__ Ob, int seq, char* lds, int tid_in) {
    using C_ = Cfg<DQK>;
    constexpr int SHM_K = C_::SHM_K, NCK = C_::NCK, C8 = C_::C8, ND0 = C_::ND0;
    int tid_ = tid_in; asm volatile("" : "+v"(tid_));
    const int tid = tid_, wid = tid >> 6, lane = tid & 63, r32 = lane & 31, hi = lane >> 5;
    char* V_lds = lds; char* K_lds = lds + 2 * SHM_V;
    float* ws = (float*)(lds + 2 * SHM_V + 2 * SHM_K) + wid * 64; float* li_l = ws; float* al_l = ws + 32;
    float m_reg = -1e30f, l_reg = 0; f32x16 o[4] = {}; bf16x8 qr[ND0];
    const bf16_t* Qw = Qb + (long)(wid * QBLK + r32) * LDQ + hi * 8;
#pragma unroll
    for (int d0 = 0; d0 < ND0; ++d0) qr[d0] = *reinterpret_cast<const bf16x8*>(Qw + d0 * 16);
    const int sr = tid >> 4, sc = (tid & 15) * 8, vst0 = v_st(sr, sc), vst1 = v_st(32 + sr, sc);
    int krow[NCK], kcol[NCK];
#pragma unroll
    for (int i = 0; i < NCK; ++i) { const int ci = tid + 512 * i; krow[i] = ci / C8; kcol[i] = (ci % C8) * 8; }
    const int vb0 = (int)(uintptr_t)V_lds + v_rd_base(lane);
    bf16x8 vs0, vs1, ks[NCK];
#define ATT1_SLOAD(k0) do { vs0 = *reinterpret_cast<const bf16x8*>(&Vh[(long)((k0) + sr) * LDV + sc]); vs1 = *reinterpret_cast<const bf16x8*>(&Vh[(long)((k0) + 32 + sr) * LDV + sc]); \
    _Pragma("unroll") for (int c_ = 0; c_ < NCK; ++c_) ks[c_] = *reinterpret_cast<const bf16x8*>(&Kh[(long)((k0) + krow[c_]) * LDK + kcol[c_]]); } while (0)
#define ATT1_SWRITE(b) do { *(bf16x8*)(V_lds + (b) * SHM_V + vst0) = vs0; *(bf16x8*)(V_lds + (b) * SHM_V + vst1) = vs1; \
    _Pragma("unroll") for (int c_ = 0; c_ < NCK; ++c_) *(bf16x8*)(K_lds + (b) * SHM_K + kswz<DQK>(krow[c_], kcol[c_] * 2)) = ks[c_]; } while (0)
    const int NT = seq / KVBLK;
    ATT1_SLOAD(0); asm volatile("s_waitcnt vmcnt(0)" ::: "memory"); ATT1_SWRITE(0); __syncthreads();
    for (int j = 0; j < NT; ++j) {
        const int b = j & 1;
        if (j + 1 < NT) ATT1_SLOAD((j + 1) * KVBLK);
        ATT_SBAR();
        f32x16 p0, p1; float mn, alpha; bf16x8 pa0, pa1, pa2, pa3;
        qkt<DQK>(p0, p1, K_lds + b * SHM_K, qr, r32, hi);
        partialSM<DQK>(p0, p1, m_reg, mn, alpha);
        if (__any(alpha < 1.f)) { if (hi == 0) al_l[r32] = alpha; asm volatile("s_waitcnt lgkmcnt(0)" ::: "memory");
#pragma unroll
            for (int d = 0; d < 4; ++d)
#pragma unroll
                for (int r = 0; r < 16; ++r) o[d][r] *= al_l[crow(r, hi)]; }
        finishSM(p0, p1, alpha, l_reg, pa0, pa1, pa2, pa3); ATT_SBAR();
        pv_d0(o, vb0 + b * (int)SHM_V, pa0, pa1, pa2, pa3);
        if (j + 1 < NT) { ATT1_SWRITE(b ^ 1); }
        __syncthreads();
    }
    if (hi == 0) li_l[r32] = l_reg;
    asm volatile("s_waitcnt lgkmcnt(0)" ::: "memory");
    __syncthreads();
    float rli[16];
#pragma unroll
    for (int r = 0; r < 16; ++r) rli[r] = __builtin_amdgcn_rcpf(li_l[crow(r, hi)]);
    unsigned short* stg = (unsigned short*)(lds + wid * 8192);
#pragma unroll
    for (int r = 0; r < 16; ++r) { const int orow = crow(r, hi);
#pragma unroll
        for (int d0 = 0; d0 < 4; ++d0) { const unsigned w = cvtpk(o[d0][r] * rli[r], 0.f); stg[orow * 128 + d0 * 32 + r32] = (unsigned short)(w & 0xffffu); } }
    asm volatile("s_waitcnt lgkmcnt(0)" ::: "memory");
    bf16_t* Ow = Ob + (long)(wid * QBLK) * LDO;
#pragma unroll
    for (int i = 0; i < 8; ++i) { const int id = lane + 64 * i, row = id >> 4, c16 = id & 15;
        const u32x4 v = *(const u32x4*)((const char*)stg + row * 256 + c16 * 16);
        *(u32x4*)(Ow + (long)row * LDO + c16 * 8) = v; }
    asm volatile("s_waitcnt lgkmcnt(0)" ::: "memory");
    __syncthreads();
#undef ATT1_SLOAD
#undef ATT1_SWRITE
}
}
constexpr int DM = 2048, NBATCH = 2, SEQ = 4096, CTX = 256, RB = SEQ + CTX  , MROWS = NBATCH * RB  ;
constexpr int NMOD = 6 * DM, NEXP = 16384;
constexpr float EPS = 1e-6f;
constexpr int NWAVES = 8, NTHREADS = 512;
constexpr size_t MiB = 1u << 20;
constexpr size_t WS_CTL = 0, CTL_ZERO_BYTES = 64 * 1024;
constexpr size_t WS_MOD = 1 * MiB;
constexpr size_t WS_ROPE = 2 * MiB;
constexpr size_t WS_SMALL = 3 * MiB;
constexpr int SM_N1G = 0, SM_N2G = 8192, SM_AQG = 16384, SM_AKG = 16384 + 384, SM_CW = 16384 + 768, SM_CB = SM_CW + 6144, SM_CQG = SM_CB + 2048, SM_CKG = SM_CQG + 256, SM_END = SM_CKG + 256;
constexpr size_t WS_PTRS = 3 * MiB + 512 * 1024;
constexpr size_t WS_XW = 4 * MiB;
constexpr size_t WS_H = 72 * MiB;
constexpr size_t WS_P = 106 * MiB;
constexpr size_t WS_QRAW = 174 * MiB;
constexpr size_t WS_KVRAW = 200 * MiB;
constexpr size_t WS_Q = 234 * MiB;
constexpr size_t WS_K = 268 * MiB;
constexpr size_t WS_V = 294 * MiB;
constexpr size_t WS_CAT = 311 * MiB;
constexpr size_t WS_PQ = 345 * MiB;
constexpr size_t WS_IDX = 379 * MiB;
constexpr size_t WS_GATE = 384 * MiB;
constexpr size_t WS_WIN = 389 * MiB;
constexpr size_t WS_WUQ = 421 * MiB;
constexpr size_t WS_WUKV = 424 * MiB;
constexpr size_t WS_WEO = 426 * MiB;
constexpr size_t WS_WQKV = 442 * MiB;
constexpr size_t WS_WCO = 466 * MiB;
constexpr size_t WS_WPQ = 482 * MiB;
constexpr size_t WS_SUBK = 514 * MiB;
#ifndef TAB_FP4
#define TAB_FP4 1
#endif
#if TAB_FP4
constexpr int ROWB = 1024;
#else
constexpr int ROWB = 1536;
#endif
constexpr size_t WS_U = 516 * MiB;
constexpr size_t WS_VT = 644 * MiB;
constexpr size_t WS_USC = 772 * MiB;
constexpr size_t WS_VSC = 773 * MiB;
constexpr size_t WS_XQ = 810 * MiB;
constexpr size_t WS_XS = 828 * MiB;
constexpr size_t WS_PART = 774 * MiB;
constexpr size_t WS_END = 834 * MiB;
#ifndef EXP_SLICED
#define EXP_SLICED 1
#endif
constexpr int CW_BAR = 4096;
constexpr int LDS_MISC = 131072 + 8192;
constexpr int LDS_BYTES = 147456;

#define LAS __attribute__((address_space(3)))
typedef unsigned short bf16_t;
typedef float f32x4 __attribute__((ext_vector_type(4)));
typedef unsigned u32x4 __attribute__((ext_vector_type(4)));
typedef unsigned u32x2 __attribute__((ext_vector_type(2)));
typedef short bf16x8 __attribute__((ext_vector_type(8)));
typedef float f32x16 __attribute__((ext_vector_type(16)));
typedef __bf16 bf16x2_t __attribute__((ext_vector_type(2)));
typedef float f32x2 __attribute__((ext_vector_type(2)));
typedef _Float16 h2_t __attribute__((ext_vector_type(2)));
typedef float f32x32 __attribute__((ext_vector_type(32)));
typedef unsigned u32x6 __attribute__((ext_vector_type(6)));

__device__ __forceinline__ unsigned f2bf(float f) { unsigned u = __builtin_bit_cast(unsigned, f); return (u + 0x7fffu + ((u >> 16) & 1u)) >> 16; }
__device__ __forceinline__ unsigned pk2(float lo, float hi) { return f2bf(lo) | (f2bf(hi) << 16); }
__device__ __forceinline__ float bf_lo(unsigned w) { return __builtin_bit_cast(float, w << 16); }
__device__ __forceinline__ float bf_hi(unsigned w) { return __builtin_bit_cast(float, w & 0xffff0000u); }
__device__ __forceinline__ float bf2f(bf16_t h) { return __builtin_bit_cast(float, (unsigned)h << 16); }
__device__ __forceinline__ float wave_sum(float v) {
#pragma unroll
    for (int o = 1; o < 64; o <<= 1) v += __shfl_xor(v, o);
    return v;
}
#define DPP_ADD(v, ctrl) ((v) + __builtin_bit_cast(float, __builtin_amdgcn_update_dpp(0, __builtin_bit_cast(int, (v)), (ctrl), 0xf, 0xf, true)))
__device__ __forceinline__ float wave_sum_dpp(float v) {
    v = DPP_ADD(v, 0xB1);
    v = DPP_ADD(v, 0x4E);
    v = DPP_ADD(v, 0x141);
    v = DPP_ADD(v, 0x140);
    const int vi = __builtin_bit_cast(int, v);
    const float s0 = __builtin_bit_cast(float, __builtin_amdgcn_readlane(vi, 0)), s1 = __builtin_bit_cast(float, __builtin_amdgcn_readlane(vi, 16));
    const float s2 = __builtin_bit_cast(float, __builtin_amdgcn_readlane(vi, 32)), s3 = __builtin_bit_cast(float, __builtin_amdgcn_readlane(vi, 48));
    return (s0 + s1) + (s2 + s3);
}
__device__ __forceinline__ float dot2_bf16(unsigned w, unsigned x, float acc) { return __builtin_amdgcn_fdot2_f32_bf16(__builtin_bit_cast(bf16x2_t, w), __builtin_bit_cast(bf16x2_t, x), acc, false); }
__device__ __forceinline__ float gelu_erf(float v) {
    const float av = fabsf(v), t = __builtin_amdgcn_rcpf(av * 0.2316418882f + 1.0f);
    float q = t * 0.5307027145f + (-0.7265760135f); q = q * t + 0.7107068705f; q = q * t + (-0.142248368f); q = q * t + 0.127414796f; q = q * t;
    const float e = __builtin_amdgcn_exp2f((v * v) * (-0.72134752044f));
    const float m = v * (q * e);
    return v < 0.f ? m : v - m;
}
#define XB_TMO      128
#define XB_XCNT(j)  (256  + 64 * (j))
#define XB_XSUB(j)  (1280 + 64 * (j))
#define XB_XGEN(j)  (2304 + 64 * (j))
#define XB_TOP      3328
#define XB_TOPGEN   3392
#define XCD_BAR_WORDS 3456
#define XB_SPIN_CAP (1u << 18)

__device__ __forceinline__ unsigned xb_ld(unsigned* p)              { return __hip_atomic_load(p, __ATOMIC_RELAXED, __HIP_MEMORY_SCOPE_AGENT); }
__device__ __forceinline__ unsigned xb_add(unsigned* p, unsigned v) { return __hip_atomic_fetch_add(p, v, __ATOMIC_RELAXED, __HIP_MEMORY_SCOPE_AGENT); }
__device__ __forceinline__ unsigned xb_xcc_id() { return (unsigned)__builtin_amdgcn_s_getreg((3 << 11) | 20) & 0xFu; }
#define XB_SPIN(cond, bar) do { unsigned _sp = 0; while (cond) { __builtin_amdgcn_s_sleep(1); \
    if ((++_sp & 255u) == 0u) { if (xb_ld(&(bar)[XB_TMO])) break; if (_sp > XB_SPIN_CAP) { atomicAdd(&(bar)[XB_TMO], 1u); break; } } } } while (0)

struct XcdBarrier {
    unsigned* bar; unsigned x;
    volatile LAS unsigned* st;
};

__device__ __forceinline__ XcdBarrier xcd_barrier_post(unsigned* bar, volatile LAS unsigned* st) {
    XcdBarrier b; b.bar = bar; b.x = xb_xcc_id(); b.st = st;
    if (threadIdx.x == 0) (void)xb_add(&bar[XB_XCNT(b.x)], 1u);
    return b;
}
__device__ __forceinline__ void xcd_barrier_complete(unsigned* bar, unsigned x, unsigned& nloc, unsigned& nx) {
    const unsigned G = gridDim.x * gridDim.y * gridDim.z;
    unsigned sum, cnt, mine, sp = 0u;
    for (;;) {
        sum = 0u; cnt = 0u; mine = 0u;
#pragma unroll
        for (unsigned j = 0; j < 16; ++j) { const unsigned c = xb_ld(&bar[XB_XCNT(j)]); sum += c; cnt += (c > 0u) ? 1u : 0u; mine = (j == x) ? c : mine; }
        if (sum == G) break;
        __builtin_amdgcn_s_sleep(1);
        if ((++sp & 255u) == 0u) { if (xb_ld(&bar[XB_TMO])) break; if (sp > XB_SPIN_CAP) { atomicAdd(&bar[XB_TMO], 1u); break; } }
    }
    nloc = mine > 0u ? mine : 1u; nx = cnt > 0u ? cnt : 1u;
}

__device__ __forceinline__ void xcd_barrier(const XcdBarrier& b) {
    asm volatile("s_waitcnt vmcnt(0)" ::: "memory");
    __syncthreads();
    if (threadIdx.x == 0) {
        unsigned* bar = b.bar; unsigned bx = b.x;
        asm volatile("" : "+s"(bar), "+s"(bx));
        __builtin_amdgcn_s_waitcnt(0);
        unsigned nloc = b.st[0], nx = b.st[1];
        if (nloc == 0u) { xcd_barrier_complete(bar, bx, nloc, nx); b.st[0] = nloc; b.st[1] = nx; }
        const unsigned old = xb_add(&bar[XB_XSUB(bx)], 1u);
        const unsigned gen = old / nloc;
        if (old + 1u == (gen + 1u) * nloc) {
            __builtin_amdgcn_fence(__ATOMIC_RELEASE, "agent");
            asm volatile("s_waitcnt vmcnt(0)" ::: "memory");
            const unsigned og = xb_add(&bar[XB_TOP], 1u);
            const unsigned tg = og / nx;
            if (og + 1u == (tg + 1u) * nx) xb_add(&bar[XB_TOPGEN], 1u);
            else XB_SPIN(xb_ld(&bar[XB_TOPGEN]) == tg, bar);
            __builtin_amdgcn_fence(__ATOMIC_ACQUIRE, "agent");
            xb_add(&bar[XB_XGEN(bx)], 1u);
            asm volatile("s_waitcnt vmcnt(0)" ::: "memory");
        } else {
            XB_SPIN(xb_ld(&bar[XB_XGEN(bx)]) == gen, bar);
            __builtin_amdgcn_fence(__ATOMIC_ACQUIRE, "agent");
            asm volatile("s_waitcnt vmcnt(0)" ::: "memory");
        }
    }
    __syncthreads();
}
struct Frame {
    LAS unsigned char* lds;
    int tid, lane, wave, vcu, G, gw, NGW;
    unsigned char* ws;
};
__device__ __forceinline__ int opaque_v(int v) { asm volatile("" : "+v"(v)); return v; }
__device__ __forceinline__ int phase_tid(int wave) { int lane; asm volatile("v_mbcnt_lo_u32_b32 %0, -1, 0\n\tv_mbcnt_hi_u32_b32 %0, -1, %0" : "=v"(lane)); return wave * 64 + lane; }
__device__ __forceinline__ Frame phase_frame(const Frame& F0) { Frame F = F0; F.tid = phase_tid(F0.wave); F.lane = F.tid & 63; return F; }
__device__ __forceinline__ float swap32(float v, int lane) { auto rr = __builtin_amdgcn_permlane32_swap(__float_as_uint(v), __float_as_uint(v), false, false); return __uint_as_float(lane < 32 ? rr[1] : rr[0]); }
__device__ __forceinline__ int row_cls(int row) { const int b = row / RB, i = row - b * RB; return i < CTX ? 2 : b; }

__device__ __forceinline__ void p0_transpose_item(const float* W, int K, int N, bf16_t* WT, const float* gain, LAS float* scr, int item, int lane, bool perm_q = false) {
    const int nblk = N / 32, kb = item / nblk, nb = item % nblk, k0 = 64 * kb, n0 = 32 * nb;
    {
        const int rgp = lane >> 3, c4 = (lane & 7) * 4; f32x4 tv[8];
#pragma unroll
        for (int i = 0; i < 8; ++i) tv[i] = *(const f32x4*)(W + (size_t)(k0 + 8 * i + rgp) * N + n0 + c4);
#pragma unroll
        for (int i = 0; i < 8; ++i) { const int kk = 8 * i + rgp; f32x4 v = tv[i]; if (gain) v = v * gain[k0 + kk];
            LAS float* d = scr + kk * 33 + c4; d[0] = v.x; d[1] = v.y; d[2] = v.z; d[3] = v.w; }
    }
    asm volatile("s_waitcnt lgkmcnt(0)" ::: "memory");
    const int c = lane & 7;
#pragma unroll
    for (int j = 0; j < 4; ++j) { const int n = (lane >> 3) + 8 * j; const LAS float* s = scr + (8 * c) * 33 + n;
        u32x4 o; o.x = pk2(s[0 * 33], s[1 * 33]); o.y = pk2(s[2 * 33], s[3 * 33]); o.z = pk2(s[4 * 33], s[5 * 33]); o.w = pk2(s[6 * 33], s[7 * 33]);
        int nn = n0 + n; if (perm_q) { const int hh = nn / 192, e = nn - hh * 192; nn = (e < 128) ? hh * 128 + e : 1024 + hh * 64 + (e - 128); }
        *(u32x4*)(WT + (size_t)nn * K + k0 + 8 * c) = o; }
    asm volatile("s_waitcnt lgkmcnt(0)" ::: "memory");
}
struct TrDesc { const float* W; const float* gain; bf16_t* WT; int K, N, items; };

__device__ __forceinline__ void p0_gemv_task(Frame& F, int task, const float* ada_w, const float* ada_b, float* mod) {
    LAS float* sv = (LAS float*)F.lds; LAS float* part = (LAS float*)(F.lds + 32768);
    const int l = task / 192, n0 = (task % 192) * 64, rg = F.lane >> 4, c4 = (F.lane & 15) * 4;
    const float* Wp = ada_w + (size_t)l * DM * NMOD + n0 + c4 + (size_t)(F.wave * 256 + rg) * NMOD;
    f32x4 a0 = {0, 0, 0, 0}, a1 = a0, a2 = a0;
    for (int k = 0; k < 256; k += 32) {
        f32x4 w[8];
#pragma unroll
        for (int u = 0; u < 8; ++u) w[u] = *(const f32x4*)(Wp + (size_t)(k + 4 * u) * NMOD);
#pragma unroll
        for (int u = 0; u < 8; ++u) { const int kk = F.wave * 256 + k + 4 * u + rg; const float s0 = sv[kk], s1 = sv[2048 + kk], s2 = sv[4096 + kk];
            a0 += w[u] * s0; a1 += w[u] * s1; a2 += w[u] * s2; }
    }
    LAS float* pp = part + ((F.wave * 4 + rg) * 3) * 64 + c4;
    *(LAS f32x4*)(pp) = a0; *(LAS f32x4*)(pp + 64) = a1; *(LAS f32x4*)(pp + 128) = a2;
    __syncthreads();
    if (F.tid < 192) { const int r = F.tid >> 6, c = F.tid & 63; float s = 0.f;
#pragma unroll
        for (int q = 0; q < 32; ++q) s += part[(q * 3 + r) * 64 + c];
        mod[(size_t)(l * 3 + r) * NMOD + n0 + c] = s + ada_b[(size_t)l * NMOD + n0 + c]; }
    __syncthreads();
}

__device__ __forceinline__ void p0_prologue(Frame& F, const float* const* in) {
    unsigned char* ws = F.ws;
    {
        LAS float* sv = (LAS float*)F.lds;
        for (int i = F.tid; i < 3 * DM; i += NTHREADS) { const int r = i / DM, k = i - r * DM; const float x = (r < 2) ? in[1][r * DM + k] : in[3][k]; sv[i] = x / (1.f + __expf(-x)); }
        __syncthreads();
        for (int task = F.vcu; task < 768; task += F.G) p0_gemv_task(F, task, in[4], in[5], (float*)(ws + WS_MOD));
        __syncthreads();
    }
    {
        float* xw = (float*)(ws + WS_XW);
        for (int row = F.gw; row < MROWS; row += F.NGW) { const int b = row / RB, i = row - b * RB;
            const float* src = (i < CTX) ? in[2] + (size_t)(b * CTX + i) * DM : in[0] + (size_t)(b * SEQ + i - CTX) * DM;
            const f32x4* s4 = (const f32x4*)src + F.lane; f32x4* d4 = (f32x4*)(xw + (size_t)row * DM) + F.lane;
#pragma unroll
            for (int j = 0; j < 8; ++j) d4[64 * j] = s4[64 * j]; }
    }
    {
        float* sm = (float*)(ws + WS_SMALL); const int g = F.vcu * NTHREADS + F.tid;
        if (g < 8192) { sm[SM_N1G + g] = in[6][g]; sm[SM_N2G + g] = in[7][g]; }
        if (g < 384) { sm[SM_AQG + g] = in[13][g]; sm[SM_AKG + g] = in[14][g]; }
        if (g < 6144) sm[SM_CW + g] = in[15][g];
        if (g < 2048) sm[SM_CB + g] = in[16][g];
        if (g < 256) { sm[SM_CQG + g] = in[19][g]; sm[SM_CKG + g] = in[20][g]; }
    }
    {
        float* rc = (float*)(ws + WS_ROPE); float* ra = rc + 64 * 32 * 2;
        const int g = F.vcu * NTHREADS + F.tid;
        if (g < 64 * 32) { const int pos = g >> 5, f = g & 31; const float fr = exp2f(-(float)f * (13.287712379549449f / 32.f)); const float ang = (float)pos * fr;
            rc[2 * g] = cosf(ang); rc[2 * g + 1] = sinf(ang); }
        else if (g < 64 * 32 + 64 * 16) { const int e = g - 64 * 32, pos = e >> 4, f = e & 15; const float fr = exp2f(-(float)f * (13.287712379549449f / 16.f)); const float ang = (float)pos * fr;
            ra[2 * e] = cosf(ang); ra[2 * e + 1] = sinf(ang); }
    }
    {
        LAS float* scr = (LAS float*)(F.lds + F.wave * 16384);
        TrDesc d[16]; int nd = 0;
#pragma unroll
        for (int i = 0; i < 2; ++i) {
            d[nd++] = TrDesc{in[8] + (size_t)i * DM * 3904, nullptr, (bf16_t*)(ws + WS_WIN) + (size_t)i * 4096 * DM, DM, 3904, 32 * 122};
            d[nd++] = TrDesc{in[11] + (size_t)i * 512 * 1536, in[9] + i * 512, (bf16_t*)(ws + WS_WUQ) + (size_t)i * 1536 * 512, 512, 1536, 8 * 48};
            d[nd++] = TrDesc{in[12] + (size_t)i * 256 * 2048, in[10] + i * 256, (bf16_t*)(ws + WS_WUKV) + (size_t)i * 2048 * 256, 256, 2048, 4 * 64};
            d[nd++] = TrDesc{in[17] + (size_t)i * DM * DM, nullptr, (bf16_t*)(ws + WS_WEO) + (size_t)i * DM * DM, DM, DM, 32 * 64};
            d[nd++] = TrDesc{in[18] + (size_t)i * DM * 3072, nullptr, (bf16_t*)(ws + WS_WQKV) + (size_t)i * 3072 * DM, DM, 3072, 32 * 96};
            d[nd++] = TrDesc{in[21] + (size_t)i * DM * DM, nullptr, (bf16_t*)(ws + WS_WCO) + (size_t)i * DM * DM, DM, DM, 32 * 64};
        }
#pragma unroll
        for (int l = 0; l < 4; ++l) d[nd++] = TrDesc{in[22] + (size_t)l * DM * DM, nullptr, (bf16_t*)(ws + WS_WPQ) + (size_t)l * DM * DM, DM, DM, 32 * 64};
#pragma unroll
        for (int m = 0; m < 16; ++m) {
            for (int it = F.gw; it < d[m].items; it += F.NGW) p0_transpose_item(d[m].W, d[m].K, d[m].N, d[m].WT, d[m].gain, scr, it, F.lane, d[m].K == 512);
        }
        for (int i = F.gw * 64 + F.lane; i < 2 * 192 * DM / 8; i += F.NGW * 64) { const int li = i / (192 * DM / 8), r = i % (192 * DM / 8);
            *(u32x4*)((bf16_t*)(ws + WS_WIN) + (size_t)li * 4096 * DM + (size_t)3904 * DM + (size_t)r * 8) = (u32x4){0u, 0u, 0u, 0u}; }
    }
    {
        const size_t n_sk = (size_t)4 * 16 * 128 * 128 / 8;
        const size_t gt = (size_t)F.vcu * NTHREADS + F.tid, GT = (size_t)F.G * NTHREADS;
        for (size_t j = gt; j < n_sk; j += GT) {
            const f32x4 a = *(const f32x4*)(in[23] + j * 8), b = *(const f32x4*)(in[23] + j * 8 + 4);
            u32x4 o; o.x = pk2(a.x, a.y); o.y = pk2(a.z, a.w); o.z = pk2(b.x, b.y); o.w = pk2(b.z, b.w);
            *(u32x4*)((bf16_t*)(ws + WS_SUBK) + j * 8) = o;
        }
    }
    {
        for (int r = F.gw; r < 2 * 4 * NEXP; r += F.NGW) {
            const int tab = r / (4 * NEXP), rr = r - tab * (4 * NEXP);
#if EXP_SLICED
            const float* src = (tab ? in[25] : in[24]) + (size_t)rr * DM + F.lane * 32;
            f32x4 v[8];
#pragma unroll
            for (int q = 0; q < 8; ++q) v[q] = *(const f32x4*)(src + q * 4);
#else
            const float* src = (tab ? in[25] : in[24]) + (size_t)rr * DM + F.lane * 16;
            f32x4 v[8];
#pragma unroll
            for (int j = 0; j < 2; ++j)
#pragma unroll
                for (int q = 0; q < 4; ++q) v[j * 4 + q] = *(const f32x4*)(src + j * 1024 + q * 4);
#endif
            float am = 0.f;
#pragma unroll
            for (int q = 0; q < 8; ++q) am = fmaxf(fmaxf(am, fmaxf(fabsf(v[q].x), fabsf(v[q].y))), fmaxf(fabsf(v[q].z), fabsf(v[q].w)));
#pragma unroll
            for (int o = 1; o < 64; o <<= 1) am = fmaxf(am, __shfl_xor(am, o));
            am = fmaxf(am, 1e-30f);
#if TAB_FP4
            float ssq = 0.f;
#pragma unroll
            for (int q = 0; q < 8; ++q) ssq += (v[q].x * v[q].x + v[q].y * v[q].y) + (v[q].z * v[q].z + v[q].w * v[q].w);
#pragma unroll
            for (int o = 1; o < 64; o <<= 1) ssq += __shfl_xor(ssq, o);
            const float sig = fmaxf(sqrtf(ssq * (1.f / DM)), am * (1.f / 64.f));
            unsigned w4[4];
#if EXP_SLICED
            if (tab == 0) {
                const float delta = 0.3352f * sig, isc = 1.0f / delta;
#pragma unroll
                for (int q = 0; q < 4; ++q) { unsigned t = 0u;
#pragma unroll
                    for (int hh = 0; hh < 2; ++hh) { const f32x4 x = v[2 * q + hh] * isc;
                        const int n0 = min(max((int)floorf(x.x), -8), 7) & 15, n1 = min(max((int)floorf(x.y), -8), 7) & 15, n2 = min(max((int)floorf(x.z), -8), 7) & 15, n3 = min(max((int)floorf(x.w), -8), 7) & 15;
                        t |= ((unsigned)n0 | ((unsigned)n1 << 4) | ((unsigned)n2 << 8) | ((unsigned)n3 << 12)) << (16 * hh); }
                    w4[q] = t; }
                { const int ll = rr / NEXP, ee = rr - ll * NEXP;
                  *(u32x4*)(ws + WS_U + (size_t)ll * NEXP * ROWB + (size_t)(F.lane >> 3) * (NEXP * 128) + (size_t)ee * 128 + (F.lane & 7) * 16) = (u32x4){w4[0], w4[1], w4[2], w4[3]}; }
                if (F.lane == 0) ((float*)(ws + WS_USC))[rr] = delta;
                continue;
            }
#endif
            const float sc = 2.0f / sig;
#pragma unroll
            for (int q = 0; q < 4; ++q) { unsigned t = 0u;
                const f32x4 xa = v[2 * q] * sc, xb = v[2 * q + 1] * sc;
#define P0_C6(x) fminf(fmaxf((x), -6.f), 6.f)
                t = __builtin_amdgcn_cvt_scalef32_pk_fp4_f32(t, P0_C6(xa.x), P0_C6(xa.y), 1.0f, 0);
                t = __builtin_amdgcn_cvt_scalef32_pk_fp4_f32(t, P0_C6(xa.z), P0_C6(xa.w), 1.0f, 1);
                t = __builtin_amdgcn_cvt_scalef32_pk_fp4_f32(t, P0_C6(xb.x), P0_C6(xb.y), 1.0f, 2);
                t = __builtin_amdgcn_cvt_scalef32_pk_fp4_f32(t, P0_C6(xb.z), P0_C6(xb.w), 1.0f, 3);
#undef P0_C6
                w4[q] = t; }
#if EXP_SLICED
            { const int ll = rr / NEXP, ee = rr - ll * NEXP;
              *(u32x4*)(ws + (tab ? WS_VT : WS_U) + (size_t)ll * NEXP * ROWB + (size_t)(F.lane >> 3) * (NEXP * 128) + (size_t)ee * 128 + (F.lane & 7) * 16) = (u32x4){w4[0], w4[1], w4[2], w4[3]}; }
#else
            *(u32x4*)(ws + (tab ? WS_VT : WS_U) + (size_t)rr * ROWB + F.lane * 16) = (u32x4){w4[0], w4[1], w4[2], w4[3]};
#endif
            if (F.lane == 0) ((float*)(ws + (tab ? WS_VSC : WS_USC)))[rr] = sig * 0.5f;
#else
            const float sc = 7.5f / am;
            f32x16 a, b;
#pragma unroll
            for (int q = 0; q < 8; ++q) { const f32x4 x = v[q] * sc; a[2 * q] = x.x; b[2 * q] = x.y; a[2 * q + 1] = x.z; b[2 * q + 1] = x.w; }
            const u32x6 w = __builtin_amdgcn_cvt_scalef32_2xpk16_fp6_f32(a, b, 1.0f);
            unsigned char* dst = ws + (tab ? WS_VT : WS_U) + (size_t)rr * ROWB;
            *(u32x4*)(dst + F.lane * 16) = (u32x4){w[0], w[1], w[2], w[3]};
            *(u32x2*)(dst + 1024 + F.lane * 8) = (u32x2){w[4], w[5]};
            if (F.lane == 0) ((float*)(ws + (tab ? WS_VSC : WS_USC)))[rr] = am * (1.0f / 7.5f);
#endif
        }
    }
}

#define DPP_MOV(v, ctrl) __builtin_bit_cast(float, __builtin_amdgcn_update_dpp(0, __builtin_bit_cast(int, (v)), (ctrl), 0xf, 0xf, true))
__device__ __forceinline__ void norm_phase(const Frame& F0, const float* xw, const float* g, const float* modl  , int off_sh, int off_sc, bf16_t* H, bool lat_only, unsigned* XQ = nullptr, float* XS = nullptr) {
    const Frame F = phase_frame(F0);
    f32x4 gm[8], shv[8]; int cur_cls = -1;
    int row = F.gw; if (lat_only) while (row < MROWS && row_cls(row) == 2) row += F.NGW;
    f32x4 v[8];
    if (row < MROWS) { const f32x4* x4 = (const f32x4*)(xw + (size_t)row * DM) + F.lane;
#pragma unroll
        for (int j = 0; j < 8; ++j) v[j] = x4[64 * j]; }
    while (row < MROWS) {
        int nrow = row + F.NGW; if (lat_only) while (nrow < MROWS && row_cls(nrow) == 2) nrow += F.NGW;
        f32x4 vn[8];
        if (nrow < MROWS) { const f32x4* x4 = (const f32x4*)(xw + (size_t)nrow * DM) + F.lane;
#pragma unroll
            for (int j = 0; j < 8; ++j) vn[j] = x4[64 * j]; }
        const int cls = row_cls(row);
        if (cls != cur_cls) {
            cur_cls = cls;
            const f32x4* g4 = (const f32x4*)g + F.lane; const f32x4* sc4 = (const f32x4*)(modl + (size_t)cls * NMOD + off_sc) + F.lane; const f32x4* sh4 = (const f32x4*)(modl + (size_t)cls * NMOD + off_sh) + F.lane;
#pragma unroll
            for (int j = 0; j < 8; ++j) { gm[j] = g4[64 * j] * (sc4[64 * j] + 1.0f); shv[j] = sh4[64 * j]; }
        }
        float ss = 0.f;
#pragma unroll
        for (int j = 0; j < 8; ++j) ss += (v[j].x * v[j].x + v[j].y * v[j].y) + (v[j].z * v[j].z + v[j].w * v[j].w);
        const float rstd = 1.0f / sqrtf(wave_sum_dpp(ss) * (1.f / DM) + EPS);
        u32x2* o2 = (u32x2*)(H + (size_t)row * DM) + F.lane;
#pragma unroll
        for (int j = 0; j < 8; ++j) { const f32x4 y = (v[j] * rstd) * gm[j] + shv[j]; u32x2 o; o.x = pk2(y.x, y.y); o.y = pk2(y.z, y.w); o2[64 * j] = o;
            if (XQ) {
                float am = fmaxf(fmaxf(fabsf(y.x), fabsf(y.y)), fmaxf(fabsf(y.z), fabsf(y.w)));
                am = fmaxf(am, DPP_MOV(am, 0xB1)); am = fmaxf(am, DPP_MOV(am, 0x4E)); am = fmaxf(am, DPP_MOV(am, 0x141)); am = fmaxf(am, 1e-20f);
                const float qs = 119.0f / am; const float yy[4] = {y.x, y.y, y.z, y.w};
                unsigned pl = 0u, ph = 0u; int sq = 0;
#pragma unroll
                for (int i = 0; i < 4; ++i) { const int qi = __float2int_rn(yy[i] * qs); const int lo = ((qi + 8) & 15) - 8; const int hi = (qi - lo) >> 4; sq += qi; pl |= (unsigned)(lo & 15) << (4 * i); ph |= (unsigned)(hi & 15) << (4 * i); }
                const unsigned pl1 = (unsigned)__builtin_amdgcn_update_dpp(0, (int)pl, 0xB1, 0xf, 0xf, true), ph1 = (unsigned)__builtin_amdgcn_update_dpp(0, (int)ph, 0xB1, 0xf, 0xf, true);
                float sqf = (float)sq; sqf = DPP_ADD(sqf, 0xB1); sqf = DPP_ADD(sqf, 0x4E); sqf = DPP_ADD(sqf, 0x141);
                const int chunk = j * 8 + (F.lane >> 3), l8 = F.lane & 7;
                if ((l8 & 1) == 0) { unsigned* q = XQ + ((size_t)row * 64 + chunk) * 8 + (l8 >> 1); q[0] = ph | (ph1 << 16); q[4] = pl | (pl1 << 16); }
                if (l8 == 0) { float* s = XS + ((size_t)row * 64 + chunk) * 2; s[0] = am * (1.0f / 119.0f); s[1] = 0.5f * sqf; }
            } }
        row = nrow;
#pragma unroll
        for (int j = 0; j < 8; ++j) v[j] = vn[j];
    }
}

__device__ __forceinline__ float row16_sum(float v) { v = DPP_ADD(v, 0xB1); v = DPP_ADD(v, 0x4E); v = DPP_ADD(v, 0x141); v = DPP_ADD(v, 0x140); return v; }
__device__ __forceinline__ void prep_odd_phase(const Frame& F0, const bf16_t* P, const float* qg, const float* kg, const float* rope_c, bf16_t* Q, bf16_t* Kb) {
    const Frame F = phase_frame(F0);
    const int l16 = F.lane & 15, d0 = l16 * 8;
    float gq[8], gk[8];
#pragma unroll
    for (int e = 0; e < 8; ++e) { gq[e] = qg[d0 + e]; gk[e] = kg[d0 + e]; }
    const bool lowhalf = l16 < 8;
    const int j0 = (l16 & 7) * 8;
    int row = F.gw;
    u32x4 w[5];
    if (row < MROWS) { const u32x4* pr = (const u32x4*)(P + (size_t)row * 3072) + F.lane;
#pragma unroll
        for (int k = 0; k < 5; ++k) w[k] = pr[64 * k]; }
    while (row < MROWS) {
        const int nrow = row + F.NGW;
        u32x4 wn[5];
        if (nrow < MROWS) { const u32x4* pr = (const u32x4*)(P + (size_t)nrow * 3072) + F.lane;
#pragma unroll
            for (int k = 0; k < 5; ++k) wn[k] = pr[64 * k]; }
        const int b = row / RB, i = row - b * RB; const bool lat = i >= CTX; const int t = i - CTX;
        float cs[8], sn[8];
#pragma unroll
        for (int e = 0; e < 8; ++e) { cs[e] = 1.f; sn[e] = 0.f; }
        if (lat) { const int pos = (j0 < 32) ? (t >> 6) : (t & 63); const f32x4* tb = (const f32x4*)(rope_c + ((pos << 5) + (j0 & 31)) * 2);
#pragma unroll
            for (int q = 0; q < 4; ++q) { const f32x4 c = tb[q]; cs[2 * q] = c.x; sn[2 * q] = c.y; cs[2 * q + 1] = c.z; sn[2 * q + 1] = c.w; } }
#pragma unroll
        for (int k = 0; k < 5; ++k) {
            const unsigned ww[4] = {w[k].x, w[k].y, w[k].z, w[k].w};
            float x[8]; float ss = 0.f;
#pragma unroll
            for (int q = 0; q < 4; ++q) { x[2 * q] = bf_lo(ww[q]); x[2 * q + 1] = bf_hi(ww[q]); ss += x[2 * q] * x[2 * q] + x[2 * q + 1] * x[2 * q + 1]; }
            const float rstd = 1.0f / sqrtf(row16_sum(ss) * (1.f / 128.f) + EPS);
            unsigned ow[4]; float o[8];
#pragma unroll
            for (int e = 0; e < 8; ++e) { const float y = x[e] * rstd * (k < 4 ? gq[e] : gk[e]); const float yp = DPP_MOV(y, 0x128);
                o[e] = lowhalf ? (y * cs[e] - yp * sn[e]) : (y * cs[e] + yp * sn[e]); }
#pragma unroll
            for (int q = 0; q < 4; ++q) ow[q] = pk2(o[2 * q], o[2 * q + 1]);
            if (k < 4) *((u32x4*)(Q + (size_t)row * 2048) + 64 * k + F.lane) = (u32x4){ow[0], ow[1], ow[2], ow[3]};
            else *((u32x4*)(Kb + (size_t)row * 512) + F.lane) = (u32x4){ow[0], ow[1], ow[2], ow[3]};
        }
        row = nrow;
#pragma unroll
        for (int k = 0; k < 5; ++k) w[k] = wn[k];
    }
}

struct PrepEvenRow { u32x4 cq; u32x2 ckv, kr; u32x4 qn[2]; u32x2 qr[2]; u32x4 kn[2], vv[2]; };
__device__ __forceinline__ void prep_even_load(PrepEvenRow& R, const bf16_t* P, const bf16_t* QR, const bf16_t* KVR, int row, int lane) {
    const bf16_t* pr = P + (size_t)row * 4096; const int l16 = lane & 15, hq = lane >> 4;
    R.cq = *((const u32x4*)pr + lane); R.ckv = *((const u32x2*)(pr + 512) + lane); R.kr = *((const u32x2*)(pr + 768) + l16);
    const bf16_t* q = QR + (size_t)row * 1536; const bf16_t* kv = KVR + (size_t)row * 2048;
#pragma unroll
    for (int k = 0; k < 2; ++k) { R.qn[k] = *((const u32x4*)q + 64 * k + lane); R.qr[k] = *((const u32x2*)(q + 1024) + 64 * k + lane);
        const bf16_t* kh = kv + (4 * k + hq) * 256 + l16 * 8; R.kn[k] = *(const u32x4*)kh; R.vv[k] = *(const u32x4*)(kh + 128); }
}
__device__ __forceinline__ void prep_even_phase(const Frame& F0, const bf16_t* P, const bf16_t* QR, const bf16_t* KVR, const float* qg, const float* kg, const float* rope_a, bf16_t* Q, bf16_t* Kb, bf16_t* Vb) {
    const Frame F = phase_frame(F0);
    const int lane = F.lane, l16 = lane & 15, hq = lane >> 4, d0 = l16 * 8, r0 = l16 * 4;
    float gqn[8], gkn[8], gqr[4], gkr[4];
#pragma unroll
    for (int e = 0; e < 8; ++e) { gqn[e] = qg[d0 + e]; gkn[e] = kg[d0 + e]; }
#pragma unroll
    for (int e = 0; e < 4; ++e) { gqr[e] = qg[128 + r0 + e]; gkr[e] = kg[128 + r0 + e]; }
    const bool lowhalf = l16 < 8; const int j0 = (l16 & 7) * 4;
    int row = F.gw;
    PrepEvenRow R;
    if (row < MROWS) prep_even_load(R, P, QR, KVR, row, lane);
    while (row < MROWS) {
        const int nrow = row + F.NGW;
        PrepEvenRow Rn;
        if (nrow < MROWS) prep_even_load(Rn, P, QR, KVR, nrow, lane);
        const int b = row / RB, i = row - b * RB; const bool lat = i >= CTX; const int t = i - CTX;
        float cs[4], sn[4];
#pragma unroll
        for (int e = 0; e < 4; ++e) { cs[e] = 1.f; sn[e] = 0.f; }
        if (lat) { const int pos = (j0 < 16) ? (t >> 6) : (t & 63); const f32x4* tb = (const f32x4*)(rope_a + ((pos << 4) + (j0 & 15)) * 2);
            const f32x4 c0 = tb[0], c1 = tb[1]; cs[0] = c0.x; sn[0] = c0.y; cs[1] = c0.z; sn[1] = c0.w; cs[2] = c1.x; sn[2] = c1.y; cs[3] = c1.z; sn[3] = c1.w; }
        float ssq = 0.f, sskv = 0.f;
        { const unsigned ww[4] = {R.cq.x, R.cq.y, R.cq.z, R.cq.w};
#pragma unroll
          for (int q = 0; q < 4; ++q) { const float a = bf_lo(ww[q]), c = bf_hi(ww[q]); ssq += a * a + c * c; } }
        { const float a = bf_lo(R.ckv.x), c = bf_hi(R.ckv.x), d = bf_lo(R.ckv.y), e = bf_hi(R.ckv.y); sskv = (a * a + c * c) + (d * d + e * e); }
        const float rstd_q = 1.0f / sqrtf(wave_sum_dpp(ssq) * (1.f / 512.f) + EPS), rstd_kv = 1.0f / sqrtf(wave_sum_dpp(sskv) * (1.f / 256.f) + EPS);
        const float krv[4] = {bf_lo(R.kr.x), bf_hi(R.kr.x), bf_lo(R.kr.y), bf_hi(R.kr.y)};
        const float krss = (krv[0] * krv[0] + krv[1] * krv[1]) + (krv[2] * krv[2] + krv[3] * krv[3]);
#pragma unroll
        for (int k = 0; k < 2; ++k) {
            const int h = 4 * k + hq;
            {
                const unsigned wn[4] = {R.qn[k].x, R.qn[k].y, R.qn[k].z, R.qn[k].w};
                float xn[8], xr[4]; float ss = 0.f;
#pragma unroll
                for (int q = 0; q < 4; ++q) { xn[2 * q] = bf_lo(wn[q]) * rstd_q; xn[2 * q + 1] = bf_hi(wn[q]) * rstd_q; ss += xn[2 * q] * xn[2 * q] + xn[2 * q + 1] * xn[2 * q + 1]; }
                xr[0] = bf_lo(R.qr[k].x) * rstd_q; xr[1] = bf_hi(R.qr[k].x) * rstd_q; xr[2] = bf_lo(R.qr[k].y) * rstd_q; xr[3] = bf_hi(R.qr[k].y) * rstd_q;
                ss += (xr[0] * xr[0] + xr[1] * xr[1]) + (xr[2] * xr[2] + xr[3] * xr[3]);
                const float r2 = 1.0f / sqrtf(row16_sum(ss) * (1.f / 192.f) + EPS);
                unsigned on[4]; float o[4];
#pragma unroll
                for (int q = 0; q < 4; ++q) on[q] = pk2(xn[2 * q] * r2 * gqn[2 * q], xn[2 * q + 1] * r2 * gqn[2 * q + 1]);
#pragma unroll
                for (int e = 0; e < 4; ++e) { const float y = xr[e] * r2 * gqr[e]; const float yp = DPP_MOV(y, 0x128); o[e] = lowhalf ? (y * cs[e] - yp * sn[e]) : (y * cs[e] + yp * sn[e]); }
                bf16_t* qo = Q + (size_t)row * 1536 + h * 192;
                *(u32x4*)(qo + d0) = (u32x4){on[0], on[1], on[2], on[3]};
                *(u32x2*)(qo + 128 + r0) = (u32x2){pk2(o[0], o[1]), pk2(o[2], o[3])};
            }
            {
                const unsigned wn[4] = {R.kn[k].x, R.kn[k].y, R.kn[k].z, R.kn[k].w}, wv[4] = {R.vv[k].x, R.vv[k].y, R.vv[k].z, R.vv[k].w};
                float xn[8]; float ss = krss;
#pragma unroll
                for (int q = 0; q < 4; ++q) { xn[2 * q] = bf_lo(wn[q]) * rstd_kv; xn[2 * q + 1] = bf_hi(wn[q]) * rstd_kv; ss += xn[2 * q] * xn[2 * q] + xn[2 * q + 1] * xn[2 * q + 1]; }
                const float r2 = 1.0f / sqrtf(row16_sum(ss) * (1.f / 192.f) + EPS);
                unsigned on[4], ov[4]; float o[4];
#pragma unroll
                for (int q = 0; q < 4; ++q) { on[q] = pk2(xn[2 * q] * r2 * gkn[2 * q], xn[2 * q + 1] * r2 * gkn[2 * q + 1]); ov[q] = pk2(bf_lo(wv[q]) * rstd_kv, bf_hi(wv[q]) * rstd_kv); }
#pragma unroll
                for (int e = 0; e < 4; ++e) { const float y = krv[e] * r2 * gkr[e]; const float yp = DPP_MOV(y, 0x128); o[e] = lowhalf ? (y * cs[e] - yp * sn[e]) : (y * cs[e] + yp * sn[e]); }
                bf16_t* ko = Kb + (size_t)row * 1536 + h * 192;
                *(u32x4*)(ko + d0) = (u32x4){on[0], on[1], on[2], on[3]};
                *(u32x2*)(ko + 128 + r0) = (u32x2){pk2(o[0], o[1]), pk2(o[2], o[3])};
                *(u32x4*)(Vb + (size_t)row * 1024 + h * 128 + d0) = (u32x4){ov[0], ov[1], ov[2], ov[3]};
            }
        }
        row = nrow; R = Rn;
    }
}

__device__ __forceinline__ void conv_phase(const Frame& F0, const bf16_t* P, const float* cw  , const float* cb  , bf16_t* CAT) {
    const Frame F = phase_frame(F0);
    const int gt = F.vcu * NTHREADS + F.tid, GT = F.G * NTHREADS;
    for (int it = gt; it < MROWS * 128; it += GT) {
        const int row = it >> 7, c0 = (it & 127) * 8; const int b = row / RB, i = row - b * RB;
        const bool first = (i == 0) || (i == CTX), last = (i == CTX - 1) || (i == RB - 1);
        const bf16_t* pr = P + (size_t)row * 4096 + 832 + c0;
        const u32x4 bg = *(const u32x4*)pr, cg = *(const u32x4*)(pr + 1024), hz = *(const u32x4*)(pr + 2048);
        u32x4 cgm = {0u, 0u, 0u, 0u}, hzm = cgm, cgp = cgm, hzp = cgm;
        if (!first) { cgm = *(const u32x4*)(pr - 4096 + 1024); hzm = *(const u32x4*)(pr - 4096 + 2048); }
        if (!last) { cgp = *(const u32x4*)(pr + 4096 + 1024); hzp = *(const u32x4*)(pr + 4096 + 2048); }
        const unsigned bgw[4] = {bg.x, bg.y, bg.z, bg.w}, cgw[4] = {cg.x, cg.y, cg.z, cg.w}, hzw[4] = {hz.x, hz.y, hz.z, hz.w};
        const unsigned cmw[4] = {cgm.x, cgm.y, cgm.z, cgm.w}, hmw[4] = {hzm.x, hzm.y, hzm.z, hzm.w}, cpw[4] = {cgp.x, cgp.y, cgp.z, cgp.w}, hpw[4] = {hzp.x, hzp.y, hzp.z, hzp.w};
        unsigned ow[4];
#pragma unroll
        for (int q = 0; q < 4; ++q) {
            const int c = c0 + 2 * q;
            const float u0a = bf_lo(cgw[q]) * bf_lo(hzw[q]), u0b = bf_hi(cgw[q]) * bf_hi(hzw[q]);
            const float uma = bf_lo(cmw[q]) * bf_lo(hmw[q]), umb = bf_hi(cmw[q]) * bf_hi(hmw[q]);
            const float upa = bf_lo(cpw[q]) * bf_lo(hpw[q]), upb = bf_hi(cpw[q]) * bf_hi(hpw[q]);
            const float ra = bf_lo(bgw[q]) * (uma * cw[c] + u0a * cw[1024 + c] + upa * cw[2048 + c] + cb[c]);
            const float rb = bf_hi(bgw[q]) * (umb * cw[c + 1] + u0b * cw[1024 + c + 1] + upb * cw[2048 + c + 1] + cb[c + 1]);
            ow[q] = pk2(ra, rb);
        }
        *(u32x4*)(CAT + (size_t)row * DM + 1024 + c0) = (u32x4){ow[0], ow[1], ow[2], ow[3]};
    }
}
__device__ __forceinline__ void attn_even_phase(const Frame& F0, const bf16_t* Q, const bf16_t* Kb, const bf16_t* Vb, bf16_t* CAT) {
    const Frame F = phase_frame(F0);
    for (int u = F.vcu; u < 272; u += F.G) {
        int b, h, qt, nk;
        if (u < 256) { b = u >> 7; h = (u >> 4) & 7; qt = 1 + (u & 15); nk = RB; } else { const int v = u - 256; b = v >> 3; h = v & 7; qt = 0; nk = CTX; }
        const size_t r0 = (size_t)b * RB;
        att::attn_body1<192, 1536, 1536, 1024, 2048>(Q + (r0 + qt * 256) * 1536 + h * 192, Kb + r0 * 1536 + h * 192, Vb + r0 * 1024 + h * 128, CAT + (r0 + qt * 256) * 2048 + h * 128, nk, (char*)F.lds, phase_tid(F.wave));
    }
}
__device__ __forceinline__ void attn_odd_phase(const Frame& F0, const bf16_t* Q, const bf16_t* Kb, const bf16_t* P, bf16_t* CAT, bool lat_only) {
    const Frame F = phase_frame(F0);
    const int nunits = lat_only ? 512 : 544;
    for (int u = F.vcu; u < nunits; u += F.G) {
        int b, hq, qt, nk;
        if (u < 512) { b = u >> 8; hq = (u >> 4) & 15; qt = 1 + (u & 15); nk = RB; } else { const int v = u - 512; b = v >> 4; hq = v & 15; qt = 0; nk = CTX; }
        const int kvh = hq >> 2; const size_t r0 = (size_t)b * RB;
        att::attn_body<128, 2048, 512, 3072, 2048, 2>(Q + (r0 + qt * 256) * 2048 + hq * 128, Kb + r0 * 512 + kvh * 128, P + r0 * 3072 + 2560 + kvh * 128, CAT + (r0 + qt * 256) * 2048 + hq * 128, nk, (char*)F.lds, phase_tid(F.wave));
    }
}

__device__ __forceinline__ int crow32(int r, int hi) { return (r & 3) + 8 * (r >> 2) + 4 * hi; }
__device__ __forceinline__ int fkey(int b) { return b ^ ((b >> 31) & 0x7fffffff); }
#define TK_CE(x, y) do { const int hi_ = max((x), (y)), lo_ = min((x), (y)); (x) = hi_; (y) = lo_; } while (0)
template <int N> __device__ __forceinline__ void tk_sort(int* v) {
#pragma unroll
    for (int k = 2; k <= N; k <<= 1)
#pragma unroll
        for (int j = k >> 1; j > 0; j >>= 1)
#pragma unroll
            for (int i = 0; i < N; ++i) { const int l = i ^ j; if (l > i) { if ((i & k) == 0) TK_CE(v[i], v[l]); else TK_CE(v[l], v[i]); } }
}
__device__ __forceinline__ void tk_merge16(int* a, const int* b) {
#pragma unroll
    for (int i = 0; i < 16; ++i) a[i] = max(a[i], b[15 - i]);
#pragma unroll
    for (int j = 8; j > 0; j >>= 1)
#pragma unroll
        for (int i = 0; i < 16; ++i) { const int l = i ^ j; if (l > i) TK_CE(a[i], a[l]); }
}
__device__ __forceinline__ void tk_merge_partner(int* a) {
    int lo[16], hi[16];
#pragma unroll
    for (int i = 0; i < 16; ++i) { auto rr = __builtin_amdgcn_permlane32_swap((unsigned)a[i], (unsigned)a[i], false, false); lo[i] = (int)rr[0]; hi[i] = (int)rr[1]; }
    tk_merge16(lo, hi);
#pragma unroll
    for (int i = 0; i < 16; ++i) a[i] = lo[i];
}
__device__ __forceinline__ void peer_topk_phase(const Frame& F0, const bf16_t* PQ, const bf16_t* subk  , int* IDX, float* GATE, bool lat_only) {
    const Frame F = phase_frame(F0);
    const int h = F.vcu & 7, jw = (F.vcu >> 3) * NWAVES + F.wave, nwh = (F.G >> 3) * NWAVES;
    {
        const bf16_t* src = subk + (size_t)h * 2 * 128 * 128;
        for (int c = F.tid; c < 4096; c += NTHREADS) { const int row = c >> 4, ch = c & 15;
            *(LAS u32x4*)(F.lds + row * 256 + ((ch ^ (row & 15)) << 4)) = *(const u32x4*)(src + (size_t)row * 128 + ch * 8); }
        __syncthreads();
    }
    const int ntg = lat_only ? 256 : MROWS / 32;
    for (int t = jw; t < ntg; t += nwh) {
        int lane_ = F.lane; asm volatile("" : "+v"(lane_));
        const int r32 = lane_ & 31, hi = lane_ >> 5;
        int tg = t; if (lat_only) tg += 8 + (tg >= 128 ? 8 : 0);
        const int token = tg * 32 + r32;
        int top[2][16];
        const int kk = (((r32 & 14) | (hi ^ (r32 & 1))) << 4);
#pragma unroll
        for (int p = 0; p < 2; ++p) {
            bf16x8 bq[8];
            const bf16_t* qp = PQ + (size_t)token * DM + h * 256 + p * 128 + hi * 8;
#pragma unroll
            for (int ks = 0; ks < 8; ++ks) bq[ks] = *(const bf16x8*)(qp + ks * 16);
            int s[4][16];
#pragma unroll
            for (int nb = 0; nb < 4; ++nb) {
                f32x16 acc = {};
                const LAS unsigned char* kp = F.lds + (p * 128 + nb * 32 + r32) * 256;
#pragma unroll
                for (int ks = 0; ks < 8; ++ks) { const bf16x8 a = *(const LAS bf16x8*)(kp + (kk ^ (ks << 5))); acc = __builtin_amdgcn_mfma_f32_32x32x16_bf16(a, bq[ks], acc, 0, 0, 0); }
#pragma unroll
                for (int r = 0; r < 16; ++r) { const int key = nb * 32 + crow32(r, hi); s[nb][r] = fkey((int)((__float_as_uint(acc[r]) & ~127u) | (unsigned)(127 - key))); }
                tk_sort<16>(s[nb]);
            }
            tk_merge16(s[0], s[1]); tk_merge16(s[2], s[3]); tk_merge16(s[0], s[2]);
            tk_merge_partner(s[0]);
#pragma unroll
            for (int j = 0; j < 16; ++j) top[p][j] = s[0][j];
        }
        int cand[32];
        unsigned long long kaLo = 0ull, kaHi = 0ull, kbLo = 0ull, kbHi = 0ull;
        {
            float fb[16]; const float fa0 = __uint_as_float((unsigned)fkey(top[0][0]) & ~127u), fb0 = __uint_as_float((unsigned)fkey(top[1][0]) & ~127u);
#pragma unroll
            for (int r = 0; r < 16; ++r) { const int ba = fkey(top[0][r]), bb = fkey(top[1][r]); fb[r] = __uint_as_float((unsigned)bb & ~127u) - fb0;
                const unsigned long long xa = (unsigned long long)(unsigned)(127 - (ba & 127)) << (8 * (r & 7)), xb = (unsigned long long)(unsigned)(127 - (bb & 127)) << (8 * (r & 7));
                if (r < 8) { kaLo |= xa; kbLo |= xb; } else { kaHi |= xa; kbHi |= xb; } }
            float fa[8];
#pragma unroll
            for (int i = 0; i < 8; ++i) { const int ka = hi ? top[0][2 * i + 1] : top[0][2 * i]; fa[i] = __uint_as_float((unsigned)fkey(ka) & ~127u) - fa0; }
            const int hid = 255 - (hi << 4);
            int n = 0;
#pragma unroll
            for (int i = 0; i < 8; ++i)
#pragma unroll
                for (int b = 0; b < 16; ++b) if ((2 * i + 1) * (b + 1) <= 16) {
                    const float sum = fa[i] + fb[b];
                    cand[n++] = fkey((int)((__float_as_uint(sum) & ~255u) | (unsigned)(hid - (32 * i + b))));
                }
#pragma unroll
            for (; n < 32; ++n) cand[n] = (int)0x80000000;
        }
        tk_sort<16>(cand); tk_sort<16>(cand + 16); tk_merge16(cand, cand + 16);
        tk_merge_partner(cand);
        float ev[16]; float esum = 0.f;
#pragma unroll
        for (int j = 0; j < 16; ++j) { ev[j] = __expf(__uint_as_float((unsigned)fkey(cand[j]) & ~255u)); esum += ev[j]; }
        const float rs = 1.0f / esum;
        int oi[8]; float og[8];
#pragma unroll
        for (int j = 0; j < 8; ++j) { const int w = hi ? cand[8 + j] : cand[j]; const float e = hi ? ev[8 + j] : ev[j];
            const int id8 = 255 - (fkey(w) & 255), ra = id8 >> 4, rb = id8 & 15;
            const unsigned long long wa = (ra & 8) ? kaHi : kaLo, wb = (rb & 8) ? kbHi : kbLo;
            const int ka = (int)(wa >> (8 * (ra & 7))) & 127, kb = (int)(wb >> (8 * (rb & 7))) & 127;
            oi[j] = ka * 128 + kb; og[j] = e * rs; }
        int* ip = IDX + (size_t)token * 128 + h * 16 + hi * 8; float* gp = GATE + (size_t)token * 128 + h * 16 + hi * 8;
        *(int4*)ip = make_int4(oi[0], oi[1], oi[2], oi[3]); *(int4*)(ip + 4) = make_int4(oi[4], oi[5], oi[6], oi[7]);
        *(f32x4*)gp = (f32x4){og[0], og[1], og[2], og[3]}; *(f32x4*)(gp + 4) = (f32x4){og[4], og[5], og[6], og[7]};
    }
}

#if TAB_FP4
__device__ __forceinline__ void peer_expert_phase(const Frame& F0, const bf16_t* H2, const int* IDX, const float* GATE, const unsigned char* U, size_t v_minus_u_bytes, const float* USC, const float* VSC,
                                                  const float* g2  , float* XW, float* OUT,
                                                  bf16_t* HN  , const float* ng  , const float* nmod  ) {
    const Frame F = phase_frame(F0);
    LAS float* red = (LAS float*)F.lds;
    const unsigned voff_tab = (unsigned)v_minus_u_bytes;
    const __amdgpu_buffer_rsrc_t rs = __builtin_amdgcn_make_buffer_rsrc((void*)U, 0, (int)(voff_tab + (unsigned)NEXP * ROWB), 0x00020000);
    const int lane = F.lane; const int voff = lane * 16;
#define PX_SB() __builtin_amdgcn_sched_barrier(0)
#define PX_LOADALL(buf, ivv, tb) do { _Pragma("unroll") for (int e_ = 0; e_ < 16; ++e_) buf[e_] = __builtin_amdgcn_raw_buffer_load_b128(rs, voff, (unsigned)__builtin_amdgcn_readlane(ivv, e_) * (unsigned)ROWB + (tb), 0); } while (0)
#define PX_U1(d_, b_) { const bf16x2_t r2_ = __builtin_amdgcn_cvt_scalef32_pk_bf16_fp4(wd_[d_], 1.0f, b_); if ((b_) & 1) a1_ = __builtin_amdgcn_fdot2_f32_bf16(r2_, __builtin_bit_cast(bf16x2_t, xpk[4 * (d_) + (b_)]), a1_, false); \
                        else a0_ = __builtin_amdgcn_fdot2_f32_bf16(r2_, __builtin_bit_cast(bf16x2_t, xpk[4 * (d_) + (b_)]), a0_, false); }
#define PX_V1(d_, b_) { const f32x2 t2_ = __builtin_amdgcn_cvt_scalef32_pk_f32_fp4(wd_[d_], 1.0f, b_); acc[8 * (d_) + 2 * (b_)] += wg_ * t2_.x; acc[8 * (d_) + 2 * (b_) + 1] += wg_ * t2_.y; }
#define PX_FETCH_TOKEN(r, XP, IV, GV) do { const u32x4* xp_ = (const u32x4*)(H2 + (size_t)(r) * DM + lane * 16); XP[0] = xp_[0]; XP[1] = xp_[1]; XP[2] = xp_[128]; XP[3] = xp_[129]; \
        IV = 0; GV = 0.f; if (lane < 16) { IV = IDX[(size_t)(r) * 128 + F.wave * 16 + lane]; GV = GATE[(size_t)(r) * 128 + F.wave * 16 + lane]; } } while (0)
    const bool skip_ctx = (OUT != nullptr);
    int row = F.vcu; if (skip_ctx && row < MROWS && row_cls(row) == 2) row += F.G;
    u32x4 xp[4]; int iv; float gv;
    u32x4 ub[16], vb[16];
    if (row < MROWS) { PX_FETCH_TOKEN(row, xp, iv, gv); PX_LOADALL(ub, iv, 0u); PX_LOADALL(vb, iv, voff_tab); }
    int par = 0;
    while (row < MROWS) {
        int nrow = row + F.G; if (skip_ctx && nrow < MROWS && row_cls(nrow) == 2) nrow += F.G;
        float usc = 0.f, vsc = 0.f;
        if (lane < 16) { usc = USC[iv]; vsc = VSC[iv]; }
        u32x4 xpn[4]; int ivn = 0; float gvn = 0.f;
        if (nrow < MROWS) PX_FETCH_TOKEN(nrow, xpn, ivn, gvn);
        const int cls = row_cls(row);
        const f32x4 x_old = *((const f32x4*)(XW + (size_t)row * DM) + F.tid), g_vec = *((const f32x4*)(g2 + (size_t)cls * NMOD) + F.tid);
        f32x4 n_g = {0.f, 0.f, 0.f, 0.f}, n_sc = n_g, n_sh = n_g;
        if (HN) { n_g = *((const f32x4*)ng + F.tid); n_sc = *((const f32x4*)(nmod + (size_t)cls * NMOD + 2048) + F.tid); n_sh = *((const f32x4*)(nmod + (size_t)cls * NMOD) + F.tid); }
        const unsigned xpk[16] = {xp[0].x, xp[0].y, xp[0].z, xp[0].w, xp[1].x, xp[1].y, xp[1].z, xp[1].w, xp[2].x, xp[2].y, xp[2].z, xp[2].w, xp[3].x, xp[3].y, xp[3].z, xp[3].w};
        float sv = 0.f;
        PX_SB();
#pragma unroll
        for (int e = 0; e < 16; ++e) {
            u32x4 w_ = ub[e]; asm volatile("" : "+v"(w_) : "v"(sv));
            const unsigned wd_[4] = {w_.x, w_.y, w_.z, w_.w}; float a0_ = 0.f, a1_ = 0.f;
            PX_U1(0, 0) PX_U1(0, 1) PX_U1(0, 2) PX_U1(0, 3) PX_U1(1, 0) PX_U1(1, 1) PX_U1(1, 2) PX_U1(1, 3) PX_U1(2, 0) PX_U1(2, 1) PX_U1(2, 2) PX_U1(2, 3) PX_U1(3, 0) PX_U1(3, 1) PX_U1(3, 2) PX_U1(3, 3)
            const float t_ = wave_sum_dpp(a0_ + a1_); sv = (lane == e) ? t_ : sv;
        }
        const float wv = gelu_erf(sv * usc) * gv * vsc;
        PX_SB();
        if (nrow < MROWS) PX_LOADALL(ub, ivn, 0u);
        PX_SB();
        f32x32 acc = {};
#pragma unroll
        for (int e = 0; e < 16; ++e) {
            u32x4 w_ = vb[e]; asm volatile("" : "+v"(w_) : "v"(acc));
            const unsigned wd_[4] = {w_.x, w_.y, w_.z, w_.w}; const float wg_ = __uint_as_float(__builtin_amdgcn_readlane(__float_as_uint(wv), e));
            PX_V1(0, 0) PX_V1(0, 1) PX_V1(0, 2) PX_V1(0, 3) PX_V1(1, 0) PX_V1(1, 1) PX_V1(1, 2) PX_V1(1, 3) PX_V1(2, 0) PX_V1(2, 1) PX_V1(2, 2) PX_V1(2, 3) PX_V1(3, 0) PX_V1(3, 1) PX_V1(3, 2) PX_V1(3, 3)
        }
        PX_SB();
        if (nrow < MROWS) PX_LOADALL(vb, ivn, voff_tab);
        PX_SB();
        LAS float* rb = red + par * (NWAVES * DM);
#pragma unroll
        for (int j = 0; j < 2; ++j)
#pragma unroll
            for (int q = 0; q < 4; ++q) *(LAS f32x4*)(rb + F.wave * DM + j * 1024 + lane * 16 + q * 4) = (f32x4){acc[j * 16 + q * 4], acc[j * 16 + q * 4 + 1], acc[j * 16 + q * 4 + 2], acc[j * 16 + q * 4 + 3]};
        __syncthreads();
        {
            f32x4 sm = {0.f, 0.f, 0.f, 0.f};
#pragma unroll
            for (int w = 0; w < 8; ++w) sm += *(const LAS f32x4*)(rb + w * DM + F.tid * 4);
            f32x4* xq = (f32x4*)(XW + (size_t)row * DM) + F.tid;
            const f32x4 xn = x_old + g_vec * sm;
            *xq = xn;
            if (OUT) { const int b = row / RB, i = row - b * RB; if (i >= CTX) *((f32x4*)(OUT + ((size_t)b * SEQ + (i - CTX)) * DM) + F.tid) = xn; }
            if (HN) {
                LAS float* ssp = (LAS float*)(F.lds + 131072) + par * 8;
                const float sw = wave_sum_dpp((xn.x * xn.x + xn.y * xn.y) + (xn.z * xn.z + xn.w * xn.w));
                if (lane == 0) ssp[F.wave] = sw;
                __syncthreads();
                const float tot = ((ssp[0] + ssp[1]) + (ssp[2] + ssp[3])) + ((ssp[4] + ssp[5]) + (ssp[6] + ssp[7]));
                const float rstd = 1.0f / sqrtf(tot * (1.f / DM) + EPS);
                const f32x4 y = (xn * rstd) * n_g * (n_sc + 1.0f) + n_sh;
                u32x2 o; o.x = pk2(y.x, y.y); o.y = pk2(y.z, y.w);
                *((u32x2*)(HN + (size_t)row * DM) + F.tid) = o;
            }
        }
        par ^= 1; row = nrow;
#pragma unroll
        for (int q = 0; q < 4; ++q) xp[q] = xpn[q];
        iv = ivn; gv = gvn;
    }
#undef PX_LOADALL
#undef PX_U1
#undef PX_V1
#undef PX_SB
#undef PX_FETCH_TOKEN
}
#else
__device__ __forceinline__ void peer_expert_phase(const Frame& F0, const bf16_t* H2, const int* IDX, const float* GATE, const unsigned char* U, size_t v_minus_u_bytes, const float* USC, const float* VSC,
                                                  const float* g2  , float* XW, float* OUT,
                                                  bf16_t* HN  , const float* ng  , const float* nmod  ) {
    const Frame F = phase_frame(F0);
    LAS float* red = (LAS float*)F.lds;
    const unsigned voff_tab = (unsigned)v_minus_u_bytes;
    const __amdgpu_buffer_rsrc_t rs = __builtin_amdgcn_make_buffer_rsrc((void*)U, 0, (int)(voff_tab + (unsigned)NEXP * ROWB), 0x00020000);
    const int lane = F.lane; const int voff = lane * 16, voff2 = 1024 + lane * 8;
#define PX_SB() __builtin_amdgcn_sched_barrier(0)
#define PX_LOAD(buf, s, ivv) do { constexpr int e0_ = ((s) & 3) * 4; const unsigned tb_ = ((s) >= 4) ? voff_tab : 0u; \
        _Pragma("unroll") for (int ee_ = 0; ee_ < 4; ++ee_) { const unsigned o_ = (unsigned)__builtin_amdgcn_readlane(ivv, e0_ + ee_) * (unsigned)ROWB + tb_; \
            buf##h[ee_] = __builtin_amdgcn_raw_buffer_load_b128(rs, voff, o_, 0); buf##l[ee_] = __builtin_amdgcn_raw_buffer_load_b64(rs, voff2, o_, 0); } } while (0)
#define PX_DECODE(buf, ee_, dep) u32x6 w6_ = {buf##h[ee_].x, buf##h[ee_].y, buf##h[ee_].z, buf##h[ee_].w, buf##l[ee_].x, buf##l[ee_].y}; \
        asm volatile("" : "+v"(w6_) : "v"(dep));     \
        const f32x32 r_ = __builtin_amdgcn_cvt_scalef32_pk32_f32_fp6(w6_, 1.0f);
#define PX_COMP_U(buf, s) do { constexpr int e0_ = ((s) & 3) * 4; \
            _Pragma("unroll") for (int ee_ = 0; ee_ < 4; ++ee_) { PX_DECODE(buf, ee_, sv) \
                const f32x32 p_ = r_ * xf; float a0_ = 0.f, a1_ = 0.f; \
                _Pragma("unroll") for (int k_ = 0; k_ < 32; k_ += 2) { a0_ += p_[k_]; a1_ += p_[k_ + 1]; } \
                const float t_ = wave_sum_dpp(a0_ + a1_); sv = (lane == e0_ + ee_) ? t_ : sv; } } while (0)
#define PX_COMP_V(buf, s) do { constexpr int e0_ = ((s) & 3) * 4; \
            _Pragma("unroll") for (int ee_ = 0; ee_ < 4; ++ee_) { const float wg_ = __uint_as_float(__builtin_amdgcn_readlane(__float_as_uint(wv), e0_ + ee_)); \
                PX_DECODE(buf, ee_, acc) \
                acc += r_ * wg_; } } while (0)
#define PX_FETCH_TOKEN(r, XP, IV, GV) do { const u32x4* xp_ = (const u32x4*)(H2 + (size_t)(r) * DM + lane * 16); XP[0] = xp_[0]; XP[1] = xp_[1]; XP[2] = xp_[128]; XP[3] = xp_[129]; \
        IV = 0; GV = 0.f; if (lane < 16) { IV = IDX[(size_t)(r) * 128 + F.wave * 16 + lane]; GV = GATE[(size_t)(r) * 128 + F.wave * 16 + lane]; } } while (0)
    const bool skip_ctx = (OUT != nullptr);
    int row = F.vcu; if (skip_ctx && row < MROWS && row_cls(row) == 2) row += F.G;
    u32x4 xp[4]; int iv; float gv;
    u32x4 bAh[4], bBh[4]; u32x2 bAl[4], bBl[4];
    if (row < MROWS) { PX_FETCH_TOKEN(row, xp, iv, gv); PX_LOAD(bA, 0, iv); }
    int par = 0;
    while (row < MROWS) {
        int nrow = row + F.G; if (skip_ctx && nrow < MROWS && row_cls(nrow) == 2) nrow += F.G;
        f32x32 xf;
#pragma unroll
        for (int q = 0; q < 4; ++q) { const unsigned ww[4] = {xp[q].x, xp[q].y, xp[q].z, xp[q].w};
#pragma unroll
            for (int k = 0; k < 4; ++k) { xf[q * 8 + 2 * k] = bf_lo(ww[k]); xf[q * 8 + 2 * k + 1] = bf_hi(ww[k]); } }
        float usc = 0.f, vsc = 0.f;
        if (lane < 16) { usc = USC[iv]; vsc = VSC[iv]; }
        u32x4 xpn[4]; int ivn = 0; float gvn = 0.f;
        if (nrow < MROWS) PX_FETCH_TOKEN(nrow, xpn, ivn, gvn);
        const int cls = row_cls(row);
        const f32x4 x_old = *((const f32x4*)(XW + (size_t)row * DM) + F.tid), g_vec = *((const f32x4*)(g2 + (size_t)cls * NMOD) + F.tid);
        f32x4 n_g = {0.f, 0.f, 0.f, 0.f}, n_sc = n_g, n_sh = n_g;
        if (HN) { n_g = *((const f32x4*)ng + F.tid); n_sc = *((const f32x4*)(nmod + (size_t)cls * NMOD + 2048) + F.tid); n_sh = *((const f32x4*)(nmod + (size_t)cls * NMOD) + F.tid); }
        float sv = 0.f, wv = 0.f;
        PX_LOAD(bB, 1, iv); PX_SB(); PX_COMP_U(bA, 0); PX_SB();
        PX_LOAD(bA, 2, iv); PX_SB(); PX_COMP_U(bB, 1); PX_SB();
        PX_LOAD(bB, 3, iv); PX_SB(); PX_COMP_U(bA, 2); PX_SB();
        PX_LOAD(bA, 4, iv); PX_SB(); PX_COMP_U(bB, 3); PX_SB();
        wv = gelu_erf(sv * usc) * gv * vsc;
        f32x32 acc = {};
        PX_LOAD(bB, 5, iv); PX_SB(); PX_COMP_V(bA, 4); PX_SB();
        PX_LOAD(bA, 6, iv); PX_SB(); PX_COMP_V(bB, 5); PX_SB();
        PX_LOAD(bB, 7, iv); PX_SB(); PX_COMP_V(bA, 6); PX_SB();
        if (nrow < MROWS) PX_LOAD(bA, 0, ivn);
        PX_SB(); PX_COMP_V(bB, 7); PX_SB();
        LAS float* rb = red + par * (NWAVES * DM);
#pragma unroll
        for (int j = 0; j < 2; ++j)
#pragma unroll
            for (int q = 0; q < 4; ++q) *(LAS f32x4*)(rb + F.wave * DM + j * 1024 + lane * 16 + q * 4) = (f32x4){acc[j * 16 + q * 4], acc[j * 16 + q * 4 + 1], acc[j * 16 + q * 4 + 2], acc[j * 16 + q * 4 + 3]};
        __syncthreads();
        {
            f32x4 sm = {0.f, 0.f, 0.f, 0.f};
#pragma unroll
            for (int w = 0; w < 8; ++w) sm += *(const LAS f32x4*)(rb + w * DM + F.tid * 4);
            f32x4* xq = (f32x4*)(XW + (size_t)row * DM) + F.tid;
            const f32x4 xn = x_old + g_vec * sm;
            *xq = xn;
            if (OUT) { const int b = row / RB, i = row - b * RB; if (i >= CTX) *((f32x4*)(OUT + ((size_t)b * SEQ + (i - CTX)) * DM) + F.tid) = xn; }
            if (HN) {
                LAS float* ssp = (LAS float*)(F.lds + 131072) + par * 8;
                const float sw = wave_sum_dpp((xn.x * xn.x + xn.y * xn.y) + (xn.z * xn.z + xn.w * xn.w));
                if (lane == 0) ssp[F.wave] = sw;
                __syncthreads();
                const float tot = ((ssp[0] + ssp[1]) + (ssp[2] + ssp[3])) + ((ssp[4] + ssp[5]) + (ssp[6] + ssp[7]));
                const float rstd = 1.0f / sqrtf(tot * (1.f / DM) + EPS);
                const f32x4 y = (xn * rstd) * n_g * (n_sc + 1.0f) + n_sh;
                u32x2 o; o.x = pk2(y.x, y.y); o.y = pk2(y.z, y.w);
                *((u32x2*)(HN + (size_t)row * DM) + F.tid) = o;
            }
        }
        par ^= 1; row = nrow;
#pragma unroll
        for (int q = 0; q < 4; ++q) xp[q] = xpn[q];
        iv = ivn; gv = gvn;
    }
#undef PX_LOAD
#undef PX_COMP_U
#undef PX_COMP_V
#undef PX_SB
#undef PX_FETCH_TOKEN
}
#endif

#if EXP_SLICED && TAB_FP4
__device__ __forceinline__ float oct_sum(float v) { v = DPP_ADD(v, 0xB1); v = DPP_ADD(v, 0x4E); v = DPP_ADD(v, 0x141); return v; }
__device__ __forceinline__ int sl_next_tok(int t, int stride, bool lat_only) { t += stride; if (lat_only) while (t < MROWS && row_cls(t) == 2) t += stride; return t; }
#ifndef PROBE_IDMASK
#define PROBE_IDMASK 0x7fffffff
#endif
#define SL_IDS(t_, A_, B_) do { A_ = IDX[(size_t)(t_) * 128 + lane] & idmask; B_ = IDX[(size_t)(t_) * 128 + 64 + lane] & idmask; } while (0)
#define SL_ROWS(buf, A_, B_) do { _Pragma("unroll") for (int i_ = 0; i_ < 16; ++i_) { const int id_ = __builtin_amdgcn_ds_bpermute(bp + 32 * (i_ & 7), (i_ < 8) ? (A_) : (B_)); \
        buf[i_] = __builtin_amdgcn_raw_buffer_load_b128(rs, id_ * 128 + coloff, 0, 0); } } while (0)
__device__ __forceinline__ void peer_u_phase(const Frame& F0, const unsigned* XQ, const float* XS, const int* IDX, const unsigned char* U, float* PART, bool lat_only, int idmask = 0x7fffffff) {
    const Frame F = phase_frame(F0);
    const int lane = F.lane, g = lane >> 3, j = lane & 7, bp = 4 * g;
    const int wps = F.G >> 3, x = F.vcu / wps, wi = (F.vcu - x * wps) * NWAVES + F.wave, stride = wps * NWAVES;
    const __amdgpu_buffer_rsrc_t rs = __builtin_amdgcn_make_buffer_rsrc((void*)(U + (size_t)x * (NEXP * 128)), 0, NEXP * 128, 0x00020000);
    const int coloff = 16 * j;
    int t = wi - stride; t = sl_next_tok(t, stride, lat_only);
    int t1 = sl_next_tok(t, stride, lat_only), t2 = sl_next_tok(t1, stride, lat_only);
    int idA1 = 0, idB1 = 0, idA2 = 0, idB2 = 0, idA3 = 0, idB3 = 0; u32x4 xs[3], xs1[3], xs2[3], w[16], wn[16];
#define SL_XS(dst, t_) do { const u32x4* xp_ = (const u32x4*)(XQ + ((size_t)(t_) * 64 + 8 * x + j) * 8); dst[0] = xp_[0]; dst[1] = xp_[1]; const f32x2 s2_ = *(const f32x2*)(XS + ((size_t)(t_) * 64 + 8 * x + j) * 2); dst[2] = (u32x4){__float_as_uint(s2_.x), __float_as_uint(s2_.y), 0u, 0u}; } while (0)
    if (t < MROWS) { int idA0, idB0; SL_IDS(t, idA0, idB0); SL_XS(xs1, t); SL_ROWS(wn, idA0, idB0); }
    if (t1 < MROWS) { SL_IDS(t1, idA2, idB2); SL_XS(xs2, t1); }
    if (t2 < MROWS) SL_IDS(t2, idA3, idB3);
    while (t < MROWS) {
        const int t3 = sl_next_tok(t2, stride, lat_only);
#pragma unroll
        for (int i = 0; i < 16; ++i) w[i] = wn[i];
#pragma unroll
        for (int q = 0; q < 3; ++q) { xs[q] = xs1[q]; xs1[q] = xs2[q]; }
        idA1 = idA2; idB1 = idB2; idA2 = idA3; idB2 = idB3;
        if (t1 < MROWS) SL_ROWS(wn, idA1, idB1);
        if (t2 < MROWS) SL_XS(xs2, t2);
        if (t3 < MROWS) SL_IDS(t3, idA3, idB3);
        const int xh[4] = {(int)xs[0].x, (int)xs[0].y, (int)xs[0].z, (int)xs[0].w}, xl[4] = {(int)xs[1].x, (int)xs[1].y, (int)xs[1].z, (int)xs[1].w};
        const float dq = __uint_as_float(xs[2].x), off = __uint_as_float(xs[2].y);
        float res_lo = 0.f, res_hi = 0.f;
#pragma unroll
        for (int i = 0; i < 16; ++i) {
            const int wd_[4] = {(int)w[i].x, (int)w[i].y, (int)w[i].z, (int)w[i].w}; int ah_ = 0, al_ = 0;
#pragma unroll
            for (int d = 0; d < 4; ++d) { ah_ = __builtin_amdgcn_sdot8(wd_[d], xh[d], ah_, false); al_ = __builtin_amdgcn_sdot8(wd_[d], xl[d], al_, false); }
            const float a_ = oct_sum(((float)(16 * ah_ + al_) + off) * dq);
            if (i < 8) res_lo = (j == i) ? a_ : res_lo; else res_hi = (j == i - 8) ? a_ : res_hi;
        }
        float* pp = PART + ((size_t)t * 8 + x) * 128 + 8 * j + g;
        pp[0] = res_lo; pp[64] = res_hi;
        t = t1; t1 = t2; t2 = t3;
    }
#undef SL_XS
}
__device__ __forceinline__ void peer_w_phase(const Frame& F0, const float* PART, const int* IDX, float* GATE, const float* USC, const float* VSC, bool lat_only) {
    const Frame F = phase_frame(F0);
    const int gt = F.vcu * NTHREADS + F.tid, GT = F.G * NTHREADS;
    for (int e0 = gt; e0 < MROWS * 128; e0 += 4 * GT) {
        float s[4]; int id[4]; float gte[4], us[4], vs[4]; bool ok[4];
#pragma unroll
        for (int u = 0; u < 4; ++u) { const int e = e0 + u * GT; ok[u] = e < MROWS * 128 && !(lat_only && row_cls(e >> 7) == 2); s[u] = 0.f; id[u] = 0; gte[u] = 0.f;
            if (ok[u]) { const float* pp = PART + (size_t)(e >> 7) * 1024 + (e & 127);
#pragma unroll
                for (int xx = 0; xx < 8; ++xx) s[u] += pp[xx * 128];
                id[u] = IDX[e]; gte[u] = GATE[e]; } }
#pragma unroll
        for (int u = 0; u < 4; ++u) { us[u] = ok[u] ? USC[id[u]] : 0.f; vs[u] = ok[u] ? VSC[id[u]] : 0.f; }
#pragma unroll
        for (int u = 0; u < 4; ++u) if (ok[u]) GATE[e0 + u * GT] = gte[u] * gelu_erf(s[u] * us[u]) * vs[u];
    }
}
__device__ __forceinline__ void peer_v_phase(const Frame& F0, const int* IDX, const float* WK, const unsigned char* VT, const float* g2  , float* XW, float* OUT, bool lat_only) {
    const int idmask = 0x7fffffff;
    const Frame F = phase_frame(F0);
    const int lane = F.lane, g = lane >> 3, j = lane & 7, bp = 4 * g;
    const int wps = F.G >> 3, x = F.vcu / wps, wi = (F.vcu - x * wps) * NWAVES + F.wave, stride = wps * NWAVES;
    const __amdgpu_buffer_rsrc_t rs = __builtin_amdgcn_make_buffer_rsrc((void*)(VT + (size_t)x * (NEXP * 128)), 0, NEXP * 128, 0x00020000);
    const int coloff = 16 * j;
    const int mycol = 256 * x + 32 * j + 4 * g;
    int t = wi - stride; t = sl_next_tok(t, stride, lat_only);
    int t1 = sl_next_tok(t, stride, lat_only), t2 = sl_next_tok(t1, stride, lat_only);
    int idA1 = 0, idB1 = 0, idA2 = 0, idB2 = 0, idA3 = 0, idB3 = 0; float wA = 0.f, wB = 0.f, wA1 = 0.f, wB1 = 0.f, wA2 = 0.f, wB2 = 0.f; u32x4 w[16], wn[16];
    f32x4 x_old = {0.f, 0.f, 0.f, 0.f}, g_vec = x_old, xo1 = x_old, gv1 = x_old, xo2 = x_old, gv2 = x_old;
#define SL_WK(t_, A_, B_) do { A_ = WK[(size_t)(t_) * 128 + lane]; B_ = WK[(size_t)(t_) * 128 + 64 + lane]; } while (0)
#define SL_XG(t_, X_, G_) do { X_ = *(const f32x4*)(XW + (size_t)(t_) * DM + mycol); G_ = *(const f32x4*)(g2 + (size_t)row_cls(t_) * NMOD + mycol); } while (0)
    if (t < MROWS) { int idA0, idB0; SL_IDS(t, idA0, idB0); SL_WK(t, wA1, wB1); SL_XG(t, xo1, gv1); SL_ROWS(wn, idA0, idB0); }
    if (t1 < MROWS) { SL_IDS(t1, idA2, idB2); SL_WK(t1, wA2, wB2); SL_XG(t1, xo2, gv2); }
    if (t2 < MROWS) SL_IDS(t2, idA3, idB3);
    while (t < MROWS) {
        const int t3 = sl_next_tok(t2, stride, lat_only);
#pragma unroll
        for (int i = 0; i < 16; ++i) w[i] = wn[i];
        wA = wA1; wB = wB1; wA1 = wA2; wB1 = wB2; x_old = xo1; g_vec = gv1; xo1 = xo2; gv1 = gv2;
        idA1 = idA2; idB1 = idB2; idA2 = idA3; idB2 = idB3;
        if (t1 < MROWS) SL_ROWS(wn, idA1, idB1);
        if (t2 < MROWS) { SL_WK(t2, wA2, wB2); SL_XG(t2, xo2, gv2); }
        if (t3 < MROWS) SL_IDS(t3, idA3, idB3);
        h2_t acc[16];
#pragma unroll
        for (int p = 0; p < 16; ++p) acc[p] = (h2_t){(_Float16)0.f, (_Float16)0.f};
#define SL_V1(d_, b_) { const h2_t r2_ = __builtin_amdgcn_cvt_scalef32_pk_f16_fp4(wd_[d_], 1.0f, b_); acc[4 * (d_) + (b_)] = __builtin_elementwise_fma(r2_, wg2_, acc[4 * (d_) + (b_)]); }
#pragma unroll
        for (int i = 0; i < 16; ++i) {
            const unsigned wd_[4] = {w[i].x, w[i].y, w[i].z, w[i].w};
            const float wgf_ = __int_as_float(__builtin_amdgcn_ds_bpermute(bp + 32 * (i & 7), __float_as_int((i < 8) ? wA : wB)));
            const _Float16 wgh_ = (_Float16)wgf_; const h2_t wg2_ = {wgh_, wgh_};
            SL_V1(0, 0) SL_V1(0, 1) SL_V1(0, 2) SL_V1(0, 3) SL_V1(1, 0) SL_V1(1, 1) SL_V1(1, 2) SL_V1(1, 3) SL_V1(2, 0) SL_V1(2, 1) SL_V1(2, 2) SL_V1(2, 3) SL_V1(3, 0) SL_V1(3, 1) SL_V1(3, 2) SL_V1(3, 3)
        }
#undef SL_V1
        unsigned m0 = 0u, m1 = 0u;
#pragma unroll
        for (int p = 0; p < 16; ++p) {
            h2_t v = acc[p];
            v = v + __builtin_bit_cast(h2_t, __builtin_amdgcn_update_dpp(0, __builtin_bit_cast(int, v), 0x128, 0xf, 0xf, true));
            { auto r = __builtin_amdgcn_permlane16_swap(__builtin_bit_cast(unsigned, v), __builtin_bit_cast(unsigned, v), false, false); v = __builtin_bit_cast(h2_t, (unsigned)r[0]) + __builtin_bit_cast(h2_t, (unsigned)r[1]); }
            { auto r = __builtin_amdgcn_permlane32_swap(__builtin_bit_cast(unsigned, v), __builtin_bit_cast(unsigned, v), false, false); v = __builtin_bit_cast(h2_t, (unsigned)r[0]) + __builtin_bit_cast(h2_t, (unsigned)r[1]); }
            if (g == (p >> 1)) { if (p & 1) m1 = __builtin_bit_cast(unsigned, v); else m0 = __builtin_bit_cast(unsigned, v); }
        }
        const h2_t q0 = __builtin_bit_cast(h2_t, m0), q1 = __builtin_bit_cast(h2_t, m1);
        const f32x4 mine = {(float)q0.x, (float)q0.y, (float)q1.x, (float)q1.y};
        const f32x4 xn = x_old + g_vec * mine;
        *(f32x4*)(XW + (size_t)t * DM + mycol) = xn;
        if (OUT) { const int b = t / RB, i = t - b * RB; if (i >= CTX) *(f32x4*)(OUT + ((size_t)b * SEQ + (i - CTX)) * DM + mycol) = xn; }
        t = t1; t1 = t2; t2 = t3;
    }
#undef SL_WK
#undef SL_XG
}
#undef SL_IDS
#undef SL_ROWS
#endif
#ifndef N_LAUNCHES
#define N_LAUNCHES 1
#endif
struct Args { const float* in[26]; float* out; unsigned char* ws; int ph_lo, ph_hi; };
constexpr int NPHASES = 39;
__global__ void __launch_bounds__(NTHREADS, 2) fwd_kernel(Args args) {
    extern __shared__ __attribute__((aligned(16))) unsigned char lds_raw[];
    Frame F_;
    F_.lds = (LAS unsigned char*)lds_raw;
    F_.tid = threadIdx.x; F_.lane = F_.tid & 63; F_.wave = __builtin_amdgcn_readfirstlane(F_.tid >> 6);
    F_.G = gridDim.x; { const int bx = blockIdx.x; F_.vcu = (F_.G % 8 == 0) ? (bx % 8) * (F_.G / 8) + bx / 8 : bx; }
    F_.gw = F_.vcu * NWAVES + F_.wave; F_.NGW = F_.G * NWAVES;
    F_.ws = args.ws;
    volatile LAS unsigned* MISC = (volatile LAS unsigned*)(F_.lds + LDS_MISC);
    if (F_.tid < 32) MISC[F_.tid] = 0u;
    __syncthreads();
    const int lo = args.ph_lo, hi = args.ph_hi;
    XcdBarrier bar; bar.bar = (unsigned*)(args.ws + WS_CTL) + CW_BAR; bar.x = 0; bar.st = nullptr;
    if (N_LAUNCHES == 1 || hi - lo > 1) bar = xcd_barrier_post((unsigned*)(args.ws + WS_CTL) + CW_BAR, MISC + 8);
#if N_LAUNCHES == 1
#define IN(k) true
#define SEAM(k) xcd_barrier(bar)
#else
#define IN(k) (lo <= (k) && (k) < hi)
#define SEAM(k) do { if (IN(k) && IN((k) + 1)) xcd_barrier(bar); } while (0)
#endif
    PG8_LAS unsigned char* glds = (PG8_LAS unsigned char*)lds_raw;

    if (IN(0)) { p0_prologue(F_, args.in); } SEAM(0);

#pragma unroll 1
    for (int lp = 0; lp < 2; ++lp) {
        const int pb = 1 + lp * 19;
        unsigned char* ws = args.ws; asm volatile("" : "+s"(ws));
        Frame F = F_; { int w_ = F_.wave, v_ = F_.vcu, g_ = F_.G; asm volatile("" : "+s"(w_), "+s"(v_), "+s"(g_)); F.wave = w_; F.vcu = v_; F.G = g_; F.gw = v_ * NWAVES + w_; F.NGW = g_ * NWAVES; F.ws = ws; }
        float* mod = (float*)(ws + WS_MOD); float* XW = (float*)(ws + WS_XW);
        bf16_t* H = (bf16_t*)(ws + WS_H); bf16_t* P = (bf16_t*)(ws + WS_P); bf16_t* QRAW = (bf16_t*)(ws + WS_QRAW); bf16_t* KVRAW = (bf16_t*)(ws + WS_KVRAW);
        bf16_t* Q = (bf16_t*)(ws + WS_Q); bf16_t* KB = (bf16_t*)(ws + WS_K); bf16_t* VB = (bf16_t*)(ws + WS_V); bf16_t* CAT = (bf16_t*)(ws + WS_CAT); bf16_t* PQ = (bf16_t*)(ws + WS_PQ);
        int* IDX = (int*)(ws + WS_IDX); float* GATE = (float*)(ws + WS_GATE);
        const float* rope_c = (const float*)(ws + WS_ROPE); const float* rope_a = rope_c + 64 * 32 * 2;
        const float* SMv = (const float*)(ws + WS_SMALL);
        {
            const int l = 2 * lp, i = lp;
            const float* modl = mod + (size_t)l * 3 * NMOD;
            if (lp == 0) { if (IN(pb + 0)) { norm_phase(F, XW, SMv + SM_N1G + l * DM, modl, 0, 2048, H, false); } SEAM(pb + 0); }
            if (IN(pb + 1)) {
                pg8::Gemm g{H, (const bf16_t*)(ws + WS_WIN) + (size_t)i * 4096 * DM, MROWS, 4096, DM, DM, DM}; pg8::StaticOrder S; S.init(MROWS, 4096, F.G, (int)blockIdx.x);
                pg8::EpiBf16 E{P, 4096};
                pg8::gemm_phase<pg8::EpiBf16, pg8::StaticOrder, true, true>(glds, g, S, E, phase_tid(F.wave));
            } SEAM(pb + 1);
            if (IN(pb + 2)) {
                { pg8::Gemm g{P, (const bf16_t*)(ws + WS_WUQ) + (size_t)i * 1536 * 512, MROWS, 1536, 512, 4096, 512}; pg8::StaticOrder S; S.init(MROWS, 1536, F.G, (int)blockIdx.x);
                  pg8::EpiBf16 E{QRAW, 1536};
                  pg8::gemm_phase<pg8::EpiBf16, pg8::StaticOrder, true, true>(glds, g, S, E, phase_tid(F.wave)); }
                __syncthreads();
                { pg8::Gemm g{P + 512, (const bf16_t*)(ws + WS_WUKV) + (size_t)i * 2048 * 256, MROWS, 2048, 256, 4096, 256}; pg8::StaticOrder S; S.init(MROWS, 2048, F.G, (int)blockIdx.x);
                  pg8::EpiBf16 E{KVRAW, 2048};
                  pg8::gemm_phase<pg8::EpiBf16, pg8::StaticOrder, true, true>(glds, g, S, E, phase_tid(F.wave)); }
                __syncthreads();
                conv_phase(F, P, SMv + SM_CW + i * 3072, SMv + SM_CB + i * 1024, CAT);
            } SEAM(pb + 2);
            if (IN(pb + 3)) { prep_even_phase(F, P, QRAW, KVRAW, SMv + SM_AQG + i * 192, SMv + SM_AKG + i * 192, rope_a, Q, KB, VB); } SEAM(pb + 3);
            if (IN(pb + 4)) { attn_even_phase(F, Q, KB, VB, CAT); } SEAM(pb + 4);
            if (IN(pb + 5)) {
                pg8::Gemm g{CAT, (const bf16_t*)(ws + WS_WEO) + (size_t)i * DM * DM, MROWS, DM, DM, DM, DM}; pg8::StaticOrder S; S.init(MROWS, DM, F.G, (int)blockIdx.x);
                pg8::EpiResid E{XW, DM, modl + 4096};
                pg8::gemm_phase<pg8::EpiResid, pg8::StaticOrder, true, true>(glds, g, S, E, phase_tid(F.wave));
            } SEAM(pb + 5);
            if (IN(pb + 6)) { norm_phase(F, XW, SMv + SM_N2G + l * DM, modl, 6144, 8192, H, l == 3, (unsigned*)(ws + WS_XQ), (float*)(ws + WS_XS)); } SEAM(pb + 6);
            if (IN(pb + 7)) {
                pg8::Gemm g{H, (const bf16_t*)(ws + WS_WPQ) + (size_t)l * DM * DM, MROWS, DM, DM, DM, DM}; pg8::StaticOrder S; S.init(MROWS, DM, F.G, (int)blockIdx.x);
                pg8::EpiBf16 E{PQ, DM};
                pg8::gemm_phase<pg8::EpiBf16, pg8::StaticOrder, true, true>(glds, g, S, E, phase_tid(F.wave));
            } SEAM(pb + 7);
            if (IN(pb + 8)) { peer_topk_phase(F, PQ, (const bf16_t*)(ws + WS_SUBK) + (size_t)l * 16 * 128 * 128, IDX, GATE, l == 3); } SEAM(pb + 8);
            {
                const unsigned char* Ut = ws + WS_U + (size_t)l * NEXP * ROWB; const unsigned char* Vt = ws + WS_VT + (size_t)l * NEXP * ROWB;
                peer_u_phase(F, (const unsigned*)(ws + WS_XQ), (const float*)(ws + WS_XS), IDX, Ut, (float*)(ws + WS_PART), false); SEAM(0);
                peer_w_phase(F, (const float*)(ws + WS_PART), IDX, GATE, (const float*)(ws + WS_USC) + l * NEXP, (const float*)(ws + WS_VSC) + l * NEXP, false); SEAM(0);
                peer_v_phase(F, IDX, GATE, Vt, modl + 10240, XW, nullptr, false); SEAM(0);
                norm_phase(F, XW, SMv + SM_N1G + (l + 1) * DM, mod + (size_t)(l + 1) * 3 * NMOD, 0, 2048, H, false); SEAM(0);
            }
        }
        {
            const int l = 2 * lp + 1, i = lp, qb = pb + 10;
            const float* modl = mod + (size_t)l * 3 * NMOD;
            if (IN(qb + 1)) {
                pg8::Gemm g{H, (const bf16_t*)(ws + WS_WQKV) + (size_t)i * 3072 * DM, MROWS, 3072, DM, DM, DM}; pg8::StaticOrder S; S.init(MROWS, 3072, F.G, (int)blockIdx.x);
                pg8::EpiBf16 E{P, 3072};
                pg8::gemm_phase<pg8::EpiBf16, pg8::StaticOrder, true, true>(glds, g, S, E, phase_tid(F.wave));
            } SEAM(qb + 1);
            if (IN(qb + 2)) { prep_odd_phase(F, P, SMv + SM_CQG + i * 128, SMv + SM_CKG + i * 128, rope_c, Q, KB); } SEAM(qb + 2);
            if (IN(qb + 3)) { attn_odd_phase(F, Q, KB, P, CAT, l == 3); } SEAM(qb + 3);
            if (IN(qb + 4)) {
                pg8::Gemm g{CAT, (const bf16_t*)(ws + WS_WCO) + (size_t)i * DM * DM, MROWS, DM, DM, DM, DM}; pg8::StaticOrder S; S.init(MROWS, DM, F.G, (int)blockIdx.x, l == 3);
                pg8::EpiResid E{XW, DM, modl + 4096};
                pg8::gemm_phase<pg8::EpiResid, pg8::StaticOrder, true, true>(glds, g, S, E, phase_tid(F.wave));
            } SEAM(qb + 4);
            if (IN(qb + 5)) { norm_phase(F, XW, SMv + SM_N2G + l * DM, modl, 6144, 8192, H, l == 3, (unsigned*)(ws + WS_XQ), (float*)(ws + WS_XS)); } SEAM(qb + 5);
            if (IN(qb + 6)) {
                pg8::Gemm g{H, (const bf16_t*)(ws + WS_WPQ) + (size_t)l * DM * DM, MROWS, DM, DM, DM, DM}; pg8::StaticOrder S; S.init(MROWS, DM, F.G, (int)blockIdx.x, l == 3);
                pg8::EpiBf16 E{PQ, DM};
                pg8::gemm_phase<pg8::EpiBf16, pg8::StaticOrder, true, true>(glds, g, S, E, phase_tid(F.wave));
            } SEAM(qb + 6);
            if (IN(qb + 7)) { peer_topk_phase(F, PQ, (const bf16_t*)(ws + WS_SUBK) + (size_t)l * 16 * 128 * 128, IDX, GATE, l == 3); } SEAM(qb + 7);
            {
                const unsigned char* Ut = ws + WS_U + (size_t)l * NEXP * ROWB; const unsigned char* Vt = ws + WS_VT + (size_t)l * NEXP * ROWB;
                peer_u_phase(F, (const unsigned*)(ws + WS_XQ), (const float*)(ws + WS_XS), IDX, Ut, (float*)(ws + WS_PART), l == 3); SEAM(0);
                peer_w_phase(F, (const float*)(ws + WS_PART), IDX, GATE, (const float*)(ws + WS_USC) + l * NEXP, (const float*)(ws + WS_VSC) + l * NEXP, l == 3); SEAM(0);
                peer_v_phase(F, IDX, GATE, Vt, modl + 10240, XW, (l == 3) ? args.out : nullptr, l == 3);
                if (lp == 0) { SEAM(0); norm_phase(F, XW, SMv + SM_N1G + (l + 1) * DM, mod + (size_t)(l + 1) * 3 * NMOD, 0, 2048, H, false); SEAM(0); }
            }
        }
    }
#undef IN
#undef SEAM
}

extern "C" void kernel_launch(void* const* d_in, const int* in_sizes, int n_in, void* d_out, int out_size, void* d_ws, size_t ws_size, hipStream_t stream) {
    static int grid = 0;
    if (grid == 0) {
        if (n_in != 26 || out_size != NBATCH * SEQ * DM || ws_size < WS_END) { fprintf(stderr, "kernel_launch: unexpected shapes: n_in %d out %d ws %zu (need %zu)\n", n_in, out_size, ws_size, (size_t)WS_END); grid = -1; return; }
        int dev = 0, cus = 0, per_cu = 0;
        if (hipGetDevice(&dev) != hipSuccess || hipDeviceGetAttribute(&cus, hipDeviceAttributeMultiprocessorCount, dev) != hipSuccess) { fprintf(stderr, "kernel_launch: device query failed\n"); grid = -1; return; }
        if (hipFuncSetAttribute((const void*)fwd_kernel, hipFuncAttributeMaxDynamicSharedMemorySize, LDS_BYTES) != hipSuccess) { fprintf(stderr, "kernel_launch: hipFuncSetAttribute failed\n"); grid = -1; return; }
        if (hipOccupancyMaxActiveBlocksPerMultiprocessor(&per_cu, (const void*)fwd_kernel, NTHREADS, LDS_BYTES) != hipSuccess || per_cu < 1) { fprintf(stderr, "kernel_launch: occupancy query says %d blocks per CU\n", per_cu); (void)hipGetLastError(); grid = -1; return; }
        if (cus % 8 != 0) { fprintf(stderr, "kernel_launch: %d CUs: the phase decompositions assume a multiple of 8 workgroups\n", cus); grid = -1; return; }
        grid = cus;
    }
    if (grid < 0) return;
    (void)hipMemsetAsync((char*)d_ws + WS_CTL, 0, CTL_ZERO_BYTES, stream);
    Args a{};
    for (int i = 0; i < 26; ++i) a.in[i] = (const float*)d_in[i];
    a.out = (float*)d_out; a.ws = (unsigned char*)d_ws;
    for (int li = 0; li < N_LAUNCHES; ++li) {
        a.ph_lo = (N_LAUNCHES == 1) ? 0 : li; a.ph_hi = (N_LAUNCHES == 1) ? NPHASES : li + 1;
        hipLaunchKernelGGL(fwd_kernel, dim3(grid), dim3(NTHREADS), LDS_BYTES, stream, a);
        const hipError_t le = hipPeekAtLastError();
        if (le != hipSuccess) { fprintf(stderr, "kernel_launch: launch %d failed: %s\n", li, hipGetErrorName(le)); break; }
    }
}
```

```cpp
#include <hip/hip_runtime.h>
#include <cstdio>
#include <cstdint>
namespace pg8 {
#define PG8_LAS __attribute__((address_space(3)))
typedef unsigned short bf16_t;
typedef short bf16x8 __attribute__((ext_vector_type(8)));
typedef float f32x4 __attribute__((ext_vector_type(4)));
typedef unsigned u32x4 __attribute__((ext_vector_type(4)));
constexpr int BM = 256, BK = 64, HALF = 128, HTB = HALF * BK * 2  , STAGE_BYTES = 8 * HTB, NXCD = 8, WGM = 8;

__host__ __device__ __forceinline__ int lds_byte(int r, int c) { const int st = (r >> 4) * 2 + (c >> 5), rr = r & 15, cc = c & 31, ob = rr * 64 + cc * 2; return st * 1024 + (ob ^ (((ob >> 9) & 1) << 5)); }
__host__ __device__ __forceinline__ void stage_rc(int b, int& R, int& C) { const int st = b / 1024, sb = b % 1024, swz = sb ^ (((sb >> 9) & 1) << 5); R = (st >> 1) * 16 + swz / 64; C = (st & 1) * 32 + (swz % 64) / 2; }
__host__ __device__ __forceinline__ int perm32(int rho) { const int n = rho >> 4, i = rho & 15; return 8 * (i >> 2) + 4 * n + (i & 3); }

struct Unit { int pm, pn; };
struct Gemm { const bf16_t* A; const bf16_t* Bt; int M, N, K, lda, ldb; };

struct StaticOrder {
    int nM, nN, nwg, G, c; bool lat_only;
    __host__ __device__ void init(int M, int N, int G_, int c_, bool lat_only_ = false) { lat_only = lat_only_; nM = lat_only_ ? 32 : M / BM; nN = N / BM; nwg = nM * nN; G = G_; c = c_; }
    __host__ __device__ bool next(int i, Unit& u) const {
        const long L = (long)i * G + c; if (L >= nwg) return false;
        int wgid = (int)L; { const int q = nwg / NXCD, r = nwg % NXCD, xcd = wgid % NXCD, off = wgid / NXCD; wgid = (xcd < r ? xcd * (q + 1) : r * (q + 1) + (xcd - r) * q) + off; }
        const int nig = WGM * nN, gid = wgid / nig, fm = gid * WGM, gsz = (nM - fm) < WGM ? (nM - fm) : WGM;
        u.pm = fm + ((wgid % nig) % gsz); u.pn = (wgid % nig) / gsz; if (lat_only) u.pm += 1 + (u.pm >= 16 ? 1 : 0); return true;
    }
    __device__ __forceinline__ void a_ready(const Unit&) const {}
    __device__ __forceinline__ void done(const Unit&) const {}
};
__device__ __forceinline__ unsigned cvt_pk_bf16(float lo, float hi) { unsigned r; asm volatile("v_cvt_pk_bf16_f32 %0, %1, %2" : "=v"(r) : "v"(lo), "v"(hi)); return r; }
typedef float f32x2 __attribute__((ext_vector_type(2)));
struct EpiBf16 {
    static constexpr bool PERM = true, AFTER_DRAIN = false;
    bf16_t* O; int ldc;
    __device__ __forceinline__ void operator()(const f32x4 (&acc)[2][2][4][2], const Unit& u, int wr, int wc, int fr, int fq) const {
        const int row0 = u.pm * BM + wr * 64 + fr, col0 = u.pn * BM + wc * 32 + 8 * fq;
#pragma unroll
        for (int ai = 0; ai < 2; ++ai)
#pragma unroll
            for (int m = 0; m < 4; ++m) { bf16_t* rowp = O + (size_t)(row0 + ai * HALF + m * 16) * ldc + col0;
#pragma unroll
                for (int bj = 0; bj < 2; ++bj) { const f32x4 v0 = acc[ai][bj][m][0], v1 = acc[ai][bj][m][1];
                    u32x4 w; w.x = cvt_pk_bf16(v0[0], v0[1]); w.y = cvt_pk_bf16(v0[2], v0[3]); w.z = cvt_pk_bf16(v1[0], v1[1]); w.w = cvt_pk_bf16(v1[2], v1[3]);
                    *(u32x4*)(rowp + bj * HALF) = w; } }
    }
};
struct EpiResid {
    static constexpr bool PERM = false, AFTER_DRAIN = false;
    float* X; int ldc; const float* gate;
    __device__ __forceinline__ void operator()(const f32x4 (&acc)[2][2][4][2], const Unit& u, int wr, int wc, int fr, int fq) const {
        const int row0 = u.pm * BM + wr * 64 + fr, col0 = u.pn * BM + wc * 32 + 4 * fq;
        const int cls = (u.pm % 17 == 0) ? 2 : (u.pm / 17);
        const float* gp = gate + (size_t)cls * 12288 + col0;
        f32x4 gv[2][2];
#pragma unroll
        for (int bj = 0; bj < 2; ++bj)
#pragma unroll
            for (int n = 0; n < 2; ++n) gv[bj][n] = *(const f32x4*)(gp + bj * HALF + n * 16);
#pragma unroll
        for (int ai = 0; ai < 2; ++ai)
#pragma unroll
            for (int m = 0; m < 4; ++m) { float* rowp = X + (size_t)(row0 + ai * HALF + m * 16) * ldc + col0;
#pragma unroll
                for (int bj = 0; bj < 2; ++bj)
#pragma unroll
                    for (int n = 0; n < 2; ++n) { f32x4* p = (f32x4*)(rowp + bj * HALF + n * 16); *p = *p + gv[bj][n] * acc[ai][bj][m][n]; } }
    }
};
template <class Epi, class Sched, bool ALIGN_EPI = false, bool SP2 = false>
__device__ __forceinline__ void gemm_phase(PG8_LAS unsigned char* lds, const Gemm g, const Sched& S, const Epi& E, int tid_in) {
    int tid_ = tid_in; asm volatile("" : "+v"(tid_));
    const int tid = tid_, wid = __builtin_amdgcn_readfirstlane(tid >> 6), lane = tid & 63, wr = wid >> 2, wc = wid & 3, fr = lane & 15, fq = lane >> 4;
    const int K = g.K, nt = K / BK;
    unsigned voffA[2], voffB[2];
#pragma unroll
    for (int i = 0; i < 2; ++i) { int R, C; stage_rc(tid * 16 + i * 8192, R, C); const int Rb = Epi::PERM ? ((R & ~31) + perm32(R & 31)) : R;
        voffA[i] = (unsigned)(R * g.lda + C) * 2u; voffB[i] = (unsigned)(Rb * g.ldb + C) * 2u; }
    const size_t kstep = (size_t)(BK * 2);
    const size_t hstepA = (size_t)HALF * g.lda * 2, hstepB = (size_t)HALF * g.ldb * 2;
    const size_t tstepA = 2 * hstepA, tstepB = 2 * hstepB;
    const unsigned ldsw = (unsigned)wid * 1024u;
    const int aoff = lds_byte(wr * 64 + fr, fq * 8), boff = lds_byte(wc * 32 + fr, fq * 8);
#define PG8_SA(b, h) (((b) * 2 + (h)) * HTB)
#define PG8_SB(b, h) ((4 + (b) * 2 + (h)) * HTB)
#define PG8_STAGE(bufoff, gbase, voff) do { _Pragma("unroll") for (int _i = 0; _i < 2; ++_i) \
        __builtin_amdgcn_global_load_lds((const unsigned*)((const char*)(gbase) + (voff)[_i]), (PG8_LAS unsigned*)(lds + (bufoff) + ldsw + _i * 8192), 16, 0, 0); } while (0)
#define PG8_LDA(dst, b, h) do { _Pragma("unroll") for (int m = 0; m < 4; ++m) _Pragma("unroll") for (int k = 0; k < 2; ++k) dst[m][k] = *(const PG8_LAS bf16x8*)(lds + PG8_SA(b, h) + aoff + m * 2048 + k * 1024); } while (0)
#define PG8_LDB(dst, b, h) do { _Pragma("unroll") for (int n = 0; n < 2; ++n) _Pragma("unroll") for (int k = 0; k < 2; ++k) dst[n][k] = *(const PG8_LAS bf16x8*)(lds + PG8_SB(b, h) + boff + n * 2048 + k * 1024); } while (0)
#define PG8_MMA(ai, bj, At, Bt) do { __builtin_amdgcn_s_setprio(1); _Pragma("unroll") for (int m = 0; m < 4; ++m) _Pragma("unroll") for (int n = 0; n < 2; ++n) _Pragma("unroll") for (int k = 0; k < 2; ++k) \
        acc[ai][bj][m][n] = __builtin_amdgcn_mfma_f32_16x16x32_bf16(Bt[n][k], At[m][k], acc[ai][bj][m][n], 0, 0, 0); __builtin_amdgcn_s_setprio(0); } while (0)
#define PG8_WAIT_V(n) asm volatile("s_waitcnt vmcnt(" #n ")" ::: "memory")
#define PG8_WAIT_L(n) asm volatile("s_waitcnt lgkmcnt(" #n ")" ::: "memory")
#define PG8_BAR __builtin_amdgcn_s_barrier()
#define PG8_SCHED __builtin_amdgcn_sched_barrier(0)
    Unit cur, nxt; int ui = 0;
    if (!S.next(0, cur)) return;
    f32x4 acc[2][2][4][2];
#pragma unroll
    for (int a = 0; a < 2; ++a)
#pragma unroll
        for (int b = 0; b < 2; ++b)
#pragma unroll
            for (int m = 0; m < 4; ++m)
#pragma unroll
                for (int n = 0; n < 2; ++n) acc[a][b][m][n] = (f32x4){0.f, 0.f, 0.f, 0.f};
    bf16x8 At[4][2], B0[2][2], B1[2][2];
    const char* cA = (const char*)g.A + (size_t)cur.pm * tstepA; const char* cB = (const char*)g.Bt + (size_t)cur.pn * tstepB;
    S.a_ready(cur);
    if constexpr (SP2) {
        PG8_STAGE(PG8_SB(0, 0), cB, voffB); PG8_STAGE(PG8_SB(0, 1), cB + hstepB, voffB); PG8_STAGE(PG8_SA(0, 0), cA, voffA); PG8_STAGE(PG8_SA(0, 1), cA + hstepA, voffA);
        if (wr == 1) PG8_BAR;
        PG8_WAIT_V(2); PG8_BAR;
        PG8_STAGE(PG8_SB(1, 0), cB + kstep, voffB); PG8_STAGE(PG8_SA(1, 0), cA + kstep, voffA); PG8_STAGE(PG8_SB(1, 1), cB + hstepB + kstep, voffB);
        PG8_WAIT_V(6); PG8_BAR;
    } else {
        PG8_STAGE(PG8_SB(0, 0), cB, voffB); PG8_STAGE(PG8_SA(0, 0), cA, voffA); PG8_STAGE(PG8_SB(0, 1), cB + hstepB, voffB); PG8_STAGE(PG8_SA(0, 1), cA + hstepA, voffA);
        if (wr == 1) PG8_BAR;
        PG8_WAIT_V(4); PG8_BAR;
        PG8_STAGE(PG8_SB(1, 0), cB + kstep, voffB); PG8_STAGE(PG8_SA(1, 0), cA + kstep, voffA); PG8_STAGE(PG8_SB(1, 1), cB + hstepB + kstep, voffB);
        PG8_WAIT_V(6); PG8_BAR;
    }
    for (;;) {
        const bool has_next = S.next(ui + 1, nxt);
        const char* nA = has_next ? (const char*)g.A + (size_t)nxt.pm * tstepA : cA; const char* nB = has_next ? (const char*)g.Bt + (size_t)nxt.pn * tstepB : cB;
        for (int t = 0; t < nt; t += 2) {
            const bool last = (t == nt - 2);
            const char* a1 = cA + (size_t)(t + 1) * kstep;
            const char* a2 = last ? nA : cA + (size_t)(t + 2) * kstep; const char* b2 = last ? nB : cB + (size_t)(t + 2) * kstep;
            const char* a3 = a2 + kstep; const char* b3 = b2 + kstep;
            if (last && has_next) S.a_ready(nxt);
            if constexpr (SP2) {
            PG8_LDB(B0, 0, 0); PG8_LDB(B1, 0, 1); PG8_SCHED; PG8_LDA(At, 0, 0); PG8_STAGE(PG8_SA(1, 1), a1 + hstepA, voffA);
            PG8_WAIT_V(8); PG8_WAIT_L(0); PG8_BAR; PG8_MMA(0, 0, At, B0); PG8_MMA(0, 1, At, B1); PG8_BAR; PG8_SCHED;
            PG8_LDA(At, 0, 1); PG8_STAGE(PG8_SB(0, 0), b2, voffB); PG8_STAGE(PG8_SB(0, 1), b2 + hstepB, voffB); PG8_STAGE(PG8_SA(0, 0), a2, voffA);
            PG8_WAIT_V(8); PG8_WAIT_L(0); PG8_BAR; PG8_MMA(1, 0, At, B0); PG8_MMA(1, 1, At, B1); PG8_BAR; PG8_SCHED;
            PG8_LDB(B0, 1, 0); PG8_LDB(B1, 1, 1); PG8_SCHED; PG8_LDA(At, 1, 0); PG8_STAGE(PG8_SA(0, 1), a2 + hstepA, voffA);
            PG8_WAIT_V(8); PG8_WAIT_L(0); PG8_BAR; PG8_MMA(0, 0, At, B0); PG8_MMA(0, 1, At, B1); PG8_BAR; PG8_SCHED;
            PG8_LDA(At, 1, 1); PG8_STAGE(PG8_SB(1, 0), b3, voffB); PG8_STAGE(PG8_SB(1, 1), b3 + hstepB, voffB); PG8_STAGE(PG8_SA(1, 0), a3, voffA);
            PG8_WAIT_V(8); PG8_WAIT_L(0); PG8_BAR; PG8_MMA(1, 0, At, B0); PG8_MMA(1, 1, At, B1); PG8_BAR; PG8_SCHED;
            } else {
            PG8_LDB(B0, 0, 0); PG8_SCHED; PG8_LDA(At, 0, 0); PG8_STAGE(PG8_SA(1, 1), a1 + hstepA, voffA);
            PG8_WAIT_L(8); PG8_BAR; PG8_WAIT_L(0); PG8_MMA(0, 0, At, B0); PG8_BAR; PG8_SCHED;
            PG8_LDB(B1, 0, 1); PG8_STAGE(PG8_SB(0, 0), b2, voffB);
            PG8_BAR; PG8_WAIT_L(0); PG8_MMA(0, 1, At, B1); PG8_BAR;
            PG8_LDA(At, 0, 1); PG8_STAGE(PG8_SA(0, 0), a2, voffA);
            PG8_BAR; PG8_WAIT_L(0); PG8_MMA(1, 0, At, B0); PG8_BAR; PG8_SCHED;
            PG8_STAGE(PG8_SB(0, 1), b2 + hstepB, voffB);
            PG8_WAIT_V(6); PG8_BAR; PG8_MMA(1, 1, At, B1); PG8_BAR;
            PG8_LDB(B0, 1, 0); PG8_SCHED; PG8_LDA(At, 1, 0); PG8_STAGE(PG8_SA(0, 1), a2 + hstepA, voffA);
            PG8_WAIT_L(8); PG8_BAR; PG8_WAIT_L(0); PG8_MMA(0, 0, At, B0); PG8_BAR; PG8_SCHED;
            PG8_LDB(B1, 1, 1); PG8_STAGE(PG8_SB(1, 0), b3, voffB);
            PG8_BAR; PG8_WAIT_L(0); PG8_MMA(0, 1, At, B1); PG8_BAR;
            PG8_LDA(At, 1, 1); PG8_STAGE(PG8_SA(1, 0), a3, voffA);
            PG8_BAR; PG8_WAIT_L(0); PG8_MMA(1, 0, At, B0); PG8_BAR; PG8_SCHED;
            PG8_STAGE(PG8_SB(1, 1), b3 + hstepB, voffB);
            PG8_WAIT_V(6); PG8_BAR; PG8_MMA(1, 1, At, B1); PG8_BAR;
            }
        }
        if constexpr (ALIGN_EPI) { if (wr == 0) PG8_BAR; }
        if constexpr (!Epi::AFTER_DRAIN) { E(acc, cur, wr, wc, fr, fq); S.done(cur); }
        if (!has_next) break;
#pragma unroll
        for (int a = 0; a < 2; ++a)
#pragma unroll
            for (int b = 0; b < 2; ++b)
#pragma unroll
                for (int m = 0; m < 4; ++m)
#pragma unroll
                    for (int n = 0; n < 2; ++n) acc[a][b][m][n] = (f32x4){0.f, 0.f, 0.f, 0.f};
        cur = nxt; cA = nA; cB = nB; ++ui;
        if constexpr (ALIGN_EPI) { if (wr == 1) PG8_BAR; }
    }
    PG8_WAIT_V(0);
    if constexpr (!ALIGN_EPI) { if (wr == 0) PG8_BAR; }
    PG8_BAR;
    if constexpr (Epi::AFTER_DRAIN) { E.fused(acc, cur, wr, wc, fr, fq, lds, wid, lane); S.done(cur); }
#undef PG8_SA
#undef PG8_SB
#undef PG8_STAGE
#undef PG8_LDA
#undef PG8_LDB
#undef PG8_MMA
#undef PG8_WAIT_V
#undef PG8_WAIT_L
#undef PG8_BAR
#undef PG8_SCHED
}
}
namespace att {
typedef unsigned short bf16_t;
using bf16x8 = __attribute__((ext_vector_type(8))) short;
using s16x4  = __attribute__((ext_vector_type(4))) short;
using f32x16 = __attribute__((ext_vector_type(16))) float;
using u32x4  = __attribute__((ext_vector_type(4))) unsigned;
constexpr int DV = 128, NW = 8, QBLK = 32, KVBLK = 64;
constexpr float THR = 8.f;
constexpr int SHM_V = KVBLK * DV * 2;
template <int DQK> struct Cfg {
    static constexpr int SHM_K = KVBLK * DQK * 2, KROWB = DQK * 2, NCK = DQK / 64, C8 = DQK / 8, ND0 = DQK / 16;
    static constexpr float SCALE = (DQK == 128) ? 0.088388347648318440f : 0.072168783648703220f;
    static constexpr int LDS_BYTES = 2 * SHM_V + 2 * SHM_K + NW * 64 * 4;
};
#define ATT_SBAR() __builtin_amdgcn_sched_barrier(0)
__device__ __forceinline__ int crow(int r, int hi) { return (r & 3) + 8 * (r >> 2) + 4 * hi; }
__device__ __forceinline__ unsigned cvtpk(float lo, float hi) { unsigned r; asm volatile("v_cvt_pk_bf16_f32 %0, %1, %2" : "=v"(r) : "v"(lo), "v"(hi)); return r; }
template <int DQK> __device__ __forceinline__ int kswz(int row, int colB) {
    const int key = (DQK == 128) ? (row & 7) : ((row >> 1) & 7);
    return row * (DQK * 2) + (colB ^ (key << 4));
}
template <int DQK> __device__ __forceinline__ void partialSM(f32x16& p0, f32x16& p1, float& m_reg, float& mn, float& alpha) {
    constexpr float SCALE = Cfg<DQK>::SCALE, C = SCALE * 1.4426950408889634f;
    float pmax = p0[0];
#pragma unroll
    for (int r = 1; r < 16; ++r) pmax = fmaxf(pmax, p0[r]);
#pragma unroll
    for (int r = 0; r < 16; ++r) pmax = fmaxf(pmax, p1[r]);
    { auto rr = __builtin_amdgcn_permlane32_swap(__float_as_uint(pmax), __float_as_uint(pmax), false, false);
      pmax = fmaxf(__uint_as_float(rr[0]), __uint_as_float(rr[1])); }
    if (__builtin_expect(__all(pmax - m_reg <= THR / SCALE), 1)) { mn = m_reg; alpha = 1.f; }
    else { mn = fmaxf(m_reg, pmax); alpha = __builtin_amdgcn_exp2f((m_reg - mn) * C); m_reg = mn; }
    const float mnC = -mn * C;
#pragma unroll
    for (int r = 0; r < 16; ++r) p0[r] = fmaf(p0[r], C, mnC);
#pragma unroll
    for (int r = 0; r < 16; ++r) p1[r] = fmaf(p1[r], C, mnC);
#pragma unroll
    for (int r = 0; r < 16; ++r) p0[r] = __builtin_amdgcn_exp2f(p0[r]);
}
__device__ __forceinline__ void finishSM(f32x16& p0, f32x16& p1, float alpha, float& l_reg, bf16x8& pa0, bf16x8& pa1, bf16x8& pa2, bf16x8& pa3) {
#pragma unroll
    for (int r = 0; r < 16; ++r) p1[r] = __builtin_amdgcn_exp2f(p1[r]);
    float ps = 0;
#pragma unroll
    for (int r = 0; r < 16; ++r) ps += p0[r];
#pragma unroll
    for (int r = 0; r < 16; ++r) ps += p1[r];
    { auto rr = __builtin_amdgcn_permlane32_swap(__float_as_uint(ps), __float_as_uint(ps), false, false);
      ps = __uint_as_float(rr[0]) + __uint_as_float(rr[1]); }
    l_reg = l_reg * alpha + ps;
#define ATT_PK4(P, BASE, OUT) do { unsigned a0 = cvtpk(P[BASE + 0], P[BASE + 1]), a1 = cvtpk(P[BASE + 2], P[BASE + 3]);   \
    unsigned b0 = cvtpk(P[BASE + 4], P[BASE + 5]), b1 = cvtpk(P[BASE + 6], P[BASE + 7]);                              \
    auto r0 = __builtin_amdgcn_permlane32_swap(a0, b0, false, false); auto r1 = __builtin_amdgcn_permlane32_swap(a1, b1, false, false); \
    u32x4 w = {r0[0], r1[0], r0[1], r1[1]}; OUT = *reinterpret_cast<bf16x8*>(&w); } while (0)
    ATT_PK4(p0, 0, pa0); ATT_PK4(p0, 8, pa1); ATT_PK4(p1, 0, pa2); ATT_PK4(p1, 8, pa3);
#undef ATT_PK4
}
template <int DQK> __device__ __forceinline__ void qkt(f32x16& p0, f32x16& p1, const char* Ks, const bf16x8* qr, int r32, int hi) {
    p0 = f32x16{}; p1 = f32x16{};
#pragma unroll
    for (int d0 = 0; d0 < Cfg<DQK>::ND0; ++d0) { const int cb = (d0 * 16 + hi * 8) * 2;
        bf16x8 b0 = *reinterpret_cast<const bf16x8*>(Ks + kswz<DQK>(r32, cb));
        bf16x8 b1 = *reinterpret_cast<const bf16x8*>(Ks + kswz<DQK>(32 + r32, cb));
        p0 = __builtin_amdgcn_mfma_f32_32x32x16_bf16(b0, qr[d0], p0, 0, 0, 0);
        p1 = __builtin_amdgcn_mfma_f32_32x32x16_bf16(b1, qr[d0], p1, 0, 0, 0); }
}
__device__ __forceinline__ int v_st(int k, int c) { const int kk = (k & ~0xC) | ((k & 4) << 1) | ((k & 8) >> 1); return ((kk >> 3) * 4 + (c >> 5)) * 512 + ((kk & 7) * 32 + (c & 31)) * 2; }
__device__ __forceinline__ int v_rd_base(int lane) { return ((lane & 3) << 3) | (((lane >> 2) & 3) << 6) | (((lane >> 4) & 1) << 5) | (((lane >> 5) & 1) << 8); }
constexpr int v_rd_off(int d0, int ks, int half) { return d0 * 512 + ks * 4096 + half * 2048; }
template <int OFF> __device__ __forceinline__ s16x4 tr_read(int vb) {
    s16x4 r; asm volatile("ds_read_b64_tr_b16 %0, %1 offset:%2" : "=&v"(r) : "v"(vb), "i"(OFF) : "memory"); return r;
}
template <int D0> __device__ __forceinline__ void pv_one(f32x16& od, int vb, bf16x8 pa0, bf16x8 pa1, bf16x8 pa2, bf16x8 pa3) {
    const s16x4 l0 = tr_read<v_rd_off(D0, 0, 0)>(vb), h0 = tr_read<v_rd_off(D0, 0, 1)>(vb), l1 = tr_read<v_rd_off(D0, 1, 0)>(vb), h1 = tr_read<v_rd_off(D0, 1, 1)>(vb);
    const s16x4 l2 = tr_read<v_rd_off(D0, 2, 0)>(vb), h2 = tr_read<v_rd_off(D0, 2, 1)>(vb), l3 = tr_read<v_rd_off(D0, 3, 0)>(vb), h3 = tr_read<v_rd_off(D0, 3, 1)>(vb);
    asm volatile("s_waitcnt lgkmcnt(0)" ::: "memory"); ATT_SBAR();
#define ATT_PK(L, H) (bf16x8){L[0], L[1], L[2], L[3], H[0], H[1], H[2], H[3]}
    od = __builtin_amdgcn_mfma_f32_32x32x16_bf16(pa0, ATT_PK(l0, h0), od, 0, 0, 0);
    od = __builtin_amdgcn_mfma_f32_32x32x16_bf16(pa1, ATT_PK(l1, h1), od, 0, 0, 0);
    od = __builtin_amdgcn_mfma_f32_32x32x16_bf16(pa2, ATT_PK(l2, h2), od, 0, 0, 0);
    od = __builtin_amdgcn_mfma_f32_32x32x16_bf16(pa3, ATT_PK(l3, h3), od, 0, 0, 0);
#undef ATT_PK
}
__device__ __forceinline__ void pv_d0(f32x16* o, int vb, bf16x8 pa0, bf16x8 pa1, bf16x8 pa2, bf16x8 pa3) {
    pv_one<0>(o[0], vb, pa0, pa1, pa2, pa3); pv_one<1>(o[1], vb, pa0, pa1, pa2, pa3); pv_one<2>(o[2], vb, pa0, pa1, pa2, pa3); pv_one<3>(o[3], vb, pa0, pa1, pa2, pa3);
}
template <int DQK, int LDQ, int LDK, int LDV, int LDO, int SDEPTH>
__device__ __forceinline__ void attn_body(const bf16_t* __restrict__ Qb, const bf16_t* __restrict__ Kh, const bf16_t* __restrict__ Vh, bf16_t* __restrict__ Ob, int seq, char* lds, int tid_in) {
    using C_ = Cfg<DQK>;
    constexpr int SHM_K = C_::SHM_K, NCK = C_::NCK, C8 = C_::C8, ND0 = C_::ND0;
    int tid_ = tid_in; asm volatile("" : "+v"(tid_));
    const int tid = tid_, wid = tid >> 6, lane = tid & 63, r32 = lane & 31, hi = lane >> 5;
    char* V_lds = lds; char* K_lds = lds + 2 * SHM_V;
    float* ws = (float*)(lds + 2 * SHM_V + 2 * SHM_K) + wid * 64; float* li_l = ws; float* al_l = ws + 32;
    float m_reg = -1e30f, l_reg = 0; f32x16 o[4] = {}; bf16x8 qr[ND0];
    const bf16_t* Qw = Qb + (long)(wid * QBLK + r32) * LDQ + hi * 8;
#pragma unroll
    for (int d0 = 0; d0 < ND0; ++d0) qr[d0] = *reinterpret_cast<const bf16x8*>(Qw + d0 * 16);
    const int sr = tid >> 4, sc = (tid & 15) * 8, vst0 = v_st(sr, sc), vst1 = v_st(32 + sr, sc);
    int krow[NCK], kcol[NCK];
#pragma unroll
    for (int i = 0; i < NCK; ++i) { const int ci = tid + 512 * i; krow[i] = ci / C8; kcol[i] = (ci % C8) * 8; }
    const int vb0 = (int)(uintptr_t)V_lds + v_rd_base(lane);
    struct { bf16x8 vs0, vs1, ks[NCK]; } sr_[SDEPTH];
#define ATT_SLOAD(i, k0) do { sr_[i].vs0 = *reinterpret_cast<const bf16x8*>(&Vh[(long)((k0) + sr) * LDV + sc]); sr_[i].vs1 = *reinterpret_cast<const bf16x8*>(&Vh[(long)((k0) + 32 + sr) * LDV + sc]); \
    _Pragma("unroll") for (int c_ = 0; c_ < NCK; ++c_) sr_[i].ks[c_] = *reinterpret_cast<const bf16x8*>(&Kh[(long)((k0) + krow[c_]) * LDK + kcol[c_]]); } while (0)
#define ATT_SWRITE(b, i) do { *(bf16x8*)(V_lds + (b) * SHM_V + vst0) = sr_[i].vs0; *(bf16x8*)(V_lds + (b) * SHM_V + vst1) = sr_[i].vs1; \
    _Pragma("unroll") for (int c_ = 0; c_ < NCK; ++c_) *(bf16x8*)(K_lds + (b) * SHM_K + kswz<DQK>(krow[c_], kcol[c_] * 2)) = sr_[i].ks[c_]; } while (0)
#define ATT_SWAIT() do { if constexpr (SDEPTH == 2) { if constexpr (NCK == 2) asm volatile("s_waitcnt vmcnt(4)" ::: "memory"); else asm volatile("s_waitcnt vmcnt(5)" ::: "memory"); } else asm volatile("s_waitcnt vmcnt(0)" ::: "memory"); } while (0)
#define ATT_RESC(a) do { if (__any((a) < 1.f)) { if (hi == 0) al_l[r32] = (a); asm volatile("s_waitcnt lgkmcnt(0)" ::: "memory"); \
    _Pragma("unroll") for (int d = 0; d < 4; ++d) _Pragma("unroll") for (int r = 0; r < 16; ++r) o[d][r] *= al_l[crow(r, hi)]; } } while (0)
    f32x16 pA0, pA1, pB0, pB1; float mnA, mnB, alA, alB; bf16x8 pa0, pa1, pa2, pa3; const int NT = seq / KVBLK;
    constexpr int SE = 0, SO = SDEPTH - 1;
    ATT_SLOAD(SE, 0); asm volatile("s_waitcnt vmcnt(0)" ::: "memory"); ATT_SWRITE(0, SE); __syncthreads();
    qkt<DQK>(pA0, pA1, K_lds, qr, r32, hi); partialSM<DQK>(pA0, pA1, m_reg, mnA, alA);
    ATT_SLOAD(SO, KVBLK); if constexpr (SDEPTH == 2) { if (2 < NT) ATT_SLOAD(SE, 2 * KVBLK); }
    ATT_SWAIT(); ATT_SWRITE(1, SO); __syncthreads();
    for (int j = 1; j + 1 < NT; j += 2) {
        ATT_SBAR(); qkt<DQK>(pB0, pB1, K_lds + SHM_K, qr, r32, hi);
        finishSM(pA0, pA1, alA, l_reg, pa0, pa1, pa2, pa3); ATT_SBAR();
        ATT_SLOAD(SO, (j + SDEPTH) * KVBLK); ATT_SBAR();
        pv_d0(o, vb0, pa0, pa1, pa2, pa3); partialSM<DQK>(pB0, pB1, m_reg, mnB, alB);
        __syncthreads(); ATT_SWAIT(); ATT_SWRITE(0, SE);
        ATT_RESC(alB); __syncthreads();
        ATT_SBAR(); qkt<DQK>(pA0, pA1, K_lds, qr, r32, hi);
        finishSM(pB0, pB1, alB, l_reg, pa0, pa1, pa2, pa3); ATT_SBAR();
        if (SDEPTH == 1 || j + 3 < NT) ATT_SLOAD(SE, (j + 1 + SDEPTH) * KVBLK); ATT_SBAR();
        pv_d0(o, vb0 + (int)SHM_V, pa0, pa1, pa2, pa3); partialSM<DQK>(pA0, pA1, m_reg, mnA, alA);
        __syncthreads(); ATT_SWAIT(); ATT_SWRITE(1, SO);
        ATT_RESC(alA); __syncthreads();
    }
    ATT_SBAR(); qkt<DQK>(pB0, pB1, K_lds + SHM_K, qr, r32, hi);
    finishSM(pA0, pA1, alA, l_reg, pa0, pa1, pa2, pa3); ATT_SBAR();
    pv_d0(o, vb0, pa0, pa1, pa2, pa3); partialSM<DQK>(pB0, pB1, m_reg, mnB, alB);
    __syncthreads(); ATT_RESC(alB);
    finishSM(pB0, pB1, alB, l_reg, pa0, pa1, pa2, pa3); ATT_SBAR();
    pv_d0(o, vb0 + (int)SHM_V, pa0, pa1, pa2, pa3);
    if (hi == 0) li_l[r32] = l_reg;
    asm volatile("s_waitcnt lgkmcnt(0)" ::: "memory");
    __syncthreads();
    float rli[16];
#pragma unroll
    for (int r = 0; r < 16; ++r) rli[r] = __builtin_amdgcn_rcpf(li_l[crow(r, hi)]);
    unsigned short* stg = (unsigned short*)(lds + wid * 8192);
#pragma unroll
    for (int r = 0; r < 16; ++r) { const int orow = crow(r, hi);
#pragma unroll
        for (int d0 = 0; d0 < 4; ++d0) { const unsigned w = cvtpk(o[d0][r] * rli[r], 0.f); stg[orow * 128 + d0 * 32 + r32] = (unsigned short)(w & 0xffffu); } }
    asm volatile("s_waitcnt lgkmcnt(0)" ::: "memory");
    bf16_t* Ow = Ob + (long)(wid * QBLK) * LDO;
#pragma unroll
    for (int i = 0; i < 8; ++i) { const int id = lane + 64 * i, row = id >> 4, c16 = id & 15;
        const u32x4 v = *(const u32x4*)((const char*)stg + row * 256 + c16 * 16);
        *(u32x4*)(Ow + (long)row * LDO + c16 * 8) = v; }
    asm volatile("s_waitcnt lgkmcnt(0)" ::: "memory");
    __syncthreads();
#undef ATT_SLOAD
#undef ATT_SWRITE
#undef ATT_SWAIT
#undef ATT_RESC
}

template <int DQK, int LDQ, int LDK, int LDV, int LDO>
__device__ __forceinline__ void attn_body1(const bf16_t* __restrict__ Qb, const bf16_t* __restrict__ Kh, const bf16_t* __restrict__ Vh, bf16_t* __restrict__ Ob, int seq, char* lds, int tid_in) {
    using C_ = Cfg<DQK>;
    constexpr int SHM_K = C_::SHM_K, NCK = C_::NCK, C8 = C_::C8, ND0 = C_::ND0;
    int tid_ = tid_in; asm volatile("" : "+v"(tid_));
    const int tid = tid_, wid = tid >> 6, lane = tid & 63, r32 = lane & 31, hi = lane >> 5;
    char* V_lds = lds; char* K_lds = lds + 2 * SHM_V;
    float* ws = (float*)(lds + 2 * SHM_V + 2 * SHM_K) + wid * 64; float* li_l = ws; float* al_l = ws + 32;
    float m_reg = -1e30f, l_reg = 0; f32x16 o[4] = {}; bf16x8 qr[ND0];
    const bf16_t* Qw = Qb + (long)(wid * QBLK + r32) * LDQ + hi * 8;
#pragma unroll
    for (int d0 = 0; d0 < ND0; ++d0) qr[d0] = *reinterpret_cast<const bf16x8*>(Qw + d0 * 16);
    const int sr = tid >> 4, sc = (tid & 15) * 8, vst0 = v_st(sr, sc), vst1 = v_st(32 + sr, sc);
    int krow[NCK], kcol[NCK];
#pragma unroll
    for (int i = 0; i < NCK; ++i) { const int ci = tid + 512 * i; krow[i] = ci / C8; kcol[i] = (ci % C8) * 8; }
    const int vb0 = (int)(uintptr_t)V_lds + v_rd_base(lane);
    bf16x8 vs0, vs1, ks[NCK];
#define ATT1_SLOAD(k0) do { vs0 = *reinterpret_cast<const bf16x8*>(&Vh[(long)((k0) + sr) * LDV + sc]); vs1 = *reinterpret_cast<const bf16x8*>(&Vh[(long)((k0) + 32 + sr) * LDV + sc]); \
    _Pragma("unroll") for (int c_ = 0; c_ < NCK; ++c_) ks[c_] = *reinterpret_cast<const bf16x8*>(&Kh[(long)((k0) + krow[c_]) * LDK + kcol[c_]]); } while (0)
#define ATT1_SWRITE(b) do { *(bf16x8*)(V_lds + (b) * SHM_V + vst0) = vs0; *(bf16x8*)(V_lds + (b) * SHM_V + vst1) = vs1; \
    _Pragma("unroll") for (int c_ = 0; c_ < NCK; ++c_) *(bf16x8*)(K_lds + (b) * SHM_K + kswz<DQK>(krow[c_], kcol[c_] * 2)) = ks[c_]; } while (0)
    const int NT = seq / KVBLK;
    ATT1_SLOAD(0); asm volatile("s_waitcnt vmcnt(0)" ::: "memory"); ATT1_SWRITE(0); __syncthreads();
    for (int j = 0; j < NT; ++j) {
        const int b = j & 1;
        if (j + 1 < NT) ATT1_SLOAD((j + 1) * KVBLK);
        ATT_SBAR();
        f32x16 p0, p1; float mn, alpha; bf16x8 pa0, pa1, pa2, pa3;
        qkt<DQK>(p0, p1, K_lds + b * SHM_K, qr, r32, hi);
        partialSM<DQK>(p0, p1, m_reg, mn, alpha);
        if (__any(alpha < 1.f)) { if (hi == 0) al_l[r32] = alpha; asm volatile("s_waitcnt lgkmcnt(0)" ::: "memory");
#pragma unroll
            for (int d = 0; d < 4; ++d)
#pragma unroll
                for (int r = 0; r < 16; ++r) o[d][r] *= al_l[crow(r, hi)]; }
        finishSM(p0, p1, alpha, l_reg, pa0, pa1, pa2, pa3); ATT_SBAR();
        pv_d0(o, vb0 + b * (int)SHM_V, pa0, pa1, pa2, pa3);
        if (j + 1 < NT) { ATT1_SWRITE(b ^ 1); }
        __syncthreads();
    }
    if (hi == 0) li_l[r32] = l_reg;
    asm volatile("s_waitcnt lgkmcnt(0)" ::: "memory");
    __syncthreads();
    float rli[16];
#pragma unroll
    for (int r = 0; r < 16; ++r) rli[r] = __builtin_amdgcn_rcpf(li_l[crow(r, hi)]);
    unsigned short* stg = (unsigned short*)(lds + wid * 8192);
#pragma unroll
    for (int r = 0; r < 16; ++r) { const int orow = crow(r, hi);
#pragma unroll
        for (int d0 = 0; d0 < 4; ++d0) { const unsigned w = cvtpk(o[d0][r] * rli[r], 0.f); stg[orow * 128 + d0 * 32 + r32] = (unsigned short)(w & 0xffffu); } }
    asm volatile("s_waitcnt lgkmcnt(0)" ::: "memory");
    bf16_t* Ow = Ob + (long)(wid * QBLK) * LDO;
#pragma unroll
    for (int i = 0; i < 8; ++i) { const int id = lane + 64 * i, row = id >> 4, c16 = id & 15;
        const u32x4 v = *(const u32x4*)((const char*)stg + row * 256 + c16 * 16);
        *(u32x4*)(Ow + (long)row * LDO + c16 * 8) = v; }
    asm volatile("s_waitcnt lgkmcnt(0)" ::: "memory");
    __syncthreads();
#undef ATT1_SLOAD
#undef ATT1_SWRITE
}
}
constexpr int DM = 2048, NBATCH = 2, SEQ = 4096, CTX = 256, RB = SEQ + CTX  , MROWS = NBATCH * RB  ;
constexpr int NMOD = 6 * DM, NEXP = 16384;
constexpr float EPS = 1e-6f;
constexpr int NWAVES = 8, NTHREADS = 512;
constexpr size_t MiB = 1u << 20;
constexpr size_t WS_CTL = 0, CTL_ZERO_BYTES = 64 * 1024;
constexpr size_t WS_MOD = 1 * MiB;
constexpr size_t WS_ROPE = 2 * MiB;
constexpr size_t WS_SMALL = 3 * MiB;
constexpr int SM_N1G = 0, SM_N2G = 8192, SM_AQG = 16384, SM_AKG = 16384 + 384, SM_CW = 16384 + 768, SM_CB = SM_CW + 6144, SM_CQG = SM_CB + 2048, SM_CKG = SM_CQG + 256, SM_END = SM_CKG + 256;
constexpr size_t WS_PTRS = 3 * MiB + 512 * 1024;
constexpr size_t WS_XW = 4 * MiB;
constexpr size_t WS_H = 72 * MiB;
constexpr size_t WS_P = 106 * MiB;
constexpr size_t WS_QRAW = 174 * MiB;
constexpr size_t WS_KVRAW = 200 * MiB;
constexpr size_t WS_Q = 234 * MiB;
constexpr size_t WS_K = 268 * MiB;
constexpr size_t WS_V = 294 * MiB;
constexpr size_t WS_CAT = 311 * MiB;
constexpr size_t WS_PQ = 345 * MiB;
constexpr size_t WS_IDX = 379 * MiB;
constexpr size_t WS_GATE = 384 * MiB;
constexpr size_t WS_WIN = 389 * MiB;
constexpr size_t WS_WUQ = 421 * MiB;
constexpr size_t WS_WUKV = 424 * MiB;
constexpr size_t WS_WEO = 426 * MiB;
constexpr size_t WS_WQKV = 442 * MiB;
constexpr size_t WS_WCO = 466 * MiB;
constexpr size_t WS_WPQ = 482 * MiB;
constexpr size_t WS_SUBK = 514 * MiB;
#ifndef TAB_FP4
#define TAB_FP4 1
#endif
#if TAB_FP4
constexpr int ROWB = 1024;
#else
constexpr int ROWB = 1536;
#endif
constexpr size_t WS_U = 516 * MiB;
constexpr size_t WS_VT = 644 * MiB;
constexpr size_t WS_USC = 772 * MiB;
constexpr size_t WS_VSC = 773 * MiB;
constexpr size_t WS_XQ = 810 * MiB;
constexpr size_t WS_XS = 828 * MiB;
constexpr size_t WS_PART = 774 * MiB;
constexpr size_t WS_END = 834 * MiB;
#ifndef EXP_SLICED
#define EXP_SLICED 1
#endif
constexpr int CW_BAR = 4096;
constexpr int LDS_MISC = 131072 + 8192;
constexpr int LDS_BYTES = 147456;

#define LAS __attribute__((address_space(3)))
typedef unsigned short bf16_t;
typedef float f32x4 __attribute__((ext_vector_type(4)));
typedef unsigned u32x4 __attribute__((ext_vector_type(4)));
typedef unsigned u32x2 __attribute__((ext_vector_type(2)));
typedef short bf16x8 __attribute__((ext_vector_type(8)));
typedef float f32x16 __attribute__((ext_vector_type(16)));
typedef __bf16 bf16x2_t __attribute__((ext_vector_type(2)));
typedef float f32x2 __attribute__((ext_vector_type(2)));
typedef _Float16 h2_t __attribute__((ext_vector_type(2)));
typedef float f32x32 __attribute__((ext_vector_type(32)));
typedef unsigned u32x6 __attribute__((ext_vector_type(6)));

__device__ __forceinline__ unsigned f2bf(float f) { unsigned u = __builtin_bit_cast(unsigned, f); return (u + 0x7fffu + ((u >> 16) & 1u)) >> 16; }
__device__ __forceinline__ unsigned pk2(float lo, float hi) { return f2bf(lo) | (f2bf(hi) << 16); }
__device__ __forceinline__ float bf_lo(unsigned w) { return __builtin_bit_cast(float, w << 16); }
__device__ __forceinline__ float bf_hi(unsigned w) { return __builtin_bit_cast(float, w & 0xffff0000u); }
__device__ __forceinline__ float bf2f(bf16_t h) { return __builtin_bit_cast(float, (unsigned)h << 16); }
__device__ __forceinline__ float wave_sum(float v) {
#pragma unroll
    for (int o = 1; o < 64; o <<= 1) v += __shfl_xor(v, o);
    return v;
}
#define DPP_ADD(v, ctrl) ((v) + __builtin_bit_cast(float, __builtin_amdgcn_update_dpp(0, __builtin_bit_cast(int, (v)), (ctrl), 0xf, 0xf, true)))
__device__ __forceinline__ float wave_sum_dpp(float v) {
    v = DPP_ADD(v, 0xB1);
    v = DPP_ADD(v, 0x4E);
    v = DPP_ADD(v, 0x141);
    v = DPP_ADD(v, 0x140);
    const int vi = __builtin_bit_cast(int, v);
    const float s0 = __builtin_bit_cast(float, __builtin_amdgcn_readlane(vi, 0)), s1 = __builtin_bit_cast(float, __builtin_amdgcn_readlane(vi, 16));
    const float s2 = __builtin_bit_cast(float, __builtin_amdgcn_readlane(vi, 32)), s3 = __builtin_bit_cast(float, __builtin_amdgcn_readlane(vi, 48));
    return (s0 + s1) + (s2 + s3);
}
__device__ __forceinline__ float dot2_bf16(unsigned w, unsigned x, float acc) { return __builtin_amdgcn_fdot2_f32_bf16(__builtin_bit_cast(bf16x2_t, w), __builtin_bit_cast(bf16x2_t, x), acc, false); }
__device__ __forceinline__ float gelu_erf(float v) {
    const float av = fabsf(v), t = __builtin_amdgcn_rcpf(av * 0.2316418882f + 1.0f);
    float q = t * 0.5307027145f + (-0.7265760135f); q = q * t + 0.7107068705f; q = q * t + (-0.142248368f); q = q * t + 0.127414796f; q = q * t;
    const float e = __builtin_amdgcn_exp2f((v * v) * (-0.72134752044f));
    const float m = v * (q * e);
    return v < 0.f ? m : v - m;
}
#define XB_TMO      128
#define XB_XCNT(j)  (256  + 64 * (j))
#define XB_XSUB(j)  (1280 + 64 * (j))
#define XB_XGEN(j)  (2304 + 64 * (j))
#define XB_TOP      3328
#define XB_TOPGEN   3392
#define XCD_BAR_WORDS 3456
#define XB_SPIN_CAP (1u << 18)

__device__ __forceinline__ unsigned xb_ld(unsigned* p)              { return __hip_atomic_load(p, __ATOMIC_RELAXED, __HIP_MEMORY_SCOPE_AGENT); }
__device__ __forceinline__ unsigned xb_add(unsigned* p, unsigned v) { return __hip_atomic_fetch_add(p, v, __ATOMIC_RELAXED, __HIP_MEMORY_SCOPE_AGENT); }
__device__ __forceinline__ unsigned xb_xcc_id() { return (unsigned)__builtin_amdgcn_s_getreg((3 << 11) | 20) & 0xFu; }
#define XB_SPIN(cond, bar) do { unsigned _sp = 0; while (cond) { __builtin_amdgcn_s_sleep(1); \
    if ((++_sp & 255u) == 0u) { if (xb_ld(&(bar)[XB_TMO])) break; if (_sp > XB_SPIN_CAP) { atomicAdd(&(bar)[XB_TMO], 1u); break; } } } } while (0)

struct XcdBarrier {
    unsigned* bar; unsigned x;
    volatile LAS unsigned* st;
};

__device__ __forceinline__ XcdBarrier xcd_barrier_post(unsigned* bar, volatile LAS unsigned* st) {
    XcdBarrier b; b.bar = bar; b.x = xb_xcc_id(); b.st = st;
    if (threadIdx.x == 0) (void)xb_add(&bar[XB_XCNT(b.x)], 1u);
    return b;
}
__device__ __forceinline__ void xcd_barrier_complete(unsigned* bar, unsigned x, unsigned& nloc, unsigned& nx) {
    const unsigned G = gridDim.x * gridDim.y * gridDim.z;
    unsigned sum, cnt, mine, sp = 0u;
    for (;;) {
        sum = 0u; cnt = 0u; mine = 0u;
#pragma unroll
        for (unsigned j = 0; j < 16; ++j) { const unsigned c = xb_ld(&bar[XB_XCNT(j)]); sum += c; cnt += (c > 0u) ? 1u : 0u; mine = (j == x) ? c : mine; }
        if (sum == G) break;
        __builtin_amdgcn_s_sleep(1);
        if ((++sp & 255u) == 0u) { if (xb_ld(&bar[XB_TMO])) break; if (sp > XB_SPIN_CAP) { atomicAdd(&bar[XB_TMO], 1u); break; } }
    }
    nloc = mine > 0u ? mine : 1u; nx = cnt > 0u ? cnt : 1u;
}

__device__ __forceinline__ void xcd_barrier(const XcdBarrier& b) {
    asm volatile("s_waitcnt vmcnt(0)" ::: "memory");
    __syncthreads();
    if (threadIdx.x == 0) {
        unsigned* bar = b.bar; unsigned bx = b.x;
        asm volatile("" : "+s"(bar), "+s"(bx));
        __builtin_amdgcn_s_waitcnt(0);
        unsigned nloc = b.st[0], nx = b.st[1];
        if (nloc == 0u) { xcd_barrier_complete(bar, bx, nloc, nx); b.st[0] = nloc; b.st[1] = nx; }
        const unsigned old = xb_add(&bar[XB_XSUB(bx)], 1u);
        const unsigned gen = old / nloc;
        if (old + 1u == (gen + 1u) * nloc) {
            __builtin_amdgcn_fence(__ATOMIC_RELEASE, "agent");
            asm volatile("s_waitcnt vmcnt(0)" ::: "memory");
            const unsigned og = xb_add(&bar[XB_TOP], 1u);
            const unsigned tg = og / nx;
            if (og + 1u == (tg + 1u) * nx) xb_add(&bar[XB_TOPGEN], 1u);
            else XB_SPIN(xb_ld(&bar[XB_TOPGEN]) == tg, bar);
            __builtin_amdgcn_fence(__ATOMIC_ACQUIRE, "agent");
            xb_add(&bar[XB_XGEN(bx)], 1u);
            asm volatile("s_waitcnt vmcnt(0)" ::: "memory");
        } else {
            XB_SPIN(xb_ld(&bar[XB_XGEN(bx)]) == gen, bar);
            __builtin_amdgcn_fence(__ATOMIC_ACQUIRE, "agent");
            asm volatile("s_waitcnt vmcnt(0)" ::: "memory");
        }
    }
    __syncthreads();
}
struct Frame {
    LAS unsigned char* lds;
    int tid, lane, wave, vcu, G, gw, NGW;
    unsigned char* ws;
};
__device__ __forceinline__ int opaque_v(int v) { asm volatile("" : "+v"(v)); return v; }
__device__ __forceinline__ int phase_tid(int wave) { int lane; asm volatile("v_mbcnt_lo_u32_b32 %0, -1, 0\n\tv_mbcnt_hi_u32_b32 %0, -1, %0" : "=v"(lane)); return wave * 64 + lane; }
__device__ __forceinline__ Frame phase_frame(const Frame& F0) { Frame F = F0; F.tid = phase_tid(F0.wave); F.lane = F.tid & 63; return F; }
__device__ __forceinline__ float swap32(float v, int lane) { auto rr = __builtin_amdgcn_permlane32_swap(__float_as_uint(v), __float_as_uint(v), false, false); return __uint_as_float(lane < 32 ? rr[1] : rr[0]); }
__device__ __forceinline__ int row_cls(int row) { const int b = row / RB, i = row - b * RB; return i < CTX ? 2 : b; }

__device__ __forceinline__ void p0_transpose_item(const float* W, int K, int N, bf16_t* WT, const float* gain, LAS float* scr, int item, int lane, bool perm_q = false) {
    const int nblk = N / 32, kb = item / nblk, nb = item % nblk, k0 = 64 * kb, n0 = 32 * nb;
    {
        const int rgp = lane >> 3, c4 = (lane & 7) * 4; f32x4 tv[8];
#pragma unroll
        for (int i = 0; i < 8; ++i) tv[i] = *(const f32x4*)(W + (size_t)(k0 + 8 * i + rgp) * N + n0 + c4);
#pragma unroll
        for (int i = 0; i < 8; ++i) { const int kk = 8 * i + rgp; f32x4 v = tv[i]; if (gain) v = v * gain[k0 + kk];
            LAS float* d = scr + kk * 33 + c4; d[0] = v.x; d[1] = v.y; d[2] = v.z; d[3] = v.w; }
    }
    asm volatile("s_waitcnt lgkmcnt(0)" ::: "memory");
    const int c = lane & 7;
#pragma unroll
    for (int j = 0; j < 4; ++j) { const int n = (lane >> 3) + 8 * j; const LAS float* s = scr + (8 * c) * 33 + n;
        u32x4 o; o.x = pk2(s[0 * 33], s[1 * 33]); o.y = pk2(s[2 * 33], s[3 * 33]); o.z = pk2(s[4 * 33], s[5 * 33]); o.w = pk2(s[6 * 33], s[7 * 33]);
        int nn = n0 + n; if (perm_q) { const int hh = nn / 192, e = nn - hh * 192; nn = (e < 128) ? hh * 128 + e : 1024 + hh * 64 + (e - 128); }
        *(u32x4*)(WT + (size_t)nn * K + k0 + 8 * c) = o; }
    asm volatile("s_waitcnt lgkmcnt(0)" ::: "memory");
}
struct TrDesc { const float* W; const float* gain; bf16_t* WT; int K, N, items; };

__device__ __forceinline__ void p0_gemv_task(Frame& F, int task, const float* ada_w, const float* ada_b, float* mod) {
    LAS float* sv = (LAS float*)F.lds; LAS float* part = (LAS float*)(F.lds + 32768);
    const int l = task / 192, n0 = (task % 192) * 64, rg = F.lane >> 4, c4 = (F.lane & 15) * 4;
    const float* Wp = ada_w + (size_t)l * DM * NMOD + n0 + c4 + (size_t)(F.wave * 256 + rg) * NMOD;
    f32x4 a0 = {0, 0, 0, 0}, a1 = a0, a2 = a0;
    for (int k = 0; k < 256; k += 32) {
        f32x4 w[8];
#pragma unroll
        for (int u = 0; u < 8; ++u) w[u] = *(const f32x4*)(Wp + (size_t)(k + 4 * u) * NMOD);
#pragma unroll
        for (int u = 0; u < 8; ++u) { const int kk = F.wave * 256 + k + 4 * u + rg; const float s0 = sv[kk], s1 = sv[2048 + kk], s2 = sv[4096 + kk];
            a0 += w[u] * s0; a1 += w[u] * s1; a2 += w[u] * s2; }
    }
    LAS float* pp = part + ((F.wave * 4 + rg) * 3) * 64 + c4;
    *(LAS f32x4*)(pp) = a0; *(LAS f32x4*)(pp + 64) = a1; *(LAS f32x4*)(pp + 128) = a2;
    __syncthreads();
    if (F.tid < 192) { const int r = F.tid >> 6, c = F.tid & 63; float s = 0.f;
#pragma unroll
        for (int q = 0; q < 32; ++q) s += part[(q * 3 + r) * 64 + c];
        mod[(size_t)(l * 3 + r) * NMOD + n0 + c] = s + ada_b[(size_t)l * NMOD + n0 + c]; }
    __syncthreads();
}

__device__ __forceinline__ void p0_prologue(Frame& F, const float* const* in) {
    unsigned char* ws = F.ws;
    {
        LAS float* sv = (LAS float*)F.lds;
        for (int i = F.tid; i < 3 * DM; i += NTHREADS) { const int r = i / DM, k = i - r * DM; const float x = (r < 2) ? in[1][r * DM + k] : in[3][k]; sv[i] = x / (1.f + __expf(-x)); }
        __syncthreads();
        for (int task = F.vcu; task < 768; task += F.G) p0_gemv_task(F, task, in[4], in[5], (float*)(ws + WS_MOD));
        __syncthreads();
    }
    {
        float* xw = (float*)(ws + WS_XW);
        for (int row = F.gw; row < MROWS; row += F.NGW) { const int b = row / RB, i = row - b * RB;
            const float* src = (i < CTX) ? in[2] + (size_t)(b * CTX + i) * DM : in[0] + (size_t)(b * SEQ + i - CTX) * DM;
            const f32x4* s4 = (const f32x4*)src + F.lane; f32x4* d4 = (f32x4*)(xw + (size_t)row * DM) + F.lane;
#pragma unroll
            for (int j = 0; j < 8; ++j) d4[64 * j] = s4[64 * j]; }
    }
    {
        float* sm = (float*)(ws + WS_SMALL); const int g = F.vcu * NTHREADS + F.tid;
        if (g < 8192) { sm[SM_N1G + g] = in[6][g]; sm[SM_N2G + g] = in[7][g]; }
        if (g < 384) { sm[SM_AQG + g] = in[13][g]; sm[SM_AKG + g] = in[14][g]; }
        if (g < 6144) sm[SM_CW + g] = in[15][g];
        if (g < 2048) sm[SM_CB + g] = in[16][g];
        if (g < 256) { sm[SM_CQG + g] = in[19][g]; sm[SM_CKG + g] = in[20][g]; }
    }
    {
        float* rc = (float*)(ws + WS_ROPE); float* ra = rc + 64 * 32 * 2;
        const int g = F.vcu * NTHREADS + F.tid;
        if (g < 64 * 32) { const int pos = g >> 5, f = g & 31; const float fr = exp2f(-(float)f * (13.287712379549449f / 32.f)); const float ang = (float)pos * fr;
            rc[2 * g] = cosf(ang); rc[2 * g + 1] = sinf(ang); }
        else if (g < 64 * 32 + 64 * 16) { const int e = g - 64 * 32, pos = e >> 4, f = e & 15; const float fr = exp2f(-(float)f * (13.287712379549449f / 16.f)); const float ang = (float)pos * fr;
            ra[2 * e] = cosf(ang); ra[2 * e + 1] = sinf(ang); }
    }
    {
        LAS float* scr = (LAS float*)(F.lds + F.wave * 16384);
        TrDesc d[16]; int nd = 0;
#pragma unroll
        for (int i = 0; i < 2; ++i) {
            d[nd++] = TrDesc{in[8] + (size_t)i * DM * 3904, nullptr, (bf16_t*)(ws + WS_WIN) + (size_t)i * 4096 * DM, DM, 3904, 32 * 122};
            d[nd++] = TrDesc{in[11] + (size_t)i * 512 * 1536, in[9] + i * 512, (bf16_t*)(ws + WS_WUQ) + (size_t)i * 1536 * 512, 512, 1536, 8 * 48};
            d[nd++] = TrDesc{in[12] + (size_t)i * 256 * 2048, in[10] + i * 256, (bf16_t*)(ws + WS_WUKV) + (size_t)i * 2048 * 256, 256, 2048, 4 * 64};
            d[nd++] = TrDesc{in[17] + (size_t)i * DM * DM, nullptr, (bf16_t*)(ws + WS_WEO) + (size_t)i * DM * DM, DM, DM, 32 * 64};
            d[nd++] = TrDesc{in[18] + (size_t)i * DM * 3072, nullptr, (bf16_t*)(ws + WS_WQKV) + (size_t)i * 3072 * DM, DM, 3072, 32 * 96};
            d[nd++] = TrDesc{in[21] + (size_t)i * DM * DM, nullptr, (bf16_t*)(ws + WS_WCO) + (size_t)i * DM * DM, DM, DM, 32 * 64};
        }
#pragma unroll
        for (int l = 0; l < 4; ++l) d[nd++] = TrDesc{in[22] + (size_t)l * DM * DM, nullptr, (bf16_t*)(ws + WS_WPQ) + (size_t)l * DM * DM, DM, DM, 32 * 64};
#pragma unroll
        for (int m = 0; m < 16; ++m) {
            for (int it = F.gw; it < d[m].items; it += F.NGW) p0_transpose_item(d[m].W, d[m].K, d[m].N, d[m].WT, d[m].gain, scr, it, F.lane, d[m].K == 512);
        }
        for (int i = F.gw * 64 + F.lane; i < 2 * 192 * DM / 8; i += F.NGW * 64) { const int li = i / (192 * DM / 8), r = i % (192 * DM / 8);
            *(u32x4*)((bf16_t*)(ws + WS_WIN) + (size_t)li * 4096 * DM + (size_t)3904 * DM + (size_t)r * 8) = (u32x4){0u, 0u, 0u, 0u}; }
    }
    {
        const size_t n_sk = (size_t)4 * 16 * 128 * 128 / 8;
        const size_t gt = (size_t)F.vcu * NTHREADS + F.tid, GT = (size_t)F.G * NTHREADS;
        for (size_t j = gt; j < n_sk; j += GT) {
            const f32x4 a = *(const f32x4*)(in[23] + j * 8), b = *(const f32x4*)(in[23] + j * 8 + 4);
            u32x4 o; o.x = pk2(a.x, a.y); o.y = pk2(a.z, a.w); o.z = pk2(b.x, b.y); o.w = pk2(b.z, b.w);
            *(u32x4*)((bf16_t*)(ws + WS_SUBK) + j * 8) = o;
        }
    }
    {
        for (int r = F.gw; r < 2 * 4 * NEXP; r += F.NGW) {
            const int tab = r / (4 * NEXP), rr = r - tab * (4 * NEXP);
#if EXP_SLICED
            const float* src = (tab ? in[25] : in[24]) + (size_t)rr * DM + F.lane * 32;
            f32x4 v[8];
#pragma unroll
            for (int q = 0; q < 8; ++q) v[q] = *(const f32x4*)(src + q * 4);
#else
            const float* src = (tab ? in[25] : in[24]) + (size_t)rr * DM + F.lane * 16;
            f32x4 v[8];
#pragma unroll
            for (int j = 0; j < 2; ++j)
#pragma unroll
                for (int q = 0; q < 4; ++q) v[j * 4 + q] = *(const f32x4*)(src + j * 1024 + q * 4);
#endif
            float am = 0.f;
#pragma unroll
            for (int q = 0; q < 8; ++q) am = fmaxf(fmaxf(am, fmaxf(fabsf(v[q].x), fabsf(v[q].y))), fmaxf(fabsf(v[q].z), fabsf(v[q].w)));
#pragma unroll
            for (int o = 1; o < 64; o <<= 1) am = fmaxf(am, __shfl_xor(am, o));
            am = fmaxf(am, 1e-30f);
#if TAB_FP4
            float ssq = 0.f;
#pragma unroll
            for (int q = 0; q < 8; ++q) ssq += (v[q].x * v[q].x + v[q].y * v[q].y) + (v[q].z * v[q].z + v[q].w * v[q].w);
#pragma unroll
            for (int o = 1; o < 64; o <<= 1) ssq += __shfl_xor(ssq, o);
            const float sig = fmaxf(sqrtf(ssq * (1.f / DM)), am * (1.f / 64.f));
            unsigned w4[4];
#if EXP_SLICED
            if (tab == 0) {
                const float delta = 0.3352f * sig, isc = 1.0f / delta;
#pragma unroll
                for (int q = 0; q < 4; ++q) { unsigned t = 0u;
#pragma unroll
                    for (int hh = 0; hh < 2; ++hh) { const f32x4 x = v[2 * q + hh] * isc;
                        const int n0 = min(max((int)floorf(x.x), -8), 7) & 15, n1 = min(max((int)floorf(x.y), -8), 7) & 15, n2 = min(max((int)floorf(x.z), -8), 7) & 15, n3 = min(max((int)floorf(x.w), -8), 7) & 15;
                        t |= ((unsigned)n0 | ((unsigned)n1 << 4) | ((unsigned)n2 << 8) | ((unsigned)n3 << 12)) << (16 * hh); }
                    w4[q] = t; }
                { const int ll = rr / NEXP, ee = rr - ll * NEXP;
                  *(u32x4*)(ws + WS_U + (size_t)ll * NEXP * ROWB + (size_t)(F.lane >> 3) * (NEXP * 128) + (size_t)ee * 128 + (F.lane & 7) * 16) = (u32x4){w4[0], w4[1], w4[2], w4[3]}; }
                if (F.lane == 0) ((float*)(ws + WS_USC))[rr] = delta;
                continue;
            }
#endif
            const float sc = 2.0f / sig;
#pragma unroll
            for (int q = 0; q < 4; ++q) { unsigned t = 0u;
                const f32x4 xa = v[2 * q] * sc, xb = v[2 * q + 1] * sc;
#define P0_C6(x) fminf(fmaxf((x), -6.f), 6.f)
                t = __builtin_amdgcn_cvt_scalef32_pk_fp4_f32(t, P0_C6(xa.x), P0_C6(xa.y), 1.0f, 0);
                t = __builtin_amdgcn_cvt_scalef32_pk_fp4_f32(t, P0_C6(xa.z), P0_C6(xa.w), 1.0f, 1);
                t = __builtin_amdgcn_cvt_scalef32_pk_fp4_f32(t, P0_C6(xb.x), P0_C6(xb.y), 1.0f, 2);
                t = __builtin_amdgcn_cvt_scalef32_pk_fp4_f32(t, P0_C6(xb.z), P0_C6(xb.w), 1.0f, 3);
#undef P0_C6
                w4[q] = t; }
#if EXP_SLICED
            { const int ll = rr / NEXP, ee = rr - ll * NEXP;
              *(u32x4*)(ws + (tab ? WS_VT : WS_U) + (size_t)ll * NEXP * ROWB + (size_t)(F.lane >> 3) * (NEXP * 128) + (size_t)ee * 128 + (F.lane & 7) * 16) = (u32x4){w4[0], w4[1], w4[2], w4[3]}; }
#else
            *(u32x4*)(ws + (tab ? WS_VT : WS_U) + (size_t)rr * ROWB + F.lane * 16) = (u32x4){w4[0], w4[1], w4[2], w4[3]};
#endif
            if (F.lane == 0) ((float*)(ws + (tab ? WS_VSC : WS_USC)))[rr] = sig * 0.5f;
#else
            const float sc = 7.5f / am;
            f32x16 a, b;
#pragma unroll
            for (int q = 0; q < 8; ++q) { const f32x4 x = v[q] * sc; a[2 * q] = x.x; b[2 * q] = x.y; a[2 * q + 1] = x.z; b[2 * q + 1] = x.w; }
            const u32x6 w = __builtin_amdgcn_cvt_scalef32_2xpk16_fp6_f32(a, b, 1.0f);
            unsigned char* dst = ws + (tab ? WS_VT : WS_U) + (size_t)rr * ROWB;
            *(u32x4*)(dst + F.lane * 16) = (u32x4){w[0], w[1], w[2], w[3]};
            *(u32x2*)(dst + 1024 + F.lane * 8) = (u32x2){w[4], w[5]};
            if (F.lane == 0) ((float*)(ws + (tab ? WS_VSC : WS_USC)))[rr] = am * (1.0f / 7.5f);
#endif
        }
    }
}

#define DPP_MOV(v, ctrl) __builtin_bit_cast(float, __builtin_amdgcn_update_dpp(0, __builtin_bit_cast(int, (v)), (ctrl), 0xf, 0xf, true))
__device__ __forceinline__ void norm_phase(const Frame& F0, const float* xw, const float* g, const float* modl  , int off_sh, int off_sc, bf16_t* H, bool lat_only, unsigned* XQ = nullptr, float* XS = nullptr) {
    const Frame F = phase_frame(F0);
    f32x4 gm[8], shv[8]; int cur_cls = -1;
    int row = F.gw; if (lat_only) while (row < MROWS && row_cls(row) == 2) row += F.NGW;
    f32x4 v[8];
    if (row < MROWS) { const f32x4* x4 = (const f32x4*)(xw + (size_t)row * DM) + F.lane;
#pragma unroll
        for (int j = 0; j < 8; ++j) v[j] = x4[64 * j]; }
    while (row < MROWS) {
        int nrow = row + F.NGW; if (lat_only) while (nrow < MROWS && row_cls(nrow) == 2) nrow += F.NGW;
        f32x4 vn[8];
        if (nrow < MROWS) { const f32x4* x4 = (const f32x4*)(xw + (size_t)nrow * DM) + F.lane;
#pragma unroll
            for (int j = 0; j < 8; ++j) vn[j] = x4[64 * j]; }
        const int cls = row_cls(row);
        if (cls != cur_cls) {
            cur_cls = cls;
            const f32x4* g4 = (const f32x4*)g + F.lane; const f32x4* sc4 = (const f32x4*)(modl + (size_t)cls * NMOD + off_sc) + F.lane; const f32x4* sh4 = (const f32x4*)(modl + (size_t)cls * NMOD + off_sh) + F.lane;
#pragma unroll
            for (int j = 0; j < 8; ++j) { gm[j] = g4[64 * j] * (sc4[64 * j] + 1.0f); shv[j] = sh4[64 * j]; }
        }
        float ss = 0.f;
#pragma unroll
        for (int j = 0; j < 8; ++j) ss += (v[j].x * v[j].x + v[j].y * v[j].y) + (v[j].z * v[j].z + v[j].w * v[j].w);
        const float rstd = 1.0f / sqrtf(wave_sum_dpp(ss) * (1.f / DM) + EPS);
        u32x2* o2 = (u32x2*)(H + (size_t)row * DM) + F.lane;
#pragma unroll
        for (int j = 0; j < 8; ++j) { const f32x4 y = (v[j] * rstd) * gm[j] + shv[j]; u32x2 o; o.x = pk2(y.x, y.y); o.y = pk2(y.z, y.w); o2[64 * j] = o;
            if (XQ) {
                float am = fmaxf(fmaxf(fabsf(y.x), fabsf(y.y)), fmaxf(fabsf(y.z), fabsf(y.w)));
                am = fmaxf(am, DPP_MOV(am, 0xB1)); am = fmaxf(am, DPP_MOV(am, 0x4E)); am = fmaxf(am, DPP_MOV(am, 0x141)); am = fmaxf(am, 1e-20f);
                const float qs = 119.0f / am; const float yy[4] = {y.x, y.y, y.z, y.w};
                unsigned pl = 0u, ph = 0u; int sq = 0;
#pragma unroll
                for (int i = 0; i < 4; ++i) { const int qi = __float2int_rn(yy[i] * qs); const int lo = ((qi + 8) & 15) - 8; const int hi = (qi - lo) >> 4; sq += qi; pl |= (unsigned)(lo & 15) << (4 * i); ph |= (unsigned)(hi & 15) << (4 * i); }
                const unsigned pl1 = (unsigned)__builtin_amdgcn_update_dpp(0, (int)pl, 0xB1, 0xf, 0xf, true), ph1 = (unsigned)__builtin_amdgcn_update_dpp(0, (int)ph, 0xB1, 0xf, 0xf, true);
                float sqf = (float)sq; sqf = DPP_ADD(sqf, 0xB1); sqf = DPP_ADD(sqf, 0x4E); sqf = DPP_ADD(sqf, 0x141);
                const int chunk = j * 8 + (F.lane >> 3), l8 = F.lane & 7;
                if ((l8 & 1) == 0) { unsigned* q = XQ + ((size_t)row * 64 + chunk) * 8 + (l8 >> 1); q[0] = ph | (ph1 << 16); q[4] = pl | (pl1 << 16); }
                if (l8 == 0) { float* s = XS + ((size_t)row * 64 + chunk) * 2; s[0] = am * (1.0f / 119.0f); s[1] = 0.5f * sqf; }
            } }
        row = nrow;
#pragma unroll
        for (int j = 0; j < 8; ++j) v[j] = vn[j];
    }
}

__device__ __forceinline__ float row16_sum(float v) { v = DPP_ADD(v, 0xB1); v = DPP_ADD(v, 0x4E); v = DPP_ADD(v, 0x141); v = DPP_ADD(v, 0x140); return v; }
__device__ __forceinline__ void prep_odd_phase(const Frame& F0, const bf16_t* P, const float* qg, const float* kg, const float* rope_c, bf16_t* Q, bf16_t* Kb) {
    const Frame F = phase_frame(F0);
    const int l16 = F.lane & 15, d0 = l16 * 8;
    float gq[8], gk[8];
#pragma unroll
    for (int e = 0; e < 8; ++e) { gq[e] = qg[d0 + e]; gk[e] = kg[d0 + e]; }
    const bool lowhalf = l16 < 8;
    const int j0 = (l16 & 7) * 8;
    int row = F.gw;
    u32x4 w[5];
    if (row < MROWS) { const u32x4* pr = (const u32x4*)(P + (size_t)row * 3072) + F.lane;
#pragma unroll
        for (int k = 0; k < 5; ++k) w[k] = pr[64 * k]; }
    while (row < MROWS) {
        const int nrow = row + F.NGW;
        u32x4 wn[5];
        if (nrow < MROWS) { const u32x4* pr = (const u32x4*)(P + (size_t)nrow * 3072) + F.lane;
#pragma unroll
            for (int k = 0; k < 5; ++k) wn[k] = pr[64 * k]; }
        const int b = row / RB, i = row - b * RB; const bool lat = i >= CTX; const int t = i - CTX;
        float cs[8], sn[8];
#pragma unroll
        for (int e = 0; e < 8; ++e) { cs[e] = 1.f; sn[e] = 0.f; }
        if (lat) { const int pos = (j0 < 32) ? (t >> 6) : (t & 63); const f32x4* tb = (const f32x4*)(rope_c + ((pos << 5) + (j0 & 31)) * 2);
#pragma unroll
            for (int q = 0; q < 4; ++q) { const f32x4 c = tb[q]; cs[2 * q] = c.x; sn[2 * q] = c.y; cs[2 * q + 1] = c.z; sn[2 * q + 1] = c.w; } }
#pragma unroll
        for (int k = 0; k < 5; ++k) {
            const unsigned ww[4] = {w[k].x, w[k].y, w[k].z, w[k].w};
            float x[8]; float ss = 0.f;
#pragma unroll
            for (int q = 0; q < 4; ++q) { x[2 * q] = bf_lo(ww[q]); x[2 * q + 1] = bf_hi(ww[q]); ss += x[2 * q] * x[2 * q] + x[2 * q + 1] * x[2 * q + 1]; }
            const float rstd = 1.0f / sqrtf(row16_sum(ss) * (1.f / 128.f) + EPS);
            unsigned ow[4]; float o[8];
#pragma unroll
            for (int e = 0; e < 8; ++e) { const float y = x[e] * rstd * (k < 4 ? gq[e] : gk[e]); const float yp = DPP_MOV(y, 0x128);
                o[e] = lowhalf ? (y * cs[e] - yp * sn[e]) : (y * cs[e] + yp * sn[e]); }
#pragma unroll
            for (int q = 0; q < 4; ++q) ow[q] = pk2(o[2 * q], o[2 * q + 1]);
            if (k < 4) *((u32x4*)(Q + (size_t)row * 2048) + 64 * k + F.lane) = (u32x4){ow[0], ow[1], ow[2], ow[3]};
            else *((u32x4*)(Kb + (size_t)row * 512) + F.lane) = (u32x4){ow[0], ow[1], ow[2], ow[3]};
        }
        row = nrow;
#pragma unroll
        for (int k = 0; k < 5; ++k) w[k] = wn[k];
    }
}

struct PrepEvenRow { u32x4 cq; u32x2 ckv, kr; u32x4 qn[2]; u32x2 qr[2]; u32x4 kn[2], vv[2]; };
__device__ __forceinline__ void prep_even_load(PrepEvenRow& R, const bf16_t* P, const bf16_t* QR, const bf16_t* KVR, int row, int lane) {
    const bf16_t* pr = P + (size_t)row * 4096; const int l16 = lane & 15, hq = lane >> 4;
    R.cq = *((const u32x4*)pr + lane); R.ckv = *((const u32x2*)(pr + 512) + lane); R.kr = *((const u32x2*)(pr + 768) + l16);
    const bf16_t* q = QR + (size_t)row * 1536; const bf16_t* kv = KVR + (size_t)row * 2048;
#pragma unroll
    for (int k = 0; k < 2; ++k) { R.qn[k] = *((const u32x4*)q + 64 * k + lane); R.qr[k] = *((const u32x2*)(q + 1024) + 64 * k + lane);
        const bf16_t* kh = kv + (4 * k + hq) * 256 + l16 * 8; R.kn[k] = *(const u32x4*)kh; R.vv[k] = *(const u32x4*)(kh + 128); }
}
__device__ __forceinline__ void prep_even_phase(const Frame& F0, const bf16_t* P, const bf16_t* QR, const bf16_t* KVR, const float* qg, const float* kg, const float* rope_a, bf16_t* Q, bf16_t* Kb, bf16_t* Vb) {
    const Frame F = phase_frame(F0);
    const int lane = F.lane, l16 = lane & 15, hq = lane >> 4, d0 = l16 * 8, r0 = l16 * 4;
    float gqn[8], gkn[8], gqr[4], gkr[4];
#pragma unroll
    for (int e = 0; e < 8; ++e) { gqn[e] = qg[d0 + e]; gkn[e] = kg[d0 + e]; }
#pragma unroll
    for (int e = 0; e < 4; ++e) { gqr[e] = qg[128 + r0 + e]; gkr[e] = kg[128 + r0 + e]; }
    const bool lowhalf = l16 < 8; const int j0 = (l16 & 7) * 4;
    int row = F.gw;
    PrepEvenRow R;
    if (row < MROWS) prep_even_load(R, P, QR, KVR, row, lane);
    while (row < MROWS) {
        const int nrow = row + F.NGW;
        PrepEvenRow Rn;
        if (nrow < MROWS) prep_even_load(Rn, P, QR, KVR, nrow, lane);
        const int b = row / RB, i = row - b * RB; const bool lat = i >= CTX; const int t = i - CTX;
        float cs[4], sn[4];
#pragma unroll
        for (int e = 0; e < 4; ++e) { cs[e] = 1.f; sn[e] = 0.f; }
        if (lat) { const int pos = (j0 < 16) ? (t >> 6) : (t & 63); const f32x4* tb = (const f32x4*)(rope_a + ((pos << 4) + (j0 & 15)) * 2);
            const f32x4 c0 = tb[0], c1 = tb[1]; cs[0] = c0.x; sn[0] = c0.y; cs[1] = c0.z; sn[1] = c0.w; cs[2] = c1.x; sn[2] = c1.y; cs[3] = c1.z; sn[3] = c1.w; }
        float ssq = 0.f, sskv = 0.f;
        { const unsigned ww[4] = {R.cq.x, R.cq.y, R.cq.z, R.cq.w};
#pragma unroll
          for (int q = 0; q < 4; ++q) { const float a = bf_lo(ww[q]), c = bf_hi(ww[q]); ssq += a * a + c * c; } }
        { const float a = bf_lo(R.ckv.x), c = bf_hi(R.ckv.x), d = bf_lo(R.ckv.y), e = bf_hi(R.ckv.y); sskv = (a * a + c * c) + (d * d + e * e); }
        const float rstd_q = 1.0f / sqrtf(wave_sum_dpp(ssq) * (1.f / 512.f) + EPS), rstd_kv = 1.0f / sqrtf(wave_sum_dpp(sskv) * (1.f / 256.f) + EPS);
        const float krv[4] = {bf_lo(R.kr.x), bf_hi(R.kr.x), bf_lo(R.kr.y), bf_hi(R.kr.y)};
        const float krss = (krv[0] * krv[0] + krv[1] * krv[1]) + (krv[2] * krv[2] + krv[3] * krv[3]);
#pragma unroll
        for (int k = 0; k < 2; ++k) {
            const int h = 4 * k + hq;
            {
                const unsigned wn[4] = {R.qn[k].x, R.qn[k].y, R.qn[k].z, R.qn[k].w};
                float xn[8], xr[4]; float ss = 0.f;
#pragma unroll
                for (int q = 0; q < 4; ++q) { xn[2 * q] = bf_lo(wn[q]) * rstd_q; xn[2 * q + 1] = bf_hi(wn[q]) * rstd_q; ss += xn[2 * q] * xn[2 * q] + xn[2 * q + 1] * xn[2 * q + 1]; }
                xr[0] = bf_lo(R.qr[k].x) * rstd_q; xr[1] = bf_hi(R.qr[k].x) * rstd_q; xr[2] = bf_lo(R.qr[k].y) * rstd_q; xr[3] = bf_hi(R.qr[k].y) * rstd_q;
                ss += (xr[0] * xr[0] + xr[1] * xr[1]) + (xr[2] * xr[2] + xr[3] * xr[3]);
                const float r2 = 1.0f / sqrtf(row16_sum(ss) * (1.f / 192.f) + EPS);
                unsigned on[4]; float o[4];
#pragma unroll
                for (int q = 0; q < 4; ++q) on[q] = pk2(xn[2 * q] * r2 * gqn[2 * q], xn[2 * q + 1] * r2 * gqn[2 * q + 1]);
#pragma unroll
                for (int e = 0; e < 4; ++e) { const float y = xr[e] * r2 * gqr[e]; const float yp = DPP_MOV(y, 0x128); o[e] = lowhalf ? (y * cs[e] - yp * sn[e]) : (y * cs[e] + yp * sn[e]); }
                bf16_t* qo = Q + (size_t)row * 1536 + h * 192;
                *(u32x4*)(qo + d0) = (u32x4){on[0], on[1], on[2], on[3]};
                *(u32x2*)(qo + 128 + r0) = (u32x2){pk2(o[0], o[1]), pk2(o[2], o[3])};
            }
            {
                const unsigned wn[4] = {R.kn[k].x, R.kn[k].y, R.kn[k].z, R.kn[k].w}, wv[4] = {R.vv[k].x, R.vv[k].y, R.vv[k].z, R.vv[k].w};
                float xn[8]; float ss = krss;
#pragma unroll
                for (int q = 0; q < 4; ++q) { xn[2 * q] = bf_lo(wn[q]) * rstd_kv; xn[2 * q + 1] = bf_hi(wn[q]) * rstd_kv; ss += xn[2 * q] * xn[2 * q] + xn[2 * q + 1] * xn[2 * q + 1]; }
                const float r2 = 1.0f / sqrtf(row16_sum(ss) * (1.f / 192.f) + EPS);
                unsigned on[4], ov[4]; float o[4];
#pragma unroll
                for (int q = 0; q < 4; ++q) { on[q] = pk2(xn[2 * q] * r2 * gkn[2 * q], xn[2 * q + 1] * r2 * gkn[2 * q + 1]); ov[q] = pk2(bf_lo(wv[q]) * rstd_kv, bf_hi(wv[q]) * rstd_kv); }
#pragma unroll
                for (int e = 0; e < 4; ++e) { const float y = krv[e] * r2 * gkr[e]; const float yp = DPP_MOV(y, 0x128); o[e] = lowhalf ? (y * cs[e] - yp * sn[e]) : (y * cs[e] + yp * sn[e]); }
                bf16_t* ko = Kb + (size_t)row * 1536 + h * 192;
                *(u32x4*)(ko + d0) = (u32x4){on[0], on[1], on[2], on[3]};
                *(u32x2*)(ko + 128 + r0) = (u32x2){pk2(o[0], o[1]), pk2(o[2], o[3])};
                *(u32x4*)(Vb + (size_t)row * 1024 + h * 128 + d0) = (u32x4){ov[0], ov[1], ov[2], ov[3]};
            }
        }
        row = nrow; R = Rn;
    }
}

__device__ __forceinline__ void conv_phase(const Frame& F0, const bf16_t* P, const float* cw  , const float* cb  , bf16_t* CAT) {
    const Frame F = phase_frame(F0);
    const int gt = F.vcu * NTHREADS + F.tid, GT = F.G * NTHREADS;
    for (int it = gt; it < MROWS * 128; it += GT) {
        const int row = it >> 7, c0 = (it & 127) * 8; const int b = row / RB, i = row - b * RB;
        const bool first = (i == 0) || (i == CTX), last = (i == CTX - 1) || (i == RB - 1);
        const bf16_t* pr = P + (size_t)row * 4096 + 832 + c0;
        const u32x4 bg = *(const u32x4*)pr, cg = *(const u32x4*)(pr + 1024), hz = *(const u32x4*)(pr + 2048);
        u32x4 cgm = {0u, 0u, 0u, 0u}, hzm = cgm, cgp = cgm, hzp = cgm;
        if (!first) { cgm = *(const u32x4*)(pr - 4096 + 1024); hzm = *(const u32x4*)(pr - 4096 + 2048); }
        if (!last) { cgp = *(const u32x4*)(pr + 4096 + 1024); hzp = *(const u32x4*)(pr + 4096 + 2048); }
        const unsigned bgw[4] = {bg.x, bg.y, bg.z, bg.w}, cgw[4] = {cg.x, cg.y, cg.z, cg.w}, hzw[4] = {hz.x, hz.y, hz.z, hz.w};
        const unsigned cmw[4] = {cgm.x, cgm.y, cgm.z, cgm.w}, hmw[4] = {hzm.x, hzm.y, hzm.z, hzm.w}, cpw[4] = {cgp.x, cgp.y, cgp.z, cgp.w}, hpw[4] = {hzp.x, hzp.y, hzp.z, hzp.w};
        unsigned ow[4];
#pragma unroll
        for (int q = 0; q < 4; ++q) {
            const int c = c0 + 2 * q;
            const float u0a = bf_lo(cgw[q]) * bf_lo(hzw[q]), u0b = bf_hi(cgw[q]) * bf_hi(hzw[q]);
            const float uma = bf_lo(cmw[q]) * bf_lo(hmw[q]), umb = bf_hi(cmw[q]) * bf_hi(hmw[q]);
            const float upa = bf_lo(cpw[q]) * bf_lo(hpw[q]), upb = bf_hi(cpw[q]) * bf_hi(hpw[q]);
            const float ra = bf_lo(bgw[q]) * (uma * cw[c] + u0a * cw[1024 + c] + upa * cw[2048 + c] + cb[c]);
            const float rb = bf_hi(bgw[q]) * (umb * cw[c + 1] + u0b * cw[1024 + c + 1] + upb * cw[2048 + c + 1] + cb[c + 1]);
            ow[q] = pk2(ra, rb);
        }
        *(u32x4*)(CAT + (size_t)row * DM + 1024 + c0) = (u32x4){ow[0], ow[1], ow[2], ow[3]};
    }
}
__device__ __forceinline__ void attn_even_phase(const Frame& F0, const bf16_t* Q, const bf16_t* Kb, const bf16_t* Vb, bf16_t* CAT) {
    const Frame F = phase_frame(F0);
    for (int u = F.vcu; u < 272; u += F.G) {
        int b, h, qt, nk;
        if (u < 256) { b = u >> 7; h = (u >> 4) & 7; qt = 1 + (u & 15); nk = RB; } else { const int v = u - 256; b = v >> 3; h = v & 7; qt = 0; nk = CTX; }
        const size_t r0 = (size_t)b * RB;
        att::attn_body1<192, 1536, 1536, 1024, 2048>(Q + (r0 + qt * 256) * 1536 + h * 192, Kb + r0 * 1536 + h * 192, Vb + r0 * 1024 + h * 128, CAT + (r0 + qt * 256) * 2048 + h * 128, nk, (char*)F.lds, phase_tid(F.wave));
    }
}
__device__ __forceinline__ void attn_odd_phase(const Frame& F0, const bf16_t* Q, const bf16_t* Kb, const bf16_t* P, bf16_t* CAT, bool lat_only) {
    const Frame F = phase_frame(F0);
    const int nunits = lat_only ? 512 : 544;
    for (int u = F.vcu; u < nunits; u += F.G) {
        int b, hq, qt, nk;
        if (u < 512) { b = u >> 8; hq = (u >> 4) & 15; qt = 1 + (u & 15); nk = RB; } else { const int v = u - 512; b = v >> 4; hq = v & 15; qt = 0; nk = CTX; }
        const int kvh = hq >> 2; const size_t r0 = (size_t)b * RB;
        att::attn_body<128, 2048, 512, 3072, 2048, 2>(Q + (r0 + qt * 256) * 2048 + hq * 128, Kb + r0 * 512 + kvh * 128, P + r0 * 3072 + 2560 + kvh * 128, CAT + (r0 + qt * 256) * 2048 + hq * 128, nk, (char*)F.lds, phase_tid(F.wave));
    }
}

__device__ __forceinline__ int crow32(int r, int hi) { return (r & 3) + 8 * (r >> 2) + 4 * hi; }
__device__ __forceinline__ int fkey(int b) { return b ^ ((b >> 31) & 0x7fffffff); }
#define TK_CE(x, y) do { const int hi_ = max((x), (y)), lo_ = min((x), (y)); (x) = hi_; (y) = lo_; } while (0)
template <int N> __device__ __forceinline__ void tk_sort(int* v) {
#pragma unroll
    for (int k = 2; k <= N; k <<= 1)
#pragma unroll
        for (int j = k >> 1; j > 0; j >>= 1)
#pragma unroll
            for (int i = 0; i < N; ++i) { const int l = i ^ j; if (l > i) { if ((i & k) == 0) TK_CE(v[i], v[l]); else TK_CE(v[l], v[i]); } }
}
__device__ __forceinline__ void tk_merge16(int* a, const int* b) {
#pragma unroll
    for (int i = 0; i < 16; ++i) a[i] = max(a[i], b[15 - i]);
#pragma unroll
    for (int j = 8; j > 0; j >>= 1)
#pragma unroll
        for (int i = 0; i < 16; ++i) { const int l = i ^ j; if (l > i) TK_CE(a[i], a[l]); }
}
__device__ __forceinline__ void tk_merge_partner(int* a) {
    int lo[16], hi[16];
#pragma unroll
    for (int i = 0; i < 16; ++i) { auto rr = __builtin_amdgcn_permlane32_swap((unsigned)a[i], (unsigned)a[i], false, false); lo[i] = (int)rr[0]; hi[i] = (int)rr[1]; }
    tk_merge16(lo, hi);
#pragma unroll
    for (int i = 0; i < 16; ++i) a[i] = lo[i];
}
__device__ __forceinline__ void peer_topk_phase(const Frame& F0, const bf16_t* PQ, const bf16_t* subk  , int* IDX, float* GATE, bool lat_only) {
    const Frame F = phase_frame(F0);
    const int h = F.vcu & 7, jw = (F.vcu >> 3) * NWAVES + F.wave, nwh = (F.G >> 3) * NWAVES;
    {
        const bf16_t* src = subk + (size_t)h * 2 * 128 * 128;
        for (int c = F.tid; c < 4096; c += NTHREADS) { const int row = c >> 4, ch = c & 15;
            *(LAS u32x4*)(F.lds + row * 256 + ((ch ^ (row & 15)) << 4)) = *(const u32x4*)(src + (size_t)row * 128 + ch * 8); }
        __syncthreads();
    }
    const int ntg = lat_only ? 256 : MROWS / 32;
    for (int t = jw; t < ntg; t += nwh) {
        int lane_ = F.lane; asm volatile("" : "+v"(lane_));
        const int r32 = lane_ & 31, hi = lane_ >> 5;
        int tg = t; if (lat_only) tg += 8 + (tg >= 128 ? 8 : 0);
        const int token = tg * 32 + r32;
        int top[2][16];
        const int kk = (((r32 & 14) | (hi ^ (r32 & 1))) << 4);
#pragma unroll
        for (int p = 0; p < 2; ++p) {
            bf16x8 bq[8];
            const bf16_t* qp = PQ + (size_t)token * DM + h * 256 + p * 128 + hi * 8;
#pragma unroll
            for (int ks = 0; ks < 8; ++ks) bq[ks] = *(const bf16x8*)(qp + ks * 16);
            int s[4][16];
#pragma unroll
            for (int nb = 0; nb < 4; ++nb) {
                f32x16 acc = {};
                const LAS unsigned char* kp = F.lds + (p * 128 + nb * 32 + r32) * 256;
#pragma unroll
                for (int ks = 0; ks < 8; ++ks) { const bf16x8 a = *(const LAS bf16x8*)(kp + (kk ^ (ks << 5))); acc = __builtin_amdgcn_mfma_f32_32x32x16_bf16(a, bq[ks], acc, 0, 0, 0); }
#pragma unroll
                for (int r = 0; r < 16; ++r) { const int key = nb * 32 + crow32(r, hi); s[nb][r] = fkey((int)((__float_as_uint(acc[r]) & ~127u) | (unsigned)(127 - key))); }
                tk_sort<16>(s[nb]);
            }
            tk_merge16(s[0], s[1]); tk_merge16(s[2], s[3]); tk_merge16(s[0], s[2]);
            tk_merge_partner(s[0]);
#pragma unroll
            for (int j = 0; j < 16; ++j) top[p][j] = s[0][j];
        }
        int cand[32];
        unsigned long long kaLo = 0ull, kaHi = 0ull, kbLo = 0ull, kbHi = 0ull;
        {
            float fb[16]; const float fa0 = __uint_as_float((unsigned)fkey(top[0][0]) & ~127u), fb0 = __uint_as_float((unsigned)fkey(top[1][0]) & ~127u);
#pragma unroll
            for (int r = 0; r < 16; ++r) { const int ba = fkey(top[0][r]), bb = fkey(top[1][r]); fb[r] = __uint_as_float((unsigned)bb & ~127u) - fb0;
                const unsigned long long xa = (unsigned long long)(unsigned)(127 - (ba & 127)) << (8 * (r & 7)), xb = (unsigned long long)(unsigned)(127 - (bb & 127)) << (8 * (r & 7));
                if (r < 8) { kaLo |= xa; kbLo |= xb; } else { kaHi |= xa; kbHi |= xb; } }
            float fa[8];
#pragma unroll
            for (int i = 0; i < 8; ++i) { const int ka = hi ? top[0][2 * i + 1] : top[0][2 * i]; fa[i] = __uint_as_float((unsigned)fkey(ka) & ~127u) - fa0; }
            const int hid = 255 - (hi << 4);
            int n = 0;
#pragma unroll
            for (int i = 0; i < 8; ++i)
#pragma unroll
                for (int b = 0; b < 16; ++b) if ((2 * i + 1) * (b + 1) <= 16) {
                    const float sum = fa[i] + fb[b];
                    cand[n++] = fkey((int)((__float_as_uint(sum) & ~255u) | (unsigned)(hid - (32 * i + b))));
                }
#pragma unroll
            for (; n < 32; ++n) cand[n] = (int)0x80000000;
        }
        tk_sort<16>(cand); tk_sort<16>(cand + 16); tk_merge16(cand, cand + 16);
        tk_merge_partner(cand);
        float ev[16]; float esum = 0.f;
#pragma unroll
        for (int j = 0; j < 16; ++j) { ev[j] = __expf(__uint_as_float((unsigned)fkey(cand[j]) & ~255u)); esum += ev[j]; }
        const float rs = 1.0f / esum;
        int oi[8]; float og[8];
#pragma unroll
        for (int j = 0; j < 8; ++j) { const int w = hi ? cand[8 + j] : cand[j]; const float e = hi ? ev[8 + j] : ev[j];
            const int id8 = 255 - (fkey(w) & 255), ra = id8 >> 4, rb = id8 & 15;
            const unsigned long long wa = (ra & 8) ? kaHi : kaLo, wb = (rb & 8) ? kbHi : kbLo;
            const int ka = (int)(wa >> (8 * (ra & 7))) & 127, kb = (int)(wb >> (8 * (rb & 7))) & 127;
            oi[j] = ka * 128 + kb; og[j] = e * rs; }
        int* ip = IDX + (size_t)token * 128 + h * 16 + hi * 8; float* gp = GATE + (size_t)token * 128 + h * 16 + hi * 8;
        *(int4*)ip = make_int4(oi[0], oi[1], oi[2], oi[3]); *(int4*)(ip + 4) = make_int4(oi[4], oi[5], oi[6], oi[7]);
        *(f32x4*)gp = (f32x4){og[0], og[1], og[2], og[3]}; *(f32x4*)(gp + 4) = (f32x4){og[4], og[5], og[6], og[7]};
    }
}

#if TAB_FP4
__device__ __forceinline__ void peer_expert_phase(const Frame& F0, const bf16_t* H2, const int* IDX, const float* GATE, const unsigned char* U, size_t v_minus_u_bytes, const float* USC, const float* VSC,
                                                  const float* g2  , float* XW, float* OUT,
                                                  bf16_t* HN  , const float* ng  , const float* nmod  ) {
    const Frame F = phase_frame(F0);
    LAS float* red = (LAS float*)F.lds;
    const unsigned voff_tab = (unsigned)v_minus_u_bytes;
    const __amdgpu_buffer_rsrc_t rs = __builtin_amdgcn_make_buffer_rsrc((void*)U, 0, (int)(voff_tab + (unsigned)NEXP * ROWB), 0x00020000);
    const int lane = F.lane; const int voff = lane * 16;
#define PX_SB() __builtin_amdgcn_sched_barrier(0)
#define PX_LOADALL(buf, ivv, tb) do { _Pragma("unroll") for (int e_ = 0; e_ < 16; ++e_) buf[e_] = __builtin_amdgcn_raw_buffer_load_b128(rs, voff, (unsigned)__builtin_amdgcn_readlane(ivv, e_) * (unsigned)ROWB + (tb), 0); } while (0)
#define PX_U1(d_, b_) { const bf16x2_t r2_ = __builtin_amdgcn_cvt_scalef32_pk_bf16_fp4(wd_[d_], 1.0f, b_); if ((b_) & 1) a1_ = __builtin_amdgcn_fdot2_f32_bf16(r2_, __builtin_bit_cast(bf16x2_t, xpk[4 * (d_) + (b_)]), a1_, false); \
                        else a0_ = __builtin_amdgcn_fdot2_f32_bf16(r2_, __builtin_bit_cast(bf16x2_t, xpk[4 * (d_) + (b_)]), a0_, false); }
#define PX_V1(d_, b_) { const f32x2 t2_ = __builtin_amdgcn_cvt_scalef32_pk_f32_fp4(wd_[d_], 1.0f, b_); acc[8 * (d_) + 2 * (b_)] += wg_ * t2_.x; acc[8 * (d_) + 2 * (b_) + 1] += wg_ * t2_.y; }
#define PX_FETCH_TOKEN(r, XP, IV, GV) do { const u32x4* xp_ = (const u32x4*)(H2 + (size_t)(r) * DM + lane * 16); XP[0] = xp_[0]; XP[1] = xp_[1]; XP[2] = xp_[128]; XP[3] = xp_[129]; \
        IV = 0; GV = 0.f; if (lane < 16) { IV = IDX[(size_t)(r) * 128 + F.wave * 16 + lane]; GV = GATE[(size_t)(r) * 128 + F.wave * 16 + lane]; } } while (0)
    const bool skip_ctx = (OUT != nullptr);
    int row = F.vcu; if (skip_ctx && row < MROWS && row_cls(row) == 2) row += F.G;
    u32x4 xp[4]; int iv; float gv;
    u32x4 ub[16], vb[16];
    if (row < MROWS) { PX_FETCH_TOKEN(row, xp, iv, gv); PX_LOADALL(ub, iv, 0u); PX_LOADALL(vb, iv, voff_tab); }
    int par = 0;
    while (row < MROWS) {
        int nrow = row + F.G; if (skip_ctx && nrow < MROWS && row_cls(nrow) == 2) nrow += F.G;
        float usc = 0.f, vsc = 0.f;
        if (lane < 16) { usc = USC[iv]; vsc = VSC[iv]; }
        u32x4 xpn[4]; int ivn = 0; float gvn = 0.f;
        if (nrow < MROWS) PX_FETCH_TOKEN(nrow, xpn, ivn, gvn);
        const int cls = row_cls(row);
        const f32x4 x_old = *((const f32x4*)(XW + (size_t)row * DM) + F.tid), g_vec = *((const f32x4*)(g2 + (size_t)cls * NMOD) + F.tid);
        f32x4 n_g = {0.f, 0.f, 0.f, 0.f}, n_sc = n_g, n_sh = n_g;
        if (HN) { n_g = *((const f32x4*)ng + F.tid); n_sc = *((const f32x4*)(nmod + (size_t)cls * NMOD + 2048) + F.tid); n_sh = *((const f32x4*)(nmod + (size_t)cls * NMOD) + F.tid); }
        const unsigned xpk[16] = {xp[0].x, xp[0].y, xp[0].z, xp[0].w, xp[1].x, xp[1].y, xp[1].z, xp[1].w, xp[2].x, xp[2].y, xp[2].z, xp[2].w, xp[3].x, xp[3].y, xp[3].z, xp[3].w};
        float sv = 0.f;
        PX_SB();
#pragma unroll
        for (int e = 0; e < 16; ++e) {
            u32x4 w_ = ub[e]; asm volatile("" : "+v"(w_) : "v"(sv));
            const unsigned wd_[4] = {w_.x, w_.y, w_.z, w_.w}; float a0_ = 0.f, a1_ = 0.f;
            PX_U1(0, 0) PX_U1(0, 1) PX_U1(0, 2) PX_U1(0, 3) PX_U1(1, 0) PX_U1(1, 1) PX_U1(1, 2) PX_U1(1, 3) PX_U1(2, 0) PX_U1(2, 1) PX_U1(2, 2) PX_U1(2, 3) PX_U1(3, 0) PX_U1(3, 1) PX_U1(3, 2) PX_U1(3, 3)
            const float t_ = wave_sum_dpp(a0_ + a1_); sv = (lane == e) ? t_ : sv;
        }
        const float wv = gelu_erf(sv * usc) * gv * vsc;
        PX_SB();
        if (nrow < MROWS) PX_LOADALL(ub, ivn, 0u);
        PX_SB();
        f32x32 acc = {};
#pragma unroll
        for (int e = 0; e < 16; ++e) {
            u32x4 w_ = vb[e]; asm volatile("" : "+v"(w_) : "v"(acc));
            const unsigned wd_[4] = {w_.x, w_.y, w_.z, w_.w}; const float wg_ = __uint_as_float(__builtin_amdgcn_readlane(__float_as_uint(wv), e));
            PX_V1(0, 0) PX_V1(0, 1) PX_V1(0, 2) PX_V1(0, 3) PX_V1(1, 0) PX_V1(1, 1) PX_V1(1, 2) PX_V1(1, 3) PX_V1(2, 0) PX_V1(2, 1) PX_V1(2, 2) PX_V1(2, 3) PX_V1(3, 0) PX_V1(3, 1) PX_V1(3, 2) PX_V1(3, 3)
        }
        PX_SB();
        if (nrow < MROWS) PX_LOADALL(vb, ivn, voff_tab);
        PX_SB();
        LAS float* rb = red + par * (NWAVES * DM);
#pragma unroll
        for (int j = 0; j < 2; ++j)
#pragma unroll
            for (int q = 0; q < 4; ++q) *(LAS f32x4*)(rb + F.wave * DM + j * 1024 + lane * 16 + q * 4) = (f32x4){acc[j * 16 + q * 4], acc[j * 16 + q * 4 + 1], acc[j * 16 + q * 4 + 2], acc[j * 16 + q * 4 + 3]};
        __syncthreads();
        {
            f32x4 sm = {0.f, 0.f, 0.f, 0.f};
#pragma unroll
            for (int w = 0; w < 8; ++w) sm += *(const LAS f32x4*)(rb + w * DM + F.tid * 4);
            f32x4* xq = (f32x4*)(XW + (size_t)row * DM) + F.tid;
            const f32x4 xn = x_old + g_vec * sm;
            *xq = xn;
            if (OUT) { const int b = row / RB, i = row - b * RB; if (i >= CTX) *((f32x4*)(OUT + ((size_t)b * SEQ + (i - CTX)) * DM) + F.tid) = xn; }
            if (HN) {
                LAS float* ssp = (LAS float*)(F.lds + 131072) + par * 8;
                const float sw = wave_sum_dpp((xn.x * xn.x + xn.y * xn.y) + (xn.z * xn.z + xn.w * xn.w));
                if (lane == 0) ssp[F.wave] = sw;
                __syncthreads();
                const float tot = ((ssp[0] + ssp[1]) + (ssp[2] + ssp[3])) + ((ssp[4] + ssp[5]) + (ssp[6] + ssp[7]));
                const float rstd = 1.0f / sqrtf(tot * (1.f / DM) + EPS);
                const f32x4 y = (xn * rstd) * n_g * (n_sc + 1.0f) + n_sh;
                u32x2 o; o.x = pk2(y.x, y.y); o.y = pk2(y.z, y.w);
                *((u32x2*)(HN + (size_t)row * DM) + F.tid) = o;
            }
        }
        par ^= 1; row = nrow;
#pragma unroll
        for (int q = 0; q < 4; ++q) xp[q] = xpn[q];
        iv = ivn; gv = gvn;
    }
#undef PX_LOADALL
#undef PX_U1
#undef PX_V1
#undef PX_SB
#undef PX_FETCH_TOKEN
}
#else
__device__ __forceinline__ void peer_expert_phase(const Frame& F0, const bf16_t* H2, const int* IDX, const float* GATE, const unsigned char* U, size_t v_minus_u_bytes, const float* USC, const float* VSC,
                                                  const float* g2  , float* XW, float* OUT,
                                                  bf16_t* HN  , const float* ng  , const float* nmod  ) {
    const Frame F = phase_frame(F0);
    LAS float* red = (LAS float*)F.lds;
    const unsigned voff_tab = (unsigned)v_minus_u_bytes;
    const __amdgpu_buffer_rsrc_t rs = __builtin_amdgcn_make_buffer_rsrc((void*)U, 0, (int)(voff_tab + (unsigned)NEXP * ROWB), 0x00020000);
    const int lane = F.lane; const int voff = lane * 16, voff2 = 1024 + lane * 8;
#define PX_SB() __builtin_amdgcn_sched_barrier(0)
#define PX_LOAD(buf, s, ivv) do { constexpr int e0_ = ((s) & 3) * 4; const unsigned tb_ = ((s) >= 4) ? voff_tab : 0u; \
        _Pragma("unroll") for (int ee_ = 0; ee_ < 4; ++ee_) { const unsigned o_ = (unsigned)__builtin_amdgcn_readlane(ivv, e0_ + ee_) * (unsigned)ROWB + tb_; \
            buf##h[ee_] = __builtin_amdgcn_raw_buffer_load_b128(rs, voff, o_, 0); buf##l[ee_] = __builtin_amdgcn_raw_buffer_load_b64(rs, voff2, o_, 0); } } while (0)
#define PX_DECODE(buf, ee_, dep) u32x6 w6_ = {buf##h[ee_].x, buf##h[ee_].y, buf##h[ee_].z, buf##h[ee_].w, buf##l[ee_].x, buf##l[ee_].y}; \
        asm volatile("" : "+v"(w6_) : "v"(dep));     \
        const f32x32 r_ = __builtin_amdgcn_cvt_scalef32_pk32_f32_fp6(w6_, 1.0f);
#define PX_COMP_U(buf, s) do { constexpr int e0_ = ((s) & 3) * 4; \
            _Pragma("unroll") for (int ee_ = 0; ee_ < 4; ++ee_) { PX_DECODE(buf, ee_, sv) \
                const f32x32 p_ = r_ * xf; float a0_ = 0.f, a1_ = 0.f; \
                _Pragma("unroll") for (int k_ = 0; k_ < 32; k_ += 2) { a0_ += p_[k_]; a1_ += p_[k_ + 1]; } \
                const float t_ = wave_sum_dpp(a0_ + a1_); sv = (lane == e0_ + ee_) ? t_ : sv; } } while (0)
#define PX_COMP_V(buf, s) do { constexpr int e0_ = ((s) & 3) * 4; \
            _Pragma("unroll") for (int ee_ = 0; ee_ < 4; ++ee_) { const float wg_ = __uint_as_float(__builtin_amdgcn_readlane(__float_as_uint(wv), e0_ + ee_)); \
                PX_DECODE(buf, ee_, acc) \
                acc += r_ * wg_; } } while (0)
#define PX_FETCH_TOKEN(r, XP, IV, GV) do { const u32x4* xp_ = (const u32x4*)(H2 + (size_t)(r) * DM + lane * 16); XP[0] = xp_[0]; XP[1] = xp_[1]; XP[2] = xp_[128]; XP[3] = xp_[129]; \
        IV = 0; GV = 0.f; if (lane < 16) { IV = IDX[(size_t)(r) * 128 + F.wave * 16 + lane]; GV = GATE[(size_t)(r) * 128 + F.wave * 16 + lane]; } } while (0)
    const bool skip_ctx = (OUT != nullptr);
    int row = F.vcu; if (skip_ctx && row < MROWS && row_cls(row) == 2) row += F.G;
    u32x4 xp[4]; int iv; float gv;
    u32x4 bAh[4], bBh[4]; u32x2 bAl[4], bBl[4];
    if (row < MROWS) { PX_FETCH_TOKEN(row, xp, iv, gv); PX_LOAD(bA, 0, iv); }
    int par = 0;
    while (row < MROWS) {
        int nrow = row + F.G; if (skip_ctx && nrow < MROWS && row_cls(nrow) == 2) nrow += F.G;
        f32x32 xf;
#pragma unroll
        for (int q = 0; q < 4; ++q) { const unsigned ww[4] = {xp[q].x, xp[q].y, xp[q].z, xp[q].w};
#pragma unroll
            for (int k = 0; k < 4; ++k) { xf[q * 8 + 2 * k] = bf_lo(ww[k]); xf[q * 8 + 2 * k + 1] = bf_hi(ww[k]); } }
        float usc = 0.f, vsc = 0.f;
        if (lane < 16) { usc = USC[iv]; vsc = VSC[iv]; }
        u32x4 xpn[4]; int ivn = 0; float gvn = 0.f;
        if (nrow < MROWS) PX_FETCH_TOKEN(nrow, xpn, ivn, gvn);
        const int cls = row_cls(row);
        const f32x4 x_old = *((const f32x4*)(XW + (size_t)row * DM) + F.tid), g_vec = *((const f32x4*)(g2 + (size_t)cls * NMOD) + F.tid);
        f32x4 n_g = {0.f, 0.f, 0.f, 0.f}, n_sc = n_g, n_sh = n_g;
        if (HN) { n_g = *((const f32x4*)ng + F.tid); n_sc = *((const f32x4*)(nmod + (size_t)cls * NMOD + 2048) + F.tid); n_sh = *((const f32x4*)(nmod + (size_t)cls * NMOD) + F.tid); }
        float sv = 0.f, wv = 0.f;
        PX_LOAD(bB, 1, iv); PX_SB(); PX_COMP_U(bA, 0); PX_SB();
        PX_LOAD(bA, 2, iv); PX_SB(); PX_COMP_U(bB, 1); PX_SB();
        PX_LOAD(bB, 3, iv); PX_SB(); PX_COMP_U(bA, 2); PX_SB();
        PX_LOAD(bA, 4, iv); PX_SB(); PX_COMP_U(bB, 3); PX_SB();
        wv = gelu_erf(sv * usc) * gv * vsc;
        f32x32 acc = {};
        PX_LOAD(bB, 5, iv); PX_SB(); PX_COMP_V(bA, 4); PX_SB();
        PX_LOAD(bA, 6, iv); PX_SB(); PX_COMP_V(bB, 5); PX_SB();
        PX_LOAD(bB, 7, iv); PX_SB(); PX_COMP_V(bA, 6); PX_SB();
        if (nrow < MROWS) PX_LOAD(bA, 0, ivn);
        PX_SB(); PX_COMP_V(bB, 7); PX_SB();
        LAS float* rb = red + par * (NWAVES * DM);
#pragma unroll
        for (int j = 0; j < 2; ++j)
#pragma unroll
            for (int q = 0; q < 4; ++q) *(LAS f32x4*)(rb + F.wave * DM + j * 1024 + lane * 16 + q * 4) = (f32x4){acc[j * 16 + q * 4], acc[j * 16 + q * 4 + 1], acc[j * 16 + q * 4 + 2], acc[j * 16 + q * 4 + 3]};
        __syncthreads();
        {
            f32x4 sm = {0.f, 0.f, 0.f, 0.f};
#pragma unroll
            for (int w = 0; w < 8; ++w) sm += *(const LAS f32x4*)(rb + w * DM + F.tid * 4);
            f32x4* xq = (f32x4*)(XW + (size_t)row * DM) + F.tid;
            const f32x4 xn = x_old + g_vec * sm;
            *xq = xn;
            if (OUT) { const int b = row / RB, i = row - b * RB; if (i >= CTX) *((f32x4*)(OUT + ((size_t)b * SEQ + (i - CTX)) * DM) + F.tid) = xn; }
            if (HN) {
                LAS float* ssp = (LAS float*)(F.lds + 131072) + par * 8;
                const float sw = wave_sum_dpp((xn.x * xn.x + xn.y * xn.y) + (xn.z * xn.z + xn.w * xn.w));
                if (lane == 0) ssp[F.wave] = sw;
                __syncthreads();
                const float tot = ((ssp[0] + ssp[1]) + (ssp[2] + ssp[3])) + ((ssp[4] + ssp[5]) + (ssp[6] + ssp[7]));
                const float rstd = 1.0f / sqrtf(tot * (1.f / DM) + EPS);
                const f32x4 y = (xn * rstd) * n_g * (n_sc + 1.0f) + n_sh;
                u32x2 o; o.x = pk2(y.x, y.y); o.y = pk2(y.z, y.w);
                *((u32x2*)(HN + (size_t)row * DM) + F.tid) = o;
            }
        }
        par ^= 1; row = nrow;
#pragma unroll
        for (int q = 0; q < 4; ++q) xp[q] = xpn[q];
        iv = ivn; gv = gvn;
    }
#undef PX_LOAD
#undef PX_COMP_U
#undef PX_COMP_V
#undef PX_SB
#undef PX_FETCH_TOKEN
}
#endif

#if EXP_SLICED && TAB_FP4
__device__ __forceinline__ float oct_sum(float v) { v = DPP_ADD(v, 0xB1); v = DPP_ADD(v, 0x4E); v = DPP_ADD(v, 0x141); return v; }
__device__ __forceinline__ int sl_next_tok(int t, int stride, bool lat_only) { t += stride; if (lat_only) while (t < MROWS && row_cls(t) == 2) t += stride; return t; }
#ifndef PROBE_IDMASK
#define PROBE_IDMASK 0x7fffffff
#endif
#define SL_IDS(t_, A_, B_) do { A_ = IDX[(size_t)(t_) * 128 + lane] & idmask; B_ = IDX[(size_t)(t_) * 128 + 64 + lane] & idmask; } while (0)
#define SL_ROWS(buf, A_, B_) do { _Pragma("unroll") for (int i_ = 0; i_ < 16; ++i_) { const int id_ = __builtin_amdgcn_ds_bpermute(bp + 32 * (i_ & 7), (i_ < 8) ? (A_) : (B_)); \
        buf[i_] = __builtin_amdgcn_raw_buffer_load_b128(rs, id_ * 128 + coloff, 0, 0); } } while (0)
__device__ __forceinline__ void peer_u_phase(const Frame& F0, const unsigned* XQ, const float* XS, const int* IDX, const unsigned char* U, float* PART, bool lat_only, int idmask = 0x7fffffff) {
    const Frame F = phase_frame(F0);
    const int lane = F.lane, g = lane >> 3, j = lane & 7, bp = 4 * g;
    const int wps = F.G >> 3, x = F.vcu / wps, wi = (F.vcu - x * wps) * NWAVES + F.wave, stride = wps * NWAVES;
    const __amdgpu_buffer_rsrc_t rs = __builtin_amdgcn_make_buffer_rsrc((void*)(U + (size_t)x * (NEXP * 128)), 0, NEXP * 128, 0x00020000);
    const int coloff = 16 * j;
    int t = wi - stride; t = sl_next_tok(t, stride, lat_only);
    int t1 = sl_next_tok(t, stride, lat_only), t2 = sl_next_tok(t1, stride, lat_only);
    int idA1 = 0, idB1 = 0, idA2 = 0, idB2 = 0, idA3 = 0, idB3 = 0; u32x4 xs[3], xs1[3], xs2[3], w[16], wn[16];
#define SL_XS(dst, t_) do { const u32x4* xp_ = (const u32x4*)(XQ + ((size_t)(t_) * 64 + 8 * x + j) * 8); dst[0] = xp_[0]; dst[1] = xp_[1]; const f32x2 s2_ = *(const f32x2*)(XS + ((size_t)(t_) * 64 + 8 * x + j) * 2); dst[2] = (u32x4){__float_as_uint(s2_.x), __float_as_uint(s2_.y), 0u, 0u}; } while (0)
    if (t < MROWS) { int idA0, idB0; SL_IDS(t, idA0, idB0); SL_XS(xs1, t); SL_ROWS(w, idA0, idB0); }
    if (t1 < MROWS) { SL_IDS(t1, idA2, idB2); SL_XS(xs2, t1); }
    if (t2 < MROWS) SL_IDS(t2, idA3, idB3);
#define SL_UBODY(CUR, NXT) do { \
        const int t3 = sl_next_tok(t2, stride, lat_only); \
_Pragma("unroll") \
        for (int q = 0; q < 3; ++q) { xs[q] = xs1[q]; xs1[q] = xs2[q]; } \
        idA1 = idA2; idB1 = idB2; idA2 = idA3; idB2 = idB3; \
        if (t1 < MROWS) SL_ROWS(NXT, idA1, idB1); \
        if (t2 < MROWS) SL_XS(xs2, t2); \
        if (t3 < MROWS) SL_IDS(t3, idA3, idB3); \
        const int xh[4] = {(int)xs[0].x, (int)xs[0].y, (int)xs[0].z, (int)xs[0].w}, xl[4] = {(int)xs[1].x, (int)xs[1].y, (int)xs[1].z, (int)xs[1].w}; \
        const float dq = __uint_as_float(xs[2].x), off = __uint_as_float(xs[2].y); \
        float res_lo = 0.f, res_hi = 0.f; \
_Pragma("unroll") \
        for (int i = 0; i < 16; ++i) { \
            const int wd_[4] = {(int)CUR[i].x, (int)CUR[i].y, (int)CUR[i].z, (int)CUR[i].w}; int ah_ = 0, al_ = 0; \
_Pragma("unroll") \
            for (int d = 0; d < 4; ++d) { ah_ = __builtin_amdgcn_sdot8(wd_[d], xh[d], ah_, false); al_ = __builtin_amdgcn_sdot8(wd_[d], xl[d], al_, false); } \
            const float a_ = oct_sum(((float)(16 * ah_ + al_) + off) * dq); \
            if (i < 8) res_lo = (j == i) ? a_ : res_lo; else res_hi = (j == i - 8) ? a_ : res_hi; \
        } \
        float* pp = PART + ((size_t)t * 8 + x) * 128 + 8 * j + g; \
        pp[0] = res_lo; pp[64] = res_hi; \
        t = t1; t1 = t2; t2 = t3; \
    } while (0)
    while (t < MROWS) { SL_UBODY(w, wn); if (!(t < MROWS)) break; SL_UBODY(wn, w); }
#undef SL_UBODY
#undef SL_XS
}
__device__ __forceinline__ void peer_w_phase(const Frame& F0, const float* PART, const int* IDX, float* GATE, const float* USC, const float* VSC, bool lat_only) {
    const Frame F = phase_frame(F0);
    const int gt = F.vcu * NTHREADS + F.tid, GT = F.G * NTHREADS;
    for (int e0 = gt; e0 < MROWS * 128; e0 += 4 * GT) {
        float s[4]; int id[4]; float gte[4], us[4], vs[4]; bool ok[4];
#pragma unroll
        for (int u = 0; u < 4; ++u) { const int e = e0 + u * GT; ok[u] = e < MROWS * 128 && !(lat_only && row_cls(e >> 7) == 2); s[u] = 0.f; id[u] = 0; gte[u] = 0.f;
            if (ok[u]) { const float* pp = PART + (size_t)(e >> 7) * 1024 + (e & 127);
#pragma unroll
                for (int xx = 0; xx < 8; ++xx) s[u] += pp[xx * 128];
                id[u] = IDX[e]; gte[u] = GATE[e]; } }
#pragma unroll
        for (int u = 0; u < 4; ++u) { us[u] = ok[u] ? USC[id[u]] : 0.f; vs[u] = ok[u] ? VSC[id[u]] : 0.f; }
#pragma unroll
        for (int u = 0; u < 4; ++u) if (ok[u]) GATE[e0 + u * GT] = gte[u] * gelu_erf(s[u] * us[u]) * vs[u];
    }
}
__device__ __forceinline__ void peer_v_phase(const Frame& F0, const int* IDX, const float* WK, const unsigned char* VT, const float* g2  , float* XW, float* OUT, bool lat_only) {
    const int idmask = 0x7fffffff;
    const Frame F = phase_frame(F0);
    const int lane = F.lane, g = lane >> 3, j = lane & 7, bp = 4 * g;
    const int wps = F.G >> 3, x = F.vcu / wps, wi = (F.vcu - x * wps) * NWAVES + F.wave, stride = wps * NWAVES;
    const __amdgpu_buffer_rsrc_t rs = __builtin_amdgcn_make_buffer_rsrc((void*)(VT + (size_t)x * (NEXP * 128)), 0, NEXP * 128, 0x00020000);
    const int coloff = 16 * j;
    const int mycol = 256 * x + 32 * j + 4 * g;
    int t = wi - stride; t = sl_next_tok(t, stride, lat_only);
    int t1 = sl_next_tok(t, stride, lat_only), t2 = sl_next_tok(t1, stride, lat_only);
    int idA1 = 0, idB1 = 0, idA2 = 0, idB2 = 0, idA3 = 0, idB3 = 0; float wA = 0.f, wB = 0.f, wA1 = 0.f, wB1 = 0.f, wA2 = 0.f, wB2 = 0.f; u32x4 w[16], wn[16];
    f32x4 x_old = {0.f, 0.f, 0.f, 0.f}, g_vec = x_old, xo1 = x_old, gv1 = x_old, xo2 = x_old, gv2 = x_old;
#define SL_WK(t_, A_, B_) do { A_ = WK[(size_t)(t_) * 128 + lane]; B_ = WK[(size_t)(t_) * 128 + 64 + lane]; } while (0)
#define SL_XG(t_, X_, G_) do { X_ = *(const f32x4*)(XW + (size_t)(t_) * DM + mycol); G_ = *(const f32x4*)(g2 + (size_t)row_cls(t_) * NMOD + mycol); } while (0)
    if (t < MROWS) { int idA0, idB0; SL_IDS(t, idA0, idB0); SL_WK(t, wA1, wB1); SL_XG(t, xo1, gv1); SL_ROWS(w, idA0, idB0); }
    if (t1 < MROWS) { SL_IDS(t1, idA2, idB2); SL_WK(t1, wA2, wB2); SL_XG(t1, xo2, gv2); }
    if (t2 < MROWS) SL_IDS(t2, idA3, idB3);
#define SL_V1(d_, b_) { const h2_t r2_ = __builtin_amdgcn_cvt_scalef32_pk_f16_fp4(wd_[d_], 1.0f, b_); acc[4 * (d_) + (b_)] = __builtin_elementwise_fma(r2_, wg2_, acc[4 * (d_) + (b_)]); }
#define SL_VBODY(CUR, NXT) do { \
        const int t3 = sl_next_tok(t2, stride, lat_only); \
        wA = wA1; wB = wB1; wA1 = wA2; wB1 = wB2; x_old = xo1; g_vec = gv1; xo1 = xo2; gv1 = gv2; \
        idA1 = idA2; idB1 = idB2; idA2 = idA3; idB2 = idB3; \
        if (t1 < MROWS) SL_ROWS(NXT, idA1, idB1); \
        if (t2 < MROWS) { SL_WK(t2, wA2, wB2); SL_XG(t2, xo2, gv2); } \
        if (t3 < MROWS) SL_IDS(t3, idA3, idB3); \
        h2_t acc[16]; \
_Pragma("unroll") \
        for (int p = 0; p < 16; ++p) acc[p] = (h2_t){(_Float16)0.f, (_Float16)0.f}; \
_Pragma("unroll") \
        for (int i = 0; i < 16; ++i) { \
            const unsigned wd_[4] = {CUR[i].x, CUR[i].y, CUR[i].z, CUR[i].w}; \
            const float wgf_ = __int_as_float(__builtin_amdgcn_ds_bpermute(bp + 32 * (i & 7), __float_as_int((i < 8) ? wA : wB))); \
            const _Float16 wgh_ = (_Float16)wgf_; const h2_t wg2_ = {wgh_, wgh_}; \
            SL_V1(0, 0) SL_V1(0, 1) SL_V1(0, 2) SL_V1(0, 3) SL_V1(1, 0) SL_V1(1, 1) SL_V1(1, 2) SL_V1(1, 3) SL_V1(2, 0) SL_V1(2, 1) SL_V1(2, 2) SL_V1(2, 3) SL_V1(3, 0) SL_V1(3, 1) SL_V1(3, 2) SL_V1(3, 3) \
        } \
        unsigned m0 = 0u, m1 = 0u; \
_Pragma("unroll") \
        for (int p = 0; p < 16; ++p) { \
            h2_t v = acc[p]; \
            v = v + __builtin_bit_cast(h2_t, __builtin_amdgcn_update_dpp(0, __builtin_bit_cast(int, v), 0x128, 0xf, 0xf, true)); \
            { auto r = __builtin_amdgcn_permlane16_swap(__builtin_bit_cast(unsigned, v), __builtin_bit_cast(unsigned, v), false, false); v = __builtin_bit_cast(h2_t, (unsigned)r[0]) + __builtin_bit_cast(h2_t, (unsigned)r[1]); } \
            { auto r = __builtin_amdgcn_permlane32_swap(__builtin_bit_cast(unsigned, v), __builtin_bit_cast(unsigned, v), false, false); v = __builtin_bit_cast(h2_t, (unsigned)r[0]) + __builtin_bit_cast(h2_t, (unsigned)r[1]); } \
            if (g == (p >> 1)) { if (p & 1) m1 = __builtin_bit_cast(unsigned, v); else m0 = __builtin_bit_cast(unsigned, v); } \
        } \
        const h2_t q0 = __builtin_bit_cast(h2_t, m0), q1 = __builtin_bit_cast(h2_t, m1); \
        const f32x4 mine = {(float)q0.x, (float)q0.y, (float)q1.x, (float)q1.y}; \
        const f32x4 xn = x_old + g_vec * mine; \
        *(f32x4*)(XW + (size_t)t * DM + mycol) = xn; \
        if (OUT) { const int b = t / RB, i = t - b * RB; if (i >= CTX) *(f32x4*)(OUT + ((size_t)b * SEQ + (i - CTX)) * DM + mycol) = xn; } \
        t = t1; t1 = t2; t2 = t3; \
    } while (0)
    while (t < MROWS) { SL_VBODY(w, wn); if (!(t < MROWS)) break; SL_VBODY(wn, w); }
#undef SL_VBODY
#undef SL_V1
#undef SL_WK
#undef SL_XG
}
#undef SL_IDS
#undef SL_ROWS
#endif
#ifndef N_LAUNCHES
#define N_LAUNCHES 1
#endif
struct Args { const float* in[26]; float* out; unsigned char* ws; int ph_lo, ph_hi; };
constexpr int NPHASES = 39;
__global__ void __launch_bounds__(NTHREADS, 2) fwd_kernel(Args args) {
    extern __shared__ __attribute__((aligned(16))) unsigned char lds_raw[];
    Frame F_;
    F_.lds = (LAS unsigned char*)lds_raw;
    F_.tid = threadIdx.x; F_.lane = F_.tid & 63; F_.wave = __builtin_amdgcn_readfirstlane(F_.tid >> 6);
    F_.G = gridDim.x; { const int bx = blockIdx.x; F_.vcu = (F_.G % 8 == 0) ? (bx % 8) * (F_.G / 8) + bx / 8 : bx; }
    F_.gw = F_.vcu * NWAVES + F_.wave; F_.NGW = F_.G * NWAVES;
    F_.ws = args.ws;
    volatile LAS unsigned* MISC = (volatile LAS unsigned*)(F_.lds + LDS_MISC);
    if (F_.tid < 32) MISC[F_.tid] = 0u;
    __syncthreads();
    const int lo = args.ph_lo, hi = args.ph_hi;
    XcdBarrier bar; bar.bar = (unsigned*)(args.ws + WS_CTL) + CW_BAR; bar.x = 0; bar.st = nullptr;
    if (N_LAUNCHES == 1 || hi - lo > 1) bar = xcd_barrier_post((unsigned*)(args.ws + WS_CTL) + CW_BAR, MISC + 8);
#if N_LAUNCHES == 1
#define IN(k) true
#define SEAM(k) xcd_barrier(bar)
#else
#define IN(k) (lo <= (k) && (k) < hi)
#define SEAM(k) do { if (IN(k) && IN((k) + 1)) xcd_barrier(bar); } while (0)
#endif
    PG8_LAS unsigned char* glds = (PG8_LAS unsigned char*)lds_raw;

    if (IN(0)) { p0_prologue(F_, args.in); } SEAM(0);

#pragma unroll 1
    for (int lp = 0; lp < 2; ++lp) {
        const int pb = 1 + lp * 19;
        unsigned char* ws = args.ws; asm volatile("" : "+s"(ws));
        Frame F = F_; { int w_ = F_.wave, v_ = F_.vcu, g_ = F_.G; asm volatile("" : "+s"(w_), "+s"(v_), "+s"(g_)); F.wave = w_; F.vcu = v_; F.G = g_; F.gw = v_ * NWAVES + w_; F.NGW = g_ * NWAVES; F.ws = ws; }
        float* mod = (float*)(ws + WS_MOD); float* XW = (float*)(ws + WS_XW);
        bf16_t* H = (bf16_t*)(ws + WS_H); bf16_t* P = (bf16_t*)(ws + WS_P); bf16_t* QRAW = (bf16_t*)(ws + WS_QRAW); bf16_t* KVRAW = (bf16_t*)(ws + WS_KVRAW);
        bf16_t* Q = (bf16_t*)(ws + WS_Q); bf16_t* KB = (bf16_t*)(ws + WS_K); bf16_t* VB = (bf16_t*)(ws + WS_V); bf16_t* CAT = (bf16_t*)(ws + WS_CAT); bf16_t* PQ = (bf16_t*)(ws + WS_PQ);
        int* IDX = (int*)(ws + WS_IDX); float* GATE = (float*)(ws + WS_GATE);
        const float* rope_c = (const float*)(ws + WS_ROPE); const float* rope_a = rope_c + 64 * 32 * 2;
        const float* SMv = (const float*)(ws + WS_SMALL);
        {
            const int l = 2 * lp, i = lp;
            const float* modl = mod + (size_t)l * 3 * NMOD;
            if (lp == 0) { if (IN(pb + 0)) { norm_phase(F, XW, SMv + SM_N1G + l * DM, modl, 0, 2048, H, false); } SEAM(pb + 0); }
            if (IN(pb + 1)) {
                pg8::Gemm g{H, (const bf16_t*)(ws + WS_WIN) + (size_t)i * 4096 * DM, MROWS, 4096, DM, DM, DM}; pg8::StaticOrder S; S.init(MROWS, 4096, F.G, (int)blockIdx.x);
                pg8::EpiBf16 E{P, 4096};
                pg8::gemm_phase<pg8::EpiBf16, pg8::StaticOrder, true, true>(glds, g, S, E, phase_tid(F.wave));
            } SEAM(pb + 1);
            if (IN(pb + 2)) {
                { pg8::Gemm g{P, (const bf16_t*)(ws + WS_WUQ) + (size_t)i * 1536 * 512, MROWS, 1536, 512, 4096, 512}; pg8::StaticOrder S; S.init(MROWS, 1536, F.G, (int)blockIdx.x);
                  pg8::EpiBf16 E{QRAW, 1536};
                  pg8::gemm_phase<pg8::EpiBf16, pg8::StaticOrder, true, true>(glds, g, S, E, phase_tid(F.wave)); }
                __syncthreads();
                { pg8::Gemm g{P + 512, (const bf16_t*)(ws + WS_WUKV) + (size_t)i * 2048 * 256, MROWS, 2048, 256, 4096, 256}; pg8::StaticOrder S; S.init(MROWS, 2048, F.G, (int)blockIdx.x);
                  pg8::EpiBf16 E{KVRAW, 2048};
                  pg8::gemm_phase<pg8::EpiBf16, pg8::StaticOrder, true, true>(glds, g, S, E, phase_tid(F.wave)); }
                __syncthreads();
                conv_phase(F, P, SMv + SM_CW + i * 3072, SMv + SM_CB + i * 1024, CAT);
            } SEAM(pb + 2);
            if (IN(pb + 3)) { prep_even_phase(F, P, QRAW, KVRAW, SMv + SM_AQG + i * 192, SMv + SM_AKG + i * 192, rope_a, Q, KB, VB); } SEAM(pb + 3);
            if (IN(pb + 4)) { attn_even_phase(F, Q, KB, VB, CAT); } SEAM(pb + 4);
            if (IN(pb + 5)) {
                pg8::Gemm g{CAT, (const bf16_t*)(ws + WS_WEO) + (size_t)i * DM * DM, MROWS, DM, DM, DM, DM}; pg8::StaticOrder S; S.init(MROWS, DM, F.G, (int)blockIdx.x);
                pg8::EpiResid E{XW, DM, modl + 4096};
                pg8::gemm_phase<pg8::EpiResid, pg8::StaticOrder, true, true>(glds, g, S, E, phase_tid(F.wave));
            } SEAM(pb + 5);
            if (IN(pb + 6)) { norm_phase(F, XW, SMv + SM_N2G + l * DM, modl, 6144, 8192, H, l == 3, (unsigned*)(ws + WS_XQ), (float*)(ws + WS_XS)); } SEAM(pb + 6);
            if (IN(pb + 7)) {
                pg8::Gemm g{H, (const bf16_t*)(ws + WS_WPQ) + (size_t)l * DM * DM, MROWS, DM, DM, DM, DM}; pg8::StaticOrder S; S.init(MROWS, DM, F.G, (int)blockIdx.x);
                pg8::EpiBf16 E{PQ, DM};
                pg8::gemm_phase<pg8::EpiBf16, pg8::StaticOrder, true, true>(glds, g, S, E, phase_tid(F.wave));
            } SEAM(pb + 7);
            if (IN(pb + 8)) { peer_topk_phase(F, PQ, (const bf16_t*)(ws + WS_SUBK) + (size_t)l * 16 * 128 * 128, IDX, GATE, l == 3); } SEAM(pb + 8);
            {
                const unsigned char* Ut = ws + WS_U + (size_t)l * NEXP * ROWB; const unsigned char* Vt = ws + WS_VT + (size_t)l * NEXP * ROWB;
                peer_u_phase(F, (const unsigned*)(ws + WS_XQ), (const float*)(ws + WS_XS), IDX, Ut, (float*)(ws + WS_PART), false); SEAM(0);
                peer_w_phase(F, (const float*)(ws + WS_PART), IDX, GATE, (const float*)(ws + WS_USC) + l * NEXP, (const float*)(ws + WS_VSC) + l * NEXP, false); SEAM(0);
                peer_v_phase(F, IDX, GATE, Vt, modl + 10240, XW, nullptr, false); SEAM(0);
                norm_phase(F, XW, SMv + SM_N1G + (l + 1) * DM, mod + (size_t)(l + 1) * 3 * NMOD, 0, 2048, H, false); SEAM(0);
            }
        }
        {
            const int l = 2 * lp + 1, i = lp, qb = pb + 10;
            const float* modl = mod + (size_t)l * 3 * NMOD;
            if (IN(qb + 1)) {
                pg8::Gemm g{H, (const bf16_t*)(ws + WS_WQKV) + (size_t)i * 3072 * DM, MROWS, 3072, DM, DM, DM}; pg8::StaticOrder S; S.init(MROWS, 3072, F.G, (int)blockIdx.x);
                pg8::EpiBf16 E{P, 3072};
                pg8::gemm_phase<pg8::EpiBf16, pg8::StaticOrder, true, true>(glds, g, S, E, phase_tid(F.wave));
            } SEAM(qb + 1);
            if (IN(qb + 2)) { prep_odd_phase(F, P, SMv + SM_CQG + i * 128, SMv + SM_CKG + i * 128, rope_c, Q, KB); } SEAM(qb + 2);
            if (IN(qb + 3)) { attn_odd_phase(F, Q, KB, P, CAT, l == 3); } SEAM(qb + 3);
            if (IN(qb + 4)) {
                pg8::Gemm g{CAT, (const bf16_t*)(ws + WS_WCO) + (size_t)i * DM * DM, MROWS, DM, DM, DM, DM}; pg8::StaticOrder S; S.init(MROWS, DM, F.G, (int)blockIdx.x, l == 3);
                pg8::EpiResid E{XW, DM, modl + 4096};
                pg8::gemm_phase<pg8::EpiResid, pg8::StaticOrder, true, true>(glds, g, S, E, phase_tid(F.wave));
            } SEAM(qb + 4);
            if (IN(qb + 5)) { norm_phase(F, XW, SMv + SM_N2G + l * DM, modl, 6144, 8192, H, l == 3, (unsigned*)(ws + WS_XQ), (float*)(ws + WS_XS)); } SEAM(qb + 5);
            if (IN(qb + 6)) {
                pg8::Gemm g{H, (const bf16_t*)(ws + WS_WPQ) + (size_t)l * DM * DM, MROWS, DM, DM, DM, DM}; pg8::StaticOrder S; S.init(MROWS, DM, F.G, (int)blockIdx.x, l == 3);
                pg8::EpiBf16 E{PQ, DM};
                pg8::gemm_phase<pg8::EpiBf16, pg8::StaticOrder, true, true>(glds, g, S, E, phase_tid(F.wave));
            } SEAM(qb + 6);
            if (IN(qb + 7)) { peer_topk_phase(F, PQ, (const bf16_t*)(ws + WS_SUBK) + (size_t)l * 16 * 128 * 128, IDX, GATE, l == 3); } SEAM(qb + 7);
            {
                const unsigned char* Ut = ws + WS_U + (size_t)l * NEXP * ROWB; const unsigned char* Vt = ws + WS_VT + (size_t)l * NEXP * ROWB;
                peer_u_phase(F, (const unsigned*)(ws + WS_XQ), (const float*)(ws + WS_XS), IDX, Ut, (float*)(ws + WS_PART), l == 3); SEAM(0);
                peer_w_phase(F, (const float*)(ws + WS_PART), IDX, GATE, (const float*)(ws + WS_USC) + l * NEXP, (const float*)(ws + WS_VSC) + l * NEXP, l == 3); SEAM(0);
                peer_v_phase(F, IDX, GATE, Vt, modl + 10240, XW, (l == 3) ? args.out : nullptr, l == 3);
                if (lp == 0) { SEAM(0); norm_phase(F, XW, SMv + SM_N1G + (l + 1) * DM, mod + (size_t)(l + 1) * 3 * NMOD, 0, 2048, H, false); SEAM(0); }
            }
        }
    }
#undef IN
#undef SEAM
}

extern "C" void kernel_launch(void* const* d_in, const int* in_sizes, int n_in, void* d_out, int out_size, void* d_ws, size_t ws_size, hipStream_t stream) {
    static int grid = 0;
    if (grid == 0) {
        if (n_in != 26 || out_size != NBATCH * SEQ * DM || ws_size < WS_END) { fprintf(stderr, "kernel_launch: unexpected shapes: n_in %d out %d ws %zu (need %zu)\n", n_in, out_size, ws_size, (size_t)WS_END); grid = -1; return; }
        int dev = 0, cus = 0, per_cu = 0;
        if (hipGetDevice(&dev) != hipSuccess || hipDeviceGetAttribute(&cus, hipDeviceAttributeMultiprocessorCount, dev) != hipSuccess) { fprintf(stderr, "kernel_launch: device query failed\n"); grid = -1; return; }
        if (hipFuncSetAttribute((const void*)fwd_kernel, hipFuncAttributeMaxDynamicSharedMemorySize, LDS_BYTES) != hipSuccess) { fprintf(stderr, "kernel_launch: hipFuncSetAttribute failed\n"); grid = -1; return; }
        if (hipOccupancyMaxActiveBlocksPerMultiprocessor(&per_cu, (const void*)fwd_kernel, NTHREADS, LDS_BYTES) != hipSuccess || per_cu < 1) { fprintf(stderr, "kernel_launch: occupancy query says %d blocks per CU\n", per_cu); (void)hipGetLastError(); grid = -1; return; }
        if (cus % 8 != 0) { fprintf(stderr, "kernel_launch: %d CUs: the phase decompositions assume a multiple of 8 workgroups\n", cus); grid = -1; return; }
        grid = cus;
    }
    if (grid < 0) return;
    (void)hipMemsetAsync((char*)d_ws + WS_CTL, 0, CTL_ZERO_BYTES, stream);
    Args a{};
    for (int i = 0; i < 26; ++i) a.in[i] = (const float*)d_in[i];
    a.out = (float*)d_out; a.ws = (unsigned char*)d_ws;
    for (int li = 0; li < N_LAUNCHES; ++li) {
        a.ph_lo = (N_LAUNCHES == 1) ? 0 : li; a.ph_hi = (N_LAUNCHES == 1) ? NPHASES : li + 1;
        hipLaunchKernelGGL(fwd_kernel, dim3(grid), dim3(NTHREADS), LDS_BYTES, stream, a);
        const hipError_t le = hipPeekAtLastError();
        if (le != hipSuccess) { fprintf(stderr, "kernel_launch: launch %d failed: %s\n", li, hipGetErrorName(le)); break; }
    }
}
```

```cpp
#include <hip/hip_runtime.h>
#include <cstdio>
#include <cstdint>
namespace pg8 {
#define PG8_LAS __attribute__((address_space(3)))
typedef unsigned short bf16_t;
typedef short bf16x8 __attribute__((ext_vector_type(8)));
typedef float f32x4 __attribute__((ext_vector_type(4)));
typedef unsigned u32x4 __attribute__((ext_vector_type(4)));
constexpr int BM = 256, BK = 64, HALF = 128, HTB = HALF * BK * 2  , STAGE_BYTES = 8 * HTB, NXCD = 8, WGM = 8;

__host__ __device__ __forceinline__ int lds_byte(int r, int c) { const int st = (r >> 4) * 2 + (c >> 5), rr = r & 15, cc = c & 31, ob = rr * 64 + cc * 2; return st * 1024 + (ob ^ (((ob >> 9) & 1) << 5)); }
__host__ __device__ __forceinline__ void stage_rc(int b, int& R, int& C) { const int st = b / 1024, sb = b % 1024, swz = sb ^ (((sb >> 9) & 1) << 5); R = (st >> 1) * 16 + swz / 64; C = (st & 1) * 32 + (swz % 64) / 2; }
__host__ __device__ __forceinline__ int perm32(int rho) { const int n = rho >> 4, i = rho & 15; return 8 * (i >> 2) + 4 * n + (i & 3); }

struct Unit { int pm, pn; };
struct Gemm { const bf16_t* A; const bf16_t* Bt; int M, N, K, lda, ldb; };

struct StaticOrder {
    int nM, nN, nwg, G, c; bool lat_only;
    __host__ __device__ void init(int M, int N, int G_, int c_, bool lat_only_ = false) { lat_only = lat_only_; nM = lat_only_ ? 32 : M / BM; nN = N / BM; nwg = nM * nN; G = G_; c = c_; }
    __host__ __device__ bool next(int i, Unit& u) const {
        const long L = (long)i * G + c; if (L >= nwg) return false;
        int wgid = (int)L; { const int q = nwg / NXCD, r = nwg % NXCD, xcd = wgid % NXCD, off = wgid / NXCD; wgid = (xcd < r ? xcd * (q + 1) : r * (q + 1) + (xcd - r) * q) + off; }
        const int nig = WGM * nN, gid = wgid / nig, fm = gid * WGM, gsz = (nM - fm) < WGM ? (nM - fm) : WGM;
        u.pm = fm + ((wgid % nig) % gsz); u.pn = (wgid % nig) / gsz; if (lat_only) u.pm += 1 + (u.pm >= 16 ? 1 : 0); return true;
    }
    __device__ __forceinline__ void a_ready(const Unit&) const {}
    __device__ __forceinline__ void done(const Unit&) const {}
};
__device__ __forceinline__ unsigned cvt_pk_bf16(float lo, float hi) { unsigned r; asm volatile("v_cvt_pk_bf16_f32 %0, %1, %2" : "=v"(r) : "v"(lo), "v"(hi)); return r; }
typedef float f32x2 __attribute__((ext_vector_type(2)));
struct EpiBf16 {
    static constexpr bool PERM = true, AFTER_DRAIN = false;
    bf16_t* O; int ldc;
    __device__ __forceinline__ void operator()(const f32x4 (&acc)[2][2][4][2], const Unit& u, int wr, int wc, int fr, int fq) const {
        const int row0 = u.pm * BM + wr * 64 + fr, col0 = u.pn * BM + wc * 32 + 8 * fq;
#pragma unroll
        for (int ai = 0; ai < 2; ++ai)
#pragma unroll
            for (int m = 0; m < 4; ++m) { bf16_t* rowp = O + (size_t)(row0 + ai * HALF + m * 16) * ldc + col0;
#pragma unroll
                for (int bj = 0; bj < 2; ++bj) { const f32x4 v0 = acc[ai][bj][m][0], v1 = acc[ai][bj][m][1];
                    u32x4 w; w.x = cvt_pk_bf16(v0[0], v0[1]); w.y = cvt_pk_bf16(v0[2], v0[3]); w.z = cvt_pk_bf16(v1[0], v1[1]); w.w = cvt_pk_bf16(v1[2], v1[3]);
                    *(u32x4*)(rowp + bj * HALF) = w; } }
    }
};
struct EpiResid {
    static constexpr bool PERM = false, AFTER_DRAIN = false;
    float* X; int ldc; const float* gate;
    __device__ __forceinline__ void operator()(const f32x4 (&acc)[2][2][4][2], const Unit& u, int wr, int wc, int fr, int fq) const {
        const int row0 = u.pm * BM + wr * 64 + fr, col0 = u.pn * BM + wc * 32 + 4 * fq;
        const int cls = (u.pm % 17 == 0) ? 2 : (u.pm / 17);
        const float* gp = gate + (size_t)cls * 12288 + col0;
        f32x4 gv[2][2];
#pragma unroll
        for (int bj = 0; bj < 2; ++bj)
#pragma unroll
            for (int n = 0; n < 2; ++n) gv[bj][n] = *(const f32x4*)(gp + bj * HALF + n * 16);
#pragma unroll
        for (int ai = 0; ai < 2; ++ai)
#pragma unroll
            for (int m = 0; m < 4; ++m) { float* rowp = X + (size_t)(row0 + ai * HALF + m * 16) * ldc + col0;
#pragma unroll
                for (int bj = 0; bj < 2; ++bj)
#pragma unroll
                    for (int n = 0; n < 2; ++n) { f32x4* p = (f32x4*)(rowp + bj * HALF + n * 16); *p = *p + gv[bj][n] * acc[ai][bj][m][n]; } }
    }
};
template <class Epi, class Sched, bool ALIGN_EPI = false, bool SP2 = false>
__device__ __forceinline__ void gemm_phase(PG8_LAS unsigned char* lds, const Gemm g, const Sched& S, const Epi& E, int tid_in) {
    int tid_ = tid_in; asm volatile("" : "+v"(tid_));
    const int tid = tid_, wid = __builtin_amdgcn_readfirstlane(tid >> 6), lane = tid & 63, wr = wid >> 2, wc = wid & 3, fr = lane & 15, fq = lane >> 4;
    const int K = g.K, nt = K / BK;
    unsigned voffA[2], voffB[2];
#pragma unroll
    for (int i = 0; i < 2; ++i) { int R, C; stage_rc(tid * 16 + i * 8192, R, C); const int Rb = Epi::PERM ? ((R & ~31) + perm32(R & 31)) : R;
        voffA[i] = (unsigned)(R * g.lda + C) * 2u; voffB[i] = (unsigned)(Rb * g.ldb + C) * 2u; }
    const size_t kstep = (size_t)(BK * 2);
    const size_t hstepA = (size_t)HALF * g.lda * 2, hstepB = (size_t)HALF * g.ldb * 2;
    const size_t tstepA = 2 * hstepA, tstepB = 2 * hstepB;
    const unsigned ldsw = (unsigned)wid * 1024u;
    const int aoff = lds_byte(wr * 64 + fr, fq * 8), boff = lds_byte(wc * 32 + fr, fq * 8);
#define PG8_SA(b, h) (((b) * 2 + (h)) * HTB)
#define PG8_SB(b, h) ((4 + (b) * 2 + (h)) * HTB)
#define PG8_STAGE(bufoff, gbase, voff) do { _Pragma("unroll") for (int _i = 0; _i < 2; ++_i) \
        __builtin_amdgcn_global_load_lds((const unsigned*)((const char*)(gbase) + (voff)[_i]), (PG8_LAS unsigned*)(lds + (bufoff) + ldsw + _i * 8192), 16, 0, 0); } while (0)
#define PG8_LDA(dst, b, h) do { _Pragma("unroll") for (int m = 0; m < 4; ++m) _Pragma("unroll") for (int k = 0; k < 2; ++k) dst[m][k] = *(const PG8_LAS bf16x8*)(lds + PG8_SA(b, h) + aoff + m * 2048 + k * 1024); } while (0)
#define PG8_LDB(dst, b, h) do { _Pragma("unroll") for (int n = 0; n < 2; ++n) _Pragma("unroll") for (int k = 0; k < 2; ++k) dst[n][k] = *(const PG8_LAS bf16x8*)(lds + PG8_SB(b, h) + boff + n * 2048 + k * 1024); } while (0)
#define PG8_MMA(ai, bj, At, Bt) do { __builtin_amdgcn_s_setprio(1); _Pragma("unroll") for (int m = 0; m < 4; ++m) _Pragma("unroll") for (int n = 0; n < 2; ++n) _Pragma("unroll") for (int k = 0; k < 2; ++k) \
        acc[ai][bj][m][n] = __builtin_amdgcn_mfma_f32_16x16x32_bf16(Bt[n][k], At[m][k], acc[ai][bj][m][n], 0, 0, 0); __builtin_amdgcn_s_setprio(0); } while (0)
#define PG8_WAIT_V(n) asm volatile("s_waitcnt vmcnt(" #n ")" ::: "memory")
#define PG8_WAIT_L(n) asm volatile("s_waitcnt lgkmcnt(" #n ")" ::: "memory")
#define PG8_BAR __builtin_amdgcn_s_barrier()
#define PG8_SCHED __builtin_amdgcn_sched_barrier(0)
    Unit cur, nxt; int ui = 0;
    if (!S.next(0, cur)) return;
    f32x4 acc[2][2][4][2];
#pragma unroll
    for (int a = 0; a < 2; ++a)
#pragma unroll
        for (int b = 0; b < 2; ++b)
#pragma unroll
            for (int m = 0; m < 4; ++m)
#pragma unroll
                for (int n = 0; n < 2; ++n) acc[a][b][m][n] = (f32x4){0.f, 0.f, 0.f, 0.f};
    bf16x8 At[4][2], B0[2][2], B1[2][2];
    const char* cA = (const char*)g.A + (size_t)cur.pm * tstepA; const char* cB = (const char*)g.Bt + (size_t)cur.pn * tstepB;
    S.a_ready(cur);
    if constexpr (SP2) {
        PG8_STAGE(PG8_SB(0, 0), cB, voffB); PG8_STAGE(PG8_SB(0, 1), cB + hstepB, voffB); PG8_STAGE(PG8_SA(0, 0), cA, voffA); PG8_STAGE(PG8_SA(0, 1), cA + hstepA, voffA);
        if (wr == 1) PG8_BAR;
        PG8_WAIT_V(2); PG8_BAR;
        PG8_STAGE(PG8_SB(1, 0), cB + kstep, voffB); PG8_STAGE(PG8_SA(1, 0), cA + kstep, voffA); PG8_STAGE(PG8_SB(1, 1), cB + hstepB + kstep, voffB);
        PG8_WAIT_V(6); PG8_BAR;
    } else {
        PG8_STAGE(PG8_SB(0, 0), cB, voffB); PG8_STAGE(PG8_SA(0, 0), cA, voffA); PG8_STAGE(PG8_SB(0, 1), cB + hstepB, voffB); PG8_STAGE(PG8_SA(0, 1), cA + hstepA, voffA);
        if (wr == 1) PG8_BAR;
        PG8_WAIT_V(4); PG8_BAR;
        PG8_STAGE(PG8_SB(1, 0), cB + kstep, voffB); PG8_STAGE(PG8_SA(1, 0), cA + kstep, voffA); PG8_STAGE(PG8_SB(1, 1), cB + hstepB + kstep, voffB);
        PG8_WAIT_V(6); PG8_BAR;
    }
    for (;;) {
        const bool has_next = S.next(ui + 1, nxt);
        const char* nA = has_next ? (const char*)g.A + (size_t)nxt.pm * tstepA : cA; const char* nB = has_next ? (const char*)g.Bt + (size_t)nxt.pn * tstepB : cB;
        for (int t = 0; t < nt; t += 2) {
            const bool last = (t == nt - 2);
            const char* a1 = cA + (size_t)(t + 1) * kstep;
            const char* a2 = last ? nA : cA + (size_t)(t + 2) * kstep; const char* b2 = last ? nB : cB + (size_t)(t + 2) * kstep;
            const char* a3 = a2 + kstep; const char* b3 = b2 + kstep;
            if (last && has_next) S.a_ready(nxt);
            if constexpr (SP2) {
            PG8_LDB(B0, 0, 0); PG8_LDB(B1, 0, 1); PG8_SCHED; PG8_LDA(At, 0, 0); PG8_STAGE(PG8_SA(1, 1), a1 + hstepA, voffA);
            PG8_WAIT_V(8); PG8_WAIT_L(0); PG8_BAR; PG8_MMA(0, 0, At, B0); PG8_MMA(0, 1, At, B1); PG8_BAR; PG8_SCHED;
            PG8_LDA(At, 0, 1); PG8_STAGE(PG8_SB(0, 0), b2, voffB); PG8_STAGE(PG8_SB(0, 1), b2 + hstepB, voffB); PG8_STAGE(PG8_SA(0, 0), a2, voffA);
            PG8_WAIT_V(8); PG8_WAIT_L(0); PG8_BAR; PG8_MMA(1, 0, At, B0); PG8_MMA(1, 1, At, B1); PG8_BAR; PG8_SCHED;
            PG8_LDB(B0, 1, 0); PG8_LDB(B1, 1, 1); PG8_SCHED; PG8_LDA(At, 1, 0); PG8_STAGE(PG8_SA(0, 1), a2 + hstepA, voffA);
            PG8_WAIT_V(8); PG8_WAIT_L(0); PG8_BAR; PG8_MMA(0, 0, At, B0); PG8_MMA(0, 1, At, B1); PG8_BAR; PG8_SCHED;
            PG8_LDA(At, 1, 1); PG8_STAGE(PG8_SB(1, 0), b3, voffB); PG8_STAGE(PG8_SB(1, 1), b3 + hstepB, voffB); PG8_STAGE(PG8_SA(1, 0), a3, voffA);
            PG8_WAIT_V(8); PG8_WAIT_L(0); PG8_BAR; PG8_MMA(1, 0, At, B0); PG8_MMA(1, 1, At, B1); PG8_BAR; PG8_SCHED;
            } else {
            PG8_LDB(B0, 0, 0); PG8_SCHED; PG8_LDA(At, 0, 0); PG8_STAGE(PG8_SA(1, 1), a1 + hstepA, voffA);
            PG8_WAIT_L(8); PG8_BAR; PG8_WAIT_L(0); PG8_MMA(0, 0, At, B0); PG8_BAR; PG8_SCHED;
            PG8_LDB(B1, 0, 1); PG8_STAGE(PG8_SB(0, 0), b2, voffB);
            PG8_BAR; PG8_WAIT_L(0); PG8_MMA(0, 1, At, B1); PG8_BAR;
            PG8_LDA(At, 0, 1); PG8_STAGE(PG8_SA(0, 0), a2, voffA);
            PG8_BAR; PG8_WAIT_L(0); PG8_MMA(1, 0, At, B0); PG8_BAR; PG8_SCHED;
            PG8_STAGE(PG8_SB(0, 1), b2 + hstepB, voffB);
            PG8_WAIT_V(6); PG8_BAR; PG8_MMA(1, 1, At, B1); PG8_BAR;
            PG8_LDB(B0, 1, 0); PG8_SCHED; PG8_LDA(At, 1, 0); PG8_STAGE(PG8_SA(0, 1), a2 + hstepA, voffA);
            PG8_WAIT_L(8); PG8_BAR; PG8_WAIT_L(0); PG8_MMA(0, 0, At, B0); PG8_BAR; PG8_SCHED;
            PG8_LDB(B1, 1, 1); PG8_STAGE(PG8_SB(1, 0), b3, voffB);
            PG8_BAR; PG8_WAIT_L(0); PG8_MMA(0, 1, At, B1); PG8_BAR;
            PG8_LDA(At, 1, 1); PG8_STAGE(PG8_SA(1, 0), a3, voffA);
            PG8_BAR; PG8_WAIT_L(0); PG8_MMA(1, 0, At, B0); PG8_BAR; PG8_SCHED;
            PG8_STAGE(PG8_SB(1, 1), b3 + hstepB, voffB);
            PG8_WAIT_V(6); PG8_BAR; PG8_MMA(1, 1, At, B1); PG8_BAR;
            }
        }
        if constexpr (ALIGN_EPI) { if (wr == 0) PG8_BAR; }
        if constexpr (!Epi::AFTER_DRAIN) { E(acc, cur, wr, wc, fr, fq); S.done(cur); }
        if (!has_next) break;
#pragma unroll
        for (int a = 0; a < 2; ++a)
#pragma unroll
            for (int b = 0; b < 2; ++b)
#pragma unroll
                for (int m = 0; m < 4; ++m)
#pragma unroll
                    for (int n = 0; n < 2; ++n) acc[a][b][m][n] = (f32x4){0.f, 0.f, 0.f, 0.f};
        cur = nxt; cA = nA; cB = nB; ++ui;
        if constexpr (ALIGN_EPI) { if (wr == 1) PG8_BAR; }
    }
    PG8_WAIT_V(0);
    if constexpr (!ALIGN_EPI) { if (wr == 0) PG8_BAR; }
    PG8_BAR;
    if constexpr (Epi::AFTER_DRAIN) { E.fused(acc, cur, wr, wc, fr, fq, lds, wid, lane); S.done(cur); }
#undef PG8_SA
#undef PG8_SB
#undef PG8_STAGE
#undef PG8_LDA
#undef PG8_LDB
#undef PG8_MMA
#undef PG8_WAIT_V
#undef PG8_WAIT_L
#undef PG8_BAR
#undef PG8_SCHED
}
}
namespace att {
typedef unsigned short bf16_t;
using bf16x8 = __attribute__((ext_vector_type(8))) short;
using s16x4  = __attribute__((ext_vector_type(4))) short;
using f32x16 = __attribute__((ext_vector_type(16))) float;
using u32x4  = __attribute__((ext_vector_type(4))) unsigned;
constexpr int DV = 128, NW = 8, QBLK = 32, KVBLK = 64;
constexpr float THR = 8.f;
constexpr int SHM_V = KVBLK * DV * 2;
template <int DQK> struct Cfg {
    static constexpr int SHM_K = KVBLK * DQK * 2, KROWB = DQK * 2, NCK = DQK / 64, C8 = DQK / 8, ND0 = DQK / 16;
    static constexpr float SCALE = (DQK == 128) ? 0.088388347648318440f : 0.072168783648703220f;
    static constexpr int LDS_BYTES = 2 * SHM_V + 2 * SHM_K + NW * 64 * 4;
};
#define ATT_SBAR() __builtin_amdgcn_sched_barrier(0)
__device__ __forceinline__ int crow(int r, int hi) { return (r & 3) + 8 * (r >> 2) + 4 * hi; }
__device__ __forceinline__ unsigned cvtpk(float lo, float hi) { unsigned r; asm volatile("v_cvt_pk_bf16_f32 %0, %1, %2" : "=v"(r) : "v"(lo), "v"(hi)); return r; }
template <int DQK> __device__ __forceinline__ int kswz(int row, int colB) {
    const int key = (DQK == 128) ? (row & 7) : ((row >> 1) & 7);
    return row * (DQK * 2) + (colB ^ (key << 4));
}
template <int DQK> __device__ __forceinline__ void partialSM(f32x16& p0, f32x16& p1, float& m_reg, float& mn, float& alpha) {
    constexpr float SCALE = Cfg<DQK>::SCALE, C = SCALE * 1.4426950408889634f;
    float pmax = p0[0];
#pragma unroll
    for (int r = 1; r < 16; ++r) pmax = fmaxf(pmax, p0[r]);
#pragma unroll
    for (int r = 0; r < 16; ++r) pmax = fmaxf(pmax, p1[r]);
    { auto rr = __builtin_amdgcn_permlane32_swap(__float_as_uint(pmax), __float_as_uint(pmax), false, false);
      pmax = fmaxf(__uint_as_float(rr[0]), __uint_as_float(rr[1])); }
    if (__builtin_expect(__all(pmax - m_reg <= THR / SCALE), 1)) { mn = m_reg; alpha = 1.f; }
    else { mn = fmaxf(m_reg, pmax); alpha = __builtin_amdgcn_exp2f((m_reg - mn) * C); m_reg = mn; }
    const float mnC = -mn * C;
#pragma unroll
    for (int r = 0; r < 16; ++r) p0[r] = fmaf(p0[r], C, mnC);
#pragma unroll
    for (int r = 0; r < 16; ++r) p1[r] = fmaf(p1[r], C, mnC);
#pragma unroll
    for (int r = 0; r < 16; ++r) p0[r] = __builtin_amdgcn_exp2f(p0[r]);
}
__device__ __forceinline__ void finishSM(f32x16& p0, f32x16& p1, float alpha, float& l_reg, bf16x8& pa0, bf16x8& pa1, bf16x8& pa2, bf16x8& pa3) {
#pragma unroll
    for (int r = 0; r < 16; ++r) p1[r] = __builtin_amdgcn_exp2f(p1[r]);
    float ps = 0;
#pragma unroll
    for (int r = 0; r < 16; ++r) ps += p0[r];
#pragma unroll
    for (int r = 0; r < 16; ++r) ps += p1[r];
    { auto rr = __builtin_amdgcn_permlane32_swap(__float_as_uint(ps), __float_as_uint(ps), false, false);
      ps = __uint_as_float(rr[0]) + __uint_as_float(rr[1]); }
    l_reg = l_reg * alpha + ps;
#define ATT_PK4(P, BASE, OUT) do { unsigned a0 = cvtpk(P[BASE + 0], P[BASE + 1]), a1 = cvtpk(P[BASE + 2], P[BASE + 3]);   \
    unsigned b0 = cvtpk(P[BASE + 4], P[BASE + 5]), b1 = cvtpk(P[BASE + 6], P[BASE + 7]);                              \
    auto r0 = __builtin_amdgcn_permlane32_swap(a0, b0, false, false); auto r1 = __builtin_amdgcn_permlane32_swap(a1, b1, false, false); \
    u32x4 w = {r0[0], r1[0], r0[1], r1[1]}; OUT = *reinterpret_cast<bf16x8*>(&w); } while (0)
    ATT_PK4(p0, 0, pa0); ATT_PK4(p0, 8, pa1); ATT_PK4(p1, 0, pa2); ATT_PK4(p1, 8, pa3);
#undef ATT_PK4
}
template <int DQK> __device__ __forceinline__ void qkt(f32x16& p0, f32x16& p1, const char* Ks, const bf16x8* qr, int r32, int hi) {
    p0 = f32x16{}; p1 = f32x16{};
#pragma unroll
    for (int d0 = 0; d0 < Cfg<DQK>::ND0; ++d0) { const int cb = (d0 * 16 + hi * 8) * 2;
        bf16x8 b0 = *reinterpret_cast<const bf16x8*>(Ks + kswz<DQK>(r32, cb));
        bf16x8 b1 = *reinterpret_cast<const bf16x8*>(Ks + kswz<DQK>(32 + r32, cb));
        p0 = __builtin_amdgcn_mfma_f32_32x32x16_bf16(b0, qr[d0], p0, 0, 0, 0);
        p1 = __builtin_amdgcn_mfma_f32_32x32x16_bf16(b1, qr[d0], p1, 0, 0, 0); }
}
__device__ __forceinline__ int v_st(int k, int c) { const int kk = (k & ~0xC) | ((k & 4) << 1) | ((k & 8) >> 1); return ((kk >> 3) * 4 + (c >> 5)) * 512 + ((kk & 7) * 32 + (c & 31)) * 2; }
__device__ __forceinline__ int v_rd_base(int lane) { return ((lane & 3) << 3) | (((lane >> 2) & 3) << 6) | (((lane >> 4) & 1) << 5) | (((lane >> 5) & 1) << 8); }
constexpr int v_rd_off(int d0, int ks, int half) { return d0 * 512 + ks * 4096 + half * 2048; }
template <int OFF> __device__ __forceinline__ s16x4 tr_read(int vb) {
    s16x4 r; asm volatile("ds_read_b64_tr_b16 %0, %1 offset:%2" : "=&v"(r) : "v"(vb), "i"(OFF) : "memory"); return r;
}
template <int D0> __device__ __forceinline__ void pv_one(f32x16& od, int vb, bf16x8 pa0, bf16x8 pa1, bf16x8 pa2, bf16x8 pa3) {
    const s16x4 l0 = tr_read<v_rd_off(D0, 0, 0)>(vb), h0 = tr_read<v_rd_off(D0, 0, 1)>(vb), l1 = tr_read<v_rd_off(D0, 1, 0)>(vb), h1 = tr_read<v_rd_off(D0, 1, 1)>(vb);
    const s16x4 l2 = tr_read<v_rd_off(D0, 2, 0)>(vb), h2 = tr_read<v_rd_off(D0, 2, 1)>(vb), l3 = tr_read<v_rd_off(D0, 3, 0)>(vb), h3 = tr_read<v_rd_off(D0, 3, 1)>(vb);
    asm volatile("s_waitcnt lgkmcnt(0)" ::: "memory"); ATT_SBAR();
#define ATT_PK(L, H) (bf16x8){L[0], L[1], L[2], L[3], H[0], H[1], H[2], H[3]}
    od = __builtin_amdgcn_mfma_f32_32x32x16_bf16(pa0, ATT_PK(l0, h0), od, 0, 0, 0);
    od = __builtin_amdgcn_mfma_f32_32x32x16_bf16(pa1, ATT_PK(l1, h1), od, 0, 0, 0);
    od = __builtin_amdgcn_mfma_f32_32x32x16_bf16(pa2, ATT_PK(l2, h2), od, 0, 0, 0);
    od = __builtin_amdgcn_mfma_f32_32x32x16_bf16(pa3, ATT_PK(l3, h3), od, 0, 0, 0);
#undef ATT_PK
}
__device__ __forceinline__ void pv_d0(f32x16* o, int vb, bf16x8 pa0, bf16x8 pa1, bf16x8 pa2, bf16x8 pa3) {
    pv_one<0>(o[0], vb, pa0, pa1, pa2, pa3); pv_one<1>(o[1], vb, pa0, pa1, pa2, pa3); pv_one<2>(o[2], vb, pa0, pa1, pa2, pa3); pv_one<3>(o[3], vb, pa0, pa1, pa2, pa3);
}
template <int DQK, int LDQ, int LDK, int LDV, int LDO, int SDEPTH>
__device__ __forceinline__ void attn_body(const bf16_t* __restrict__ Qb, const bf16_t* __restrict__ Kh, const bf16_t* __restrict__ Vh, bf16_t* __restrict__ Ob, int seq, char* lds, int tid_in) {
    using C_ = Cfg<DQK>;
    constexpr int SHM_K = C_::SHM_K, NCK = C_::NCK, C8 = C_::C8, ND0 = C_::ND0;
    int tid_ = tid_in; asm volatile("" : "+v"(tid_));
    const int tid = tid_, wid = tid >> 6, lane = tid & 63, r32 = lane & 31, hi = lane >> 5;
    char* V_lds = lds; char* K_lds = lds + 2 * SHM_V;
    float* ws = (float*)(lds + 2 * SHM_V + 2 * SHM_K) + wid * 64; float* li_l = ws; float* al_l = ws + 32;
    float m_reg = -1e30f, l_reg = 0; f32x16 o[4] = {}; bf16x8 qr[ND0];
    const bf16_t* Qw = Qb + (long)(wid * QBLK + r32) * LDQ + hi * 8;
#pragma unroll
    for (int d0 = 0; d0 < ND0; ++d0) qr[d0] = *reinterpret_cast<const bf16x8*>(Qw + d0 * 16);
    const int sr = tid >> 4, sc = (tid & 15) * 8, vst0 = v_st(sr, sc), vst1 = v_st(32 + sr, sc);
    int krow[NCK], kcol[NCK];
#pragma unroll
    for (int i = 0; i < NCK; ++i) { const int ci = tid + 512 * i; krow[i] = ci / C8; kcol[i] = (ci % C8) * 8; }
    const int vb0 = (int)(uintptr_t)V_lds + v_rd_base(lane);
    struct { bf16x8 vs0, vs1, ks[NCK]; } sr_[SDEPTH];
#define ATT_SLOAD(i, k0) do { sr_[i].vs0 = *reinterpret_cast<const bf16x8*>(&Vh[(long)((k0) + sr) * LDV + sc]); sr_[i].vs1 = *reinterpret_cast<const bf16x8*>(&Vh[(long)((k0) + 32 + sr) * LDV + sc]); \
    _Pragma("unroll") for (int c_ = 0; c_ < NCK; ++c_) sr_[i].ks[c_] = *reinterpret_cast<const bf16x8*>(&Kh[(long)((k0) + krow[c_]) * LDK + kcol[c_]]); } while (0)
#define ATT_SWRITE(b, i) do { *(bf16x8*)(V_lds + (b) * SHM_V + vst0) = sr_[i].vs0; *(bf16x8*)(V_lds + (b) * SHM_V + vst1) = sr_[i].vs1; \
    _Pragma("unroll") for (int c_ = 0; c_ < NCK; ++c_) *(bf16x8*)(K_lds + (b) * SHM_K + kswz<DQK>(krow[c_], kcol[c_] * 2)) = sr_[i].ks[c_]; } while (0)
#define ATT_SWAIT() do { if constexpr (SDEPTH == 2) { if constexpr (NCK == 2) asm volatile("s_waitcnt vmcnt(4)" ::: "memory"); else asm volatile("s_waitcnt vmcnt(5)" ::: "memory"); } else asm volatile("s_waitcnt vmcnt(0)" ::: "memory"); } while (0)
#define ATT_RESC(a) do { if (__any((a) < 1.f)) { if (hi == 0) al_l[r32] = (a); asm volatile("s_waitcnt lgkmcnt(0)" ::: "memory"); \
    _Pragma("unroll") for (int d = 0; d < 4; ++d) _Pragma("unroll") for (int r = 0; r < 16; ++r) o[d][r] *= al_l[crow(r, hi)]; } } while (0)
    f32x16 pA0, pA1, pB0, pB1; float mnA, mnB, alA, alB; bf16x8 pa0, pa1, pa2, pa3; const int NT = seq / KVBLK;
    constexpr int SE = 0, SO = SDEPTH - 1;
    ATT_SLOAD(SE, 0); asm volatile("s_waitcnt vmcnt(0)" ::: "memory"); ATT_SWRITE(0, SE); __syncthreads();
    qkt<DQK>(pA0, pA1, K_lds, qr, r32, hi); partialSM<DQK>(pA0, pA1, m_reg, mnA, alA);
    ATT_SLOAD(SO, KVBLK); if constexpr (SDEPTH == 2) { if (2 < NT) ATT_SLOAD(SE, 2 * KVBLK); }
    ATT_SWAIT(); ATT_SWRITE(1, SO); __syncthreads();
    for (int j = 1; j + 1 < NT; j += 2) {
        ATT_SBAR(); qkt<DQK>(pB0, pB1, K_lds + SHM_K, qr, r32, hi);
        finishSM(pA0, pA1, alA, l_reg, pa0, pa1, pa2, pa3); ATT_SBAR();
        ATT_SLOAD(SO, (j + SDEPTH) * KVBLK); ATT_SBAR();
        pv_d0(o, vb0, pa0, pa1, pa2, pa3); partialSM<DQK>(pB0, pB1, m_reg, mnB, alB);
        __syncthreads(); ATT_SWAIT(); ATT_SWRITE(0, SE);
        ATT_RESC(alB); __syncthreads();
        ATT_SBAR(); qkt<DQK>(pA0, pA1, K_lds, qr, r32, hi);
        finishSM(pB0, pB1, alB, l_reg, pa0, pa1, pa2, pa3); ATT_SBAR();
        if (SDEPTH == 1 || j + 3 < NT) ATT_SLOAD(SE, (j + 1 + SDEPTH) * KVBLK); ATT_SBAR();
        pv_d0(o, vb0 + (int)SHM_V, pa0, pa1, pa2, pa3); partialSM<DQK>(pA0, pA1, m_reg, mnA, alA);
        __syncthreads(); ATT_SWAIT(); ATT_SWRITE(1, SO);
        ATT_RESC(alA); __syncthreads();
    }
    ATT_SBAR(); qkt<DQK>(pB0, pB1, K_lds + SHM_K, qr, r32, hi);
    finishSM(pA0, pA1, alA, l_reg, pa0, pa1, pa2, pa3); ATT_SBAR();
    pv_d0(o, vb0, pa0, pa1, pa2, pa3); partialSM<DQK>(pB0, pB1, m_reg, mnB, alB);
    __syncthreads(); ATT_RESC(alB);
    finishSM(pB0, pB1, alB, l_reg, pa0, pa1, pa2, pa3); ATT_SBAR();
    pv_d0(o, vb0 + (int)SHM_V, pa0, pa1, pa2, pa3);
    if (hi == 0) li_l[r32] = l_reg;
    asm volatile("s_waitcnt lgkmcnt(0)" ::: "memory");
    __syncthreads();
    float rli[16];
#pragma unroll
    for (int r = 0; r < 16; ++r) rli[r] = __builtin_amdgcn_rcpf(li_l[crow(r, hi)]);
    unsigned short* stg = (unsigned short*)(lds + wid * 8192);
#pragma unroll
    for (int r = 0; r < 16; ++r) { const int orow = crow(r, hi);
#pragma unroll
        for (int d0 = 0; d0 < 4; ++d0) { const unsigned w = cvtpk(o[d0][r] * rli[r], 0.f); stg[orow * 128 + d0 * 32 + r32] = (unsigned short)(w & 0xffffu); } }
    asm volatile("s_waitcnt lgkmcnt(0)" ::: "memory");
    bf16_t* Ow = Ob + (long)(wid * QBLK) * LDO;
#pragma unroll
    for (int i = 0; i < 8; ++i) { const int id = lane + 64 * i, row = id >> 4, c16 = id & 15;
        const u32x4 v = *(const u32x4*)((const char*)stg + row * 256 + c16 * 16);
        *(u32x4*)(Ow + (long)row * LDO + c16 * 8) = v; }
    asm volatile("s_waitcnt lgkmcnt(0)" ::: "memory");
    __syncthreads();
#undef ATT_SLOAD
#undef ATT_SWRITE
#undef ATT_SWAIT
#undef ATT_RESC
}

template <int DQK, int LDQ, int LDK, int LDV, int LDO>
__device__ __forceinline__ void attn_body1(const bf16_t* __restrict__ Qb, const bf16_t* __restrict__ Kh, const bf16_t* __restrict__ Vh, bf16_t* __restrict__ Ob, int seq, char* lds, int tid_in) {
    using C_ = Cfg<DQK>;
    constexpr int SHM_K = C_::SHM_K, NCK = C_::NCK, C8 = C_::C8, ND0 = C_::ND0;
    int tid_ = tid_in; asm volatile("" : "+v"(tid_));
    const int tid = tid_, wid = tid >> 6, lane = tid & 63, r32 = lane & 31, hi = lane >> 5;
    char* V_lds = lds; char* K_lds = lds + 2 * SHM_V;
    float* ws = (float*)(lds + 2 * SHM_V + 2 * SHM_K) + wid * 64; float* li_l = ws; float* al_l = ws + 32;
    float m_reg = -1e30f, l_reg = 0; f32x16 o[4] = {}; bf16x8 qr[ND0];
    const bf16_t* Qw = Qb + (long)(wid * QBLK + r32) * LDQ + hi * 8;
#pragma unroll
    for (int d0 = 0; d0 < ND0; ++d0) qr[d0] = *reinterpret_cast<const bf16x8*>(Qw + d0 * 16);
    const int sr = tid >> 4, sc = (tid & 15) * 8, vst0 = v_st(sr, sc), vst1 = v_st(32 + sr, sc);
    int krow[NCK], kcol[NCK];
#pragma unroll
    for (int i = 0; i < NCK; ++i) { const int ci = tid + 512 * i; krow[i] = ci / C8; kcol[i] = (ci % C8) * 8; }
    const int vb0 = (int)(uintptr_t)V_lds + v_rd_base(lane);
    bf16x8 vs0, vs1, ks[NCK];
#define ATT1_SLOAD(k0) do { vs0 = *reinterpret_cast<const bf16x8*>(&Vh[(long)((k0) + sr) * LDV + sc]); vs1 = *reinterpret_cast<const bf16x8*>(&Vh[(long)((k0) + 32 + sr) * LDV + sc]); \
    _Pragma("unroll") for (int c_ = 0; c_ < NCK; ++c_) ks[c_] = *reinterpret_cast<const bf16x8*>(&Kh[(long)((k0) + krow[c_]) * LDK + kcol[c_]]); } while (0)
#define ATT1_SWRITE(b) do { *(bf16x8*)(V_lds + (b) * SHM_V + vst0) = vs0; *(bf16x8*)(V_lds + (b) * SHM_V + vst1) = vs1; \
    _Pragma("unroll") for (int c_ = 0; c_ < NCK; ++c_) *(bf16x8*)(K_lds + (b) * SHM_K + kswz<DQK>(krow[c_], kcol[c_] * 2)) = ks[c_]; } while (0)
    const int NT = seq / KVBLK;
    ATT1_SLOAD(0); asm volatile("s_waitcnt vmcnt(0)" ::: "memory"); ATT1_SWRITE(0); __syncthreads();
    for (int j = 0; j < NT; ++j) {
        const int b = j & 1;
        if (j + 1 < NT) ATT1_SLOAD((j + 1) * KVBLK);
        ATT_SBAR();
        f32x16 p0, p1; float mn, alpha; bf16x8 pa0, pa1, pa2, pa3;
        qkt<DQK>(p0, p1, K_lds + b * SHM_K, qr, r32, hi);
        partialSM<DQK>(p0, p1, m_reg, mn, alpha);
        if (__any(alpha < 1.f)) { if (hi == 0) al_l[r32] = alpha; asm volatile("s_waitcnt lgkmcnt(0)" ::: "memory");
#pragma unroll
            for (int d = 0; d < 4; ++d)
#pragma unroll
                for (int r = 0; r < 16; ++r) o[d][r] *= al_l[crow(r, hi)]; }
        finishSM(p0, p1, alpha, l_reg, pa0, pa1, pa2, pa3); ATT_SBAR();
        pv_d0(o, vb0 + b * (int)SHM_V, pa0, pa1, pa2, pa3);
        if (j + 1 < NT) { ATT1_SWRITE(b ^ 1); }
        __syncthreads();
    }
    if (hi == 0) li_l[r32] = l_reg;
    asm volatile("s_waitcnt lgkmcnt(0)" ::: "memory");
    __syncthreads();
    float rli[16];
#pragma unroll
    for (int r = 0; r < 16; ++r) rli[r] = __builtin_amdgcn_rcpf(li_l[crow(r, hi)]);
    unsigned short* stg = (unsigned short*)(lds + wid * 8192);
#pragma unroll
    for (int r = 0; r < 16; ++r) { const int orow = crow(r, hi);
#pragma unroll
        for (int d0 = 0; d0 < 4; ++d0) { const unsigned w = cvtpk(o[d0][r] * rli[r], 0.f); stg[orow * 128 + d0 * 32 + r32] = (unsigned short)(w & 0xffffu); } }
    asm volatile("s_waitcnt lgkmcnt(0)" ::: "memory");
    bf16_t* Ow = Ob + (long)(wid * QBLK) * LDO;
#pragma unroll
    for (int i = 0; i < 8; ++i) { const int id = lane + 64 * i, row = id >> 4, c16 = id & 15;
        const u32x4 v = *(const u32x4*)((const char*)stg + row * 256 + c16 * 16);
        *(u32x4*)(Ow + (long)row * LDO + c16 * 8) = v; }
    asm volatile("s_waitcnt lgkmcnt(0)" ::: "memory");
    __syncthreads();
#undef ATT1_SLOAD
#undef ATT1_SWRITE
}
}
constexpr int DM = 2048, NBATCH = 2, SEQ = 4096, CTX = 256, RB = SEQ + CTX  , MROWS = NBATCH * RB  ;
constexpr int NMOD = 6 * DM, NEXP = 16384;
constexpr float EPS = 1e-6f;
constexpr int NWAVES = 8, NTHREADS = 512;
constexpr size_t MiB = 1u << 20;
constexpr size_t WS_CTL = 0, CTL_ZERO_BYTES = 64 * 1024;
constexpr size_t WS_MOD = 1 * MiB;
constexpr size_t WS_ROPE = 2 * MiB;
constexpr size_t WS_SMALL = 3 * MiB;
constexpr int SM_N1G = 0, SM_N2G = 8192, SM_AQG = 16384, SM_AKG = 16384 + 384, SM_CW = 16384 + 768, SM_CB = SM_CW + 6144, SM_CQG = SM_CB + 2048, SM_CKG = SM_CQG + 256, SM_END = SM_CKG + 256;
constexpr size_t WS_PTRS = 3 * MiB + 512 * 1024;
constexpr size_t WS_XW = 4 * MiB;
constexpr size_t WS_H = 72 * MiB;
constexpr size_t WS_P = 106 * MiB;
constexpr size_t WS_QRAW = 174 * MiB;
constexpr size_t WS_KVRAW = 200 * MiB;
constexpr size_t WS_Q = 234 * MiB;
constexpr size_t WS_K = 268 * MiB;
constexpr size_t WS_V = 294 * MiB;
constexpr size_t WS_CAT = 311 * MiB;
constexpr size_t WS_PQ = 345 * MiB;
constexpr size_t WS_IDX = 379 * MiB;
constexpr size_t WS_GATE = 384 * MiB;
constexpr size_t WS_WIN = 389 * MiB;
constexpr size_t WS_WUQ = 421 * MiB;
constexpr size_t WS_WUKV = 424 * MiB;
constexpr size_t WS_WEO = 426 * MiB;
constexpr size_t WS_WQKV = 442 * MiB;
constexpr size_t WS_WCO = 466 * MiB;
constexpr size_t WS_WPQ = 482 * MiB;
constexpr size_t WS_SUBK = 514 * MiB;
#ifndef TAB_FP4
#define TAB_FP4 1
#endif
#if TAB_FP4
constexpr int ROWB = 1024;
#else
constexpr int ROWB = 1536;
#endif
constexpr size_t WS_U = 516 * MiB;
constexpr size_t WS_VT = 644 * MiB;
constexpr size_t WS_USC = 772 * MiB;
constexpr size_t WS_VSC = 773 * MiB;
constexpr size_t WS_XQ = 810 * MiB;
constexpr size_t WS_XS = 828 * MiB;
constexpr size_t WS_WQ8 = 834 * MiB;
constexpr size_t WS_WSC = 836 * MiB;
constexpr size_t WS_PART = 774 * MiB;
constexpr size_t WS_END = 837 * MiB;
#ifndef EXP_SLICED
#define EXP_SLICED 1
#endif
#ifndef PEER_MFMA
#define PEER_MFMA 0
#endif
#ifndef PEER_VMFMA
#define PEER_VMFMA 1
#endif
constexpr int CW_BAR = 4096;
constexpr int LDS_MISC = 131072 + 8192;
constexpr int LDS_BYTES = 147456;

#define LAS __attribute__((address_space(3)))
typedef unsigned short bf16_t;
typedef float f32x4 __attribute__((ext_vector_type(4)));
typedef unsigned u32x4 __attribute__((ext_vector_type(4)));
typedef unsigned u32x2 __attribute__((ext_vector_type(2)));
typedef short bf16x8 __attribute__((ext_vector_type(8)));
typedef float f32x16 __attribute__((ext_vector_type(16)));
typedef __bf16 bf16x2_t __attribute__((ext_vector_type(2)));
typedef float f32x2 __attribute__((ext_vector_type(2)));
typedef _Float16 h2_t __attribute__((ext_vector_type(2)));
typedef float f32x32 __attribute__((ext_vector_type(32)));
typedef unsigned u32x6 __attribute__((ext_vector_type(6)));

__device__ __forceinline__ unsigned f2bf(float f) { unsigned u = __builtin_bit_cast(unsigned, f); return (u + 0x7fffu + ((u >> 16) & 1u)) >> 16; }
__device__ __forceinline__ unsigned pk2(float lo, float hi) { return f2bf(lo) | (f2bf(hi) << 16); }
__device__ __forceinline__ float bf_lo(unsigned w) { return __builtin_bit_cast(float, w << 16); }
__device__ __forceinline__ float bf_hi(unsigned w) { return __builtin_bit_cast(float, w & 0xffff0000u); }
__device__ __forceinline__ float bf2f(bf16_t h) { return __builtin_bit_cast(float, (unsigned)h << 16); }
__device__ __forceinline__ float wave_sum(float v) {
#pragma unroll
    for (int o = 1; o < 64; o <<= 1) v += __shfl_xor(v, o);
    return v;
}
#define DPP_ADD(v, ctrl) ((v) + __builtin_bit_cast(float, __builtin_amdgcn_update_dpp(0, __builtin_bit_cast(int, (v)), (ctrl), 0xf, 0xf, true)))
__device__ __forceinline__ float wave_sum_dpp(float v) {
    v = DPP_ADD(v, 0xB1);
    v = DPP_ADD(v, 0x4E);
    v = DPP_ADD(v, 0x141);
    v = DPP_ADD(v, 0x140);
    const int vi = __builtin_bit_cast(int, v);
    const float s0 = __builtin_bit_cast(float, __builtin_amdgcn_readlane(vi, 0)), s1 = __builtin_bit_cast(float, __builtin_amdgcn_readlane(vi, 16));
    const float s2 = __builtin_bit_cast(float, __builtin_amdgcn_readlane(vi, 32)), s3 = __builtin_bit_cast(float, __builtin_amdgcn_readlane(vi, 48));
    return (s0 + s1) + (s2 + s3);
}
__device__ __forceinline__ float dot2_bf16(unsigned w, unsigned x, float acc) { return __builtin_amdgcn_fdot2_f32_bf16(__builtin_bit_cast(bf16x2_t, w), __builtin_bit_cast(bf16x2_t, x), acc, false); }
__device__ __forceinline__ float gelu_erf(float v) {
    const float av = fabsf(v), t = __builtin_amdgcn_rcpf(av * 0.2316418882f + 1.0f);
    float q = t * 0.5307027145f + (-0.7265760135f); q = q * t + 0.7107068705f; q = q * t + (-0.142248368f); q = q * t + 0.127414796f; q = q * t;
    const float e = __builtin_amdgcn_exp2f((v * v) * (-0.72134752044f));
    const float m = v * (q * e);
    return v < 0.f ? m : v - m;
}
#define XB_TMO      128
#define XB_XCNT(j)  (256  + 64 * (j))
#define XB_XSUB(j)  (1280 + 64 * (j))
#define XB_XGEN(j)  (2304 + 64 * (j))
#define XB_TOP      3328
#define XB_TOPGEN   3392
#define XCD_BAR_WORDS 3456
#define XB_SPIN_CAP (1u << 18)

__device__ __forceinline__ unsigned xb_ld(unsigned* p)              { return __hip_atomic_load(p, __ATOMIC_RELAXED, __HIP_MEMORY_SCOPE_AGENT); }
__device__ __forceinline__ unsigned xb_add(unsigned* p, unsigned v) { return __hip_atomic_fetch_add(p, v, __ATOMIC_RELAXED, __HIP_MEMORY_SCOPE_AGENT); }
__device__ __forceinline__ unsigned xb_xcc_id() { return (unsigned)__builtin_amdgcn_s_getreg((3 << 11) | 20) & 0xFu; }
#define XB_SPIN(cond, bar) do { unsigned _sp = 0; while (cond) { __builtin_amdgcn_s_sleep(1); \
    if ((++_sp & 255u) == 0u) { if (xb_ld(&(bar)[XB_TMO])) break; if (_sp > XB_SPIN_CAP) { atomicAdd(&(bar)[XB_TMO], 1u); break; } } } } while (0)

struct XcdBarrier {
    unsigned* bar; unsigned x;
    volatile LAS unsigned* st;
};

__device__ __forceinline__ XcdBarrier xcd_barrier_post(unsigned* bar, volatile LAS unsigned* st) {
    XcdBarrier b; b.bar = bar; b.x = xb_xcc_id(); b.st = st;
    if (threadIdx.x == 0) (void)xb_add(&bar[XB_XCNT(b.x)], 1u);
    return b;
}
__device__ __forceinline__ void xcd_barrier_complete(unsigned* bar, unsigned x, unsigned& nloc, unsigned& nx) {
    const unsigned G = gridDim.x * gridDim.y * gridDim.z;
    unsigned sum, cnt, mine, sp = 0u;
    for (;;) {
        sum = 0u; cnt = 0u; mine = 0u;
#pragma unroll
        for (unsigned j = 0; j < 16; ++j) { const unsigned c = xb_ld(&bar[XB_XCNT(j)]); sum += c; cnt += (c > 0u) ? 1u : 0u; mine = (j == x) ? c : mine; }
        if (sum == G) break;
        __builtin_amdgcn_s_sleep(1);
        if ((++sp & 255u) == 0u) { if (xb_ld(&bar[XB_TMO])) break; if (sp > XB_SPIN_CAP) { atomicAdd(&bar[XB_TMO], 1u); break; } }
    }
    nloc = mine > 0u ? mine : 1u; nx = cnt > 0u ? cnt : 1u;
}

__device__ __forceinline__ void xcd_barrier(const XcdBarrier& b) {
    asm volatile("s_waitcnt vmcnt(0)" ::: "memory");
    __syncthreads();
    if (threadIdx.x == 0) {
        unsigned* bar = b.bar; unsigned bx = b.x;
        asm volatile("" : "+s"(bar), "+s"(bx));
        __builtin_amdgcn_s_waitcnt(0);
        unsigned nloc = b.st[0], nx = b.st[1];
        if (nloc == 0u) { xcd_barrier_complete(bar, bx, nloc, nx); b.st[0] = nloc; b.st[1] = nx; }
        const unsigned old = xb_add(&bar[XB_XSUB(bx)], 1u);
        const unsigned gen = old / nloc;
        if (old + 1u == (gen + 1u) * nloc) {
            __builtin_amdgcn_fence(__ATOMIC_RELEASE, "agent");
            asm volatile("s_waitcnt vmcnt(0)" ::: "memory");
            const unsigned og = xb_add(&bar[XB_TOP], 1u);
            const unsigned tg = og / nx;
            if (og + 1u == (tg + 1u) * nx) xb_add(&bar[XB_TOPGEN], 1u);
            else XB_SPIN(xb_ld(&bar[XB_TOPGEN]) == tg, bar);
            __builtin_amdgcn_fence(__ATOMIC_ACQUIRE, "agent");
            xb_add(&bar[XB_XGEN(bx)], 1u);
            asm volatile("s_waitcnt vmcnt(0)" ::: "memory");
        } else {
            XB_SPIN(xb_ld(&bar[XB_XGEN(bx)]) == gen, bar);
            __builtin_amdgcn_fence(__ATOMIC_ACQUIRE, "agent");
            asm volatile("s_waitcnt vmcnt(0)" ::: "memory");
        }
    }
    __syncthreads();
}
struct Frame {
    LAS unsigned char* lds;
    int tid, lane, wave, vcu, G, gw, NGW;
    unsigned char* ws;
};
__device__ __forceinline__ int opaque_v(int v) { asm volatile("" : "+v"(v)); return v; }
__device__ __forceinline__ int phase_tid(int wave) { int lane; asm volatile("v_mbcnt_lo_u32_b32 %0, -1, 0\n\tv_mbcnt_hi_u32_b32 %0, -1, %0" : "=v"(lane)); return wave * 64 + lane; }
__device__ __forceinline__ Frame phase_frame(const Frame& F0) { Frame F = F0; F.tid = phase_tid(F0.wave); F.lane = F.tid & 63; return F; }
__device__ __forceinline__ float swap32(float v, int lane) { auto rr = __builtin_amdgcn_permlane32_swap(__float_as_uint(v), __float_as_uint(v), false, false); return __uint_as_float(lane < 32 ? rr[1] : rr[0]); }
__device__ __forceinline__ int row_cls(int row) { const int b = row / RB, i = row - b * RB; return i < CTX ? 2 : b; }

__device__ __forceinline__ void p0_transpose_item(const float* W, int K, int N, bf16_t* WT, const float* gain, LAS float* scr, int item, int lane, bool perm_q = false) {
    const int nblk = N / 32, kb = item / nblk, nb = item % nblk, k0 = 64 * kb, n0 = 32 * nb;
    {
        const int rgp = lane >> 3, c4 = (lane & 7) * 4; f32x4 tv[8];
#pragma unroll
        for (int i = 0; i < 8; ++i) tv[i] = *(const f32x4*)(W + (size_t)(k0 + 8 * i + rgp) * N + n0 + c4);
#pragma unroll
        for (int i = 0; i < 8; ++i) { const int kk = 8 * i + rgp; f32x4 v = tv[i]; if (gain) v = v * gain[k0 + kk];
            LAS float* d = scr + kk * 33 + c4; d[0] = v.x; d[1] = v.y; d[2] = v.z; d[3] = v.w; }
    }
    asm volatile("s_waitcnt lgkmcnt(0)" ::: "memory");
    const int c = lane & 7;
#pragma unroll
    for (int j = 0; j < 4; ++j) { const int n = (lane >> 3) + 8 * j; const LAS float* s = scr + (8 * c) * 33 + n;
        u32x4 o; o.x = pk2(s[0 * 33], s[1 * 33]); o.y = pk2(s[2 * 33], s[3 * 33]); o.z = pk2(s[4 * 33], s[5 * 33]); o.w = pk2(s[6 * 33], s[7 * 33]);
        int nn = n0 + n; if (perm_q) { const int hh = nn / 192, e = nn - hh * 192; nn = (e < 128) ? hh * 128 + e : 1024 + hh * 64 + (e - 128); }
        *(u32x4*)(WT + (size_t)nn * K + k0 + 8 * c) = o; }
    asm volatile("s_waitcnt lgkmcnt(0)" ::: "memory");
}
struct TrDesc { const float* W; const float* gain; bf16_t* WT; int K, N, items; };

__device__ __forceinline__ void p0_gemv_task(Frame& F, int task, const float* ada_w, const float* ada_b, float* mod) {
    LAS float* sv = (LAS float*)F.lds; LAS float* part = (LAS float*)(F.lds + 32768);
    const int l = task / 192, n0 = (task % 192) * 64, rg = F.lane >> 4, c4 = (F.lane & 15) * 4;
    const float* Wp = ada_w + (size_t)l * DM * NMOD + n0 + c4 + (size_t)(F.wave * 256 + rg) * NMOD;
    f32x4 a0 = {0, 0, 0, 0}, a1 = a0, a2 = a0;
    for (int k = 0; k < 256; k += 32) {
        f32x4 w[8];
#pragma unroll
        for (int u = 0; u < 8; ++u) w[u] = *(const f32x4*)(Wp + (size_t)(k + 4 * u) * NMOD);
#pragma unroll
        for (int u = 0; u < 8; ++u) { const int kk = F.wave * 256 + k + 4 * u + rg; const float s0 = sv[kk], s1 = sv[2048 + kk], s2 = sv[4096 + kk];
            a0 += w[u] * s0; a1 += w[u] * s1; a2 += w[u] * s2; }
    }
    LAS float* pp = part + ((F.wave * 4 + rg) * 3) * 64 + c4;
    *(LAS f32x4*)(pp) = a0; *(LAS f32x4*)(pp + 64) = a1; *(LAS f32x4*)(pp + 128) = a2;
    __syncthreads();
    if (F.tid < 192) { const int r = F.tid >> 6, c = F.tid & 63; float s = 0.f;
#pragma unroll
        for (int q = 0; q < 32; ++q) s += part[(q * 3 + r) * 64 + c];
        mod[(size_t)(l * 3 + r) * NMOD + n0 + c] = s + ada_b[(size_t)l * NMOD + n0 + c]; }
    __syncthreads();
}

__device__ __forceinline__ void p0_prologue(Frame& F, const float* const* in) {
    unsigned char* ws = F.ws;
    {
        LAS float* sv = (LAS float*)F.lds;
        for (int i = F.tid; i < 3 * DM; i += NTHREADS) { const int r = i / DM, k = i - r * DM; const float x = (r < 2) ? in[1][r * DM + k] : in[3][k]; sv[i] = x / (1.f + __expf(-x)); }
        __syncthreads();
        for (int task = F.vcu; task < 768; task += F.G) p0_gemv_task(F, task, in[4], in[5], (float*)(ws + WS_MOD));
        __syncthreads();
    }
    {
        float* xw = (float*)(ws + WS_XW);
        for (int row = F.gw; row < MROWS; row += F.NGW) { const int b = row / RB, i = row - b * RB;
            const float* src = (i < CTX) ? in[2] + (size_t)(b * CTX + i) * DM : in[0] + (size_t)(b * SEQ + i - CTX) * DM;
            const f32x4* s4 = (const f32x4*)src + F.lane; f32x4* d4 = (f32x4*)(xw + (size_t)row * DM) + F.lane;
#pragma unroll
            for (int j = 0; j < 8; ++j) d4[64 * j] = s4[64 * j]; }
    }
    {
        float* sm = (float*)(ws + WS_SMALL); const int g = F.vcu * NTHREADS + F.tid;
        if (g < 8192) { sm[SM_N1G + g] = in[6][g]; sm[SM_N2G + g] = in[7][g]; }
        if (g < 384) { sm[SM_AQG + g] = in[13][g]; sm[SM_AKG + g] = in[14][g]; }
        if (g < 6144) sm[SM_CW + g] = in[15][g];
        if (g < 2048) sm[SM_CB + g] = in[16][g];
        if (g < 256) { sm[SM_CQG + g] = in[19][g]; sm[SM_CKG + g] = in[20][g]; }
    }
    {
        float* rc = (float*)(ws + WS_ROPE); float* ra = rc + 64 * 32 * 2;
        const int g = F.vcu * NTHREADS + F.tid;
        if (g < 64 * 32) { const int pos = g >> 5, f = g & 31; const float fr = exp2f(-(float)f * (13.287712379549449f / 32.f)); const float ang = (float)pos * fr;
            rc[2 * g] = cosf(ang); rc[2 * g + 1] = sinf(ang); }
        else if (g < 64 * 32 + 64 * 16) { const int e = g - 64 * 32, pos = e >> 4, f = e & 15; const float fr = exp2f(-(float)f * (13.287712379549449f / 16.f)); const float ang = (float)pos * fr;
            ra[2 * e] = cosf(ang); ra[2 * e + 1] = sinf(ang); }
    }
    {
        LAS float* scr = (LAS float*)(F.lds + F.wave * 16384);
        TrDesc d[16]; int nd = 0;
#pragma unroll
        for (int i = 0; i < 2; ++i) {
            d[nd++] = TrDesc{in[8] + (size_t)i * DM * 3904, nullptr, (bf16_t*)(ws + WS_WIN) + (size_t)i * 4096 * DM, DM, 3904, 32 * 122};
            d[nd++] = TrDesc{in[11] + (size_t)i * 512 * 1536, in[9] + i * 512, (bf16_t*)(ws + WS_WUQ) + (size_t)i * 1536 * 512, 512, 1536, 8 * 48};
            d[nd++] = TrDesc{in[12] + (size_t)i * 256 * 2048, in[10] + i * 256, (bf16_t*)(ws + WS_WUKV) + (size_t)i * 2048 * 256, 256, 2048, 4 * 64};
            d[nd++] = TrDesc{in[17] + (size_t)i * DM * DM, nullptr, (bf16_t*)(ws + WS_WEO) + (size_t)i * DM * DM, DM, DM, 32 * 64};
            d[nd++] = TrDesc{in[18] + (size_t)i * DM * 3072, nullptr, (bf16_t*)(ws + WS_WQKV) + (size_t)i * 3072 * DM, DM, 3072, 32 * 96};
            d[nd++] = TrDesc{in[21] + (size_t)i * DM * DM, nullptr, (bf16_t*)(ws + WS_WCO) + (size_t)i * DM * DM, DM, DM, 32 * 64};
        }
#pragma unroll
        for (int l = 0; l < 4; ++l) d[nd++] = TrDesc{in[22] + (size_t)l * DM * DM, nullptr, (bf16_t*)(ws + WS_WPQ) + (size_t)l * DM * DM, DM, DM, 32 * 64};
#pragma unroll
        for (int m = 0; m < 16; ++m) {
            for (int it = F.gw; it < d[m].items; it += F.NGW) p0_transpose_item(d[m].W, d[m].K, d[m].N, d[m].WT, d[m].gain, scr, it, F.lane, d[m].K == 512);
        }
        for (int i = F.gw * 64 + F.lane; i < 2 * 192 * DM / 8; i += F.NGW * 64) { const int li = i / (192 * DM / 8), r = i % (192 * DM / 8);
            *(u32x4*)((bf16_t*)(ws + WS_WIN) + (size_t)li * 4096 * DM + (size_t)3904 * DM + (size_t)r * 8) = (u32x4){0u, 0u, 0u, 0u}; }
    }
    {
        const size_t n_sk = (size_t)4 * 16 * 128 * 128 / 8;
        const size_t gt = (size_t)F.vcu * NTHREADS + F.tid, GT = (size_t)F.G * NTHREADS;
        for (size_t j = gt; j < n_sk; j += GT) {
            const f32x4 a = *(const f32x4*)(in[23] + j * 8), b = *(const f32x4*)(in[23] + j * 8 + 4);
            u32x4 o; o.x = pk2(a.x, a.y); o.y = pk2(a.z, a.w); o.z = pk2(b.x, b.y); o.w = pk2(b.z, b.w);
            *(u32x4*)((bf16_t*)(ws + WS_SUBK) + j * 8) = o;
        }
    }
    {
        for (int r = F.gw; r < 2 * 4 * NEXP; r += F.NGW) {
            const int tab = r / (4 * NEXP), rr = r - tab * (4 * NEXP);
#if EXP_SLICED
            const float* src = (tab ? in[25] : in[24]) + (size_t)rr * DM + F.lane * 32;
            f32x4 v[8];
#pragma unroll
            for (int q = 0; q < 8; ++q) v[q] = *(const f32x4*)(src + q * 4);
#else
            const float* src = (tab ? in[25] : in[24]) + (size_t)rr * DM + F.lane * 16;
            f32x4 v[8];
#pragma unroll
            for (int j = 0; j < 2; ++j)
#pragma unroll
                for (int q = 0; q < 4; ++q) v[j * 4 + q] = *(const f32x4*)(src + j * 1024 + q * 4);
#endif
            float am = 0.f;
#pragma unroll
            for (int q = 0; q < 8; ++q) am = fmaxf(fmaxf(am, fmaxf(fabsf(v[q].x), fabsf(v[q].y))), fmaxf(fabsf(v[q].z), fabsf(v[q].w)));
#pragma unroll
            for (int o = 1; o < 64; o <<= 1) am = fmaxf(am, __shfl_xor(am, o));
            am = fmaxf(am, 1e-30f);
#if TAB_FP4
            float ssq = 0.f;
#pragma unroll
            for (int q = 0; q < 8; ++q) ssq += (v[q].x * v[q].x + v[q].y * v[q].y) + (v[q].z * v[q].z + v[q].w * v[q].w);
#pragma unroll
            for (int o = 1; o < 64; o <<= 1) ssq += __shfl_xor(ssq, o);
            const float sig = fmaxf(sqrtf(ssq * (1.f / DM)), am * (1.f / 64.f));
            unsigned w4[4];
#if EXP_SLICED
            if (tab == 0 && !PEER_MFMA) {
                const float delta = 0.3352f * sig, isc = 1.0f / delta;
#pragma unroll
                for (int q = 0; q < 4; ++q) { unsigned t = 0u;
#pragma unroll
                    for (int hh = 0; hh < 2; ++hh) { const f32x4 x = v[2 * q + hh] * isc;
                        const int n0 = min(max((int)floorf(x.x), -8), 7) & 15, n1 = min(max((int)floorf(x.y), -8), 7) & 15, n2 = min(max((int)floorf(x.z), -8), 7) & 15, n3 = min(max((int)floorf(x.w), -8), 7) & 15;
                        t |= ((unsigned)n0 | ((unsigned)n1 << 4) | ((unsigned)n2 << 8) | ((unsigned)n3 << 12)) << (16 * hh); }
                    w4[q] = t; }
                { const int ll = rr / NEXP, ee = rr - ll * NEXP;
                  *(u32x4*)(ws + WS_U + (size_t)ll * NEXP * ROWB + (size_t)(F.lane >> 3) * (NEXP * 128) + (size_t)ee * 128 + (F.lane & 7) * 16) = (u32x4){w4[0], w4[1], w4[2], w4[3]}; }
                if (F.lane == 0) ((float*)(ws + WS_USC))[rr] = delta;
                continue;
            }
#endif
            const float sc = 2.0f / sig;
#pragma unroll
            for (int q = 0; q < 4; ++q) { unsigned t = 0u;
                const f32x4 xa = v[2 * q] * sc, xb = v[2 * q + 1] * sc;
#define P0_C6(x) fminf(fmaxf((x), -6.f), 6.f)
                t = __builtin_amdgcn_cvt_scalef32_pk_fp4_f32(t, P0_C6(xa.x), P0_C6(xa.y), 1.0f, 0);
                t = __builtin_amdgcn_cvt_scalef32_pk_fp4_f32(t, P0_C6(xa.z), P0_C6(xa.w), 1.0f, 1);
                t = __builtin_amdgcn_cvt_scalef32_pk_fp4_f32(t, P0_C6(xb.x), P0_C6(xb.y), 1.0f, 2);
                t = __builtin_amdgcn_cvt_scalef32_pk_fp4_f32(t, P0_C6(xb.z), P0_C6(xb.w), 1.0f, 3);
#undef P0_C6
                w4[q] = t; }
#if EXP_SLICED
            { const int ll = rr / NEXP, ee = rr - ll * NEXP;
              *(u32x4*)(ws + (tab ? WS_VT : WS_U) + (size_t)ll * NEXP * ROWB + (size_t)(F.lane >> 3) * (NEXP * 128) + (size_t)ee * 128 + (F.lane & 7) * 16) = (u32x4){w4[0], w4[1], w4[2], w4[3]}; }
#else
            *(u32x4*)(ws + (tab ? WS_VT : WS_U) + (size_t)rr * ROWB + F.lane * 16) = (u32x4){w4[0], w4[1], w4[2], w4[3]};
#endif
            if (F.lane == 0) ((float*)(ws + (tab ? WS_VSC : WS_USC)))[rr] = sig * 0.5f;
#else
            const float sc = 7.5f / am;
            f32x16 a, b;
#pragma unroll
            for (int q = 0; q < 8; ++q) { const f32x4 x = v[q] * sc; a[2 * q] = x.x; b[2 * q] = x.y; a[2 * q + 1] = x.z; b[2 * q + 1] = x.w; }
            const u32x6 w = __builtin_amdgcn_cvt_scalef32_2xpk16_fp6_f32(a, b, 1.0f);
            unsigned char* dst = ws + (tab ? WS_VT : WS_U) + (size_t)rr * ROWB;
            *(u32x4*)(dst + F.lane * 16) = (u32x4){w[0], w[1], w[2], w[3]};
            *(u32x2*)(dst + 1024 + F.lane * 8) = (u32x2){w[4], w[5]};
            if (F.lane == 0) ((float*)(ws + (tab ? WS_VSC : WS_USC)))[rr] = am * (1.0f / 7.5f);
#endif
        }
    }
}

#define DPP_MOV(v, ctrl) __builtin_bit_cast(float, __builtin_amdgcn_update_dpp(0, __builtin_bit_cast(int, (v)), (ctrl), 0xf, 0xf, true))
__device__ __forceinline__ void norm_phase(const Frame& F0, const float* xw, const float* g, const float* modl  , int off_sh, int off_sc, bf16_t* H, bool lat_only, unsigned* XQ = nullptr, float* XS = nullptr) {
    const Frame F = phase_frame(F0);
    f32x4 gm[8], shv[8]; int cur_cls = -1;
    int row = F.gw; if (lat_only) while (row < MROWS && row_cls(row) == 2) row += F.NGW;
    f32x4 v[8];
    if (row < MROWS) { const f32x4* x4 = (const f32x4*)(xw + (size_t)row * DM) + F.lane;
#pragma unroll
        for (int j = 0; j < 8; ++j) v[j] = x4[64 * j]; }
    while (row < MROWS) {
        int nrow = row + F.NGW; if (lat_only) while (nrow < MROWS && row_cls(nrow) == 2) nrow += F.NGW;
        f32x4 vn[8];
        if (nrow < MROWS) { const f32x4* x4 = (const f32x4*)(xw + (size_t)nrow * DM) + F.lane;
#pragma unroll
            for (int j = 0; j < 8; ++j) vn[j] = x4[64 * j]; }
        const int cls = row_cls(row);
        if (cls != cur_cls) {
            cur_cls = cls;
            const f32x4* g4 = (const f32x4*)g + F.lane; const f32x4* sc4 = (const f32x4*)(modl + (size_t)cls * NMOD + off_sc) + F.lane; const f32x4* sh4 = (const f32x4*)(modl + (size_t)cls * NMOD + off_sh) + F.lane;
#pragma unroll
            for (int j = 0; j < 8; ++j) { gm[j] = g4[64 * j] * (sc4[64 * j] + 1.0f); shv[j] = sh4[64 * j]; }
        }
        float ss = 0.f;
#pragma unroll
        for (int j = 0; j < 8; ++j) ss += (v[j].x * v[j].x + v[j].y * v[j].y) + (v[j].z * v[j].z + v[j].w * v[j].w);
        const float rstd = 1.0f / sqrtf(wave_sum_dpp(ss) * (1.f / DM) + EPS);
        u32x2* o2 = (u32x2*)(H + (size_t)row * DM) + F.lane;
#if PEER_MFMA
        if (XQ) {
            f32x4 yv[8]; float am = 0.f;
#pragma unroll
            for (int j = 0; j < 8; ++j) { const f32x4 y = (v[j] * rstd) * gm[j] + shv[j]; yv[j] = y; u32x2 o; o.x = pk2(y.x, y.y); o.y = pk2(y.z, y.w); o2[64 * j] = o;
                am = fmaxf(fmaxf(am, fmaxf(fabsf(y.x), fabsf(y.y))), fmaxf(fabsf(y.z), fabsf(y.w))); }
            am = fmaxf(am, DPP_MOV(am, 0xB1)); am = fmaxf(am, DPP_MOV(am, 0x4E)); am = fmaxf(am, DPP_MOV(am, 0x141)); am = fmaxf(am, DPP_MOV(am, 0x140));
            { const int ai = __builtin_bit_cast(int, am);
              am = fmaxf(fmaxf(__builtin_bit_cast(float, __builtin_amdgcn_readlane(ai, 0)), __builtin_bit_cast(float, __builtin_amdgcn_readlane(ai, 16))),
                         fmaxf(__builtin_bit_cast(float, __builtin_amdgcn_readlane(ai, 32)), __builtin_bit_cast(float, __builtin_amdgcn_readlane(ai, 48)))); }
            am = fmaxf(am, 1e-20f);
            const float qs = 440.0f / am;
            unsigned* q8 = XQ + (size_t)row * (DM / 4) + F.lane;
#pragma unroll
            for (int j = 0; j < 8; ++j) { const f32x4 y = yv[j] * qs; int pk = 0; pk = __builtin_amdgcn_cvt_pk_fp8_f32(y.x, y.y, pk, false); pk = __builtin_amdgcn_cvt_pk_fp8_f32(y.z, y.w, pk, true); q8[64 * j] = (unsigned)pk; }
            if (F.lane == 0) XS[row] = am * (1.0f / 440.0f);
        } else
#endif
        {
#pragma unroll
        for (int j = 0; j < 8; ++j) { const f32x4 y = (v[j] * rstd) * gm[j] + shv[j]; u32x2 o; o.x = pk2(y.x, y.y); o.y = pk2(y.z, y.w); o2[64 * j] = o;
            if (XQ) {
                float am = fmaxf(fmaxf(fabsf(y.x), fabsf(y.y)), fmaxf(fabsf(y.z), fabsf(y.w)));
                am = fmaxf(am, DPP_MOV(am, 0xB1)); am = fmaxf(am, DPP_MOV(am, 0x4E)); am = fmaxf(am, DPP_MOV(am, 0x141)); am = fmaxf(am, 1e-20f);
                const float qs = 119.0f / am; const float yy[4] = {y.x, y.y, y.z, y.w};
                unsigned pl = 0u, ph = 0u; int sq = 0;
#pragma unroll
                for (int i = 0; i < 4; ++i) { const int qi = __float2int_rn(yy[i] * qs); const int lo = ((qi + 8) & 15) - 8; const int hi = (qi - lo) >> 4; sq += qi; pl |= (unsigned)(lo & 15) << (4 * i); ph |= (unsigned)(hi & 15) << (4 * i); }
                const unsigned pl1 = (unsigned)__builtin_amdgcn_update_dpp(0, (int)pl, 0xB1, 0xf, 0xf, true), ph1 = (unsigned)__builtin_amdgcn_update_dpp(0, (int)ph, 0xB1, 0xf, 0xf, true);
                float sqf = (float)sq; sqf = DPP_ADD(sqf, 0xB1); sqf = DPP_ADD(sqf, 0x4E); sqf = DPP_ADD(sqf, 0x141);
                const int chunk = j * 8 + (F.lane >> 3), l8 = F.lane & 7;
                if ((l8 & 1) == 0) { unsigned* q = XQ + ((size_t)row * 64 + chunk) * 8 + (l8 >> 1); q[0] = ph | (ph1 << 16); q[4] = pl | (pl1 << 16); }
                if (l8 == 0) { float* s = XS + ((size_t)row * 64 + chunk) * 2; s[0] = am * (1.0f / 119.0f); s[1] = 0.5f * sqf; }
            } }
        }
        row = nrow;
#pragma unroll
        for (int j = 0; j < 8; ++j) v[j] = vn[j];
    }
}

__device__ __forceinline__ float row16_sum(float v) { v = DPP_ADD(v, 0xB1); v = DPP_ADD(v, 0x4E); v = DPP_ADD(v, 0x141); v = DPP_ADD(v, 0x140); return v; }
__device__ __forceinline__ void prep_odd_phase(const Frame& F0, const bf16_t* P, const float* qg, const float* kg, const float* rope_c, bf16_t* Q, bf16_t* Kb) {
    const Frame F = phase_frame(F0);
    const int l16 = F.lane & 15, d0 = l16 * 8;
    float gq[8], gk[8];
#pragma unroll
    for (int e = 0; e < 8; ++e) { gq[e] = qg[d0 + e]; gk[e] = kg[d0 + e]; }
    const bool lowhalf = l16 < 8;
    const int j0 = (l16 & 7) * 8;
    int row = F.gw;
    u32x4 w[5];
    if (row < MROWS) { const u32x4* pr = (const u32x4*)(P + (size_t)row * 3072) + F.lane;
#pragma unroll
        for (int k = 0; k < 5; ++k) w[k] = pr[64 * k]; }
    while (row < MROWS) {
        const int nrow = row + F.NGW;
        u32x4 wn[5];
        if (nrow < MROWS) { const u32x4* pr = (const u32x4*)(P + (size_t)nrow * 3072) + F.lane;
#pragma unroll
            for (int k = 0; k < 5; ++k) wn[k] = pr[64 * k]; }
        const int b = row / RB, i = row - b * RB; const bool lat = i >= CTX; const int t = i - CTX;
        float cs[8], sn[8];
#pragma unroll
        for (int e = 0; e < 8; ++e) { cs[e] = 1.f; sn[e] = 0.f; }
        if (lat) { const int pos = (j0 < 32) ? (t >> 6) : (t & 63); const f32x4* tb = (const f32x4*)(rope_c + ((pos << 5) + (j0 & 31)) * 2);
#pragma unroll
            for (int q = 0; q < 4; ++q) { const f32x4 c = tb[q]; cs[2 * q] = c.x; sn[2 * q] = c.y; cs[2 * q + 1] = c.z; sn[2 * q + 1] = c.w; } }
#pragma unroll
        for (int k = 0; k < 5; ++k) {
            const unsigned ww[4] = {w[k].x, w[k].y, w[k].z, w[k].w};
            float x[8]; float ss = 0.f;
#pragma unroll
            for (int q = 0; q < 4; ++q) { x[2 * q] = bf_lo(ww[q]); x[2 * q + 1] = bf_hi(ww[q]); ss += x[2 * q] * x[2 * q] + x[2 * q + 1] * x[2 * q + 1]; }
            const float rstd = 1.0f / sqrtf(row16_sum(ss) * (1.f / 128.f) + EPS);
            unsigned ow[4]; float o[8];
#pragma unroll
            for (int e = 0; e < 8; ++e) { const float y = x[e] * rstd * (k < 4 ? gq[e] : gk[e]); const float yp = DPP_MOV(y, 0x128);
                o[e] = lowhalf ? (y * cs[e] - yp * sn[e]) : (y * cs[e] + yp * sn[e]); }
#pragma unroll
            for (int q = 0; q < 4; ++q) ow[q] = pk2(o[2 * q], o[2 * q + 1]);
            if (k < 4) *((u32x4*)(Q + (size_t)row * 2048) + 64 * k + F.lane) = (u32x4){ow[0], ow[1], ow[2], ow[3]};
            else *((u32x4*)(Kb + (size_t)row * 512) + F.lane) = (u32x4){ow[0], ow[1], ow[2], ow[3]};
        }
        row = nrow;
#pragma unroll
        for (int k = 0; k < 5; ++k) w[k] = wn[k];
    }
}

struct PrepEvenRow { u32x4 cq; u32x2 ckv, kr; u32x4 qn[2]; u32x2 qr[2]; u32x4 kn[2], vv[2]; };
__device__ __forceinline__ void prep_even_load(PrepEvenRow& R, const bf16_t* P, const bf16_t* QR, const bf16_t* KVR, int row, int lane) {
    const bf16_t* pr = P + (size_t)row * 4096; const int l16 = lane & 15, hq = lane >> 4;
    R.cq = *((const u32x4*)pr + lane); R.ckv = *((const u32x2*)(pr + 512) + lane); R.kr = *((const u32x2*)(pr + 768) + l16);
    const bf16_t* q = QR + (size_t)row * 1536; const bf16_t* kv = KVR + (size_t)row * 2048;
#pragma unroll
    for (int k = 0; k < 2; ++k) { R.qn[k] = *((const u32x4*)q + 64 * k + lane); R.qr[k] = *((const u32x2*)(q + 1024) + 64 * k + lane);
        const bf16_t* kh = kv + (4 * k + hq) * 256 + l16 * 8; R.kn[k] = *(const u32x4*)kh; R.vv[k] = *(const u32x4*)(kh + 128); }
}
__device__ __forceinline__ void prep_even_phase(const Frame& F0, const bf16_t* P, const bf16_t* QR, const bf16_t* KVR, const float* qg, const float* kg, const float* rope_a, bf16_t* Q, bf16_t* Kb, bf16_t* Vb) {
    const Frame F = phase_frame(F0);
    const int lane = F.lane, l16 = lane & 15, hq = lane >> 4, d0 = l16 * 8, r0 = l16 * 4;
    float gqn[8], gkn[8], gqr[4], gkr[4];
#pragma unroll
    for (int e = 0; e < 8; ++e) { gqn[e] = qg[d0 + e]; gkn[e] = kg[d0 + e]; }
#pragma unroll
    for (int e = 0; e < 4; ++e) { gqr[e] = qg[128 + r0 + e]; gkr[e] = kg[128 + r0 + e]; }
    const bool lowhalf = l16 < 8; const int j0 = (l16 & 7) * 4;
    int row = F.gw;
    PrepEvenRow R;
    if (row < MROWS) prep_even_load(R, P, QR, KVR, row, lane);
    while (row < MROWS) {
        const int nrow = row + F.NGW;
        PrepEvenRow Rn;
        if (nrow < MROWS) prep_even_load(Rn, P, QR, KVR, nrow, lane);
        const int b = row / RB, i = row - b * RB; const bool lat = i >= CTX; const int t = i - CTX;
        float cs[4], sn[4];
#pragma unroll
        for (int e = 0; e < 4; ++e) { cs[e] = 1.f; sn[e] = 0.f; }
        if (lat) { const int pos = (j0 < 16) ? (t >> 6) : (t & 63); const f32x4* tb = (const f32x4*)(rope_a + ((pos << 4) + (j0 & 15)) * 2);
            const f32x4 c0 = tb[0], c1 = tb[1]; cs[0] = c0.x; sn[0] = c0.y; cs[1] = c0.z; sn[1] = c0.w; cs[2] = c1.x; sn[2] = c1.y; cs[3] = c1.z; sn[3] = c1.w; }
        float ssq = 0.f, sskv = 0.f;
        { const unsigned ww[4] = {R.cq.x, R.cq.y, R.cq.z, R.cq.w};
#pragma unroll
          for (int q = 0; q < 4; ++q) { const float a = bf_lo(ww[q]), c = bf_hi(ww[q]); ssq += a * a + c * c; } }
        { const float a = bf_lo(R.ckv.x), c = bf_hi(R.ckv.x), d = bf_lo(R.ckv.y), e = bf_hi(R.ckv.y); sskv = (a * a + c * c) + (d * d + e * e); }
        const float rstd_q = 1.0f / sqrtf(wave_sum_dpp(ssq) * (1.f / 512.f) + EPS), rstd_kv = 1.0f / sqrtf(wave_sum_dpp(sskv) * (1.f / 256.f) + EPS);
        const float krv[4] = {bf_lo(R.kr.x), bf_hi(R.kr.x), bf_lo(R.kr.y), bf_hi(R.kr.y)};
        const float krss = (krv[0] * krv[0] + krv[1] * krv[1]) + (krv[2] * krv[2] + krv[3] * krv[3]);
#pragma unroll
        for (int k = 0; k < 2; ++k) {
            const int h = 4 * k + hq;
            {
                const unsigned wn[4] = {R.qn[k].x, R.qn[k].y, R.qn[k].z, R.qn[k].w};
                float xn[8], xr[4]; float ss = 0.f;
#pragma unroll
                for (int q = 0; q < 4; ++q) { xn[2 * q] = bf_lo(wn[q]) * rstd_q; xn[2 * q + 1] = bf_hi(wn[q]) * rstd_q; ss += xn[2 * q] * xn[2 * q] + xn[2 * q + 1] * xn[2 * q + 1]; }
                xr[0] = bf_lo(R.qr[k].x) * rstd_q; xr[1] = bf_hi(R.qr[k].x) * rstd_q; xr[2] = bf_lo(R.qr[k].y) * rstd_q; xr[3] = bf_hi(R.qr[k].y) * rstd_q;
                ss += (xr[0] * xr[0] + xr[1] * xr[1]) + (xr[2] * xr[2] + xr[3] * xr[3]);
                const float r2 = 1.0f / sqrtf(row16_sum(ss) * (1.f / 192.f) + EPS);
                unsigned on[4]; float o[4];
#pragma unroll
                for (int q = 0; q < 4; ++q) on[q] = pk2(xn[2 * q] * r2 * gqn[2 * q], xn[2 * q + 1] * r2 * gqn[2 * q + 1]);
#pragma unroll
                for (int e = 0; e < 4; ++e) { const float y = xr[e] * r2 * gqr[e]; const float yp = DPP_MOV(y, 0x128); o[e] = lowhalf ? (y * cs[e] - yp * sn[e]) : (y * cs[e] + yp * sn[e]); }
                bf16_t* qo = Q + (size_t)row * 1536 + h * 192;
                *(u32x4*)(qo + d0) = (u32x4){on[0], on[1], on[2], on[3]};
                *(u32x2*)(qo + 128 + r0) = (u32x2){pk2(o[0], o[1]), pk2(o[2], o[3])};
            }
            {
                const unsigned wn[4] = {R.kn[k].x, R.kn[k].y, R.kn[k].z, R.kn[k].w}, wv[4] = {R.vv[k].x, R.vv[k].y, R.vv[k].z, R.vv[k].w};
                float xn[8]; float ss = krss;
#pragma unroll
                for (int q = 0; q < 4; ++q) { xn[2 * q] = bf_lo(wn[q]) * rstd_kv; xn[2 * q + 1] = bf_hi(wn[q]) * rstd_kv; ss += xn[2 * q] * xn[2 * q] + xn[2 * q + 1] * xn[2 * q + 1]; }
                const float r2 = 1.0f / sqrtf(row16_sum(ss) * (1.f / 192.f) + EPS);
                unsigned on[4], ov[4]; float o[4];
#pragma unroll
                for (int q = 0; q < 4; ++q) { on[q] = pk2(xn[2 * q] * r2 * gkn[2 * q], xn[2 * q + 1] * r2 * gkn[2 * q + 1]); ov[q] = pk2(bf_lo(wv[q]) * rstd_kv, bf_hi(wv[q]) * rstd_kv); }
#pragma unroll
                for (int e = 0; e < 4; ++e) { const float y = krv[e] * r2 * gkr[e]; const float yp = DPP_MOV(y, 0x128); o[e] = lowhalf ? (y * cs[e] - yp * sn[e]) : (y * cs[e] + yp * sn[e]); }
                bf16_t* ko = Kb + (size_t)row * 1536 + h * 192;
                *(u32x4*)(ko + d0) = (u32x4){on[0], on[1], on[2], on[3]};
                *(u32x2*)(ko + 128 + r0) = (u32x2){pk2(o[0], o[1]), pk2(o[2], o[3])};
                *(u32x4*)(Vb + (size_t)row * 1024 + h * 128 + d0) = (u32x4){ov[0], ov[1], ov[2], ov[3]};
            }
        }
        row = nrow; R = Rn;
    }
}

__device__ __forceinline__ void conv_phase(const Frame& F0, const bf16_t* P, const float* cw  , const float* cb  , bf16_t* CAT) {
    const Frame F = phase_frame(F0);
    const int gt = F.vcu * NTHREADS + F.tid, GT = F.G * NTHREADS;
    for (int it = gt; it < MROWS * 128; it += GT) {
        const int row = it >> 7, c0 = (it & 127) * 8; const int b = row / RB, i = row - b * RB;
        const bool first = (i == 0) || (i == CTX), last = (i == CTX - 1) || (i == RB - 1);
        const bf16_t* pr = P + (size_t)row * 4096 + 832 + c0;
        const u32x4 bg = *(const u32x4*)pr, cg = *(const u32x4*)(pr + 1024), hz = *(const u32x4*)(pr + 2048);
        u32x4 cgm = {0u, 0u, 0u, 0u}, hzm = cgm, cgp = cgm, hzp = cgm;
        if (!first) { cgm = *(const u32x4*)(pr - 4096 + 1024); hzm = *(const u32x4*)(pr - 4096 + 2048); }
        if (!last) { cgp = *(const u32x4*)(pr + 4096 + 1024); hzp = *(const u32x4*)(pr + 4096 + 2048); }
        const unsigned bgw[4] = {bg.x, bg.y, bg.z, bg.w}, cgw[4] = {cg.x, cg.y, cg.z, cg.w}, hzw[4] = {hz.x, hz.y, hz.z, hz.w};
        const unsigned cmw[4] = {cgm.x, cgm.y, cgm.z, cgm.w}, hmw[4] = {hzm.x, hzm.y, hzm.z, hzm.w}, cpw[4] = {cgp.x, cgp.y, cgp.z, cgp.w}, hpw[4] = {hzp.x, hzp.y, hzp.z, hzp.w};
        unsigned ow[4];
#pragma unroll
        for (int q = 0; q < 4; ++q) {
            const int c = c0 + 2 * q;
            const float u0a = bf_lo(cgw[q]) * bf_lo(hzw[q]), u0b = bf_hi(cgw[q]) * bf_hi(hzw[q]);
            const float uma = bf_lo(cmw[q]) * bf_lo(hmw[q]), umb = bf_hi(cmw[q]) * bf_hi(hmw[q]);
            const float upa = bf_lo(cpw[q]) * bf_lo(hpw[q]), upb = bf_hi(cpw[q]) * bf_hi(hpw[q]);
            const float ra = bf_lo(bgw[q]) * (uma * cw[c] + u0a * cw[1024 + c] + upa * cw[2048 + c] + cb[c]);
            const float rb = bf_hi(bgw[q]) * (umb * cw[c + 1] + u0b * cw[1024 + c + 1] + upb * cw[2048 + c + 1] + cb[c + 1]);
            ow[q] = pk2(ra, rb);
        }
        *(u32x4*)(CAT + (size_t)row * DM + 1024 + c0) = (u32x4){ow[0], ow[1], ow[2], ow[3]};
    }
}
__device__ __forceinline__ void attn_even_phase(const Frame& F0, const bf16_t* Q, const bf16_t* Kb, const bf16_t* Vb, bf16_t* CAT) {
    const Frame F = phase_frame(F0);
    for (int u = F.vcu; u < 272; u += F.G) {
        int b, h, qt, nk;
        if (u < 256) { b = u >> 7; h = (u >> 4) & 7; qt = 1 + (u & 15); nk = RB; } else { const int v = u - 256; b = v >> 3; h = v & 7; qt = 0; nk = CTX; }
        const size_t r0 = (size_t)b * RB;
        att::attn_body1<192, 1536, 1536, 1024, 2048>(Q + (r0 + qt * 256) * 1536 + h * 192, Kb + r0 * 1536 + h * 192, Vb + r0 * 1024 + h * 128, CAT + (r0 + qt * 256) * 2048 + h * 128, nk, (char*)F.lds, phase_tid(F.wave));
    }
}
__device__ __forceinline__ void attn_odd_phase(const Frame& F0, const bf16_t* Q, const bf16_t* Kb, const bf16_t* P, bf16_t* CAT, bool lat_only) {
    const Frame F = phase_frame(F0);
    const int nunits = lat_only ? 512 : 544;
    for (int u = F.vcu; u < nunits; u += F.G) {
        int b, hq, qt, nk;
        if (u < 512) { b = u >> 8; hq = (u >> 4) & 15; qt = 1 + (u & 15); nk = RB; } else { const int v = u - 512; b = v >> 4; hq = v & 15; qt = 0; nk = CTX; }
        const int kvh = hq >> 2; const size_t r0 = (size_t)b * RB;
        att::attn_body<128, 2048, 512, 3072, 2048, 2>(Q + (r0 + qt * 256) * 2048 + hq * 128, Kb + r0 * 512 + kvh * 128, P + r0 * 3072 + 2560 + kvh * 128, CAT + (r0 + qt * 256) * 2048 + hq * 128, nk, (char*)F.lds, phase_tid(F.wave));
    }
}

__device__ __forceinline__ int crow32(int r, int hi) { return (r & 3) + 8 * (r >> 2) + 4 * hi; }
__device__ __forceinline__ int fkey(int b) { return b ^ ((b >> 31) & 0x7fffffff); }
#define TK_CE(x, y) do { const int hi_ = max((x), (y)), lo_ = min((x), (y)); (x) = hi_; (y) = lo_; } while (0)
template <int N> __device__ __forceinline__ void tk_sort(int* v) {
#pragma unroll
    for (int k = 2; k <= N; k <<= 1)
#pragma unroll
        for (int j = k >> 1; j > 0; j >>= 1)
#pragma unroll
            for (int i = 0; i < N; ++i) { const int l = i ^ j; if (l > i) { if ((i & k) == 0) TK_CE(v[i], v[l]); else TK_CE(v[l], v[i]); } }
}
__device__ __forceinline__ void tk_merge16(int* a, const int* b) {
#pragma unroll
    for (int i = 0; i < 16; ++i) a[i] = max(a[i], b[15 - i]);
#pragma unroll
    for (int j = 8; j > 0; j >>= 1)
#pragma unroll
        for (int i = 0; i < 16; ++i) { const int l = i ^ j; if (l > i) TK_CE(a[i], a[l]); }
}
__device__ __forceinline__ void tk_merge_partner(int* a) {
    int lo[16], hi[16];
#pragma unroll
    for (int i = 0; i < 16; ++i) { auto rr = __builtin_amdgcn_permlane32_swap((unsigned)a[i], (unsigned)a[i], false, false); lo[i] = (int)rr[0]; hi[i] = (int)rr[1]; }
    tk_merge16(lo, hi);
#pragma unroll
    for (int i = 0; i < 16; ++i) a[i] = lo[i];
}
__device__ __forceinline__ void peer_topk_phase(const Frame& F0, const bf16_t* PQ, const bf16_t* subk  , int* IDX, float* GATE, bool lat_only) {
    const Frame F = phase_frame(F0);
    const int h = F.vcu & 7, jw = (F.vcu >> 3) * NWAVES + F.wave, nwh = (F.G >> 3) * NWAVES;
    {
        const bf16_t* src = subk + (size_t)h * 2 * 128 * 128;
        for (int c = F.tid; c < 4096; c += NTHREADS) { const int row = c >> 4, ch = c & 15;
            *(LAS u32x4*)(F.lds + row * 256 + ((ch ^ (row & 15)) << 4)) = *(const u32x4*)(src + (size_t)row * 128 + ch * 8); }
        __syncthreads();
    }
    const int ntg = lat_only ? 256 : MROWS / 32;
    for (int t = jw; t < ntg; t += nwh) {
        int lane_ = F.lane; asm volatile("" : "+v"(lane_));
        const int r32 = lane_ & 31, hi = lane_ >> 5;
        int tg = t; if (lat_only) tg += 8 + (tg >= 128 ? 8 : 0);
        const int token = tg * 32 + r32;
        int top[2][16];
        const int kk = (((r32 & 14) | (hi ^ (r32 & 1))) << 4);
#pragma unroll
        for (int p = 0; p < 2; ++p) {
            bf16x8 bq[8];
            const bf16_t* qp = PQ + (size_t)token * DM + h * 256 + p * 128 + hi * 8;
#pragma unroll
            for (int ks = 0; ks < 8; ++ks) bq[ks] = *(const bf16x8*)(qp + ks * 16);
            int s[4][16];
#pragma unroll
            for (int nb = 0; nb < 4; ++nb) {
                f32x16 acc = {};
                const LAS unsigned char* kp = F.lds + (p * 128 + nb * 32 + r32) * 256;
#pragma unroll
                for (int ks = 0; ks < 8; ++ks) { const bf16x8 a = *(const LAS bf16x8*)(kp + (kk ^ (ks << 5))); acc = __builtin_amdgcn_mfma_f32_32x32x16_bf16(a, bq[ks], acc, 0, 0, 0); }
#pragma unroll
                for (int r = 0; r < 16; ++r) { const int key = nb * 32 + crow32(r, hi); s[nb][r] = fkey((int)((__float_as_uint(acc[r]) & ~127u) | (unsigned)(127 - key))); }
                tk_sort<16>(s[nb]);
            }
            tk_merge16(s[0], s[1]); tk_merge16(s[2], s[3]); tk_merge16(s[0], s[2]);
            tk_merge_partner(s[0]);
#pragma unroll
            for (int j = 0; j < 16; ++j) top[p][j] = s[0][j];
        }
        int cand[32];
        unsigned long long kaLo = 0ull, kaHi = 0ull, kbLo = 0ull, kbHi = 0ull;
        {
            float fb[16]; const float fa0 = __uint_as_float((unsigned)fkey(top[0][0]) & ~127u), fb0 = __uint_as_float((unsigned)fkey(top[1][0]) & ~127u);
#pragma unroll
            for (int r = 0; r < 16; ++r) { const int ba = fkey(top[0][r]), bb = fkey(top[1][r]); fb[r] = __uint_as_float((unsigned)bb & ~127u) - fb0;
                const unsigned long long xa = (unsigned long long)(unsigned)(127 - (ba & 127)) << (8 * (r & 7)), xb = (unsigned long long)(unsigned)(127 - (bb & 127)) << (8 * (r & 7));
                if (r < 8) { kaLo |= xa; kbLo |= xb; } else { kaHi |= xa; kbHi |= xb; } }
            float fa[8];
#pragma unroll
            for (int i = 0; i < 8; ++i) { const int ka = hi ? top[0][2 * i + 1] : top[0][2 * i]; fa[i] = __uint_as_float((unsigned)fkey(ka) & ~127u) - fa0; }
            const int hid = 255 - (hi << 4);
            int n = 0;
#pragma unroll
            for (int i = 0; i < 8; ++i)
#pragma unroll
                for (int b = 0; b < 16; ++b) if ((2 * i + 1) * (b + 1) <= 16) {
                    const float sum = fa[i] + fb[b];
                    cand[n++] = fkey((int)((__float_as_uint(sum) & ~255u) | (unsigned)(hid - (32 * i + b))));
                }
#pragma unroll
            for (; n < 32; ++n) cand[n] = (int)0x80000000;
        }
        tk_sort<16>(cand); tk_sort<16>(cand + 16); tk_merge16(cand, cand + 16);
        tk_merge_partner(cand);
        float ev[16]; float esum = 0.f;
#pragma unroll
        for (int j = 0; j < 16; ++j) { ev[j] = __expf(__uint_as_float((unsigned)fkey(cand[j]) & ~255u)); esum += ev[j]; }
        const float rs = 1.0f / esum;
        int oi[8]; float og[8];
#pragma unroll
        for (int j = 0; j < 8; ++j) { const int w = hi ? cand[8 + j] : cand[j]; const float e = hi ? ev[8 + j] : ev[j];
            const int id8 = 255 - (fkey(w) & 255), ra = id8 >> 4, rb = id8 & 15;
            const unsigned long long wa = (ra & 8) ? kaHi : kaLo, wb = (rb & 8) ? kbHi : kbLo;
            const int ka = (int)(wa >> (8 * (ra & 7))) & 127, kb = (int)(wb >> (8 * (rb & 7))) & 127;
            oi[j] = ka * 128 + kb; og[j] = e * rs; }
        int* ip = IDX + (size_t)token * 128 + h * 16 + hi * 8; float* gp = GATE + (size_t)token * 128 + h * 16 + hi * 8;
        *(int4*)ip = make_int4(oi[0], oi[1], oi[2], oi[3]); *(int4*)(ip + 4) = make_int4(oi[4], oi[5], oi[6], oi[7]);
        *(f32x4*)gp = (f32x4){og[0], og[1], og[2], og[3]}; *(f32x4*)(gp + 4) = (f32x4){og[4], og[5], og[6], og[7]};
    }
}

#if TAB_FP4
__device__ __forceinline__ void peer_expert_phase(const Frame& F0, const bf16_t* H2, const int* IDX, const float* GATE, const unsigned char* U, size_t v_minus_u_bytes, const float* USC, const float* VSC,
                                                  const float* g2  , float* XW, float* OUT,
                                                  bf16_t* HN  , const float* ng  , const float* nmod  ) {
    const Frame F = phase_frame(F0);
    LAS float* red = (LAS float*)F.lds;
    const unsigned voff_tab = (unsigned)v_minus_u_bytes;
    const __amdgpu_buffer_rsrc_t rs = __builtin_amdgcn_make_buffer_rsrc((void*)U, 0, (int)(voff_tab + (unsigned)NEXP * ROWB), 0x00020000);
    const int lane = F.lane; const int voff = lane * 16;
#define PX_SB() __builtin_amdgcn_sched_barrier(0)
#define PX_LOADALL(buf, ivv, tb) do { _Pragma("unroll") for (int e_ = 0; e_ < 16; ++e_) buf[e_] = __builtin_amdgcn_raw_buffer_load_b128(rs, voff, (unsigned)__builtin_amdgcn_readlane(ivv, e_) * (unsigned)ROWB + (tb), 0); } while (0)
#define PX_U1(d_, b_) { const bf16x2_t r2_ = __builtin_amdgcn_cvt_scalef32_pk_bf16_fp4(wd_[d_], 1.0f, b_); if ((b_) & 1) a1_ = __builtin_amdgcn_fdot2_f32_bf16(r2_, __builtin_bit_cast(bf16x2_t, xpk[4 * (d_) + (b_)]), a1_, false); \
                        else a0_ = __builtin_amdgcn_fdot2_f32_bf16(r2_, __builtin_bit_cast(bf16x2_t, xpk[4 * (d_) + (b_)]), a0_, false); }
#define PX_V1(d_, b_) { const f32x2 t2_ = __builtin_amdgcn_cvt_scalef32_pk_f32_fp4(wd_[d_], 1.0f, b_); acc[8 * (d_) + 2 * (b_)] += wg_ * t2_.x; acc[8 * (d_) + 2 * (b_) + 1] += wg_ * t2_.y; }
#define PX_FETCH_TOKEN(r, XP, IV, GV) do { const u32x4* xp_ = (const u32x4*)(H2 + (size_t)(r) * DM + lane * 16); XP[0] = xp_[0]; XP[1] = xp_[1]; XP[2] = xp_[128]; XP[3] = xp_[129]; \
        IV = 0; GV = 0.f; if (lane < 16) { IV = IDX[(size_t)(r) * 128 + F.wave * 16 + lane]; GV = GATE[(size_t)(r) * 128 + F.wave * 16 + lane]; } } while (0)
    const bool skip_ctx = (OUT != nullptr);
    int row = F.vcu; if (skip_ctx && row < MROWS && row_cls(row) == 2) row += F.G;
    u32x4 xp[4]; int iv; float gv;
    u32x4 ub[16], vb[16];
    if (row < MROWS) { PX_FETCH_TOKEN(row, xp, iv, gv); PX_LOADALL(ub, iv, 0u); PX_LOADALL(vb, iv, voff_tab); }
    int par = 0;
    while (row < MROWS) {
        int nrow = row + F.G; if (skip_ctx && nrow < MROWS && row_cls(nrow) == 2) nrow += F.G;
        float usc = 0.f, vsc = 0.f;
        if (lane < 16) { usc = USC[iv]; vsc = VSC[iv]; }
        u32x4 xpn[4]; int ivn = 0; float gvn = 0.f;
        if (nrow < MROWS) PX_FETCH_TOKEN(nrow, xpn, ivn, gvn);
        const int cls = row_cls(row);
        const f32x4 x_old = *((const f32x4*)(XW + (size_t)row * DM) + F.tid), g_vec = *((const f32x4*)(g2 + (size_t)cls * NMOD) + F.tid);
        f32x4 n_g = {0.f, 0.f, 0.f, 0.f}, n_sc = n_g, n_sh = n_g;
        if (HN) { n_g = *((const f32x4*)ng + F.tid); n_sc = *((const f32x4*)(nmod + (size_t)cls * NMOD + 2048) + F.tid); n_sh = *((const f32x4*)(nmod + (size_t)cls * NMOD) + F.tid); }
        const unsigned xpk[16] = {xp[0].x, xp[0].y, xp[0].z, xp[0].w, xp[1].x, xp[1].y, xp[1].z, xp[1].w, xp[2].x, xp[2].y, xp[2].z, xp[2].w, xp[3].x, xp[3].y, xp[3].z, xp[3].w};
        float sv = 0.f;
        PX_SB();
#pragma unroll
        for (int e = 0; e < 16; ++e) {
            u32x4 w_ = ub[e]; asm volatile("" : "+v"(w_) : "v"(sv));
            const unsigned wd_[4] = {w_.x, w_.y, w_.z, w_.w}; float a0_ = 0.f, a1_ = 0.f;
            PX_U1(0, 0) PX_U1(0, 1) PX_U1(0, 2) PX_U1(0, 3) PX_U1(1, 0) PX_U1(1, 1) PX_U1(1, 2) PX_U1(1, 3) PX_U1(2, 0) PX_U1(2, 1) PX_U1(2, 2) PX_U1(2, 3) PX_U1(3, 0) PX_U1(3, 1) PX_U1(3, 2) PX_U1(3, 3)
            const float t_ = wave_sum_dpp(a0_ + a1_); sv = (lane == e) ? t_ : sv;
        }
        const float wv = gelu_erf(sv * usc) * gv * vsc;
        PX_SB();
        if (nrow < MROWS) PX_LOADALL(ub, ivn, 0u);
        PX_SB();
        f32x32 acc = {};
#pragma unroll
        for (int e = 0; e < 16; ++e) {
            u32x4 w_ = vb[e]; asm volatile("" : "+v"(w_) : "v"(acc));
            const unsigned wd_[4] = {w_.x, w_.y, w_.z, w_.w}; const float wg_ = __uint_as_float(__builtin_amdgcn_readlane(__float_as_uint(wv), e));
            PX_V1(0, 0) PX_V1(0, 1) PX_V1(0, 2) PX_V1(0, 3) PX_V1(1, 0) PX_V1(1, 1) PX_V1(1, 2) PX_V1(1, 3) PX_V1(2, 0) PX_V1(2, 1) PX_V1(2, 2) PX_V1(2, 3) PX_V1(3, 0) PX_V1(3, 1) PX_V1(3, 2) PX_V1(3, 3)
        }
        PX_SB();
        if (nrow < MROWS) PX_LOADALL(vb, ivn, voff_tab);
        PX_SB();
        LAS float* rb = red + par * (NWAVES * DM);
#pragma unroll
        for (int j = 0; j < 2; ++j)
#pragma unroll
            for (int q = 0; q < 4; ++q) *(LAS f32x4*)(rb + F.wave * DM + j * 1024 + lane * 16 + q * 4) = (f32x4){acc[j * 16 + q * 4], acc[j * 16 + q * 4 + 1], acc[j * 16 + q * 4 + 2], acc[j * 16 + q * 4 + 3]};
        __syncthreads();
        {
            f32x4 sm = {0.f, 0.f, 0.f, 0.f};
#pragma unroll
            for (int w = 0; w < 8; ++w) sm += *(const LAS f32x4*)(rb + w * DM + F.tid * 4);
            f32x4* xq = (f32x4*)(XW + (size_t)row * DM) + F.tid;
            const f32x4 xn = x_old + g_vec * sm;
            *xq = xn;
            if (OUT) { const int b = row / RB, i = row - b * RB; if (i >= CTX) *((f32x4*)(OUT + ((size_t)b * SEQ + (i - CTX)) * DM) + F.tid) = xn; }
            if (HN) {
                LAS float* ssp = (LAS float*)(F.lds + 131072) + par * 8;
                const float sw = wave_sum_dpp((xn.x * xn.x + xn.y * xn.y) + (xn.z * xn.z + xn.w * xn.w));
                if (lane == 0) ssp[F.wave] = sw;
                __syncthreads();
                const float tot = ((ssp[0] + ssp[1]) + (ssp[2] + ssp[3])) + ((ssp[4] + ssp[5]) + (ssp[6] + ssp[7]));
                const float rstd = 1.0f / sqrtf(tot * (1.f / DM) + EPS);
                const f32x4 y = (xn * rstd) * n_g * (n_sc + 1.0f) + n_sh;
                u32x2 o; o.x = pk2(y.x, y.y); o.y = pk2(y.z, y.w);
                *((u32x2*)(HN + (size_t)row * DM) + F.tid) = o;
            }
        }
        par ^= 1; row = nrow;
#pragma unroll
        for (int q = 0; q < 4; ++q) xp[q] = xpn[q];
        iv = ivn; gv = gvn;
    }
#undef PX_LOADALL
#undef PX_U1
#undef PX_V1
#undef PX_SB
#undef PX_FETCH_TOKEN
}
#else
__device__ __forceinline__ void peer_expert_phase(const Frame& F0, const bf16_t* H2, const int* IDX, const float* GATE, const unsigned char* U, size_t v_minus_u_bytes, const float* USC, const float* VSC,
                                                  const float* g2  , float* XW, float* OUT,
                                                  bf16_t* HN  , const float* ng  , const float* nmod  ) {
    const Frame F = phase_frame(F0);
    LAS float* red = (LAS float*)F.lds;
    const unsigned voff_tab = (unsigned)v_minus_u_bytes;
    const __amdgpu_buffer_rsrc_t rs = __builtin_amdgcn_make_buffer_rsrc((void*)U, 0, (int)(voff_tab + (unsigned)NEXP * ROWB), 0x00020000);
    const int lane = F.lane; const int voff = lane * 16, voff2 = 1024 + lane * 8;
#define PX_SB() __builtin_amdgcn_sched_barrier(0)
#define PX_LOAD(buf, s, ivv) do { constexpr int e0_ = ((s) & 3) * 4; const unsigned tb_ = ((s) >= 4) ? voff_tab : 0u; \
        _Pragma("unroll") for (int ee_ = 0; ee_ < 4; ++ee_) { const unsigned o_ = (unsigned)__builtin_amdgcn_readlane(ivv, e0_ + ee_) * (unsigned)ROWB + tb_; \
            buf##h[ee_] = __builtin_amdgcn_raw_buffer_load_b128(rs, voff, o_, 0); buf##l[ee_] = __builtin_amdgcn_raw_buffer_load_b64(rs, voff2, o_, 0); } } while (0)
#define PX_DECODE(buf, ee_, dep) u32x6 w6_ = {buf##h[ee_].x, buf##h[ee_].y, buf##h[ee_].z, buf##h[ee_].w, buf##l[ee_].x, buf##l[ee_].y}; \
        asm volatile("" : "+v"(w6_) : "v"(dep));     \
        const f32x32 r_ = __builtin_amdgcn_cvt_scalef32_pk32_f32_fp6(w6_, 1.0f);
#define PX_COMP_U(buf, s) do { constexpr int e0_ = ((s) & 3) * 4; \
            _Pragma("unroll") for (int ee_ = 0; ee_ < 4; ++ee_) { PX_DECODE(buf, ee_, sv) \
                const f32x32 p_ = r_ * xf; float a0_ = 0.f, a1_ = 0.f; \
                _Pragma("unroll") for (int k_ = 0; k_ < 32; k_ += 2) { a0_ += p_[k_]; a1_ += p_[k_ + 1]; } \
                const float t_ = wave_sum_dpp(a0_ + a1_); sv = (lane == e0_ + ee_) ? t_ : sv; } } while (0)
#define PX_COMP_V(buf, s) do { constexpr int e0_ = ((s) & 3) * 4; \
            _Pragma("unroll") for (int ee_ = 0; ee_ < 4; ++ee_) { const float wg_ = __uint_as_float(__builtin_amdgcn_readlane(__float_as_uint(wv), e0_ + ee_)); \
                PX_DECODE(buf, ee_, acc) \
                acc += r_ * wg_; } } while (0)
#define PX_FETCH_TOKEN(r, XP, IV, GV) do { const u32x4* xp_ = (const u32x4*)(H2 + (size_t)(r) * DM + lane * 16); XP[0] = xp_[0]; XP[1] = xp_[1]; XP[2] = xp_[128]; XP[3] = xp_[129]; \
        IV = 0; GV = 0.f; if (lane < 16) { IV = IDX[(size_t)(r) * 128 + F.wave * 16 + lane]; GV = GATE[(size_t)(r) * 128 + F.wave * 16 + lane]; } } while (0)
    const bool skip_ctx = (OUT != nullptr);
    int row = F.vcu; if (skip_ctx && row < MROWS && row_cls(row) == 2) row += F.G;
    u32x4 xp[4]; int iv; float gv;
    u32x4 bAh[4], bBh[4]; u32x2 bAl[4], bBl[4];
    if (row < MROWS) { PX_FETCH_TOKEN(row, xp, iv, gv); PX_LOAD(bA, 0, iv); }
    int par = 0;
    while (row < MROWS) {
        int nrow = row + F.G; if (skip_ctx && nrow < MROWS && row_cls(nrow) == 2) nrow += F.G;
        f32x32 xf;
#pragma unroll
        for (int q = 0; q < 4; ++q) { const unsigned ww[4] = {xp[q].x, xp[q].y, xp[q].z, xp[q].w};
#pragma unroll
            for (int k = 0; k < 4; ++k) { xf[q * 8 + 2 * k] = bf_lo(ww[k]); xf[q * 8 + 2 * k + 1] = bf_hi(ww[k]); } }
        float usc = 0.f, vsc = 0.f;
        if (lane < 16) { usc = USC[iv]; vsc = VSC[iv]; }
        u32x4 xpn[4]; int ivn = 0; float gvn = 0.f;
        if (nrow < MROWS) PX_FETCH_TOKEN(nrow, xpn, ivn, gvn);
        const int cls = row_cls(row);
        const f32x4 x_old = *((const f32x4*)(XW + (size_t)row * DM) + F.tid), g_vec = *((const f32x4*)(g2 + (size_t)cls * NMOD) + F.tid);
        f32x4 n_g = {0.f, 0.f, 0.f, 0.f}, n_sc = n_g, n_sh = n_g;
        if (HN) { n_g = *((const f32x4*)ng + F.tid); n_sc = *((const f32x4*)(nmod + (size_t)cls * NMOD + 2048) + F.tid); n_sh = *((const f32x4*)(nmod + (size_t)cls * NMOD) + F.tid); }
        float sv = 0.f, wv = 0.f;
        PX_LOAD(bB, 1, iv); PX_SB(); PX_COMP_U(bA, 0); PX_SB();
        PX_LOAD(bA, 2, iv); PX_SB(); PX_COMP_U(bB, 1); PX_SB();
        PX_LOAD(bB, 3, iv); PX_SB(); PX_COMP_U(bA, 2); PX_SB();
        PX_LOAD(bA, 4, iv); PX_SB(); PX_COMP_U(bB, 3); PX_SB();
        wv = gelu_erf(sv * usc) * gv * vsc;
        f32x32 acc = {};
        PX_LOAD(bB, 5, iv); PX_SB(); PX_COMP_V(bA, 4); PX_SB();
        PX_LOAD(bA, 6, iv); PX_SB(); PX_COMP_V(bB, 5); PX_SB();
        PX_LOAD(bB, 7, iv); PX_SB(); PX_COMP_V(bA, 6); PX_SB();
        if (nrow < MROWS) PX_LOAD(bA, 0, ivn);
        PX_SB(); PX_COMP_V(bB, 7); PX_SB();
        LAS float* rb = red + par * (NWAVES * DM);
#pragma unroll
        for (int j = 0; j < 2; ++j)
#pragma unroll
            for (int q = 0; q < 4; ++q) *(LAS f32x4*)(rb + F.wave * DM + j * 1024 + lane * 16 + q * 4) = (f32x4){acc[j * 16 + q * 4], acc[j * 16 + q * 4 + 1], acc[j * 16 + q * 4 + 2], acc[j * 16 + q * 4 + 3]};
        __syncthreads();
        {
            f32x4 sm = {0.f, 0.f, 0.f, 0.f};
#pragma unroll
            for (int w = 0; w < 8; ++w) sm += *(const LAS f32x4*)(rb + w * DM + F.tid * 4);
            f32x4* xq = (f32x4*)(XW + (size_t)row * DM) + F.tid;
            const f32x4 xn = x_old + g_vec * sm;
            *xq = xn;
            if (OUT) { const int b = row / RB, i = row - b * RB; if (i >= CTX) *((f32x4*)(OUT + ((size_t)b * SEQ + (i - CTX)) * DM) + F.tid) = xn; }
            if (HN) {
                LAS float* ssp = (LAS float*)(F.lds + 131072) + par * 8;
                const float sw = wave_sum_dpp((xn.x * xn.x + xn.y * xn.y) + (xn.z * xn.z + xn.w * xn.w));
                if (lane == 0) ssp[F.wave] = sw;
                __syncthreads();
                const float tot = ((ssp[0] + ssp[1]) + (ssp[2] + ssp[3])) + ((ssp[4] + ssp[5]) + (ssp[6] + ssp[7]));
                const float rstd = 1.0f / sqrtf(tot * (1.f / DM) + EPS);
                const f32x4 y = (xn * rstd) * n_g * (n_sc + 1.0f) + n_sh;
                u32x2 o; o.x = pk2(y.x, y.y); o.y = pk2(y.z, y.w);
                *((u32x2*)(HN + (size_t)row * DM) + F.tid) = o;
            }
        }
        par ^= 1; row = nrow;
#pragma unroll
        for (int q = 0; q < 4; ++q) xp[q] = xpn[q];
        iv = ivn; gv = gvn;
    }
#undef PX_LOAD
#undef PX_COMP_U
#undef PX_COMP_V
#undef PX_SB
#undef PX_FETCH_TOKEN
}
#endif

#if EXP_SLICED && TAB_FP4
__device__ __forceinline__ float oct_sum(float v) { v = DPP_ADD(v, 0xB1); v = DPP_ADD(v, 0x4E); v = DPP_ADD(v, 0x141); return v; }
__device__ __forceinline__ int sl_next_tok(int t, int stride, bool lat_only) { t += stride; if (lat_only) while (t < MROWS && row_cls(t) == 2) t += stride; return t; }
#ifndef PROBE_IDMASK
#define PROBE_IDMASK 0x7fffffff
#endif
#define SL_IDS(t_, A_, B_) do { A_ = IDX[(size_t)(t_) * 128 + lane] & idmask; B_ = IDX[(size_t)(t_) * 128 + 64 + lane] & idmask; } while (0)
#define SL_ROWS(buf, A_, B_) do { _Pragma("unroll") for (int i_ = 0; i_ < 16; ++i_) { const int id_ = __builtin_amdgcn_ds_bpermute(bp + 32 * (i_ & 7), (i_ < 8) ? (A_) : (B_)); \
        buf[i_] = __builtin_amdgcn_raw_buffer_load_b128(rs, id_ * 128 + coloff, 0, 0); } } while (0)
#if PEER_MFMA
typedef int i32x8 __attribute__((ext_vector_type(8)));
__device__ __forceinline__ void peer_u_phase(const Frame& F0, const unsigned* XQ, const float* XS, const int* IDX, const unsigned char* U, float* PART, bool lat_only, int idmask = 0x7fffffff) {
    const Frame F = phase_frame(F0);
    const int lane = F.lane, n = lane & 15, kb = lane >> 4, bp = 4 * n;
    const int wps = F.G >> 3, x = F.vcu / wps, wi = (F.vcu - x * wps) * NWAVES + F.wave, stride = wps * NWAVES;
    const __amdgpu_buffer_rsrc_t rs = __builtin_amdgcn_make_buffer_rsrc((void*)(U + (size_t)x * (NEXP * 128)), 0, NEXP * 128, 0x00020000);
    const int coloff = 16 * kb;
    int t = wi - stride; t = sl_next_tok(t, stride, lat_only);
    int t1 = sl_next_tok(t, stride, lat_only), t2 = sl_next_tok(t1, stride, lat_only);
    int idA1 = 0, idB1 = 0, idA2 = 0, idB2 = 0, idA3 = 0, idB3 = 0; u32x4 xs[4], xs1[4], xs2[4], w[16], wn[16];
#define SL_XS(dst, t_) do { const u32x4* xp_ = (const u32x4*)((const unsigned char*)XQ + (size_t)(t_) * DM + 256 * x + 16 * kb); dst[0] = xp_[0]; dst[1] = xp_[4]; dst[2] = xp_[8]; dst[3] = xp_[12]; } while (0)
#define SL_UROWS(buf, A_, B_) do { _Pragma("unroll") for (int h_ = 0; h_ < 8; ++h_) { const int id_ = __builtin_amdgcn_ds_bpermute(bp + 64 * (h_ & 3), (h_ < 4) ? (A_) : (B_)); \
        buf[2 * h_] = __builtin_amdgcn_raw_buffer_load_b128(rs, id_ * 128 + coloff, 0, 0); buf[2 * h_ + 1] = __builtin_amdgcn_raw_buffer_load_b128(rs, id_ * 128 + coloff + 64, 0, 0); } } while (0)
    if (t < MROWS) { int idA0, idB0; SL_IDS(t, idA0, idB0); SL_XS(xs1, t); SL_UROWS(w, idA0, idB0); }
    if (t1 < MROWS) { SL_IDS(t1, idA2, idB2); SL_XS(xs2, t1); }
    if (t2 < MROWS) SL_IDS(t2, idA3, idB3);
#define SL_UBODY(CUR, NXT) do { \
        const int t3 = sl_next_tok(t2, stride, lat_only); \
_Pragma("unroll") \
        for (int q = 0; q < 4; ++q) { xs[q] = xs1[q]; xs1[q] = xs2[q]; } \
        idA1 = idA2; idB1 = idB2; idA2 = idA3; idB2 = idB3; \
        if (t1 < MROWS) SL_UROWS(NXT, idA1, idB1); \
        if (t2 < MROWS) SL_XS(xs2, t2); \
        if (t3 < MROWS) SL_IDS(t3, idA3, idB3); \
        const i32x8 a0 = {(int)xs[0].x, (int)xs[0].y, (int)xs[0].z, (int)xs[0].w, (int)xs[1].x, (int)xs[1].y, (int)xs[1].z, (int)xs[1].w}; \
        const i32x8 a1 = {(int)xs[2].x, (int)xs[2].y, (int)xs[2].z, (int)xs[2].w, (int)xs[3].x, (int)xs[3].y, (int)xs[3].z, (int)xs[3].w}; \
        float res_lo = 0.f, res_hi = 0.f; \
_Pragma("unroll") \
        for (int h = 0; h < 8; ++h) { \
            const i32x8 b0 = {(int)CUR[2 * h].x, (int)CUR[2 * h].y, (int)CUR[2 * h].z, (int)CUR[2 * h].w, 0, 0, 0, 0}; \
            const i32x8 b1 = {(int)CUR[2 * h + 1].x, (int)CUR[2 * h + 1].y, (int)CUR[2 * h + 1].z, (int)CUR[2 * h + 1].w, 0, 0, 0, 0}; \
            f32x4 d = {0.f, 0.f, 0.f, 0.f}; \
            d = __builtin_amdgcn_mfma_scale_f32_16x16x128_f8f6f4(a0, b0, d, 0, 4, 0, 0, 0, 0); \
            d = __builtin_amdgcn_mfma_scale_f32_16x16x128_f8f6f4(a1, b1, d, 0, 4, 0, 0, 0, 0); \
            if (h < 4) res_lo = (kb == h) ? d[0] : res_lo; else res_hi = (kb == h - 4) ? d[0] : res_hi; \
        } \
        float* pp = PART + ((size_t)t * 8 + x) * 128 + lane; \
        pp[0] = res_lo; pp[64] = res_hi; \
        t = t1; t1 = t2; t2 = t3; \
    } while (0)
    while (t < MROWS) { SL_UBODY(w, wn); if (!(t < MROWS)) break; SL_UBODY(wn, w); }
#undef SL_UBODY
#undef SL_UROWS
#undef SL_XS
}
#else
__device__ __forceinline__ void peer_u_phase(const Frame& F0, const unsigned* XQ, const float* XS, const int* IDX, const unsigned char* U, float* PART, bool lat_only, int idmask = 0x7fffffff) {
    const Frame F = phase_frame(F0);
    const int lane = F.lane, g = lane >> 3, j = lane & 7, bp = 4 * g;
    const int wps = F.G >> 3, x = F.vcu / wps, wi = (F.vcu - x * wps) * NWAVES + F.wave, stride = wps * NWAVES;
    const __amdgpu_buffer_rsrc_t rs = __builtin_amdgcn_make_buffer_rsrc((void*)(U + (size_t)x * (NEXP * 128)), 0, NEXP * 128, 0x00020000);
    const int coloff = 16 * j;
    int t = wi - stride; t = sl_next_tok(t, stride, lat_only);
    int t1 = sl_next_tok(t, stride, lat_only), t2 = sl_next_tok(t1, stride, lat_only);
    int idA1 = 0, idB1 = 0, idA2 = 0, idB2 = 0, idA3 = 0, idB3 = 0; u32x4 xs[3], xs1[3], xs2[3], w[16], wn[16];
#define SL_XS(dst, t_) do { const u32x4* xp_ = (const u32x4*)(XQ + ((size_t)(t_) * 64 + 8 * x + j) * 8); dst[0] = xp_[0]; dst[1] = xp_[1]; const f32x2 s2_ = *(const f32x2*)(XS + ((size_t)(t_) * 64 + 8 * x + j) * 2); dst[2] = (u32x4){__float_as_uint(s2_.x), __float_as_uint(s2_.y), 0u, 0u}; } while (0)
    if (t < MROWS) { int idA0, idB0; SL_IDS(t, idA0, idB0); SL_XS(xs1, t); SL_ROWS(w, idA0, idB0); }
    if (t1 < MROWS) { SL_IDS(t1, idA2, idB2); SL_XS(xs2, t1); }
    if (t2 < MROWS) SL_IDS(t2, idA3, idB3);
#define SL_UBODY(CUR, NXT) do { \
        const int t3 = sl_next_tok(t2, stride, lat_only); \
_Pragma("unroll") \
        for (int q = 0; q < 3; ++q) { xs[q] = xs1[q]; xs1[q] = xs2[q]; } \
        idA1 = idA2; idB1 = idB2; idA2 = idA3; idB2 = idB3; \
        if (t1 < MROWS) SL_ROWS(NXT, idA1, idB1); \
        if (t2 < MROWS) SL_XS(xs2, t2); \
        if (t3 < MROWS) SL_IDS(t3, idA3, idB3); \
        const int xh[4] = {(int)xs[0].x, (int)xs[0].y, (int)xs[0].z, (int)xs[0].w}, xl[4] = {(int)xs[1].x, (int)xs[1].y, (int)xs[1].z, (int)xs[1].w}; \
        const float dq = __uint_as_float(xs[2].x), off = __uint_as_float(xs[2].y); \
        float res_lo = 0.f, res_hi = 0.f; \
_Pragma("unroll") \
        for (int i = 0; i < 16; ++i) { \
            const int wd_[4] = {(int)CUR[i].x, (int)CUR[i].y, (int)CUR[i].z, (int)CUR[i].w}; int ah_ = 0, al_ = 0; \
_Pragma("unroll") \
            for (int d = 0; d < 4; ++d) { ah_ = __builtin_amdgcn_sdot8(wd_[d], xh[d], ah_, false); al_ = __builtin_amdgcn_sdot8(wd_[d], xl[d], al_, false); } \
            const float a_ = oct_sum(((float)(16 * ah_ + al_) + off) * dq); \
            if (i < 8) res_lo = (j == i) ? a_ : res_lo; else res_hi = (j == i - 8) ? a_ : res_hi; \
        } \
        float* pp = PART + ((size_t)t * 8 + x) * 128 + 8 * j + g; \
        pp[0] = res_lo; pp[64] = res_hi; \
        t = t1; t1 = t2; t2 = t3; \
    } while (0)
    while (t < MROWS) { SL_UBODY(w, wn); if (!(t < MROWS)) break; SL_UBODY(wn, w); }
#undef SL_UBODY
#undef SL_XS
}
#endif
#if PEER_VMFMA
typedef int i32x8v __attribute__((ext_vector_type(8)));
typedef int i32x2v __attribute__((ext_vector_type(2)));
__device__ __forceinline__ float wave_max_dpp(float v) {
    v = fmaxf(v, DPP_MOV(v, 0xB1)); v = fmaxf(v, DPP_MOV(v, 0x4E)); v = fmaxf(v, DPP_MOV(v, 0x141)); v = fmaxf(v, DPP_MOV(v, 0x140));
    const int vi = __builtin_bit_cast(int, v);
    return fmaxf(fmaxf(__builtin_bit_cast(float, __builtin_amdgcn_readlane(vi, 0)), __builtin_bit_cast(float, __builtin_amdgcn_readlane(vi, 16))),
                 fmaxf(__builtin_bit_cast(float, __builtin_amdgcn_readlane(vi, 32)), __builtin_bit_cast(float, __builtin_amdgcn_readlane(vi, 48))));
}
__device__ __forceinline__ void peer_wq_phase(const Frame& F0, const float* PART, const int* IDX, const float* GATE, const float* USC, const float* VSC, bool lat_only, unsigned char* WQ8, float* WSC) {
    const Frame F = phase_frame(F0);
    const int lane = F.lane;
    for (int t0 = F.gw; t0 < MROWS; t0 += 2 * F.NGW) {
        float s[2][2]; int id[2][2]; float gt[2][2]; bool ok[2];
#pragma unroll
        for (int u = 0; u < 2; ++u) { const int t = t0 + u * F.NGW; ok[u] = t < MROWS && !(lat_only && row_cls(t) == 2);
            s[u][0] = s[u][1] = 0.f; id[u][0] = id[u][1] = 0; gt[u][0] = gt[u][1] = 0.f;
            if (ok[u]) { const float* pp = PART + (size_t)t * 1024 + lane;
#pragma unroll
                for (int xx = 0; xx < 8; ++xx) { s[u][0] += pp[xx * 128]; s[u][1] += pp[xx * 128 + 64]; }
                id[u][0] = IDX[(size_t)t * 128 + lane]; id[u][1] = IDX[(size_t)t * 128 + 64 + lane]; gt[u][0] = GATE[(size_t)t * 128 + lane]; gt[u][1] = GATE[(size_t)t * 128 + 64 + lane]; } }
        float us[2][2], vs[2][2];
#pragma unroll
        for (int u = 0; u < 2; ++u)
#pragma unroll
            for (int q = 0; q < 2; ++q) { us[u][q] = ok[u] ? USC[id[u][q]] : 0.f; vs[u][q] = ok[u] ? VSC[id[u][q]] : 0.f; }
#pragma unroll
        for (int u = 0; u < 2; ++u) if (ok[u]) { const int t = t0 + u * F.NGW;
            const float w0 = gt[u][0] * gelu_erf(s[u][0] * us[u][0]) * vs[u][0], w1 = gt[u][1] * gelu_erf(s[u][1] * us[u][1]) * vs[u][1];
            const float am = fmaxf(wave_max_dpp(fmaxf(fabsf(w0), fabsf(w1))), 1e-30f), qs = 440.0f / am;
            const int pk = __builtin_amdgcn_cvt_pk_fp8_f32(w0 * qs, w1 * qs, 0, false);
            WQ8[(size_t)t * 128 + lane] = (unsigned char)(pk & 0xff); WQ8[(size_t)t * 128 + 64 + lane] = (unsigned char)((pk >> 8) & 0xff);
            if (lane == 0) WSC[t] = am * (1.0f / 440.0f); }
    }
}
__device__ __forceinline__ void peer_v_phase(const Frame& F0, const int* IDX, const unsigned char* WQ8, const float* WSC, const unsigned char* VT, const float* g2  , float* XW, float* OUT, bool lat_only) {
    const int idmask = 0x7fffffff;
    const Frame F = phase_frame(F0);
    const int lane = F.lane, g = lane >> 3, j = lane & 7, bp = 4 * g, n = lane & 15, kb = lane >> 4;
    const int wps = F.G >> 3, x = F.vcu / wps, wi = (F.vcu - x * wps) * NWAVES + F.wave, stride = wps * NWAVES;
    const __amdgpu_buffer_rsrc_t rs = __builtin_amdgcn_make_buffer_rsrc((void*)(VT + (size_t)x * (NEXP * 128)), 0, NEXP * 128, 0x00020000);
    const int coloff = 16 * j;
    LAS unsigned char* const lbase = F.lds + F.wave * 16384;
    LAS unsigned char* const wr_even = lbase + g * 128 + ((j ^ (g >> 1)) << 4);
    LAS unsigned char* const wr_odd = lbase + g * 128 + ((j ^ (g >> 1) ^ 4) << 4);
    LAS unsigned char* const rd_row = lbase + (32 * kb + n) * 128;
    const int rsw = (n >> 1) << 4;
    const int col0 = 256 * x + lane;
    int t = wi - stride; t = sl_next_tok(t, stride, lat_only);
    int t1 = sl_next_tok(t, stride, lat_only), t2 = sl_next_tok(t1, stride, lat_only);
    int idA1 = 0, idB1 = 0, idA2 = 0, idB2 = 0, idA3 = 0, idB3 = 0; u32x4 w[16], wn[16];
    u32x4 wa[2], wa1[2], wa2[2]; float sc = 0.f, sc1 = 0.f, sc2 = 0.f;
    float xo[4], gv[4], xo1[4], gv1[4], xo2[4], gv2[4];
#pragma unroll
    for (int q = 0; q < 4; ++q) { xo[q] = gv[q] = xo1[q] = gv1[q] = xo2[q] = gv2[q] = 0.f; }
    wa[0] = wa[1] = wa1[0] = wa1[1] = wa2[0] = wa2[1] = (u32x4){0u, 0u, 0u, 0u};
#define SL_WA(dst, S_, t_) do { const u32x4* wp_ = (const u32x4*)(WQ8 + (size_t)(t_) * 128 + 16 * kb); dst[0] = wp_[0]; dst[1] = wp_[4]; S_ = WSC[t_]; } while (0)
#define SL_XG(t_, X_, G_) do { const float* xp_ = XW + (size_t)(t_) * DM + col0; const float* gp_ = g2 + (size_t)row_cls(t_) * NMOD + col0; _Pragma("unroll") for (int q_ = 0; q_ < 4; ++q_) { X_[q_] = xp_[64 * q_]; G_[q_] = gp_[64 * q_]; } } while (0)
    if (t < MROWS) { int idA0, idB0; SL_IDS(t, idA0, idB0); SL_WA(wa1, sc1, t); SL_XG(t, xo1, gv1); SL_ROWS(w, idA0, idB0); }
    if (t1 < MROWS) { SL_IDS(t1, idA2, idB2); SL_WA(wa2, sc2, t1); SL_XG(t1, xo2, gv2); }
    if (t2 < MROWS) SL_IDS(t2, idA3, idB3);
#define SL_VBODY(CUR, NXT) do { \
        const int t3 = sl_next_tok(t2, stride, lat_only); \
        wa[0] = wa1[0]; wa[1] = wa1[1]; wa1[0] = wa2[0]; wa1[1] = wa2[1]; sc = sc1; sc1 = sc2; \
_Pragma("unroll") \
        for (int q = 0; q < 4; ++q) { xo[q] = xo1[q]; gv[q] = gv1[q]; xo1[q] = xo2[q]; gv1[q] = gv2[q]; } \
        idA1 = idA2; idB1 = idB2; idA2 = idA3; idB2 = idB3; \
        if (t1 < MROWS) SL_ROWS(NXT, idA1, idB1); \
        if (t2 < MROWS) { SL_WA(wa2, sc2, t2); SL_XG(t2, xo2, gv2); } \
        if (t3 < MROWS) SL_IDS(t3, idA3, idB3); \
_Pragma("unroll") \
        for (int i = 0; i < 16; ++i) *(LAS u32x4*)(((i & 1) ? wr_odd : wr_even) + i * 1024) = CUR[i]; \
        const i32x8v a = {(int)wa[0].x, (int)wa[0].y, (int)wa[0].z, (int)wa[0].w, (int)wa[1].x, (int)wa[1].y, (int)wa[1].z, (int)wa[1].w}; \
        float vs[4] = {0.f, 0.f, 0.f, 0.f}; \
_Pragma("unroll") \
        for (int cb = 0; cb < 16; ++cb) { \
            LAS unsigned char* ra_ = rd_row + ((((cb >> 1) << 4) ^ rsw) + ((cb & 1) << 3)); \
            const i32x2v lo_ = __builtin_amdgcn_ds_read_tr4_b64_v2i32((LAS i32x2v*)ra_), hi_ = __builtin_amdgcn_ds_read_tr4_b64_v2i32((LAS i32x2v*)(ra_ + 2048)); \
            const i32x8v b_ = {lo_.x, lo_.y, hi_.x, hi_.y, 0, 0, 0, 0}; \
            const f32x4 z_ = {0.f, 0.f, 0.f, 0.f}; \
            const f32x4 d_ = __builtin_amdgcn_mfma_scale_f32_16x16x128_f8f6f4(a, b_, z_, 0, 4, 0, 0, 0, 0); \
            vs[cb >> 2] = (kb == (cb & 3)) ? d_[0] : vs[cb >> 2]; \
        } \
        { const int b = t / RB, i = t - b * RB; \
_Pragma("unroll") \
          for (int q = 0; q < 4; ++q) { const float xn = xo[q] + gv[q] * (sc * vs[q]); XW[(size_t)t * DM + col0 + 64 * q] = xn; \
              if (OUT) { if (i >= CTX) OUT[((size_t)b * SEQ + (i - CTX)) * DM + col0 + 64 * q] = xn; } } } \
        t = t1; t1 = t2; t2 = t3; \
    } while (0)
    while (t < MROWS) { SL_VBODY(w, wn); if (!(t < MROWS)) break; SL_VBODY(wn, w); }
#undef SL_VBODY
#undef SL_WA
#undef SL_XG
}
#else
__device__ __forceinline__ void peer_w_phase(const Frame& F0, const float* PART, const int* IDX, float* GATE, const float* USC, const float* VSC, bool lat_only, const float* XS = nullptr) {
    const Frame F = phase_frame(F0);
    const int gt = F.vcu * NTHREADS + F.tid, GT = F.G * NTHREADS;
    for (int e0 = gt; e0 < MROWS * 128; e0 += 4 * GT) {
        float s[4]; int id[4]; float gte[4], us[4], vs[4]; bool ok[4];
#pragma unroll
        for (int u = 0; u < 4; ++u) { const int e = e0 + u * GT; ok[u] = e < MROWS * 128 && !(lat_only && row_cls(e >> 7) == 2); s[u] = 0.f; id[u] = 0; gte[u] = 0.f;
            if (ok[u]) { const float* pp = PART + (size_t)(e >> 7) * 1024 + (e & 127);
#pragma unroll
                for (int xx = 0; xx < 8; ++xx) s[u] += pp[xx * 128];
                id[u] = IDX[e]; gte[u] = GATE[e]; } }
#pragma unroll
        for (int u = 0; u < 4; ++u) { us[u] = ok[u] ? USC[id[u]] : 0.f; vs[u] = ok[u] ? VSC[id[u]] : 0.f;
#if PEER_MFMA
            if (ok[u]) us[u] *= XS[(e0 + u * GT) >> 7];
#endif
        }
#pragma unroll
        for (int u = 0; u < 4; ++u) if (ok[u]) GATE[e0 + u * GT] = gte[u] * gelu_erf(s[u] * us[u]) * vs[u];
    }
}
#ifdef SELFTEST
#define SELFTEST_LEAK * (1.0f + sqrtf(*(const volatile float*)((const unsigned char*)XW - WS_XW + WS_CTL + 32768)))
#define SELFTEST_SPIKE do { if (b == 0 && i == CTX && mycol == 0) xo_.x += *(const volatile float*)((const unsigned char*)XW - WS_XW + WS_CTL + 32772); } while (0)
#else
#define SELFTEST_LEAK
#define SELFTEST_SPIKE do {} while (0)
#endif
__device__ __forceinline__ void peer_v_phase(const Frame& F0, const int* IDX, const float* WK, const unsigned char* VT, const float* g2  , float* XW, float* OUT, bool lat_only) {
    const int idmask = 0x7fffffff;
    const Frame F = phase_frame(F0);
    const int lane = F.lane, g = lane >> 3, j = lane & 7, bp = 4 * g;
    const int wps = F.G >> 3, x = F.vcu / wps, wi = (F.vcu - x * wps) * NWAVES + F.wave, stride = wps * NWAVES;
    const __amdgpu_buffer_rsrc_t rs = __builtin_amdgcn_make_buffer_rsrc((void*)(VT + (size_t)x * (NEXP * 128)), 0, NEXP * 128, 0x00020000);
    const int coloff = 16 * j;
    const int mycol = 256 * x + 32 * j + 4 * g;
    int t = wi - stride; t = sl_next_tok(t, stride, lat_only);
    int t1 = sl_next_tok(t, stride, lat_only), t2 = sl_next_tok(t1, stride, lat_only);
    int idA1 = 0, idB1 = 0, idA2 = 0, idB2 = 0, idA3 = 0, idB3 = 0; float wA = 0.f, wB = 0.f, wA1 = 0.f, wB1 = 0.f, wA2 = 0.f, wB2 = 0.f; u32x4 w[16], wn[16];
    f32x4 x_old = {0.f, 0.f, 0.f, 0.f}, g_vec = x_old, xo1 = x_old, gv1 = x_old, xo2 = x_old, gv2 = x_old;
#define SL_WK(t_, A_, B_) do { A_ = WK[(size_t)(t_) * 128 + lane]; B_ = WK[(size_t)(t_) * 128 + 64 + lane]; } while (0)
#define SL_XG(t_, X_, G_) do { X_ = *(const f32x4*)(XW + (size_t)(t_) * DM + mycol); G_ = *(const f32x4*)(g2 + (size_t)row_cls(t_) * NMOD + mycol); } while (0)
    if (t < MROWS) { int idA0, idB0; SL_IDS(t, idA0, idB0); SL_WK(t, wA1, wB1); SL_XG(t, xo1, gv1); SL_ROWS(w, idA0, idB0); }
    if (t1 < MROWS) { SL_IDS(t1, idA2, idB2); SL_WK(t1, wA2, wB2); SL_XG(t1, xo2, gv2); }
    if (t2 < MROWS) SL_IDS(t2, idA3, idB3);
#define SL_V1(d_, b_) { const h2_t r2_ = __builtin_amdgcn_cvt_scalef32_pk_f16_fp4(wd_[d_], 1.0f, b_); acc[4 * (d_) + (b_)] = __builtin_elementwise_fma(r2_, wg2_, acc[4 * (d_) + (b_)]); }
#define SL_VBODY(CUR, NXT) do { \
        const int t3 = sl_next_tok(t2, stride, lat_only); \
        wA = wA1; wB = wB1; wA1 = wA2; wB1 = wB2; x_old = xo1; g_vec = gv1; xo1 = xo2; gv1 = gv2; \
        idA1 = idA2; idB1 = idB2; idA2 = idA3; idB2 = idB3; \
        if (t1 < MROWS) SL_ROWS(NXT, idA1, idB1); \
        if (t2 < MROWS) { SL_WK(t2, wA2, wB2); SL_XG(t2, xo2, gv2); } \
        if (t3 < MROWS) SL_IDS(t3, idA3, idB3); \
        h2_t acc[16]; \
_Pragma("unroll") \
        for (int p = 0; p < 16; ++p) acc[p] = (h2_t){(_Float16)0.f, (_Float16)0.f}; \
_Pragma("unroll") \
        for (int i = 0; i < 16; ++i) { \
            const unsigned wd_[4] = {CUR[i].x, CUR[i].y, CUR[i].z, CUR[i].w}; \
            const float wgf_ = __int_as_float(__builtin_amdgcn_ds_bpermute(bp + 32 * (i & 7), __float_as_int((i < 8) ? wA : wB))); \
            const _Float16 wgh_ = (_Float16)wgf_; const h2_t wg2_ = {wgh_, wgh_}; \
            SL_V1(0, 0) SL_V1(0, 1) SL_V1(0, 2) SL_V1(0, 3) SL_V1(1, 0) SL_V1(1, 1) SL_V1(1, 2) SL_V1(1, 3) SL_V1(2, 0) SL_V1(2, 1) SL_V1(2, 2) SL_V1(2, 3) SL_V1(3, 0) SL_V1(3, 1) SL_V1(3, 2) SL_V1(3, 3) \
        } \
        unsigned m0 = 0u, m1 = 0u; \
_Pragma("unroll") \
        for (int p = 0; p < 16; ++p) { \
            h2_t v = acc[p]; \
            v = v + __builtin_bit_cast(h2_t, __builtin_amdgcn_update_dpp(0, __builtin_bit_cast(int, v), 0x128, 0xf, 0xf, true)); \
            { auto r = __builtin_amdgcn_permlane16_swap(__builtin_bit_cast(unsigned, v), __builtin_bit_cast(unsigned, v), false, false); v = __builtin_bit_cast(h2_t, (unsigned)r[0]) + __builtin_bit_cast(h2_t, (unsigned)r[1]); } \
            { auto r = __builtin_amdgcn_permlane32_swap(__builtin_bit_cast(unsigned, v), __builtin_bit_cast(unsigned, v), false, false); v = __builtin_bit_cast(h2_t, (unsigned)r[0]) + __builtin_bit_cast(h2_t, (unsigned)r[1]); } \
            if (g == (p >> 1)) { if (p & 1) m1 = __builtin_bit_cast(unsigned, v); else m0 = __builtin_bit_cast(unsigned, v); } \
        } \
        const h2_t q0 = __builtin_bit_cast(h2_t, m0), q1 = __builtin_bit_cast(h2_t, m1); \
        const f32x4 mine = {(float)q0.x, (float)q0.y, (float)q1.x, (float)q1.y}; \
        const f32x4 xn = x_old + g_vec * mine; \
        *(f32x4*)(XW + (size_t)t * DM + mycol) = xn; \
        if (OUT) { const int b = t / RB, i = t - b * RB; if (i >= CTX) { f32x4 xo_ = xn SELFTEST_LEAK; SELFTEST_SPIKE; *(f32x4*)(OUT + ((size_t)b * SEQ + (i - CTX)) * DM + mycol) = xo_; } } \
        t = t1; t1 = t2; t2 = t3; \
    } while (0)
    while (t < MROWS) { SL_VBODY(w, wn); if (!(t < MROWS)) break; SL_VBODY(wn, w); }
#undef SL_VBODY
#undef SL_V1
#undef SL_WK
#undef SL_XG
}
#endif
#undef SL_IDS
#undef SL_ROWS
#endif
#ifndef N_LAUNCHES
#define N_LAUNCHES 1
#endif
struct Args { const float* in[26]; float* out; unsigned char* ws; int ph_lo, ph_hi; };
constexpr int NPHASES = 39;
__global__ void __launch_bounds__(NTHREADS, 2) fwd_kernel(Args args) {
    extern __shared__ __attribute__((aligned(16))) unsigned char lds_raw[];
    Frame F_;
    F_.lds = (LAS unsigned char*)lds_raw;
    F_.tid = threadIdx.x; F_.lane = F_.tid & 63; F_.wave = __builtin_amdgcn_readfirstlane(F_.tid >> 6);
    F_.G = gridDim.x; { const int bx = blockIdx.x; F_.vcu = (F_.G % 8 == 0) ? (bx % 8) * (F_.G / 8) + bx / 8 : bx; }
    F_.gw = F_.vcu * NWAVES + F_.wave; F_.NGW = F_.G * NWAVES;
    F_.ws = args.ws;
    volatile LAS unsigned* MISC = (volatile LAS unsigned*)(F_.lds + LDS_MISC);
    if (F_.tid < 32) MISC[F_.tid] = 0u;
    __syncthreads();
    const int lo = args.ph_lo, hi = args.ph_hi;
    XcdBarrier bar; bar.bar = (unsigned*)(args.ws + WS_CTL) + CW_BAR; bar.x = 0; bar.st = nullptr;
    if (N_LAUNCHES == 1 || hi - lo > 1) bar = xcd_barrier_post((unsigned*)(args.ws + WS_CTL) + CW_BAR, MISC + 8);
#if N_LAUNCHES == 1
#define IN(k) true
#define SEAM(k) xcd_barrier(bar)
#else
#define IN(k) (lo <= (k) && (k) < hi)
#define SEAM(k) do { if (IN(k) && IN((k) + 1)) xcd_barrier(bar); } while (0)
#endif
    PG8_LAS unsigned char* glds = (PG8_LAS unsigned char*)lds_raw;

    if (IN(0)) { p0_prologue(F_, args.in); } SEAM(0);

#pragma unroll 1
    for (int lp = 0; lp < 2; ++lp) {
        const int pb = 1 + lp * 19;
        unsigned char* ws = args.ws; asm volatile("" : "+s"(ws));
        Frame F = F_; { int w_ = F_.wave, v_ = F_.vcu, g_ = F_.G; asm volatile("" : "+s"(w_), "+s"(v_), "+s"(g_)); F.wave = w_; F.vcu = v_; F.G = g_; F.gw = v_ * NWAVES + w_; F.NGW = g_ * NWAVES; F.ws = ws; }
        float* mod = (float*)(ws + WS_MOD); float* XW = (float*)(ws + WS_XW);
        bf16_t* H = (bf16_t*)(ws + WS_H); bf16_t* P = (bf16_t*)(ws + WS_P); bf16_t* QRAW = (bf16_t*)(ws + WS_QRAW); bf16_t* KVRAW = (bf16_t*)(ws + WS_KVRAW);
        bf16_t* Q = (bf16_t*)(ws + WS_Q); bf16_t* KB = (bf16_t*)(ws + WS_K); bf16_t* VB = (bf16_t*)(ws + WS_V); bf16_t* CAT = (bf16_t*)(ws + WS_CAT); bf16_t* PQ = (bf16_t*)(ws + WS_PQ);
        int* IDX = (int*)(ws + WS_IDX); float* GATE = (float*)(ws + WS_GATE);
        const float* rope_c = (const float*)(ws + WS_ROPE); const float* rope_a = rope_c + 64 * 32 * 2;
        const float* SMv = (const float*)(ws + WS_SMALL);
        {
            const int l = 2 * lp, i = lp;
            const float* modl = mod + (size_t)l * 3 * NMOD;
            if (lp == 0) { if (IN(pb + 0)) { norm_phase(F, XW, SMv + SM_N1G + l * DM, modl, 0, 2048, H, false); } SEAM(pb + 0); }
            if (IN(pb + 1)) {
                pg8::Gemm g{H, (const bf16_t*)(ws + WS_WIN) + (size_t)i * 4096 * DM, MROWS, 4096, DM, DM, DM}; pg8::StaticOrder S; S.init(MROWS, 4096, F.G, (int)blockIdx.x);
                pg8::EpiBf16 E{P, 4096};
                pg8::gemm_phase<pg8::EpiBf16, pg8::StaticOrder, true, true>(glds, g, S, E, phase_tid(F.wave));
            } SEAM(pb + 1);
            if (IN(pb + 2)) {
                { pg8::Gemm g{P, (const bf16_t*)(ws + WS_WUQ) + (size_t)i * 1536 * 512, MROWS, 1536, 512, 4096, 512}; pg8::StaticOrder S; S.init(MROWS, 1536, F.G, (int)blockIdx.x);
                  pg8::EpiBf16 E{QRAW, 1536};
                  pg8::gemm_phase<pg8::EpiBf16, pg8::StaticOrder, true, true>(glds, g, S, E, phase_tid(F.wave)); }
                __syncthreads();
                { pg8::Gemm g{P + 512, (const bf16_t*)(ws + WS_WUKV) + (size_t)i * 2048 * 256, MROWS, 2048, 256, 4096, 256}; pg8::StaticOrder S; S.init(MROWS, 2048, F.G, (int)blockIdx.x);
                  pg8::EpiBf16 E{KVRAW, 2048};
                  pg8::gemm_phase<pg8::EpiBf16, pg8::StaticOrder, true, true>(glds, g, S, E, phase_tid(F.wave)); }
                __syncthreads();
                conv_phase(F, P, SMv + SM_CW + i * 3072, SMv + SM_CB + i * 1024, CAT);
            } SEAM(pb + 2);
            if (IN(pb + 3)) { prep_even_phase(F, P, QRAW, KVRAW, SMv + SM_AQG + i * 192, SMv + SM_AKG + i * 192, rope_a, Q, KB, VB); } SEAM(pb + 3);
            if (IN(pb + 4)) { attn_even_phase(F, Q, KB, VB, CAT); } SEAM(pb + 4);
            if (IN(pb + 5)) {
                pg8::Gemm g{CAT, (const bf16_t*)(ws + WS_WEO) + (size_t)i * DM * DM, MROWS, DM, DM, DM, DM}; pg8::StaticOrder S; S.init(MROWS, DM, F.G, (int)blockIdx.x);
                pg8::EpiResid E{XW, DM, modl + 4096};
                pg8::gemm_phase<pg8::EpiResid, pg8::StaticOrder, true, true>(glds, g, S, E, phase_tid(F.wave));
            } SEAM(pb + 5);
            if (IN(pb + 6)) { norm_phase(F, XW, SMv + SM_N2G + l * DM, modl, 6144, 8192, H, l == 3, (unsigned*)(ws + WS_XQ), (float*)(ws + WS_XS)); } SEAM(pb + 6);
            if (IN(pb + 7)) {
                pg8::Gemm g{H, (const bf16_t*)(ws + WS_WPQ) + (size_t)l * DM * DM, MROWS, DM, DM, DM, DM}; pg8::StaticOrder S; S.init(MROWS, DM, F.G, (int)blockIdx.x);
                pg8::EpiBf16 E{PQ, DM};
                pg8::gemm_phase<pg8::EpiBf16, pg8::StaticOrder, true, true>(glds, g, S, E, phase_tid(F.wave));
            } SEAM(pb + 7);
            if (IN(pb + 8)) { peer_topk_phase(F, PQ, (const bf16_t*)(ws + WS_SUBK) + (size_t)l * 16 * 128 * 128, IDX, GATE, l == 3); } SEAM(pb + 8);
            {
                const unsigned char* Ut = ws + WS_U + (size_t)l * NEXP * ROWB; const unsigned char* Vt = ws + WS_VT + (size_t)l * NEXP * ROWB;
                peer_u_phase(F, (const unsigned*)(ws + WS_XQ), (const float*)(ws + WS_XS), IDX, Ut, (float*)(ws + WS_PART), false); SEAM(0);
                peer_wq_phase(F, (const float*)(ws + WS_PART), IDX, GATE, (const float*)(ws + WS_USC) + l * NEXP, (const float*)(ws + WS_VSC) + l * NEXP, false, ws + WS_WQ8, (float*)(ws + WS_WSC)); SEAM(0);
                peer_v_phase(F, IDX, ws + WS_WQ8, (const float*)(ws + WS_WSC), Vt, modl + 10240, XW, nullptr, false); SEAM(0);
                norm_phase(F, XW, SMv + SM_N1G + (l + 1) * DM, mod + (size_t)(l + 1) * 3 * NMOD, 0, 2048, H, false); SEAM(0);
            }
        }
        {
            const int l = 2 * lp + 1, i = lp, qb = pb + 10;
            const float* modl = mod + (size_t)l * 3 * NMOD;
            if (IN(qb + 1)) {
                pg8::Gemm g{H, (const bf16_t*)(ws + WS_WQKV) + (size_t)i * 3072 * DM, MROWS, 3072, DM, DM, DM}; pg8::StaticOrder S; S.init(MROWS, 3072, F.G, (int)blockIdx.x);
                pg8::EpiBf16 E{P, 3072};
                pg8::gemm_phase<pg8::EpiBf16, pg8::StaticOrder, true, true>(glds, g, S, E, phase_tid(F.wave));
            } SEAM(qb + 1);
            if (IN(qb + 2)) { prep_odd_phase(F, P, SMv + SM_CQG + i * 128, SMv + SM_CKG + i * 128, rope_c, Q, KB); } SEAM(qb + 2);
            if (IN(qb + 3)) { attn_odd_phase(F, Q, KB, P, CAT, l == 3); } SEAM(qb + 3);
            if (IN(qb + 4)) {
                pg8::Gemm g{CAT, (const bf16_t*)(ws + WS_WCO) + (size_t)i * DM * DM, MROWS, DM, DM, DM, DM}; pg8::StaticOrder S; S.init(MROWS, DM, F.G, (int)blockIdx.x, l == 3);
                pg8::EpiResid E{XW, DM, modl + 4096};
                pg8::gemm_phase<pg8::EpiResid, pg8::StaticOrder, true, true>(glds, g, S, E, phase_tid(F.wave));
            } SEAM(qb + 4);
            if (IN(qb + 5)) { norm_phase(F, XW, SMv + SM_N2G + l * DM, modl, 6144, 8192, H, l == 3, (unsigned*)(ws + WS_XQ), (float*)(ws + WS_XS)); } SEAM(qb + 5);
            if (IN(qb + 6)) {
                pg8::Gemm g{H, (const bf16_t*)(ws + WS_WPQ) + (size_t)l * DM * DM, MROWS, DM, DM, DM, DM}; pg8::StaticOrder S; S.init(MROWS, DM, F.G, (int)blockIdx.x, l == 3);
                pg8::EpiBf16 E{PQ, DM};
                pg8::gemm_phase<pg8::EpiBf16, pg8::StaticOrder, true, true>(glds, g, S, E, phase_tid(F.wave));
            } SEAM(qb + 6);
            if (IN(qb + 7)) { peer_topk_phase(F, PQ, (const bf16_t*)(ws + WS_SUBK) + (size_t)l * 16 * 128 * 128, IDX, GATE, l == 3); } SEAM(qb + 7);
            {
                const unsigned char* Ut = ws + WS_U + (size_t)l * NEXP * ROWB; const unsigned char* Vt = ws + WS_VT + (size_t)l * NEXP * ROWB;
                peer_u_phase(F, (const unsigned*)(ws + WS_XQ), (const float*)(ws + WS_XS), IDX, Ut, (float*)(ws + WS_PART), l == 3); SEAM(0);
                peer_wq_phase(F, (const float*)(ws + WS_PART), IDX, GATE, (const float*)(ws + WS_USC) + l * NEXP, (const float*)(ws + WS_VSC) + l * NEXP, l == 3, ws + WS_WQ8, (float*)(ws + WS_WSC)); SEAM(0);
                peer_v_phase(F, IDX, ws + WS_WQ8, (const float*)(ws + WS_WSC), Vt, modl + 10240, XW, (l == 3) ? args.out : nullptr, l == 3);
                if (lp == 0) { SEAM(0); norm_phase(F, XW, SMv + SM_N1G + (l + 1) * DM, mod + (size_t)(l + 1) * 3 * NMOD, 0, 2048, H, false); SEAM(0); }
            }
        }
    }
#undef IN
#undef SEAM
}

extern "C" void kernel_launch(void* const* d_in, const int* in_sizes, int n_in, void* d_out, int out_size, void* d_ws, size_t ws_size, hipStream_t stream) {
    static int grid = 0;
    if (grid == 0) {
        if (n_in != 26 || out_size != NBATCH * SEQ * DM || ws_size < WS_END) { fprintf(stderr, "kernel_launch: unexpected shapes: n_in %d out %d ws %zu (need %zu)\n", n_in, out_size, ws_size, (size_t)WS_END); grid = -1; return; }
        int dev = 0, cus = 0, per_cu = 0;
        if (hipGetDevice(&dev) != hipSuccess || hipDeviceGetAttribute(&cus, hipDeviceAttributeMultiprocessorCount, dev) != hipSuccess) { fprintf(stderr, "kernel_launch: device query failed\n"); grid = -1; return; }
        if (hipFuncSetAttribute((const void*)fwd_kernel, hipFuncAttributeMaxDynamicSharedMemorySize, LDS_BYTES) != hipSuccess) { fprintf(stderr, "kernel_launch: hipFuncSetAttribute failed\n"); grid = -1; return; }
        if (hipOccupancyMaxActiveBlocksPerMultiprocessor(&per_cu, (const void*)fwd_kernel, NTHREADS, LDS_BYTES) != hipSuccess || per_cu < 1) { fprintf(stderr, "kernel_launch: occupancy query says %d blocks per CU\n", per_cu); (void)hipGetLastError(); grid = -1; return; }
        if (cus % 8 != 0) { fprintf(stderr, "kernel_launch: %d CUs: the phase decompositions assume a multiple of 8 workgroups\n", cus); grid = -1; return; }
        grid = cus;
    }
    if (grid < 0) return;
    (void)hipMemsetAsync((char*)d_ws + WS_CTL, 0, CTL_ZERO_BYTES, stream);
    Args a{};
    for (int i = 0; i < 26; ++i) a.in[i] = (const float*)d_in[i];
    a.out = (float*)d_out; a.ws = (unsigned char*)d_ws;
    for (int li = 0; li < N_LAUNCHES; ++li) {
        a.ph_lo = (N_LAUNCHES == 1) ? 0 : li; a.ph_hi = (N_LAUNCHES == 1) ? NPHASES : li + 1;
        hipLaunchKernelGGL(fwd_kernel, dim3(grid), dim3(NTHREADS), LDS_BYTES, stream, a);
        const hipError_t le = hipPeekAtLastError();
        if (le != hipSuccess) { fprintf(stderr, "kernel_launch: launch %d failed: %s\n", li, hipGetErrorName(le)); break; }
    }
}
```

```cpp
#include <hip/hip_runtime.h>
#include <cstdio>
#include <cstdint>
namespace pg8 {
#define PG8_LAS __attribute__((address_space(3)))
typedef unsigned short bf16_t;
typedef short bf16x8 __attribute__((ext_vector_type(8)));
typedef float f32x4 __attribute__((ext_vector_type(4)));
typedef unsigned u32x4 __attribute__((ext_vector_type(4)));
constexpr int BM = 256, BK = 64, HALF = 128, HTB = HALF * BK * 2  , STAGE_BYTES = 8 * HTB, NXCD = 8, WGM = 8;

__host__ __device__ __forceinline__ int lds_byte(int r, int c) { const int st = (r >> 4) * 2 + (c >> 5), rr = r & 15, cc = c & 31, ob = rr * 64 + cc * 2; return st * 1024 + (ob ^ (((ob >> 9) & 1) << 5)); }
__host__ __device__ __forceinline__ void stage_rc(int b, int& R, int& C) { const int st = b / 1024, sb = b % 1024, swz = sb ^ (((sb >> 9) & 1) << 5); R = (st >> 1) * 16 + swz / 64; C = (st & 1) * 32 + (swz % 64) / 2; }
__host__ __device__ __forceinline__ int perm32(int rho) { const int n = rho >> 4, i = rho & 15; return 8 * (i >> 2) + 4 * n + (i & 3); }

struct Unit { int pm, pn; };
struct Gemm { const bf16_t* A; const bf16_t* Bt; int M, N, K, lda, ldb; };

struct StaticOrder {
    int nM, nN, nwg, G, c; bool lat_only;
    __host__ __device__ void init(int M, int N, int G_, int c_, bool lat_only_ = false) { lat_only = lat_only_; nM = lat_only_ ? 32 : M / BM; nN = N / BM; nwg = nM * nN; G = G_; c = c_; }
    __host__ __device__ bool next(int i, Unit& u) const {
        const long L = (long)i * G + c; if (L >= nwg) return false;
        int wgid = (int)L; { const int q = nwg / NXCD, r = nwg % NXCD, xcd = wgid % NXCD, off = wgid / NXCD; wgid = (xcd < r ? xcd * (q + 1) : r * (q + 1) + (xcd - r) * q) + off; }
        const int nig = WGM * nN, gid = wgid / nig, fm = gid * WGM, gsz = (nM - fm) < WGM ? (nM - fm) : WGM;
        u.pm = fm + ((wgid % nig) % gsz); u.pn = (wgid % nig) / gsz; if (lat_only) u.pm += 1 + (u.pm >= 16 ? 1 : 0); return true;
    }
    __device__ __forceinline__ void a_ready(const Unit&) const {}
    __device__ __forceinline__ void done(const Unit&) const {}
};
__device__ __forceinline__ unsigned cvt_pk_bf16(float lo, float hi) { unsigned r; asm volatile("v_cvt_pk_bf16_f32 %0, %1, %2" : "=v"(r) : "v"(lo), "v"(hi)); return r; }
typedef float f32x2 __attribute__((ext_vector_type(2)));
struct EpiBf16 {
    static constexpr bool PERM = true, AFTER_DRAIN = false;
    bf16_t* O; int ldc;
    __device__ __forceinline__ void operator()(const f32x4 (&acc)[2][2][4][2], const Unit& u, int wr, int wc, int fr, int fq) const {
        const int row0 = u.pm * BM + wr * 64 + fr, col0 = u.pn * BM + wc * 32 + 8 * fq;
#pragma unroll
        for (int ai = 0; ai < 2; ++ai)
#pragma unroll
            for (int m = 0; m < 4; ++m) { bf16_t* rowp = O + (size_t)(row0 + ai * HALF + m * 16) * ldc + col0;
#pragma unroll
                for (int bj = 0; bj < 2; ++bj) { const f32x4 v0 = acc[ai][bj][m][0], v1 = acc[ai][bj][m][1];
                    u32x4 w; w.x = cvt_pk_bf16(v0[0], v0[1]); w.y = cvt_pk_bf16(v0[2], v0[3]); w.z = cvt_pk_bf16(v1[0], v1[1]); w.w = cvt_pk_bf16(v1[2], v1[3]);
                    *(u32x4*)(rowp + bj * HALF) = w; } }
    }
};
struct EpiResid {
    static constexpr bool PERM = false, AFTER_DRAIN = false;
    float* X; int ldc; const float* gate;
    __device__ __forceinline__ void operator()(const f32x4 (&acc)[2][2][4][2], const Unit& u, int wr, int wc, int fr, int fq) const {
        const int row0 = u.pm * BM + wr * 64 + fr, col0 = u.pn * BM + wc * 32 + 4 * fq;
        const int cls = (u.pm % 17 == 0) ? 2 : (u.pm / 17);
        const float* gp = gate + (size_t)cls * 12288 + col0;
        f32x4 gv[2][2];
#pragma unroll
        for (int bj = 0; bj < 2; ++bj)
#pragma unroll
            for (int n = 0; n < 2; ++n) gv[bj][n] = *(const f32x4*)(gp + bj * HALF + n * 16);
#pragma unroll
        for (int ai = 0; ai < 2; ++ai)
#pragma unroll
            for (int m = 0; m < 4; ++m) { float* rowp = X + (size_t)(row0 + ai * HALF + m * 16) * ldc + col0;
#pragma unroll
                for (int bj = 0; bj < 2; ++bj)
#pragma unroll
                    for (int n = 0; n < 2; ++n) { f32x4* p = (f32x4*)(rowp + bj * HALF + n * 16); *p = *p + gv[bj][n] * acc[ai][bj][m][n]; } }
    }
};
template <class Epi, class Sched, bool ALIGN_EPI = false, bool SP2 = false>
__device__ __forceinline__ void gemm_phase(PG8_LAS unsigned char* lds, const Gemm g, const Sched& S, const Epi& E, int tid_in) {
    int tid_ = tid_in; asm volatile("" : "+v"(tid_));
    const int tid = tid_, wid = __builtin_amdgcn_readfirstlane(tid >> 6), lane = tid & 63, wr = wid >> 2, wc = wid & 3, fr = lane & 15, fq = lane >> 4;
    const int K = g.K, nt = K / BK;
    unsigned voffA[2], voffB[2];
#pragma unroll
    for (int i = 0; i < 2; ++i) { int R, C; stage_rc(tid * 16 + i * 8192, R, C); const int Rb = Epi::PERM ? ((R & ~31) + perm32(R & 31)) : R;
        voffA[i] = (unsigned)(R * g.lda + C) * 2u; voffB[i] = (unsigned)(Rb * g.ldb + C) * 2u; }
    const size_t kstep = (size_t)(BK * 2);
    const size_t hstepA = (size_t)HALF * g.lda * 2, hstepB = (size_t)HALF * g.ldb * 2;
    const size_t tstepA = 2 * hstepA, tstepB = 2 * hstepB;
    const unsigned ldsw = (unsigned)wid * 1024u;
    const int aoff = lds_byte(wr * 64 + fr, fq * 8), boff = lds_byte(wc * 32 + fr, fq * 8);
#define PG8_SA(b, h) (((b) * 2 + (h)) * HTB)
#define PG8_SB(b, h) ((4 + (b) * 2 + (h)) * HTB)
#define PG8_STAGE(bufoff, gbase, voff) do { _Pragma("unroll") for (int _i = 0; _i < 2; ++_i) \
        __builtin_amdgcn_global_load_lds((const unsigned*)((const char*)(gbase) + (voff)[_i]), (PG8_LAS unsigned*)(lds + (bufoff) + ldsw + _i * 8192), 16, 0, 0); } while (0)
#define PG8_LDA(dst, b, h) do { _Pragma("unroll") for (int m = 0; m < 4; ++m) _Pragma("unroll") for (int k = 0; k < 2; ++k) dst[m][k] = *(const PG8_LAS bf16x8*)(lds + PG8_SA(b, h) + aoff + m * 2048 + k * 1024); } while (0)
#define PG8_LDB(dst, b, h) do { _Pragma("unroll") for (int n = 0; n < 2; ++n) _Pragma("unroll") for (int k = 0; k < 2; ++k) dst[n][k] = *(const PG8_LAS bf16x8*)(lds + PG8_SB(b, h) + boff + n * 2048 + k * 1024); } while (0)
#define PG8_MMA(ai, bj, At, Bt) do { __builtin_amdgcn_s_setprio(1); _Pragma("unroll") for (int m = 0; m < 4; ++m) _Pragma("unroll") for (int n = 0; n < 2; ++n) _Pragma("unroll") for (int k = 0; k < 2; ++k) \
        acc[ai][bj][m][n] = __builtin_amdgcn_mfma_f32_16x16x32_bf16(Bt[n][k], At[m][k], acc[ai][bj][m][n], 0, 0, 0); __builtin_amdgcn_s_setprio(0); } while (0)
#define PG8_WAIT_V(n) asm volatile("s_waitcnt vmcnt(" #n ")" ::: "memory")
#define PG8_WAIT_L(n) asm volatile("s_waitcnt lgkmcnt(" #n ")" ::: "memory")
#define PG8_BAR __builtin_amdgcn_s_barrier()
#define PG8_SCHED __builtin_amdgcn_sched_barrier(0)
    Unit cur, nxt; int ui = 0;
    if (!S.next(0, cur)) return;
    f32x4 acc[2][2][4][2];
#pragma unroll
    for (int a = 0; a < 2; ++a)
#pragma unroll
        for (int b = 0; b < 2; ++b)
#pragma unroll
            for (int m = 0; m < 4; ++m)
#pragma unroll
                for (int n = 0; n < 2; ++n) acc[a][b][m][n] = (f32x4){0.f, 0.f, 0.f, 0.f};
    bf16x8 At[4][2], B0[2][2], B1[2][2];
    const char* cA = (const char*)g.A + (size_t)cur.pm * tstepA; const char* cB = (const char*)g.Bt + (size_t)cur.pn * tstepB;
    S.a_ready(cur);
    if constexpr (SP2) {
        PG8_STAGE(PG8_SB(0, 0), cB, voffB); PG8_STAGE(PG8_SB(0, 1), cB + hstepB, voffB); PG8_STAGE(PG8_SA(0, 0), cA, voffA); PG8_STAGE(PG8_SA(0, 1), cA + hstepA, voffA);
        if (wr == 1) PG8_BAR;
        PG8_WAIT_V(2); PG8_BAR;
        PG8_STAGE(PG8_SB(1, 0), cB + kstep, voffB); PG8_STAGE(PG8_SA(1, 0), cA + kstep, voffA); PG8_STAGE(PG8_SB(1, 1), cB + hstepB + kstep, voffB);
        PG8_WAIT_V(6); PG8_BAR;
    } else {
        PG8_STAGE(PG8_SB(0, 0), cB, voffB); PG8_STAGE(PG8_SA(0, 0), cA, voffA); PG8_STAGE(PG8_SB(0, 1), cB + hstepB, voffB); PG8_STAGE(PG8_SA(0, 1), cA + hstepA, voffA);
        if (wr == 1) PG8_BAR;
        PG8_WAIT_V(4); PG8_BAR;
        PG8_STAGE(PG8_SB(1, 0), cB + kstep, voffB); PG8_STAGE(PG8_SA(1, 0), cA + kstep, voffA); PG8_STAGE(PG8_SB(1, 1), cB + hstepB + kstep, voffB);
        PG8_WAIT_V(6); PG8_BAR;
    }
    for (;;) {
        const bool has_next = S.next(ui + 1, nxt);
        const char* nA = has_next ? (const char*)g.A + (size_t)nxt.pm * tstepA : cA; const char* nB = has_next ? (const char*)g.Bt + (size_t)nxt.pn * tstepB : cB;
        for (int t = 0; t < nt; t += 2) {
            const bool last = (t == nt - 2);
            const char* a1 = cA + (size_t)(t + 1) * kstep;
            const char* a2 = last ? nA : cA + (size_t)(t + 2) * kstep; const char* b2 = last ? nB : cB + (size_t)(t + 2) * kstep;
            const char* a3 = a2 + kstep; const char* b3 = b2 + kstep;
            if (last && has_next) S.a_ready(nxt);
            if constexpr (SP2) {
            PG8_LDB(B0, 0, 0); PG8_LDB(B1, 0, 1); PG8_SCHED; PG8_LDA(At, 0, 0); PG8_STAGE(PG8_SA(1, 1), a1 + hstepA, voffA);
            PG8_WAIT_V(8); PG8_WAIT_L(0); PG8_BAR; PG8_MMA(0, 0, At, B0); PG8_MMA(0, 1, At, B1); PG8_BAR; PG8_SCHED;
            PG8_LDA(At, 0, 1); PG8_STAGE(PG8_SB(0, 0), b2, voffB); PG8_STAGE(PG8_SB(0, 1), b2 + hstepB, voffB); PG8_STAGE(PG8_SA(0, 0), a2, voffA);
            PG8_WAIT_V(8); PG8_WAIT_L(0); PG8_BAR; PG8_MMA(1, 0, At, B0); PG8_MMA(1, 1, At, B1); PG8_BAR; PG8_SCHED;
            PG8_LDB(B0, 1, 0); PG8_LDB(B1, 1, 1); PG8_SCHED; PG8_LDA(At, 1, 0); PG8_STAGE(PG8_SA(0, 1), a2 + hstepA, voffA);
            PG8_WAIT_V(8); PG8_WAIT_L(0); PG8_BAR; PG8_MMA(0, 0, At, B0); PG8_MMA(0, 1, At, B1); PG8_BAR; PG8_SCHED;
            PG8_LDA(At, 1, 1); PG8_STAGE(PG8_SB(1, 0), b3, voffB); PG8_STAGE(PG8_SB(1, 1), b3 + hstepB, voffB); PG8_STAGE(PG8_SA(1, 0), a3, voffA);
            PG8_WAIT_V(8); PG8_WAIT_L(0); PG8_BAR; PG8_MMA(1, 0, At, B0); PG8_MMA(1, 1, At, B1); PG8_BAR; PG8_SCHED;
            } else {
            PG8_LDB(B0, 0, 0); PG8_SCHED; PG8_LDA(At, 0, 0); PG8_STAGE(PG8_SA(1, 1), a1 + hstepA, voffA);
            PG8_WAIT_L(8); PG8_BAR; PG8_WAIT_L(0); PG8_MMA(0, 0, At, B0); PG8_BAR; PG8_SCHED;
            PG8_LDB(B1, 0, 1); PG8_STAGE(PG8_SB(0, 0), b2, voffB);
            PG8_BAR; PG8_WAIT_L(0); PG8_MMA(0, 1, At, B1); PG8_BAR;
            PG8_LDA(At, 0, 1); PG8_STAGE(PG8_SA(0, 0), a2, voffA);
            PG8_BAR; PG8_WAIT_L(0); PG8_MMA(1, 0, At, B0); PG8_BAR; PG8_SCHED;
            PG8_STAGE(PG8_SB(0, 1), b2 + hstepB, voffB);
            PG8_WAIT_V(6); PG8_BAR; PG8_MMA(1, 1, At, B1); PG8_BAR;
            PG8_LDB(B0, 1, 0); PG8_SCHED; PG8_LDA(At, 1, 0); PG8_STAGE(PG8_SA(0, 1), a2 + hstepA, voffA);
            PG8_WAIT_L(8); PG8_BAR; PG8_WAIT_L(0); PG8_MMA(0, 0, At, B0); PG8_BAR; PG8_SCHED;
            PG8_LDB(B1, 1, 1); PG8_STAGE(PG8_SB(1, 0), b3, voffB);
            PG8_BAR; PG8_WAIT_L(0); PG8_MMA(0, 1, At, B1); PG8_BAR;
            PG8_LDA(At, 1, 1); PG8_STAGE(PG8_SA(1, 0), a3, voffA);
            PG8_BAR; PG8_WAIT_L(0); PG8_MMA(1, 0, At, B0); PG8_BAR; PG8_SCHED;
            PG8_STAGE(PG8_SB(1, 1), b3 + hstepB, voffB);
            PG8_WAIT_V(6); PG8_BAR; PG8_MMA(1, 1, At, B1); PG8_BAR;
            }
        }
        if constexpr (ALIGN_EPI) { if (wr == 0) PG8_BAR; }
        if constexpr (!Epi::AFTER_DRAIN) { E(acc, cur, wr, wc, fr, fq); S.done(cur); }
        if (!has_next) break;
#pragma unroll
        for (int a = 0; a < 2; ++a)
#pragma unroll
            for (int b = 0; b < 2; ++b)
#pragma unroll
                for (int m = 0; m < 4; ++m)
#pragma unroll
                    for (int n = 0; n < 2; ++n) acc[a][b][m][n] = (f32x4){0.f, 0.f, 0.f, 0.f};
        cur = nxt; cA = nA; cB = nB; ++ui;
        if constexpr (ALIGN_EPI) { if (wr == 1) PG8_BAR; }
    }
    PG8_WAIT_V(0);
    if constexpr (!ALIGN_EPI) { if (wr == 0) PG8_BAR; }
    PG8_BAR;
    if constexpr (Epi::AFTER_DRAIN) { E.fused(acc, cur, wr, wc, fr, fq, lds, wid, lane); S.done(cur); }
#undef PG8_SA
#undef PG8_SB
#undef PG8_STAGE
#undef PG8_LDA
#undef PG8_LDB
#undef PG8_MMA
#undef PG8_WAIT_V
#undef PG8_WAIT_L
#undef PG8_BAR
#undef PG8_SCHED
}
}
namespace att {
typedef unsigned short bf16_t;
using bf16x8 = __attribute__((ext_vector_type(8))) short;
using s16x4  = __attribute__((ext_vector_type(4))) short;
using f32x16 = __attribute__((ext_vector_type(16))) float;
using u32x4  = __attribute__((ext_vector_type(4))) unsigned;
constexpr int DV = 128, NW = 8, QBLK = 32, KVBLK = 64;
constexpr float THR = 8.f;
constexpr int SHM_V = KVBLK * DV * 2;
template <int DQK> struct Cfg {
    static constexpr int SHM_K = KVBLK * DQK * 2, KROWB = DQK * 2, NCK = DQK / 64, C8 = DQK / 8, ND0 = DQK / 16;
    static constexpr float SCALE = (DQK == 128) ? 0.088388347648318440f : 0.072168783648703220f;
    static constexpr int LDS_BYTES = 2 * SHM_V + 2 * SHM_K + NW * 64 * 4;
};
#define ATT_SBAR() __builtin_amdgcn_sched_barrier(0)
__device__ __forceinline__ int crow(int r, int hi) { return (r & 3) + 8 * (r >> 2) + 4 * hi; }
__device__ __forceinline__ unsigned cvtpk(float lo, float hi) { unsigned r; asm volatile("v_cvt_pk_bf16_f32 %0, %1, %2" : "=v"(r) : "v"(lo), "v"(hi)); return r; }
template <int DQK> __device__ __forceinline__ int kswz(int row, int colB) {
    const int key = (DQK == 128) ? (row & 7) : ((row >> 1) & 7);
    return row * (DQK * 2) + (colB ^ (key << 4));
}
template <int DQK> __device__ __forceinline__ void partialSM(f32x16& p0, f32x16& p1, float& m_reg, float& mn, float& alpha) {
    constexpr float SCALE = Cfg<DQK>::SCALE, C = SCALE * 1.4426950408889634f;
    float pmax = p0[0];
#pragma unroll
    for (int r = 1; r < 16; ++r) pmax = fmaxf(pmax, p0[r]);
#pragma unroll
    for (int r = 0; r < 16; ++r) pmax = fmaxf(pmax, p1[r]);
    { auto rr = __builtin_amdgcn_permlane32_swap(__float_as_uint(pmax), __float_as_uint(pmax), false, false);
      pmax = fmaxf(__uint_as_float(rr[0]), __uint_as_float(rr[1])); }
    if (__builtin_expect(__all(pmax - m_reg <= THR / SCALE), 1)) { mn = m_reg; alpha = 1.f; }
    else { mn = fmaxf(m_reg, pmax); alpha = __builtin_amdgcn_exp2f((m_reg - mn) * C); m_reg = mn; }
    const float mnC = -mn * C;
#pragma unroll
    for (int r = 0; r < 16; ++r) p0[r] = fmaf(p0[r], C, mnC);
#pragma unroll
    for (int r = 0; r < 16; ++r) p1[r] = fmaf(p1[r], C, mnC);
#pragma unroll
    for (int r = 0; r < 16; ++r) p0[r] = __builtin_amdgcn_exp2f(p0[r]);
}
__device__ __forceinline__ void finishSM(f32x16& p0, f32x16& p1, float alpha, float& l_reg, bf16x8& pa0, bf16x8& pa1, bf16x8& pa2, bf16x8& pa3) {
#pragma unroll
    for (int r = 0; r < 16; ++r) p1[r] = __builtin_amdgcn_exp2f(p1[r]);
    float ps = 0;
#pragma unroll
    for (int r = 0; r < 16; ++r) ps += p0[r];
#pragma unroll
    for (int r = 0; r < 16; ++r) ps += p1[r];
    { auto rr = __builtin_amdgcn_permlane32_swap(__float_as_uint(ps), __float_as_uint(ps), false, false);
      ps = __uint_as_float(rr[0]) + __uint_as_float(rr[1]); }
    l_reg = l_reg * alpha + ps;
#define ATT_PK4(P, BASE, OUT) do { unsigned a0 = cvtpk(P[BASE + 0], P[BASE + 1]), a1 = cvtpk(P[BASE + 2], P[BASE + 3]);   \
    unsigned b0 = cvtpk(P[BASE + 4], P[BASE + 5]), b1 = cvtpk(P[BASE + 6], P[BASE + 7]);                              \
    auto r0 = __builtin_amdgcn_permlane32_swap(a0, b0, false, false); auto r1 = __builtin_amdgcn_permlane32_swap(a1, b1, false, false); \
    u32x4 w = {r0[0], r1[0], r0[1], r1[1]}; OUT = *reinterpret_cast<bf16x8*>(&w); } while (0)
    ATT_PK4(p0, 0, pa0); ATT_PK4(p0, 8, pa1); ATT_PK4(p1, 0, pa2); ATT_PK4(p1, 8, pa3);
#undef ATT_PK4
}
template <int DQK> __device__ __forceinline__ void qkt(f32x16& p0, f32x16& p1, const char* Ks, const bf16x8* qr, int r32, int hi) {
    p0 = f32x16{}; p1 = f32x16{};
#pragma unroll
    for (int d0 = 0; d0 < Cfg<DQK>::ND0; ++d0) { const int cb = (d0 * 16 + hi * 8) * 2;
        bf16x8 b0 = *reinterpret_cast<const bf16x8*>(Ks + kswz<DQK>(r32, cb));
        bf16x8 b1 = *reinterpret_cast<const bf16x8*>(Ks + kswz<DQK>(32 + r32, cb));
        p0 = __builtin_amdgcn_mfma_f32_32x32x16_bf16(b0, qr[d0], p0, 0, 0, 0);
        p1 = __builtin_amdgcn_mfma_f32_32x32x16_bf16(b1, qr[d0], p1, 0, 0, 0); }
}
__device__ __forceinline__ int v_st(int k, int c) { const int kk = (k & ~0xC) | ((k & 4) << 1) | ((k & 8) >> 1); return ((kk >> 3) * 4 + (c >> 5)) * 512 + ((kk & 7) * 32 + (c & 31)) * 2; }
__device__ __forceinline__ int v_rd_base(int lane) { return ((lane & 3) << 3) | (((lane >> 2) & 3) << 6) | (((lane >> 4) & 1) << 5) | (((lane >> 5) & 1) << 8); }
constexpr int v_rd_off(int d0, int ks, int half) { return d0 * 512 + ks * 4096 + half * 2048; }
template <int OFF> __device__ __forceinline__ s16x4 tr_read(int vb) {
    s16x4 r; asm volatile("ds_read_b64_tr_b16 %0, %1 offset:%2" : "=&v"(r) : "v"(vb), "i"(OFF) : "memory"); return r;
}
template <int D0> __device__ __forceinline__ void pv_one(f32x16& od, int vb, bf16x8 pa0, bf16x8 pa1, bf16x8 pa2, bf16x8 pa3) {
    const s16x4 l0 = tr_read<v_rd_off(D0, 0, 0)>(vb), h0 = tr_read<v_rd_off(D0, 0, 1)>(vb), l1 = tr_read<v_rd_off(D0, 1, 0)>(vb), h1 = tr_read<v_rd_off(D0, 1, 1)>(vb);
    const s16x4 l2 = tr_read<v_rd_off(D0, 2, 0)>(vb), h2 = tr_read<v_rd_off(D0, 2, 1)>(vb), l3 = tr_read<v_rd_off(D0, 3, 0)>(vb), h3 = tr_read<v_rd_off(D0, 3, 1)>(vb);
    asm volatile("s_waitcnt lgkmcnt(0)" ::: "memory"); ATT_SBAR();
#define ATT_PK(L, H) (bf16x8){L[0], L[1], L[2], L[3], H[0], H[1], H[2], H[3]}
    od = __builtin_amdgcn_mfma_f32_32x32x16_bf16(pa0, ATT_PK(l0, h0), od, 0, 0, 0);
    od = __builtin_amdgcn_mfma_f32_32x32x16_bf16(pa1, ATT_PK(l1, h1), od, 0, 0, 0);
    od = __builtin_amdgcn_mfma_f32_32x32x16_bf16(pa2, ATT_PK(l2, h2), od, 0, 0, 0);
    od = __builtin_amdgcn_mfma_f32_32x32x16_bf16(pa3, ATT_PK(l3, h3), od, 0, 0, 0);
#undef ATT_PK
}
__device__ __forceinline__ void pv_d0(f32x16* o, int vb, bf16x8 pa0, bf16x8 pa1, bf16x8 pa2, bf16x8 pa3) {
    pv_one<0>(o[0], vb, pa0, pa1, pa2, pa3); pv_one<1>(o[1], vb, pa0, pa1, pa2, pa3); pv_one<2>(o[2], vb, pa0, pa1, pa2, pa3); pv_one<3>(o[3], vb, pa0, pa1, pa2, pa3);
}
template <int DQK, int LDQ, int LDK, int LDV, int LDO, int SDEPTH>
__device__ __forceinline__ void attn_body(const bf16_t* __restrict__ Qb, const bf16_t* __restrict__ Kh, const bf16_t* __restrict__ Vh, bf16_t* __restrict__ Ob, int seq, char* lds, int tid_in) {
    using C_ = Cfg<DQK>;
    constexpr int SHM_K = C_::SHM_K, NCK = C_::NCK, C8 = C_::C8, ND0 = C_::ND0;
    int tid_ = tid_in; asm volatile("" : "+v"(tid_));
    const int tid = tid_, wid = tid >> 6, lane = tid & 63, r32 = lane & 31, hi = lane >> 5;
    char* V_lds = lds; char* K_lds = lds + 2 * SHM_V;
    float* ws = (float*)(lds + 2 * SHM_V + 2 * SHM_K) + wid * 64; float* li_l = ws; float* al_l = ws + 32;
    float m_reg = -1e30f, l_reg = 0; f32x16 o[4] = {}; bf16x8 qr[ND0];
    const bf16_t* Qw = Qb + (long)(wid * QBLK + r32) * LDQ + hi * 8;
#pragma unroll
    for (int d0 = 0; d0 < ND0; ++d0) qr[d0] = *reinterpret_cast<const bf16x8*>(Qw + d0 * 16);
    const int sr = tid >> 4, sc = (tid & 15) * 8, vst0 = v_st(sr, sc), vst1 = v_st(32 + sr, sc);
    int krow[NCK], kcol[NCK];
#pragma unroll
    for (int i = 0; i < NCK; ++i) { const int ci = tid + 512 * i; krow[i] = ci / C8; kcol[i] = (ci % C8) * 8; }
    const int vb0 = (int)(uintptr_t)V_lds + v_rd_base(lane);
    struct { bf16x8 vs0, vs1, ks[NCK]; } sr_[SDEPTH];
#define ATT_SLOAD(i, k0) do { sr_[i].vs0 = *reinterpret_cast<const bf16x8*>(&Vh[(long)((k0) + sr) * LDV + sc]); sr_[i].vs1 = *reinterpret_cast<const bf16x8*>(&Vh[(long)((k0) + 32 + sr) * LDV + sc]); \
    _Pragma("unroll") for (int c_ = 0; c_ < NCK; ++c_) sr_[i].ks[c_] = *reinterpret_cast<const bf16x8*>(&Kh[(long)((k0) + krow[c_]) * LDK + kcol[c_]]); } while (0)
#define ATT_SWRITE(b, i) do { *(bf16x8*)(V_lds + (b) * SHM_V + vst0) = sr_[i].vs0; *(bf16x8*)(V_lds + (b) * SHM_V + vst1) = sr_[i].vs1; \
    _Pragma("unroll") for (int c_ = 0; c_ < NCK; ++c_) *(bf16x8*)(K_lds + (b) * SHM_K + kswz<DQK>(krow[c_], kcol[c_] * 2)) = sr_[i].ks[c_]; } while (0)
#define ATT_SWAIT() do { if constexpr (SDEPTH == 2) { if constexpr (NCK == 2) asm volatile("s_waitcnt vmcnt(4)" ::: "memory"); else asm volatile("s_waitcnt vmcnt(5)" ::: "memory"); } else asm volatile("s_waitcnt vmcnt(0)" ::: "memory"); } while (0)
#define ATT_RESC(a) do { if (__any((a) < 1.f)) { if (hi == 0) al_l[r32] = (a); asm volatile("s_waitcnt lgkmcnt(0)" ::: "memory"); \
    _Pragma("unroll") for (int d = 0; d < 4; ++d) _Pragma("unroll") for (int r = 0; r < 16; ++r) o[d][r] *= al_l[crow(r, hi)]; } } while (0)
    f32x16 pA0, pA1, pB0, pB1; float mnA, mnB, alA, alB; bf16x8 pa0, pa1, pa2, pa3; const int NT = seq / KVBLK;
    constexpr int SE = 0, SO = SDEPTH - 1;
    ATT_SLOAD(SE, 0); asm volatile("s_waitcnt vmcnt(0)" ::: "memory"); ATT_SWRITE(0, SE); __syncthreads();
    qkt<DQK>(pA0, pA1, K_lds, qr, r32, hi); partialSM<DQK>(pA0, pA1, m_reg, mnA, alA);
    ATT_SLOAD(SO, KVBLK); if constexpr (SDEPTH == 2) { if (2 < NT) ATT_SLOAD(SE, 2 * KVBLK); }
    ATT_SWAIT(); ATT_SWRITE(1, SO); __syncthreads();
    for (int j = 1; j + 1 < NT; j += 2) {
        ATT_SBAR(); qkt<DQK>(pB0, pB1, K_lds + SHM_K, qr, r32, hi);
        finishSM(pA0, pA1, alA, l_reg, pa0, pa1, pa2, pa3); ATT_SBAR();
        ATT_SLOAD(SO, (j + SDEPTH) * KVBLK); ATT_SBAR();
        pv_d0(o, vb0, pa0, pa1, pa2, pa3); partialSM<DQK>(pB0, pB1, m_reg, mnB, alB);
        __syncthreads(); ATT_SWAIT(); ATT_SWRITE(0, SE);
        ATT_RESC(alB); __syncthreads();
        ATT_SBAR(); qkt<DQK>(pA0, pA1, K_lds, qr, r32, hi);
        finishSM(pB0, pB1, alB, l_reg, pa0, pa1, pa2, pa3); ATT_SBAR();
        if (SDEPTH == 1 || j + 3 < NT) ATT_SLOAD(SE, (j + 1 + SDEPTH) * KVBLK); ATT_SBAR();
        pv_d0(o, vb0 + (int)SHM_V, pa0, pa1, pa2, pa3); partialSM<DQK>(pA0, pA1, m_reg, mnA, alA);
        __syncthreads(); ATT_SWAIT(); ATT_SWRITE(1, SO);
        ATT_RESC(alA); __syncthreads();
    }
    ATT_SBAR(); qkt<DQK>(pB0, pB1, K_lds + SHM_K, qr, r32, hi);
    finishSM(pA0, pA1, alA, l_reg, pa0, pa1, pa2, pa3); ATT_SBAR();
    pv_d0(o, vb0, pa0, pa1, pa2, pa3); partialSM<DQK>(pB0, pB1, m_reg, mnB, alB);
    __syncthreads(); ATT_RESC(alB);
    finishSM(pB0, pB1, alB, l_reg, pa0, pa1, pa2, pa3); ATT_SBAR();
    pv_d0(o, vb0 + (int)SHM_V, pa0, pa1, pa2, pa3);
    if (hi == 0) li_l[r32] = l_reg;
    asm volatile("s_waitcnt lgkmcnt(0)" ::: "memory");
    __syncthreads();
    float rli[16];
#pragma unroll
    for (int r = 0; r < 16; ++r) rli[r] = __builtin_amdgcn_rcpf(li_l[crow(r, hi)]);
    unsigned short* stg = (unsigned short*)(lds + wid * 8192);
#pragma unroll
    for (int r = 0; r < 16; ++r) { const int orow = crow(r, hi);
#pragma unroll
        for (int d0 = 0; d0 < 4; ++d0) { const unsigned w = cvtpk(o[d0][r] * rli[r], 0.f); stg[orow * 128 + d0 * 32 + r32] = (unsigned short)(w & 0xffffu); } }
    asm volatile("s_waitcnt lgkmcnt(0)" ::: "memory");
    bf16_t* Ow = Ob + (long)(wid * QBLK) * LDO;
#pragma unroll
    for (int i = 0; i < 8; ++i) { const int id = lane + 64 * i, row = id >> 4, c16 = id & 15;
        const u32x4 v = *(const u32x4*)((const char*)stg + row * 256 + c16 * 16);
        *(u32x4*)(Ow + (long)row * LDO + c16 * 8) = v; }
    asm volatile("s_waitcnt lgkmcnt(0)" ::: "memory");
    __syncthreads();
#undef ATT_SLOAD
#undef ATT_SWRITE
#undef ATT_SWAIT
#undef ATT_RESC
}

template <int DQK, int LDQ, int LDK, int LDV, int LDO>
__device__ __forceinline__ void attn_body1(const bf16_t* __restrict__ Qb, const bf16_t* __restrict__ Kh, const bf16_t* __restrict__ Vh, bf16_t* __restrict__ Ob, int seq, char* lds, int tid_in) {
    using C_ = Cfg<DQK>;
    constexpr int SHM_K = C_::SHM_K, NCK = C_::NCK, C8 = C_::C8, ND0 = C_::ND0;
    int tid_ = tid_in; asm volatile("" : "+v"(tid_));
    const int tid = tid_, wid = tid >> 6, lane = tid & 63, r32 = lane & 31, hi = lane >> 5;
    char* V_lds = lds; char* K_lds = lds + 2 * SHM_V;
    float* ws = (float*)(lds + 2 * SHM_V + 2 * SHM_K) + wid * 64; float* li_l = ws; float* al_l = ws + 32;
    float m_reg = -1e30f, l_reg = 0; f32x16 o[4] = {}; bf16x8 qr[ND0];
    const bf16_t* Qw = Qb + (long)(wid * QBLK + r32) * LDQ + hi * 8;
#pragma unroll
    for (int d0 = 0; d0 < ND0; ++d0) qr[d0] = *reinterpret_cast<const bf16x8*>(Qw + d0 * 16);
    const int sr = tid >> 4, sc = (tid & 15) * 8, vst0 = v_st(sr, sc), vst1 = v_st(32 + sr, sc);
    int krow[NCK], kcol[NCK];
#pragma unroll
    for (int i = 0; i < NCK; ++i) { const int ci = tid + 512 * i; krow[i] = ci / C8; kcol[i] = (ci % C8) * 8; }
    const int vb0 = (int)(uintptr_t)V_lds + v_rd_base(lane);
    bf16x8 vs0, vs1, ks[NCK];
#define ATT1_SLOAD(k0) do { vs0 = *reinterpret_cast<const bf16x8*>(&Vh[(long)((k0) + sr) * LDV + sc]); vs1 = *reinterpret_cast<const bf16x8*>(&Vh[(long)((k0) + 32 + sr) * LDV + sc]); \
    _Pragma("unroll") for (int c_ = 0; c_ < NCK; ++c_) ks[c_] = *reinterpret_cast<const bf16x8*>(&Kh[(long)((k0) + krow[c_]) * LDK + kcol[c_]]); } while (0)
#define ATT1_SWRITE(b) do { *(bf16x8*)(V_lds + (b) * SHM_V + vst0) = vs0; *(bf16x8*)(V_lds + (b) * SHM_V + vst1) = vs1; \
    _Pragma("unroll") for (int c_ = 0; c_ < NCK; ++c_) *(bf16x8*)(K_lds + (b) * SHM_K + kswz<DQK>(krow[c_], kcol[c_] * 2)) = ks[c_]; } while (0)
    const int NT = seq / KVBLK;
    ATT1_SLOAD(0); asm volatile("s_waitcnt vmcnt(0)" ::: "memory"); ATT1_SWRITE(0); __syncthreads();
    for (int j = 0; j < NT; ++j) {
        const int b = j & 1;
        if (j + 1 < NT) ATT1_SLOAD((j + 1) * KVBLK);
        ATT_SBAR();
        f32x16 p0, p1; float mn, alpha; bf16x8 pa0, pa1, pa2, pa3;
        qkt<DQK>(p0, p1, K_lds + b * SHM_K, qr, r32, hi);
        partialSM<DQK>(p0, p1, m_reg, mn, alpha);
        if (__any(alpha < 1.f)) { if (hi == 0) al_l[r32] = alpha; asm volatile("s_waitcnt lgkmcnt(0)" ::: "memory");
#pragma unroll
            for (int d = 0; d < 4; ++d)
#pragma unroll
                for (int r = 0; r < 16; ++r) o[d][r] *= al_l[crow(r, hi)]; }
        finishSM(p0, p1, alpha, l_reg, pa0, pa1, pa2, pa3); ATT_SBAR();
        pv_d0(o, vb0 + b * (int)SHM_V, pa0, pa1, pa2, pa3);
        if (j + 1 < NT) { ATT1_SWRITE(b ^ 1); }
        __syncthreads();
    }
    if (hi == 0) li_l[r32] = l_reg;
    asm volatile("s_waitcnt lgkmcnt(0)" ::: "memory");
    __syncthreads();
    float rli[16];
#pragma unroll
    for (int r = 0; r < 16; ++r) rli[r] = __builtin_amdgcn_rcpf(li_l[crow(r, hi)]);
    unsigned short* stg = (unsigned short*)(lds + wid * 8192);
#pragma unroll
    for (int r = 0; r < 16; ++r) { const int orow = crow(r, hi);
#pragma unroll
        for (int d0 = 0; d0 < 4; ++d0) { const unsigned w = cvtpk(o[d0][r] * rli[r], 0.f); stg[orow * 128 + d0 * 32 + r32] = (unsigned short)(w & 0xffffu); } }
    asm volatile("s_waitcnt lgkmcnt(0)" ::: "memory");
    bf16_t* Ow = Ob + (long)(wid * QBLK) * LDO;
#pragma unroll
    for (int i = 0; i < 8; ++i) { const int id = lane + 64 * i, row = id >> 4, c16 = id & 15;
        const u32x4 v = *(const u32x4*)((const char*)stg + row * 256 + c16 * 16);
        *(u32x4*)(Ow + (long)row * LDO + c16 * 8) = v; }
    asm volatile("s_waitcnt lgkmcnt(0)" ::: "memory");
    __syncthreads();
#undef ATT1_SLOAD
#undef ATT1_SWRITE
}
}
constexpr int DM = 2048, NBATCH = 2, SEQ = 4096, CTX = 256, RB = SEQ + CTX  , MROWS = NBATCH * RB  ;
constexpr int NMOD = 6 * DM, NEXP = 16384;
constexpr float EPS = 1e-6f;
constexpr int NWAVES = 8, NTHREADS = 512;
constexpr size_t MiB = 1u << 20;
constexpr size_t WS_CTL = 0, CTL_ZERO_BYTES = 64 * 1024;
constexpr size_t WS_MOD = 1 * MiB;
constexpr size_t WS_ROPE = 2 * MiB;
constexpr size_t WS_SMALL = 3 * MiB;
constexpr int SM_N1G = 0, SM_N2G = 8192, SM_AQG = 16384, SM_AKG = 16384 + 384, SM_CW = 16384 + 768, SM_CB = SM_CW + 6144, SM_CQG = SM_CB + 2048, SM_CKG = SM_CQG + 256, SM_END = SM_CKG + 256;
constexpr size_t WS_PTRS = 3 * MiB + 512 * 1024;
constexpr size_t WS_XW = 4 * MiB;
constexpr size_t WS_H = 72 * MiB;
constexpr size_t WS_P = 106 * MiB;
constexpr size_t WS_QRAW = 174 * MiB;
constexpr size_t WS_KVRAW = 200 * MiB;
constexpr size_t WS_Q = 234 * MiB;
constexpr size_t WS_K = 268 * MiB;
constexpr size_t WS_V = 294 * MiB;
constexpr size_t WS_CAT = 311 * MiB;
constexpr size_t WS_PQ = 345 * MiB;
constexpr size_t WS_IDX = 379 * MiB;
constexpr size_t WS_GATE = 384 * MiB;
constexpr size_t WS_WIN = 389 * MiB;
constexpr size_t WS_WUQ = 421 * MiB;
constexpr size_t WS_WUKV = 424 * MiB;
constexpr size_t WS_WEO = 426 * MiB;
constexpr size_t WS_WQKV = 442 * MiB;
constexpr size_t WS_WCO = 466 * MiB;
constexpr size_t WS_WPQ = 482 * MiB;
constexpr size_t WS_SUBK = 514 * MiB;
#ifndef TAB_FP4
#define TAB_FP4 1
#endif
#if TAB_FP4
constexpr int ROWB = 1024;
#else
constexpr int ROWB = 1536;
#endif
constexpr size_t WS_U = 516 * MiB;
constexpr size_t WS_VT = 644 * MiB;
constexpr size_t WS_USC = 772 * MiB;
constexpr size_t WS_VSC = 773 * MiB;
constexpr size_t WS_XQ = 810 * MiB;
constexpr size_t WS_XS = 828 * MiB;
constexpr size_t WS_WQ8 = 834 * MiB;
constexpr size_t WS_WSC = 836 * MiB;
constexpr size_t WS_PART = 774 * MiB;
constexpr size_t WS_END = 837 * MiB;
#ifndef EXP_SLICED
#define EXP_SLICED 1
#endif
#ifndef PEER_MFMA
#define PEER_MFMA 0
#endif
#ifndef PEER_VMFMA
#define PEER_VMFMA 1
#endif
constexpr int CW_BAR = 4096;
constexpr int LDS_MISC = 131072 + 8192;
constexpr int LDS_BYTES = 147456;

#define LAS __attribute__((address_space(3)))
typedef unsigned short bf16_t;
typedef float f32x4 __attribute__((ext_vector_type(4)));
typedef unsigned u32x4 __attribute__((ext_vector_type(4)));
typedef unsigned u32x2 __attribute__((ext_vector_type(2)));
typedef short bf16x8 __attribute__((ext_vector_type(8)));
typedef float f32x16 __attribute__((ext_vector_type(16)));
typedef __bf16 bf16x2_t __attribute__((ext_vector_type(2)));
typedef float f32x2 __attribute__((ext_vector_type(2)));
typedef _Float16 h2_t __attribute__((ext_vector_type(2)));
typedef float f32x32 __attribute__((ext_vector_type(32)));
typedef unsigned u32x6 __attribute__((ext_vector_type(6)));

__device__ __forceinline__ unsigned f2bf(float f) { unsigned u = __builtin_bit_cast(unsigned, f); return (u + 0x7fffu + ((u >> 16) & 1u)) >> 16; }
__device__ __forceinline__ unsigned pk2(float lo, float hi) { return f2bf(lo) | (f2bf(hi) << 16); }
__device__ __forceinline__ float bf_lo(unsigned w) { return __builtin_bit_cast(float, w << 16); }
__device__ __forceinline__ float bf_hi(unsigned w) { return __builtin_bit_cast(float, w & 0xffff0000u); }
__device__ __forceinline__ float bf2f(bf16_t h) { return __builtin_bit_cast(float, (unsigned)h << 16); }
__device__ __forceinline__ float wave_sum(float v) {
#pragma unroll
    for (int o = 1; o < 64; o <<= 1) v += __shfl_xor(v, o);
    return v;
}
#define DPP_ADD(v, ctrl) ((v) + __builtin_bit_cast(float, __builtin_amdgcn_update_dpp(0, __builtin_bit_cast(int, (v)), (ctrl), 0xf, 0xf, true)))
__device__ __forceinline__ float wave_sum_dpp(float v) {
    v = DPP_ADD(v, 0xB1);
    v = DPP_ADD(v, 0x4E);
    v = DPP_ADD(v, 0x141);
    v = DPP_ADD(v, 0x140);
    const int vi = __builtin_bit_cast(int, v);
    const float s0 = __builtin_bit_cast(float, __builtin_amdgcn_readlane(vi, 0)), s1 = __builtin_bit_cast(float, __builtin_amdgcn_readlane(vi, 16));
    const float s2 = __builtin_bit_cast(float, __builtin_amdgcn_readlane(vi, 32)), s3 = __builtin_bit_cast(float, __builtin_amdgcn_readlane(vi, 48));
    return (s0 + s1) + (s2 + s3);
}
__device__ __forceinline__ float dot2_bf16(unsigned w, unsigned x, float acc) { return __builtin_amdgcn_fdot2_f32_bf16(__builtin_bit_cast(bf16x2_t, w), __builtin_bit_cast(bf16x2_t, x), acc, false); }
__device__ __forceinline__ float gelu_erf(float v) {
    const float av = fabsf(v), t = __builtin_amdgcn_rcpf(av * 0.2316418882f + 1.0f);
    float q = t * 0.5307027145f + (-0.7265760135f); q = q * t + 0.7107068705f; q = q * t + (-0.142248368f); q = q * t + 0.127414796f; q = q * t;
    const float e = __builtin_amdgcn_exp2f((v * v) * (-0.72134752044f));
    const float m = v * (q * e);
    return v < 0.f ? m : v - m;
}
#define XB_TMO      128
#define XB_XCNT(j)  (256  + 64 * (j))
#define XB_XSUB(j)  (1280 + 64 * (j))
#define XB_XGEN(j)  (2304 + 64 * (j))
#define XB_TOP      3328
#define XB_TOPGEN   3392
#define XCD_BAR_WORDS 3456
#define XB_SPIN_CAP (1u << 18)

__device__ __forceinline__ unsigned xb_ld(unsigned* p)              { return __hip_atomic_load(p, __ATOMIC_RELAXED, __HIP_MEMORY_SCOPE_AGENT); }
__device__ __forceinline__ unsigned xb_add(unsigned* p, unsigned v) { return __hip_atomic_fetch_add(p, v, __ATOMIC_RELAXED, __HIP_MEMORY_SCOPE_AGENT); }
__device__ __forceinline__ unsigned xb_xcc_id() { return (unsigned)__builtin_amdgcn_s_getreg((3 << 11) | 20) & 0xFu; }
#define XB_SPIN(cond, bar) do { unsigned _sp = 0; while (cond) { __builtin_amdgcn_s_sleep(1); \
    if ((++_sp & 255u) == 0u) { if (xb_ld(&(bar)[XB_TMO])) break; if (_sp > XB_SPIN_CAP) { atomicAdd(&(bar)[XB_TMO], 1u); break; } } } } while (0)

struct XcdBarrier {
    unsigned* bar; unsigned x;
    volatile LAS unsigned* st;
};

__device__ __forceinline__ XcdBarrier xcd_barrier_post(unsigned* bar, volatile LAS unsigned* st) {
    XcdBarrier b; b.bar = bar; b.x = xb_xcc_id(); b.st = st;
    if (threadIdx.x == 0) (void)xb_add(&bar[XB_XCNT(b.x)], 1u);
    return b;
}
__device__ __forceinline__ void xcd_barrier_complete(unsigned* bar, unsigned x, unsigned& nloc, unsigned& nx) {
    const unsigned G = gridDim.x * gridDim.y * gridDim.z;
    unsigned sum, cnt, mine, sp = 0u;
    for (;;) {
        sum = 0u; cnt = 0u; mine = 0u;
#pragma unroll
        for (unsigned j = 0; j < 16; ++j) { const unsigned c = xb_ld(&bar[XB_XCNT(j)]); sum += c; cnt += (c > 0u) ? 1u : 0u; mine = (j == x) ? c : mine; }
        if (sum == G) break;
        __builtin_amdgcn_s_sleep(1);
        if ((++sp & 255u) == 0u) { if (xb_ld(&bar[XB_TMO])) break; if (sp > XB_SPIN_CAP) { atomicAdd(&bar[XB_TMO], 1u); break; } }
    }
    nloc = mine > 0u ? mine : 1u; nx = cnt > 0u ? cnt : 1u;
}

__device__ __forceinline__ void xcd_barrier(const XcdBarrier& b) {
    asm volatile("s_waitcnt vmcnt(0)" ::: "memory");
    __syncthreads();
    if (threadIdx.x == 0) {
        unsigned* bar = b.bar; unsigned bx = b.x;
        asm volatile("" : "+s"(bar), "+s"(bx));
        __builtin_amdgcn_s_waitcnt(0);
        unsigned nloc = b.st[0], nx = b.st[1];
        if (nloc == 0u) { xcd_barrier_complete(bar, bx, nloc, nx); b.st[0] = nloc; b.st[1] = nx; }
        const unsigned old = xb_add(&bar[XB_XSUB(bx)], 1u);
        const unsigned gen = old / nloc;
        if (old + 1u == (gen + 1u) * nloc) {
            __builtin_amdgcn_fence(__ATOMIC_RELEASE, "agent");
            asm volatile("s_waitcnt vmcnt(0)" ::: "memory");
            const unsigned og = xb_add(&bar[XB_TOP], 1u);
            const unsigned tg = og / nx;
            if (og + 1u == (tg + 1u) * nx) xb_add(&bar[XB_TOPGEN], 1u);
            else XB_SPIN(xb_ld(&bar[XB_TOPGEN]) == tg, bar);
            __builtin_amdgcn_fence(__ATOMIC_ACQUIRE, "agent");
            xb_add(&bar[XB_XGEN(bx)], 1u);
            asm volatile("s_waitcnt vmcnt(0)" ::: "memory");
        } else {
            XB_SPIN(xb_ld(&bar[XB_XGEN(bx)]) == gen, bar);
            __builtin_amdgcn_fence(__ATOMIC_ACQUIRE, "agent");
            asm volatile("s_waitcnt vmcnt(0)" ::: "memory");
        }
    }
    __syncthreads();
}
struct Frame {
    LAS unsigned char* lds;
    int tid, lane, wave, vcu, G, gw, NGW;
    unsigned char* ws;
};
__device__ __forceinline__ int opaque_v(int v) { asm volatile("" : "+v"(v)); return v; }
__device__ __forceinline__ int phase_tid(int wave) { int lane; asm volatile("v_mbcnt_lo_u32_b32 %0, -1, 0\n\tv_mbcnt_hi_u32_b32 %0, -1, %0" : "=v"(lane)); return wave * 64 + lane; }
__device__ __forceinline__ Frame phase_frame(const Frame& F0) { Frame F = F0; F.tid = phase_tid(F0.wave); F.lane = F.tid & 63; return F; }
__device__ __forceinline__ float swap32(float v, int lane) { auto rr = __builtin_amdgcn_permlane32_swap(__float_as_uint(v), __float_as_uint(v), false, false); return __uint_as_float(lane < 32 ? rr[1] : rr[0]); }
__device__ __forceinline__ int row_cls(int row) { const int b = row / RB, i = row - b * RB; return i < CTX ? 2 : b; }

__device__ __forceinline__ void p0_transpose_item(const float* W, int K, int N, bf16_t* WT, const float* gain, LAS float* scr, int item, int lane, bool perm_q = false) {
    const int nblk = N / 32, kb = item / nblk, nb = item % nblk, k0 = 64 * kb, n0 = 32 * nb;
    {
        const int rgp = lane >> 3, c4 = (lane & 7) * 4; f32x4 tv[8];
#pragma unroll
        for (int i = 0; i < 8; ++i) tv[i] = *(const f32x4*)(W + (size_t)(k0 + 8 * i + rgp) * N + n0 + c4);
#pragma unroll
        for (int i = 0; i < 8; ++i) { const int kk = 8 * i + rgp; f32x4 v = tv[i]; if (gain) v = v * gain[k0 + kk];
            LAS float* d = scr + kk * 33 + c4; d[0] = v.x; d[1] = v.y; d[2] = v.z; d[3] = v.w; }
    }
    asm volatile("s_waitcnt lgkmcnt(0)" ::: "memory");
    const int c = lane & 7;
#pragma unroll
    for (int j = 0; j < 4; ++j) { const int n = (lane >> 3) + 8 * j; const LAS float* s = scr + (8 * c) * 33 + n;
        u32x4 o; o.x = pk2(s[0 * 33], s[1 * 33]); o.y = pk2(s[2 * 33], s[3 * 33]); o.z = pk2(s[4 * 33], s[5 * 33]); o.w = pk2(s[6 * 33], s[7 * 33]);
        int nn = n0 + n; if (perm_q) { const int hh = nn / 192, e = nn - hh * 192; nn = (e < 128) ? hh * 128 + e : 1024 + hh * 64 + (e - 128); }
        *(u32x4*)(WT + (size_t)nn * K + k0 + 8 * c) = o; }
    asm volatile("s_waitcnt lgkmcnt(0)" ::: "memory");
}
struct TrDesc { const float* W; const float* gain; bf16_t* WT; int K, N, items; };

__device__ __forceinline__ void p0_gemv_task(Frame& F, int task, const float* ada_w, const float* ada_b, float* mod) {
    LAS float* sv = (LAS float*)F.lds; LAS float* part = (LAS float*)(F.lds + 32768);
    const int l = task / 192, n0 = (task % 192) * 64, rg = F.lane >> 4, c4 = (F.lane & 15) * 4;
    const float* Wp = ada_w + (size_t)l * DM * NMOD + n0 + c4 + (size_t)(F.wave * 256 + rg) * NMOD;
    f32x4 a0 = {0, 0, 0, 0}, a1 = a0, a2 = a0;
    for (int k = 0; k < 256; k += 32) {
        f32x4 w[8];
#pragma unroll
        for (int u = 0; u < 8; ++u) w[u] = *(const f32x4*)(Wp + (size_t)(k + 4 * u) * NMOD);
#pragma unroll
        for (int u = 0; u < 8; ++u) { const int kk = F.wave * 256 + k + 4 * u + rg; const float s0 = sv[kk], s1 = sv[2048 + kk], s2 = sv[4096 + kk];
            a0 += w[u] * s0; a1 += w[u] * s1; a2 += w[u] * s2; }
    }
    LAS float* pp = part + ((F.wave * 4 + rg) * 3) * 64 + c4;
    *(LAS f32x4*)(pp) = a0; *(LAS f32x4*)(pp + 64) = a1; *(LAS f32x4*)(pp + 128) = a2;
    __syncthreads();
    if (F.tid < 192) { const int r = F.tid >> 6, c = F.tid & 63; float s = 0.f;
#pragma unroll
        for (int q = 0; q < 32; ++q) s += part[(q * 3 + r) * 64 + c];
        mod[(size_t)(l * 3 + r) * NMOD + n0 + c] = s + ada_b[(size_t)l * NMOD + n0 + c]; }
    __syncthreads();
}

__device__ __forceinline__ void p0_prologue(Frame& F, const float* const* in) {
    unsigned char* ws = F.ws;
    {
        LAS float* sv = (LAS float*)F.lds;
        for (int i = F.tid; i < 3 * DM; i += NTHREADS) { const int r = i / DM, k = i - r * DM; const float x = (r < 2) ? in[1][r * DM + k] : in[3][k]; sv[i] = x / (1.f + __expf(-x)); }
        __syncthreads();
        for (int task = F.vcu; task < 768; task += F.G) p0_gemv_task(F, task, in[4], in[5], (float*)(ws + WS_MOD));
        __syncthreads();
    }
    {
        float* xw = (float*)(ws + WS_XW);
        for (int row = F.gw; row < MROWS; row += F.NGW) { const int b = row / RB, i = row - b * RB;
            const float* src = (i < CTX) ? in[2] + (size_t)(b * CTX + i) * DM : in[0] + (size_t)(b * SEQ + i - CTX) * DM;
            const f32x4* s4 = (const f32x4*)src + F.lane; f32x4* d4 = (f32x4*)(xw + (size_t)row * DM) + F.lane;
#pragma unroll
            for (int j = 0; j < 8; ++j) d4[64 * j] = s4[64 * j]; }
    }
    {
        float* sm = (float*)(ws + WS_SMALL); const int g = F.vcu * NTHREADS + F.tid;
        if (g < 8192) { sm[SM_N1G + g] = in[6][g]; sm[SM_N2G + g] = in[7][g]; }
        if (g < 384) { sm[SM_AQG + g] = in[13][g]; sm[SM_AKG + g] = in[14][g]; }
        if (g < 6144) sm[SM_CW + g] = in[15][g];
        if (g < 2048) sm[SM_CB + g] = in[16][g];
        if (g < 256) { sm[SM_CQG + g] = in[19][g]; sm[SM_CKG + g] = in[20][g]; }
    }
    {
        float* rc = (float*)(ws + WS_ROPE); float* ra = rc + 64 * 32 * 2;
        const int g = F.vcu * NTHREADS + F.tid;
        if (g < 64 * 32) { const int pos = g >> 5, f = g & 31; const float fr = exp2f(-(float)f * (13.287712379549449f / 32.f)); const float ang = (float)pos * fr;
            rc[2 * g] = cosf(ang); rc[2 * g + 1] = sinf(ang); }
        else if (g < 64 * 32 + 64 * 16) { const int e = g - 64 * 32, pos = e >> 4, f = e & 15; const float fr = exp2f(-(float)f * (13.287712379549449f / 16.f)); const float ang = (float)pos * fr;
            ra[2 * e] = cosf(ang); ra[2 * e + 1] = sinf(ang); }
    }
    {
        LAS float* scr = (LAS float*)(F.lds + F.wave * 16384);
        TrDesc d[16]; int nd = 0;
#pragma unroll
        for (int i = 0; i < 2; ++i) {
            d[nd++] = TrDesc{in[8] + (size_t)i * DM * 3904, nullptr, (bf16_t*)(ws + WS_WIN) + (size_t)i * 4096 * DM, DM, 3904, 32 * 122};
            d[nd++] = TrDesc{in[11] + (size_t)i * 512 * 1536, in[9] + i * 512, (bf16_t*)(ws + WS_WUQ) + (size_t)i * 1536 * 512, 512, 1536, 8 * 48};
            d[nd++] = TrDesc{in[12] + (size_t)i * 256 * 2048, in[10] + i * 256, (bf16_t*)(ws + WS_WUKV) + (size_t)i * 2048 * 256, 256, 2048, 4 * 64};
            d[nd++] = TrDesc{in[17] + (size_t)i * DM * DM, nullptr, (bf16_t*)(ws + WS_WEO) + (size_t)i * DM * DM, DM, DM, 32 * 64};
            d[nd++] = TrDesc{in[18] + (size_t)i * DM * 3072, nullptr, (bf16_t*)(ws + WS_WQKV) + (size_t)i * 3072 * DM, DM, 3072, 32 * 96};
            d[nd++] = TrDesc{in[21] + (size_t)i * DM * DM, nullptr, (bf16_t*)(ws + WS_WCO) + (size_t)i * DM * DM, DM, DM, 32 * 64};
        }
#pragma unroll
        for (int l = 0; l < 4; ++l) d[nd++] = TrDesc{in[22] + (size_t)l * DM * DM, nullptr, (bf16_t*)(ws + WS_WPQ) + (size_t)l * DM * DM, DM, DM, 32 * 64};
#pragma unroll
        for (int m = 0; m < 16; ++m) {
            for (int it = F.gw; it < d[m].items; it += F.NGW) p0_transpose_item(d[m].W, d[m].K, d[m].N, d[m].WT, d[m].gain, scr, it, F.lane, d[m].K == 512);
        }
        for (int i = F.gw * 64 + F.lane; i < 2 * 192 * DM / 8; i += F.NGW * 64) { const int li = i / (192 * DM / 8), r = i % (192 * DM / 8);
            *(u32x4*)((bf16_t*)(ws + WS_WIN) + (size_t)li * 4096 * DM + (size_t)3904 * DM + (size_t)r * 8) = (u32x4){0u, 0u, 0u, 0u}; }
    }
    {
        const size_t n_sk = (size_t)4 * 16 * 128 * 128 / 8;
        const size_t gt = (size_t)F.vcu * NTHREADS + F.tid, GT = (size_t)F.G * NTHREADS;
        for (size_t j = gt; j < n_sk; j += GT) {
            const f32x4 a = *(const f32x4*)(in[23] + j * 8), b = *(const f32x4*)(in[23] + j * 8 + 4);
            u32x4 o; o.x = pk2(a.x, a.y); o.y = pk2(a.z, a.w); o.z = pk2(b.x, b.y); o.w = pk2(b.z, b.w);
            *(u32x4*)((bf16_t*)(ws + WS_SUBK) + j * 8) = o;
        }
    }
    {
        for (int r = F.gw; r < 2 * 4 * NEXP; r += F.NGW) {
            const int tab = r / (4 * NEXP), rr = r - tab * (4 * NEXP);
#if EXP_SLICED
            const float* src = (tab ? in[25] : in[24]) + (size_t)rr * DM + F.lane * 32;
            f32x4 v[8];
#pragma unroll
            for (int q = 0; q < 8; ++q) v[q] = *(const f32x4*)(src + q * 4);
#else
            const float* src = (tab ? in[25] : in[24]) + (size_t)rr * DM + F.lane * 16;
            f32x4 v[8];
#pragma unroll
            for (int j = 0; j < 2; ++j)
#pragma unroll
                for (int q = 0; q < 4; ++q) v[j * 4 + q] = *(const f32x4*)(src + j * 1024 + q * 4);
#endif
            float am = 0.f;
#pragma unroll
            for (int q = 0; q < 8; ++q) am = fmaxf(fmaxf(am, fmaxf(fabsf(v[q].x), fabsf(v[q].y))), fmaxf(fabsf(v[q].z), fabsf(v[q].w)));
#pragma unroll
            for (int o = 1; o < 64; o <<= 1) am = fmaxf(am, __shfl_xor(am, o));
            am = fmaxf(am, 1e-30f);
#if TAB_FP4
            float ssq = 0.f;
#pragma unroll
            for (int q = 0; q < 8; ++q) ssq += (v[q].x * v[q].x + v[q].y * v[q].y) + (v[q].z * v[q].z + v[q].w * v[q].w);
#pragma unroll
            for (int o = 1; o < 64; o <<= 1) ssq += __shfl_xor(ssq, o);
            const float sig = fmaxf(sqrtf(ssq * (1.f / DM)), am * (1.f / 64.f));
            unsigned w4[4];
#if EXP_SLICED
            if (tab == 0 && !PEER_MFMA) {
                const float delta = 0.3352f * sig, isc = 1.0f / delta;
#pragma unroll
                for (int q = 0; q < 4; ++q) { unsigned t = 0u;
#pragma unroll
                    for (int hh = 0; hh < 2; ++hh) { const f32x4 x = v[2 * q + hh] * isc;
                        const int n0 = min(max((int)floorf(x.x), -8), 7) & 15, n1 = min(max((int)floorf(x.y), -8), 7) & 15, n2 = min(max((int)floorf(x.z), -8), 7) & 15, n3 = min(max((int)floorf(x.w), -8), 7) & 15;
                        t |= ((unsigned)n0 | ((unsigned)n1 << 4) | ((unsigned)n2 << 8) | ((unsigned)n3 << 12)) << (16 * hh); }
                    w4[q] = t; }
                { const int ll = rr / NEXP, ee = rr - ll * NEXP;
                  *(u32x4*)(ws + WS_U + (size_t)ll * NEXP * ROWB + (size_t)(F.lane >> 3) * (NEXP * 128) + (size_t)ee * 128 + (F.lane & 7) * 16) = (u32x4){w4[0], w4[1], w4[2], w4[3]}; }
                if (F.lane == 0) ((float*)(ws + WS_USC))[rr] = delta;
                continue;
            }
#endif
            const float sc = 2.0f / sig;
#pragma unroll
            for (int q = 0; q < 4; ++q) { unsigned t = 0u;
                const f32x4 xa = v[2 * q] * sc, xb = v[2 * q + 1] * sc;
#define P0_C6(x) fminf(fmaxf((x), -6.f), 6.f)
                t = __builtin_amdgcn_cvt_scalef32_pk_fp4_f32(t, P0_C6(xa.x), P0_C6(xa.y), 1.0f, 0);
                t = __builtin_amdgcn_cvt_scalef32_pk_fp4_f32(t, P0_C6(xa.z), P0_C6(xa.w), 1.0f, 1);
                t = __builtin_amdgcn_cvt_scalef32_pk_fp4_f32(t, P0_C6(xb.x), P0_C6(xb.y), 1.0f, 2);
                t = __builtin_amdgcn_cvt_scalef32_pk_fp4_f32(t, P0_C6(xb.z), P0_C6(xb.w), 1.0f, 3);
#undef P0_C6
                w4[q] = t; }
#if EXP_SLICED
            { const int ll = rr / NEXP, ee = rr - ll * NEXP;
              *(u32x4*)(ws + (tab ? WS_VT : WS_U) + (size_t)ll * NEXP * ROWB + (size_t)(F.lane >> 3) * (NEXP * 128) + (size_t)ee * 128 + (F.lane & 7) * 16) = (u32x4){w4[0], w4[1], w4[2], w4[3]}; }
#else
            *(u32x4*)(ws + (tab ? WS_VT : WS_U) + (size_t)rr * ROWB + F.lane * 16) = (u32x4){w4[0], w4[1], w4[2], w4[3]};
#endif
            if (F.lane == 0) ((float*)(ws + (tab ? WS_VSC : WS_USC)))[rr] = sig * 0.5f;
#else
            const float sc = 7.5f / am;
            f32x16 a, b;
#pragma unroll
            for (int q = 0; q < 8; ++q) { const f32x4 x = v[q] * sc; a[2 * q] = x.x; b[2 * q] = x.y; a[2 * q + 1] = x.z; b[2 * q + 1] = x.w; }
            const u32x6 w = __builtin_amdgcn_cvt_scalef32_2xpk16_fp6_f32(a, b, 1.0f);
            unsigned char* dst = ws + (tab ? WS_VT : WS_U) + (size_t)rr * ROWB;
            *(u32x4*)(dst + F.lane * 16) = (u32x4){w[0], w[1], w[2], w[3]};
            *(u32x2*)(dst + 1024 + F.lane * 8) = (u32x2){w[4], w[5]};
            if (F.lane == 0) ((float*)(ws + (tab ? WS_VSC : WS_USC)))[rr] = am * (1.0f / 7.5f);
#endif
        }
    }
}

#define DPP_MOV(v, ctrl) __builtin_bit_cast(float, __builtin_amdgcn_update_dpp(0, __builtin_bit_cast(int, (v)), (ctrl), 0xf, 0xf, true))
__device__ __forceinline__ void norm_phase(const Frame& F0, const float* xw, const float* g, const float* modl  , int off_sh, int off_sc, bf16_t* H, bool lat_only, unsigned* XQ = nullptr, float* XS = nullptr) {
    const Frame F = phase_frame(F0);
    f32x4 gm[8], shv[8]; int cur_cls = -1;
    int row = F.gw; if (lat_only) while (row < MROWS && row_cls(row) == 2) row += F.NGW;
    f32x4 v[8];
    if (row < MROWS) { const f32x4* x4 = (const f32x4*)(xw + (size_t)row * DM) + F.lane;
#pragma unroll
        for (int j = 0; j < 8; ++j) v[j] = x4[64 * j]; }
    while (row < MROWS) {
        int nrow = row + F.NGW; if (lat_only) while (nrow < MROWS && row_cls(nrow) == 2) nrow += F.NGW;
        f32x4 vn[8];
        if (nrow < MROWS) { const f32x4* x4 = (const f32x4*)(xw + (size_t)nrow * DM) + F.lane;
#pragma unroll
            for (int j = 0; j < 8; ++j) vn[j] = x4[64 * j]; }
        const int cls = row_cls(row);
        if (cls != cur_cls) {
            cur_cls = cls;
            const f32x4* g4 = (const f32x4*)g + F.lane; const f32x4* sc4 = (const f32x4*)(modl + (size_t)cls * NMOD + off_sc) + F.lane; const f32x4* sh4 = (const f32x4*)(modl + (size_t)cls * NMOD + off_sh) + F.lane;
#pragma unroll
            for (int j = 0; j < 8; ++j) { gm[j] = g4[64 * j] * (sc4[64 * j] + 1.0f); shv[j] = sh4[64 * j]; }
        }
        float ss = 0.f;
#pragma unroll
        for (int j = 0; j < 8; ++j) ss += (v[j].x * v[j].x + v[j].y * v[j].y) + (v[j].z * v[j].z + v[j].w * v[j].w);
        const float rstd = 1.0f / sqrtf(wave_sum_dpp(ss) * (1.f / DM) + EPS);
        u32x2* o2 = (u32x2*)(H + (size_t)row * DM) + F.lane;
#if PEER_MFMA
        if (XQ) {
            f32x4 yv[8]; float am = 0.f;
#pragma unroll
            for (int j = 0; j < 8; ++j) { const f32x4 y = (v[j] * rstd) * gm[j] + shv[j]; yv[j] = y; u32x2 o; o.x = pk2(y.x, y.y); o.y = pk2(y.z, y.w); o2[64 * j] = o;
                am = fmaxf(fmaxf(am, fmaxf(fabsf(y.x), fabsf(y.y))), fmaxf(fabsf(y.z), fabsf(y.w))); }
            am = fmaxf(am, DPP_MOV(am, 0xB1)); am = fmaxf(am, DPP_MOV(am, 0x4E)); am = fmaxf(am, DPP_MOV(am, 0x141)); am = fmaxf(am, DPP_MOV(am, 0x140));
            { const int ai = __builtin_bit_cast(int, am);
              am = fmaxf(fmaxf(__builtin_bit_cast(float, __builtin_amdgcn_readlane(ai, 0)), __builtin_bit_cast(float, __builtin_amdgcn_readlane(ai, 16))),
                         fmaxf(__builtin_bit_cast(float, __builtin_amdgcn_readlane(ai, 32)), __builtin_bit_cast(float, __builtin_amdgcn_readlane(ai, 48)))); }
            am = fmaxf(am, 1e-20f);
            const float qs = 440.0f / am;
            unsigned* q8 = XQ + (size_t)row * (DM / 4) + F.lane;
#pragma unroll
            for (int j = 0; j < 8; ++j) { const f32x4 y = yv[j] * qs; int pk = 0; pk = __builtin_amdgcn_cvt_pk_fp8_f32(y.x, y.y, pk, false); pk = __builtin_amdgcn_cvt_pk_fp8_f32(y.z, y.w, pk, true); q8[64 * j] = (unsigned)pk; }
            if (F.lane == 0) XS[row] = am * (1.0f / 440.0f);
        } else
#endif
        {
#pragma unroll
        for (int j = 0; j < 8; ++j) { const f32x4 y = (v[j] * rstd) * gm[j] + shv[j]; u32x2 o; o.x = pk2(y.x, y.y); o.y = pk2(y.z, y.w); o2[64 * j] = o;
            if (XQ) {
                float am = fmaxf(fmaxf(fabsf(y.x), fabsf(y.y)), fmaxf(fabsf(y.z), fabsf(y.w)));
                am = fmaxf(am, DPP_MOV(am, 0xB1)); am = fmaxf(am, DPP_MOV(am, 0x4E)); am = fmaxf(am, DPP_MOV(am, 0x141)); am = fmaxf(am, 1e-20f);
                const float qs = 119.0f / am; const float yy[4] = {y.x, y.y, y.z, y.w};
                unsigned pl = 0u, ph = 0u; int sq = 0;
#pragma unroll
                for (int i = 0; i < 4; ++i) { const int qi = __float2int_rn(yy[i] * qs); const int lo = ((qi + 8) & 15) - 8; const int hi = (qi - lo) >> 4; sq += qi; pl |= (unsigned)(lo & 15) << (4 * i); ph |= (unsigned)(hi & 15) << (4 * i); }
                const unsigned pl1 = (unsigned)__builtin_amdgcn_update_dpp(0, (int)pl, 0xB1, 0xf, 0xf, true), ph1 = (unsigned)__builtin_amdgcn_update_dpp(0, (int)ph, 0xB1, 0xf, 0xf, true);
                float sqf = (float)sq; sqf = DPP_ADD(sqf, 0xB1); sqf = DPP_ADD(sqf, 0x4E); sqf = DPP_ADD(sqf, 0x141);
                const int chunk = j * 8 + (F.lane >> 3), l8 = F.lane & 7;
                if ((l8 & 1) == 0) { unsigned* q = XQ + ((size_t)row * 64 + chunk) * 8 + (l8 >> 1); q[0] = ph | (ph1 << 16); q[4] = pl | (pl1 << 16); }
                if (l8 == 0) { float* s = XS + ((size_t)row * 64 + chunk) * 2; s[0] = am * (1.0f / 119.0f); s[1] = 0.5f * sqf; }
            } }
        }
        row = nrow;
#pragma unroll
        for (int j = 0; j < 8; ++j) v[j] = vn[j];
    }
}

__device__ __forceinline__ float row16_sum(float v) { v = DPP_ADD(v, 0xB1); v = DPP_ADD(v, 0x4E); v = DPP_ADD(v, 0x141); v = DPP_ADD(v, 0x140); return v; }
__device__ __forceinline__ void prep_odd_phase(const Frame& F0, const bf16_t* P, const float* qg, const float* kg, const float* rope_c, bf16_t* Q, bf16_t* Kb) {
    const Frame F = phase_frame(F0);
    const int l16 = F.lane & 15, d0 = l16 * 8;
    float gq[8], gk[8];
#pragma unroll
    for (int e = 0; e < 8; ++e) { gq[e] = qg[d0 + e]; gk[e] = kg[d0 + e]; }
    const bool lowhalf = l16 < 8;
    const int j0 = (l16 & 7) * 8;
    int row = F.gw;
    u32x4 w[5];
    if (row < MROWS) { const u32x4* pr = (const u32x4*)(P + (size_t)row * 3072) + F.lane;
#pragma unroll
        for (int k = 0; k < 5; ++k) w[k] = pr[64 * k]; }
    while (row < MROWS) {
        const int nrow = row + F.NGW;
        u32x4 wn[5];
        if (nrow < MROWS) { const u32x4* pr = (const u32x4*)(P + (size_t)nrow * 3072) + F.lane;
#pragma unroll
            for (int k = 0; k < 5; ++k) wn[k] = pr[64 * k]; }
        const int b = row / RB, i = row - b * RB; const bool lat = i >= CTX; const int t = i - CTX;
        float cs[8], sn[8];
#pragma unroll
        for (int e = 0; e < 8; ++e) { cs[e] = 1.f; sn[e] = 0.f; }
        if (lat) { const int pos = (j0 < 32) ? (t >> 6) : (t & 63); const f32x4* tb = (const f32x4*)(rope_c + ((pos << 5) + (j0 & 31)) * 2);
#pragma unroll
            for (int q = 0; q < 4; ++q) { const f32x4 c = tb[q]; cs[2 * q] = c.x; sn[2 * q] = c.y; cs[2 * q + 1] = c.z; sn[2 * q + 1] = c.w; } }
#pragma unroll
        for (int k = 0; k < 5; ++k) {
            const unsigned ww[4] = {w[k].x, w[k].y, w[k].z, w[k].w};
            float x[8]; float ss = 0.f;
#pragma unroll
            for (int q = 0; q < 4; ++q) { x[2 * q] = bf_lo(ww[q]); x[2 * q + 1] = bf_hi(ww[q]); ss += x[2 * q] * x[2 * q] + x[2 * q + 1] * x[2 * q + 1]; }
            const float rstd = 1.0f / sqrtf(row16_sum(ss) * (1.f / 128.f) + EPS);
            unsigned ow[4]; float o[8];
#pragma unroll
            for (int e = 0; e < 8; ++e) { const float y = x[e] * rstd * (k < 4 ? gq[e] : gk[e]); const float yp = DPP_MOV(y, 0x128);
                o[e] = lowhalf ? (y * cs[e] - yp * sn[e]) : (y * cs[e] + yp * sn[e]); }
#pragma unroll
            for (int q = 0; q < 4; ++q) ow[q] = pk2(o[2 * q], o[2 * q + 1]);
            if (k < 4) *((u32x4*)(Q + (size_t)row * 2048) + 64 * k + F.lane) = (u32x4){ow[0], ow[1], ow[2], ow[3]};
            else *((u32x4*)(Kb + (size_t)row * 512) + F.lane) = (u32x4){ow[0], ow[1], ow[2], ow[3]};
        }
        row = nrow;
#pragma unroll
        for (int k = 0; k < 5; ++k) w[k] = wn[k];
    }
}

struct PrepEvenRow { u32x4 cq; u32x2 ckv, kr; u32x4 qn[2]; u32x2 qr[2]; u32x4 kn[2], vv[2]; };
__device__ __forceinline__ void prep_even_load(PrepEvenRow& R, const bf16_t* P, const bf16_t* QR, const bf16_t* KVR, int row, int lane) {
    const bf16_t* pr = P + (size_t)row * 4096; const int l16 = lane & 15, hq = lane >> 4;
    R.cq = *((const u32x4*)pr + lane); R.ckv = *((const u32x2*)(pr + 512) + lane); R.kr = *((const u32x2*)(pr + 768) + l16);
    const bf16_t* q = QR + (size_t)row * 1536; const bf16_t* kv = KVR + (size_t)row * 2048;
#pragma unroll
    for (int k = 0; k < 2; ++k) { R.qn[k] = *((const u32x4*)q + 64 * k + lane); R.qr[k] = *((const u32x2*)(q + 1024) + 64 * k + lane);
        const bf16_t* kh = kv + (4 * k + hq) * 256 + l16 * 8; R.kn[k] = *(const u32x4*)kh; R.vv[k] = *(const u32x4*)(kh + 128); }
}
__device__ __forceinline__ void prep_even_phase(const Frame& F0, const bf16_t* P, const bf16_t* QR, const bf16_t* KVR, const float* qg, const float* kg, const float* rope_a, bf16_t* Q, bf16_t* Kb, bf16_t* Vb) {
    const Frame F = phase_frame(F0);
    const int lane = F.lane, l16 = lane & 15, hq = lane >> 4, d0 = l16 * 8, r0 = l16 * 4;
    float gqn[8], gkn[8], gqr[4], gkr[4];
#pragma unroll
    for (int e = 0; e < 8; ++e) { gqn[e] = qg[d0 + e]; gkn[e] = kg[d0 + e]; }
#pragma unroll
    for (int e = 0; e < 4; ++e) { gqr[e] = qg[128 + r0 + e]; gkr[e] = kg[128 + r0 + e]; }
    const bool lowhalf = l16 < 8; const int j0 = (l16 & 7) * 4;
    int row = F.gw;
    PrepEvenRow R;
    if (row < MROWS) prep_even_load(R, P, QR, KVR, row, lane);
    while (row < MROWS) {
        const int nrow = row + F.NGW;
        PrepEvenRow Rn;
        if (nrow < MROWS) prep_even_load(Rn, P, QR, KVR, nrow, lane);
        const int b = row / RB, i = row - b * RB; const bool lat = i >= CTX; const int t = i - CTX;
        float cs[4], sn[4];
#pragma unroll
        for (int e = 0; e < 4; ++e) { cs[e] = 1.f; sn[e] = 0.f; }
        if (lat) { const int pos = (j0 < 16) ? (t >> 6) : (t & 63); const f32x4* tb = (const f32x4*)(rope_a + ((pos << 4) + (j0 & 15)) * 2);
            const f32x4 c0 = tb[0], c1 = tb[1]; cs[0] = c0.x; sn[0] = c0.y; cs[1] = c0.z; sn[1] = c0.w; cs[2] = c1.x; sn[2] = c1.y; cs[3] = c1.z; sn[3] = c1.w; }
        float ssq = 0.f, sskv = 0.f;
        { const unsigned ww[4] = {R.cq.x, R.cq.y, R.cq.z, R.cq.w};
#pragma unroll
          for (int q = 0; q < 4; ++q) { const float a = bf_lo(ww[q]), c = bf_hi(ww[q]); ssq += a * a + c * c; } }
        { const float a = bf_lo(R.ckv.x), c = bf_hi(R.ckv.x), d = bf_lo(R.ckv.y), e = bf_hi(R.ckv.y); sskv = (a * a + c * c) + (d * d + e * e); }
        const float rstd_q = 1.0f / sqrtf(wave_sum_dpp(ssq) * (1.f / 512.f) + EPS), rstd_kv = 1.0f / sqrtf(wave_sum_dpp(sskv) * (1.f / 256.f) + EPS);
        const float krv[4] = {bf_lo(R.kr.x), bf_hi(R.kr.x), bf_lo(R.kr.y), bf_hi(R.kr.y)};
        const float krss = (krv[0] * krv[0] + krv[1] * krv[1]) + (krv[2] * krv[2] + krv[3] * krv[3]);
#pragma unroll
        for (int k = 0; k < 2; ++k) {
            const int h = 4 * k + hq;
            {
                const unsigned wn[4] = {R.qn[k].x, R.qn[k].y, R.qn[k].z, R.qn[k].w};
                float xn[8], xr[4]; float ss = 0.f;
#pragma unroll
                for (int q = 0; q < 4; ++q) { xn[2 * q] = bf_lo(wn[q]) * rstd_q; xn[2 * q + 1] = bf_hi(wn[q]) * rstd_q; ss += xn[2 * q] * xn[2 * q] + xn[2 * q + 1] * xn[2 * q + 1]; }
                xr[0] = bf_lo(R.qr[k].x) * rstd_q; xr[1] = bf_hi(R.qr[k].x) * rstd_q; xr[2] = bf_lo(R.qr[k].y) * rstd_q; xr[3] = bf_hi(R.qr[k].y) * rstd_q;
                ss += (xr[0] * xr[0] + xr[1] * xr[1]) + (xr[2] * xr[2] + xr[3] * xr[3]);
                const float r2 = 1.0f / sqrtf(row16_sum(ss) * (1.f / 192.f) + EPS);
                unsigned on[4]; float o[4];
#pragma unroll
                for (int q = 0; q < 4; ++q) on[q] = pk2(xn[2 * q] * r2 * gqn[2 * q], xn[2 * q + 1] * r2 * gqn[2 * q + 1]);
#pragma unroll
                for (int e = 0; e < 4; ++e) { const float y = xr[e] * r2 * gqr[e]; const float yp = DPP_MOV(y, 0x128); o[e] = lowhalf ? (y * cs[e] - yp * sn[e]) : (y * cs[e] + yp * sn[e]); }
                bf16_t* qo = Q + (size_t)row * 1536 + h * 192;
                *(u32x4*)(qo + d0) = (u32x4){on[0], on[1], on[2], on[3]};
                *(u32x2*)(qo + 128 + r0) = (u32x2){pk2(o[0], o[1]), pk2(o[2], o[3])};
            }
            {
                const unsigned wn[4] = {R.kn[k].x, R.kn[k].y, R.kn[k].z, R.kn[k].w}, wv[4] = {R.vv[k].x, R.vv[k].y, R.vv[k].z, R.vv[k].w};
                float xn[8]; float ss = krss;
#pragma unroll
                for (int q = 0; q < 4; ++q) { xn[2 * q] = bf_lo(wn[q]) * rstd_kv; xn[2 * q + 1] = bf_hi(wn[q]) * rstd_kv; ss += xn[2 * q] * xn[2 * q] + xn[2 * q + 1] * xn[2 * q + 1]; }
                const float r2 = 1.0f / sqrtf(row16_sum(ss) * (1.f / 192.f) + EPS);
                unsigned on[4], ov[4]; float o[4];
#pragma unroll
                for (int q = 0; q < 4; ++q) { on[q] = pk2(xn[2 * q] * r2 * gkn[2 * q], xn[2 * q + 1] * r2 * gkn[2 * q + 1]); ov[q] = pk2(bf_lo(wv[q]) * rstd_kv, bf_hi(wv[q]) * rstd_kv); }
#pragma unroll
                for (int e = 0; e < 4; ++e) { const float y = krv[e] * r2 * gkr[e]; const float yp = DPP_MOV(y, 0x128); o[e] = lowhalf ? (y * cs[e] - yp * sn[e]) : (y * cs[e] + yp * sn[e]); }
                bf16_t* ko = Kb + (size_t)row * 1536 + h * 192;
                *(u32x4*)(ko + d0) = (u32x4){on[0], on[1], on[2], on[3]};
                *(u32x2*)(ko + 128 + r0) = (u32x2){pk2(o[0], o[1]), pk2(o[2], o[3])};
                *(u32x4*)(Vb + (size_t)row * 1024 + h * 128 + d0) = (u32x4){ov[0], ov[1], ov[2], ov[3]};
            }
        }
        row = nrow; R = Rn;
    }
}

__device__ __forceinline__ void conv_phase(const Frame& F0, const bf16_t* P, const float* cw  , const float* cb  , bf16_t* CAT) {
    const Frame F = phase_frame(F0);
    const int gt = F.vcu * NTHREADS + F.tid, GT = F.G * NTHREADS;
    for (int it = gt; it < MROWS * 128; it += GT) {
        const int row = it >> 7, c0 = (it & 127) * 8; const int b = row / RB, i = row - b * RB;
        const bool first = (i == 0) || (i == CTX), last = (i == CTX - 1) || (i == RB - 1);
        const bf16_t* pr = P + (size_t)row * 4096 + 832 + c0;
        const u32x4 bg = *(const u32x4*)pr, cg = *(const u32x4*)(pr + 1024), hz = *(const u32x4*)(pr + 2048);
        u32x4 cgm = {0u, 0u, 0u, 0u}, hzm = cgm, cgp = cgm, hzp = cgm;
        if (!first) { cgm = *(const u32x4*)(pr - 4096 + 1024); hzm = *(const u32x4*)(pr - 4096 + 2048); }
        if (!last) { cgp = *(const u32x4*)(pr + 4096 + 1024); hzp = *(const u32x4*)(pr + 4096 + 2048); }
        const unsigned bgw[4] = {bg.x, bg.y, bg.z, bg.w}, cgw[4] = {cg.x, cg.y, cg.z, cg.w}, hzw[4] = {hz.x, hz.y, hz.z, hz.w};
        const unsigned cmw[4] = {cgm.x, cgm.y, cgm.z, cgm.w}, hmw[4] = {hzm.x, hzm.y, hzm.z, hzm.w}, cpw[4] = {cgp.x, cgp.y, cgp.z, cgp.w}, hpw[4] = {hzp.x, hzp.y, hzp.z, hzp.w};
        unsigned ow[4];
#pragma unroll
        for (int q = 0; q < 4; ++q) {
            const int c = c0 + 2 * q;
            const float u0a = bf_lo(cgw[q]) * bf_lo(hzw[q]), u0b = bf_hi(cgw[q]) * bf_hi(hzw[q]);
            const float uma = bf_lo(cmw[q]) * bf_lo(hmw[q]), umb = bf_hi(cmw[q]) * bf_hi(hmw[q]);
            const float upa = bf_lo(cpw[q]) * bf_lo(hpw[q]), upb = bf_hi(cpw[q]) * bf_hi(hpw[q]);
            const float ra = bf_lo(bgw[q]) * (uma * cw[c] + u0a * cw[1024 + c] + upa * cw[2048 + c] + cb[c]);
            const float rb = bf_hi(bgw[q]) * (umb * cw[c + 1] + u0b * cw[1024 + c + 1] + upb * cw[2048 + c + 1] + cb[c + 1]);
            ow[q] = pk2(ra, rb);
        }
        *(u32x4*)(CAT + (size_t)row * DM + 1024 + c0) = (u32x4){ow[0], ow[1], ow[2], ow[3]};
    }
}
__device__ __forceinline__ void attn_even_phase(const Frame& F0, const bf16_t* Q, const bf16_t* Kb, const bf16_t* Vb, bf16_t* CAT) {
    const Frame F = phase_frame(F0);
    for (int u = F.vcu; u < 272; u += F.G) {
        int b, h, qt, nk;
        if (u < 256) { b = u >> 7; h = (u >> 4) & 7; qt = 1 + (u & 15); nk = RB; } else { const int v = u - 256; b = v >> 3; h = v & 7; qt = 0; nk = CTX; }
        const size_t r0 = (size_t)b * RB;
        att::attn_body1<192, 1536, 1536, 1024, 2048>(Q + (r0 + qt * 256) * 1536 + h * 192, Kb + r0 * 1536 + h * 192, Vb + r0 * 1024 + h * 128, CAT + (r0 + qt * 256) * 2048 + h * 128, nk, (char*)F.lds, phase_tid(F.wave));
    }
}
__device__ __forceinline__ void attn_odd_phase(const Frame& F0, const bf16_t* Q, const bf16_t* Kb, const bf16_t* P, bf16_t* CAT, bool lat_only) {
    const Frame F = phase_frame(F0);
    const int nunits = lat_only ? 512 : 544;
    for (int u = F.vcu; u < nunits; u += F.G) {
        int b, hq, qt, nk;
        if (u < 512) { b = u >> 8; hq = (u >> 4) & 15; qt = 1 + (u & 15); nk = RB; } else { const int v = u - 512; b = v >> 4; hq = v & 15; qt = 0; nk = CTX; }
        const int kvh = hq >> 2; const size_t r0 = (size_t)b * RB;
        att::attn_body<128, 2048, 512, 3072, 2048, 2>(Q + (r0 + qt * 256) * 2048 + hq * 128, Kb + r0 * 512 + kvh * 128, P + r0 * 3072 + 2560 + kvh * 128, CAT + (r0 + qt * 256) * 2048 + hq * 128, nk, (char*)F.lds, phase_tid(F.wave));
    }
}

__device__ __forceinline__ int crow32(int r, int hi) { return (r & 3) + 8 * (r >> 2) + 4 * hi; }
__device__ __forceinline__ int fkey(int b) { return b ^ ((b >> 31) & 0x7fffffff); }
#define TK_CE(x, y) do { const int hi_ = max((x), (y)), lo_ = min((x), (y)); (x) = hi_; (y) = lo_; } while (0)
template <int N> __device__ __forceinline__ void tk_sort(int* v) {
#pragma unroll
    for (int k = 2; k <= N; k <<= 1)
#pragma unroll
        for (int j = k >> 1; j > 0; j >>= 1)
#pragma unroll
            for (int i = 0; i < N; ++i) { const int l = i ^ j; if (l > i) { if ((i & k) == 0) TK_CE(v[i], v[l]); else TK_CE(v[l], v[i]); } }
}
__device__ __forceinline__ void tk_merge16(int* a, const int* b) {
#pragma unroll
    for (int i = 0; i < 16; ++i) a[i] = max(a[i], b[15 - i]);
#pragma unroll
    for (int j = 8; j > 0; j >>= 1)
#pragma unroll
        for (int i = 0; i < 16; ++i) { const int l = i ^ j; if (l > i) TK_CE(a[i], a[l]); }
}
__device__ __forceinline__ void tk_merge_partner(int* a) {
    int lo[16], hi[16];
#pragma unroll
    for (int i = 0; i < 16; ++i) { auto rr = __builtin_amdgcn_permlane32_swap((unsigned)a[i], (unsigned)a[i], false, false); lo[i] = (int)rr[0]; hi[i] = (int)rr[1]; }
    tk_merge16(lo, hi);
#pragma unroll
    for (int i = 0; i < 16; ++i) a[i] = lo[i];
}
__device__ __forceinline__ void peer_topk_phase(const Frame& F0, const bf16_t* PQ, const bf16_t* subk  , int* IDX, float* GATE, bool lat_only) {
    const Frame F = phase_frame(F0);
    const int h = F.vcu & 7, jw = (F.vcu >> 3) * NWAVES + F.wave, nwh = (F.G >> 3) * NWAVES;
    {
        const bf16_t* src = subk + (size_t)h * 2 * 128 * 128;
        for (int c = F.tid; c < 4096; c += NTHREADS) { const int row = c >> 4, ch = c & 15;
            *(LAS u32x4*)(F.lds + row * 256 + ((ch ^ (row & 15)) << 4)) = *(const u32x4*)(src + (size_t)row * 128 + ch * 8); }
        __syncthreads();
    }
    const int ntg = lat_only ? 256 : MROWS / 32;
    for (int t = jw; t < ntg; t += nwh) {
        int lane_ = F.lane; asm volatile("" : "+v"(lane_));
        const int r32 = lane_ & 31, hi = lane_ >> 5;
        int tg = t; if (lat_only) tg += 8 + (tg >= 128 ? 8 : 0);
        const int token = tg * 32 + r32;
        int top[2][16];
        const int kk = (((r32 & 14) | (hi ^ (r32 & 1))) << 4);
#pragma unroll
        for (int p = 0; p < 2; ++p) {
            bf16x8 bq[8];
            const bf16_t* qp = PQ + (size_t)token * DM + h * 256 + p * 128 + hi * 8;
#pragma unroll
            for (int ks = 0; ks < 8; ++ks) bq[ks] = *(const bf16x8*)(qp + ks * 16);
            int s[4][16];
#pragma unroll
            for (int nb = 0; nb < 4; ++nb) {
                f32x16 acc = {};
                const LAS unsigned char* kp = F.lds + (p * 128 + nb * 32 + r32) * 256;
#pragma unroll
                for (int ks = 0; ks < 8; ++ks) { const bf16x8 a = *(const LAS bf16x8*)(kp + (kk ^ (ks << 5))); acc = __builtin_amdgcn_mfma_f32_32x32x16_bf16(a, bq[ks], acc, 0, 0, 0); }
#pragma unroll
                for (int r = 0; r < 16; ++r) { const int key = nb * 32 + crow32(r, hi); s[nb][r] = fkey((int)((__float_as_uint(acc[r]) & ~127u) | (unsigned)(127 - key))); }
                tk_sort<16>(s[nb]);
            }
            tk_merge16(s[0], s[1]); tk_merge16(s[2], s[3]); tk_merge16(s[0], s[2]);
            tk_merge_partner(s[0]);
#pragma unroll
            for (int j = 0; j < 16; ++j) top[p][j] = s[0][j];
        }
        int cand[32];
        unsigned long long kaLo = 0ull, kaHi = 0ull, kbLo = 0ull, kbHi = 0ull;
        {
            float fb[16]; const float fa0 = __uint_as_float((unsigned)fkey(top[0][0]) & ~127u), fb0 = __uint_as_float((unsigned)fkey(top[1][0]) & ~127u);
#pragma unroll
            for (int r = 0; r < 16; ++r) { const int ba = fkey(top[0][r]), bb = fkey(top[1][r]); fb[r] = __uint_as_float((unsigned)bb & ~127u) - fb0;
                const unsigned long long xa = (unsigned long long)(unsigned)(127 - (ba & 127)) << (8 * (r & 7)), xb = (unsigned long long)(unsigned)(127 - (bb & 127)) << (8 * (r & 7));
                if (r < 8) { kaLo |= xa; kbLo |= xb; } else { kaHi |= xa; kbHi |= xb; } }
            float fa[8];
#pragma unroll
            for (int i = 0; i < 8; ++i) { const int ka = hi ? top[0][2 * i + 1] : top[0][2 * i]; fa[i] = __uint_as_float((unsigned)fkey(ka) & ~127u) - fa0; }
            const int hid = 255 - (hi << 4);
            int n = 0;
#pragma unroll
            for (int i = 0; i < 8; ++i)
#pragma unroll
                for (int b = 0; b < 16; ++b) if ((2 * i + 1) * (b + 1) <= 16) {
                    const float sum = fa[i] + fb[b];
                    cand[n++] = fkey((int)((__float_as_uint(sum) & ~255u) | (unsigned)(hid - (32 * i + b))));
                }
#pragma unroll
            for (; n < 32; ++n) cand[n] = (int)0x80000000;
        }
        tk_sort<16>(cand); tk_sort<16>(cand + 16); tk_merge16(cand, cand + 16);
        tk_merge_partner(cand);
        float ev[16]; float esum = 0.f;
#pragma unroll
        for (int j = 0; j < 16; ++j) { ev[j] = __expf(__uint_as_float((unsigned)fkey(cand[j]) & ~255u)); esum += ev[j]; }
        const float rs = 1.0f / esum;
        int oi[8]; float og[8];
#pragma unroll
        for (int j = 0; j < 8; ++j) { const int w = hi ? cand[8 + j] : cand[j]; const float e = hi ? ev[8 + j] : ev[j];
            const int id8 = 255 - (fkey(w) & 255), ra = id8 >> 4, rb = id8 & 15;
            const unsigned long long wa = (ra & 8) ? kaHi : kaLo, wb = (rb & 8) ? kbHi : kbLo;
            const int ka = (int)(wa >> (8 * (ra & 7))) & 127, kb = (int)(wb >> (8 * (rb & 7))) & 127;
            oi[j] = ka * 128 + kb; og[j] = e * rs; }
        int* ip = IDX + (size_t)token * 128 + h * 16 + hi * 8; float* gp = GATE + (size_t)token * 128 + h * 16 + hi * 8;
        *(int4*)ip = make_int4(oi[0], oi[1], oi[2], oi[3]); *(int4*)(ip + 4) = make_int4(oi[4], oi[5], oi[6], oi[7]);
        *(f32x4*)gp = (f32x4){og[0], og[1], og[2], og[3]}; *(f32x4*)(gp + 4) = (f32x4){og[4], og[5], og[6], og[7]};
    }
}

#if TAB_FP4
__device__ __forceinline__ void peer_expert_phase(const Frame& F0, const bf16_t* H2, const int* IDX, const float* GATE, const unsigned char* U, size_t v_minus_u_bytes, const float* USC, const float* VSC,
                                                  const float* g2  , float* XW, float* OUT,
                                                  bf16_t* HN  , const float* ng  , const float* nmod  ) {
    const Frame F = phase_frame(F0);
    LAS float* red = (LAS float*)F.lds;
    const unsigned voff_tab = (unsigned)v_minus_u_bytes;
    const __amdgpu_buffer_rsrc_t rs = __builtin_amdgcn_make_buffer_rsrc((void*)U, 0, (int)(voff_tab + (unsigned)NEXP * ROWB), 0x00020000);
    const int lane = F.lane; const int voff = lane * 16;
#define PX_SB() __builtin_amdgcn_sched_barrier(0)
#define PX_LOADALL(buf, ivv, tb) do { _Pragma("unroll") for (int e_ = 0; e_ < 16; ++e_) buf[e_] = __builtin_amdgcn_raw_buffer_load_b128(rs, voff, (unsigned)__builtin_amdgcn_readlane(ivv, e_) * (unsigned)ROWB + (tb), 0); } while (0)
#define PX_U1(d_, b_) { const bf16x2_t r2_ = __builtin_amdgcn_cvt_scalef32_pk_bf16_fp4(wd_[d_], 1.0f, b_); if ((b_) & 1) a1_ = __builtin_amdgcn_fdot2_f32_bf16(r2_, __builtin_bit_cast(bf16x2_t, xpk[4 * (d_) + (b_)]), a1_, false); \
                        else a0_ = __builtin_amdgcn_fdot2_f32_bf16(r2_, __builtin_bit_cast(bf16x2_t, xpk[4 * (d_) + (b_)]), a0_, false); }
#define PX_V1(d_, b_) { const f32x2 t2_ = __builtin_amdgcn_cvt_scalef32_pk_f32_fp4(wd_[d_], 1.0f, b_); acc[8 * (d_) + 2 * (b_)] += wg_ * t2_.x; acc[8 * (d_) + 2 * (b_) + 1] += wg_ * t2_.y; }
#define PX_FETCH_TOKEN(r, XP, IV, GV) do { const u32x4* xp_ = (const u32x4*)(H2 + (size_t)(r) * DM + lane * 16); XP[0] = xp_[0]; XP[1] = xp_[1]; XP[2] = xp_[128]; XP[3] = xp_[129]; \
        IV = 0; GV = 0.f; if (lane < 16) { IV = IDX[(size_t)(r) * 128 + F.wave * 16 + lane]; GV = GATE[(size_t)(r) * 128 + F.wave * 16 + lane]; } } while (0)
    const bool skip_ctx = (OUT != nullptr);
    int row = F.vcu; if (skip_ctx && row < MROWS && row_cls(row) == 2) row += F.G;
    u32x4 xp[4]; int iv; float gv;
    u32x4 ub[16], vb[16];
    if (row < MROWS) { PX_FETCH_TOKEN(row, xp, iv, gv); PX_LOADALL(ub, iv, 0u); PX_LOADALL(vb, iv, voff_tab); }
    int par = 0;
    while (row < MROWS) {
        int nrow = row + F.G; if (skip_ctx && nrow < MROWS && row_cls(nrow) == 2) nrow += F.G;
        float usc = 0.f, vsc = 0.f;
        if (lane < 16) { usc = USC[iv]; vsc = VSC[iv]; }
        u32x4 xpn[4]; int ivn = 0; float gvn = 0.f;
        if (nrow < MROWS) PX_FETCH_TOKEN(nrow, xpn, ivn, gvn);
        const int cls = row_cls(row);
        const f32x4 x_old = *((const f32x4*)(XW + (size_t)row * DM) + F.tid), g_vec = *((const f32x4*)(g2 + (size_t)cls * NMOD) + F.tid);
        f32x4 n_g = {0.f, 0.f, 0.f, 0.f}, n_sc = n_g, n_sh = n_g;
        if (HN) { n_g = *((const f32x4*)ng + F.tid); n_sc = *((const f32x4*)(nmod + (size_t)cls * NMOD + 2048) + F.tid); n_sh = *((const f32x4*)(nmod + (size_t)cls * NMOD) + F.tid); }
        const unsigned xpk[16] = {xp[0].x, xp[0].y, xp[0].z, xp[0].w, xp[1].x, xp[1].y, xp[1].z, xp[1].w, xp[2].x, xp[2].y, xp[2].z, xp[2].w, xp[3].x, xp[3].y, xp[3].z, xp[3].w};
        float sv = 0.f;
        PX_SB();
#pragma unroll
        for (int e = 0; e < 16; ++e) {
            u32x4 w_ = ub[e]; asm volatile("" : "+v"(w_) : "v"(sv));
            const unsigned wd_[4] = {w_.x, w_.y, w_.z, w_.w}; float a0_ = 0.f, a1_ = 0.f;
            PX_U1(0, 0) PX_U1(0, 1) PX_U1(0, 2) PX_U1(0, 3) PX_U1(1, 0) PX_U1(1, 1) PX_U1(1, 2) PX_U1(1, 3) PX_U1(2, 0) PX_U1(2, 1) PX_U1(2, 2) PX_U1(2, 3) PX_U1(3, 0) PX_U1(3, 1) PX_U1(3, 2) PX_U1(3, 3)
            const float t_ = wave_sum_dpp(a0_ + a1_); sv = (lane == e) ? t_ : sv;
        }
        const float wv = gelu_erf(sv * usc) * gv * vsc;
        PX_SB();
        if (nrow < MROWS) PX_LOADALL(ub, ivn, 0u);
        PX_SB();
        f32x32 acc = {};
#pragma unroll
        for (int e = 0; e < 16; ++e) {
            u32x4 w_ = vb[e]; asm volatile("" : "+v"(w_) : "v"(acc));
            const unsigned wd_[4] = {w_.x, w_.y, w_.z, w_.w}; const float wg_ = __uint_as_float(__builtin_amdgcn_readlane(__float_as_uint(wv), e));
            PX_V1(0, 0) PX_V1(0, 1) PX_V1(0, 2) PX_V1(0, 3) PX_V1(1, 0) PX_V1(1, 1) PX_V1(1, 2) PX_V1(1, 3) PX_V1(2, 0) PX_V1(2, 1) PX_V1(2, 2) PX_V1(2, 3) PX_V1(3, 0) PX_V1(3, 1) PX_V1(3, 2) PX_V1(3, 3)
        }
        PX_SB();
        if (nrow < MROWS) PX_LOADALL(vb, ivn, voff_tab);
        PX_SB();
        LAS float* rb = red + par * (NWAVES * DM);
#pragma unroll
        for (int j = 0; j < 2; ++j)
#pragma unroll
            for (int q = 0; q < 4; ++q) *(LAS f32x4*)(rb + F.wave * DM + j * 1024 + lane * 16 + q * 4) = (f32x4){acc[j * 16 + q * 4], acc[j * 16 + q * 4 + 1], acc[j * 16 + q * 4 + 2], acc[j * 16 + q * 4 + 3]};
        __syncthreads();
        {
            f32x4 sm = {0.f, 0.f, 0.f, 0.f};
#pragma unroll
            for (int w = 0; w < 8; ++w) sm += *(const LAS f32x4*)(rb + w * DM + F.tid * 4);
            f32x4* xq = (f32x4*)(XW + (size_t)row * DM) + F.tid;
            const f32x4 xn = x_old + g_vec * sm;
            *xq = xn;
            if (OUT) { const int b = row / RB, i = row - b * RB; if (i >= CTX) *((f32x4*)(OUT + ((size_t)b * SEQ + (i - CTX)) * DM) + F.tid) = xn; }
            if (HN) {
                LAS float* ssp = (LAS float*)(F.lds + 131072) + par * 8;
                const float sw = wave_sum_dpp((xn.x * xn.x + xn.y * xn.y) + (xn.z * xn.z + xn.w * xn.w));
                if (lane == 0) ssp[F.wave] = sw;
                __syncthreads();
                const float tot = ((ssp[0] + ssp[1]) + (ssp[2] + ssp[3])) + ((ssp[4] + ssp[5]) + (ssp[6] + ssp[7]));
                const float rstd = 1.0f / sqrtf(tot * (1.f / DM) + EPS);
                const f32x4 y = (xn * rstd) * n_g * (n_sc + 1.0f) + n_sh;
                u32x2 o; o.x = pk2(y.x, y.y); o.y = pk2(y.z, y.w);
                *((u32x2*)(HN + (size_t)row * DM) + F.tid) = o;
            }
        }
        par ^= 1; row = nrow;
#pragma unroll
        for (int q = 0; q < 4; ++q) xp[q] = xpn[q];
        iv = ivn; gv = gvn;
    }
#undef PX_LOADALL
#undef PX_U1
#undef PX_V1
#undef PX_SB
#undef PX_FETCH_TOKEN
}
#else
__device__ __forceinline__ void peer_expert_phase(const Frame& F0, const bf16_t* H2, const int* IDX, const float* GATE, const unsigned char* U, size_t v_minus_u_bytes, const float* USC, const float* VSC,
                                                  const float* g2  , float* XW, float* OUT,
                                                  bf16_t* HN  , const float* ng  , const float* nmod  ) {
    const Frame F = phase_frame(F0);
    LAS float* red = (LAS float*)F.lds;
    const unsigned voff_tab = (unsigned)v_minus_u_bytes;
    const __amdgpu_buffer_rsrc_t rs = __builtin_amdgcn_make_buffer_rsrc((void*)U, 0, (int)(voff_tab + (unsigned)NEXP * ROWB), 0x00020000);
    const int lane = F.lane; const int voff = lane * 16, voff2 = 1024 + lane * 8;
#define PX_SB() __builtin_amdgcn_sched_barrier(0)
#define PX_LOAD(buf, s, ivv) do { constexpr int e0_ = ((s) & 3) * 4; const unsigned tb_ = ((s) >= 4) ? voff_tab : 0u; \
        _Pragma("unroll") for (int ee_ = 0; ee_ < 4; ++ee_) { const unsigned o_ = (unsigned)__builtin_amdgcn_readlane(ivv, e0_ + ee_) * (unsigned)ROWB + tb_; \
            buf##h[ee_] = __builtin_amdgcn_raw_buffer_load_b128(rs, voff, o_, 0); buf##l[ee_] = __builtin_amdgcn_raw_buffer_load_b64(rs, voff2, o_, 0); } } while (0)
#define PX_DECODE(buf, ee_, dep) u32x6 w6_ = {buf##h[ee_].x, buf##h[ee_].y, buf##h[ee_].z, buf##h[ee_].w, buf##l[ee_].x, buf##l[ee_].y}; \
        asm volatile("" : "+v"(w6_) : "v"(dep));     \
        const f32x32 r_ = __builtin_amdgcn_cvt_scalef32_pk32_f32_fp6(w6_, 1.0f);
#define PX_COMP_U(buf, s) do { constexpr int e0_ = ((s) & 3) * 4; \
            _Pragma("unroll") for (int ee_ = 0; ee_ < 4; ++ee_) { PX_DECODE(buf, ee_, sv) \
                const f32x32 p_ = r_ * xf; float a0_ = 0.f, a1_ = 0.f; \
                _Pragma("unroll") for (int k_ = 0; k_ < 32; k_ += 2) { a0_ += p_[k_]; a1_ += p_[k_ + 1]; } \
                const float t_ = wave_sum_dpp(a0_ + a1_); sv = (lane == e0_ + ee_) ? t_ : sv; } } while (0)
#define PX_COMP_V(buf, s) do { constexpr int e0_ = ((s) & 3) * 4; \
            _Pragma("unroll") for (int ee_ = 0; ee_ < 4; ++ee_) { const float wg_ = __uint_as_float(__builtin_amdgcn_readlane(__float_as_uint(wv), e0_ + ee_)); \
                PX_DECODE(buf, ee_, acc) \
                acc += r_ * wg_; } } while (0)
#define PX_FETCH_TOKEN(r, XP, IV, GV) do { const u32x4* xp_ = (const u32x4*)(H2 + (size_t)(r) * DM + lane * 16); XP[0] = xp_[0]; XP[1] = xp_[1]; XP[2] = xp_[128]; XP[3] = xp_[129]; \
        IV = 0; GV = 0.f; if (lane < 16) { IV = IDX[(size_t)(r) * 128 + F.wave * 16 + lane]; GV = GATE[(size_t)(r) * 128 + F.wave * 16 + lane]; } } while (0)
    const bool skip_ctx = (OUT != nullptr);
    int row = F.vcu; if (skip_ctx && row < MROWS && row_cls(row) == 2) row += F.G;
    u32x4 xp[4]; int iv; float gv;
    u32x4 bAh[4], bBh[4]; u32x2 bAl[4], bBl[4];
    if (row < MROWS) { PX_FETCH_TOKEN(row, xp, iv, gv); PX_LOAD(bA, 0, iv); }
    int par = 0;
    while (row < MROWS) {
        int nrow = row + F.G; if (skip_ctx && nrow < MROWS && row_cls(nrow) == 2) nrow += F.G;
        f32x32 xf;
#pragma unroll
        for (int q = 0; q < 4; ++q) { const unsigned ww[4] = {xp[q].x, xp[q].y, xp[q].z, xp[q].w};
#pragma unroll
            for (int k = 0; k < 4; ++k) { xf[q * 8 + 2 * k] = bf_lo(ww[k]); xf[q * 8 + 2 * k + 1] = bf_hi(ww[k]); } }
        float usc = 0.f, vsc = 0.f;
        if (lane < 16) { usc = USC[iv]; vsc = VSC[iv]; }
        u32x4 xpn[4]; int ivn = 0; float gvn = 0.f;
        if (nrow < MROWS) PX_FETCH_TOKEN(nrow, xpn, ivn, gvn);
        const int cls = row_cls(row);
        const f32x4 x_old = *((const f32x4*)(XW + (size_t)row * DM) + F.tid), g_vec = *((const f32x4*)(g2 + (size_t)cls * NMOD) + F.tid);
        f32x4 n_g = {0.f, 0.f, 0.f, 0.f}, n_sc = n_g, n_sh = n_g;
        if (HN) { n_g = *((const f32x4*)ng + F.tid); n_sc = *((const f32x4*)(nmod + (size_t)cls * NMOD + 2048) + F.tid); n_sh = *((const f32x4*)(nmod + (size_t)cls * NMOD) + F.tid); }
        float sv = 0.f, wv = 0.f;
        PX_LOAD(bB, 1, iv); PX_SB(); PX_COMP_U(bA, 0); PX_SB();
        PX_LOAD(bA, 2, iv); PX_SB(); PX_COMP_U(bB, 1); PX_SB();
        PX_LOAD(bB, 3, iv); PX_SB(); PX_COMP_U(bA, 2); PX_SB();
        PX_LOAD(bA, 4, iv); PX_SB(); PX_COMP_U(bB, 3); PX_SB();
        wv = gelu_erf(sv * usc) * gv * vsc;
        f32x32 acc = {};
        PX_LOAD(bB, 5, iv); PX_SB(); PX_COMP_V(bA, 4); PX_SB();
        PX_LOAD(bA, 6, iv); PX_SB(); PX_COMP_V(bB, 5); PX_SB();
        PX_LOAD(bB, 7, iv); PX_SB(); PX_COMP_V(bA, 6); PX_SB();
        if (nrow < MROWS) PX_LOAD(bA, 0, ivn);
        PX_SB(); PX_COMP_V(bB, 7); PX_SB();
        LAS float* rb = red + par * (NWAVES * DM);
#pragma unroll
        for (int j = 0; j < 2; ++j)
#pragma unroll
            for (int q = 0; q < 4; ++q) *(LAS f32x4*)(rb + F.wave * DM + j * 1024 + lane * 16 + q * 4) = (f32x4){acc[j * 16 + q * 4], acc[j * 16 + q * 4 + 1], acc[j * 16 + q * 4 + 2], acc[j * 16 + q * 4 + 3]};
        __syncthreads();
        {
            f32x4 sm = {0.f, 0.f, 0.f, 0.f};
#pragma unroll
            for (int w = 0; w < 8; ++w) sm += *(const LAS f32x4*)(rb + w * DM + F.tid * 4);
            f32x4* xq = (f32x4*)(XW + (size_t)row * DM) + F.tid;
            const f32x4 xn = x_old + g_vec * sm;
            *xq = xn;
            if (OUT) { const int b = row / RB, i = row - b * RB; if (i >= CTX) *((f32x4*)(OUT + ((size_t)b * SEQ + (i - CTX)) * DM) + F.tid) = xn; }
            if (HN) {
                LAS float* ssp = (LAS float*)(F.lds + 131072) + par * 8;
                const float sw = wave_sum_dpp((xn.x * xn.x + xn.y * xn.y) + (xn.z * xn.z + xn.w * xn.w));
                if (lane == 0) ssp[F.wave] = sw;
                __syncthreads();
                const float tot = ((ssp[0] + ssp[1]) + (ssp[2] + ssp[3])) + ((ssp[4] + ssp[5]) + (ssp[6] + ssp[7]));
                const float rstd = 1.0f / sqrtf(tot * (1.f / DM) + EPS);
                const f32x4 y = (xn * rstd) * n_g * (n_sc + 1.0f) + n_sh;
                u32x2 o; o.x = pk2(y.x, y.y); o.y = pk2(y.z, y.w);
                *((u32x2*)(HN + (size_t)row * DM) + F.tid) = o;
            }
        }
        par ^= 1; row = nrow;
#pragma unroll
        for (int q = 0; q < 4; ++q) xp[q] = xpn[q];
        iv = ivn; gv = gvn;
    }
#undef PX_LOAD
#undef PX_COMP_U
#undef PX_COMP_V
#undef PX_SB
#undef PX_FETCH_TOKEN
}
#endif

#if EXP_SLICED && TAB_FP4
__device__ __forceinline__ float oct_sum(float v) { v = DPP_ADD(v, 0xB1); v = DPP_ADD(v, 0x4E); v = DPP_ADD(v, 0x141); return v; }
__device__ __forceinline__ int sl_next_tok(int t, int stride, bool lat_only) { t += stride; if (lat_only) while (t < MROWS && row_cls(t) == 2) t += stride; return t; }
#ifndef PROBE_IDMASK
#define PROBE_IDMASK 0x7fffffff
#endif
#define SL_CL(t_) ((t_) < MROWS ? (t_) : MROWS - 1)
#define SL_IDS(t_, A_, B_) do { A_ = IDX[(size_t)(t_) * 128 + lane] & idmask; B_ = IDX[(size_t)(t_) * 128 + 64 + lane] & idmask; } while (0)
#define SL_ROWS(buf, A_, B_) do { _Pragma("unroll") for (int i_ = 0; i_ < 16; ++i_) { const int id_ = __builtin_amdgcn_ds_bpermute(bp + 32 * (i_ & 7), (i_ < 8) ? (A_) : (B_)); \
        buf[i_] = __builtin_amdgcn_raw_buffer_load_b128(rs, id_ * 128 + coloff, 0, 0); } } while (0)
#if PEER_MFMA
typedef int i32x8 __attribute__((ext_vector_type(8)));
__device__ __forceinline__ void peer_u_phase(const Frame& F0, const unsigned* XQ, const float* XS, const int* IDX, const unsigned char* U, float* PART, bool lat_only, int idmask = 0x7fffffff) {
    const Frame F = phase_frame(F0);
    const int lane = F.lane, n = lane & 15, kb = lane >> 4, bp = 4 * n;
    const int wps = F.G >> 3, x = F.vcu / wps, wi = (F.vcu - x * wps) * NWAVES + F.wave, stride = wps * NWAVES;
    const __amdgpu_buffer_rsrc_t rs = __builtin_amdgcn_make_buffer_rsrc((void*)(U + (size_t)x * (NEXP * 128)), 0, NEXP * 128, 0x00020000);
    const int coloff = 16 * kb;
    int t = wi - stride; t = sl_next_tok(t, stride, lat_only);
    int t1 = sl_next_tok(t, stride, lat_only), t2 = sl_next_tok(t1, stride, lat_only);
    int idA1 = 0, idB1 = 0, idA2 = 0, idB2 = 0, idA3 = 0, idB3 = 0; u32x4 xs[4], xs1[4], xs2[4], w[16], wn[16];
#define SL_XS(dst, t_) do { const u32x4* xp_ = (const u32x4*)((const unsigned char*)XQ + (size_t)(t_) * DM + 256 * x + 16 * kb); dst[0] = xp_[0]; dst[1] = xp_[4]; dst[2] = xp_[8]; dst[3] = xp_[12]; } while (0)
#define SL_UROWS(buf, A_, B_) do { _Pragma("unroll") for (int h_ = 0; h_ < 8; ++h_) { const int id_ = __builtin_amdgcn_ds_bpermute(bp + 64 * (h_ & 3), (h_ < 4) ? (A_) : (B_)); \
        buf[2 * h_] = __builtin_amdgcn_raw_buffer_load_b128(rs, id_ * 128 + coloff, 0, 0); buf[2 * h_ + 1] = __builtin_amdgcn_raw_buffer_load_b128(rs, id_ * 128 + coloff + 64, 0, 0); } } while (0)
    if (t < MROWS) { int idA0, idB0; SL_IDS(t, idA0, idB0); SL_XS(xs1, t); SL_UROWS(w, idA0, idB0); }
    if (t1 < MROWS) { SL_IDS(t1, idA2, idB2); SL_XS(xs2, t1); }
    if (t2 < MROWS) SL_IDS(t2, idA3, idB3);
#define SL_UBODY(CUR, NXT) do { \
        const int t3 = sl_next_tok(t2, stride, lat_only); \
_Pragma("unroll") \
        for (int q = 0; q < 4; ++q) { xs[q] = xs1[q]; xs1[q] = xs2[q]; } \
        idA1 = idA2; idB1 = idB2; idA2 = idA3; idB2 = idB3; \
        if (t1 < MROWS) SL_UROWS(NXT, idA1, idB1); \
        if (t2 < MROWS) SL_XS(xs2, t2); \
        if (t3 < MROWS) SL_IDS(t3, idA3, idB3); \
        const i32x8 a0 = {(int)xs[0].x, (int)xs[0].y, (int)xs[0].z, (int)xs[0].w, (int)xs[1].x, (int)xs[1].y, (int)xs[1].z, (int)xs[1].w}; \
        const i32x8 a1 = {(int)xs[2].x, (int)xs[2].y, (int)xs[2].z, (int)xs[2].w, (int)xs[3].x, (int)xs[3].y, (int)xs[3].z, (int)xs[3].w}; \
        float res_lo = 0.f, res_hi = 0.f; \
_Pragma("unroll") \
        for (int h = 0; h < 8; ++h) { \
            const i32x8 b0 = {(int)CUR[2 * h].x, (int)CUR[2 * h].y, (int)CUR[2 * h].z, (int)CUR[2 * h].w, 0, 0, 0, 0}; \
            const i32x8 b1 = {(int)CUR[2 * h + 1].x, (int)CUR[2 * h + 1].y, (int)CUR[2 * h + 1].z, (int)CUR[2 * h + 1].w, 0, 0, 0, 0}; \
            f32x4 d = {0.f, 0.f, 0.f, 0.f}; \
            d = __builtin_amdgcn_mfma_scale_f32_16x16x128_f8f6f4(a0, b0, d, 0, 4, 0, 0, 0, 0); \
            d = __builtin_amdgcn_mfma_scale_f32_16x16x128_f8f6f4(a1, b1, d, 0, 4, 0, 0, 0, 0); \
            if (h < 4) res_lo = (kb == h) ? d[0] : res_lo; else res_hi = (kb == h - 4) ? d[0] : res_hi; \
        } \
        float* pp = PART + ((size_t)t * 8 + x) * 128 + lane; \
        pp[0] = res_lo; pp[64] = res_hi; \
        t = t1; t1 = t2; t2 = t3; \
    } while (0)
    while (t < MROWS) { SL_UBODY(w, wn); if (!(t < MROWS)) break; SL_UBODY(wn, w); }
#undef SL_UBODY
#undef SL_UROWS
#undef SL_XS
}
#else
__device__ __forceinline__ void peer_u_phase(const Frame& F0, const unsigned* XQ, const float* XS, const int* IDX, const unsigned char* U, float* PART, bool lat_only, int idmask = 0x7fffffff) {
    const Frame F = phase_frame(F0);
    const int lane = F.lane, g = lane >> 3, j = lane & 7, bp = 4 * g;
    const int wps = F.G >> 3, x = F.vcu / wps, wi = (F.vcu - x * wps) * NWAVES + F.wave, stride = wps * NWAVES;
    const __amdgpu_buffer_rsrc_t rs = __builtin_amdgcn_make_buffer_rsrc((void*)(U + (size_t)x * (NEXP * 128)), 0, NEXP * 128, 0x00020000);
    const int coloff = 16 * j;
    int t = wi - stride; t = sl_next_tok(t, stride, lat_only);
    int t1 = sl_next_tok(t, stride, lat_only), t2 = sl_next_tok(t1, stride, lat_only);
    int idA1 = 0, idB1 = 0, idA2 = 0, idB2 = 0, idA3 = 0, idB3 = 0; u32x4 xs[3], xs1[3], xs2[3], w[16], wn[16];
#define SL_XS(dst, t_) do { const u32x4* xp_ = (const u32x4*)(XQ + ((size_t)(t_) * 64 + 8 * x + j) * 8); dst[0] = xp_[0]; dst[1] = xp_[1]; const f32x2 s2_ = *(const f32x2*)(XS + ((size_t)(t_) * 64 + 8 * x + j) * 2); dst[2] = (u32x4){__float_as_uint(s2_.x), __float_as_uint(s2_.y), 0u, 0u}; } while (0)
    { int idA0, idB0; const int c0_ = SL_CL(t), c1_ = SL_CL(t1), c2_ = SL_CL(t2); SL_IDS(c0_, idA0, idB0); SL_XS(xs1, c0_); SL_ROWS(w, idA0, idB0); SL_IDS(c1_, idA2, idB2); SL_XS(xs2, c1_); SL_IDS(c2_, idA3, idB3); }
#define SL_UBODY(CUR, NXT) do { \
        const int t3 = sl_next_tok(t2, stride, lat_only); \
_Pragma("unroll") \
        for (int q = 0; q < 3; ++q) { xs[q] = xs1[q]; xs1[q] = xs2[q]; } \
        idA1 = idA2; idB1 = idB2; idA2 = idA3; idB2 = idB3; \
        SL_ROWS(NXT, idA1, idB1); \
        { const int c2_ = SL_CL(t2), c3_ = SL_CL(t3); SL_XS(xs2, c2_); SL_IDS(c3_, idA3, idB3); } \
        const int xh[4] = {(int)xs[0].x, (int)xs[0].y, (int)xs[0].z, (int)xs[0].w}, xl[4] = {(int)xs[1].x, (int)xs[1].y, (int)xs[1].z, (int)xs[1].w}; \
        const float dq = __uint_as_float(xs[2].x), off = __uint_as_float(xs[2].y); \
        float res_lo = 0.f, res_hi = 0.f; \
_Pragma("unroll") \
        for (int i = 0; i < 16; ++i) { \
            const int wd_[4] = {(int)CUR[i].x, (int)CUR[i].y, (int)CUR[i].z, (int)CUR[i].w}; int ah_ = 0, al_ = 0; \
_Pragma("unroll") \
            for (int d = 0; d < 4; ++d) { ah_ = __builtin_amdgcn_sdot8(wd_[d], xh[d], ah_, false); al_ = __builtin_amdgcn_sdot8(wd_[d], xl[d], al_, false); } \
            const float a_ = oct_sum(((float)(16 * ah_ + al_) + off) * dq); \
            if (i < 8) res_lo = (j == i) ? a_ : res_lo; else res_hi = (j == i - 8) ? a_ : res_hi; \
        } \
        float* pp = PART + ((size_t)t * 8 + x) * 128 + 8 * j + g; \
        pp[0] = res_lo; pp[64] = res_hi; \
        t = t1; t1 = t2; t2 = t3; \
    } while (0)
    while (t < MROWS) { SL_UBODY(w, wn); if (!(t < MROWS)) break; SL_UBODY(wn, w); }
#undef SL_UBODY
#undef SL_XS
}
#endif
#if PEER_VMFMA
typedef int i32x8v __attribute__((ext_vector_type(8)));
typedef int i32x2v __attribute__((ext_vector_type(2)));
__device__ __forceinline__ float wave_max_dpp(float v) {
    v = fmaxf(v, DPP_MOV(v, 0xB1)); v = fmaxf(v, DPP_MOV(v, 0x4E)); v = fmaxf(v, DPP_MOV(v, 0x141)); v = fmaxf(v, DPP_MOV(v, 0x140));
    const int vi = __builtin_bit_cast(int, v);
    return fmaxf(fmaxf(__builtin_bit_cast(float, __builtin_amdgcn_readlane(vi, 0)), __builtin_bit_cast(float, __builtin_amdgcn_readlane(vi, 16))),
                 fmaxf(__builtin_bit_cast(float, __builtin_amdgcn_readlane(vi, 32)), __builtin_bit_cast(float, __builtin_amdgcn_readlane(vi, 48))));
}
__device__ __forceinline__ void peer_wq_phase(const Frame& F0, const float* PART, const int* IDX, const float* GATE, const float* USC, const float* VSC, bool lat_only, unsigned char* WQ8, float* WSC) {
    const Frame F = phase_frame(F0);
    const int lane = F.lane;
    for (int t0 = F.gw; t0 < MROWS; t0 += 2 * F.NGW) {
        float s[2][2]; int id[2][2]; float gt[2][2]; bool ok[2];
#pragma unroll
        for (int u = 0; u < 2; ++u) { const int t = t0 + u * F.NGW; ok[u] = t < MROWS && !(lat_only && row_cls(t) == 2);
            s[u][0] = s[u][1] = 0.f; id[u][0] = id[u][1] = 0; gt[u][0] = gt[u][1] = 0.f;
            if (ok[u]) { const float* pp = PART + (size_t)t * 1024 + lane;
#pragma unroll
                for (int xx = 0; xx < 8; ++xx) { s[u][0] += pp[xx * 128]; s[u][1] += pp[xx * 128 + 64]; }
                id[u][0] = IDX[(size_t)t * 128 + lane]; id[u][1] = IDX[(size_t)t * 128 + 64 + lane]; gt[u][0] = GATE[(size_t)t * 128 + lane]; gt[u][1] = GATE[(size_t)t * 128 + 64 + lane]; } }
        float us[2][2], vs[2][2];
#pragma unroll
        for (int u = 0; u < 2; ++u)
#pragma unroll
            for (int q = 0; q < 2; ++q) { us[u][q] = ok[u] ? USC[id[u][q]] : 0.f; vs[u][q] = ok[u] ? VSC[id[u][q]] : 0.f; }
#pragma unroll
        for (int u = 0; u < 2; ++u) if (ok[u]) { const int t = t0 + u * F.NGW;
            const float w0 = gt[u][0] * gelu_erf(s[u][0] * us[u][0]) * vs[u][0], w1 = gt[u][1] * gelu_erf(s[u][1] * us[u][1]) * vs[u][1];
            const float am = fmaxf(wave_max_dpp(fmaxf(fabsf(w0), fabsf(w1))), 1e-30f), qs = 440.0f / am;
            const int pk = __builtin_amdgcn_cvt_pk_fp8_f32(w0 * qs, w1 * qs, 0, false);
            WQ8[(size_t)t * 128 + lane] = (unsigned char)(pk & 0xff); WQ8[(size_t)t * 128 + 64 + lane] = (unsigned char)((pk >> 8) & 0xff);
            if (lane == 0) WSC[t] = am * (1.0f / 440.0f); }
    }
}
__device__ __forceinline__ void peer_v_phase(const Frame& F0, const int* IDX, const unsigned char* WQ8, const float* WSC, const unsigned char* VT, const float* g2  , float* XW, float* OUT, bool lat_only) {
    const int idmask = 0x7fffffff;
    const Frame F = phase_frame(F0);
    const int lane = F.lane, g = lane >> 3, j = lane & 7, bp = 4 * g, n = lane & 15, kb = lane >> 4;
    const int wps = F.G >> 3, x = F.vcu / wps, wi = (F.vcu - x * wps) * NWAVES + F.wave, stride = wps * NWAVES;
    const __amdgpu_buffer_rsrc_t rs = __builtin_amdgcn_make_buffer_rsrc((void*)(VT + (size_t)x * (NEXP * 128)), 0, NEXP * 128, 0x00020000);
    const int coloff = 16 * j;
    LAS unsigned char* const lbase = F.lds + F.wave * 16384;
    LAS unsigned char* const wr_even = lbase + g * 128 + ((j ^ (g >> 1)) << 4);
    LAS unsigned char* const wr_odd = lbase + g * 128 + ((j ^ (g >> 1) ^ 4) << 4);
    LAS unsigned char* const rd_row = lbase + (32 * kb + n) * 128;
    const int rsw = (n >> 1) << 4;
    const int col0 = 256 * x + lane;
    int t = wi - stride; t = sl_next_tok(t, stride, lat_only);
    int t1 = sl_next_tok(t, stride, lat_only), t2 = sl_next_tok(t1, stride, lat_only);
    int idA1 = 0, idB1 = 0, idA2 = 0, idB2 = 0, idA3 = 0, idB3 = 0; u32x4 w[16], wn[16];
    u32x4 wa[2], wa1[2], wa2[2]; float sc = 0.f, sc1 = 0.f, sc2 = 0.f;
    float xo[4], gv[4], xo1[4], gv1[4], xo2[4], gv2[4];
#pragma unroll
    for (int q = 0; q < 4; ++q) { xo[q] = gv[q] = xo1[q] = gv1[q] = xo2[q] = gv2[q] = 0.f; }
    wa[0] = wa[1] = wa1[0] = wa1[1] = wa2[0] = wa2[1] = (u32x4){0u, 0u, 0u, 0u};
#define SL_WA(dst, S_, t_) do { const u32x4* wp_ = (const u32x4*)(WQ8 + (size_t)(t_) * 128 + 16 * kb); dst[0] = wp_[0]; dst[1] = wp_[4]; S_ = WSC[t_]; } while (0)
#define SL_XG(t_, X_, G_) do { const float* xp_ = XW + (size_t)(t_) * DM + col0; const float* gp_ = g2 + (size_t)row_cls(t_) * NMOD + col0; _Pragma("unroll") for (int q_ = 0; q_ < 4; ++q_) { X_[q_] = xp_[64 * q_]; G_[q_] = gp_[64 * q_]; } } while (0)
    { int idA0, idB0; const int c0_ = SL_CL(t), c1_ = SL_CL(t1), c2_ = SL_CL(t2); SL_IDS(c0_, idA0, idB0); SL_WA(wa1, sc1, c0_); SL_XG(c0_, xo1, gv1); SL_ROWS(w, idA0, idB0);
      SL_IDS(c1_, idA2, idB2); SL_WA(wa2, sc2, c1_); SL_XG(c1_, xo2, gv2); SL_IDS(c2_, idA3, idB3); }
#define SL_VBODY(CUR, NXT) do { \
        const int t3 = sl_next_tok(t2, stride, lat_only); \
        wa[0] = wa1[0]; wa[1] = wa1[1]; wa1[0] = wa2[0]; wa1[1] = wa2[1]; sc = sc1; sc1 = sc2; \
_Pragma("unroll") \
        for (int q = 0; q < 4; ++q) { xo[q] = xo1[q]; gv[q] = gv1[q]; xo1[q] = xo2[q]; gv1[q] = gv2[q]; } \
        idA1 = idA2; idB1 = idB2; idA2 = idA3; idB2 = idB3; \
        SL_ROWS(NXT, idA1, idB1); \
        { const int c2_ = SL_CL(t2), c3_ = SL_CL(t3); SL_WA(wa2, sc2, c2_); SL_XG(c2_, xo2, gv2); SL_IDS(c3_, idA3, idB3); } \
_Pragma("unroll") \
        for (int i = 0; i < 16; ++i) *(LAS u32x4*)(((i & 1) ? wr_odd : wr_even) + i * 1024) = CUR[i]; \
        const i32x8v a = {(int)wa[0].x, (int)wa[0].y, (int)wa[0].z, (int)wa[0].w, (int)wa[1].x, (int)wa[1].y, (int)wa[1].z, (int)wa[1].w}; \
        float vs[4] = {0.f, 0.f, 0.f, 0.f}; \
_Pragma("unroll") \
        for (int cb = 0; cb < 16; ++cb) { \
            LAS unsigned char* ra_ = rd_row + ((((cb >> 1) << 4) ^ rsw) + ((cb & 1) << 3)); \
            const i32x2v lo_ = __builtin_amdgcn_ds_read_tr4_b64_v2i32((LAS i32x2v*)ra_), hi_ = __builtin_amdgcn_ds_read_tr4_b64_v2i32((LAS i32x2v*)(ra_ + 2048)); \
            const i32x8v b_ = {lo_.x, lo_.y, hi_.x, hi_.y, 0, 0, 0, 0}; \
            const f32x4 z_ = {0.f, 0.f, 0.f, 0.f}; \
            const f32x4 d_ = __builtin_amdgcn_mfma_scale_f32_16x16x128_f8f6f4(a, b_, z_, 0, 4, 0, 0, 0, 0); \
            vs[cb >> 2] = (kb == (cb & 3)) ? d_[0] : vs[cb >> 2]; \
        } \
        { const int b = t / RB, i = t - b * RB; \
_Pragma("unroll") \
          for (int q = 0; q < 4; ++q) { const float xn = xo[q] + gv[q] * (sc * vs[q]); XW[(size_t)t * DM + col0 + 64 * q] = xn; \
              if (OUT) { if (i >= CTX) OUT[((size_t)b * SEQ + (i - CTX)) * DM + col0 + 64 * q] = xn; } } } \
        t = t1; t1 = t2; t2 = t3; \
    } while (0)
    while (t < MROWS) { SL_VBODY(w, wn); if (!(t < MROWS)) break; SL_VBODY(wn, w); }
#undef SL_VBODY
#undef SL_WA
#undef SL_XG
}
#else
__device__ __forceinline__ void peer_w_phase(const Frame& F0, const float* PART, const int* IDX, float* GATE, const float* USC, const float* VSC, bool lat_only, const float* XS = nullptr) {
    const Frame F = phase_frame(F0);
    const int gt = F.vcu * NTHREADS + F.tid, GT = F.G * NTHREADS;
    for (int e0 = gt; e0 < MROWS * 128; e0 += 4 * GT) {
        float s[4]; int id[4]; float gte[4], us[4], vs[4]; bool ok[4];
#pragma unroll
        for (int u = 0; u < 4; ++u) { const int e = e0 + u * GT; ok[u] = e < MROWS * 128 && !(lat_only && row_cls(e >> 7) == 2); s[u] = 0.f; id[u] = 0; gte[u] = 0.f;
            if (ok[u]) { const float* pp = PART + (size_t)(e >> 7) * 1024 + (e & 127);
#pragma unroll
                for (int xx = 0; xx < 8; ++xx) s[u] += pp[xx * 128];
                id[u] = IDX[e]; gte[u] = GATE[e]; } }
#pragma unroll
        for (int u = 0; u < 4; ++u) { us[u] = ok[u] ? USC[id[u]] : 0.f; vs[u] = ok[u] ? VSC[id[u]] : 0.f;
#if PEER_MFMA
            if (ok[u]) us[u] *= XS[(e0 + u * GT) >> 7];
#endif
        }
#pragma unroll
        for (int u = 0; u < 4; ++u) if (ok[u]) GATE[e0 + u * GT] = gte[u] * gelu_erf(s[u] * us[u]) * vs[u];
    }
}
#ifdef SELFTEST
#define SELFTEST_LEAK * (1.0f + sqrtf(*(const volatile float*)((const unsigned char*)XW - WS_XW + WS_CTL + 32768)))
#define SELFTEST_SPIKE do { if (b == 0 && i == CTX && mycol == 0) xo_.x += *(const volatile float*)((const unsigned char*)XW - WS_XW + WS_CTL + 32772); } while (0)
#else
#define SELFTEST_LEAK
#define SELFTEST_SPIKE do {} while (0)
#endif
__device__ __forceinline__ void peer_v_phase(const Frame& F0, const int* IDX, const float* WK, const unsigned char* VT, const float* g2  , float* XW, float* OUT, bool lat_only) {
    const int idmask = 0x7fffffff;
    const Frame F = phase_frame(F0);
    const int lane = F.lane, g = lane >> 3, j = lane & 7, bp = 4 * g;
    const int wps = F.G >> 3, x = F.vcu / wps, wi = (F.vcu - x * wps) * NWAVES + F.wave, stride = wps * NWAVES;
    const __amdgpu_buffer_rsrc_t rs = __builtin_amdgcn_make_buffer_rsrc((void*)(VT + (size_t)x * (NEXP * 128)), 0, NEXP * 128, 0x00020000);
    const int coloff = 16 * j;
    const int mycol = 256 * x + 32 * j + 4 * g;
    int t = wi - stride; t = sl_next_tok(t, stride, lat_only);
    int t1 = sl_next_tok(t, stride, lat_only), t2 = sl_next_tok(t1, stride, lat_only);
    int idA1 = 0, idB1 = 0, idA2 = 0, idB2 = 0, idA3 = 0, idB3 = 0; float wA = 0.f, wB = 0.f, wA1 = 0.f, wB1 = 0.f, wA2 = 0.f, wB2 = 0.f; u32x4 w[16], wn[16];
    f32x4 x_old = {0.f, 0.f, 0.f, 0.f}, g_vec = x_old, xo1 = x_old, gv1 = x_old, xo2 = x_old, gv2 = x_old;
#define SL_WK(t_, A_, B_) do { A_ = WK[(size_t)(t_) * 128 + lane]; B_ = WK[(size_t)(t_) * 128 + 64 + lane]; } while (0)
#define SL_XG(t_, X_, G_) do { X_ = *(const f32x4*)(XW + (size_t)(t_) * DM + mycol); G_ = *(const f32x4*)(g2 + (size_t)row_cls(t_) * NMOD + mycol); } while (0)
    if (t < MROWS) { int idA0, idB0; SL_IDS(t, idA0, idB0); SL_WK(t, wA1, wB1); SL_XG(t, xo1, gv1); SL_ROWS(w, idA0, idB0); }
    if (t1 < MROWS) { SL_IDS(t1, idA2, idB2); SL_WK(t1, wA2, wB2); SL_XG(t1, xo2, gv2); }
    if (t2 < MROWS) SL_IDS(t2, idA3, idB3);
#define SL_V1(d_, b_) { const h2_t r2_ = __builtin_amdgcn_cvt_scalef32_pk_f16_fp4(wd_[d_], 1.0f, b_); acc[4 * (d_) + (b_)] = __builtin_elementwise_fma(r2_, wg2_, acc[4 * (d_) + (b_)]); }
#define SL_VBODY(CUR, NXT) do { \
        const int t3 = sl_next_tok(t2, stride, lat_only); \
        wA = wA1; wB = wB1; wA1 = wA2; wB1 = wB2; x_old = xo1; g_vec = gv1; xo1 = xo2; gv1 = gv2; \
        idA1 = idA2; idB1 = idB2; idA2 = idA3; idB2 = idB3; \
        if (t1 < MROWS) SL_ROWS(NXT, idA1, idB1); \
        if (t2 < MROWS) { SL_WK(t2, wA2, wB2); SL_XG(t2, xo2, gv2); } \
        if (t3 < MROWS) SL_IDS(t3, idA3, idB3); \
        h2_t acc[16]; \
_Pragma("unroll") \
        for (int p = 0; p < 16; ++p) acc[p] = (h2_t){(_Float16)0.f, (_Float16)0.f}; \
_Pragma("unroll") \
        for (int i = 0; i < 16; ++i) { \
            const unsigned wd_[4] = {CUR[i].x, CUR[i].y, CUR[i].z, CUR[i].w}; \
            const float wgf_ = __int_as_float(__builtin_amdgcn_ds_bpermute(bp + 32 * (i & 7), __float_as_int((i < 8) ? wA : wB))); \
            const _Float16 wgh_ = (_Float16)wgf_; const h2_t wg2_ = {wgh_, wgh_}; \
            SL_V1(0, 0) SL_V1(0, 1) SL_V1(0, 2) SL_V1(0, 3) SL_V1(1, 0) SL_V1(1, 1) SL_V1(1, 2) SL_V1(1, 3) SL_V1(2, 0) SL_V1(2, 1) SL_V1(2, 2) SL_V1(2, 3) SL_V1(3, 0) SL_V1(3, 1) SL_V1(3, 2) SL_V1(3, 3) \
        } \
        unsigned m0 = 0u, m1 = 0u; \
_Pragma("unroll") \
        for (int p = 0; p < 16; ++p) { \
            h2_t v = acc[p]; \
            v = v + __builtin_bit_cast(h2_t, __builtin_amdgcn_update_dpp(0, __builtin_bit_cast(int, v), 0x128, 0xf, 0xf, true)); \
            { auto r = __builtin_amdgcn_permlane16_swap(__builtin_bit_cast(unsigned, v), __builtin_bit_cast(unsigned, v), false, false); v = __builtin_bit_cast(h2_t, (unsigned)r[0]) + __builtin_bit_cast(h2_t, (unsigned)r[1]); } \
            { auto r = __builtin_amdgcn_permlane32_swap(__builtin_bit_cast(unsigned, v), __builtin_bit_cast(unsigned, v), false, false); v = __builtin_bit_cast(h2_t, (unsigned)r[0]) + __builtin_bit_cast(h2_t, (unsigned)r[1]); } \
            if (g == (p >> 1)) { if (p & 1) m1 = __builtin_bit_cast(unsigned, v); else m0 = __builtin_bit_cast(unsigned, v); } \
        } \
        const h2_t q0 = __builtin_bit_cast(h2_t, m0), q1 = __builtin_bit_cast(h2_t, m1); \
        const f32x4 mine = {(float)q0.x, (float)q0.y, (float)q1.x, (float)q1.y}; \
        const f32x4 xn = x_old + g_vec * mine; \
        *(f32x4*)(XW + (size_t)t * DM + mycol) = xn; \
        if (OUT) { const int b = t / RB, i = t - b * RB; if (i >= CTX) { f32x4 xo_ = xn SELFTEST_LEAK; SELFTEST_SPIKE; *(f32x4*)(OUT + ((size_t)b * SEQ + (i - CTX)) * DM + mycol) = xo_; } } \
        t = t1; t1 = t2; t2 = t3; \
    } while (0)
    while (t < MROWS) { SL_VBODY(w, wn); if (!(t < MROWS)) break; SL_VBODY(wn, w); }
#undef SL_VBODY
#undef SL_V1
#undef SL_WK
#undef SL_XG
}
#endif
#undef SL_IDS
#undef SL_ROWS
#undef SL_CL
#endif
#ifndef N_LAUNCHES
#define N_LAUNCHES 1
#endif
struct Args { const float* in[26]; float* out; unsigned char* ws; int ph_lo, ph_hi; };
constexpr int NPHASES = 39;
__global__ void __launch_bounds__(NTHREADS, 2) fwd_kernel(Args args) {
    extern __shared__ __attribute__((aligned(16))) unsigned char lds_raw[];
    Frame F_;
    F_.lds = (LAS unsigned char*)lds_raw;
    F_.tid = threadIdx.x; F_.lane = F_.tid & 63; F_.wave = __builtin_amdgcn_readfirstlane(F_.tid >> 6);
    F_.G = gridDim.x; { const int bx = blockIdx.x; F_.vcu = (F_.G % 8 == 0) ? (bx % 8) * (F_.G / 8) + bx / 8 : bx; }
    F_.gw = F_.vcu * NWAVES + F_.wave; F_.NGW = F_.G * NWAVES;
    F_.ws = args.ws;
    volatile LAS unsigned* MISC = (volatile LAS unsigned*)(F_.lds + LDS_MISC);
    if (F_.tid < 32) MISC[F_.tid] = 0u;
    __syncthreads();
    const int lo = args.ph_lo, hi = args.ph_hi;
    XcdBarrier bar; bar.bar = (unsigned*)(args.ws + WS_CTL) + CW_BAR; bar.x = 0; bar.st = nullptr;
    if (N_LAUNCHES == 1 || hi - lo > 1) bar = xcd_barrier_post((unsigned*)(args.ws + WS_CTL) + CW_BAR, MISC + 8);
#if N_LAUNCHES == 1
#define IN(k) true
#define SEAM(k) xcd_barrier(bar)
#else
#define IN(k) (lo <= (k) && (k) < hi)
#define SEAM(k) do { if (IN(k) && IN((k) + 1)) xcd_barrier(bar); } while (0)
#endif
    PG8_LAS unsigned char* glds = (PG8_LAS unsigned char*)lds_raw;

    if (IN(0)) { p0_prologue(F_, args.in); } SEAM(0);

#pragma unroll 1
    for (int lp = 0; lp < 2; ++lp) {
        const int pb = 1 + lp * 19;
        unsigned char* ws = args.ws; asm volatile("" : "+s"(ws));
        Frame F = F_; { int w_ = F_.wave, v_ = F_.vcu, g_ = F_.G; asm volatile("" : "+s"(w_), "+s"(v_), "+s"(g_)); F.wave = w_; F.vcu = v_; F.G = g_; F.gw = v_ * NWAVES + w_; F.NGW = g_ * NWAVES; F.ws = ws; }
        float* mod = (float*)(ws + WS_MOD); float* XW = (float*)(ws + WS_XW);
        bf16_t* H = (bf16_t*)(ws + WS_H); bf16_t* P = (bf16_t*)(ws + WS_P); bf16_t* QRAW = (bf16_t*)(ws + WS_QRAW); bf16_t* KVRAW = (bf16_t*)(ws + WS_KVRAW);
        bf16_t* Q = (bf16_t*)(ws + WS_Q); bf16_t* KB = (bf16_t*)(ws + WS_K); bf16_t* VB = (bf16_t*)(ws + WS_V); bf16_t* CAT = (bf16_t*)(ws + WS_CAT); bf16_t* PQ = (bf16_t*)(ws + WS_PQ);
        int* IDX = (int*)(ws + WS_IDX); float* GATE = (float*)(ws + WS_GATE);
        const float* rope_c = (const float*)(ws + WS_ROPE); const float* rope_a = rope_c + 64 * 32 * 2;
        const float* SMv = (const float*)(ws + WS_SMALL);
        {
            const int l = 2 * lp, i = lp;
            const float* modl = mod + (size_t)l * 3 * NMOD;
            if (lp == 0) { if (IN(pb + 0)) { norm_phase(F, XW, SMv + SM_N1G + l * DM, modl, 0, 2048, H, false); } SEAM(pb + 0); }
            if (IN(pb + 1)) {
                pg8::Gemm g{H, (const bf16_t*)(ws + WS_WIN) + (size_t)i * 4096 * DM, MROWS, 4096, DM, DM, DM}; pg8::StaticOrder S; S.init(MROWS, 4096, F.G, (int)blockIdx.x);
                pg8::EpiBf16 E{P, 4096};
                pg8::gemm_phase<pg8::EpiBf16, pg8::StaticOrder, true, true>(glds, g, S, E, phase_tid(F.wave));
            } SEAM(pb + 1);
            if (IN(pb + 2)) {
                { pg8::Gemm g{P, (const bf16_t*)(ws + WS_WUQ) + (size_t)i * 1536 * 512, MROWS, 1536, 512, 4096, 512}; pg8::StaticOrder S; S.init(MROWS, 1536, F.G, (int)blockIdx.x);
                  pg8::EpiBf16 E{QRAW, 1536};
                  pg8::gemm_phase<pg8::EpiBf16, pg8::StaticOrder, true, true>(glds, g, S, E, phase_tid(F.wave)); }
                __syncthreads();
                { pg8::Gemm g{P + 512, (const bf16_t*)(ws + WS_WUKV) + (size_t)i * 2048 * 256, MROWS, 2048, 256, 4096, 256}; pg8::StaticOrder S; S.init(MROWS, 2048, F.G, (int)blockIdx.x);
                  pg8::EpiBf16 E{KVRAW, 2048};
                  pg8::gemm_phase<pg8::EpiBf16, pg8::StaticOrder, true, true>(glds, g, S, E, phase_tid(F.wave)); }
                __syncthreads();
                conv_phase(F, P, SMv + SM_CW + i * 3072, SMv + SM_CB + i * 1024, CAT);
            } SEAM(pb + 2);
            if (IN(pb + 3)) { prep_even_phase(F, P, QRAW, KVRAW, SMv + SM_AQG + i * 192, SMv + SM_AKG + i * 192, rope_a, Q, KB, VB); } SEAM(pb + 3);
            if (IN(pb + 4)) { attn_even_phase(F, Q, KB, VB, CAT); } SEAM(pb + 4);
            if (IN(pb + 5)) {
                pg8::Gemm g{CAT, (const bf16_t*)(ws + WS_WEO) + (size_t)i * DM * DM, MROWS, DM, DM, DM, DM}; pg8::StaticOrder S; S.init(MROWS, DM, F.G, (int)blockIdx.x);
                pg8::EpiResid E{XW, DM, modl + 4096};
                pg8::gemm_phase<pg8::EpiResid, pg8::StaticOrder, true, true>(glds, g, S, E, phase_tid(F.wave));
            } SEAM(pb + 5);
            if (IN(pb + 6)) { norm_phase(F, XW, SMv + SM_N2G + l * DM, modl, 6144, 8192, H, l == 3, (unsigned*)(ws + WS_XQ), (float*)(ws + WS_XS)); } SEAM(pb + 6);
            if (IN(pb + 7)) {
                pg8::Gemm g{H, (const bf16_t*)(ws + WS_WPQ) + (size_t)l * DM * DM, MROWS, DM, DM, DM, DM}; pg8::StaticOrder S; S.init(MROWS, DM, F.G, (int)blockIdx.x);
                pg8::EpiBf16 E{PQ, DM};
                pg8::gemm_phase<pg8::EpiBf16, pg8::StaticOrder, true, true>(glds, g, S, E, phase_tid(F.wave));
            } SEAM(pb + 7);
            if (IN(pb + 8)) { peer_topk_phase(F, PQ, (const bf16_t*)(ws + WS_SUBK) + (size_t)l * 16 * 128 * 128, IDX, GATE, l == 3); } SEAM(pb + 8);
            {
                const unsigned char* Ut = ws + WS_U + (size_t)l * NEXP * ROWB; const unsigned char* Vt = ws + WS_VT + (size_t)l * NEXP * ROWB;
                peer_u_phase(F, (const unsigned*)(ws + WS_XQ), (const float*)(ws + WS_XS), IDX, Ut, (float*)(ws + WS_PART), false); SEAM(0);
                peer_wq_phase(F, (const float*)(ws + WS_PART), IDX, GATE, (const float*)(ws + WS_USC) + l * NEXP, (const float*)(ws + WS_VSC) + l * NEXP, false, ws + WS_WQ8, (float*)(ws + WS_WSC)); SEAM(0);
                peer_v_phase(F, IDX, ws + WS_WQ8, (const float*)(ws + WS_WSC), Vt, modl + 10240, XW, nullptr, false); SEAM(0);
                norm_phase(F, XW, SMv + SM_N1G + (l + 1) * DM, mod + (size_t)(l + 1) * 3 * NMOD, 0, 2048, H, false); SEAM(0);
            }
        }
        {
            const int l = 2 * lp + 1, i = lp, qb = pb + 10;
            const float* modl = mod + (size_t)l * 3 * NMOD;
            if (IN(qb + 1)) {
                pg8::Gemm g{H, (const bf16_t*)(ws + WS_WQKV) + (size_t)i * 3072 * DM, MROWS, 3072, DM, DM, DM}; pg8::StaticOrder S; S.init(MROWS, 3072, F.G, (int)blockIdx.x);
                pg8::EpiBf16 E{P, 3072};
                pg8::gemm_phase<pg8::EpiBf16, pg8::StaticOrder, true, true>(glds, g, S, E, phase_tid(F.wave));
            } SEAM(qb + 1);
            if (IN(qb + 2)) { prep_odd_phase(F, P, SMv + SM_CQG + i * 128, SMv + SM_CKG + i * 128, rope_c, Q, KB); } SEAM(qb + 2);
            if (IN(qb + 3)) { attn_odd_phase(F, Q, KB, P, CAT, l == 3); } SEAM(qb + 3);
            if (IN(qb + 4)) {
                pg8::Gemm g{CAT, (const bf16_t*)(ws + WS_WCO) + (size_t)i * DM * DM, MROWS, DM, DM, DM, DM}; pg8::StaticOrder S; S.init(MROWS, DM, F.G, (int)blockIdx.x, l == 3);
                pg8::EpiResid E{XW, DM, modl + 4096};
                pg8::gemm_phase<pg8::EpiResid, pg8::StaticOrder, true, true>(glds, g, S, E, phase_tid(F.wave));
            } SEAM(qb + 4);
            if (IN(qb + 5)) { norm_phase(F, XW, SMv + SM_N2G + l * DM, modl, 6144, 8192, H, l == 3, (unsigned*)(ws + WS_XQ), (float*)(ws + WS_XS)); } SEAM(qb + 5);
            if (IN(qb + 6)) {
                pg8::Gemm g{H, (const bf16_t*)(ws + WS_WPQ) + (size_t)l * DM * DM, MROWS, DM, DM, DM, DM}; pg8::StaticOrder S; S.init(MROWS, DM, F.G, (int)blockIdx.x, l == 3);
                pg8::EpiBf16 E{PQ, DM};
                pg8::gemm_phase<pg8::EpiBf16, pg8::StaticOrder, true, true>(glds, g, S, E, phase_tid(F.wave));
            } SEAM(qb + 6);
            if (IN(qb + 7)) { peer_topk_phase(F, PQ, (const bf16_t*)(ws + WS_SUBK) + (size_t)l * 16 * 128 * 128, IDX, GATE, l == 3); } SEAM(qb + 7);
            {
                const unsigned char* Ut = ws + WS_U + (size_t)l * NEXP * ROWB; const unsigned char* Vt = ws + WS_VT + (size_t)l * NEXP * ROWB;
                peer_u_phase(F, (const unsigned*)(ws + WS_XQ), (const float*)(ws + WS_XS), IDX, Ut, (float*)(ws + WS_PART), l == 3); SEAM(0);
                peer_wq_phase(F, (const float*)(ws + WS_PART), IDX, GATE, (const float*)(ws + WS_USC) + l * NEXP, (const float*)(ws + WS_VSC) + l * NEXP, l == 3, ws + WS_WQ8, (float*)(ws + WS_WSC)); SEAM(0);
                peer_v_phase(F, IDX, ws + WS_WQ8, (const float*)(ws + WS_WSC), Vt, modl + 10240, XW, (l == 3) ? args.out : nullptr, l == 3);
                if (lp == 0) { SEAM(0); norm_phase(F, XW, SMv + SM_N1G + (l + 1) * DM, mod + (size_t)(l + 1) * 3 * NMOD, 0, 2048, H, false); SEAM(0); }
            }
        }
    }
#undef IN
#undef SEAM
}

extern "C" void kernel_launch(void* const* d_in, const int* in_sizes, int n_in, void* d_out, int out_size, void* d_ws, size_t ws_size, hipStream_t stream) {
    static int grid = 0;
    if (grid == 0) {
        if (n_in != 26 || out_size != NBATCH * SEQ * DM || ws_size < WS_END) { fprintf(stderr, "kernel_launch: unexpected shapes: n_in %d out %d ws %zu (need %zu)\n", n_in, out_size, ws_size, (size_t)WS_END); grid = -1; return; }
        int dev = 0, cus = 0, per_cu = 0;
        if (hipGetDevice(&dev) != hipSuccess || hipDeviceGetAttribute(&cus, hipDeviceAttributeMultiprocessorCount, dev) != hipSuccess) { fprintf(stderr, "kernel_launch: device query failed\n"); grid = -1; return; }
        if (hipFuncSetAttribute((const void*)fwd_kernel, hipFuncAttributeMaxDynamicSharedMemorySize, LDS_BYTES) != hipSuccess) { fprintf(stderr, "kernel_launch: hipFuncSetAttribute failed\n"); grid = -1; return; }
        if (hipOccupancyMaxActiveBlocksPerMultiprocessor(&per_cu, (const void*)fwd_kernel, NTHREADS, LDS_BYTES) != hipSuccess || per_cu < 1) { fprintf(stderr, "kernel_launch: occupancy query says %d blocks per CU\n", per_cu); (void)hipGetLastError(); grid = -1; return; }
        if (cus % 8 != 0) { fprintf(stderr, "kernel_launch: %d CUs: the phase decompositions assume a multiple of 8 workgroups\n", cus); grid = -1; return; }
        grid = cus;
    }
    if (grid < 0) return;
    (void)hipMemsetAsync((char*)d_ws + WS_CTL, 0, CTL_ZERO_BYTES, stream);
    Args a{};
    for (int i = 0; i < 26; ++i) a.in[i] = (const float*)d_in[i];
    a.out = (float*)d_out; a.ws = (unsigned char*)d_ws;
    for (int li = 0; li < N_LAUNCHES; ++li) {
        a.ph_lo = (N_LAUNCHES == 1) ? 0 : li; a.ph_hi = (N_LAUNCHES == 1) ? NPHASES : li + 1;
        hipLaunchKernelGGL(fwd_kernel, dim3(grid), dim3(NTHREADS), LDS_BYTES, stream, a);
        const hipError_t le = hipPeekAtLastError();
        if (le != hipSuccess) { fprintf(stderr, "kernel_launch: launch %d failed: %s\n", li, hipGetErrorName(le)); break; }
    }
}
```

```cpp
#include <hip/hip_runtime.h>
#include <cstdio>
#include <cstdint>
namespace pg8 {
#define PG8_LAS __attribute__((address_space(3)))
typedef unsigned short bf16_t;
typedef short bf16x8 __attribute__((ext_vector_type(8)));
typedef float f32x4 __attribute__((ext_vector_type(4)));
typedef unsigned u32x4 __attribute__((ext_vector_type(4)));
constexpr int BM = 256, BK = 64, HALF = 128, HTB = HALF * BK * 2  , STAGE_BYTES = 8 * HTB, NXCD = 8, WGM = 8;

__host__ __device__ __forceinline__ int lds_byte(int r, int c) { const int st = (r >> 4) * 2 + (c >> 5), rr = r & 15, cc = c & 31, ob = rr * 64 + cc * 2; return st * 1024 + (ob ^ (((ob >> 9) & 1) << 5)); }
__host__ __device__ __forceinline__ void stage_rc(int b, int& R, int& C) { const int st = b / 1024, sb = b % 1024, swz = sb ^ (((sb >> 9) & 1) << 5); R = (st >> 1) * 16 + swz / 64; C = (st & 1) * 32 + (swz % 64) / 2; }
__host__ __device__ __forceinline__ int perm32(int rho) { const int n = rho >> 4, i = rho & 15; return 8 * (i >> 2) + 4 * n + (i & 3); }

struct Unit { int pm, pn; };
struct Gemm { const bf16_t* A; const bf16_t* Bt; int M, N, K, lda, ldb; };

struct StaticOrder {
    int nM, nN, nwg, G, c; bool lat_only;
    __host__ __device__ void init(int M, int N, int G_, int c_, bool lat_only_ = false) { lat_only = lat_only_; nM = lat_only_ ? 32 : M / BM; nN = N / BM; nwg = nM * nN; G = G_; c = c_; }
    __host__ __device__ bool next(int i, Unit& u) const {
        const long L = (long)i * G + c; if (L >= nwg) return false;
        int wgid = (int)L; { const int q = nwg / NXCD, r = nwg % NXCD, xcd = wgid % NXCD, off = wgid / NXCD; wgid = (xcd < r ? xcd * (q + 1) : r * (q + 1) + (xcd - r) * q) + off; }
        const int nig = WGM * nN, gid = wgid / nig, fm = gid * WGM, gsz = (nM - fm) < WGM ? (nM - fm) : WGM;
        u.pm = fm + ((wgid % nig) % gsz); u.pn = (wgid % nig) / gsz; if (lat_only) u.pm += 1 + (u.pm >= 16 ? 1 : 0); return true;
    }
    __device__ __forceinline__ void a_ready(const Unit&) const {}
    __device__ __forceinline__ void done(const Unit&) const {}
};
__device__ __forceinline__ unsigned cvt_pk_bf16(float lo, float hi) { unsigned r; asm volatile("v_cvt_pk_bf16_f32 %0, %1, %2" : "=v"(r) : "v"(lo), "v"(hi)); return r; }
typedef float f32x2 __attribute__((ext_vector_type(2)));
struct EpiBf16 {
    static constexpr bool PERM = true, AFTER_DRAIN = false;
    bf16_t* O; int ldc;
    __device__ __forceinline__ void operator()(const f32x4 (&acc)[2][2][4][2], const Unit& u, int wr, int wc, int fr, int fq) const {
        const int row0 = u.pm * BM + wr * 64 + fr, col0 = u.pn * BM + wc * 32 + 8 * fq;
#pragma unroll
        for (int ai = 0; ai < 2; ++ai)
#pragma unroll
            for (int m = 0; m < 4; ++m) { bf16_t* rowp = O + (size_t)(row0 + ai * HALF + m * 16) * ldc + col0;
#pragma unroll
                for (int bj = 0; bj < 2; ++bj) { const f32x4 v0 = acc[ai][bj][m][0], v1 = acc[ai][bj][m][1];
                    u32x4 w; w.x = cvt_pk_bf16(v0[0], v0[1]); w.y = cvt_pk_bf16(v0[2], v0[3]); w.z = cvt_pk_bf16(v1[0], v1[1]); w.w = cvt_pk_bf16(v1[2], v1[3]);
                    *(u32x4*)(rowp + bj * HALF) = w; } }
    }
};
struct EpiResid {
    static constexpr bool PERM = false, AFTER_DRAIN = false;
    float* X; int ldc; const float* gate;
    __device__ __forceinline__ void operator()(const f32x4 (&acc)[2][2][4][2], const Unit& u, int wr, int wc, int fr, int fq) const {
        const int row0 = u.pm * BM + wr * 64 + fr, col0 = u.pn * BM + wc * 32 + 4 * fq;
        const int cls = (u.pm % 17 == 0) ? 2 : (u.pm / 17);
        const float* gp = gate + (size_t)cls * 12288 + col0;
        f32x4 gv[2][2];
#pragma unroll
        for (int bj = 0; bj < 2; ++bj)
#pragma unroll
            for (int n = 0; n < 2; ++n) gv[bj][n] = *(const f32x4*)(gp + bj * HALF + n * 16);
#pragma unroll
        for (int ai = 0; ai < 2; ++ai)
#pragma unroll
            for (int m = 0; m < 4; ++m) { float* rowp = X + (size_t)(row0 + ai * HALF + m * 16) * ldc + col0;
#pragma unroll
                for (int bj = 0; bj < 2; ++bj)
#pragma unroll
                    for (int n = 0; n < 2; ++n) { f32x4* p = (f32x4*)(rowp + bj * HALF + n * 16); *p = *p + gv[bj][n] * acc[ai][bj][m][n]; } }
    }
};
template <class Epi, class Sched, bool ALIGN_EPI = false, bool SP2 = false>
__device__ __forceinline__ void gemm_phase(PG8_LAS unsigned char* lds, const Gemm g, const Sched& S, const Epi& E, int tid_in) {
    int tid_ = tid_in; asm volatile("" : "+v"(tid_));
    const int tid = tid_, wid = __builtin_amdgcn_readfirstlane(tid >> 6), lane = tid & 63, wr = wid >> 2, wc = wid & 3, fr = lane & 15, fq = lane >> 4;
    const int K = g.K, nt = K / BK;
    unsigned voffA[2], voffB[2];
#pragma unroll
    for (int i = 0; i < 2; ++i) { int R, C; stage_rc(tid * 16 + i * 8192, R, C); const int Rb = Epi::PERM ? ((R & ~31) + perm32(R & 31)) : R;
        voffA[i] = (unsigned)(R * g.lda + C) * 2u; voffB[i] = (unsigned)(Rb * g.ldb + C) * 2u; }
    const size_t kstep = (size_t)(BK * 2);
    const size_t hstepA = (size_t)HALF * g.lda * 2, hstepB = (size_t)HALF * g.ldb * 2;
    const size_t tstepA = 2 * hstepA, tstepB = 2 * hstepB;
    const unsigned ldsw = (unsigned)wid * 1024u;
    const int aoff = lds_byte(wr * 64 + fr, fq * 8), boff = lds_byte(wc * 32 + fr, fq * 8);
#define PG8_SA(b, h) (((b) * 2 + (h)) * HTB)
#define PG8_SB(b, h) ((4 + (b) * 2 + (h)) * HTB)
#define PG8_STAGE(bufoff, gbase, voff) do { _Pragma("unroll") for (int _i = 0; _i < 2; ++_i) \
        __builtin_amdgcn_global_load_lds((const unsigned*)((const char*)(gbase) + (voff)[_i]), (PG8_LAS unsigned*)(lds + (bufoff) + ldsw + _i * 8192), 16, 0, 0); } while (0)
#define PG8_LDA(dst, b, h) do { _Pragma("unroll") for (int m = 0; m < 4; ++m) _Pragma("unroll") for (int k = 0; k < 2; ++k) dst[m][k] = *(const PG8_LAS bf16x8*)(lds + PG8_SA(b, h) + aoff + m * 2048 + k * 1024); } while (0)
#define PG8_LDB(dst, b, h) do { _Pragma("unroll") for (int n = 0; n < 2; ++n) _Pragma("unroll") for (int k = 0; k < 2; ++k) dst[n][k] = *(const PG8_LAS bf16x8*)(lds + PG8_SB(b, h) + boff + n * 2048 + k * 1024); } while (0)
#define PG8_MMA(ai, bj, At, Bt) do { __builtin_amdgcn_s_setprio(1); _Pragma("unroll") for (int m = 0; m < 4; ++m) _Pragma("unroll") for (int n = 0; n < 2; ++n) _Pragma("unroll") for (int k = 0; k < 2; ++k) \
        acc[ai][bj][m][n] = __builtin_amdgcn_mfma_f32_16x16x32_bf16(Bt[n][k], At[m][k], acc[ai][bj][m][n], 0, 0, 0); __builtin_amdgcn_s_setprio(0); } while (0)
#define PG8_WAIT_V(n) asm volatile("s_waitcnt vmcnt(" #n ")" ::: "memory")
#define PG8_WAIT_L(n) asm volatile("s_waitcnt lgkmcnt(" #n ")" ::: "memory")
#define PG8_BAR __builtin_amdgcn_s_barrier()
#define PG8_SCHED __builtin_amdgcn_sched_barrier(0)
    Unit cur, nxt; int ui = 0;
    if (!S.next(0, cur)) return;
    f32x4 acc[2][2][4][2];
#pragma unroll
    for (int a = 0; a < 2; ++a)
#pragma unroll
        for (int b = 0; b < 2; ++b)
#pragma unroll
            for (int m = 0; m < 4; ++m)
#pragma unroll
                for (int n = 0; n < 2; ++n) acc[a][b][m][n] = (f32x4){0.f, 0.f, 0.f, 0.f};
    bf16x8 At[4][2], B0[2][2], B1[2][2];
    const char* cA = (const char*)g.A + (size_t)cur.pm * tstepA; const char* cB = (const char*)g.Bt + (size_t)cur.pn * tstepB;
    S.a_ready(cur);
    if constexpr (SP2) {
        PG8_STAGE(PG8_SB(0, 0), cB, voffB); PG8_STAGE(PG8_SB(0, 1), cB + hstepB, voffB); PG8_STAGE(PG8_SA(0, 0), cA, voffA); PG8_STAGE(PG8_SA(0, 1), cA + hstepA, voffA);
        if (wr == 1) PG8_BAR;
        PG8_WAIT_V(2); PG8_BAR;
        PG8_STAGE(PG8_SB(1, 0), cB + kstep, voffB); PG8_STAGE(PG8_SA(1, 0), cA + kstep, voffA); PG8_STAGE(PG8_SB(1, 1), cB + hstepB + kstep, voffB);
        PG8_WAIT_V(6); PG8_BAR;
    } else {
        PG8_STAGE(PG8_SB(0, 0), cB, voffB); PG8_STAGE(PG8_SA(0, 0), cA, voffA); PG8_STAGE(PG8_SB(0, 1), cB + hstepB, voffB); PG8_STAGE(PG8_SA(0, 1), cA + hstepA, voffA);
        if (wr == 1) PG8_BAR;
        PG8_WAIT_V(4); PG8_BAR;
        PG8_STAGE(PG8_SB(1, 0), cB + kstep, voffB); PG8_STAGE(PG8_SA(1, 0), cA + kstep, voffA); PG8_STAGE(PG8_SB(1, 1), cB + hstepB + kstep, voffB);
        PG8_WAIT_V(6); PG8_BAR;
    }
    for (;;) {
        const bool has_next = S.next(ui + 1, nxt);
        const char* nA = has_next ? (const char*)g.A + (size_t)nxt.pm * tstepA : cA; const char* nB = has_next ? (const char*)g.Bt + (size_t)nxt.pn * tstepB : cB;
        for (int t = 0; t < nt; t += 2) {
            const bool last = (t == nt - 2);
            const char* a1 = cA + (size_t)(t + 1) * kstep;
            const char* a2 = last ? nA : cA + (size_t)(t + 2) * kstep; const char* b2 = last ? nB : cB + (size_t)(t + 2) * kstep;
            const char* a3 = a2 + kstep; const char* b3 = b2 + kstep;
            if (last && has_next) S.a_ready(nxt);
            if constexpr (SP2) {
            PG8_LDB(B0, 0, 0); PG8_LDB(B1, 0, 1); PG8_SCHED; PG8_LDA(At, 0, 0); PG8_STAGE(PG8_SA(1, 1), a1 + hstepA, voffA);
            PG8_WAIT_V(8); PG8_WAIT_L(0); PG8_BAR; PG8_MMA(0, 0, At, B0); PG8_MMA(0, 1, At, B1); PG8_BAR; PG8_SCHED;
            PG8_LDA(At, 0, 1); PG8_STAGE(PG8_SB(0, 0), b2, voffB); PG8_STAGE(PG8_SB(0, 1), b2 + hstepB, voffB); PG8_STAGE(PG8_SA(0, 0), a2, voffA);
            PG8_WAIT_V(8); PG8_WAIT_L(0); PG8_BAR; PG8_MMA(1, 0, At, B0); PG8_MMA(1, 1, At, B1); PG8_BAR; PG8_SCHED;
            PG8_LDB(B0, 1, 0); PG8_LDB(B1, 1, 1); PG8_SCHED; PG8_LDA(At, 1, 0); PG8_STAGE(PG8_SA(0, 1), a2 + hstepA, voffA);
            PG8_WAIT_V(8); PG8_WAIT_L(0); PG8_BAR; PG8_MMA(0, 0, At, B0); PG8_MMA(0, 1, At, B1); PG8_BAR; PG8_SCHED;
            PG8_LDA(At, 1, 1); PG8_STAGE(PG8_SB(1, 0), b3, voffB); PG8_STAGE(PG8_SB(1, 1), b3 + hstepB, voffB); PG8_STAGE(PG8_SA(1, 0), a3, voffA);
            PG8_WAIT_V(8); PG8_WAIT_L(0); PG8_BAR; PG8_MMA(1, 0, At, B0); PG8_MMA(1, 1, At, B1); PG8_BAR; PG8_SCHED;
            } else {
            PG8_LDB(B0, 0, 0); PG8_SCHED; PG8_LDA(At, 0, 0); PG8_STAGE(PG8_SA(1, 1), a1 + hstepA, voffA);
            PG8_WAIT_L(8); PG8_BAR; PG8_WAIT_L(0); PG8_MMA(0, 0, At, B0); PG8_BAR; PG8_SCHED;
            PG8_LDB(B1, 0, 1); PG8_STAGE(PG8_SB(0, 0), b2, voffB);
            PG8_BAR; PG8_WAIT_L(0); PG8_MMA(0, 1, At, B1); PG8_BAR;
            PG8_LDA(At, 0, 1); PG8_STAGE(PG8_SA(0, 0), a2, voffA);
            PG8_BAR; PG8_WAIT_L(0); PG8_MMA(1, 0, At, B0); PG8_BAR; PG8_SCHED;
            PG8_STAGE(PG8_SB(0, 1), b2 + hstepB, voffB);
            PG8_WAIT_V(6); PG8_BAR; PG8_MMA(1, 1, At, B1); PG8_BAR;
            PG8_LDB(B0, 1, 0); PG8_SCHED; PG8_LDA(At, 1, 0); PG8_STAGE(PG8_SA(0, 1), a2 + hstepA, voffA);
            PG8_WAIT_L(8); PG8_BAR; PG8_WAIT_L(0); PG8_MMA(0, 0, At, B0); PG8_BAR; PG8_SCHED;
            PG8_LDB(B1, 1, 1); PG8_STAGE(PG8_SB(1, 0), b3, voffB);
            PG8_BAR; PG8_WAIT_L(0); PG8_MMA(0, 1, At, B1); PG8_BAR;
            PG8_LDA(At, 1, 1); PG8_STAGE(PG8_SA(1, 0), a3, voffA);
            PG8_BAR; PG8_WAIT_L(0); PG8_MMA(1, 0, At, B0); PG8_BAR; PG8_SCHED;
            PG8_STAGE(PG8_SB(1, 1), b3 + hstepB, voffB);
            PG8_WAIT_V(6); PG8_BAR; PG8_MMA(1, 1, At, B1); PG8_BAR;
            }
        }
        if constexpr (ALIGN_EPI) { if (wr == 0) PG8_BAR; }
        if constexpr (!Epi::AFTER_DRAIN) { E(acc, cur, wr, wc, fr, fq); S.done(cur); }
        if (!has_next) break;
#pragma unroll
        for (int a = 0; a < 2; ++a)
#pragma unroll
            for (int b = 0; b < 2; ++b)
#pragma unroll
                for (int m = 0; m < 4; ++m)
#pragma unroll
                    for (int n = 0; n < 2; ++n) acc[a][b][m][n] = (f32x4){0.f, 0.f, 0.f, 0.f};
        cur = nxt; cA = nA; cB = nB; ++ui;
        if constexpr (ALIGN_EPI) { if (wr == 1) PG8_BAR; }
    }
    PG8_WAIT_V(0);
    if constexpr (!ALIGN_EPI) { if (wr == 0) PG8_BAR; }
    PG8_BAR;
    if constexpr (Epi::AFTER_DRAIN) { E.fused(acc, cur, wr, wc, fr, fq, lds, wid, lane); S.done(cur); }
#undef PG8_SA
#undef PG8_SB
#undef PG8_STAGE
#undef PG8_LDA
#undef PG8_LDB
#undef PG8_MMA
#undef PG8_WAIT_V
#undef PG8_WAIT_L
#undef PG8_BAR
#undef PG8_SCHED
}
}
namespace att {
typedef unsigned short bf16_t;
using bf16x8 = __attribute__((ext_vector_type(8))) short;
using s16x4  = __attribute__((ext_vector_type(4))) short;
using f32x16 = __attribute__((ext_vector_type(16))) float;
using u32x4  = __attribute__((ext_vector_type(4))) unsigned;
constexpr int DV = 128, NW = 8, QBLK = 32, KVBLK = 64;
constexpr float THR = 8.f;
constexpr int SHM_V = KVBLK * DV * 2;
template <int DQK> struct Cfg {
    static constexpr int SHM_K = KVBLK * DQK * 2, KROWB = DQK * 2, NCK = DQK / 64, C8 = DQK / 8, ND0 = DQK / 16;
    static constexpr float SCALE = (DQK == 128) ? 0.088388347648318440f : 0.072168783648703220f;
    static constexpr int LDS_BYTES = 2 * SHM_V + 2 * SHM_K + NW * 64 * 4;
};
#define ATT_SBAR() __builtin_amdgcn_sched_barrier(0)
__device__ __forceinline__ int crow(int r, int hi) { return (r & 3) + 8 * (r >> 2) + 4 * hi; }
__device__ __forceinline__ unsigned cvtpk(float lo, float hi) { unsigned r; asm volatile("v_cvt_pk_bf16_f32 %0, %1, %2" : "=v"(r) : "v"(lo), "v"(hi)); return r; }
template <int DQK> __device__ __forceinline__ int kswz(int row, int colB) {
    const int key = (DQK == 128) ? (row & 7) : ((row >> 1) & 7);
    return row * (DQK * 2) + (colB ^ (key << 4));
}
template <int DQK> __device__ __forceinline__ void partialSM(f32x16& p0, f32x16& p1, float& m_reg, float& mn, float& alpha) {
    constexpr float SCALE = Cfg<DQK>::SCALE, C = SCALE * 1.4426950408889634f;
    float pmax = p0[0];
#pragma unroll
    for (int r = 1; r < 16; ++r) pmax = fmaxf(pmax, p0[r]);
#pragma unroll
    for (int r = 0; r < 16; ++r) pmax = fmaxf(pmax, p1[r]);
    { auto rr = __builtin_amdgcn_permlane32_swap(__float_as_uint(pmax), __float_as_uint(pmax), false, false);
      pmax = fmaxf(__uint_as_float(rr[0]), __uint_as_float(rr[1])); }
    if (__builtin_expect(__all(pmax - m_reg <= THR / SCALE), 1)) { mn = m_reg; alpha = 1.f; }
    else { mn = fmaxf(m_reg, pmax); alpha = __builtin_amdgcn_exp2f((m_reg - mn) * C); m_reg = mn; }
    const float mnC = -mn * C;
#pragma unroll
    for (int r = 0; r < 16; ++r) p0[r] = fmaf(p0[r], C, mnC);
#pragma unroll
    for (int r = 0; r < 16; ++r) p1[r] = fmaf(p1[r], C, mnC);
#pragma unroll
    for (int r = 0; r < 16; ++r) p0[r] = __builtin_amdgcn_exp2f(p0[r]);
}
__device__ __forceinline__ void finishSM(f32x16& p0, f32x16& p1, float alpha, float& l_reg, bf16x8& pa0, bf16x8& pa1, bf16x8& pa2, bf16x8& pa3) {
#pragma unroll
    for (int r = 0; r < 16; ++r) p1[r] = __builtin_amdgcn_exp2f(p1[r]);
    float ps = 0;
#pragma unroll
    for (int r = 0; r < 16; ++r) ps += p0[r];
#pragma unroll
    for (int r = 0; r < 16; ++r) ps += p1[r];
    { auto rr = __builtin_amdgcn_permlane32_swap(__float_as_uint(ps), __float_as_uint(ps), false, false);
      ps = __uint_as_float(rr[0]) + __uint_as_float(rr[1]); }
    l_reg = l_reg * alpha + ps;
#define ATT_PK4(P, BASE, OUT) do { unsigned a0 = cvtpk(P[BASE + 0], P[BASE + 1]), a1 = cvtpk(P[BASE + 2], P[BASE + 3]);   \
    unsigned b0 = cvtpk(P[BASE + 4], P[BASE + 5]), b1 = cvtpk(P[BASE + 6], P[BASE + 7]);                              \
    auto r0 = __builtin_amdgcn_permlane32_swap(a0, b0, false, false); auto r1 = __builtin_amdgcn_permlane32_swap(a1, b1, false, false); \
    u32x4 w = {r0[0], r1[0], r0[1], r1[1]}; OUT = *reinterpret_cast<bf16x8*>(&w); } while (0)
    ATT_PK4(p0, 0, pa0); ATT_PK4(p0, 8, pa1); ATT_PK4(p1, 0, pa2); ATT_PK4(p1, 8, pa3);
#undef ATT_PK4
}
template <int DQK> __device__ __forceinline__ void qkt(f32x16& p0, f32x16& p1, const char* Ks, const bf16x8* qr, int r32, int hi) {
    p0 = f32x16{}; p1 = f32x16{};
#pragma unroll
    for (int d0 = 0; d0 < Cfg<DQK>::ND0; ++d0) { const int cb = (d0 * 16 + hi * 8) * 2;
        bf16x8 b0 = *reinterpret_cast<const bf16x8*>(Ks + kswz<DQK>(r32, cb));
        bf16x8 b1 = *reinterpret_cast<const bf16x8*>(Ks + kswz<DQK>(32 + r32, cb));
        p0 = __builtin_amdgcn_mfma_f32_32x32x16_bf16(b0, qr[d0], p0, 0, 0, 0);
        p1 = __builtin_amdgcn_mfma_f32_32x32x16_bf16(b1, qr[d0], p1, 0, 0, 0); }
}
__device__ __forceinline__ int v_st(int k, int c) { const int kk = (k & ~0xC) | ((k & 4) << 1) | ((k & 8) >> 1); return ((kk >> 3) * 4 + (c >> 5)) * 512 + ((kk & 7) * 32 + (c & 31)) * 2; }
__device__ __forceinline__ int v_rd_base(int lane) { return ((lane & 3) << 3) | (((lane >> 2) & 3) << 6) | (((lane >> 4) & 1) << 5) | (((lane >> 5) & 1) << 8); }
constexpr int v_rd_off(int d0, int ks, int half) { return d0 * 512 + ks * 4096 + half * 2048; }
template <int OFF> __device__ __forceinline__ s16x4 tr_read(int vb) {
    s16x4 r; asm volatile("ds_read_b64_tr_b16 %0, %1 offset:%2" : "=&v"(r) : "v"(vb), "i"(OFF) : "memory"); return r;
}
template <int D0> __device__ __forceinline__ void pv_one(f32x16& od, int vb, bf16x8 pa0, bf16x8 pa1, bf16x8 pa2, bf16x8 pa3) {
    const s16x4 l0 = tr_read<v_rd_off(D0, 0, 0)>(vb), h0 = tr_read<v_rd_off(D0, 0, 1)>(vb), l1 = tr_read<v_rd_off(D0, 1, 0)>(vb), h1 = tr_read<v_rd_off(D0, 1, 1)>(vb);
    const s16x4 l2 = tr_read<v_rd_off(D0, 2, 0)>(vb), h2 = tr_read<v_rd_off(D0, 2, 1)>(vb), l3 = tr_read<v_rd_off(D0, 3, 0)>(vb), h3 = tr_read<v_rd_off(D0, 3, 1)>(vb);
    asm volatile("s_waitcnt lgkmcnt(0)" ::: "memory"); ATT_SBAR();
#define ATT_PK(L, H) (bf16x8){L[0], L[1], L[2], L[3], H[0], H[1], H[2], H[3]}
    od = __builtin_amdgcn_mfma_f32_32x32x16_bf16(pa0, ATT_PK(l0, h0), od, 0, 0, 0);
    od = __builtin_amdgcn_mfma_f32_32x32x16_bf16(pa1, ATT_PK(l1, h1), od, 0, 0, 0);
    od = __builtin_amdgcn_mfma_f32_32x32x16_bf16(pa2, ATT_PK(l2, h2), od, 0, 0, 0);
    od = __builtin_amdgcn_mfma_f32_32x32x16_bf16(pa3, ATT_PK(l3, h3), od, 0, 0, 0);
#undef ATT_PK
}
__device__ __forceinline__ void pv_d0(f32x16* o, int vb, bf16x8 pa0, bf16x8 pa1, bf16x8 pa2, bf16x8 pa3) {
    pv_one<0>(o[0], vb, pa0, pa1, pa2, pa3); pv_one<1>(o[1], vb, pa0, pa1, pa2, pa3); pv_one<2>(o[2], vb, pa0, pa1, pa2, pa3); pv_one<3>(o[3], vb, pa0, pa1, pa2, pa3);
}
template <int DQK, int LDQ, int LDK, int LDV, int LDO, int SDEPTH>
__device__ __forceinline__ void attn_body(const bf16_t* __restrict__ Qb, const bf16_t* __restrict__ Kh, const bf16_t* __restrict__ Vh, bf16_t* __restrict__ Ob, int seq, char* lds, int tid_in) {
    using C_ = Cfg<DQK>;
    constexpr int SHM_K = C_::SHM_K, NCK = C_::NCK, C8 = C_::C8, ND0 = C_::ND0;
    int tid_ = tid_in; asm volatile("" : "+v"(tid_));
    const int tid = tid_, wid = tid >> 6, lane = tid & 63, r32 = lane & 31, hi = lane >> 5;
    char* V_lds = lds; char* K_lds = lds + 2 * SHM_V;
    float* ws = (float*)(lds + 2 * SHM_V + 2 * SHM_K) + wid * 64; float* li_l = ws; float* al_l = ws + 32;
    float m_reg = -1e30f, l_reg = 0; f32x16 o[4] = {}; bf16x8 qr[ND0];
    const bf16_t* Qw = Qb + (long)(wid * QBLK + r32) * LDQ + hi * 8;
#pragma unroll
    for (int d0 = 0; d0 < ND0; ++d0) qr[d0] = *reinterpret_cast<const bf16x8*>(Qw + d0 * 16);
    const int sr = tid >> 4, sc = (tid & 15) * 8, vst0 = v_st(sr, sc), vst1 = v_st(32 + sr, sc);
    int krow[NCK], kcol[NCK];
#pragma unroll
    for (int i = 0; i < NCK; ++i) { const int ci = tid + 512 * i; krow[i] = ci / C8; kcol[i] = (ci % C8) * 8; }
    const int vb0 = (int)(uintptr_t)V_lds + v_rd_base(lane);
    struct { bf16x8 vs0, vs1, ks[NCK]; } sr_[SDEPTH];
#define ATT_SLOAD(i, k0) do { sr_[i].vs0 = *reinterpret_cast<const bf16x8*>(&Vh[(long)((k0) + sr) * LDV + sc]); sr_[i].vs1 = *reinterpret_cast<const bf16x8*>(&Vh[(long)((k0) + 32 + sr) * LDV + sc]); \
    _Pragma("unroll") for (int c_ = 0; c_ < NCK; ++c_) sr_[i].ks[c_] = *reinterpret_cast<const bf16x8*>(&Kh[(long)((k0) + krow[c_]) * LDK + kcol[c_]]); } while (0)
#define ATT_SWRITE(b, i) do { *(bf16x8*)(V_lds + (b) * SHM_V + vst0) = sr_[i].vs0; *(bf16x8*)(V_lds + (b) * SHM_V + vst1) = sr_[i].vs1; \
    _Pragma("unroll") for (int c_ = 0; c_ < NCK; ++c_) *(bf16x8*)(K_lds + (b) * SHM_K + kswz<DQK>(krow[c_], kcol[c_] * 2)) = sr_[i].ks[c_]; } while (0)
#define ATT_SWAIT() do { if constexpr (SDEPTH == 2) { if constexpr (NCK == 2) asm volatile("s_waitcnt vmcnt(4)" ::: "memory"); else asm volatile("s_waitcnt vmcnt(5)" ::: "memory"); } else asm volatile("s_waitcnt vmcnt(0)" ::: "memory"); } while (0)
#define ATT_RESC(a) do { if (__any((a) < 1.f)) { if (hi == 0) al_l[r32] = (a); asm volatile("s_waitcnt lgkmcnt(0)" ::: "memory"); \
    _Pragma("unroll") for (int d = 0; d < 4; ++d) _Pragma("unroll") for (int r = 0; r < 16; ++r) o[d][r] *= al_l[crow(r, hi)]; } } while (0)
    f32x16 pA0, pA1, pB0, pB1; float mnA, mnB, alA, alB; bf16x8 pa0, pa1, pa2, pa3; const int NT = seq / KVBLK;
    constexpr int SE = 0, SO = SDEPTH - 1;
    ATT_SLOAD(SE, 0); asm volatile("s_waitcnt vmcnt(0)" ::: "memory"); ATT_SWRITE(0, SE); __syncthreads();
    qkt<DQK>(pA0, pA1, K_lds, qr, r32, hi); partialSM<DQK>(pA0, pA1, m_reg, mnA, alA);
    ATT_SLOAD(SO, KVBLK); if constexpr (SDEPTH == 2) { if (2 < NT) ATT_SLOAD(SE, 2 * KVBLK); }
    ATT_SWAIT(); ATT_SWRITE(1, SO); __syncthreads();
    for (int j = 1; j + 1 < NT; j += 2) {
        ATT_SBAR(); qkt<DQK>(pB0, pB1, K_lds + SHM_K, qr, r32, hi);
        finishSM(pA0, pA1, alA, l_reg, pa0, pa1, pa2, pa3); ATT_SBAR();
        ATT_SLOAD(SO, (j + SDEPTH) * KVBLK); ATT_SBAR();
        pv_d0(o, vb0, pa0, pa1, pa2, pa3); partialSM<DQK>(pB0, pB1, m_reg, mnB, alB);
        __syncthreads(); ATT_SWAIT(); ATT_SWRITE(0, SE);
        ATT_RESC(alB); __syncthreads();
        ATT_SBAR(); qkt<DQK>(pA0, pA1, K_lds, qr, r32, hi);
        finishSM(pB0, pB1, alB, l_reg, pa0, pa1, pa2, pa3); ATT_SBAR();
        if (SDEPTH == 1 || j + 3 < NT) ATT_SLOAD(SE, (j + 1 + SDEPTH) * KVBLK); ATT_SBAR();
        pv_d0(o, vb0 + (int)SHM_V, pa0, pa1, pa2, pa3); partialSM<DQK>(pA0, pA1, m_reg, mnA, alA);
        __syncthreads(); ATT_SWAIT(); ATT_SWRITE(1, SO);
        ATT_RESC(alA); __syncthreads();
    }
    ATT_SBAR(); qkt<DQK>(pB0, pB1, K_lds + SHM_K, qr, r32, hi);
    finishSM(pA0, pA1, alA, l_reg, pa0, pa1, pa2, pa3); ATT_SBAR();
    pv_d0(o, vb0, pa0, pa1, pa2, pa3); partialSM<DQK>(pB0, pB1, m_reg, mnB, alB);
    __syncthreads(); ATT_RESC(alB);
    finishSM(pB0, pB1, alB, l_reg, pa0, pa1, pa2, pa3); ATT_SBAR();
    pv_d0(o, vb0 + (int)SHM_V, pa0, pa1, pa2, pa3);
    if (hi == 0) li_l[r32] = l_reg;
    asm volatile("s_waitcnt lgkmcnt(0)" ::: "memory");
    __syncthreads();
    float rli[16];
#pragma unroll
    for (int r = 0; r < 16; ++r) rli[r] = __builtin_amdgcn_rcpf(li_l[crow(r, hi)]);
    unsigned short* stg = (unsigned short*)(lds + wid * 8192);
#pragma unroll
    for (int r = 0; r < 16; ++r) { const int orow = crow(r, hi);
#pragma unroll
        for (int d0 = 0; d0 < 4; ++d0) { const unsigned w = cvtpk(o[d0][r] * rli[r], 0.f); stg[orow * 128 + d0 * 32 + r32] = (unsigned short)(w & 0xffffu); } }
    asm volatile("s_waitcnt lgkmcnt(0)" ::: "memory");
    bf16_t* Ow = Ob + (long)(wid * QBLK) * LDO;
#pragma unroll
    for (int i = 0; i < 8; ++i) { const int id = lane + 64 * i, row = id >> 4, c16 = id & 15;
        const u32x4 v = *(const u32x4*)((const char*)stg + row * 256 + c16 * 16);
        *(u32x4*)(Ow + (long)row * LDO + c16 * 8) = v; }
    asm volatile("s_waitcnt lgkmcnt(0)" ::: "memory");
    __syncthreads();
#undef ATT_SLOAD
#undef ATT_SWRITE
#undef ATT_SWAIT
#undef ATT_RESC
}

template <int DQK, int LDQ, int LDK, int LDV, int LDO>
__device__ __forceinline__ void attn_body1(const bf16_t* __restrict__ Qb, const bf16_t* __restrict__ Kh, const bf16_t* __restrict__ Vh, bf16_t* __restrict__ Ob, int seq, char* lds, int tid_in) {
    using C_ = Cfg<DQK>;
    constexpr int SHM_K = C_::SHM_K, NCK = C_::NCK, C8 = C_::C8, ND0 = C_::ND0;
    int tid_ = tid_in; asm volatile("" : "+v"(tid_));
    const int tid = tid_, wid = tid >> 6, lane = tid & 63, r32 = lane & 31, hi = lane >> 5;
    char* V_lds = lds; char* K_lds = lds + 2 * SHM_V;
    float* ws = (float*)(lds + 2 * SHM_V + 2 * SHM_K) + wid * 64; float* li_l = ws; float* al_l = ws + 32;
    float m_reg = -1e30f, l_reg = 0; f32x16 o[4] = {}; bf16x8 qr[ND0];
    const bf16_t* Qw = Qb + (long)(wid * QBLK + r32) * LDQ + hi * 8;
#pragma unroll
    for (int d0 = 0; d0 < ND0; ++d0) qr[d0] = *reinterpret_cast<const bf16x8*>(Qw + d0 * 16);
    const int sr = tid >> 4, sc = (tid & 15) * 8, vst0 = v_st(sr, sc), vst1 = v_st(32 + sr, sc);
    int krow[NCK], kcol[NCK];
#pragma unroll
    for (int i = 0; i < NCK; ++i) { const int ci = tid + 512 * i; krow[i] = ci / C8; kcol[i] = (ci % C8) * 8; }
    const int vb0 = (int)(uintptr_t)V_lds + v_rd_base(lane);
    bf16x8 vs0, vs1, ks[NCK];
#define ATT1_SLOAD(k0) do { vs0 = *reinterpret_cast<const bf16x8*>(&Vh[(long)((k0) + sr) * LDV + sc]); vs1 = *reinterpret_cast<const bf16x8*>(&Vh[(long)((k0) + 32 + sr) * LDV + sc]); \
    _Pragma("unroll") for (int c_ = 0; c_ < NCK; ++c_) ks[c_] = *reinterpret_cast<const bf16x8*>(&Kh[(long)((k0) + krow[c_]) * LDK + kcol[c_]]); } while (0)
#define ATT1_SWRITE(b) do { *(bf16x8*)(V_lds + (b) * SHM_V + vst0) = vs0; *(bf16x8*)(V_lds + (b) * SHM_V + vst1) = vs1; \
    _Pragma("unroll") for (int c_ = 0; c_ < NCK; ++c_) *(bf16x8*)(K_lds + (b) * SHM_K + kswz<DQK>(krow[c_], kcol[c_] * 2)) = ks[c_]; } while (0)
    const int NT = seq / KVBLK;
    ATT1_SLOAD(0); asm volatile("s_waitcnt vmcnt(0)" ::: "memory"); ATT1_SWRITE(0); __syncthreads();
    for (int j = 0; j < NT; ++j) {
        const int b = j & 1;
        if (j + 1 < NT) ATT1_SLOAD((j + 1) * KVBLK);
        ATT_SBAR();
        f32x16 p0, p1; float mn, alpha; bf16x8 pa0, pa1, pa2, pa3;
        qkt<DQK>(p0, p1, K_lds + b * SHM_K, qr, r32, hi);
        partialSM<DQK>(p0, p1, m_reg, mn, alpha);
        if (__any(alpha < 1.f)) { if (hi == 0) al_l[r32] = alpha; asm volatile("s_waitcnt lgkmcnt(0)" ::: "memory");
#pragma unroll
            for (int d = 0; d < 4; ++d)
#pragma unroll
                for (int r = 0; r < 16; ++r) o[d][r] *= al_l[crow(r, hi)]; }
        finishSM(p0, p1, alpha, l_reg, pa0, pa1, pa2, pa3); ATT_SBAR();
        pv_d0(o, vb0 + b * (int)SHM_V, pa0, pa1, pa2, pa3);
        if (j + 1 < NT) { ATT1_SWRITE(b ^ 1); }
        __syncthreads();
    }
    if (hi == 0) li_l[r32] = l_reg;
    asm volatile("s_waitcnt lgkmcnt(0)" ::: "memory");
    __syncthreads();
    float rli[16];
#pragma unroll
    for (int r = 0; r < 16; ++r) rli[r] = __builtin_amdgcn_rcpf(li_l[crow(r, hi)]);
    unsigned short* stg = (unsigned short*)(lds + wid * 8192);
#pragma unroll
    for (int r = 0; r < 16; ++r) { const int orow = crow(r, hi);
#pragma unroll
        for (int d0 = 0; d0 < 4; ++d0) { const unsigned w = cvtpk(o[d0][r] * rli[r], 0.f); stg[orow * 128 + d0 * 32 + r32] = (unsigned short)(w & 0xffffu); } }
    asm volatile("s_waitcnt lgkmcnt(0)" ::: "memory");
    bf16_t* Ow = Ob + (long)(wid * QBLK) * LDO;
#pragma unroll
    for (int i = 0; i < 8; ++i) { const int id = lane + 64 * i, row = id >> 4, c16 = id & 15;
        const u32x4 v = *(const u32x4*)((const char*)stg + row * 256 + c16 * 16);
        *(u32x4*)(Ow + (long)row * LDO + c16 * 8) = v; }
    asm volatile("s_waitcnt lgkmcnt(0)" ::: "memory");
    __syncthreads();
#undef ATT1_SLOAD
#undef ATT1_SWRITE
}
}
constexpr int DM = 2048, NBATCH = 2, SEQ = 4096, CTX = 256, RB = SEQ + CTX  , MROWS = NBATCH * RB  ;
constexpr int NMOD = 6 * DM, NEXP = 16384;
constexpr float EPS = 1e-6f;
constexpr int NWAVES = 8, NTHREADS = 512;
constexpr size_t MiB = 1u << 20;
constexpr size_t WS_CTL = 0, CTL_ZERO_BYTES = 64 * 1024;
constexpr size_t WS_MOD = 1 * MiB;
constexpr size_t WS_ROPE = 2 * MiB;
constexpr size_t WS_SMALL = 3 * MiB;
constexpr int SM_N1G = 0, SM_N2G = 8192, SM_AQG = 16384, SM_AKG = 16384 + 384, SM_CW = 16384 + 768, SM_CB = SM_CW + 6144, SM_CQG = SM_CB + 2048, SM_CKG = SM_CQG + 256, SM_END = SM_CKG + 256;
constexpr size_t WS_PTRS = 3 * MiB + 512 * 1024;
constexpr size_t WS_XW = 4 * MiB;
constexpr size_t WS_H = 72 * MiB;
constexpr size_t WS_P = 106 * MiB;
constexpr size_t WS_QRAW = 174 * MiB;
constexpr size_t WS_KVRAW = 200 * MiB;
constexpr size_t WS_Q = 234 * MiB;
constexpr size_t WS_K = 268 * MiB;
constexpr size_t WS_V = 294 * MiB;
constexpr size_t WS_CAT = 311 * MiB;
constexpr size_t WS_PQ = 345 * MiB;
constexpr size_t WS_IDX = 379 * MiB;
constexpr size_t WS_GATE = 384 * MiB;
constexpr size_t WS_WIN = 389 * MiB;
constexpr size_t WS_WUQ = 421 * MiB;
constexpr size_t WS_WUKV = 424 * MiB;
constexpr size_t WS_WEO = 426 * MiB;
constexpr size_t WS_WQKV = 442 * MiB;
constexpr size_t WS_WCO = 466 * MiB;
constexpr size_t WS_WPQ = 482 * MiB;
constexpr size_t WS_SUBK = 514 * MiB;
#ifndef TAB_FP4
#define TAB_FP4 1
#endif
#if TAB_FP4
constexpr int ROWB = 1024;
#else
constexpr int ROWB = 1536;
#endif
constexpr size_t WS_U = 516 * MiB;
constexpr size_t WS_VT = 644 * MiB;
constexpr size_t WS_USC = 772 * MiB;
constexpr size_t WS_VSC = 773 * MiB;
constexpr size_t WS_XQ = 810 * MiB;
constexpr size_t WS_XS = 828 * MiB;
constexpr size_t WS_WQ8 = 834 * MiB;
constexpr size_t WS_WSC = 836 * MiB;
constexpr size_t WS_PART = 774 * MiB;
constexpr size_t WS_END = 837 * MiB;
#ifndef EXP_SLICED
#define EXP_SLICED 1
#endif
#ifndef PEER_MFMA
#define PEER_MFMA 1
#endif
#ifndef PEER_VMFMA
#define PEER_VMFMA 1
#endif
constexpr int CW_BAR = 4096;
constexpr int LDS_MISC = 131072 + 8192;
constexpr int LDS_BYTES = 147456;

#define LAS __attribute__((address_space(3)))
typedef unsigned short bf16_t;
typedef float f32x4 __attribute__((ext_vector_type(4)));
typedef unsigned u32x4 __attribute__((ext_vector_type(4)));
typedef unsigned u32x2 __attribute__((ext_vector_type(2)));
typedef short bf16x8 __attribute__((ext_vector_type(8)));
typedef float f32x16 __attribute__((ext_vector_type(16)));
typedef __bf16 bf16x2_t __attribute__((ext_vector_type(2)));
typedef float f32x2 __attribute__((ext_vector_type(2)));
typedef _Float16 h2_t __attribute__((ext_vector_type(2)));
typedef float f32x32 __attribute__((ext_vector_type(32)));
typedef unsigned u32x6 __attribute__((ext_vector_type(6)));

__device__ __forceinline__ unsigned f2bf(float f) { unsigned u = __builtin_bit_cast(unsigned, f); return (u + 0x7fffu + ((u >> 16) & 1u)) >> 16; }
__device__ __forceinline__ unsigned pk2(float lo, float hi) { return f2bf(lo) | (f2bf(hi) << 16); }
__device__ __forceinline__ float bf_lo(unsigned w) { return __builtin_bit_cast(float, w << 16); }
__device__ __forceinline__ float bf_hi(unsigned w) { return __builtin_bit_cast(float, w & 0xffff0000u); }
__device__ __forceinline__ float bf2f(bf16_t h) { return __builtin_bit_cast(float, (unsigned)h << 16); }
__device__ __forceinline__ float wave_sum(float v) {
#pragma unroll
    for (int o = 1; o < 64; o <<= 1) v += __shfl_xor(v, o);
    return v;
}
#define DPP_ADD(v, ctrl) ((v) + __builtin_bit_cast(float, __builtin_amdgcn_update_dpp(0, __builtin_bit_cast(int, (v)), (ctrl), 0xf, 0xf, true)))
__device__ __forceinline__ float wave_sum_dpp(float v) {
    v = DPP_ADD(v, 0xB1);
    v = DPP_ADD(v, 0x4E);
    v = DPP_ADD(v, 0x141);
    v = DPP_ADD(v, 0x140);
    const int vi = __builtin_bit_cast(int, v);
    const float s0 = __builtin_bit_cast(float, __builtin_amdgcn_readlane(vi, 0)), s1 = __builtin_bit_cast(float, __builtin_amdgcn_readlane(vi, 16));
    const float s2 = __builtin_bit_cast(float, __builtin_amdgcn_readlane(vi, 32)), s3 = __builtin_bit_cast(float, __builtin_amdgcn_readlane(vi, 48));
    return (s0 + s1) + (s2 + s3);
}
__device__ __forceinline__ float dot2_bf16(unsigned w, unsigned x, float acc) { return __builtin_amdgcn_fdot2_f32_bf16(__builtin_bit_cast(bf16x2_t, w), __builtin_bit_cast(bf16x2_t, x), acc, false); }
__device__ __forceinline__ float gelu_erf(float v) {
    const float av = fabsf(v), t = __builtin_amdgcn_rcpf(av * 0.2316418882f + 1.0f);
    float q = t * 0.5307027145f + (-0.7265760135f); q = q * t + 0.7107068705f; q = q * t + (-0.142248368f); q = q * t + 0.127414796f; q = q * t;
    const float e = __builtin_amdgcn_exp2f((v * v) * (-0.72134752044f));
    const float m = v * (q * e);
    return v < 0.f ? m : v - m;
}
#define XB_TMO      128
#define XB_XCNT(j)  (256  + 64 * (j))
#define XB_XSUB(j)  (1280 + 64 * (j))
#define XB_XGEN(j)  (2304 + 64 * (j))
#define XB_TOP      3328
#define XB_TOPGEN   3392
#define XCD_BAR_WORDS 3456
#define XB_SPIN_CAP (1u << 18)

__device__ __forceinline__ unsigned xb_ld(unsigned* p)              { return __hip_atomic_load(p, __ATOMIC_RELAXED, __HIP_MEMORY_SCOPE_AGENT); }
__device__ __forceinline__ unsigned xb_add(unsigned* p, unsigned v) { return __hip_atomic_fetch_add(p, v, __ATOMIC_RELAXED, __HIP_MEMORY_SCOPE_AGENT); }
__device__ __forceinline__ unsigned xb_xcc_id() { return (unsigned)__builtin_amdgcn_s_getreg((3 << 11) | 20) & 0xFu; }
#define XB_SPIN(cond, bar) do { unsigned _sp = 0; while (cond) { __builtin_amdgcn_s_sleep(1); \
    if ((++_sp & 255u) == 0u) { if (xb_ld(&(bar)[XB_TMO])) break; if (_sp > XB_SPIN_CAP) { atomicAdd(&(bar)[XB_TMO], 1u); break; } } } } while (0)

struct XcdBarrier {
    unsigned* bar; unsigned x;
    volatile LAS unsigned* st;
};

__device__ __forceinline__ XcdBarrier xcd_barrier_post(unsigned* bar, volatile LAS unsigned* st) {
    XcdBarrier b; b.bar = bar; b.x = xb_xcc_id(); b.st = st;
    if (threadIdx.x == 0) (void)xb_add(&bar[XB_XCNT(b.x)], 1u);
    return b;
}
__device__ __forceinline__ void xcd_barrier_complete(unsigned* bar, unsigned x, unsigned& nloc, unsigned& nx) {
    const unsigned G = gridDim.x * gridDim.y * gridDim.z;
    unsigned sum, cnt, mine, sp = 0u;
    for (;;) {
        sum = 0u; cnt = 0u; mine = 0u;
#pragma unroll
        for (unsigned j = 0; j < 16; ++j) { const unsigned c = xb_ld(&bar[XB_XCNT(j)]); sum += c; cnt += (c > 0u) ? 1u : 0u; mine = (j == x) ? c : mine; }
        if (sum == G) break;
        __builtin_amdgcn_s_sleep(1);
        if ((++sp & 255u) == 0u) { if (xb_ld(&bar[XB_TMO])) break; if (sp > XB_SPIN_CAP) { atomicAdd(&bar[XB_TMO], 1u); break; } }
    }
    nloc = mine > 0u ? mine : 1u; nx = cnt > 0u ? cnt : 1u;
}

__device__ __forceinline__ void xcd_barrier(const XcdBarrier& b) {
    asm volatile("s_waitcnt vmcnt(0)" ::: "memory");
    __syncthreads();
    if (threadIdx.x == 0) {
        unsigned* bar = b.bar; unsigned bx = b.x;
        asm volatile("" : "+s"(bar), "+s"(bx));
        __builtin_amdgcn_s_waitcnt(0);
        unsigned nloc = b.st[0], nx = b.st[1];
        if (nloc == 0u) { xcd_barrier_complete(bar, bx, nloc, nx); b.st[0] = nloc; b.st[1] = nx; }
        const unsigned old = xb_add(&bar[XB_XSUB(bx)], 1u);
        const unsigned gen = old / nloc;
        if (old + 1u == (gen + 1u) * nloc) {
            __builtin_amdgcn_fence(__ATOMIC_RELEASE, "agent");
            asm volatile("s_waitcnt vmcnt(0)" ::: "memory");
            const unsigned og = xb_add(&bar[XB_TOP], 1u);
            const unsigned tg = og / nx;
            if (og + 1u == (tg + 1u) * nx) xb_add(&bar[XB_TOPGEN], 1u);
            else XB_SPIN(xb_ld(&bar[XB_TOPGEN]) == tg, bar);
            __builtin_amdgcn_fence(__ATOMIC_ACQUIRE, "agent");
            xb_add(&bar[XB_XGEN(bx)], 1u);
            asm volatile("s_waitcnt vmcnt(0)" ::: "memory");
        } else {
            XB_SPIN(xb_ld(&bar[XB_XGEN(bx)]) == gen, bar);
            __builtin_amdgcn_fence(__ATOMIC_ACQUIRE, "agent");
            asm volatile("s_waitcnt vmcnt(0)" ::: "memory");
        }
    }
    __syncthreads();
}
struct Frame {
    LAS unsigned char* lds;
    int tid, lane, wave, vcu, G, gw, NGW;
    unsigned char* ws;
};
__device__ __forceinline__ int opaque_v(int v) { asm volatile("" : "+v"(v)); return v; }
__device__ __forceinline__ int phase_tid(int wave) { int lane; asm volatile("v_mbcnt_lo_u32_b32 %0, -1, 0\n\tv_mbcnt_hi_u32_b32 %0, -1, %0" : "=v"(lane)); return wave * 64 + lane; }
__device__ __forceinline__ Frame phase_frame(const Frame& F0) { Frame F = F0; F.tid = phase_tid(F0.wave); F.lane = F.tid & 63; return F; }
__device__ __forceinline__ float swap32(float v, int lane) { auto rr = __builtin_amdgcn_permlane32_swap(__float_as_uint(v), __float_as_uint(v), false, false); return __uint_as_float(lane < 32 ? rr[1] : rr[0]); }
__device__ __forceinline__ int row_cls(int row) { const int b = row / RB, i = row - b * RB; return i < CTX ? 2 : b; }

__device__ __forceinline__ void p0_transpose_item(const float* W, int K, int N, bf16_t* WT, const float* gain, LAS float* scr, int item, int lane, bool perm_q = false) {
    const int nblk = N / 32, kb = item / nblk, nb = item % nblk, k0 = 64 * kb, n0 = 32 * nb;
    {
        const int rgp = lane >> 3, c4 = (lane & 7) * 4; f32x4 tv[8];
#pragma unroll
        for (int i = 0; i < 8; ++i) tv[i] = *(const f32x4*)(W + (size_t)(k0 + 8 * i + rgp) * N + n0 + c4);
#pragma unroll
        for (int i = 0; i < 8; ++i) { const int kk = 8 * i + rgp; f32x4 v = tv[i]; if (gain) v = v * gain[k0 + kk];
            LAS float* d = scr + kk * 33 + c4; d[0] = v.x; d[1] = v.y; d[2] = v.z; d[3] = v.w; }
    }
    asm volatile("s_waitcnt lgkmcnt(0)" ::: "memory");
    const int c = lane & 7;
#pragma unroll
    for (int j = 0; j < 4; ++j) { const int n = (lane >> 3) + 8 * j; const LAS float* s = scr + (8 * c) * 33 + n;
        u32x4 o; o.x = pk2(s[0 * 33], s[1 * 33]); o.y = pk2(s[2 * 33], s[3 * 33]); o.z = pk2(s[4 * 33], s[5 * 33]); o.w = pk2(s[6 * 33], s[7 * 33]);
        int nn = n0 + n; if (perm_q) { const int hh = nn / 192, e = nn - hh * 192; nn = (e < 128) ? hh * 128 + e : 1024 + hh * 64 + (e - 128); }
        *(u32x4*)(WT + (size_t)nn * K + k0 + 8 * c) = o; }
    asm volatile("s_waitcnt lgkmcnt(0)" ::: "memory");
}
struct TrDesc { const float* W; const float* gain; bf16_t* WT; int K, N, items; };

__device__ __forceinline__ void p0_gemv_task(Frame& F, int task, const float* ada_w, const float* ada_b, float* mod) {
    LAS float* sv = (LAS float*)F.lds; LAS float* part = (LAS float*)(F.lds + 32768);
    const int l = task / 192, n0 = (task % 192) * 64, rg = F.lane >> 4, c4 = (F.lane & 15) * 4;
    const float* Wp = ada_w + (size_t)l * DM * NMOD + n0 + c4 + (size_t)(F.wave * 256 + rg) * NMOD;
    f32x4 a0 = {0, 0, 0, 0}, a1 = a0, a2 = a0;
    for (int k = 0; k < 256; k += 32) {
        f32x4 w[8];
#pragma unroll
        for (int u = 0; u < 8; ++u) w[u] = *(const f32x4*)(Wp + (size_t)(k + 4 * u) * NMOD);
#pragma unroll
        for (int u = 0; u < 8; ++u) { const int kk = F.wave * 256 + k + 4 * u + rg; const float s0 = sv[kk], s1 = sv[2048 + kk], s2 = sv[4096 + kk];
            a0 += w[u] * s0; a1 += w[u] * s1; a2 += w[u] * s2; }
    }
    LAS float* pp = part + ((F.wave * 4 + rg) * 3) * 64 + c4;
    *(LAS f32x4*)(pp) = a0; *(LAS f32x4*)(pp + 64) = a1; *(LAS f32x4*)(pp + 128) = a2;
    __syncthreads();
    if (F.tid < 192) { const int r = F.tid >> 6, c = F.tid & 63; float s = 0.f;
#pragma unroll
        for (int q = 0; q < 32; ++q) s += part[(q * 3 + r) * 64 + c];
        mod[(size_t)(l * 3 + r) * NMOD + n0 + c] = s + ada_b[(size_t)l * NMOD + n0 + c]; }
    __syncthreads();
}

__device__ __forceinline__ void p0_prologue(Frame& F, const float* const* in) {
    unsigned char* ws = F.ws;
    {
        LAS float* sv = (LAS float*)F.lds;
        for (int i = F.tid; i < 3 * DM; i += NTHREADS) { const int r = i / DM, k = i - r * DM; const float x = (r < 2) ? in[1][r * DM + k] : in[3][k]; sv[i] = x / (1.f + __expf(-x)); }
        __syncthreads();
        for (int task = F.vcu; task < 768; task += F.G) p0_gemv_task(F, task, in[4], in[5], (float*)(ws + WS_MOD));
        __syncthreads();
    }
    {
        float* xw = (float*)(ws + WS_XW);
        for (int row = F.gw; row < MROWS; row += F.NGW) { const int b = row / RB, i = row - b * RB;
            const float* src = (i < CTX) ? in[2] + (size_t)(b * CTX + i) * DM : in[0] + (size_t)(b * SEQ + i - CTX) * DM;
            const f32x4* s4 = (const f32x4*)src + F.lane; f32x4* d4 = (f32x4*)(xw + (size_t)row * DM) + F.lane;
#pragma unroll
            for (int j = 0; j < 8; ++j) d4[64 * j] = s4[64 * j]; }
    }
    {
        float* sm = (float*)(ws + WS_SMALL); const int g = F.vcu * NTHREADS + F.tid;
        if (g < 8192) { sm[SM_N1G + g] = in[6][g]; sm[SM_N2G + g] = in[7][g]; }
        if (g < 384) { sm[SM_AQG + g] = in[13][g]; sm[SM_AKG + g] = in[14][g]; }
        if (g < 6144) sm[SM_CW + g] = in[15][g];
        if (g < 2048) sm[SM_CB + g] = in[16][g];
        if (g < 256) { sm[SM_CQG + g] = in[19][g]; sm[SM_CKG + g] = in[20][g]; }
    }
    {
        float* rc = (float*)(ws + WS_ROPE); float* ra = rc + 64 * 32 * 2;
        const int g = F.vcu * NTHREADS + F.tid;
        if (g < 64 * 32) { const int pos = g >> 5, f = g & 31; const float fr = exp2f(-(float)f * (13.287712379549449f / 32.f)); const float ang = (float)pos * fr;
            rc[2 * g] = cosf(ang); rc[2 * g + 1] = sinf(ang); }
        else if (g < 64 * 32 + 64 * 16) { const int e = g - 64 * 32, pos = e >> 4, f = e & 15; const float fr = exp2f(-(float)f * (13.287712379549449f / 16.f)); const float ang = (float)pos * fr;
            ra[2 * e] = cosf(ang); ra[2 * e + 1] = sinf(ang); }
    }
    {
        LAS float* scr = (LAS float*)(F.lds + F.wave * 16384);
        TrDesc d[16]; int nd = 0;
#pragma unroll
        for (int i = 0; i < 2; ++i) {
            d[nd++] = TrDesc{in[8] + (size_t)i * DM * 3904, nullptr, (bf16_t*)(ws + WS_WIN) + (size_t)i * 4096 * DM, DM, 3904, 32 * 122};
            d[nd++] = TrDesc{in[11] + (size_t)i * 512 * 1536, in[9] + i * 512, (bf16_t*)(ws + WS_WUQ) + (size_t)i * 1536 * 512, 512, 1536, 8 * 48};
            d[nd++] = TrDesc{in[12] + (size_t)i * 256 * 2048, in[10] + i * 256, (bf16_t*)(ws + WS_WUKV) + (size_t)i * 2048 * 256, 256, 2048, 4 * 64};
            d[nd++] = TrDesc{in[17] + (size_t)i * DM * DM, nullptr, (bf16_t*)(ws + WS_WEO) + (size_t)i * DM * DM, DM, DM, 32 * 64};
            d[nd++] = TrDesc{in[18] + (size_t)i * DM * 3072, nullptr, (bf16_t*)(ws + WS_WQKV) + (size_t)i * 3072 * DM, DM, 3072, 32 * 96};
            d[nd++] = TrDesc{in[21] + (size_t)i * DM * DM, nullptr, (bf16_t*)(ws + WS_WCO) + (size_t)i * DM * DM, DM, DM, 32 * 64};
        }
#pragma unroll
        for (int l = 0; l < 4; ++l) d[nd++] = TrDesc{in[22] + (size_t)l * DM * DM, nullptr, (bf16_t*)(ws + WS_WPQ) + (size_t)l * DM * DM, DM, DM, 32 * 64};
#pragma unroll
        for (int m = 0; m < 16; ++m) {
            for (int it = F.gw; it < d[m].items; it += F.NGW) p0_transpose_item(d[m].W, d[m].K, d[m].N, d[m].WT, d[m].gain, scr, it, F.lane, d[m].K == 512);
        }
        for (int i = F.gw * 64 + F.lane; i < 2 * 192 * DM / 8; i += F.NGW * 64) { const int li = i / (192 * DM / 8), r = i % (192 * DM / 8);
            *(u32x4*)((bf16_t*)(ws + WS_WIN) + (size_t)li * 4096 * DM + (size_t)3904 * DM + (size_t)r * 8) = (u32x4){0u, 0u, 0u, 0u}; }
    }
    {
        const size_t n_sk = (size_t)4 * 16 * 128 * 128 / 8;
        const size_t gt = (size_t)F.vcu * NTHREADS + F.tid, GT = (size_t)F.G * NTHREADS;
        for (size_t j = gt; j < n_sk; j += GT) {
            const f32x4 a = *(const f32x4*)(in[23] + j * 8), b = *(const f32x4*)(in[23] + j * 8 + 4);
            u32x4 o; o.x = pk2(a.x, a.y); o.y = pk2(a.z, a.w); o.z = pk2(b.x, b.y); o.w = pk2(b.z, b.w);
            *(u32x4*)((bf16_t*)(ws + WS_SUBK) + j * 8) = o;
        }
    }
    {
        for (int r = F.gw; r < 2 * 4 * NEXP; r += F.NGW) {
            const int tab = r / (4 * NEXP), rr = r - tab * (4 * NEXP);
#if EXP_SLICED
            const float* src = (tab ? in[25] : in[24]) + (size_t)rr * DM + F.lane * 32;
            f32x4 v[8];
#pragma unroll
            for (int q = 0; q < 8; ++q) v[q] = *(const f32x4*)(src + q * 4);
#else
            const float* src = (tab ? in[25] : in[24]) + (size_t)rr * DM + F.lane * 16;
            f32x4 v[8];
#pragma unroll
            for (int j = 0; j < 2; ++j)
#pragma unroll
                for (int q = 0; q < 4; ++q) v[j * 4 + q] = *(const f32x4*)(src + j * 1024 + q * 4);
#endif
            float am = 0.f;
#pragma unroll
            for (int q = 0; q < 8; ++q) am = fmaxf(fmaxf(am, fmaxf(fabsf(v[q].x), fabsf(v[q].y))), fmaxf(fabsf(v[q].z), fabsf(v[q].w)));
#pragma unroll
            for (int o = 1; o < 64; o <<= 1) am = fmaxf(am, __shfl_xor(am, o));
            am = fmaxf(am, 1e-30f);
#if TAB_FP4
            float ssq = 0.f;
#pragma unroll
            for (int q = 0; q < 8; ++q) ssq += (v[q].x * v[q].x + v[q].y * v[q].y) + (v[q].z * v[q].z + v[q].w * v[q].w);
#pragma unroll
            for (int o = 1; o < 64; o <<= 1) ssq += __shfl_xor(ssq, o);
            const float sig = fmaxf(sqrtf(ssq * (1.f / DM)), am * (1.f / 64.f));
            unsigned w4[4];
#if EXP_SLICED
            if (tab == 0 && !PEER_MFMA) {
                const float delta = 0.3352f * sig, isc = 1.0f / delta;
#pragma unroll
                for (int q = 0; q < 4; ++q) { unsigned t = 0u;
#pragma unroll
                    for (int hh = 0; hh < 2; ++hh) { const f32x4 x = v[2 * q + hh] * isc;
                        const int n0 = min(max((int)floorf(x.x), -8), 7) & 15, n1 = min(max((int)floorf(x.y), -8), 7) & 15, n2 = min(max((int)floorf(x.z), -8), 7) & 15, n3 = min(max((int)floorf(x.w), -8), 7) & 15;
                        t |= ((unsigned)n0 | ((unsigned)n1 << 4) | ((unsigned)n2 << 8) | ((unsigned)n3 << 12)) << (16 * hh); }
                    w4[q] = t; }
                { const int ll = rr / NEXP, ee = rr - ll * NEXP;
                  *(u32x4*)(ws + WS_U + (size_t)ll * NEXP * ROWB + (size_t)(F.lane >> 3) * (NEXP * 128) + (size_t)ee * 128 + (F.lane & 7) * 16) = (u32x4){w4[0], w4[1], w4[2], w4[3]}; }
                if (F.lane == 0) ((float*)(ws + WS_USC))[rr] = delta;
                continue;
            }
#endif
            const float sc = 2.0f / sig;
#pragma unroll
            for (int q = 0; q < 4; ++q) { unsigned t = 0u;
                const f32x4 xa = v[2 * q] * sc, xb = v[2 * q + 1] * sc;
#define P0_C6(x) fminf(fmaxf((x), -6.f), 6.f)
                t = __builtin_amdgcn_cvt_scalef32_pk_fp4_f32(t, P0_C6(xa.x), P0_C6(xa.y), 1.0f, 0);
                t = __builtin_amdgcn_cvt_scalef32_pk_fp4_f32(t, P0_C6(xa.z), P0_C6(xa.w), 1.0f, 1);
                t = __builtin_amdgcn_cvt_scalef32_pk_fp4_f32(t, P0_C6(xb.x), P0_C6(xb.y), 1.0f, 2);
                t = __builtin_amdgcn_cvt_scalef32_pk_fp4_f32(t, P0_C6(xb.z), P0_C6(xb.w), 1.0f, 3);
#undef P0_C6
                w4[q] = t; }
#if EXP_SLICED
            { const int ll = rr / NEXP, ee = rr - ll * NEXP;
              *(u32x4*)(ws + (tab ? WS_VT : WS_U) + (size_t)ll * NEXP * ROWB + (size_t)(F.lane >> 3) * (NEXP * 128) + (size_t)ee * 128 + (F.lane & 7) * 16) = (u32x4){w4[0], w4[1], w4[2], w4[3]}; }
#else
            *(u32x4*)(ws + (tab ? WS_VT : WS_U) + (size_t)rr * ROWB + F.lane * 16) = (u32x4){w4[0], w4[1], w4[2], w4[3]};
#endif
            if (F.lane == 0) ((float*)(ws + (tab ? WS_VSC : WS_USC)))[rr] = sig * 0.5f;
#else
            const float sc = 7.5f / am;
            f32x16 a, b;
#pragma unroll
            for (int q = 0; q < 8; ++q) { const f32x4 x = v[q] * sc; a[2 * q] = x.x; b[2 * q] = x.y; a[2 * q + 1] = x.z; b[2 * q + 1] = x.w; }
            const u32x6 w = __builtin_amdgcn_cvt_scalef32_2xpk16_fp6_f32(a, b, 1.0f);
            unsigned char* dst = ws + (tab ? WS_VT : WS_U) + (size_t)rr * ROWB;
            *(u32x4*)(dst + F.lane * 16) = (u32x4){w[0], w[1], w[2], w[3]};
            *(u32x2*)(dst + 1024 + F.lane * 8) = (u32x2){w[4], w[5]};
            if (F.lane == 0) ((float*)(ws + (tab ? WS_VSC : WS_USC)))[rr] = am * (1.0f / 7.5f);
#endif
        }
    }
}

#define DPP_MOV(v, ctrl) __builtin_bit_cast(float, __builtin_amdgcn_update_dpp(0, __builtin_bit_cast(int, (v)), (ctrl), 0xf, 0xf, true))
__device__ __forceinline__ void norm_phase(const Frame& F0, const float* xw, const float* g, const float* modl  , int off_sh, int off_sc, bf16_t* H, bool lat_only, unsigned* XQ = nullptr, float* XS = nullptr) {
    const Frame F = phase_frame(F0);
    f32x4 gm[8], shv[8]; int cur_cls = -1;
    int row = F.gw; if (lat_only) while (row < MROWS && row_cls(row) == 2) row += F.NGW;
    f32x4 v[8];
    if (row < MROWS) { const f32x4* x4 = (const f32x4*)(xw + (size_t)row * DM) + F.lane;
#pragma unroll
        for (int j = 0; j < 8; ++j) v[j] = x4[64 * j]; }
    while (row < MROWS) {
        int nrow = row + F.NGW; if (lat_only) while (nrow < MROWS && row_cls(nrow) == 2) nrow += F.NGW;
        f32x4 vn[8];
        if (nrow < MROWS) { const f32x4* x4 = (const f32x4*)(xw + (size_t)nrow * DM) + F.lane;
#pragma unroll
            for (int j = 0; j < 8; ++j) vn[j] = x4[64 * j]; }
        const int cls = row_cls(row);
        if (cls != cur_cls) {
            cur_cls = cls;
            const f32x4* g4 = (const f32x4*)g + F.lane; const f32x4* sc4 = (const f32x4*)(modl + (size_t)cls * NMOD + off_sc) + F.lane; const f32x4* sh4 = (const f32x4*)(modl + (size_t)cls * NMOD + off_sh) + F.lane;
#pragma unroll
            for (int j = 0; j < 8; ++j) { gm[j] = g4[64 * j] * (sc4[64 * j] + 1.0f); shv[j] = sh4[64 * j]; }
        }
        float ss = 0.f;
#pragma unroll
        for (int j = 0; j < 8; ++j) ss += (v[j].x * v[j].x + v[j].y * v[j].y) + (v[j].z * v[j].z + v[j].w * v[j].w);
        const float rstd = 1.0f / sqrtf(wave_sum_dpp(ss) * (1.f / DM) + EPS);
        u32x2* o2 = (u32x2*)(H + (size_t)row * DM) + F.lane;
#if PEER_MFMA
        if (XQ) {
            f32x4 yv[8]; float am = 0.f;
#pragma unroll
            for (int j = 0; j < 8; ++j) { const f32x4 y = (v[j] * rstd) * gm[j] + shv[j]; yv[j] = y; u32x2 o; o.x = pk2(y.x, y.y); o.y = pk2(y.z, y.w); o2[64 * j] = o;
                am = fmaxf(fmaxf(am, fmaxf(fabsf(y.x), fabsf(y.y))), fmaxf(fabsf(y.z), fabsf(y.w))); }
            am = fmaxf(am, DPP_MOV(am, 0xB1)); am = fmaxf(am, DPP_MOV(am, 0x4E)); am = fmaxf(am, DPP_MOV(am, 0x141)); am = fmaxf(am, DPP_MOV(am, 0x140));
            { const int ai = __builtin_bit_cast(int, am);
              am = fmaxf(fmaxf(__builtin_bit_cast(float, __builtin_amdgcn_readlane(ai, 0)), __builtin_bit_cast(float, __builtin_amdgcn_readlane(ai, 16))),
                         fmaxf(__builtin_bit_cast(float, __builtin_amdgcn_readlane(ai, 32)), __builtin_bit_cast(float, __builtin_amdgcn_readlane(ai, 48)))); }
            am = fmaxf(am, 1e-20f);
            const float qs = 440.0f / am;
            unsigned* q8 = XQ + (size_t)row * (DM / 4) + F.lane;
#pragma unroll
            for (int j = 0; j < 8; ++j) { const f32x4 y = yv[j] * qs; int pk = 0; pk = __builtin_amdgcn_cvt_pk_fp8_f32(y.x, y.y, pk, false); pk = __builtin_amdgcn_cvt_pk_fp8_f32(y.z, y.w, pk, true); q8[64 * j] = (unsigned)pk; }
            if (F.lane == 0) XS[row] = am * (1.0f / 440.0f);
        } else
#endif
        {
#pragma unroll
        for (int j = 0; j < 8; ++j) { const f32x4 y = (v[j] * rstd) * gm[j] + shv[j]; u32x2 o; o.x = pk2(y.x, y.y); o.y = pk2(y.z, y.w); o2[64 * j] = o;
            if (XQ) {
                float am = fmaxf(fmaxf(fabsf(y.x), fabsf(y.y)), fmaxf(fabsf(y.z), fabsf(y.w)));
                am = fmaxf(am, DPP_MOV(am, 0xB1)); am = fmaxf(am, DPP_MOV(am, 0x4E)); am = fmaxf(am, DPP_MOV(am, 0x141)); am = fmaxf(am, 1e-20f);
                const float qs = 119.0f / am; const float yy[4] = {y.x, y.y, y.z, y.w};
                unsigned pl = 0u, ph = 0u; int sq = 0;
#pragma unroll
                for (int i = 0; i < 4; ++i) { const int qi = __float2int_rn(yy[i] * qs); const int lo = ((qi + 8) & 15) - 8; const int hi = (qi - lo) >> 4; sq += qi; pl |= (unsigned)(lo & 15) << (4 * i); ph |= (unsigned)(hi & 15) << (4 * i); }
                const unsigned pl1 = (unsigned)__builtin_amdgcn_update_dpp(0, (int)pl, 0xB1, 0xf, 0xf, true), ph1 = (unsigned)__builtin_amdgcn_update_dpp(0, (int)ph, 0xB1, 0xf, 0xf, true);
                float sqf = (float)sq; sqf = DPP_ADD(sqf, 0xB1); sqf = DPP_ADD(sqf, 0x4E); sqf = DPP_ADD(sqf, 0x141);
                const int chunk = j * 8 + (F.lane >> 3), l8 = F.lane & 7;
                if ((l8 & 1) == 0) { unsigned* q = XQ + ((size_t)row * 64 + chunk) * 8 + (l8 >> 1); q[0] = ph | (ph1 << 16); q[4] = pl | (pl1 << 16); }
                if (l8 == 0) { float* s = XS + ((size_t)row * 64 + chunk) * 2; s[0] = am * (1.0f / 119.0f); s[1] = 0.5f * sqf; }
            } }
        }
        row = nrow;
#pragma unroll
        for (int j = 0; j < 8; ++j) v[j] = vn[j];
    }
}

__device__ __forceinline__ float row16_sum(float v) { v = DPP_ADD(v, 0xB1); v = DPP_ADD(v, 0x4E); v = DPP_ADD(v, 0x141); v = DPP_ADD(v, 0x140); return v; }
__device__ __forceinline__ void prep_odd_phase(const Frame& F0, const bf16_t* P, const float* qg, const float* kg, const float* rope_c, bf16_t* Q, bf16_t* Kb) {
    const Frame F = phase_frame(F0);
    const int l16 = F.lane & 15, d0 = l16 * 8;
    float gq[8], gk[8];
#pragma unroll
    for (int e = 0; e < 8; ++e) { gq[e] = qg[d0 + e]; gk[e] = kg[d0 + e]; }
    const bool lowhalf = l16 < 8;
    const int j0 = (l16 & 7) * 8;
    int row = F.gw;
    u32x4 w[5];
    if (row < MROWS) { const u32x4* pr = (const u32x4*)(P + (size_t)row * 3072) + F.lane;
#pragma unroll
        for (int k = 0; k < 5; ++k) w[k] = pr[64 * k]; }
    while (row < MROWS) {
        const int nrow = row + F.NGW;
        u32x4 wn[5];
        if (nrow < MROWS) { const u32x4* pr = (const u32x4*)(P + (size_t)nrow * 3072) + F.lane;
#pragma unroll
            for (int k = 0; k < 5; ++k) wn[k] = pr[64 * k]; }
        const int b = row / RB, i = row - b * RB; const bool lat = i >= CTX; const int t = i - CTX;
        float cs[8], sn[8];
#pragma unroll
        for (int e = 0; e < 8; ++e) { cs[e] = 1.f; sn[e] = 0.f; }
        if (lat) { const int pos = (j0 < 32) ? (t >> 6) : (t & 63); const f32x4* tb = (const f32x4*)(rope_c + ((pos << 5) + (j0 & 31)) * 2);
#pragma unroll
            for (int q = 0; q < 4; ++q) { const f32x4 c = tb[q]; cs[2 * q] = c.x; sn[2 * q] = c.y; cs[2 * q + 1] = c.z; sn[2 * q + 1] = c.w; } }
#pragma unroll
        for (int k = 0; k < 5; ++k) {
            const unsigned ww[4] = {w[k].x, w[k].y, w[k].z, w[k].w};
            float x[8]; float ss = 0.f;
#pragma unroll
            for (int q = 0; q < 4; ++q) { x[2 * q] = bf_lo(ww[q]); x[2 * q + 1] = bf_hi(ww[q]); ss += x[2 * q] * x[2 * q] + x[2 * q + 1] * x[2 * q + 1]; }
            const float rstd = 1.0f / sqrtf(row16_sum(ss) * (1.f / 128.f) + EPS);
            unsigned ow[4]; float o[8];
#pragma unroll
            for (int e = 0; e < 8; ++e) { const float y = x[e] * rstd * (k < 4 ? gq[e] : gk[e]); const float yp = DPP_MOV(y, 0x128);
                o[e] = lowhalf ? (y * cs[e] - yp * sn[e]) : (y * cs[e] + yp * sn[e]); }
#pragma unroll
            for (int q = 0; q < 4; ++q) ow[q] = pk2(o[2 * q], o[2 * q + 1]);
            if (k < 4) *((u32x4*)(Q + (size_t)row * 2048) + 64 * k + F.lane) = (u32x4){ow[0], ow[1], ow[2], ow[3]};
            else *((u32x4*)(Kb + (size_t)row * 512) + F.lane) = (u32x4){ow[0], ow[1], ow[2], ow[3]};
        }
        row = nrow;
#pragma unroll
        for (int k = 0; k < 5; ++k) w[k] = wn[k];
    }
}

struct PrepEvenRow { u32x4 cq; u32x2 ckv, kr; u32x4 qn[2]; u32x2 qr[2]; u32x4 kn[2], vv[2]; };
__device__ __forceinline__ void prep_even_load(PrepEvenRow& R, const bf16_t* P, const bf16_t* QR, const bf16_t* KVR, int row, int lane) {
    const bf16_t* pr = P + (size_t)row * 4096; const int l16 = lane & 15, hq = lane >> 4;
    R.cq = *((const u32x4*)pr + lane); R.ckv = *((const u32x2*)(pr + 512) + lane); R.kr = *((const u32x2*)(pr + 768) + l16);
    const bf16_t* q = QR + (size_t)row * 1536; const bf16_t* kv = KVR + (size_t)row * 2048;
#pragma unroll
    for (int k = 0; k < 2; ++k) { R.qn[k] = *((const u32x4*)q + 64 * k + lane); R.qr[k] = *((const u32x2*)(q + 1024) + 64 * k + lane);
        const bf16_t* kh = kv + (4 * k + hq) * 256 + l16 * 8; R.kn[k] = *(const u32x4*)kh; R.vv[k] = *(const u32x4*)(kh + 128); }
}
__device__ __forceinline__ void prep_even_phase(const Frame& F0, const bf16_t* P, const bf16_t* QR, const bf16_t* KVR, const float* qg, const float* kg, const float* rope_a, bf16_t* Q, bf16_t* Kb, bf16_t* Vb) {
    const Frame F = phase_frame(F0);
    const int lane = F.lane, l16 = lane & 15, hq = lane >> 4, d0 = l16 * 8, r0 = l16 * 4;
    float gqn[8], gkn[8], gqr[4], gkr[4];
#pragma unroll
    for (int e = 0; e < 8; ++e) { gqn[e] = qg[d0 + e]; gkn[e] = kg[d0 + e]; }
#pragma unroll
    for (int e = 0; e < 4; ++e) { gqr[e] = qg[128 + r0 + e]; gkr[e] = kg[128 + r0 + e]; }
    const bool lowhalf = l16 < 8; const int j0 = (l16 & 7) * 4;
    int row = F.gw;
    PrepEvenRow R;
    if (row < MROWS) prep_even_load(R, P, QR, KVR, row, lane);
    while (row < MROWS) {
        const int nrow = row + F.NGW;
        PrepEvenRow Rn;
        if (nrow < MROWS) prep_even_load(Rn, P, QR, KVR, nrow, lane);
        const int b = row / RB, i = row - b * RB; const bool lat = i >= CTX; const int t = i - CTX;
        float cs[4], sn[4];
#pragma unroll
        for (int e = 0; e < 4; ++e) { cs[e] = 1.f; sn[e] = 0.f; }
        if (lat) { const int pos = (j0 < 16) ? (t >> 6) : (t & 63); const f32x4* tb = (const f32x4*)(rope_a + ((pos << 4) + (j0 & 15)) * 2);
            const f32x4 c0 = tb[0], c1 = tb[1]; cs[0] = c0.x; sn[0] = c0.y; cs[1] = c0.z; sn[1] = c0.w; cs[2] = c1.x; sn[2] = c1.y; cs[3] = c1.z; sn[3] = c1.w; }
        float ssq = 0.f, sskv = 0.f;
        { const unsigned ww[4] = {R.cq.x, R.cq.y, R.cq.z, R.cq.w};
#pragma unroll
          for (int q = 0; q < 4; ++q) { const float a = bf_lo(ww[q]), c = bf_hi(ww[q]); ssq += a * a + c * c; } }
        { const float a = bf_lo(R.ckv.x), c = bf_hi(R.ckv.x), d = bf_lo(R.ckv.y), e = bf_hi(R.ckv.y); sskv = (a * a + c * c) + (d * d + e * e); }
        const float rstd_q = 1.0f / sqrtf(wave_sum_dpp(ssq) * (1.f / 512.f) + EPS), rstd_kv = 1.0f / sqrtf(wave_sum_dpp(sskv) * (1.f / 256.f) + EPS);
        const float krv[4] = {bf_lo(R.kr.x), bf_hi(R.kr.x), bf_lo(R.kr.y), bf_hi(R.kr.y)};
        const float krss = (krv[0] * krv[0] + krv[1] * krv[1]) + (krv[2] * krv[2] + krv[3] * krv[3]);
#pragma unroll
        for (int k = 0; k < 2; ++k) {
            const int h = 4 * k + hq;
            {
                const unsigned wn[4] = {R.qn[k].x, R.qn[k].y, R.qn[k].z, R.qn[k].w};
                float xn[8], xr[4]; float ss = 0.f;
#pragma unroll
                for (int q = 0; q < 4; ++q) { xn[2 * q] = bf_lo(wn[q]) * rstd_q; xn[2 * q + 1] = bf_hi(wn[q]) * rstd_q; ss += xn[2 * q] * xn[2 * q] + xn[2 * q + 1] * xn[2 * q + 1]; }
                xr[0] = bf_lo(R.qr[k].x) * rstd_q; xr[1] = bf_hi(R.qr[k].x) * rstd_q; xr[2] = bf_lo(R.qr[k].y) * rstd_q; xr[3] = bf_hi(R.qr[k].y) * rstd_q;
                ss += (xr[0] * xr[0] + xr[1] * xr[1]) + (xr[2] * xr[2] + xr[3] * xr[3]);
                const float r2 = 1.0f / sqrtf(row16_sum(ss) * (1.f / 192.f) + EPS);
                unsigned on[4]; float o[4];
#pragma unroll
                for (int q = 0; q < 4; ++q) on[q] = pk2(xn[2 * q] * r2 * gqn[2 * q], xn[2 * q + 1] * r2 * gqn[2 * q + 1]);
#pragma unroll
                for (int e = 0; e < 4; ++e) { const float y = xr[e] * r2 * gqr[e]; const float yp = DPP_MOV(y, 0x128); o[e] = lowhalf ? (y * cs[e] - yp * sn[e]) : (y * cs[e] + yp * sn[e]); }
                bf16_t* qo = Q + (size_t)row * 1536 + h * 192;
                *(u32x4*)(qo + d0) = (u32x4){on[0], on[1], on[2], on[3]};
                *(u32x2*)(qo + 128 + r0) = (u32x2){pk2(o[0], o[1]), pk2(o[2], o[3])};
            }
            {
                const unsigned wn[4] = {R.kn[k].x, R.kn[k].y, R.kn[k].z, R.kn[k].w}, wv[4] = {R.vv[k].x, R.vv[k].y, R.vv[k].z, R.vv[k].w};
                float xn[8]; float ss = krss;
#pragma unroll
                for (int q = 0; q < 4; ++q) { xn[2 * q] = bf_lo(wn[q]) * rstd_kv; xn[2 * q + 1] = bf_hi(wn[q]) * rstd_kv; ss += xn[2 * q] * xn[2 * q] + xn[2 * q + 1] * xn[2 * q + 1]; }
                const float r2 = 1.0f / sqrtf(row16_sum(ss) * (1.f / 192.f) + EPS);
                unsigned on[4], ov[4]; float o[4];
#pragma unroll
                for (int q = 0; q < 4; ++q) { on[q] = pk2(xn[2 * q] * r2 * gkn[2 * q], xn[2 * q + 1] * r2 * gkn[2 * q + 1]); ov[q] = pk2(bf_lo(wv[q]) * rstd_kv, bf_hi(wv[q]) * rstd_kv); }
#pragma unroll
                for (int e = 0; e < 4; ++e) { const float y = krv[e] * r2 * gkr[e]; const float yp = DPP_MOV(y, 0x128); o[e] = lowhalf ? (y * cs[e] - yp * sn[e]) : (y * cs[e] + yp * sn[e]); }
                bf16_t* ko = Kb + (size_t)row * 1536 + h * 192;
                *(u32x4*)(ko + d0) = (u32x4){on[0], on[1], on[2], on[3]};
                *(u32x2*)(ko + 128 + r0) = (u32x2){pk2(o[0], o[1]), pk2(o[2], o[3])};
                *(u32x4*)(Vb + (size_t)row * 1024 + h * 128 + d0) = (u32x4){ov[0], ov[1], ov[2], ov[3]};
            }
        }
        row = nrow; R = Rn;
    }
}

__device__ __forceinline__ void conv_phase(const Frame& F0, const bf16_t* P, const float* cw  , const float* cb  , bf16_t* CAT) {
    const Frame F = phase_frame(F0);
    const int gt = F.vcu * NTHREADS + F.tid, GT = F.G * NTHREADS;
    for (int it = gt; it < MROWS * 128; it += GT) {
        const int row = it >> 7, c0 = (it & 127) * 8; const int b = row / RB, i = row - b * RB;
        const bool first = (i == 0) || (i == CTX), last = (i == CTX - 1) || (i == RB - 1);
        const bf16_t* pr = P + (size_t)row * 4096 + 832 + c0;
        const u32x4 bg = *(const u32x4*)pr, cg = *(const u32x4*)(pr + 1024), hz = *(const u32x4*)(pr + 2048);
        u32x4 cgm = {0u, 0u, 0u, 0u}, hzm = cgm, cgp = cgm, hzp = cgm;
        if (!first) { cgm = *(const u32x4*)(pr - 4096 + 1024); hzm = *(const u32x4*)(pr - 4096 + 2048); }
        if (!last) { cgp = *(const u32x4*)(pr + 4096 + 1024); hzp = *(const u32x4*)(pr + 4096 + 2048); }
        const unsigned bgw[4] = {bg.x, bg.y, bg.z, bg.w}, cgw[4] = {cg.x, cg.y, cg.z, cg.w}, hzw[4] = {hz.x, hz.y, hz.z, hz.w};
        const unsigned cmw[4] = {cgm.x, cgm.y, cgm.z, cgm.w}, hmw[4] = {hzm.x, hzm.y, hzm.z, hzm.w}, cpw[4] = {cgp.x, cgp.y, cgp.z, cgp.w}, hpw[4] = {hzp.x, hzp.y, hzp.z, hzp.w};
        unsigned ow[4];
#pragma unroll
        for (int q = 0; q < 4; ++q) {
            const int c = c0 + 2 * q;
            const float u0a = bf_lo(cgw[q]) * bf_lo(hzw[q]), u0b = bf_hi(cgw[q]) * bf_hi(hzw[q]);
            const float uma = bf_lo(cmw[q]) * bf_lo(hmw[q]), umb = bf_hi(cmw[q]) * bf_hi(hmw[q]);
            const float upa = bf_lo(cpw[q]) * bf_lo(hpw[q]), upb = bf_hi(cpw[q]) * bf_hi(hpw[q]);
            const float ra = bf_lo(bgw[q]) * (uma * cw[c] + u0a * cw[1024 + c] + upa * cw[2048 + c] + cb[c]);
            const float rb = bf_hi(bgw[q]) * (umb * cw[c + 1] + u0b * cw[1024 + c + 1] + upb * cw[2048 + c + 1] + cb[c + 1]);
            ow[q] = pk2(ra, rb);
        }
        *(u32x4*)(CAT + (size_t)row * DM + 1024 + c0) = (u32x4){ow[0], ow[1], ow[2], ow[3]};
    }
}
__device__ __forceinline__ void attn_even_phase(const Frame& F0, const bf16_t* Q, const bf16_t* Kb, const bf16_t* Vb, bf16_t* CAT) {
    const Frame F = phase_frame(F0);
    for (int u = F.vcu; u < 272; u += F.G) {
        int b, h, qt, nk;
        if (u < 256) { b = u >> 7; h = (u >> 4) & 7; qt = 1 + (u & 15); nk = RB; } else { const int v = u - 256; b = v >> 3; h = v & 7; qt = 0; nk = CTX; }
        const size_t r0 = (size_t)b * RB;
        att::attn_body1<192, 1536, 1536, 1024, 2048>(Q + (r0 + qt * 256) * 1536 + h * 192, Kb + r0 * 1536 + h * 192, Vb + r0 * 1024 + h * 128, CAT + (r0 + qt * 256) * 2048 + h * 128, nk, (char*)F.lds, phase_tid(F.wave));
    }
}
__device__ __forceinline__ void attn_odd_phase(const Frame& F0, const bf16_t* Q, const bf16_t* Kb, const bf16_t* P, bf16_t* CAT, bool lat_only) {
    const Frame F = phase_frame(F0);
    const int nunits = lat_only ? 512 : 544;
    for (int u = F.vcu; u < nunits; u += F.G) {
        int b, hq, qt, nk;
        if (u < 512) { b = u >> 8; hq = (u >> 4) & 15; qt = 1 + (u & 15); nk = RB; } else { const int v = u - 512; b = v >> 4; hq = v & 15; qt = 0; nk = CTX; }
        const int kvh = hq >> 2; const size_t r0 = (size_t)b * RB;
        att::attn_body<128, 2048, 512, 3072, 2048, 2>(Q + (r0 + qt * 256) * 2048 + hq * 128, Kb + r0 * 512 + kvh * 128, P + r0 * 3072 + 2560 + kvh * 128, CAT + (r0 + qt * 256) * 2048 + hq * 128, nk, (char*)F.lds, phase_tid(F.wave));
    }
}

__device__ __forceinline__ int crow32(int r, int hi) { return (r & 3) + 8 * (r >> 2) + 4 * hi; }
__device__ __forceinline__ int fkey(int b) { return b ^ ((b >> 31) & 0x7fffffff); }
#define TK_CE(x, y) do { const int hi_ = max((x), (y)), lo_ = min((x), (y)); (x) = hi_; (y) = lo_; } while (0)
template <int N> __device__ __forceinline__ void tk_sort(int* v) {
#pragma unroll
    for (int k = 2; k <= N; k <<= 1)
#pragma unroll
        for (int j = k >> 1; j > 0; j >>= 1)
#pragma unroll
            for (int i = 0; i < N; ++i) { const int l = i ^ j; if (l > i) { if ((i & k) == 0) TK_CE(v[i], v[l]); else TK_CE(v[l], v[i]); } }
}
__device__ __forceinline__ void tk_merge16(int* a, const int* b) {
#pragma unroll
    for (int i = 0; i < 16; ++i) a[i] = max(a[i], b[15 - i]);
#pragma unroll
    for (int j = 8; j > 0; j >>= 1)
#pragma unroll
        for (int i = 0; i < 16; ++i) { const int l = i ^ j; if (l > i) TK_CE(a[i], a[l]); }
}
__device__ __forceinline__ void tk_merge_partner(int* a) {
    int lo[16], hi[16];
#pragma unroll
    for (int i = 0; i < 16; ++i) { auto rr = __builtin_amdgcn_permlane32_swap((unsigned)a[i], (unsigned)a[i], false, false); lo[i] = (int)rr[0]; hi[i] = (int)rr[1]; }
    tk_merge16(lo, hi);
#pragma unroll
    for (int i = 0; i < 16; ++i) a[i] = lo[i];
}
__device__ __forceinline__ void peer_topk_phase(const Frame& F0, const bf16_t* PQ, const bf16_t* subk  , int* IDX, float* GATE, bool lat_only) {
    const Frame F = phase_frame(F0);
    const int h = F.vcu & 7, jw = (F.vcu >> 3) * NWAVES + F.wave, nwh = (F.G >> 3) * NWAVES;
    {
        const bf16_t* src = subk + (size_t)h * 2 * 128 * 128;
        for (int c = F.tid; c < 4096; c += NTHREADS) { const int row = c >> 4, ch = c & 15;
            *(LAS u32x4*)(F.lds + row * 256 + ((ch ^ (row & 15)) << 4)) = *(const u32x4*)(src + (size_t)row * 128 + ch * 8); }
        __syncthreads();
    }
    const int ntg = lat_only ? 256 : MROWS / 32;
    for (int t = jw; t < ntg; t += nwh) {
        int lane_ = F.lane; asm volatile("" : "+v"(lane_));
        const int r32 = lane_ & 31, hi = lane_ >> 5;
        int tg = t; if (lat_only) tg += 8 + (tg >= 128 ? 8 : 0);
        const int token = tg * 32 + r32;
        int top[2][16];
        const int kk = (((r32 & 14) | (hi ^ (r32 & 1))) << 4);
#pragma unroll
        for (int p = 0; p < 2; ++p) {
            bf16x8 bq[8];
            const bf16_t* qp = PQ + (size_t)token * DM + h * 256 + p * 128 + hi * 8;
#pragma unroll
            for (int ks = 0; ks < 8; ++ks) bq[ks] = *(const bf16x8*)(qp + ks * 16);
            int s[4][16];
#pragma unroll
            for (int nb = 0; nb < 4; ++nb) {
                f32x16 acc = {};
                const LAS unsigned char* kp = F.lds + (p * 128 + nb * 32 + r32) * 256;
#pragma unroll
                for (int ks = 0; ks < 8; ++ks) { const bf16x8 a = *(const LAS bf16x8*)(kp + (kk ^ (ks << 5))); acc = __builtin_amdgcn_mfma_f32_32x32x16_bf16(a, bq[ks], acc, 0, 0, 0); }
#pragma unroll
                for (int r = 0; r < 16; ++r) { const int key = nb * 32 + crow32(r, hi); s[nb][r] = fkey((int)((__float_as_uint(acc[r]) & ~127u) | (unsigned)(127 - key))); }
                tk_sort<16>(s[nb]);
            }
            tk_merge16(s[0], s[1]); tk_merge16(s[2], s[3]); tk_merge16(s[0], s[2]);
            tk_merge_partner(s[0]);
#pragma unroll
            for (int j = 0; j < 16; ++j) top[p][j] = s[0][j];
        }
        int cand[32];
        unsigned long long kaLo = 0ull, kaHi = 0ull, kbLo = 0ull, kbHi = 0ull;
        {
            float fb[16]; const float fa0 = __uint_as_float((unsigned)fkey(top[0][0]) & ~127u), fb0 = __uint_as_float((unsigned)fkey(top[1][0]) & ~127u);
#pragma unroll
            for (int r = 0; r < 16; ++r) { const int ba = fkey(top[0][r]), bb = fkey(top[1][r]); fb[r] = __uint_as_float((unsigned)bb & ~127u) - fb0;
                const unsigned long long xa = (unsigned long long)(unsigned)(127 - (ba & 127)) << (8 * (r & 7)), xb = (unsigned long long)(unsigned)(127 - (bb & 127)) << (8 * (r & 7));
                if (r < 8) { kaLo |= xa; kbLo |= xb; } else { kaHi |= xa; kbHi |= xb; } }
            float fa[8];
#pragma unroll
            for (int i = 0; i < 8; ++i) { const int ka = hi ? top[0][2 * i + 1] : top[0][2 * i]; fa[i] = __uint_as_float((unsigned)fkey(ka) & ~127u) - fa0; }
            const int hid = 255 - (hi << 4);
            int n = 0;
#pragma unroll
            for (int i = 0; i < 8; ++i)
#pragma unroll
                for (int b = 0; b < 16; ++b) if ((2 * i + 1) * (b + 1) <= 16) {
                    const float sum = fa[i] + fb[b];
                    cand[n++] = fkey((int)((__float_as_uint(sum) & ~255u) | (unsigned)(hid - (32 * i + b))));
                }
#pragma unroll
            for (; n < 32; ++n) cand[n] = (int)0x80000000;
        }
        tk_sort<16>(cand); tk_sort<16>(cand + 16); tk_merge16(cand, cand + 16);
        tk_merge_partner(cand);
        float ev[16]; float esum = 0.f;
#pragma unroll
        for (int j = 0; j < 16; ++j) { ev[j] = __expf(__uint_as_float((unsigned)fkey(cand[j]) & ~255u)); esum += ev[j]; }
        const float rs = 1.0f / esum;
        int oi[8]; float og[8];
#pragma unroll
        for (int j = 0; j < 8; ++j) { const int w = hi ? cand[8 + j] : cand[j]; const float e = hi ? ev[8 + j] : ev[j];
            const int id8 = 255 - (fkey(w) & 255), ra = id8 >> 4, rb = id8 & 15;
            const unsigned long long wa = (ra & 8) ? kaHi : kaLo, wb = (rb & 8) ? kbHi : kbLo;
            const int ka = (int)(wa >> (8 * (ra & 7))) & 127, kb = (int)(wb >> (8 * (rb & 7))) & 127;
            oi[j] = ka * 128 + kb; og[j] = e * rs; }
        int* ip = IDX + (size_t)token * 128 + h * 16 + hi * 8; float* gp = GATE + (size_t)token * 128 + h * 16 + hi * 8;
        *(int4*)ip = make_int4(oi[0], oi[1], oi[2], oi[3]); *(int4*)(ip + 4) = make_int4(oi[4], oi[5], oi[6], oi[7]);
        *(f32x4*)gp = (f32x4){og[0], og[1], og[2], og[3]}; *(f32x4*)(gp + 4) = (f32x4){og[4], og[5], og[6], og[7]};
    }
}

#if TAB_FP4
__device__ __forceinline__ void peer_expert_phase(const Frame& F0, const bf16_t* H2, const int* IDX, const float* GATE, const unsigned char* U, size_t v_minus_u_bytes, const float* USC, const float* VSC,
                                                  const float* g2  , float* XW, float* OUT,
                                                  bf16_t* HN  , const float* ng  , const float* nmod  ) {
    const Frame F = phase_frame(F0);
    LAS float* red = (LAS float*)F.lds;
    const unsigned voff_tab = (unsigned)v_minus_u_bytes;
    const __amdgpu_buffer_rsrc_t rs = __builtin_amdgcn_make_buffer_rsrc((void*)U, 0, (int)(voff_tab + (unsigned)NEXP * ROWB), 0x00020000);
    const int lane = F.lane; const int voff = lane * 16;
#define PX_SB() __builtin_amdgcn_sched_barrier(0)
#define PX_LOADALL(buf, ivv, tb) do { _Pragma("unroll") for (int e_ = 0; e_ < 16; ++e_) buf[e_] = __builtin_amdgcn_raw_buffer_load_b128(rs, voff, (unsigned)__builtin_amdgcn_readlane(ivv, e_) * (unsigned)ROWB + (tb), 0); } while (0)
#define PX_U1(d_, b_) { const bf16x2_t r2_ = __builtin_amdgcn_cvt_scalef32_pk_bf16_fp4(wd_[d_], 1.0f, b_); if ((b_) & 1) a1_ = __builtin_amdgcn_fdot2_f32_bf16(r2_, __builtin_bit_cast(bf16x2_t, xpk[4 * (d_) + (b_)]), a1_, false); \
                        else a0_ = __builtin_amdgcn_fdot2_f32_bf16(r2_, __builtin_bit_cast(bf16x2_t, xpk[4 * (d_) + (b_)]), a0_, false); }
#define PX_V1(d_, b_) { const f32x2 t2_ = __builtin_amdgcn_cvt_scalef32_pk_f32_fp4(wd_[d_], 1.0f, b_); acc[8 * (d_) + 2 * (b_)] += wg_ * t2_.x; acc[8 * (d_) + 2 * (b_) + 1] += wg_ * t2_.y; }
#define PX_FETCH_TOKEN(r, XP, IV, GV) do { const u32x4* xp_ = (const u32x4*)(H2 + (size_t)(r) * DM + lane * 16); XP[0] = xp_[0]; XP[1] = xp_[1]; XP[2] = xp_[128]; XP[3] = xp_[129]; \
        IV = 0; GV = 0.f; if (lane < 16) { IV = IDX[(size_t)(r) * 128 + F.wave * 16 + lane]; GV = GATE[(size_t)(r) * 128 + F.wave * 16 + lane]; } } while (0)
    const bool skip_ctx = (OUT != nullptr);
    int row = F.vcu; if (skip_ctx && row < MROWS && row_cls(row) == 2) row += F.G;
    u32x4 xp[4]; int iv; float gv;
    u32x4 ub[16], vb[16];
    if (row < MROWS) { PX_FETCH_TOKEN(row, xp, iv, gv); PX_LOADALL(ub, iv, 0u); PX_LOADALL(vb, iv, voff_tab); }
    int par = 0;
    while (row < MROWS) {
        int nrow = row + F.G; if (skip_ctx && nrow < MROWS && row_cls(nrow) == 2) nrow += F.G;
        float usc = 0.f, vsc = 0.f;
        if (lane < 16) { usc = USC[iv]; vsc = VSC[iv]; }
        u32x4 xpn[4]; int ivn = 0; float gvn = 0.f;
        if (nrow < MROWS) PX_FETCH_TOKEN(nrow, xpn, ivn, gvn);
        const int cls = row_cls(row);
        const f32x4 x_old = *((const f32x4*)(XW + (size_t)row * DM) + F.tid), g_vec = *((const f32x4*)(g2 + (size_t)cls * NMOD) + F.tid);
        f32x4 n_g = {0.f, 0.f, 0.f, 0.f}, n_sc = n_g, n_sh = n_g;
        if (HN) { n_g = *((const f32x4*)ng + F.tid); n_sc = *((const f32x4*)(nmod + (size_t)cls * NMOD + 2048) + F.tid); n_sh = *((const f32x4*)(nmod + (size_t)cls * NMOD) + F.tid); }
        const unsigned xpk[16] = {xp[0].x, xp[0].y, xp[0].z, xp[0].w, xp[1].x, xp[1].y, xp[1].z, xp[1].w, xp[2].x, xp[2].y, xp[2].z, xp[2].w, xp[3].x, xp[3].y, xp[3].z, xp[3].w};
        float sv = 0.f;
        PX_SB();
#pragma unroll
        for (int e = 0; e < 16; ++e) {
            u32x4 w_ = ub[e]; asm volatile("" : "+v"(w_) : "v"(sv));
            const unsigned wd_[4] = {w_.x, w_.y, w_.z, w_.w}; float a0_ = 0.f, a1_ = 0.f;
            PX_U1(0, 0) PX_U1(0, 1) PX_U1(0, 2) PX_U1(0, 3) PX_U1(1, 0) PX_U1(1, 1) PX_U1(1, 2) PX_U1(1, 3) PX_U1(2, 0) PX_U1(2, 1) PX_U1(2, 2) PX_U1(2, 3) PX_U1(3, 0) PX_U1(3, 1) PX_U1(3, 2) PX_U1(3, 3)
            const float t_ = wave_sum_dpp(a0_ + a1_); sv = (lane == e) ? t_ : sv;
        }
        const float wv = gelu_erf(sv * usc) * gv * vsc;
        PX_SB();
        if (nrow < MROWS) PX_LOADALL(ub, ivn, 0u);
        PX_SB();
        f32x32 acc = {};
#pragma unroll
        for (int e = 0; e < 16; ++e) {
            u32x4 w_ = vb[e]; asm volatile("" : "+v"(w_) : "v"(acc));
            const unsigned wd_[4] = {w_.x, w_.y, w_.z, w_.w}; const float wg_ = __uint_as_float(__builtin_amdgcn_readlane(__float_as_uint(wv), e));
            PX_V1(0, 0) PX_V1(0, 1) PX_V1(0, 2) PX_V1(0, 3) PX_V1(1, 0) PX_V1(1, 1) PX_V1(1, 2) PX_V1(1, 3) PX_V1(2, 0) PX_V1(2, 1) PX_V1(2, 2) PX_V1(2, 3) PX_V1(3, 0) PX_V1(3, 1) PX_V1(3, 2) PX_V1(3, 3)
        }
        PX_SB();
        if (nrow < MROWS) PX_LOADALL(vb, ivn, voff_tab);
        PX_SB();
        LAS float* rb = red + par * (NWAVES * DM);
#pragma unroll
        for (int j = 0; j < 2; ++j)
#pragma unroll
            for (int q = 0; q < 4; ++q) *(LAS f32x4*)(rb + F.wave * DM + j * 1024 + lane * 16 + q * 4) = (f32x4){acc[j * 16 + q * 4], acc[j * 16 + q * 4 + 1], acc[j * 16 + q * 4 + 2], acc[j * 16 + q * 4 + 3]};
        __syncthreads();
        {
            f32x4 sm = {0.f, 0.f, 0.f, 0.f};
#pragma unroll
            for (int w = 0; w < 8; ++w) sm += *(const LAS f32x4*)(rb + w * DM + F.tid * 4);
            f32x4* xq = (f32x4*)(XW + (size_t)row * DM) + F.tid;
            const f32x4 xn = x_old + g_vec * sm;
            *xq = xn;
            if (OUT) { const int b = row / RB, i = row - b * RB; if (i >= CTX) *((f32x4*)(OUT + ((size_t)b * SEQ + (i - CTX)) * DM) + F.tid) = xn; }
            if (HN) {
                LAS float* ssp = (LAS float*)(F.lds + 131072) + par * 8;
                const float sw = wave_sum_dpp((xn.x * xn.x + xn.y * xn.y) + (xn.z * xn.z + xn.w * xn.w));
                if (lane == 0) ssp[F.wave] = sw;
                __syncthreads();
                const float tot = ((ssp[0] + ssp[1]) + (ssp[2] + ssp[3])) + ((ssp[4] + ssp[5]) + (ssp[6] + ssp[7]));
                const float rstd = 1.0f / sqrtf(tot * (1.f / DM) + EPS);
                const f32x4 y = (xn * rstd) * n_g * (n_sc + 1.0f) + n_sh;
                u32x2 o; o.x = pk2(y.x, y.y); o.y = pk2(y.z, y.w);
                *((u32x2*)(HN + (size_t)row * DM) + F.tid) = o;
            }
        }
        par ^= 1; row = nrow;
#pragma unroll
        for (int q = 0; q < 4; ++q) xp[q] = xpn[q];
        iv = ivn; gv = gvn;
    }
#undef PX_LOADALL
#undef PX_U1
#undef PX_V1
#undef PX_SB
#undef PX_FETCH_TOKEN
}
#else
__device__ __forceinline__ void peer_expert_phase(const Frame& F0, const bf16_t* H2, const int* IDX, const float* GATE, const unsigned char* U, size_t v_minus_u_bytes, const float* USC, const float* VSC,
                                                  const float* g2  , float* XW, float* OUT,
                                                  bf16_t* HN  , const float* ng  , const float* nmod  ) {
    const Frame F = phase_frame(F0);
    LAS float* red = (LAS float*)F.lds;
    const unsigned voff_tab = (unsigned)v_minus_u_bytes;
    const __amdgpu_buffer_rsrc_t rs = __builtin_amdgcn_make_buffer_rsrc((void*)U, 0, (int)(voff_tab + (unsigned)NEXP * ROWB), 0x00020000);
    const int lane = F.lane; const int voff = lane * 16, voff2 = 1024 + lane * 8;
#define PX_SB() __builtin_amdgcn_sched_barrier(0)
#define PX_LOAD(buf, s, ivv) do { constexpr int e0_ = ((s) & 3) * 4; const unsigned tb_ = ((s) >= 4) ? voff_tab : 0u; \
        _Pragma("unroll") for (int ee_ = 0; ee_ < 4; ++ee_) { const unsigned o_ = (unsigned)__builtin_amdgcn_readlane(ivv, e0_ + ee_) * (unsigned)ROWB + tb_; \
            buf##h[ee_] = __builtin_amdgcn_raw_buffer_load_b128(rs, voff, o_, 0); buf##l[ee_] = __builtin_amdgcn_raw_buffer_load_b64(rs, voff2, o_, 0); } } while (0)
#define PX_DECODE(buf, ee_, dep) u32x6 w6_ = {buf##h[ee_].x, buf##h[ee_].y, buf##h[ee_].z, buf##h[ee_].w, buf##l[ee_].x, buf##l[ee_].y}; \
        asm volatile("" : "+v"(w6_) : "v"(dep));     \
        const f32x32 r_ = __builtin_amdgcn_cvt_scalef32_pk32_f32_fp6(w6_, 1.0f);
#define PX_COMP_U(buf, s) do { constexpr int e0_ = ((s) & 3) * 4; \
            _Pragma("unroll") for (int ee_ = 0; ee_ < 4; ++ee_) { PX_DECODE(buf, ee_, sv) \
                const f32x32 p_ = r_ * xf; float a0_ = 0.f, a1_ = 0.f; \
                _Pragma("unroll") for (int k_ = 0; k_ < 32; k_ += 2) { a0_ += p_[k_]; a1_ += p_[k_ + 1]; } \
                const float t_ = wave_sum_dpp(a0_ + a1_); sv = (lane == e0_ + ee_) ? t_ : sv; } } while (0)
#define PX_COMP_V(buf, s) do { constexpr int e0_ = ((s) & 3) * 4; \
            _Pragma("unroll") for (int ee_ = 0; ee_ < 4; ++ee_) { const float wg_ = __uint_as_float(__builtin_amdgcn_readlane(__float_as_uint(wv), e0_ + ee_)); \
                PX_DECODE(buf, ee_, acc) \
                acc += r_ * wg_; } } while (0)
#define PX_FETCH_TOKEN(r, XP, IV, GV) do { const u32x4* xp_ = (const u32x4*)(H2 + (size_t)(r) * DM + lane * 16); XP[0] = xp_[0]; XP[1] = xp_[1]; XP[2] = xp_[128]; XP[3] = xp_[129]; \
        IV = 0; GV = 0.f; if (lane < 16) { IV = IDX[(size_t)(r) * 128 + F.wave * 16 + lane]; GV = GATE[(size_t)(r) * 128 + F.wave * 16 + lane]; } } while (0)
    const bool skip_ctx = (OUT != nullptr);
    int row = F.vcu; if (skip_ctx && row < MROWS && row_cls(row) == 2) row += F.G;
    u32x4 xp[4]; int iv; float gv;
    u32x4 bAh[4], bBh[4]; u32x2 bAl[4], bBl[4];
    if (row < MROWS) { PX_FETCH_TOKEN(row, xp, iv, gv); PX_LOAD(bA, 0, iv); }
    int par = 0;
    while (row < MROWS) {
        int nrow = row + F.G; if (skip_ctx && nrow < MROWS && row_cls(nrow) == 2) nrow += F.G;
        f32x32 xf;
#pragma unroll
        for (int q = 0; q < 4; ++q) { const unsigned ww[4] = {xp[q].x, xp[q].y, xp[q].z, xp[q].w};
#pragma unroll
            for (int k = 0; k < 4; ++k) { xf[q * 8 + 2 * k] = bf_lo(ww[k]); xf[q * 8 + 2 * k + 1] = bf_hi(ww[k]); } }
        float usc = 0.f, vsc = 0.f;
        if (lane < 16) { usc = USC[iv]; vsc = VSC[iv]; }
        u32x4 xpn[4]; int ivn = 0; float gvn = 0.f;
        if (nrow < MROWS) PX_FETCH_TOKEN(nrow, xpn, ivn, gvn);
        const int cls = row_cls(row);
        const f32x4 x_old = *((const f32x4*)(XW + (size_t)row * DM) + F.tid), g_vec = *((const f32x4*)(g2 + (size_t)cls * NMOD) + F.tid);
        f32x4 n_g = {0.f, 0.f, 0.f, 0.f}, n_sc = n_g, n_sh = n_g;
        if (HN) { n_g = *((const f32x4*)ng + F.tid); n_sc = *((const f32x4*)(nmod + (size_t)cls * NMOD + 2048) + F.tid); n_sh = *((const f32x4*)(nmod + (size_t)cls * NMOD) + F.tid); }
        float sv = 0.f, wv = 0.f;
        PX_LOAD(bB, 1, iv); PX_SB(); PX_COMP_U(bA, 0); PX_SB();
        PX_LOAD(bA, 2, iv); PX_SB(); PX_COMP_U(bB, 1); PX_SB();
        PX_LOAD(bB, 3, iv); PX_SB(); PX_COMP_U(bA, 2); PX_SB();
        PX_LOAD(bA, 4, iv); PX_SB(); PX_COMP_U(bB, 3); PX_SB();
        wv = gelu_erf(sv * usc) * gv * vsc;
        f32x32 acc = {};
        PX_LOAD(bB, 5, iv); PX_SB(); PX_COMP_V(bA, 4); PX_SB();
        PX_LOAD(bA, 6, iv); PX_SB(); PX_COMP_V(bB, 5); PX_SB();
        PX_LOAD(bB, 7, iv); PX_SB(); PX_COMP_V(bA, 6); PX_SB();
        if (nrow < MROWS) PX_LOAD(bA, 0, ivn);
        PX_SB(); PX_COMP_V(bB, 7); PX_SB();
        LAS float* rb = red + par * (NWAVES * DM);
#pragma unroll
        for (int j = 0; j < 2; ++j)
#pragma unroll
            for (int q = 0; q < 4; ++q) *(LAS f32x4*)(rb + F.wave * DM + j * 1024 + lane * 16 + q * 4) = (f32x4){acc[j * 16 + q * 4], acc[j * 16 + q * 4 + 1], acc[j * 16 + q * 4 + 2], acc[j * 16 + q * 4 + 3]};
        __syncthreads();
        {
            f32x4 sm = {0.f, 0.f, 0.f, 0.f};
#pragma unroll
            for (int w = 0; w < 8; ++w) sm += *(const LAS f32x4*)(rb + w * DM + F.tid * 4);
            f32x4* xq = (f32x4*)(XW + (size_t)row * DM) + F.tid;
            const f32x4 xn = x_old + g_vec * sm;
            *xq = xn;
            if (OUT) { const int b = row / RB, i = row - b * RB; if (i >= CTX) *((f32x4*)(OUT + ((size_t)b * SEQ + (i - CTX)) * DM) + F.tid) = xn; }
            if (HN) {
                LAS float* ssp = (LAS float*)(F.lds + 131072) + par * 8;
                const float sw = wave_sum_dpp((xn.x * xn.x + xn.y * xn.y) + (xn.z * xn.z + xn.w * xn.w));
                if (lane == 0) ssp[F.wave] = sw;
                __syncthreads();
                const float tot = ((ssp[0] + ssp[1]) + (ssp[2] + ssp[3])) + ((ssp[4] + ssp[5]) + (ssp[6] + ssp[7]));
                const float rstd = 1.0f / sqrtf(tot * (1.f / DM) + EPS);
                const f32x4 y = (xn * rstd) * n_g * (n_sc + 1.0f) + n_sh;
                u32x2 o; o.x = pk2(y.x, y.y); o.y = pk2(y.z, y.w);
                *((u32x2*)(HN + (size_t)row * DM) + F.tid) = o;
            }
        }
        par ^= 1; row = nrow;
#pragma unroll
        for (int q = 0; q < 4; ++q) xp[q] = xpn[q];
        iv = ivn; gv = gvn;
    }
#undef PX_LOAD
#undef PX_COMP_U
#undef PX_COMP_V
#undef PX_SB
#undef PX_FETCH_TOKEN
}
#endif

#if EXP_SLICED && TAB_FP4
__device__ __forceinline__ float oct_sum(float v) { v = DPP_ADD(v, 0xB1); v = DPP_ADD(v, 0x4E); v = DPP_ADD(v, 0x141); return v; }
__device__ __forceinline__ int sl_next_tok(int t, int stride, bool lat_only) { t += stride; if (lat_only) while (t < MROWS && row_cls(t) == 2) t += stride; return t; }
#ifndef PROBE_IDMASK
#define PROBE_IDMASK 0x7fffffff
#endif
#define SL_CL(t_) ((t_) < MROWS ? (t_) : MROWS - 1)
#define SL_IDS(t_, A_, B_) do { A_ = IDX[(size_t)(t_) * 128 + lane] & idmask; B_ = IDX[(size_t)(t_) * 128 + 64 + lane] & idmask; } while (0)
#define SL_ROWS(buf, A_, B_) do { _Pragma("unroll") for (int i_ = 0; i_ < 16; ++i_) { const int id_ = __builtin_amdgcn_ds_bpermute(bp + 32 * (i_ & 7), (i_ < 8) ? (A_) : (B_)); \
        buf[i_] = __builtin_amdgcn_raw_buffer_load_b128(rs, id_ * 128 + coloff, 0, 0); } } while (0)
#if PEER_MFMA
typedef int i32x8 __attribute__((ext_vector_type(8)));
__device__ __forceinline__ void peer_u_phase(const Frame& F0, const unsigned* XQ, const float* XS, const int* IDX, const unsigned char* U, float* PART, bool lat_only, int idmask = 0x7fffffff) {
    const Frame F = phase_frame(F0);
    const int lane = F.lane, g = lane >> 3, j = lane & 7, bp = 4 * g, n = lane & 15, kb = lane >> 4;
    const int wps = F.G >> 3, x = F.vcu / wps, wi = (F.vcu - x * wps) * NWAVES + F.wave, stride = wps * NWAVES;
    const __amdgpu_buffer_rsrc_t rs = __builtin_amdgcn_make_buffer_rsrc((void*)(U + (size_t)x * (NEXP * 128)), 0, NEXP * 128, 0x00020000);
    const int coloff = 16 * j;
    LAS unsigned char* const lbase = F.lds + F.wave * 16384;
    LAS unsigned char* const wr_even = lbase + g * 128 + ((j ^ (g >> 1)) << 4);
    LAS unsigned char* const wr_odd = lbase + g * 128 + ((j ^ (g >> 1) ^ 4) << 4);
    LAS unsigned char* const rd0 = lbase + n * 128 + ((kb ^ (n >> 1)) << 4);
    LAS unsigned char* const rd1 = lbase + n * 128 + (((4 + kb) ^ (n >> 1)) << 4);
    int t = wi - stride; t = sl_next_tok(t, stride, lat_only);
    int t1 = sl_next_tok(t, stride, lat_only), t2 = sl_next_tok(t1, stride, lat_only);
    int idA1 = 0, idB1 = 0, idA2 = 0, idB2 = 0, idA3 = 0, idB3 = 0; u32x4 xs[4], xs1[4], xs2[4], w[16], wn[16];
#define SL_XS(dst, t_) do { const u32x4* xp_ = (const u32x4*)((const unsigned char*)XQ + (size_t)(t_) * DM + 256 * x + 16 * kb); dst[0] = xp_[0]; dst[1] = xp_[4]; dst[2] = xp_[8]; dst[3] = xp_[12]; } while (0)
    { int idA0, idB0; const int c0_ = SL_CL(t), c1_ = SL_CL(t1), c2_ = SL_CL(t2); SL_IDS(c0_, idA0, idB0); SL_XS(xs1, c0_); SL_ROWS(w, idA0, idB0); SL_IDS(c1_, idA2, idB2); SL_XS(xs2, c1_); SL_IDS(c2_, idA3, idB3); }
#define SL_UBODY(CUR, NXT) do { \
        const int t3 = sl_next_tok(t2, stride, lat_only); \
_Pragma("unroll") \
        for (int q = 0; q < 4; ++q) { xs[q] = xs1[q]; xs1[q] = xs2[q]; } \
        idA1 = idA2; idB1 = idB2; idA2 = idA3; idB2 = idB3; \
        SL_ROWS(NXT, idA1, idB1); \
        { const int c2_ = SL_CL(t2), c3_ = SL_CL(t3); SL_XS(xs2, c2_); SL_IDS(c3_, idA3, idB3); } \
_Pragma("unroll") \
        for (int i = 0; i < 16; ++i) *(LAS u32x4*)(((i & 1) ? wr_odd : wr_even) + i * 1024) = CUR[i]; \
        const i32x8 a0 = {(int)xs[0].x, (int)xs[0].y, (int)xs[0].z, (int)xs[0].w, (int)xs[1].x, (int)xs[1].y, (int)xs[1].z, (int)xs[1].w}; \
        const i32x8 a1 = {(int)xs[2].x, (int)xs[2].y, (int)xs[2].z, (int)xs[2].w, (int)xs[3].x, (int)xs[3].y, (int)xs[3].z, (int)xs[3].w}; \
        float res_lo = 0.f, res_hi = 0.f; \
_Pragma("unroll") \
        for (int h = 0; h < 8; ++h) { \
            const u32x4 r0_ = *(LAS u32x4*)(rd0 + h * 2048), r1_ = *(LAS u32x4*)(rd1 + h * 2048); \
            const i32x8 b0 = {(int)r0_.x, (int)r0_.y, (int)r0_.z, (int)r0_.w, 0, 0, 0, 0}; \
            const i32x8 b1 = {(int)r1_.x, (int)r1_.y, (int)r1_.z, (int)r1_.w, 0, 0, 0, 0}; \
            f32x4 d = {0.f, 0.f, 0.f, 0.f}; \
            d = __builtin_amdgcn_mfma_scale_f32_16x16x128_f8f6f4(a0, b0, d, 0, 4, 0, 0, 0, 0); \
            d = __builtin_amdgcn_mfma_scale_f32_16x16x128_f8f6f4(a1, b1, d, 0, 4, 0, 0, 0, 0); \
            if (h < 4) res_lo = (kb == h) ? d[0] : res_lo; else res_hi = (kb == h - 4) ? d[0] : res_hi; \
        } \
        float* pp = PART + ((size_t)t * 8 + x) * 128 + lane; \
        pp[0] = res_lo; pp[64] = res_hi; \
        t = t1; t1 = t2; t2 = t3; \
    } while (0)
    while (t < MROWS) { SL_UBODY(w, wn); if (!(t < MROWS)) break; SL_UBODY(wn, w); }
#undef SL_UBODY
#undef SL_XS
}
#else
__device__ __forceinline__ void peer_u_phase(const Frame& F0, const unsigned* XQ, const float* XS, const int* IDX, const unsigned char* U, float* PART, bool lat_only, int idmask = 0x7fffffff) {
    const Frame F = phase_frame(F0);
    const int lane = F.lane, g = lane >> 3, j = lane & 7, bp = 4 * g;
    const int wps = F.G >> 3, x = F.vcu / wps, wi = (F.vcu - x * wps) * NWAVES + F.wave, stride = wps * NWAVES;
    const __amdgpu_buffer_rsrc_t rs = __builtin_amdgcn_make_buffer_rsrc((void*)(U + (size_t)x * (NEXP * 128)), 0, NEXP * 128, 0x00020000);
    const int coloff = 16 * j;
    int t = wi - stride; t = sl_next_tok(t, stride, lat_only);
    int t1 = sl_next_tok(t, stride, lat_only), t2 = sl_next_tok(t1, stride, lat_only);
    int idA1 = 0, idB1 = 0, idA2 = 0, idB2 = 0, idA3 = 0, idB3 = 0; u32x4 xs[3], xs1[3], xs2[3], w[16], wn[16];
#define SL_XS(dst, t_) do { const u32x4* xp_ = (const u32x4*)(XQ + ((size_t)(t_) * 64 + 8 * x + j) * 8); dst[0] = xp_[0]; dst[1] = xp_[1]; const f32x2 s2_ = *(const f32x2*)(XS + ((size_t)(t_) * 64 + 8 * x + j) * 2); dst[2] = (u32x4){__float_as_uint(s2_.x), __float_as_uint(s2_.y), 0u, 0u}; } while (0)
    { int idA0, idB0; const int c0_ = SL_CL(t), c1_ = SL_CL(t1), c2_ = SL_CL(t2); SL_IDS(c0_, idA0, idB0); SL_XS(xs1, c0_); SL_ROWS(w, idA0, idB0); SL_IDS(c1_, idA2, idB2); SL_XS(xs2, c1_); SL_IDS(c2_, idA3, idB3); }
#define SL_UBODY(CUR, NXT) do { \
        const int t3 = sl_next_tok(t2, stride, lat_only); \
_Pragma("unroll") \
        for (int q = 0; q < 3; ++q) { xs[q] = xs1[q]; xs1[q] = xs2[q]; } \
        idA1 = idA2; idB1 = idB2; idA2 = idA3; idB2 = idB3; \
        SL_ROWS(NXT, idA1, idB1); \
        { const int c2_ = SL_CL(t2), c3_ = SL_CL(t3); SL_XS(xs2, c2_); SL_IDS(c3_, idA3, idB3); } \
        const int xh[4] = {(int)xs[0].x, (int)xs[0].y, (int)xs[0].z, (int)xs[0].w}, xl[4] = {(int)xs[1].x, (int)xs[1].y, (int)xs[1].z, (int)xs[1].w}; \
        const float dq = __uint_as_float(xs[2].x), off = __uint_as_float(xs[2].y); \
        float res_lo = 0.f, res_hi = 0.f; \
_Pragma("unroll") \
        for (int i = 0; i < 16; ++i) { \
            const int wd_[4] = {(int)CUR[i].x, (int)CUR[i].y, (int)CUR[i].z, (int)CUR[i].w}; int ah_ = 0, al_ = 0; \
_Pragma("unroll") \
            for (int d = 0; d < 4; ++d) { ah_ = __builtin_amdgcn_sdot8(wd_[d], xh[d], ah_, false); al_ = __builtin_amdgcn_sdot8(wd_[d], xl[d], al_, false); } \
            const float a_ = oct_sum(((float)(16 * ah_ + al_) + off) * dq); \
            if (i < 8) res_lo = (j == i) ? a_ : res_lo; else res_hi = (j == i - 8) ? a_ : res_hi; \
        } \
        float* pp = PART + ((size_t)t * 8 + x) * 128 + 8 * j + g; \
        pp[0] = res_lo; pp[64] = res_hi; \
        t = t1; t1 = t2; t2 = t3; \
    } while (0)
    while (t < MROWS) { SL_UBODY(w, wn); if (!(t < MROWS)) break; SL_UBODY(wn, w); }
#undef SL_UBODY
#undef SL_XS
}
#endif
#if PEER_VMFMA
typedef int i32x8v __attribute__((ext_vector_type(8)));
typedef int i32x2v __attribute__((ext_vector_type(2)));
__device__ __forceinline__ float wave_max_dpp(float v) {
    v = fmaxf(v, DPP_MOV(v, 0xB1)); v = fmaxf(v, DPP_MOV(v, 0x4E)); v = fmaxf(v, DPP_MOV(v, 0x141)); v = fmaxf(v, DPP_MOV(v, 0x140));
    const int vi = __builtin_bit_cast(int, v);
    return fmaxf(fmaxf(__builtin_bit_cast(float, __builtin_amdgcn_readlane(vi, 0)), __builtin_bit_cast(float, __builtin_amdgcn_readlane(vi, 16))),
                 fmaxf(__builtin_bit_cast(float, __builtin_amdgcn_readlane(vi, 32)), __builtin_bit_cast(float, __builtin_amdgcn_readlane(vi, 48))));
}
__device__ __forceinline__ void peer_wq_phase(const Frame& F0, const float* PART, const int* IDX, const float* GATE, const float* USC, const float* VSC, bool lat_only, unsigned char* WQ8, float* WSC, const float* XS = nullptr) {
    const Frame F = phase_frame(F0);
    const int lane = F.lane;
    for (int t0 = F.gw; t0 < MROWS; t0 += 2 * F.NGW) {
        float s[2][2]; int id[2][2]; float gt[2][2]; bool ok[2];
#pragma unroll
        for (int u = 0; u < 2; ++u) { const int t = t0 + u * F.NGW; ok[u] = t < MROWS && !(lat_only && row_cls(t) == 2);
            s[u][0] = s[u][1] = 0.f; id[u][0] = id[u][1] = 0; gt[u][0] = gt[u][1] = 0.f;
            if (ok[u]) { const float* pp = PART + (size_t)t * 1024 + lane;
#pragma unroll
                for (int xx = 0; xx < 8; ++xx) { s[u][0] += pp[xx * 128]; s[u][1] += pp[xx * 128 + 64]; }
                id[u][0] = IDX[(size_t)t * 128 + lane]; id[u][1] = IDX[(size_t)t * 128 + 64 + lane]; gt[u][0] = GATE[(size_t)t * 128 + lane]; gt[u][1] = GATE[(size_t)t * 128 + 64 + lane]; } }
        float us[2][2], vs[2][2];
#pragma unroll
        for (int u = 0; u < 2; ++u)
#pragma unroll
            for (int q = 0; q < 2; ++q) { us[u][q] = ok[u] ? USC[id[u][q]] : 0.f; vs[u][q] = ok[u] ? VSC[id[u][q]] : 0.f; }
#pragma unroll
        for (int u = 0; u < 2; ++u) if (ok[u]) { const int t = t0 + u * F.NGW;
#if PEER_MFMA
            { const float xsc = XS[t]; us[u][0] *= xsc; us[u][1] *= xsc; }
#endif
            const float w0 = gt[u][0] * gelu_erf(s[u][0] * us[u][0]) * vs[u][0], w1 = gt[u][1] * gelu_erf(s[u][1] * us[u][1]) * vs[u][1];
            const float am = fmaxf(wave_max_dpp(fmaxf(fabsf(w0), fabsf(w1))), 1e-30f), qs = 440.0f / am;
            const int pk = __builtin_amdgcn_cvt_pk_fp8_f32(w0 * qs, w1 * qs, 0, false);
            WQ8[(size_t)t * 128 + lane] = (unsigned char)(pk & 0xff); WQ8[(size_t)t * 128 + 64 + lane] = (unsigned char)((pk >> 8) & 0xff);
            if (lane == 0) WSC[t] = am * (1.0f / 440.0f); }
    }
}
__device__ __forceinline__ void peer_v_phase(const Frame& F0, const int* IDX, const unsigned char* WQ8, const float* WSC, const unsigned char* VT, const float* g2  , float* XW, float* OUT, bool lat_only) {
    const int idmask = 0x7fffffff;
    const Frame F = phase_frame(F0);
    const int lane = F.lane, g = lane >> 3, j = lane & 7, bp = 4 * g, n = lane & 15, kb = lane >> 4;
    const int wps = F.G >> 3, x = F.vcu / wps, wi = (F.vcu - x * wps) * NWAVES + F.wave, stride = wps * NWAVES;
    const __amdgpu_buffer_rsrc_t rs = __builtin_amdgcn_make_buffer_rsrc((void*)(VT + (size_t)x * (NEXP * 128)), 0, NEXP * 128, 0x00020000);
    const int coloff = 16 * j;
    LAS unsigned char* const lbase = F.lds + F.wave * 16384;
    LAS unsigned char* const wr_even = lbase + g * 128 + ((j ^ (g >> 1)) << 4);
    LAS unsigned char* const wr_odd = lbase + g * 128 + ((j ^ (g >> 1) ^ 4) << 4);
    LAS unsigned char* const rd_row = lbase + (32 * kb + n) * 128;
    const int rsw = (n >> 1) << 4;
    const int col0 = 256 * x + lane;
    int t = wi - stride; t = sl_next_tok(t, stride, lat_only);
    int t1 = sl_next_tok(t, stride, lat_only), t2 = sl_next_tok(t1, stride, lat_only);
    int idA1 = 0, idB1 = 0, idA2 = 0, idB2 = 0, idA3 = 0, idB3 = 0; u32x4 w[16], wn[16];
    u32x4 wa[2], wa1[2], wa2[2]; float sc = 0.f, sc1 = 0.f, sc2 = 0.f;
    float xo[4], gv[4], xo1[4], gv1[4], xo2[4], gv2[4];
#pragma unroll
    for (int q = 0; q < 4; ++q) { xo[q] = gv[q] = xo1[q] = gv1[q] = xo2[q] = gv2[q] = 0.f; }
    wa[0] = wa[1] = wa1[0] = wa1[1] = wa2[0] = wa2[1] = (u32x4){0u, 0u, 0u, 0u};
#define SL_WA(dst, S_, t_) do { const u32x4* wp_ = (const u32x4*)(WQ8 + (size_t)(t_) * 128 + 16 * kb); dst[0] = wp_[0]; dst[1] = wp_[4]; S_ = WSC[t_]; } while (0)
#define SL_XG(t_, X_, G_) do { const float* xp_ = XW + (size_t)(t_) * DM + col0; const float* gp_ = g2 + (size_t)row_cls(t_) * NMOD + col0; _Pragma("unroll") for (int q_ = 0; q_ < 4; ++q_) { X_[q_] = xp_[64 * q_]; G_[q_] = gp_[64 * q_]; } } while (0)
    { int idA0, idB0; const int c0_ = SL_CL(t), c1_ = SL_CL(t1), c2_ = SL_CL(t2); SL_IDS(c0_, idA0, idB0); SL_WA(wa1, sc1, c0_); SL_XG(c0_, xo1, gv1); SL_ROWS(w, idA0, idB0);
      SL_IDS(c1_, idA2, idB2); SL_WA(wa2, sc2, c1_); SL_XG(c1_, xo2, gv2); SL_IDS(c2_, idA3, idB3); }
#define SL_VBODY(CUR, NXT) do { \
        const int t3 = sl_next_tok(t2, stride, lat_only); \
        wa[0] = wa1[0]; wa[1] = wa1[1]; wa1[0] = wa2[0]; wa1[1] = wa2[1]; sc = sc1; sc1 = sc2; \
_Pragma("unroll") \
        for (int q = 0; q < 4; ++q) { xo[q] = xo1[q]; gv[q] = gv1[q]; xo1[q] = xo2[q]; gv1[q] = gv2[q]; } \
        idA1 = idA2; idB1 = idB2; idA2 = idA3; idB2 = idB3; \
        SL_ROWS(NXT, idA1, idB1); \
        { const int c2_ = SL_CL(t2), c3_ = SL_CL(t3); SL_WA(wa2, sc2, c2_); SL_XG(c2_, xo2, gv2); SL_IDS(c3_, idA3, idB3); } \
_Pragma("unroll") \
        for (int i = 0; i < 16; ++i) *(LAS u32x4*)(((i & 1) ? wr_odd : wr_even) + i * 1024) = CUR[i]; \
        const i32x8v a = {(int)wa[0].x, (int)wa[0].y, (int)wa[0].z, (int)wa[0].w, (int)wa[1].x, (int)wa[1].y, (int)wa[1].z, (int)wa[1].w}; \
        float vs[4] = {0.f, 0.f, 0.f, 0.f}; \
_Pragma("unroll") \
        for (int cb = 0; cb < 16; ++cb) { \
            LAS unsigned char* ra_ = rd_row + ((((cb >> 1) << 4) ^ rsw) + ((cb & 1) << 3)); \
            const i32x2v lo_ = __builtin_amdgcn_ds_read_tr4_b64_v2i32((LAS i32x2v*)ra_), hi_ = __builtin_amdgcn_ds_read_tr4_b64_v2i32((LAS i32x2v*)(ra_ + 2048)); \
            const i32x8v b_ = {lo_.x, lo_.y, hi_.x, hi_.y, 0, 0, 0, 0}; \
            const f32x4 z_ = {0.f, 0.f, 0.f, 0.f}; \
            const f32x4 d_ = __builtin_amdgcn_mfma_scale_f32_16x16x128_f8f6f4(a, b_, z_, 0, 4, 0, 0, 0, 0); \
            vs[cb >> 2] = (kb == (cb & 3)) ? d_[0] : vs[cb >> 2]; \
        } \
        { const int b = t / RB, i = t - b * RB; \
_Pragma("unroll") \
          for (int q = 0; q < 4; ++q) { const float xn = xo[q] + gv[q] * (sc * vs[q]); XW[(size_t)t * DM + col0 + 64 * q] = xn; \
              if (OUT) { if (i >= CTX) OUT[((size_t)b * SEQ + (i - CTX)) * DM + col0 + 64 * q] = xn; } } } \
        t = t1; t1 = t2; t2 = t3; \
    } while (0)
    while (t < MROWS) { SL_VBODY(w, wn); if (!(t < MROWS)) break; SL_VBODY(wn, w); }
#undef SL_VBODY
#undef SL_WA
#undef SL_XG
}
#else
__device__ __forceinline__ void peer_w_phase(const Frame& F0, const float* PART, const int* IDX, float* GATE, const float* USC, const float* VSC, bool lat_only, const float* XS = nullptr) {
    const Frame F = phase_frame(F0);
    const int gt = F.vcu * NTHREADS + F.tid, GT = F.G * NTHREADS;
    for (int e0 = gt; e0 < MROWS * 128; e0 += 4 * GT) {
        float s[4]; int id[4]; float gte[4], us[4], vs[4]; bool ok[4];
#pragma unroll
        for (int u = 0; u < 4; ++u) { const int e = e0 + u * GT; ok[u] = e < MROWS * 128 && !(lat_only && row_cls(e >> 7) == 2); s[u] = 0.f; id[u] = 0; gte[u] = 0.f;
            if (ok[u]) { const float* pp = PART + (size_t)(e >> 7) * 1024 + (e & 127);
#pragma unroll
                for (int xx = 0; xx < 8; ++xx) s[u] += pp[xx * 128];
                id[u] = IDX[e]; gte[u] = GATE[e]; } }
#pragma unroll
        for (int u = 0; u < 4; ++u) { us[u] = ok[u] ? USC[id[u]] : 0.f; vs[u] = ok[u] ? VSC[id[u]] : 0.f;
#if PEER_MFMA
            if (ok[u]) us[u] *= XS[(e0 + u * GT) >> 7];
#endif
        }
#pragma unroll
        for (int u = 0; u < 4; ++u) if (ok[u]) GATE[e0 + u * GT] = gte[u] * gelu_erf(s[u] * us[u]) * vs[u];
    }
}
#ifdef SELFTEST
#define SELFTEST_LEAK * (1.0f + sqrtf(*(const volatile float*)((const unsigned char*)XW - WS_XW + WS_CTL + 32768)))
#define SELFTEST_SPIKE do { if (b == 0 && i == CTX && mycol == 0) xo_.x += *(const volatile float*)((const unsigned char*)XW - WS_XW + WS_CTL + 32772); } while (0)
#else
#define SELFTEST_LEAK
#define SELFTEST_SPIKE do {} while (0)
#endif
__device__ __forceinline__ void peer_v_phase(const Frame& F0, const int* IDX, const float* WK, const unsigned char* VT, const float* g2  , float* XW, float* OUT, bool lat_only) {
    const int idmask = 0x7fffffff;
    const Frame F = phase_frame(F0);
    const int lane = F.lane, g = lane >> 3, j = lane & 7, bp = 4 * g;
    const int wps = F.G >> 3, x = F.vcu / wps, wi = (F.vcu - x * wps) * NWAVES + F.wave, stride = wps * NWAVES;
    const __amdgpu_buffer_rsrc_t rs = __builtin_amdgcn_make_buffer_rsrc((void*)(VT + (size_t)x * (NEXP * 128)), 0, NEXP * 128, 0x00020000);
    const int coloff = 16 * j;
    const int mycol = 256 * x + 32 * j + 4 * g;
    int t = wi - stride; t = sl_next_tok(t, stride, lat_only);
    int t1 = sl_next_tok(t, stride, lat_only), t2 = sl_next_tok(t1, stride, lat_only);
    int idA1 = 0, idB1 = 0, idA2 = 0, idB2 = 0, idA3 = 0, idB3 = 0; float wA = 0.f, wB = 0.f, wA1 = 0.f, wB1 = 0.f, wA2 = 0.f, wB2 = 0.f; u32x4 w[16], wn[16];
    f32x4 x_old = {0.f, 0.f, 0.f, 0.f}, g_vec = x_old, xo1 = x_old, gv1 = x_old, xo2 = x_old, gv2 = x_old;
#define SL_WK(t_, A_, B_) do { A_ = WK[(size_t)(t_) * 128 + lane]; B_ = WK[(size_t)(t_) * 128 + 64 + lane]; } while (0)
#define SL_XG(t_, X_, G_) do { X_ = *(const f32x4*)(XW + (size_t)(t_) * DM + mycol); G_ = *(const f32x4*)(g2 + (size_t)row_cls(t_) * NMOD + mycol); } while (0)
    if (t < MROWS) { int idA0, idB0; SL_IDS(t, idA0, idB0); SL_WK(t, wA1, wB1); SL_XG(t, xo1, gv1); SL_ROWS(w, idA0, idB0); }
    if (t1 < MROWS) { SL_IDS(t1, idA2, idB2); SL_WK(t1, wA2, wB2); SL_XG(t1, xo2, gv2); }
    if (t2 < MROWS) SL_IDS(t2, idA3, idB3);
#define SL_V1(d_, b_) { const h2_t r2_ = __builtin_amdgcn_cvt_scalef32_pk_f16_fp4(wd_[d_], 1.0f, b_); acc[4 * (d_) + (b_)] = __builtin_elementwise_fma(r2_, wg2_, acc[4 * (d_) + (b_)]); }
#define SL_VBODY(CUR, NXT) do { \
        const int t3 = sl_next_tok(t2, stride, lat_only); \
        wA = wA1; wB = wB1; wA1 = wA2; wB1 = wB2; x_old = xo1; g_vec = gv1; xo1 = xo2; gv1 = gv2; \
        idA1 = idA2; idB1 = idB2; idA2 = idA3; idB2 = idB3; \
        if (t1 < MROWS) SL_ROWS(NXT, idA1, idB1); \
        if (t2 < MROWS) { SL_WK(t2, wA2, wB2); SL_XG(t2, xo2, gv2); } \
        if (t3 < MROWS) SL_IDS(t3, idA3, idB3); \
        h2_t acc[16]; \
_Pragma("unroll") \
        for (int p = 0; p < 16; ++p) acc[p] = (h2_t){(_Float16)0.f, (_Float16)0.f}; \
_Pragma("unroll") \
        for (int i = 0; i < 16; ++i) { \
            const unsigned wd_[4] = {CUR[i].x, CUR[i].y, CUR[i].z, CUR[i].w}; \
            const float wgf_ = __int_as_float(__builtin_amdgcn_ds_bpermute(bp + 32 * (i & 7), __float_as_int((i < 8) ? wA : wB))); \
            const _Float16 wgh_ = (_Float16)wgf_; const h2_t wg2_ = {wgh_, wgh_}; \
            SL_V1(0, 0) SL_V1(0, 1) SL_V1(0, 2) SL_V1(0, 3) SL_V1(1, 0) SL_V1(1, 1) SL_V1(1, 2) SL_V1(1, 3) SL_V1(2, 0) SL_V1(2, 1) SL_V1(2, 2) SL_V1(2, 3) SL_V1(3, 0) SL_V1(3, 1) SL_V1(3, 2) SL_V1(3, 3) \
        } \
        unsigned m0 = 0u, m1 = 0u; \
_Pragma("unroll") \
        for (int p = 0; p < 16; ++p) { \
            h2_t v = acc[p]; \
            v = v + __builtin_bit_cast(h2_t, __builtin_amdgcn_update_dpp(0, __builtin_bit_cast(int, v), 0x128, 0xf, 0xf, true)); \
            { auto r = __builtin_amdgcn_permlane16_swap(__builtin_bit_cast(unsigned, v), __builtin_bit_cast(unsigned, v), false, false); v = __builtin_bit_cast(h2_t, (unsigned)r[0]) + __builtin_bit_cast(h2_t, (unsigned)r[1]); } \
            { auto r = __builtin_amdgcn_permlane32_swap(__builtin_bit_cast(unsigned, v), __builtin_bit_cast(unsigned, v), false, false); v = __builtin_bit_cast(h2_t, (unsigned)r[0]) + __builtin_bit_cast(h2_t, (unsigned)r[1]); } \
            if (g == (p >> 1)) { if (p & 1) m1 = __builtin_bit_cast(unsigned, v); else m0 = __builtin_bit_cast(unsigned, v); } \
        } \
        const h2_t q0 = __builtin_bit_cast(h2_t, m0), q1 = __builtin_bit_cast(h2_t, m1); \
        const f32x4 mine = {(float)q0.x, (float)q0.y, (float)q1.x, (float)q1.y}; \
        const f32x4 xn = x_old + g_vec * mine; \
        *(f32x4*)(XW + (size_t)t * DM + mycol) = xn; \
        if (OUT) { const int b = t / RB, i = t - b * RB; if (i >= CTX) { f32x4 xo_ = xn SELFTEST_LEAK; SELFTEST_SPIKE; *(f32x4*)(OUT + ((size_t)b * SEQ + (i - CTX)) * DM + mycol) = xo_; } } \
        t = t1; t1 = t2; t2 = t3; \
    } while (0)
    while (t < MROWS) { SL_VBODY(w, wn); if (!(t < MROWS)) break; SL_VBODY(wn, w); }
#undef SL_VBODY
#undef SL_V1
#undef SL_WK
#undef SL_XG
}
#endif
#undef SL_IDS
#undef SL_ROWS
#undef SL_CL
#endif
#ifndef N_LAUNCHES
#define N_LAUNCHES 1
#endif
struct Args { const float* in[26]; float* out; unsigned char* ws; int ph_lo, ph_hi; };
constexpr int NPHASES = 39;
__global__ void __launch_bounds__(NTHREADS, 2) fwd_kernel(Args args) {
    extern __shared__ __attribute__((aligned(16))) unsigned char lds_raw[];
    Frame F_;
    F_.lds = (LAS unsigned char*)lds_raw;
    F_.tid = threadIdx.x; F_.lane = F_.tid & 63; F_.wave = __builtin_amdgcn_readfirstlane(F_.tid >> 6);
    F_.G = gridDim.x; { const int bx = blockIdx.x; F_.vcu = (F_.G % 8 == 0) ? (bx % 8) * (F_.G / 8) + bx / 8 : bx; }
    F_.gw = F_.vcu * NWAVES + F_.wave; F_.NGW = F_.G * NWAVES;
    F_.ws = args.ws;
    volatile LAS unsigned* MISC = (volatile LAS unsigned*)(F_.lds + LDS_MISC);
    if (F_.tid < 32) MISC[F_.tid] = 0u;
    __syncthreads();
    const int lo = args.ph_lo, hi = args.ph_hi;
    XcdBarrier bar; bar.bar = (unsigned*)(args.ws + WS_CTL) + CW_BAR; bar.x = 0; bar.st = nullptr;
    if (N_LAUNCHES == 1 || hi - lo > 1) bar = xcd_barrier_post((unsigned*)(args.ws + WS_CTL) + CW_BAR, MISC + 8);
#if N_LAUNCHES == 1
#define IN(k) true
#define SEAM(k) xcd_barrier(bar)
#else
#define IN(k) (lo <= (k) && (k) < hi)
#define SEAM(k) do { if (IN(k) && IN((k) + 1)) xcd_barrier(bar); } while (0)
#endif
    PG8_LAS unsigned char* glds = (PG8_LAS unsigned char*)lds_raw;

    if (IN(0)) { p0_prologue(F_, args.in); } SEAM(0);

#pragma unroll 1
    for (int lp = 0; lp < 2; ++lp) {
        const int pb = 1 + lp * 19;
        unsigned char* ws = args.ws; asm volatile("" : "+s"(ws));
        Frame F = F_; { int w_ = F_.wave, v_ = F_.vcu, g_ = F_.G; asm volatile("" : "+s"(w_), "+s"(v_), "+s"(g_)); F.wave = w_; F.vcu = v_; F.G = g_; F.gw = v_ * NWAVES + w_; F.NGW = g_ * NWAVES; F.ws = ws; }
        float* mod = (float*)(ws + WS_MOD); float* XW = (float*)(ws + WS_XW);
        bf16_t* H = (bf16_t*)(ws + WS_H); bf16_t* P = (bf16_t*)(ws + WS_P); bf16_t* QRAW = (bf16_t*)(ws + WS_QRAW); bf16_t* KVRAW = (bf16_t*)(ws + WS_KVRAW);
        bf16_t* Q = (bf16_t*)(ws + WS_Q); bf16_t* KB = (bf16_t*)(ws + WS_K); bf16_t* VB = (bf16_t*)(ws + WS_V); bf16_t* CAT = (bf16_t*)(ws + WS_CAT); bf16_t* PQ = (bf16_t*)(ws + WS_PQ);
        int* IDX = (int*)(ws + WS_IDX); float* GATE = (float*)(ws + WS_GATE);
        const float* rope_c = (const float*)(ws + WS_ROPE); const float* rope_a = rope_c + 64 * 32 * 2;
        const float* SMv = (const float*)(ws + WS_SMALL);
        {
            const int l = 2 * lp, i = lp;
            const float* modl = mod + (size_t)l * 3 * NMOD;
            if (lp == 0) { if (IN(pb + 0)) { norm_phase(F, XW, SMv + SM_N1G + l * DM, modl, 0, 2048, H, false); } SEAM(pb + 0); }
            if (IN(pb + 1)) {
                pg8::Gemm g{H, (const bf16_t*)(ws + WS_WIN) + (size_t)i * 4096 * DM, MROWS, 4096, DM, DM, DM}; pg8::StaticOrder S; S.init(MROWS, 4096, F.G, (int)blockIdx.x);
                pg8::EpiBf16 E{P, 4096};
                pg8::gemm_phase<pg8::EpiBf16, pg8::StaticOrder, true, true>(glds, g, S, E, phase_tid(F.wave));
            } SEAM(pb + 1);
            if (IN(pb + 2)) {
                { pg8::Gemm g{P, (const bf16_t*)(ws + WS_WUQ) + (size_t)i * 1536 * 512, MROWS, 1536, 512, 4096, 512}; pg8::StaticOrder S; S.init(MROWS, 1536, F.G, (int)blockIdx.x);
                  pg8::EpiBf16 E{QRAW, 1536};
                  pg8::gemm_phase<pg8::EpiBf16, pg8::StaticOrder, true, true>(glds, g, S, E, phase_tid(F.wave)); }
                __syncthreads();
                { pg8::Gemm g{P + 512, (const bf16_t*)(ws + WS_WUKV) + (size_t)i * 2048 * 256, MROWS, 2048, 256, 4096, 256}; pg8::StaticOrder S; S.init(MROWS, 2048, F.G, (int)blockIdx.x);
                  pg8::EpiBf16 E{KVRAW, 2048};
                  pg8::gemm_phase<pg8::EpiBf16, pg8::StaticOrder, true, true>(glds, g, S, E, phase_tid(F.wave)); }
                __syncthreads();
                conv_phase(F, P, SMv + SM_CW + i * 3072, SMv + SM_CB + i * 1024, CAT);
            } SEAM(pb + 2);
            if (IN(pb + 3)) { prep_even_phase(F, P, QRAW, KVRAW, SMv + SM_AQG + i * 192, SMv + SM_AKG + i * 192, rope_a, Q, KB, VB); } SEAM(pb + 3);
            if (IN(pb + 4)) { attn_even_phase(F, Q, KB, VB, CAT); } SEAM(pb + 4);
            if (IN(pb + 5)) {
                pg8::Gemm g{CAT, (const bf16_t*)(ws + WS_WEO) + (size_t)i * DM * DM, MROWS, DM, DM, DM, DM}; pg8::StaticOrder S; S.init(MROWS, DM, F.G, (int)blockIdx.x);
                pg8::EpiResid E{XW, DM, modl + 4096};
                pg8::gemm_phase<pg8::EpiResid, pg8::StaticOrder, true, true>(glds, g, S, E, phase_tid(F.wave));
            } SEAM(pb + 5);
            if (IN(pb + 6)) { norm_phase(F, XW, SMv + SM_N2G + l * DM, modl, 6144, 8192, H, l == 3, (unsigned*)(ws + WS_XQ), (float*)(ws + WS_XS)); } SEAM(pb + 6);
            if (IN(pb + 7)) {
                pg8::Gemm g{H, (const bf16_t*)(ws + WS_WPQ) + (size_t)l * DM * DM, MROWS, DM, DM, DM, DM}; pg8::StaticOrder S; S.init(MROWS, DM, F.G, (int)blockIdx.x);
                pg8::EpiBf16 E{PQ, DM};
                pg8::gemm_phase<pg8::EpiBf16, pg8::StaticOrder, true, true>(glds, g, S, E, phase_tid(F.wave));
            } SEAM(pb + 7);
            if (IN(pb + 8)) { peer_topk_phase(F, PQ, (const bf16_t*)(ws + WS_SUBK) + (size_t)l * 16 * 128 * 128, IDX, GATE, l == 3); } SEAM(pb + 8);
            {
                const unsigned char* Ut = ws + WS_U + (size_t)l * NEXP * ROWB; const unsigned char* Vt = ws + WS_VT + (size_t)l * NEXP * ROWB;
                peer_u_phase(F, (const unsigned*)(ws + WS_XQ), (const float*)(ws + WS_XS), IDX, Ut, (float*)(ws + WS_PART), false); SEAM(0);
                peer_wq_phase(F, (const float*)(ws + WS_PART), IDX, GATE, (const float*)(ws + WS_USC) + l * NEXP, (const float*)(ws + WS_VSC) + l * NEXP, false, ws + WS_WQ8, (float*)(ws + WS_WSC), (const float*)(ws + WS_XS)); SEAM(0);
                peer_v_phase(F, IDX, ws + WS_WQ8, (const float*)(ws + WS_WSC), Vt, modl + 10240, XW, nullptr, false); SEAM(0);
                norm_phase(F, XW, SMv + SM_N1G + (l + 1) * DM, mod + (size_t)(l + 1) * 3 * NMOD, 0, 2048, H, false); SEAM(0);
            }
        }
        {
            const int l = 2 * lp + 1, i = lp, qb = pb + 10;
            const float* modl = mod + (size_t)l * 3 * NMOD;
            if (IN(qb + 1)) {
                pg8::Gemm g{H, (const bf16_t*)(ws + WS_WQKV) + (size_t)i * 3072 * DM, MROWS, 3072, DM, DM, DM}; pg8::StaticOrder S; S.init(MROWS, 3072, F.G, (int)blockIdx.x);
                pg8::EpiBf16 E{P, 3072};
                pg8::gemm_phase<pg8::EpiBf16, pg8::StaticOrder, true, true>(glds, g, S, E, phase_tid(F.wave));
            } SEAM(qb + 1);
            if (IN(qb + 2)) { prep_odd_phase(F, P, SMv + SM_CQG + i * 128, SMv + SM_CKG + i * 128, rope_c, Q, KB); } SEAM(qb + 2);
            if (IN(qb + 3)) { attn_odd_phase(F, Q, KB, P, CAT, l == 3); } SEAM(qb + 3);
            if (IN(qb + 4)) {
                pg8::Gemm g{CAT, (const bf16_t*)(ws + WS_WCO) + (size_t)i * DM * DM, MROWS, DM, DM, DM, DM}; pg8::StaticOrder S; S.init(MROWS, DM, F.G, (int)blockIdx.x, l == 3);
                pg8::EpiResid E{XW, DM, modl + 4096};
                pg8::gemm_phase<pg8::EpiResid, pg8::StaticOrder, true, true>(glds, g, S, E, phase_tid(F.wave));
            } SEAM(qb + 4);
            if (IN(qb + 5)) { norm_phase(F, XW, SMv + SM_N2G + l * DM, modl, 6144, 8192, H, l == 3, (unsigned*)(ws + WS_XQ), (float*)(ws + WS_XS)); } SEAM(qb + 5);
            if (IN(qb + 6)) {
                pg8::Gemm g{H, (const bf16_t*)(ws + WS_WPQ) + (size_t)l * DM * DM, MROWS, DM, DM, DM, DM}; pg8::StaticOrder S; S.init(MROWS, DM, F.G, (int)blockIdx.x, l == 3);
                pg8::EpiBf16 E{PQ, DM};
                pg8::gemm_phase<pg8::EpiBf16, pg8::StaticOrder, true, true>(glds, g, S, E, phase_tid(F.wave));
            } SEAM(qb + 6);
            if (IN(qb + 7)) { peer_topk_phase(F, PQ, (const bf16_t*)(ws + WS_SUBK) + (size_t)l * 16 * 128 * 128, IDX, GATE, l == 3); } SEAM(qb + 7);
            {
                const unsigned char* Ut = ws + WS_U + (size_t)l * NEXP * ROWB; const unsigned char* Vt = ws + WS_VT + (size_t)l * NEXP * ROWB;
                peer_u_phase(F, (const unsigned*)(ws + WS_XQ), (const float*)(ws + WS_XS), IDX, Ut, (float*)(ws + WS_PART), l == 3); SEAM(0);
                peer_wq_phase(F, (const float*)(ws + WS_PART), IDX, GATE, (const float*)(ws + WS_USC) + l * NEXP, (const float*)(ws + WS_VSC) + l * NEXP, l == 3, ws + WS_WQ8, (float*)(ws + WS_WSC), (const float*)(ws + WS_XS)); SEAM(0);
                peer_v_phase(F, IDX, ws + WS_WQ8, (const float*)(ws + WS_WSC), Vt, modl + 10240, XW, (l == 3) ? args.out : nullptr, l == 3);
                if (lp == 0) { SEAM(0); norm_phase(F, XW, SMv + SM_N1G + (l + 1) * DM, mod + (size_t)(l + 1) * 3 * NMOD, 0, 2048, H, false); SEAM(0); }
            }
        }
    }
#undef IN
#undef SEAM
}

extern "C" void kernel_launch(void* const* d_in, const int* in_sizes, int n_in, void* d_out, int out_size, void* d_ws, size_t ws_size, hipStream_t stream) {
    static int grid = 0;
    if (grid == 0) {
        if (n_in != 26 || out_size != NBATCH * SEQ * DM || ws_size < WS_END) { fprintf(stderr, "kernel_launch: unexpected shapes: n_in %d out %d ws %zu (need %zu)\n", n_in, out_size, ws_size, (size_t)WS_END); grid = -1; return; }
        int dev = 0, cus = 0, per_cu = 0;
        if (hipGetDevice(&dev) != hipSuccess || hipDeviceGetAttribute(&cus, hipDeviceAttributeMultiprocessorCount, dev) != hipSuccess) { fprintf(stderr, "kernel_launch: device query failed\n"); grid = -1; return; }
        if (hipFuncSetAttribute((const void*)fwd_kernel, hipFuncAttributeMaxDynamicSharedMemorySize, LDS_BYTES) != hipSuccess) { fprintf(stderr, "kernel_launch: hipFuncSetAttribute failed\n"); grid = -1; return; }
        if (hipOccupancyMaxActiveBlocksPerMultiprocessor(&per_cu, (const void*)fwd_kernel, NTHREADS, LDS_BYTES) != hipSuccess || per_cu < 1) { fprintf(stderr, "kernel_launch: occupancy query says %d blocks per CU\n", per_cu); (void)hipGetLastError(); grid = -1; return; }
        if (cus % 8 != 0) { fprintf(stderr, "kernel_launch: %d CUs: the phase decompositions assume a multiple of 8 workgroups\n", cus); grid = -1; return; }
        grid = cus;
    }
    if (grid < 0) return;
    (void)hipMemsetAsync((char*)d_ws + WS_CTL, 0, CTL_ZERO_BYTES, stream);
    Args a{};
    for (int i = 0; i < 26; ++i) a.in[i] = (const float*)d_in[i];
    a.out = (float*)d_out; a.ws = (unsigned char*)d_ws;
    for (int li = 0; li < N_LAUNCHES; ++li) {
        a.ph_lo = (N_LAUNCHES == 1) ? 0 : li; a.ph_hi = (N_LAUNCHES == 1) ? NPHASES : li + 1;
        hipLaunchKernelGGL(fwd_kernel, dim3(grid), dim3(NTHREADS), LDS_BYTES, stream, a);
        const hipError_t le = hipPeekAtLastError();
        if (le != hipSuccess) { fprintf(stderr, "kernel_launch: launch %d failed: %s\n", li, hipGetErrorName(le)); break; }
    }
}
```

```cpp
#include <hip/hip_runtime.h>
#include <cstdio>
#include <cstdint>
namespace pg8 {
#define PG8_LAS __attribute__((address_space(3)))
typedef unsigned short bf16_t;
typedef short bf16x8 __attribute__((ext_vector_type(8)));
typedef float f32x4 __attribute__((ext_vector_type(4)));
typedef unsigned u32x4 __attribute__((ext_vector_type(4)));
constexpr int BM = 256, BK = 64, HALF = 128, HTB = HALF * BK * 2  , STAGE_BYTES = 8 * HTB, NXCD = 8, WGM = 8;

__host__ __device__ __forceinline__ int lds_byte(int r, int c) { const int st = (r >> 4) * 2 + (c >> 5), rr = r & 15, cc = c & 31, ob = rr * 64 + cc * 2; return st * 1024 + (ob ^ (((ob >> 9) & 1) << 5)); }
__host__ __device__ __forceinline__ void stage_rc(int b, int& R, int& C) { const int st = b / 1024, sb = b % 1024, swz = sb ^ (((sb >> 9) & 1) << 5); R = (st >> 1) * 16 + swz / 64; C = (st & 1) * 32 + (swz % 64) / 2; }
__host__ __device__ __forceinline__ int perm32(int rho) { const int n = rho >> 4, i = rho & 15; return 8 * (i >> 2) + 4 * n + (i & 3); }

struct Unit { int pm, pn; };
struct Gemm { const bf16_t* A; const bf16_t* Bt; int M, N, K, lda, ldb; };

struct StaticOrder {
    int nM, nN, nwg, G, c; bool lat_only;
    __host__ __device__ void init(int M, int N, int G_, int c_, bool lat_only_ = false) { lat_only = lat_only_; nM = lat_only_ ? 32 : M / BM; nN = N / BM; nwg = nM * nN; G = G_; c = c_; }
    __host__ __device__ bool next(int i, Unit& u) const {
        const long L = (long)i * G + c; if (L >= nwg) return false;
        int wgid = (int)L; { const int q = nwg / NXCD, r = nwg % NXCD, xcd = wgid % NXCD, off = wgid / NXCD; wgid = (xcd < r ? xcd * (q + 1) : r * (q + 1) + (xcd - r) * q) + off; }
        const int nig = WGM * nN, gid = wgid / nig, fm = gid * WGM, gsz = (nM - fm) < WGM ? (nM - fm) : WGM;
        u.pm = fm + ((wgid % nig) % gsz); u.pn = (wgid % nig) / gsz; if (lat_only) u.pm += 1 + (u.pm >= 16 ? 1 : 0); return true;
    }
    __device__ __forceinline__ void a_ready(const Unit&) const {}
    __device__ __forceinline__ void done(const Unit&) const {}
};
__device__ __forceinline__ unsigned cvt_pk_bf16(float lo, float hi) { unsigned r; asm volatile("v_cvt_pk_bf16_f32 %0, %1, %2" : "=v"(r) : "v"(lo), "v"(hi)); return r; }
typedef float f32x2 __attribute__((ext_vector_type(2)));
struct EpiBf16 {
    static constexpr bool PERM = true, AFTER_DRAIN = false;
    bf16_t* O; int ldc;
    __device__ __forceinline__ void operator()(const f32x4 (&acc)[2][2][4][2], const Unit& u, int wr, int wc, int fr, int fq) const {
        const int row0 = u.pm * BM + wr * 64 + fr, col0 = u.pn * BM + wc * 32 + 8 * fq;
#pragma unroll
        for (int ai = 0; ai < 2; ++ai)
#pragma unroll
            for (int m = 0; m < 4; ++m) { bf16_t* rowp = O + (size_t)(row0 + ai * HALF + m * 16) * ldc + col0;
#pragma unroll
                for (int bj = 0; bj < 2; ++bj) { const f32x4 v0 = acc[ai][bj][m][0], v1 = acc[ai][bj][m][1];
                    u32x4 w; w.x = cvt_pk_bf16(v0[0], v0[1]); w.y = cvt_pk_bf16(v0[2], v0[3]); w.z = cvt_pk_bf16(v1[0], v1[1]); w.w = cvt_pk_bf16(v1[2], v1[3]);
                    *(u32x4*)(rowp + bj * HALF) = w; } }
    }
};
struct EpiResid {
    static constexpr bool PERM = false, AFTER_DRAIN = false;
    bf16_t* X; int ldc; const float* gate;
    __device__ __forceinline__ void operator()(const f32x4 (&acc)[2][2][4][2], const Unit& u, int wr, int wc, int fr, int fq) const {
        const int row0 = u.pm * BM + wr * 64 + fr, col0 = u.pn * BM + wc * 32 + 4 * fq;
        const int cls = (u.pm % 17 == 0) ? 2 : (u.pm / 17);
        const float* gp = gate + (size_t)cls * 12288 + col0;
        f32x4 gv[2][2];
#pragma unroll
        for (int bj = 0; bj < 2; ++bj)
#pragma unroll
            for (int n = 0; n < 2; ++n) gv[bj][n] = *(const f32x4*)(gp + bj * HALF + n * 16);
#pragma unroll
        for (int ai = 0; ai < 2; ++ai)
#pragma unroll
            for (int m = 0; m < 4; ++m) { bf16_t* rowp = X + (size_t)(row0 + ai * HALF + m * 16) * ldc + col0;
#pragma unroll
                for (int bj = 0; bj < 2; ++bj)
#pragma unroll
                    for (int n = 0; n < 2; ++n) { typedef unsigned u32x2_ __attribute__((ext_vector_type(2))); u32x2_* p = (u32x2_*)(rowp + bj * HALF + n * 16); const u32x2_ w_ = *p;
                        const f32x4 xo_ = {__builtin_bit_cast(float, w_.x << 16), __builtin_bit_cast(float, w_.x & 0xffff0000u), __builtin_bit_cast(float, w_.y << 16), __builtin_bit_cast(float, w_.y & 0xffff0000u)};
                        const f32x4 xn_ = xo_ + gv[bj][n] * acc[ai][bj][m][n]; u32x2_ o_; o_.x = cvt_pk_bf16(xn_[0], xn_[1]); o_.y = cvt_pk_bf16(xn_[2], xn_[3]); *p = o_; } }
    }
};
template <class Epi, class Sched, bool ALIGN_EPI = false, bool SP2 = false>
__device__ __forceinline__ void gemm_phase(PG8_LAS unsigned char* lds, const Gemm g, const Sched& S, const Epi& E, int tid_in) {
    int tid_ = tid_in; asm volatile("" : "+v"(tid_));
    const int tid = tid_, wid = __builtin_amdgcn_readfirstlane(tid >> 6), lane = tid & 63, wr = wid >> 2, wc = wid & 3, fr = lane & 15, fq = lane >> 4;
    const int K = g.K, nt = K / BK;
    unsigned voffA[2], voffB[2];
#pragma unroll
    for (int i = 0; i < 2; ++i) { int R, C; stage_rc(tid * 16 + i * 8192, R, C); const int Rb = Epi::PERM ? ((R & ~31) + perm32(R & 31)) : R;
        voffA[i] = (unsigned)(R * g.lda + C) * 2u; voffB[i] = (unsigned)(Rb * g.ldb + C) * 2u; }
    const size_t kstep = (size_t)(BK * 2);
    const size_t hstepA = (size_t)HALF * g.lda * 2, hstepB = (size_t)HALF * g.ldb * 2;
    const size_t tstepA = 2 * hstepA, tstepB = 2 * hstepB;
    const unsigned ldsw = (unsigned)wid * 1024u;
    const int aoff = lds_byte(wr * 64 + fr, fq * 8), boff = lds_byte(wc * 32 + fr, fq * 8);
#define PG8_SA(b, h) (((b) * 2 + (h)) * HTB)
#define PG8_SB(b, h) ((4 + (b) * 2 + (h)) * HTB)
#define PG8_STAGE(bufoff, gbase, voff) do { _Pragma("unroll") for (int _i = 0; _i < 2; ++_i) \
        __builtin_amdgcn_global_load_lds((const unsigned*)((const char*)(gbase) + (voff)[_i]), (PG8_LAS unsigned*)(lds + (bufoff) + ldsw + _i * 8192), 16, 0, 0); } while (0)
#define PG8_LDA(dst, b, h) do { _Pragma("unroll") for (int m = 0; m < 4; ++m) _Pragma("unroll") for (int k = 0; k < 2; ++k) dst[m][k] = *(const PG8_LAS bf16x8*)(lds + PG8_SA(b, h) + aoff + m * 2048 + k * 1024); } while (0)
#define PG8_LDB(dst, b, h) do { _Pragma("unroll") for (int n = 0; n < 2; ++n) _Pragma("unroll") for (int k = 0; k < 2; ++k) dst[n][k] = *(const PG8_LAS bf16x8*)(lds + PG8_SB(b, h) + boff + n * 2048 + k * 1024); } while (0)
#define PG8_MMA(ai, bj, At, Bt) do { __builtin_amdgcn_s_setprio(1); _Pragma("unroll") for (int m = 0; m < 4; ++m) _Pragma("unroll") for (int n = 0; n < 2; ++n) _Pragma("unroll") for (int k = 0; k < 2; ++k) \
        acc[ai][bj][m][n] = __builtin_amdgcn_mfma_f32_16x16x32_bf16(Bt[n][k], At[m][k], acc[ai][bj][m][n], 0, 0, 0); __builtin_amdgcn_s_setprio(0); } while (0)
#define PG8_WAIT_V(n) asm volatile("s_waitcnt vmcnt(" #n ")" ::: "memory")
#define PG8_WAIT_L(n) asm volatile("s_waitcnt lgkmcnt(" #n ")" ::: "memory")
#define PG8_BAR __builtin_amdgcn_s_barrier()
#define PG8_SCHED __builtin_amdgcn_sched_barrier(0)
    Unit cur, nxt; int ui = 0;
    if (!S.next(0, cur)) return;
    f32x4 acc[2][2][4][2];
#pragma unroll
    for (int a = 0; a < 2; ++a)
#pragma unroll
        for (int b = 0; b < 2; ++b)
#pragma unroll
            for (int m = 0; m < 4; ++m)
#pragma unroll
                for (int n = 0; n < 2; ++n) acc[a][b][m][n] = (f32x4){0.f, 0.f, 0.f, 0.f};
    bf16x8 At[4][2], B0[2][2], B1[2][2];
    const char* cA = (const char*)g.A + (size_t)cur.pm * tstepA; const char* cB = (const char*)g.Bt + (size_t)cur.pn * tstepB;
    S.a_ready(cur);
    if constexpr (SP2) {
        PG8_STAGE(PG8_SB(0, 0), cB, voffB); PG8_STAGE(PG8_SB(0, 1), cB + hstepB, voffB); PG8_STAGE(PG8_SA(0, 0), cA, voffA); PG8_STAGE(PG8_SA(0, 1), cA + hstepA, voffA);
        if (wr == 1) PG8_BAR;
        PG8_WAIT_V(2); PG8_BAR;
        PG8_STAGE(PG8_SB(1, 0), cB + kstep, voffB); PG8_STAGE(PG8_SA(1, 0), cA + kstep, voffA); PG8_STAGE(PG8_SB(1, 1), cB + hstepB + kstep, voffB);
        PG8_WAIT_V(6); PG8_BAR;
    } else {
        PG8_STAGE(PG8_SB(0, 0), cB, voffB); PG8_STAGE(PG8_SA(0, 0), cA, voffA); PG8_STAGE(PG8_SB(0, 1), cB + hstepB, voffB); PG8_STAGE(PG8_SA(0, 1), cA + hstepA, voffA);
        if (wr == 1) PG8_BAR;
        PG8_WAIT_V(4); PG8_BAR;
        PG8_STAGE(PG8_SB(1, 0), cB + kstep, voffB); PG8_STAGE(PG8_SA(1, 0), cA + kstep, voffA); PG8_STAGE(PG8_SB(1, 1), cB + hstepB + kstep, voffB);
        PG8_WAIT_V(6); PG8_BAR;
    }
    for (;;) {
        const bool has_next = S.next(ui + 1, nxt);
        const char* nA = has_next ? (const char*)g.A + (size_t)nxt.pm * tstepA : cA; const char* nB = has_next ? (const char*)g.Bt + (size_t)nxt.pn * tstepB : cB;
        for (int t = 0; t < nt; t += 2) {
            const bool last = (t == nt - 2);
            const char* a1 = cA + (size_t)(t + 1) * kstep;
            const char* a2 = last ? nA : cA + (size_t)(t + 2) * kstep; const char* b2 = last ? nB : cB + (size_t)(t + 2) * kstep;
            const char* a3 = a2 + kstep; const char* b3 = b2 + kstep;
            if (last && has_next) S.a_ready(nxt);
            if constexpr (SP2) {
            PG8_LDB(B0, 0, 0); PG8_LDB(B1, 0, 1); PG8_SCHED; PG8_LDA(At, 0, 0); PG8_STAGE(PG8_SA(1, 1), a1 + hstepA, voffA);
            PG8_WAIT_V(8); PG8_WAIT_L(0); PG8_BAR; PG8_MMA(0, 0, At, B0); PG8_MMA(0, 1, At, B1); PG8_BAR; PG8_SCHED;
            PG8_LDA(At, 0, 1); PG8_STAGE(PG8_SB(0, 0), b2, voffB); PG8_STAGE(PG8_SB(0, 1), b2 + hstepB, voffB); PG8_STAGE(PG8_SA(0, 0), a2, voffA);
            PG8_WAIT_V(8); PG8_WAIT_L(0); PG8_BAR; PG8_MMA(1, 0, At, B0); PG8_MMA(1, 1, At, B1); PG8_BAR; PG8_SCHED;
            PG8_LDB(B0, 1, 0); PG8_LDB(B1, 1, 1); PG8_SCHED; PG8_LDA(At, 1, 0); PG8_STAGE(PG8_SA(0, 1), a2 + hstepA, voffA);
            PG8_WAIT_V(8); PG8_WAIT_L(0); PG8_BAR; PG8_MMA(0, 0, At, B0); PG8_MMA(0, 1, At, B1); PG8_BAR; PG8_SCHED;
            PG8_LDA(At, 1, 1); PG8_STAGE(PG8_SB(1, 0), b3, voffB); PG8_STAGE(PG8_SB(1, 1), b3 + hstepB, voffB); PG8_STAGE(PG8_SA(1, 0), a3, voffA);
            PG8_WAIT_V(8); PG8_WAIT_L(0); PG8_BAR; PG8_MMA(1, 0, At, B0); PG8_MMA(1, 1, At, B1); PG8_BAR; PG8_SCHED;
            } else {
            PG8_LDB(B0, 0, 0); PG8_SCHED; PG8_LDA(At, 0, 0); PG8_STAGE(PG8_SA(1, 1), a1 + hstepA, voffA);
            PG8_WAIT_L(8); PG8_BAR; PG8_WAIT_L(0); PG8_MMA(0, 0, At, B0); PG8_BAR; PG8_SCHED;
            PG8_LDB(B1, 0, 1); PG8_STAGE(PG8_SB(0, 0), b2, voffB);
            PG8_BAR; PG8_WAIT_L(0); PG8_MMA(0, 1, At, B1); PG8_BAR;
            PG8_LDA(At, 0, 1); PG8_STAGE(PG8_SA(0, 0), a2, voffA);
            PG8_BAR; PG8_WAIT_L(0); PG8_MMA(1, 0, At, B0); PG8_BAR; PG8_SCHED;
            PG8_STAGE(PG8_SB(0, 1), b2 + hstepB, voffB);
            PG8_WAIT_V(6); PG8_BAR; PG8_MMA(1, 1, At, B1); PG8_BAR;
            PG8_LDB(B0, 1, 0); PG8_SCHED; PG8_LDA(At, 1, 0); PG8_STAGE(PG8_SA(0, 1), a2 + hstepA, voffA);
            PG8_WAIT_L(8); PG8_BAR; PG8_WAIT_L(0); PG8_MMA(0, 0, At, B0); PG8_BAR; PG8_SCHED;
            PG8_LDB(B1, 1, 1); PG8_STAGE(PG8_SB(1, 0), b3, voffB);
            PG8_BAR; PG8_WAIT_L(0); PG8_MMA(0, 1, At, B1); PG8_BAR;
            PG8_LDA(At, 1, 1); PG8_STAGE(PG8_SA(1, 0), a3, voffA);
            PG8_BAR; PG8_WAIT_L(0); PG8_MMA(1, 0, At, B0); PG8_BAR; PG8_SCHED;
            PG8_STAGE(PG8_SB(1, 1), b3 + hstepB, voffB);
            PG8_WAIT_V(6); PG8_BAR; PG8_MMA(1, 1, At, B1); PG8_BAR;
            }
        }
        if constexpr (ALIGN_EPI) { if (wr == 0) PG8_BAR; }
        if constexpr (!Epi::AFTER_DRAIN) { E(acc, cur, wr, wc, fr, fq); S.done(cur); }
        if (!has_next) break;
#pragma unroll
        for (int a = 0; a < 2; ++a)
#pragma unroll
            for (int b = 0; b < 2; ++b)
#pragma unroll
                for (int m = 0; m < 4; ++m)
#pragma unroll
                    for (int n = 0; n < 2; ++n) acc[a][b][m][n] = (f32x4){0.f, 0.f, 0.f, 0.f};
        cur = nxt; cA = nA; cB = nB; ++ui;
        if constexpr (ALIGN_EPI) { if (wr == 1) PG8_BAR; }
    }
    PG8_WAIT_V(0);
    if constexpr (!ALIGN_EPI) { if (wr == 0) PG8_BAR; }
    PG8_BAR;
    if constexpr (Epi::AFTER_DRAIN) { E.fused(acc, cur, wr, wc, fr, fq, lds, wid, lane); S.done(cur); }
#undef PG8_SA
#undef PG8_SB
#undef PG8_STAGE
#undef PG8_LDA
#undef PG8_LDB
#undef PG8_MMA
#undef PG8_WAIT_V
#undef PG8_WAIT_L
#undef PG8_BAR
#undef PG8_SCHED
}
}
namespace att {
typedef unsigned short bf16_t;
using bf16x8 = __attribute__((ext_vector_type(8))) short;
using s16x4  = __attribute__((ext_vector_type(4))) short;
using f32x16 = __attribute__((ext_vector_type(16))) float;
using u32x4  = __attribute__((ext_vector_type(4))) unsigned;
constexpr int DV = 128, NW = 8, QBLK = 32, KVBLK = 64;
constexpr float THR = 8.f;
constexpr int SHM_V = KVBLK * DV * 2;
template <int DQK> struct Cfg {
    static constexpr int SHM_K = KVBLK * DQK * 2, KROWB = DQK * 2, NCK = DQK / 64, C8 = DQK / 8, ND0 = DQK / 16;
    static constexpr float SCALE = (DQK == 128) ? 0.088388347648318440f : 0.072168783648703220f;
    static constexpr int LDS_BYTES = 2 * SHM_V + 2 * SHM_K + NW * 64 * 4;
};
#define ATT_SBAR() __builtin_amdgcn_sched_barrier(0)
__device__ __forceinline__ int crow(int r, int hi) { return (r & 3) + 8 * (r >> 2) + 4 * hi; }
__device__ __forceinline__ unsigned cvtpk(float lo, float hi) { unsigned r; asm volatile("v_cvt_pk_bf16_f32 %0, %1, %2" : "=v"(r) : "v"(lo), "v"(hi)); return r; }
template <int DQK> __device__ __forceinline__ int kswz(int row, int colB) {
    const int key = (DQK == 128) ? (row & 7) : ((row >> 1) & 7);
    return row * (DQK * 2) + (colB ^ (key << 4));
}
template <int DQK> __device__ __forceinline__ void partialSM(f32x16& p0, f32x16& p1, float& m_reg, float& mn, float& alpha) {
    constexpr float SCALE = Cfg<DQK>::SCALE, C = SCALE * 1.4426950408889634f;
    float pmax = p0[0];
#pragma unroll
    for (int r = 1; r < 16; ++r) pmax = fmaxf(pmax, p0[r]);
#pragma unroll
    for (int r = 0; r < 16; ++r) pmax = fmaxf(pmax, p1[r]);
    { auto rr = __builtin_amdgcn_permlane32_swap(__float_as_uint(pmax), __float_as_uint(pmax), false, false);
      pmax = fmaxf(__uint_as_float(rr[0]), __uint_as_float(rr[1])); }
    if (__builtin_expect(__all(pmax - m_reg <= THR / SCALE), 1)) { mn = m_reg; alpha = 1.f; }
    else { mn = fmaxf(m_reg, pmax); alpha = __builtin_amdgcn_exp2f((m_reg - mn) * C); m_reg = mn; }
    const float mnC = -mn * C;
#pragma unroll
    for (int r = 0; r < 16; ++r) p0[r] = fmaf(p0[r], C, mnC);
#pragma unroll
    for (int r = 0; r < 16; ++r) p1[r] = fmaf(p1[r], C, mnC);
#pragma unroll
    for (int r = 0; r < 16; ++r) p0[r] = __builtin_amdgcn_exp2f(p0[r]);
}
__device__ __forceinline__ void finishSM(f32x16& p0, f32x16& p1, float alpha, float& l_reg, bf16x8& pa0, bf16x8& pa1, bf16x8& pa2, bf16x8& pa3) {
#pragma unroll
    for (int r = 0; r < 16; ++r) p1[r] = __builtin_amdgcn_exp2f(p1[r]);
    float ps = 0;
#pragma unroll
    for (int r = 0; r < 16; ++r) ps += p0[r];
#pragma unroll
    for (int r = 0; r < 16; ++r) ps += p1[r];
    { auto rr = __builtin_amdgcn_permlane32_swap(__float_as_uint(ps), __float_as_uint(ps), false, false);
      ps = __uint_as_float(rr[0]) + __uint_as_float(rr[1]); }
    l_reg = l_reg * alpha + ps;
#define ATT_PK4(P, BASE, OUT) do { unsigned a0 = cvtpk(P[BASE + 0], P[BASE + 1]), a1 = cvtpk(P[BASE + 2], P[BASE + 3]);   \
    unsigned b0 = cvtpk(P[BASE + 4], P[BASE + 5]), b1 = cvtpk(P[BASE + 6], P[BASE + 7]);                              \
    auto r0 = __builtin_amdgcn_permlane32_swap(a0, b0, false, false); auto r1 = __builtin_amdgcn_permlane32_swap(a1, b1, false, false); \
    u32x4 w = {r0[0], r1[0], r0[1], r1[1]}; OUT = *reinterpret_cast<bf16x8*>(&w); } while (0)
    ATT_PK4(p0, 0, pa0); ATT_PK4(p0, 8, pa1); ATT_PK4(p1, 0, pa2); ATT_PK4(p1, 8, pa3);
#undef ATT_PK4
}
template <int DQK> __device__ __forceinline__ void qkt(f32x16& p0, f32x16& p1, const char* Ks, const bf16x8* qr, int r32, int hi) {
    p0 = f32x16{}; p1 = f32x16{};
#pragma unroll
    for (int d0 = 0; d0 < Cfg<DQK>::ND0; ++d0) { const int cb = (d0 * 16 + hi * 8) * 2;
        bf16x8 b0 = *reinterpret_cast<const bf16x8*>(Ks + kswz<DQK>(r32, cb));
        bf16x8 b1 = *reinterpret_cast<const bf16x8*>(Ks + kswz<DQK>(32 + r32, cb));
        p0 = __builtin_amdgcn_mfma_f32_32x32x16_bf16(b0, qr[d0], p0, 0, 0, 0);
        p1 = __builtin_amdgcn_mfma_f32_32x32x16_bf16(b1, qr[d0], p1, 0, 0, 0); }
}
__device__ __forceinline__ int v_st(int k, int c) { const int kk = (k & ~0xC) | ((k & 4) << 1) | ((k & 8) >> 1); return ((kk >> 3) * 4 + (c >> 5)) * 512 + ((kk & 7) * 32 + (c & 31)) * 2; }
__device__ __forceinline__ int v_rd_base(int lane) { return ((lane & 3) << 3) | (((lane >> 2) & 3) << 6) | (((lane >> 4) & 1) << 5) | (((lane >> 5) & 1) << 8); }
constexpr int v_rd_off(int d0, int ks, int half) { return d0 * 512 + ks * 4096 + half * 2048; }
template <int OFF> __device__ __forceinline__ s16x4 tr_read(int vb) {
    s16x4 r; asm volatile("ds_read_b64_tr_b16 %0, %1 offset:%2" : "=&v"(r) : "v"(vb), "i"(OFF) : "memory"); return r;
}
template <int D0> __device__ __forceinline__ void pv_one(f32x16& od, int vb, bf16x8 pa0, bf16x8 pa1, bf16x8 pa2, bf16x8 pa3) {
    const s16x4 l0 = tr_read<v_rd_off(D0, 0, 0)>(vb), h0 = tr_read<v_rd_off(D0, 0, 1)>(vb), l1 = tr_read<v_rd_off(D0, 1, 0)>(vb), h1 = tr_read<v_rd_off(D0, 1, 1)>(vb);
    const s16x4 l2 = tr_read<v_rd_off(D0, 2, 0)>(vb), h2 = tr_read<v_rd_off(D0, 2, 1)>(vb), l3 = tr_read<v_rd_off(D0, 3, 0)>(vb), h3 = tr_read<v_rd_off(D0, 3, 1)>(vb);
    asm volatile("s_waitcnt lgkmcnt(0)" ::: "memory"); ATT_SBAR();
#define ATT_PK(L, H) (bf16x8){L[0], L[1], L[2], L[3], H[0], H[1], H[2], H[3]}
    od = __builtin_amdgcn_mfma_f32_32x32x16_bf16(pa0, ATT_PK(l0, h0), od, 0, 0, 0);
    od = __builtin_amdgcn_mfma_f32_32x32x16_bf16(pa1, ATT_PK(l1, h1), od, 0, 0, 0);
    od = __builtin_amdgcn_mfma_f32_32x32x16_bf16(pa2, ATT_PK(l2, h2), od, 0, 0, 0);
    od = __builtin_amdgcn_mfma_f32_32x32x16_bf16(pa3, ATT_PK(l3, h3), od, 0, 0, 0);
#undef ATT_PK
}
__device__ __forceinline__ void pv_d0(f32x16* o, int vb, bf16x8 pa0, bf16x8 pa1, bf16x8 pa2, bf16x8 pa3) {
    pv_one<0>(o[0], vb, pa0, pa1, pa2, pa3); pv_one<1>(o[1], vb, pa0, pa1, pa2, pa3); pv_one<2>(o[2], vb, pa0, pa1, pa2, pa3); pv_one<3>(o[3], vb, pa0, pa1, pa2, pa3);
}
template <int DQK, int LDQ, int LDK, int LDV, int LDO, int SDEPTH>
__device__ __forceinline__ void attn_body(const bf16_t* __restrict__ Qb, const bf16_t* __restrict__ Kh, const bf16_t* __restrict__ Vh, bf16_t* __restrict__ Ob, int seq, char* lds, int tid_in) {
    using C_ = Cfg<DQK>;
    constexpr int SHM_K = C_::SHM_K, NCK = C_::NCK, C8 = C_::C8, ND0 = C_::ND0;
    int tid_ = tid_in; asm volatile("" : "+v"(tid_));
    const int tid = tid_, wid = tid >> 6, lane = tid & 63, r32 = lane & 31, hi = lane >> 5;
    char* V_lds = lds; char* K_lds = lds + 2 * SHM_V;
    float* ws = (float*)(lds + 2 * SHM_V + 2 * SHM_K) + wid * 64; float* li_l = ws; float* al_l = ws + 32;
    float m_reg = -1e30f, l_reg = 0; f32x16 o[4] = {}; bf16x8 qr[ND0];
    const bf16_t* Qw = Qb + (long)(wid * QBLK + r32) * LDQ + hi * 8;
#pragma unroll
    for (int d0 = 0; d0 < ND0; ++d0) qr[d0] = *reinterpret_cast<const bf16x8*>(Qw + d0 * 16);
    const int sr = tid >> 4, sc = (tid & 15) * 8, vst0 = v_st(sr, sc), vst1 = v_st(32 + sr, sc);
    int krow[NCK], kcol[NCK];
#pragma unroll
    for (int i = 0; i < NCK; ++i) { const int ci = tid + 512 * i; krow[i] = ci / C8; kcol[i] = (ci % C8) * 8; }
    const int vb0 = (int)(uintptr_t)V_lds + v_rd_base(lane);
    struct { bf16x8 vs0, vs1, ks[NCK]; } sr_[SDEPTH];
#define ATT_SLOAD(i, k0) do { sr_[i].vs0 = *reinterpret_cast<const bf16x8*>(&Vh[(long)((k0) + sr) * LDV + sc]); sr_[i].vs1 = *reinterpret_cast<const bf16x8*>(&Vh[(long)((k0) + 32 + sr) * LDV + sc]); \
    _Pragma("unroll") for (int c_ = 0; c_ < NCK; ++c_) sr_[i].ks[c_] = *reinterpret_cast<const bf16x8*>(&Kh[(long)((k0) + krow[c_]) * LDK + kcol[c_]]); } while (0)
#define ATT_SWRITE(b, i) do { *(bf16x8*)(V_lds + (b) * SHM_V + vst0) = sr_[i].vs0; *(bf16x8*)(V_lds + (b) * SHM_V + vst1) = sr_[i].vs1; \
    _Pragma("unroll") for (int c_ = 0; c_ < NCK; ++c_) *(bf16x8*)(K_lds + (b) * SHM_K + kswz<DQK>(krow[c_], kcol[c_] * 2)) = sr_[i].ks[c_]; } while (0)
#define ATT_SWAIT() do { if constexpr (SDEPTH == 2) { if constexpr (NCK == 2) asm volatile("s_waitcnt vmcnt(4)" ::: "memory"); else asm volatile("s_waitcnt vmcnt(5)" ::: "memory"); } else asm volatile("s_waitcnt vmcnt(0)" ::: "memory"); } while (0)
#define ATT_RESC(a) do { if (__any((a) < 1.f)) { if (hi == 0) al_l[r32] = (a); asm volatile("s_waitcnt lgkmcnt(0)" ::: "memory"); \
    _Pragma("unroll") for (int d = 0; d < 4; ++d) _Pragma("unroll") for (int r = 0; r < 16; ++r) o[d][r] *= al_l[crow(r, hi)]; } } while (0)
    f32x16 pA0, pA1, pB0, pB1; float mnA, mnB, alA, alB; bf16x8 pa0, pa1, pa2, pa3; const int NT = seq / KVBLK;
    constexpr int SE = 0, SO = SDEPTH - 1;
    ATT_SLOAD(SE, 0); asm volatile("s_waitcnt vmcnt(0)" ::: "memory"); ATT_SWRITE(0, SE); __syncthreads();
    qkt<DQK>(pA0, pA1, K_lds, qr, r32, hi); partialSM<DQK>(pA0, pA1, m_reg, mnA, alA);
    ATT_SLOAD(SO, KVBLK); if constexpr (SDEPTH == 2) { if (2 < NT) ATT_SLOAD(SE, 2 * KVBLK); }
    ATT_SWAIT(); ATT_SWRITE(1, SO); __syncthreads();
    for (int j = 1; j + 1 < NT; j += 2) {
        ATT_SBAR(); qkt<DQK>(pB0, pB1, K_lds + SHM_K, qr, r32, hi);
        finishSM(pA0, pA1, alA, l_reg, pa0, pa1, pa2, pa3); ATT_SBAR();
        ATT_SLOAD(SO, (j + SDEPTH) * KVBLK); ATT_SBAR();
        pv_d0(o, vb0, pa0, pa1, pa2, pa3); partialSM<DQK>(pB0, pB1, m_reg, mnB, alB);
        __syncthreads(); ATT_SWAIT(); ATT_SWRITE(0, SE);
        ATT_RESC(alB); __syncthreads();
        ATT_SBAR(); qkt<DQK>(pA0, pA1, K_lds, qr, r32, hi);
        finishSM(pB0, pB1, alB, l_reg, pa0, pa1, pa2, pa3); ATT_SBAR();
        if (SDEPTH == 1 || j + 3 < NT) ATT_SLOAD(SE, (j + 1 + SDEPTH) * KVBLK); ATT_SBAR();
        pv_d0(o, vb0 + (int)SHM_V, pa0, pa1, pa2, pa3); partialSM<DQK>(pA0, pA1, m_reg, mnA, alA);
        __syncthreads(); ATT_SWAIT(); ATT_SWRITE(1, SO);
        ATT_RESC(alA); __syncthreads();
    }
    ATT_SBAR(); qkt<DQK>(pB0, pB1, K_lds + SHM_K, qr, r32, hi);
    finishSM(pA0, pA1, alA, l_reg, pa0, pa1, pa2, pa3); ATT_SBAR();
    pv_d0(o, vb0, pa0, pa1, pa2, pa3); partialSM<DQK>(pB0, pB1, m_reg, mnB, alB);
    __syncthreads(); ATT_RESC(alB);
    finishSM(pB0, pB1, alB, l_reg, pa0, pa1, pa2, pa3); ATT_SBAR();
    pv_d0(o, vb0 + (int)SHM_V, pa0, pa1, pa2, pa3);
    if (hi == 0) li_l[r32] = l_reg;
    asm volatile("s_waitcnt lgkmcnt(0)" ::: "memory");
    __syncthreads();
    float rli[16];
#pragma unroll
    for (int r = 0; r < 16; ++r) rli[r] = __builtin_amdgcn_rcpf(li_l[crow(r, hi)]);
    unsigned short* stg = (unsigned short*)(lds + wid * 8192);
#pragma unroll
    for (int r = 0; r < 16; ++r) { const int orow = crow(r, hi);
#pragma unroll
        for (int d0 = 0; d0 < 4; ++d0) { const unsigned w = cvtpk(o[d0][r] * rli[r], 0.f); stg[orow * 128 + d0 * 32 + r32] = (unsigned short)(w & 0xffffu); } }
    asm volatile("s_waitcnt lgkmcnt(0)" ::: "memory");
    bf16_t* Ow = Ob + (long)(wid * QBLK) * LDO;
#pragma unroll
    for (int i = 0; i < 8; ++i) { const int id = lane + 64 * i, row = id >> 4, c16 = id & 15;
        const u32x4 v = *(const u32x4*)((const char*)stg + row * 256 + c16 * 16);
        *(u32x4*)(Ow + (long)row * LDO + c16 * 8) = v; }
    asm volatile("s_waitcnt lgkmcnt(0)" ::: "memory");
    __syncthreads();
#undef ATT_SLOAD
#undef ATT_SWRITE
#undef ATT_SWAIT
#undef ATT_RESC
}

template <int DQK, int LDQ, int LDK, int LDV, int LDO>
__device__ __forceinline__ void attn_body1(const bf16_t* __restrict__ Qb, const bf16_t* __restrict__ Kh, const bf16_t* __restrict__ Vh, bf16_t* __restrict__ Ob, int seq, char* lds, int tid_in) {
    using C_ = Cfg<DQK>;
    constexpr int SHM_K = C_::SHM_K, NCK = C_::NCK, C8 = C_::C8, ND0 = C_::ND0;
    int tid_ = tid_in; asm volatile("" : "+v"(tid_));
    const int tid = tid_, wid = tid >> 6, lane = tid & 63, r32 = lane & 31, hi = lane >> 5;
    char* V_lds = lds; char* K_lds = lds + 2 * SHM_V;
    float* ws = (float*)(lds + 2 * SHM_V + 2 * SHM_K) + wid * 64; float* li_l = ws; float* al_l = ws + 32;
    float m_reg = -1e30f, l_reg = 0; f32x16 o[4] = {}; bf16x8 qr[ND0];
    const bf16_t* Qw = Qb + (long)(wid * QBLK + r32) * LDQ + hi * 8;
#pragma unroll
    for (int d0 = 0; d0 < ND0; ++d0) qr[d0] = *reinterpret_cast<const bf16x8*>(Qw + d0 * 16);
    const int sr = tid >> 4, sc = (tid & 15) * 8, vst0 = v_st(sr, sc), vst1 = v_st(32 + sr, sc);
    int krow[NCK], kcol[NCK];
#pragma unroll
    for (int i = 0; i < NCK; ++i) { const int ci = tid + 512 * i; krow[i] = ci / C8; kcol[i] = (ci % C8) * 8; }
    const int vb0 = (int)(uintptr_t)V_lds + v_rd_base(lane);
    bf16x8 vs0, vs1, ks[NCK];
#define ATT1_SLOAD(k0) do { vs0 = *reinterpret_cast<const bf16x8*>(&Vh[(long)((k0) + sr) * LDV + sc]); vs1 = *reinterpret_cast<const bf16x8*>(&Vh[(long)((k0) + 32 + sr) * LDV + sc]); \
    _Pragma("unroll") for (int c_ = 0; c_ < NCK; ++c_) ks[c_] = *reinterpret_cast<const bf16x8*>(&Kh[(long)((k0) + krow[c_]) * LDK + kcol[c_]]); } while (0)
#define ATT1_SWRITE(b) do { *(bf16x8*)(V_lds + (b) * SHM_V + vst0) = vs0; *(bf16x8*)(V_lds + (b) * SHM_V + vst1) = vs1; \
    _Pragma("unroll") for (int c_ = 0; c_ < NCK; ++c_) *(bf16x8*)(K_lds + (b) * SHM_K + kswz<DQK>(krow[c_], kcol[c_] * 2)) = ks[c_]; } while (0)
    const int NT = seq / KVBLK;
    ATT1_SLOAD(0); asm volatile("s_waitcnt vmcnt(0)" ::: "memory"); ATT1_SWRITE(0); __syncthreads();
    for (int j = 0; j < NT; ++j) {
        const int b = j & 1;
        if (j + 1 < NT) ATT1_SLOAD((j + 1) * KVBLK);
        ATT_SBAR();
        f32x16 p0, p1; float mn, alpha; bf16x8 pa0, pa1, pa2, pa3;
        qkt<DQK>(p0, p1, K_lds + b * SHM_K, qr, r32, hi);
        partialSM<DQK>(p0, p1, m_reg, mn, alpha);
        if (__any(alpha < 1.f)) { if (hi == 0) al_l[r32] = alpha; asm volatile("s_waitcnt lgkmcnt(0)" ::: "memory");
#pragma unroll
            for (int d = 0; d < 4; ++d)
#pragma unroll
                for (int r = 0; r < 16; ++r) o[d][r] *= al_l[crow(r, hi)]; }
        finishSM(p0, p1, alpha, l_reg, pa0, pa1, pa2, pa3); ATT_SBAR();
        pv_d0(o, vb0 + b * (int)SHM_V, pa0, pa1, pa2, pa3);
        if (j + 1 < NT) { ATT1_SWRITE(b ^ 1); }
        __syncthreads();
    }
    if (hi == 0) li_l[r32] = l_reg;
    asm volatile("s_waitcnt lgkmcnt(0)" ::: "memory");
    __syncthreads();
    float rli[16];
#pragma unroll
    for (int r = 0; r < 16; ++r) rli[r] = __builtin_amdgcn_rcpf(li_l[crow(r, hi)]);
    unsigned short* stg = (unsigned short*)(lds + wid * 8192);
#pragma unroll
    for (int r = 0; r < 16; ++r) { const int orow = crow(r, hi);
#pragma unroll
        for (int d0 = 0; d0 < 4; ++d0) { const unsigned w = cvtpk(o[d0][r] * rli[r], 0.f); stg[orow * 128 + d0 * 32 + r32] = (unsigned short)(w & 0xffffu); } }
    asm volatile("s_waitcnt lgkmcnt(0)" ::: "memory");
    bf16_t* Ow = Ob + (long)(wid * QBLK) * LDO;
#pragma unroll
    for (int i = 0; i < 8; ++i) { const int id = lane + 64 * i, row = id >> 4, c16 = id & 15;
        const u32x4 v = *(const u32x4*)((const char*)stg + row * 256 + c16 * 16);
        *(u32x4*)(Ow + (long)row * LDO + c16 * 8) = v; }
    asm volatile("s_waitcnt lgkmcnt(0)" ::: "memory");
    __syncthreads();
#undef ATT1_SLOAD
#undef ATT1_SWRITE
}
template <int DQK, int LDQ, int LDK, int LDV, int LDO>
__device__ __forceinline__ void attn_body1g(const bf16_t* __restrict__ Qb, const bf16_t* __restrict__ Kh, const bf16_t* __restrict__ Vh, bf16_t* __restrict__ Ob, int seq, char* lds, int tid_in) {
    using C_ = Cfg<DQK>;
    constexpr int SHM_K = C_::SHM_K, NCK = C_::NCK, ND0 = C_::ND0, KROWB = C_::KROWB;
    typedef __attribute__((address_space(3))) unsigned l3u;
    int tid_ = tid_in; asm volatile("" : "+v"(tid_));
    const int tid = tid_, wid = tid >> 6, lane = tid & 63, r32 = lane & 31, hi = lane >> 5;
    const int widu = __builtin_amdgcn_readfirstlane(wid);
    char* V_lds = lds; char* K_lds = lds + 3 * SHM_V;
    __attribute__((address_space(3))) char* l3 = (__attribute__((address_space(3))) char*)lds;
    float* ws = (float*)(lds + 3 * SHM_V + 3 * SHM_K) + wid * 64; float* li_l = ws; float* al_l = ws + 32;
    float m_reg = -1e30f, l_reg = 0; f32x16 o[4] = {}; bf16x8 qr[ND0];
    const bf16_t* Qw = Qb + (long)(wid * QBLK + r32) * LDQ + hi * 8;
#pragma unroll
    for (int d0 = 0; d0 < ND0; ++d0) qr[d0] = *reinterpret_cast<const bf16x8*>(Qw + d0 * 16);
    int koff[NCK], voff[2];
#pragma unroll
    for (int i = 0; i < NCK; ++i) { const int ob = (wid + 8 * i) * 1024 + 16 * lane, row = ob / KROWB, pos = (ob - row * KROWB) >> 4;
        const int key = (DQK == 128) ? (row & 7) : ((row >> 1) & 7); koff[i] = row * LDK + ((pos ^ key) << 3); }
#pragma unroll
    for (int i = 0; i < 2; ++i) { const int ob = (wid + 8 * i) * 1024 + 16 * lane, st = ob >> 9, r = ob & 511, kk = (st >> 2) * 8 + (r >> 6), c = (st & 3) * 32 + ((r & 63) >> 1);
        const int k = (kk & ~0xC) | ((kk & 4) << 1) | ((kk & 8) >> 1); voff[i] = k * LDV + c; }
    const int vb0 = (int)(uintptr_t)V_lds + v_rd_base(lane);
    const int NT = seq / KVBLK;
#define ATT1G_ISSUE(jt, b) do { const int jc_ = (jt) < NT ? (jt) : NT - 1; const bf16_t* kp_ = Kh + (long)jc_ * KVBLK * LDK; const bf16_t* vp_ = Vh + (long)jc_ * KVBLK * LDV; \
    _Pragma("unroll") for (int i_ = 0; i_ < NCK; ++i_) __builtin_amdgcn_global_load_lds((const unsigned*)(kp_ + koff[i_]), (l3u*)(l3 + 3 * SHM_V + (b) * SHM_K + (widu + 8 * i_) * 1024), 16, 0, 0); \
    _Pragma("unroll") for (int i_ = 0; i_ < 2; ++i_) __builtin_amdgcn_global_load_lds((const unsigned*)(vp_ + voff[i_]), (l3u*)(l3 + (b) * SHM_V + (widu + 8 * i_) * 1024), 16, 0, 0); } while (0)
    ATT1G_ISSUE(0, 0); ATT1G_ISSUE(1, 1);
    asm volatile("s_waitcnt vmcnt(%0)" :: "n"(NCK + 2) : "memory");
    __builtin_amdgcn_s_barrier(); ATT_SBAR();
    int b = 0, b2 = 2;
    for (int j = 0; j < NT; ++j) {
        ATT1G_ISSUE(j + 2, b2);
        ATT_SBAR();
        f32x16 p0, p1; float mn, alpha; bf16x8 pa0, pa1, pa2, pa3;
        qkt<DQK>(p0, p1, K_lds + b * SHM_K, qr, r32, hi);
        partialSM<DQK>(p0, p1, m_reg, mn, alpha);
        if (__any(alpha < 1.f)) { if (hi == 0) al_l[r32] = alpha; asm volatile("s_waitcnt lgkmcnt(0)" ::: "memory");
#pragma unroll
            for (int d = 0; d < 4; ++d)
#pragma unroll
                for (int r = 0; r < 16; ++r) o[d][r] *= al_l[crow(r, hi)]; }
        finishSM(p0, p1, alpha, l_reg, pa0, pa1, pa2, pa3); ATT_SBAR();
        pv_d0(o, vb0 + b * (int)SHM_V, pa0, pa1, pa2, pa3);
        asm volatile("s_waitcnt vmcnt(%0) lgkmcnt(0)" :: "n"(NCK + 2) : "memory");
        __builtin_amdgcn_s_barrier(); ATT_SBAR();
        b = (b == 2) ? 0 : b + 1; b2 = (b2 == 2) ? 0 : b2 + 1;
    }
    asm volatile("s_waitcnt vmcnt(0)" ::: "memory");
    if (hi == 0) li_l[r32] = l_reg;
    asm volatile("s_waitcnt lgkmcnt(0)" ::: "memory");
    __syncthreads();
    float rli[16];
#pragma unroll
    for (int r = 0; r < 16; ++r) rli[r] = __builtin_amdgcn_rcpf(li_l[crow(r, hi)]);
    unsigned short* stg = (unsigned short*)(lds + wid * 8192);
#pragma unroll
    for (int r = 0; r < 16; ++r) { const int orow = crow(r, hi);
#pragma unroll
        for (int d0 = 0; d0 < 4; ++d0) { const unsigned w = cvtpk(o[d0][r] * rli[r], 0.f); stg[orow * 128 + d0 * 32 + r32] = (unsigned short)(w & 0xffffu); } }
    asm volatile("s_waitcnt lgkmcnt(0)" ::: "memory");
    bf16_t* Ow = Ob + (long)(wid * QBLK) * LDO;
#pragma unroll
    for (int i = 0; i < 8; ++i) { const int id = lane + 64 * i, row = id >> 4, c16 = id & 15;
        const u32x4 v = *(const u32x4*)((const char*)stg + row * 256 + c16 * 16);
        *(u32x4*)(Ow + (long)row * LDO + c16 * 8) = v; }
    asm volatile("s_waitcnt lgkmcnt(0)" ::: "memory");
    __syncthreads();
#undef ATT1G_ISSUE
}
template <int DQK, int LDQ, int LDK, int LDV, int LDO>
__device__ __forceinline__ void attn_body2g(const bf16_t* __restrict__ Qb, const bf16_t* __restrict__ Kh, const bf16_t* __restrict__ Vh, bf16_t* __restrict__ Ob, int seq, char* lds, int tid_in) {
    using C_ = Cfg<DQK>;
    constexpr int SHM_K = C_::SHM_K, NCK = C_::NCK, ND0 = C_::ND0, KROWB = C_::KROWB;
    typedef __attribute__((address_space(3))) unsigned l3u;
    int tid_ = tid_in; asm volatile("" : "+v"(tid_));
    const int tid = tid_, wid = tid >> 6, lane = tid & 63, r32 = lane & 31, hi = lane >> 5;
    const int widu = __builtin_amdgcn_readfirstlane(wid);
    char* V_lds = lds; char* K_lds = lds + 3 * SHM_V;
    __attribute__((address_space(3))) char* l3 = (__attribute__((address_space(3))) char*)lds;
    float* ws = (float*)(lds + 3 * SHM_V + 3 * SHM_K) + wid * 64; float* li_l = ws; float* al_l = ws + 32;
    float m_reg = -1e30f, l_reg = 0; f32x16 o[4] = {}; bf16x8 qr[ND0];
    const bf16_t* Qw = Qb + (long)(wid * QBLK + r32) * LDQ + hi * 8;
#pragma unroll
    for (int d0 = 0; d0 < ND0; ++d0) qr[d0] = *reinterpret_cast<const bf16x8*>(Qw + d0 * 16);
    int koff[NCK], voff[2];
#pragma unroll
    for (int i = 0; i < NCK; ++i) { const int ob = (wid + 8 * i) * 1024 + 16 * lane, row = ob / KROWB, pos = (ob - row * KROWB) >> 4;
        const int key = (DQK == 128) ? (row & 7) : ((row >> 1) & 7); koff[i] = row * LDK + ((pos ^ key) << 3); }
#pragma unroll
    for (int i = 0; i < 2; ++i) { const int ob = (wid + 8 * i) * 1024 + 16 * lane, st = ob >> 9, r = ob & 511, kk = (st >> 2) * 8 + (r >> 6), c = (st & 3) * 32 + ((r & 63) >> 1);
        const int k = (kk & ~0xC) | ((kk & 4) << 1) | ((kk & 8) >> 1); voff[i] = k * LDV + c; }
    const int vb0 = (int)(uintptr_t)V_lds + v_rd_base(lane);
    const int NT = seq / KVBLK;
#define ATT2G_K(jt, b) do { const int jc_ = (jt) < NT ? (jt) : NT - 1; const bf16_t* kp_ = Kh + (long)jc_ * KVBLK * LDK; \
    _Pragma("unroll") for (int i_ = 0; i_ < NCK; ++i_) __builtin_amdgcn_global_load_lds((const unsigned*)(kp_ + koff[i_]), (l3u*)(l3 + 3 * SHM_V + (b) * SHM_K + (widu + 8 * i_) * 1024), 16, 0, 0); } while (0)
#define ATT2G_V(jt, b) do { const int jc_ = (jt) < NT ? (jt) : NT - 1; const bf16_t* vp_ = Vh + (long)jc_ * KVBLK * LDV; \
    _Pragma("unroll") for (int i_ = 0; i_ < 2; ++i_) __builtin_amdgcn_global_load_lds((const unsigned*)(vp_ + voff[i_]), (l3u*)(l3 + (b) * SHM_V + (widu + 8 * i_) * 1024), 16, 0, 0); } while (0)
#define ATT2G_RESC(a) do { if (__any((a) < 1.f)) { if (hi == 0) al_l[r32] = (a); asm volatile("s_waitcnt lgkmcnt(0)" ::: "memory"); \
    _Pragma("unroll") for (int d = 0; d < 4; ++d) _Pragma("unroll") for (int r = 0; r < 16; ++r) o[d][r] *= al_l[crow(r, hi)]; } } while (0)
#define ATT2G_SYNC() do { asm volatile("s_waitcnt vmcnt(%0) lgkmcnt(0)" :: "n"(NCK + 2) : "memory"); __builtin_amdgcn_s_barrier(); ATT_SBAR(); } while (0)
#define ATT2G_STEP(PC0, PC1, PP0, PP1, ALP, ALC, MNC) do { \
        ATT2G_K(j + 2, k2); ATT2G_V(j + 1, v1); ATT_SBAR(); \
        qkt<DQK>(PC0, PC1, K_lds + kc * SHM_K, qr, r32, hi); \
        finishSM(PP0, PP1, ALP, l_reg, pa0, pa1, pa2, pa3); ATT_SBAR(); \
        pv_d0(o, vb0 + vp * (int)SHM_V, pa0, pa1, pa2, pa3); partialSM<DQK>(PC0, PC1, m_reg, MNC, ALC); \
        ATT2G_SYNC(); ATT2G_RESC(ALC); \
        kc = (kc == 2) ? 0 : kc + 1; k2 = (k2 == 2) ? 0 : k2 + 1; vp = (vp == 2) ? 0 : vp + 1; v1 = (v1 == 2) ? 0 : v1 + 1; ++j; } while (0)
    f32x16 pA0, pA1, pB0, pB1; float mnA, mnB, alA, alB; bf16x8 pa0, pa1, pa2, pa3;
    ATT2G_K(0, 0); ATT2G_V(0, 0); ATT2G_K(1, 1);
    ATT2G_K(2, 2); ATT2G_V(1, 1);
    ATT2G_SYNC();
    qkt<DQK>(pA0, pA1, K_lds, qr, r32, hi); partialSM<DQK>(pA0, pA1, m_reg, mnA, alA);
    asm volatile("s_waitcnt lgkmcnt(0)" ::: "memory"); __builtin_amdgcn_s_barrier(); ATT_SBAR();
    int j = 1, kc = 1, k2 = 0, vp = 0, v1 = 2;
    while (j + 1 < NT) {
        ATT2G_STEP(pB0, pB1, pA0, pA1, alA, alB, mnB);
        ATT2G_STEP(pA0, pA1, pB0, pB1, alB, alA, mnA);
    }
    ATT2G_STEP(pB0, pB1, pA0, pA1, alA, alB, mnB);
    finishSM(pB0, pB1, alB, l_reg, pa0, pa1, pa2, pa3); ATT_SBAR();
    pv_d0(o, vb0 + vp * (int)SHM_V, pa0, pa1, pa2, pa3);
    asm volatile("s_waitcnt vmcnt(0)" ::: "memory");
    if (hi == 0) li_l[r32] = l_reg;
    asm volatile("s_waitcnt lgkmcnt(0)" ::: "memory");
    __syncthreads();
    float rli[16];
#pragma unroll
    for (int r = 0; r < 16; ++r) rli[r] = __builtin_amdgcn_rcpf(li_l[crow(r, hi)]);
    unsigned short* stg = (unsigned short*)(lds + wid * 8192);
#pragma unroll
    for (int r = 0; r < 16; ++r) { const int orow = crow(r, hi);
#pragma unroll
        for (int d0 = 0; d0 < 4; ++d0) { const unsigned w = cvtpk(o[d0][r] * rli[r], 0.f); stg[orow * 128 + d0 * 32 + r32] = (unsigned short)(w & 0xffffu); } }
    asm volatile("s_waitcnt lgkmcnt(0)" ::: "memory");
    bf16_t* Ow = Ob + (long)(wid * QBLK) * LDO;
#pragma unroll
    for (int i = 0; i < 8; ++i) { const int id = lane + 64 * i, row = id >> 4, c16 = id & 15;
        const u32x4 v = *(const u32x4*)((const char*)stg + row * 256 + c16 * 16);
        *(u32x4*)(Ow + (long)row * LDO + c16 * 8) = v; }
    asm volatile("s_waitcnt lgkmcnt(0)" ::: "memory");
    __syncthreads();
#undef ATT2G_STEP
#undef ATT2G_SYNC
#undef ATT2G_RESC
#undef ATT2G_V
#undef ATT2G_K
}
template <int DQK, int LDQ, int LDK, int LDV, int LDO>
__device__ __forceinline__ void attn_body1s(const bf16_t* __restrict__ Qb, const bf16_t* __restrict__ Kh, const bf16_t* __restrict__ Vh, bf16_t* __restrict__ Ob, int seq, char* lds, int tid_in) {
    using C_ = Cfg<DQK>;
    constexpr int SHM_K = C_::SHM_K, NCK = C_::NCK, C8 = C_::C8, ND0 = C_::ND0;
    int tid_ = tid_in; asm volatile("" : "+v"(tid_));
    const bool grpB = __builtin_amdgcn_readfirstlane(tid_ >> 16) != 0;
    const int tid = tid_ & 0xffff, wid = tid >> 6, lane = tid & 63, r32 = lane & 31, hi = lane >> 5;
    char* V_lds = lds; char* K_lds = lds + 2 * SHM_V;
    float* ws = (float*)(lds + 2 * SHM_V + 2 * SHM_K) + wid * 64; float* li_l = ws; float* al_l = ws + 32;
    float m_reg = -1e30f, l_reg = 0; f32x16 o[4] = {}; bf16x8 qr[ND0];
    const bf16_t* Qw = Qb + (long)(wid * QBLK + r32) * LDQ + hi * 8;
#pragma unroll
    for (int d0 = 0; d0 < ND0; ++d0) qr[d0] = *reinterpret_cast<const bf16x8*>(Qw + d0 * 16);
    const int sr = tid >> 4, sc = (tid & 15) * 8, vst0 = v_st(sr, sc), vst1 = v_st(32 + sr, sc);
    int krow[NCK], kcol[NCK];
#pragma unroll
    for (int i = 0; i < NCK; ++i) { const int ci = tid + 512 * i; krow[i] = ci / C8; kcol[i] = (ci % C8) * 8; }
    const int vb0 = (int)(uintptr_t)V_lds + v_rd_base(lane);
    bf16x8 vs0, vs1, ks[NCK];
#define ATT1_SLOAD(k0) do { vs0 = *reinterpret_cast<const bf16x8*>(&Vh[(long)((k0) + sr) * LDV + sc]); vs1 = *reinterpret_cast<const bf16x8*>(&Vh[(long)((k0) + 32 + sr) * LDV + sc]); \
    _Pragma("unroll") for (int c_ = 0; c_ < NCK; ++c_) ks[c_] = *reinterpret_cast<const bf16x8*>(&Kh[(long)((k0) + krow[c_]) * LDK + kcol[c_]]); } while (0)
#define ATT1_SWRITE(b) do { *(bf16x8*)(V_lds + (b) * SHM_V + vst0) = vs0; *(bf16x8*)(V_lds + (b) * SHM_V + vst1) = vs1; \
    _Pragma("unroll") for (int c_ = 0; c_ < NCK; ++c_) *(bf16x8*)(K_lds + (b) * SHM_K + kswz<DQK>(krow[c_], kcol[c_] * 2)) = ks[c_]; } while (0)
    const int NT = seq / KVBLK;
    ATT1_SLOAD(0); asm volatile("s_waitcnt vmcnt(0)" ::: "memory"); ATT1_SWRITE(0); __syncthreads();
#define ATT1_SM(P0, P1, PA0, PA1, PA2, PA3) do { float mn, alpha; partialSM<DQK>(P0, P1, m_reg, mn, alpha); \
        if (__any(alpha < 1.f)) { if (hi == 0) al_l[r32] = alpha; asm volatile("s_waitcnt lgkmcnt(0)" ::: "memory"); \
            _Pragma("unroll") for (int d = 0; d < 4; ++d) _Pragma("unroll") for (int r = 0; r < 16; ++r) o[d][r] *= al_l[crow(r, hi)]; } \
        finishSM(P0, P1, alpha, l_reg, PA0, PA1, PA2, PA3); ATT_SBAR(); } while (0)
    if (!grpB) {
        for (int j = 0; j < NT; ++j) {
            const int b = j & 1;
            if (j + 1 < NT) ATT1_SLOAD((j + 1) * KVBLK);
            ATT_SBAR();
            f32x16 p0, p1; bf16x8 pa0, pa1, pa2, pa3;
            qkt<DQK>(p0, p1, K_lds + b * SHM_K, qr, r32, hi);
            __syncthreads();
            ATT1_SM(p0, p1, pa0, pa1, pa2, pa3);
            pv_d0(o, vb0 + b * (int)SHM_V, pa0, pa1, pa2, pa3);
            if (j + 1 < NT) { ATT1_SWRITE(b ^ 1); }
            __syncthreads();
        }
    } else {
        bf16x8 pa0, pa1, pa2, pa3;
        {
            if (1 < NT) ATT1_SLOAD(KVBLK);
            ATT_SBAR();
            __syncthreads();
            f32x16 p0, p1;
            qkt<DQK>(p0, p1, K_lds, qr, r32, hi);
            ATT1_SM(p0, p1, pa0, pa1, pa2, pa3);
            if (1 < NT) { ATT1_SWRITE(1); }
            __syncthreads();
        }
        for (int j = 1; j < NT; ++j) {
            const int b = j & 1;
            if (j + 1 < NT) ATT1_SLOAD((j + 1) * KVBLK);
            ATT_SBAR();
            pv_d0(o, vb0 + (b ^ 1) * (int)SHM_V, pa0, pa1, pa2, pa3);
            __syncthreads();
            f32x16 p0, p1;
            qkt<DQK>(p0, p1, K_lds + b * SHM_K, qr, r32, hi);
            ATT1_SM(p0, p1, pa0, pa1, pa2, pa3);
            if (j + 1 < NT) { ATT1_SWRITE(b ^ 1); }
            __syncthreads();
        }
        pv_d0(o, vb0 + ((NT - 1) & 1) * (int)SHM_V, pa0, pa1, pa2, pa3);
    }
#undef ATT1_SM
    if (hi == 0) li_l[r32] = l_reg;
    asm volatile("s_waitcnt lgkmcnt(0)" ::: "memory");
    __syncthreads();
    float rli[16];
#pragma unroll
    for (int r = 0; r < 16; ++r) rli[r] = __builtin_amdgcn_rcpf(li_l[crow(r, hi)]);
    unsigned short* stg = (unsigned short*)(lds + wid * 8192);
#pragma unroll
    for (int r = 0; r < 16; ++r) { const int orow = crow(r, hi);
#pragma unroll
        for (int d0 = 0; d0 < 4; ++d0) { const unsigned w = cvtpk(o[d0][r] * rli[r], 0.f); stg[orow * 128 + d0 * 32 + r32] = (unsigned short)(w & 0xffffu); } }
    asm volatile("s_waitcnt lgkmcnt(0)" ::: "memory");
    bf16_t* Ow = Ob + (long)(wid * QBLK) * LDO;
#pragma unroll
    for (int i = 0; i < 8; ++i) { const int id = lane + 64 * i, row = id >> 4, c16 = id & 15;
        const u32x4 v = *(const u32x4*)((const char*)stg + row * 256 + c16 * 16);
        *(u32x4*)(Ow + (long)row * LDO + c16 * 8) = v; }
    asm volatile("s_waitcnt lgkmcnt(0)" ::: "memory");
    __syncthreads();
#undef ATT1_SLOAD
#undef ATT1_SWRITE
}
}
constexpr int DM = 2048, NBATCH = 2, SEQ = 4096, CTX = 256, RB = SEQ + CTX  , MROWS = NBATCH * RB  ;
constexpr int NMOD = 6 * DM, NEXP = 16384;
constexpr float EPS = 1e-6f;
constexpr int NWAVES = 8, NTHREADS = 512;
constexpr size_t MiB = 1u << 20;
constexpr size_t WS_CTL = 0, CTL_ZERO_BYTES = 64 * 1024;
constexpr size_t WS_MOD = 1 * MiB;
constexpr size_t WS_ROPE = 2 * MiB;
constexpr size_t WS_SMALL = 3 * MiB;
constexpr int SM_N1G = 0, SM_N2G = 8192, SM_AQG = 16384, SM_AKG = 16384 + 384, SM_CW = 16384 + 768, SM_CB = SM_CW + 6144, SM_CQG = SM_CB + 2048, SM_CKG = SM_CQG + 256, SM_END = SM_CKG + 256;
constexpr size_t WS_PTRS = 3 * MiB + 512 * 1024;
constexpr size_t WS_XW = 4 * MiB;
constexpr size_t WS_H = 72 * MiB;
constexpr size_t WS_P = 106 * MiB;
constexpr size_t WS_QRAW = 174 * MiB;
constexpr size_t WS_KVRAW = 200 * MiB;
constexpr size_t WS_Q = 234 * MiB;
constexpr size_t WS_K = 268 * MiB;
constexpr size_t WS_V = 294 * MiB;
constexpr size_t WS_CAT = 311 * MiB;
constexpr size_t WS_PQ = 345 * MiB;
constexpr size_t WS_IDX = 379 * MiB;
constexpr size_t WS_GATE = 384 * MiB;
constexpr size_t WS_WIN = 389 * MiB;
constexpr size_t WS_WUQ = 421 * MiB;
constexpr size_t WS_WUKV = 424 * MiB;
constexpr size_t WS_WEO = 426 * MiB;
constexpr size_t WS_WQKV = 442 * MiB;
constexpr size_t WS_WCO = 466 * MiB;
constexpr size_t WS_WPQ = 482 * MiB;
constexpr size_t WS_SUBK = 514 * MiB;
#ifndef TAB_FP4
#define TAB_FP4 1
#endif
#if TAB_FP4
constexpr int ROWB = 1024;
#else
constexpr int ROWB = 1536;
#endif
constexpr size_t WS_U = 516 * MiB;
constexpr size_t WS_VT = 644 * MiB;
constexpr size_t WS_USC = 772 * MiB;
constexpr size_t WS_VSC = 773 * MiB;
constexpr size_t WS_XQ = 810 * MiB;
constexpr size_t WS_XS = 828 * MiB;
constexpr size_t WS_WQ8 = 834 * MiB;
constexpr size_t WS_WSC = 836 * MiB;
constexpr size_t WS_PART = 774 * MiB;
constexpr size_t WS_END = 837 * MiB;
#ifndef EXP_SLICED
#define EXP_SLICED 1
#endif
#ifndef PEER_MFMA
#define PEER_MFMA 1
#endif
#ifndef PEER_VMFMA
#define PEER_VMFMA 1
#endif
constexpr int CW_BAR = 4096;
constexpr int LDS_MISC = 131072 + 8192;
constexpr int LDS_BYTES = 147456;

#define LAS __attribute__((address_space(3)))
typedef unsigned short bf16_t;
typedef float f32x4 __attribute__((ext_vector_type(4)));
typedef unsigned u32x4 __attribute__((ext_vector_type(4)));
typedef unsigned u32x2 __attribute__((ext_vector_type(2)));
typedef short bf16x8 __attribute__((ext_vector_type(8)));
typedef float f32x16 __attribute__((ext_vector_type(16)));
typedef __bf16 bf16x2_t __attribute__((ext_vector_type(2)));
typedef float f32x2 __attribute__((ext_vector_type(2)));
typedef _Float16 h2_t __attribute__((ext_vector_type(2)));
typedef float f32x32 __attribute__((ext_vector_type(32)));
typedef unsigned u32x6 __attribute__((ext_vector_type(6)));

__device__ __forceinline__ unsigned f2bf(float f) { unsigned u = __builtin_bit_cast(unsigned, f); return (u + 0x7fffu + ((u >> 16) & 1u)) >> 16; }
__device__ __forceinline__ unsigned pk2(float lo, float hi) { return f2bf(lo) | (f2bf(hi) << 16); }
__device__ __forceinline__ float bf_lo(unsigned w) { return __builtin_bit_cast(float, w << 16); }
__device__ __forceinline__ float bf_hi(unsigned w) { return __builtin_bit_cast(float, w & 0xffff0000u); }
__device__ __forceinline__ float bf2f(bf16_t h) { return __builtin_bit_cast(float, (unsigned)h << 16); }
__device__ __forceinline__ float wave_sum(float v) {
#pragma unroll
    for (int o = 1; o < 64; o <<= 1) v += __shfl_xor(v, o);
    return v;
}
#define DPP_ADD(v, ctrl) ((v) + __builtin_bit_cast(float, __builtin_amdgcn_update_dpp(0, __builtin_bit_cast(int, (v)), (ctrl), 0xf, 0xf, true)))
__device__ __forceinline__ float wave_sum_dpp(float v) {
    v = DPP_ADD(v, 0xB1);
    v = DPP_ADD(v, 0x4E);
    v = DPP_ADD(v, 0x141);
    v = DPP_ADD(v, 0x140);
    const int vi = __builtin_bit_cast(int, v);
    const float s0 = __builtin_bit_cast(float, __builtin_amdgcn_readlane(vi, 0)), s1 = __builtin_bit_cast(float, __builtin_amdgcn_readlane(vi, 16));
    const float s2 = __builtin_bit_cast(float, __builtin_amdgcn_readlane(vi, 32)), s3 = __builtin_bit_cast(float, __builtin_amdgcn_readlane(vi, 48));
    return (s0 + s1) + (s2 + s3);
}
#define DPP_MOV(v, ctrl) __builtin_bit_cast(float, __builtin_amdgcn_update_dpp(0, __builtin_bit_cast(int, (v)), (ctrl), 0xf, 0xf, true))
__device__ __forceinline__ float wave_max_dpp(float v) {
    v = fmaxf(v, DPP_MOV(v, 0xB1)); v = fmaxf(v, DPP_MOV(v, 0x4E)); v = fmaxf(v, DPP_MOV(v, 0x141)); v = fmaxf(v, DPP_MOV(v, 0x140));
    const int vi = __builtin_bit_cast(int, v);
    return fmaxf(fmaxf(__builtin_bit_cast(float, __builtin_amdgcn_readlane(vi, 0)), __builtin_bit_cast(float, __builtin_amdgcn_readlane(vi, 16))),
                 fmaxf(__builtin_bit_cast(float, __builtin_amdgcn_readlane(vi, 32)), __builtin_bit_cast(float, __builtin_amdgcn_readlane(vi, 48))));
}
__device__ __forceinline__ float dot2_bf16(unsigned w, unsigned x, float acc) { return __builtin_amdgcn_fdot2_f32_bf16(__builtin_bit_cast(bf16x2_t, w), __builtin_bit_cast(bf16x2_t, x), acc, false); }
__device__ __forceinline__ float gelu_erf(float v) {
    const float av = fabsf(v), t = __builtin_amdgcn_rcpf(av * 0.2316418882f + 1.0f);
    float q = t * 0.5307027145f + (-0.7265760135f); q = q * t + 0.7107068705f; q = q * t + (-0.142248368f); q = q * t + 0.127414796f; q = q * t;
    const float e = __builtin_amdgcn_exp2f((v * v) * (-0.72134752044f));
    const float m = v * (q * e);
    return v < 0.f ? m : v - m;
}
#define XB_TMO      128
#define XB_XCNT(j)  (256  + 64 * (j))
#define XB_XSUB(j)  (1280 + 64 * (j))
#define XB_XGEN(j)  (2304 + 64 * (j))
#define XB_TOP      3328
#define XB_TOPGEN   3392
#define XCD_BAR_WORDS 3456
#define XB_SPIN_CAP (1u << 18)

__device__ __forceinline__ unsigned xb_ld(unsigned* p)              { return __hip_atomic_load(p, __ATOMIC_RELAXED, __HIP_MEMORY_SCOPE_AGENT); }
__device__ __forceinline__ unsigned xb_add(unsigned* p, unsigned v) { return __hip_atomic_fetch_add(p, v, __ATOMIC_RELAXED, __HIP_MEMORY_SCOPE_AGENT); }
__device__ __forceinline__ unsigned xb_xcc_id() { return (unsigned)__builtin_amdgcn_s_getreg((3 << 11) | 20) & 0xFu; }
#define XB_SPIN(cond, bar) do { unsigned _sp = 0; while (cond) { __builtin_amdgcn_s_sleep(1); \
    if ((++_sp & 255u) == 0u) { if (xb_ld(&(bar)[XB_TMO])) break; if (_sp > XB_SPIN_CAP) { atomicAdd(&(bar)[XB_TMO], 1u); break; } } } } while (0)

struct XcdBarrier {
    unsigned* bar; unsigned x;
    volatile LAS unsigned* st;
};

__device__ __forceinline__ XcdBarrier xcd_barrier_post(unsigned* bar, volatile LAS unsigned* st) {
    XcdBarrier b; b.bar = bar; b.x = xb_xcc_id(); b.st = st;
    if (threadIdx.x == 0) (void)xb_add(&bar[XB_XCNT(b.x)], 1u);
    return b;
}
__device__ __forceinline__ void xcd_barrier_complete(unsigned* bar, unsigned x, unsigned& nloc, unsigned& nx) {
    const unsigned G = gridDim.x * gridDim.y * gridDim.z;
    unsigned sum, cnt, mine, sp = 0u;
    for (;;) {
        sum = 0u; cnt = 0u; mine = 0u;
#pragma unroll
        for (unsigned j = 0; j < 16; ++j) { const unsigned c = xb_ld(&bar[XB_XCNT(j)]); sum += c; cnt += (c > 0u) ? 1u : 0u; mine = (j == x) ? c : mine; }
        if (sum == G) break;
        __builtin_amdgcn_s_sleep(1);
        if ((++sp & 255u) == 0u) { if (xb_ld(&bar[XB_TMO])) break; if (sp > XB_SPIN_CAP) { atomicAdd(&bar[XB_TMO], 1u); break; } }
    }
    nloc = mine > 0u ? mine : 1u; nx = cnt > 0u ? cnt : 1u;
}

__device__ __forceinline__ void xcd_barrier(const XcdBarrier& b) {
    asm volatile("s_waitcnt vmcnt(0)" ::: "memory");
    __syncthreads();
    if (threadIdx.x == 0) {
        unsigned* bar = b.bar; unsigned bx = b.x;
        asm volatile("" : "+s"(bar), "+s"(bx));
        __builtin_amdgcn_s_waitcnt(0);
        unsigned nloc = b.st[0], nx = b.st[1];
        if (nloc == 0u) { xcd_barrier_complete(bar, bx, nloc, nx); b.st[0] = nloc; b.st[1] = nx; }
        const unsigned old = xb_add(&bar[XB_XSUB(bx)], 1u);
        const unsigned gen = old / nloc;
        if (old + 1u == (gen + 1u) * nloc) {
            __builtin_amdgcn_fence(__ATOMIC_RELEASE, "agent");
            asm volatile("s_waitcnt vmcnt(0)" ::: "memory");
            const unsigned og = xb_add(&bar[XB_TOP], 1u);
            const unsigned tg = og / nx;
            if (og + 1u == (tg + 1u) * nx) xb_add(&bar[XB_TOPGEN], 1u);
            else XB_SPIN(xb_ld(&bar[XB_TOPGEN]) == tg, bar);
            __builtin_amdgcn_fence(__ATOMIC_ACQUIRE, "agent");
            xb_add(&bar[XB_XGEN(bx)], 1u);
            asm volatile("s_waitcnt vmcnt(0)" ::: "memory");
        } else {
            XB_SPIN(xb_ld(&bar[XB_XGEN(bx)]) == gen, bar);
            __builtin_amdgcn_fence(__ATOMIC_ACQUIRE, "agent");
            asm volatile("s_waitcnt vmcnt(0)" ::: "memory");
        }
    }
    __syncthreads();
}
struct Frame {
    LAS unsigned char* lds;
    int tid, lane, wave, vcu, G, gw, NGW;
    unsigned char* ws;
};
__device__ __forceinline__ int opaque_v(int v) { asm volatile("" : "+v"(v)); return v; }
__device__ __forceinline__ int phase_tid(int wave) { int lane; asm volatile("v_mbcnt_lo_u32_b32 %0, -1, 0\n\tv_mbcnt_hi_u32_b32 %0, -1, %0" : "=v"(lane)); return wave * 64 + lane; }
__device__ __forceinline__ Frame phase_frame(const Frame& F0) { Frame F = F0; F.tid = phase_tid(F0.wave); F.lane = F.tid & 63; return F; }
__device__ __forceinline__ float swap32(float v, int lane) { auto rr = __builtin_amdgcn_permlane32_swap(__float_as_uint(v), __float_as_uint(v), false, false); return __uint_as_float(lane < 32 ? rr[1] : rr[0]); }
__device__ __forceinline__ int row_cls(int row) { const int b = row / RB, i = row - b * RB; return i < CTX ? 2 : b; }

__device__ __forceinline__ void p0_transpose_item(const float* W, int K, int N, bf16_t* WT, const float* gain, LAS float* scr, int item, int lane, bool perm_q = false) {
    const int nblk = N / 32, kb = item / nblk, nb = item % nblk, k0 = 64 * kb, n0 = 32 * nb;
    {
        const int rgp = lane >> 3, c4 = (lane & 7) * 4; f32x4 tv[8];
#pragma unroll
        for (int i = 0; i < 8; ++i) tv[i] = *(const f32x4*)(W + (size_t)(k0 + 8 * i + rgp) * N + n0 + c4);
#pragma unroll
        for (int i = 0; i < 8; ++i) { const int kk = 8 * i + rgp; f32x4 v = tv[i]; if (gain) v = v * gain[k0 + kk];
            LAS float* d = scr + kk * 33 + c4; d[0] = v.x; d[1] = v.y; d[2] = v.z; d[3] = v.w; }
    }
    asm volatile("s_waitcnt lgkmcnt(0)" ::: "memory");
    const int c = lane & 7;
#pragma unroll
    for (int j = 0; j < 4; ++j) { const int n = (lane >> 3) + 8 * j; const LAS float* s = scr + (8 * c) * 33 + n;
        u32x4 o; o.x = pk2(s[0 * 33], s[1 * 33]); o.y = pk2(s[2 * 33], s[3 * 33]); o.z = pk2(s[4 * 33], s[5 * 33]); o.w = pk2(s[6 * 33], s[7 * 33]);
        int nn = n0 + n; if (perm_q) { const int hh = nn / 192, e = nn - hh * 192; nn = (e < 128) ? hh * 128 + e : 1024 + hh * 64 + (e - 128); }
        *(u32x4*)(WT + (size_t)nn * K + k0 + 8 * c) = o; }
    asm volatile("s_waitcnt lgkmcnt(0)" ::: "memory");
}
struct TrDesc { const float* W; const float* gain; bf16_t* WT; int K, N, items; };

__device__ __forceinline__ void p0_gemv_task(Frame& F, int task, const float* ada_w, const float* ada_b, float* mod) {
    LAS float* sv = (LAS float*)F.lds; LAS float* part = (LAS float*)(F.lds + 32768);
    const int l = task / 192, n0 = (task % 192) * 64, rg = F.lane >> 4, c4 = (F.lane & 15) * 4;
    const float* Wp = ada_w + (size_t)l * DM * NMOD + n0 + c4 + (size_t)(F.wave * 256 + rg) * NMOD;
    f32x4 a0 = {0, 0, 0, 0}, a1 = a0, a2 = a0;
    for (int k = 0; k < 256; k += 32) {
        f32x4 w[8];
#pragma unroll
        for (int u = 0; u < 8; ++u) w[u] = *(const f32x4*)(Wp + (size_t)(k + 4 * u) * NMOD);
#pragma unroll
        for (int u = 0; u < 8; ++u) { const int kk = F.wave * 256 + k + 4 * u + rg; const float s0 = sv[kk], s1 = sv[2048 + kk], s2 = sv[4096 + kk];
            a0 += w[u] * s0; a1 += w[u] * s1; a2 += w[u] * s2; }
    }
    LAS float* pp = part + ((F.wave * 4 + rg) * 3) * 64 + c4;
    *(LAS f32x4*)(pp) = a0; *(LAS f32x4*)(pp + 64) = a1; *(LAS f32x4*)(pp + 128) = a2;
    __syncthreads();
    if (F.tid < 192) { const int r = F.tid >> 6, c = F.tid & 63; float s = 0.f;
#pragma unroll
        for (int q = 0; q < 32; ++q) s += part[(q * 3 + r) * 64 + c];
        mod[(size_t)(l * 3 + r) * NMOD + n0 + c] = s + ada_b[(size_t)l * NMOD + n0 + c]; }
    __syncthreads();
}

__device__ __forceinline__ void p0_prologue(Frame& F, const float* const* in, const int parts = 15) {
    unsigned char* ws = F.ws;
    if (parts & 1) {
        LAS float* sv = (LAS float*)F.lds;
        for (int i = F.tid; i < 3 * DM; i += NTHREADS) { const int r = i / DM, k = i - r * DM; const float x = (r < 2) ? in[1][r * DM + k] : in[3][k]; sv[i] = x / (1.f + __expf(-x)); }
        __syncthreads();
        for (int task = F.vcu; task < 768; task += F.G) p0_gemv_task(F, task, in[4], in[5], (float*)(ws + WS_MOD));
        __syncthreads();
    }
    if (parts & 2) {
        bf16_t* xw = (bf16_t*)(ws + WS_XW);
        for (int row = F.gw; row < MROWS; row += F.NGW) { const int b = row / RB, i = row - b * RB;
            const float* src = (i < CTX) ? in[2] + (size_t)(b * CTX + i) * DM : in[0] + (size_t)(b * SEQ + i - CTX) * DM;
            const f32x4* s4 = (const f32x4*)src + F.lane; u32x2* d4 = (u32x2*)(xw + (size_t)row * DM) + F.lane;
#pragma unroll
            for (int j = 0; j < 8; ++j) { const f32x4 v = s4[64 * j]; u32x2 o; o.x = pk2(v.x, v.y); o.y = pk2(v.z, v.w); d4[64 * j] = o; } }
    }
    if (parts & 2) {
        float* sm = (float*)(ws + WS_SMALL); const int g = F.vcu * NTHREADS + F.tid;
        if (g < 8192) { sm[SM_N1G + g] = in[6][g]; sm[SM_N2G + g] = in[7][g]; }
        if (g < 384) { sm[SM_AQG + g] = in[13][g]; sm[SM_AKG + g] = in[14][g]; }
        if (g < 6144) sm[SM_CW + g] = in[15][g];
        if (g < 2048) sm[SM_CB + g] = in[16][g];
        if (g < 256) { sm[SM_CQG + g] = in[19][g]; sm[SM_CKG + g] = in[20][g]; }
    }
    if (parts & 2) {
        float* rc = (float*)(ws + WS_ROPE); float* ra = rc + 64 * 32 * 2;
        const int g = F.vcu * NTHREADS + F.tid;
        if (g < 64 * 32) { const int pos = g >> 5, f = g & 31; const float fr = exp2f(-(float)f * (13.287712379549449f / 32.f)); const float ang = (float)pos * fr;
            rc[2 * g] = cosf(ang); rc[2 * g + 1] = sinf(ang); }
        else if (g < 64 * 32 + 64 * 16) { const int e = g - 64 * 32, pos = e >> 4, f = e & 15; const float fr = exp2f(-(float)f * (13.287712379549449f / 16.f)); const float ang = (float)pos * fr;
            ra[2 * e] = cosf(ang); ra[2 * e + 1] = sinf(ang); }
    }
    if (parts & 4) {
        LAS float* scr = (LAS float*)(F.lds + F.wave * 16384);
        TrDesc d[16]; int nd = 0;
#pragma unroll
        for (int i = 0; i < 2; ++i) {
            d[nd++] = TrDesc{in[8] + (size_t)i * DM * 3904, nullptr, (bf16_t*)(ws + WS_WIN) + (size_t)i * 4096 * DM, DM, 3904, 32 * 122};
            d[nd++] = TrDesc{in[11] + (size_t)i * 512 * 1536, in[9] + i * 512, (bf16_t*)(ws + WS_WUQ) + (size_t)i * 1536 * 512, 512, 1536, 8 * 48};
            d[nd++] = TrDesc{in[12] + (size_t)i * 256 * 2048, in[10] + i * 256, (bf16_t*)(ws + WS_WUKV) + (size_t)i * 2048 * 256, 256, 2048, 4 * 64};
            d[nd++] = TrDesc{in[17] + (size_t)i * DM * DM, nullptr, (bf16_t*)(ws + WS_WEO) + (size_t)i * DM * DM, DM, DM, 32 * 64};
            d[nd++] = TrDesc{in[18] + (size_t)i * DM * 3072, nullptr, (bf16_t*)(ws + WS_WQKV) + (size_t)i * 3072 * DM, DM, 3072, 32 * 96};
            d[nd++] = TrDesc{in[21] + (size_t)i * DM * DM, nullptr, (bf16_t*)(ws + WS_WCO) + (size_t)i * DM * DM, DM, DM, 32 * 64};
        }
#pragma unroll
        for (int l = 0; l < 4; ++l) d[nd++] = TrDesc{in[22] + (size_t)l * DM * DM, nullptr, (bf16_t*)(ws + WS_WPQ) + (size_t)l * DM * DM, DM, DM, 32 * 64};
#pragma unroll
        for (int m = 0; m < 16; ++m) {
            for (int it = F.gw; it < d[m].items; it += F.NGW) p0_transpose_item(d[m].W, d[m].K, d[m].N, d[m].WT, d[m].gain, scr, it, F.lane, d[m].K == 512);
        }
        for (int i = F.gw * 64 + F.lane; i < 2 * 192 * DM / 8; i += F.NGW * 64) { const int li = i / (192 * DM / 8), r = i % (192 * DM / 8);
            *(u32x4*)((bf16_t*)(ws + WS_WIN) + (size_t)li * 4096 * DM + (size_t)3904 * DM + (size_t)r * 8) = (u32x4){0u, 0u, 0u, 0u}; }
    }
    if (parts & 2) {
        const size_t n_sk = (size_t)4 * 16 * 128 * 128 / 8;
        const size_t gt = (size_t)F.vcu * NTHREADS + F.tid, GT = (size_t)F.G * NTHREADS;
        for (size_t j = gt; j < n_sk; j += GT) {
            const f32x4 a = *(const f32x4*)(in[23] + j * 8), b = *(const f32x4*)(in[23] + j * 8 + 4);
            u32x4 o; o.x = pk2(a.x, a.y); o.y = pk2(a.z, a.w); o.z = pk2(b.x, b.y); o.w = pk2(b.z, b.w);
            *(u32x4*)((bf16_t*)(ws + WS_SUBK) + j * 8) = o;
        }
    }
#if TAB_FP4 && EXP_SLICED && PEER_MFMA && !defined(P0_NOCOAL)
    if (parts & 8) {
        const int NR = 2 * 4 * NEXP;
        for (int r = F.gw; r < NR; r += F.NGW) {
            const int tab = r >= 4 * NEXP, rr = r - tab * (4 * NEXP);
            const float* src = (tab ? in[25] : in[24]) + (size_t)rr * DM + F.lane * 4;
            f32x4 v[8];
#pragma unroll
            for (int q = 0; q < 8; ++q) v[q] = *(const f32x4*)(src + q * 256);
            float am = 0.f, ssq = 0.f;
#pragma unroll
            for (int q = 0; q < 8; ++q) { am = fmaxf(fmaxf(am, fmaxf(fabsf(v[q].x), fabsf(v[q].y))), fmaxf(fabsf(v[q].z), fabsf(v[q].w))); ssq += (v[q].x * v[q].x + v[q].y * v[q].y) + (v[q].z * v[q].z + v[q].w * v[q].w); }
            am = fmaxf(wave_max_dpp(am), 1e-30f); ssq = wave_sum_dpp(ssq);
            const float sig = fmaxf(sqrtf(ssq * (1.f / DM)), am * (1.f / 64.f)), sc = 2.0f / sig;
            const int ll = rr / NEXP, ee = rr - ll * NEXP;
            unsigned char* dst = ws + (tab ? WS_VT : WS_U) + (size_t)ll * NEXP * ROWB + (size_t)ee * 128 + F.lane * 2;
#define P0_C6(x) fminf(fmaxf((x), -6.f), 6.f)
#pragma unroll
            for (int q = 0; q < 8; ++q) { const f32x4 x = v[q] * sc; unsigned t = 0u;
                t = __builtin_amdgcn_cvt_scalef32_pk_fp4_f32(t, P0_C6(x.x), P0_C6(x.y), 1.0f, 0); t = __builtin_amdgcn_cvt_scalef32_pk_fp4_f32(t, P0_C6(x.z), P0_C6(x.w), 1.0f, 1);
                *(unsigned short*)(dst + (size_t)q * (NEXP * 128)) = (unsigned short)t; }
#undef P0_C6
            if (F.lane == 0) ((float*)(ws + (tab ? WS_VSC : WS_USC)))[rr] = sig * 0.5f;
        }
    }
#elif TAB_FP4 && EXP_SLICED && PEER_MFMA && defined(P0_PIPE)
    {
        const int NR = 2 * 4 * NEXP;
#define P0_LOAD(V, r_) do { const int rc_ = (r_) < NR ? (r_) : NR - 1; const float* s_ = ((rc_ >= 4 * NEXP) ? in[25] + (size_t)(rc_ - 4 * NEXP) * DM : in[24] + (size_t)rc_ * DM) + F.lane * 32; \
        _Pragma("unroll") for (int q = 0; q < 8; ++q) V[q] = *(const f32x4*)(s_ + q * 4); } while (0)
#define P0_C6(x) fminf(fmaxf((x), -6.f), 6.f)
#define P0_ROW(V, VN) do { \
        const int rn = r + F.NGW; P0_LOAD(VN, rn); \
        const int tab = r >= 4 * NEXP, rr = r - tab * (4 * NEXP); \
        float am = 0.f, ssq = 0.f; \
        _Pragma("unroll") for (int q = 0; q < 8; ++q) { am = fmaxf(fmaxf(am, fmaxf(fabsf(V[q].x), fabsf(V[q].y))), fmaxf(fabsf(V[q].z), fabsf(V[q].w))); ssq += (V[q].x * V[q].x + V[q].y * V[q].y) + (V[q].z * V[q].z + V[q].w * V[q].w); } \
        am = fmaxf(wave_max_dpp(am), 1e-30f); ssq = wave_sum_dpp(ssq); \
        const float sig = fmaxf(sqrtf(ssq * (1.f / DM)), am * (1.f / 64.f)), sc = 2.0f / sig; \
        unsigned w4[4]; \
        _Pragma("unroll") for (int q = 0; q < 4; ++q) { unsigned t = 0u; const f32x4 xa = V[2 * q] * sc, xb = V[2 * q + 1] * sc; \
            t = __builtin_amdgcn_cvt_scalef32_pk_fp4_f32(t, P0_C6(xa.x), P0_C6(xa.y), 1.0f, 0); t = __builtin_amdgcn_cvt_scalef32_pk_fp4_f32(t, P0_C6(xa.z), P0_C6(xa.w), 1.0f, 1); \
            t = __builtin_amdgcn_cvt_scalef32_pk_fp4_f32(t, P0_C6(xb.x), P0_C6(xb.y), 1.0f, 2); t = __builtin_amdgcn_cvt_scalef32_pk_fp4_f32(t, P0_C6(xb.z), P0_C6(xb.w), 1.0f, 3); w4[q] = t; } \
        { const int ll = rr / NEXP, ee = rr - ll * NEXP; \
          *(u32x4*)(ws + (tab ? WS_VT : WS_U) + (size_t)ll * NEXP * ROWB + (size_t)(F.lane >> 3) * (NEXP * 128) + (size_t)ee * 128 + (F.lane & 7) * 16) = (u32x4){w4[0], w4[1], w4[2], w4[3]}; } \
        if (F.lane == 0) ((float*)(ws + (tab ? WS_VSC : WS_USC)))[rr] = sig * 0.5f; \
        r = rn; } while (0)
        int r = F.gw; f32x4 va[8], vb[8]; P0_LOAD(va, r);
        while (r < NR) { P0_ROW(va, vb); if (!(r < NR)) break; P0_ROW(vb, va); }
#undef P0_ROW
#undef P0_C6
#undef P0_LOAD
    }
#else
    {
        for (int r = F.gw; r < 2 * 4 * NEXP; r += F.NGW) {
            const int tab = r / (4 * NEXP), rr = r - tab * (4 * NEXP);
#if EXP_SLICED
            const float* src = (tab ? in[25] : in[24]) + (size_t)rr * DM + F.lane * 32;
            f32x4 v[8];
#pragma unroll
            for (int q = 0; q < 8; ++q) v[q] = *(const f32x4*)(src + q * 4);
#else
            const float* src = (tab ? in[25] : in[24]) + (size_t)rr * DM + F.lane * 16;
            f32x4 v[8];
#pragma unroll
            for (int j = 0; j < 2; ++j)
#pragma unroll
                for (int q = 0; q < 4; ++q) v[j * 4 + q] = *(const f32x4*)(src + j * 1024 + q * 4);
#endif
            float am = 0.f;
#pragma unroll
            for (int q = 0; q < 8; ++q) am = fmaxf(fmaxf(am, fmaxf(fabsf(v[q].x), fabsf(v[q].y))), fmaxf(fabsf(v[q].z), fabsf(v[q].w)));
#pragma unroll
            for (int o = 1; o < 64; o <<= 1) am = fmaxf(am, __shfl_xor(am, o));
            am = fmaxf(am, 1e-30f);
#if TAB_FP4
            float ssq = 0.f;
#pragma unroll
            for (int q = 0; q < 8; ++q) ssq += (v[q].x * v[q].x + v[q].y * v[q].y) + (v[q].z * v[q].z + v[q].w * v[q].w);
#pragma unroll
            for (int o = 1; o < 64; o <<= 1) ssq += __shfl_xor(ssq, o);
            const float sig = fmaxf(sqrtf(ssq * (1.f / DM)), am * (1.f / 64.f));
            unsigned w4[4];
#if EXP_SLICED
            if (tab == 0 && !PEER_MFMA) {
                const float delta = 0.3352f * sig, isc = 1.0f / delta;
#pragma unroll
                for (int q = 0; q < 4; ++q) { unsigned t = 0u;
#pragma unroll
                    for (int hh = 0; hh < 2; ++hh) { const f32x4 x = v[2 * q + hh] * isc;
                        const int n0 = min(max((int)floorf(x.x), -8), 7) & 15, n1 = min(max((int)floorf(x.y), -8), 7) & 15, n2 = min(max((int)floorf(x.z), -8), 7) & 15, n3 = min(max((int)floorf(x.w), -8), 7) & 15;
                        t |= ((unsigned)n0 | ((unsigned)n1 << 4) | ((unsigned)n2 << 8) | ((unsigned)n3 << 12)) << (16 * hh); }
                    w4[q] = t; }
                { const int ll = rr / NEXP, ee = rr - ll * NEXP;
                  *(u32x4*)(ws + WS_U + (size_t)ll * NEXP * ROWB + (size_t)(F.lane >> 3) * (NEXP * 128) + (size_t)ee * 128 + (F.lane & 7) * 16) = (u32x4){w4[0], w4[1], w4[2], w4[3]}; }
                if (F.lane == 0) ((float*)(ws + WS_USC))[rr] = delta;
                continue;
            }
#endif
            const float sc = 2.0f / sig;
#pragma unroll
            for (int q = 0; q < 4; ++q) { unsigned t = 0u;
                const f32x4 xa = v[2 * q] * sc, xb = v[2 * q + 1] * sc;
#define P0_C6(x) fminf(fmaxf((x), -6.f), 6.f)
                t = __builtin_amdgcn_cvt_scalef32_pk_fp4_f32(t, P0_C6(xa.x), P0_C6(xa.y), 1.0f, 0);
                t = __builtin_amdgcn_cvt_scalef32_pk_fp4_f32(t, P0_C6(xa.z), P0_C6(xa.w), 1.0f, 1);
                t = __builtin_amdgcn_cvt_scalef32_pk_fp4_f32(t, P0_C6(xb.x), P0_C6(xb.y), 1.0f, 2);
                t = __builtin_amdgcn_cvt_scalef32_pk_fp4_f32(t, P0_C6(xb.z), P0_C6(xb.w), 1.0f, 3);
#undef P0_C6
                w4[q] = t; }
#if EXP_SLICED
            { const int ll = rr / NEXP, ee = rr - ll * NEXP;
              *(u32x4*)(ws + (tab ? WS_VT : WS_U) + (size_t)ll * NEXP * ROWB + (size_t)(F.lane >> 3) * (NEXP * 128) + (size_t)ee * 128 + (F.lane & 7) * 16) = (u32x4){w4[0], w4[1], w4[2], w4[3]}; }
#else
            *(u32x4*)(ws + (tab ? WS_VT : WS_U) + (size_t)rr * ROWB + F.lane * 16) = (u32x4){w4[0], w4[1], w4[2], w4[3]};
#endif
            if (F.lane == 0) ((float*)(ws + (tab ? WS_VSC : WS_USC)))[rr] = sig * 0.5f;
#else
            const float sc = 7.5f / am;
            f32x16 a, b;
#pragma unroll
            for (int q = 0; q < 8; ++q) { const f32x4 x = v[q] * sc; a[2 * q] = x.x; b[2 * q] = x.y; a[2 * q + 1] = x.z; b[2 * q + 1] = x.w; }
            const u32x6 w = __builtin_amdgcn_cvt_scalef32_2xpk16_fp6_f32(a, b, 1.0f);
            unsigned char* dst = ws + (tab ? WS_VT : WS_U) + (size_t)rr * ROWB;
            *(u32x4*)(dst + F.lane * 16) = (u32x4){w[0], w[1], w[2], w[3]};
            *(u32x2*)(dst + 1024 + F.lane * 8) = (u32x2){w[4], w[5]};
            if (F.lane == 0) ((float*)(ws + (tab ? WS_VSC : WS_USC)))[rr] = am * (1.0f / 7.5f);
#endif
        }
    }
#endif
}

template <bool RESID>
__device__ __forceinline__ void ctx_gemm_phase(const Frame& F0, const bf16_t* A, int lda, const bf16_t* Bt, int ldb, int N, int K, bf16_t* O, bf16_t* X, int ldc, const float* gate) {
    const Frame F = phase_frame(F0);
    const int lane = F.lane, li = lane & 15, lq = lane >> 4, wave = F.wave;
    LAS float* red = (LAS float*)F.lds;
    LAS unsigned char* priv = F.lds + wave * 12288;
    const int lr = lane >> 3, lc = lane & 7;
    const int wr_even = lr * 128 + ((lc ^ (lr >> 1)) << 4), wr_odd = lr * 128 + ((lc ^ (4 + (lr >> 1))) << 4);
    const int rd_row = li * 128;
    const int ntask = 8 * (N / 32), k0 = wave * (K / 8);
#define CG_PTRS(t_, XG, WG) do { const int tc_ = (t_) < ntask ? (t_) : ntask - 1; const int rb_ = tc_ & 7, cb_ = tc_ >> 3; const int r0_ = (rb_ < 4) ? rb_ * 64 : RB + (rb_ - 4) * 64; \
        XG = A + (size_t)(r0_ + lr) * lda + k0 + 8 * lc; WG = Bt + (size_t)(cb_ * 32 + lr) * ldb + k0 + 8 * lc; } while (0)
#define CG_LOAD(XQ, WQ, XG, WG, q_) do { _Pragma("unroll") for (int i = 0; i < 8; ++i) XQ[i] = *(const u32x4*)(XG + (size_t)(8 * i) * lda + 64 * (q_)); \
        _Pragma("unroll") for (int i = 0; i < 4; ++i) WQ[i] = *(const u32x4*)(WG + (size_t)(8 * i) * ldb + 64 * (q_)); } while (0)
#define CG_QUARTER(XQ, WQ, XGN, WGN, qn_) do { \
        _Pragma("unroll") for (int i = 0; i < 8; ++i) *(LAS u32x4*)(priv + ((i & 1) ? wr_odd : wr_even) + i * 1024) = XQ[i]; \
        _Pragma("unroll") for (int i = 0; i < 4; ++i) *(LAS u32x4*)(priv + 8192 + ((i & 1) ? wr_odd : wr_even) + i * 1024) = WQ[i]; \
        __builtin_amdgcn_sched_barrier(0); \
        CG_LOAD(XQ, WQ, XGN, WGN, qn_); \
        __builtin_amdgcn_sched_barrier(0); \
        _Pragma("unroll") for (int s = 0; s < 2; ++s) { \
            const int ro = rd_row + (((4 * s + lq) ^ (li >> 1)) << 4); \
            bf16x8 xa[4], wb[2]; \
            _Pragma("unroll") for (int m = 0; m < 4; ++m) xa[m] = *(const LAS bf16x8*)(priv + ro + m * 2048); \
            _Pragma("unroll") for (int n = 0; n < 2; ++n) wb[n] = *(const LAS bf16x8*)(priv + 8192 + ro + n * 2048); \
            _Pragma("unroll") for (int m = 0; m < 4; ++m) _Pragma("unroll") for (int n = 0; n < 2; ++n) acc[m][n] = __builtin_amdgcn_mfma_f32_16x16x32_bf16(wb[n], xa[m], acc[m][n], 0, 0, 0); } \
    } while (0)
    u32x4 xa_[8], wa_[4], xb_[8], wb_[4];
    const bf16_t *xg, *wg, *xgn, *wgn;
    CG_PTRS(F.vcu, xg, wg);
    __builtin_amdgcn_s_waitcnt(0x0f70);
    __builtin_amdgcn_sched_barrier(0); CG_LOAD(xa_, wa_, xg, wg, 0); __builtin_amdgcn_sched_barrier(0); CG_LOAD(xb_, wb_, xg, wg, 1); __builtin_amdgcn_sched_barrier(0);
    for (int task = F.vcu; task < ntask; task += F.G) {
        const int rb = task & 7, cb = task >> 3;
        const int row0 = (rb < 4) ? rb * 64 : RB + (rb - 4) * 64, col0 = cb * 32;
        CG_PTRS(task + F.G, xgn, wgn);
        const int row = row0 + 16 * (wave >> 1) + li, col = col0 + 16 * (wave & 1) + 4 * lq;
        f32x4 xold = {0.f, 0.f, 0.f, 0.f}, gv = xold;
        if (RESID) { const u32x2 w_ = *(const u32x2*)(X + (size_t)row * ldc + col); xold = (f32x4){bf_lo(w_.x), bf_hi(w_.x), bf_lo(w_.y), bf_hi(w_.y)}; gv = *(const f32x4*)(gate + (size_t)2 * 12288 + col); }
        __builtin_amdgcn_sched_barrier(0);
        f32x4 acc[4][2];
#pragma unroll
        for (int m = 0; m < 4; ++m) { acc[m][0] = (f32x4){0.f, 0.f, 0.f, 0.f}; acc[m][1] = acc[m][0]; }
        CG_QUARTER(xa_, wa_, xg, wg, 2);
        CG_QUARTER(xb_, wb_, xg, wg, 3);
        CG_QUARTER(xa_, wa_, xgn, wgn, 0);
        CG_QUARTER(xb_, wb_, xgn, wgn, 1);
        xg = xgn; wg = wgn;
        __syncthreads();
#pragma unroll
        for (int m = 0; m < 4; ++m)
#pragma unroll
            for (int n = 0; n < 2; ++n)
#pragma unroll
                for (int r = 0; r < 4; ++r) red[(wave * 32 + (m * 2 + n) * 4 + r) * 64 + lane] = acc[m][n][r];
        __syncthreads();
        f32x4 sum = {0.f, 0.f, 0.f, 0.f};
#pragma unroll
        for (int w2 = 0; w2 < 8; ++w2)
#pragma unroll
            for (int r = 0; r < 4; ++r) sum[r] += red[(w2 * 32 + wave * 4 + r) * 64 + lane];
        if (RESID) { const f32x4 xn_ = xold + gv * sum; u32x2 o; o.x = pk2(xn_[0], xn_[1]); o.y = pk2(xn_[2], xn_[3]); *(u32x2*)(X + (size_t)row * ldc + col) = o; }
        else { u32x2 o; o.x = pk2(sum[0], sum[1]); o.y = pk2(sum[2], sum[3]); *(u32x2*)(O + (size_t)row * ldc + col) = o; }
        __syncthreads();
    }
#undef CG_QUARTER
#undef CG_LOAD
#undef CG_PTRS
    __syncthreads();
}

__device__ __forceinline__ void norm_phase(const Frame& F0, const bf16_t* xw, const float* g, const float* modl  , int off_sh, int off_sc, bf16_t* H, bool lat_only, unsigned* XQ = nullptr, float* XS = nullptr) {
    const Frame F = phase_frame(F0);
    f32x4 gm[8], shv[8]; int cur_cls = -1;
    int row = F.gw; if (lat_only) while (row < MROWS && row_cls(row) == 2) row += F.NGW;
    f32x4 v[8];
    if (row < MROWS) { const u32x2* x4 = (const u32x2*)(xw + (size_t)row * DM) + F.lane;
#pragma unroll
        for (int j = 0; j < 8; ++j) { const u32x2 w_ = x4[64 * j]; v[j] = (f32x4){bf_lo(w_.x), bf_hi(w_.x), bf_lo(w_.y), bf_hi(w_.y)}; } }
    while (row < MROWS) {
        int nrow = row + F.NGW; if (lat_only) while (nrow < MROWS && row_cls(nrow) == 2) nrow += F.NGW;
        f32x4 vn[8];
        if (nrow < MROWS) { const u32x2* x4 = (const u32x2*)(xw + (size_t)nrow * DM) + F.lane;
#pragma unroll
            for (int j = 0; j < 8; ++j) { const u32x2 w_ = x4[64 * j]; vn[j] = (f32x4){bf_lo(w_.x), bf_hi(w_.x), bf_lo(w_.y), bf_hi(w_.y)}; } }
        const int cls = row_cls(row);
        if (cls != cur_cls) {
            cur_cls = cls;
            const f32x4* g4 = (const f32x4*)g + F.lane; const f32x4* sc4 = (const f32x4*)(modl + (size_t)cls * NMOD + off_sc) + F.lane; const f32x4* sh4 = (const f32x4*)(modl + (size_t)cls * NMOD + off_sh) + F.lane;
#pragma unroll
            for (int j = 0; j < 8; ++j) { gm[j] = g4[64 * j] * (sc4[64 * j] + 1.0f); shv[j] = sh4[64 * j]; }
        }
        float ss = 0.f;
#pragma unroll
        for (int j = 0; j < 8; ++j) ss += (v[j].x * v[j].x + v[j].y * v[j].y) + (v[j].z * v[j].z + v[j].w * v[j].w);
        const float rstd = 1.0f / sqrtf(wave_sum_dpp(ss) * (1.f / DM) + EPS);
        u32x2* o2 = (u32x2*)(H + (size_t)row * DM) + F.lane;
#if PEER_MFMA
        if (XQ) {
            f32x4 yv[8]; float am = 0.f;
#pragma unroll
            for (int j = 0; j < 8; ++j) { const f32x4 y = (v[j] * rstd) * gm[j] + shv[j]; yv[j] = y; u32x2 o; o.x = pk2(y.x, y.y); o.y = pk2(y.z, y.w); o2[64 * j] = o;
                am = fmaxf(fmaxf(am, fmaxf(fabsf(y.x), fabsf(y.y))), fmaxf(fabsf(y.z), fabsf(y.w))); }
            am = fmaxf(am, DPP_MOV(am, 0xB1)); am = fmaxf(am, DPP_MOV(am, 0x4E)); am = fmaxf(am, DPP_MOV(am, 0x141)); am = fmaxf(am, DPP_MOV(am, 0x140));
            { const int ai = __builtin_bit_cast(int, am);
              am = fmaxf(fmaxf(__builtin_bit_cast(float, __builtin_amdgcn_readlane(ai, 0)), __builtin_bit_cast(float, __builtin_amdgcn_readlane(ai, 16))),
                         fmaxf(__builtin_bit_cast(float, __builtin_amdgcn_readlane(ai, 32)), __builtin_bit_cast(float, __builtin_amdgcn_readlane(ai, 48)))); }
            am = fmaxf(am, 1e-20f);
            const float qs = 440.0f / am;
            unsigned* q8 = XQ + (size_t)row * (DM / 4) + F.lane;
#pragma unroll
            for (int j = 0; j < 8; ++j) { const f32x4 y = yv[j] * qs; int pk = 0; pk = __builtin_amdgcn_cvt_pk_fp8_f32(y.x, y.y, pk, false); pk = __builtin_amdgcn_cvt_pk_fp8_f32(y.z, y.w, pk, true); q8[64 * j] = (unsigned)pk; }
            if (F.lane == 0) XS[row] = am * (1.0f / 440.0f);
        } else
#endif
        {
#pragma unroll
        for (int j = 0; j < 8; ++j) { const f32x4 y = (v[j] * rstd) * gm[j] + shv[j]; u32x2 o; o.x = pk2(y.x, y.y); o.y = pk2(y.z, y.w); o2[64 * j] = o;
            if (XQ) {
                float am = fmaxf(fmaxf(fabsf(y.x), fabsf(y.y)), fmaxf(fabsf(y.z), fabsf(y.w)));
                am = fmaxf(am, DPP_MOV(am, 0xB1)); am = fmaxf(am, DPP_MOV(am, 0x4E)); am = fmaxf(am, DPP_MOV(am, 0x141)); am = fmaxf(am, 1e-20f);
                const float qs = 119.0f / am; const float yy[4] = {y.x, y.y, y.z, y.w};
                unsigned pl = 0u, ph = 0u; int sq = 0;
#pragma unroll
                for (int i = 0; i < 4; ++i) { const int qi = __float2int_rn(yy[i] * qs); const int lo = ((qi + 8) & 15) - 8; const int hi = (qi - lo) >> 4; sq += qi; pl |= (unsigned)(lo & 15) << (4 * i); ph |= (unsigned)(hi & 15) << (4 * i); }
                const unsigned pl1 = (unsigned)__builtin_amdgcn_update_dpp(0, (int)pl, 0xB1, 0xf, 0xf, true), ph1 = (unsigned)__builtin_amdgcn_update_dpp(0, (int)ph, 0xB1, 0xf, 0xf, true);
                float sqf = (float)sq; sqf = DPP_ADD(sqf, 0xB1); sqf = DPP_ADD(sqf, 0x4E); sqf = DPP_ADD(sqf, 0x141);
                const int chunk = j * 8 + (F.lane >> 3), l8 = F.lane & 7;
                if ((l8 & 1) == 0) { unsigned* q = XQ + ((size_t)row * 64 + chunk) * 8 + (l8 >> 1); q[0] = ph | (ph1 << 16); q[4] = pl | (pl1 << 16); }
                if (l8 == 0) { float* s = XS + ((size_t)row * 64 + chunk) * 2; s[0] = am * (1.0f / 119.0f); s[1] = 0.5f * sqf; }
            } }
        }
        row = nrow;
#pragma unroll
        for (int j = 0; j < 8; ++j) v[j] = vn[j];
    }
}

__device__ __forceinline__ float row16_sum(float v) { v = DPP_ADD(v, 0xB1); v = DPP_ADD(v, 0x4E); v = DPP_ADD(v, 0x141); v = DPP_ADD(v, 0x140); return v; }
__device__ __forceinline__ void prep_odd_phase(const Frame& F0, const bf16_t* P, const float* qg, const float* kg, const float* rope_c, bf16_t* Q, bf16_t* Kb) {
    const Frame F = phase_frame(F0);
    const int l16 = F.lane & 15, d0 = l16 * 8;
    float gq[8], gk[8];
#pragma unroll
    for (int e = 0; e < 8; ++e) { gq[e] = qg[d0 + e]; gk[e] = kg[d0 + e]; }
    const bool lowhalf = l16 < 8;
    const int j0 = (l16 & 7) * 8;
    int row = F.gw;
    u32x4 w[5];
    if (row < MROWS) { const u32x4* pr = (const u32x4*)(P + (size_t)row * 3072) + F.lane;
#pragma unroll
        for (int k = 0; k < 5; ++k) w[k] = pr[64 * k]; }
    while (row < MROWS) {
        const int nrow = row + F.NGW;
        u32x4 wn[5];
        if (nrow < MROWS) { const u32x4* pr = (const u32x4*)(P + (size_t)nrow * 3072) + F.lane;
#pragma unroll
            for (int k = 0; k < 5; ++k) wn[k] = pr[64 * k]; }
        const int b = row / RB, i = row - b * RB; const bool lat = i >= CTX; const int t = i - CTX;
        float cs[8], sn[8];
#pragma unroll
        for (int e = 0; e < 8; ++e) { cs[e] = 1.f; sn[e] = 0.f; }
        if (lat) { const int pos = (j0 < 32) ? (t >> 6) : (t & 63); const f32x4* tb = (const f32x4*)(rope_c + ((pos << 5) + (j0 & 31)) * 2);
#pragma unroll
            for (int q = 0; q < 4; ++q) { const f32x4 c = tb[q]; cs[2 * q] = c.x; sn[2 * q] = c.y; cs[2 * q + 1] = c.z; sn[2 * q + 1] = c.w; } }
#pragma unroll
        for (int k = 0; k < 5; ++k) {
            const unsigned ww[4] = {w[k].x, w[k].y, w[k].z, w[k].w};
            float x[8]; float ss = 0.f;
#pragma unroll
            for (int q = 0; q < 4; ++q) { x[2 * q] = bf_lo(ww[q]); x[2 * q + 1] = bf_hi(ww[q]); ss += x[2 * q] * x[2 * q] + x[2 * q + 1] * x[2 * q + 1]; }
            const float rstd = 1.0f / sqrtf(row16_sum(ss) * (1.f / 128.f) + EPS);
            unsigned ow[4]; float o[8];
#pragma unroll
            for (int e = 0; e < 8; ++e) { const float y = x[e] * rstd * (k < 4 ? gq[e] : gk[e]); const float yp = DPP_MOV(y, 0x128);
                o[e] = lowhalf ? (y * cs[e] - yp * sn[e]) : (y * cs[e] + yp * sn[e]); }
#pragma unroll
            for (int q = 0; q < 4; ++q) ow[q] = pk2(o[2 * q], o[2 * q + 1]);
            if (k < 4) *((u32x4*)(Q + (size_t)row * 2048) + 64 * k + F.lane) = (u32x4){ow[0], ow[1], ow[2], ow[3]};
            else *((u32x4*)(Kb + (size_t)row * 512) + F.lane) = (u32x4){ow[0], ow[1], ow[2], ow[3]};
        }
        row = nrow;
#pragma unroll
        for (int k = 0; k < 5; ++k) w[k] = wn[k];
    }
}

struct PrepEvenRow { u32x4 cq; u32x2 ckv, kr; u32x4 qn[2]; u32x2 qr[2]; u32x4 kn[2], vv[2]; };
__device__ __forceinline__ void prep_even_load(PrepEvenRow& R, const bf16_t* P, const bf16_t* QR, const bf16_t* KVR, int row, int lane) {
    const bf16_t* pr = P + (size_t)row * 4096; const int l16 = lane & 15, hq = lane >> 4;
    R.cq = *((const u32x4*)pr + lane); R.ckv = *((const u32x2*)(pr + 512) + lane); R.kr = *((const u32x2*)(pr + 768) + l16);
    const bf16_t* q = QR + (size_t)row * 1536; const bf16_t* kv = KVR + (size_t)row * 2048;
#pragma unroll
    for (int k = 0; k < 2; ++k) { R.qn[k] = *((const u32x4*)q + 64 * k + lane); R.qr[k] = *((const u32x2*)(q + 1024) + 64 * k + lane);
        const bf16_t* kh = kv + (4 * k + hq) * 256 + l16 * 8; R.kn[k] = *(const u32x4*)kh; R.vv[k] = *(const u32x4*)(kh + 128); }
}
__device__ __forceinline__ void prep_even_phase(const Frame& F0, const bf16_t* P, const bf16_t* QR, const bf16_t* KVR, const float* qg, const float* kg, const float* rope_a, bf16_t* Q, bf16_t* Kb, bf16_t* Vb) {
    const Frame F = phase_frame(F0);
    const int lane = F.lane, l16 = lane & 15, hq = lane >> 4, d0 = l16 * 8, r0 = l16 * 4;
    float gqn[8], gkn[8], gqr[4], gkr[4];
#pragma unroll
    for (int e = 0; e < 8; ++e) { gqn[e] = qg[d0 + e]; gkn[e] = kg[d0 + e]; }
#pragma unroll
    for (int e = 0; e < 4; ++e) { gqr[e] = qg[128 + r0 + e]; gkr[e] = kg[128 + r0 + e]; }
    const bool lowhalf = l16 < 8; const int j0 = (l16 & 7) * 4;
    int row = F.gw;
    PrepEvenRow R;
    if (row < MROWS) prep_even_load(R, P, QR, KVR, row, lane);
    while (row < MROWS) {
        const int nrow = row + F.NGW;
        PrepEvenRow Rn;
        if (nrow < MROWS) prep_even_load(Rn, P, QR, KVR, nrow, lane);
        const int b = row / RB, i = row - b * RB; const bool lat = i >= CTX; const int t = i - CTX;
        float cs[4], sn[4];
#pragma unroll
        for (int e = 0; e < 4; ++e) { cs[e] = 1.f; sn[e] = 0.f; }
        if (lat) { const int pos = (j0 < 16) ? (t >> 6) : (t & 63); const f32x4* tb = (const f32x4*)(rope_a + ((pos << 4) + (j0 & 15)) * 2);
            const f32x4 c0 = tb[0], c1 = tb[1]; cs[0] = c0.x; sn[0] = c0.y; cs[1] = c0.z; sn[1] = c0.w; cs[2] = c1.x; sn[2] = c1.y; cs[3] = c1.z; sn[3] = c1.w; }
        float ssq = 0.f, sskv = 0.f;
        { const unsigned ww[4] = {R.cq.x, R.cq.y, R.cq.z, R.cq.w};
#pragma unroll
          for (int q = 0; q < 4; ++q) { const float a = bf_lo(ww[q]), c = bf_hi(ww[q]); ssq += a * a + c * c; } }
        { const float a = bf_lo(R.ckv.x), c = bf_hi(R.ckv.x), d = bf_lo(R.ckv.y), e = bf_hi(R.ckv.y); sskv = (a * a + c * c) + (d * d + e * e); }
        const float rstd_q = 1.0f / sqrtf(wave_sum_dpp(ssq) * (1.f / 512.f) + EPS), rstd_kv = 1.0f / sqrtf(wave_sum_dpp(sskv) * (1.f / 256.f) + EPS);
        const float krv[4] = {bf_lo(R.kr.x), bf_hi(R.kr.x), bf_lo(R.kr.y), bf_hi(R.kr.y)};
        const float krss = (krv[0] * krv[0] + krv[1] * krv[1]) + (krv[2] * krv[2] + krv[3] * krv[3]);
#pragma unroll
        for (int k = 0; k < 2; ++k) {
            const int h = 4 * k + hq;
            {
                const unsigned wn[4] = {R.qn[k].x, R.qn[k].y, R.qn[k].z, R.qn[k].w};
                float xn[8], xr[4]; float ss = 0.f;
#pragma unroll
                for (int q = 0; q < 4; ++q) { xn[2 * q] = bf_lo(wn[q]) * rstd_q; xn[2 * q + 1] = bf_hi(wn[q]) * rstd_q; ss += xn[2 * q] * xn[2 * q] + xn[2 * q + 1] * xn[2 * q + 1]; }
                xr[0] = bf_lo(R.qr[k].x) * rstd_q; xr[1] = bf_hi(R.qr[k].x) * rstd_q; xr[2] = bf_lo(R.qr[k].y) * rstd_q; xr[3] = bf_hi(R.qr[k].y) * rstd_q;
                ss += (xr[0] * xr[0] + xr[1] * xr[1]) + (xr[2] * xr[2] + xr[3] * xr[3]);
                const float r2 = 1.0f / sqrtf(row16_sum(ss) * (1.f / 192.f) + EPS);
                unsigned on[4]; float o[4];
#pragma unroll
                for (int q = 0; q < 4; ++q) on[q] = pk2(xn[2 * q] * r2 * gqn[2 * q], xn[2 * q + 1] * r2 * gqn[2 * q + 1]);
#pragma unroll
                for (int e = 0; e < 4; ++e) { const float y = xr[e] * r2 * gqr[e]; const float yp = DPP_MOV(y, 0x128); o[e] = lowhalf ? (y * cs[e] - yp * sn[e]) : (y * cs[e] + yp * sn[e]); }
                bf16_t* qo = Q + (size_t)row * 1536 + h * 192;
                *(u32x4*)(qo + d0) = (u32x4){on[0], on[1], on[2], on[3]};
                *(u32x2*)(qo + 128 + r0) = (u32x2){pk2(o[0], o[1]), pk2(o[2], o[3])};
            }
            {
                const unsigned wn[4] = {R.kn[k].x, R.kn[k].y, R.kn[k].z, R.kn[k].w}, wv[4] = {R.vv[k].x, R.vv[k].y, R.vv[k].z, R.vv[k].w};
                float xn[8]; float ss = krss;
#pragma unroll
                for (int q = 0; q < 4; ++q) { xn[2 * q] = bf_lo(wn[q]) * rstd_kv; xn[2 * q + 1] = bf_hi(wn[q]) * rstd_kv; ss += xn[2 * q] * xn[2 * q] + xn[2 * q + 1] * xn[2 * q + 1]; }
                const float r2 = 1.0f / sqrtf(row16_sum(ss) * (1.f / 192.f) + EPS);
                unsigned on[4], ov[4]; float o[4];
#pragma unroll
                for (int q = 0; q < 4; ++q) { on[q] = pk2(xn[2 * q] * r2 * gkn[2 * q], xn[2 * q + 1] * r2 * gkn[2 * q + 1]); ov[q] = pk2(bf_lo(wv[q]) * rstd_kv, bf_hi(wv[q]) * rstd_kv); }
#pragma unroll
                for (int e = 0; e < 4; ++e) { const float y = krv[e] * r2 * gkr[e]; const float yp = DPP_MOV(y, 0x128); o[e] = lowhalf ? (y * cs[e] - yp * sn[e]) : (y * cs[e] + yp * sn[e]); }
                bf16_t* ko = Kb + (size_t)row * 1536 + h * 192;
                *(u32x4*)(ko + d0) = (u32x4){on[0], on[1], on[2], on[3]};
                *(u32x2*)(ko + 128 + r0) = (u32x2){pk2(o[0], o[1]), pk2(o[2], o[3])};
                *(u32x4*)(Vb + (size_t)row * 1024 + h * 128 + d0) = (u32x4){ov[0], ov[1], ov[2], ov[3]};
            }
        }
        row = nrow; R = Rn;
    }
}

__device__ __forceinline__ void conv_phase(const Frame& F0, const bf16_t* P, const float* cw  , const float* cb  , bf16_t* CAT) {
    const Frame F = phase_frame(F0);
    const int gt = F.vcu * NTHREADS + F.tid, GT = F.G * NTHREADS;
    for (int it = gt; it < MROWS * 128; it += GT) {
        const int row = it >> 7, c0 = (it & 127) * 8; const int b = row / RB, i = row - b * RB;
        const bool first = (i == 0) || (i == CTX), last = (i == CTX - 1) || (i == RB - 1);
        const bf16_t* pr = P + (size_t)row * 4096 + 832 + c0;
        const u32x4 bg = *(const u32x4*)pr, cg = *(const u32x4*)(pr + 1024), hz = *(const u32x4*)(pr + 2048);
        u32x4 cgm = {0u, 0u, 0u, 0u}, hzm = cgm, cgp = cgm, hzp = cgm;
        if (!first) { cgm = *(const u32x4*)(pr - 4096 + 1024); hzm = *(const u32x4*)(pr - 4096 + 2048); }
        if (!last) { cgp = *(const u32x4*)(pr + 4096 + 1024); hzp = *(const u32x4*)(pr + 4096 + 2048); }
        const unsigned bgw[4] = {bg.x, bg.y, bg.z, bg.w}, cgw[4] = {cg.x, cg.y, cg.z, cg.w}, hzw[4] = {hz.x, hz.y, hz.z, hz.w};
        const unsigned cmw[4] = {cgm.x, cgm.y, cgm.z, cgm.w}, hmw[4] = {hzm.x, hzm.y, hzm.z, hzm.w}, cpw[4] = {cgp.x, cgp.y, cgp.z, cgp.w}, hpw[4] = {hzp.x, hzp.y, hzp.z, hzp.w};
        unsigned ow[4];
#pragma unroll
        for (int q = 0; q < 4; ++q) {
            const int c = c0 + 2 * q;
            const float u0a = bf_lo(cgw[q]) * bf_lo(hzw[q]), u0b = bf_hi(cgw[q]) * bf_hi(hzw[q]);
            const float uma = bf_lo(cmw[q]) * bf_lo(hmw[q]), umb = bf_hi(cmw[q]) * bf_hi(hmw[q]);
            const float upa = bf_lo(cpw[q]) * bf_lo(hpw[q]), upb = bf_hi(cpw[q]) * bf_hi(hpw[q]);
            const float ra = bf_lo(bgw[q]) * (uma * cw[c] + u0a * cw[1024 + c] + upa * cw[2048 + c] + cb[c]);
            const float rb = bf_hi(bgw[q]) * (umb * cw[c + 1] + u0b * cw[1024 + c + 1] + upb * cw[2048 + c + 1] + cb[c + 1]);
            ow[q] = pk2(ra, rb);
        }
        *(u32x4*)(CAT + (size_t)row * DM + 1024 + c0) = (u32x4){ow[0], ow[1], ow[2], ow[3]};
    }
}
__device__ __forceinline__ void attn_even_phase(const Frame& F0, const bf16_t* Q, const bf16_t* Kb, const bf16_t* Vb, bf16_t* CAT) {
    const Frame F = phase_frame(F0);
    for (int u = F.vcu; u < 272; u += F.G) {
        int b, h, qt, nk;
        if (u < 256) { b = u >> 7; h = (u >> 4) & 7; qt = 1 + (u & 15); nk = RB; } else { const int v = u - 256; b = v >> 3; h = v & 7; qt = 0; nk = CTX; }
        const size_t r0 = (size_t)b * RB;
        att::attn_body2g<192, 1536, 1536, 1024, 2048>(Q + (r0 + qt * 256) * 1536 + h * 192, Kb + r0 * 1536 + h * 192, Vb + r0 * 1024 + h * 128, CAT + (r0 + qt * 256) * 2048 + h * 128, nk, (char*)F.lds, phase_tid(F.wave));
    }
}
__device__ __forceinline__ void attn_odd_phase(const Frame& F0, const bf16_t* Q, const bf16_t* Kb, const bf16_t* P, bf16_t* CAT, bool lat_only) {
    const Frame F = phase_frame(F0);
    const int nunits = lat_only ? 512 : 544;
    for (int u = F.vcu; u < nunits; u += F.G) {
        int b, hq, qt, nk;
        if (u < 512) { b = u >> 8; hq = (u >> 4) & 15; qt = 1 + (u & 15); nk = RB; } else { const int v = u - 512; b = v >> 4; hq = v & 15; qt = 0; nk = CTX; }
        const int kvh = hq >> 2; const size_t r0 = (size_t)b * RB;
        att::attn_body<128, 2048, 512, 3072, 2048, 2>(Q + (r0 + qt * 256) * 2048 + hq * 128, Kb + r0 * 512 + kvh * 128, P + r0 * 3072 + 2560 + kvh * 128, CAT + (r0 + qt * 256) * 2048 + hq * 128, nk, (char*)F.lds, phase_tid(F.wave));
    }
}

__device__ __forceinline__ int crow32(int r, int hi) { return (r & 3) + 8 * (r >> 2) + 4 * hi; }
__device__ __forceinline__ int fkey(int b) { return b ^ ((b >> 31) & 0x7fffffff); }
#define TK_CE(x, y) do { const int hi_ = max((x), (y)), lo_ = min((x), (y)); (x) = hi_; (y) = lo_; } while (0)
template <int N> __device__ __forceinline__ void tk_sort(int* v) {
#pragma unroll
    for (int k = 2; k <= N; k <<= 1)
#pragma unroll
        for (int j = k >> 1; j > 0; j >>= 1)
#pragma unroll
            for (int i = 0; i < N; ++i) { const int l = i ^ j; if (l > i) { if ((i & k) == 0) TK_CE(v[i], v[l]); else TK_CE(v[l], v[i]); } }
}
__device__ __forceinline__ void tk_merge16(int* a, const int* b) {
#pragma unroll
    for (int i = 0; i < 16; ++i) a[i] = max(a[i], b[15 - i]);
#pragma unroll
    for (int j = 8; j > 0; j >>= 1)
#pragma unroll
        for (int i = 0; i < 16; ++i) { const int l = i ^ j; if (l > i) TK_CE(a[i], a[l]); }
}
__device__ __forceinline__ void tk_merge_partner(int* a) {
    int lo[16], hi[16];
#pragma unroll
    for (int i = 0; i < 16; ++i) { auto rr = __builtin_amdgcn_permlane32_swap((unsigned)a[i], (unsigned)a[i], false, false); lo[i] = (int)rr[0]; hi[i] = (int)rr[1]; }
    tk_merge16(lo, hi);
#pragma unroll
    for (int i = 0; i < 16; ++i) a[i] = lo[i];
}
__device__ __forceinline__ void peer_topk_phase(const Frame& F0, const bf16_t* PQ, const bf16_t* subk  , int* IDX, float* GATE, bool lat_only) {
    const Frame F = phase_frame(F0);
    const int h = F.vcu & 7, jw = (F.vcu >> 3) * NWAVES + F.wave, nwh = (F.G >> 3) * NWAVES;
    {
        const bf16_t* src = subk + (size_t)h * 2 * 128 * 128;
        for (int c = F.tid; c < 4096; c += NTHREADS) { const int row = c >> 4, ch = c & 15;
            *(LAS u32x4*)(F.lds + row * 256 + ((ch ^ (row & 15)) << 4)) = *(const u32x4*)(src + (size_t)row * 128 + ch * 8); }
        __syncthreads();
    }
    const int ntg = lat_only ? 256 : MROWS / 32;
    const bool spread = (nwh == 256) && !lat_only;
    for (int kr = 0; ; ++kr) {
        int t;
        if (!spread) { t = jw + kr * nwh; if (t >= ntg) break; }
        else { if (kr == 0) t = jw; else if (kr == 1 && F.wave == 0 && (F.vcu >> 3) < ntg - 256) t = 256 + (F.vcu >> 3); else break; }
        int lane_ = F.lane; asm volatile("" : "+v"(lane_));
        const int r32 = lane_ & 31, hi = lane_ >> 5;
        int tg = t; if (lat_only) tg += 8 + (tg >= 128 ? 8 : 0);
        const int token = tg * 32 + r32;
        int top[2][16];
        const int kk = (((r32 & 14) | (hi ^ (r32 & 1))) << 4);
#pragma unroll
        for (int p = 0; p < 2; ++p) {
            bf16x8 bq[8];
            const bf16_t* qp = PQ + (size_t)token * DM + h * 256 + p * 128 + hi * 8;
#pragma unroll
            for (int ks = 0; ks < 8; ++ks) bq[ks] = *(const bf16x8*)(qp + ks * 16);
            int s[4][16];
#pragma unroll
            for (int nb = 0; nb < 4; ++nb) {
                f32x16 acc = {};
                const LAS unsigned char* kp = F.lds + (p * 128 + nb * 32 + r32) * 256;
#pragma unroll
                for (int ks = 0; ks < 8; ++ks) { const bf16x8 a = *(const LAS bf16x8*)(kp + (kk ^ (ks << 5))); acc = __builtin_amdgcn_mfma_f32_32x32x16_bf16(a, bq[ks], acc, 0, 0, 0); }
#pragma unroll
                for (int r = 0; r < 16; ++r) { const int key = nb * 32 + crow32(r, hi); s[nb][r] = fkey((int)((__float_as_uint(acc[r]) & ~127u) | (unsigned)(127 - key))); }
                tk_sort<16>(s[nb]);
            }
            tk_merge16(s[0], s[1]); tk_merge16(s[2], s[3]); tk_merge16(s[0], s[2]);
            tk_merge_partner(s[0]);
#pragma unroll
            for (int j = 0; j < 16; ++j) top[p][j] = s[0][j];
        }
        int cand[32];
        unsigned long long kaLo = 0ull, kaHi = 0ull, kbLo = 0ull, kbHi = 0ull;
        {
            float fb[16]; const float fa0 = __uint_as_float((unsigned)fkey(top[0][0]) & ~127u), fb0 = __uint_as_float((unsigned)fkey(top[1][0]) & ~127u);
#pragma unroll
            for (int r = 0; r < 16; ++r) { const int ba = fkey(top[0][r]), bb = fkey(top[1][r]); fb[r] = __uint_as_float((unsigned)bb & ~127u) - fb0;
                const unsigned long long xa = (unsigned long long)(unsigned)(127 - (ba & 127)) << (8 * (r & 7)), xb = (unsigned long long)(unsigned)(127 - (bb & 127)) << (8 * (r & 7));
                if (r < 8) { kaLo |= xa; kbLo |= xb; } else { kaHi |= xa; kbHi |= xb; } }
            float fa[8];
#pragma unroll
            for (int i = 0; i < 8; ++i) { const int ka = hi ? top[0][2 * i + 1] : top[0][2 * i]; fa[i] = __uint_as_float((unsigned)fkey(ka) & ~127u) - fa0; }
            const int hid = 255 - (hi << 4);
            int n = 0;
#pragma unroll
            for (int i = 0; i < 8; ++i)
#pragma unroll
                for (int b = 0; b < 16; ++b) if ((2 * i + 1) * (b + 1) <= 16) {
                    const float sum = fa[i] + fb[b];
                    cand[n++] = fkey((int)((__float_as_uint(sum) & ~255u) | (unsigned)(hid - (32 * i + b))));
                }
#pragma unroll
            for (; n < 32; ++n) cand[n] = (int)0x80000000;
        }
        tk_sort<16>(cand); tk_sort<16>(cand + 16); tk_merge16(cand, cand + 16);
        tk_merge_partner(cand);
        float ev[16]; float esum = 0.f;
#pragma unroll
        for (int j = 0; j < 16; ++j) { ev[j] = __expf(__uint_as_float((unsigned)fkey(cand[j]) & ~255u)); esum += ev[j]; }
        const float rs = 1.0f / esum;
        int oi[8]; float og[8];
#pragma unroll
        for (int j = 0; j < 8; ++j) { const int w = hi ? cand[8 + j] : cand[j]; const float e = hi ? ev[8 + j] : ev[j];
            const int id8 = 255 - (fkey(w) & 255), ra = id8 >> 4, rb = id8 & 15;
            const unsigned long long wa = (ra & 8) ? kaHi : kaLo, wb = (rb & 8) ? kbHi : kbLo;
            const int ka = (int)(wa >> (8 * (ra & 7))) & 127, kb = (int)(wb >> (8 * (rb & 7))) & 127;
            oi[j] = ka * 128 + kb; og[j] = e * rs; }
        int* ip = IDX + (size_t)token * 128 + h * 16 + hi * 8; float* gp = GATE + (size_t)token * 128 + h * 16 + hi * 8;
        *(int4*)ip = make_int4(oi[0], oi[1], oi[2], oi[3]); *(int4*)(ip + 4) = make_int4(oi[4], oi[5], oi[6], oi[7]);
        *(f32x4*)gp = (f32x4){og[0], og[1], og[2], og[3]}; *(f32x4*)(gp + 4) = (f32x4){og[4], og[5], og[6], og[7]};
    }
}

#if TAB_FP4
__device__ __forceinline__ void peer_expert_phase(const Frame& F0, const bf16_t* H2, const int* IDX, const float* GATE, const unsigned char* U, size_t v_minus_u_bytes, const float* USC, const float* VSC,
                                                  const float* g2  , float* XW, float* OUT,
                                                  bf16_t* HN  , const float* ng  , const float* nmod  ) {
    const Frame F = phase_frame(F0);
    LAS float* red = (LAS float*)F.lds;
    const unsigned voff_tab = (unsigned)v_minus_u_bytes;
    const __amdgpu_buffer_rsrc_t rs = __builtin_amdgcn_make_buffer_rsrc((void*)U, 0, (int)(voff_tab + (unsigned)NEXP * ROWB), 0x00020000);
    const int lane = F.lane; const int voff = lane * 16;
#define PX_SB() __builtin_amdgcn_sched_barrier(0)
#define PX_LOADALL(buf, ivv, tb) do { _Pragma("unroll") for (int e_ = 0; e_ < 16; ++e_) buf[e_] = __builtin_amdgcn_raw_buffer_load_b128(rs, voff, (unsigned)__builtin_amdgcn_readlane(ivv, e_) * (unsigned)ROWB + (tb), 0); } while (0)
#define PX_U1(d_, b_) { const bf16x2_t r2_ = __builtin_amdgcn_cvt_scalef32_pk_bf16_fp4(wd_[d_], 1.0f, b_); if ((b_) & 1) a1_ = __builtin_amdgcn_fdot2_f32_bf16(r2_, __builtin_bit_cast(bf16x2_t, xpk[4 * (d_) + (b_)]), a1_, false); \
                        else a0_ = __builtin_amdgcn_fdot2_f32_bf16(r2_, __builtin_bit_cast(bf16x2_t, xpk[4 * (d_) + (b_)]), a0_, false); }
#define PX_V1(d_, b_) { const f32x2 t2_ = __builtin_amdgcn_cvt_scalef32_pk_f32_fp4(wd_[d_], 1.0f, b_); acc[8 * (d_) + 2 * (b_)] += wg_ * t2_.x; acc[8 * (d_) + 2 * (b_) + 1] += wg_ * t2_.y; }
#define PX_FETCH_TOKEN(r, XP, IV, GV) do { const u32x4* xp_ = (const u32x4*)(H2 + (size_t)(r) * DM + lane * 16); XP[0] = xp_[0]; XP[1] = xp_[1]; XP[2] = xp_[128]; XP[3] = xp_[129]; \
        IV = 0; GV = 0.f; if (lane < 16) { IV = IDX[(size_t)(r) * 128 + F.wave * 16 + lane]; GV = GATE[(size_t)(r) * 128 + F.wave * 16 + lane]; } } while (0)
    const bool skip_ctx = (OUT != nullptr);
    int row = F.vcu; if (skip_ctx && row < MROWS && row_cls(row) == 2) row += F.G;
    u32x4 xp[4]; int iv; float gv;
    u32x4 ub[16], vb[16];
    if (row < MROWS) { PX_FETCH_TOKEN(row, xp, iv, gv); PX_LOADALL(ub, iv, 0u); PX_LOADALL(vb, iv, voff_tab); }
    int par = 0;
    while (row < MROWS) {
        int nrow = row + F.G; if (skip_ctx && nrow < MROWS && row_cls(nrow) == 2) nrow += F.G;
        float usc = 0.f, vsc = 0.f;
        if (lane < 16) { usc = USC[iv]; vsc = VSC[iv]; }
        u32x4 xpn[4]; int ivn = 0; float gvn = 0.f;
        if (nrow < MROWS) PX_FETCH_TOKEN(nrow, xpn, ivn, gvn);
        const int cls = row_cls(row);
        const f32x4 x_old = *((const f32x4*)(XW + (size_t)row * DM) + F.tid), g_vec = *((const f32x4*)(g2 + (size_t)cls * NMOD) + F.tid);
        f32x4 n_g = {0.f, 0.f, 0.f, 0.f}, n_sc = n_g, n_sh = n_g;
        if (HN) { n_g = *((const f32x4*)ng + F.tid); n_sc = *((const f32x4*)(nmod + (size_t)cls * NMOD + 2048) + F.tid); n_sh = *((const f32x4*)(nmod + (size_t)cls * NMOD) + F.tid); }
        const unsigned xpk[16] = {xp[0].x, xp[0].y, xp[0].z, xp[0].w, xp[1].x, xp[1].y, xp[1].z, xp[1].w, xp[2].x, xp[2].y, xp[2].z, xp[2].w, xp[3].x, xp[3].y, xp[3].z, xp[3].w};
        float sv = 0.f;
        PX_SB();
#pragma unroll
        for (int e = 0; e < 16; ++e) {
            u32x4 w_ = ub[e]; asm volatile("" : "+v"(w_) : "v"(sv));
            const unsigned wd_[4] = {w_.x, w_.y, w_.z, w_.w}; float a0_ = 0.f, a1_ = 0.f;
            PX_U1(0, 0) PX_U1(0, 1) PX_U1(0, 2) PX_U1(0, 3) PX_U1(1, 0) PX_U1(1, 1) PX_U1(1, 2) PX_U1(1, 3) PX_U1(2, 0) PX_U1(2, 1) PX_U1(2, 2) PX_U1(2, 3) PX_U1(3, 0) PX_U1(3, 1) PX_U1(3, 2) PX_U1(3, 3)
            const float t_ = wave_sum_dpp(a0_ + a1_); sv = (lane == e) ? t_ : sv;
        }
        const float wv = gelu_erf(sv * usc) * gv * vsc;
        PX_SB();
        if (nrow < MROWS) PX_LOADALL(ub, ivn, 0u);
        PX_SB();
        f32x32 acc = {};
#pragma unroll
        for (int e = 0; e < 16; ++e) {
            u32x4 w_ = vb[e]; asm volatile("" : "+v"(w_) : "v"(acc));
            const unsigned wd_[4] = {w_.x, w_.y, w_.z, w_.w}; const float wg_ = __uint_as_float(__builtin_amdgcn_readlane(__float_as_uint(wv), e));
            PX_V1(0, 0) PX_V1(0, 1) PX_V1(0, 2) PX_V1(0, 3) PX_V1(1, 0) PX_V1(1, 1) PX_V1(1, 2) PX_V1(1, 3) PX_V1(2, 0) PX_V1(2, 1) PX_V1(2, 2) PX_V1(2, 3) PX_V1(3, 0) PX_V1(3, 1) PX_V1(3, 2) PX_V1(3, 3)
        }
        PX_SB();
        if (nrow < MROWS) PX_LOADALL(vb, ivn, voff_tab);
        PX_SB();
        LAS float* rb = red + par * (NWAVES * DM);
#pragma unroll
        for (int j = 0; j < 2; ++j)
#pragma unroll
            for (int q = 0; q < 4; ++q) *(LAS f32x4*)(rb + F.wave * DM + j * 1024 + lane * 16 + q * 4) = (f32x4){acc[j * 16 + q * 4], acc[j * 16 + q * 4 + 1], acc[j * 16 + q * 4 + 2], acc[j * 16 + q * 4 + 3]};
        __syncthreads();
        {
            f32x4 sm = {0.f, 0.f, 0.f, 0.f};
#pragma unroll
            for (int w = 0; w < 8; ++w) sm += *(const LAS f32x4*)(rb + w * DM + F.tid * 4);
            f32x4* xq = (f32x4*)(XW + (size_t)row * DM) + F.tid;
            const f32x4 xn = x_old + g_vec * sm;
            *xq = xn;
            if (OUT) { const int b = row / RB, i = row - b * RB; if (i >= CTX) *((f32x4*)(OUT + ((size_t)b * SEQ + (i - CTX)) * DM) + F.tid) = xn; }
            if (HN) {
                LAS float* ssp = (LAS float*)(F.lds + 131072) + par * 8;
                const float sw = wave_sum_dpp((xn.x * xn.x + xn.y * xn.y) + (xn.z * xn.z + xn.w * xn.w));
                if (lane == 0) ssp[F.wave] = sw;
                __syncthreads();
                const float tot = ((ssp[0] + ssp[1]) + (ssp[2] + ssp[3])) + ((ssp[4] + ssp[5]) + (ssp[6] + ssp[7]));
                const float rstd = 1.0f / sqrtf(tot * (1.f / DM) + EPS);
                const f32x4 y = (xn * rstd) * n_g * (n_sc + 1.0f) + n_sh;
                u32x2 o; o.x = pk2(y.x, y.y); o.y = pk2(y.z, y.w);
                *((u32x2*)(HN + (size_t)row * DM) + F.tid) = o;
            }
        }
        par ^= 1; row = nrow;
#pragma unroll
        for (int q = 0; q < 4; ++q) xp[q] = xpn[q];
        iv = ivn; gv = gvn;
    }
#undef PX_LOADALL
#undef PX_U1
#undef PX_V1
#undef PX_SB
#undef PX_FETCH_TOKEN
}
#else
__device__ __forceinline__ void peer_expert_phase(const Frame& F0, const bf16_t* H2, const int* IDX, const float* GATE, const unsigned char* U, size_t v_minus_u_bytes, const float* USC, const float* VSC,
                                                  const float* g2  , float* XW, float* OUT,
                                                  bf16_t* HN  , const float* ng  , const float* nmod  ) {
    const Frame F = phase_frame(F0);
    LAS float* red = (LAS float*)F.lds;
    const unsigned voff_tab = (unsigned)v_minus_u_bytes;
    const __amdgpu_buffer_rsrc_t rs = __builtin_amdgcn_make_buffer_rsrc((void*)U, 0, (int)(voff_tab + (unsigned)NEXP * ROWB), 0x00020000);
    const int lane = F.lane; const int voff = lane * 16, voff2 = 1024 + lane * 8;
#define PX_SB() __builtin_amdgcn_sched_barrier(0)
#define PX_LOAD(buf, s, ivv) do { constexpr int e0_ = ((s) & 3) * 4; const unsigned tb_ = ((s) >= 4) ? voff_tab : 0u; \
        _Pragma("unroll") for (int ee_ = 0; ee_ < 4; ++ee_) { const unsigned o_ = (unsigned)__builtin_amdgcn_readlane(ivv, e0_ + ee_) * (unsigned)ROWB + tb_; \
            buf##h[ee_] = __builtin_amdgcn_raw_buffer_load_b128(rs, voff, o_, 0); buf##l[ee_] = __builtin_amdgcn_raw_buffer_load_b64(rs, voff2, o_, 0); } } while (0)
#define PX_DECODE(buf, ee_, dep) u32x6 w6_ = {buf##h[ee_].x, buf##h[ee_].y, buf##h[ee_].z, buf##h[ee_].w, buf##l[ee_].x, buf##l[ee_].y}; \
        asm volatile("" : "+v"(w6_) : "v"(dep));     \
        const f32x32 r_ = __builtin_amdgcn_cvt_scalef32_pk32_f32_fp6(w6_, 1.0f);
#define PX_COMP_U(buf, s) do { constexpr int e0_ = ((s) & 3) * 4; \
            _Pragma("unroll") for (int ee_ = 0; ee_ < 4; ++ee_) { PX_DECODE(buf, ee_, sv) \
                const f32x32 p_ = r_ * xf; float a0_ = 0.f, a1_ = 0.f; \
                _Pragma("unroll") for (int k_ = 0; k_ < 32; k_ += 2) { a0_ += p_[k_]; a1_ += p_[k_ + 1]; } \
                const float t_ = wave_sum_dpp(a0_ + a1_); sv = (lane == e0_ + ee_) ? t_ : sv; } } while (0)
#define PX_COMP_V(buf, s) do { constexpr int e0_ = ((s) & 3) * 4; \
            _Pragma("unroll") for (int ee_ = 0; ee_ < 4; ++ee_) { const float wg_ = __uint_as_float(__builtin_amdgcn_readlane(__float_as_uint(wv), e0_ + ee_)); \
                PX_DECODE(buf, ee_, acc) \
                acc += r_ * wg_; } } while (0)
#define PX_FETCH_TOKEN(r, XP, IV, GV) do { const u32x4* xp_ = (const u32x4*)(H2 + (size_t)(r) * DM + lane * 16); XP[0] = xp_[0]; XP[1] = xp_[1]; XP[2] = xp_[128]; XP[3] = xp_[129]; \
        IV = 0; GV = 0.f; if (lane < 16) { IV = IDX[(size_t)(r) * 128 + F.wave * 16 + lane]; GV = GATE[(size_t)(r) * 128 + F.wave * 16 + lane]; } } while (0)
    const bool skip_ctx = (OUT != nullptr);
    int row = F.vcu; if (skip_ctx && row < MROWS && row_cls(row) == 2) row += F.G;
    u32x4 xp[4]; int iv; float gv;
    u32x4 bAh[4], bBh[4]; u32x2 bAl[4], bBl[4];
    if (row < MROWS) { PX_FETCH_TOKEN(row, xp, iv, gv); PX_LOAD(bA, 0, iv); }
    int par = 0;
    while (row < MROWS) {
        int nrow = row + F.G; if (skip_ctx && nrow < MROWS && row_cls(nrow) == 2) nrow += F.G;
        f32x32 xf;
#pragma unroll
        for (int q = 0; q < 4; ++q) { const unsigned ww[4] = {xp[q].x, xp[q].y, xp[q].z, xp[q].w};
#pragma unroll
            for (int k = 0; k < 4; ++k) { xf[q * 8 + 2 * k] = bf_lo(ww[k]); xf[q * 8 + 2 * k + 1] = bf_hi(ww[k]); } }
        float usc = 0.f, vsc = 0.f;
        if (lane < 16) { usc = USC[iv]; vsc = VSC[iv]; }
        u32x4 xpn[4]; int ivn = 0; float gvn = 0.f;
        if (nrow < MROWS) PX_FETCH_TOKEN(nrow, xpn, ivn, gvn);
        const int cls = row_cls(row);
        const f32x4 x_old = *((const f32x4*)(XW + (size_t)row * DM) + F.tid), g_vec = *((const f32x4*)(g2 + (size_t)cls * NMOD) + F.tid);
        f32x4 n_g = {0.f, 0.f, 0.f, 0.f}, n_sc = n_g, n_sh = n_g;
        if (HN) { n_g = *((const f32x4*)ng + F.tid); n_sc = *((const f32x4*)(nmod + (size_t)cls * NMOD + 2048) + F.tid); n_sh = *((const f32x4*)(nmod + (size_t)cls * NMOD) + F.tid); }
        float sv = 0.f, wv = 0.f;
        PX_LOAD(bB, 1, iv); PX_SB(); PX_COMP_U(bA, 0); PX_SB();
        PX_LOAD(bA, 2, iv); PX_SB(); PX_COMP_U(bB, 1); PX_SB();
        PX_LOAD(bB, 3, iv); PX_SB(); PX_COMP_U(bA, 2); PX_SB();
        PX_LOAD(bA, 4, iv); PX_SB(); PX_COMP_U(bB, 3); PX_SB();
        wv = gelu_erf(sv * usc) * gv * vsc;
        f32x32 acc = {};
        PX_LOAD(bB, 5, iv); PX_SB(); PX_COMP_V(bA, 4); PX_SB();
        PX_LOAD(bA, 6, iv); PX_SB(); PX_COMP_V(bB, 5); PX_SB();
        PX_LOAD(bB, 7, iv); PX_SB(); PX_COMP_V(bA, 6); PX_SB();
        if (nrow < MROWS) PX_LOAD(bA, 0, ivn);
        PX_SB(); PX_COMP_V(bB, 7); PX_SB();
        LAS float* rb = red + par * (NWAVES * DM);
#pragma unroll
        for (int j = 0; j < 2; ++j)
#pragma unroll
            for (int q = 0; q < 4; ++q) *(LAS f32x4*)(rb + F.wave * DM + j * 1024 + lane * 16 + q * 4) = (f32x4){acc[j * 16 + q * 4], acc[j * 16 + q * 4 + 1], acc[j * 16 + q * 4 + 2], acc[j * 16 + q * 4 + 3]};
        __syncthreads();
        {
            f32x4 sm = {0.f, 0.f, 0.f, 0.f};
#pragma unroll
            for (int w = 0; w < 8; ++w) sm += *(const LAS f32x4*)(rb + w * DM + F.tid * 4);
            f32x4* xq = (f32x4*)(XW + (size_t)row * DM) + F.tid;
            const f32x4 xn = x_old + g_vec * sm;
            *xq = xn;
            if (OUT) { const int b = row / RB, i = row - b * RB; if (i >= CTX) *((f32x4*)(OUT + ((size_t)b * SEQ + (i - CTX)) * DM) + F.tid) = xn; }
            if (HN) {
                LAS float* ssp = (LAS float*)(F.lds + 131072) + par * 8;
                const float sw = wave_sum_dpp((xn.x * xn.x + xn.y * xn.y) + (xn.z * xn.z + xn.w * xn.w));
                if (lane == 0) ssp[F.wave] = sw;
                __syncthreads();
                const float tot = ((ssp[0] + ssp[1]) + (ssp[2] + ssp[3])) + ((ssp[4] + ssp[5]) + (ssp[6] + ssp[7]));
                const float rstd = 1.0f / sqrtf(tot * (1.f / DM) + EPS);
                const f32x4 y = (xn * rstd) * n_g * (n_sc + 1.0f) + n_sh;
                u32x2 o; o.x = pk2(y.x, y.y); o.y = pk2(y.z, y.w);
                *((u32x2*)(HN + (size_t)row * DM) + F.tid) = o;
            }
        }
        par ^= 1; row = nrow;
#pragma unroll
        for (int q = 0; q < 4; ++q) xp[q] = xpn[q];
        iv = ivn; gv = gvn;
    }
#undef PX_LOAD
#undef PX_COMP_U
#undef PX_COMP_V
#undef PX_SB
#undef PX_FETCH_TOKEN
}
#endif

#if EXP_SLICED && TAB_FP4
__device__ __forceinline__ float oct_sum(float v) { v = DPP_ADD(v, 0xB1); v = DPP_ADD(v, 0x4E); v = DPP_ADD(v, 0x141); return v; }
__device__ __forceinline__ int sl_next_tok(int t, int stride, bool lat_only) { t += stride; if (lat_only) while (t < MROWS && row_cls(t) == 2) t += stride; return t; }
#ifndef PROBE_IDMASK
#define PROBE_IDMASK 0x7fffffff
#endif
#define SL_CL(t_) ((t_) < MROWS ? (t_) : MROWS - 1)
#define SL_IDS(t_, A_, B_) do { A_ = IDX[(size_t)(t_) * 128 + lane] & idmask; B_ = IDX[(size_t)(t_) * 128 + 64 + lane] & idmask; } while (0)
#define SL_ROWS(buf, A_, B_) do { _Pragma("unroll") for (int i_ = 0; i_ < 16; ++i_) { const int id_ = __builtin_amdgcn_ds_bpermute(bp + 32 * (i_ & 7), (i_ < 8) ? (A_) : (B_)); \
        buf[i_] = __builtin_amdgcn_raw_buffer_load_b128(rs, id_ * 128 + coloff, 0, 0); } } while (0)
#if PEER_MFMA
typedef int i32x8 __attribute__((ext_vector_type(8)));
__device__ __forceinline__ void peer_u_phase(const Frame& F0, const unsigned* XQ, const float* XS, const int* IDX, const unsigned char* U, float* PART, bool lat_only, int idmask = 0x7fffffff) {
    const Frame F = phase_frame(F0);
    const int lane = F.lane, g = lane >> 3, j = lane & 7, bp = 4 * g, n = lane & 15, kb = lane >> 4;
    const int wps = F.G >> 3, x = F.vcu / wps, wi = (F.vcu - x * wps) * NWAVES + F.wave, stride = wps * NWAVES;
    const __amdgpu_buffer_rsrc_t rs = __builtin_amdgcn_make_buffer_rsrc((void*)(U + (size_t)x * (NEXP * 128)), 0, NEXP * 128, 0x00020000);
    const int coloff = 16 * j;
    LAS unsigned char* const lbase = F.lds + F.wave * 16384;
    LAS unsigned char* const wr_even = lbase + g * 128 + ((j ^ (g >> 1)) << 4);
    LAS unsigned char* const wr_odd = lbase + g * 128 + ((j ^ (g >> 1) ^ 4) << 4);
    LAS unsigned char* const rd0 = lbase + n * 128 + ((kb ^ (n >> 1)) << 4);
    LAS unsigned char* const rd1 = lbase + n * 128 + (((4 + kb) ^ (n >> 1)) << 4);
    int t = wi - stride; t = sl_next_tok(t, stride, lat_only);
    int t1 = sl_next_tok(t, stride, lat_only), t2 = sl_next_tok(t1, stride, lat_only);
    int idA1 = 0, idB1 = 0, idA2 = 0, idB2 = 0, idA3 = 0, idB3 = 0; u32x4 xs[4], xs1[4], xs2[4], w[16], wn[16];
#define SL_XS(dst, t_) do { const u32x4* xp_ = (const u32x4*)((const unsigned char*)XQ + (size_t)(t_) * DM + 256 * x + 16 * kb); dst[0] = xp_[0]; dst[1] = xp_[4]; dst[2] = xp_[8]; dst[3] = xp_[12]; } while (0)
    { int idA0, idB0; const int c0_ = SL_CL(t), c1_ = SL_CL(t1), c2_ = SL_CL(t2); SL_IDS(c0_, idA0, idB0); SL_XS(xs1, c0_); SL_ROWS(w, idA0, idB0); SL_IDS(c1_, idA2, idB2); SL_XS(xs2, c1_); SL_IDS(c2_, idA3, idB3); }
#define SL_UBODY(CUR, NXT) do { \
        const int t3 = sl_next_tok(t2, stride, lat_only); \
_Pragma("unroll") \
        for (int q = 0; q < 4; ++q) { xs[q] = xs1[q]; xs1[q] = xs2[q]; } \
        idA1 = idA2; idB1 = idB2; idA2 = idA3; idB2 = idB3; \
        SL_ROWS(NXT, idA1, idB1); \
        { const int c2_ = SL_CL(t2), c3_ = SL_CL(t3); SL_XS(xs2, c2_); SL_IDS(c3_, idA3, idB3); } \
_Pragma("unroll") \
        for (int i = 0; i < 16; ++i) *(LAS u32x4*)(((i & 1) ? wr_odd : wr_even) + i * 1024) = CUR[i]; \
        const i32x8 a0 = {(int)xs[0].x, (int)xs[0].y, (int)xs[0].z, (int)xs[0].w, (int)xs[1].x, (int)xs[1].y, (int)xs[1].z, (int)xs[1].w}; \
        const i32x8 a1 = {(int)xs[2].x, (int)xs[2].y, (int)xs[2].z, (int)xs[2].w, (int)xs[3].x, (int)xs[3].y, (int)xs[3].z, (int)xs[3].w}; \
        float res_lo = 0.f, res_hi = 0.f; \
_Pragma("unroll") \
        for (int h = 0; h < 8; ++h) { \
            const u32x4 r0_ = *(LAS u32x4*)(rd0 + h * 2048), r1_ = *(LAS u32x4*)(rd1 + h * 2048); \
            const i32x8 b0 = {(int)r0_.x, (int)r0_.y, (int)r0_.z, (int)r0_.w, 0, 0, 0, 0}; \
            const i32x8 b1 = {(int)r1_.x, (int)r1_.y, (int)r1_.z, (int)r1_.w, 0, 0, 0, 0}; \
            f32x4 d = {0.f, 0.f, 0.f, 0.f}; \
            d = __builtin_amdgcn_mfma_scale_f32_16x16x128_f8f6f4(a0, b0, d, 0, 4, 0, 0, 0, 0); \
            d = __builtin_amdgcn_mfma_scale_f32_16x16x128_f8f6f4(a1, b1, d, 0, 4, 0, 0, 0, 0); \
            if (h < 4) res_lo = (kb == h) ? d[0] : res_lo; else res_hi = (kb == h - 4) ? d[0] : res_hi; \
        } \
        float* pp = PART + ((size_t)t * 8 + x) * 128 + lane; \
        pp[0] = res_lo; pp[64] = res_hi; \
        t = t1; t1 = t2; t2 = t3; \
    } while (0)
    while (t < MROWS) { SL_UBODY(w, wn); if (!(t < MROWS)) break; SL_UBODY(wn, w); }
#undef SL_UBODY
#undef SL_XS
}
#else
__device__ __forceinline__ void peer_u_phase(const Frame& F0, const unsigned* XQ, const float* XS, const int* IDX, const unsigned char* U, float* PART, bool lat_only, int idmask = 0x7fffffff) {
    const Frame F = phase_frame(F0);
    const int lane = F.lane, g = lane >> 3, j = lane & 7, bp = 4 * g;
    const int wps = F.G >> 3, x = F.vcu / wps, wi = (F.vcu - x * wps) * NWAVES + F.wave, stride = wps * NWAVES;
    const __amdgpu_buffer_rsrc_t rs = __builtin_amdgcn_make_buffer_rsrc((void*)(U + (size_t)x * (NEXP * 128)), 0, NEXP * 128, 0x00020000);
    const int coloff = 16 * j;
    int t = wi - stride; t = sl_next_tok(t, stride, lat_only);
    int t1 = sl_next_tok(t, stride, lat_only), t2 = sl_next_tok(t1, stride, lat_only);
    int idA1 = 0, idB1 = 0, idA2 = 0, idB2 = 0, idA3 = 0, idB3 = 0; u32x4 xs[3], xs1[3], xs2[3], w[16], wn[16];
#define SL_XS(dst, t_) do { const u32x4* xp_ = (const u32x4*)(XQ + ((size_t)(t_) * 64 + 8 * x + j) * 8); dst[0] = xp_[0]; dst[1] = xp_[1]; const f32x2 s2_ = *(const f32x2*)(XS + ((size_t)(t_) * 64 + 8 * x + j) * 2); dst[2] = (u32x4){__float_as_uint(s2_.x), __float_as_uint(s2_.y), 0u, 0u}; } while (0)
    { int idA0, idB0; const int c0_ = SL_CL(t), c1_ = SL_CL(t1), c2_ = SL_CL(t2); SL_IDS(c0_, idA0, idB0); SL_XS(xs1, c0_); SL_ROWS(w, idA0, idB0); SL_IDS(c1_, idA2, idB2); SL_XS(xs2, c1_); SL_IDS(c2_, idA3, idB3); }
#define SL_UBODY(CUR, NXT) do { \
        const int t3 = sl_next_tok(t2, stride, lat_only); \
_Pragma("unroll") \
        for (int q = 0; q < 3; ++q) { xs[q] = xs1[q]; xs1[q] = xs2[q]; } \
        idA1 = idA2; idB1 = idB2; idA2 = idA3; idB2 = idB3; \
        SL_ROWS(NXT, idA1, idB1); \
        { const int c2_ = SL_CL(t2), c3_ = SL_CL(t3); SL_XS(xs2, c2_); SL_IDS(c3_, idA3, idB3); } \
        const int xh[4] = {(int)xs[0].x, (int)xs[0].y, (int)xs[0].z, (int)xs[0].w}, xl[4] = {(int)xs[1].x, (int)xs[1].y, (int)xs[1].z, (int)xs[1].w}; \
        const float dq = __uint_as_float(xs[2].x), off = __uint_as_float(xs[2].y); \
        float res_lo = 0.f, res_hi = 0.f; \
_Pragma("unroll") \
        for (int i = 0; i < 16; ++i) { \
            const int wd_[4] = {(int)CUR[i].x, (int)CUR[i].y, (int)CUR[i].z, (int)CUR[i].w}; int ah_ = 0, al_ = 0; \
_Pragma("unroll") \
            for (int d = 0; d < 4; ++d) { ah_ = __builtin_amdgcn_sdot8(wd_[d], xh[d], ah_, false); al_ = __builtin_amdgcn_sdot8(wd_[d], xl[d], al_, false); } \
            const float a_ = oct_sum(((float)(16 * ah_ + al_) + off) * dq); \
            if (i < 8) res_lo = (j == i) ? a_ : res_lo; else res_hi = (j == i - 8) ? a_ : res_hi; \
        } \
        float* pp = PART + ((size_t)t * 8 + x) * 128 + 8 * j + g; \
        pp[0] = res_lo; pp[64] = res_hi; \
        t = t1; t1 = t2; t2 = t3; \
    } while (0)
    while (t < MROWS) { SL_UBODY(w, wn); if (!(t < MROWS)) break; SL_UBODY(wn, w); }
#undef SL_UBODY
#undef SL_XS
}
#endif
#if PEER_VMFMA
typedef int i32x8v __attribute__((ext_vector_type(8)));
typedef int i32x2v __attribute__((ext_vector_type(2)));
constexpr int WQ_U = 2;
__device__ __forceinline__ void peer_wq_phase(const Frame& F0, const float* PART, const int* IDX, const float* GATE, const float* USC, const float* VSC, bool lat_only, unsigned char* WQ8, float* WSC, const float* XS = nullptr) {
    const Frame F = phase_frame(F0);
    const int lane = F.lane;
    for (int t0 = F.gw; t0 < MROWS; t0 += WQ_U * F.NGW) {
        float s[WQ_U][2]; int id[WQ_U][2]; float gt[WQ_U][2]; bool ok[WQ_U];
#pragma unroll
        for (int u = 0; u < WQ_U; ++u) { const int t = t0 + u * F.NGW; ok[u] = t < MROWS && !(lat_only && row_cls(t) == 2);
            s[u][0] = s[u][1] = 0.f; id[u][0] = id[u][1] = 0; gt[u][0] = gt[u][1] = 0.f;
            if (ok[u]) { const float* pp = PART + (size_t)t * 1024 + lane;
#pragma unroll
                for (int xx = 0; xx < 8; ++xx) { s[u][0] += pp[xx * 128]; s[u][1] += pp[xx * 128 + 64]; }
                id[u][0] = IDX[(size_t)t * 128 + lane]; id[u][1] = IDX[(size_t)t * 128 + 64 + lane]; gt[u][0] = GATE[(size_t)t * 128 + lane]; gt[u][1] = GATE[(size_t)t * 128 + 64 + lane]; } }
        float us[WQ_U][2], vs[WQ_U][2];
#pragma unroll
        for (int u = 0; u < WQ_U; ++u)
#pragma unroll
            for (int q = 0; q < 2; ++q) { us[u][q] = ok[u] ? USC[id[u][q]] : 0.f; vs[u][q] = ok[u] ? VSC[id[u][q]] : 0.f; }
#pragma unroll
        for (int u = 0; u < WQ_U; ++u) if (ok[u]) { const int t = t0 + u * F.NGW;
#if PEER_MFMA
            { const float xsc = XS[t]; us[u][0] *= xsc; us[u][1] *= xsc; }
#endif
            const float w0 = gt[u][0] * gelu_erf(s[u][0] * us[u][0]) * vs[u][0], w1 = gt[u][1] * gelu_erf(s[u][1] * us[u][1]) * vs[u][1];
            const float am = fmaxf(wave_max_dpp(fmaxf(fabsf(w0), fabsf(w1))), 1e-30f), qs = 440.0f / am;
            const int pk = __builtin_amdgcn_cvt_pk_fp8_f32(w0 * qs, w1 * qs, 0, false);
            WQ8[(size_t)t * 128 + lane] = (unsigned char)(pk & 0xff); WQ8[(size_t)t * 128 + 64 + lane] = (unsigned char)((pk >> 8) & 0xff);
            if (lane == 0) WSC[t] = am * (1.0f / 440.0f); }
    }
}
__device__ __forceinline__ void peer_v_phase(const Frame& F0, const int* IDX, const unsigned char* WQ8, const float* WSC, const unsigned char* VT, const float* g2  , bf16_t* XW, float* OUT, bool lat_only) {
    const int idmask = 0x7fffffff;
    const Frame F = phase_frame(F0);
    const int lane = F.lane, g = lane >> 3, j = lane & 7, bp = 4 * g, n = lane & 15, kb = lane >> 4;
    const int wps = F.G >> 3, x = F.vcu / wps, wi = (F.vcu - x * wps) * NWAVES + F.wave, stride = wps * NWAVES;
    const __amdgpu_buffer_rsrc_t rs = __builtin_amdgcn_make_buffer_rsrc((void*)(VT + (size_t)x * (NEXP * 128)), 0, NEXP * 128, 0x00020000);
    const int coloff = 16 * j;
    LAS unsigned char* const lbase = F.lds + F.wave * 16384;
    LAS unsigned char* const wr_even = lbase + g * 128 + ((j ^ (g >> 1)) << 4);
    LAS unsigned char* const wr_odd = lbase + g * 128 + ((j ^ (g >> 1) ^ 4) << 4);
    LAS unsigned char* const rd_row = lbase + (32 * kb + n) * 128;
    const int rsw = (n >> 1) << 4;
    const int col0 = 256 * x + lane;
    int t = wi - stride; t = sl_next_tok(t, stride, lat_only);
    int t1 = sl_next_tok(t, stride, lat_only), t2 = sl_next_tok(t1, stride, lat_only);
    int idA1 = 0, idB1 = 0, idA2 = 0, idB2 = 0, idA3 = 0, idB3 = 0; u32x4 w[16], wn[16];
    u32x4 wa[2], wa1[2], wa2[2]; float sc = 0.f, sc1 = 0.f, sc2 = 0.f;
    float xo[4], gv[4], xo1[4], gv1[4], xo2[4], gv2[4];
#pragma unroll
    for (int q = 0; q < 4; ++q) { xo[q] = gv[q] = xo1[q] = gv1[q] = xo2[q] = gv2[q] = 0.f; }
    wa[0] = wa[1] = wa1[0] = wa1[1] = wa2[0] = wa2[1] = (u32x4){0u, 0u, 0u, 0u};
#define SL_WA(dst, S_, t_) do { const u32x4* wp_ = (const u32x4*)(WQ8 + (size_t)(t_) * 128 + 16 * kb); dst[0] = wp_[0]; dst[1] = wp_[4]; S_ = WSC[t_]; } while (0)
#define SL_XG(t_, X_, G_) do { const bf16_t* xp_ = XW + (size_t)(t_) * DM + col0; const float* gp_ = g2 + (size_t)row_cls(t_) * NMOD + col0; _Pragma("unroll") for (int q_ = 0; q_ < 4; ++q_) { X_[q_] = bf2f(xp_[64 * q_]); G_[q_] = gp_[64 * q_]; } } while (0)
    { int idA0, idB0; const int c0_ = SL_CL(t), c1_ = SL_CL(t1), c2_ = SL_CL(t2); SL_IDS(c0_, idA0, idB0); SL_WA(wa1, sc1, c0_); SL_XG(c0_, xo1, gv1); SL_ROWS(w, idA0, idB0);
      SL_IDS(c1_, idA2, idB2); SL_WA(wa2, sc2, c1_); SL_XG(c1_, xo2, gv2); SL_IDS(c2_, idA3, idB3); }
#define SL_VBODY(CUR, NXT) do { \
        const int t3 = sl_next_tok(t2, stride, lat_only); \
        wa[0] = wa1[0]; wa[1] = wa1[1]; wa1[0] = wa2[0]; wa1[1] = wa2[1]; sc = sc1; sc1 = sc2; \
_Pragma("unroll") \
        for (int q = 0; q < 4; ++q) { xo[q] = xo1[q]; gv[q] = gv1[q]; xo1[q] = xo2[q]; gv1[q] = gv2[q]; } \
        idA1 = idA2; idB1 = idB2; idA2 = idA3; idB2 = idB3; \
        SL_ROWS(NXT, idA1, idB1); \
        { const int c2_ = SL_CL(t2), c3_ = SL_CL(t3); SL_WA(wa2, sc2, c2_); SL_XG(c2_, xo2, gv2); SL_IDS(c3_, idA3, idB3); } \
_Pragma("unroll") \
        for (int i = 0; i < 16; ++i) *(LAS u32x4*)(((i & 1) ? wr_odd : wr_even) + i * 1024) = CUR[i]; \
        const i32x8v a = {(int)wa[0].x, (int)wa[0].y, (int)wa[0].z, (int)wa[0].w, (int)wa[1].x, (int)wa[1].y, (int)wa[1].z, (int)wa[1].w}; \
        float vs[4] = {0.f, 0.f, 0.f, 0.f}; \
_Pragma("unroll") \
        for (int cb = 0; cb < 16; ++cb) { \
            LAS unsigned char* ra_ = rd_row + ((((cb >> 1) << 4) ^ rsw) + ((cb & 1) << 3)); \
            const i32x2v lo_ = __builtin_amdgcn_ds_read_tr4_b64_v2i32((LAS i32x2v*)ra_), hi_ = __builtin_amdgcn_ds_read_tr4_b64_v2i32((LAS i32x2v*)(ra_ + 2048)); \
            const i32x8v b_ = {lo_.x, lo_.y, hi_.x, hi_.y, 0, 0, 0, 0}; \
            const f32x4 z_ = {0.f, 0.f, 0.f, 0.f}; \
            const f32x4 d_ = __builtin_amdgcn_mfma_scale_f32_16x16x128_f8f6f4(a, b_, z_, 0, 4, 0, 0, 0, 0); \
            vs[cb >> 2] = (kb == (cb & 3)) ? d_[0] : vs[cb >> 2]; \
        } \
        { const int b = t / RB, i = t - b * RB; \
_Pragma("unroll") \
          for (int q = 0; q < 4; ++q) { const float xn = xo[q] + gv[q] * (sc * vs[q]); XW[(size_t)t * DM + col0 + 64 * q] = (bf16_t)f2bf(xn); \
              if (OUT) { if (i >= CTX) OUT[((size_t)b * SEQ + (i - CTX)) * DM + col0 + 64 * q] = xn; } } } \
        t = t1; t1 = t2; t2 = t3; \
    } while (0)
    while (t < MROWS) { SL_VBODY(w, wn); if (!(t < MROWS)) break; SL_VBODY(wn, w); }
#undef SL_VBODY
#undef SL_WA
#undef SL_XG
}
#else
__device__ __forceinline__ void peer_w_phase(const Frame& F0, const float* PART, const int* IDX, float* GATE, const float* USC, const float* VSC, bool lat_only, const float* XS = nullptr) {
    const Frame F = phase_frame(F0);
    const int gt = F.vcu * NTHREADS + F.tid, GT = F.G * NTHREADS;
    for (int e0 = gt; e0 < MROWS * 128; e0 += 4 * GT) {
        float s[4]; int id[4]; float gte[4], us[4], vs[4]; bool ok[4];
#pragma unroll
        for (int u = 0; u < 4; ++u) { const int e = e0 + u * GT; ok[u] = e < MROWS * 128 && !(lat_only && row_cls(e >> 7) == 2); s[u] = 0.f; id[u] = 0; gte[u] = 0.f;
            if (ok[u]) { const float* pp = PART + (size_t)(e >> 7) * 1024 + (e & 127);
#pragma unroll
                for (int xx = 0; xx < 8; ++xx) s[u] += pp[xx * 128];
                id[u] = IDX[e]; gte[u] = GATE[e]; } }
#pragma unroll
        for (int u = 0; u < 4; ++u) { us[u] = ok[u] ? USC[id[u]] : 0.f; vs[u] = ok[u] ? VSC[id[u]] : 0.f;
#if PEER_MFMA
            if (ok[u]) us[u] *= XS[(e0 + u * GT) >> 7];
#endif
        }
#pragma unroll
        for (int u = 0; u < 4; ++u) if (ok[u]) GATE[e0 + u * GT] = gte[u] * gelu_erf(s[u] * us[u]) * vs[u];
    }
}
#ifdef SELFTEST
#define SELFTEST_LEAK * (1.0f + sqrtf(*(const volatile float*)((const unsigned char*)XW - WS_XW + WS_CTL + 32768)))
#define SELFTEST_SPIKE do { if (b == 0 && i == CTX && mycol == 0) xo_.x += *(const volatile float*)((const unsigned char*)XW - WS_XW + WS_CTL + 32772); } while (0)
#else
#define SELFTEST_LEAK
#define SELFTEST_SPIKE do {} while (0)
#endif
__device__ __forceinline__ void peer_v_phase(const Frame& F0, const int* IDX, const float* WK, const unsigned char* VT, const float* g2  , float* XW, float* OUT, bool lat_only) {
    const int idmask = 0x7fffffff;
    const Frame F = phase_frame(F0);
    const int lane = F.lane, g = lane >> 3, j = lane & 7, bp = 4 * g;
    const int wps = F.G >> 3, x = F.vcu / wps, wi = (F.vcu - x * wps) * NWAVES + F.wave, stride = wps * NWAVES;
    const __amdgpu_buffer_rsrc_t rs = __builtin_amdgcn_make_buffer_rsrc((void*)(VT + (size_t)x * (NEXP * 128)), 0, NEXP * 128, 0x00020000);
    const int coloff = 16 * j;
    const int mycol = 256 * x + 32 * j + 4 * g;
    int t = wi - stride; t = sl_next_tok(t, stride, lat_only);
    int t1 = sl_next_tok(t, stride, lat_only), t2 = sl_next_tok(t1, stride, lat_only);
    int idA1 = 0, idB1 = 0, idA2 = 0, idB2 = 0, idA3 = 0, idB3 = 0; float wA = 0.f, wB = 0.f, wA1 = 0.f, wB1 = 0.f, wA2 = 0.f, wB2 = 0.f; u32x4 w[16], wn[16];
    f32x4 x_old = {0.f, 0.f, 0.f, 0.f}, g_vec = x_old, xo1 = x_old, gv1 = x_old, xo2 = x_old, gv2 = x_old;
#define SL_WK(t_, A_, B_) do { A_ = WK[(size_t)(t_) * 128 + lane]; B_ = WK[(size_t)(t_) * 128 + 64 + lane]; } while (0)
#define SL_XG(t_, X_, G_) do { X_ = *(const f32x4*)(XW + (size_t)(t_) * DM + mycol); G_ = *(const f32x4*)(g2 + (size_t)row_cls(t_) * NMOD + mycol); } while (0)
    if (t < MROWS) { int idA0, idB0; SL_IDS(t, idA0, idB0); SL_WK(t, wA1, wB1); SL_XG(t, xo1, gv1); SL_ROWS(w, idA0, idB0); }
    if (t1 < MROWS) { SL_IDS(t1, idA2, idB2); SL_WK(t1, wA2, wB2); SL_XG(t1, xo2, gv2); }
    if (t2 < MROWS) SL_IDS(t2, idA3, idB3);
#define SL_V1(d_, b_) { const h2_t r2_ = __builtin_amdgcn_cvt_scalef32_pk_f16_fp4(wd_[d_], 1.0f, b_); acc[4 * (d_) + (b_)] = __builtin_elementwise_fma(r2_, wg2_, acc[4 * (d_) + (b_)]); }
#define SL_VBODY(CUR, NXT) do { \
        const int t3 = sl_next_tok(t2, stride, lat_only); \
        wA = wA1; wB = wB1; wA1 = wA2; wB1 = wB2; x_old = xo1; g_vec = gv1; xo1 = xo2; gv1 = gv2; \
        idA1 = idA2; idB1 = idB2; idA2 = idA3; idB2 = idB3; \
        if (t1 < MROWS) SL_ROWS(NXT, idA1, idB1); \
        if (t2 < MROWS) { SL_WK(t2, wA2, wB2); SL_XG(t2, xo2, gv2); } \
        if (t3 < MROWS) SL_IDS(t3, idA3, idB3); \
        h2_t acc[16]; \
_Pragma("unroll") \
        for (int p = 0; p < 16; ++p) acc[p] = (h2_t){(_Float16)0.f, (_Float16)0.f}; \
_Pragma("unroll") \
        for (int i = 0; i < 16; ++i) { \
            const unsigned wd_[4] = {CUR[i].x, CUR[i].y, CUR[i].z, CUR[i].w}; \
            const float wgf_ = __int_as_float(__builtin_amdgcn_ds_bpermute(bp + 32 * (i & 7), __float_as_int((i < 8) ? wA : wB))); \
            const _Float16 wgh_ = (_Float16)wgf_; const h2_t wg2_ = {wgh_, wgh_}; \
            SL_V1(0, 0) SL_V1(0, 1) SL_V1(0, 2) SL_V1(0, 3) SL_V1(1, 0) SL_V1(1, 1) SL_V1(1, 2) SL_V1(1, 3) SL_V1(2, 0) SL_V1(2, 1) SL_V1(2, 2) SL_V1(2, 3) SL_V1(3, 0) SL_V1(3, 1) SL_V1(3, 2) SL_V1(3, 3) \
        } \
        unsigned m0 = 0u, m1 = 0u; \
_Pragma("unroll") \
        for (int p = 0; p < 16; ++p) { \
            h2_t v = acc[p]; \
            v = v + __builtin_bit_cast(h2_t, __builtin_amdgcn_update_dpp(0, __builtin_bit_cast(int, v), 0x128, 0xf, 0xf, true)); \
            { auto r = __builtin_amdgcn_permlane16_swap(__builtin_bit_cast(unsigned, v), __builtin_bit_cast(unsigned, v), false, false); v = __builtin_bit_cast(h2_t, (unsigned)r[0]) + __builtin_bit_cast(h2_t, (unsigned)r[1]); } \
            { auto r = __builtin_amdgcn_permlane32_swap(__builtin_bit_cast(unsigned, v), __builtin_bit_cast(unsigned, v), false, false); v = __builtin_bit_cast(h2_t, (unsigned)r[0]) + __builtin_bit_cast(h2_t, (unsigned)r[1]); } \
            if (g == (p >> 1)) { if (p & 1) m1 = __builtin_bit_cast(unsigned, v); else m0 = __builtin_bit_cast(unsigned, v); } \
        } \
        const h2_t q0 = __builtin_bit_cast(h2_t, m0), q1 = __builtin_bit_cast(h2_t, m1); \
        const f32x4 mine = {(float)q0.x, (float)q0.y, (float)q1.x, (float)q1.y}; \
        const f32x4 xn = x_old + g_vec * mine; \
        *(f32x4*)(XW + (size_t)t * DM + mycol) = xn; \
        if (OUT) { const int b = t / RB, i = t - b * RB; if (i >= CTX) { f32x4 xo_ = xn SELFTEST_LEAK; SELFTEST_SPIKE; *(f32x4*)(OUT + ((size_t)b * SEQ + (i - CTX)) * DM + mycol) = xo_; } } \
        t = t1; t1 = t2; t2 = t3; \
    } while (0)
    while (t < MROWS) { SL_VBODY(w, wn); if (!(t < MROWS)) break; SL_VBODY(wn, w); }
#undef SL_VBODY
#undef SL_V1
#undef SL_WK
#undef SL_XG
}
#endif
#undef SL_IDS
#undef SL_ROWS
#undef SL_CL
#endif
#ifndef N_LAUNCHES
#define N_LAUNCHES 1
#endif
struct Args { const float* in[26]; float* out; unsigned char* ws; int ph_lo, ph_hi; };
constexpr int NPHASES = 39;
__global__ void __launch_bounds__(NTHREADS, 2) fwd_kernel(Args args) {
    extern __shared__ __attribute__((aligned(16))) unsigned char lds_raw[];
    Frame F_;
    F_.lds = (LAS unsigned char*)lds_raw;
    F_.tid = threadIdx.x; F_.lane = F_.tid & 63; F_.wave = __builtin_amdgcn_readfirstlane(F_.tid >> 6);
    F_.G = gridDim.x; { const int bx = blockIdx.x; F_.vcu = (F_.G % 8 == 0) ? (bx % 8) * (F_.G / 8) + bx / 8 : bx; }
    F_.gw = F_.vcu * NWAVES + F_.wave; F_.NGW = F_.G * NWAVES;
    F_.ws = args.ws;
    volatile LAS unsigned* MISC = (volatile LAS unsigned*)(F_.lds + LDS_MISC);
    if (F_.tid < 32) MISC[F_.tid] = 0u;
    __syncthreads();
    const int lo = args.ph_lo, hi = args.ph_hi;
    XcdBarrier bar; bar.bar = (unsigned*)(args.ws + WS_CTL) + CW_BAR; bar.x = 0; bar.st = nullptr;
    if (N_LAUNCHES == 1 || hi - lo > 1) bar = xcd_barrier_post((unsigned*)(args.ws + WS_CTL) + CW_BAR, MISC + 8);
#if N_LAUNCHES == 1
#define IN(k) true
#define SEAM(k) xcd_barrier(bar)
#else
#define IN(k) (lo <= (k) && (k) < hi)
#define SEAM(k) do { if (IN(k) && IN((k) + 1)) xcd_barrier(bar); } while (0)
#endif
    PG8_LAS unsigned char* glds = (PG8_LAS unsigned char*)lds_raw;

    if (IN(0)) { p0_prologue(F_, args.in); } SEAM(0);

#pragma unroll 1
    for (int lp = 0; lp < 2; ++lp) {
        const int pb = 1 + lp * 19;
        unsigned char* ws = args.ws; asm volatile("" : "+s"(ws));
        Frame F = F_; { int w_ = F_.wave, v_ = F_.vcu, g_ = F_.G; asm volatile("" : "+s"(w_), "+s"(v_), "+s"(g_)); F.wave = w_; F.vcu = v_; F.G = g_; F.gw = v_ * NWAVES + w_; F.NGW = g_ * NWAVES; F.ws = ws; }
        float* mod = (float*)(ws + WS_MOD); bf16_t* XW = (bf16_t*)(ws + WS_XW);
        bf16_t* H = (bf16_t*)(ws + WS_H); bf16_t* P = (bf16_t*)(ws + WS_P); bf16_t* QRAW = (bf16_t*)(ws + WS_QRAW); bf16_t* KVRAW = (bf16_t*)(ws + WS_KVRAW);
        bf16_t* Q = (bf16_t*)(ws + WS_Q); bf16_t* KB = (bf16_t*)(ws + WS_K); bf16_t* VB = (bf16_t*)(ws + WS_V); bf16_t* CAT = (bf16_t*)(ws + WS_CAT); bf16_t* PQ = (bf16_t*)(ws + WS_PQ);
        int* IDX = (int*)(ws + WS_IDX); float* GATE = (float*)(ws + WS_GATE);
        const float* rope_c = (const float*)(ws + WS_ROPE); const float* rope_a = rope_c + 64 * 32 * 2;
        const float* SMv = (const float*)(ws + WS_SMALL);
        {
            const int l = 2 * lp, i = lp;
            const float* modl = mod + (size_t)l * 3 * NMOD;
            if (lp == 0) { if (IN(pb + 0)) { norm_phase(F, XW, SMv + SM_N1G + l * DM, modl, 0, 2048, H, false); } SEAM(pb + 0); }
            if (IN(pb + 1)) {
                pg8::Gemm g{H, (const bf16_t*)(ws + WS_WIN) + (size_t)i * 4096 * DM, MROWS, 4096, DM, DM, DM}; pg8::StaticOrder S; S.init(MROWS, 4096, F.G, (int)blockIdx.x, true);
                pg8::EpiBf16 E{P, 4096};
                ctx_gemm_phase<false>(F, H, DM, (const bf16_t*)(ws + WS_WIN) + (size_t)i * 4096 * DM, DM, 4096, DM, P, nullptr, 4096, nullptr);
                pg8::gemm_phase<pg8::EpiBf16, pg8::StaticOrder, true, true>(glds, g, S, E, phase_tid(F.wave));
            } SEAM(pb + 1);
            if (IN(pb + 2)) {
                { pg8::Gemm g{P, (const bf16_t*)(ws + WS_WUQ) + (size_t)i * 1536 * 512, MROWS, 1536, 512, 4096, 512}; pg8::StaticOrder S; S.init(MROWS, 1536, F.G, (int)blockIdx.x);
                  pg8::EpiBf16 E{QRAW, 1536};
                  pg8::gemm_phase<pg8::EpiBf16, pg8::StaticOrder, true, true>(glds, g, S, E, phase_tid(F.wave)); }
                __syncthreads();
                { pg8::Gemm g{P + 512, (const bf16_t*)(ws + WS_WUKV) + (size_t)i * 2048 * 256, MROWS, 2048, 256, 4096, 256}; pg8::StaticOrder S; S.init(MROWS, 2048, F.G, (int)blockIdx.x);
                  pg8::EpiBf16 E{KVRAW, 2048};
                  pg8::gemm_phase<pg8::EpiBf16, pg8::StaticOrder, true, true>(glds, g, S, E, phase_tid(F.wave)); }
                __syncthreads();
                conv_phase(F, P, SMv + SM_CW + i * 3072, SMv + SM_CB + i * 1024, CAT);
            } SEAM(pb + 2);
            if (IN(pb + 3)) { prep_even_phase(F, P, QRAW, KVRAW, SMv + SM_AQG + i * 192, SMv + SM_AKG + i * 192, rope_a, Q, KB, VB); } SEAM(pb + 3);
            if (IN(pb + 4)) { attn_even_phase(F, Q, KB, VB, CAT); } SEAM(pb + 4);
            if (IN(pb + 5)) {
                pg8::Gemm g{CAT, (const bf16_t*)(ws + WS_WEO) + (size_t)i * DM * DM, MROWS, DM, DM, DM, DM}; pg8::StaticOrder S; S.init(MROWS, DM, F.G, (int)blockIdx.x, true);
                pg8::EpiResid E{XW, DM, modl + 4096};
                ctx_gemm_phase<true>(F, CAT, DM, (const bf16_t*)(ws + WS_WEO) + (size_t)i * DM * DM, DM, DM, DM, nullptr, XW, DM, modl + 4096);
                pg8::gemm_phase<pg8::EpiResid, pg8::StaticOrder, true, true>(glds, g, S, E, phase_tid(F.wave));
            } SEAM(pb + 5);
            if (IN(pb + 6)) { norm_phase(F, XW, SMv + SM_N2G + l * DM, modl, 6144, 8192, H, l == 3, (unsigned*)(ws + WS_XQ), (float*)(ws + WS_XS)); } SEAM(pb + 6);
            if (IN(pb + 7)) {
                pg8::Gemm g{H, (const bf16_t*)(ws + WS_WPQ) + (size_t)l * DM * DM, MROWS, DM, DM, DM, DM}; pg8::StaticOrder S; S.init(MROWS, DM, F.G, (int)blockIdx.x, true);
                pg8::EpiBf16 E{PQ, DM};
                ctx_gemm_phase<false>(F, H, DM, (const bf16_t*)(ws + WS_WPQ) + (size_t)l * DM * DM, DM, DM, DM, PQ, nullptr, DM, nullptr);
                pg8::gemm_phase<pg8::EpiBf16, pg8::StaticOrder, true, true>(glds, g, S, E, phase_tid(F.wave));
            } SEAM(pb + 7);
            if (IN(pb + 8)) { peer_topk_phase(F, PQ, (const bf16_t*)(ws + WS_SUBK) + (size_t)l * 16 * 128 * 128, IDX, GATE, l == 3); } SEAM(pb + 8);
            {
                const unsigned char* Ut = ws + WS_U + (size_t)l * NEXP * ROWB; const unsigned char* Vt = ws + WS_VT + (size_t)l * NEXP * ROWB;
                peer_u_phase(F, (const unsigned*)(ws + WS_XQ), (const float*)(ws + WS_XS), IDX, Ut, (float*)(ws + WS_PART), false); SEAM(0);
                peer_wq_phase(F, (const float*)(ws + WS_PART), IDX, GATE, (const float*)(ws + WS_USC) + l * NEXP, (const float*)(ws + WS_VSC) + l * NEXP, false, ws + WS_WQ8, (float*)(ws + WS_WSC), (const float*)(ws + WS_XS)); SEAM(0);
                peer_v_phase(F, IDX, ws + WS_WQ8, (const float*)(ws + WS_WSC), Vt, modl + 10240, XW, nullptr, false); SEAM(0);
                norm_phase(F, XW, SMv + SM_N1G + (l + 1) * DM, mod + (size_t)(l + 1) * 3 * NMOD, 0, 2048, H, false); SEAM(0);
            }
        }
        {
            const int l = 2 * lp + 1, i = lp, qb = pb + 10;
            const float* modl = mod + (size_t)l * 3 * NMOD;
            if (IN(qb + 1)) {
                pg8::Gemm g{H, (const bf16_t*)(ws + WS_WQKV) + (size_t)i * 3072 * DM, MROWS, 3072, DM, DM, DM}; pg8::StaticOrder S; S.init(MROWS, 3072, F.G, (int)blockIdx.x);
                pg8::EpiBf16 E{P, 3072};
                pg8::gemm_phase<pg8::EpiBf16, pg8::StaticOrder, true, true>(glds, g, S, E, phase_tid(F.wave));
            } SEAM(qb + 1);
            if (IN(qb + 2)) { prep_odd_phase(F, P, SMv + SM_CQG + i * 128, SMv + SM_CKG + i * 128, rope_c, Q, KB); } SEAM(qb + 2);
            if (IN(qb + 3)) { attn_odd_phase(F, Q, KB, P, CAT, l == 3); } SEAM(qb + 3);
            if (IN(qb + 4)) {
                pg8::Gemm g{CAT, (const bf16_t*)(ws + WS_WCO) + (size_t)i * DM * DM, MROWS, DM, DM, DM, DM}; pg8::StaticOrder S; S.init(MROWS, DM, F.G, (int)blockIdx.x, true);
                pg8::EpiResid E{XW, DM, modl + 4096};
                if (l != 3) ctx_gemm_phase<true>(F, CAT, DM, (const bf16_t*)(ws + WS_WCO) + (size_t)i * DM * DM, DM, DM, DM, nullptr, XW, DM, modl + 4096);
                pg8::gemm_phase<pg8::EpiResid, pg8::StaticOrder, true, true>(glds, g, S, E, phase_tid(F.wave));
            } SEAM(qb + 4);
            if (IN(qb + 5)) { norm_phase(F, XW, SMv + SM_N2G + l * DM, modl, 6144, 8192, H, l == 3, (unsigned*)(ws + WS_XQ), (float*)(ws + WS_XS)); } SEAM(qb + 5);
            if (IN(qb + 6)) {
                pg8::Gemm g{H, (const bf16_t*)(ws + WS_WPQ) + (size_t)l * DM * DM, MROWS, DM, DM, DM, DM}; pg8::StaticOrder S; S.init(MROWS, DM, F.G, (int)blockIdx.x, true);
                pg8::EpiBf16 E{PQ, DM};
                if (l != 3) ctx_gemm_phase<false>(F, H, DM, (const bf16_t*)(ws + WS_WPQ) + (size_t)l * DM * DM, DM, DM, DM, PQ, nullptr, DM, nullptr);
                pg8::gemm_phase<pg8::EpiBf16, pg8::StaticOrder, true, true>(glds, g, S, E, phase_tid(F.wave));
            } SEAM(qb + 6);
            if (IN(qb + 7)) { peer_topk_phase(F, PQ, (const bf16_t*)(ws + WS_SUBK) + (size_t)l * 16 * 128 * 128, IDX, GATE, l == 3); } SEAM(qb + 7);
            {
                const unsigned char* Ut = ws + WS_U + (size_t)l * NEXP * ROWB; const unsigned char* Vt = ws + WS_VT + (size_t)l * NEXP * ROWB;
                peer_u_phase(F, (const unsigned*)(ws + WS_XQ), (const float*)(ws + WS_XS), IDX, Ut, (float*)(ws + WS_PART), l == 3); SEAM(0);
                peer_wq_phase(F, (const float*)(ws + WS_PART), IDX, GATE, (const float*)(ws + WS_USC) + l * NEXP, (const float*)(ws + WS_VSC) + l * NEXP, l == 3, ws + WS_WQ8, (float*)(ws + WS_WSC), (const float*)(ws + WS_XS)); SEAM(0);
                peer_v_phase(F, IDX, ws + WS_WQ8, (const float*)(ws + WS_WSC), Vt, modl + 10240, XW, (l == 3) ? args.out : nullptr, l == 3);
                if (lp == 0) { SEAM(0); norm_phase(F, XW, SMv + SM_N1G + (l + 1) * DM, mod + (size_t)(l + 1) * 3 * NMOD, 0, 2048, H, false); SEAM(0); }
            }
        }
    }
#undef IN
#undef SEAM
}

extern "C" void kernel_launch(void* const* d_in, const int* in_sizes, int n_in, void* d_out, int out_size, void* d_ws, size_t ws_size, hipStream_t stream) {
    static int grid = 0;
    if (grid == 0) {
        if (n_in != 26 || out_size != NBATCH * SEQ * DM || ws_size < WS_END) { fprintf(stderr, "kernel_launch: unexpected shapes: n_in %d out %d ws %zu (need %zu)\n", n_in, out_size, ws_size, (size_t)WS_END); grid = -1; return; }
        int dev = 0, cus = 0, per_cu = 0;
        if (hipGetDevice(&dev) != hipSuccess || hipDeviceGetAttribute(&cus, hipDeviceAttributeMultiprocessorCount, dev) != hipSuccess) { fprintf(stderr, "kernel_launch: device query failed\n"); grid = -1; return; }
        if (hipFuncSetAttribute((const void*)fwd_kernel, hipFuncAttributeMaxDynamicSharedMemorySize, LDS_BYTES) != hipSuccess) { fprintf(stderr, "kernel_launch: hipFuncSetAttribute failed\n"); grid = -1; return; }
        if (hipOccupancyMaxActiveBlocksPerMultiprocessor(&per_cu, (const void*)fwd_kernel, NTHREADS, LDS_BYTES) != hipSuccess || per_cu < 1) { fprintf(stderr, "kernel_launch: occupancy query says %d blocks per CU\n", per_cu); (void)hipGetLastError(); grid = -1; return; }
        if (cus % 8 != 0) { fprintf(stderr, "kernel_launch: %d CUs: the phase decompositions assume a multiple of 8 workgroups\n", cus); grid = -1; return; }
        grid = cus;
    }
    if (grid < 0) return;
    (void)hipMemsetAsync((char*)d_ws + WS_CTL, 0, CTL_ZERO_BYTES, stream);
    Args a{};
    for (int i = 0; i < 26; ++i) a.in[i] = (const float*)d_in[i];
    a.out = (float*)d_out; a.ws = (unsigned char*)d_ws;
    for (int li = 0; li < N_LAUNCHES; ++li) {
        a.ph_lo = (N_LAUNCHES == 1) ? 0 : li; a.ph_hi = (N_LAUNCHES == 1) ? NPHASES : li + 1;
        hipLaunchKernelGGL(fwd_kernel, dim3(grid), dim3(NTHREADS), LDS_BYTES, stream, a);
        const hipError_t le = hipPeekAtLastError();
        if (le != hipSuccess) { fprintf(stderr, "kernel_launch: launch %d failed: %s\n", li, hipGetErrorName(le)); break; }
    }
}
```

```cpp
#include <hip/hip_runtime.h>
#include <cstdio>
#include <cstdint>
namespace pg8 {
#define PG8_LAS __attribute__((address_space(3)))
typedef unsigned short bf16_t;
typedef short bf16x8 __attribute__((ext_vector_type(8)));
typedef float f32x4 __attribute__((ext_vector_type(4)));
typedef unsigned u32x4 __attribute__((ext_vector_type(4)));
constexpr int BM = 256, BK = 64, HALF = 128, HTB = HALF * BK * 2  , STAGE_BYTES = 8 * HTB, NXCD = 8, WGM = 8;

__host__ __device__ __forceinline__ int lds_byte(int r, int c) { const int st = (r >> 4) * 2 + (c >> 5), rr = r & 15, cc = c & 31, ob = rr * 64 + cc * 2; return st * 1024 + (ob ^ (((ob >> 9) & 1) << 5)); }
__host__ __device__ __forceinline__ void stage_rc(int b, int& R, int& C) { const int st = b / 1024, sb = b % 1024, swz = sb ^ (((sb >> 9) & 1) << 5); R = (st >> 1) * 16 + swz / 64; C = (st & 1) * 32 + (swz % 64) / 2; }
__host__ __device__ __forceinline__ int perm32(int rho) { const int n = rho >> 4, i = rho & 15; return 8 * (i >> 2) + 4 * n + (i & 3); }

struct Unit { int pm, pn; };
struct Gemm { const bf16_t* A; const bf16_t* Bt; int M, N, K, lda, ldb; };

struct StaticOrder {
    int nM, nN, nwg, G, c; bool lat_only;
    __host__ __device__ void init(int M, int N, int G_, int c_, bool lat_only_ = false) { lat_only = lat_only_; nM = lat_only_ ? 32 : M / BM; nN = N / BM; nwg = nM * nN; G = G_; c = c_; }
    __host__ __device__ bool next(int i, Unit& u) const {
        const long L = (long)i * G + c; if (L >= nwg) return false;
        int wgid = (int)L; { const int q = nwg / NXCD, r = nwg % NXCD, xcd = wgid % NXCD, off = wgid / NXCD; wgid = (xcd < r ? xcd * (q + 1) : r * (q + 1) + (xcd - r) * q) + off; }
        const int nig = WGM * nN, gid = wgid / nig, fm = gid * WGM, gsz = (nM - fm) < WGM ? (nM - fm) : WGM;
        u.pm = fm + ((wgid % nig) % gsz); u.pn = (wgid % nig) / gsz; if (lat_only) u.pm += 1 + (u.pm >= 16 ? 1 : 0); return true;
    }
    __device__ __forceinline__ void a_ready(const Unit&) const {}
    __device__ __forceinline__ void done(const Unit&) const {}
};
__device__ __forceinline__ unsigned cvt_pk_bf16(float lo, float hi) { unsigned r; asm volatile("v_cvt_pk_bf16_f32 %0, %1, %2" : "=v"(r) : "v"(lo), "v"(hi)); return r; }
typedef float f32x2 __attribute__((ext_vector_type(2)));
struct EpiBf16 {
    static constexpr bool PERM = true, AFTER_DRAIN = false;
    bf16_t* O; int ldc;
    __device__ __forceinline__ void operator()(const f32x4 (&acc)[2][2][4][2], const Unit& u, int wr, int wc, int fr, int fq) const {
        const int row0 = u.pm * BM + wr * 64 + fr, col0 = u.pn * BM + wc * 32 + 8 * fq;
#pragma unroll
        for (int ai = 0; ai < 2; ++ai)
#pragma unroll
            for (int m = 0; m < 4; ++m) { bf16_t* rowp = O + (size_t)(row0 + ai * HALF + m * 16) * ldc + col0;
#pragma unroll
                for (int bj = 0; bj < 2; ++bj) { const f32x4 v0 = acc[ai][bj][m][0], v1 = acc[ai][bj][m][1];
                    u32x4 w; w.x = cvt_pk_bf16(v0[0], v0[1]); w.y = cvt_pk_bf16(v0[2], v0[3]); w.z = cvt_pk_bf16(v1[0], v1[1]); w.w = cvt_pk_bf16(v1[2], v1[3]);
                    *(u32x4*)(rowp + bj * HALF) = w; } }
    }
};
struct EpiResid {
    static constexpr bool PERM = false, AFTER_DRAIN = false;
    bf16_t* X; int ldc; const float* gate;
    __device__ __forceinline__ void operator()(const f32x4 (&acc)[2][2][4][2], const Unit& u, int wr, int wc, int fr, int fq) const {
        const int row0 = u.pm * BM + wr * 64 + fr, col0 = u.pn * BM + wc * 32 + 4 * fq;
        const int cls = (u.pm % 17 == 0) ? 2 : (u.pm / 17);
        const float* gp = gate + (size_t)cls * 12288 + col0;
        f32x4 gv[2][2];
#pragma unroll
        for (int bj = 0; bj < 2; ++bj)
#pragma unroll
            for (int n = 0; n < 2; ++n) gv[bj][n] = *(const f32x4*)(gp + bj * HALF + n * 16);
#pragma unroll
        for (int ai = 0; ai < 2; ++ai)
#pragma unroll
            for (int m = 0; m < 4; ++m) { bf16_t* rowp = X + (size_t)(row0 + ai * HALF + m * 16) * ldc + col0;
#pragma unroll
                for (int bj = 0; bj < 2; ++bj)
#pragma unroll
                    for (int n = 0; n < 2; ++n) { typedef unsigned u32x2_ __attribute__((ext_vector_type(2))); u32x2_* p = (u32x2_*)(rowp + bj * HALF + n * 16); const u32x2_ w_ = *p;
                        const f32x4 xo_ = {__builtin_bit_cast(float, w_.x << 16), __builtin_bit_cast(float, w_.x & 0xffff0000u), __builtin_bit_cast(float, w_.y << 16), __builtin_bit_cast(float, w_.y & 0xffff0000u)};
                        const f32x4 xn_ = xo_ + gv[bj][n] * acc[ai][bj][m][n]; u32x2_ o_; o_.x = cvt_pk_bf16(xn_[0], xn_[1]); o_.y = cvt_pk_bf16(xn_[2], xn_[3]); *p = o_; } }
    }
};
template <class Epi, class Sched, bool ALIGN_EPI = false, bool SP2 = false>
__device__ __forceinline__ void gemm_phase(PG8_LAS unsigned char* lds, const Gemm g, const Sched& S, const Epi& E, int tid_in) {
    int tid_ = tid_in; asm volatile("" : "+v"(tid_));
    const int tid = tid_, wid = __builtin_amdgcn_readfirstlane(tid >> 6), lane = tid & 63, wr = wid >> 2, wc = wid & 3, fr = lane & 15, fq = lane >> 4;
    const int K = g.K, nt = K / BK;
    unsigned voffA[2], voffB[2];
#pragma unroll
    for (int i = 0; i < 2; ++i) { int R, C; stage_rc(tid * 16 + i * 8192, R, C); const int Rb = Epi::PERM ? ((R & ~31) + perm32(R & 31)) : R;
        voffA[i] = (unsigned)(R * g.lda + C) * 2u; voffB[i] = (unsigned)(Rb * g.ldb + C) * 2u; }
    const size_t kstep = (size_t)(BK * 2);
    const size_t hstepA = (size_t)HALF * g.lda * 2, hstepB = (size_t)HALF * g.ldb * 2;
    const size_t tstepA = 2 * hstepA, tstepB = 2 * hstepB;
    const unsigned ldsw = (unsigned)wid * 1024u;
    const int aoff = lds_byte(wr * 64 + fr, fq * 8), boff = lds_byte(wc * 32 + fr, fq * 8);
#define PG8_SA(b, h) (((b) * 2 + (h)) * HTB)
#define PG8_SB(b, h) ((4 + (b) * 2 + (h)) * HTB)
#define PG8_STAGE(bufoff, gbase, voff) do { _Pragma("unroll") for (int _i = 0; _i < 2; ++_i) \
        __builtin_amdgcn_global_load_lds((const unsigned*)((const char*)(gbase) + (voff)[_i]), (PG8_LAS unsigned*)(lds + (bufoff) + ldsw + _i * 8192), 16, 0, 0); } while (0)
#define PG8_LDA(dst, b, h) do { _Pragma("unroll") for (int m = 0; m < 4; ++m) _Pragma("unroll") for (int k = 0; k < 2; ++k) dst[m][k] = *(const PG8_LAS bf16x8*)(lds + PG8_SA(b, h) + aoff + m * 2048 + k * 1024); } while (0)
#define PG8_LDB(dst, b, h) do { _Pragma("unroll") for (int n = 0; n < 2; ++n) _Pragma("unroll") for (int k = 0; k < 2; ++k) dst[n][k] = *(const PG8_LAS bf16x8*)(lds + PG8_SB(b, h) + boff + n * 2048 + k * 1024); } while (0)
#define PG8_MMA(ai, bj, At, Bt) do { __builtin_amdgcn_s_setprio(1); _Pragma("unroll") for (int m = 0; m < 4; ++m) _Pragma("unroll") for (int n = 0; n < 2; ++n) _Pragma("unroll") for (int k = 0; k < 2; ++k) \
        acc[ai][bj][m][n] = __builtin_amdgcn_mfma_f32_16x16x32_bf16(Bt[n][k], At[m][k], acc[ai][bj][m][n], 0, 0, 0); __builtin_amdgcn_s_setprio(0); } while (0)
#define PG8_WAIT_V(n) asm volatile("s_waitcnt vmcnt(" #n ")" ::: "memory")
#define PG8_WAIT_L(n) asm volatile("s_waitcnt lgkmcnt(" #n ")" ::: "memory")
#define PG8_BAR __builtin_amdgcn_s_barrier()
#define PG8_SCHED __builtin_amdgcn_sched_barrier(0)
    Unit cur, nxt; int ui = 0;
    if (!S.next(0, cur)) return;
    f32x4 acc[2][2][4][2];
#pragma unroll
    for (int a = 0; a < 2; ++a)
#pragma unroll
        for (int b = 0; b < 2; ++b)
#pragma unroll
            for (int m = 0; m < 4; ++m)
#pragma unroll
                for (int n = 0; n < 2; ++n) acc[a][b][m][n] = (f32x4){0.f, 0.f, 0.f, 0.f};
    bf16x8 At[4][2], B0[2][2], B1[2][2];
    const char* cA = (const char*)g.A + (size_t)cur.pm * tstepA; const char* cB = (const char*)g.Bt + (size_t)cur.pn * tstepB;
    S.a_ready(cur);
    if constexpr (SP2) {
        PG8_STAGE(PG8_SB(0, 0), cB, voffB); PG8_STAGE(PG8_SB(0, 1), cB + hstepB, voffB); PG8_STAGE(PG8_SA(0, 0), cA, voffA); PG8_STAGE(PG8_SA(0, 1), cA + hstepA, voffA);
        if (wr == 1) PG8_BAR;
        PG8_WAIT_V(2); PG8_BAR;
        PG8_STAGE(PG8_SB(1, 0), cB + kstep, voffB); PG8_STAGE(PG8_SA(1, 0), cA + kstep, voffA); PG8_STAGE(PG8_SB(1, 1), cB + hstepB + kstep, voffB);
        PG8_WAIT_V(6); PG8_BAR;
    } else {
        PG8_STAGE(PG8_SB(0, 0), cB, voffB); PG8_STAGE(PG8_SA(0, 0), cA, voffA); PG8_STAGE(PG8_SB(0, 1), cB + hstepB, voffB); PG8_STAGE(PG8_SA(0, 1), cA + hstepA, voffA);
        if (wr == 1) PG8_BAR;
        PG8_WAIT_V(4); PG8_BAR;
        PG8_STAGE(PG8_SB(1, 0), cB + kstep, voffB); PG8_STAGE(PG8_SA(1, 0), cA + kstep, voffA); PG8_STAGE(PG8_SB(1, 1), cB + hstepB + kstep, voffB);
        PG8_WAIT_V(6); PG8_BAR;
    }
    for (;;) {
        const bool has_next = S.next(ui + 1, nxt);
        const char* nA = has_next ? (const char*)g.A + (size_t)nxt.pm * tstepA : cA; const char* nB = has_next ? (const char*)g.Bt + (size_t)nxt.pn * tstepB : cB;
        for (int t = 0; t < nt; t += 2) {
            const bool last = (t == nt - 2);
            const char* a1 = cA + (size_t)(t + 1) * kstep;
            const char* a2 = last ? nA : cA + (size_t)(t + 2) * kstep; const char* b2 = last ? nB : cB + (size_t)(t + 2) * kstep;
            const char* a3 = a2 + kstep; const char* b3 = b2 + kstep;
            if (last && has_next) S.a_ready(nxt);
            if constexpr (SP2) {
            PG8_LDB(B0, 0, 0); PG8_LDB(B1, 0, 1); PG8_SCHED; PG8_LDA(At, 0, 0); PG8_STAGE(PG8_SA(1, 1), a1 + hstepA, voffA);
            PG8_WAIT_V(8); PG8_WAIT_L(0); PG8_BAR; PG8_MMA(0, 0, At, B0); PG8_MMA(0, 1, At, B1); PG8_BAR; PG8_SCHED;
            PG8_LDA(At, 0, 1); PG8_STAGE(PG8_SB(0, 0), b2, voffB); PG8_STAGE(PG8_SB(0, 1), b2 + hstepB, voffB); PG8_STAGE(PG8_SA(0, 0), a2, voffA);
            PG8_WAIT_V(8); PG8_WAIT_L(0); PG8_BAR; PG8_MMA(1, 0, At, B0); PG8_MMA(1, 1, At, B1); PG8_BAR; PG8_SCHED;
            PG8_LDB(B0, 1, 0); PG8_LDB(B1, 1, 1); PG8_SCHED; PG8_LDA(At, 1, 0); PG8_STAGE(PG8_SA(0, 1), a2 + hstepA, voffA);
            PG8_WAIT_V(8); PG8_WAIT_L(0); PG8_BAR; PG8_MMA(0, 0, At, B0); PG8_MMA(0, 1, At, B1); PG8_BAR; PG8_SCHED;
            PG8_LDA(At, 1, 1); PG8_STAGE(PG8_SB(1, 0), b3, voffB); PG8_STAGE(PG8_SB(1, 1), b3 + hstepB, voffB); PG8_STAGE(PG8_SA(1, 0), a3, voffA);
            PG8_WAIT_V(8); PG8_WAIT_L(0); PG8_BAR; PG8_MMA(1, 0, At, B0); PG8_MMA(1, 1, At, B1); PG8_BAR; PG8_SCHED;
            } else {
            PG8_LDB(B0, 0, 0); PG8_SCHED; PG8_LDA(At, 0, 0); PG8_STAGE(PG8_SA(1, 1), a1 + hstepA, voffA);
            PG8_WAIT_L(8); PG8_BAR; PG8_WAIT_L(0); PG8_MMA(0, 0, At, B0); PG8_BAR; PG8_SCHED;
            PG8_LDB(B1, 0, 1); PG8_STAGE(PG8_SB(0, 0), b2, voffB);
            PG8_BAR; PG8_WAIT_L(0); PG8_MMA(0, 1, At, B1); PG8_BAR;
            PG8_LDA(At, 0, 1); PG8_STAGE(PG8_SA(0, 0), a2, voffA);
            PG8_BAR; PG8_WAIT_L(0); PG8_MMA(1, 0, At, B0); PG8_BAR; PG8_SCHED;
            PG8_STAGE(PG8_SB(0, 1), b2 + hstepB, voffB);
            PG8_WAIT_V(6); PG8_BAR; PG8_MMA(1, 1, At, B1); PG8_BAR;
            PG8_LDB(B0, 1, 0); PG8_SCHED; PG8_LDA(At, 1, 0); PG8_STAGE(PG8_SA(0, 1), a2 + hstepA, voffA);
            PG8_WAIT_L(8); PG8_BAR; PG8_WAIT_L(0); PG8_MMA(0, 0, At, B0); PG8_BAR; PG8_SCHED;
            PG8_LDB(B1, 1, 1); PG8_STAGE(PG8_SB(1, 0), b3, voffB);
            PG8_BAR; PG8_WAIT_L(0); PG8_MMA(0, 1, At, B1); PG8_BAR;
            PG8_LDA(At, 1, 1); PG8_STAGE(PG8_SA(1, 0), a3, voffA);
            PG8_BAR; PG8_WAIT_L(0); PG8_MMA(1, 0, At, B0); PG8_BAR; PG8_SCHED;
            PG8_STAGE(PG8_SB(1, 1), b3 + hstepB, voffB);
            PG8_WAIT_V(6); PG8_BAR; PG8_MMA(1, 1, At, B1); PG8_BAR;
            }
        }
        if constexpr (ALIGN_EPI) { if (wr == 0) PG8_BAR; }
        if constexpr (!Epi::AFTER_DRAIN) { E(acc, cur, wr, wc, fr, fq); S.done(cur); }
        if (!has_next) break;
#pragma unroll
        for (int a = 0; a < 2; ++a)
#pragma unroll
            for (int b = 0; b < 2; ++b)
#pragma unroll
                for (int m = 0; m < 4; ++m)
#pragma unroll
                    for (int n = 0; n < 2; ++n) acc[a][b][m][n] = (f32x4){0.f, 0.f, 0.f, 0.f};
        cur = nxt; cA = nA; cB = nB; ++ui;
        if constexpr (ALIGN_EPI) { if (wr == 1) PG8_BAR; }
    }
    PG8_WAIT_V(0);
    if constexpr (!ALIGN_EPI) { if (wr == 0) PG8_BAR; }
    PG8_BAR;
    if constexpr (Epi::AFTER_DRAIN) { E.fused(acc, cur, wr, wc, fr, fq, lds, wid, lane); S.done(cur); }
#undef PG8_SA
#undef PG8_SB
#undef PG8_STAGE
#undef PG8_LDA
#undef PG8_LDB
#undef PG8_MMA
#undef PG8_WAIT_V
#undef PG8_WAIT_L
#undef PG8_BAR
#undef PG8_SCHED
}
}
namespace att {
typedef unsigned short bf16_t;
using bf16x8 = __attribute__((ext_vector_type(8))) short;
using s16x4  = __attribute__((ext_vector_type(4))) short;
using f32x16 = __attribute__((ext_vector_type(16))) float;
using u32x4  = __attribute__((ext_vector_type(4))) unsigned;
constexpr int DV = 128, NW = 8, QBLK = 32, KVBLK = 64;
constexpr float THR = 8.f;
constexpr int SHM_V = KVBLK * DV * 2;
template <int DQK> struct Cfg {
    static constexpr int SHM_K = KVBLK * DQK * 2, KROWB = DQK * 2, NCK = DQK / 64, C8 = DQK / 8, ND0 = DQK / 16;
    static constexpr float SCALE = (DQK == 128) ? 0.088388347648318440f : 0.072168783648703220f;
    static constexpr int LDS_BYTES = 2 * SHM_V + 2 * SHM_K + NW * 64 * 4;
};
#define ATT_SBAR() __builtin_amdgcn_sched_barrier(0)
__device__ __forceinline__ int crow(int r, int hi) { return (r & 3) + 8 * (r >> 2) + 4 * hi; }
__device__ __forceinline__ unsigned cvtpk(float lo, float hi) { unsigned r; asm volatile("v_cvt_pk_bf16_f32 %0, %1, %2" : "=v"(r) : "v"(lo), "v"(hi)); return r; }
template <int DQK> __device__ __forceinline__ int kswz(int row, int colB) {
    const int key = (DQK == 128) ? (row & 7) : ((row >> 1) & 7);
    return row * (DQK * 2) + (colB ^ (key << 4));
}
template <int DQK> __device__ __forceinline__ void partialSM(f32x16& p0, f32x16& p1, float& m_reg, float& mn, float& alpha) {
    constexpr float SCALE = Cfg<DQK>::SCALE, C = SCALE * 1.4426950408889634f;
    float pmax = p0[0];
#pragma unroll
    for (int r = 1; r < 16; ++r) pmax = fmaxf(pmax, p0[r]);
#pragma unroll
    for (int r = 0; r < 16; ++r) pmax = fmaxf(pmax, p1[r]);
    { auto rr = __builtin_amdgcn_permlane32_swap(__float_as_uint(pmax), __float_as_uint(pmax), false, false);
      pmax = fmaxf(__uint_as_float(rr[0]), __uint_as_float(rr[1])); }
    if (__builtin_expect(__all(pmax - m_reg <= THR / SCALE), 1)) { mn = m_reg; alpha = 1.f; }
    else { mn = fmaxf(m_reg, pmax); alpha = __builtin_amdgcn_exp2f((m_reg - mn) * C); m_reg = mn; }
    const float mnC = -mn * C;
#pragma unroll
    for (int r = 0; r < 16; ++r) p0[r] = fmaf(p0[r], C, mnC);
#pragma unroll
    for (int r = 0; r < 16; ++r) p1[r] = fmaf(p1[r], C, mnC);
#pragma unroll
    for (int r = 0; r < 16; ++r) p0[r] = __builtin_amdgcn_exp2f(p0[r]);
}
__device__ __forceinline__ void finishSM(f32x16& p0, f32x16& p1, float alpha, float& l_reg, bf16x8& pa0, bf16x8& pa1, bf16x8& pa2, bf16x8& pa3) {
#pragma unroll
    for (int r = 0; r < 16; ++r) p1[r] = __builtin_amdgcn_exp2f(p1[r]);
    float ps = 0;
#pragma unroll
    for (int r = 0; r < 16; ++r) ps += p0[r];
#pragma unroll
    for (int r = 0; r < 16; ++r) ps += p1[r];
    { auto rr = __builtin_amdgcn_permlane32_swap(__float_as_uint(ps), __float_as_uint(ps), false, false);
      ps = __uint_as_float(rr[0]) + __uint_as_float(rr[1]); }
    l_reg = l_reg * alpha + ps;
#define ATT_PK4(P, BASE, OUT) do { unsigned a0 = cvtpk(P[BASE + 0], P[BASE + 1]), a1 = cvtpk(P[BASE + 2], P[BASE + 3]);   \
    unsigned b0 = cvtpk(P[BASE + 4], P[BASE + 5]), b1 = cvtpk(P[BASE + 6], P[BASE + 7]);                              \
    auto r0 = __builtin_amdgcn_permlane32_swap(a0, b0, false, false); auto r1 = __builtin_amdgcn_permlane32_swap(a1, b1, false, false); \
    u32x4 w = {r0[0], r1[0], r0[1], r1[1]}; OUT = *reinterpret_cast<bf16x8*>(&w); } while (0)
    ATT_PK4(p0, 0, pa0); ATT_PK4(p0, 8, pa1); ATT_PK4(p1, 0, pa2); ATT_PK4(p1, 8, pa3);
#undef ATT_PK4
}
template <int DQK> __device__ __forceinline__ void qkt(f32x16& p0, f32x16& p1, const char* Ks, const bf16x8* qr, int r32, int hi) {
    p0 = f32x16{}; p1 = f32x16{};
#pragma unroll
    for (int d0 = 0; d0 < Cfg<DQK>::ND0; ++d0) { const int cb = (d0 * 16 + hi * 8) * 2;
        bf16x8 b0 = *reinterpret_cast<const bf16x8*>(Ks + kswz<DQK>(r32, cb));
        bf16x8 b1 = *reinterpret_cast<const bf16x8*>(Ks + kswz<DQK>(32 + r32, cb));
        p0 = __builtin_amdgcn_mfma_f32_32x32x16_bf16(b0, qr[d0], p0, 0, 0, 0);
        p1 = __builtin_amdgcn_mfma_f32_32x32x16_bf16(b1, qr[d0], p1, 0, 0, 0); }
}
__device__ __forceinline__ int v_st(int k, int c) { const int kk = (k & ~0xC) | ((k & 4) << 1) | ((k & 8) >> 1); return ((kk >> 3) * 4 + (c >> 5)) * 512 + ((kk & 7) * 32 + (c & 31)) * 2; }
__device__ __forceinline__ int v_rd_base(int lane) { return ((lane & 3) << 3) | (((lane >> 2) & 3) << 6) | (((lane >> 4) & 1) << 5) | (((lane >> 5) & 1) << 8); }
constexpr int v_rd_off(int d0, int ks, int half) { return d0 * 512 + ks * 4096 + half * 2048; }
template <int OFF> __device__ __forceinline__ s16x4 tr_read(int vb) {
    s16x4 r; asm volatile("ds_read_b64_tr_b16 %0, %1 offset:%2" : "=&v"(r) : "v"(vb), "i"(OFF) : "memory"); return r;
}
template <int D0> __device__ __forceinline__ void pv_one(f32x16& od, int vb, bf16x8 pa0, bf16x8 pa1, bf16x8 pa2, bf16x8 pa3) {
    const s16x4 l0 = tr_read<v_rd_off(D0, 0, 0)>(vb), h0 = tr_read<v_rd_off(D0, 0, 1)>(vb), l1 = tr_read<v_rd_off(D0, 1, 0)>(vb), h1 = tr_read<v_rd_off(D0, 1, 1)>(vb);
    const s16x4 l2 = tr_read<v_rd_off(D0, 2, 0)>(vb), h2 = tr_read<v_rd_off(D0, 2, 1)>(vb), l3 = tr_read<v_rd_off(D0, 3, 0)>(vb), h3 = tr_read<v_rd_off(D0, 3, 1)>(vb);
    asm volatile("s_waitcnt lgkmcnt(0)" ::: "memory"); ATT_SBAR();
#define ATT_PK(L, H) (bf16x8){L[0], L[1], L[2], L[3], H[0], H[1], H[2], H[3]}
    od = __builtin_amdgcn_mfma_f32_32x32x16_bf16(pa0, ATT_PK(l0, h0), od, 0, 0, 0);
    od = __builtin_amdgcn_mfma_f32_32x32x16_bf16(pa1, ATT_PK(l1, h1), od, 0, 0, 0);
    od = __builtin_amdgcn_mfma_f32_32x32x16_bf16(pa2, ATT_PK(l2, h2), od, 0, 0, 0);
    od = __builtin_amdgcn_mfma_f32_32x32x16_bf16(pa3, ATT_PK(l3, h3), od, 0, 0, 0);
#undef ATT_PK
}
__device__ __forceinline__ void pv_d0(f32x16* o, int vb, bf16x8 pa0, bf16x8 pa1, bf16x8 pa2, bf16x8 pa3) {
    pv_one<0>(o[0], vb, pa0, pa1, pa2, pa3); pv_one<1>(o[1], vb, pa0, pa1, pa2, pa3); pv_one<2>(o[2], vb, pa0, pa1, pa2, pa3); pv_one<3>(o[3], vb, pa0, pa1, pa2, pa3);
}
template <int DQK, int LDQ, int LDK, int LDV, int LDO, int SDEPTH>
__device__ __forceinline__ void attn_body(const bf16_t* __restrict__ Qb, const bf16_t* __restrict__ Kh, const bf16_t* __restrict__ Vh, bf16_t* __restrict__ Ob, int seq, char* lds, int tid_in) {
    using C_ = Cfg<DQK>;
    constexpr int SHM_K = C_::SHM_K, NCK = C_::NCK, C8 = C_::C8, ND0 = C_::ND0;
    int tid_ = tid_in; asm volatile("" : "+v"(tid_));
    const int tid = tid_, wid = tid >> 6, lane = tid & 63, r32 = lane & 31, hi = lane >> 5;
    char* V_lds = lds; char* K_lds = lds + 2 * SHM_V;
    float* ws = (float*)(lds + 2 * SHM_V + 2 * SHM_K) + wid * 64; float* li_l = ws; float* al_l = ws + 32;
    float m_reg = -1e30f, l_reg = 0; f32x16 o[4] = {}; bf16x8 qr[ND0];
    const bf16_t* Qw = Qb + (long)(wid * QBLK + r32) * LDQ + hi * 8;
#pragma unroll
    for (int d0 = 0; d0 < ND0; ++d0) qr[d0] = *reinterpret_cast<const bf16x8*>(Qw + d0 * 16);
    const int sr = tid >> 4, sc = (tid & 15) * 8, vst0 = v_st(sr, sc), vst1 = v_st(32 + sr, sc);
    int krow[NCK], kcol[NCK];
#pragma unroll
    for (int i = 0; i < NCK; ++i) { const int ci = tid + 512 * i; krow[i] = ci / C8; kcol[i] = (ci % C8) * 8; }
    const int vb0 = (int)(uintptr_t)V_lds + v_rd_base(lane);
    struct { bf16x8 vs0, vs1, ks[NCK]; } sr_[SDEPTH];
#define ATT_SLOAD(i, k0) do { sr_[i].vs0 = *reinterpret_cast<const bf16x8*>(&Vh[(long)((k0) + sr) * LDV + sc]); sr_[i].vs1 = *reinterpret_cast<const bf16x8*>(&Vh[(long)((k0) + 32 + sr) * LDV + sc]); \
    _Pragma("unroll") for (int c_ = 0; c_ < NCK; ++c_) sr_[i].ks[c_] = *reinterpret_cast<const bf16x8*>(&Kh[(long)((k0) + krow[c_]) * LDK + kcol[c_]]); } while (0)
#define ATT_SWRITE(b, i) do { *(bf16x8*)(V_lds + (b) * SHM_V + vst0) = sr_[i].vs0; *(bf16x8*)(V_lds + (b) * SHM_V + vst1) = sr_[i].vs1; \
    _Pragma("unroll") for (int c_ = 0; c_ < NCK; ++c_) *(bf16x8*)(K_lds + (b) * SHM_K + kswz<DQK>(krow[c_], kcol[c_] * 2)) = sr_[i].ks[c_]; } while (0)
#define ATT_SWAIT() do { if constexpr (SDEPTH == 2) { if constexpr (NCK == 2) asm volatile("s_waitcnt vmcnt(4)" ::: "memory"); else asm volatile("s_waitcnt vmcnt(5)" ::: "memory"); } else asm volatile("s_waitcnt vmcnt(0)" ::: "memory"); } while (0)
#define ATT_RESC(a) do { if (__any((a) < 1.f)) { if (hi == 0) al_l[r32] = (a); asm volatile("s_waitcnt lgkmcnt(0)" ::: "memory"); \
    _Pragma("unroll") for (int d = 0; d < 4; ++d) _Pragma("unroll") for (int r = 0; r < 16; ++r) o[d][r] *= al_l[crow(r, hi)]; } } while (0)
    f32x16 pA0, pA1, pB0, pB1; float mnA, mnB, alA, alB; bf16x8 pa0, pa1, pa2, pa3; const int NT = seq / KVBLK;
    constexpr int SE = 0, SO = SDEPTH - 1;
    ATT_SLOAD(SE, 0); asm volatile("s_waitcnt vmcnt(0)" ::: "memory"); ATT_SWRITE(0, SE); __syncthreads();
    qkt<DQK>(pA0, pA1, K_lds, qr, r32, hi); partialSM<DQK>(pA0, pA1, m_reg, mnA, alA);
    ATT_SLOAD(SO, KVBLK); if constexpr (SDEPTH == 2) { if (2 < NT) ATT_SLOAD(SE, 2 * KVBLK); }
    ATT_SWAIT(); ATT_SWRITE(1, SO); __syncthreads();
    for (int j = 1; j + 1 < NT; j += 2) {
        ATT_SBAR(); qkt<DQK>(pB0, pB1, K_lds + SHM_K, qr, r32, hi);
        finishSM(pA0, pA1, alA, l_reg, pa0, pa1, pa2, pa3); ATT_SBAR();
        ATT_SLOAD(SO, (j + SDEPTH) * KVBLK); ATT_SBAR();
        pv_d0(o, vb0, pa0, pa1, pa2, pa3); partialSM<DQK>(pB0, pB1, m_reg, mnB, alB);
        __syncthreads(); ATT_SWAIT(); ATT_SWRITE(0, SE);
        ATT_RESC(alB); __syncthreads();
        ATT_SBAR(); qkt<DQK>(pA0, pA1, K_lds, qr, r32, hi);
        finishSM(pB0, pB1, alB, l_reg, pa0, pa1, pa2, pa3); ATT_SBAR();
        if (SDEPTH == 1 || j + 3 < NT) ATT_SLOAD(SE, (j + 1 + SDEPTH) * KVBLK); ATT_SBAR();
        pv_d0(o, vb0 + (int)SHM_V, pa0, pa1, pa2, pa3); partialSM<DQK>(pA0, pA1, m_reg, mnA, alA);
        __syncthreads(); ATT_SWAIT(); ATT_SWRITE(1, SO);
        ATT_RESC(alA); __syncthreads();
    }
    ATT_SBAR(); qkt<DQK>(pB0, pB1, K_lds + SHM_K, qr, r32, hi);
    finishSM(pA0, pA1, alA, l_reg, pa0, pa1, pa2, pa3); ATT_SBAR();
    pv_d0(o, vb0, pa0, pa1, pa2, pa3); partialSM<DQK>(pB0, pB1, m_reg, mnB, alB);
    __syncthreads(); ATT_RESC(alB);
    finishSM(pB0, pB1, alB, l_reg, pa0, pa1, pa2, pa3); ATT_SBAR();
    pv_d0(o, vb0 + (int)SHM_V, pa0, pa1, pa2, pa3);
    if (hi == 0) li_l[r32] = l_reg;
    asm volatile("s_waitcnt lgkmcnt(0)" ::: "memory");
    __syncthreads();
    float rli[16];
#pragma unroll
    for (int r = 0; r < 16; ++r) rli[r] = __builtin_amdgcn_rcpf(li_l[crow(r, hi)]);
    unsigned short* stg = (unsigned short*)(lds + wid * 8192);
#pragma unroll
    for (int r = 0; r < 16; ++r) { const int orow = crow(r, hi);
#pragma unroll
        for (int d0 = 0; d0 < 4; ++d0) { const unsigned w = cvtpk(o[d0][r] * rli[r], 0.f); stg[orow * 128 + d0 * 32 + r32] = (unsigned short)(w & 0xffffu); } }
    asm volatile("s_waitcnt lgkmcnt(0)" ::: "memory");
    bf16_t* Ow = Ob + (long)(wid * QBLK) * LDO;
#pragma unroll
    for (int i = 0; i < 8; ++i) { const int id = lane + 64 * i, row = id >> 4, c16 = id & 15;
        const u32x4 v = *(const u32x4*)((const char*)stg + row * 256 + c16 * 16);
        *(u32x4*)(Ow + (long)row * LDO + c16 * 8) = v; }
    asm volatile("s_waitcnt lgkmcnt(0)" ::: "memory");
    __syncthreads();
#undef ATT_SLOAD
#undef ATT_SWRITE
#undef ATT_SWAIT
#undef ATT_RESC
}

template <int DQK, int LDQ, int LDK, int LDV, int LDO>
__device__ __forceinline__ void attn_body1(const bf16_t* __restrict__ Qb, const bf16_t* __restrict__ Kh, const bf16_t* __restrict__ Vh, bf16_t* __restrict__ Ob, int seq, char* lds, int tid_in) {
    using C_ = Cfg<DQK>;
    constexpr int SHM_K = C_::SHM_K, NCK = C_::NCK, C8 = C_::C8, ND0 = C_::ND0;
    int tid_ = tid_in; asm volatile("" : "+v"(tid_));
    const int tid = tid_, wid = tid >> 6, lane = tid & 63, r32 = lane & 31, hi = lane >> 5;
    char* V_lds = lds; char* K_lds = lds + 2 * SHM_V;
    float* ws = (float*)(lds + 2 * SHM_V + 2 * SHM_K) + wid * 64; float* li_l = ws; float* al_l = ws + 32;
    float m_reg = -1e30f, l_reg = 0; f32x16 o[4] = {}; bf16x8 qr[ND0];
    const bf16_t* Qw = Qb + (long)(wid * QBLK + r32) * LDQ + hi * 8;
#pragma unroll
    for (int d0 = 0; d0 < ND0; ++d0) qr[d0] = *reinterpret_cast<const bf16x8*>(Qw + d0 * 16);
    const int sr = tid >> 4, sc = (tid & 15) * 8, vst0 = v_st(sr, sc), vst1 = v_st(32 + sr, sc);
    int krow[NCK], kcol[NCK];
#pragma unroll
    for (int i = 0; i < NCK; ++i) { const int ci = tid + 512 * i; krow[i] = ci / C8; kcol[i] = (ci % C8) * 8; }
    const int vb0 = (int)(uintptr_t)V_lds + v_rd_base(lane);
    bf16x8 vs0, vs1, ks[NCK];
#define ATT1_SLOAD(k0) do { vs0 = *reinterpret_cast<const bf16x8*>(&Vh[(long)((k0) + sr) * LDV + sc]); vs1 = *reinterpret_cast<const bf16x8*>(&Vh[(long)((k0) + 32 + sr) * LDV + sc]); \
    _Pragma("unroll") for (int c_ = 0; c_ < NCK; ++c_) ks[c_] = *reinterpret_cast<const bf16x8*>(&Kh[(long)((k0) + krow[c_]) * LDK + kcol[c_]]); } while (0)
#define ATT1_SWRITE(b) do { *(bf16x8*)(V_lds + (b) * SHM_V + vst0) = vs0; *(bf16x8*)(V_lds + (b) * SHM_V + vst1) = vs1; \
    _Pragma("unroll") for (int c_ = 0; c_ < NCK; ++c_) *(bf16x8*)(K_lds + (b) * SHM_K + kswz<DQK>(krow[c_], kcol[c_] * 2)) = ks[c_]; } while (0)
    const int NT = seq / KVBLK;
    ATT1_SLOAD(0); asm volatile("s_waitcnt vmcnt(0)" ::: "memory"); ATT1_SWRITE(0); __syncthreads();
    for (int j = 0; j < NT; ++j) {
        const int b = j & 1;
        if (j + 1 < NT) ATT1_SLOAD((j + 1) * KVBLK);
        ATT_SBAR();
        f32x16 p0, p1; float mn, alpha; bf16x8 pa0, pa1, pa2, pa3;
        qkt<DQK>(p0, p1, K_lds + b * SHM_K, qr, r32, hi);
        partialSM<DQK>(p0, p1, m_reg, mn, alpha);
        if (__any(alpha < 1.f)) { if (hi == 0) al_l[r32] = alpha; asm volatile("s_waitcnt lgkmcnt(0)" ::: "memory");
#pragma unroll
            for (int d = 0; d < 4; ++d)
#pragma unroll
                for (int r = 0; r < 16; ++r) o[d][r] *= al_l[crow(r, hi)]; }
        finishSM(p0, p1, alpha, l_reg, pa0, pa1, pa2, pa3); ATT_SBAR();
        pv_d0(o, vb0 + b * (int)SHM_V, pa0, pa1, pa2, pa3);
        if (j + 1 < NT) { ATT1_SWRITE(b ^ 1); }
        __syncthreads();
    }
    if (hi == 0) li_l[r32] = l_reg;
    asm volatile("s_waitcnt lgkmcnt(0)" ::: "memory");
    __syncthreads();
    float rli[16];
#pragma unroll
    for (int r = 0; r < 16; ++r) rli[r] = __builtin_amdgcn_rcpf(li_l[crow(r, hi)]);
    unsigned short* stg = (unsigned short*)(lds + wid * 8192);
#pragma unroll
    for (int r = 0; r < 16; ++r) { const int orow = crow(r, hi);
#pragma unroll
        for (int d0 = 0; d0 < 4; ++d0) { const unsigned w = cvtpk(o[d0][r] * rli[r], 0.f); stg[orow * 128 + d0 * 32 + r32] = (unsigned short)(w & 0xffffu); } }
    asm volatile("s_waitcnt lgkmcnt(0)" ::: "memory");
    bf16_t* Ow = Ob + (long)(wid * QBLK) * LDO;
#pragma unroll
    for (int i = 0; i < 8; ++i) { const int id = lane + 64 * i, row = id >> 4, c16 = id & 15;
        const u32x4 v = *(const u32x4*)((const char*)stg + row * 256 + c16 * 16);
        *(u32x4*)(Ow + (long)row * LDO + c16 * 8) = v; }
    asm volatile("s_waitcnt lgkmcnt(0)" ::: "memory");
    __syncthreads();
#undef ATT1_SLOAD
#undef ATT1_SWRITE
}
template <int DQK, int LDQ, int LDK, int LDV, int LDO>
__device__ __forceinline__ void attn_body1g(const bf16_t* __restrict__ Qb, const bf16_t* __restrict__ Kh, const bf16_t* __restrict__ Vh, bf16_t* __restrict__ Ob, int seq, char* lds, int tid_in) {
    using C_ = Cfg<DQK>;
    constexpr int SHM_K = C_::SHM_K, NCK = C_::NCK, ND0 = C_::ND0, KROWB = C_::KROWB;
    typedef __attribute__((address_space(3))) unsigned l3u;
    int tid_ = tid_in; asm volatile("" : "+v"(tid_));
    const int tid = tid_, wid = tid >> 6, lane = tid & 63, r32 = lane & 31, hi = lane >> 5;
    const int widu = __builtin_amdgcn_readfirstlane(wid);
    char* V_lds = lds; char* K_lds = lds + 3 * SHM_V;
    __attribute__((address_space(3))) char* l3 = (__attribute__((address_space(3))) char*)lds;
    float* ws = (float*)(lds + 3 * SHM_V + 3 * SHM_K) + wid * 64; float* li_l = ws; float* al_l = ws + 32;
    float m_reg = -1e30f, l_reg = 0; f32x16 o[4] = {}; bf16x8 qr[ND0];
    const bf16_t* Qw = Qb + (long)(wid * QBLK + r32) * LDQ + hi * 8;
#pragma unroll
    for (int d0 = 0; d0 < ND0; ++d0) qr[d0] = *reinterpret_cast<const bf16x8*>(Qw + d0 * 16);
    int koff[NCK], voff[2];
#pragma unroll
    for (int i = 0; i < NCK; ++i) { const int ob = (wid + 8 * i) * 1024 + 16 * lane, row = ob / KROWB, pos = (ob - row * KROWB) >> 4;
        const int key = (DQK == 128) ? (row & 7) : ((row >> 1) & 7); koff[i] = row * LDK + ((pos ^ key) << 3); }
#pragma unroll
    for (int i = 0; i < 2; ++i) { const int ob = (wid + 8 * i) * 1024 + 16 * lane, st = ob >> 9, r = ob & 511, kk = (st >> 2) * 8 + (r >> 6), c = (st & 3) * 32 + ((r & 63) >> 1);
        const int k = (kk & ~0xC) | ((kk & 4) << 1) | ((kk & 8) >> 1); voff[i] = k * LDV + c; }
    const int vb0 = (int)(uintptr_t)V_lds + v_rd_base(lane);
    const int NT = seq / KVBLK;
#define ATT1G_ISSUE(jt, b) do { const int jc_ = (jt) < NT ? (jt) : NT - 1; const bf16_t* kp_ = Kh + (long)jc_ * KVBLK * LDK; const bf16_t* vp_ = Vh + (long)jc_ * KVBLK * LDV; \
    _Pragma("unroll") for (int i_ = 0; i_ < NCK; ++i_) __builtin_amdgcn_global_load_lds((const unsigned*)(kp_ + koff[i_]), (l3u*)(l3 + 3 * SHM_V + (b) * SHM_K + (widu + 8 * i_) * 1024), 16, 0, 0); \
    _Pragma("unroll") for (int i_ = 0; i_ < 2; ++i_) __builtin_amdgcn_global_load_lds((const unsigned*)(vp_ + voff[i_]), (l3u*)(l3 + (b) * SHM_V + (widu + 8 * i_) * 1024), 16, 0, 0); } while (0)
    ATT1G_ISSUE(0, 0); ATT1G_ISSUE(1, 1);
    asm volatile("s_waitcnt vmcnt(%0)" :: "n"(NCK + 2) : "memory");
    __builtin_amdgcn_s_barrier(); ATT_SBAR();
    int b = 0, b2 = 2;
    for (int j = 0; j < NT; ++j) {
        ATT1G_ISSUE(j + 2, b2);
        ATT_SBAR();
        f32x16 p0, p1; float mn, alpha; bf16x8 pa0, pa1, pa2, pa3;
        qkt<DQK>(p0, p1, K_lds + b * SHM_K, qr, r32, hi);
        partialSM<DQK>(p0, p1, m_reg, mn, alpha);
        if (__any(alpha < 1.f)) { if (hi == 0) al_l[r32] = alpha; asm volatile("s_waitcnt lgkmcnt(0)" ::: "memory");
#pragma unroll
            for (int d = 0; d < 4; ++d)
#pragma unroll
                for (int r = 0; r < 16; ++r) o[d][r] *= al_l[crow(r, hi)]; }
        finishSM(p0, p1, alpha, l_reg, pa0, pa1, pa2, pa3); ATT_SBAR();
        pv_d0(o, vb0 + b * (int)SHM_V, pa0, pa1, pa2, pa3);
        asm volatile("s_waitcnt vmcnt(%0) lgkmcnt(0)" :: "n"(NCK + 2) : "memory");
        __builtin_amdgcn_s_barrier(); ATT_SBAR();
        b = (b == 2) ? 0 : b + 1; b2 = (b2 == 2) ? 0 : b2 + 1;
    }
    asm volatile("s_waitcnt vmcnt(0)" ::: "memory");
    if (hi == 0) li_l[r32] = l_reg;
    asm volatile("s_waitcnt lgkmcnt(0)" ::: "memory");
    __syncthreads();
    float rli[16];
#pragma unroll
    for (int r = 0; r < 16; ++r) rli[r] = __builtin_amdgcn_rcpf(li_l[crow(r, hi)]);
    unsigned short* stg = (unsigned short*)(lds + wid * 8192);
#pragma unroll
    for (int r = 0; r < 16; ++r) { const int orow = crow(r, hi);
#pragma unroll
        for (int d0 = 0; d0 < 4; ++d0) { const unsigned w = cvtpk(o[d0][r] * rli[r], 0.f); stg[orow * 128 + d0 * 32 + r32] = (unsigned short)(w & 0xffffu); } }
    asm volatile("s_waitcnt lgkmcnt(0)" ::: "memory");
    bf16_t* Ow = Ob + (long)(wid * QBLK) * LDO;
#pragma unroll
    for (int i = 0; i < 8; ++i) { const int id = lane + 64 * i, row = id >> 4, c16 = id & 15;
        const u32x4 v = *(const u32x4*)((const char*)stg + row * 256 + c16 * 16);
        *(u32x4*)(Ow + (long)row * LDO + c16 * 8) = v; }
    asm volatile("s_waitcnt lgkmcnt(0)" ::: "memory");
    __syncthreads();
#undef ATT1G_ISSUE
}
template <int DQK, int LDQ, int LDK, int LDV, int LDO>
__device__ __forceinline__ void attn_body2g(const bf16_t* __restrict__ Qb, const bf16_t* __restrict__ Kh, const bf16_t* __restrict__ Vh, bf16_t* __restrict__ Ob, int seq, char* lds, int tid_in) {
    using C_ = Cfg<DQK>;
    constexpr int SHM_K = C_::SHM_K, NCK = C_::NCK, ND0 = C_::ND0, KROWB = C_::KROWB;
    typedef __attribute__((address_space(3))) unsigned l3u;
    int tid_ = tid_in; asm volatile("" : "+v"(tid_));
    const int tid = tid_, wid = tid >> 6, lane = tid & 63, r32 = lane & 31, hi = lane >> 5;
    const int widu = __builtin_amdgcn_readfirstlane(wid);
    char* V_lds = lds; char* K_lds = lds + 3 * SHM_V;
    __attribute__((address_space(3))) char* l3 = (__attribute__((address_space(3))) char*)lds;
    float* ws = (float*)(lds + 3 * SHM_V + 3 * SHM_K) + wid * 64; float* li_l = ws; float* al_l = ws + 32;
    float m_reg = -1e30f, l_reg = 0; f32x16 o[4] = {}; bf16x8 qr[ND0];
    const bf16_t* Qw = Qb + (long)(wid * QBLK + r32) * LDQ + hi * 8;
#pragma unroll
    for (int d0 = 0; d0 < ND0; ++d0) qr[d0] = *reinterpret_cast<const bf16x8*>(Qw + d0 * 16);
    int koff[NCK], voff[2];
#pragma unroll
    for (int i = 0; i < NCK; ++i) { const int ob = (wid + 8 * i) * 1024 + 16 * lane, row = ob / KROWB, pos = (ob - row * KROWB) >> 4;
        const int key = (DQK == 128) ? (row & 7) : ((row >> 1) & 7); koff[i] = row * LDK + ((pos ^ key) << 3); }
#pragma unroll
    for (int i = 0; i < 2; ++i) { const int ob = (wid + 8 * i) * 1024 + 16 * lane, st = ob >> 9, r = ob & 511, kk = (st >> 2) * 8 + (r >> 6), c = (st & 3) * 32 + ((r & 63) >> 1);
        const int k = (kk & ~0xC) | ((kk & 4) << 1) | ((kk & 8) >> 1); voff[i] = k * LDV + c; }
    const int vb0 = (int)(uintptr_t)V_lds + v_rd_base(lane);
    const int NT = seq / KVBLK;
#define ATT2G_K(jt, b) do { const int jc_ = (jt) < NT ? (jt) : NT - 1; const bf16_t* kp_ = Kh + (long)jc_ * KVBLK * LDK; \
    _Pragma("unroll") for (int i_ = 0; i_ < NCK; ++i_) __builtin_amdgcn_global_load_lds((const unsigned*)(kp_ + koff[i_]), (l3u*)(l3 + 3 * SHM_V + (b) * SHM_K + (widu + 8 * i_) * 1024), 16, 0, 0); } while (0)
#define ATT2G_V(jt, b) do { const int jc_ = (jt) < NT ? (jt) : NT - 1; const bf16_t* vp_ = Vh + (long)jc_ * KVBLK * LDV; \
    _Pragma("unroll") for (int i_ = 0; i_ < 2; ++i_) __builtin_amdgcn_global_load_lds((const unsigned*)(vp_ + voff[i_]), (l3u*)(l3 + (b) * SHM_V + (widu + 8 * i_) * 1024), 16, 0, 0); } while (0)
#define ATT2G_RESC(a) do { if (__any((a) < 1.f)) { if (hi == 0) al_l[r32] = (a); asm volatile("s_waitcnt lgkmcnt(0)" ::: "memory"); \
    _Pragma("unroll") for (int d = 0; d < 4; ++d) _Pragma("unroll") for (int r = 0; r < 16; ++r) o[d][r] *= al_l[crow(r, hi)]; } } while (0)
#define ATT2G_SYNC() do { asm volatile("s_waitcnt vmcnt(%0) lgkmcnt(0)" :: "n"(NCK + 2) : "memory"); __builtin_amdgcn_s_barrier(); ATT_SBAR(); } while (0)
#define ATT2G_STEP(PC0, PC1, PP0, PP1, ALP, ALC, MNC) do { \
        ATT2G_K(j + 2, k2); ATT2G_V(j + 1, v1); ATT_SBAR(); \
        qkt<DQK>(PC0, PC1, K_lds + kc * SHM_K, qr, r32, hi); \
        finishSM(PP0, PP1, ALP, l_reg, pa0, pa1, pa2, pa3); ATT_SBAR(); \
        pv_d0(o, vb0 + vp * (int)SHM_V, pa0, pa1, pa2, pa3); partialSM<DQK>(PC0, PC1, m_reg, MNC, ALC); \
        ATT2G_SYNC(); ATT2G_RESC(ALC); \
        kc = (kc == 2) ? 0 : kc + 1; k2 = (k2 == 2) ? 0 : k2 + 1; vp = (vp == 2) ? 0 : vp + 1; v1 = (v1 == 2) ? 0 : v1 + 1; ++j; } while (0)
    f32x16 pA0, pA1, pB0, pB1; float mnA, mnB, alA, alB; bf16x8 pa0, pa1, pa2, pa3;
    ATT2G_K(0, 0); ATT2G_V(0, 0); ATT2G_K(1, 1);
    ATT2G_K(2, 2); ATT2G_V(1, 1);
    ATT2G_SYNC();
    qkt<DQK>(pA0, pA1, K_lds, qr, r32, hi); partialSM<DQK>(pA0, pA1, m_reg, mnA, alA);
    asm volatile("s_waitcnt lgkmcnt(0)" ::: "memory"); __builtin_amdgcn_s_barrier(); ATT_SBAR();
    int j = 1, kc = 1, k2 = 0, vp = 0, v1 = 2;
    while (j + 1 < NT) {
        ATT2G_STEP(pB0, pB1, pA0, pA1, alA, alB, mnB);
        ATT2G_STEP(pA0, pA1, pB0, pB1, alB, alA, mnA);
    }
    ATT2G_STEP(pB0, pB1, pA0, pA1, alA, alB, mnB);
    finishSM(pB0, pB1, alB, l_reg, pa0, pa1, pa2, pa3); ATT_SBAR();
    pv_d0(o, vb0 + vp * (int)SHM_V, pa0, pa1, pa2, pa3);
    asm volatile("s_waitcnt vmcnt(0)" ::: "memory");
    if (hi == 0) li_l[r32] = l_reg;
    asm volatile("s_waitcnt lgkmcnt(0)" ::: "memory");
    __syncthreads();
    float rli[16];
#pragma unroll
    for (int r = 0; r < 16; ++r) rli[r] = __builtin_amdgcn_rcpf(li_l[crow(r, hi)]);
    unsigned short* stg = (unsigned short*)(lds + wid * 8192);
#pragma unroll
    for (int r = 0; r < 16; ++r) { const int orow = crow(r, hi);
#pragma unroll
        for (int d0 = 0; d0 < 4; ++d0) { const unsigned w = cvtpk(o[d0][r] * rli[r], 0.f); stg[orow * 128 + d0 * 32 + r32] = (unsigned short)(w & 0xffffu); } }
    asm volatile("s_waitcnt lgkmcnt(0)" ::: "memory");
    bf16_t* Ow = Ob + (long)(wid * QBLK) * LDO;
#pragma unroll
    for (int i = 0; i < 8; ++i) { const int id = lane + 64 * i, row = id >> 4, c16 = id & 15;
        const u32x4 v = *(const u32x4*)((const char*)stg + row * 256 + c16 * 16);
        *(u32x4*)(Ow + (long)row * LDO + c16 * 8) = v; }
    asm volatile("s_waitcnt lgkmcnt(0)" ::: "memory");
    __syncthreads();
#undef ATT2G_STEP
#undef ATT2G_SYNC
#undef ATT2G_RESC
#undef ATT2G_V
#undef ATT2G_K
}
template <int DQK, int LDQ, int LDK, int LDV, int LDO>
__device__ __forceinline__ void attn_body1s(const bf16_t* __restrict__ Qb, const bf16_t* __restrict__ Kh, const bf16_t* __restrict__ Vh, bf16_t* __restrict__ Ob, int seq, char* lds, int tid_in) {
    using C_ = Cfg<DQK>;
    constexpr int SHM_K = C_::SHM_K, NCK = C_::NCK, C8 = C_::C8, ND0 = C_::ND0;
    int tid_ = tid_in; asm volatile("" : "+v"(tid_));
    const bool grpB = __builtin_amdgcn_readfirstlane(tid_ >> 16) != 0;
    const int tid = tid_ & 0xffff, wid = tid >> 6, lane = tid & 63, r32 = lane & 31, hi = lane >> 5;
    char* V_lds = lds; char* K_lds = lds + 2 * SHM_V;
    float* ws = (float*)(lds + 2 * SHM_V + 2 * SHM_K) + wid * 64; float* li_l = ws; float* al_l = ws + 32;
    float m_reg = -1e30f, l_reg = 0; f32x16 o[4] = {}; bf16x8 qr[ND0];
    const bf16_t* Qw = Qb + (long)(wid * QBLK + r32) * LDQ + hi * 8;
#pragma unroll
    for (int d0 = 0; d0 < ND0; ++d0) qr[d0] = *reinterpret_cast<const bf16x8*>(Qw + d0 * 16);
    const int sr = tid >> 4, sc = (tid & 15) * 8, vst0 = v_st(sr, sc), vst1 = v_st(32 + sr, sc);
    int krow[NCK], kcol[NCK];
#pragma unroll
    for (int i = 0; i < NCK; ++i) { const int ci = tid + 512 * i; krow[i] = ci / C8; kcol[i] = (ci % C8) * 8; }
    const int vb0 = (int)(uintptr_t)V_lds + v_rd_base(lane);
    bf16x8 vs0, vs1, ks[NCK];
#define ATT1_SLOAD(k0) do { vs0 = *reinterpret_cast<const bf16x8*>(&Vh[(long)((k0) + sr) * LDV + sc]); vs1 = *reinterpret_cast<const bf16x8*>(&Vh[(long)((k0) + 32 + sr) * LDV + sc]); \
    _Pragma("unroll") for (int c_ = 0; c_ < NCK; ++c_) ks[c_] = *reinterpret_cast<const bf16x8*>(&Kh[(long)((k0) + krow[c_]) * LDK + kcol[c_]]); } while (0)
#define ATT1_SWRITE(b) do { *(bf16x8*)(V_lds + (b) * SHM_V + vst0) = vs0; *(bf16x8*)(V_lds + (b) * SHM_V + vst1) = vs1; \
    _Pragma("unroll") for (int c_ = 0; c_ < NCK; ++c_) *(bf16x8*)(K_lds + (b) * SHM_K + kswz<DQK>(krow[c_], kcol[c_] * 2)) = ks[c_]; } while (0)
    const int NT = seq / KVBLK;
    ATT1_SLOAD(0); asm volatile("s_waitcnt vmcnt(0)" ::: "memory"); ATT1_SWRITE(0); __syncthreads();
#define ATT1_SM(P0, P1, PA0, PA1, PA2, PA3) do { float mn, alpha; partialSM<DQK>(P0, P1, m_reg, mn, alpha); \
        if (__any(alpha < 1.f)) { if (hi == 0) al_l[r32] = alpha; asm volatile("s_waitcnt lgkmcnt(0)" ::: "memory"); \
            _Pragma("unroll") for (int d = 0; d < 4; ++d) _Pragma("unroll") for (int r = 0; r < 16; ++r) o[d][r] *= al_l[crow(r, hi)]; } \
        finishSM(P0, P1, alpha, l_reg, PA0, PA1, PA2, PA3); ATT_SBAR(); } while (0)
    if (!grpB) {
        for (int j = 0; j < NT; ++j) {
            const int b = j & 1;
            if (j + 1 < NT) ATT1_SLOAD((j + 1) * KVBLK);
            ATT_SBAR();
            f32x16 p0, p1; bf16x8 pa0, pa1, pa2, pa3;
            qkt<DQK>(p0, p1, K_lds + b * SHM_K, qr, r32, hi);
            __syncthreads();
            ATT1_SM(p0, p1, pa0, pa1, pa2, pa3);
            pv_d0(o, vb0 + b * (int)SHM_V, pa0, pa1, pa2, pa3);
            if (j + 1 < NT) { ATT1_SWRITE(b ^ 1); }
            __syncthreads();
        }
    } else {
        bf16x8 pa0, pa1, pa2, pa3;
        {
            if (1 < NT) ATT1_SLOAD(KVBLK);
            ATT_SBAR();
            __syncthreads();
            f32x16 p0, p1;
            qkt<DQK>(p0, p1, K_lds, qr, r32, hi);
            ATT1_SM(p0, p1, pa0, pa1, pa2, pa3);
            if (1 < NT) { ATT1_SWRITE(1); }
            __syncthreads();
        }
        for (int j = 1; j < NT; ++j) {
            const int b = j & 1;
            if (j + 1 < NT) ATT1_SLOAD((j + 1) * KVBLK);
            ATT_SBAR();
            pv_d0(o, vb0 + (b ^ 1) * (int)SHM_V, pa0, pa1, pa2, pa3);
            __syncthreads();
            f32x16 p0, p1;
            qkt<DQK>(p0, p1, K_lds + b * SHM_K, qr, r32, hi);
            ATT1_SM(p0, p1, pa0, pa1, pa2, pa3);
            if (j + 1 < NT) { ATT1_SWRITE(b ^ 1); }
            __syncthreads();
        }
        pv_d0(o, vb0 + ((NT - 1) & 1) * (int)SHM_V, pa0, pa1, pa2, pa3);
    }
#undef ATT1_SM
    if (hi == 0) li_l[r32] = l_reg;
    asm volatile("s_waitcnt lgkmcnt(0)" ::: "memory");
    __syncthreads();
    float rli[16];
#pragma unroll
    for (int r = 0; r < 16; ++r) rli[r] = __builtin_amdgcn_rcpf(li_l[crow(r, hi)]);
    unsigned short* stg = (unsigned short*)(lds + wid * 8192);
#pragma unroll
    for (int r = 0; r < 16; ++r) { const int orow = crow(r, hi);
#pragma unroll
        for (int d0 = 0; d0 < 4; ++d0) { const unsigned w = cvtpk(o[d0][r] * rli[r], 0.f); stg[orow * 128 + d0 * 32 + r32] = (unsigned short)(w & 0xffffu); } }
    asm volatile("s_waitcnt lgkmcnt(0)" ::: "memory");
    bf16_t* Ow = Ob + (long)(wid * QBLK) * LDO;
#pragma unroll
    for (int i = 0; i < 8; ++i) { const int id = lane + 64 * i, row = id >> 4, c16 = id & 15;
        const u32x4 v = *(const u32x4*)((const char*)stg + row * 256 + c16 * 16);
        *(u32x4*)(Ow + (long)row * LDO + c16 * 8) = v; }
    asm volatile("s_waitcnt lgkmcnt(0)" ::: "memory");
    __syncthreads();
#undef ATT1_SLOAD
#undef ATT1_SWRITE
}
}
constexpr int DM = 2048, NBATCH = 2, SEQ = 4096, CTX = 256, RB = SEQ + CTX  , MROWS = NBATCH * RB  ;
constexpr int NMOD = 6 * DM, NEXP = 16384;
constexpr float EPS = 1e-6f;
constexpr int NWAVES = 8, NTHREADS = 512;
constexpr size_t MiB = 1u << 20;
constexpr size_t WS_CTL = 0, CTL_ZERO_BYTES = 64 * 1024;
constexpr size_t WS_MOD = 1 * MiB;
constexpr size_t WS_ROPE = 2 * MiB;
constexpr size_t WS_SMALL = 3 * MiB;
constexpr int SM_N1G = 0, SM_N2G = 8192, SM_AQG = 16384, SM_AKG = 16384 + 384, SM_CW = 16384 + 768, SM_CB = SM_CW + 6144, SM_CQG = SM_CB + 2048, SM_CKG = SM_CQG + 256, SM_END = SM_CKG + 256;
constexpr size_t WS_PTRS = 3 * MiB + 512 * 1024;
constexpr size_t WS_XW = 4 * MiB;
constexpr size_t WS_H = 72 * MiB;
constexpr size_t WS_P = 106 * MiB;
constexpr size_t WS_QRAW = 174 * MiB;
constexpr size_t WS_KVRAW = 200 * MiB;
constexpr size_t WS_Q = 234 * MiB;
constexpr size_t WS_K = 268 * MiB;
constexpr size_t WS_V = 294 * MiB;
constexpr size_t WS_CAT = 311 * MiB;
constexpr size_t WS_PQ = 345 * MiB;
constexpr size_t WS_IDX = 379 * MiB;
constexpr size_t WS_GATE = 384 * MiB;
constexpr size_t WS_WIN = 389 * MiB;
constexpr size_t WS_WUQ = 421 * MiB;
constexpr size_t WS_WUKV = 424 * MiB;
constexpr size_t WS_WEO = 426 * MiB;
constexpr size_t WS_WQKV = 442 * MiB;
constexpr size_t WS_WCO = 466 * MiB;
constexpr size_t WS_WPQ = 482 * MiB;
constexpr size_t WS_SUBK = 514 * MiB;
#ifndef TAB_FP4
#define TAB_FP4 1
#endif
#if TAB_FP4
constexpr int ROWB = 1024;
#else
constexpr int ROWB = 1536;
#endif
constexpr size_t WS_U = 516 * MiB;
constexpr size_t WS_VT = 644 * MiB;
constexpr size_t WS_USC = 772 * MiB;
constexpr size_t WS_VSC = 773 * MiB;
constexpr size_t WS_XQ = 810 * MiB;
constexpr size_t WS_XS = 828 * MiB;
constexpr size_t WS_WQ8 = 834 * MiB;
constexpr size_t WS_WSC = 836 * MiB;
constexpr size_t WS_PART = 774 * MiB;
constexpr size_t WS_END = 837 * MiB;
#ifndef EXP_SLICED
#define EXP_SLICED 1
#endif
#ifndef PEER_MFMA
#define PEER_MFMA 1
#endif
#ifndef PEER_VMFMA
#define PEER_VMFMA 1
#endif
constexpr int CW_BAR = 4096;
constexpr int LDS_MISC = 131072 + 8192;
constexpr int LDS_BYTES = 147456;

#define LAS __attribute__((address_space(3)))
typedef unsigned short bf16_t;
typedef float f32x4 __attribute__((ext_vector_type(4)));
typedef unsigned u32x4 __attribute__((ext_vector_type(4)));
typedef unsigned u32x2 __attribute__((ext_vector_type(2)));
typedef short bf16x8 __attribute__((ext_vector_type(8)));
typedef float f32x16 __attribute__((ext_vector_type(16)));
typedef __bf16 bf16x2_t __attribute__((ext_vector_type(2)));
typedef float f32x2 __attribute__((ext_vector_type(2)));
typedef _Float16 h2_t __attribute__((ext_vector_type(2)));
typedef float f32x32 __attribute__((ext_vector_type(32)));
typedef unsigned u32x6 __attribute__((ext_vector_type(6)));

__device__ __forceinline__ unsigned f2bf(float f) { unsigned u = __builtin_bit_cast(unsigned, f); return (u + 0x7fffu + ((u >> 16) & 1u)) >> 16; }
__device__ __forceinline__ unsigned pk2(float lo, float hi) { return f2bf(lo) | (f2bf(hi) << 16); }
__device__ __forceinline__ float bf_lo(unsigned w) { return __builtin_bit_cast(float, w << 16); }
__device__ __forceinline__ float bf_hi(unsigned w) { return __builtin_bit_cast(float, w & 0xffff0000u); }
__device__ __forceinline__ float bf2f(bf16_t h) { return __builtin_bit_cast(float, (unsigned)h << 16); }
__device__ __forceinline__ float wave_sum(float v) {
#pragma unroll
    for (int o = 1; o < 64; o <<= 1) v += __shfl_xor(v, o);
    return v;
}
#define DPP_ADD(v, ctrl) ((v) + __builtin_bit_cast(float, __builtin_amdgcn_update_dpp(0, __builtin_bit_cast(int, (v)), (ctrl), 0xf, 0xf, true)))
__device__ __forceinline__ float wave_sum_dpp(float v) {
    v = DPP_ADD(v, 0xB1);
    v = DPP_ADD(v, 0x4E);
    v = DPP_ADD(v, 0x141);
    v = DPP_ADD(v, 0x140);
    const int vi = __builtin_bit_cast(int, v);
    const float s0 = __builtin_bit_cast(float, __builtin_amdgcn_readlane(vi, 0)), s1 = __builtin_bit_cast(float, __builtin_amdgcn_readlane(vi, 16));
    const float s2 = __builtin_bit_cast(float, __builtin_amdgcn_readlane(vi, 32)), s3 = __builtin_bit_cast(float, __builtin_amdgcn_readlane(vi, 48));
    return (s0 + s1) + (s2 + s3);
}
#define DPP_MOV(v, ctrl) __builtin_bit_cast(float, __builtin_amdgcn_update_dpp(0, __builtin_bit_cast(int, (v)), (ctrl), 0xf, 0xf, true))
__device__ __forceinline__ float wave_max_dpp(float v) {
    v = fmaxf(v, DPP_MOV(v, 0xB1)); v = fmaxf(v, DPP_MOV(v, 0x4E)); v = fmaxf(v, DPP_MOV(v, 0x141)); v = fmaxf(v, DPP_MOV(v, 0x140));
    const int vi = __builtin_bit_cast(int, v);
    return fmaxf(fmaxf(__builtin_bit_cast(float, __builtin_amdgcn_readlane(vi, 0)), __builtin_bit_cast(float, __builtin_amdgcn_readlane(vi, 16))),
                 fmaxf(__builtin_bit_cast(float, __builtin_amdgcn_readlane(vi, 32)), __builtin_bit_cast(float, __builtin_amdgcn_readlane(vi, 48))));
}
__device__ __forceinline__ float dot2_bf16(unsigned w, unsigned x, float acc) { return __builtin_amdgcn_fdot2_f32_bf16(__builtin_bit_cast(bf16x2_t, w), __builtin_bit_cast(bf16x2_t, x), acc, false); }
__device__ __forceinline__ float gelu_erf(float v) {
    const float av = fabsf(v), t = __builtin_amdgcn_rcpf(av * 0.2316418882f + 1.0f);
    float q = t * 0.5307027145f + (-0.7265760135f); q = q * t + 0.7107068705f; q = q * t + (-0.142248368f); q = q * t + 0.127414796f; q = q * t;
    const float e = __builtin_amdgcn_exp2f((v * v) * (-0.72134752044f));
    const float m = v * (q * e);
    return v < 0.f ? m : v - m;
}
#define XB_TMO      128
#define XB_XCNT(j)  (256  + 64 * (j))
#define XB_XSUB(j)  (1280 + 64 * (j))
#define XB_XGEN(j)  (2304 + 64 * (j))
#define XB_TOP      3328
#define XB_TOPGEN   3392
#define XCD_BAR_WORDS 3456
#define XB_SPIN_CAP (1u << 18)

__device__ __forceinline__ unsigned xb_ld(unsigned* p)              { return __hip_atomic_load(p, __ATOMIC_RELAXED, __HIP_MEMORY_SCOPE_AGENT); }
__device__ __forceinline__ unsigned xb_add(unsigned* p, unsigned v) { return __hip_atomic_fetch_add(p, v, __ATOMIC_RELAXED, __HIP_MEMORY_SCOPE_AGENT); }
__device__ __forceinline__ unsigned xb_xcc_id() { return (unsigned)__builtin_amdgcn_s_getreg((3 << 11) | 20) & 0xFu; }
#define XB_SPIN(cond, bar) do { unsigned _sp = 0; while (cond) { __builtin_amdgcn_s_sleep(1); \
    if ((++_sp & 255u) == 0u) { if (xb_ld(&(bar)[XB_TMO])) break; if (_sp > XB_SPIN_CAP) { atomicAdd(&(bar)[XB_TMO], 1u); break; } } } } while (0)

struct XcdBarrier {
    unsigned* bar; unsigned x;
    volatile LAS unsigned* st;
};

__device__ __forceinline__ XcdBarrier xcd_barrier_post(unsigned* bar, volatile LAS unsigned* st) {
    XcdBarrier b; b.bar = bar; b.x = xb_xcc_id(); b.st = st;
    if (threadIdx.x == 0) (void)xb_add(&bar[XB_XCNT(b.x)], 1u);
    return b;
}
__device__ __forceinline__ void xcd_barrier_complete(unsigned* bar, unsigned x, unsigned& nloc, unsigned& nx) {
    const unsigned G = gridDim.x * gridDim.y * gridDim.z;
    unsigned sum, cnt, mine, sp = 0u;
    for (;;) {
        sum = 0u; cnt = 0u; mine = 0u;
#pragma unroll
        for (unsigned j = 0; j < 16; ++j) { const unsigned c = xb_ld(&bar[XB_XCNT(j)]); sum += c; cnt += (c > 0u) ? 1u : 0u; mine = (j == x) ? c : mine; }
        if (sum == G) break;
        __builtin_amdgcn_s_sleep(1);
        if ((++sp & 255u) == 0u) { if (xb_ld(&bar[XB_TMO])) break; if (sp > XB_SPIN_CAP) { atomicAdd(&bar[XB_TMO], 1u); break; } }
    }
    nloc = mine > 0u ? mine : 1u; nx = cnt > 0u ? cnt : 1u;
}

__device__ __forceinline__ void xcd_barrier(const XcdBarrier& b) {
    asm volatile("s_waitcnt vmcnt(0)" ::: "memory");
    __syncthreads();
    if (threadIdx.x == 0) {
        unsigned* bar = b.bar; unsigned bx = b.x;
        asm volatile("" : "+s"(bar), "+s"(bx));
        __builtin_amdgcn_s_waitcnt(0);
        unsigned nloc = b.st[0], nx = b.st[1];
        if (nloc == 0u) { xcd_barrier_complete(bar, bx, nloc, nx); b.st[0] = nloc; b.st[1] = nx; }
        const unsigned old = xb_add(&bar[XB_XSUB(bx)], 1u);
        const unsigned gen = old / nloc;
        if (old + 1u == (gen + 1u) * nloc) {
            __builtin_amdgcn_fence(__ATOMIC_RELEASE, "agent");
            asm volatile("s_waitcnt vmcnt(0)" ::: "memory");
            const unsigned og = xb_add(&bar[XB_TOP], 1u);
            const unsigned tg = og / nx;
            if (og + 1u == (tg + 1u) * nx) xb_add(&bar[XB_TOPGEN], 1u);
            else XB_SPIN(xb_ld(&bar[XB_TOPGEN]) == tg, bar);
            __builtin_amdgcn_fence(__ATOMIC_ACQUIRE, "agent");
            xb_add(&bar[XB_XGEN(bx)], 1u);
            asm volatile("s_waitcnt vmcnt(0)" ::: "memory");
        } else {
            XB_SPIN(xb_ld(&bar[XB_XGEN(bx)]) == gen, bar);
            __builtin_amdgcn_fence(__ATOMIC_ACQUIRE, "agent");
            asm volatile("s_waitcnt vmcnt(0)" ::: "memory");
        }
    }
    __syncthreads();
}
struct Frame {
    LAS unsigned char* lds;
    int tid, lane, wave, vcu, G, gw, NGW;
    unsigned char* ws;
};
__device__ __forceinline__ int opaque_v(int v) { asm volatile("" : "+v"(v)); return v; }
__device__ __forceinline__ int phase_tid(int wave) { int lane; asm volatile("v_mbcnt_lo_u32_b32 %0, -1, 0\n\tv_mbcnt_hi_u32_b32 %0, -1, %0" : "=v"(lane)); return wave * 64 + lane; }
__device__ __forceinline__ Frame phase_frame(const Frame& F0) { Frame F = F0; F.tid = phase_tid(F0.wave); F.lane = F.tid & 63; return F; }
__device__ __forceinline__ float swap32(float v, int lane) { auto rr = __builtin_amdgcn_permlane32_swap(__float_as_uint(v), __float_as_uint(v), false, false); return __uint_as_float(lane < 32 ? rr[1] : rr[0]); }
__device__ __forceinline__ int row_cls(int row) { const int b = row / RB, i = row - b * RB; return i < CTX ? 2 : b; }

__device__ __forceinline__ void p0_transpose_item(const float* W, int K, int N, bf16_t* WT, const float* gain, LAS float* scr, int item, int lane, bool perm_q = false) {
    const int nblk = N / 32, kb = item / nblk, nb = item % nblk, k0 = 64 * kb, n0 = 32 * nb;
    {
        const int rgp = lane >> 3, c4 = (lane & 7) * 4; f32x4 tv[8];
#pragma unroll
        for (int i = 0; i < 8; ++i) tv[i] = *(const f32x4*)(W + (size_t)(k0 + 8 * i + rgp) * N + n0 + c4);
#pragma unroll
        for (int i = 0; i < 8; ++i) { const int kk = 8 * i + rgp; f32x4 v = tv[i]; if (gain) v = v * gain[k0 + kk];
            LAS float* d = scr + kk * 33 + c4; d[0] = v.x; d[1] = v.y; d[2] = v.z; d[3] = v.w; }
    }
    asm volatile("s_waitcnt lgkmcnt(0)" ::: "memory");
    const int c = lane & 7;
#pragma unroll
    for (int j = 0; j < 4; ++j) { const int n = (lane >> 3) + 8 * j; const LAS float* s = scr + (8 * c) * 33 + n;
        u32x4 o; o.x = pk2(s[0 * 33], s[1 * 33]); o.y = pk2(s[2 * 33], s[3 * 33]); o.z = pk2(s[4 * 33], s[5 * 33]); o.w = pk2(s[6 * 33], s[7 * 33]);
        int nn = n0 + n; if (perm_q) { const int hh = nn / 192, e = nn - hh * 192; nn = (e < 128) ? hh * 128 + e : 1024 + hh * 64 + (e - 128); }
        *(u32x4*)(WT + (size_t)nn * K + k0 + 8 * c) = o; }
    asm volatile("s_waitcnt lgkmcnt(0)" ::: "memory");
}
struct TrDesc { const float* W; const float* gain; bf16_t* WT; int K, N, items; };

__device__ __forceinline__ void p0_gemv_task(Frame& F, int task, const float* ada_w, const float* ada_b, float* mod) {
    LAS float* sv = (LAS float*)F.lds; LAS float* part = (LAS float*)(F.lds + 32768);
    const int l = task / 192, n0 = (task % 192) * 64, rg = F.lane >> 4, c4 = (F.lane & 15) * 4;
    const float* Wp = ada_w + (size_t)l * DM * NMOD + n0 + c4 + (size_t)(F.wave * 256 + rg) * NMOD;
    f32x4 a0 = {0, 0, 0, 0}, a1 = a0, a2 = a0;
    for (int k = 0; k < 256; k += 32) {
        f32x4 w[8];
#pragma unroll
        for (int u = 0; u < 8; ++u) w[u] = *(const f32x4*)(Wp + (size_t)(k + 4 * u) * NMOD);
#pragma unroll
        for (int u = 0; u < 8; ++u) { const int kk = F.wave * 256 + k + 4 * u + rg; const float s0 = sv[kk], s1 = sv[2048 + kk], s2 = sv[4096 + kk];
            a0 += w[u] * s0; a1 += w[u] * s1; a2 += w[u] * s2; }
    }
    LAS float* pp = part + ((F.wave * 4 + rg) * 3) * 64 + c4;
    *(LAS f32x4*)(pp) = a0; *(LAS f32x4*)(pp + 64) = a1; *(LAS f32x4*)(pp + 128) = a2;
    __syncthreads();
    if (F.tid < 192) { const int r = F.tid >> 6, c = F.tid & 63; float s = 0.f;
#pragma unroll
        for (int q = 0; q < 32; ++q) s += part[(q * 3 + r) * 64 + c];
        mod[(size_t)(l * 3 + r) * NMOD + n0 + c] = s + ada_b[(size_t)l * NMOD + n0 + c]; }
    __syncthreads();
}

__device__ __forceinline__ void p0_prologue(Frame& F, const float* const* in, const int parts = 15) {
    unsigned char* ws = F.ws;
    if (parts & 1) {
        LAS float* sv = (LAS float*)F.lds;
        for (int i = F.tid; i < 3 * DM; i += NTHREADS) { const int r = i / DM, k = i - r * DM; const float x = (r < 2) ? in[1][r * DM + k] : in[3][k]; sv[i] = x / (1.f + __expf(-x)); }
        __syncthreads();
        for (int task = F.vcu; task < 768; task += F.G) p0_gemv_task(F, task, in[4], in[5], (float*)(ws + WS_MOD));
        __syncthreads();
    }
    if (parts & 2) {
        bf16_t* xw = (bf16_t*)(ws + WS_XW);
        for (int row = F.gw; row < MROWS; row += F.NGW) { const int b = row / RB, i = row - b * RB;
            const float* src = (i < CTX) ? in[2] + (size_t)(b * CTX + i) * DM : in[0] + (size_t)(b * SEQ + i - CTX) * DM;
            const f32x4* s4 = (const f32x4*)src + F.lane; u32x2* d4 = (u32x2*)(xw + (size_t)row * DM) + F.lane;
#pragma unroll
            for (int j = 0; j < 8; ++j) { const f32x4 v = s4[64 * j]; u32x2 o; o.x = pk2(v.x, v.y); o.y = pk2(v.z, v.w); d4[64 * j] = o; } }
    }
    if (parts & 2) {
        float* sm = (float*)(ws + WS_SMALL); const int g = F.vcu * NTHREADS + F.tid;
        if (g < 8192) { sm[SM_N1G + g] = in[6][g]; sm[SM_N2G + g] = in[7][g]; }
        if (g < 384) { sm[SM_AQG + g] = in[13][g]; sm[SM_AKG + g] = in[14][g]; }
        if (g < 6144) sm[SM_CW + g] = in[15][g];
        if (g < 2048) sm[SM_CB + g] = in[16][g];
        if (g < 256) { sm[SM_CQG + g] = in[19][g]; sm[SM_CKG + g] = in[20][g]; }
    }
    if (parts & 2) {
        float* rc = (float*)(ws + WS_ROPE); float* ra = rc + 64 * 32 * 2;
        const int g = F.vcu * NTHREADS + F.tid;
        if (g < 64 * 32) { const int pos = g >> 5, f = g & 31; const float fr = exp2f(-(float)f * (13.287712379549449f / 32.f)); const float ang = (float)pos * fr;
            rc[2 * g] = cosf(ang); rc[2 * g + 1] = sinf(ang); }
        else if (g < 64 * 32 + 64 * 16) { const int e = g - 64 * 32, pos = e >> 4, f = e & 15; const float fr = exp2f(-(float)f * (13.287712379549449f / 16.f)); const float ang = (float)pos * fr;
            ra[2 * e] = cosf(ang); ra[2 * e + 1] = sinf(ang); }
    }
    if (parts & 4) {
        LAS float* scr = (LAS float*)(F.lds + F.wave * 16384);
        TrDesc d[16]; int nd = 0;
#pragma unroll
        for (int i = 0; i < 2; ++i) {
            d[nd++] = TrDesc{in[8] + (size_t)i * DM * 3904, nullptr, (bf16_t*)(ws + WS_WIN) + (size_t)i * 4096 * DM, DM, 3904, 32 * 122};
            d[nd++] = TrDesc{in[11] + (size_t)i * 512 * 1536, in[9] + i * 512, (bf16_t*)(ws + WS_WUQ) + (size_t)i * 1536 * 512, 512, 1536, 8 * 48};
            d[nd++] = TrDesc{in[12] + (size_t)i * 256 * 2048, in[10] + i * 256, (bf16_t*)(ws + WS_WUKV) + (size_t)i * 2048 * 256, 256, 2048, 4 * 64};
            d[nd++] = TrDesc{in[17] + (size_t)i * DM * DM, nullptr, (bf16_t*)(ws + WS_WEO) + (size_t)i * DM * DM, DM, DM, 32 * 64};
            d[nd++] = TrDesc{in[18] + (size_t)i * DM * 3072, nullptr, (bf16_t*)(ws + WS_WQKV) + (size_t)i * 3072 * DM, DM, 3072, 32 * 96};
            d[nd++] = TrDesc{in[21] + (size_t)i * DM * DM, nullptr, (bf16_t*)(ws + WS_WCO) + (size_t)i * DM * DM, DM, DM, 32 * 64};
        }
#pragma unroll
        for (int l = 0; l < 4; ++l) d[nd++] = TrDesc{in[22] + (size_t)l * DM * DM, nullptr, (bf16_t*)(ws + WS_WPQ) + (size_t)l * DM * DM, DM, DM, 32 * 64};
#pragma unroll
        for (int m = 0; m < 16; ++m) {
            for (int it = F.gw; it < d[m].items; it += F.NGW) p0_transpose_item(d[m].W, d[m].K, d[m].N, d[m].WT, d[m].gain, scr, it, F.lane, d[m].K == 512);
        }
        for (int i = F.gw * 64 + F.lane; i < 2 * 192 * DM / 8; i += F.NGW * 64) { const int li = i / (192 * DM / 8), r = i % (192 * DM / 8);
            *(u32x4*)((bf16_t*)(ws + WS_WIN) + (size_t)li * 4096 * DM + (size_t)3904 * DM + (size_t)r * 8) = (u32x4){0u, 0u, 0u, 0u}; }
    }
    if (parts & 2) {
        const size_t n_sk = (size_t)4 * 16 * 128 * 128 / 8;
        const size_t gt = (size_t)F.vcu * NTHREADS + F.tid, GT = (size_t)F.G * NTHREADS;
        for (size_t j = gt; j < n_sk; j += GT) {
            const f32x4 a = *(const f32x4*)(in[23] + j * 8), b = *(const f32x4*)(in[23] + j * 8 + 4);
            u32x4 o; o.x = pk2(a.x, a.y); o.y = pk2(a.z, a.w); o.z = pk2(b.x, b.y); o.w = pk2(b.z, b.w);
            *(u32x4*)((bf16_t*)(ws + WS_SUBK) + j * 8) = o;
        }
    }
#if TAB_FP4 && EXP_SLICED && PEER_MFMA && !defined(P0_NOCOAL)
    if (parts & 8) {
        const int NR = 2 * 4 * NEXP;
        for (int r = F.gw; r < NR; r += F.NGW) {
            const int tab = r >= 4 * NEXP, rr = r - tab * (4 * NEXP);
            const float* src = (tab ? in[25] : in[24]) + (size_t)rr * DM + F.lane * 4;
            f32x4 v[8];
#pragma unroll
            for (int q = 0; q < 8; ++q) v[q] = *(const f32x4*)(src + q * 256);
            float am = 0.f, ssq = 0.f;
#pragma unroll
            for (int q = 0; q < 8; ++q) { am = fmaxf(fmaxf(am, fmaxf(fabsf(v[q].x), fabsf(v[q].y))), fmaxf(fabsf(v[q].z), fabsf(v[q].w))); ssq += (v[q].x * v[q].x + v[q].y * v[q].y) + (v[q].z * v[q].z + v[q].w * v[q].w); }
            am = fmaxf(wave_max_dpp(am), 1e-30f); ssq = wave_sum_dpp(ssq);
            const float sig = fmaxf(sqrtf(ssq * (1.f / DM)), am * (1.f / 64.f)), sc = 2.0f / sig;
            const int ll = rr / NEXP, ee = rr - ll * NEXP;
            unsigned char* dst = ws + (tab ? WS_VT : WS_U) + (size_t)ll * NEXP * ROWB + (size_t)ee * 128 + F.lane * 2;
#define P0_C6(x) fminf(fmaxf((x), -6.f), 6.f)
#pragma unroll
            for (int q = 0; q < 8; ++q) { const f32x4 x = v[q] * sc; unsigned t = 0u;
                t = __builtin_amdgcn_cvt_scalef32_pk_fp4_f32(t, P0_C6(x.x), P0_C6(x.y), 1.0f, 0); t = __builtin_amdgcn_cvt_scalef32_pk_fp4_f32(t, P0_C6(x.z), P0_C6(x.w), 1.0f, 1);
                *(unsigned short*)(dst + (size_t)q * (NEXP * 128)) = (unsigned short)t; }
#undef P0_C6
            if (F.lane == 0) ((float*)(ws + (tab ? WS_VSC : WS_USC)))[rr] = sig * 0.5f;
        }
    }
#elif TAB_FP4 && EXP_SLICED && PEER_MFMA && defined(P0_PIPE)
    {
        const int NR = 2 * 4 * NEXP;
#define P0_LOAD(V, r_) do { const int rc_ = (r_) < NR ? (r_) : NR - 1; const float* s_ = ((rc_ >= 4 * NEXP) ? in[25] + (size_t)(rc_ - 4 * NEXP) * DM : in[24] + (size_t)rc_ * DM) + F.lane * 32; \
        _Pragma("unroll") for (int q = 0; q < 8; ++q) V[q] = *(const f32x4*)(s_ + q * 4); } while (0)
#define P0_C6(x) fminf(fmaxf((x), -6.f), 6.f)
#define P0_ROW(V, VN) do { \
        const int rn = r + F.NGW; P0_LOAD(VN, rn); \
        const int tab = r >= 4 * NEXP, rr = r - tab * (4 * NEXP); \
        float am = 0.f, ssq = 0.f; \
        _Pragma("unroll") for (int q = 0; q < 8; ++q) { am = fmaxf(fmaxf(am, fmaxf(fabsf(V[q].x), fabsf(V[q].y))), fmaxf(fabsf(V[q].z), fabsf(V[q].w))); ssq += (V[q].x * V[q].x + V[q].y * V[q].y) + (V[q].z * V[q].z + V[q].w * V[q].w); } \
        am = fmaxf(wave_max_dpp(am), 1e-30f); ssq = wave_sum_dpp(ssq); \
        const float sig = fmaxf(sqrtf(ssq * (1.f / DM)), am * (1.f / 64.f)), sc = 2.0f / sig; \
        unsigned w4[4]; \
        _Pragma("unroll") for (int q = 0; q < 4; ++q) { unsigned t = 0u; const f32x4 xa = V[2 * q] * sc, xb = V[2 * q + 1] * sc; \
            t = __builtin_amdgcn_cvt_scalef32_pk_fp4_f32(t, P0_C6(xa.x), P0_C6(xa.y), 1.0f, 0); t = __builtin_amdgcn_cvt_scalef32_pk_fp4_f32(t, P0_C6(xa.z), P0_C6(xa.w), 1.0f, 1); \
            t = __builtin_amdgcn_cvt_scalef32_pk_fp4_f32(t, P0_C6(xb.x), P0_C6(xb.y), 1.0f, 2); t = __builtin_amdgcn_cvt_scalef32_pk_fp4_f32(t, P0_C6(xb.z), P0_C6(xb.w), 1.0f, 3); w4[q] = t; } \
        { const int ll = rr / NEXP, ee = rr - ll * NEXP; \
          *(u32x4*)(ws + (tab ? WS_VT : WS_U) + (size_t)ll * NEXP * ROWB + (size_t)(F.lane >> 3) * (NEXP * 128) + (size_t)ee * 128 + (F.lane & 7) * 16) = (u32x4){w4[0], w4[1], w4[2], w4[3]}; } \
        if (F.lane == 0) ((float*)(ws + (tab ? WS_VSC : WS_USC)))[rr] = sig * 0.5f; \
        r = rn; } while (0)
        int r = F.gw; f32x4 va[8], vb[8]; P0_LOAD(va, r);
        while (r < NR) { P0_ROW(va, vb); if (!(r < NR)) break; P0_ROW(vb, va); }
#undef P0_ROW
#undef P0_C6
#undef P0_LOAD
    }
#else
    {
        for (int r = F.gw; r < 2 * 4 * NEXP; r += F.NGW) {
            const int tab = r / (4 * NEXP), rr = r - tab * (4 * NEXP);
#if EXP_SLICED
            const float* src = (tab ? in[25] : in[24]) + (size_t)rr * DM + F.lane * 32;
            f32x4 v[8];
#pragma unroll
            for (int q = 0; q < 8; ++q) v[q] = *(const f32x4*)(src + q * 4);
#else
            const float* src = (tab ? in[25] : in[24]) + (size_t)rr * DM + F.lane * 16;
            f32x4 v[8];
#pragma unroll
            for (int j = 0; j < 2; ++j)
#pragma unroll
                for (int q = 0; q < 4; ++q) v[j * 4 + q] = *(const f32x4*)(src + j * 1024 + q * 4);
#endif
            float am = 0.f;
#pragma unroll
            for (int q = 0; q < 8; ++q) am = fmaxf(fmaxf(am, fmaxf(fabsf(v[q].x), fabsf(v[q].y))), fmaxf(fabsf(v[q].z), fabsf(v[q].w)));
#pragma unroll
            for (int o = 1; o < 64; o <<= 1) am = fmaxf(am, __shfl_xor(am, o));
            am = fmaxf(am, 1e-30f);
#if TAB_FP4
            float ssq = 0.f;
#pragma unroll
            for (int q = 0; q < 8; ++q) ssq += (v[q].x * v[q].x + v[q].y * v[q].y) + (v[q].z * v[q].z + v[q].w * v[q].w);
#pragma unroll
            for (int o = 1; o < 64; o <<= 1) ssq += __shfl_xor(ssq, o);
            const float sig = fmaxf(sqrtf(ssq * (1.f / DM)), am * (1.f / 64.f));
            unsigned w4[4];
#if EXP_SLICED
            if (tab == 0 && !PEER_MFMA) {
                const float delta = 0.3352f * sig, isc = 1.0f / delta;
#pragma unroll
                for (int q = 0; q < 4; ++q) { unsigned t = 0u;
#pragma unroll
                    for (int hh = 0; hh < 2; ++hh) { const f32x4 x = v[2 * q + hh] * isc;
                        const int n0 = min(max((int)floorf(x.x), -8), 7) & 15, n1 = min(max((int)floorf(x.y), -8), 7) & 15, n2 = min(max((int)floorf(x.z), -8), 7) & 15, n3 = min(max((int)floorf(x.w), -8), 7) & 15;
                        t |= ((unsigned)n0 | ((unsigned)n1 << 4) | ((unsigned)n2 << 8) | ((unsigned)n3 << 12)) << (16 * hh); }
                    w4[q] = t; }
                { const int ll = rr / NEXP, ee = rr - ll * NEXP;
                  *(u32x4*)(ws + WS_U + (size_t)ll * NEXP * ROWB + (size_t)(F.lane >> 3) * (NEXP * 128) + (size_t)ee * 128 + (F.lane & 7) * 16) = (u32x4){w4[0], w4[1], w4[2], w4[3]}; }
                if (F.lane == 0) ((float*)(ws + WS_USC))[rr] = delta;
                continue;
            }
#endif
            const float sc = 2.0f / sig;
#pragma unroll
            for (int q = 0; q < 4; ++q) { unsigned t = 0u;
                const f32x4 xa = v[2 * q] * sc, xb = v[2 * q + 1] * sc;
#define P0_C6(x) fminf(fmaxf((x), -6.f), 6.f)
                t = __builtin_amdgcn_cvt_scalef32_pk_fp4_f32(t, P0_C6(xa.x), P0_C6(xa.y), 1.0f, 0);
                t = __builtin_amdgcn_cvt_scalef32_pk_fp4_f32(t, P0_C6(xa.z), P0_C6(xa.w), 1.0f, 1);
                t = __builtin_amdgcn_cvt_scalef32_pk_fp4_f32(t, P0_C6(xb.x), P0_C6(xb.y), 1.0f, 2);
                t = __builtin_amdgcn_cvt_scalef32_pk_fp4_f32(t, P0_C6(xb.z), P0_C6(xb.w), 1.0f, 3);
#undef P0_C6
                w4[q] = t; }
#if EXP_SLICED
            { const int ll = rr / NEXP, ee = rr - ll * NEXP;
              *(u32x4*)(ws + (tab ? WS_VT : WS_U) + (size_t)ll * NEXP * ROWB + (size_t)(F.lane >> 3) * (NEXP * 128) + (size_t)ee * 128 + (F.lane & 7) * 16) = (u32x4){w4[0], w4[1], w4[2], w4[3]}; }
#else
            *(u32x4*)(ws + (tab ? WS_VT : WS_U) + (size_t)rr * ROWB + F.lane * 16) = (u32x4){w4[0], w4[1], w4[2], w4[3]};
#endif
            if (F.lane == 0) ((float*)(ws + (tab ? WS_VSC : WS_USC)))[rr] = sig * 0.5f;
#else
            const float sc = 7.5f / am;
            f32x16 a, b;
#pragma unroll
            for (int q = 0; q < 8; ++q) { const f32x4 x = v[q] * sc; a[2 * q] = x.x; b[2 * q] = x.y; a[2 * q + 1] = x.z; b[2 * q + 1] = x.w; }
            const u32x6 w = __builtin_amdgcn_cvt_scalef32_2xpk16_fp6_f32(a, b, 1.0f);
            unsigned char* dst = ws + (tab ? WS_VT : WS_U) + (size_t)rr * ROWB;
            *(u32x4*)(dst + F.lane * 16) = (u32x4){w[0], w[1], w[2], w[3]};
            *(u32x2*)(dst + 1024 + F.lane * 8) = (u32x2){w[4], w[5]};
            if (F.lane == 0) ((float*)(ws + (tab ? WS_VSC : WS_USC)))[rr] = am * (1.0f / 7.5f);
#endif
        }
    }
#endif
}

template <bool RESID>
__device__ __forceinline__ void ctx_gemm_phase(const Frame& F0, const bf16_t* A, int lda, const bf16_t* Bt, int ldb, int N, int K, bf16_t* O, bf16_t* X, int ldc, const float* gate) {
    const Frame F = phase_frame(F0);
    const int lane = F.lane, li = lane & 15, lq = lane >> 4, wave = F.wave;
    LAS float* red = (LAS float*)F.lds;
    LAS unsigned char* priv = F.lds + wave * 12288;
    const int lr = lane >> 3, lc = lane & 7;
    const int wr_even = lr * 128 + ((lc ^ (lr >> 1)) << 4), wr_odd = lr * 128 + ((lc ^ (4 + (lr >> 1))) << 4);
    const int rd_row = li * 128;
    const int ntask = 8 * (N / 32), k0 = wave * (K / 8);
#define CG_PTRS(t_, XG, WG) do { const int tc_ = (t_) < ntask ? (t_) : ntask - 1; const int rb_ = tc_ & 7, cb_ = tc_ >> 3; const int r0_ = (rb_ < 4) ? rb_ * 64 : RB + (rb_ - 4) * 64; \
        XG = A + (size_t)(r0_ + lr) * lda + k0 + 8 * lc; WG = Bt + (size_t)(cb_ * 32 + lr) * ldb + k0 + 8 * lc; } while (0)
#define CG_LOAD(XQ, WQ, XG, WG, q_) do { _Pragma("unroll") for (int i = 0; i < 8; ++i) XQ[i] = *(const u32x4*)(XG + (size_t)(8 * i) * lda + 64 * (q_)); \
        _Pragma("unroll") for (int i = 0; i < 4; ++i) WQ[i] = *(const u32x4*)(WG + (size_t)(8 * i) * ldb + 64 * (q_)); } while (0)
#define CG_QUARTER(XQ, WQ, XGN, WGN, qn_) do { \
        _Pragma("unroll") for (int i = 0; i < 8; ++i) *(LAS u32x4*)(priv + ((i & 1) ? wr_odd : wr_even) + i * 1024) = XQ[i]; \
        _Pragma("unroll") for (int i = 0; i < 4; ++i) *(LAS u32x4*)(priv + 8192 + ((i & 1) ? wr_odd : wr_even) + i * 1024) = WQ[i]; \
        __builtin_amdgcn_sched_barrier(0); \
        CG_LOAD(XQ, WQ, XGN, WGN, qn_); \
        __builtin_amdgcn_sched_barrier(0); \
        _Pragma("unroll") for (int s = 0; s < 2; ++s) { \
            const int ro = rd_row + (((4 * s + lq) ^ (li >> 1)) << 4); \
            bf16x8 xa[4], wb[2]; \
            _Pragma("unroll") for (int m = 0; m < 4; ++m) xa[m] = *(const LAS bf16x8*)(priv + ro + m * 2048); \
            _Pragma("unroll") for (int n = 0; n < 2; ++n) wb[n] = *(const LAS bf16x8*)(priv + 8192 + ro + n * 2048); \
            _Pragma("unroll") for (int m = 0; m < 4; ++m) _Pragma("unroll") for (int n = 0; n < 2; ++n) acc[m][n] = __builtin_amdgcn_mfma_f32_16x16x32_bf16(wb[n], xa[m], acc[m][n], 0, 0, 0); } \
    } while (0)
    u32x4 xa_[8], wa_[4], xb_[8], wb_[4];
    const bf16_t *xg, *wg, *xgn, *wgn;
    CG_PTRS(F.vcu, xg, wg);
    __builtin_amdgcn_s_waitcnt(0x0f70);
    __builtin_amdgcn_sched_barrier(0); CG_LOAD(xa_, wa_, xg, wg, 0); __builtin_amdgcn_sched_barrier(0); CG_LOAD(xb_, wb_, xg, wg, 1); __builtin_amdgcn_sched_barrier(0);
    for (int task = F.vcu; task < ntask; task += F.G) {
        const int rb = task & 7, cb = task >> 3;
        const int row0 = (rb < 4) ? rb * 64 : RB + (rb - 4) * 64, col0 = cb * 32;
        CG_PTRS(task + F.G, xgn, wgn);
        const int row = row0 + 16 * (wave >> 1) + li, col = col0 + 16 * (wave & 1) + 4 * lq;
        f32x4 xold = {0.f, 0.f, 0.f, 0.f}, gv = xold;
        if (RESID) { const u32x2 w_ = *(const u32x2*)(X + (size_t)row * ldc + col); xold = (f32x4){bf_lo(w_.x), bf_hi(w_.x), bf_lo(w_.y), bf_hi(w_.y)}; gv = *(const f32x4*)(gate + (size_t)2 * 12288 + col); }
        __builtin_amdgcn_sched_barrier(0);
        f32x4 acc[4][2];
#pragma unroll
        for (int m = 0; m < 4; ++m) { acc[m][0] = (f32x4){0.f, 0.f, 0.f, 0.f}; acc[m][1] = acc[m][0]; }
        CG_QUARTER(xa_, wa_, xg, wg, 2);
        CG_QUARTER(xb_, wb_, xg, wg, 3);
        CG_QUARTER(xa_, wa_, xgn, wgn, 0);
        CG_QUARTER(xb_, wb_, xgn, wgn, 1);
        xg = xgn; wg = wgn;
        __syncthreads();
#pragma unroll
        for (int m = 0; m < 4; ++m)
#pragma unroll
            for (int n = 0; n < 2; ++n)
#pragma unroll
                for (int r = 0; r < 4; ++r) red[(wave * 32 + (m * 2 + n) * 4 + r) * 64 + lane] = acc[m][n][r];
        __syncthreads();
        f32x4 sum = {0.f, 0.f, 0.f, 0.f};
#pragma unroll
        for (int w2 = 0; w2 < 8; ++w2)
#pragma unroll
            for (int r = 0; r < 4; ++r) sum[r] += red[(w2 * 32 + wave * 4 + r) * 64 + lane];
        if (RESID) { const f32x4 xn_ = xold + gv * sum; u32x2 o; o.x = pk2(xn_[0], xn_[1]); o.y = pk2(xn_[2], xn_[3]); *(u32x2*)(X + (size_t)row * ldc + col) = o; }
        else { u32x2 o; o.x = pk2(sum[0], sum[1]); o.y = pk2(sum[2], sum[3]); *(u32x2*)(O + (size_t)row * ldc + col) = o; }
        __syncthreads();
    }
#undef CG_QUARTER
#undef CG_LOAD
#undef CG_PTRS
    __syncthreads();
}

__device__ __forceinline__ void norm_phase(const Frame& F0, const bf16_t* xw, const float* g, const float* modl  , int off_sh, int off_sc, bf16_t* H, bool lat_only, unsigned* XQ = nullptr, float* XS = nullptr) {
    const Frame F = phase_frame(F0);
    f32x4 gm[8], shv[8]; int cur_cls = -1;
    int row = F.gw; if (lat_only) while (row < MROWS && row_cls(row) == 2) row += F.NGW;
    f32x4 v[8];
    if (row < MROWS) { const u32x2* x4 = (const u32x2*)(xw + (size_t)row * DM) + F.lane;
#pragma unroll
        for (int j = 0; j < 8; ++j) { const u32x2 w_ = x4[64 * j]; v[j] = (f32x4){bf_lo(w_.x), bf_hi(w_.x), bf_lo(w_.y), bf_hi(w_.y)}; } }
    while (row < MROWS) {
        int nrow = row + F.NGW; if (lat_only) while (nrow < MROWS && row_cls(nrow) == 2) nrow += F.NGW;
        f32x4 vn[8];
        if (nrow < MROWS) { const u32x2* x4 = (const u32x2*)(xw + (size_t)nrow * DM) + F.lane;
#pragma unroll
            for (int j = 0; j < 8; ++j) { const u32x2 w_ = x4[64 * j]; vn[j] = (f32x4){bf_lo(w_.x), bf_hi(w_.x), bf_lo(w_.y), bf_hi(w_.y)}; } }
        const int cls = row_cls(row);
        if (cls != cur_cls) {
            cur_cls = cls;
            const f32x4* g4 = (const f32x4*)g + F.lane; const f32x4* sc4 = (const f32x4*)(modl + (size_t)cls * NMOD + off_sc) + F.lane; const f32x4* sh4 = (const f32x4*)(modl + (size_t)cls * NMOD + off_sh) + F.lane;
#pragma unroll
            for (int j = 0; j < 8; ++j) { gm[j] = g4[64 * j] * (sc4[64 * j] + 1.0f); shv[j] = sh4[64 * j]; }
        }
        float ss = 0.f;
#pragma unroll
        for (int j = 0; j < 8; ++j) ss += (v[j].x * v[j].x + v[j].y * v[j].y) + (v[j].z * v[j].z + v[j].w * v[j].w);
        const float rstd = 1.0f / sqrtf(wave_sum_dpp(ss) * (1.f / DM) + EPS);
        u32x2* o2 = (u32x2*)(H + (size_t)row * DM) + F.lane;
#if PEER_MFMA
        if (XQ) {
            f32x4 yv[8]; float am = 0.f;
#pragma unroll
            for (int j = 0; j < 8; ++j) { const f32x4 y = (v[j] * rstd) * gm[j] + shv[j]; yv[j] = y; u32x2 o; o.x = pk2(y.x, y.y); o.y = pk2(y.z, y.w); o2[64 * j] = o;
                am = fmaxf(fmaxf(am, fmaxf(fabsf(y.x), fabsf(y.y))), fmaxf(fabsf(y.z), fabsf(y.w))); }
            am = fmaxf(am, DPP_MOV(am, 0xB1)); am = fmaxf(am, DPP_MOV(am, 0x4E)); am = fmaxf(am, DPP_MOV(am, 0x141)); am = fmaxf(am, DPP_MOV(am, 0x140));
            { const int ai = __builtin_bit_cast(int, am);
              am = fmaxf(fmaxf(__builtin_bit_cast(float, __builtin_amdgcn_readlane(ai, 0)), __builtin_bit_cast(float, __builtin_amdgcn_readlane(ai, 16))),
                         fmaxf(__builtin_bit_cast(float, __builtin_amdgcn_readlane(ai, 32)), __builtin_bit_cast(float, __builtin_amdgcn_readlane(ai, 48)))); }
            am = fmaxf(am, 1e-20f);
            const float qs = 440.0f / am;
            unsigned* q8 = XQ + (size_t)row * (DM / 4) + F.lane;
#pragma unroll
            for (int j = 0; j < 8; ++j) { const f32x4 y = yv[j] * qs; int pk = 0; pk = __builtin_amdgcn_cvt_pk_fp8_f32(y.x, y.y, pk, false); pk = __builtin_amdgcn_cvt_pk_fp8_f32(y.z, y.w, pk, true); q8[64 * j] = (unsigned)pk; }
            if (F.lane == 0) XS[row] = am * (1.0f / 440.0f);
        } else
#endif
        {
#pragma unroll
        for (int j = 0; j < 8; ++j) { const f32x4 y = (v[j] * rstd) * gm[j] + shv[j]; u32x2 o; o.x = pk2(y.x, y.y); o.y = pk2(y.z, y.w); o2[64 * j] = o;
            if (XQ) {
                float am = fmaxf(fmaxf(fabsf(y.x), fabsf(y.y)), fmaxf(fabsf(y.z), fabsf(y.w)));
                am = fmaxf(am, DPP_MOV(am, 0xB1)); am = fmaxf(am, DPP_MOV(am, 0x4E)); am = fmaxf(am, DPP_MOV(am, 0x141)); am = fmaxf(am, 1e-20f);
                const float qs = 119.0f / am; const float yy[4] = {y.x, y.y, y.z, y.w};
                unsigned pl = 0u, ph = 0u; int sq = 0;
#pragma unroll
                for (int i = 0; i < 4; ++i) { const int qi = __float2int_rn(yy[i] * qs); const int lo = ((qi + 8) & 15) - 8; const int hi = (qi - lo) >> 4; sq += qi; pl |= (unsigned)(lo & 15) << (4 * i); ph |= (unsigned)(hi & 15) << (4 * i); }
                const unsigned pl1 = (unsigned)__builtin_amdgcn_update_dpp(0, (int)pl, 0xB1, 0xf, 0xf, true), ph1 = (unsigned)__builtin_amdgcn_update_dpp(0, (int)ph, 0xB1, 0xf, 0xf, true);
                float sqf = (float)sq; sqf = DPP_ADD(sqf, 0xB1); sqf = DPP_ADD(sqf, 0x4E); sqf = DPP_ADD(sqf, 0x141);
                const int chunk = j * 8 + (F.lane >> 3), l8 = F.lane & 7;
                if ((l8 & 1) == 0) { unsigned* q = XQ + ((size_t)row * 64 + chunk) * 8 + (l8 >> 1); q[0] = ph | (ph1 << 16); q[4] = pl | (pl1 << 16); }
                if (l8 == 0) { float* s = XS + ((size_t)row * 64 + chunk) * 2; s[0] = am * (1.0f / 119.0f); s[1] = 0.5f * sqf; }
            } }
        }
        row = nrow;
#pragma unroll
        for (int j = 0; j < 8; ++j) v[j] = vn[j];
    }
}

__device__ __forceinline__ float row16_sum(float v) { v = DPP_ADD(v, 0xB1); v = DPP_ADD(v, 0x4E); v = DPP_ADD(v, 0x141); v = DPP_ADD(v, 0x140); return v; }
__device__ __forceinline__ void prep_odd_phase(const Frame& F0, const bf16_t* P, const float* qg, const float* kg, const float* rope_c, bf16_t* Q, bf16_t* Kb) {
    const Frame F = phase_frame(F0);
    const int l16 = F.lane & 15, d0 = l16 * 8;
    float gq[8], gk[8];
#pragma unroll
    for (int e = 0; e < 8; ++e) { gq[e] = qg[d0 + e]; gk[e] = kg[d0 + e]; }
    const bool lowhalf = l16 < 8;
    const int j0 = (l16 & 7) * 8;
    int row = F.gw;
    u32x4 w[5];
    if (row < MROWS) { const u32x4* pr = (const u32x4*)(P + (size_t)row * 3072) + F.lane;
#pragma unroll
        for (int k = 0; k < 5; ++k) w[k] = pr[64 * k]; }
    while (row < MROWS) {
        const int nrow = row + F.NGW;
        u32x4 wn[5];
        if (nrow < MROWS) { const u32x4* pr = (const u32x4*)(P + (size_t)nrow * 3072) + F.lane;
#pragma unroll
            for (int k = 0; k < 5; ++k) wn[k] = pr[64 * k]; }
        const int b = row / RB, i = row - b * RB; const bool lat = i >= CTX; const int t = i - CTX;
        float cs[8], sn[8];
#pragma unroll
        for (int e = 0; e < 8; ++e) { cs[e] = 1.f; sn[e] = 0.f; }
        if (lat) { const int pos = (j0 < 32) ? (t >> 6) : (t & 63); const f32x4* tb = (const f32x4*)(rope_c + ((pos << 5) + (j0 & 31)) * 2);
#pragma unroll
            for (int q = 0; q < 4; ++q) { const f32x4 c = tb[q]; cs[2 * q] = c.x; sn[2 * q] = c.y; cs[2 * q + 1] = c.z; sn[2 * q + 1] = c.w; } }
#pragma unroll
        for (int k = 0; k < 5; ++k) {
            const unsigned ww[4] = {w[k].x, w[k].y, w[k].z, w[k].w};
            float x[8]; float ss = 0.f;
#pragma unroll
            for (int q = 0; q < 4; ++q) { x[2 * q] = bf_lo(ww[q]); x[2 * q + 1] = bf_hi(ww[q]); ss += x[2 * q] * x[2 * q] + x[2 * q + 1] * x[2 * q + 1]; }
            const float rstd = 1.0f / sqrtf(row16_sum(ss) * (1.f / 128.f) + EPS);
            unsigned ow[4]; float o[8];
#pragma unroll
            for (int e = 0; e < 8; ++e) { const float y = x[e] * rstd * (k < 4 ? gq[e] : gk[e]); const float yp = DPP_MOV(y, 0x128);
                o[e] = lowhalf ? (y * cs[e] - yp * sn[e]) : (y * cs[e] + yp * sn[e]); }
#pragma unroll
            for (int q = 0; q < 4; ++q) ow[q] = pk2(o[2 * q], o[2 * q + 1]);
            if (k < 4) *((u32x4*)(Q + (size_t)row * 2048) + 64 * k + F.lane) = (u32x4){ow[0], ow[1], ow[2], ow[3]};
            else *((u32x4*)(Kb + (size_t)row * 512) + F.lane) = (u32x4){ow[0], ow[1], ow[2], ow[3]};
        }
        row = nrow;
#pragma unroll
        for (int k = 0; k < 5; ++k) w[k] = wn[k];
    }
}

struct PrepEvenRow { u32x4 cq; u32x2 ckv, kr; u32x4 qn[2]; u32x2 qr[2]; u32x4 kn[2], vv[2]; };
__device__ __forceinline__ void prep_even_load(PrepEvenRow& R, const bf16_t* P, const bf16_t* QR, const bf16_t* KVR, int row, int lane) {
    const bf16_t* pr = P + (size_t)row * 4096; const int l16 = lane & 15, hq = lane >> 4;
    R.cq = *((const u32x4*)pr + lane); R.ckv = *((const u32x2*)(pr + 512) + lane); R.kr = *((const u32x2*)(pr + 768) + l16);
    const bf16_t* q = QR + (size_t)row * 1536; const bf16_t* kv = KVR + (size_t)row * 2048;
#pragma unroll
    for (int k = 0; k < 2; ++k) { R.qn[k] = *((const u32x4*)q + 64 * k + lane); R.qr[k] = *((const u32x2*)(q + 1024) + 64 * k + lane);
        const bf16_t* kh = kv + (4 * k + hq) * 256 + l16 * 8; R.kn[k] = *(const u32x4*)kh; R.vv[k] = *(const u32x4*)(kh + 128); }
}
__device__ __forceinline__ void prep_even_phase(const Frame& F0, const bf16_t* P, const bf16_t* QR, const bf16_t* KVR, const float* qg, const float* kg, const float* rope_a, bf16_t* Q, bf16_t* Kb, bf16_t* Vb) {
    const Frame F = phase_frame(F0);
    const int lane = F.lane, l16 = lane & 15, hq = lane >> 4, d0 = l16 * 8, r0 = l16 * 4;
    float gqn[8], gkn[8], gqr[4], gkr[4];
#pragma unroll
    for (int e = 0; e < 8; ++e) { gqn[e] = qg[d0 + e]; gkn[e] = kg[d0 + e]; }
#pragma unroll
    for (int e = 0; e < 4; ++e) { gqr[e] = qg[128 + r0 + e]; gkr[e] = kg[128 + r0 + e]; }
    const bool lowhalf = l16 < 8; const int j0 = (l16 & 7) * 4;
    int row = F.gw;
    PrepEvenRow R;
    if (row < MROWS) prep_even_load(R, P, QR, KVR, row, lane);
    while (row < MROWS) {
        const int nrow = row + F.NGW;
        PrepEvenRow Rn;
        if (nrow < MROWS) prep_even_load(Rn, P, QR, KVR, nrow, lane);
        const int b = row / RB, i = row - b * RB; const bool lat = i >= CTX; const int t = i - CTX;
        float cs[4], sn[4];
#pragma unroll
        for (int e = 0; e < 4; ++e) { cs[e] = 1.f; sn[e] = 0.f; }
        if (lat) { const int pos = (j0 < 16) ? (t >> 6) : (t & 63); const f32x4* tb = (const f32x4*)(rope_a + ((pos << 4) + (j0 & 15)) * 2);
            const f32x4 c0 = tb[0], c1 = tb[1]; cs[0] = c0.x; sn[0] = c0.y; cs[1] = c0.z; sn[1] = c0.w; cs[2] = c1.x; sn[2] = c1.y; cs[3] = c1.z; sn[3] = c1.w; }
        float ssq = 0.f, sskv = 0.f;
        { const unsigned ww[4] = {R.cq.x, R.cq.y, R.cq.z, R.cq.w};
#pragma unroll
          for (int q = 0; q < 4; ++q) { const float a = bf_lo(ww[q]), c = bf_hi(ww[q]); ssq += a * a + c * c; } }
        { const float a = bf_lo(R.ckv.x), c = bf_hi(R.ckv.x), d = bf_lo(R.ckv.y), e = bf_hi(R.ckv.y); sskv = (a * a + c * c) + (d * d + e * e); }
        const float rstd_q = 1.0f / sqrtf(wave_sum_dpp(ssq) * (1.f / 512.f) + EPS), rstd_kv = 1.0f / sqrtf(wave_sum_dpp(sskv) * (1.f / 256.f) + EPS);
        const float krv[4] = {bf_lo(R.kr.x), bf_hi(R.kr.x), bf_lo(R.kr.y), bf_hi(R.kr.y)};
        const float krss = (krv[0] * krv[0] + krv[1] * krv[1]) + (krv[2] * krv[2] + krv[3] * krv[3]);
#pragma unroll
        for (int k = 0; k < 2; ++k) {
            const int h = 4 * k + hq;
            {
                const unsigned wn[4] = {R.qn[k].x, R.qn[k].y, R.qn[k].z, R.qn[k].w};
                float xn[8], xr[4]; float ss = 0.f;
#pragma unroll
                for (int q = 0; q < 4; ++q) { xn[2 * q] = bf_lo(wn[q]) * rstd_q; xn[2 * q + 1] = bf_hi(wn[q]) * rstd_q; ss += xn[2 * q] * xn[2 * q] + xn[2 * q + 1] * xn[2 * q + 1]; }
                xr[0] = bf_lo(R.qr[k].x) * rstd_q; xr[1] = bf_hi(R.qr[k].x) * rstd_q; xr[2] = bf_lo(R.qr[k].y) * rstd_q; xr[3] = bf_hi(R.qr[k].y) * rstd_q;
                ss += (xr[0] * xr[0] + xr[1] * xr[1]) + (xr[2] * xr[2] + xr[3] * xr[3]);
                const float r2 = 1.0f / sqrtf(row16_sum(ss) * (1.f / 192.f) + EPS);
                unsigned on[4]; float o[4];
#pragma unroll
                for (int q = 0; q < 4; ++q) on[q] = pk2(xn[2 * q] * r2 * gqn[2 * q], xn[2 * q + 1] * r2 * gqn[2 * q + 1]);
#pragma unroll
                for (int e = 0; e < 4; ++e) { const float y = xr[e] * r2 * gqr[e]; const float yp = DPP_MOV(y, 0x128); o[e] = lowhalf ? (y * cs[e] - yp * sn[e]) : (y * cs[e] + yp * sn[e]); }
                bf16_t* qo = Q + (size_t)row * 1536 + h * 192;
                *(u32x4*)(qo + d0) = (u32x4){on[0], on[1], on[2], on[3]};
                *(u32x2*)(qo + 128 + r0) = (u32x2){pk2(o[0], o[1]), pk2(o[2], o[3])};
            }
            {
                const unsigned wn[4] = {R.kn[k].x, R.kn[k].y, R.kn[k].z, R.kn[k].w}, wv[4] = {R.vv[k].x, R.vv[k].y, R.vv[k].z, R.vv[k].w};
                float xn[8]; float ss = krss;
#pragma unroll
                for (int q = 0; q < 4; ++q) { xn[2 * q] = bf_lo(wn[q]) * rstd_kv; xn[2 * q + 1] = bf_hi(wn[q]) * rstd_kv; ss += xn[2 * q] * xn[2 * q] + xn[2 * q + 1] * xn[2 * q + 1]; }
                const float r2 = 1.0f / sqrtf(row16_sum(ss) * (1.f / 192.f) + EPS);
                unsigned on[4], ov[4]; float o[4];
#pragma unroll
                for (int q = 0; q < 4; ++q) { on[q] = pk2(xn[2 * q] * r2 * gkn[2 * q], xn[2 * q + 1] * r2 * gkn[2 * q + 1]); ov[q] = pk2(bf_lo(wv[q]) * rstd_kv, bf_hi(wv[q]) * rstd_kv); }
#pragma unroll
                for (int e = 0; e < 4; ++e) { const float y = krv[e] * r2 * gkr[e]; const float yp = DPP_MOV(y, 0x128); o[e] = lowhalf ? (y * cs[e] - yp * sn[e]) : (y * cs[e] + yp * sn[e]); }
                bf16_t* ko = Kb + (size_t)row * 1536 + h * 192;
                *(u32x4*)(ko + d0) = (u32x4){on[0], on[1], on[2], on[3]};
                *(u32x2*)(ko + 128 + r0) = (u32x2){pk2(o[0], o[1]), pk2(o[2], o[3])};
                *(u32x4*)(Vb + (size_t)row * 1024 + h * 128 + d0) = (u32x4){ov[0], ov[1], ov[2], ov[3]};
            }
        }
        row = nrow; R = Rn;
    }
}

__device__ __forceinline__ void conv_phase(const Frame& F0, const bf16_t* P, const float* cw  , const float* cb  , bf16_t* CAT) {
    const Frame F = phase_frame(F0);
    const int gt = F.vcu * NTHREADS + F.tid, GT = F.G * NTHREADS;
    for (int it = gt; it < MROWS * 128; it += GT) {
        const int row = it >> 7, c0 = (it & 127) * 8; const int b = row / RB, i = row - b * RB;
        const bool first = (i == 0) || (i == CTX), last = (i == CTX - 1) || (i == RB - 1);
        const bf16_t* pr = P + (size_t)row * 4096 + 832 + c0;
        const u32x4 bg = *(const u32x4*)pr, cg = *(const u32x4*)(pr + 1024), hz = *(const u32x4*)(pr + 2048);
        u32x4 cgm = {0u, 0u, 0u, 0u}, hzm = cgm, cgp = cgm, hzp = cgm;
        if (!first) { cgm = *(const u32x4*)(pr - 4096 + 1024); hzm = *(const u32x4*)(pr - 4096 + 2048); }
        if (!last) { cgp = *(const u32x4*)(pr + 4096 + 1024); hzp = *(const u32x4*)(pr + 4096 + 2048); }
        const unsigned bgw[4] = {bg.x, bg.y, bg.z, bg.w}, cgw[4] = {cg.x, cg.y, cg.z, cg.w}, hzw[4] = {hz.x, hz.y, hz.z, hz.w};
        const unsigned cmw[4] = {cgm.x, cgm.y, cgm.z, cgm.w}, hmw[4] = {hzm.x, hzm.y, hzm.z, hzm.w}, cpw[4] = {cgp.x, cgp.y, cgp.z, cgp.w}, hpw[4] = {hzp.x, hzp.y, hzp.z, hzp.w};
        unsigned ow[4];
#pragma unroll
        for (int q = 0; q < 4; ++q) {
            const int c = c0 + 2 * q;
            const float u0a = bf_lo(cgw[q]) * bf_lo(hzw[q]), u0b = bf_hi(cgw[q]) * bf_hi(hzw[q]);
            const float uma = bf_lo(cmw[q]) * bf_lo(hmw[q]), umb = bf_hi(cmw[q]) * bf_hi(hmw[q]);
            const float upa = bf_lo(cpw[q]) * bf_lo(hpw[q]), upb = bf_hi(cpw[q]) * bf_hi(hpw[q]);
            const float ra = bf_lo(bgw[q]) * (uma * cw[c] + u0a * cw[1024 + c] + upa * cw[2048 + c] + cb[c]);
            const float rb = bf_hi(bgw[q]) * (umb * cw[c + 1] + u0b * cw[1024 + c + 1] + upb * cw[2048 + c + 1] + cb[c + 1]);
            ow[q] = pk2(ra, rb);
        }
        *(u32x4*)(CAT + (size_t)row * DM + 1024 + c0) = (u32x4){ow[0], ow[1], ow[2], ow[3]};
    }
}
__device__ __forceinline__ void attn_even_phase(const Frame& F0, const bf16_t* Q, const bf16_t* Kb, const bf16_t* Vb, bf16_t* CAT) {
    const Frame F = phase_frame(F0);
    for (int u = F.vcu; u < 272; u += F.G) {
        int b, h, qt, nk;
        if (u < 256) { b = u >> 7; h = (u >> 4) & 7; qt = 1 + (u & 15); nk = RB; } else { const int v = u - 256; b = v >> 3; h = v & 7; qt = 0; nk = CTX; }
        const size_t r0 = (size_t)b * RB;
        att::attn_body2g<192, 1536, 1536, 1024, 2048>(Q + (r0 + qt * 256) * 1536 + h * 192, Kb + r0 * 1536 + h * 192, Vb + r0 * 1024 + h * 128, CAT + (r0 + qt * 256) * 2048 + h * 128, nk, (char*)F.lds, phase_tid(F.wave));
    }
}
__device__ __forceinline__ void attn_odd_phase(const Frame& F0, const bf16_t* Q, const bf16_t* Kb, const bf16_t* P, bf16_t* CAT, bool lat_only) {
    const Frame F = phase_frame(F0);
    const int nunits = lat_only ? 512 : 544;
    for (int u = F.vcu; u < nunits; u += F.G) {
        int b, hq, qt, nk;
        if (u < 512) { b = u >> 8; hq = (u >> 4) & 15; qt = 1 + (u & 15); nk = RB; } else { const int v = u - 512; b = v >> 4; hq = v & 15; qt = 0; nk = CTX; }
        const int kvh = hq >> 2; const size_t r0 = (size_t)b * RB;
        att::attn_body2g<128, 2048, 512, 3072, 2048>(Q + (r0 + qt * 256) * 2048 + hq * 128, Kb + r0 * 512 + kvh * 128, P + r0 * 3072 + 2560 + kvh * 128, CAT + (r0 + qt * 256) * 2048 + hq * 128, nk, (char*)F.lds, phase_tid(F.wave));
    }
}

__device__ __forceinline__ int crow32(int r, int hi) { return (r & 3) + 8 * (r >> 2) + 4 * hi; }
__device__ __forceinline__ int fkey(int b) { return b ^ ((b >> 31) & 0x7fffffff); }
#define TK_CE(x, y) do { const int hi_ = max((x), (y)), lo_ = min((x), (y)); (x) = hi_; (y) = lo_; } while (0)
template <int N> __device__ __forceinline__ void tk_sort(int* v) {
#pragma unroll
    for (int k = 2; k <= N; k <<= 1)
#pragma unroll
        for (int j = k >> 1; j > 0; j >>= 1)
#pragma unroll
            for (int i = 0; i < N; ++i) { const int l = i ^ j; if (l > i) { if ((i & k) == 0) TK_CE(v[i], v[l]); else TK_CE(v[l], v[i]); } }
}
__device__ __forceinline__ void tk_merge16(int* a, const int* b) {
#pragma unroll
    for (int i = 0; i < 16; ++i) a[i] = max(a[i], b[15 - i]);
#pragma unroll
    for (int j = 8; j > 0; j >>= 1)
#pragma unroll
        for (int i = 0; i < 16; ++i) { const int l = i ^ j; if (l > i) TK_CE(a[i], a[l]); }
}
__device__ __forceinline__ void tk_merge_partner(int* a) {
    int lo[16], hi[16];
#pragma unroll
    for (int i = 0; i < 16; ++i) { auto rr = __builtin_amdgcn_permlane32_swap((unsigned)a[i], (unsigned)a[i], false, false); lo[i] = (int)rr[0]; hi[i] = (int)rr[1]; }
    tk_merge16(lo, hi);
#pragma unroll
    for (int i = 0; i < 16; ++i) a[i] = lo[i];
}
__device__ __forceinline__ void peer_topk_phase(const Frame& F0, const bf16_t* PQ, const bf16_t* subk  , int* IDX, float* GATE, bool lat_only) {
    const Frame F = phase_frame(F0);
    const int h = F.vcu & 7, jw = (F.vcu >> 3) * NWAVES + F.wave, nwh = (F.G >> 3) * NWAVES;
    {
        const bf16_t* src = subk + (size_t)h * 2 * 128 * 128;
        for (int c = F.tid; c < 4096; c += NTHREADS) { const int row = c >> 4, ch = c & 15;
            *(LAS u32x4*)(F.lds + row * 256 + ((ch ^ (row & 15)) << 4)) = *(const u32x4*)(src + (size_t)row * 128 + ch * 8); }
        __syncthreads();
    }
    const int ntg = lat_only ? 256 : MROWS / 32;
    const bool spread = (nwh == 256) && !lat_only;
    for (int kr = 0; ; ++kr) {
        int t;
        if (!spread) { t = jw + kr * nwh; if (t >= ntg) break; }
        else { if (kr == 0) t = jw; else if (kr == 1 && F.wave == 0 && (F.vcu >> 3) < ntg - 256) t = 256 + (F.vcu >> 3); else break; }
        int lane_ = F.lane; asm volatile("" : "+v"(lane_));
        const int r32 = lane_ & 31, hi = lane_ >> 5;
        int tg = t; if (lat_only) tg += 8 + (tg >= 128 ? 8 : 0);
        const int token = tg * 32 + r32;
        int top[2][16];
        const int kk = (((r32 & 14) | (hi ^ (r32 & 1))) << 4);
#pragma unroll
        for (int p = 0; p < 2; ++p) {
            bf16x8 bq[8];
            const bf16_t* qp = PQ + (size_t)token * DM + h * 256 + p * 128 + hi * 8;
#pragma unroll
            for (int ks = 0; ks < 8; ++ks) bq[ks] = *(const bf16x8*)(qp + ks * 16);
            int s[4][16];
#pragma unroll
            for (int nb = 0; nb < 4; ++nb) {
                f32x16 acc = {};
                const LAS unsigned char* kp = F.lds + (p * 128 + nb * 32 + r32) * 256;
#pragma unroll
                for (int ks = 0; ks < 8; ++ks) { const bf16x8 a = *(const LAS bf16x8*)(kp + (kk ^ (ks << 5))); acc = __builtin_amdgcn_mfma_f32_32x32x16_bf16(a, bq[ks], acc, 0, 0, 0); }
#pragma unroll
                for (int r = 0; r < 16; ++r) { const int key = nb * 32 + crow32(r, hi); s[nb][r] = fkey((int)((__float_as_uint(acc[r]) & ~127u) | (unsigned)(127 - key))); }
                tk_sort<16>(s[nb]);
            }
            tk_merge16(s[0], s[1]); tk_merge16(s[2], s[3]); tk_merge16(s[0], s[2]);
            tk_merge_partner(s[0]);
#pragma unroll
            for (int j = 0; j < 16; ++j) top[p][j] = s[0][j];
        }
        int cand[32];
        unsigned long long kaLo = 0ull, kaHi = 0ull, kbLo = 0ull, kbHi = 0ull;
        {
            float fb[16]; const float fa0 = __uint_as_float((unsigned)fkey(top[0][0]) & ~127u), fb0 = __uint_as_float((unsigned)fkey(top[1][0]) & ~127u);
#pragma unroll
            for (int r = 0; r < 16; ++r) { const int ba = fkey(top[0][r]), bb = fkey(top[1][r]); fb[r] = __uint_as_float((unsigned)bb & ~127u) - fb0;
                const unsigned long long xa = (unsigned long long)(unsigned)(127 - (ba & 127)) << (8 * (r & 7)), xb = (unsigned long long)(unsigned)(127 - (bb & 127)) << (8 * (r & 7));
                if (r < 8) { kaLo |= xa; kbLo |= xb; } else { kaHi |= xa; kbHi |= xb; } }
            float fa[8];
#pragma unroll
            for (int i = 0; i < 8; ++i) { const int ka = hi ? top[0][2 * i + 1] : top[0][2 * i]; fa[i] = __uint_as_float((unsigned)fkey(ka) & ~127u) - fa0; }
            const int hid = 255 - (hi << 4);
            int n = 0;
#pragma unroll
            for (int i = 0; i < 8; ++i)
#pragma unroll
                for (int b = 0; b < 16; ++b) if ((2 * i + 1) * (b + 1) <= 16) {
                    const float sum = fa[i] + fb[b];
                    cand[n++] = fkey((int)((__float_as_uint(sum) & ~255u) | (unsigned)(hid - (32 * i + b))));
                }
#pragma unroll
            for (; n < 32; ++n) cand[n] = (int)0x80000000;
        }
        tk_sort<16>(cand); tk_sort<16>(cand + 16); tk_merge16(cand, cand + 16);
        tk_merge_partner(cand);
        float ev[16]; float esum = 0.f;
#pragma unroll
        for (int j = 0; j < 16; ++j) { ev[j] = __expf(__uint_as_float((unsigned)fkey(cand[j]) & ~255u)); esum += ev[j]; }
        const float rs = 1.0f / esum;
        int oi[8]; float og[8];
#pragma unroll
        for (int j = 0; j < 8; ++j) { const int w = hi ? cand[8 + j] : cand[j]; const float e = hi ? ev[8 + j] : ev[j];
            const int id8 = 255 - (fkey(w) & 255), ra = id8 >> 4, rb = id8 & 15;
            const unsigned long long wa = (ra & 8) ? kaHi : kaLo, wb = (rb & 8) ? kbHi : kbLo;
            const int ka = (int)(wa >> (8 * (ra & 7))) & 127, kb = (int)(wb >> (8 * (rb & 7))) & 127;
            oi[j] = ka * 128 + kb; og[j] = e * rs; }
        int* ip = IDX + (size_t)token * 128 + h * 16 + hi * 8; float* gp = GATE + (size_t)token * 128 + h * 16 + hi * 8;
        *(int4*)ip = make_int4(oi[0], oi[1], oi[2], oi[3]); *(int4*)(ip + 4) = make_int4(oi[4], oi[5], oi[6], oi[7]);
        *(f32x4*)gp = (f32x4){og[0], og[1], og[2], og[3]}; *(f32x4*)(gp + 4) = (f32x4){og[4], og[5], og[6], og[7]};
    }
}

#if TAB_FP4
__device__ __forceinline__ void peer_expert_phase(const Frame& F0, const bf16_t* H2, const int* IDX, const float* GATE, const unsigned char* U, size_t v_minus_u_bytes, const float* USC, const float* VSC,
                                                  const float* g2  , float* XW, float* OUT,
                                                  bf16_t* HN  , const float* ng  , const float* nmod  ) {
    const Frame F = phase_frame(F0);
    LAS float* red = (LAS float*)F.lds;
    const unsigned voff_tab = (unsigned)v_minus_u_bytes;
    const __amdgpu_buffer_rsrc_t rs = __builtin_amdgcn_make_buffer_rsrc((void*)U, 0, (int)(voff_tab + (unsigned)NEXP * ROWB), 0x00020000);
    const int lane = F.lane; const int voff = lane * 16;
#define PX_SB() __builtin_amdgcn_sched_barrier(0)
#define PX_LOADALL(buf, ivv, tb) do { _Pragma("unroll") for (int e_ = 0; e_ < 16; ++e_) buf[e_] = __builtin_amdgcn_raw_buffer_load_b128(rs, voff, (unsigned)__builtin_amdgcn_readlane(ivv, e_) * (unsigned)ROWB + (tb), 0); } while (0)
#define PX_U1(d_, b_) { const bf16x2_t r2_ = __builtin_amdgcn_cvt_scalef32_pk_bf16_fp4(wd_[d_], 1.0f, b_); if ((b_) & 1) a1_ = __builtin_amdgcn_fdot2_f32_bf16(r2_, __builtin_bit_cast(bf16x2_t, xpk[4 * (d_) + (b_)]), a1_, false); \
                        else a0_ = __builtin_amdgcn_fdot2_f32_bf16(r2_, __builtin_bit_cast(bf16x2_t, xpk[4 * (d_) + (b_)]), a0_, false); }
#define PX_V1(d_, b_) { const f32x2 t2_ = __builtin_amdgcn_cvt_scalef32_pk_f32_fp4(wd_[d_], 1.0f, b_); acc[8 * (d_) + 2 * (b_)] += wg_ * t2_.x; acc[8 * (d_) + 2 * (b_) + 1] += wg_ * t2_.y; }
#define PX_FETCH_TOKEN(r, XP, IV, GV) do { const u32x4* xp_ = (const u32x4*)(H2 + (size_t)(r) * DM + lane * 16); XP[0] = xp_[0]; XP[1] = xp_[1]; XP[2] = xp_[128]; XP[3] = xp_[129]; \
        IV = 0; GV = 0.f; if (lane < 16) { IV = IDX[(size_t)(r) * 128 + F.wave * 16 + lane]; GV = GATE[(size_t)(r) * 128 + F.wave * 16 + lane]; } } while (0)
    const bool skip_ctx = (OUT != nullptr);
    int row = F.vcu; if (skip_ctx && row < MROWS && row_cls(row) == 2) row += F.G;
    u32x4 xp[4]; int iv; float gv;
    u32x4 ub[16], vb[16];
    if (row < MROWS) { PX_FETCH_TOKEN(row, xp, iv, gv); PX_LOADALL(ub, iv, 0u); PX_LOADALL(vb, iv, voff_tab); }
    int par = 0;
    while (row < MROWS) {
        int nrow = row + F.G; if (skip_ctx && nrow < MROWS && row_cls(nrow) == 2) nrow += F.G;
        float usc = 0.f, vsc = 0.f;
        if (lane < 16) { usc = USC[iv]; vsc = VSC[iv]; }
        u32x4 xpn[4]; int ivn = 0; float gvn = 0.f;
        if (nrow < MROWS) PX_FETCH_TOKEN(nrow, xpn, ivn, gvn);
        const int cls = row_cls(row);
        const f32x4 x_old = *((const f32x4*)(XW + (size_t)row * DM) + F.tid), g_vec = *((const f32x4*)(g2 + (size_t)cls * NMOD) + F.tid);
        f32x4 n_g = {0.f, 0.f, 0.f, 0.f}, n_sc = n_g, n_sh = n_g;
        if (HN) { n_g = *((const f32x4*)ng + F.tid); n_sc = *((const f32x4*)(nmod + (size_t)cls * NMOD + 2048) + F.tid); n_sh = *((const f32x4*)(nmod + (size_t)cls * NMOD) + F.tid); }
        const unsigned xpk[16] = {xp[0].x, xp[0].y, xp[0].z, xp[0].w, xp[1].x, xp[1].y, xp[1].z, xp[1].w, xp[2].x, xp[2].y, xp[2].z, xp[2].w, xp[3].x, xp[3].y, xp[3].z, xp[3].w};
        float sv = 0.f;
        PX_SB();
#pragma unroll
        for (int e = 0; e < 16; ++e) {
            u32x4 w_ = ub[e]; asm volatile("" : "+v"(w_) : "v"(sv));
            const unsigned wd_[4] = {w_.x, w_.y, w_.z, w_.w}; float a0_ = 0.f, a1_ = 0.f;
            PX_U1(0, 0) PX_U1(0, 1) PX_U1(0, 2) PX_U1(0, 3) PX_U1(1, 0) PX_U1(1, 1) PX_U1(1, 2) PX_U1(1, 3) PX_U1(2, 0) PX_U1(2, 1) PX_U1(2, 2) PX_U1(2, 3) PX_U1(3, 0) PX_U1(3, 1) PX_U1(3, 2) PX_U1(3, 3)
            const float t_ = wave_sum_dpp(a0_ + a1_); sv = (lane == e) ? t_ : sv;
        }
        const float wv = gelu_erf(sv * usc) * gv * vsc;
        PX_SB();
        if (nrow < MROWS) PX_LOADALL(ub, ivn, 0u);
        PX_SB();
        f32x32 acc = {};
#pragma unroll
        for (int e = 0; e < 16; ++e) {
            u32x4 w_ = vb[e]; asm volatile("" : "+v"(w_) : "v"(acc));
            const unsigned wd_[4] = {w_.x, w_.y, w_.z, w_.w}; const float wg_ = __uint_as_float(__builtin_amdgcn_readlane(__float_as_uint(wv), e));
            PX_V1(0, 0) PX_V1(0, 1) PX_V1(0, 2) PX_V1(0, 3) PX_V1(1, 0) PX_V1(1, 1) PX_V1(1, 2) PX_V1(1, 3) PX_V1(2, 0) PX_V1(2, 1) PX_V1(2, 2) PX_V1(2, 3) PX_V1(3, 0) PX_V1(3, 1) PX_V1(3, 2) PX_V1(3, 3)
        }
        PX_SB();
        if (nrow < MROWS) PX_LOADALL(vb, ivn, voff_tab);
        PX_SB();
        LAS float* rb = red + par * (NWAVES * DM);
#pragma unroll
        for (int j = 0; j < 2; ++j)
#pragma unroll
            for (int q = 0; q < 4; ++q) *(LAS f32x4*)(rb + F.wave * DM + j * 1024 + lane * 16 + q * 4) = (f32x4){acc[j * 16 + q * 4], acc[j * 16 + q * 4 + 1], acc[j * 16 + q * 4 + 2], acc[j * 16 + q * 4 + 3]};
        __syncthreads();
        {
            f32x4 sm = {0.f, 0.f, 0.f, 0.f};
#pragma unroll
            for (int w = 0; w < 8; ++w) sm += *(const LAS f32x4*)(rb + w * DM + F.tid * 4);
            f32x4* xq = (f32x4*)(XW + (size_t)row * DM) + F.tid;
            const f32x4 xn = x_old + g_vec * sm;
            *xq = xn;
            if (OUT) { const int b = row / RB, i = row - b * RB; if (i >= CTX) *((f32x4*)(OUT + ((size_t)b * SEQ + (i - CTX)) * DM) + F.tid) = xn; }
            if (HN) {
                LAS float* ssp = (LAS float*)(F.lds + 131072) + par * 8;
                const float sw = wave_sum_dpp((xn.x * xn.x + xn.y * xn.y) + (xn.z * xn.z + xn.w * xn.w));
                if (lane == 0) ssp[F.wave] = sw;
                __syncthreads();
                const float tot = ((ssp[0] + ssp[1]) + (ssp[2] + ssp[3])) + ((ssp[4] + ssp[5]) + (ssp[6] + ssp[7]));
                const float rstd = 1.0f / sqrtf(tot * (1.f / DM) + EPS);
                const f32x4 y = (xn * rstd) * n_g * (n_sc + 1.0f) + n_sh;
                u32x2 o; o.x = pk2(y.x, y.y); o.y = pk2(y.z, y.w);
                *((u32x2*)(HN + (size_t)row * DM) + F.tid) = o;
            }
        }
        par ^= 1; row = nrow;
#pragma unroll
        for (int q = 0; q < 4; ++q) xp[q] = xpn[q];
        iv = ivn; gv = gvn;
    }
#undef PX_LOADALL
#undef PX_U1
#undef PX_V1
#undef PX_SB
#undef PX_FETCH_TOKEN
}
#else
__device__ __forceinline__ void peer_expert_phase(const Frame& F0, const bf16_t* H2, const int* IDX, const float* GATE, const unsigned char* U, size_t v_minus_u_bytes, const float* USC, const float* VSC,
                                                  const float* g2  , float* XW, float* OUT,
                                                  bf16_t* HN  , const float* ng  , const float* nmod  ) {
    const Frame F = phase_frame(F0);
    LAS float* red = (LAS float*)F.lds;
    const unsigned voff_tab = (unsigned)v_minus_u_bytes;
    const __amdgpu_buffer_rsrc_t rs = __builtin_amdgcn_make_buffer_rsrc((void*)U, 0, (int)(voff_tab + (unsigned)NEXP * ROWB), 0x00020000);
    const int lane = F.lane; const int voff = lane * 16, voff2 = 1024 + lane * 8;
#define PX_SB() __builtin_amdgcn_sched_barrier(0)
#define PX_LOAD(buf, s, ivv) do { constexpr int e0_ = ((s) & 3) * 4; const unsigned tb_ = ((s) >= 4) ? voff_tab : 0u; \
        _Pragma("unroll") for (int ee_ = 0; ee_ < 4; ++ee_) { const unsigned o_ = (unsigned)__builtin_amdgcn_readlane(ivv, e0_ + ee_) * (unsigned)ROWB + tb_; \
            buf##h[ee_] = __builtin_amdgcn_raw_buffer_load_b128(rs, voff, o_, 0); buf##l[ee_] = __builtin_amdgcn_raw_buffer_load_b64(rs, voff2, o_, 0); } } while (0)
#define PX_DECODE(buf, ee_, dep) u32x6 w6_ = {buf##h[ee_].x, buf##h[ee_].y, buf##h[ee_].z, buf##h[ee_].w, buf##l[ee_].x, buf##l[ee_].y}; \
        asm volatile("" : "+v"(w6_) : "v"(dep));     \
        const f32x32 r_ = __builtin_amdgcn_cvt_scalef32_pk32_f32_fp6(w6_, 1.0f);
#define PX_COMP_U(buf, s) do { constexpr int e0_ = ((s) & 3) * 4; \
            _Pragma("unroll") for (int ee_ = 0; ee_ < 4; ++ee_) { PX_DECODE(buf, ee_, sv) \
                const f32x32 p_ = r_ * xf; float a0_ = 0.f, a1_ = 0.f; \
                _Pragma("unroll") for (int k_ = 0; k_ < 32; k_ += 2) { a0_ += p_[k_]; a1_ += p_[k_ + 1]; } \
                const float t_ = wave_sum_dpp(a0_ + a1_); sv = (lane == e0_ + ee_) ? t_ : sv; } } while (0)
#define PX_COMP_V(buf, s) do { constexpr int e0_ = ((s) & 3) * 4; \
            _Pragma("unroll") for (int ee_ = 0; ee_ < 4; ++ee_) { const float wg_ = __uint_as_float(__builtin_amdgcn_readlane(__float_as_uint(wv), e0_ + ee_)); \
                PX_DECODE(buf, ee_, acc) \
                acc += r_ * wg_; } } while (0)
#define PX_FETCH_TOKEN(r, XP, IV, GV) do { const u32x4* xp_ = (const u32x4*)(H2 + (size_t)(r) * DM + lane * 16); XP[0] = xp_[0]; XP[1] = xp_[1]; XP[2] = xp_[128]; XP[3] = xp_[129]; \
        IV = 0; GV = 0.f; if (lane < 16) { IV = IDX[(size_t)(r) * 128 + F.wave * 16 + lane]; GV = GATE[(size_t)(r) * 128 + F.wave * 16 + lane]; } } while (0)
    const bool skip_ctx = (OUT != nullptr);
    int row = F.vcu; if (skip_ctx && row < MROWS && row_cls(row) == 2) row += F.G;
    u32x4 xp[4]; int iv; float gv;
    u32x4 bAh[4], bBh[4]; u32x2 bAl[4], bBl[4];
    if (row < MROWS) { PX_FETCH_TOKEN(row, xp, iv, gv); PX_LOAD(bA, 0, iv); }
    int par = 0;
    while (row < MROWS) {
        int nrow = row + F.G; if (skip_ctx && nrow < MROWS && row_cls(nrow) == 2) nrow += F.G;
        f32x32 xf;
#pragma unroll
        for (int q = 0; q < 4; ++q) { const unsigned ww[4] = {xp[q].x, xp[q].y, xp[q].z, xp[q].w};
#pragma unroll
            for (int k = 0; k < 4; ++k) { xf[q * 8 + 2 * k] = bf_lo(ww[k]); xf[q * 8 + 2 * k + 1] = bf_hi(ww[k]); } }
        float usc = 0.f, vsc = 0.f;
        if (lane < 16) { usc = USC[iv]; vsc = VSC[iv]; }
        u32x4 xpn[4]; int ivn = 0; float gvn = 0.f;
        if (nrow < MROWS) PX_FETCH_TOKEN(nrow, xpn, ivn, gvn);
        const int cls = row_cls(row);
        const f32x4 x_old = *((const f32x4*)(XW + (size_t)row * DM) + F.tid), g_vec = *((const f32x4*)(g2 + (size_t)cls * NMOD) + F.tid);
        f32x4 n_g = {0.f, 0.f, 0.f, 0.f}, n_sc = n_g, n_sh = n_g;
        if (HN) { n_g = *((const f32x4*)ng + F.tid); n_sc = *((const f32x4*)(nmod + (size_t)cls * NMOD + 2048) + F.tid); n_sh = *((const f32x4*)(nmod + (size_t)cls * NMOD) + F.tid); }
        float sv = 0.f, wv = 0.f;
        PX_LOAD(bB, 1, iv); PX_SB(); PX_COMP_U(bA, 0); PX_SB();
        PX_LOAD(bA, 2, iv); PX_SB(); PX_COMP_U(bB, 1); PX_SB();
        PX_LOAD(bB, 3, iv); PX_SB(); PX_COMP_U(bA, 2); PX_SB();
        PX_LOAD(bA, 4, iv); PX_SB(); PX_COMP_U(bB, 3); PX_SB();
        wv = gelu_erf(sv * usc) * gv * vsc;
        f32x32 acc = {};
        PX_LOAD(bB, 5, iv); PX_SB(); PX_COMP_V(bA, 4); PX_SB();
        PX_LOAD(bA, 6, iv); PX_SB(); PX_COMP_V(bB, 5); PX_SB();
        PX_LOAD(bB, 7, iv); PX_SB(); PX_COMP_V(bA, 6); PX_SB();
        if (nrow < MROWS) PX_LOAD(bA, 0, ivn);
        PX_SB(); PX_COMP_V(bB, 7); PX_SB();
        LAS float* rb = red + par * (NWAVES * DM);
#pragma unroll
        for (int j = 0; j < 2; ++j)
#pragma unroll
            for (int q = 0; q < 4; ++q) *(LAS f32x4*)(rb + F.wave * DM + j * 1024 + lane * 16 + q * 4) = (f32x4){acc[j * 16 + q * 4], acc[j * 16 + q * 4 + 1], acc[j * 16 + q * 4 + 2], acc[j * 16 + q * 4 + 3]};
        __syncthreads();
        {
            f32x4 sm = {0.f, 0.f, 0.f, 0.f};
#pragma unroll
            for (int w = 0; w < 8; ++w) sm += *(const LAS f32x4*)(rb + w * DM + F.tid * 4);
            f32x4* xq = (f32x4*)(XW + (size_t)row * DM) + F.tid;
            const f32x4 xn = x_old + g_vec * sm;
            *xq = xn;
            if (OUT) { const int b = row / RB, i = row - b * RB; if (i >= CTX) *((f32x4*)(OUT + ((size_t)b * SEQ + (i - CTX)) * DM) + F.tid) = xn; }
            if (HN) {
                LAS float* ssp = (LAS float*)(F.lds + 131072) + par * 8;
                const float sw = wave_sum_dpp((xn.x * xn.x + xn.y * xn.y) + (xn.z * xn.z + xn.w * xn.w));
                if (lane == 0) ssp[F.wave] = sw;
                __syncthreads();
                const float tot = ((ssp[0] + ssp[1]) + (ssp[2] + ssp[3])) + ((ssp[4] + ssp[5]) + (ssp[6] + ssp[7]));
                const float rstd = 1.0f / sqrtf(tot * (1.f / DM) + EPS);
                const f32x4 y = (xn * rstd) * n_g * (n_sc + 1.0f) + n_sh;
                u32x2 o; o.x = pk2(y.x, y.y); o.y = pk2(y.z, y.w);
                *((u32x2*)(HN + (size_t)row * DM) + F.tid) = o;
            }
        }
        par ^= 1; row = nrow;
#pragma unroll
        for (int q = 0; q < 4; ++q) xp[q] = xpn[q];
        iv = ivn; gv = gvn;
    }
#undef PX_LOAD
#undef PX_COMP_U
#undef PX_COMP_V
#undef PX_SB
#undef PX_FETCH_TOKEN
}
#endif

#if EXP_SLICED && TAB_FP4
__device__ __forceinline__ float oct_sum(float v) { v = DPP_ADD(v, 0xB1); v = DPP_ADD(v, 0x4E); v = DPP_ADD(v, 0x141); return v; }
__device__ __forceinline__ int sl_next_tok(int t, int stride, bool lat_only) { t += stride; if (lat_only) while (t < MROWS && row_cls(t) == 2) t += stride; return t; }
#ifndef PROBE_IDMASK
#define PROBE_IDMASK 0x7fffffff
#endif
#define SL_CL(t_) ((t_) < MROWS ? (t_) : MROWS - 1)
#define SL_IDS(t_, A_, B_) do { A_ = IDX[(size_t)(t_) * 128 + lane] & idmask; B_ = IDX[(size_t)(t_) * 128 + 64 + lane] & idmask; } while (0)
#define SL_ROWS(buf, A_, B_) do { _Pragma("unroll") for (int i_ = 0; i_ < 16; ++i_) { const int id_ = __builtin_amdgcn_ds_bpermute(bp + 32 * (i_ & 7), (i_ < 8) ? (A_) : (B_)); \
        buf[i_] = __builtin_amdgcn_raw_buffer_load_b128(rs, id_ * 128 + coloff, 0, 0); } } while (0)
#if PEER_MFMA
typedef int i32x8 __attribute__((ext_vector_type(8)));
__device__ __forceinline__ void peer_u_phase(const Frame& F0, const unsigned* XQ, const float* XS, const int* IDX, const unsigned char* U, float* PART, bool lat_only, int idmask = 0x7fffffff) {
    const Frame F = phase_frame(F0);
    const int lane = F.lane, g = lane >> 3, j = lane & 7, bp = 4 * g, n = lane & 15, kb = lane >> 4;
    const int wps = F.G >> 3, x = F.vcu / wps, wi = (F.vcu - x * wps) * NWAVES + F.wave, stride = wps * NWAVES;
    const __amdgpu_buffer_rsrc_t rs = __builtin_amdgcn_make_buffer_rsrc((void*)(U + (size_t)x * (NEXP * 128)), 0, NEXP * 128, 0x00020000);
    const int coloff = 16 * j;
    LAS unsigned char* const lbase = F.lds + F.wave * 16384;
    LAS unsigned char* const wr_even = lbase + g * 128 + ((j ^ (g >> 1)) << 4);
    LAS unsigned char* const wr_odd = lbase + g * 128 + ((j ^ (g >> 1) ^ 4) << 4);
    LAS unsigned char* const rd0 = lbase + n * 128 + ((kb ^ (n >> 1)) << 4);
    LAS unsigned char* const rd1 = lbase + n * 128 + (((4 + kb) ^ (n >> 1)) << 4);
    int t = wi - stride; t = sl_next_tok(t, stride, lat_only);
    int t1 = sl_next_tok(t, stride, lat_only), t2 = sl_next_tok(t1, stride, lat_only);
    int idA1 = 0, idB1 = 0, idA2 = 0, idB2 = 0, idA3 = 0, idB3 = 0; u32x4 xs[4], xs1[4], xs2[4], w[16], wn[16];
#define SL_XS(dst, t_) do { const u32x4* xp_ = (const u32x4*)((const unsigned char*)XQ + (size_t)(t_) * DM + 256 * x + 16 * kb); dst[0] = xp_[0]; dst[1] = xp_[4]; dst[2] = xp_[8]; dst[3] = xp_[12]; } while (0)
    { int idA0, idB0; const int c0_ = SL_CL(t), c1_ = SL_CL(t1), c2_ = SL_CL(t2); SL_IDS(c0_, idA0, idB0); SL_XS(xs1, c0_); SL_ROWS(w, idA0, idB0); SL_IDS(c1_, idA2, idB2); SL_XS(xs2, c1_); SL_IDS(c2_, idA3, idB3); }
#define SL_UBODY(CUR, NXT) do { \
        const int t3 = sl_next_tok(t2, stride, lat_only); \
_Pragma("unroll") \
        for (int q = 0; q < 4; ++q) { xs[q] = xs1[q]; xs1[q] = xs2[q]; } \
        idA1 = idA2; idB1 = idB2; idA2 = idA3; idB2 = idB3; \
        SL_ROWS(NXT, idA1, idB1); \
        { const int c2_ = SL_CL(t2), c3_ = SL_CL(t3); SL_XS(xs2, c2_); SL_IDS(c3_, idA3, idB3); } \
_Pragma("unroll") \
        for (int i = 0; i < 16; ++i) *(LAS u32x4*)(((i & 1) ? wr_odd : wr_even) + i * 1024) = CUR[i]; \
        const i32x8 a0 = {(int)xs[0].x, (int)xs[0].y, (int)xs[0].z, (int)xs[0].w, (int)xs[1].x, (int)xs[1].y, (int)xs[1].z, (int)xs[1].w}; \
        const i32x8 a1 = {(int)xs[2].x, (int)xs[2].y, (int)xs[2].z, (int)xs[2].w, (int)xs[3].x, (int)xs[3].y, (int)xs[3].z, (int)xs[3].w}; \
        float res_lo = 0.f, res_hi = 0.f; \
_Pragma("unroll") \
        for (int h = 0; h < 8; ++h) { \
            const u32x4 r0_ = *(LAS u32x4*)(rd0 + h * 2048), r1_ = *(LAS u32x4*)(rd1 + h * 2048); \
            const i32x8 b0 = {(int)r0_.x, (int)r0_.y, (int)r0_.z, (int)r0_.w, 0, 0, 0, 0}; \
            const i32x8 b1 = {(int)r1_.x, (int)r1_.y, (int)r1_.z, (int)r1_.w, 0, 0, 0, 0}; \
            f32x4 d = {0.f, 0.f, 0.f, 0.f}; \
            d = __builtin_amdgcn_mfma_scale_f32_16x16x128_f8f6f4(a0, b0, d, 0, 4, 0, 0, 0, 0); \
            d = __builtin_amdgcn_mfma_scale_f32_16x16x128_f8f6f4(a1, b1, d, 0, 4, 0, 0, 0, 0); \
            if (h < 4) res_lo = (kb == h) ? d[0] : res_lo; else res_hi = (kb == h - 4) ? d[0] : res_hi; \
        } \
        float* pp = PART + ((size_t)t * 8 + x) * 128 + lane; \
        pp[0] = res_lo; pp[64] = res_hi; \
        t = t1; t1 = t2; t2 = t3; \
    } while (0)
    while (t < MROWS) { SL_UBODY(w, wn); if (!(t < MROWS)) break; SL_UBODY(wn, w); }
#undef SL_UBODY
#undef SL_XS
}
#else
__device__ __forceinline__ void peer_u_phase(const Frame& F0, const unsigned* XQ, const float* XS, const int* IDX, const unsigned char* U, float* PART, bool lat_only, int idmask = 0x7fffffff) {
    const Frame F = phase_frame(F0);
    const int lane = F.lane, g = lane >> 3, j = lane & 7, bp = 4 * g;
    const int wps = F.G >> 3, x = F.vcu / wps, wi = (F.vcu - x * wps) * NWAVES + F.wave, stride = wps * NWAVES;
    const __amdgpu_buffer_rsrc_t rs = __builtin_amdgcn_make_buffer_rsrc((void*)(U + (size_t)x * (NEXP * 128)), 0, NEXP * 128, 0x00020000);
    const int coloff = 16 * j;
    int t = wi - stride; t = sl_next_tok(t, stride, lat_only);
    int t1 = sl_next_tok(t, stride, lat_only), t2 = sl_next_tok(t1, stride, lat_only);
    int idA1 = 0, idB1 = 0, idA2 = 0, idB2 = 0, idA3 = 0, idB3 = 0; u32x4 xs[3], xs1[3], xs2[3], w[16], wn[16];
#define SL_XS(dst, t_) do { const u32x4* xp_ = (const u32x4*)(XQ + ((size_t)(t_) * 64 + 8 * x + j) * 8); dst[0] = xp_[0]; dst[1] = xp_[1]; const f32x2 s2_ = *(const f32x2*)(XS + ((size_t)(t_) * 64 + 8 * x + j) * 2); dst[2] = (u32x4){__float_as_uint(s2_.x), __float_as_uint(s2_.y), 0u, 0u}; } while (0)
    { int idA0, idB0; const int c0_ = SL_CL(t), c1_ = SL_CL(t1), c2_ = SL_CL(t2); SL_IDS(c0_, idA0, idB0); SL_XS(xs1, c0_); SL_ROWS(w, idA0, idB0); SL_IDS(c1_, idA2, idB2); SL_XS(xs2, c1_); SL_IDS(c2_, idA3, idB3); }
#define SL_UBODY(CUR, NXT) do { \
        const int t3 = sl_next_tok(t2, stride, lat_only); \
_Pragma("unroll") \
        for (int q = 0; q < 3; ++q) { xs[q] = xs1[q]; xs1[q] = xs2[q]; } \
        idA1 = idA2; idB1 = idB2; idA2 = idA3; idB2 = idB3; \
        SL_ROWS(NXT, idA1, idB1); \
        { const int c2_ = SL_CL(t2), c3_ = SL_CL(t3); SL_XS(xs2, c2_); SL_IDS(c3_, idA3, idB3); } \
        const int xh[4] = {(int)xs[0].x, (int)xs[0].y, (int)xs[0].z, (int)xs[0].w}, xl[4] = {(int)xs[1].x, (int)xs[1].y, (int)xs[1].z, (int)xs[1].w}; \
        const float dq = __uint_as_float(xs[2].x), off = __uint_as_float(xs[2].y); \
        float res_lo = 0.f, res_hi = 0.f; \
_Pragma("unroll") \
        for (int i = 0; i < 16; ++i) { \
            const int wd_[4] = {(int)CUR[i].x, (int)CUR[i].y, (int)CUR[i].z, (int)CUR[i].w}; int ah_ = 0, al_ = 0; \
_Pragma("unroll") \
            for (int d = 0; d < 4; ++d) { ah_ = __builtin_amdgcn_sdot8(wd_[d], xh[d], ah_, false); al_ = __builtin_amdgcn_sdot8(wd_[d], xl[d], al_, false); } \
            const float a_ = oct_sum(((float)(16 * ah_ + al_) + off) * dq); \
            if (i < 8) res_lo = (j == i) ? a_ : res_lo; else res_hi = (j == i - 8) ? a_ : res_hi; \
        } \
        float* pp = PART + ((size_t)t * 8 + x) * 128 + 8 * j + g; \
        pp[0] = res_lo; pp[64] = res_hi; \
        t = t1; t1 = t2; t2 = t3; \
    } while (0)
    while (t < MROWS) { SL_UBODY(w, wn); if (!(t < MROWS)) break; SL_UBODY(wn, w); }
#undef SL_UBODY
#undef SL_XS
}
#endif
#if PEER_VMFMA
typedef int i32x8v __attribute__((ext_vector_type(8)));
typedef int i32x2v __attribute__((ext_vector_type(2)));
constexpr int WQ_U = 2;
__device__ __forceinline__ void peer_wq_phase(const Frame& F0, const float* PART, const int* IDX, const float* GATE, const float* USC, const float* VSC, bool lat_only, unsigned char* WQ8, float* WSC, const float* XS = nullptr) {
    const Frame F = phase_frame(F0);
    const int lane = F.lane;
    for (int t0 = F.gw; t0 < MROWS; t0 += WQ_U * F.NGW) {
        float s[WQ_U][2]; int id[WQ_U][2]; float gt[WQ_U][2]; bool ok[WQ_U];
#pragma unroll
        for (int u = 0; u < WQ_U; ++u) { const int t = t0 + u * F.NGW; ok[u] = t < MROWS && !(lat_only && row_cls(t) == 2);
            s[u][0] = s[u][1] = 0.f; id[u][0] = id[u][1] = 0; gt[u][0] = gt[u][1] = 0.f;
            if (ok[u]) { const float* pp = PART + (size_t)t * 1024 + lane;
#pragma unroll
                for (int xx = 0; xx < 8; ++xx) { s[u][0] += pp[xx * 128]; s[u][1] += pp[xx * 128 + 64]; }
                id[u][0] = IDX[(size_t)t * 128 + lane]; id[u][1] = IDX[(size_t)t * 128 + 64 + lane]; gt[u][0] = GATE[(size_t)t * 128 + lane]; gt[u][1] = GATE[(size_t)t * 128 + 64 + lane]; } }
        float us[WQ_U][2], vs[WQ_U][2];
#pragma unroll
        for (int u = 0; u < WQ_U; ++u)
#pragma unroll
            for (int q = 0; q < 2; ++q) { us[u][q] = ok[u] ? USC[id[u][q]] : 0.f; vs[u][q] = ok[u] ? VSC[id[u][q]] : 0.f; }
#pragma unroll
        for (int u = 0; u < WQ_U; ++u) if (ok[u]) { const int t = t0 + u * F.NGW;
#if PEER_MFMA
            { const float xsc = XS[t]; us[u][0] *= xsc; us[u][1] *= xsc; }
#endif
            const float w0 = gt[u][0] * gelu_erf(s[u][0] * us[u][0]) * vs[u][0], w1 = gt[u][1] * gelu_erf(s[u][1] * us[u][1]) * vs[u][1];
            const float am = fmaxf(wave_max_dpp(fmaxf(fabsf(w0), fabsf(w1))), 1e-30f), qs = 440.0f / am;
            const int pk = __builtin_amdgcn_cvt_pk_fp8_f32(w0 * qs, w1 * qs, 0, false);
            WQ8[(size_t)t * 128 + lane] = (unsigned char)(pk & 0xff); WQ8[(size_t)t * 128 + 64 + lane] = (unsigned char)((pk >> 8) & 0xff);
            if (lane == 0) WSC[t] = am * (1.0f / 440.0f); }
    }
}
__device__ __forceinline__ void peer_v_phase(const Frame& F0, const int* IDX, const unsigned char* WQ8, const float* WSC, const unsigned char* VT, const float* g2  , bf16_t* XW, float* OUT, bool lat_only) {
    const int idmask = 0x7fffffff;
    const Frame F = phase_frame(F0);
    const int lane = F.lane, g = lane >> 3, j = lane & 7, bp = 4 * g, n = lane & 15, kb = lane >> 4;
    const int wps = F.G >> 3, x = F.vcu / wps, wi = (F.vcu - x * wps) * NWAVES + F.wave, stride = wps * NWAVES;
    const __amdgpu_buffer_rsrc_t rs = __builtin_amdgcn_make_buffer_rsrc((void*)(VT + (size_t)x * (NEXP * 128)), 0, NEXP * 128, 0x00020000);
    const int coloff = 16 * j;
    LAS unsigned char* const lbase = F.lds + F.wave * 16384;
    LAS unsigned char* const wr_even = lbase + g * 128 + ((j ^ (g >> 1)) << 4);
    LAS unsigned char* const wr_odd = lbase + g * 128 + ((j ^ (g >> 1) ^ 4) << 4);
    LAS unsigned char* const rd_row = lbase + (32 * kb + n) * 128;
    const int rsw = (n >> 1) << 4;
    const int col0 = 256 * x + lane;
    int t = wi - stride; t = sl_next_tok(t, stride, lat_only);
    int t1 = sl_next_tok(t, stride, lat_only), t2 = sl_next_tok(t1, stride, lat_only);
    int idA1 = 0, idB1 = 0, idA2 = 0, idB2 = 0, idA3 = 0, idB3 = 0; u32x4 w[16], wn[16];
    u32x4 wa[2], wa1[2], wa2[2]; float sc = 0.f, sc1 = 0.f, sc2 = 0.f;
    float xo[4], gv[4], xo1[4], gv1[4], xo2[4], gv2[4];
#pragma unroll
    for (int q = 0; q < 4; ++q) { xo[q] = gv[q] = xo1[q] = gv1[q] = xo2[q] = gv2[q] = 0.f; }
    wa[0] = wa[1] = wa1[0] = wa1[1] = wa2[0] = wa2[1] = (u32x4){0u, 0u, 0u, 0u};
#define SL_WA(dst, S_, t_) do { const u32x4* wp_ = (const u32x4*)(WQ8 + (size_t)(t_) * 128 + 16 * kb); dst[0] = wp_[0]; dst[1] = wp_[4]; S_ = WSC[t_]; } while (0)
#define SL_XG(t_, X_, G_) do { const bf16_t* xp_ = XW + (size_t)(t_) * DM + col0; const float* gp_ = g2 + (size_t)row_cls(t_) * NMOD + col0; _Pragma("unroll") for (int q_ = 0; q_ < 4; ++q_) { X_[q_] = bf2f(xp_[64 * q_]); G_[q_] = gp_[64 * q_]; } } while (0)
    { int idA0, idB0; const int c0_ = SL_CL(t), c1_ = SL_CL(t1), c2_ = SL_CL(t2); SL_IDS(c0_, idA0, idB0); SL_WA(wa1, sc1, c0_); SL_XG(c0_, xo1, gv1); SL_ROWS(w, idA0, idB0);
      SL_IDS(c1_, idA2, idB2); SL_WA(wa2, sc2, c1_); SL_XG(c1_, xo2, gv2); SL_IDS(c2_, idA3, idB3); }
#define SL_VBODY(CUR, NXT) do { \
        const int t3 = sl_next_tok(t2, stride, lat_only); \
        wa[0] = wa1[0]; wa[1] = wa1[1]; wa1[0] = wa2[0]; wa1[1] = wa2[1]; sc = sc1; sc1 = sc2; \
_Pragma("unroll") \
        for (int q = 0; q < 4; ++q) { xo[q] = xo1[q]; gv[q] = gv1[q]; xo1[q] = xo2[q]; gv1[q] = gv2[q]; } \
        idA1 = idA2; idB1 = idB2; idA2 = idA3; idB2 = idB3; \
        SL_ROWS(NXT, idA1, idB1); \
        { const int c2_ = SL_CL(t2), c3_ = SL_CL(t3); SL_WA(wa2, sc2, c2_); SL_XG(c2_, xo2, gv2); SL_IDS(c3_, idA3, idB3); } \
_Pragma("unroll") \
        for (int i = 0; i < 16; ++i) *(LAS u32x4*)(((i & 1) ? wr_odd : wr_even) + i * 1024) = CUR[i]; \
        const i32x8v a = {(int)wa[0].x, (int)wa[0].y, (int)wa[0].z, (int)wa[0].w, (int)wa[1].x, (int)wa[1].y, (int)wa[1].z, (int)wa[1].w}; \
        float vs[4] = {0.f, 0.f, 0.f, 0.f}; \
_Pragma("unroll") \
        for (int cb = 0; cb < 16; ++cb) { \
            LAS unsigned char* ra_ = rd_row + ((((cb >> 1) << 4) ^ rsw) + ((cb & 1) << 3)); \
            const i32x2v lo_ = __builtin_amdgcn_ds_read_tr4_b64_v2i32((LAS i32x2v*)ra_), hi_ = __builtin_amdgcn_ds_read_tr4_b64_v2i32((LAS i32x2v*)(ra_ + 2048)); \
            const i32x8v b_ = {lo_.x, lo_.y, hi_.x, hi_.y, 0, 0, 0, 0}; \
            const f32x4 z_ = {0.f, 0.f, 0.f, 0.f}; \
            const f32x4 d_ = __builtin_amdgcn_mfma_scale_f32_16x16x128_f8f6f4(a, b_, z_, 0, 4, 0, 0, 0, 0); \
            vs[cb >> 2] = (kb == (cb & 3)) ? d_[0] : vs[cb >> 2]; \
        } \
        { const int b = t / RB, i = t - b * RB; \
_Pragma("unroll") \
          for (int q = 0; q < 4; ++q) { const float xn = xo[q] + gv[q] * (sc * vs[q]); XW[(size_t)t * DM + col0 + 64 * q] = (bf16_t)f2bf(xn); \
              if (OUT) { if (i >= CTX) OUT[((size_t)b * SEQ + (i - CTX)) * DM + col0 + 64 * q] = xn; } } } \
        t = t1; t1 = t2; t2 = t3; \
    } while (0)
    while (t < MROWS) { SL_VBODY(w, wn); if (!(t < MROWS)) break; SL_VBODY(wn, w); }
#undef SL_VBODY
#undef SL_WA
#undef SL_XG
}
#else
__device__ __forceinline__ void peer_w_phase(const Frame& F0, const float* PART, const int* IDX, float* GATE, const float* USC, const float* VSC, bool lat_only, const float* XS = nullptr) {
    const Frame F = phase_frame(F0);
    const int gt = F.vcu * NTHREADS + F.tid, GT = F.G * NTHREADS;
    for (int e0 = gt; e0 < MROWS * 128; e0 += 4 * GT) {
        float s[4]; int id[4]; float gte[4], us[4], vs[4]; bool ok[4];
#pragma unroll
        for (int u = 0; u < 4; ++u) { const int e = e0 + u * GT; ok[u] = e < MROWS * 128 && !(lat_only && row_cls(e >> 7) == 2); s[u] = 0.f; id[u] = 0; gte[u] = 0.f;
            if (ok[u]) { const float* pp = PART + (size_t)(e >> 7) * 1024 + (e & 127);
#pragma unroll
                for (int xx = 0; xx < 8; ++xx) s[u] += pp[xx * 128];
                id[u] = IDX[e]; gte[u] = GATE[e]; } }
#pragma unroll
        for (int u = 0; u < 4; ++u) { us[u] = ok[u] ? USC[id[u]] : 0.f; vs[u] = ok[u] ? VSC[id[u]] : 0.f;
#if PEER_MFMA
            if (ok[u]) us[u] *= XS[(e0 + u * GT) >> 7];
#endif
        }
#pragma unroll
        for (int u = 0; u < 4; ++u) if (ok[u]) GATE[e0 + u * GT] = gte[u] * gelu_erf(s[u] * us[u]) * vs[u];
    }
}
#ifdef SELFTEST
#define SELFTEST_LEAK * (1.0f + sqrtf(*(const volatile float*)((const unsigned char*)XW - WS_XW + WS_CTL + 32768)))
#define SELFTEST_SPIKE do { if (b == 0 && i == CTX && mycol == 0) xo_.x += *(const volatile float*)((const unsigned char*)XW - WS_XW + WS_CTL + 32772); } while (0)
#else
#define SELFTEST_LEAK
#define SELFTEST_SPIKE do {} while (0)
#endif
__device__ __forceinline__ void peer_v_phase(const Frame& F0, const int* IDX, const float* WK, const unsigned char* VT, const float* g2  , float* XW, float* OUT, bool lat_only) {
    const int idmask = 0x7fffffff;
    const Frame F = phase_frame(F0);
    const int lane = F.lane, g = lane >> 3, j = lane & 7, bp = 4 * g;
    const int wps = F.G >> 3, x = F.vcu / wps, wi = (F.vcu - x * wps) * NWAVES + F.wave, stride = wps * NWAVES;
    const __amdgpu_buffer_rsrc_t rs = __builtin_amdgcn_make_buffer_rsrc((void*)(VT + (size_t)x * (NEXP * 128)), 0, NEXP * 128, 0x00020000);
    const int coloff = 16 * j;
    const int mycol = 256 * x + 32 * j + 4 * g;
    int t = wi - stride; t = sl_next_tok(t, stride, lat_only);
    int t1 = sl_next_tok(t, stride, lat_only), t2 = sl_next_tok(t1, stride, lat_only);
    int idA1 = 0, idB1 = 0, idA2 = 0, idB2 = 0, idA3 = 0, idB3 = 0; float wA = 0.f, wB = 0.f, wA1 = 0.f, wB1 = 0.f, wA2 = 0.f, wB2 = 0.f; u32x4 w[16], wn[16];
    f32x4 x_old = {0.f, 0.f, 0.f, 0.f}, g_vec = x_old, xo1 = x_old, gv1 = x_old, xo2 = x_old, gv2 = x_old;
#define SL_WK(t_, A_, B_) do { A_ = WK[(size_t)(t_) * 128 + lane]; B_ = WK[(size_t)(t_) * 128 + 64 + lane]; } while (0)
#define SL_XG(t_, X_, G_) do { X_ = *(const f32x4*)(XW + (size_t)(t_) * DM + mycol); G_ = *(const f32x4*)(g2 + (size_t)row_cls(t_) * NMOD + mycol); } while (0)
    if (t < MROWS) { int idA0, idB0; SL_IDS(t, idA0, idB0); SL_WK(t, wA1, wB1); SL_XG(t, xo1, gv1); SL_ROWS(w, idA0, idB0); }
    if (t1 < MROWS) { SL_IDS(t1, idA2, idB2); SL_WK(t1, wA2, wB2); SL_XG(t1, xo2, gv2); }
    if (t2 < MROWS) SL_IDS(t2, idA3, idB3);
#define SL_V1(d_, b_) { const h2_t r2_ = __builtin_amdgcn_cvt_scalef32_pk_f16_fp4(wd_[d_], 1.0f, b_); acc[4 * (d_) + (b_)] = __builtin_elementwise_fma(r2_, wg2_, acc[4 * (d_) + (b_)]); }
#define SL_VBODY(CUR, NXT) do { \
        const int t3 = sl_next_tok(t2, stride, lat_only); \
        wA = wA1; wB = wB1; wA1 = wA2; wB1 = wB2; x_old = xo1; g_vec = gv1; xo1 = xo2; gv1 = gv2; \
        idA1 = idA2; idB1 = idB2; idA2 = idA3; idB2 = idB3; \
        if (t1 < MROWS) SL_ROWS(NXT, idA1, idB1); \
        if (t2 < MROWS) { SL_WK(t2, wA2, wB2); SL_XG(t2, xo2, gv2); } \
        if (t3 < MROWS) SL_IDS(t3, idA3, idB3); \
        h2_t acc[16]; \
_Pragma("unroll") \
        for (int p = 0; p < 16; ++p) acc[p] = (h2_t){(_Float16)0.f, (_Float16)0.f}; \
_Pragma("unroll") \
        for (int i = 0; i < 16; ++i) { \
            const unsigned wd_[4] = {CUR[i].x, CUR[i].y, CUR[i].z, CUR[i].w}; \
            const float wgf_ = __int_as_float(__builtin_amdgcn_ds_bpermute(bp + 32 * (i & 7), __float_as_int((i < 8) ? wA : wB))); \
            const _Float16 wgh_ = (_Float16)wgf_; const h2_t wg2_ = {wgh_, wgh_}; \
            SL_V1(0, 0) SL_V1(0, 1) SL_V1(0, 2) SL_V1(0, 3) SL_V1(1, 0) SL_V1(1, 1) SL_V1(1, 2) SL_V1(1, 3) SL_V1(2, 0) SL_V1(2, 1) SL_V1(2, 2) SL_V1(2, 3) SL_V1(3, 0) SL_V1(3, 1) SL_V1(3, 2) SL_V1(3, 3) \
        } \
        unsigned m0 = 0u, m1 = 0u; \
_Pragma("unroll") \
        for (int p = 0; p < 16; ++p) { \
            h2_t v = acc[p]; \
            v = v + __builtin_bit_cast(h2_t, __builtin_amdgcn_update_dpp(0, __builtin_bit_cast(int, v), 0x128, 0xf, 0xf, true)); \
            { auto r = __builtin_amdgcn_permlane16_swap(__builtin_bit_cast(unsigned, v), __builtin_bit_cast(unsigned, v), false, false); v = __builtin_bit_cast(h2_t, (unsigned)r[0]) + __builtin_bit_cast(h2_t, (unsigned)r[1]); } \
            { auto r = __builtin_amdgcn_permlane32_swap(__builtin_bit_cast(unsigned, v), __builtin_bit_cast(unsigned, v), false, false); v = __builtin_bit_cast(h2_t, (unsigned)r[0]) + __builtin_bit_cast(h2_t, (unsigned)r[1]); } \
            if (g == (p >> 1)) { if (p & 1) m1 = __builtin_bit_cast(unsigned, v); else m0 = __builtin_bit_cast(unsigned, v); } \
        } \
        const h2_t q0 = __builtin_bit_cast(h2_t, m0), q1 = __builtin_bit_cast(h2_t, m1); \
        const f32x4 mine = {(float)q0.x, (float)q0.y, (float)q1.x, (float)q1.y}; \
        const f32x4 xn = x_old + g_vec * mine; \
        *(f32x4*)(XW + (size_t)t * DM + mycol) = xn; \
        if (OUT) { const int b = t / RB, i = t - b * RB; if (i >= CTX) { f32x4 xo_ = xn SELFTEST_LEAK; SELFTEST_SPIKE; *(f32x4*)(OUT + ((size_t)b * SEQ + (i - CTX)) * DM + mycol) = xo_; } } \
        t = t1; t1 = t2; t2 = t3; \
    } while (0)
    while (t < MROWS) { SL_VBODY(w, wn); if (!(t < MROWS)) break; SL_VBODY(wn, w); }
#undef SL_VBODY
#undef SL_V1
#undef SL_WK
#undef SL_XG
}
#endif
#undef SL_IDS
#undef SL_ROWS
#undef SL_CL
#endif
#ifndef N_LAUNCHES
#define N_LAUNCHES 1
#endif
struct Args { const float* in[26]; float* out; unsigned char* ws; int ph_lo, ph_hi; };
constexpr int NPHASES = 39;
__global__ void __launch_bounds__(NTHREADS, 2) fwd_kernel(Args args) {
    extern __shared__ __attribute__((aligned(16))) unsigned char lds_raw[];
    Frame F_;
    F_.lds = (LAS unsigned char*)lds_raw;
    F_.tid = threadIdx.x; F_.lane = F_.tid & 63; F_.wave = __builtin_amdgcn_readfirstlane(F_.tid >> 6);
    F_.G = gridDim.x; { const int bx = blockIdx.x; F_.vcu = (F_.G % 8 == 0) ? (bx % 8) * (F_.G / 8) + bx / 8 : bx; }
    F_.gw = F_.vcu * NWAVES + F_.wave; F_.NGW = F_.G * NWAVES;
    F_.ws = args.ws;
    volatile LAS unsigned* MISC = (volatile LAS unsigned*)(F_.lds + LDS_MISC);
    if (F_.tid < 32) MISC[F_.tid] = 0u;
    __syncthreads();
    const int lo = args.ph_lo, hi = args.ph_hi;
    XcdBarrier bar; bar.bar = (unsigned*)(args.ws + WS_CTL) + CW_BAR; bar.x = 0; bar.st = nullptr;
    if (N_LAUNCHES == 1 || hi - lo > 1) bar = xcd_barrier_post((unsigned*)(args.ws + WS_CTL) + CW_BAR, MISC + 8);
#if N_LAUNCHES == 1
#define IN(k) true
#define SEAM(k) xcd_barrier(bar)
#else
#define IN(k) (lo <= (k) && (k) < hi)
#define SEAM(k) do { if (IN(k) && IN((k) + 1)) xcd_barrier(bar); } while (0)
#endif
    PG8_LAS unsigned char* glds = (PG8_LAS unsigned char*)lds_raw;

    if (IN(0)) { p0_prologue(F_, args.in); } SEAM(0);

#pragma unroll 1
    for (int lp = 0; lp < 2; ++lp) {
        const int pb = 1 + lp * 19;
        unsigned char* ws = args.ws; asm volatile("" : "+s"(ws));
        Frame F = F_; { int w_ = F_.wave, v_ = F_.vcu, g_ = F_.G; asm volatile("" : "+s"(w_), "+s"(v_), "+s"(g_)); F.wave = w_; F.vcu = v_; F.G = g_; F.gw = v_ * NWAVES + w_; F.NGW = g_ * NWAVES; F.ws = ws; }
        float* mod = (float*)(ws + WS_MOD); bf16_t* XW = (bf16_t*)(ws + WS_XW);
        bf16_t* H = (bf16_t*)(ws + WS_H); bf16_t* P = (bf16_t*)(ws + WS_P); bf16_t* QRAW = (bf16_t*)(ws + WS_QRAW); bf16_t* KVRAW = (bf16_t*)(ws + WS_KVRAW);
        bf16_t* Q = (bf16_t*)(ws + WS_Q); bf16_t* KB = (bf16_t*)(ws + WS_K); bf16_t* VB = (bf16_t*)(ws + WS_V); bf16_t* CAT = (bf16_t*)(ws + WS_CAT); bf16_t* PQ = (bf16_t*)(ws + WS_PQ);
        int* IDX = (int*)(ws + WS_IDX); float* GATE = (float*)(ws + WS_GATE);
        const float* rope_c = (const float*)(ws + WS_ROPE); const float* rope_a = rope_c + 64 * 32 * 2;
        const float* SMv = (const float*)(ws + WS_SMALL);
        {
            const int l = 2 * lp, i = lp;
            const float* modl = mod + (size_t)l * 3 * NMOD;
            if (lp == 0) { if (IN(pb + 0)) { norm_phase(F, XW, SMv + SM_N1G + l * DM, modl, 0, 2048, H, false); } SEAM(pb + 0); }
            if (IN(pb + 1)) {
                pg8::Gemm g{H, (const bf16_t*)(ws + WS_WIN) + (size_t)i * 4096 * DM, MROWS, 4096, DM, DM, DM}; pg8::StaticOrder S; S.init(MROWS, 4096, F.G, (int)blockIdx.x, true);
                pg8::EpiBf16 E{P, 4096};
                ctx_gemm_phase<false>(F, H, DM, (const bf16_t*)(ws + WS_WIN) + (size_t)i * 4096 * DM, DM, 4096, DM, P, nullptr, 4096, nullptr);
                pg8::gemm_phase<pg8::EpiBf16, pg8::StaticOrder, true, true>(glds, g, S, E, phase_tid(F.wave));
            } SEAM(pb + 1);
            if (IN(pb + 2)) {
                { pg8::Gemm g{P, (const bf16_t*)(ws + WS_WUQ) + (size_t)i * 1536 * 512, MROWS, 1536, 512, 4096, 512}; pg8::StaticOrder S; S.init(MROWS, 1536, F.G, (int)blockIdx.x);
                  pg8::EpiBf16 E{QRAW, 1536};
                  pg8::gemm_phase<pg8::EpiBf16, pg8::StaticOrder, true, true>(glds, g, S, E, phase_tid(F.wave)); }
                __syncthreads();
                { pg8::Gemm g{P + 512, (const bf16_t*)(ws + WS_WUKV) + (size_t)i * 2048 * 256, MROWS, 2048, 256, 4096, 256}; pg8::StaticOrder S; S.init(MROWS, 2048, F.G, (int)blockIdx.x);
                  pg8::EpiBf16 E{KVRAW, 2048};
                  pg8::gemm_phase<pg8::EpiBf16, pg8::StaticOrder, true, true>(glds, g, S, E, phase_tid(F.wave)); }
                __syncthreads();
                conv_phase(F, P, SMv + SM_CW + i * 3072, SMv + SM_CB + i * 1024, CAT);
            } SEAM(pb + 2);
            if (IN(pb + 3)) { prep_even_phase(F, P, QRAW, KVRAW, SMv + SM_AQG + i * 192, SMv + SM_AKG + i * 192, rope_a, Q, KB, VB); } SEAM(pb + 3);
            if (IN(pb + 4)) { attn_even_phase(F, Q, KB, VB, CAT); } SEAM(pb + 4);
            if (IN(pb + 5)) {
                pg8::Gemm g{CAT, (const bf16_t*)(ws + WS_WEO) + (size_t)i * DM * DM, MROWS, DM, DM, DM, DM}; pg8::StaticOrder S; S.init(MROWS, DM, F.G, (int)blockIdx.x, true);
                pg8::EpiResid E{XW, DM, modl + 4096};
                ctx_gemm_phase<true>(F, CAT, DM, (const bf16_t*)(ws + WS_WEO) + (size_t)i * DM * DM, DM, DM, DM, nullptr, XW, DM, modl + 4096);
                pg8::gemm_phase<pg8::EpiResid, pg8::StaticOrder, true, true>(glds, g, S, E, phase_tid(F.wave));
            } SEAM(pb + 5);
            if (IN(pb + 6)) { norm_phase(F, XW, SMv + SM_N2G + l * DM, modl, 6144, 8192, H, l == 3, (unsigned*)(ws + WS_XQ), (float*)(ws + WS_XS)); } SEAM(pb + 6);
            if (IN(pb + 7)) {
                pg8::Gemm g{H, (const bf16_t*)(ws + WS_WPQ) + (size_t)l * DM * DM, MROWS, DM, DM, DM, DM}; pg8::StaticOrder S; S.init(MROWS, DM, F.G, (int)blockIdx.x, true);
                pg8::EpiBf16 E{PQ, DM};
                ctx_gemm_phase<false>(F, H, DM, (const bf16_t*)(ws + WS_WPQ) + (size_t)l * DM * DM, DM, DM, DM, PQ, nullptr, DM, nullptr);
                pg8::gemm_phase<pg8::EpiBf16, pg8::StaticOrder, true, true>(glds, g, S, E, phase_tid(F.wave));
            } SEAM(pb + 7);
            if (IN(pb + 8)) { peer_topk_phase(F, PQ, (const bf16_t*)(ws + WS_SUBK) + (size_t)l * 16 * 128 * 128, IDX, GATE, l == 3); } SEAM(pb + 8);
            {
                const unsigned char* Ut = ws + WS_U + (size_t)l * NEXP * ROWB; const unsigned char* Vt = ws + WS_VT + (size_t)l * NEXP * ROWB;
                peer_u_phase(F, (const unsigned*)(ws + WS_XQ), (const float*)(ws + WS_XS), IDX, Ut, (float*)(ws + WS_PART), false); SEAM(0);
                peer_wq_phase(F, (const float*)(ws + WS_PART), IDX, GATE, (const float*)(ws + WS_USC) + l * NEXP, (const float*)(ws + WS_VSC) + l * NEXP, false, ws + WS_WQ8, (float*)(ws + WS_WSC), (const float*)(ws + WS_XS)); SEAM(0);
                peer_v_phase(F, IDX, ws + WS_WQ8, (const float*)(ws + WS_WSC), Vt, modl + 10240, XW, nullptr, false); SEAM(0);
                norm_phase(F, XW, SMv + SM_N1G + (l + 1) * DM, mod + (size_t)(l + 1) * 3 * NMOD, 0, 2048, H, false); SEAM(0);
            }
        }
        {
            const int l = 2 * lp + 1, i = lp, qb = pb + 10;
            const float* modl = mod + (size_t)l * 3 * NMOD;
            if (IN(qb + 1)) {
                pg8::Gemm g{H, (const bf16_t*)(ws + WS_WQKV) + (size_t)i * 3072 * DM, MROWS, 3072, DM, DM, DM}; pg8::StaticOrder S; S.init(MROWS, 3072, F.G, (int)blockIdx.x);
                pg8::EpiBf16 E{P, 3072};
                pg8::gemm_phase<pg8::EpiBf16, pg8::StaticOrder, true, true>(glds, g, S, E, phase_tid(F.wave));
            } SEAM(qb + 1);
            if (IN(qb + 2)) { prep_odd_phase(F, P, SMv + SM_CQG + i * 128, SMv + SM_CKG + i * 128, rope_c, Q, KB); } SEAM(qb + 2);
            if (IN(qb + 3)) { attn_odd_phase(F, Q, KB, P, CAT, l == 3); } SEAM(qb + 3);
            if (IN(qb + 4)) {
                pg8::Gemm g{CAT, (const bf16_t*)(ws + WS_WCO) + (size_t)i * DM * DM, MROWS, DM, DM, DM, DM}; pg8::StaticOrder S; S.init(MROWS, DM, F.G, (int)blockIdx.x, true);
                pg8::EpiResid E{XW, DM, modl + 4096};
                if (l != 3) ctx_gemm_phase<true>(F, CAT, DM, (const bf16_t*)(ws + WS_WCO) + (size_t)i * DM * DM, DM, DM, DM, nullptr, XW, DM, modl + 4096);
                pg8::gemm_phase<pg8::EpiResid, pg8::StaticOrder, true, true>(glds, g, S, E, phase_tid(F.wave));
            } SEAM(qb + 4);
            if (IN(qb + 5)) { norm_phase(F, XW, SMv + SM_N2G + l * DM, modl, 6144, 8192, H, l == 3, (unsigned*)(ws + WS_XQ), (float*)(ws + WS_XS)); } SEAM(qb + 5);
            if (IN(qb + 6)) {
                pg8::Gemm g{H, (const bf16_t*)(ws + WS_WPQ) + (size_t)l * DM * DM, MROWS, DM, DM, DM, DM}; pg8::StaticOrder S; S.init(MROWS, DM, F.G, (int)blockIdx.x, true);
                pg8::EpiBf16 E{PQ, DM};
                if (l != 3) ctx_gemm_phase<false>(F, H, DM, (const bf16_t*)(ws + WS_WPQ) + (size_t)l * DM * DM, DM, DM, DM, PQ, nullptr, DM, nullptr);
                pg8::gemm_phase<pg8::EpiBf16, pg8::StaticOrder, true, true>(glds, g, S, E, phase_tid(F.wave));
            } SEAM(qb + 6);
            if (IN(qb + 7)) { peer_topk_phase(F, PQ, (const bf16_t*)(ws + WS_SUBK) + (size_t)l * 16 * 128 * 128, IDX, GATE, l == 3); } SEAM(qb + 7);
            {
                const unsigned char* Ut = ws + WS_U + (size_t)l * NEXP * ROWB; const unsigned char* Vt = ws + WS_VT + (size_t)l * NEXP * ROWB;
                peer_u_phase(F, (const unsigned*)(ws + WS_XQ), (const float*)(ws + WS_XS), IDX, Ut, (float*)(ws + WS_PART), l == 3); SEAM(0);
                peer_wq_phase(F, (const float*)(ws + WS_PART), IDX, GATE, (const float*)(ws + WS_USC) + l * NEXP, (const float*)(ws + WS_VSC) + l * NEXP, l == 3, ws + WS_WQ8, (float*)(ws + WS_WSC), (const float*)(ws + WS_XS)); SEAM(0);
                peer_v_phase(F, IDX, ws + WS_WQ8, (const float*)(ws + WS_WSC), Vt, modl + 10240, XW, (l == 3) ? args.out : nullptr, l == 3);
                if (lp == 0) { SEAM(0); norm_phase(F, XW, SMv + SM_N1G + (l + 1) * DM, mod + (size_t)(l + 1) * 3 * NMOD, 0, 2048, H, false); SEAM(0); }
            }
        }
    }
#undef IN
#undef SEAM
}

extern "C" void kernel_launch(void* const* d_in, const int* in_sizes, int n_in, void* d_out, int out_size, void* d_ws, size_t ws_size, hipStream_t stream) {
    static int grid = 0;
    if (grid == 0) {
        if (n_in != 26 || out_size != NBATCH * SEQ * DM || ws_size < WS_END) { fprintf(stderr, "kernel_launch: unexpected shapes: n_in %d out %d ws %zu (need %zu)\n", n_in, out_size, ws_size, (size_t)WS_END); grid = -1; return; }
        int dev = 0, cus = 0, per_cu = 0;
        if (hipGetDevice(&dev) != hipSuccess || hipDeviceGetAttribute(&cus, hipDeviceAttributeMultiprocessorCount, dev) != hipSuccess) { fprintf(stderr, "kernel_launch: device query failed\n"); grid = -1; return; }
        if (hipFuncSetAttribute((const void*)fwd_kernel, hipFuncAttributeMaxDynamicSharedMemorySize, LDS_BYTES) != hipSuccess) { fprintf(stderr, "kernel_launch: hipFuncSetAttribute failed\n"); grid = -1; return; }
        if (hipOccupancyMaxActiveBlocksPerMultiprocessor(&per_cu, (const void*)fwd_kernel, NTHREADS, LDS_BYTES) != hipSuccess || per_cu < 1) { fprintf(stderr, "kernel_launch: occupancy query says %d blocks per CU\n", per_cu); (void)hipGetLastError(); grid = -1; return; }
        if (cus % 8 != 0) { fprintf(stderr, "kernel_launch: %d CUs: the phase decompositions assume a multiple of 8 workgroups\n", cus); grid = -1; return; }
        grid = cus;
    }
    if (grid < 0) return;
    (void)hipMemsetAsync((char*)d_ws + WS_CTL, 0, CTL_ZERO_BYTES, stream);
    Args a{};
    for (int i = 0; i < 26; ++i) a.in[i] = (const float*)d_in[i];
    a.out = (float*)d_out; a.ws = (unsigned char*)d_ws;
    for (int li = 0; li < N_LAUNCHES; ++li) {
        a.ph_lo = (N_LAUNCHES == 1) ? 0 : li; a.ph_hi = (N_LAUNCHES == 1) ? NPHASES : li + 1;
        hipLaunchKernelGGL(fwd_kernel, dim3(grid), dim3(NTHREADS), LDS_BYTES, stream, a);
        const hipError_t le = hipPeekAtLastError();
        if (le != hipSuccess) { fprintf(stderr, "kernel_launch: launch %d failed: %s\n", li, hipGetErrorName(le)); break; }
    }
}
```

```cpp
#include <hip/hip_runtime.h>
#include <cstdio>
#include <cstdint>
namespace pg8 {
#define PG8_LAS __attribute__((address_space(3)))
typedef unsigned short bf16_t;
typedef short bf16x8 __attribute__((ext_vector_type(8)));
typedef float f32x4 __attribute__((ext_vector_type(4)));
typedef unsigned u32x4 __attribute__((ext_vector_type(4)));
constexpr int BM = 256, BK = 64, HALF = 128, HTB = HALF * BK * 2  , STAGE_BYTES = 8 * HTB, NXCD = 8, WGM = 8;

__host__ __device__ __forceinline__ int lds_byte(int r, int c) { const int st = (r >> 4) * 2 + (c >> 5), rr = r & 15, cc = c & 31, ob = rr * 64 + cc * 2; return st * 1024 + (ob ^ (((ob >> 9) & 1) << 5)); }
__host__ __device__ __forceinline__ void stage_rc(int b, int& R, int& C) { const int st = b / 1024, sb = b % 1024, swz = sb ^ (((sb >> 9) & 1) << 5); R = (st >> 1) * 16 + swz / 64; C = (st & 1) * 32 + (swz % 64) / 2; }
__host__ __device__ __forceinline__ int perm32(int rho) { const int n = rho >> 4, i = rho & 15; return 8 * (i >> 2) + 4 * n + (i & 3); }

struct Unit { int pm, pn; };
struct Gemm { const bf16_t* A; const bf16_t* Bt; int M, N, K, lda, ldb; };

struct StaticOrder {
    int nM, nN, nwg, G, c; bool lat_only;
    __host__ __device__ void init(int M, int N, int G_, int c_, bool lat_only_ = false) { lat_only = lat_only_; nM = lat_only_ ? 32 : M / BM; nN = N / BM; nwg = nM * nN; G = G_; c = c_; }
    __host__ __device__ bool next(int i, Unit& u) const {
        const long L = (long)i * G + c; if (L >= nwg) return false;
        int wgid = (int)L; { const int q = nwg / NXCD, r = nwg % NXCD, xcd = wgid % NXCD, off = wgid / NXCD; wgid = (xcd < r ? xcd * (q + 1) : r * (q + 1) + (xcd - r) * q) + off; }
        const int nig = WGM * nN, gid = wgid / nig, fm = gid * WGM, gsz = (nM - fm) < WGM ? (nM - fm) : WGM;
        u.pm = fm + ((wgid % nig) % gsz); u.pn = (wgid % nig) / gsz; if (lat_only) u.pm += 1 + (u.pm >= 16 ? 1 : 0); return true;
    }
    __device__ __forceinline__ void a_ready(const Unit&) const {}
    __device__ __forceinline__ void done(const Unit&) const {}
};
__device__ __forceinline__ unsigned cvt_pk_bf16(float lo, float hi) { unsigned r; asm volatile("v_cvt_pk_bf16_f32 %0, %1, %2" : "=v"(r) : "v"(lo), "v"(hi)); return r; }
typedef float f32x2 __attribute__((ext_vector_type(2)));
struct EpiBf16 {
    static constexpr bool PERM = true, AFTER_DRAIN = false;
    bf16_t* O; int ldc;
    __device__ __forceinline__ void operator()(const f32x4 (&acc)[2][2][4][2], const Unit& u, int wr, int wc, int fr, int fq) const {
        const int row0 = u.pm * BM + wr * 64 + fr, col0 = u.pn * BM + wc * 32 + 8 * fq;
#pragma unroll
        for (int ai = 0; ai < 2; ++ai)
#pragma unroll
            for (int m = 0; m < 4; ++m) { bf16_t* rowp = O + (size_t)(row0 + ai * HALF + m * 16) * ldc + col0;
#pragma unroll
                for (int bj = 0; bj < 2; ++bj) { const f32x4 v0 = acc[ai][bj][m][0], v1 = acc[ai][bj][m][1];
                    u32x4 w; w.x = cvt_pk_bf16(v0[0], v0[1]); w.y = cvt_pk_bf16(v0[2], v0[3]); w.z = cvt_pk_bf16(v1[0], v1[1]); w.w = cvt_pk_bf16(v1[2], v1[3]);
                    *(u32x4*)(rowp + bj * HALF) = w; } }
    }
};
struct EpiResid {
    static constexpr bool PERM = false, AFTER_DRAIN = false;
    bf16_t* X; int ldc; const float* gate;
    __device__ __forceinline__ void operator()(const f32x4 (&acc)[2][2][4][2], const Unit& u, int wr, int wc, int fr, int fq) const {
        const int row0 = u.pm * BM + wr * 64 + fr, col0 = u.pn * BM + wc * 32 + 4 * fq;
        const int cls = (u.pm % 17 == 0) ? 2 : (u.pm / 17);
        const float* gp = gate + (size_t)cls * 12288 + col0;
        f32x4 gv[2][2];
#pragma unroll
        for (int bj = 0; bj < 2; ++bj)
#pragma unroll
            for (int n = 0; n < 2; ++n) gv[bj][n] = *(const f32x4*)(gp + bj * HALF + n * 16);
#pragma unroll
        for (int ai = 0; ai < 2; ++ai)
#pragma unroll
            for (int m = 0; m < 4; ++m) { bf16_t* rowp = X + (size_t)(row0 + ai * HALF + m * 16) * ldc + col0;
#pragma unroll
                for (int bj = 0; bj < 2; ++bj)
#pragma unroll
                    for (int n = 0; n < 2; ++n) { typedef unsigned u32x2_ __attribute__((ext_vector_type(2))); u32x2_* p = (u32x2_*)(rowp + bj * HALF + n * 16); const u32x2_ w_ = *p;
                        const f32x4 xo_ = {__builtin_bit_cast(float, w_.x << 16), __builtin_bit_cast(float, w_.x & 0xffff0000u), __builtin_bit_cast(float, w_.y << 16), __builtin_bit_cast(float, w_.y & 0xffff0000u)};
                        const f32x4 xn_ = xo_ + gv[bj][n] * acc[ai][bj][m][n]; u32x2_ o_; o_.x = cvt_pk_bf16(xn_[0], xn_[1]); o_.y = cvt_pk_bf16(xn_[2], xn_[3]); *p = o_; } }
    }
};
template <class Epi, class Sched, bool ALIGN_EPI = false, bool SP2 = false>
__device__ __forceinline__ void gemm_phase(PG8_LAS unsigned char* lds, const Gemm g, const Sched& S, const Epi& E, int tid_in) {
    int tid_ = tid_in; asm volatile("" : "+v"(tid_));
    const int tid = tid_, wid = __builtin_amdgcn_readfirstlane(tid >> 6), lane = tid & 63, wr = wid >> 2, wc = wid & 3, fr = lane & 15, fq = lane >> 4;
    const int K = g.K, nt = K / BK;
    unsigned voffA[2], voffB[2];
#pragma unroll
    for (int i = 0; i < 2; ++i) { int R, C; stage_rc(tid * 16 + i * 8192, R, C); const int Rb = Epi::PERM ? ((R & ~31) + perm32(R & 31)) : R;
        voffA[i] = (unsigned)(R * g.lda + C) * 2u; voffB[i] = (unsigned)(Rb * g.ldb + C) * 2u; }
    const size_t kstep = (size_t)(BK * 2);
    const size_t hstepA = (size_t)HALF * g.lda * 2, hstepB = (size_t)HALF * g.ldb * 2;
    const size_t tstepA = 2 * hstepA, tstepB = 2 * hstepB;
    const unsigned ldsw = (unsigned)wid * 1024u;
    const int aoff = lds_byte(wr * 64 + fr, fq * 8), boff = lds_byte(wc * 32 + fr, fq * 8);
#define PG8_SA(b, h) (((b) * 2 + (h)) * HTB)
#define PG8_SB(b, h) ((4 + (b) * 2 + (h)) * HTB)
#define PG8_STAGE(bufoff, gbase, voff) do { _Pragma("unroll") for (int _i = 0; _i < 2; ++_i) \
        __builtin_amdgcn_global_load_lds((const unsigned*)((const char*)(gbase) + (voff)[_i]), (PG8_LAS unsigned*)(lds + (bufoff) + ldsw + _i * 8192), 16, 0, 0); } while (0)
#define PG8_LDA(dst, b, h) do { _Pragma("unroll") for (int m = 0; m < 4; ++m) _Pragma("unroll") for (int k = 0; k < 2; ++k) dst[m][k] = *(const PG8_LAS bf16x8*)(lds + PG8_SA(b, h) + aoff + m * 2048 + k * 1024); } while (0)
#define PG8_LDB(dst, b, h) do { _Pragma("unroll") for (int n = 0; n < 2; ++n) _Pragma("unroll") for (int k = 0; k < 2; ++k) dst[n][k] = *(const PG8_LAS bf16x8*)(lds + PG8_SB(b, h) + boff + n * 2048 + k * 1024); } while (0)
#define PG8_MMA(ai, bj, At, Bt) do { __builtin_amdgcn_s_setprio(1); _Pragma("unroll") for (int m = 0; m < 4; ++m) _Pragma("unroll") for (int n = 0; n < 2; ++n) _Pragma("unroll") for (int k = 0; k < 2; ++k) \
        acc[ai][bj][m][n] = __builtin_amdgcn_mfma_f32_16x16x32_bf16(Bt[n][k], At[m][k], acc[ai][bj][m][n], 0, 0, 0); __builtin_amdgcn_s_setprio(0); } while (0)
#define PG8_WAIT_V(n) asm volatile("s_waitcnt vmcnt(" #n ")" ::: "memory")
#define PG8_WAIT_L(n) asm volatile("s_waitcnt lgkmcnt(" #n ")" ::: "memory")
#define PG8_BAR __builtin_amdgcn_s_barrier()
#define PG8_SCHED __builtin_amdgcn_sched_barrier(0)
    Unit cur, nxt; int ui = 0;
    if (!S.next(0, cur)) return;
    f32x4 acc[2][2][4][2];
#pragma unroll
    for (int a = 0; a < 2; ++a)
#pragma unroll
        for (int b = 0; b < 2; ++b)
#pragma unroll
            for (int m = 0; m < 4; ++m)
#pragma unroll
                for (int n = 0; n < 2; ++n) acc[a][b][m][n] = (f32x4){0.f, 0.f, 0.f, 0.f};
    bf16x8 At[4][2], B0[2][2], B1[2][2];
    const char* cA = (const char*)g.A + (size_t)cur.pm * tstepA; const char* cB = (const char*)g.Bt + (size_t)cur.pn * tstepB;
    S.a_ready(cur);
    if constexpr (SP2) {
        PG8_STAGE(PG8_SB(0, 0), cB, voffB); PG8_STAGE(PG8_SB(0, 1), cB + hstepB, voffB); PG8_STAGE(PG8_SA(0, 0), cA, voffA); PG8_STAGE(PG8_SA(0, 1), cA + hstepA, voffA);
        if (wr == 1) PG8_BAR;
        PG8_WAIT_V(2); PG8_BAR;
        PG8_STAGE(PG8_SB(1, 0), cB + kstep, voffB); PG8_STAGE(PG8_SA(1, 0), cA + kstep, voffA); PG8_STAGE(PG8_SB(1, 1), cB + hstepB + kstep, voffB);
        PG8_WAIT_V(6); PG8_BAR;
    } else {
        PG8_STAGE(PG8_SB(0, 0), cB, voffB); PG8_STAGE(PG8_SA(0, 0), cA, voffA); PG8_STAGE(PG8_SB(0, 1), cB + hstepB, voffB); PG8_STAGE(PG8_SA(0, 1), cA + hstepA, voffA);
        if (wr == 1) PG8_BAR;
        PG8_WAIT_V(4); PG8_BAR;
        PG8_STAGE(PG8_SB(1, 0), cB + kstep, voffB); PG8_STAGE(PG8_SA(1, 0), cA + kstep, voffA); PG8_STAGE(PG8_SB(1, 1), cB + hstepB + kstep, voffB);
        PG8_WAIT_V(6); PG8_BAR;
    }
    for (;;) {
        const bool has_next = S.next(ui + 1, nxt);
        const char* nA = has_next ? (const char*)g.A + (size_t)nxt.pm * tstepA : cA; const char* nB = has_next ? (const char*)g.Bt + (size_t)nxt.pn * tstepB : cB;
        for (int t = 0; t < nt; t += 2) {
            const bool last = (t == nt - 2);
            const char* a1 = cA + (size_t)(t + 1) * kstep;
            const char* a2 = last ? nA : cA + (size_t)(t + 2) * kstep; const char* b2 = last ? nB : cB + (size_t)(t + 2) * kstep;
            const char* a3 = a2 + kstep; const char* b3 = b2 + kstep;
            if (last && has_next) S.a_ready(nxt);
            if constexpr (SP2) {
            PG8_LDB(B0, 0, 0); PG8_LDB(B1, 0, 1); PG8_SCHED; PG8_LDA(At, 0, 0); PG8_STAGE(PG8_SA(1, 1), a1 + hstepA, voffA);
            PG8_WAIT_V(8); PG8_WAIT_L(0); PG8_BAR; PG8_MMA(0, 0, At, B0); PG8_MMA(0, 1, At, B1); PG8_BAR; PG8_SCHED;
            PG8_LDA(At, 0, 1); PG8_STAGE(PG8_SB(0, 0), b2, voffB); PG8_STAGE(PG8_SB(0, 1), b2 + hstepB, voffB); PG8_STAGE(PG8_SA(0, 0), a2, voffA);
            PG8_WAIT_V(8); PG8_WAIT_L(0); PG8_BAR; PG8_MMA(1, 0, At, B0); PG8_MMA(1, 1, At, B1); PG8_BAR; PG8_SCHED;
            PG8_LDB(B0, 1, 0); PG8_LDB(B1, 1, 1); PG8_SCHED; PG8_LDA(At, 1, 0); PG8_STAGE(PG8_SA(0, 1), a2 + hstepA, voffA);
            PG8_WAIT_V(8); PG8_WAIT_L(0); PG8_BAR; PG8_MMA(0, 0, At, B0); PG8_MMA(0, 1, At, B1); PG8_BAR; PG8_SCHED;
            PG8_LDA(At, 1, 1); PG8_STAGE(PG8_SB(1, 0), b3, voffB); PG8_STAGE(PG8_SB(1, 1), b3 + hstepB, voffB); PG8_STAGE(PG8_SA(1, 0), a3, voffA);
            PG8_WAIT_V(8); PG8_WAIT_L(0); PG8_BAR; PG8_MMA(1, 0, At, B0); PG8_MMA(1, 1, At, B1); PG8_BAR; PG8_SCHED;
            } else {
            PG8_LDB(B0, 0, 0); PG8_SCHED; PG8_LDA(At, 0, 0); PG8_STAGE(PG8_SA(1, 1), a1 + hstepA, voffA);
            PG8_WAIT_L(8); PG8_BAR; PG8_WAIT_L(0); PG8_MMA(0, 0, At, B0); PG8_BAR; PG8_SCHED;
            PG8_LDB(B1, 0, 1); PG8_STAGE(PG8_SB(0, 0), b2, voffB);
            PG8_BAR; PG8_WAIT_L(0); PG8_MMA(0, 1, At, B1); PG8_BAR;
            PG8_LDA(At, 0, 1); PG8_STAGE(PG8_SA(0, 0), a2, voffA);
            PG8_BAR; PG8_WAIT_L(0); PG8_MMA(1, 0, At, B0); PG8_BAR; PG8_SCHED;
            PG8_STAGE(PG8_SB(0, 1), b2 + hstepB, voffB);
            PG8_WAIT_V(6); PG8_BAR; PG8_MMA(1, 1, At, B1); PG8_BAR;
            PG8_LDB(B0, 1, 0); PG8_SCHED; PG8_LDA(At, 1, 0); PG8_STAGE(PG8_SA(0, 1), a2 + hstepA, voffA);
            PG8_WAIT_L(8); PG8_BAR; PG8_WAIT_L(0); PG8_MMA(0, 0, At, B0); PG8_BAR; PG8_SCHED;
            PG8_LDB(B1, 1, 1); PG8_STAGE(PG8_SB(1, 0), b3, voffB);
            PG8_BAR; PG8_WAIT_L(0); PG8_MMA(0, 1, At, B1); PG8_BAR;
            PG8_LDA(At, 1, 1); PG8_STAGE(PG8_SA(1, 0), a3, voffA);
            PG8_BAR; PG8_WAIT_L(0); PG8_MMA(1, 0, At, B0); PG8_BAR; PG8_SCHED;
            PG8_STAGE(PG8_SB(1, 1), b3 + hstepB, voffB);
            PG8_WAIT_V(6); PG8_BAR; PG8_MMA(1, 1, At, B1); PG8_BAR;
            }
        }
        if constexpr (ALIGN_EPI) { if (wr == 0) PG8_BAR; }
        if constexpr (!Epi::AFTER_DRAIN) { E(acc, cur, wr, wc, fr, fq); S.done(cur); }
        if (!has_next) break;
#pragma unroll
        for (int a = 0; a < 2; ++a)
#pragma unroll
            for (int b = 0; b < 2; ++b)
#pragma unroll
                for (int m = 0; m < 4; ++m)
#pragma unroll
                    for (int n = 0; n < 2; ++n) acc[a][b][m][n] = (f32x4){0.f, 0.f, 0.f, 0.f};
        cur = nxt; cA = nA; cB = nB; ++ui;
        if constexpr (ALIGN_EPI) { if (wr == 1) PG8_BAR; }
    }
    PG8_WAIT_V(0);
    if constexpr (!ALIGN_EPI) { if (wr == 0) PG8_BAR; }
    PG8_BAR;
    if constexpr (Epi::AFTER_DRAIN) { E.fused(acc, cur, wr, wc, fr, fq, lds, wid, lane); S.done(cur); }
#undef PG8_SA
#undef PG8_SB
#undef PG8_STAGE
#undef PG8_LDA
#undef PG8_LDB
#undef PG8_MMA
#undef PG8_WAIT_V
#undef PG8_WAIT_L
#undef PG8_BAR
#undef PG8_SCHED
}
}
namespace att {
typedef unsigned short bf16_t;
using bf16x8 = __attribute__((ext_vector_type(8))) short;
using s16x4  = __attribute__((ext_vector_type(4))) short;
using f32x16 = __attribute__((ext_vector_type(16))) float;
using u32x4  = __attribute__((ext_vector_type(4))) unsigned;
constexpr int DV = 128, NW = 8, QBLK = 32, KVBLK = 64;
constexpr float THR = 8.f;
constexpr int SHM_V = KVBLK * DV * 2;
template <int DQK> struct Cfg {
    static constexpr int SHM_K = KVBLK * DQK * 2, KROWB = DQK * 2, NCK = DQK / 64, C8 = DQK / 8, ND0 = DQK / 16;
    static constexpr float SCALE = (DQK == 128) ? 0.088388347648318440f : 0.072168783648703220f;
    static constexpr int LDS_BYTES = 2 * SHM_V + 2 * SHM_K + NW * 64 * 4;
};
#define ATT_SBAR() __builtin_amdgcn_sched_barrier(0)
__device__ __forceinline__ int crow(int r, int hi) { return (r & 3) + 8 * (r >> 2) + 4 * hi; }
__device__ __forceinline__ unsigned cvtpk(float lo, float hi) { unsigned r; asm volatile("v_cvt_pk_bf16_f32 %0, %1, %2" : "=v"(r) : "v"(lo), "v"(hi)); return r; }
template <int DQK> __device__ __forceinline__ int kswz(int row, int colB) {
    const int key = (DQK == 128) ? (row & 7) : ((row >> 1) & 7);
    return row * (DQK * 2) + (colB ^ (key << 4));
}
template <int DQK> __device__ __forceinline__ void partialSM(f32x16& p0, f32x16& p1, float& m_reg, float& mn, float& alpha) {
    constexpr float SCALE = Cfg<DQK>::SCALE, C = SCALE * 1.4426950408889634f;
    float pmax = p0[0];
#pragma unroll
    for (int r = 1; r < 16; ++r) pmax = fmaxf(pmax, p0[r]);
#pragma unroll
    for (int r = 0; r < 16; ++r) pmax = fmaxf(pmax, p1[r]);
    { auto rr = __builtin_amdgcn_permlane32_swap(__float_as_uint(pmax), __float_as_uint(pmax), false, false);
      pmax = fmaxf(__uint_as_float(rr[0]), __uint_as_float(rr[1])); }
    if (__builtin_expect(__all(pmax - m_reg <= THR / SCALE), 1)) { mn = m_reg; alpha = 1.f; }
    else { mn = fmaxf(m_reg, pmax); alpha = __builtin_amdgcn_exp2f((m_reg - mn) * C); m_reg = mn; }
    const float mnC = -mn * C;
#pragma unroll
    for (int r = 0; r < 16; ++r) p0[r] = fmaf(p0[r], C, mnC);
#pragma unroll
    for (int r = 0; r < 16; ++r) p1[r] = fmaf(p1[r], C, mnC);
#pragma unroll
    for (int r = 0; r < 16; ++r) p0[r] = __builtin_amdgcn_exp2f(p0[r]);
}
__device__ __forceinline__ void finishSM(f32x16& p0, f32x16& p1, float alpha, float& l_reg, bf16x8& pa0, bf16x8& pa1, bf16x8& pa2, bf16x8& pa3) {
#pragma unroll
    for (int r = 0; r < 16; ++r) p1[r] = __builtin_amdgcn_exp2f(p1[r]);
    float ps = 0;
#pragma unroll
    for (int r = 0; r < 16; ++r) ps += p0[r];
#pragma unroll
    for (int r = 0; r < 16; ++r) ps += p1[r];
    { auto rr = __builtin_amdgcn_permlane32_swap(__float_as_uint(ps), __float_as_uint(ps), false, false);
      ps = __uint_as_float(rr[0]) + __uint_as_float(rr[1]); }
    l_reg = l_reg * alpha + ps;
#define ATT_PK4(P, BASE, OUT) do { unsigned a0 = cvtpk(P[BASE + 0], P[BASE + 1]), a1 = cvtpk(P[BASE + 2], P[BASE + 3]);   \
    unsigned b0 = cvtpk(P[BASE + 4], P[BASE + 5]), b1 = cvtpk(P[BASE + 6], P[BASE + 7]);                              \
    auto r0 = __builtin_amdgcn_permlane32_swap(a0, b0, false, false); auto r1 = __builtin_amdgcn_permlane32_swap(a1, b1, false, false); \
    u32x4 w = {r0[0], r1[0], r0[1], r1[1]}; OUT = *reinterpret_cast<bf16x8*>(&w); } while (0)
    ATT_PK4(p0, 0, pa0); ATT_PK4(p0, 8, pa1); ATT_PK4(p1, 0, pa2); ATT_PK4(p1, 8, pa3);
#undef ATT_PK4
}
template <int DQK> __device__ __forceinline__ void qkt(f32x16& p0, f32x16& p1, const char* Ks, const bf16x8* qr, int r32, int hi) {
    p0 = f32x16{}; p1 = f32x16{};
#pragma unroll
    for (int d0 = 0; d0 < Cfg<DQK>::ND0; ++d0) { const int cb = (d0 * 16 + hi * 8) * 2;
        bf16x8 b0 = *reinterpret_cast<const bf16x8*>(Ks + kswz<DQK>(r32, cb));
        bf16x8 b1 = *reinterpret_cast<const bf16x8*>(Ks + kswz<DQK>(32 + r32, cb));
        p0 = __builtin_amdgcn_mfma_f32_32x32x16_bf16(b0, qr[d0], p0, 0, 0, 0);
        p1 = __builtin_amdgcn_mfma_f32_32x32x16_bf16(b1, qr[d0], p1, 0, 0, 0); }
}
__device__ __forceinline__ int v_st(int k, int c) { const int kk = (k & ~0xC) | ((k & 4) << 1) | ((k & 8) >> 1); return ((kk >> 3) * 4 + (c >> 5)) * 512 + ((kk & 7) * 32 + (c & 31)) * 2; }
__device__ __forceinline__ int v_rd_base(int lane) { return ((lane & 3) << 3) | (((lane >> 2) & 3) << 6) | (((lane >> 4) & 1) << 5) | (((lane >> 5) & 1) << 8); }
constexpr int v_rd_off(int d0, int ks, int half) { return d0 * 512 + ks * 4096 + half * 2048; }
template <int OFF> __device__ __forceinline__ s16x4 tr_read(int vb) {
    s16x4 r; asm volatile("ds_read_b64_tr_b16 %0, %1 offset:%2" : "=&v"(r) : "v"(vb), "i"(OFF) : "memory"); return r;
}
template <int D0> __device__ __forceinline__ void pv_one(f32x16& od, int vb, bf16x8 pa0, bf16x8 pa1, bf16x8 pa2, bf16x8 pa3) {
    const s16x4 l0 = tr_read<v_rd_off(D0, 0, 0)>(vb), h0 = tr_read<v_rd_off(D0, 0, 1)>(vb), l1 = tr_read<v_rd_off(D0, 1, 0)>(vb), h1 = tr_read<v_rd_off(D0, 1, 1)>(vb);
    const s16x4 l2 = tr_read<v_rd_off(D0, 2, 0)>(vb), h2 = tr_read<v_rd_off(D0, 2, 1)>(vb), l3 = tr_read<v_rd_off(D0, 3, 0)>(vb), h3 = tr_read<v_rd_off(D0, 3, 1)>(vb);
    asm volatile("s_waitcnt lgkmcnt(0)" ::: "memory"); ATT_SBAR();
#define ATT_PK(L, H) (bf16x8){L[0], L[1], L[2], L[3], H[0], H[1], H[2], H[3]}
    od = __builtin_amdgcn_mfma_f32_32x32x16_bf16(pa0, ATT_PK(l0, h0), od, 0, 0, 0);
    od = __builtin_amdgcn_mfma_f32_32x32x16_bf16(pa1, ATT_PK(l1, h1), od, 0, 0, 0);
    od = __builtin_amdgcn_mfma_f32_32x32x16_bf16(pa2, ATT_PK(l2, h2), od, 0, 0, 0);
    od = __builtin_amdgcn_mfma_f32_32x32x16_bf16(pa3, ATT_PK(l3, h3), od, 0, 0, 0);
#undef ATT_PK
}
__device__ __forceinline__ void pv_d0(f32x16* o, int vb, bf16x8 pa0, bf16x8 pa1, bf16x8 pa2, bf16x8 pa3) {
    pv_one<0>(o[0], vb, pa0, pa1, pa2, pa3); pv_one<1>(o[1], vb, pa0, pa1, pa2, pa3); pv_one<2>(o[2], vb, pa0, pa1, pa2, pa3); pv_one<3>(o[3], vb, pa0, pa1, pa2, pa3);
}
template <int DQK, int LDQ, int LDK, int LDV, int LDO, int SDEPTH>
__device__ __forceinline__ void attn_body(const bf16_t* __restrict__ Qb, const bf16_t* __restrict__ Kh, const bf16_t* __restrict__ Vh, bf16_t* __restrict__ Ob, int seq, char* lds, int tid_in) {
    using C_ = Cfg<DQK>;
    constexpr int SHM_K = C_::SHM_K, NCK = C_::NCK, C8 = C_::C8, ND0 = C_::ND0;
    int tid_ = tid_in; asm volatile("" : "+v"(tid_));
    const int tid = tid_, wid = tid >> 6, lane = tid & 63, r32 = lane & 31, hi = lane >> 5;
    char* V_lds = lds; char* K_lds = lds + 2 * SHM_V;
    float* ws = (float*)(lds + 2 * SHM_V + 2 * SHM_K) + wid * 64; float* li_l = ws; float* al_l = ws + 32;
    float m_reg = -1e30f, l_reg = 0; f32x16 o[4] = {}; bf16x8 qr[ND0];
    const bf16_t* Qw = Qb + (long)(wid * QBLK + r32) * LDQ + hi * 8;
#pragma unroll
    for (int d0 = 0; d0 < ND0; ++d0) qr[d0] = *reinterpret_cast<const bf16x8*>(Qw + d0 * 16);
    const int sr = tid >> 4, sc = (tid & 15) * 8, vst0 = v_st(sr, sc), vst1 = v_st(32 + sr, sc);
    int krow[NCK], kcol[NCK];
#pragma unroll
    for (int i = 0; i < NCK; ++i) { const int ci = tid + 512 * i; krow[i] = ci / C8; kcol[i] = (ci % C8) * 8; }
    const int vb0 = (int)(uintptr_t)V_lds + v_rd_base(lane);
    struct { bf16x8 vs0, vs1, ks[NCK]; } sr_[SDEPTH];
#define ATT_SLOAD(i, k0) do { sr_[i].vs0 = *reinterpret_cast<const bf16x8*>(&Vh[(long)((k0) + sr) * LDV + sc]); sr_[i].vs1 = *reinterpret_cast<const bf16x8*>(&Vh[(long)((k0) + 32 + sr) * LDV + sc]); \
    _Pragma("unroll") for (int c_ = 0; c_ < NCK; ++c_) sr_[i].ks[c_] = *reinterpret_cast<const bf16x8*>(&Kh[(long)((k0) + krow[c_]) * LDK + kcol[c_]]); } while (0)
#define ATT_SWRITE(b, i) do { *(bf16x8*)(V_lds + (b) * SHM_V + vst0) = sr_[i].vs0; *(bf16x8*)(V_lds + (b) * SHM_V + vst1) = sr_[i].vs1; \
    _Pragma("unroll") for (int c_ = 0; c_ < NCK; ++c_) *(bf16x8*)(K_lds + (b) * SHM_K + kswz<DQK>(krow[c_], kcol[c_] * 2)) = sr_[i].ks[c_]; } while (0)
#define ATT_SWAIT() do { if constexpr (SDEPTH == 2) { if constexpr (NCK == 2) asm volatile("s_waitcnt vmcnt(4)" ::: "memory"); else asm volatile("s_waitcnt vmcnt(5)" ::: "memory"); } else asm volatile("s_waitcnt vmcnt(0)" ::: "memory"); } while (0)
#define ATT_RESC(a) do { if (__any((a) < 1.f)) { if (hi == 0) al_l[r32] = (a); asm volatile("s_waitcnt lgkmcnt(0)" ::: "memory"); \
    _Pragma("unroll") for (int d = 0; d < 4; ++d) _Pragma("unroll") for (int r = 0; r < 16; ++r) o[d][r] *= al_l[crow(r, hi)]; } } while (0)
    f32x16 pA0, pA1, pB0, pB1; float mnA, mnB, alA, alB; bf16x8 pa0, pa1, pa2, pa3; const int NT = seq / KVBLK;
    constexpr int SE = 0, SO = SDEPTH - 1;
    ATT_SLOAD(SE, 0); asm volatile("s_waitcnt vmcnt(0)" ::: "memory"); ATT_SWRITE(0, SE); __syncthreads();
    qkt<DQK>(pA0, pA1, K_lds, qr, r32, hi); partialSM<DQK>(pA0, pA1, m_reg, mnA, alA);
    ATT_SLOAD(SO, KVBLK); if constexpr (SDEPTH == 2) { if (2 < NT) ATT_SLOAD(SE, 2 * KVBLK); }
    ATT_SWAIT(); ATT_SWRITE(1, SO); __syncthreads();
    for (int j = 1; j + 1 < NT; j += 2) {
        ATT_SBAR(); qkt<DQK>(pB0, pB1, K_lds + SHM_K, qr, r32, hi);
        finishSM(pA0, pA1, alA, l_reg, pa0, pa1, pa2, pa3); ATT_SBAR();
        ATT_SLOAD(SO, (j + SDEPTH) * KVBLK); ATT_SBAR();
        pv_d0(o, vb0, pa0, pa1, pa2, pa3); partialSM<DQK>(pB0, pB1, m_reg, mnB, alB);
        __syncthreads(); ATT_SWAIT(); ATT_SWRITE(0, SE);
        ATT_RESC(alB); __syncthreads();
        ATT_SBAR(); qkt<DQK>(pA0, pA1, K_lds, qr, r32, hi);
        finishSM(pB0, pB1, alB, l_reg, pa0, pa1, pa2, pa3); ATT_SBAR();
        if (SDEPTH == 1 || j + 3 < NT) ATT_SLOAD(SE, (j + 1 + SDEPTH) * KVBLK); ATT_SBAR();
        pv_d0(o, vb0 + (int)SHM_V, pa0, pa1, pa2, pa3); partialSM<DQK>(pA0, pA1, m_reg, mnA, alA);
        __syncthreads(); ATT_SWAIT(); ATT_SWRITE(1, SO);
        ATT_RESC(alA); __syncthreads();
    }
    ATT_SBAR(); qkt<DQK>(pB0, pB1, K_lds + SHM_K, qr, r32, hi);
    finishSM(pA0, pA1, alA, l_reg, pa0, pa1, pa2, pa3); ATT_SBAR();
    pv_d0(o, vb0, pa0, pa1, pa2, pa3); partialSM<DQK>(pB0, pB1, m_reg, mnB, alB);
    __syncthreads(); ATT_RESC(alB);
    finishSM(pB0, pB1, alB, l_reg, pa0, pa1, pa2, pa3); ATT_SBAR();
    pv_d0(o, vb0 + (int)SHM_V, pa0, pa1, pa2, pa3);
    if (hi == 0) li_l[r32] = l_reg;
    asm volatile("s_waitcnt lgkmcnt(0)" ::: "memory");
    __syncthreads();
    float rli[16];
#pragma unroll
    for (int r = 0; r < 16; ++r) rli[r] = __builtin_amdgcn_rcpf(li_l[crow(r, hi)]);
    unsigned short* stg = (unsigned short*)(lds + wid * 8192);
#pragma unroll
    for (int r = 0; r < 16; ++r) { const int orow = crow(r, hi);
#pragma unroll
        for (int d0 = 0; d0 < 4; ++d0) { const unsigned w = cvtpk(o[d0][r] * rli[r], 0.f); stg[orow * 128 + d0 * 32 + r32] = (unsigned short)(w & 0xffffu); } }
    asm volatile("s_waitcnt lgkmcnt(0)" ::: "memory");
    bf16_t* Ow = Ob + (long)(wid * QBLK) * LDO;
#pragma unroll
    for (int i = 0; i < 8; ++i) { const int id = lane + 64 * i, row = id >> 4, c16 = id & 15;
        const u32x4 v = *(const u32x4*)((const char*)stg + row * 256 + c16 * 16);
        *(u32x4*)(Ow + (long)row * LDO + c16 * 8) = v; }
    asm volatile("s_waitcnt lgkmcnt(0)" ::: "memory");
    __syncthreads();
#undef ATT_SLOAD
#undef ATT_SWRITE
#undef ATT_SWAIT
#undef ATT_RESC
}

template <int DQK, int LDQ, int LDK, int LDV, int LDO>
__device__ __forceinline__ void attn_body1(const bf16_t* __restrict__ Qb, const bf16_t* __restrict__ Kh, const bf16_t* __restrict__ Vh, bf16_t* __restrict__ Ob, int seq, char* lds, int tid_in) {
    using C_ = Cfg<DQK>;
    constexpr int SHM_K = C_::SHM_K, NCK = C_::NCK, C8 = C_::C8, ND0 = C_::ND0;
    int tid_ = tid_in; asm volatile("" : "+v"(tid_));
    const int tid = tid_, wid = tid >> 6, lane = tid & 63, r32 = lane & 31, hi = lane >> 5;
    char* V_lds = lds; char* K_lds = lds + 2 * SHM_V;
    float* ws = (float*)(lds + 2 * SHM_V + 2 * SHM_K) + wid * 64; float* li_l = ws; float* al_l = ws + 32;
    float m_reg = -1e30f, l_reg = 0; f32x16 o[4] = {}; bf16x8 qr[ND0];
    const bf16_t* Qw = Qb + (long)(wid * QBLK + r32) * LDQ + hi * 8;
#pragma unroll
    for (int d0 = 0; d0 < ND0; ++d0) qr[d0] = *reinterpret_cast<const bf16x8*>(Qw + d0 * 16);
    const int sr = tid >> 4, sc = (tid & 15) * 8, vst0 = v_st(sr, sc), vst1 = v_st(32 + sr, sc);
    int krow[NCK], kcol[NCK];
#pragma unroll
    for (int i = 0; i < NCK; ++i) { const int ci = tid + 512 * i; krow[i] = ci / C8; kcol[i] = (ci % C8) * 8; }
    const int vb0 = (int)(uintptr_t)V_lds + v_rd_base(lane);
    bf16x8 vs0, vs1, ks[NCK];
#define ATT1_SLOAD(k0) do { vs0 = *reinterpret_cast<const bf16x8*>(&Vh[(long)((k0) + sr) * LDV + sc]); vs1 = *reinterpret_cast<const bf16x8*>(&Vh[(long)((k0) + 32 + sr) * LDV + sc]); \
    _Pragma("unroll") for (int c_ = 0; c_ < NCK; ++c_) ks[c_] = *reinterpret_cast<const bf16x8*>(&Kh[(long)((k0) + krow[c_]) * LDK + kcol[c_]]); } while (0)
#define ATT1_SWRITE(b) do { *(bf16x8*)(V_lds + (b) * SHM_V + vst0) = vs0; *(bf16x8*)(V_lds + (b) * SHM_V + vst1) = vs1; \
    _Pragma("unroll") for (int c_ = 0; c_ < NCK; ++c_) *(bf16x8*)(K_lds + (b) * SHM_K + kswz<DQK>(krow[c_], kcol[c_] * 2)) = ks[c_]; } while (0)
    const int NT = seq / KVBLK;
    ATT1_SLOAD(0); asm volatile("s_waitcnt vmcnt(0)" ::: "memory"); ATT1_SWRITE(0); __syncthreads();
    for (int j = 0; j < NT; ++j) {
        const int b = j & 1;
        if (j + 1 < NT) ATT1_SLOAD((j + 1) * KVBLK);
        ATT_SBAR();
        f32x16 p0, p1; float mn, alpha; bf16x8 pa0, pa1, pa2, pa3;
        qkt<DQK>(p0, p1, K_lds + b * SHM_K, qr, r32, hi);
        partialSM<DQK>(p0, p1, m_reg, mn, alpha);
        if (__any(alpha < 1.f)) { if (hi == 0) al_l[r32] = alpha; asm volatile("s_waitcnt lgkmcnt(0)" ::: "memory");
#pragma unroll
            for (int d = 0; d < 4; ++d)
#pragma unroll
                for (int r = 0; r < 16; ++r) o[d][r] *= al_l[crow(r, hi)]; }
        finishSM(p0, p1, alpha, l_reg, pa0, pa1, pa2, pa3); ATT_SBAR();
        pv_d0(o, vb0 + b * (int)SHM_V, pa0, pa1, pa2, pa3);
        if (j + 1 < NT) { ATT1_SWRITE(b ^ 1); }
        __syncthreads();
    }
    if (hi == 0) li_l[r32] = l_reg;
    asm volatile("s_waitcnt lgkmcnt(0)" ::: "memory");
    __syncthreads();
    float rli[16];
#pragma unroll
    for (int r = 0; r < 16; ++r) rli[r] = __builtin_amdgcn_rcpf(li_l[crow(r, hi)]);
    unsigned short* stg = (unsigned short*)(lds + wid * 8192);
#pragma unroll
    for (int r = 0; r < 16; ++r) { const int orow = crow(r, hi);
#pragma unroll
        for (int d0 = 0; d0 < 4; ++d0) { const unsigned w = cvtpk(o[d0][r] * rli[r], 0.f); stg[orow * 128 + d0 * 32 + r32] = (unsigned short)(w & 0xffffu); } }
    asm volatile("s_waitcnt lgkmcnt(0)" ::: "memory");
    bf16_t* Ow = Ob + (long)(wid * QBLK) * LDO;
#pragma unroll
    for (int i = 0; i < 8; ++i) { const int id = lane + 64 * i, row = id >> 4, c16 = id & 15;
        const u32x4 v = *(const u32x4*)((const char*)stg + row * 256 + c16 * 16);
        *(u32x4*)(Ow + (long)row * LDO + c16 * 8) = v; }
    asm volatile("s_waitcnt lgkmcnt(0)" ::: "memory");
    __syncthreads();
#undef ATT1_SLOAD
#undef ATT1_SWRITE
}
template <int DQK, int LDQ, int LDK, int LDV, int LDO>
__device__ __forceinline__ void attn_body1g(const bf16_t* __restrict__ Qb, const bf16_t* __restrict__ Kh, const bf16_t* __restrict__ Vh, bf16_t* __restrict__ Ob, int seq, char* lds, int tid_in) {
    using C_ = Cfg<DQK>;
    constexpr int SHM_K = C_::SHM_K, NCK = C_::NCK, ND0 = C_::ND0, KROWB = C_::KROWB;
    typedef __attribute__((address_space(3))) unsigned l3u;
    int tid_ = tid_in; asm volatile("" : "+v"(tid_));
    const int tid = tid_, wid = tid >> 6, lane = tid & 63, r32 = lane & 31, hi = lane >> 5;
    const int widu = __builtin_amdgcn_readfirstlane(wid);
    char* V_lds = lds; char* K_lds = lds + 3 * SHM_V;
    __attribute__((address_space(3))) char* l3 = (__attribute__((address_space(3))) char*)lds;
    float* ws = (float*)(lds + 3 * SHM_V + 3 * SHM_K) + wid * 64; float* li_l = ws; float* al_l = ws + 32;
    float m_reg = -1e30f, l_reg = 0; f32x16 o[4] = {}; bf16x8 qr[ND0];
    const bf16_t* Qw = Qb + (long)(wid * QBLK + r32) * LDQ + hi * 8;
#pragma unroll
    for (int d0 = 0; d0 < ND0; ++d0) qr[d0] = *reinterpret_cast<const bf16x8*>(Qw + d0 * 16);
    int koff[NCK], voff[2];
#pragma unroll
    for (int i = 0; i < NCK; ++i) { const int ob = (wid + 8 * i) * 1024 + 16 * lane, row = ob / KROWB, pos = (ob - row * KROWB) >> 4;
        const int key = (DQK == 128) ? (row & 7) : ((row >> 1) & 7); koff[i] = row * LDK + ((pos ^ key) << 3); }
#pragma unroll
    for (int i = 0; i < 2; ++i) { const int ob = (wid + 8 * i) * 1024 + 16 * lane, st = ob >> 9, r = ob & 511, kk = (st >> 2) * 8 + (r >> 6), c = (st & 3) * 32 + ((r & 63) >> 1);
        const int k = (kk & ~0xC) | ((kk & 4) << 1) | ((kk & 8) >> 1); voff[i] = k * LDV + c; }
    const int vb0 = (int)(uintptr_t)V_lds + v_rd_base(lane);
    const int NT = seq / KVBLK;
#define ATT1G_ISSUE(jt, b) do { const int jc_ = (jt) < NT ? (jt) : NT - 1; const bf16_t* kp_ = Kh + (long)jc_ * KVBLK * LDK; const bf16_t* vp_ = Vh + (long)jc_ * KVBLK * LDV; \
    _Pragma("unroll") for (int i_ = 0; i_ < NCK; ++i_) __builtin_amdgcn_global_load_lds((const unsigned*)(kp_ + koff[i_]), (l3u*)(l3 + 3 * SHM_V + (b) * SHM_K + (widu + 8 * i_) * 1024), 16, 0, 0); \
    _Pragma("unroll") for (int i_ = 0; i_ < 2; ++i_) __builtin_amdgcn_global_load_lds((const unsigned*)(vp_ + voff[i_]), (l3u*)(l3 + (b) * SHM_V + (widu + 8 * i_) * 1024), 16, 0, 0); } while (0)
    ATT1G_ISSUE(0, 0); ATT1G_ISSUE(1, 1);
    asm volatile("s_waitcnt vmcnt(%0)" :: "n"(NCK + 2) : "memory");
    __builtin_amdgcn_s_barrier(); ATT_SBAR();
    int b = 0, b2 = 2;
    for (int j = 0; j < NT; ++j) {
        ATT1G_ISSUE(j + 2, b2);
        ATT_SBAR();
        f32x16 p0, p1; float mn, alpha; bf16x8 pa0, pa1, pa2, pa3;
        qkt<DQK>(p0, p1, K_lds + b * SHM_K, qr, r32, hi);
        partialSM<DQK>(p0, p1, m_reg, mn, alpha);
        if (__any(alpha < 1.f)) { if (hi == 0) al_l[r32] = alpha; asm volatile("s_waitcnt lgkmcnt(0)" ::: "memory");
#pragma unroll
            for (int d = 0; d < 4; ++d)
#pragma unroll
                for (int r = 0; r < 16; ++r) o[d][r] *= al_l[crow(r, hi)]; }
        finishSM(p0, p1, alpha, l_reg, pa0, pa1, pa2, pa3); ATT_SBAR();
        pv_d0(o, vb0 + b * (int)SHM_V, pa0, pa1, pa2, pa3);
        asm volatile("s_waitcnt vmcnt(%0) lgkmcnt(0)" :: "n"(NCK + 2) : "memory");
        __builtin_amdgcn_s_barrier(); ATT_SBAR();
        b = (b == 2) ? 0 : b + 1; b2 = (b2 == 2) ? 0 : b2 + 1;
    }
    asm volatile("s_waitcnt vmcnt(0)" ::: "memory");
    if (hi == 0) li_l[r32] = l_reg;
    asm volatile("s_waitcnt lgkmcnt(0)" ::: "memory");
    __syncthreads();
    float rli[16];
#pragma unroll
    for (int r = 0; r < 16; ++r) rli[r] = __builtin_amdgcn_rcpf(li_l[crow(r, hi)]);
    unsigned short* stg = (unsigned short*)(lds + wid * 8192);
#pragma unroll
    for (int r = 0; r < 16; ++r) { const int orow = crow(r, hi);
#pragma unroll
        for (int d0 = 0; d0 < 4; ++d0) { const unsigned w = cvtpk(o[d0][r] * rli[r], 0.f); stg[orow * 128 + d0 * 32 + r32] = (unsigned short)(w & 0xffffu); } }
    asm volatile("s_waitcnt lgkmcnt(0)" ::: "memory");
    bf16_t* Ow = Ob + (long)(wid * QBLK) * LDO;
#pragma unroll
    for (int i = 0; i < 8; ++i) { const int id = lane + 64 * i, row = id >> 4, c16 = id & 15;
        const u32x4 v = *(const u32x4*)((const char*)stg + row * 256 + c16 * 16);
        *(u32x4*)(Ow + (long)row * LDO + c16 * 8) = v; }
    asm volatile("s_waitcnt lgkmcnt(0)" ::: "memory");
    __syncthreads();
#undef ATT1G_ISSUE
}
template <int DQK, int LDQ, int LDK, int LDV, int LDO>
__device__ __forceinline__ void attn_body2g(const bf16_t* __restrict__ Qb, const bf16_t* __restrict__ Kh, const bf16_t* __restrict__ Vh, bf16_t* __restrict__ Ob, int seq, char* lds, int tid_in) {
    using C_ = Cfg<DQK>;
    constexpr int SHM_K = C_::SHM_K, NCK = C_::NCK, ND0 = C_::ND0, KROWB = C_::KROWB;
    typedef __attribute__((address_space(3))) unsigned l3u;
    int tid_ = tid_in; asm volatile("" : "+v"(tid_));
    const int tid = tid_, wid = tid >> 6, lane = tid & 63, r32 = lane & 31, hi = lane >> 5;
    const int widu = __builtin_amdgcn_readfirstlane(wid);
    char* V_lds = lds; char* K_lds = lds + 3 * SHM_V;
    __attribute__((address_space(3))) char* l3 = (__attribute__((address_space(3))) char*)lds;
    float* ws = (float*)(lds + 3 * SHM_V + 3 * SHM_K) + wid * 64; float* li_l = ws; float* al_l = ws + 32;
    float m_reg = -1e30f, l_reg = 0; f32x16 o[4] = {}; bf16x8 qr[ND0];
    const bf16_t* Qw = Qb + (long)(wid * QBLK + r32) * LDQ + hi * 8;
#pragma unroll
    for (int d0 = 0; d0 < ND0; ++d0) qr[d0] = *reinterpret_cast<const bf16x8*>(Qw + d0 * 16);
    int koff[NCK], voff[2];
#pragma unroll
    for (int i = 0; i < NCK; ++i) { const int ob = (wid + 8 * i) * 1024 + 16 * lane, row = ob / KROWB, pos = (ob - row * KROWB) >> 4;
        const int key = (DQK == 128) ? (row & 7) : ((row >> 1) & 7); koff[i] = row * LDK + ((pos ^ key) << 3); }
#pragma unroll
    for (int i = 0; i < 2; ++i) { const int ob = (wid + 8 * i) * 1024 + 16 * lane, st = ob >> 9, r = ob & 511, kk = (st >> 2) * 8 + (r >> 6), c = (st & 3) * 32 + ((r & 63) >> 1);
        const int k = (kk & ~0xC) | ((kk & 4) << 1) | ((kk & 8) >> 1); voff[i] = k * LDV + c; }
    const int vb0 = (int)(uintptr_t)V_lds + v_rd_base(lane);
    const int NT = seq / KVBLK;
#define ATT2G_K(jt, b) do { const int jc_ = (jt) < NT ? (jt) : NT - 1; const bf16_t* kp_ = Kh + (long)jc_ * KVBLK * LDK; \
    _Pragma("unroll") for (int i_ = 0; i_ < NCK; ++i_) __builtin_amdgcn_global_load_lds((const unsigned*)(kp_ + koff[i_]), (l3u*)(l3 + 3 * SHM_V + (b) * SHM_K + (widu + 8 * i_) * 1024), 16, 0, 0); } while (0)
#define ATT2G_V(jt, b) do { const int jc_ = (jt) < NT ? (jt) : NT - 1; const bf16_t* vp_ = Vh + (long)jc_ * KVBLK * LDV; \
    _Pragma("unroll") for (int i_ = 0; i_ < 2; ++i_) __builtin_amdgcn_global_load_lds((const unsigned*)(vp_ + voff[i_]), (l3u*)(l3 + (b) * SHM_V + (widu + 8 * i_) * 1024), 16, 0, 0); } while (0)
#define ATT2G_RESC(a) do { if (__any((a) < 1.f)) { if (hi == 0) al_l[r32] = (a); asm volatile("s_waitcnt lgkmcnt(0)" ::: "memory"); \
    _Pragma("unroll") for (int d = 0; d < 4; ++d) _Pragma("unroll") for (int r = 0; r < 16; ++r) o[d][r] *= al_l[crow(r, hi)]; } } while (0)
#define ATT2G_SYNC() do { asm volatile("s_waitcnt vmcnt(%0) lgkmcnt(0)" :: "n"(NCK + 2) : "memory"); __builtin_amdgcn_s_barrier(); ATT_SBAR(); } while (0)
#define ATT2G_STEP(PC0, PC1, PP0, PP1, ALP, ALC, MNC) do { \
        ATT2G_K(j + 2, k2); ATT2G_V(j + 1, v1); ATT_SBAR(); \
        qkt<DQK>(PC0, PC1, K_lds + kc * SHM_K, qr, r32, hi); \
        finishSM(PP0, PP1, ALP, l_reg, pa0, pa1, pa2, pa3); ATT_SBAR(); \
        pv_d0(o, vb0 + vp * (int)SHM_V, pa0, pa1, pa2, pa3); partialSM<DQK>(PC0, PC1, m_reg, MNC, ALC); \
        ATT2G_SYNC(); ATT2G_RESC(ALC); \
        kc = (kc == 2) ? 0 : kc + 1; k2 = (k2 == 2) ? 0 : k2 + 1; vp = (vp == 2) ? 0 : vp + 1; v1 = (v1 == 2) ? 0 : v1 + 1; ++j; } while (0)
    f32x16 pA0, pA1, pB0, pB1; float mnA, mnB, alA, alB; bf16x8 pa0, pa1, pa2, pa3;
    ATT2G_K(0, 0); ATT2G_V(0, 0); ATT2G_K(1, 1);
    ATT2G_K(2, 2); ATT2G_V(1, 1);
    ATT2G_SYNC();
    qkt<DQK>(pA0, pA1, K_lds, qr, r32, hi); partialSM<DQK>(pA0, pA1, m_reg, mnA, alA);
    asm volatile("s_waitcnt lgkmcnt(0)" ::: "memory"); __builtin_amdgcn_s_barrier(); ATT_SBAR();
    int j = 1, kc = 1, k2 = 0, vp = 0, v1 = 2;
    while (j + 1 < NT) {
        ATT2G_STEP(pB0, pB1, pA0, pA1, alA, alB, mnB);
        ATT2G_STEP(pA0, pA1, pB0, pB1, alB, alA, mnA);
    }
    ATT2G_STEP(pB0, pB1, pA0, pA1, alA, alB, mnB);
    finishSM(pB0, pB1, alB, l_reg, pa0, pa1, pa2, pa3); ATT_SBAR();
    pv_d0(o, vb0 + vp * (int)SHM_V, pa0, pa1, pa2, pa3);
    asm volatile("s_waitcnt vmcnt(0)" ::: "memory");
    if (hi == 0) li_l[r32] = l_reg;
    asm volatile("s_waitcnt lgkmcnt(0)" ::: "memory");
    __syncthreads();
    float rli[16];
#pragma unroll
    for (int r = 0; r < 16; ++r) rli[r] = __builtin_amdgcn_rcpf(li_l[crow(r, hi)]);
    unsigned short* stg = (unsigned short*)(lds + wid * 8192);
#pragma unroll
    for (int r = 0; r < 16; ++r) { const int orow = crow(r, hi);
#pragma unroll
        for (int d0 = 0; d0 < 4; ++d0) { const unsigned w = cvtpk(o[d0][r] * rli[r], 0.f); stg[orow * 128 + d0 * 32 + r32] = (unsigned short)(w & 0xffffu); } }
    asm volatile("s_waitcnt lgkmcnt(0)" ::: "memory");
    bf16_t* Ow = Ob + (long)(wid * QBLK) * LDO;
#pragma unroll
    for (int i = 0; i < 8; ++i) { const int id = lane + 64 * i, row = id >> 4, c16 = id & 15;
        const u32x4 v = *(const u32x4*)((const char*)stg + row * 256 + c16 * 16);
        *(u32x4*)(Ow + (long)row * LDO + c16 * 8) = v; }
    asm volatile("s_waitcnt lgkmcnt(0)" ::: "memory");
    __syncthreads();
#undef ATT2G_STEP
#undef ATT2G_SYNC
#undef ATT2G_RESC
#undef ATT2G_V
#undef ATT2G_K
}
template <int DQK, int LDQ, int LDK, int LDV, int LDO>
__device__ __forceinline__ void attn_body1s(const bf16_t* __restrict__ Qb, const bf16_t* __restrict__ Kh, const bf16_t* __restrict__ Vh, bf16_t* __restrict__ Ob, int seq, char* lds, int tid_in) {
    using C_ = Cfg<DQK>;
    constexpr int SHM_K = C_::SHM_K, NCK = C_::NCK, C8 = C_::C8, ND0 = C_::ND0;
    int tid_ = tid_in; asm volatile("" : "+v"(tid_));
    const bool grpB = __builtin_amdgcn_readfirstlane(tid_ >> 16) != 0;
    const int tid = tid_ & 0xffff, wid = tid >> 6, lane = tid & 63, r32 = lane & 31, hi = lane >> 5;
    char* V_lds = lds; char* K_lds = lds + 2 * SHM_V;
    float* ws = (float*)(lds + 2 * SHM_V + 2 * SHM_K) + wid * 64; float* li_l = ws; float* al_l = ws + 32;
    float m_reg = -1e30f, l_reg = 0; f32x16 o[4] = {}; bf16x8 qr[ND0];
    const bf16_t* Qw = Qb + (long)(wid * QBLK + r32) * LDQ + hi * 8;
#pragma unroll
    for (int d0 = 0; d0 < ND0; ++d0) qr[d0] = *reinterpret_cast<const bf16x8*>(Qw + d0 * 16);
    const int sr = tid >> 4, sc = (tid & 15) * 8, vst0 = v_st(sr, sc), vst1 = v_st(32 + sr, sc);
    int krow[NCK], kcol[NCK];
#pragma unroll
    for (int i = 0; i < NCK; ++i) { const int ci = tid + 512 * i; krow[i] = ci / C8; kcol[i] = (ci % C8) * 8; }
    const int vb0 = (int)(uintptr_t)V_lds + v_rd_base(lane);
    bf16x8 vs0, vs1, ks[NCK];
#define ATT1_SLOAD(k0) do { vs0 = *reinterpret_cast<const bf16x8*>(&Vh[(long)((k0) + sr) * LDV + sc]); vs1 = *reinterpret_cast<const bf16x8*>(&Vh[(long)((k0) + 32 + sr) * LDV + sc]); \
    _Pragma("unroll") for (int c_ = 0; c_ < NCK; ++c_) ks[c_] = *reinterpret_cast<const bf16x8*>(&Kh[(long)((k0) + krow[c_]) * LDK + kcol[c_]]); } while (0)
#define ATT1_SWRITE(b) do { *(bf16x8*)(V_lds + (b) * SHM_V + vst0) = vs0; *(bf16x8*)(V_lds + (b) * SHM_V + vst1) = vs1; \
    _Pragma("unroll") for (int c_ = 0; c_ < NCK; ++c_) *(bf16x8*)(K_lds + (b) * SHM_K + kswz<DQK>(krow[c_], kcol[c_] * 2)) = ks[c_]; } while (0)
    const int NT = seq / KVBLK;
    ATT1_SLOAD(0); asm volatile("s_waitcnt vmcnt(0)" ::: "memory"); ATT1_SWRITE(0); __syncthreads();
#define ATT1_SM(P0, P1, PA0, PA1, PA2, PA3) do { float mn, alpha; partialSM<DQK>(P0, P1, m_reg, mn, alpha); \
        if (__any(alpha < 1.f)) { if (hi == 0) al_l[r32] = alpha; asm volatile("s_waitcnt lgkmcnt(0)" ::: "memory"); \
            _Pragma("unroll") for (int d = 0; d < 4; ++d) _Pragma("unroll") for (int r = 0; r < 16; ++r) o[d][r] *= al_l[crow(r, hi)]; } \
        finishSM(P0, P1, alpha, l_reg, PA0, PA1, PA2, PA3); ATT_SBAR(); } while (0)
    if (!grpB) {
        for (int j = 0; j < NT; ++j) {
            const int b = j & 1;
            if (j + 1 < NT) ATT1_SLOAD((j + 1) * KVBLK);
            ATT_SBAR();
            f32x16 p0, p1; bf16x8 pa0, pa1, pa2, pa3;
            qkt<DQK>(p0, p1, K_lds + b * SHM_K, qr, r32, hi);
            __syncthreads();
            ATT1_SM(p0, p1, pa0, pa1, pa2, pa3);
            pv_d0(o, vb0 + b * (int)SHM_V, pa0, pa1, pa2, pa3);
            if (j + 1 < NT) { ATT1_SWRITE(b ^ 1); }
            __syncthreads();
        }
    } else {
        bf16x8 pa0, pa1, pa2, pa3;
        {
            if (1 < NT) ATT1_SLOAD(KVBLK);
            ATT_SBAR();
            __syncthreads();
            f32x16 p0, p1;
            qkt<DQK>(p0, p1, K_lds, qr, r32, hi);
            ATT1_SM(p0, p1, pa0, pa1, pa2, pa3);
            if (1 < NT) { ATT1_SWRITE(1); }
            __syncthreads();
        }
        for (int j = 1; j < NT; ++j) {
            const int b = j & 1;
            if (j + 1 < NT) ATT1_SLOAD((j + 1) * KVBLK);
            ATT_SBAR();
            pv_d0(o, vb0 + (b ^ 1) * (int)SHM_V, pa0, pa1, pa2, pa3);
            __syncthreads();
            f32x16 p0, p1;
            qkt<DQK>(p0, p1, K_lds + b * SHM_K, qr, r32, hi);
            ATT1_SM(p0, p1, pa0, pa1, pa2, pa3);
            if (j + 1 < NT) { ATT1_SWRITE(b ^ 1); }
            __syncthreads();
        }
        pv_d0(o, vb0 + ((NT - 1) & 1) * (int)SHM_V, pa0, pa1, pa2, pa3);
    }
#undef ATT1_SM
    if (hi == 0) li_l[r32] = l_reg;
    asm volatile("s_waitcnt lgkmcnt(0)" ::: "memory");
    __syncthreads();
    float rli[16];
#pragma unroll
    for (int r = 0; r < 16; ++r) rli[r] = __builtin_amdgcn_rcpf(li_l[crow(r, hi)]);
    unsigned short* stg = (unsigned short*)(lds + wid * 8192);
#pragma unroll
    for (int r = 0; r < 16; ++r) { const int orow = crow(r, hi);
#pragma unroll
        for (int d0 = 0; d0 < 4; ++d0) { const unsigned w = cvtpk(o[d0][r] * rli[r], 0.f); stg[orow * 128 + d0 * 32 + r32] = (unsigned short)(w & 0xffffu); } }
    asm volatile("s_waitcnt lgkmcnt(0)" ::: "memory");
    bf16_t* Ow = Ob + (long)(wid * QBLK) * LDO;
#pragma unroll
    for (int i = 0; i < 8; ++i) { const int id = lane + 64 * i, row = id >> 4, c16 = id & 15;
        const u32x4 v = *(const u32x4*)((const char*)stg + row * 256 + c16 * 16);
        *(u32x4*)(Ow + (long)row * LDO + c16 * 8) = v; }
    asm volatile("s_waitcnt lgkmcnt(0)" ::: "memory");
    __syncthreads();
#undef ATT1_SLOAD
#undef ATT1_SWRITE
}
}
constexpr int DM = 2048, NBATCH = 2, SEQ = 4096, CTX = 256, RB = SEQ + CTX  , MROWS = NBATCH * RB  ;
constexpr int NMOD = 6 * DM, NEXP = 16384;
constexpr float EPS = 1e-6f;
constexpr int NWAVES = 8, NTHREADS = 512;
constexpr size_t MiB = 1u << 20;
constexpr size_t WS_CTL = 0, CTL_ZERO_BYTES = 64 * 1024;
constexpr size_t WS_MOD = 1 * MiB;
constexpr size_t WS_ROPE = 2 * MiB;
constexpr size_t WS_SMALL = 3 * MiB;
constexpr int SM_N1G = 0, SM_N2G = 8192, SM_AQG = 16384, SM_AKG = 16384 + 384, SM_CW = 16384 + 768, SM_CB = SM_CW + 6144, SM_CQG = SM_CB + 2048, SM_CKG = SM_CQG + 256, SM_END = SM_CKG + 256;
constexpr size_t WS_PTRS = 3 * MiB + 512 * 1024;
constexpr size_t WS_XW = 4 * MiB;
constexpr size_t WS_H = 72 * MiB;
constexpr size_t WS_P = 106 * MiB;
constexpr size_t WS_QRAW = 174 * MiB;
constexpr size_t WS_KVRAW = 200 * MiB;
constexpr size_t WS_Q = 234 * MiB;
constexpr size_t WS_K = 268 * MiB;
constexpr size_t WS_V = 294 * MiB;
constexpr size_t WS_CAT = 311 * MiB;
constexpr size_t WS_PQ = 345 * MiB;
constexpr size_t WS_IDX = 379 * MiB;
constexpr size_t WS_GATE = 384 * MiB;
constexpr size_t WS_WIN = 389 * MiB;
constexpr size_t WS_WUQ = 421 * MiB;
constexpr size_t WS_WUKV = 424 * MiB;
constexpr size_t WS_WEO = 426 * MiB;
constexpr size_t WS_WQKV = 442 * MiB;
constexpr size_t WS_WCO = 466 * MiB;
constexpr size_t WS_WPQ = 482 * MiB;
constexpr size_t WS_SUBK = 514 * MiB;
#ifndef TAB_FP4
#define TAB_FP4 1
#endif
#if TAB_FP4
constexpr int ROWB = 1024;
#else
constexpr int ROWB = 1536;
#endif
constexpr size_t WS_U = 516 * MiB;
constexpr size_t WS_VT = 644 * MiB;
constexpr size_t WS_USC = 772 * MiB;
constexpr size_t WS_VSC = 773 * MiB;
constexpr size_t WS_XQ = 810 * MiB;
constexpr size_t WS_XS = 828 * MiB;
constexpr size_t WS_WQ8 = 834 * MiB;
constexpr size_t WS_WSC = 836 * MiB;
constexpr size_t WS_PART = 774 * MiB;
constexpr size_t WS_END = 837 * MiB;
#ifndef EXP_SLICED
#define EXP_SLICED 1
#endif
#ifndef PEER_MFMA
#define PEER_MFMA 1
#endif
#ifndef PEER_VMFMA
#define PEER_VMFMA 1
#endif
constexpr int CW_BAR = 4096;
constexpr int LDS_MISC = 131072 + 8192;
constexpr int LDS_BYTES = 147456;

#define LAS __attribute__((address_space(3)))
typedef unsigned short bf16_t;
typedef float f32x4 __attribute__((ext_vector_type(4)));
typedef unsigned u32x4 __attribute__((ext_vector_type(4)));
typedef unsigned u32x2 __attribute__((ext_vector_type(2)));
typedef short bf16x8 __attribute__((ext_vector_type(8)));
typedef float f32x16 __attribute__((ext_vector_type(16)));
typedef __bf16 bf16x2_t __attribute__((ext_vector_type(2)));
typedef float f32x2 __attribute__((ext_vector_type(2)));
typedef _Float16 h2_t __attribute__((ext_vector_type(2)));
typedef float f32x32 __attribute__((ext_vector_type(32)));
typedef unsigned u32x6 __attribute__((ext_vector_type(6)));

__device__ __forceinline__ unsigned f2bf(float f) { unsigned u = __builtin_bit_cast(unsigned, f); return (u + 0x7fffu + ((u >> 16) & 1u)) >> 16; }
__device__ __forceinline__ unsigned pk2(float lo, float hi) { return f2bf(lo) | (f2bf(hi) << 16); }
__device__ __forceinline__ float bf_lo(unsigned w) { return __builtin_bit_cast(float, w << 16); }
__device__ __forceinline__ float bf_hi(unsigned w) { return __builtin_bit_cast(float, w & 0xffff0000u); }
__device__ __forceinline__ float bf2f(bf16_t h) { return __builtin_bit_cast(float, (unsigned)h << 16); }
__device__ __forceinline__ float wave_sum(float v) {
#pragma unroll
    for (int o = 1; o < 64; o <<= 1) v += __shfl_xor(v, o);
    return v;
}
#define DPP_ADD(v, ctrl) ((v) + __builtin_bit_cast(float, __builtin_amdgcn_update_dpp(0, __builtin_bit_cast(int, (v)), (ctrl), 0xf, 0xf, true)))
__device__ __forceinline__ float wave_sum_dpp(float v) {
    v = DPP_ADD(v, 0xB1);
    v = DPP_ADD(v, 0x4E);
    v = DPP_ADD(v, 0x141);
    v = DPP_ADD(v, 0x140);
    const int vi = __builtin_bit_cast(int, v);
    const float s0 = __builtin_bit_cast(float, __builtin_amdgcn_readlane(vi, 0)), s1 = __builtin_bit_cast(float, __builtin_amdgcn_readlane(vi, 16));
    const float s2 = __builtin_bit_cast(float, __builtin_amdgcn_readlane(vi, 32)), s3 = __builtin_bit_cast(float, __builtin_amdgcn_readlane(vi, 48));
    return (s0 + s1) + (s2 + s3);
}
#define DPP_MOV(v, ctrl) __builtin_bit_cast(float, __builtin_amdgcn_update_dpp(0, __builtin_bit_cast(int, (v)), (ctrl), 0xf, 0xf, true))
__device__ __forceinline__ float wave_max_dpp(float v) {
    v = fmaxf(v, DPP_MOV(v, 0xB1)); v = fmaxf(v, DPP_MOV(v, 0x4E)); v = fmaxf(v, DPP_MOV(v, 0x141)); v = fmaxf(v, DPP_MOV(v, 0x140));
    const int vi = __builtin_bit_cast(int, v);
    return fmaxf(fmaxf(__builtin_bit_cast(float, __builtin_amdgcn_readlane(vi, 0)), __builtin_bit_cast(float, __builtin_amdgcn_readlane(vi, 16))),
                 fmaxf(__builtin_bit_cast(float, __builtin_amdgcn_readlane(vi, 32)), __builtin_bit_cast(float, __builtin_amdgcn_readlane(vi, 48))));
}
__device__ __forceinline__ float dot2_bf16(unsigned w, unsigned x, float acc) { return __builtin_amdgcn_fdot2_f32_bf16(__builtin_bit_cast(bf16x2_t, w), __builtin_bit_cast(bf16x2_t, x), acc, false); }
__device__ __forceinline__ float gelu_erf(float v) {
    const float av = fabsf(v), t = __builtin_amdgcn_rcpf(av * 0.2316418882f + 1.0f);
    float q = t * 0.5307027145f + (-0.7265760135f); q = q * t + 0.7107068705f; q = q * t + (-0.142248368f); q = q * t + 0.127414796f; q = q * t;
    const float e = __builtin_amdgcn_exp2f((v * v) * (-0.72134752044f));
    const float m = v * (q * e);
    return v < 0.f ? m : v - m;
}
#define XB_TMO      128
#define XB_XCNT(j)  (256  + 64 * (j))
#define XB_XSUB(j)  (1280 + 64 * (j))
#define XB_XGEN(j)  (2304 + 64 * (j))
#define XB_TOP      3328
#define XB_TOPGEN   3392
#define XCD_BAR_WORDS 3456
#define XB_SPIN_CAP (1u << 18)

__device__ __forceinline__ unsigned xb_ld(unsigned* p)              { return __hip_atomic_load(p, __ATOMIC_RELAXED, __HIP_MEMORY_SCOPE_AGENT); }
__device__ __forceinline__ unsigned xb_add(unsigned* p, unsigned v) { return __hip_atomic_fetch_add(p, v, __ATOMIC_RELAXED, __HIP_MEMORY_SCOPE_AGENT); }
__device__ __forceinline__ unsigned xb_xcc_id() { return (unsigned)__builtin_amdgcn_s_getreg((3 << 11) | 20) & 0xFu; }
#define XB_SPIN(cond, bar) do { unsigned _sp = 0; while (cond) { __builtin_amdgcn_s_sleep(1); \
    if ((++_sp & 255u) == 0u) { if (xb_ld(&(bar)[XB_TMO])) break; if (_sp > XB_SPIN_CAP) { atomicAdd(&(bar)[XB_TMO], 1u); break; } } } } while (0)

struct XcdBarrier {
    unsigned* bar; unsigned x;
    volatile LAS unsigned* st;
};

__device__ __forceinline__ XcdBarrier xcd_barrier_post(unsigned* bar, volatile LAS unsigned* st) {
    XcdBarrier b; b.bar = bar; b.x = xb_xcc_id(); b.st = st;
    if (threadIdx.x == 0) (void)xb_add(&bar[XB_XCNT(b.x)], 1u);
    return b;
}
__device__ __forceinline__ void xcd_barrier_complete(unsigned* bar, unsigned x, unsigned& nloc, unsigned& nx) {
    const unsigned G = gridDim.x * gridDim.y * gridDim.z;
    unsigned sum, cnt, mine, sp = 0u;
    for (;;) {
        sum = 0u; cnt = 0u; mine = 0u;
#pragma unroll
        for (unsigned j = 0; j < 16; ++j) { const unsigned c = xb_ld(&bar[XB_XCNT(j)]); sum += c; cnt += (c > 0u) ? 1u : 0u; mine = (j == x) ? c : mine; }
        if (sum == G) break;
        __builtin_amdgcn_s_sleep(1);
        if ((++sp & 255u) == 0u) { if (xb_ld(&bar[XB_TMO])) break; if (sp > XB_SPIN_CAP) { atomicAdd(&bar[XB_TMO], 1u); break; } }
    }
    nloc = mine > 0u ? mine : 1u; nx = cnt > 0u ? cnt : 1u;
}

__device__ __forceinline__ void xcd_barrier(const XcdBarrier& b) {
    asm volatile("s_waitcnt vmcnt(0)" ::: "memory");
    __syncthreads();
    if (threadIdx.x == 0) {
        unsigned* bar = b.bar; unsigned bx = b.x;
        asm volatile("" : "+s"(bar), "+s"(bx));
        __builtin_amdgcn_s_waitcnt(0);
        unsigned nloc = b.st[0], nx = b.st[1];
        if (nloc == 0u) { xcd_barrier_complete(bar, bx, nloc, nx); b.st[0] = nloc; b.st[1] = nx; }
        const unsigned old = xb_add(&bar[XB_XSUB(bx)], 1u);
        const unsigned gen = old / nloc;
        if (old + 1u == (gen + 1u) * nloc) {
            __builtin_amdgcn_fence(__ATOMIC_RELEASE, "agent");
            asm volatile("s_waitcnt vmcnt(0)" ::: "memory");
            const unsigned og = xb_add(&bar[XB_TOP], 1u);
            const unsigned tg = og / nx;
            if (og + 1u == (tg + 1u) * nx) xb_add(&bar[XB_TOPGEN], 1u);
            else XB_SPIN(xb_ld(&bar[XB_TOPGEN]) == tg, bar);
            __builtin_amdgcn_fence(__ATOMIC_ACQUIRE, "agent");
            xb_add(&bar[XB_XGEN(bx)], 1u);
            asm volatile("s_waitcnt vmcnt(0)" ::: "memory");
        } else {
            XB_SPIN(xb_ld(&bar[XB_XGEN(bx)]) == gen, bar);
            __builtin_amdgcn_fence(__ATOMIC_ACQUIRE, "agent");
            asm volatile("s_waitcnt vmcnt(0)" ::: "memory");
        }
    }
    __syncthreads();
}
struct Frame {
    LAS unsigned char* lds;
    int tid, lane, wave, vcu, G, gw, NGW;
    unsigned char* ws;
};
__device__ __forceinline__ int opaque_v(int v) { asm volatile("" : "+v"(v)); return v; }
__device__ __forceinline__ int phase_tid(int wave) { int lane; asm volatile("v_mbcnt_lo_u32_b32 %0, -1, 0\n\tv_mbcnt_hi_u32_b32 %0, -1, %0" : "=v"(lane)); return wave * 64 + lane; }
__device__ __forceinline__ Frame phase_frame(const Frame& F0) { Frame F = F0; F.tid = phase_tid(F0.wave); F.lane = F.tid & 63; return F; }
__device__ __forceinline__ float swap32(float v, int lane) { auto rr = __builtin_amdgcn_permlane32_swap(__float_as_uint(v), __float_as_uint(v), false, false); return __uint_as_float(lane < 32 ? rr[1] : rr[0]); }
__device__ __forceinline__ int row_cls(int row) { const int b = row / RB, i = row - b * RB; return i < CTX ? 2 : b; }

__device__ __forceinline__ void p0_transpose_item(const float* W, int K, int N, bf16_t* WT, const float* gain, LAS float* scr, int item, int lane, bool perm_q = false) {
    const int nblk = N / 32, kb = item / nblk, nb = item % nblk, k0 = 64 * kb, n0 = 32 * nb;
    {
        const int rgp = lane >> 3, c4 = (lane & 7) * 4; f32x4 tv[8];
#pragma unroll
        for (int i = 0; i < 8; ++i) tv[i] = *(const f32x4*)(W + (size_t)(k0 + 8 * i + rgp) * N + n0 + c4);
#pragma unroll
        for (int i = 0; i < 8; ++i) { const int kk = 8 * i + rgp; f32x4 v = tv[i]; if (gain) v = v * gain[k0 + kk];
            LAS float* d = scr + kk * 33 + c4; d[0] = v.x; d[1] = v.y; d[2] = v.z; d[3] = v.w; }
    }
    asm volatile("s_waitcnt lgkmcnt(0)" ::: "memory");
    const int c = lane & 7;
#pragma unroll
    for (int j = 0; j < 4; ++j) { const int n = (lane >> 3) + 8 * j; const LAS float* s = scr + (8 * c) * 33 + n;
        u32x4 o; o.x = pk2(s[0 * 33], s[1 * 33]); o.y = pk2(s[2 * 33], s[3 * 33]); o.z = pk2(s[4 * 33], s[5 * 33]); o.w = pk2(s[6 * 33], s[7 * 33]);
        int nn = n0 + n; if (perm_q) { const int hh = nn / 192, e = nn - hh * 192; nn = (e < 128) ? hh * 128 + e : 1024 + hh * 64 + (e - 128); }
        *(u32x4*)(WT + (size_t)nn * K + k0 + 8 * c) = o; }
    asm volatile("s_waitcnt lgkmcnt(0)" ::: "memory");
}
struct TrDesc { const float* W; const float* gain; bf16_t* WT; int K, N, items; };

__device__ __forceinline__ void p0_gemv_task(Frame& F, int task, const float* ada_w, const float* ada_b, float* mod) {
    LAS float* sv = (LAS float*)F.lds; LAS float* part = (LAS float*)(F.lds + 32768);
    const int l = task / 192, n0 = (task % 192) * 64, rg = F.lane >> 4, c4 = (F.lane & 15) * 4;
    const float* Wp = ada_w + (size_t)l * DM * NMOD + n0 + c4 + (size_t)(F.wave * 256 + rg) * NMOD;
    f32x4 a0 = {0, 0, 0, 0}, a1 = a0, a2 = a0;
    for (int k = 0; k < 256; k += 32) {
        f32x4 w[8];
#pragma unroll
        for (int u = 0; u < 8; ++u) w[u] = *(const f32x4*)(Wp + (size_t)(k + 4 * u) * NMOD);
#pragma unroll
        for (int u = 0; u < 8; ++u) { const int kk = F.wave * 256 + k + 4 * u + rg; const float s0 = sv[kk], s1 = sv[2048 + kk], s2 = sv[4096 + kk];
            a0 += w[u] * s0; a1 += w[u] * s1; a2 += w[u] * s2; }
    }
    LAS float* pp = part + ((F.wave * 4 + rg) * 3) * 64 + c4;
    *(LAS f32x4*)(pp) = a0; *(LAS f32x4*)(pp + 64) = a1; *(LAS f32x4*)(pp + 128) = a2;
    __syncthreads();
    if (F.tid < 192) { const int r = F.tid >> 6, c = F.tid & 63; float s = 0.f;
#pragma unroll
        for (int q = 0; q < 32; ++q) s += part[(q * 3 + r) * 64 + c];
        mod[(size_t)(l * 3 + r) * NMOD + n0 + c] = s + ada_b[(size_t)l * NMOD + n0 + c]; }
    __syncthreads();
}

constexpr int TAB_DEFER_PER_WAVE = 12, TAB_DEFER = 104 * NWAVES * TAB_DEFER_PER_WAVE;
__device__ __forceinline__ void tab_row_convert(const float* src_row, unsigned char* ws, int tab, int rr  , int lane) {
    const float* src = src_row + lane * 4;
    f32x4 v[8];
#pragma unroll
    for (int q = 0; q < 8; ++q) v[q] = *(const f32x4*)(src + q * 256);
    float am = 0.f, ssq = 0.f;
#pragma unroll
    for (int q = 0; q < 8; ++q) { am = fmaxf(fmaxf(am, fmaxf(fabsf(v[q].x), fabsf(v[q].y))), fmaxf(fabsf(v[q].z), fabsf(v[q].w))); ssq += (v[q].x * v[q].x + v[q].y * v[q].y) + (v[q].z * v[q].z + v[q].w * v[q].w); }
    am = fmaxf(wave_max_dpp(am), 1e-30f); ssq = wave_sum_dpp(ssq);
    const float sig = fmaxf(sqrtf(ssq * (1.f / DM)), am * (1.f / 64.f)), sc = 2.0f / sig;
    const int ll = rr / NEXP, ee = rr - ll * NEXP;
    unsigned char* dst = ws + (tab ? WS_VT : WS_U) + (size_t)ll * NEXP * ROWB + (size_t)ee * 128 + lane * 2;
#define P0_C6(x) fminf(fmaxf((x), -6.f), 6.f)
#pragma unroll
    for (int q = 0; q < 8; ++q) { const f32x4 x = v[q] * sc; unsigned t = 0u;
        t = __builtin_amdgcn_cvt_scalef32_pk_fp4_f32(t, P0_C6(x.x), P0_C6(x.y), 1.0f, 0); t = __builtin_amdgcn_cvt_scalef32_pk_fp4_f32(t, P0_C6(x.z), P0_C6(x.w), 1.0f, 1);
        *(unsigned short*)(dst + (size_t)q * (NEXP * 128)) = (unsigned short)t; }
#undef P0_C6
    if (lane == 0) ((float*)(ws + (tab ? WS_VSC : WS_USC)))[rr] = sig * 0.5f;
}
__device__ __forceinline__ void tab_deferred_rows(const Frame& F0, int l, int wslot) {
    const Frame F = phase_frame(F0);
    unsigned char* ws = F.ws;
    const float* in_v = ((const float* const*)(ws + WS_PTRS))[1];
#pragma unroll 1
    for (int i = 0; i < TAB_DEFER_PER_WAVE; ++i) { const int rr = l * NEXP + NEXP - TAB_DEFER + wslot * TAB_DEFER_PER_WAVE + i; tab_row_convert(in_v + (size_t)rr * DM, ws, 1, rr, F.lane); }
}
__device__ __forceinline__ void p0_prologue(Frame& F, const float* const* in, const int parts = 15) {
    unsigned char* ws = F.ws;
    if (parts & 1) {
        LAS float* sv = (LAS float*)F.lds;
        for (int i = F.tid; i < 3 * DM; i += NTHREADS) { const int r = i / DM, k = i - r * DM; const float x = (r < 2) ? in[1][r * DM + k] : in[3][k]; sv[i] = x / (1.f + __expf(-x)); }
        __syncthreads();
        for (int task = F.vcu; task < 768; task += F.G) p0_gemv_task(F, task, in[4], in[5], (float*)(ws + WS_MOD));
        __syncthreads();
    }
    if (parts & 2) {
        bf16_t* xw = (bf16_t*)(ws + WS_XW);
        for (int row = F.gw; row < MROWS; row += F.NGW) { const int b = row / RB, i = row - b * RB;
            const float* src = (i < CTX) ? in[2] + (size_t)(b * CTX + i) * DM : in[0] + (size_t)(b * SEQ + i - CTX) * DM;
            const f32x4* s4 = (const f32x4*)src + F.lane; u32x2* d4 = (u32x2*)(xw + (size_t)row * DM) + F.lane;
#pragma unroll
            for (int j = 0; j < 8; ++j) { const f32x4 v = s4[64 * j]; u32x2 o; o.x = pk2(v.x, v.y); o.y = pk2(v.z, v.w); d4[64 * j] = o; } }
    }
    if (parts & 2) {
        float* sm = (float*)(ws + WS_SMALL); const int g = F.vcu * NTHREADS + F.tid;
        if (g < 8192) { sm[SM_N1G + g] = in[6][g]; sm[SM_N2G + g] = in[7][g]; }
        if (g < 384) { sm[SM_AQG + g] = in[13][g]; sm[SM_AKG + g] = in[14][g]; }
        if (g < 6144) sm[SM_CW + g] = in[15][g];
        if (g < 2048) sm[SM_CB + g] = in[16][g];
        if (g < 256) { sm[SM_CQG + g] = in[19][g]; sm[SM_CKG + g] = in[20][g]; }
    }
    if (parts & 2) {
        float* rc = (float*)(ws + WS_ROPE); float* ra = rc + 64 * 32 * 2;
        const int g = F.vcu * NTHREADS + F.tid;
        if (g < 64 * 32) { const int pos = g >> 5, f = g & 31; const float fr = exp2f(-(float)f * (13.287712379549449f / 32.f)); const float ang = (float)pos * fr;
            rc[2 * g] = cosf(ang); rc[2 * g + 1] = sinf(ang); }
        else if (g < 64 * 32 + 64 * 16) { const int e = g - 64 * 32, pos = e >> 4, f = e & 15; const float fr = exp2f(-(float)f * (13.287712379549449f / 16.f)); const float ang = (float)pos * fr;
            ra[2 * e] = cosf(ang); ra[2 * e + 1] = sinf(ang); }
    }
    if (parts & 4) {
        LAS float* scr = (LAS float*)(F.lds + F.wave * 16384);
        TrDesc d[16]; int nd = 0;
#pragma unroll
        for (int i = 0; i < 2; ++i) {
            d[nd++] = TrDesc{in[8] + (size_t)i * DM * 3904, nullptr, (bf16_t*)(ws + WS_WIN) + (size_t)i * 4096 * DM, DM, 3904, 32 * 122};
            d[nd++] = TrDesc{in[11] + (size_t)i * 512 * 1536, in[9] + i * 512, (bf16_t*)(ws + WS_WUQ) + (size_t)i * 1536 * 512, 512, 1536, 8 * 48};
            d[nd++] = TrDesc{in[12] + (size_t)i * 256 * 2048, in[10] + i * 256, (bf16_t*)(ws + WS_WUKV) + (size_t)i * 2048 * 256, 256, 2048, 4 * 64};
            d[nd++] = TrDesc{in[17] + (size_t)i * DM * DM, nullptr, (bf16_t*)(ws + WS_WEO) + (size_t)i * DM * DM, DM, DM, 32 * 64};
            d[nd++] = TrDesc{in[18] + (size_t)i * DM * 3072, nullptr, (bf16_t*)(ws + WS_WQKV) + (size_t)i * 3072 * DM, DM, 3072, 32 * 96};
            d[nd++] = TrDesc{in[21] + (size_t)i * DM * DM, nullptr, (bf16_t*)(ws + WS_WCO) + (size_t)i * DM * DM, DM, DM, 32 * 64};
        }
#pragma unroll
        for (int l = 0; l < 4; ++l) d[nd++] = TrDesc{in[22] + (size_t)l * DM * DM, nullptr, (bf16_t*)(ws + WS_WPQ) + (size_t)l * DM * DM, DM, DM, 32 * 64};
#pragma unroll
        for (int m = 0; m < 16; ++m) {
            for (int it = F.gw; it < d[m].items; it += F.NGW) p0_transpose_item(d[m].W, d[m].K, d[m].N, d[m].WT, d[m].gain, scr, it, F.lane, d[m].K == 512);
        }
        for (int i = F.gw * 64 + F.lane; i < 2 * 192 * DM / 8; i += F.NGW * 64) { const int li = i / (192 * DM / 8), r = i % (192 * DM / 8);
            *(u32x4*)((bf16_t*)(ws + WS_WIN) + (size_t)li * 4096 * DM + (size_t)3904 * DM + (size_t)r * 8) = (u32x4){0u, 0u, 0u, 0u}; }
    }
    if (parts & 2) {
        const size_t n_sk = (size_t)4 * 16 * 128 * 128 / 8;
        const size_t gt = (size_t)F.vcu * NTHREADS + F.tid, GT = (size_t)F.G * NTHREADS;
        for (size_t j = gt; j < n_sk; j += GT) {
            const f32x4 a = *(const f32x4*)(in[23] + j * 8), b = *(const f32x4*)(in[23] + j * 8 + 4);
            u32x4 o; o.x = pk2(a.x, a.y); o.y = pk2(a.z, a.w); o.z = pk2(b.x, b.y); o.w = pk2(b.z, b.w);
            *(u32x4*)((bf16_t*)(ws + WS_SUBK) + j * 8) = o;
        }
    }
#if TAB_FP4 && EXP_SLICED && PEER_MFMA && !defined(P0_NOCOAL)
    if (parts & 8) {
        if (F.vcu == 0 && F.tid == 0) { const float** pp = (const float**)(ws + WS_PTRS); pp[0] = in[24]; pp[1] = in[25]; }
        for (int r = F.gw; r < 2 * 4 * NEXP; r += F.NGW) { const int tab = r >= 4 * NEXP, rr = r - tab * (4 * NEXP);
            if (F.G == 256 && tab == 1) { const int ll = rr / NEXP, ee = rr - ll * NEXP; if ((ll & 1) && ee >= NEXP - TAB_DEFER) continue; }
            tab_row_convert((tab ? in[25] : in[24]) + (size_t)rr * DM, ws, tab, rr, F.lane); }
    }
#elif TAB_FP4 && EXP_SLICED && PEER_MFMA && defined(P0_PIPE)
    {
        const int NR = 2 * 4 * NEXP;
#define P0_LOAD(V, r_) do { const int rc_ = (r_) < NR ? (r_) : NR - 1; const float* s_ = ((rc_ >= 4 * NEXP) ? in[25] + (size_t)(rc_ - 4 * NEXP) * DM : in[24] + (size_t)rc_ * DM) + F.lane * 32; \
        _Pragma("unroll") for (int q = 0; q < 8; ++q) V[q] = *(const f32x4*)(s_ + q * 4); } while (0)
#define P0_C6(x) fminf(fmaxf((x), -6.f), 6.f)
#define P0_ROW(V, VN) do { \
        const int rn = r + F.NGW; P0_LOAD(VN, rn); \
        const int tab = r >= 4 * NEXP, rr = r - tab * (4 * NEXP); \
        float am = 0.f, ssq = 0.f; \
        _Pragma("unroll") for (int q = 0; q < 8; ++q) { am = fmaxf(fmaxf(am, fmaxf(fabsf(V[q].x), fabsf(V[q].y))), fmaxf(fabsf(V[q].z), fabsf(V[q].w))); ssq += (V[q].x * V[q].x + V[q].y * V[q].y) + (V[q].z * V[q].z + V[q].w * V[q].w); } \
        am = fmaxf(wave_max_dpp(am), 1e-30f); ssq = wave_sum_dpp(ssq); \
        const float sig = fmaxf(sqrtf(ssq * (1.f / DM)), am * (1.f / 64.f)), sc = 2.0f / sig; \
        unsigned w4[4]; \
        _Pragma("unroll") for (int q = 0; q < 4; ++q) { unsigned t = 0u; const f32x4 xa = V[2 * q] * sc, xb = V[2 * q + 1] * sc; \
            t = __builtin_amdgcn_cvt_scalef32_pk_fp4_f32(t, P0_C6(xa.x), P0_C6(xa.y), 1.0f, 0); t = __builtin_amdgcn_cvt_scalef32_pk_fp4_f32(t, P0_C6(xa.z), P0_C6(xa.w), 1.0f, 1); \
            t = __builtin_amdgcn_cvt_scalef32_pk_fp4_f32(t, P0_C6(xb.x), P0_C6(xb.y), 1.0f, 2); t = __builtin_amdgcn_cvt_scalef32_pk_fp4_f32(t, P0_C6(xb.z), P0_C6(xb.w), 1.0f, 3); w4[q] = t; } \
        { const int ll = rr / NEXP, ee = rr - ll * NEXP; \
          *(u32x4*)(ws + (tab ? WS_VT : WS_U) + (size_t)ll * NEXP * ROWB + (size_t)(F.lane >> 3) * (NEXP * 128) + (size_t)ee * 128 + (F.lane & 7) * 16) = (u32x4){w4[0], w4[1], w4[2], w4[3]}; } \
        if (F.lane == 0) ((float*)(ws + (tab ? WS_VSC : WS_USC)))[rr] = sig * 0.5f; \
        r = rn; } while (0)
        int r = F.gw; f32x4 va[8], vb[8]; P0_LOAD(va, r);
        while (r < NR) { P0_ROW(va, vb); if (!(r < NR)) break; P0_ROW(vb, va); }
#undef P0_ROW
#undef P0_C6
#undef P0_LOAD
    }
#else
    {
        for (int r = F.gw; r < 2 * 4 * NEXP; r += F.NGW) {
            const int tab = r / (4 * NEXP), rr = r - tab * (4 * NEXP);
#if EXP_SLICED
            const float* src = (tab ? in[25] : in[24]) + (size_t)rr * DM + F.lane * 32;
            f32x4 v[8];
#pragma unroll
            for (int q = 0; q < 8; ++q) v[q] = *(const f32x4*)(src + q * 4);
#else
            const float* src = (tab ? in[25] : in[24]) + (size_t)rr * DM + F.lane * 16;
            f32x4 v[8];
#pragma unroll
            for (int j = 0; j < 2; ++j)
#pragma unroll
                for (int q = 0; q < 4; ++q) v[j * 4 + q] = *(const f32x4*)(src + j * 1024 + q * 4);
#endif
            float am = 0.f;
#pragma unroll
            for (int q = 0; q < 8; ++q) am = fmaxf(fmaxf(am, fmaxf(fabsf(v[q].x), fabsf(v[q].y))), fmaxf(fabsf(v[q].z), fabsf(v[q].w)));
#pragma unroll
            for (int o = 1; o < 64; o <<= 1) am = fmaxf(am, __shfl_xor(am, o));
            am = fmaxf(am, 1e-30f);
#if TAB_FP4
            float ssq = 0.f;
#pragma unroll
            for (int q = 0; q < 8; ++q) ssq += (v[q].x * v[q].x + v[q].y * v[q].y) + (v[q].z * v[q].z + v[q].w * v[q].w);
#pragma unroll
            for (int o = 1; o < 64; o <<= 1) ssq += __shfl_xor(ssq, o);
            const float sig = fmaxf(sqrtf(ssq * (1.f / DM)), am * (1.f / 64.f));
            unsigned w4[4];
#if EXP_SLICED
            if (tab == 0 && !PEER_MFMA) {
                const float delta = 0.3352f * sig, isc = 1.0f / delta;
#pragma unroll
                for (int q = 0; q < 4; ++q) { unsigned t = 0u;
#pragma unroll
                    for (int hh = 0; hh < 2; ++hh) { const f32x4 x = v[2 * q + hh] * isc;
                        const int n0 = min(max((int)floorf(x.x), -8), 7) & 15, n1 = min(max((int)floorf(x.y), -8), 7) & 15, n2 = min(max((int)floorf(x.z), -8), 7) & 15, n3 = min(max((int)floorf(x.w), -8), 7) & 15;
                        t |= ((unsigned)n0 | ((unsigned)n1 << 4) | ((unsigned)n2 << 8) | ((unsigned)n3 << 12)) << (16 * hh); }
                    w4[q] = t; }
                { const int ll = rr / NEXP, ee = rr - ll * NEXP;
                  *(u32x4*)(ws + WS_U + (size_t)ll * NEXP * ROWB + (size_t)(F.lane >> 3) * (NEXP * 128) + (size_t)ee * 128 + (F.lane & 7) * 16) = (u32x4){w4[0], w4[1], w4[2], w4[3]}; }
                if (F.lane == 0) ((float*)(ws + WS_USC))[rr] = delta;
                continue;
            }
#endif
            const float sc = 2.0f / sig;
#pragma unroll
            for (int q = 0; q < 4; ++q) { unsigned t = 0u;
                const f32x4 xa = v[2 * q] * sc, xb = v[2 * q + 1] * sc;
#define P0_C6(x) fminf(fmaxf((x), -6.f), 6.f)
                t = __builtin_amdgcn_cvt_scalef32_pk_fp4_f32(t, P0_C6(xa.x), P0_C6(xa.y), 1.0f, 0);
                t = __builtin_amdgcn_cvt_scalef32_pk_fp4_f32(t, P0_C6(xa.z), P0_C6(xa.w), 1.0f, 1);
                t = __builtin_amdgcn_cvt_scalef32_pk_fp4_f32(t, P0_C6(xb.x), P0_C6(xb.y), 1.0f, 2);
                t = __builtin_amdgcn_cvt_scalef32_pk_fp4_f32(t, P0_C6(xb.z), P0_C6(xb.w), 1.0f, 3);
#undef P0_C6
                w4[q] = t; }
#if EXP_SLICED
            { const int ll = rr / NEXP, ee = rr - ll * NEXP;
              *(u32x4*)(ws + (tab ? WS_VT : WS_U) + (size_t)ll * NEXP * ROWB + (size_t)(F.lane >> 3) * (NEXP * 128) + (size_t)ee * 128 + (F.lane & 7) * 16) = (u32x4){w4[0], w4[1], w4[2], w4[3]}; }
#else
            *(u32x4*)(ws + (tab ? WS_VT : WS_U) + (size_t)rr * ROWB + F.lane * 16) = (u32x4){w4[0], w4[1], w4[2], w4[3]};
#endif
            if (F.lane == 0) ((float*)(ws + (tab ? WS_VSC : WS_USC)))[rr] = sig * 0.5f;
#else
            const float sc = 7.5f / am;
            f32x16 a, b;
#pragma unroll
            for (int q = 0; q < 8; ++q) { const f32x4 x = v[q] * sc; a[2 * q] = x.x; b[2 * q] = x.y; a[2 * q + 1] = x.z; b[2 * q + 1] = x.w; }
            const u32x6 w = __builtin_amdgcn_cvt_scalef32_2xpk16_fp6_f32(a, b, 1.0f);
            unsigned char* dst = ws + (tab ? WS_VT : WS_U) + (size_t)rr * ROWB;
            *(u32x4*)(dst + F.lane * 16) = (u32x4){w[0], w[1], w[2], w[3]};
            *(u32x2*)(dst + 1024 + F.lane * 8) = (u32x2){w[4], w[5]};
            if (F.lane == 0) ((float*)(ws + (tab ? WS_VSC : WS_USC)))[rr] = am * (1.0f / 7.5f);
#endif
        }
    }
#endif
}

template <bool RESID>
__device__ __forceinline__ void ctx_gemm_phase(const Frame& F0, const bf16_t* A, int lda, const bf16_t* Bt, int ldb, int N, int K, bf16_t* O, bf16_t* X, int ldc, const float* gate) {
    const Frame F = phase_frame(F0);
    const int lane = F.lane, li = lane & 15, lq = lane >> 4, wave = F.wave;
    LAS float* red = (LAS float*)F.lds;
    LAS unsigned char* priv = F.lds + wave * 12288;
    const int lr = lane >> 3, lc = lane & 7;
    const int wr_even = lr * 128 + ((lc ^ (lr >> 1)) << 4), wr_odd = lr * 128 + ((lc ^ (4 + (lr >> 1))) << 4);
    const int rd_row = li * 128;
    const int ntask = 8 * (N / 32), k0 = wave * (K / 8);
#define CG_PTRS(t_, XG, WG) do { const int tc_ = (t_) < ntask ? (t_) : ntask - 1; const int rb_ = tc_ & 7, cb_ = tc_ >> 3; const int r0_ = (rb_ < 4) ? rb_ * 64 : RB + (rb_ - 4) * 64; \
        XG = A + (size_t)(r0_ + lr) * lda + k0 + 8 * lc; WG = Bt + (size_t)(cb_ * 32 + lr) * ldb + k0 + 8 * lc; } while (0)
#define CG_LOAD(XQ, WQ, XG, WG, q_) do { _Pragma("unroll") for (int i = 0; i < 8; ++i) XQ[i] = *(const u32x4*)(XG + (size_t)(8 * i) * lda + 64 * (q_)); \
        _Pragma("unroll") for (int i = 0; i < 4; ++i) WQ[i] = *(const u32x4*)(WG + (size_t)(8 * i) * ldb + 64 * (q_)); } while (0)
#define CG_QUARTER(XQ, WQ, XGN, WGN, qn_) do { \
        _Pragma("unroll") for (int i = 0; i < 8; ++i) *(LAS u32x4*)(priv + ((i & 1) ? wr_odd : wr_even) + i * 1024) = XQ[i]; \
        _Pragma("unroll") for (int i = 0; i < 4; ++i) *(LAS u32x4*)(priv + 8192 + ((i & 1) ? wr_odd : wr_even) + i * 1024) = WQ[i]; \
        __builtin_amdgcn_sched_barrier(0); \
        CG_LOAD(XQ, WQ, XGN, WGN, qn_); \
        __builtin_amdgcn_sched_barrier(0); \
        _Pragma("unroll") for (int s = 0; s < 2; ++s) { \
            const int ro = rd_row + (((4 * s + lq) ^ (li >> 1)) << 4); \
            bf16x8 xa[4], wb[2]; \
            _Pragma("unroll") for (int m = 0; m < 4; ++m) xa[m] = *(const LAS bf16x8*)(priv + ro + m * 2048); \
            _Pragma("unroll") for (int n = 0; n < 2; ++n) wb[n] = *(const LAS bf16x8*)(priv + 8192 + ro + n * 2048); \
            _Pragma("unroll") for (int m = 0; m < 4; ++m) _Pragma("unroll") for (int n = 0; n < 2; ++n) acc[m][n] = __builtin_amdgcn_mfma_f32_16x16x32_bf16(wb[n], xa[m], acc[m][n], 0, 0, 0); } \
    } while (0)
    u32x4 xa_[8], wa_[4], xb_[8], wb_[4];
    const bf16_t *xg, *wg, *xgn, *wgn;
    CG_PTRS(F.vcu, xg, wg);
    __builtin_amdgcn_s_waitcnt(0x0f70);
    __builtin_amdgcn_sched_barrier(0); CG_LOAD(xa_, wa_, xg, wg, 0); __builtin_amdgcn_sched_barrier(0); CG_LOAD(xb_, wb_, xg, wg, 1); __builtin_amdgcn_sched_barrier(0);
    for (int task = F.vcu; task < ntask; task += F.G) {
        const int rb = task & 7, cb = task >> 3;
        const int row0 = (rb < 4) ? rb * 64 : RB + (rb - 4) * 64, col0 = cb * 32;
        CG_PTRS(task + F.G, xgn, wgn);
        const int row = row0 + 16 * (wave >> 1) + li, col = col0 + 16 * (wave & 1) + 4 * lq;
        f32x4 xold = {0.f, 0.f, 0.f, 0.f}, gv = xold;
        if (RESID) { const u32x2 w_ = *(const u32x2*)(X + (size_t)row * ldc + col); xold = (f32x4){bf_lo(w_.x), bf_hi(w_.x), bf_lo(w_.y), bf_hi(w_.y)}; gv = *(const f32x4*)(gate + (size_t)2 * 12288 + col); }
        __builtin_amdgcn_sched_barrier(0);
        f32x4 acc[4][2];
#pragma unroll
        for (int m = 0; m < 4; ++m) { acc[m][0] = (f32x4){0.f, 0.f, 0.f, 0.f}; acc[m][1] = acc[m][0]; }
        CG_QUARTER(xa_, wa_, xg, wg, 2);
        CG_QUARTER(xb_, wb_, xg, wg, 3);
        CG_QUARTER(xa_, wa_, xgn, wgn, 0);
        CG_QUARTER(xb_, wb_, xgn, wgn, 1);
        xg = xgn; wg = wgn;
        __syncthreads();
#pragma unroll
        for (int m = 0; m < 4; ++m)
#pragma unroll
            for (int n = 0; n < 2; ++n)
#pragma unroll
                for (int r = 0; r < 4; ++r) red[(wave * 32 + (m * 2 + n) * 4 + r) * 64 + lane] = acc[m][n][r];
        __syncthreads();
        f32x4 sum = {0.f, 0.f, 0.f, 0.f};
#pragma unroll
        for (int w2 = 0; w2 < 8; ++w2)
#pragma unroll
            for (int r = 0; r < 4; ++r) sum[r] += red[(w2 * 32 + wave * 4 + r) * 64 + lane];
        if (RESID) { const f32x4 xn_ = xold + gv * sum; u32x2 o; o.x = pk2(xn_[0], xn_[1]); o.y = pk2(xn_[2], xn_[3]); *(u32x2*)(X + (size_t)row * ldc + col) = o; }
        else { u32x2 o; o.x = pk2(sum[0], sum[1]); o.y = pk2(sum[2], sum[3]); *(u32x2*)(O + (size_t)row * ldc + col) = o; }
        __syncthreads();
    }
#undef CG_QUARTER
#undef CG_LOAD
#undef CG_PTRS
    __syncthreads();
}

__device__ __forceinline__ void norm_phase(const Frame& F0, const bf16_t* xw, const float* g, const float* modl  , int off_sh, int off_sc, bf16_t* H, bool lat_only, unsigned* XQ = nullptr, float* XS = nullptr) {
    const Frame F = phase_frame(F0);
    f32x4 gm[8], shv[8]; int cur_cls = -1;
    int row = F.gw; if (lat_only) while (row < MROWS && row_cls(row) == 2) row += F.NGW;
    f32x4 v[8];
    if (row < MROWS) { const u32x2* x4 = (const u32x2*)(xw + (size_t)row * DM) + F.lane;
#pragma unroll
        for (int j = 0; j < 8; ++j) { const u32x2 w_ = x4[64 * j]; v[j] = (f32x4){bf_lo(w_.x), bf_hi(w_.x), bf_lo(w_.y), bf_hi(w_.y)}; } }
    while (row < MROWS) {
        int nrow = row + F.NGW; if (lat_only) while (nrow < MROWS && row_cls(nrow) == 2) nrow += F.NGW;
        f32x4 vn[8];
        if (nrow < MROWS) { const u32x2* x4 = (const u32x2*)(xw + (size_t)nrow * DM) + F.lane;
#pragma unroll
            for (int j = 0; j < 8; ++j) { const u32x2 w_ = x4[64 * j]; vn[j] = (f32x4){bf_lo(w_.x), bf_hi(w_.x), bf_lo(w_.y), bf_hi(w_.y)}; } }
        const int cls = row_cls(row);
        if (cls != cur_cls) {
            cur_cls = cls;
            const f32x4* g4 = (const f32x4*)g + F.lane; const f32x4* sc4 = (const f32x4*)(modl + (size_t)cls * NMOD + off_sc) + F.lane; const f32x4* sh4 = (const f32x4*)(modl + (size_t)cls * NMOD + off_sh) + F.lane;
#pragma unroll
            for (int j = 0; j < 8; ++j) { gm[j] = g4[64 * j] * (sc4[64 * j] + 1.0f); shv[j] = sh4[64 * j]; }
        }
        float ss = 0.f;
#pragma unroll
        for (int j = 0; j < 8; ++j) ss += (v[j].x * v[j].x + v[j].y * v[j].y) + (v[j].z * v[j].z + v[j].w * v[j].w);
        const float rstd = 1.0f / sqrtf(wave_sum_dpp(ss) * (1.f / DM) + EPS);
        u32x2* o2 = (u32x2*)(H + (size_t)row * DM) + F.lane;
#if PEER_MFMA
        if (XQ) {
            f32x4 yv[8]; float am = 0.f;
#pragma unroll
            for (int j = 0; j < 8; ++j) { const f32x4 y = (v[j] * rstd) * gm[j] + shv[j]; yv[j] = y; u32x2 o; o.x = pk2(y.x, y.y); o.y = pk2(y.z, y.w); o2[64 * j] = o;
                am = fmaxf(fmaxf(am, fmaxf(fabsf(y.x), fabsf(y.y))), fmaxf(fabsf(y.z), fabsf(y.w))); }
            am = fmaxf(am, DPP_MOV(am, 0xB1)); am = fmaxf(am, DPP_MOV(am, 0x4E)); am = fmaxf(am, DPP_MOV(am, 0x141)); am = fmaxf(am, DPP_MOV(am, 0x140));
            { const int ai = __builtin_bit_cast(int, am);
              am = fmaxf(fmaxf(__builtin_bit_cast(float, __builtin_amdgcn_readlane(ai, 0)), __builtin_bit_cast(float, __builtin_amdgcn_readlane(ai, 16))),
                         fmaxf(__builtin_bit_cast(float, __builtin_amdgcn_readlane(ai, 32)), __builtin_bit_cast(float, __builtin_amdgcn_readlane(ai, 48)))); }
            am = fmaxf(am, 1e-20f);
            const float qs = 440.0f / am;
            unsigned* q8 = XQ + (size_t)row * (DM / 4) + F.lane;
#pragma unroll
            for (int j = 0; j < 8; ++j) { const f32x4 y = yv[j] * qs; int pk = 0; pk = __builtin_amdgcn_cvt_pk_fp8_f32(y.x, y.y, pk, false); pk = __builtin_amdgcn_cvt_pk_fp8_f32(y.z, y.w, pk, true); q8[64 * j] = (unsigned)pk; }
            if (F.lane == 0) XS[row] = am * (1.0f / 440.0f);
        } else
#endif
        {
#pragma unroll
        for (int j = 0; j < 8; ++j) { const f32x4 y = (v[j] * rstd) * gm[j] + shv[j]; u32x2 o; o.x = pk2(y.x, y.y); o.y = pk2(y.z, y.w); o2[64 * j] = o;
            if (XQ) {
                float am = fmaxf(fmaxf(fabsf(y.x), fabsf(y.y)), fmaxf(fabsf(y.z), fabsf(y.w)));
                am = fmaxf(am, DPP_MOV(am, 0xB1)); am = fmaxf(am, DPP_MOV(am, 0x4E)); am = fmaxf(am, DPP_MOV(am, 0x141)); am = fmaxf(am, 1e-20f);
                const float qs = 119.0f / am; const float yy[4] = {y.x, y.y, y.z, y.w};
                unsigned pl = 0u, ph = 0u; int sq = 0;
#pragma unroll
                for (int i = 0; i < 4; ++i) { const int qi = __float2int_rn(yy[i] * qs); const int lo = ((qi + 8) & 15) - 8; const int hi = (qi - lo) >> 4; sq += qi; pl |= (unsigned)(lo & 15) << (4 * i); ph |= (unsigned)(hi & 15) << (4 * i); }
                const unsigned pl1 = (unsigned)__builtin_amdgcn_update_dpp(0, (int)pl, 0xB1, 0xf, 0xf, true), ph1 = (unsigned)__builtin_amdgcn_update_dpp(0, (int)ph, 0xB1, 0xf, 0xf, true);
                float sqf = (float)sq; sqf = DPP_ADD(sqf, 0xB1); sqf = DPP_ADD(sqf, 0x4E); sqf = DPP_ADD(sqf, 0x141);
                const int chunk = j * 8 + (F.lane >> 3), l8 = F.lane & 7;
                if ((l8 & 1) == 0) { unsigned* q = XQ + ((size_t)row * 64 + chunk) * 8 + (l8 >> 1); q[0] = ph | (ph1 << 16); q[4] = pl | (pl1 << 16); }
                if (l8 == 0) { float* s = XS + ((size_t)row * 64 + chunk) * 2; s[0] = am * (1.0f / 119.0f); s[1] = 0.5f * sqf; }
            } }
        }
        row = nrow;
#pragma unroll
        for (int j = 0; j < 8; ++j) v[j] = vn[j];
    }
}

__device__ __forceinline__ float row16_sum(float v) { v = DPP_ADD(v, 0xB1); v = DPP_ADD(v, 0x4E); v = DPP_ADD(v, 0x141); v = DPP_ADD(v, 0x140); return v; }
__device__ __forceinline__ void prep_odd_phase(const Frame& F0, const bf16_t* P, const float* qg, const float* kg, const float* rope_c, bf16_t* Q, bf16_t* Kb) {
    const Frame F = phase_frame(F0);
    const int l16 = F.lane & 15, d0 = l16 * 8;
    float gq[8], gk[8];
#pragma unroll
    for (int e = 0; e < 8; ++e) { gq[e] = qg[d0 + e]; gk[e] = kg[d0 + e]; }
    const bool lowhalf = l16 < 8;
    const int j0 = (l16 & 7) * 8;
    int row = F.gw;
    u32x4 w[5];
    if (row < MROWS) { const u32x4* pr = (const u32x4*)(P + (size_t)row * 3072) + F.lane;
#pragma unroll
        for (int k = 0; k < 5; ++k) w[k] = pr[64 * k]; }
    while (row < MROWS) {
        const int nrow = row + F.NGW;
        u32x4 wn[5];
        if (nrow < MROWS) { const u32x4* pr = (const u32x4*)(P + (size_t)nrow * 3072) + F.lane;
#pragma unroll
            for (int k = 0; k < 5; ++k) wn[k] = pr[64 * k]; }
        const int b = row / RB, i = row - b * RB; const bool lat = i >= CTX; const int t = i - CTX;
        float cs[8], sn[8];
#pragma unroll
        for (int e = 0; e < 8; ++e) { cs[e] = 1.f; sn[e] = 0.f; }
        if (lat) { const int pos = (j0 < 32) ? (t >> 6) : (t & 63); const f32x4* tb = (const f32x4*)(rope_c + ((pos << 5) + (j0 & 31)) * 2);
#pragma unroll
            for (int q = 0; q < 4; ++q) { const f32x4 c = tb[q]; cs[2 * q] = c.x; sn[2 * q] = c.y; cs[2 * q + 1] = c.z; sn[2 * q + 1] = c.w; } }
#pragma unroll
        for (int k = 0; k < 5; ++k) {
            const unsigned ww[4] = {w[k].x, w[k].y, w[k].z, w[k].w};
            float x[8]; float ss = 0.f;
#pragma unroll
            for (int q = 0; q < 4; ++q) { x[2 * q] = bf_lo(ww[q]); x[2 * q + 1] = bf_hi(ww[q]); ss += x[2 * q] * x[2 * q] + x[2 * q + 1] * x[2 * q + 1]; }
            const float rstd = 1.0f / sqrtf(row16_sum(ss) * (1.f / 128.f) + EPS);
            unsigned ow[4]; float o[8];
#pragma unroll
            for (int e = 0; e < 8; ++e) { const float y = x[e] * rstd * (k < 4 ? gq[e] : gk[e]); const float yp = DPP_MOV(y, 0x128);
                o[e] = lowhalf ? (y * cs[e] - yp * sn[e]) : (y * cs[e] + yp * sn[e]); }
#pragma unroll
            for (int q = 0; q < 4; ++q) ow[q] = pk2(o[2 * q], o[2 * q + 1]);
            if (k < 4) *((u32x4*)(Q + (size_t)row * 2048) + 64 * k + F.lane) = (u32x4){ow[0], ow[1], ow[2], ow[3]};
            else *((u32x4*)(Kb + (size_t)row * 512) + F.lane) = (u32x4){ow[0], ow[1], ow[2], ow[3]};
        }
        row = nrow;
#pragma unroll
        for (int k = 0; k < 5; ++k) w[k] = wn[k];
    }
}

struct PrepEvenRow { u32x4 cq; u32x2 ckv, kr; u32x4 qn[2]; u32x2 qr[2]; u32x4 kn[2], vv[2]; };
__device__ __forceinline__ void prep_even_load(PrepEvenRow& R, const bf16_t* P, const bf16_t* QR, const bf16_t* KVR, int row, int lane) {
    const bf16_t* pr = P + (size_t)row * 4096; const int l16 = lane & 15, hq = lane >> 4;
    R.cq = *((const u32x4*)pr + lane); R.ckv = *((const u32x2*)(pr + 512) + lane); R.kr = *((const u32x2*)(pr + 768) + l16);
    const bf16_t* q = QR + (size_t)row * 1536; const bf16_t* kv = KVR + (size_t)row * 2048;
#pragma unroll
    for (int k = 0; k < 2; ++k) { R.qn[k] = *((const u32x4*)q + 64 * k + lane); R.qr[k] = *((const u32x2*)(q + 1024) + 64 * k + lane);
        const bf16_t* kh = kv + (4 * k + hq) * 256 + l16 * 8; R.kn[k] = *(const u32x4*)kh; R.vv[k] = *(const u32x4*)(kh + 128); }
}
__device__ __forceinline__ void prep_even_phase(const Frame& F0, const bf16_t* P, const bf16_t* QR, const bf16_t* KVR, const float* qg, const float* kg, const float* rope_a, bf16_t* Q, bf16_t* Kb, bf16_t* Vb) {
    const Frame F = phase_frame(F0);
    const int lane = F.lane, l16 = lane & 15, hq = lane >> 4, d0 = l16 * 8, r0 = l16 * 4;
    float gqn[8], gkn[8], gqr[4], gkr[4];
#pragma unroll
    for (int e = 0; e < 8; ++e) { gqn[e] = qg[d0 + e]; gkn[e] = kg[d0 + e]; }
#pragma unroll
    for (int e = 0; e < 4; ++e) { gqr[e] = qg[128 + r0 + e]; gkr[e] = kg[128 + r0 + e]; }
    const bool lowhalf = l16 < 8; const int j0 = (l16 & 7) * 4;
    int row = F.gw;
    PrepEvenRow R;
    if (row < MROWS) prep_even_load(R, P, QR, KVR, row, lane);
    while (row < MROWS) {
        const int nrow = row + F.NGW;
        PrepEvenRow Rn;
        if (nrow < MROWS) prep_even_load(Rn, P, QR, KVR, nrow, lane);
        const int b = row / RB, i = row - b * RB; const bool lat = i >= CTX; const int t = i - CTX;
        float cs[4], sn[4];
#pragma unroll
        for (int e = 0; e < 4; ++e) { cs[e] = 1.f; sn[e] = 0.f; }
        if (lat) { const int pos = (j0 < 16) ? (t >> 6) : (t & 63); const f32x4* tb = (const f32x4*)(rope_a + ((pos << 4) + (j0 & 15)) * 2);
            const f32x4 c0 = tb[0], c1 = tb[1]; cs[0] = c0.x; sn[0] = c0.y; cs[1] = c0.z; sn[1] = c0.w; cs[2] = c1.x; sn[2] = c1.y; cs[3] = c1.z; sn[3] = c1.w; }
        float ssq = 0.f, sskv = 0.f;
        { const unsigned ww[4] = {R.cq.x, R.cq.y, R.cq.z, R.cq.w};
#pragma unroll
          for (int q = 0; q < 4; ++q) { const float a = bf_lo(ww[q]), c = bf_hi(ww[q]); ssq += a * a + c * c; } }
        { const float a = bf_lo(R.ckv.x), c = bf_hi(R.ckv.x), d = bf_lo(R.ckv.y), e = bf_hi(R.ckv.y); sskv = (a * a + c * c) + (d * d + e * e); }
        const float rstd_q = 1.0f / sqrtf(wave_sum_dpp(ssq) * (1.f / 512.f) + EPS), rstd_kv = 1.0f / sqrtf(wave_sum_dpp(sskv) * (1.f / 256.f) + EPS);
        const float krv[4] = {bf_lo(R.kr.x), bf_hi(R.kr.x), bf_lo(R.kr.y), bf_hi(R.kr.y)};
        const float krss = (krv[0] * krv[0] + krv[1] * krv[1]) + (krv[2] * krv[2] + krv[3] * krv[3]);
#pragma unroll
        for (int k = 0; k < 2; ++k) {
            const int h = 4 * k + hq;
            {
                const unsigned wn[4] = {R.qn[k].x, R.qn[k].y, R.qn[k].z, R.qn[k].w};
                float xn[8], xr[4]; float ss = 0.f;
#pragma unroll
                for (int q = 0; q < 4; ++q) { xn[2 * q] = bf_lo(wn[q]) * rstd_q; xn[2 * q + 1] = bf_hi(wn[q]) * rstd_q; ss += xn[2 * q] * xn[2 * q] + xn[2 * q + 1] * xn[2 * q + 1]; }
                xr[0] = bf_lo(R.qr[k].x) * rstd_q; xr[1] = bf_hi(R.qr[k].x) * rstd_q; xr[2] = bf_lo(R.qr[k].y) * rstd_q; xr[3] = bf_hi(R.qr[k].y) * rstd_q;
                ss += (xr[0] * xr[0] + xr[1] * xr[1]) + (xr[2] * xr[2] + xr[3] * xr[3]);
                const float r2 = 1.0f / sqrtf(row16_sum(ss) * (1.f / 192.f) + EPS);
                unsigned on[4]; float o[4];
#pragma unroll
                for (int q = 0; q < 4; ++q) on[q] = pk2(xn[2 * q] * r2 * gqn[2 * q], xn[2 * q + 1] * r2 * gqn[2 * q + 1]);
#pragma unroll
                for (int e = 0; e < 4; ++e) { const float y = xr[e] * r2 * gqr[e]; const float yp = DPP_MOV(y, 0x128); o[e] = lowhalf ? (y * cs[e] - yp * sn[e]) : (y * cs[e] + yp * sn[e]); }
                bf16_t* qo = Q + (size_t)row * 1536 + h * 192;
                *(u32x4*)(qo + d0) = (u32x4){on[0], on[1], on[2], on[3]};
                *(u32x2*)(qo + 128 + r0) = (u32x2){pk2(o[0], o[1]), pk2(o[2], o[3])};
            }
            {
                const unsigned wn[4] = {R.kn[k].x, R.kn[k].y, R.kn[k].z, R.kn[k].w}, wv[4] = {R.vv[k].x, R.vv[k].y, R.vv[k].z, R.vv[k].w};
                float xn[8]; float ss = krss;
#pragma unroll
                for (int q = 0; q < 4; ++q) { xn[2 * q] = bf_lo(wn[q]) * rstd_kv; xn[2 * q + 1] = bf_hi(wn[q]) * rstd_kv; ss += xn[2 * q] * xn[2 * q] + xn[2 * q + 1] * xn[2 * q + 1]; }
                const float r2 = 1.0f / sqrtf(row16_sum(ss) * (1.f / 192.f) + EPS);
                unsigned on[4], ov[4]; float o[4];
#pragma unroll
                for (int q = 0; q < 4; ++q) { on[q] = pk2(xn[2 * q] * r2 * gkn[2 * q], xn[2 * q + 1] * r2 * gkn[2 * q + 1]); ov[q] = pk2(bf_lo(wv[q]) * rstd_kv, bf_hi(wv[q]) * rstd_kv); }
#pragma unroll
                for (int e = 0; e < 4; ++e) { const float y = krv[e] * r2 * gkr[e]; const float yp = DPP_MOV(y, 0x128); o[e] = lowhalf ? (y * cs[e] - yp * sn[e]) : (y * cs[e] + yp * sn[e]); }
                bf16_t* ko = Kb + (size_t)row * 1536 + h * 192;
                *(u32x4*)(ko + d0) = (u32x4){on[0], on[1], on[2], on[3]};
                *(u32x2*)(ko + 128 + r0) = (u32x2){pk2(o[0], o[1]), pk2(o[2], o[3])};
                *(u32x4*)(Vb + (size_t)row * 1024 + h * 128 + d0) = (u32x4){ov[0], ov[1], ov[2], ov[3]};
            }
        }
        row = nrow; R = Rn;
    }
}

__device__ __forceinline__ void conv_phase(const Frame& F0, const bf16_t* P, const float* cw  , const float* cb  , bf16_t* CAT) {
    const Frame F = phase_frame(F0);
    const int gt = F.vcu * NTHREADS + F.tid, GT = F.G * NTHREADS;
    for (int it = gt; it < MROWS * 128; it += GT) {
        const int row = it >> 7, c0 = (it & 127) * 8; const int b = row / RB, i = row - b * RB;
        const bool first = (i == 0) || (i == CTX), last = (i == CTX - 1) || (i == RB - 1);
        const bf16_t* pr = P + (size_t)row * 4096 + 832 + c0;
        const u32x4 bg = *(const u32x4*)pr, cg = *(const u32x4*)(pr + 1024), hz = *(const u32x4*)(pr + 2048);
        u32x4 cgm = {0u, 0u, 0u, 0u}, hzm = cgm, cgp = cgm, hzp = cgm;
        if (!first) { cgm = *(const u32x4*)(pr - 4096 + 1024); hzm = *(const u32x4*)(pr - 4096 + 2048); }
        if (!last) { cgp = *(const u32x4*)(pr + 4096 + 1024); hzp = *(const u32x4*)(pr + 4096 + 2048); }
        const unsigned bgw[4] = {bg.x, bg.y, bg.z, bg.w}, cgw[4] = {cg.x, cg.y, cg.z, cg.w}, hzw[4] = {hz.x, hz.y, hz.z, hz.w};
        const unsigned cmw[4] = {cgm.x, cgm.y, cgm.z, cgm.w}, hmw[4] = {hzm.x, hzm.y, hzm.z, hzm.w}, cpw[4] = {cgp.x, cgp.y, cgp.z, cgp.w}, hpw[4] = {hzp.x, hzp.y, hzp.z, hzp.w};
        unsigned ow[4];
#pragma unroll
        for (int q = 0; q < 4; ++q) {
            const int c = c0 + 2 * q;
            const float u0a = bf_lo(cgw[q]) * bf_lo(hzw[q]), u0b = bf_hi(cgw[q]) * bf_hi(hzw[q]);
            const float uma = bf_lo(cmw[q]) * bf_lo(hmw[q]), umb = bf_hi(cmw[q]) * bf_hi(hmw[q]);
            const float upa = bf_lo(cpw[q]) * bf_lo(hpw[q]), upb = bf_hi(cpw[q]) * bf_hi(hpw[q]);
            const float ra = bf_lo(bgw[q]) * (uma * cw[c] + u0a * cw[1024 + c] + upa * cw[2048 + c] + cb[c]);
            const float rb = bf_hi(bgw[q]) * (umb * cw[c + 1] + u0b * cw[1024 + c + 1] + upb * cw[2048 + c + 1] + cb[c + 1]);
            ow[q] = pk2(ra, rb);
        }
        *(u32x4*)(CAT + (size_t)row * DM + 1024 + c0) = (u32x4){ow[0], ow[1], ow[2], ow[3]};
    }
}
__device__ __forceinline__ void attn_even_phase(const Frame& F0, const bf16_t* Q, const bf16_t* Kb, const bf16_t* Vb, bf16_t* CAT) {
    const Frame F = phase_frame(F0);
    for (int u = F.vcu; u < 272; u += F.G) {
        int b, h, qt, nk;
        if (u < 256) { b = u >> 7; h = (u >> 4) & 7; qt = 1 + (u & 15); nk = RB; } else { const int v = u - 256; b = v >> 3; h = v & 7; qt = 0; nk = CTX; }
        const size_t r0 = (size_t)b * RB;
        att::attn_body2g<192, 1536, 1536, 1024, 2048>(Q + (r0 + qt * 256) * 1536 + h * 192, Kb + r0 * 1536 + h * 192, Vb + r0 * 1024 + h * 128, CAT + (r0 + qt * 256) * 2048 + h * 128, nk, (char*)F.lds, phase_tid(F.wave));
    }
}
__device__ __forceinline__ void attn_odd_phase(const Frame& F0, const bf16_t* Q, const bf16_t* Kb, const bf16_t* P, bf16_t* CAT, bool lat_only) {
    const Frame F = phase_frame(F0);
    const int nunits = lat_only ? 512 : 544;
    for (int u = F.vcu; u < nunits; u += F.G) {
        int b, hq, qt, nk;
        if (u < 512) { b = u >> 8; hq = (u >> 4) & 15; qt = 1 + (u & 15); nk = RB; } else { const int v = u - 512; b = v >> 4; hq = v & 15; qt = 0; nk = CTX; }
        const int kvh = hq >> 2; const size_t r0 = (size_t)b * RB;
        att::attn_body2g<128, 2048, 512, 3072, 2048>(Q + (r0 + qt * 256) * 2048 + hq * 128, Kb + r0 * 512 + kvh * 128, P + r0 * 3072 + 2560 + kvh * 128, CAT + (r0 + qt * 256) * 2048 + hq * 128, nk, (char*)F.lds, phase_tid(F.wave));
    }
}

__device__ __forceinline__ int crow32(int r, int hi) { return (r & 3) + 8 * (r >> 2) + 4 * hi; }
__device__ __forceinline__ int fkey(int b) { return b ^ ((b >> 31) & 0x7fffffff); }
#define TK_CE(x, y) do { const int hi_ = max((x), (y)), lo_ = min((x), (y)); (x) = hi_; (y) = lo_; } while (0)
template <int N> __device__ __forceinline__ void tk_sort(int* v) {
#pragma unroll
    for (int k = 2; k <= N; k <<= 1)
#pragma unroll
        for (int j = k >> 1; j > 0; j >>= 1)
#pragma unroll
            for (int i = 0; i < N; ++i) { const int l = i ^ j; if (l > i) { if ((i & k) == 0) TK_CE(v[i], v[l]); else TK_CE(v[l], v[i]); } }
}
__device__ __forceinline__ void tk_merge16(int* a, const int* b) {
#pragma unroll
    for (int i = 0; i < 16; ++i) a[i] = max(a[i], b[15 - i]);
#pragma unroll
    for (int j = 8; j > 0; j >>= 1)
#pragma unroll
        for (int i = 0; i < 16; ++i) { const int l = i ^ j; if (l > i) TK_CE(a[i], a[l]); }
}
__device__ __forceinline__ void tk_merge_partner(int* a) {
    int lo[16], hi[16];
#pragma unroll
    for (int i = 0; i < 16; ++i) { auto rr = __builtin_amdgcn_permlane32_swap((unsigned)a[i], (unsigned)a[i], false, false); lo[i] = (int)rr[0]; hi[i] = (int)rr[1]; }
    tk_merge16(lo, hi);
#pragma unroll
    for (int i = 0; i < 16; ++i) a[i] = lo[i];
}
__device__ __forceinline__ void peer_topk_phase(const Frame& F0, const bf16_t* PQ, const bf16_t* subk  , int* IDX, float* GATE, bool lat_only) {
    const Frame F = phase_frame(F0);
    const int h = F.vcu & 7, jw = (F.vcu >> 3) * NWAVES + F.wave, nwh = (F.G >> 3) * NWAVES;
    {
        const bf16_t* src = subk + (size_t)h * 2 * 128 * 128;
        for (int c = F.tid; c < 4096; c += NTHREADS) { const int row = c >> 4, ch = c & 15;
            *(LAS u32x4*)(F.lds + row * 256 + ((ch ^ (row & 15)) << 4)) = *(const u32x4*)(src + (size_t)row * 128 + ch * 8); }
        __syncthreads();
    }
    const int ntg = lat_only ? 256 : MROWS / 32;
    const bool spread = (nwh == 256) && !lat_only;
    for (int kr = 0; ; ++kr) {
        int t;
        if (!spread) { t = jw + kr * nwh; if (t >= ntg) break; }
        else { if (kr == 0) t = jw; else if (kr == 1 && F.wave == 0 && (F.vcu >> 3) < ntg - 256) t = 256 + (F.vcu >> 3); else break; }
        int lane_ = F.lane; asm volatile("" : "+v"(lane_));
        const int r32 = lane_ & 31, hi = lane_ >> 5;
        int tg = t; if (lat_only) tg += 8 + (tg >= 128 ? 8 : 0);
        const int token = tg * 32 + r32;
        int top[2][16];
        const int kk = (((r32 & 14) | (hi ^ (r32 & 1))) << 4);
#pragma unroll
        for (int p = 0; p < 2; ++p) {
            bf16x8 bq[8];
            const bf16_t* qp = PQ + (size_t)token * DM + h * 256 + p * 128 + hi * 8;
#pragma unroll
            for (int ks = 0; ks < 8; ++ks) bq[ks] = *(const bf16x8*)(qp + ks * 16);
            int s[4][16];
#pragma unroll
            for (int nb = 0; nb < 4; ++nb) {
                f32x16 acc = {};
                const LAS unsigned char* kp = F.lds + (p * 128 + nb * 32 + r32) * 256;
#pragma unroll
                for (int ks = 0; ks < 8; ++ks) { const bf16x8 a = *(const LAS bf16x8*)(kp + (kk ^ (ks << 5))); acc = __builtin_amdgcn_mfma_f32_32x32x16_bf16(a, bq[ks], acc, 0, 0, 0); }
#pragma unroll
                for (int r = 0; r < 16; ++r) { const int key = nb * 32 + crow32(r, hi); s[nb][r] = fkey((int)((__float_as_uint(acc[r]) & ~127u) | (unsigned)(127 - key))); }
                tk_sort<16>(s[nb]);
            }
            tk_merge16(s[0], s[1]); tk_merge16(s[2], s[3]); tk_merge16(s[0], s[2]);
            tk_merge_partner(s[0]);
#pragma unroll
            for (int j = 0; j < 16; ++j) top[p][j] = s[0][j];
        }
        int cand[32];
        unsigned long long kaLo = 0ull, kaHi = 0ull, kbLo = 0ull, kbHi = 0ull;
        {
            float fb[16]; const float fa0 = __uint_as_float((unsigned)fkey(top[0][0]) & ~127u), fb0 = __uint_as_float((unsigned)fkey(top[1][0]) & ~127u);
#pragma unroll
            for (int r = 0; r < 16; ++r) { const int ba = fkey(top[0][r]), bb = fkey(top[1][r]); fb[r] = __uint_as_float((unsigned)bb & ~127u) - fb0;
                const unsigned long long xa = (unsigned long long)(unsigned)(127 - (ba & 127)) << (8 * (r & 7)), xb = (unsigned long long)(unsigned)(127 - (bb & 127)) << (8 * (r & 7));
                if (r < 8) { kaLo |= xa; kbLo |= xb; } else { kaHi |= xa; kbHi |= xb; } }
            float fa[8];
#pragma unroll
            for (int i = 0; i < 8; ++i) { const int ka = hi ? top[0][2 * i + 1] : top[0][2 * i]; fa[i] = __uint_as_float((unsigned)fkey(ka) & ~127u) - fa0; }
            const int hid = 255 - (hi << 4);
            int n = 0;
#pragma unroll
            for (int i = 0; i < 8; ++i)
#pragma unroll
                for (int b = 0; b < 16; ++b) if ((2 * i + 1) * (b + 1) <= 16) {
                    const float sum = fa[i] + fb[b];
                    cand[n++] = fkey((int)((__float_as_uint(sum) & ~255u) | (unsigned)(hid - (32 * i + b))));
                }
#pragma unroll
            for (; n < 32; ++n) cand[n] = (int)0x80000000;
        }
        tk_sort<16>(cand); tk_sort<16>(cand + 16); tk_merge16(cand, cand + 16);
        tk_merge_partner(cand);
        float ev[16]; float esum = 0.f;
#pragma unroll
        for (int j = 0; j < 16; ++j) { ev[j] = __expf(__uint_as_float((unsigned)fkey(cand[j]) & ~255u)); esum += ev[j]; }
        const float rs = 1.0f / esum;
        int oi[8]; float og[8];
#pragma unroll
        for (int j = 0; j < 8; ++j) { const int w = hi ? cand[8 + j] : cand[j]; const float e = hi ? ev[8 + j] : ev[j];
            const int id8 = 255 - (fkey(w) & 255), ra = id8 >> 4, rb = id8 & 15;
            const unsigned long long wa = (ra & 8) ? kaHi : kaLo, wb = (rb & 8) ? kbHi : kbLo;
            const int ka = (int)(wa >> (8 * (ra & 7))) & 127, kb = (int)(wb >> (8 * (rb & 7))) & 127;
            oi[j] = ka * 128 + kb; og[j] = e * rs; }
        int* ip = IDX + (size_t)token * 128 + h * 16 + hi * 8; float* gp = GATE + (size_t)token * 128 + h * 16 + hi * 8;
        *(int4*)ip = make_int4(oi[0], oi[1], oi[2], oi[3]); *(int4*)(ip + 4) = make_int4(oi[4], oi[5], oi[6], oi[7]);
        *(f32x4*)gp = (f32x4){og[0], og[1], og[2], og[3]}; *(f32x4*)(gp + 4) = (f32x4){og[4], og[5], og[6], og[7]};
    }
}

#if TAB_FP4
__device__ __forceinline__ void peer_expert_phase(const Frame& F0, const bf16_t* H2, const int* IDX, const float* GATE, const unsigned char* U, size_t v_minus_u_bytes, const float* USC, const float* VSC,
                                                  const float* g2  , float* XW, float* OUT,
                                                  bf16_t* HN  , const float* ng  , const float* nmod  ) {
    const Frame F = phase_frame(F0);
    LAS float* red = (LAS float*)F.lds;
    const unsigned voff_tab = (unsigned)v_minus_u_bytes;
    const __amdgpu_buffer_rsrc_t rs = __builtin_amdgcn_make_buffer_rsrc((void*)U, 0, (int)(voff_tab + (unsigned)NEXP * ROWB), 0x00020000);
    const int lane = F.lane; const int voff = lane * 16;
#define PX_SB() __builtin_amdgcn_sched_barrier(0)
#define PX_LOADALL(buf, ivv, tb) do { _Pragma("unroll") for (int e_ = 0; e_ < 16; ++e_) buf[e_] = __builtin_amdgcn_raw_buffer_load_b128(rs, voff, (unsigned)__builtin_amdgcn_readlane(ivv, e_) * (unsigned)ROWB + (tb), 0); } while (0)
#define PX_U1(d_, b_) { const bf16x2_t r2_ = __builtin_amdgcn_cvt_scalef32_pk_bf16_fp4(wd_[d_], 1.0f, b_); if ((b_) & 1) a1_ = __builtin_amdgcn_fdot2_f32_bf16(r2_, __builtin_bit_cast(bf16x2_t, xpk[4 * (d_) + (b_)]), a1_, false); \
                        else a0_ = __builtin_amdgcn_fdot2_f32_bf16(r2_, __builtin_bit_cast(bf16x2_t, xpk[4 * (d_) + (b_)]), a0_, false); }
#define PX_V1(d_, b_) { const f32x2 t2_ = __builtin_amdgcn_cvt_scalef32_pk_f32_fp4(wd_[d_], 1.0f, b_); acc[8 * (d_) + 2 * (b_)] += wg_ * t2_.x; acc[8 * (d_) + 2 * (b_) + 1] += wg_ * t2_.y; }
#define PX_FETCH_TOKEN(r, XP, IV, GV) do { const u32x4* xp_ = (const u32x4*)(H2 + (size_t)(r) * DM + lane * 16); XP[0] = xp_[0]; XP[1] = xp_[1]; XP[2] = xp_[128]; XP[3] = xp_[129]; \
        IV = 0; GV = 0.f; if (lane < 16) { IV = IDX[(size_t)(r) * 128 + F.wave * 16 + lane]; GV = GATE[(size_t)(r) * 128 + F.wave * 16 + lane]; } } while (0)
    const bool skip_ctx = (OUT != nullptr);
    int row = F.vcu; if (skip_ctx && row < MROWS && row_cls(row) == 2) row += F.G;
    u32x4 xp[4]; int iv; float gv;
    u32x4 ub[16], vb[16];
    if (row < MROWS) { PX_FETCH_TOKEN(row, xp, iv, gv); PX_LOADALL(ub, iv, 0u); PX_LOADALL(vb, iv, voff_tab); }
    int par = 0;
    while (row < MROWS) {
        int nrow = row + F.G; if (skip_ctx && nrow < MROWS && row_cls(nrow) == 2) nrow += F.G;
        float usc = 0.f, vsc = 0.f;
        if (lane < 16) { usc = USC[iv]; vsc = VSC[iv]; }
        u32x4 xpn[4]; int ivn = 0; float gvn = 0.f;
        if (nrow < MROWS) PX_FETCH_TOKEN(nrow, xpn, ivn, gvn);
        const int cls = row_cls(row);
        const f32x4 x_old = *((const f32x4*)(XW + (size_t)row * DM) + F.tid), g_vec = *((const f32x4*)(g2 + (size_t)cls * NMOD) + F.tid);
        f32x4 n_g = {0.f, 0.f, 0.f, 0.f}, n_sc = n_g, n_sh = n_g;
        if (HN) { n_g = *((const f32x4*)ng + F.tid); n_sc = *((const f32x4*)(nmod + (size_t)cls * NMOD + 2048) + F.tid); n_sh = *((const f32x4*)(nmod + (size_t)cls * NMOD) + F.tid); }
        const unsigned xpk[16] = {xp[0].x, xp[0].y, xp[0].z, xp[0].w, xp[1].x, xp[1].y, xp[1].z, xp[1].w, xp[2].x, xp[2].y, xp[2].z, xp[2].w, xp[3].x, xp[3].y, xp[3].z, xp[3].w};
        float sv = 0.f;
        PX_SB();
#pragma unroll
        for (int e = 0; e < 16; ++e) {
            u32x4 w_ = ub[e]; asm volatile("" : "+v"(w_) : "v"(sv));
            const unsigned wd_[4] = {w_.x, w_.y, w_.z, w_.w}; float a0_ = 0.f, a1_ = 0.f;
            PX_U1(0, 0) PX_U1(0, 1) PX_U1(0, 2) PX_U1(0, 3) PX_U1(1, 0) PX_U1(1, 1) PX_U1(1, 2) PX_U1(1, 3) PX_U1(2, 0) PX_U1(2, 1) PX_U1(2, 2) PX_U1(2, 3) PX_U1(3, 0) PX_U1(3, 1) PX_U1(3, 2) PX_U1(3, 3)
            const float t_ = wave_sum_dpp(a0_ + a1_); sv = (lane == e) ? t_ : sv;
        }
        const float wv = gelu_erf(sv * usc) * gv * vsc;
        PX_SB();
        if (nrow < MROWS) PX_LOADALL(ub, ivn, 0u);
        PX_SB();
        f32x32 acc = {};
#pragma unroll
        for (int e = 0; e < 16; ++e) {
            u32x4 w_ = vb[e]; asm volatile("" : "+v"(w_) : "v"(acc));
            const unsigned wd_[4] = {w_.x, w_.y, w_.z, w_.w}; const float wg_ = __uint_as_float(__builtin_amdgcn_readlane(__float_as_uint(wv), e));
            PX_V1(0, 0) PX_V1(0, 1) PX_V1(0, 2) PX_V1(0, 3) PX_V1(1, 0) PX_V1(1, 1) PX_V1(1, 2) PX_V1(1, 3) PX_V1(2, 0) PX_V1(2, 1) PX_V1(2, 2) PX_V1(2, 3) PX_V1(3, 0) PX_V1(3, 1) PX_V1(3, 2) PX_V1(3, 3)
        }
        PX_SB();
        if (nrow < MROWS) PX_LOADALL(vb, ivn, voff_tab);
        PX_SB();
        LAS float* rb = red + par * (NWAVES * DM);
#pragma unroll
        for (int j = 0; j < 2; ++j)
#pragma unroll
            for (int q = 0; q < 4; ++q) *(LAS f32x4*)(rb + F.wave * DM + j * 1024 + lane * 16 + q * 4) = (f32x4){acc[j * 16 + q * 4], acc[j * 16 + q * 4 + 1], acc[j * 16 + q * 4 + 2], acc[j * 16 + q * 4 + 3]};
        __syncthreads();
        {
            f32x4 sm = {0.f, 0.f, 0.f, 0.f};
#pragma unroll
            for (int w = 0; w < 8; ++w) sm += *(const LAS f32x4*)(rb + w * DM + F.tid * 4);
            f32x4* xq = (f32x4*)(XW + (size_t)row * DM) + F.tid;
            const f32x4 xn = x_old + g_vec * sm;
            *xq = xn;
            if (OUT) { const int b = row / RB, i = row - b * RB; if (i >= CTX) *((f32x4*)(OUT + ((size_t)b * SEQ + (i - CTX)) * DM) + F.tid) = xn; }
            if (HN) {
                LAS float* ssp = (LAS float*)(F.lds + 131072) + par * 8;
                const float sw = wave_sum_dpp((xn.x * xn.x + xn.y * xn.y) + (xn.z * xn.z + xn.w * xn.w));
                if (lane == 0) ssp[F.wave] = sw;
                __syncthreads();
                const float tot = ((ssp[0] + ssp[1]) + (ssp[2] + ssp[3])) + ((ssp[4] + ssp[5]) + (ssp[6] + ssp[7]));
                const float rstd = 1.0f / sqrtf(tot * (1.f / DM) + EPS);
                const f32x4 y = (xn * rstd) * n_g * (n_sc + 1.0f) + n_sh;
                u32x2 o; o.x = pk2(y.x, y.y); o.y = pk2(y.z, y.w);
                *((u32x2*)(HN + (size_t)row * DM) + F.tid) = o;
            }
        }
        par ^= 1; row = nrow;
#pragma unroll
        for (int q = 0; q < 4; ++q) xp[q] = xpn[q];
        iv = ivn; gv = gvn;
    }
#undef PX_LOADALL
#undef PX_U1
#undef PX_V1
#undef PX_SB
#undef PX_FETCH_TOKEN
}
#else
__device__ __forceinline__ void peer_expert_phase(const Frame& F0, const bf16_t* H2, const int* IDX, const float* GATE, const unsigned char* U, size_t v_minus_u_bytes, const float* USC, const float* VSC,
                                                  const float* g2  , float* XW, float* OUT,
                                                  bf16_t* HN  , const float* ng  , const float* nmod  ) {
    const Frame F = phase_frame(F0);
    LAS float* red = (LAS float*)F.lds;
    const unsigned voff_tab = (unsigned)v_minus_u_bytes;
    const __amdgpu_buffer_rsrc_t rs = __builtin_amdgcn_make_buffer_rsrc((void*)U, 0, (int)(voff_tab + (unsigned)NEXP * ROWB), 0x00020000);
    const int lane = F.lane; const int voff = lane * 16, voff2 = 1024 + lane * 8;
#define PX_SB() __builtin_amdgcn_sched_barrier(0)
#define PX_LOAD(buf, s, ivv) do { constexpr int e0_ = ((s) & 3) * 4; const unsigned tb_ = ((s) >= 4) ? voff_tab : 0u; \
        _Pragma("unroll") for (int ee_ = 0; ee_ < 4; ++ee_) { const unsigned o_ = (unsigned)__builtin_amdgcn_readlane(ivv, e0_ + ee_) * (unsigned)ROWB + tb_; \
            buf##h[ee_] = __builtin_amdgcn_raw_buffer_load_b128(rs, voff, o_, 0); buf##l[ee_] = __builtin_amdgcn_raw_buffer_load_b64(rs, voff2, o_, 0); } } while (0)
#define PX_DECODE(buf, ee_, dep) u32x6 w6_ = {buf##h[ee_].x, buf##h[ee_].y, buf##h[ee_].z, buf##h[ee_].w, buf##l[ee_].x, buf##l[ee_].y}; \
        asm volatile("" : "+v"(w6_) : "v"(dep));     \
        const f32x32 r_ = __builtin_amdgcn_cvt_scalef32_pk32_f32_fp6(w6_, 1.0f);
#define PX_COMP_U(buf, s) do { constexpr int e0_ = ((s) & 3) * 4; \
            _Pragma("unroll") for (int ee_ = 0; ee_ < 4; ++ee_) { PX_DECODE(buf, ee_, sv) \
                const f32x32 p_ = r_ * xf; float a0_ = 0.f, a1_ = 0.f; \
                _Pragma("unroll") for (int k_ = 0; k_ < 32; k_ += 2) { a0_ += p_[k_]; a1_ += p_[k_ + 1]; } \
                const float t_ = wave_sum_dpp(a0_ + a1_); sv = (lane == e0_ + ee_) ? t_ : sv; } } while (0)
#define PX_COMP_V(buf, s) do { constexpr int e0_ = ((s) & 3) * 4; \
            _Pragma("unroll") for (int ee_ = 0; ee_ < 4; ++ee_) { const float wg_ = __uint_as_float(__builtin_amdgcn_readlane(__float_as_uint(wv), e0_ + ee_)); \
                PX_DECODE(buf, ee_, acc) \
                acc += r_ * wg_; } } while (0)
#define PX_FETCH_TOKEN(r, XP, IV, GV) do { const u32x4* xp_ = (const u32x4*)(H2 + (size_t)(r) * DM + lane * 16); XP[0] = xp_[0]; XP[1] = xp_[1]; XP[2] = xp_[128]; XP[3] = xp_[129]; \
        IV = 0; GV = 0.f; if (lane < 16) { IV = IDX[(size_t)(r) * 128 + F.wave * 16 + lane]; GV = GATE[(size_t)(r) * 128 + F.wave * 16 + lane]; } } while (0)
    const bool skip_ctx = (OUT != nullptr);
    int row = F.vcu; if (skip_ctx && row < MROWS && row_cls(row) == 2) row += F.G;
    u32x4 xp[4]; int iv; float gv;
    u32x4 bAh[4], bBh[4]; u32x2 bAl[4], bBl[4];
    if (row < MROWS) { PX_FETCH_TOKEN(row, xp, iv, gv); PX_LOAD(bA, 0, iv); }
    int par = 0;
    while (row < MROWS) {
        int nrow = row + F.G; if (skip_ctx && nrow < MROWS && row_cls(nrow) == 2) nrow += F.G;
        f32x32 xf;
#pragma unroll
        for (int q = 0; q < 4; ++q) { const unsigned ww[4] = {xp[q].x, xp[q].y, xp[q].z, xp[q].w};
#pragma unroll
            for (int k = 0; k < 4; ++k) { xf[q * 8 + 2 * k] = bf_lo(ww[k]); xf[q * 8 + 2 * k + 1] = bf_hi(ww[k]); } }
        float usc = 0.f, vsc = 0.f;
        if (lane < 16) { usc = USC[iv]; vsc = VSC[iv]; }
        u32x4 xpn[4]; int ivn = 0; float gvn = 0.f;
        if (nrow < MROWS) PX_FETCH_TOKEN(nrow, xpn, ivn, gvn);
        const int cls = row_cls(row);
        const f32x4 x_old = *((const f32x4*)(XW + (size_t)row * DM) + F.tid), g_vec = *((const f32x4*)(g2 + (size_t)cls * NMOD) + F.tid);
        f32x4 n_g = {0.f, 0.f, 0.f, 0.f}, n_sc = n_g, n_sh = n_g;
        if (HN) { n_g = *((const f32x4*)ng + F.tid); n_sc = *((const f32x4*)(nmod + (size_t)cls * NMOD + 2048) + F.tid); n_sh = *((const f32x4*)(nmod + (size_t)cls * NMOD) + F.tid); }
        float sv = 0.f, wv = 0.f;
        PX_LOAD(bB, 1, iv); PX_SB(); PX_COMP_U(bA, 0); PX_SB();
        PX_LOAD(bA, 2, iv); PX_SB(); PX_COMP_U(bB, 1); PX_SB();
        PX_LOAD(bB, 3, iv); PX_SB(); PX_COMP_U(bA, 2); PX_SB();
        PX_LOAD(bA, 4, iv); PX_SB(); PX_COMP_U(bB, 3); PX_SB();
        wv = gelu_erf(sv * usc) * gv * vsc;
        f32x32 acc = {};
        PX_LOAD(bB, 5, iv); PX_SB(); PX_COMP_V(bA, 4); PX_SB();
        PX_LOAD(bA, 6, iv); PX_SB(); PX_COMP_V(bB, 5); PX_SB();
        PX_LOAD(bB, 7, iv); PX_SB(); PX_COMP_V(bA, 6); PX_SB();
        if (nrow < MROWS) PX_LOAD(bA, 0, ivn);
        PX_SB(); PX_COMP_V(bB, 7); PX_SB();
        LAS float* rb = red + par * (NWAVES * DM);
#pragma unroll
        for (int j = 0; j < 2; ++j)
#pragma unroll
            for (int q = 0; q < 4; ++q) *(LAS f32x4*)(rb + F.wave * DM + j * 1024 + lane * 16 + q * 4) = (f32x4){acc[j * 16 + q * 4], acc[j * 16 + q * 4 + 1], acc[j * 16 + q * 4 + 2], acc[j * 16 + q * 4 + 3]};
        __syncthreads();
        {
            f32x4 sm = {0.f, 0.f, 0.f, 0.f};
#pragma unroll
            for (int w = 0; w < 8; ++w) sm += *(const LAS f32x4*)(rb + w * DM + F.tid * 4);
            f32x4* xq = (f32x4*)(XW + (size_t)row * DM) + F.tid;
            const f32x4 xn = x_old + g_vec * sm;
            *xq = xn;
            if (OUT) { const int b = row / RB, i = row - b * RB; if (i >= CTX) *((f32x4*)(OUT + ((size_t)b * SEQ + (i - CTX)) * DM) + F.tid) = xn; }
            if (HN) {
                LAS float* ssp = (LAS float*)(F.lds + 131072) + par * 8;
                const float sw = wave_sum_dpp((xn.x * xn.x + xn.y * xn.y) + (xn.z * xn.z + xn.w * xn.w));
                if (lane == 0) ssp[F.wave] = sw;
                __syncthreads();
                const float tot = ((ssp[0] + ssp[1]) + (ssp[2] + ssp[3])) + ((ssp[4] + ssp[5]) + (ssp[6] + ssp[7]));
                const float rstd = 1.0f / sqrtf(tot * (1.f / DM) + EPS);
                const f32x4 y = (xn * rstd) * n_g * (n_sc + 1.0f) + n_sh;
                u32x2 o; o.x = pk2(y.x, y.y); o.y = pk2(y.z, y.w);
                *((u32x2*)(HN + (size_t)row * DM) + F.tid) = o;
            }
        }
        par ^= 1; row = nrow;
#pragma unroll
        for (int q = 0; q < 4; ++q) xp[q] = xpn[q];
        iv = ivn; gv = gvn;
    }
#undef PX_LOAD
#undef PX_COMP_U
#undef PX_COMP_V
#undef PX_SB
#undef PX_FETCH_TOKEN
}
#endif

#if EXP_SLICED && TAB_FP4
__device__ __forceinline__ float oct_sum(float v) { v = DPP_ADD(v, 0xB1); v = DPP_ADD(v, 0x4E); v = DPP_ADD(v, 0x141); return v; }
__device__ __forceinline__ int sl_next_tok(int t, int stride, bool lat_only) { t += stride; if (lat_only) while (t < MROWS && row_cls(t) == 2) t += stride; return t; }
#ifndef PROBE_IDMASK
#define PROBE_IDMASK 0x7fffffff
#endif
#define SL_CL(t_) ((t_) < MROWS ? (t_) : MROWS - 1)
#define SL_IDS(t_, A_, B_) do { A_ = IDX[(size_t)(t_) * 128 + lane] & idmask; B_ = IDX[(size_t)(t_) * 128 + 64 + lane] & idmask; } while (0)
#define SL_ROWS(buf, A_, B_) do { _Pragma("unroll") for (int i_ = 0; i_ < 16; ++i_) { const int id_ = __builtin_amdgcn_ds_bpermute(bp + 32 * (i_ & 7), (i_ < 8) ? (A_) : (B_)); \
        buf[i_] = __builtin_amdgcn_raw_buffer_load_b128(rs, id_ * 128 + coloff, 0, 0); } } while (0)
#if PEER_MFMA
typedef int i32x8 __attribute__((ext_vector_type(8)));
__device__ __forceinline__ void peer_u_phase(const Frame& F0, const unsigned* XQ, const float* XS, const int* IDX, const unsigned char* U, float* PART, bool lat_only, int idmask = 0x7fffffff) {
    const Frame F = phase_frame(F0);
    const int lane = F.lane, g = lane >> 3, j = lane & 7, bp = 4 * g, n = lane & 15, kb = lane >> 4;
    const int wps = F.G >> 3, x = F.vcu / wps, wi = (F.vcu - x * wps) * NWAVES + F.wave, stride = wps * NWAVES;
    const __amdgpu_buffer_rsrc_t rs = __builtin_amdgcn_make_buffer_rsrc((void*)(U + (size_t)x * (NEXP * 128)), 0, NEXP * 128, 0x00020000);
    const int coloff = 16 * j;
    LAS unsigned char* const lbase = F.lds + F.wave * 16384;
    LAS unsigned char* const wr_even = lbase + g * 128 + ((j ^ (g >> 1)) << 4);
    LAS unsigned char* const wr_odd = lbase + g * 128 + ((j ^ (g >> 1) ^ 4) << 4);
    LAS unsigned char* const rd0 = lbase + n * 128 + ((kb ^ (n >> 1)) << 4);
    LAS unsigned char* const rd1 = lbase + n * 128 + (((4 + kb) ^ (n >> 1)) << 4);
    int t = wi - stride; t = sl_next_tok(t, stride, lat_only);
    int t1 = sl_next_tok(t, stride, lat_only), t2 = sl_next_tok(t1, stride, lat_only);
    int idA1 = 0, idB1 = 0, idA2 = 0, idB2 = 0, idA3 = 0, idB3 = 0; u32x4 xs[4], xs1[4], xs2[4], w[16], wn[16];
#define SL_XS(dst, t_) do { const u32x4* xp_ = (const u32x4*)((const unsigned char*)XQ + (size_t)(t_) * DM + 256 * x + 16 * kb); dst[0] = xp_[0]; dst[1] = xp_[4]; dst[2] = xp_[8]; dst[3] = xp_[12]; } while (0)
    { int idA0, idB0; const int c0_ = SL_CL(t), c1_ = SL_CL(t1), c2_ = SL_CL(t2); SL_IDS(c0_, idA0, idB0); SL_XS(xs1, c0_); SL_ROWS(w, idA0, idB0); SL_IDS(c1_, idA2, idB2); SL_XS(xs2, c1_); SL_IDS(c2_, idA3, idB3); }
#define SL_UBODY(CUR, NXT) do { \
        const int t3 = sl_next_tok(t2, stride, lat_only); \
_Pragma("unroll") \
        for (int q = 0; q < 4; ++q) { xs[q] = xs1[q]; xs1[q] = xs2[q]; } \
        idA1 = idA2; idB1 = idB2; idA2 = idA3; idB2 = idB3; \
        SL_ROWS(NXT, idA1, idB1); \
        { const int c2_ = SL_CL(t2), c3_ = SL_CL(t3); SL_XS(xs2, c2_); SL_IDS(c3_, idA3, idB3); } \
_Pragma("unroll") \
        for (int i = 0; i < 16; ++i) *(LAS u32x4*)(((i & 1) ? wr_odd : wr_even) + i * 1024) = CUR[i]; \
        const i32x8 a0 = {(int)xs[0].x, (int)xs[0].y, (int)xs[0].z, (int)xs[0].w, (int)xs[1].x, (int)xs[1].y, (int)xs[1].z, (int)xs[1].w}; \
        const i32x8 a1 = {(int)xs[2].x, (int)xs[2].y, (int)xs[2].z, (int)xs[2].w, (int)xs[3].x, (int)xs[3].y, (int)xs[3].z, (int)xs[3].w}; \
        float res_lo = 0.f, res_hi = 0.f; \
_Pragma("unroll") \
        for (int h = 0; h < 8; ++h) { \
            const u32x4 r0_ = *(LAS u32x4*)(rd0 + h * 2048), r1_ = *(LAS u32x4*)(rd1 + h * 2048); \
            const i32x8 b0 = {(int)r0_.x, (int)r0_.y, (int)r0_.z, (int)r0_.w, 0, 0, 0, 0}; \
            const i32x8 b1 = {(int)r1_.x, (int)r1_.y, (int)r1_.z, (int)r1_.w, 0, 0, 0, 0}; \
            f32x4 d = {0.f, 0.f, 0.f, 0.f}; \
            d = __builtin_amdgcn_mfma_scale_f32_16x16x128_f8f6f4(a0, b0, d, 0, 4, 0, 0, 0, 0); \
            d = __builtin_amdgcn_mfma_scale_f32_16x16x128_f8f6f4(a1, b1, d, 0, 4, 0, 0, 0, 0); \
            if (h < 4) res_lo = (kb == h) ? d[0] : res_lo; else res_hi = (kb == h - 4) ? d[0] : res_hi; \
        } \
        float* pp = PART + ((size_t)t * 8 + x) * 128 + lane; \
        pp[0] = res_lo; pp[64] = res_hi; \
        t = t1; t1 = t2; t2 = t3; \
    } while (0)
    while (t < MROWS) { SL_UBODY(w, wn); if (!(t < MROWS)) break; SL_UBODY(wn, w); }
#undef SL_UBODY
#undef SL_XS
}
#else
__device__ __forceinline__ void peer_u_phase(const Frame& F0, const unsigned* XQ, const float* XS, const int* IDX, const unsigned char* U, float* PART, bool lat_only, int idmask = 0x7fffffff) {
    const Frame F = phase_frame(F0);
    const int lane = F.lane, g = lane >> 3, j = lane & 7, bp = 4 * g;
    const int wps = F.G >> 3, x = F.vcu / wps, wi = (F.vcu - x * wps) * NWAVES + F.wave, stride = wps * NWAVES;
    const __amdgpu_buffer_rsrc_t rs = __builtin_amdgcn_make_buffer_rsrc((void*)(U + (size_t)x * (NEXP * 128)), 0, NEXP * 128, 0x00020000);
    const int coloff = 16 * j;
    int t = wi - stride; t = sl_next_tok(t, stride, lat_only);
    int t1 = sl_next_tok(t, stride, lat_only), t2 = sl_next_tok(t1, stride, lat_only);
    int idA1 = 0, idB1 = 0, idA2 = 0, idB2 = 0, idA3 = 0, idB3 = 0; u32x4 xs[3], xs1[3], xs2[3], w[16], wn[16];
#define SL_XS(dst, t_) do { const u32x4* xp_ = (const u32x4*)(XQ + ((size_t)(t_) * 64 + 8 * x + j) * 8); dst[0] = xp_[0]; dst[1] = xp_[1]; const f32x2 s2_ = *(const f32x2*)(XS + ((size_t)(t_) * 64 + 8 * x + j) * 2); dst[2] = (u32x4){__float_as_uint(s2_.x), __float_as_uint(s2_.y), 0u, 0u}; } while (0)
    { int idA0, idB0; const int c0_ = SL_CL(t), c1_ = SL_CL(t1), c2_ = SL_CL(t2); SL_IDS(c0_, idA0, idB0); SL_XS(xs1, c0_); SL_ROWS(w, idA0, idB0); SL_IDS(c1_, idA2, idB2); SL_XS(xs2, c1_); SL_IDS(c2_, idA3, idB3); }
#define SL_UBODY(CUR, NXT) do { \
        const int t3 = sl_next_tok(t2, stride, lat_only); \
_Pragma("unroll") \
        for (int q = 0; q < 3; ++q) { xs[q] = xs1[q]; xs1[q] = xs2[q]; } \
        idA1 = idA2; idB1 = idB2; idA2 = idA3; idB2 = idB3; \
        SL_ROWS(NXT, idA1, idB1); \
        { const int c2_ = SL_CL(t2), c3_ = SL_CL(t3); SL_XS(xs2, c2_); SL_IDS(c3_, idA3, idB3); } \
        const int xh[4] = {(int)xs[0].x, (int)xs[0].y, (int)xs[0].z, (int)xs[0].w}, xl[4] = {(int)xs[1].x, (int)xs[1].y, (int)xs[1].z, (int)xs[1].w}; \
        const float dq = __uint_as_float(xs[2].x), off = __uint_as_float(xs[2].y); \
        float res_lo = 0.f, res_hi = 0.f; \
_Pragma("unroll") \
        for (int i = 0; i < 16; ++i) { \
            const int wd_[4] = {(int)CUR[i].x, (int)CUR[i].y, (int)CUR[i].z, (int)CUR[i].w}; int ah_ = 0, al_ = 0; \
_Pragma("unroll") \
            for (int d = 0; d < 4; ++d) { ah_ = __builtin_amdgcn_sdot8(wd_[d], xh[d], ah_, false); al_ = __builtin_amdgcn_sdot8(wd_[d], xl[d], al_, false); } \
            const float a_ = oct_sum(((float)(16 * ah_ + al_) + off) * dq); \
            if (i < 8) res_lo = (j == i) ? a_ : res_lo; else res_hi = (j == i - 8) ? a_ : res_hi; \
        } \
        float* pp = PART + ((size_t)t * 8 + x) * 128 + 8 * j + g; \
        pp[0] = res_lo; pp[64] = res_hi; \
        t = t1; t1 = t2; t2 = t3; \
    } while (0)
    while (t < MROWS) { SL_UBODY(w, wn); if (!(t < MROWS)) break; SL_UBODY(wn, w); }
#undef SL_UBODY
#undef SL_XS
}
#endif
#if PEER_VMFMA
typedef int i32x8v __attribute__((ext_vector_type(8)));
typedef int i32x2v __attribute__((ext_vector_type(2)));
constexpr int WQ_U = 3;
__device__ __forceinline__ void peer_wq_phase(const Frame& F0, const float* PART, const int* IDX, const float* GATE, const float* USC, const float* VSC, bool lat_only, unsigned char* WQ8, float* WSC, const float* XS = nullptr) {
    const Frame F = phase_frame(F0);
    const int lane = F.lane;
    for (int t0 = F.gw; t0 < MROWS; t0 += WQ_U * F.NGW) {
        float s[WQ_U][2]; int id[WQ_U][2]; float gt[WQ_U][2]; bool ok[WQ_U];
#pragma unroll
        for (int u = 0; u < WQ_U; ++u) { const int t = t0 + u * F.NGW; ok[u] = t < MROWS && !(lat_only && row_cls(t) == 2);
            s[u][0] = s[u][1] = 0.f; id[u][0] = id[u][1] = 0; gt[u][0] = gt[u][1] = 0.f;
            if (ok[u]) { const float* pp = PART + (size_t)t * 1024 + lane;
#pragma unroll
                for (int xx = 0; xx < 8; ++xx) { s[u][0] += pp[xx * 128]; s[u][1] += pp[xx * 128 + 64]; }
                id[u][0] = IDX[(size_t)t * 128 + lane]; id[u][1] = IDX[(size_t)t * 128 + 64 + lane]; gt[u][0] = GATE[(size_t)t * 128 + lane]; gt[u][1] = GATE[(size_t)t * 128 + 64 + lane]; } }
        float us[WQ_U][2], vs[WQ_U][2];
#pragma unroll
        for (int u = 0; u < WQ_U; ++u)
#pragma unroll
            for (int q = 0; q < 2; ++q) { us[u][q] = ok[u] ? USC[id[u][q]] : 0.f; vs[u][q] = ok[u] ? VSC[id[u][q]] : 0.f; }
#pragma unroll
        for (int u = 0; u < WQ_U; ++u) if (ok[u]) { const int t = t0 + u * F.NGW;
#if PEER_MFMA
            { const float xsc = XS[t]; us[u][0] *= xsc; us[u][1] *= xsc; }
#endif
            const float w0 = gt[u][0] * gelu_erf(s[u][0] * us[u][0]) * vs[u][0], w1 = gt[u][1] * gelu_erf(s[u][1] * us[u][1]) * vs[u][1];
            const float am = fmaxf(wave_max_dpp(fmaxf(fabsf(w0), fabsf(w1))), 1e-30f), qs = 440.0f / am;
            const int pk = __builtin_amdgcn_cvt_pk_fp8_f32(w0 * qs, w1 * qs, 0, false);
            WQ8[(size_t)t * 128 + lane] = (unsigned char)(pk & 0xff); WQ8[(size_t)t * 128 + 64 + lane] = (unsigned char)((pk >> 8) & 0xff);
            if (lane == 0) WSC[t] = am * (1.0f / 440.0f); }
    }
}
__device__ __forceinline__ void peer_v_phase(const Frame& F0, const int* IDX, const unsigned char* WQ8, const float* WSC, const unsigned char* VT, const float* g2  , bf16_t* XW, float* OUT, bool lat_only) {
    const int idmask = 0x7fffffff;
    const Frame F = phase_frame(F0);
    const int lane = F.lane, g = lane >> 3, j = lane & 7, bp = 4 * g, n = lane & 15, kb = lane >> 4;
    const int wps = F.G >> 3, x = F.vcu / wps, wi = (F.vcu - x * wps) * NWAVES + F.wave, stride = wps * NWAVES;
    const __amdgpu_buffer_rsrc_t rs = __builtin_amdgcn_make_buffer_rsrc((void*)(VT + (size_t)x * (NEXP * 128)), 0, NEXP * 128, 0x00020000);
    const int coloff = 16 * j;
    LAS unsigned char* const lbase = F.lds + F.wave * 16384;
    LAS unsigned char* const wr_even = lbase + g * 128 + ((j ^ (g >> 1)) << 4);
    LAS unsigned char* const wr_odd = lbase + g * 128 + ((j ^ (g >> 1) ^ 4) << 4);
    LAS unsigned char* const rd_row = lbase + (32 * kb + n) * 128;
    const int rsw = (n >> 1) << 4;
    const int col0 = 256 * x + lane;
    int t = wi - stride; t = sl_next_tok(t, stride, lat_only);
    int t1 = sl_next_tok(t, stride, lat_only), t2 = sl_next_tok(t1, stride, lat_only);
    int idA1 = 0, idB1 = 0, idA2 = 0, idB2 = 0, idA3 = 0, idB3 = 0; u32x4 w[16], wn[16];
    u32x4 wa[2], wa1[2], wa2[2]; float sc = 0.f, sc1 = 0.f, sc2 = 0.f;
    float xo[4], gv[4], xo1[4], gv1[4], xo2[4], gv2[4];
#pragma unroll
    for (int q = 0; q < 4; ++q) { xo[q] = gv[q] = xo1[q] = gv1[q] = xo2[q] = gv2[q] = 0.f; }
    wa[0] = wa[1] = wa1[0] = wa1[1] = wa2[0] = wa2[1] = (u32x4){0u, 0u, 0u, 0u};
#define SL_WA(dst, S_, t_) do { const u32x4* wp_ = (const u32x4*)(WQ8 + (size_t)(t_) * 128 + 16 * kb); dst[0] = wp_[0]; dst[1] = wp_[4]; S_ = WSC[t_]; } while (0)
#define SL_XG(t_, X_, G_) do { const bf16_t* xp_ = XW + (size_t)(t_) * DM + col0; const float* gp_ = g2 + (size_t)row_cls(t_) * NMOD + col0; _Pragma("unroll") for (int q_ = 0; q_ < 4; ++q_) { X_[q_] = bf2f(xp_[64 * q_]); G_[q_] = gp_[64 * q_]; } } while (0)
    { int idA0, idB0; const int c0_ = SL_CL(t), c1_ = SL_CL(t1), c2_ = SL_CL(t2); SL_IDS(c0_, idA0, idB0); SL_WA(wa1, sc1, c0_); SL_XG(c0_, xo1, gv1); SL_ROWS(w, idA0, idB0);
      SL_IDS(c1_, idA2, idB2); SL_WA(wa2, sc2, c1_); SL_XG(c1_, xo2, gv2); SL_IDS(c2_, idA3, idB3); }
#define SL_VBODY(CUR, NXT) do { \
        const int t3 = sl_next_tok(t2, stride, lat_only); \
        wa[0] = wa1[0]; wa[1] = wa1[1]; wa1[0] = wa2[0]; wa1[1] = wa2[1]; sc = sc1; sc1 = sc2; \
_Pragma("unroll") \
        for (int q = 0; q < 4; ++q) { xo[q] = xo1[q]; gv[q] = gv1[q]; xo1[q] = xo2[q]; gv1[q] = gv2[q]; } \
        idA1 = idA2; idB1 = idB2; idA2 = idA3; idB2 = idB3; \
        SL_ROWS(NXT, idA1, idB1); \
        { const int c2_ = SL_CL(t2), c3_ = SL_CL(t3); SL_WA(wa2, sc2, c2_); SL_XG(c2_, xo2, gv2); SL_IDS(c3_, idA3, idB3); } \
_Pragma("unroll") \
        for (int i = 0; i < 16; ++i) *(LAS u32x4*)(((i & 1) ? wr_odd : wr_even) + i * 1024) = CUR[i]; \
        const i32x8v a = {(int)wa[0].x, (int)wa[0].y, (int)wa[0].z, (int)wa[0].w, (int)wa[1].x, (int)wa[1].y, (int)wa[1].z, (int)wa[1].w}; \
        float vs[4] = {0.f, 0.f, 0.f, 0.f}; \
_Pragma("unroll") \
        for (int cb = 0; cb < 16; ++cb) { \
            LAS unsigned char* ra_ = rd_row + ((((cb >> 1) << 4) ^ rsw) + ((cb & 1) << 3)); \
            const i32x2v lo_ = __builtin_amdgcn_ds_read_tr4_b64_v2i32((LAS i32x2v*)ra_), hi_ = __builtin_amdgcn_ds_read_tr4_b64_v2i32((LAS i32x2v*)(ra_ + 2048)); \
            const i32x8v b_ = {lo_.x, lo_.y, hi_.x, hi_.y, 0, 0, 0, 0}; \
            const f32x4 z_ = {0.f, 0.f, 0.f, 0.f}; \
            const f32x4 d_ = __builtin_amdgcn_mfma_scale_f32_16x16x128_f8f6f4(a, b_, z_, 0, 4, 0, 0, 0, 0); \
            vs[cb >> 2] = (kb == (cb & 3)) ? d_[0] : vs[cb >> 2]; \
        } \
        { const int b = t / RB, i = t - b * RB; \
_Pragma("unroll") \
          for (int q = 0; q < 4; ++q) { const float xn = xo[q] + gv[q] * (sc * vs[q]); XW[(size_t)t * DM + col0 + 64 * q] = (bf16_t)f2bf(xn); \
              if (OUT) { if (i >= CTX) OUT[((size_t)b * SEQ + (i - CTX)) * DM + col0 + 64 * q] = xn; } } } \
        t = t1; t1 = t2; t2 = t3; \
    } while (0)
    while (t < MROWS) { SL_VBODY(w, wn); if (!(t < MROWS)) break; SL_VBODY(wn, w); }
#undef SL_VBODY
#undef SL_WA
#undef SL_XG
}
#else
__device__ __forceinline__ void peer_w_phase(const Frame& F0, const float* PART, const int* IDX, float* GATE, const float* USC, const float* VSC, bool lat_only, const float* XS = nullptr) {
    const Frame F = phase_frame(F0);
    const int gt = F.vcu * NTHREADS + F.tid, GT = F.G * NTHREADS;
    for (int e0 = gt; e0 < MROWS * 128; e0 += 4 * GT) {
        float s[4]; int id[4]; float gte[4], us[4], vs[4]; bool ok[4];
#pragma unroll
        for (int u = 0; u < 4; ++u) { const int e = e0 + u * GT; ok[u] = e < MROWS * 128 && !(lat_only && row_cls(e >> 7) == 2); s[u] = 0.f; id[u] = 0; gte[u] = 0.f;
            if (ok[u]) { const float* pp = PART + (size_t)(e >> 7) * 1024 + (e & 127);
#pragma unroll
                for (int xx = 0; xx < 8; ++xx) s[u] += pp[xx * 128];
                id[u] = IDX[e]; gte[u] = GATE[e]; } }
#pragma unroll
        for (int u = 0; u < 4; ++u) { us[u] = ok[u] ? USC[id[u]] : 0.f; vs[u] = ok[u] ? VSC[id[u]] : 0.f;
#if PEER_MFMA
            if (ok[u]) us[u] *= XS[(e0 + u * GT) >> 7];
#endif
        }
#pragma unroll
        for (int u = 0; u < 4; ++u) if (ok[u]) GATE[e0 + u * GT] = gte[u] * gelu_erf(s[u] * us[u]) * vs[u];
    }
}
#ifdef SELFTEST
#define SELFTEST_LEAK * (1.0f + sqrtf(*(const volatile float*)((const unsigned char*)XW - WS_XW + WS_CTL + 32768)))
#define SELFTEST_SPIKE do { if (b == 0 && i == CTX && mycol == 0) xo_.x += *(const volatile float*)((const unsigned char*)XW - WS_XW + WS_CTL + 32772); } while (0)
#else
#define SELFTEST_LEAK
#define SELFTEST_SPIKE do {} while (0)
#endif
__device__ __forceinline__ void peer_v_phase(const Frame& F0, const int* IDX, const float* WK, const unsigned char* VT, const float* g2  , float* XW, float* OUT, bool lat_only) {
    const int idmask = 0x7fffffff;
    const Frame F = phase_frame(F0);
    const int lane = F.lane, g = lane >> 3, j = lane & 7, bp = 4 * g;
    const int wps = F.G >> 3, x = F.vcu / wps, wi = (F.vcu - x * wps) * NWAVES + F.wave, stride = wps * NWAVES;
    const __amdgpu_buffer_rsrc_t rs = __builtin_amdgcn_make_buffer_rsrc((void*)(VT + (size_t)x * (NEXP * 128)), 0, NEXP * 128, 0x00020000);
    const int coloff = 16 * j;
    const int mycol = 256 * x + 32 * j + 4 * g;
    int t = wi - stride; t = sl_next_tok(t, stride, lat_only);
    int t1 = sl_next_tok(t, stride, lat_only), t2 = sl_next_tok(t1, stride, lat_only);
    int idA1 = 0, idB1 = 0, idA2 = 0, idB2 = 0, idA3 = 0, idB3 = 0; float wA = 0.f, wB = 0.f, wA1 = 0.f, wB1 = 0.f, wA2 = 0.f, wB2 = 0.f; u32x4 w[16], wn[16];
    f32x4 x_old = {0.f, 0.f, 0.f, 0.f}, g_vec = x_old, xo1 = x_old, gv1 = x_old, xo2 = x_old, gv2 = x_old;
#define SL_WK(t_, A_, B_) do { A_ = WK[(size_t)(t_) * 128 + lane]; B_ = WK[(size_t)(t_) * 128 + 64 + lane]; } while (0)
#define SL_XG(t_, X_, G_) do { X_ = *(const f32x4*)(XW + (size_t)(t_) * DM + mycol); G_ = *(const f32x4*)(g2 + (size_t)row_cls(t_) * NMOD + mycol); } while (0)
    if (t < MROWS) { int idA0, idB0; SL_IDS(t, idA0, idB0); SL_WK(t, wA1, wB1); SL_XG(t, xo1, gv1); SL_ROWS(w, idA0, idB0); }
    if (t1 < MROWS) { SL_IDS(t1, idA2, idB2); SL_WK(t1, wA2, wB2); SL_XG(t1, xo2, gv2); }
    if (t2 < MROWS) SL_IDS(t2, idA3, idB3);
#define SL_V1(d_, b_) { const h2_t r2_ = __builtin_amdgcn_cvt_scalef32_pk_f16_fp4(wd_[d_], 1.0f, b_); acc[4 * (d_) + (b_)] = __builtin_elementwise_fma(r2_, wg2_, acc[4 * (d_) + (b_)]); }
#define SL_VBODY(CUR, NXT) do { \
        const int t3 = sl_next_tok(t2, stride, lat_only); \
        wA = wA1; wB = wB1; wA1 = wA2; wB1 = wB2; x_old = xo1; g_vec = gv1; xo1 = xo2; gv1 = gv2; \
        idA1 = idA2; idB1 = idB2; idA2 = idA3; idB2 = idB3; \
        if (t1 < MROWS) SL_ROWS(NXT, idA1, idB1); \
        if (t2 < MROWS) { SL_WK(t2, wA2, wB2); SL_XG(t2, xo2, gv2); } \
        if (t3 < MROWS) SL_IDS(t3, idA3, idB3); \
        h2_t acc[16]; \
_Pragma("unroll") \
        for (int p = 0; p < 16; ++p) acc[p] = (h2_t){(_Float16)0.f, (_Float16)0.f}; \
_Pragma("unroll") \
        for (int i = 0; i < 16; ++i) { \
            const unsigned wd_[4] = {CUR[i].x, CUR[i].y, CUR[i].z, CUR[i].w}; \
            const float wgf_ = __int_as_float(__builtin_amdgcn_ds_bpermute(bp + 32 * (i & 7), __float_as_int((i < 8) ? wA : wB))); \
            const _Float16 wgh_ = (_Float16)wgf_; const h2_t wg2_ = {wgh_, wgh_}; \
            SL_V1(0, 0) SL_V1(0, 1) SL_V1(0, 2) SL_V1(0, 3) SL_V1(1, 0) SL_V1(1, 1) SL_V1(1, 2) SL_V1(1, 3) SL_V1(2, 0) SL_V1(2, 1) SL_V1(2, 2) SL_V1(2, 3) SL_V1(3, 0) SL_V1(3, 1) SL_V1(3, 2) SL_V1(3, 3) \
        } \
        unsigned m0 = 0u, m1 = 0u; \
_Pragma("unroll") \
        for (int p = 0; p < 16; ++p) { \
            h2_t v = acc[p]; \
            v = v + __builtin_bit_cast(h2_t, __builtin_amdgcn_update_dpp(0, __builtin_bit_cast(int, v), 0x128, 0xf, 0xf, true)); \
            { auto r = __builtin_amdgcn_permlane16_swap(__builtin_bit_cast(unsigned, v), __builtin_bit_cast(unsigned, v), false, false); v = __builtin_bit_cast(h2_t, (unsigned)r[0]) + __builtin_bit_cast(h2_t, (unsigned)r[1]); } \
            { auto r = __builtin_amdgcn_permlane32_swap(__builtin_bit_cast(unsigned, v), __builtin_bit_cast(unsigned, v), false, false); v = __builtin_bit_cast(h2_t, (unsigned)r[0]) + __builtin_bit_cast(h2_t, (unsigned)r[1]); } \
            if (g == (p >> 1)) { if (p & 1) m1 = __builtin_bit_cast(unsigned, v); else m0 = __builtin_bit_cast(unsigned, v); } \
        } \
        const h2_t q0 = __builtin_bit_cast(h2_t, m0), q1 = __builtin_bit_cast(h2_t, m1); \
        const f32x4 mine = {(float)q0.x, (float)q0.y, (float)q1.x, (float)q1.y}; \
        const f32x4 xn = x_old + g_vec * mine; \
        *(f32x4*)(XW + (size_t)t * DM + mycol) = xn; \
        if (OUT) { const int b = t / RB, i = t - b * RB; if (i >= CTX) { f32x4 xo_ = xn SELFTEST_LEAK; SELFTEST_SPIKE; *(f32x4*)(OUT + ((size_t)b * SEQ + (i - CTX)) * DM + mycol) = xo_; } } \
        t = t1; t1 = t2; t2 = t3; \
    } while (0)
    while (t < MROWS) { SL_VBODY(w, wn); if (!(t < MROWS)) break; SL_VBODY(wn, w); }
#undef SL_VBODY
#undef SL_V1
#undef SL_WK
#undef SL_XG
}
#endif
#undef SL_IDS
#undef SL_ROWS
#undef SL_CL
#endif
#ifndef N_LAUNCHES
#define N_LAUNCHES 1
#endif
struct Args { const float* in[26]; float* out; unsigned char* ws; int ph_lo, ph_hi; };
constexpr int NPHASES = 39;
__global__ void __launch_bounds__(NTHREADS, 2) fwd_kernel(Args args) {
    extern __shared__ __attribute__((aligned(16))) unsigned char lds_raw[];
    Frame F_;
    F_.lds = (LAS unsigned char*)lds_raw;
    F_.tid = threadIdx.x; F_.lane = F_.tid & 63; F_.wave = __builtin_amdgcn_readfirstlane(F_.tid >> 6);
    F_.G = gridDim.x; { const int bx = blockIdx.x; F_.vcu = (F_.G % 8 == 0) ? (bx % 8) * (F_.G / 8) + bx / 8 : bx; }
    F_.gw = F_.vcu * NWAVES + F_.wave; F_.NGW = F_.G * NWAVES;
    F_.ws = args.ws;
    volatile LAS unsigned* MISC = (volatile LAS unsigned*)(F_.lds + LDS_MISC);
    if (F_.tid < 32) MISC[F_.tid] = 0u;
    __syncthreads();
    const int lo = args.ph_lo, hi = args.ph_hi;
    XcdBarrier bar; bar.bar = (unsigned*)(args.ws + WS_CTL) + CW_BAR; bar.x = 0; bar.st = nullptr;
    if (N_LAUNCHES == 1 || hi - lo > 1) bar = xcd_barrier_post((unsigned*)(args.ws + WS_CTL) + CW_BAR, MISC + 8);
#if N_LAUNCHES == 1
#define IN(k) true
#define SEAM(k) xcd_barrier(bar)
#else
#define IN(k) (lo <= (k) && (k) < hi)
#define SEAM(k) do { if (IN(k) && IN((k) + 1)) xcd_barrier(bar); } while (0)
#endif
    PG8_LAS unsigned char* glds = (PG8_LAS unsigned char*)lds_raw;

    if (IN(0)) { p0_prologue(F_, args.in); } SEAM(0);

#pragma unroll 1
    for (int lp = 0; lp < 2; ++lp) {
        const int pb = 1 + lp * 19;
        unsigned char* ws = args.ws; asm volatile("" : "+s"(ws));
        Frame F = F_; { int w_ = F_.wave, v_ = F_.vcu, g_ = F_.G; asm volatile("" : "+s"(w_), "+s"(v_), "+s"(g_)); F.wave = w_; F.vcu = v_; F.G = g_; F.gw = v_ * NWAVES + w_; F.NGW = g_ * NWAVES; F.ws = ws; }
        float* mod = (float*)(ws + WS_MOD); bf16_t* XW = (bf16_t*)(ws + WS_XW);
        bf16_t* H = (bf16_t*)(ws + WS_H); bf16_t* P = (bf16_t*)(ws + WS_P); bf16_t* QRAW = (bf16_t*)(ws + WS_QRAW); bf16_t* KVRAW = (bf16_t*)(ws + WS_KVRAW);
        bf16_t* Q = (bf16_t*)(ws + WS_Q); bf16_t* KB = (bf16_t*)(ws + WS_K); bf16_t* VB = (bf16_t*)(ws + WS_V); bf16_t* CAT = (bf16_t*)(ws + WS_CAT); bf16_t* PQ = (bf16_t*)(ws + WS_PQ);
        int* IDX = (int*)(ws + WS_IDX); float* GATE = (float*)(ws + WS_GATE);
        const float* rope_c = (const float*)(ws + WS_ROPE); const float* rope_a = rope_c + 64 * 32 * 2;
        const float* SMv = (const float*)(ws + WS_SMALL);
        {
            const int l = 2 * lp, i = lp;
            const float* modl = mod + (size_t)l * 3 * NMOD;
            if (lp == 0) { if (IN(pb + 0)) { norm_phase(F, XW, SMv + SM_N1G + l * DM, modl, 0, 2048, H, false); } SEAM(pb + 0); }
            if (IN(pb + 1)) {
                pg8::Gemm g{H, (const bf16_t*)(ws + WS_WIN) + (size_t)i * 4096 * DM, MROWS, 4096, DM, DM, DM}; pg8::StaticOrder S; S.init(MROWS, 4096, F.G, (int)blockIdx.x, true);
                pg8::EpiBf16 E{P, 4096};
                ctx_gemm_phase<false>(F, H, DM, (const bf16_t*)(ws + WS_WIN) + (size_t)i * 4096 * DM, DM, 4096, DM, P, nullptr, 4096, nullptr);
                pg8::gemm_phase<pg8::EpiBf16, pg8::StaticOrder, true, true>(glds, g, S, E, phase_tid(F.wave));
            } SEAM(pb + 1);
            if (IN(pb + 2)) {
                { pg8::Gemm g{P, (const bf16_t*)(ws + WS_WUQ) + (size_t)i * 1536 * 512, MROWS, 1536, 512, 4096, 512}; pg8::StaticOrder S; S.init(MROWS, 1536, F.G, (int)blockIdx.x);
                  pg8::EpiBf16 E{QRAW, 1536};
                  pg8::gemm_phase<pg8::EpiBf16, pg8::StaticOrder, true, true>(glds, g, S, E, phase_tid(F.wave)); }
                __syncthreads();
                { pg8::Gemm g{P + 512, (const bf16_t*)(ws + WS_WUKV) + (size_t)i * 2048 * 256, MROWS, 2048, 256, 4096, 256}; pg8::StaticOrder S; S.init(MROWS, 2048, F.G, (F.G == 256) ? (((int)blockIdx.x + 48) & 255) : (int)blockIdx.x);
                  pg8::EpiBf16 E{KVRAW, 2048};
                  pg8::gemm_phase<pg8::EpiBf16, pg8::StaticOrder, true, true>(glds, g, S, E, phase_tid(F.wave)); }
                __syncthreads();
                conv_phase(F, P, SMv + SM_CW + i * 3072, SMv + SM_CB + i * 1024, CAT);
            } SEAM(pb + 2);
            if (IN(pb + 3)) { prep_even_phase(F, P, QRAW, KVRAW, SMv + SM_AQG + i * 192, SMv + SM_AKG + i * 192, rope_a, Q, KB, VB); } SEAM(pb + 3);
            if (IN(pb + 4)) { attn_even_phase(F, Q, KB, VB, CAT); } SEAM(pb + 4);
            if (IN(pb + 5)) {
                pg8::Gemm g{CAT, (const bf16_t*)(ws + WS_WEO) + (size_t)i * DM * DM, MROWS, DM, DM, DM, DM}; pg8::StaticOrder S; S.init(MROWS, DM, F.G, (int)blockIdx.x, true);
                pg8::EpiResid E{XW, DM, modl + 4096};
                ctx_gemm_phase<true>(F, CAT, DM, (const bf16_t*)(ws + WS_WEO) + (size_t)i * DM * DM, DM, DM, DM, nullptr, XW, DM, modl + 4096);
                pg8::gemm_phase<pg8::EpiResid, pg8::StaticOrder, true, true>(glds, g, S, E, phase_tid(F.wave));
            } SEAM(pb + 5);
            if (IN(pb + 6)) { norm_phase(F, XW, SMv + SM_N2G + l * DM, modl, 6144, 8192, H, l == 3, (unsigned*)(ws + WS_XQ), (float*)(ws + WS_XS)); } SEAM(pb + 6);
            if (IN(pb + 7)) {
                pg8::Gemm g{H, (const bf16_t*)(ws + WS_WPQ) + (size_t)l * DM * DM, MROWS, DM, DM, DM, DM}; pg8::StaticOrder S; S.init(MROWS, DM, F.G, (int)blockIdx.x, true);
                pg8::EpiBf16 E{PQ, DM};
                ctx_gemm_phase<false>(F, H, DM, (const bf16_t*)(ws + WS_WPQ) + (size_t)l * DM * DM, DM, DM, DM, PQ, nullptr, DM, nullptr);
                pg8::gemm_phase<pg8::EpiBf16, pg8::StaticOrder, true, true>(glds, g, S, E, phase_tid(F.wave));
            } SEAM(pb + 7);
            if (IN(pb + 8)) { peer_topk_phase(F, PQ, (const bf16_t*)(ws + WS_SUBK) + (size_t)l * 16 * 128 * 128, IDX, GATE, l == 3); } SEAM(pb + 8);
            {
                const unsigned char* Ut = ws + WS_U + (size_t)l * NEXP * ROWB; const unsigned char* Vt = ws + WS_VT + (size_t)l * NEXP * ROWB;
                peer_u_phase(F, (const unsigned*)(ws + WS_XQ), (const float*)(ws + WS_XS), IDX, Ut, (float*)(ws + WS_PART), false); SEAM(0);
                peer_wq_phase(F, (const float*)(ws + WS_PART), IDX, GATE, (const float*)(ws + WS_USC) + l * NEXP, (const float*)(ws + WS_VSC) + l * NEXP, false, ws + WS_WQ8, (float*)(ws + WS_WSC), (const float*)(ws + WS_XS)); SEAM(0);
                peer_v_phase(F, IDX, ws + WS_WQ8, (const float*)(ws + WS_WSC), Vt, modl + 10240, XW, nullptr, false); SEAM(0);
                norm_phase(F, XW, SMv + SM_N1G + (l + 1) * DM, mod + (size_t)(l + 1) * 3 * NMOD, 0, 2048, H, false); SEAM(0);
            }
        }
        {
            const int l = 2 * lp + 1, i = lp, qb = pb + 10;
            const float* modl = mod + (size_t)l * 3 * NMOD;
            if (IN(qb + 1)) {
                pg8::Gemm g{H, (const bf16_t*)(ws + WS_WQKV) + (size_t)i * 3072 * DM, MROWS, 3072, DM, DM, DM}; pg8::StaticOrder S; S.init(MROWS, 3072, F.G, (int)blockIdx.x);
                pg8::EpiBf16 E{P, 3072};
                pg8::gemm_phase<pg8::EpiBf16, pg8::StaticOrder, true, true>(glds, g, S, E, phase_tid(F.wave));
                if (F.G == 256 && (int)blockIdx.x >= 152) tab_deferred_rows(F, l, ((int)blockIdx.x - 152) * NWAVES + F.wave);
            } SEAM(qb + 1);
            if (IN(qb + 2)) { prep_odd_phase(F, P, SMv + SM_CQG + i * 128, SMv + SM_CKG + i * 128, rope_c, Q, KB); } SEAM(qb + 2);
            if (IN(qb + 3)) { attn_odd_phase(F, Q, KB, P, CAT, l == 3); } SEAM(qb + 3);
            if (IN(qb + 4)) {
                pg8::Gemm g{CAT, (const bf16_t*)(ws + WS_WCO) + (size_t)i * DM * DM, MROWS, DM, DM, DM, DM}; pg8::StaticOrder S; S.init(MROWS, DM, F.G, (int)blockIdx.x, true);
                pg8::EpiResid E{XW, DM, modl + 4096};
                if (l != 3) ctx_gemm_phase<true>(F, CAT, DM, (const bf16_t*)(ws + WS_WCO) + (size_t)i * DM * DM, DM, DM, DM, nullptr, XW, DM, modl + 4096);
                pg8::gemm_phase<pg8::EpiResid, pg8::StaticOrder, true, true>(glds, g, S, E, phase_tid(F.wave));
            } SEAM(qb + 4);
            if (IN(qb + 5)) { norm_phase(F, XW, SMv + SM_N2G + l * DM, modl, 6144, 8192, H, l == 3, (unsigned*)(ws + WS_XQ), (float*)(ws + WS_XS)); } SEAM(qb + 5);
            if (IN(qb + 6)) {
                pg8::Gemm g{H, (const bf16_t*)(ws + WS_WPQ) + (size_t)l * DM * DM, MROWS, DM, DM, DM, DM}; pg8::StaticOrder S; S.init(MROWS, DM, F.G, (int)blockIdx.x, true);
                pg8::EpiBf16 E{PQ, DM};
                if (l != 3) ctx_gemm_phase<false>(F, H, DM, (const bf16_t*)(ws + WS_WPQ) + (size_t)l * DM * DM, DM, DM, DM, PQ, nullptr, DM, nullptr);
                pg8::gemm_phase<pg8::EpiBf16, pg8::StaticOrder, true, true>(glds, g, S, E, phase_tid(F.wave));
            } SEAM(qb + 6);
            if (IN(qb + 7)) { peer_topk_phase(F, PQ, (const bf16_t*)(ws + WS_SUBK) + (size_t)l * 16 * 128 * 128, IDX, GATE, l == 3); } SEAM(qb + 7);
            {
                const unsigned char* Ut = ws + WS_U + (size_t)l * NEXP * ROWB; const unsigned char* Vt = ws + WS_VT + (size_t)l * NEXP * ROWB;
                peer_u_phase(F, (const unsigned*)(ws + WS_XQ), (const float*)(ws + WS_XS), IDX, Ut, (float*)(ws + WS_PART), l == 3); SEAM(0);
                peer_wq_phase(F, (const float*)(ws + WS_PART), IDX, GATE, (const float*)(ws + WS_USC) + l * NEXP, (const float*)(ws + WS_VSC) + l * NEXP, l == 3, ws + WS_WQ8, (float*)(ws + WS_WSC), (const float*)(ws + WS_XS)); SEAM(0);
                peer_v_phase(F, IDX, ws + WS_WQ8, (const float*)(ws + WS_WSC), Vt, modl + 10240, XW, (l == 3) ? args.out : nullptr, l == 3);
                if (lp == 0) { SEAM(0); norm_phase(F, XW, SMv + SM_N1G + (l + 1) * DM, mod + (size_t)(l + 1) * 3 * NMOD, 0, 2048, H, false); SEAM(0); }
            }
        }
    }
#undef IN
#undef SEAM
}

extern "C" void kernel_launch(void* const* d_in, const int* in_sizes, int n_in, void* d_out, int out_size, void* d_ws, size_t ws_size, hipStream_t stream) {
    static int grid = 0;
    if (grid == 0) {
        if (n_in != 26 || out_size != NBATCH * SEQ * DM || ws_size < WS_END) { fprintf(stderr, "kernel_launch: unexpected shapes: n_in %d out %d ws %zu (need %zu)\n", n_in, out_size, ws_size, (size_t)WS_END); grid = -1; return; }
        int dev = 0, cus = 0, per_cu = 0;
        if (hipGetDevice(&dev) != hipSuccess || hipDeviceGetAttribute(&cus, hipDeviceAttributeMultiprocessorCount, dev) != hipSuccess) { fprintf(stderr, "kernel_launch: device query failed\n"); grid = -1; return; }
        if (hipFuncSetAttribute((const void*)fwd_kernel, hipFuncAttributeMaxDynamicSharedMemorySize, LDS_BYTES) != hipSuccess) { fprintf(stderr, "kernel_launch: hipFuncSetAttribute failed\n"); grid = -1; return; }
        if (hipOccupancyMaxActiveBlocksPerMultiprocessor(&per_cu, (const void*)fwd_kernel, NTHREADS, LDS_BYTES) != hipSuccess || per_cu < 1) { fprintf(stderr, "kernel_launch: occupancy query says %d blocks per CU\n", per_cu); (void)hipGetLastError(); grid = -1; return; }
        if (cus % 8 != 0) { fprintf(stderr, "kernel_launch: %d CUs: the phase decompositions assume a multiple of 8 workgroups\n", cus); grid = -1; return; }
        grid = cus;
    }
    if (grid < 0) return;
    (void)hipMemsetAsync((char*)d_ws + WS_CTL, 0, CTL_ZERO_BYTES, stream);
    Args a{};
    for (int i = 0; i < 26; ++i) a.in[i] = (const float*)d_in[i];
    a.out = (float*)d_out; a.ws = (unsigned char*)d_ws;
    for (int li = 0; li < N_LAUNCHES; ++li) {
        a.ph_lo = (N_LAUNCHES == 1) ? 0 : li; a.ph_hi = (N_LAUNCHES == 1) ? NPHASES : li + 1;
        hipLaunchKernelGGL(fwd_kernel, dim3(grid), dim3(NTHREADS), LDS_BYTES, stream, a);
        const hipError_t le = hipPeekAtLastError();
        if (le != hipSuccess) { fprintf(stderr, "kernel_launch: launch %d failed: %s\n", li, hipGetErrorName(le)); break; }
    }
}
```

```cpp
#include <hip/hip_runtime.h>
#include <cstdio>
#include <cstdint>
namespace pg8 {
#define PG8_LAS __attribute__((address_space(3)))
typedef unsigned short bf16_t;
typedef short bf16x8 __attribute__((ext_vector_type(8)));
typedef float f32x4 __attribute__((ext_vector_type(4)));
typedef unsigned u32x4 __attribute__((ext_vector_type(4)));
constexpr int BM = 256, BK = 64, HALF = 128, HTB = HALF * BK * 2  , STAGE_BYTES = 8 * HTB, NXCD = 8, WGM = 8;

__host__ __device__ __forceinline__ int lds_byte(int r, int c) { const int st = (r >> 4) * 2 + (c >> 5), rr = r & 15, cc = c & 31, ob = rr * 64 + cc * 2; return st * 1024 + (ob ^ (((ob >> 9) & 1) << 5)); }
__host__ __device__ __forceinline__ void stage_rc(int b, int& R, int& C) { const int st = b / 1024, sb = b % 1024, swz = sb ^ (((sb >> 9) & 1) << 5); R = (st >> 1) * 16 + swz / 64; C = (st & 1) * 32 + (swz % 64) / 2; }
__host__ __device__ __forceinline__ int perm32(int rho) { const int n = rho >> 4, i = rho & 15; return 8 * (i >> 2) + 4 * n + (i & 3); }

struct Unit { int pm, pn; };
struct Gemm { const bf16_t* A; const bf16_t* Bt; int M, N, K, lda, ldb; };

struct StaticOrder {
    int nM, nN, nwg, G, c; bool lat_only;
    __host__ __device__ void init(int M, int N, int G_, int c_, bool lat_only_ = false) { lat_only = lat_only_; nM = lat_only_ ? 32 : M / BM; nN = N / BM; nwg = nM * nN; G = G_; c = c_; }
    __host__ __device__ bool next(int i, Unit& u) const {
        const long L = (long)i * G + c; if (L >= nwg) return false;
        int wgid = (int)L; { const int q = nwg / NXCD, r = nwg % NXCD, xcd = wgid % NXCD, off = wgid / NXCD; wgid = (xcd < r ? xcd * (q + 1) : r * (q + 1) + (xcd - r) * q) + off; }
        const int nig = WGM * nN, gid = wgid / nig, fm = gid * WGM, gsz = (nM - fm) < WGM ? (nM - fm) : WGM;
        u.pm = fm + ((wgid % nig) % gsz); u.pn = (wgid % nig) / gsz; if (lat_only) u.pm += 1 + (u.pm >= 16 ? 1 : 0); return true;
    }
    __device__ __forceinline__ void a_ready(const Unit&) const {}
    __device__ __forceinline__ void done(const Unit&) const {}
};
__device__ __forceinline__ unsigned cvt_pk_bf16(float lo, float hi) { unsigned r; asm volatile("v_cvt_pk_bf16_f32 %0, %1, %2" : "=v"(r) : "v"(lo), "v"(hi)); return r; }
typedef float f32x2 __attribute__((ext_vector_type(2)));
struct EpiBf16 {
    static constexpr bool PERM = true, AFTER_DRAIN = false;
    bf16_t* O; int ldc;
    __device__ __forceinline__ void operator()(const f32x4 (&acc)[2][2][4][2], const Unit& u, int wr, int wc, int fr, int fq) const {
        const int row0 = u.pm * BM + wr * 64 + fr, col0 = u.pn * BM + wc * 32 + 8 * fq;
#pragma unroll
        for (int ai = 0; ai < 2; ++ai)
#pragma unroll
            for (int m = 0; m < 4; ++m) { bf16_t* rowp = O + (size_t)(row0 + ai * HALF + m * 16) * ldc + col0;
#pragma unroll
                for (int bj = 0; bj < 2; ++bj) { const f32x4 v0 = acc[ai][bj][m][0], v1 = acc[ai][bj][m][1];
                    u32x4 w; w.x = cvt_pk_bf16(v0[0], v0[1]); w.y = cvt_pk_bf16(v0[2], v0[3]); w.z = cvt_pk_bf16(v1[0], v1[1]); w.w = cvt_pk_bf16(v1[2], v1[3]);
                    *(u32x4*)(rowp + bj * HALF) = w; } }
    }
};
struct EpiResid {
    static constexpr bool PERM = false, AFTER_DRAIN = false;
    bf16_t* X; int ldc; const float* gate;
    __device__ __forceinline__ void operator()(const f32x4 (&acc)[2][2][4][2], const Unit& u, int wr, int wc, int fr, int fq) const {
        const int row0 = u.pm * BM + wr * 64 + fr, col0 = u.pn * BM + wc * 32 + 4 * fq;
        const int cls = (u.pm % 17 == 0) ? 2 : (u.pm / 17);
        const float* gp = gate + (size_t)cls * 12288 + col0;
        f32x4 gv[2][2];
#pragma unroll
        for (int bj = 0; bj < 2; ++bj)
#pragma unroll
            for (int n = 0; n < 2; ++n) gv[bj][n] = *(const f32x4*)(gp + bj * HALF + n * 16);
#pragma unroll
        for (int ai = 0; ai < 2; ++ai)
#pragma unroll
            for (int m = 0; m < 4; ++m) { bf16_t* rowp = X + (size_t)(row0 + ai * HALF + m * 16) * ldc + col0;
#pragma unroll
                for (int bj = 0; bj < 2; ++bj)
#pragma unroll
                    for (int n = 0; n < 2; ++n) { typedef unsigned u32x2_ __attribute__((ext_vector_type(2))); u32x2_* p = (u32x2_*)(rowp + bj * HALF + n * 16); const u32x2_ w_ = *p;
                        const f32x4 xo_ = {__builtin_bit_cast(float, w_.x << 16), __builtin_bit_cast(float, w_.x & 0xffff0000u), __builtin_bit_cast(float, w_.y << 16), __builtin_bit_cast(float, w_.y & 0xffff0000u)};
                        const f32x4 xn_ = xo_ + gv[bj][n] * acc[ai][bj][m][n]; u32x2_ o_; o_.x = cvt_pk_bf16(xn_[0], xn_[1]); o_.y = cvt_pk_bf16(xn_[2], xn_[3]); *p = o_; } }
    }
};
template <class Epi, class Sched, bool ALIGN_EPI = false, bool SP2 = false>
__device__ __forceinline__ void gemm_phase(PG8_LAS unsigned char* lds, const Gemm g, const Sched& S, const Epi& E, int tid_in) {
    int tid_ = tid_in; asm volatile("" : "+v"(tid_));
    const int tid = tid_, wid = __builtin_amdgcn_readfirstlane(tid >> 6), lane = tid & 63, wr = wid >> 2, wc = wid & 3, fr = lane & 15, fq = lane >> 4;
    const int K = g.K, nt = K / BK;
    unsigned voffA[2], voffB[2];
#pragma unroll
    for (int i = 0; i < 2; ++i) { int R, C; stage_rc(tid * 16 + i * 8192, R, C); const int Rb = Epi::PERM ? ((R & ~31) + perm32(R & 31)) : R;
        voffA[i] = (unsigned)(R * g.lda + C) * 2u; voffB[i] = (unsigned)(Rb * g.ldb + C) * 2u; }
    const size_t kstep = (size_t)(BK * 2);
    const size_t hstepA = (size_t)HALF * g.lda * 2, hstepB = (size_t)HALF * g.ldb * 2;
    const size_t tstepA = 2 * hstepA, tstepB = 2 * hstepB;
    const unsigned ldsw = (unsigned)wid * 1024u;
    const int aoff = lds_byte(wr * 64 + fr, fq * 8), boff = lds_byte(wc * 32 + fr, fq * 8);
#define PG8_SA(b, h) (((b) * 2 + (h)) * HTB)
#define PG8_SB(b, h) ((4 + (b) * 2 + (h)) * HTB)
#define PG8_STAGE(bufoff, gbase, voff) do { _Pragma("unroll") for (int _i = 0; _i < 2; ++_i) \
        __builtin_amdgcn_global_load_lds((const unsigned*)((const char*)(gbase) + (voff)[_i]), (PG8_LAS unsigned*)(lds + (bufoff) + ldsw + _i * 8192), 16, 0, 0); } while (0)
#define PG8_LDA(dst, b, h) do { _Pragma("unroll") for (int m = 0; m < 4; ++m) _Pragma("unroll") for (int k = 0; k < 2; ++k) dst[m][k] = *(const PG8_LAS bf16x8*)(lds + PG8_SA(b, h) + aoff + m * 2048 + k * 1024); } while (0)
#define PG8_LDB(dst, b, h) do { _Pragma("unroll") for (int n = 0; n < 2; ++n) _Pragma("unroll") for (int k = 0; k < 2; ++k) dst[n][k] = *(const PG8_LAS bf16x8*)(lds + PG8_SB(b, h) + boff + n * 2048 + k * 1024); } while (0)
#define PG8_MMA(ai, bj, At, Bt) do { __builtin_amdgcn_s_setprio(1); _Pragma("unroll") for (int m = 0; m < 4; ++m) _Pragma("unroll") for (int n = 0; n < 2; ++n) _Pragma("unroll") for (int k = 0; k < 2; ++k) \
        acc[ai][bj][m][n] = __builtin_amdgcn_mfma_f32_16x16x32_bf16(Bt[n][k], At[m][k], acc[ai][bj][m][n], 0, 0, 0); __builtin_amdgcn_s_setprio(0); } while (0)
#define PG8_WAIT_V(n) asm volatile("s_waitcnt vmcnt(" #n ")" ::: "memory")
#define PG8_WAIT_L(n) asm volatile("s_waitcnt lgkmcnt(" #n ")" ::: "memory")
#define PG8_BAR __builtin_amdgcn_s_barrier()
#define PG8_SCHED __builtin_amdgcn_sched_barrier(0)
    Unit cur, nxt; int ui = 0;
    if (!S.next(0, cur)) return;
    f32x4 acc[2][2][4][2];
#pragma unroll
    for (int a = 0; a < 2; ++a)
#pragma unroll
        for (int b = 0; b < 2; ++b)
#pragma unroll
            for (int m = 0; m < 4; ++m)
#pragma unroll
                for (int n = 0; n < 2; ++n) acc[a][b][m][n] = (f32x4){0.f, 0.f, 0.f, 0.f};
    bf16x8 At[4][2], B0[2][2], B1[2][2];
    const char* cA = (const char*)g.A + (size_t)cur.pm * tstepA; const char* cB = (const char*)g.Bt + (size_t)cur.pn * tstepB;
    S.a_ready(cur);
    if constexpr (SP2) {
        PG8_STAGE(PG8_SB(0, 0), cB, voffB); PG8_STAGE(PG8_SB(0, 1), cB + hstepB, voffB); PG8_STAGE(PG8_SA(0, 0), cA, voffA); PG8_STAGE(PG8_SA(0, 1), cA + hstepA, voffA);
        if (wr == 1) PG8_BAR;
        PG8_WAIT_V(2); PG8_BAR;
        PG8_STAGE(PG8_SB(1, 0), cB + kstep, voffB); PG8_STAGE(PG8_SA(1, 0), cA + kstep, voffA); PG8_STAGE(PG8_SB(1, 1), cB + hstepB + kstep, voffB);
        PG8_WAIT_V(6); PG8_BAR;
    } else {
        PG8_STAGE(PG8_SB(0, 0), cB, voffB); PG8_STAGE(PG8_SA(0, 0), cA, voffA); PG8_STAGE(PG8_SB(0, 1), cB + hstepB, voffB); PG8_STAGE(PG8_SA(0, 1), cA + hstepA, voffA);
        if (wr == 1) PG8_BAR;
        PG8_WAIT_V(4); PG8_BAR;
        PG8_STAGE(PG8_SB(1, 0), cB + kstep, voffB); PG8_STAGE(PG8_SA(1, 0), cA + kstep, voffA); PG8_STAGE(PG8_SB(1, 1), cB + hstepB + kstep, voffB);
        PG8_WAIT_V(6); PG8_BAR;
    }
    for (;;) {
        const bool has_next = S.next(ui + 1, nxt);
        const char* nA = has_next ? (const char*)g.A + (size_t)nxt.pm * tstepA : cA; const char* nB = has_next ? (const char*)g.Bt + (size_t)nxt.pn * tstepB : cB;
        for (int t = 0; t < nt; t += 2) {
            const bool last = (t == nt - 2);
            const char* a1 = cA + (size_t)(t + 1) * kstep;
            const char* a2 = last ? nA : cA + (size_t)(t + 2) * kstep; const char* b2 = last ? nB : cB + (size_t)(t + 2) * kstep;
            const char* a3 = a2 + kstep; const char* b3 = b2 + kstep;
            if (last && has_next) S.a_ready(nxt);
            if constexpr (SP2) {
            PG8_LDB(B0, 0, 0); PG8_LDB(B1, 0, 1); PG8_SCHED; PG8_LDA(At, 0, 0); PG8_STAGE(PG8_SA(1, 1), a1 + hstepA, voffA);
            PG8_WAIT_V(8); PG8_WAIT_L(0); PG8_BAR; PG8_MMA(0, 0, At, B0); PG8_MMA(0, 1, At, B1); PG8_BAR; PG8_SCHED;
            PG8_LDA(At, 0, 1); PG8_STAGE(PG8_SB(0, 0), b2, voffB); PG8_STAGE(PG8_SB(0, 1), b2 + hstepB, voffB); PG8_STAGE(PG8_SA(0, 0), a2, voffA);
            PG8_WAIT_V(8); PG8_WAIT_L(0); PG8_BAR; PG8_MMA(1, 0, At, B0); PG8_MMA(1, 1, At, B1); PG8_BAR; PG8_SCHED;
            PG8_LDB(B0, 1, 0); PG8_LDB(B1, 1, 1); PG8_SCHED; PG8_LDA(At, 1, 0); PG8_STAGE(PG8_SA(0, 1), a2 + hstepA, voffA);
            PG8_WAIT_V(8); PG8_WAIT_L(0); PG8_BAR; PG8_MMA(0, 0, At, B0); PG8_MMA(0, 1, At, B1); PG8_BAR; PG8_SCHED;
            PG8_LDA(At, 1, 1); PG8_STAGE(PG8_SB(1, 0), b3, voffB); PG8_STAGE(PG8_SB(1, 1), b3 + hstepB, voffB); PG8_STAGE(PG8_SA(1, 0), a3, voffA);
            PG8_WAIT_V(8); PG8_WAIT_L(0); PG8_BAR; PG8_MMA(1, 0, At, B0); PG8_MMA(1, 1, At, B1); PG8_BAR; PG8_SCHED;
            } else {
            PG8_LDB(B0, 0, 0); PG8_SCHED; PG8_LDA(At, 0, 0); PG8_STAGE(PG8_SA(1, 1), a1 + hstepA, voffA);
            PG8_WAIT_L(8); PG8_BAR; PG8_WAIT_L(0); PG8_MMA(0, 0, At, B0); PG8_BAR; PG8_SCHED;
            PG8_LDB(B1, 0, 1); PG8_STAGE(PG8_SB(0, 0), b2, voffB);
            PG8_BAR; PG8_WAIT_L(0); PG8_MMA(0, 1, At, B1); PG8_BAR;
            PG8_LDA(At, 0, 1); PG8_STAGE(PG8_SA(0, 0), a2, voffA);
            PG8_BAR; PG8_WAIT_L(0); PG8_MMA(1, 0, At, B0); PG8_BAR; PG8_SCHED;
            PG8_STAGE(PG8_SB(0, 1), b2 + hstepB, voffB);
            PG8_WAIT_V(6); PG8_BAR; PG8_MMA(1, 1, At, B1); PG8_BAR;
            PG8_LDB(B0, 1, 0); PG8_SCHED; PG8_LDA(At, 1, 0); PG8_STAGE(PG8_SA(0, 1), a2 + hstepA, voffA);
            PG8_WAIT_L(8); PG8_BAR; PG8_WAIT_L(0); PG8_MMA(0, 0, At, B0); PG8_BAR; PG8_SCHED;
            PG8_LDB(B1, 1, 1); PG8_STAGE(PG8_SB(1, 0), b3, voffB);
            PG8_BAR; PG8_WAIT_L(0); PG8_MMA(0, 1, At, B1); PG8_BAR;
            PG8_LDA(At, 1, 1); PG8_STAGE(PG8_SA(1, 0), a3, voffA);
            PG8_BAR; PG8_WAIT_L(0); PG8_MMA(1, 0, At, B0); PG8_BAR; PG8_SCHED;
            PG8_STAGE(PG8_SB(1, 1), b3 + hstepB, voffB);
            PG8_WAIT_V(6); PG8_BAR; PG8_MMA(1, 1, At, B1); PG8_BAR;
            }
        }
        if constexpr (ALIGN_EPI) { if (wr == 0) PG8_BAR; }
        if constexpr (!Epi::AFTER_DRAIN) { E(acc, cur, wr, wc, fr, fq); S.done(cur); }
        if (!has_next) break;
#pragma unroll
        for (int a = 0; a < 2; ++a)
#pragma unroll
            for (int b = 0; b < 2; ++b)
#pragma unroll
                for (int m = 0; m < 4; ++m)
#pragma unroll
                    for (int n = 0; n < 2; ++n) acc[a][b][m][n] = (f32x4){0.f, 0.f, 0.f, 0.f};
        cur = nxt; cA = nA; cB = nB; ++ui;
        if constexpr (ALIGN_EPI) { if (wr == 1) PG8_BAR; }
    }
    PG8_WAIT_V(0);
    if constexpr (!ALIGN_EPI) { if (wr == 0) PG8_BAR; }
    PG8_BAR;
    if constexpr (Epi::AFTER_DRAIN) { E.fused(acc, cur, wr, wc, fr, fq, lds, wid, lane); S.done(cur); }
#undef PG8_SA
#undef PG8_SB
#undef PG8_STAGE
#undef PG8_LDA
#undef PG8_LDB
#undef PG8_MMA
#undef PG8_WAIT_V
#undef PG8_WAIT_L
#undef PG8_BAR
#undef PG8_SCHED
}
}
namespace att {
typedef unsigned short bf16_t;
using bf16x8 = __attribute__((ext_vector_type(8))) short;
using s16x4  = __attribute__((ext_vector_type(4))) short;
using f32x16 = __attribute__((ext_vector_type(16))) float;
using u32x4  = __attribute__((ext_vector_type(4))) unsigned;
constexpr int DV = 128, NW = 8, QBLK = 32, KVBLK = 64;
constexpr float THR = 8.f;
constexpr int SHM_V = KVBLK * DV * 2;
template <int DQK> struct Cfg {
    static constexpr int SHM_K = KVBLK * DQK * 2, KROWB = DQK * 2, NCK = DQK / 64, C8 = DQK / 8, ND0 = DQK / 16;
    static constexpr float SCALE = (DQK == 128) ? 0.088388347648318440f : 0.072168783648703220f;
    static constexpr int LDS_BYTES = 2 * SHM_V + 2 * SHM_K + NW * 64 * 4;
};
#define ATT_SBAR() __builtin_amdgcn_sched_barrier(0)
__device__ __forceinline__ int crow(int r, int hi) { return (r & 3) + 8 * (r >> 2) + 4 * hi; }
__device__ __forceinline__ unsigned cvtpk(float lo, float hi) { unsigned r; asm volatile("v_cvt_pk_bf16_f32 %0, %1, %2" : "=v"(r) : "v"(lo), "v"(hi)); return r; }
template <int DQK> __device__ __forceinline__ int kswz(int row, int colB) {
    const int key = (DQK == 128) ? (row & 7) : ((row >> 1) & 7);
    return row * (DQK * 2) + (colB ^ (key << 4));
}
template <int DQK> __device__ __forceinline__ void partialSM(f32x16& p0, f32x16& p1, float& m_reg, float& mn, float& alpha) {
    constexpr float SCALE = Cfg<DQK>::SCALE, C = SCALE * 1.4426950408889634f;
    float pmax = p0[0];
#pragma unroll
    for (int r = 1; r < 16; ++r) pmax = fmaxf(pmax, p0[r]);
#pragma unroll
    for (int r = 0; r < 16; ++r) pmax = fmaxf(pmax, p1[r]);
    { auto rr = __builtin_amdgcn_permlane32_swap(__float_as_uint(pmax), __float_as_uint(pmax), false, false);
      pmax = fmaxf(__uint_as_float(rr[0]), __uint_as_float(rr[1])); }
    if (__builtin_expect(__all(pmax - m_reg <= THR / SCALE), 1)) { mn = m_reg; alpha = 1.f; }
    else { mn = fmaxf(m_reg, pmax); alpha = __builtin_amdgcn_exp2f((m_reg - mn) * C); m_reg = mn; }
    const float mnC = -mn * C;
#pragma unroll
    for (int r = 0; r < 16; ++r) p0[r] = fmaf(p0[r], C, mnC);
#pragma unroll
    for (int r = 0; r < 16; ++r) p1[r] = fmaf(p1[r], C, mnC);
#pragma unroll
    for (int r = 0; r < 16; ++r) p0[r] = __builtin_amdgcn_exp2f(p0[r]);
}
__device__ __forceinline__ void finishSM(f32x16& p0, f32x16& p1, float alpha, float& l_reg, bf16x8& pa0, bf16x8& pa1, bf16x8& pa2, bf16x8& pa3) {
#pragma unroll
    for (int r = 0; r < 16; ++r) p1[r] = __builtin_amdgcn_exp2f(p1[r]);
    float ps = 0;
#pragma unroll
    for (int r = 0; r < 16; ++r) ps += p0[r];
#pragma unroll
    for (int r = 0; r < 16; ++r) ps += p1[r];
    { auto rr = __builtin_amdgcn_permlane32_swap(__float_as_uint(ps), __float_as_uint(ps), false, false);
      ps = __uint_as_float(rr[0]) + __uint_as_float(rr[1]); }
    l_reg = l_reg * alpha + ps;
#define ATT_PK4(P, BASE, OUT) do { unsigned a0 = cvtpk(P[BASE + 0], P[BASE + 1]), a1 = cvtpk(P[BASE + 2], P[BASE + 3]);   \
    unsigned b0 = cvtpk(P[BASE + 4], P[BASE + 5]), b1 = cvtpk(P[BASE + 6], P[BASE + 7]);                              \
    auto r0 = __builtin_amdgcn_permlane32_swap(a0, b0, false, false); auto r1 = __builtin_amdgcn_permlane32_swap(a1, b1, false, false); \
    u32x4 w = {r0[0], r1[0], r0[1], r1[1]}; OUT = *reinterpret_cast<bf16x8*>(&w); } while (0)
    ATT_PK4(p0, 0, pa0); ATT_PK4(p0, 8, pa1); ATT_PK4(p1, 0, pa2); ATT_PK4(p1, 8, pa3);
#undef ATT_PK4
}
template <int DQK> __device__ __forceinline__ void qkt(f32x16& p0, f32x16& p1, const char* Ks, const bf16x8* qr, int r32, int hi) {
    p0 = f32x16{}; p1 = f32x16{};
#pragma unroll
    for (int d0 = 0; d0 < Cfg<DQK>::ND0; ++d0) { const int cb = (d0 * 16 + hi * 8) * 2;
        bf16x8 b0 = *reinterpret_cast<const bf16x8*>(Ks + kswz<DQK>(r32, cb));
        bf16x8 b1 = *reinterpret_cast<const bf16x8*>(Ks + kswz<DQK>(32 + r32, cb));
        p0 = __builtin_amdgcn_mfma_f32_32x32x16_bf16(b0, qr[d0], p0, 0, 0, 0);
        p1 = __builtin_amdgcn_mfma_f32_32x32x16_bf16(b1, qr[d0], p1, 0, 0, 0); }
}
__device__ __forceinline__ int v_st(int k, int c) { const int kk = (k & ~0xC) | ((k & 4) << 1) | ((k & 8) >> 1); return ((kk >> 3) * 4 + (c >> 5)) * 512 + ((kk & 7) * 32 + (c & 31)) * 2; }
__device__ __forceinline__ int v_rd_base(int lane) { return ((lane & 3) << 3) | (((lane >> 2) & 3) << 6) | (((lane >> 4) & 1) << 5) | (((lane >> 5) & 1) << 8); }
constexpr int v_rd_off(int d0, int ks, int half) { return d0 * 512 + ks * 4096 + half * 2048; }
template <int OFF> __device__ __forceinline__ s16x4 tr_read(int vb) {
    s16x4 r; asm volatile("ds_read_b64_tr_b16 %0, %1 offset:%2" : "=&v"(r) : "v"(vb), "i"(OFF) : "memory"); return r;
}
template <int D0> __device__ __forceinline__ void pv_one(f32x16& od, int vb, bf16x8 pa0, bf16x8 pa1, bf16x8 pa2, bf16x8 pa3) {
    const s16x4 l0 = tr_read<v_rd_off(D0, 0, 0)>(vb), h0 = tr_read<v_rd_off(D0, 0, 1)>(vb), l1 = tr_read<v_rd_off(D0, 1, 0)>(vb), h1 = tr_read<v_rd_off(D0, 1, 1)>(vb);
    const s16x4 l2 = tr_read<v_rd_off(D0, 2, 0)>(vb), h2 = tr_read<v_rd_off(D0, 2, 1)>(vb), l3 = tr_read<v_rd_off(D0, 3, 0)>(vb), h3 = tr_read<v_rd_off(D0, 3, 1)>(vb);
    asm volatile("s_waitcnt lgkmcnt(0)" ::: "memory"); ATT_SBAR();
#define ATT_PK(L, H) (bf16x8){L[0], L[1], L[2], L[3], H[0], H[1], H[2], H[3]}
    od = __builtin_amdgcn_mfma_f32_32x32x16_bf16(pa0, ATT_PK(l0, h0), od, 0, 0, 0);
    od = __builtin_amdgcn_mfma_f32_32x32x16_bf16(pa1, ATT_PK(l1, h1), od, 0, 0, 0);
    od = __builtin_amdgcn_mfma_f32_32x32x16_bf16(pa2, ATT_PK(l2, h2), od, 0, 0, 0);
    od = __builtin_amdgcn_mfma_f32_32x32x16_bf16(pa3, ATT_PK(l3, h3), od, 0, 0, 0);
#undef ATT_PK
}
__device__ __forceinline__ void pv_d0(f32x16* o, int vb, bf16x8 pa0, bf16x8 pa1, bf16x8 pa2, bf16x8 pa3) {
    pv_one<0>(o[0], vb, pa0, pa1, pa2, pa3); pv_one<1>(o[1], vb, pa0, pa1, pa2, pa3); pv_one<2>(o[2], vb, pa0, pa1, pa2, pa3); pv_one<3>(o[3], vb, pa0, pa1, pa2, pa3);
}
template <int DQK, int LDQ, int LDK, int LDV, int LDO, int SDEPTH>
__device__ __forceinline__ void attn_body(const bf16_t* __restrict__ Qb, const bf16_t* __restrict__ Kh, const bf16_t* __restrict__ Vh, bf16_t* __restrict__ Ob, int seq, char* lds, int tid_in) {
    using C_ = Cfg<DQK>;
    constexpr int SHM_K = C_::SHM_K, NCK = C_::NCK, C8 = C_::C8, ND0 = C_::ND0;
    int tid_ = tid_in; asm volatile("" : "+v"(tid_));
    const int tid = tid_, wid = tid >> 6, lane = tid & 63, r32 = lane & 31, hi = lane >> 5;
    char* V_lds = lds; char* K_lds = lds + 2 * SHM_V;
    float* ws = (float*)(lds + 2 * SHM_V + 2 * SHM_K) + wid * 64; float* li_l = ws; float* al_l = ws + 32;
    float m_reg = -1e30f, l_reg = 0; f32x16 o[4] = {}; bf16x8 qr[ND0];
    const bf16_t* Qw = Qb + (long)(wid * QBLK + r32) * LDQ + hi * 8;
#pragma unroll
    for (int d0 = 0; d0 < ND0; ++d0) qr[d0] = *reinterpret_cast<const bf16x8*>(Qw + d0 * 16);
    const int sr = tid >> 4, sc = (tid & 15) * 8, vst0 = v_st(sr, sc), vst1 = v_st(32 + sr, sc);
    int krow[NCK], kcol[NCK];
#pragma unroll
    for (int i = 0; i < NCK; ++i) { const int ci = tid + 512 * i; krow[i] = ci / C8; kcol[i] = (ci % C8) * 8; }
    const int vb0 = (int)(uintptr_t)V_lds + v_rd_base(lane);
    struct { bf16x8 vs0, vs1, ks[NCK]; } sr_[SDEPTH];
#define ATT_SLOAD(i, k0) do { sr_[i].vs0 = *reinterpret_cast<const bf16x8*>(&Vh[(long)((k0) + sr) * LDV + sc]); sr_[i].vs1 = *reinterpret_cast<const bf16x8*>(&Vh[(long)((k0) + 32 + sr) * LDV + sc]); \
    _Pragma("unroll") for (int c_ = 0; c_ < NCK; ++c_) sr_[i].ks[c_] = *reinterpret_cast<const bf16x8*>(&Kh[(long)((k0) + krow[c_]) * LDK + kcol[c_]]); } while (0)
#define ATT_SWRITE(b, i) do { *(bf16x8*)(V_lds + (b) * SHM_V + vst0) = sr_[i].vs0; *(bf16x8*)(V_lds + (b) * SHM_V + vst1) = sr_[i].vs1; \
    _Pragma("unroll") for (int c_ = 0; c_ < NCK; ++c_) *(bf16x8*)(K_lds + (b) * SHM_K + kswz<DQK>(krow[c_], kcol[c_] * 2)) = sr_[i].ks[c_]; } while (0)
#define ATT_SWAIT() do { if constexpr (SDEPTH == 2) { if constexpr (NCK == 2) asm volatile("s_waitcnt vmcnt(4)" ::: "memory"); else asm volatile("s_waitcnt vmcnt(5)" ::: "memory"); } else asm volatile("s_waitcnt vmcnt(0)" ::: "memory"); } while (0)
#define ATT_RESC(a) do { if (__any((a) < 1.f)) { if (hi == 0) al_l[r32] = (a); asm volatile("s_waitcnt lgkmcnt(0)" ::: "memory"); \
    _Pragma("unroll") for (int d = 0; d < 4; ++d) _Pragma("unroll") for (int r = 0; r < 16; ++r) o[d][r] *= al_l[crow(r, hi)]; } } while (0)
    f32x16 pA0, pA1, pB0, pB1; float mnA, mnB, alA, alB; bf16x8 pa0, pa1, pa2, pa3; const int NT = seq / KVBLK;
    constexpr int SE = 0, SO = SDEPTH - 1;
    ATT_SLOAD(SE, 0); asm volatile("s_waitcnt vmcnt(0)" ::: "memory"); ATT_SWRITE(0, SE); __syncthreads();
    qkt<DQK>(pA0, pA1, K_lds, qr, r32, hi); partialSM<DQK>(pA0, pA1, m_reg, mnA, alA);
    ATT_SLOAD(SO, KVBLK); if constexpr (SDEPTH == 2) { if (2 < NT) ATT_SLOAD(SE, 2 * KVBLK); }
    ATT_SWAIT(); ATT_SWRITE(1, SO); __syncthreads();
    for (int j = 1; j + 1 < NT; j += 2) {
        ATT_SBAR(); qkt<DQK>(pB0, pB1, K_lds + SHM_K, qr, r32, hi);
        finishSM(pA0, pA1, alA, l_reg, pa0, pa1, pa2, pa3); ATT_SBAR();
        ATT_SLOAD(SO, (j + SDEPTH) * KVBLK); ATT_SBAR();
        pv_d0(o, vb0, pa0, pa1, pa2, pa3); partialSM<DQK>(pB0, pB1, m_reg, mnB, alB);
        __syncthreads(); ATT_SWAIT(); ATT_SWRITE(0, SE);
        ATT_RESC(alB); __syncthreads();
        ATT_SBAR(); qkt<DQK>(pA0, pA1, K_lds, qr, r32, hi);
        finishSM(pB0, pB1, alB, l_reg, pa0, pa1, pa2, pa3); ATT_SBAR();
        if (SDEPTH == 1 || j + 3 < NT) ATT_SLOAD(SE, (j + 1 + SDEPTH) * KVBLK); ATT_SBAR();
        pv_d0(o, vb0 + (int)SHM_V, pa0, pa1, pa2, pa3); partialSM<DQK>(pA0, pA1, m_reg, mnA, alA);
        __syncthreads(); ATT_SWAIT(); ATT_SWRITE(1, SO);
        ATT_RESC(alA); __syncthreads();
    }
    ATT_SBAR(); qkt<DQK>(pB0, pB1, K_lds + SHM_K, qr, r32, hi);
    finishSM(pA0, pA1, alA, l_reg, pa0, pa1, pa2, pa3); ATT_SBAR();
    pv_d0(o, vb0, pa0, pa1, pa2, pa3); partialSM<DQK>(pB0, pB1, m_reg, mnB, alB);
    __syncthreads(); ATT_RESC(alB);
    finishSM(pB0, pB1, alB, l_reg, pa0, pa1, pa2, pa3); ATT_SBAR();
    pv_d0(o, vb0 + (int)SHM_V, pa0, pa1, pa2, pa3);
    if (hi == 0) li_l[r32] = l_reg;
    asm volatile("s_waitcnt lgkmcnt(0)" ::: "memory");
    __syncthreads();
    float rli[16];
#pragma unroll
    for (int r = 0; r < 16; ++r) rli[r] = __builtin_amdgcn_rcpf(li_l[crow(r, hi)]);
    unsigned short* stg = (unsigned short*)(lds + wid * 8192);
#pragma unroll
    for (int r = 0; r < 16; ++r) { const int orow = crow(r, hi);
#pragma unroll
        for (int d0 = 0; d0 < 4; ++d0) { const unsigned w = cvtpk(o[d0][r] * rli[r], 0.f); stg[orow * 128 + d0 * 32 + r32] = (unsigned short)(w & 0xffffu); } }
    asm volatile("s_waitcnt lgkmcnt(0)" ::: "memory");
    bf16_t* Ow = Ob + (long)(wid * QBLK) * LDO;
#pragma unroll
    for (int i = 0; i < 8; ++i) { const int id = lane + 64 * i, row = id >> 4, c16 = id & 15;
        const u32x4 v = *(const u32x4*)((const char*)stg + row * 256 + c16 * 16);
        *(u32x4*)(Ow + (long)row * LDO + c16 * 8) = v; }
    asm volatile("s_waitcnt lgkmcnt(0)" ::: "memory");
    __syncthreads();
#undef ATT_SLOAD
#undef ATT_SWRITE
#undef ATT_SWAIT
#undef ATT_RESC
}

template <int DQK, int LDQ, int LDK, int LDV, int LDO>
__device__ __forceinline__ void attn_body1(const bf16_t* __restrict__ Qb, const bf16_t* __restrict__ Kh, const bf16_t* __restrict__ Vh, bf16_t* __restrict__ Ob, int seq, char* lds, int tid_in) {
    using C_ = Cfg<DQK>;
    constexpr int SHM_K = C_::SHM_K, NCK = C_::NCK, C8 = C_::C8, ND0 = C_::ND0;
    int tid_ = tid_in; asm volatile("" : "+v"(tid_));
    const int tid = tid_, wid = tid >> 6, lane = tid & 63, r32 = lane & 31, hi = lane >> 5;
    char* V_lds = lds; char* K_lds = lds + 2 * SHM_V;
    float* ws = (float*)(lds + 2 * SHM_V + 2 * SHM_K) + wid * 64; float* li_l = ws; float* al_l = ws + 32;
    float m_reg = -1e30f, l_reg = 0; f32x16 o[4] = {}; bf16x8 qr[ND0];
    const bf16_t* Qw = Qb + (long)(wid * QBLK + r32) * LDQ + hi * 8;
#pragma unroll
    for (int d0 = 0; d0 < ND0; ++d0) qr[d0] = *reinterpret_cast<const bf16x8*>(Qw + d0 * 16);
    const int sr = tid >> 4, sc = (tid & 15) * 8, vst0 = v_st(sr, sc), vst1 = v_st(32 + sr, sc);
    int krow[NCK], kcol[NCK];
#pragma unroll
    for (int i = 0; i < NCK; ++i) { const int ci = tid + 512 * i; krow[i] = ci / C8; kcol[i] = (ci % C8) * 8; }
    const int vb0 = (int)(uintptr_t)V_lds + v_rd_base(lane);
    bf16x8 vs0, vs1, ks[NCK];
#define ATT1_SLOAD(k0) do { vs0 = *reinterpret_cast<const bf16x8*>(&Vh[(long)((k0) + sr) * LDV + sc]); vs1 = *reinterpret_cast<const bf16x8*>(&Vh[(long)((k0) + 32 + sr) * LDV + sc]); \
    _Pragma("unroll") for (int c_ = 0; c_ < NCK; ++c_) ks[c_] = *reinterpret_cast<const bf16x8*>(&Kh[(long)((k0) + krow[c_]) * LDK + kcol[c_]]); } while (0)
#define ATT1_SWRITE(b) do { *(bf16x8*)(V_lds + (b) * SHM_V + vst0) = vs0; *(bf16x8*)(V_lds + (b) * SHM_V + vst1) = vs1; \
    _Pragma("unroll") for (int c_ = 0; c_ < NCK; ++c_) *(bf16x8*)(K_lds + (b) * SHM_K + kswz<DQK>(krow[c_], kcol[c_] * 2)) = ks[c_]; } while (0)
    const int NT = seq / KVBLK;
    ATT1_SLOAD(0); asm volatile("s_waitcnt vmcnt(0)" ::: "memory"); ATT1_SWRITE(0); __syncthreads();
    for (int j = 0; j < NT; ++j) {
        const int b = j & 1;
        if (j + 1 < NT) ATT1_SLOAD((j + 1) * KVBLK);
        ATT_SBAR();
        f32x16 p0, p1; float mn, alpha; bf16x8 pa0, pa1, pa2, pa3;
        qkt<DQK>(p0, p1, K_lds + b * SHM_K, qr, r32, hi);
        partialSM<DQK>(p0, p1, m_reg, mn, alpha);
        if (__any(alpha < 1.f)) { if (hi == 0) al_l[r32] = alpha; asm volatile("s_waitcnt lgkmcnt(0)" ::: "memory");
#pragma unroll
            for (int d = 0; d < 4; ++d)
#pragma unroll
                for (int r = 0; r < 16; ++r) o[d][r] *= al_l[crow(r, hi)]; }
        finishSM(p0, p1, alpha, l_reg, pa0, pa1, pa2, pa3); ATT_SBAR();
        pv_d0(o, vb0 + b * (int)SHM_V, pa0, pa1, pa2, pa3);
        if (j + 1 < NT) { ATT1_SWRITE(b ^ 1); }
        __syncthreads();
    }
    if (hi == 0) li_l[r32] = l_reg;
    asm volatile("s_waitcnt lgkmcnt(0)" ::: "memory");
    __syncthreads();
    float rli[16];
#pragma unroll
    for (int r = 0; r < 16; ++r) rli[r] = __builtin_amdgcn_rcpf(li_l[crow(r, hi)]);
    unsigned short* stg = (unsigned short*)(lds + wid * 8192);
#pragma unroll
    for (int r = 0; r < 16; ++r) { const int orow = crow(r, hi);
#pragma unroll
        for (int d0 = 0; d0 < 4; ++d0) { const unsigned w = cvtpk(o[d0][r] * rli[r], 0.f); stg[orow * 128 + d0 * 32 + r32] = (unsigned short)(w & 0xffffu); } }
    asm volatile("s_waitcnt lgkmcnt(0)" ::: "memory");
    bf16_t* Ow = Ob + (long)(wid * QBLK) * LDO;
#pragma unroll
    for (int i = 0; i < 8; ++i) { const int id = lane + 64 * i, row = id >> 4, c16 = id & 15;
        const u32x4 v = *(const u32x4*)((const char*)stg + row * 256 + c16 * 16);
        *(u32x4*)(Ow + (long)row * LDO + c16 * 8) = v; }
    asm volatile("s_waitcnt lgkmcnt(0)" ::: "memory");
    __syncthreads();
#undef ATT1_SLOAD
#undef ATT1_SWRITE
}
template <int DQK, int LDQ, int LDK, int LDV, int LDO>
__device__ __forceinline__ void attn_body1g(const bf16_t* __restrict__ Qb, const bf16_t* __restrict__ Kh, const bf16_t* __restrict__ Vh, bf16_t* __restrict__ Ob, int seq, char* lds, int tid_in) {
    using C_ = Cfg<DQK>;
    constexpr int SHM_K = C_::SHM_K, NCK = C_::NCK, ND0 = C_::ND0, KROWB = C_::KROWB;
    typedef __attribute__((address_space(3))) unsigned l3u;
    int tid_ = tid_in; asm volatile("" : "+v"(tid_));
    const int tid = tid_, wid = tid >> 6, lane = tid & 63, r32 = lane & 31, hi = lane >> 5;
    const int widu = __builtin_amdgcn_readfirstlane(wid);
    char* V_lds = lds; char* K_lds = lds + 3 * SHM_V;
    __attribute__((address_space(3))) char* l3 = (__attribute__((address_space(3))) char*)lds;
    float* ws = (float*)(lds + 3 * SHM_V + 3 * SHM_K) + wid * 64; float* li_l = ws; float* al_l = ws + 32;
    float m_reg = -1e30f, l_reg = 0; f32x16 o[4] = {}; bf16x8 qr[ND0];
    const bf16_t* Qw = Qb + (long)(wid * QBLK + r32) * LDQ + hi * 8;
#pragma unroll
    for (int d0 = 0; d0 < ND0; ++d0) qr[d0] = *reinterpret_cast<const bf16x8*>(Qw + d0 * 16);
    int koff[NCK], voff[2];
#pragma unroll
    for (int i = 0; i < NCK; ++i) { const int ob = (wid + 8 * i) * 1024 + 16 * lane, row = ob / KROWB, pos = (ob - row * KROWB) >> 4;
        const int key = (DQK == 128) ? (row & 7) : ((row >> 1) & 7); koff[i] = row * LDK + ((pos ^ key) << 3); }
#pragma unroll
    for (int i = 0; i < 2; ++i) { const int ob = (wid + 8 * i) * 1024 + 16 * lane, st = ob >> 9, r = ob & 511, kk = (st >> 2) * 8 + (r >> 6), c = (st & 3) * 32 + ((r & 63) >> 1);
        const int k = (kk & ~0xC) | ((kk & 4) << 1) | ((kk & 8) >> 1); voff[i] = k * LDV + c; }
    const int vb0 = (int)(uintptr_t)V_lds + v_rd_base(lane);
    const int NT = seq / KVBLK;
#define ATT1G_ISSUE(jt, b) do { const int jc_ = (jt) < NT ? (jt) : NT - 1; const bf16_t* kp_ = Kh + (long)jc_ * KVBLK * LDK; const bf16_t* vp_ = Vh + (long)jc_ * KVBLK * LDV; \
    _Pragma("unroll") for (int i_ = 0; i_ < NCK; ++i_) __builtin_amdgcn_global_load_lds((const unsigned*)(kp_ + koff[i_]), (l3u*)(l3 + 3 * SHM_V + (b) * SHM_K + (widu + 8 * i_) * 1024), 16, 0, 0); \
    _Pragma("unroll") for (int i_ = 0; i_ < 2; ++i_) __builtin_amdgcn_global_load_lds((const unsigned*)(vp_ + voff[i_]), (l3u*)(l3 + (b) * SHM_V + (widu + 8 * i_) * 1024), 16, 0, 0); } while (0)
    ATT1G_ISSUE(0, 0); ATT1G_ISSUE(1, 1);
    asm volatile("s_waitcnt vmcnt(%0)" :: "n"(NCK + 2) : "memory");
    __builtin_amdgcn_s_barrier(); ATT_SBAR();
    int b = 0, b2 = 2;
    for (int j = 0; j < NT; ++j) {
        ATT1G_ISSUE(j + 2, b2);
        ATT_SBAR();
        f32x16 p0, p1; float mn, alpha; bf16x8 pa0, pa1, pa2, pa3;
        qkt<DQK>(p0, p1, K_lds + b * SHM_K, qr, r32, hi);
        partialSM<DQK>(p0, p1, m_reg, mn, alpha);
        if (__any(alpha < 1.f)) { if (hi == 0) al_l[r32] = alpha; asm volatile("s_waitcnt lgkmcnt(0)" ::: "memory");
#pragma unroll
            for (int d = 0; d < 4; ++d)
#pragma unroll
                for (int r = 0; r < 16; ++r) o[d][r] *= al_l[crow(r, hi)]; }
        finishSM(p0, p1, alpha, l_reg, pa0, pa1, pa2, pa3); ATT_SBAR();
        pv_d0(o, vb0 + b * (int)SHM_V, pa0, pa1, pa2, pa3);
        asm volatile("s_waitcnt vmcnt(%0) lgkmcnt(0)" :: "n"(NCK + 2) : "memory");
        __builtin_amdgcn_s_barrier(); ATT_SBAR();
        b = (b == 2) ? 0 : b + 1; b2 = (b2 == 2) ? 0 : b2 + 1;
    }
    asm volatile("s_waitcnt vmcnt(0)" ::: "memory");
    if (hi == 0) li_l[r32] = l_reg;
    asm volatile("s_waitcnt lgkmcnt(0)" ::: "memory");
    __syncthreads();
    float rli[16];
#pragma unroll
    for (int r = 0; r < 16; ++r) rli[r] = __builtin_amdgcn_rcpf(li_l[crow(r, hi)]);
    unsigned short* stg = (unsigned short*)(lds + wid * 8192);
#pragma unroll
    for (int r = 0; r < 16; ++r) { const int orow = crow(r, hi);
#pragma unroll
        for (int d0 = 0; d0 < 4; ++d0) { const unsigned w = cvtpk(o[d0][r] * rli[r], 0.f); stg[orow * 128 + d0 * 32 + r32] = (unsigned short)(w & 0xffffu); } }
    asm volatile("s_waitcnt lgkmcnt(0)" ::: "memory");
    bf16_t* Ow = Ob + (long)(wid * QBLK) * LDO;
#pragma unroll
    for (int i = 0; i < 8; ++i) { const int id = lane + 64 * i, row = id >> 4, c16 = id & 15;
        const u32x4 v = *(const u32x4*)((const char*)stg + row * 256 + c16 * 16);
        *(u32x4*)(Ow + (long)row * LDO + c16 * 8) = v; }
    asm volatile("s_waitcnt lgkmcnt(0)" ::: "memory");
    __syncthreads();
#undef ATT1G_ISSUE
}
template <int DQK, int LDQ, int LDK, int LDV, int LDO>
__device__ __forceinline__ void attn_body2g(const bf16_t* __restrict__ Qb, const bf16_t* __restrict__ Kh, const bf16_t* __restrict__ Vh, bf16_t* __restrict__ Ob, int seq, char* lds, int tid_in) {
    using C_ = Cfg<DQK>;
    constexpr int SHM_K = C_::SHM_K, NCK = C_::NCK, ND0 = C_::ND0, KROWB = C_::KROWB;
    typedef __attribute__((address_space(3))) unsigned l3u;
    int tid_ = tid_in; asm volatile("" : "+v"(tid_));
    const int tid = tid_, wid = tid >> 6, lane = tid & 63, r32 = lane & 31, hi = lane >> 5;
    const int widu = __builtin_amdgcn_readfirstlane(wid);
    char* V_lds = lds; char* K_lds = lds + 3 * SHM_V;
    __attribute__((address_space(3))) char* l3 = (__attribute__((address_space(3))) char*)lds;
    float* ws = (float*)(lds + 3 * SHM_V + 3 * SHM_K) + wid * 64; float* li_l = ws; float* al_l = ws + 32;
    float m_reg = -1e30f, l_reg = 0; f32x16 o[4] = {}; bf16x8 qr[ND0];
    const bf16_t* Qw = Qb + (long)(wid * QBLK + r32) * LDQ + hi * 8;
#pragma unroll
    for (int d0 = 0; d0 < ND0; ++d0) qr[d0] = *reinterpret_cast<const bf16x8*>(Qw + d0 * 16);
    int koff[NCK], voff[2];
#pragma unroll
    for (int i = 0; i < NCK; ++i) { const int ob = (wid + 8 * i) * 1024 + 16 * lane, row = ob / KROWB, pos = (ob - row * KROWB) >> 4;
        const int key = (DQK == 128) ? (row & 7) : ((row >> 1) & 7); koff[i] = row * LDK + ((pos ^ key) << 3); }
#pragma unroll
    for (int i = 0; i < 2; ++i) { const int ob = (wid + 8 * i) * 1024 + 16 * lane, st = ob >> 9, r = ob & 511, kk = (st >> 2) * 8 + (r >> 6), c = (st & 3) * 32 + ((r & 63) >> 1);
        const int k = (kk & ~0xC) | ((kk & 4) << 1) | ((kk & 8) >> 1); voff[i] = k * LDV + c; }
    const int vb0 = (int)(uintptr_t)V_lds + v_rd_base(lane);
    const int NT = seq / KVBLK;
#define ATT2G_K(jt, b) do { const int jc_ = (jt) < NT ? (jt) : NT - 1; const bf16_t* kp_ = Kh + (long)jc_ * KVBLK * LDK; \
    _Pragma("unroll") for (int i_ = 0; i_ < NCK; ++i_) __builtin_amdgcn_global_load_lds((const unsigned*)(kp_ + koff[i_]), (l3u*)(l3 + 3 * SHM_V + (b) * SHM_K + (widu + 8 * i_) * 1024), 16, 0, 0); } while (0)
#define ATT2G_V(jt, b) do { const int jc_ = (jt) < NT ? (jt) : NT - 1; const bf16_t* vp_ = Vh + (long)jc_ * KVBLK * LDV; \
    _Pragma("unroll") for (int i_ = 0; i_ < 2; ++i_) __builtin_amdgcn_global_load_lds((const unsigned*)(vp_ + voff[i_]), (l3u*)(l3 + (b) * SHM_V + (widu + 8 * i_) * 1024), 16, 0, 0); } while (0)
#define ATT2G_RESC(a) do { if (__any((a) < 1.f)) { if (hi == 0) al_l[r32] = (a); asm volatile("s_waitcnt lgkmcnt(0)" ::: "memory"); \
    _Pragma("unroll") for (int d = 0; d < 4; ++d) _Pragma("unroll") for (int r = 0; r < 16; ++r) o[d][r] *= al_l[crow(r, hi)]; } } while (0)
#define ATT2G_SYNC() do { asm volatile("s_waitcnt vmcnt(%0) lgkmcnt(0)" :: "n"(NCK + 2) : "memory"); __builtin_amdgcn_s_barrier(); ATT_SBAR(); } while (0)
#define ATT2G_STEP(PC0, PC1, PP0, PP1, ALP, ALC, MNC) do { \
        ATT2G_K(j + 2, k2); ATT2G_V(j + 1, v1); ATT_SBAR(); \
        qkt<DQK>(PC0, PC1, K_lds + kc * SHM_K, qr, r32, hi); \
        finishSM(PP0, PP1, ALP, l_reg, pa0, pa1, pa2, pa3); ATT_SBAR(); \
        pv_d0(o, vb0 + vp * (int)SHM_V, pa0, pa1, pa2, pa3); partialSM<DQK>(PC0, PC1, m_reg, MNC, ALC); \
        ATT2G_SYNC(); ATT2G_RESC(ALC); \
        kc = (kc == 2) ? 0 : kc + 1; k2 = (k2 == 2) ? 0 : k2 + 1; vp = (vp == 2) ? 0 : vp + 1; v1 = (v1 == 2) ? 0 : v1 + 1; ++j; } while (0)
    f32x16 pA0, pA1, pB0, pB1; float mnA, mnB, alA, alB; bf16x8 pa0, pa1, pa2, pa3;
    ATT2G_K(0, 0); ATT2G_V(0, 0); ATT2G_K(1, 1);
    ATT2G_K(2, 2); ATT2G_V(1, 1);
    ATT2G_SYNC();
    qkt<DQK>(pA0, pA1, K_lds, qr, r32, hi); partialSM<DQK>(pA0, pA1, m_reg, mnA, alA);
    asm volatile("s_waitcnt lgkmcnt(0)" ::: "memory"); __builtin_amdgcn_s_barrier(); ATT_SBAR();
    int j = 1, kc = 1, k2 = 0, vp = 0, v1 = 2;
    while (j + 1 < NT) {
        ATT2G_STEP(pB0, pB1, pA0, pA1, alA, alB, mnB);
        ATT2G_STEP(pA0, pA1, pB0, pB1, alB, alA, mnA);
    }
    ATT2G_STEP(pB0, pB1, pA0, pA1, alA, alB, mnB);
    finishSM(pB0, pB1, alB, l_reg, pa0, pa1, pa2, pa3); ATT_SBAR();
    pv_d0(o, vb0 + vp * (int)SHM_V, pa0, pa1, pa2, pa3);
    asm volatile("s_waitcnt vmcnt(0)" ::: "memory");
    if (hi == 0) li_l[r32] = l_reg;
    asm volatile("s_waitcnt lgkmcnt(0)" ::: "memory");
    __syncthreads();
    float rli[16];
#pragma unroll
    for (int r = 0; r < 16; ++r) rli[r] = __builtin_amdgcn_rcpf(li_l[crow(r, hi)]);
    unsigned short* stg = (unsigned short*)(lds + wid * 8192);
#pragma unroll
    for (int r = 0; r < 16; ++r) { const int orow = crow(r, hi);
#pragma unroll
        for (int d0 = 0; d0 < 4; ++d0) { const unsigned w = cvtpk(o[d0][r] * rli[r], 0.f); stg[orow * 128 + d0 * 32 + r32] = (unsigned short)(w & 0xffffu); } }
    asm volatile("s_waitcnt lgkmcnt(0)" ::: "memory");
    bf16_t* Ow = Ob + (long)(wid * QBLK) * LDO;
#pragma unroll
    for (int i = 0; i < 8; ++i) { const int id = lane + 64 * i, row = id >> 4, c16 = id & 15;
        const u32x4 v = *(const u32x4*)((const char*)stg + row * 256 + c16 * 16);
        *(u32x4*)(Ow + (long)row * LDO + c16 * 8) = v; }
    asm volatile("s_waitcnt lgkmcnt(0)" ::: "memory");
    __syncthreads();
#undef ATT2G_STEP
#undef ATT2G_SYNC
#undef ATT2G_RESC
#undef ATT2G_V
#undef ATT2G_K
}
template <int DQK, int LDQ, int LDK, int LDV, int LDO>
__device__ __forceinline__ void attn_body1s(const bf16_t* __restrict__ Qb, const bf16_t* __restrict__ Kh, const bf16_t* __restrict__ Vh, bf16_t* __restrict__ Ob, int seq, char* lds, int tid_in) {
    using C_ = Cfg<DQK>;
    constexpr int SHM_K = C_::SHM_K, NCK = C_::NCK, C8 = C_::C8, ND0 = C_::ND0;
    int tid_ = tid_in; asm volatile("" : "+v"(tid_));
    const bool grpB = __builtin_amdgcn_readfirstlane(tid_ >> 16) != 0;
    const int tid = tid_ & 0xffff, wid = tid >> 6, lane = tid & 63, r32 = lane & 31, hi = lane >> 5;
    char* V_lds = lds; char* K_lds = lds + 2 * SHM_V;
    float* ws = (float*)(lds + 2 * SHM_V + 2 * SHM_K) + wid * 64; float* li_l = ws; float* al_l = ws + 32;
    float m_reg = -1e30f, l_reg = 0; f32x16 o[4] = {}; bf16x8 qr[ND0];
    const bf16_t* Qw = Qb + (long)(wid * QBLK + r32) * LDQ + hi * 8;
#pragma unroll
    for (int d0 = 0; d0 < ND0; ++d0) qr[d0] = *reinterpret_cast<const bf16x8*>(Qw + d0 * 16);
    const int sr = tid >> 4, sc = (tid & 15) * 8, vst0 = v_st(sr, sc), vst1 = v_st(32 + sr, sc);
    int krow[NCK], kcol[NCK];
#pragma unroll
    for (int i = 0; i < NCK; ++i) { const int ci = tid + 512 * i; krow[i] = ci / C8; kcol[i] = (ci % C8) * 8; }
    const int vb0 = (int)(uintptr_t)V_lds + v_rd_base(lane);
    bf16x8 vs0, vs1, ks[NCK];
#define ATT1_SLOAD(k0) do { vs0 = *reinterpret_cast<const bf16x8*>(&Vh[(long)((k0) + sr) * LDV + sc]); vs1 = *reinterpret_cast<const bf16x8*>(&Vh[(long)((k0) + 32 + sr) * LDV + sc]); \
    _Pragma("unroll") for (int c_ = 0; c_ < NCK; ++c_) ks[c_] = *reinterpret_cast<const bf16x8*>(&Kh[(long)((k0) + krow[c_]) * LDK + kcol[c_]]); } while (0)
#define ATT1_SWRITE(b) do { *(bf16x8*)(V_lds + (b) * SHM_V + vst0) = vs0; *(bf16x8*)(V_lds + (b) * SHM_V + vst1) = vs1; \
    _Pragma("unroll") for (int c_ = 0; c_ < NCK; ++c_) *(bf16x8*)(K_lds + (b) * SHM_K + kswz<DQK>(krow[c_], kcol[c_] * 2)) = ks[c_]; } while (0)
    const int NT = seq / KVBLK;
    ATT1_SLOAD(0); asm volatile("s_waitcnt vmcnt(0)" ::: "memory"); ATT1_SWRITE(0); __syncthreads();
#define ATT1_SM(P0, P1, PA0, PA1, PA2, PA3) do { float mn, alpha; partialSM<DQK>(P0, P1, m_reg, mn, alpha); \
        if (__any(alpha < 1.f)) { if (hi == 0) al_l[r32] = alpha; asm volatile("s_waitcnt lgkmcnt(0)" ::: "memory"); \
            _Pragma("unroll") for (int d = 0; d < 4; ++d) _Pragma("unroll") for (int r = 0; r < 16; ++r) o[d][r] *= al_l[crow(r, hi)]; } \
        finishSM(P0, P1, alpha, l_reg, PA0, PA1, PA2, PA3); ATT_SBAR(); } while (0)
    if (!grpB) {
        for (int j = 0; j < NT; ++j) {
            const int b = j & 1;
            if (j + 1 < NT) ATT1_SLOAD((j + 1) * KVBLK);
            ATT_SBAR();
            f32x16 p0, p1; bf16x8 pa0, pa1, pa2, pa3;
            qkt<DQK>(p0, p1, K_lds + b * SHM_K, qr, r32, hi);
            __syncthreads();
            ATT1_SM(p0, p1, pa0, pa1, pa2, pa3);
            pv_d0(o, vb0 + b * (int)SHM_V, pa0, pa1, pa2, pa3);
            if (j + 1 < NT) { ATT1_SWRITE(b ^ 1); }
            __syncthreads();
        }
    } else {
        bf16x8 pa0, pa1, pa2, pa3;
        {
            if (1 < NT) ATT1_SLOAD(KVBLK);
            ATT_SBAR();
            __syncthreads();
            f32x16 p0, p1;
            qkt<DQK>(p0, p1, K_lds, qr, r32, hi);
            ATT1_SM(p0, p1, pa0, pa1, pa2, pa3);
            if (1 < NT) { ATT1_SWRITE(1); }
            __syncthreads();
        }
        for (int j = 1; j < NT; ++j) {
            const int b = j & 1;
            if (j + 1 < NT) ATT1_SLOAD((j + 1) * KVBLK);
            ATT_SBAR();
            pv_d0(o, vb0 + (b ^ 1) * (int)SHM_V, pa0, pa1, pa2, pa3);
            __syncthreads();
            f32x16 p0, p1;
            qkt<DQK>(p0, p1, K_lds + b * SHM_K, qr, r32, hi);
            ATT1_SM(p0, p1, pa0, pa1, pa2, pa3);
            if (j + 1 < NT) { ATT1_SWRITE(b ^ 1); }
            __syncthreads();
        }
        pv_d0(o, vb0 + ((NT - 1) & 1) * (int)SHM_V, pa0, pa1, pa2, pa3);
    }
#undef ATT1_SM
    if (hi == 0) li_l[r32] = l_reg;
    asm volatile("s_waitcnt lgkmcnt(0)" ::: "memory");
    __syncthreads();
    float rli[16];
#pragma unroll
    for (int r = 0; r < 16; ++r) rli[r] = __builtin_amdgcn_rcpf(li_l[crow(r, hi)]);
    unsigned short* stg = (unsigned short*)(lds + wid * 8192);
#pragma unroll
    for (int r = 0; r < 16; ++r) { const int orow = crow(r, hi);
#pragma unroll
        for (int d0 = 0; d0 < 4; ++d0) { const unsigned w = cvtpk(o[d0][r] * rli[r], 0.f); stg[orow * 128 + d0 * 32 + r32] = (unsigned short)(w & 0xffffu); } }
    asm volatile("s_waitcnt lgkmcnt(0)" ::: "memory");
    bf16_t* Ow = Ob + (long)(wid * QBLK) * LDO;
#pragma unroll
    for (int i = 0; i < 8; ++i) { const int id = lane + 64 * i, row = id >> 4, c16 = id & 15;
        const u32x4 v = *(const u32x4*)((const char*)stg + row * 256 + c16 * 16);
        *(u32x4*)(Ow + (long)row * LDO + c16 * 8) = v; }
    asm volatile("s_waitcnt lgkmcnt(0)" ::: "memory");
    __syncthreads();
#undef ATT1_SLOAD
#undef ATT1_SWRITE
}
}
constexpr int DM = 2048, NBATCH = 2, SEQ = 4096, CTX = 256, RB = SEQ + CTX  , MROWS = NBATCH * RB  ;
constexpr int NMOD = 6 * DM, NEXP = 16384;
constexpr float EPS = 1e-6f;
constexpr int NWAVES = 8, NTHREADS = 512;
constexpr size_t MiB = 1u << 20;
constexpr size_t WS_CTL = 0, CTL_ZERO_BYTES = 64 * 1024;
constexpr size_t WS_MOD = 1 * MiB;
constexpr size_t WS_ROPE = 2 * MiB;
constexpr size_t WS_SMALL = 3 * MiB;
constexpr int SM_N1G = 0, SM_N2G = 8192, SM_AQG = 16384, SM_AKG = 16384 + 384, SM_CW = 16384 + 768, SM_CB = SM_CW + 6144, SM_CQG = SM_CB + 2048, SM_CKG = SM_CQG + 256, SM_END = SM_CKG + 256;
constexpr size_t WS_PTRS = 3 * MiB + 512 * 1024;
constexpr size_t WS_XW = 4 * MiB;
constexpr size_t WS_H = 72 * MiB;
constexpr size_t WS_P = 106 * MiB;
constexpr size_t WS_QRAW = 174 * MiB;
constexpr size_t WS_KVRAW = 200 * MiB;
constexpr size_t WS_Q = 234 * MiB;
constexpr size_t WS_K = 268 * MiB;
constexpr size_t WS_V = 294 * MiB;
constexpr size_t WS_CAT = 311 * MiB;
constexpr size_t WS_PQ = 345 * MiB;
constexpr size_t WS_IDX = 379 * MiB;
constexpr size_t WS_GATE = 384 * MiB;
constexpr size_t WS_WIN = 389 * MiB;
constexpr size_t WS_WUQ = 421 * MiB;
constexpr size_t WS_WUKV = 424 * MiB;
constexpr size_t WS_WEO = 426 * MiB;
constexpr size_t WS_WQKV = 442 * MiB;
constexpr size_t WS_WCO = 466 * MiB;
constexpr size_t WS_WPQ = 482 * MiB;
constexpr size_t WS_SUBK = 514 * MiB;
#ifndef TAB_FP4
#define TAB_FP4 1
#endif
#if TAB_FP4
constexpr int ROWB = 1024;
#else
constexpr int ROWB = 1536;
#endif
constexpr size_t WS_U = 516 * MiB;
constexpr size_t WS_VT = 644 * MiB;
constexpr size_t WS_USC = 772 * MiB;
constexpr size_t WS_VSC = 773 * MiB;
constexpr size_t WS_XQ = 810 * MiB;
constexpr size_t WS_XS = 828 * MiB;
constexpr size_t WS_WQ8 = 834 * MiB;
constexpr size_t WS_WSC = 836 * MiB;
constexpr size_t WS_PART = 774 * MiB;
constexpr size_t WS_END = 837 * MiB;
#ifndef EXP_SLICED
#define EXP_SLICED 1
#endif
#ifndef PEER_MFMA
#define PEER_MFMA 1
#endif
#ifndef PEER_VMFMA
#define PEER_VMFMA 1
#endif
constexpr int CW_BAR = 4096;
constexpr int LDS_MISC = 131072 + 8192;
constexpr int LDS_BYTES = 147456;

#define LAS __attribute__((address_space(3)))
typedef unsigned short bf16_t;
typedef float f32x4 __attribute__((ext_vector_type(4)));
typedef unsigned u32x4 __attribute__((ext_vector_type(4)));
typedef unsigned u32x2 __attribute__((ext_vector_type(2)));
typedef short bf16x8 __attribute__((ext_vector_type(8)));
typedef float f32x16 __attribute__((ext_vector_type(16)));
typedef __bf16 bf16x2_t __attribute__((ext_vector_type(2)));
typedef float f32x2 __attribute__((ext_vector_type(2)));
typedef _Float16 h2_t __attribute__((ext_vector_type(2)));
typedef float f32x32 __attribute__((ext_vector_type(32)));
typedef unsigned u32x6 __attribute__((ext_vector_type(6)));

__device__ __forceinline__ unsigned f2bf(float f) { unsigned u = __builtin_bit_cast(unsigned, f); return (u + 0x7fffu + ((u >> 16) & 1u)) >> 16; }
__device__ __forceinline__ unsigned pk2(float lo, float hi) { return f2bf(lo) | (f2bf(hi) << 16); }
__device__ __forceinline__ float bf_lo(unsigned w) { return __builtin_bit_cast(float, w << 16); }
__device__ __forceinline__ float bf_hi(unsigned w) { return __builtin_bit_cast(float, w & 0xffff0000u); }
__device__ __forceinline__ float bf2f(bf16_t h) { return __builtin_bit_cast(float, (unsigned)h << 16); }
__device__ __forceinline__ float wave_sum(float v) {
#pragma unroll
    for (int o = 1; o < 64; o <<= 1) v += __shfl_xor(v, o);
    return v;
}
#define DPP_ADD(v, ctrl) ((v) + __builtin_bit_cast(float, __builtin_amdgcn_update_dpp(0, __builtin_bit_cast(int, (v)), (ctrl), 0xf, 0xf, true)))
__device__ __forceinline__ float wave_sum_dpp(float v) {
    v = DPP_ADD(v, 0xB1);
    v = DPP_ADD(v, 0x4E);
    v = DPP_ADD(v, 0x141);
    v = DPP_ADD(v, 0x140);
    const int vi = __builtin_bit_cast(int, v);
    const float s0 = __builtin_bit_cast(float, __builtin_amdgcn_readlane(vi, 0)), s1 = __builtin_bit_cast(float, __builtin_amdgcn_readlane(vi, 16));
    const float s2 = __builtin_bit_cast(float, __builtin_amdgcn_readlane(vi, 32)), s3 = __builtin_bit_cast(float, __builtin_amdgcn_readlane(vi, 48));
    return (s0 + s1) + (s2 + s3);
}
#define DPP_MOV(v, ctrl) __builtin_bit_cast(float, __builtin_amdgcn_update_dpp(0, __builtin_bit_cast(int, (v)), (ctrl), 0xf, 0xf, true))
__device__ __forceinline__ float wave_max_dpp(float v) {
    v = fmaxf(v, DPP_MOV(v, 0xB1)); v = fmaxf(v, DPP_MOV(v, 0x4E)); v = fmaxf(v, DPP_MOV(v, 0x141)); v = fmaxf(v, DPP_MOV(v, 0x140));
    const int vi = __builtin_bit_cast(int, v);
    return fmaxf(fmaxf(__builtin_bit_cast(float, __builtin_amdgcn_readlane(vi, 0)), __builtin_bit_cast(float, __builtin_amdgcn_readlane(vi, 16))),
                 fmaxf(__builtin_bit_cast(float, __builtin_amdgcn_readlane(vi, 32)), __builtin_bit_cast(float, __builtin_amdgcn_readlane(vi, 48))));
}
__device__ __forceinline__ float dot2_bf16(unsigned w, unsigned x, float acc) { return __builtin_amdgcn_fdot2_f32_bf16(__builtin_bit_cast(bf16x2_t, w), __builtin_bit_cast(bf16x2_t, x), acc, false); }
__device__ __forceinline__ float gelu_erf(float v) {
    const float av = fabsf(v), t = __builtin_amdgcn_rcpf(av * 0.2316418882f + 1.0f);
    float q = t * 0.5307027145f + (-0.7265760135f); q = q * t + 0.7107068705f; q = q * t + (-0.142248368f); q = q * t + 0.127414796f; q = q * t;
    const float e = __builtin_amdgcn_exp2f((v * v) * (-0.72134752044f));
    const float m = v * (q * e);
    return v < 0.f ? m : v - m;
}
#define XB_TMO      128
#define XB_XCNT(j)  (256  + 64 * (j))
#define XB_XSUB(j)  (1280 + 64 * (j))
#define XB_XGEN(j)  (2304 + 64 * (j))
#define XB_TOP      3328
#define XB_TOPGEN   3392
#define XCD_BAR_WORDS 3456
#define XB_SPIN_CAP (1u << 18)

__device__ __forceinline__ unsigned xb_ld(unsigned* p)              { return __hip_atomic_load(p, __ATOMIC_RELAXED, __HIP_MEMORY_SCOPE_AGENT); }
__device__ __forceinline__ unsigned xb_add(unsigned* p, unsigned v) { return __hip_atomic_fetch_add(p, v, __ATOMIC_RELAXED, __HIP_MEMORY_SCOPE_AGENT); }
__device__ __forceinline__ unsigned xb_xcc_id() { return (unsigned)__builtin_amdgcn_s_getreg((3 << 11) | 20) & 0xFu; }
#define XB_SPIN(cond, bar) do { unsigned _sp = 0; while (cond) { __builtin_amdgcn_s_sleep(1); \
    if ((++_sp & 255u) == 0u) { if (xb_ld(&(bar)[XB_TMO])) break; if (_sp > XB_SPIN_CAP) { atomicAdd(&(bar)[XB_TMO], 1u); break; } } } } while (0)

struct XcdBarrier {
    unsigned* bar; unsigned x;
    volatile LAS unsigned* st;
};

__device__ __forceinline__ XcdBarrier xcd_barrier_post(unsigned* bar, volatile LAS unsigned* st) {
    XcdBarrier b; b.bar = bar; b.x = xb_xcc_id(); b.st = st;
    if (threadIdx.x == 0) (void)xb_add(&bar[XB_XCNT(b.x)], 1u);
    return b;
}
__device__ __forceinline__ void xcd_barrier_complete(unsigned* bar, unsigned x, unsigned& nloc, unsigned& nx) {
    const unsigned G = gridDim.x * gridDim.y * gridDim.z;
    unsigned sum, cnt, mine, sp = 0u;
    for (;;) {
        sum = 0u; cnt = 0u; mine = 0u;
#pragma unroll
        for (unsigned j = 0; j < 16; ++j) { const unsigned c = xb_ld(&bar[XB_XCNT(j)]); sum += c; cnt += (c > 0u) ? 1u : 0u; mine = (j == x) ? c : mine; }
        if (sum == G) break;
        __builtin_amdgcn_s_sleep(1);
        if ((++sp & 255u) == 0u) { if (xb_ld(&bar[XB_TMO])) break; if (sp > XB_SPIN_CAP) { atomicAdd(&bar[XB_TMO], 1u); break; } }
    }
    nloc = mine > 0u ? mine : 1u; nx = cnt > 0u ? cnt : 1u;
}

__device__ __forceinline__ void xcd_barrier(const XcdBarrier& b) {
    asm volatile("s_waitcnt vmcnt(0)" ::: "memory");
    __syncthreads();
    if (threadIdx.x == 0) {
        unsigned* bar = b.bar; unsigned bx = b.x;
        asm volatile("" : "+s"(bar), "+s"(bx));
        __builtin_amdgcn_s_waitcnt(0);
        unsigned nloc = b.st[0], nx = b.st[1];
        if (nloc == 0u) { xcd_barrier_complete(bar, bx, nloc, nx); b.st[0] = nloc; b.st[1] = nx; }
        const unsigned old = xb_add(&bar[XB_XSUB(bx)], 1u);
        const unsigned gen = old / nloc;
        if (old + 1u == (gen + 1u) * nloc) {
            __builtin_amdgcn_fence(__ATOMIC_RELEASE, "agent");
            asm volatile("s_waitcnt vmcnt(0)" ::: "memory");
            const unsigned og = xb_add(&bar[XB_TOP], 1u);
            const unsigned tg = og / nx;
            if (og + 1u == (tg + 1u) * nx) xb_add(&bar[XB_TOPGEN], 1u);
            else XB_SPIN(xb_ld(&bar[XB_TOPGEN]) == tg, bar);
            __builtin_amdgcn_fence(__ATOMIC_ACQUIRE, "agent");
            xb_add(&bar[XB_XGEN(bx)], 1u);
            asm volatile("s_waitcnt vmcnt(0)" ::: "memory");
        } else {
            XB_SPIN(xb_ld(&bar[XB_XGEN(bx)]) == gen, bar);
            __builtin_amdgcn_fence(__ATOMIC_ACQUIRE, "agent");
            asm volatile("s_waitcnt vmcnt(0)" ::: "memory");
        }
    }
    __syncthreads();
}
struct Frame {
    LAS unsigned char* lds;
    int tid, lane, wave, vcu, G, gw, NGW;
    unsigned char* ws;
};
__device__ __forceinline__ int opaque_v(int v) { asm volatile("" : "+v"(v)); return v; }
__device__ __forceinline__ int phase_tid(int wave) { int lane; asm volatile("v_mbcnt_lo_u32_b32 %0, -1, 0\n\tv_mbcnt_hi_u32_b32 %0, -1, %0" : "=v"(lane)); return wave * 64 + lane; }
__device__ __forceinline__ Frame phase_frame(const Frame& F0) { Frame F = F0; F.tid = phase_tid(F0.wave); F.lane = F.tid & 63; return F; }
__device__ __forceinline__ float swap32(float v, int lane) { auto rr = __builtin_amdgcn_permlane32_swap(__float_as_uint(v), __float_as_uint(v), false, false); return __uint_as_float(lane < 32 ? rr[1] : rr[0]); }
__device__ __forceinline__ int row_cls(int row) { const int b = row / RB, i = row - b * RB; return i < CTX ? 2 : b; }

__device__ __forceinline__ void p0_transpose_item(const float* W, int K, int N, bf16_t* WT, const float* gain, LAS float* scr, int item, int lane, bool perm_q = false) {
    const int nblk = N / 32, kb = item / nblk, nb = item % nblk, k0 = 64 * kb, n0 = 32 * nb;
    {
        const int rgp = lane >> 3, c4 = (lane & 7) * 4; f32x4 tv[8];
#pragma unroll
        for (int i = 0; i < 8; ++i) tv[i] = *(const f32x4*)(W + (size_t)(k0 + 8 * i + rgp) * N + n0 + c4);
#pragma unroll
        for (int i = 0; i < 8; ++i) { const int kk = 8 * i + rgp; f32x4 v = tv[i]; if (gain) v = v * gain[k0 + kk];
            LAS float* d = scr + kk * 33 + c4; d[0] = v.x; d[1] = v.y; d[2] = v.z; d[3] = v.w; }
    }
    asm volatile("s_waitcnt lgkmcnt(0)" ::: "memory");
    const int c = lane & 7;
#pragma unroll
    for (int j = 0; j < 4; ++j) { const int n = (lane >> 3) + 8 * j; const LAS float* s = scr + (8 * c) * 33 + n;
        u32x4 o; o.x = pk2(s[0 * 33], s[1 * 33]); o.y = pk2(s[2 * 33], s[3 * 33]); o.z = pk2(s[4 * 33], s[5 * 33]); o.w = pk2(s[6 * 33], s[7 * 33]);
        int nn = n0 + n; if (perm_q) { const int hh = nn / 192, e = nn - hh * 192; nn = (e < 128) ? hh * 128 + e : 1024 + hh * 64 + (e - 128); }
        *(u32x4*)(WT + (size_t)nn * K + k0 + 8 * c) = o; }
    asm volatile("s_waitcnt lgkmcnt(0)" ::: "memory");
}
struct TrDesc { const float* W; const float* gain; bf16_t* WT; int K, N, items; };

__device__ __forceinline__ void p0_gemv_task(Frame& F, int task, const float* ada_w, const float* ada_b, float* mod) {
    LAS float* sv = (LAS float*)F.lds; LAS float* part = (LAS float*)(F.lds + 32768);
    const int l = task / 192, n0 = (task % 192) * 64, rg = F.lane >> 4, c4 = (F.lane & 15) * 4;
    const float* Wp = ada_w + (size_t)l * DM * NMOD + n0 + c4 + (size_t)(F.wave * 256 + rg) * NMOD;
    f32x4 a0 = {0, 0, 0, 0}, a1 = a0, a2 = a0;
    for (int k = 0; k < 256; k += 32) {
        f32x4 w[8];
#pragma unroll
        for (int u = 0; u < 8; ++u) w[u] = *(const f32x4*)(Wp + (size_t)(k + 4 * u) * NMOD);
#pragma unroll
        for (int u = 0; u < 8; ++u) { const int kk = F.wave * 256 + k + 4 * u + rg; const float s0 = sv[kk], s1 = sv[2048 + kk], s2 = sv[4096 + kk];
            a0 += w[u] * s0; a1 += w[u] * s1; a2 += w[u] * s2; }
    }
    LAS float* pp = part + ((F.wave * 4 + rg) * 3) * 64 + c4;
    *(LAS f32x4*)(pp) = a0; *(LAS f32x4*)(pp + 64) = a1; *(LAS f32x4*)(pp + 128) = a2;
    __syncthreads();
    if (F.tid < 192) { const int r = F.tid >> 6, c = F.tid & 63; float s = 0.f;
#pragma unroll
        for (int q = 0; q < 32; ++q) s += part[(q * 3 + r) * 64 + c];
        mod[(size_t)(l * 3 + r) * NMOD + n0 + c] = s + ada_b[(size_t)l * NMOD + n0 + c]; }
    __syncthreads();
}

constexpr int TAB_DEFER_PER_WAVE = 12, TAB_DEFER = 104 * NWAVES * TAB_DEFER_PER_WAVE;
constexpr int TAB_DEFA_EVEN = 6, TAB_DEFA_ODD = 4;
__device__ __forceinline__ int tab_defer_u(int ll) { return (ll == 0 || ll == 2) ? 240 * NWAVES * TAB_DEFA_EVEN : (ll == 1 ? 224 * NWAVES * TAB_DEFA_ODD : 0); }
__device__ __forceinline__ void tab_row_convert(const float* src_row, unsigned char* ws, int tab, int rr  , int lane) {
    const float* src = src_row + lane * 4;
    f32x4 v[8];
#pragma unroll
    for (int q = 0; q < 8; ++q) v[q] = *(const f32x4*)(src + q * 256);
    float am = 0.f, ssq = 0.f;
#pragma unroll
    for (int q = 0; q < 8; ++q) { am = fmaxf(fmaxf(am, fmaxf(fabsf(v[q].x), fabsf(v[q].y))), fmaxf(fabsf(v[q].z), fabsf(v[q].w))); ssq += (v[q].x * v[q].x + v[q].y * v[q].y) + (v[q].z * v[q].z + v[q].w * v[q].w); }
    am = fmaxf(wave_max_dpp(am), 1e-30f); ssq = wave_sum_dpp(ssq);
    const float sig = fmaxf(sqrtf(ssq * (1.f / DM)), am * (1.f / 64.f)), sc = 2.0f / sig;
    const int ll = rr / NEXP, ee = rr - ll * NEXP;
    unsigned char* dst = ws + (tab ? WS_VT : WS_U) + (size_t)ll * NEXP * ROWB + (size_t)ee * 128 + lane * 2;
#define P0_C6(x) fminf(fmaxf((x), -6.f), 6.f)
#pragma unroll
    for (int q = 0; q < 8; ++q) { const f32x4 x = v[q] * sc; unsigned t = 0u;
        t = __builtin_amdgcn_cvt_scalef32_pk_fp4_f32(t, P0_C6(x.x), P0_C6(x.y), 1.0f, 0); t = __builtin_amdgcn_cvt_scalef32_pk_fp4_f32(t, P0_C6(x.z), P0_C6(x.w), 1.0f, 1);
        *(unsigned short*)(dst + (size_t)q * (NEXP * 128)) = (unsigned short)t; }
#undef P0_C6
    if (lane == 0) ((float*)(ws + (tab ? WS_VSC : WS_USC)))[rr] = sig * 0.5f;
}
__device__ __forceinline__ void tab_deferred_u_rows(const Frame& F0, int l, int wslot, int per) {
    const Frame F = phase_frame(F0);
    unsigned char* ws = F.ws;
    const float* in_u = ((const float* const*)(ws + WS_PTRS))[0];
#pragma unroll 1
    for (int i = 0; i < per; ++i) { const int rr = l * NEXP + NEXP - tab_defer_u(l) + wslot * per + i; tab_row_convert(in_u + (size_t)rr * DM, ws, 0, rr, F.lane); }
}
__device__ __forceinline__ void tab_deferred_rows(const Frame& F0, int l, int wslot) {
    const Frame F = phase_frame(F0);
    unsigned char* ws = F.ws;
    const float* in_v = ((const float* const*)(ws + WS_PTRS))[1];
#pragma unroll 1
    for (int i = 0; i < TAB_DEFER_PER_WAVE; ++i) { const int rr = l * NEXP + NEXP - TAB_DEFER + wslot * TAB_DEFER_PER_WAVE + i; tab_row_convert(in_v + (size_t)rr * DM, ws, 1, rr, F.lane); }
}
__device__ __forceinline__ void p0_prologue(Frame& F, const float* const* in, const int parts = 15) {
    unsigned char* ws = F.ws;
    if (parts & 1) {
        LAS float* sv = (LAS float*)F.lds;
        for (int i = F.tid; i < 3 * DM; i += NTHREADS) { const int r = i / DM, k = i - r * DM; const float x = (r < 2) ? in[1][r * DM + k] : in[3][k]; sv[i] = x / (1.f + __expf(-x)); }
        __syncthreads();
        for (int task = F.vcu; task < 768; task += F.G) p0_gemv_task(F, task, in[4], in[5], (float*)(ws + WS_MOD));
        __syncthreads();
    }
    if (parts & 2) {
        bf16_t* xw = (bf16_t*)(ws + WS_XW);
        for (int row = F.gw; row < MROWS; row += F.NGW) { const int b = row / RB, i = row - b * RB;
            const float* src = (i < CTX) ? in[2] + (size_t)(b * CTX + i) * DM : in[0] + (size_t)(b * SEQ + i - CTX) * DM;
            const f32x4* s4 = (const f32x4*)src + F.lane; u32x2* d4 = (u32x2*)(xw + (size_t)row * DM) + F.lane;
#pragma unroll
            for (int j = 0; j < 8; ++j) { const f32x4 v = s4[64 * j]; u32x2 o; o.x = pk2(v.x, v.y); o.y = pk2(v.z, v.w); d4[64 * j] = o; } }
    }
    if (parts & 2) {
        float* sm = (float*)(ws + WS_SMALL); const int g = F.vcu * NTHREADS + F.tid;
        if (g < 8192) { sm[SM_N1G + g] = in[6][g]; sm[SM_N2G + g] = in[7][g]; }
        if (g < 384) { sm[SM_AQG + g] = in[13][g]; sm[SM_AKG + g] = in[14][g]; }
        if (g < 6144) sm[SM_CW + g] = in[15][g];
        if (g < 2048) sm[SM_CB + g] = in[16][g];
        if (g < 256) { sm[SM_CQG + g] = in[19][g]; sm[SM_CKG + g] = in[20][g]; }
    }
    if (parts & 2) {
        float* rc = (float*)(ws + WS_ROPE); float* ra = rc + 64 * 32 * 2;
        const int g = F.vcu * NTHREADS + F.tid;
        if (g < 64 * 32) { const int pos = g >> 5, f = g & 31; const float fr = exp2f(-(float)f * (13.287712379549449f / 32.f)); const float ang = (float)pos * fr;
            rc[2 * g] = cosf(ang); rc[2 * g + 1] = sinf(ang); }
        else if (g < 64 * 32 + 64 * 16) { const int e = g - 64 * 32, pos = e >> 4, f = e & 15; const float fr = exp2f(-(float)f * (13.287712379549449f / 16.f)); const float ang = (float)pos * fr;
            ra[2 * e] = cosf(ang); ra[2 * e + 1] = sinf(ang); }
    }
    if (parts & 4) {
        LAS float* scr = (LAS float*)(F.lds + F.wave * 16384);
        TrDesc d[16]; int nd = 0;
#pragma unroll
        for (int i = 0; i < 2; ++i) {
            d[nd++] = TrDesc{in[8] + (size_t)i * DM * 3904, nullptr, (bf16_t*)(ws + WS_WIN) + (size_t)i * 4096 * DM, DM, 3904, 32 * 122};
            d[nd++] = TrDesc{in[11] + (size_t)i * 512 * 1536, in[9] + i * 512, (bf16_t*)(ws + WS_WUQ) + (size_t)i * 1536 * 512, 512, 1536, 8 * 48};
            d[nd++] = TrDesc{in[12] + (size_t)i * 256 * 2048, in[10] + i * 256, (bf16_t*)(ws + WS_WUKV) + (size_t)i * 2048 * 256, 256, 2048, 4 * 64};
            d[nd++] = TrDesc{in[17] + (size_t)i * DM * DM, nullptr, (bf16_t*)(ws + WS_WEO) + (size_t)i * DM * DM, DM, DM, 32 * 64};
            d[nd++] = TrDesc{in[18] + (size_t)i * DM * 3072, nullptr, (bf16_t*)(ws + WS_WQKV) + (size_t)i * 3072 * DM, DM, 3072, 32 * 96};
            d[nd++] = TrDesc{in[21] + (size_t)i * DM * DM, nullptr, (bf16_t*)(ws + WS_WCO) + (size_t)i * DM * DM, DM, DM, 32 * 64};
        }
#pragma unroll
        for (int l = 0; l < 4; ++l) d[nd++] = TrDesc{in[22] + (size_t)l * DM * DM, nullptr, (bf16_t*)(ws + WS_WPQ) + (size_t)l * DM * DM, DM, DM, 32 * 64};
#pragma unroll
        for (int m = 0; m < 16; ++m) {
            for (int it = F.gw; it < d[m].items; it += F.NGW) p0_transpose_item(d[m].W, d[m].K, d[m].N, d[m].WT, d[m].gain, scr, it, F.lane, d[m].K == 512);
        }
        for (int i = F.gw * 64 + F.lane; i < 2 * 192 * DM / 8; i += F.NGW * 64) { const int li = i / (192 * DM / 8), r = i % (192 * DM / 8);
            *(u32x4*)((bf16_t*)(ws + WS_WIN) + (size_t)li * 4096 * DM + (size_t)3904 * DM + (size_t)r * 8) = (u32x4){0u, 0u, 0u, 0u}; }
    }
    if (parts & 2) {
        const size_t n_sk = (size_t)4 * 16 * 128 * 128 / 8;
        const size_t gt = (size_t)F.vcu * NTHREADS + F.tid, GT = (size_t)F.G * NTHREADS;
        for (size_t j = gt; j < n_sk; j += GT) {
            const f32x4 a = *(const f32x4*)(in[23] + j * 8), b = *(const f32x4*)(in[23] + j * 8 + 4);
            u32x4 o; o.x = pk2(a.x, a.y); o.y = pk2(a.z, a.w); o.z = pk2(b.x, b.y); o.w = pk2(b.z, b.w);
            *(u32x4*)((bf16_t*)(ws + WS_SUBK) + j * 8) = o;
        }
    }
#if TAB_FP4 && EXP_SLICED && PEER_MFMA && !defined(P0_NOCOAL)
    if (parts & 8) {
        if (F.vcu == 0 && F.tid == 0) { const float** pp = (const float**)(ws + WS_PTRS); pp[0] = in[24]; pp[1] = in[25]; }
        for (int r = F.gw; r < 2 * 4 * NEXP; r += F.NGW) { const int tab = r >= 4 * NEXP, rr = r - tab * (4 * NEXP);
            if (F.G == 256) { const int ll = rr / NEXP, ee = rr - ll * NEXP; if (tab == 1 ? ((ll & 1) && ee >= NEXP - TAB_DEFER) : (ee >= NEXP - tab_defer_u(ll))) continue; }
            tab_row_convert((tab ? in[25] : in[24]) + (size_t)rr * DM, ws, tab, rr, F.lane); }
    }
#elif TAB_FP4 && EXP_SLICED && PEER_MFMA && defined(P0_PIPE)
    {
        const int NR = 2 * 4 * NEXP;
#define P0_LOAD(V, r_) do { const int rc_ = (r_) < NR ? (r_) : NR - 1; const float* s_ = ((rc_ >= 4 * NEXP) ? in[25] + (size_t)(rc_ - 4 * NEXP) * DM : in[24] + (size_t)rc_ * DM) + F.lane * 32; \
        _Pragma("unroll") for (int q = 0; q < 8; ++q) V[q] = *(const f32x4*)(s_ + q * 4); } while (0)
#define P0_C6(x) fminf(fmaxf((x), -6.f), 6.f)
#define P0_ROW(V, VN) do { \
        const int rn = r + F.NGW; P0_LOAD(VN, rn); \
        const int tab = r >= 4 * NEXP, rr = r - tab * (4 * NEXP); \
        float am = 0.f, ssq = 0.f; \
        _Pragma("unroll") for (int q = 0; q < 8; ++q) { am = fmaxf(fmaxf(am, fmaxf(fabsf(V[q].x), fabsf(V[q].y))), fmaxf(fabsf(V[q].z), fabsf(V[q].w))); ssq += (V[q].x * V[q].x + V[q].y * V[q].y) + (V[q].z * V[q].z + V[q].w * V[q].w); } \
        am = fmaxf(wave_max_dpp(am), 1e-30f); ssq = wave_sum_dpp(ssq); \
        const float sig = fmaxf(sqrtf(ssq * (1.f / DM)), am * (1.f / 64.f)), sc = 2.0f / sig; \
        unsigned w4[4]; \
        _Pragma("unroll") for (int q = 0; q < 4; ++q) { unsigned t = 0u; const f32x4 xa = V[2 * q] * sc, xb = V[2 * q + 1] * sc; \
            t = __builtin_amdgcn_cvt_scalef32_pk_fp4_f32(t, P0_C6(xa.x), P0_C6(xa.y), 1.0f, 0); t = __builtin_amdgcn_cvt_scalef32_pk_fp4_f32(t, P0_C6(xa.z), P0_C6(xa.w), 1.0f, 1); \
            t = __builtin_amdgcn_cvt_scalef32_pk_fp4_f32(t, P0_C6(xb.x), P0_C6(xb.y), 1.0f, 2); t = __builtin_amdgcn_cvt_scalef32_pk_fp4_f32(t, P0_C6(xb.z), P0_C6(xb.w), 1.0f, 3); w4[q] = t; } \
        { const int ll = rr / NEXP, ee = rr - ll * NEXP; \
          *(u32x4*)(ws + (tab ? WS_VT : WS_U) + (size_t)ll * NEXP * ROWB + (size_t)(F.lane >> 3) * (NEXP * 128) + (size_t)ee * 128 + (F.lane & 7) * 16) = (u32x4){w4[0], w4[1], w4[2], w4[3]}; } \
        if (F.lane == 0) ((float*)(ws + (tab ? WS_VSC : WS_USC)))[rr] = sig * 0.5f; \
        r = rn; } while (0)
        int r = F.gw; f32x4 va[8], vb[8]; P0_LOAD(va, r);
        while (r < NR) { P0_ROW(va, vb); if (!(r < NR)) break; P0_ROW(vb, va); }
#undef P0_ROW
#undef P0_C6
#undef P0_LOAD
    }
#else
    {
        for (int r = F.gw; r < 2 * 4 * NEXP; r += F.NGW) {
            const int tab = r / (4 * NEXP), rr = r - tab * (4 * NEXP);
#if EXP_SLICED
            const float* src = (tab ? in[25] : in[24]) + (size_t)rr * DM + F.lane * 32;
            f32x4 v[8];
#pragma unroll
            for (int q = 0; q < 8; ++q) v[q] = *(const f32x4*)(src + q * 4);
#else
            const float* src = (tab ? in[25] : in[24]) + (size_t)rr * DM + F.lane * 16;
            f32x4 v[8];
#pragma unroll
            for (int j = 0; j < 2; ++j)
#pragma unroll
                for (int q = 0; q < 4; ++q) v[j * 4 + q] = *(const f32x4*)(src + j * 1024 + q * 4);
#endif
            float am = 0.f;
#pragma unroll
            for (int q = 0; q < 8; ++q) am = fmaxf(fmaxf(am, fmaxf(fabsf(v[q].x), fabsf(v[q].y))), fmaxf(fabsf(v[q].z), fabsf(v[q].w)));
#pragma unroll
            for (int o = 1; o < 64; o <<= 1) am = fmaxf(am, __shfl_xor(am, o));
            am = fmaxf(am, 1e-30f);
#if TAB_FP4
            float ssq = 0.f;
#pragma unroll
            for (int q = 0; q < 8; ++q) ssq += (v[q].x * v[q].x + v[q].y * v[q].y) + (v[q].z * v[q].z + v[q].w * v[q].w);
#pragma unroll
            for (int o = 1; o < 64; o <<= 1) ssq += __shfl_xor(ssq, o);
            const float sig = fmaxf(sqrtf(ssq * (1.f / DM)), am * (1.f / 64.f));
            unsigned w4[4];
#if EXP_SLICED
            if (tab == 0 && !PEER_MFMA) {
                const float delta = 0.3352f * sig, isc = 1.0f / delta;
#pragma unroll
                for (int q = 0; q < 4; ++q) { unsigned t = 0u;
#pragma unroll
                    for (int hh = 0; hh < 2; ++hh) { const f32x4 x = v[2 * q + hh] * isc;
                        const int n0 = min(max((int)floorf(x.x), -8), 7) & 15, n1 = min(max((int)floorf(x.y), -8), 7) & 15, n2 = min(max((int)floorf(x.z), -8), 7) & 15, n3 = min(max((int)floorf(x.w), -8), 7) & 15;
                        t |= ((unsigned)n0 | ((unsigned)n1 << 4) | ((unsigned)n2 << 8) | ((unsigned)n3 << 12)) << (16 * hh); }
                    w4[q] = t; }
                { const int ll = rr / NEXP, ee = rr - ll * NEXP;
                  *(u32x4*)(ws + WS_U + (size_t)ll * NEXP * ROWB + (size_t)(F.lane >> 3) * (NEXP * 128) + (size_t)ee * 128 + (F.lane & 7) * 16) = (u32x4){w4[0], w4[1], w4[2], w4[3]}; }
                if (F.lane == 0) ((float*)(ws + WS_USC))[rr] = delta;
                continue;
            }
#endif
            const float sc = 2.0f / sig;
#pragma unroll
            for (int q = 0; q < 4; ++q) { unsigned t = 0u;
                const f32x4 xa = v[2 * q] * sc, xb = v[2 * q + 1] * sc;
#define P0_C6(x) fminf(fmaxf((x), -6.f), 6.f)
                t = __builtin_amdgcn_cvt_scalef32_pk_fp4_f32(t, P0_C6(xa.x), P0_C6(xa.y), 1.0f, 0);
                t = __builtin_amdgcn_cvt_scalef32_pk_fp4_f32(t, P0_C6(xa.z), P0_C6(xa.w), 1.0f, 1);
                t = __builtin_amdgcn_cvt_scalef32_pk_fp4_f32(t, P0_C6(xb.x), P0_C6(xb.y), 1.0f, 2);
                t = __builtin_amdgcn_cvt_scalef32_pk_fp4_f32(t, P0_C6(xb.z), P0_C6(xb.w), 1.0f, 3);
#undef P0_C6
                w4[q] = t; }
#if EXP_SLICED
            { const int ll = rr / NEXP, ee = rr - ll * NEXP;
              *(u32x4*)(ws + (tab ? WS_VT : WS_U) + (size_t)ll * NEXP * ROWB + (size_t)(F.lane >> 3) * (NEXP * 128) + (size_t)ee * 128 + (F.lane & 7) * 16) = (u32x4){w4[0], w4[1], w4[2], w4[3]}; }
#else
            *(u32x4*)(ws + (tab ? WS_VT : WS_U) + (size_t)rr * ROWB + F.lane * 16) = (u32x4){w4[0], w4[1], w4[2], w4[3]};
#endif
            if (F.lane == 0) ((float*)(ws + (tab ? WS_VSC : WS_USC)))[rr] = sig * 0.5f;
#else
            const float sc = 7.5f / am;
            f32x16 a, b;
#pragma unroll
            for (int q = 0; q < 8; ++q) { const f32x4 x = v[q] * sc; a[2 * q] = x.x; b[2 * q] = x.y; a[2 * q + 1] = x.z; b[2 * q + 1] = x.w; }
            const u32x6 w = __builtin_amdgcn_cvt_scalef32_2xpk16_fp6_f32(a, b, 1.0f);
            unsigned char* dst = ws + (tab ? WS_VT : WS_U) + (size_t)rr * ROWB;
            *(u32x4*)(dst + F.lane * 16) = (u32x4){w[0], w[1], w[2], w[3]};
            *(u32x2*)(dst + 1024 + F.lane * 8) = (u32x2){w[4], w[5]};
            if (F.lane == 0) ((float*)(ws + (tab ? WS_VSC : WS_USC)))[rr] = am * (1.0f / 7.5f);
#endif
        }
    }
#endif
}

template <bool RESID>
__device__ __forceinline__ void ctx_gemm_phase(const Frame& F0, const bf16_t* A, int lda, const bf16_t* Bt, int ldb, int N, int K, bf16_t* O, bf16_t* X, int ldc, const float* gate) {
    const Frame F = phase_frame(F0);
    const int lane = F.lane, li = lane & 15, lq = lane >> 4, wave = F.wave;
    LAS float* red = (LAS float*)F.lds;
    LAS unsigned char* priv = F.lds + wave * 12288;
    const int lr = lane >> 3, lc = lane & 7;
    const int wr_even = lr * 128 + ((lc ^ (lr >> 1)) << 4), wr_odd = lr * 128 + ((lc ^ (4 + (lr >> 1))) << 4);
    const int rd_row = li * 128;
    const int ntask = 8 * (N / 32), k0 = wave * (K / 8);
#define CG_PTRS(t_, XG, WG) do { const int tc_ = (t_) < ntask ? (t_) : ntask - 1; const int rb_ = tc_ & 7, cb_ = tc_ >> 3; const int r0_ = (rb_ < 4) ? rb_ * 64 : RB + (rb_ - 4) * 64; \
        XG = A + (size_t)(r0_ + lr) * lda + k0 + 8 * lc; WG = Bt + (size_t)(cb_ * 32 + lr) * ldb + k0 + 8 * lc; } while (0)
#define CG_LOAD(XQ, WQ, XG, WG, q_) do { _Pragma("unroll") for (int i = 0; i < 8; ++i) XQ[i] = *(const u32x4*)(XG + (size_t)(8 * i) * lda + 64 * (q_)); \
        _Pragma("unroll") for (int i = 0; i < 4; ++i) WQ[i] = *(const u32x4*)(WG + (size_t)(8 * i) * ldb + 64 * (q_)); } while (0)
#define CG_QUARTER(XQ, WQ, XGN, WGN, qn_) do { \
        _Pragma("unroll") for (int i = 0; i < 8; ++i) *(LAS u32x4*)(priv + ((i & 1) ? wr_odd : wr_even) + i * 1024) = XQ[i]; \
        _Pragma("unroll") for (int i = 0; i < 4; ++i) *(LAS u32x4*)(priv + 8192 + ((i & 1) ? wr_odd : wr_even) + i * 1024) = WQ[i]; \
        __builtin_amdgcn_sched_barrier(0); \
        CG_LOAD(XQ, WQ, XGN, WGN, qn_); \
        __builtin_amdgcn_sched_barrier(0); \
        _Pragma("unroll") for (int s = 0; s < 2; ++s) { \
            const int ro = rd_row + (((4 * s + lq) ^ (li >> 1)) << 4); \
            bf16x8 xa[4], wb[2]; \
            _Pragma("unroll") for (int m = 0; m < 4; ++m) xa[m] = *(const LAS bf16x8*)(priv + ro + m * 2048); \
            _Pragma("unroll") for (int n = 0; n < 2; ++n) wb[n] = *(const LAS bf16x8*)(priv + 8192 + ro + n * 2048); \
            _Pragma("unroll") for (int m = 0; m < 4; ++m) _Pragma("unroll") for (int n = 0; n < 2; ++n) acc[m][n] = __builtin_amdgcn_mfma_f32_16x16x32_bf16(wb[n], xa[m], acc[m][n], 0, 0, 0); } \
    } while (0)
    u32x4 xa_[8], wa_[4], xb_[8], wb_[4];
    const bf16_t *xg, *wg, *xgn, *wgn;
    CG_PTRS(F.vcu, xg, wg);
    __builtin_amdgcn_s_waitcnt(0x0f70);
    __builtin_amdgcn_sched_barrier(0); CG_LOAD(xa_, wa_, xg, wg, 0); __builtin_amdgcn_sched_barrier(0); CG_LOAD(xb_, wb_, xg, wg, 1); __builtin_amdgcn_sched_barrier(0);
    for (int task = F.vcu; task < ntask; task += F.G) {
        const int rb = task & 7, cb = task >> 3;
        const int row0 = (rb < 4) ? rb * 64 : RB + (rb - 4) * 64, col0 = cb * 32;
        CG_PTRS(task + F.G, xgn, wgn);
        const int row = row0 + 16 * (wave >> 1) + li, col = col0 + 16 * (wave & 1) + 4 * lq;
        f32x4 xold = {0.f, 0.f, 0.f, 0.f}, gv = xold;
        if (RESID) { const u32x2 w_ = *(const u32x2*)(X + (size_t)row * ldc + col); xold = (f32x4){bf_lo(w_.x), bf_hi(w_.x), bf_lo(w_.y), bf_hi(w_.y)}; gv = *(const f32x4*)(gate + (size_t)2 * 12288 + col); }
        __builtin_amdgcn_sched_barrier(0);
        f32x4 acc[4][2];
#pragma unroll
        for (int m = 0; m < 4; ++m) { acc[m][0] = (f32x4){0.f, 0.f, 0.f, 0.f}; acc[m][1] = acc[m][0]; }
        CG_QUARTER(xa_, wa_, xg, wg, 2);
        CG_QUARTER(xb_, wb_, xg, wg, 3);
        CG_QUARTER(xa_, wa_, xgn, wgn, 0);
        CG_QUARTER(xb_, wb_, xgn, wgn, 1);
        xg = xgn; wg = wgn;
        __syncthreads();
#pragma unroll
        for (int m = 0; m < 4; ++m)
#pragma unroll
            for (int n = 0; n < 2; ++n)
#pragma unroll
                for (int r = 0; r < 4; ++r) red[(wave * 32 + (m * 2 + n) * 4 + r) * 64 + lane] = acc[m][n][r];
        __syncthreads();
        f32x4 sum = {0.f, 0.f, 0.f, 0.f};
#pragma unroll
        for (int w2 = 0; w2 < 8; ++w2)
#pragma unroll
            for (int r = 0; r < 4; ++r) sum[r] += red[(w2 * 32 + wave * 4 + r) * 64 + lane];
        if (RESID) { const f32x4 xn_ = xold + gv * sum; u32x2 o; o.x = pk2(xn_[0], xn_[1]); o.y = pk2(xn_[2], xn_[3]); *(u32x2*)(X + (size_t)row * ldc + col) = o; }
        else { u32x2 o; o.x = pk2(sum[0], sum[1]); o.y = pk2(sum[2], sum[3]); *(u32x2*)(O + (size_t)row * ldc + col) = o; }
        __syncthreads();
    }
#undef CG_QUARTER
#undef CG_LOAD
#undef CG_PTRS
    __syncthreads();
}

__device__ __forceinline__ void norm_phase(const Frame& F0, const bf16_t* xw, const float* g, const float* modl  , int off_sh, int off_sc, bf16_t* H, bool lat_only, unsigned* XQ = nullptr, float* XS = nullptr) {
    const Frame F = phase_frame(F0);
    f32x4 gm[8], shv[8]; int cur_cls = -1;
    int row = F.gw; if (lat_only) while (row < MROWS && row_cls(row) == 2) row += F.NGW;
    f32x4 v[8];
    if (row < MROWS) { const u32x2* x4 = (const u32x2*)(xw + (size_t)row * DM) + F.lane;
#pragma unroll
        for (int j = 0; j < 8; ++j) { const u32x2 w_ = x4[64 * j]; v[j] = (f32x4){bf_lo(w_.x), bf_hi(w_.x), bf_lo(w_.y), bf_hi(w_.y)}; } }
    while (row < MROWS) {
        int nrow = row + F.NGW; if (lat_only) while (nrow < MROWS && row_cls(nrow) == 2) nrow += F.NGW;
        f32x4 vn[8];
        if (nrow < MROWS) { const u32x2* x4 = (const u32x2*)(xw + (size_t)nrow * DM) + F.lane;
#pragma unroll
            for (int j = 0; j < 8; ++j) { const u32x2 w_ = x4[64 * j]; vn[j] = (f32x4){bf_lo(w_.x), bf_hi(w_.x), bf_lo(w_.y), bf_hi(w_.y)}; } }
        const int cls = row_cls(row);
        if (cls != cur_cls) {
            cur_cls = cls;
            const f32x4* g4 = (const f32x4*)g + F.lane; const f32x4* sc4 = (const f32x4*)(modl + (size_t)cls * NMOD + off_sc) + F.lane; const f32x4* sh4 = (const f32x4*)(modl + (size_t)cls * NMOD + off_sh) + F.lane;
#pragma unroll
            for (int j = 0; j < 8; ++j) { gm[j] = g4[64 * j] * (sc4[64 * j] + 1.0f); shv[j] = sh4[64 * j]; }
        }
        float ss = 0.f;
#pragma unroll
        for (int j = 0; j < 8; ++j) ss += (v[j].x * v[j].x + v[j].y * v[j].y) + (v[j].z * v[j].z + v[j].w * v[j].w);
        const float rstd = 1.0f / sqrtf(wave_sum_dpp(ss) * (1.f / DM) + EPS);
        u32x2* o2 = (u32x2*)(H + (size_t)row * DM) + F.lane;
#if PEER_MFMA
        if (XQ) {
            f32x4 yv[8]; float am = 0.f;
#pragma unroll
            for (int j = 0; j < 8; ++j) { const f32x4 y = (v[j] * rstd) * gm[j] + shv[j]; yv[j] = y; u32x2 o; o.x = pk2(y.x, y.y); o.y = pk2(y.z, y.w); o2[64 * j] = o;
                am = fmaxf(fmaxf(am, fmaxf(fabsf(y.x), fabsf(y.y))), fmaxf(fabsf(y.z), fabsf(y.w))); }
            am = fmaxf(am, DPP_MOV(am, 0xB1)); am = fmaxf(am, DPP_MOV(am, 0x4E)); am = fmaxf(am, DPP_MOV(am, 0x141)); am = fmaxf(am, DPP_MOV(am, 0x140));
            { const int ai = __builtin_bit_cast(int, am);
              am = fmaxf(fmaxf(__builtin_bit_cast(float, __builtin_amdgcn_readlane(ai, 0)), __builtin_bit_cast(float, __builtin_amdgcn_readlane(ai, 16))),
                         fmaxf(__builtin_bit_cast(float, __builtin_amdgcn_readlane(ai, 32)), __builtin_bit_cast(float, __builtin_amdgcn_readlane(ai, 48)))); }
            am = fmaxf(am, 1e-20f);
            const float qs = 440.0f / am;
            unsigned* q8 = XQ + (size_t)row * (DM / 4) + F.lane;
#pragma unroll
            for (int j = 0; j < 8; ++j) { const f32x4 y = yv[j] * qs; int pk = 0; pk = __builtin_amdgcn_cvt_pk_fp8_f32(y.x, y.y, pk, false); pk = __builtin_amdgcn_cvt_pk_fp8_f32(y.z, y.w, pk, true); q8[64 * j] = (unsigned)pk; }
            if (F.lane == 0) XS[row] = am * (1.0f / 440.0f);
        } else
#endif
        {
#pragma unroll
        for (int j = 0; j < 8; ++j) { const f32x4 y = (v[j] * rstd) * gm[j] + shv[j]; u32x2 o; o.x = pk2(y.x, y.y); o.y = pk2(y.z, y.w); o2[64 * j] = o;
            if (XQ) {
                float am = fmaxf(fmaxf(fabsf(y.x), fabsf(y.y)), fmaxf(fabsf(y.z), fabsf(y.w)));
                am = fmaxf(am, DPP_MOV(am, 0xB1)); am = fmaxf(am, DPP_MOV(am, 0x4E)); am = fmaxf(am, DPP_MOV(am, 0x141)); am = fmaxf(am, 1e-20f);
                const float qs = 119.0f / am; const float yy[4] = {y.x, y.y, y.z, y.w};
                unsigned pl = 0u, ph = 0u; int sq = 0;
#pragma unroll
                for (int i = 0; i < 4; ++i) { const int qi = __float2int_rn(yy[i] * qs); const int lo = ((qi + 8) & 15) - 8; const int hi = (qi - lo) >> 4; sq += qi; pl |= (unsigned)(lo & 15) << (4 * i); ph |= (unsigned)(hi & 15) << (4 * i); }
                const unsigned pl1 = (unsigned)__builtin_amdgcn_update_dpp(0, (int)pl, 0xB1, 0xf, 0xf, true), ph1 = (unsigned)__builtin_amdgcn_update_dpp(0, (int)ph, 0xB1, 0xf, 0xf, true);
                float sqf = (float)sq; sqf = DPP_ADD(sqf, 0xB1); sqf = DPP_ADD(sqf, 0x4E); sqf = DPP_ADD(sqf, 0x141);
                const int chunk = j * 8 + (F.lane >> 3), l8 = F.lane & 7;
                if ((l8 & 1) == 0) { unsigned* q = XQ + ((size_t)row * 64 + chunk) * 8 + (l8 >> 1); q[0] = ph | (ph1 << 16); q[4] = pl | (pl1 << 16); }
                if (l8 == 0) { float* s = XS + ((size_t)row * 64 + chunk) * 2; s[0] = am * (1.0f / 119.0f); s[1] = 0.5f * sqf; }
            } }
        }
        row = nrow;
#pragma unroll
        for (int j = 0; j < 8; ++j) v[j] = vn[j];
    }
}

__device__ __forceinline__ float row16_sum(float v) { v = DPP_ADD(v, 0xB1); v = DPP_ADD(v, 0x4E); v = DPP_ADD(v, 0x141); v = DPP_ADD(v, 0x140); return v; }
__device__ __forceinline__ void prep_odd_phase(const Frame& F0, const bf16_t* P, const float* qg, const float* kg, const float* rope_c, bf16_t* Q, bf16_t* Kb) {
    const Frame F = phase_frame(F0);
    const int l16 = F.lane & 15, d0 = l16 * 8;
    float gq[8], gk[8];
#pragma unroll
    for (int e = 0; e < 8; ++e) { gq[e] = qg[d0 + e]; gk[e] = kg[d0 + e]; }
    const bool lowhalf = l16 < 8;
    const int j0 = (l16 & 7) * 8;
    int row = F.gw;
    u32x4 w[5];
    if (row < MROWS) { const u32x4* pr = (const u32x4*)(P + (size_t)row * 3072) + F.lane;
#pragma unroll
        for (int k = 0; k < 5; ++k) w[k] = pr[64 * k]; }
    while (row < MROWS) {
        const int nrow = row + F.NGW;
        u32x4 wn[5];
        if (nrow < MROWS) { const u32x4* pr = (const u32x4*)(P + (size_t)nrow * 3072) + F.lane;
#pragma unroll
            for (int k = 0; k < 5; ++k) wn[k] = pr[64 * k]; }
        const int b = row / RB, i = row - b * RB; const bool lat = i >= CTX; const int t = i - CTX;
        float cs[8], sn[8];
#pragma unroll
        for (int e = 0; e < 8; ++e) { cs[e] = 1.f; sn[e] = 0.f; }
        if (lat) { const int pos = (j0 < 32) ? (t >> 6) : (t & 63); const f32x4* tb = (const f32x4*)(rope_c + ((pos << 5) + (j0 & 31)) * 2);
#pragma unroll
            for (int q = 0; q < 4; ++q) { const f32x4 c = tb[q]; cs[2 * q] = c.x; sn[2 * q] = c.y; cs[2 * q + 1] = c.z; sn[2 * q + 1] = c.w; } }
#pragma unroll
        for (int k = 0; k < 5; ++k) {
            const unsigned ww[4] = {w[k].x, w[k].y, w[k].z, w[k].w};
            float x[8]; float ss = 0.f;
#pragma unroll
            for (int q = 0; q < 4; ++q) { x[2 * q] = bf_lo(ww[q]); x[2 * q + 1] = bf_hi(ww[q]); ss += x[2 * q] * x[2 * q] + x[2 * q + 1] * x[2 * q + 1]; }
            const float rstd = 1.0f / sqrtf(row16_sum(ss) * (1.f / 128.f) + EPS);
            unsigned ow[4]; float o[8];
#pragma unroll
            for (int e = 0; e < 8; ++e) { const float y = x[e] * rstd * (k < 4 ? gq[e] : gk[e]); const float yp = DPP_MOV(y, 0x128);
                o[e] = lowhalf ? (y * cs[e] - yp * sn[e]) : (y * cs[e] + yp * sn[e]); }
#pragma unroll
            for (int q = 0; q < 4; ++q) ow[q] = pk2(o[2 * q], o[2 * q + 1]);
            if (k < 4) *((u32x4*)(Q + (size_t)row * 2048) + 64 * k + F.lane) = (u32x4){ow[0], ow[1], ow[2], ow[3]};
            else *((u32x4*)(Kb + (size_t)row * 512) + F.lane) = (u32x4){ow[0], ow[1], ow[2], ow[3]};
        }
        row = nrow;
#pragma unroll
        for (int k = 0; k < 5; ++k) w[k] = wn[k];
    }
}

struct PrepEvenRow { u32x4 cq; u32x2 ckv, kr; u32x4 qn[2]; u32x2 qr[2]; u32x4 kn[2], vv[2]; };
__device__ __forceinline__ void prep_even_load(PrepEvenRow& R, const bf16_t* P, const bf16_t* QR, const bf16_t* KVR, int row, int lane) {
    const bf16_t* pr = P + (size_t)row * 4096; const int l16 = lane & 15, hq = lane >> 4;
    R.cq = *((const u32x4*)pr + lane); R.ckv = *((const u32x2*)(pr + 512) + lane); R.kr = *((const u32x2*)(pr + 768) + l16);
    const bf16_t* q = QR + (size_t)row * 1536; const bf16_t* kv = KVR + (size_t)row * 2048;
#pragma unroll
    for (int k = 0; k < 2; ++k) { R.qn[k] = *((const u32x4*)q + 64 * k + lane); R.qr[k] = *((const u32x2*)(q + 1024) + 64 * k + lane);
        const bf16_t* kh = kv + (4 * k + hq) * 256 + l16 * 8; R.kn[k] = *(const u32x4*)kh; R.vv[k] = *(const u32x4*)(kh + 128); }
}
__device__ __forceinline__ void prep_even_phase(const Frame& F0, const bf16_t* P, const bf16_t* QR, const bf16_t* KVR, const float* qg, const float* kg, const float* rope_a, bf16_t* Q, bf16_t* Kb, bf16_t* Vb) {
    const Frame F = phase_frame(F0);
    const int lane = F.lane, l16 = lane & 15, hq = lane >> 4, d0 = l16 * 8, r0 = l16 * 4;
    float gqn[8], gkn[8], gqr[4], gkr[4];
#pragma unroll
    for (int e = 0; e < 8; ++e) { gqn[e] = qg[d0 + e]; gkn[e] = kg[d0 + e]; }
#pragma unroll
    for (int e = 0; e < 4; ++e) { gqr[e] = qg[128 + r0 + e]; gkr[e] = kg[128 + r0 + e]; }
    const bool lowhalf = l16 < 8; const int j0 = (l16 & 7) * 4;
    int row = F.gw;
    PrepEvenRow R;
    if (row < MROWS) prep_even_load(R, P, QR, KVR, row, lane);
    while (row < MROWS) {
        const int nrow = row + F.NGW;
        PrepEvenRow Rn;
        if (nrow < MROWS) prep_even_load(Rn, P, QR, KVR, nrow, lane);
        const int b = row / RB, i = row - b * RB; const bool lat = i >= CTX; const int t = i - CTX;
        float cs[4], sn[4];
#pragma unroll
        for (int e = 0; e < 4; ++e) { cs[e] = 1.f; sn[e] = 0.f; }
        if (lat) { const int pos = (j0 < 16) ? (t >> 6) : (t & 63); const f32x4* tb = (const f32x4*)(rope_a + ((pos << 4) + (j0 & 15)) * 2);
            const f32x4 c0 = tb[0], c1 = tb[1]; cs[0] = c0.x; sn[0] = c0.y; cs[1] = c0.z; sn[1] = c0.w; cs[2] = c1.x; sn[2] = c1.y; cs[3] = c1.z; sn[3] = c1.w; }
        float ssq = 0.f, sskv = 0.f;
        { const unsigned ww[4] = {R.cq.x, R.cq.y, R.cq.z, R.cq.w};
#pragma unroll
          for (int q = 0; q < 4; ++q) { const float a = bf_lo(ww[q]), c = bf_hi(ww[q]); ssq += a * a + c * c; } }
        { const float a = bf_lo(R.ckv.x), c = bf_hi(R.ckv.x), d = bf_lo(R.ckv.y), e = bf_hi(R.ckv.y); sskv = (a * a + c * c) + (d * d + e * e); }
        const float rstd_q = 1.0f / sqrtf(wave_sum_dpp(ssq) * (1.f / 512.f) + EPS), rstd_kv = 1.0f / sqrtf(wave_sum_dpp(sskv) * (1.f / 256.f) + EPS);
        const float krv[4] = {bf_lo(R.kr.x), bf_hi(R.kr.x), bf_lo(R.kr.y), bf_hi(R.kr.y)};
        const float krss = (krv[0] * krv[0] + krv[1] * krv[1]) + (krv[2] * krv[2] + krv[3] * krv[3]);
#pragma unroll
        for (int k = 0; k < 2; ++k) {
            const int h = 4 * k + hq;
            {
                const unsigned wn[4] = {R.qn[k].x, R.qn[k].y, R.qn[k].z, R.qn[k].w};
                float xn[8], xr[4]; float ss = 0.f;
#pragma unroll
                for (int q = 0; q < 4; ++q) { xn[2 * q] = bf_lo(wn[q]) * rstd_q; xn[2 * q + 1] = bf_hi(wn[q]) * rstd_q; ss += xn[2 * q] * xn[2 * q] + xn[2 * q + 1] * xn[2 * q + 1]; }
                xr[0] = bf_lo(R.qr[k].x) * rstd_q; xr[1] = bf_hi(R.qr[k].x) * rstd_q; xr[2] = bf_lo(R.qr[k].y) * rstd_q; xr[3] = bf_hi(R.qr[k].y) * rstd_q;
                ss += (xr[0] * xr[0] + xr[1] * xr[1]) + (xr[2] * xr[2] + xr[3] * xr[3]);
                const float r2 = 1.0f / sqrtf(row16_sum(ss) * (1.f / 192.f) + EPS);
                unsigned on[4]; float o[4];
#pragma unroll
                for (int q = 0; q < 4; ++q) on[q] = pk2(xn[2 * q] * r2 * gqn[2 * q], xn[2 * q + 1] * r2 * gqn[2 * q + 1]);
#pragma unroll
                for (int e = 0; e < 4; ++e) { const float y = xr[e] * r2 * gqr[e]; const float yp = DPP_MOV(y, 0x128); o[e] = lowhalf ? (y * cs[e] - yp * sn[e]) : (y * cs[e] + yp * sn[e]); }
                bf16_t* qo = Q + (size_t)row * 1536 + h * 192;
                *(u32x4*)(qo + d0) = (u32x4){on[0], on[1], on[2], on[3]};
                *(u32x2*)(qo + 128 + r0) = (u32x2){pk2(o[0], o[1]), pk2(o[2], o[3])};
            }
            {
                const unsigned wn[4] = {R.kn[k].x, R.kn[k].y, R.kn[k].z, R.kn[k].w}, wv[4] = {R.vv[k].x, R.vv[k].y, R.vv[k].z, R.vv[k].w};
                float xn[8]; float ss = krss;
#pragma unroll
                for (int q = 0; q < 4; ++q) { xn[2 * q] = bf_lo(wn[q]) * rstd_kv; xn[2 * q + 1] = bf_hi(wn[q]) * rstd_kv; ss += xn[2 * q] * xn[2 * q] + xn[2 * q + 1] * xn[2 * q + 1]; }
                const float r2 = 1.0f / sqrtf(row16_sum(ss) * (1.f / 192.f) + EPS);
                unsigned on[4], ov[4]; float o[4];
#pragma unroll
                for (int q = 0; q < 4; ++q) { on[q] = pk2(xn[2 * q] * r2 * gkn[2 * q], xn[2 * q + 1] * r2 * gkn[2 * q + 1]); ov[q] = pk2(bf_lo(wv[q]) * rstd_kv, bf_hi(wv[q]) * rstd_kv); }
#pragma unroll
                for (int e = 0; e < 4; ++e) { const float y = krv[e] * r2 * gkr[e]; const float yp = DPP_MOV(y, 0x128); o[e] = lowhalf ? (y * cs[e] - yp * sn[e]) : (y * cs[e] + yp * sn[e]); }
                bf16_t* ko = Kb + (size_t)row * 1536 + h * 192;
                *(u32x4*)(ko + d0) = (u32x4){on[0], on[1], on[2], on[3]};
                *(u32x2*)(ko + 128 + r0) = (u32x2){pk2(o[0], o[1]), pk2(o[2], o[3])};
                *(u32x4*)(Vb + (size_t)row * 1024 + h * 128 + d0) = (u32x4){ov[0], ov[1], ov[2], ov[3]};
            }
        }
        row = nrow; R = Rn;
    }
}

__device__ __forceinline__ void conv_phase(const Frame& F0, const bf16_t* P, const float* cw  , const float* cb  , bf16_t* CAT) {
    const Frame F = phase_frame(F0);
    const int gt = F.vcu * NTHREADS + F.tid, GT = F.G * NTHREADS;
    for (int it = gt; it < MROWS * 128; it += GT) {
        const int row = it >> 7, c0 = (it & 127) * 8; const int b = row / RB, i = row - b * RB;
        const bool first = (i == 0) || (i == CTX), last = (i == CTX - 1) || (i == RB - 1);
        const bf16_t* pr = P + (size_t)row * 4096 + 832 + c0;
        const u32x4 bg = *(const u32x4*)pr, cg = *(const u32x4*)(pr + 1024), hz = *(const u32x4*)(pr + 2048);
        u32x4 cgm = {0u, 0u, 0u, 0u}, hzm = cgm, cgp = cgm, hzp = cgm;
        if (!first) { cgm = *(const u32x4*)(pr - 4096 + 1024); hzm = *(const u32x4*)(pr - 4096 + 2048); }
        if (!last) { cgp = *(const u32x4*)(pr + 4096 + 1024); hzp = *(const u32x4*)(pr + 4096 + 2048); }
        const unsigned bgw[4] = {bg.x, bg.y, bg.z, bg.w}, cgw[4] = {cg.x, cg.y, cg.z, cg.w}, hzw[4] = {hz.x, hz.y, hz.z, hz.w};
        const unsigned cmw[4] = {cgm.x, cgm.y, cgm.z, cgm.w}, hmw[4] = {hzm.x, hzm.y, hzm.z, hzm.w}, cpw[4] = {cgp.x, cgp.y, cgp.z, cgp.w}, hpw[4] = {hzp.x, hzp.y, hzp.z, hzp.w};
        unsigned ow[4];
#pragma unroll
        for (int q = 0; q < 4; ++q) {
            const int c = c0 + 2 * q;
            const float u0a = bf_lo(cgw[q]) * bf_lo(hzw[q]), u0b = bf_hi(cgw[q]) * bf_hi(hzw[q]);
            const float uma = bf_lo(cmw[q]) * bf_lo(hmw[q]), umb = bf_hi(cmw[q]) * bf_hi(hmw[q]);
            const float upa = bf_lo(cpw[q]) * bf_lo(hpw[q]), upb = bf_hi(cpw[q]) * bf_hi(hpw[q]);
            const float ra = bf_lo(bgw[q]) * (uma * cw[c] + u0a * cw[1024 + c] + upa * cw[2048 + c] + cb[c]);
            const float rb = bf_hi(bgw[q]) * (umb * cw[c + 1] + u0b * cw[1024 + c + 1] + upb * cw[2048 + c + 1] + cb[c + 1]);
            ow[q] = pk2(ra, rb);
        }
        *(u32x4*)(CAT + (size_t)row * DM + 1024 + c0) = (u32x4){ow[0], ow[1], ow[2], ow[3]};
    }
}
__device__ __forceinline__ void attn_even_phase(const Frame& F0, const bf16_t* Q, const bf16_t* Kb, const bf16_t* Vb, bf16_t* CAT, int bgl = -1) {
    const Frame F = phase_frame(F0);
    for (int u = F.vcu; u < 272; u += F.G) {
        int b, h, qt, nk;
        if (u < 256) { b = u >> 7; h = (u >> 4) & 7; qt = 1 + (u & 15); nk = RB; } else { const int v = u - 256; b = v >> 3; h = v & 7; qt = 0; nk = CTX; }
        const size_t r0 = (size_t)b * RB;
        att::attn_body2g<192, 1536, 1536, 1024, 2048>(Q + (r0 + qt * 256) * 1536 + h * 192, Kb + r0 * 1536 + h * 192, Vb + r0 * 1024 + h * 128, CAT + (r0 + qt * 256) * 2048 + h * 128, nk, (char*)F.lds, phase_tid(F.wave));
    }    if (bgl >= 0 && F.G == 256 && F.vcu >= 16) tab_deferred_u_rows(F0, bgl, (F.vcu - 16) * NWAVES + F.wave, TAB_DEFA_EVEN);
}
__device__ __forceinline__ void attn_odd_phase(const Frame& F0, const bf16_t* Q, const bf16_t* Kb, const bf16_t* P, bf16_t* CAT, bool lat_only, int bgl = -1) {
    const Frame F = phase_frame(F0);
    const int nunits = lat_only ? 512 : 544;
    for (int u = F.vcu; u < nunits; u += F.G) {
        int b, hq, qt, nk;
        if (u < 512) { b = u >> 8; hq = (u >> 4) & 15; qt = 1 + (u & 15); nk = RB; } else { const int v = u - 512; b = v >> 4; hq = v & 15; qt = 0; nk = CTX; }
        const int kvh = hq >> 2; const size_t r0 = (size_t)b * RB;
        att::attn_body2g<128, 2048, 512, 3072, 2048>(Q + (r0 + qt * 256) * 2048 + hq * 128, Kb + r0 * 512 + kvh * 128, P + r0 * 3072 + 2560 + kvh * 128, CAT + (r0 + qt * 256) * 2048 + hq * 128, nk, (char*)F.lds, phase_tid(F.wave));
    }    if (bgl == 1 && F.G == 256 && !lat_only && F.vcu >= 32) tab_deferred_u_rows(F0, 1, (F.vcu - 32) * NWAVES + F.wave, TAB_DEFA_ODD);
}

__device__ __forceinline__ int crow32(int r, int hi) { return (r & 3) + 8 * (r >> 2) + 4 * hi; }
__device__ __forceinline__ int fkey(int b) { return b ^ ((b >> 31) & 0x7fffffff); }
#define TK_CE(x, y) do { const int hi_ = max((x), (y)), lo_ = min((x), (y)); (x) = hi_; (y) = lo_; } while (0)
template <int N> __device__ __forceinline__ void tk_sort(int* v) {
#pragma unroll
    for (int k = 2; k <= N; k <<= 1)
#pragma unroll
        for (int j = k >> 1; j > 0; j >>= 1)
#pragma unroll
            for (int i = 0; i < N; ++i) { const int l = i ^ j; if (l > i) { if ((i & k) == 0) TK_CE(v[i], v[l]); else TK_CE(v[l], v[i]); } }
}
__device__ __forceinline__ void tk_merge16(int* a, const int* b) {
#pragma unroll
    for (int i = 0; i < 16; ++i) a[i] = max(a[i], b[15 - i]);
#pragma unroll
    for (int j = 8; j > 0; j >>= 1)
#pragma unroll
        for (int i = 0; i < 16; ++i) { const int l = i ^ j; if (l > i) TK_CE(a[i], a[l]); }
}
__device__ __forceinline__ void tk_merge_partner(int* a) {
    int lo[16], hi[16];
#pragma unroll
    for (int i = 0; i < 16; ++i) { auto rr = __builtin_amdgcn_permlane32_swap((unsigned)a[i], (unsigned)a[i], false, false); lo[i] = (int)rr[0]; hi[i] = (int)rr[1]; }
    tk_merge16(lo, hi);
#pragma unroll
    for (int i = 0; i < 16; ++i) a[i] = lo[i];
}
__device__ __forceinline__ void peer_topk_phase(const Frame& F0, const bf16_t* PQ, const bf16_t* subk  , int* IDX, float* GATE, bool lat_only) {
    const Frame F = phase_frame(F0);
    const int h = F.vcu & 7, jw = (F.vcu >> 3) * NWAVES + F.wave, nwh = (F.G >> 3) * NWAVES;
    {
        const bf16_t* src = subk + (size_t)h * 2 * 128 * 128;
        for (int c = F.tid; c < 4096; c += NTHREADS) { const int row = c >> 4, ch = c & 15;
            *(LAS u32x4*)(F.lds + row * 256 + ((ch ^ (row & 15)) << 4)) = *(const u32x4*)(src + (size_t)row * 128 + ch * 8); }
        __syncthreads();
    }
    const int ntg = lat_only ? 256 : MROWS / 32;
    const bool spread = (nwh == 256) && !lat_only;
    for (int kr = 0; ; ++kr) {
        int t;
        if (!spread) { t = jw + kr * nwh; if (t >= ntg) break; }
        else { if (kr == 0) t = jw; else if (kr == 1 && F.wave == 0 && (F.vcu >> 3) < ntg - 256) t = 256 + (F.vcu >> 3); else break; }
        int lane_ = F.lane; asm volatile("" : "+v"(lane_));
        const int r32 = lane_ & 31, hi = lane_ >> 5;
        int tg = t; if (lat_only) tg += 8 + (tg >= 128 ? 8 : 0);
        const int token = tg * 32 + r32;
        int top[2][16];
        const int kk = (((r32 & 14) | (hi ^ (r32 & 1))) << 4);
#pragma unroll
        for (int p = 0; p < 2; ++p) {
            bf16x8 bq[8];
            const bf16_t* qp = PQ + (size_t)token * DM + h * 256 + p * 128 + hi * 8;
#pragma unroll
            for (int ks = 0; ks < 8; ++ks) bq[ks] = *(const bf16x8*)(qp + ks * 16);
            int s[4][16];
#pragma unroll
            for (int nb = 0; nb < 4; ++nb) {
                f32x16 acc = {};
                const LAS unsigned char* kp = F.lds + (p * 128 + nb * 32 + r32) * 256;
#pragma unroll
                for (int ks = 0; ks < 8; ++ks) { const bf16x8 a = *(const LAS bf16x8*)(kp + (kk ^ (ks << 5))); acc = __builtin_amdgcn_mfma_f32_32x32x16_bf16(a, bq[ks], acc, 0, 0, 0); }
#pragma unroll
                for (int r = 0; r < 16; ++r) { const int key = nb * 32 + crow32(r, hi); s[nb][r] = fkey((int)((__float_as_uint(acc[r]) & ~127u) | (unsigned)(127 - key))); }
                tk_sort<16>(s[nb]);
            }
            tk_merge16(s[0], s[1]); tk_merge16(s[2], s[3]); tk_merge16(s[0], s[2]);
            tk_merge_partner(s[0]);
#pragma unroll
            for (int j = 0; j < 16; ++j) top[p][j] = s[0][j];
        }
        int cand[32];
        unsigned long long kaLo = 0ull, kaHi = 0ull, kbLo = 0ull, kbHi = 0ull;
        {
            float fb[16]; const float fa0 = __uint_as_float((unsigned)fkey(top[0][0]) & ~127u), fb0 = __uint_as_float((unsigned)fkey(top[1][0]) & ~127u);
#pragma unroll
            for (int r = 0; r < 16; ++r) { const int ba = fkey(top[0][r]), bb = fkey(top[1][r]); fb[r] = __uint_as_float((unsigned)bb & ~127u) - fb0;
                const unsigned long long xa = (unsigned long long)(unsigned)(127 - (ba & 127)) << (8 * (r & 7)), xb = (unsigned long long)(unsigned)(127 - (bb & 127)) << (8 * (r & 7));
                if (r < 8) { kaLo |= xa; kbLo |= xb; } else { kaHi |= xa; kbHi |= xb; } }
            float fa[8];
#pragma unroll
            for (int i = 0; i < 8; ++i) { const int ka = hi ? top[0][2 * i + 1] : top[0][2 * i]; fa[i] = __uint_as_float((unsigned)fkey(ka) & ~127u) - fa0; }
            const int hid = 255 - (hi << 4);
            int n = 0;
#pragma unroll
            for (int i = 0; i < 8; ++i)
#pragma unroll
                for (int b = 0; b < 16; ++b) if ((2 * i + 1) * (b + 1) <= 16) {
                    const float sum = fa[i] + fb[b];
                    cand[n++] = fkey((int)((__float_as_uint(sum) & ~255u) | (unsigned)(hid - (32 * i + b))));
                }
#pragma unroll
            for (; n < 32; ++n) cand[n] = (int)0x80000000;
        }
        tk_sort<16>(cand); tk_sort<16>(cand + 16); tk_merge16(cand, cand + 16);
        tk_merge_partner(cand);
        float ev[16]; float esum = 0.f;
#pragma unroll
        for (int j = 0; j < 16; ++j) { ev[j] = __expf(__uint_as_float((unsigned)fkey(cand[j]) & ~255u)); esum += ev[j]; }
        const float rs = 1.0f / esum;
        int oi[8]; float og[8];
#pragma unroll
        for (int j = 0; j < 8; ++j) { const int w = hi ? cand[8 + j] : cand[j]; const float e = hi ? ev[8 + j] : ev[j];
            const int id8 = 255 - (fkey(w) & 255), ra = id8 >> 4, rb = id8 & 15;
            const unsigned long long wa = (ra & 8) ? kaHi : kaLo, wb = (rb & 8) ? kbHi : kbLo;
            const int ka = (int)(wa >> (8 * (ra & 7))) & 127, kb = (int)(wb >> (8 * (rb & 7))) & 127;
            oi[j] = ka * 128 + kb; og[j] = e * rs; }
        int* ip = IDX + (size_t)token * 128 + h * 16 + hi * 8; float* gp = GATE + (size_t)token * 128 + h * 16 + hi * 8;
        *(int4*)ip = make_int4(oi[0], oi[1], oi[2], oi[3]); *(int4*)(ip + 4) = make_int4(oi[4], oi[5], oi[6], oi[7]);
        *(f32x4*)gp = (f32x4){og[0], og[1], og[2], og[3]}; *(f32x4*)(gp + 4) = (f32x4){og[4], og[5], og[6], og[7]};
    }
}

#if TAB_FP4
__device__ __forceinline__ void peer_expert_phase(const Frame& F0, const bf16_t* H2, const int* IDX, const float* GATE, const unsigned char* U, size_t v_minus_u_bytes, const float* USC, const float* VSC,
                                                  const float* g2  , float* XW, float* OUT,
                                                  bf16_t* HN  , const float* ng  , const float* nmod  ) {
    const Frame F = phase_frame(F0);
    LAS float* red = (LAS float*)F.lds;
    const unsigned voff_tab = (unsigned)v_minus_u_bytes;
    const __amdgpu_buffer_rsrc_t rs = __builtin_amdgcn_make_buffer_rsrc((void*)U, 0, (int)(voff_tab + (unsigned)NEXP * ROWB), 0x00020000);
    const int lane = F.lane; const int voff = lane * 16;
#define PX_SB() __builtin_amdgcn_sched_barrier(0)
#define PX_LOADALL(buf, ivv, tb) do { _Pragma("unroll") for (int e_ = 0; e_ < 16; ++e_) buf[e_] = __builtin_amdgcn_raw_buffer_load_b128(rs, voff, (unsigned)__builtin_amdgcn_readlane(ivv, e_) * (unsigned)ROWB + (tb), 0); } while (0)
#define PX_U1(d_, b_) { const bf16x2_t r2_ = __builtin_amdgcn_cvt_scalef32_pk_bf16_fp4(wd_[d_], 1.0f, b_); if ((b_) & 1) a1_ = __builtin_amdgcn_fdot2_f32_bf16(r2_, __builtin_bit_cast(bf16x2_t, xpk[4 * (d_) + (b_)]), a1_, false); \
                        else a0_ = __builtin_amdgcn_fdot2_f32_bf16(r2_, __builtin_bit_cast(bf16x2_t, xpk[4 * (d_) + (b_)]), a0_, false); }
#define PX_V1(d_, b_) { const f32x2 t2_ = __builtin_amdgcn_cvt_scalef32_pk_f32_fp4(wd_[d_], 1.0f, b_); acc[8 * (d_) + 2 * (b_)] += wg_ * t2_.x; acc[8 * (d_) + 2 * (b_) + 1] += wg_ * t2_.y; }
#define PX_FETCH_TOKEN(r, XP, IV, GV) do { const u32x4* xp_ = (const u32x4*)(H2 + (size_t)(r) * DM + lane * 16); XP[0] = xp_[0]; XP[1] = xp_[1]; XP[2] = xp_[128]; XP[3] = xp_[129]; \
        IV = 0; GV = 0.f; if (lane < 16) { IV = IDX[(size_t)(r) * 128 + F.wave * 16 + lane]; GV = GATE[(size_t)(r) * 128 + F.wave * 16 + lane]; } } while (0)
    const bool skip_ctx = (OUT != nullptr);
    int row = F.vcu; if (skip_ctx && row < MROWS && row_cls(row) == 2) row += F.G;
    u32x4 xp[4]; int iv; float gv;
    u32x4 ub[16], vb[16];
    if (row < MROWS) { PX_FETCH_TOKEN(row, xp, iv, gv); PX_LOADALL(ub, iv, 0u); PX_LOADALL(vb, iv, voff_tab); }
    int par = 0;
    while (row < MROWS) {
        int nrow = row + F.G; if (skip_ctx && nrow < MROWS && row_cls(nrow) == 2) nrow += F.G;
        float usc = 0.f, vsc = 0.f;
        if (lane < 16) { usc = USC[iv]; vsc = VSC[iv]; }
        u32x4 xpn[4]; int ivn = 0; float gvn = 0.f;
        if (nrow < MROWS) PX_FETCH_TOKEN(nrow, xpn, ivn, gvn);
        const int cls = row_cls(row);
        const f32x4 x_old = *((const f32x4*)(XW + (size_t)row * DM) + F.tid), g_vec = *((const f32x4*)(g2 + (size_t)cls * NMOD) + F.tid);
        f32x4 n_g = {0.f, 0.f, 0.f, 0.f}, n_sc = n_g, n_sh = n_g;
        if (HN) { n_g = *((const f32x4*)ng + F.tid); n_sc = *((const f32x4*)(nmod + (size_t)cls * NMOD + 2048) + F.tid); n_sh = *((const f32x4*)(nmod + (size_t)cls * NMOD) + F.tid); }
        const unsigned xpk[16] = {xp[0].x, xp[0].y, xp[0].z, xp[0].w, xp[1].x, xp[1].y, xp[1].z, xp[1].w, xp[2].x, xp[2].y, xp[2].z, xp[2].w, xp[3].x, xp[3].y, xp[3].z, xp[3].w};
        float sv = 0.f;
        PX_SB();
#pragma unroll
        for (int e = 0; e < 16; ++e) {
            u32x4 w_ = ub[e]; asm volatile("" : "+v"(w_) : "v"(sv));
            const unsigned wd_[4] = {w_.x, w_.y, w_.z, w_.w}; float a0_ = 0.f, a1_ = 0.f;
            PX_U1(0, 0) PX_U1(0, 1) PX_U1(0, 2) PX_U1(0, 3) PX_U1(1, 0) PX_U1(1, 1) PX_U1(1, 2) PX_U1(1, 3) PX_U1(2, 0) PX_U1(2, 1) PX_U1(2, 2) PX_U1(2, 3) PX_U1(3, 0) PX_U1(3, 1) PX_U1(3, 2) PX_U1(3, 3)
            const float t_ = wave_sum_dpp(a0_ + a1_); sv = (lane == e) ? t_ : sv;
        }
        const float wv = gelu_erf(sv * usc) * gv * vsc;
        PX_SB();
        if (nrow < MROWS) PX_LOADALL(ub, ivn, 0u);
        PX_SB();
        f32x32 acc = {};
#pragma unroll
        for (int e = 0; e < 16; ++e) {
            u32x4 w_ = vb[e]; asm volatile("" : "+v"(w_) : "v"(acc));
            const unsigned wd_[4] = {w_.x, w_.y, w_.z, w_.w}; const float wg_ = __uint_as_float(__builtin_amdgcn_readlane(__float_as_uint(wv), e));
            PX_V1(0, 0) PX_V1(0, 1) PX_V1(0, 2) PX_V1(0, 3) PX_V1(1, 0) PX_V1(1, 1) PX_V1(1, 2) PX_V1(1, 3) PX_V1(2, 0) PX_V1(2, 1) PX_V1(2, 2) PX_V1(2, 3) PX_V1(3, 0) PX_V1(3, 1) PX_V1(3, 2) PX_V1(3, 3)
        }
        PX_SB();
        if (nrow < MROWS) PX_LOADALL(vb, ivn, voff_tab);
        PX_SB();
        LAS float* rb = red + par * (NWAVES * DM);
#pragma unroll
        for (int j = 0; j < 2; ++j)
#pragma unroll
            for (int q = 0; q < 4; ++q) *(LAS f32x4*)(rb + F.wave * DM + j * 1024 + lane * 16 + q * 4) = (f32x4){acc[j * 16 + q * 4], acc[j * 16 + q * 4 + 1], acc[j * 16 + q * 4 + 2], acc[j * 16 + q * 4 + 3]};
        __syncthreads();
        {
            f32x4 sm = {0.f, 0.f, 0.f, 0.f};
#pragma unroll
            for (int w = 0; w < 8; ++w) sm += *(const LAS f32x4*)(rb + w * DM + F.tid * 4);
            f32x4* xq = (f32x4*)(XW + (size_t)row * DM) + F.tid;
            const f32x4 xn = x_old + g_vec * sm;
            *xq = xn;
            if (OUT) { const int b = row / RB, i = row - b * RB; if (i >= CTX) *((f32x4*)(OUT + ((size_t)b * SEQ + (i - CTX)) * DM) + F.tid) = xn; }
            if (HN) {
                LAS float* ssp = (LAS float*)(F.lds + 131072) + par * 8;
                const float sw = wave_sum_dpp((xn.x * xn.x + xn.y * xn.y) + (xn.z * xn.z + xn.w * xn.w));
                if (lane == 0) ssp[F.wave] = sw;
                __syncthreads();
                const float tot = ((ssp[0] + ssp[1]) + (ssp[2] + ssp[3])) + ((ssp[4] + ssp[5]) + (ssp[6] + ssp[7]));
                const float rstd = 1.0f / sqrtf(tot * (1.f / DM) + EPS);
                const f32x4 y = (xn * rstd) * n_g * (n_sc + 1.0f) + n_sh;
                u32x2 o; o.x = pk2(y.x, y.y); o.y = pk2(y.z, y.w);
                *((u32x2*)(HN + (size_t)row * DM) + F.tid) = o;
            }
        }
        par ^= 1; row = nrow;
#pragma unroll
        for (int q = 0; q < 4; ++q) xp[q] = xpn[q];
        iv = ivn; gv = gvn;
    }
#undef PX_LOADALL
#undef PX_U1
#undef PX_V1
#undef PX_SB
#undef PX_FETCH_TOKEN
}
#else
__device__ __forceinline__ void peer_expert_phase(const Frame& F0, const bf16_t* H2, const int* IDX, const float* GATE, const unsigned char* U, size_t v_minus_u_bytes, const float* USC, const float* VSC,
                                                  const float* g2  , float* XW, float* OUT,
                                                  bf16_t* HN  , const float* ng  , const float* nmod  ) {
    const Frame F = phase_frame(F0);
    LAS float* red = (LAS float*)F.lds;
    const unsigned voff_tab = (unsigned)v_minus_u_bytes;
    const __amdgpu_buffer_rsrc_t rs = __builtin_amdgcn_make_buffer_rsrc((void*)U, 0, (int)(voff_tab + (unsigned)NEXP * ROWB), 0x00020000);
    const int lane = F.lane; const int voff = lane * 16, voff2 = 1024 + lane * 8;
#define PX_SB() __builtin_amdgcn_sched_barrier(0)
#define PX_LOAD(buf, s, ivv) do { constexpr int e0_ = ((s) & 3) * 4; const unsigned tb_ = ((s) >= 4) ? voff_tab : 0u; \
        _Pragma("unroll") for (int ee_ = 0; ee_ < 4; ++ee_) { const unsigned o_ = (unsigned)__builtin_amdgcn_readlane(ivv, e0_ + ee_) * (unsigned)ROWB + tb_; \
            buf##h[ee_] = __builtin_amdgcn_raw_buffer_load_b128(rs, voff, o_, 0); buf##l[ee_] = __builtin_amdgcn_raw_buffer_load_b64(rs, voff2, o_, 0); } } while (0)
#define PX_DECODE(buf, ee_, dep) u32x6 w6_ = {buf##h[ee_].x, buf##h[ee_].y, buf##h[ee_].z, buf##h[ee_].w, buf##l[ee_].x, buf##l[ee_].y}; \
        asm volatile("" : "+v"(w6_) : "v"(dep));     \
        const f32x32 r_ = __builtin_amdgcn_cvt_scalef32_pk32_f32_fp6(w6_, 1.0f);
#define PX_COMP_U(buf, s) do { constexpr int e0_ = ((s) & 3) * 4; \
            _Pragma("unroll") for (int ee_ = 0; ee_ < 4; ++ee_) { PX_DECODE(buf, ee_, sv) \
                const f32x32 p_ = r_ * xf; float a0_ = 0.f, a1_ = 0.f; \
                _Pragma("unroll") for (int k_ = 0; k_ < 32; k_ += 2) { a0_ += p_[k_]; a1_ += p_[k_ + 1]; } \
                const float t_ = wave_sum_dpp(a0_ + a1_); sv = (lane == e0_ + ee_) ? t_ : sv; } } while (0)
#define PX_COMP_V(buf, s) do { constexpr int e0_ = ((s) & 3) * 4; \
            _Pragma("unroll") for (int ee_ = 0; ee_ < 4; ++ee_) { const float wg_ = __uint_as_float(__builtin_amdgcn_readlane(__float_as_uint(wv), e0_ + ee_)); \
                PX_DECODE(buf, ee_, acc) \
                acc += r_ * wg_; } } while (0)
#define PX_FETCH_TOKEN(r, XP, IV, GV) do { const u32x4* xp_ = (const u32x4*)(H2 + (size_t)(r) * DM + lane * 16); XP[0] = xp_[0]; XP[1] = xp_[1]; XP[2] = xp_[128]; XP[3] = xp_[129]; \
        IV = 0; GV = 0.f; if (lane < 16) { IV = IDX[(size_t)(r) * 128 + F.wave * 16 + lane]; GV = GATE[(size_t)(r) * 128 + F.wave * 16 + lane]; } } while (0)
    const bool skip_ctx = (OUT != nullptr);
    int row = F.vcu; if (skip_ctx && row < MROWS && row_cls(row) == 2) row += F.G;
    u32x4 xp[4]; int iv; float gv;
    u32x4 bAh[4], bBh[4]; u32x2 bAl[4], bBl[4];
    if (row < MROWS) { PX_FETCH_TOKEN(row, xp, iv, gv); PX_LOAD(bA, 0, iv); }
    int par = 0;
    while (row < MROWS) {
        int nrow = row + F.G; if (skip_ctx && nrow < MROWS && row_cls(nrow) == 2) nrow += F.G;
        f32x32 xf;
#pragma unroll
        for (int q = 0; q < 4; ++q) { const unsigned ww[4] = {xp[q].x, xp[q].y, xp[q].z, xp[q].w};
#pragma unroll
            for (int k = 0; k < 4; ++k) { xf[q * 8 + 2 * k] = bf_lo(ww[k]); xf[q * 8 + 2 * k + 1] = bf_hi(ww[k]); } }
        float usc = 0.f, vsc = 0.f;
        if (lane < 16) { usc = USC[iv]; vsc = VSC[iv]; }
        u32x4 xpn[4]; int ivn = 0; float gvn = 0.f;
        if (nrow < MROWS) PX_FETCH_TOKEN(nrow, xpn, ivn, gvn);
        const int cls = row_cls(row);
        const f32x4 x_old = *((const f32x4*)(XW + (size_t)row * DM) + F.tid), g_vec = *((const f32x4*)(g2 + (size_t)cls * NMOD) + F.tid);
        f32x4 n_g = {0.f, 0.f, 0.f, 0.f}, n_sc = n_g, n_sh = n_g;
        if (HN) { n_g = *((const f32x4*)ng + F.tid); n_sc = *((const f32x4*)(nmod + (size_t)cls * NMOD + 2048) + F.tid); n_sh = *((const f32x4*)(nmod + (size_t)cls * NMOD) + F.tid); }
        float sv = 0.f, wv = 0.f;
        PX_LOAD(bB, 1, iv); PX_SB(); PX_COMP_U(bA, 0); PX_SB();
        PX_LOAD(bA, 2, iv); PX_SB(); PX_COMP_U(bB, 1); PX_SB();
        PX_LOAD(bB, 3, iv); PX_SB(); PX_COMP_U(bA, 2); PX_SB();
        PX_LOAD(bA, 4, iv); PX_SB(); PX_COMP_U(bB, 3); PX_SB();
        wv = gelu_erf(sv * usc) * gv * vsc;
        f32x32 acc = {};
        PX_LOAD(bB, 5, iv); PX_SB(); PX_COMP_V(bA, 4); PX_SB();
        PX_LOAD(bA, 6, iv); PX_SB(); PX_COMP_V(bB, 5); PX_SB();
        PX_LOAD(bB, 7, iv); PX_SB(); PX_COMP_V(bA, 6); PX_SB();
        if (nrow < MROWS) PX_LOAD(bA, 0, ivn);
        PX_SB(); PX_COMP_V(bB, 7); PX_SB();
        LAS float* rb = red + par * (NWAVES * DM);
#pragma unroll
        for (int j = 0; j < 2; ++j)
#pragma unroll
            for (int q = 0; q < 4; ++q) *(LAS f32x4*)(rb + F.wave * DM + j * 1024 + lane * 16 + q * 4) = (f32x4){acc[j * 16 + q * 4], acc[j * 16 + q * 4 + 1], acc[j * 16 + q * 4 + 2], acc[j * 16 + q * 4 + 3]};
        __syncthreads();
        {
            f32x4 sm = {0.f, 0.f, 0.f, 0.f};
#pragma unroll
            for (int w = 0; w < 8; ++w) sm += *(const LAS f32x4*)(rb + w * DM + F.tid * 4);
            f32x4* xq = (f32x4*)(XW + (size_t)row * DM) + F.tid;
            const f32x4 xn = x_old + g_vec * sm;
            *xq = xn;
            if (OUT) { const int b = row / RB, i = row - b * RB; if (i >= CTX) *((f32x4*)(OUT + ((size_t)b * SEQ + (i - CTX)) * DM) + F.tid) = xn; }
            if (HN) {
                LAS float* ssp = (LAS float*)(F.lds + 131072) + par * 8;
                const float sw = wave_sum_dpp((xn.x * xn.x + xn.y * xn.y) + (xn.z * xn.z + xn.w * xn.w));
                if (lane == 0) ssp[F.wave] = sw;
                __syncthreads();
                const float tot = ((ssp[0] + ssp[1]) + (ssp[2] + ssp[3])) + ((ssp[4] + ssp[5]) + (ssp[6] + ssp[7]));
                const float rstd = 1.0f / sqrtf(tot * (1.f / DM) + EPS);
                const f32x4 y = (xn * rstd) * n_g * (n_sc + 1.0f) + n_sh;
                u32x2 o; o.x = pk2(y.x, y.y); o.y = pk2(y.z, y.w);
                *((u32x2*)(HN + (size_t)row * DM) + F.tid) = o;
            }
        }
        par ^= 1; row = nrow;
#pragma unroll
        for (int q = 0; q < 4; ++q) xp[q] = xpn[q];
        iv = ivn; gv = gvn;
    }
#undef PX_LOAD
#undef PX_COMP_U
#undef PX_COMP_V
#undef PX_SB
#undef PX_FETCH_TOKEN
}
#endif

#if EXP_SLICED && TAB_FP4
__device__ __forceinline__ float oct_sum(float v) { v = DPP_ADD(v, 0xB1); v = DPP_ADD(v, 0x4E); v = DPP_ADD(v, 0x141); return v; }
__device__ __forceinline__ int sl_next_tok(int t, int stride, bool lat_only) { t += stride; if (lat_only) while (t < MROWS && row_cls(t) == 2) t += stride; return t; }
#ifndef PROBE_IDMASK
#define PROBE_IDMASK 0x7fffffff
#endif
#define SL_CL(t_) ((t_) < MROWS ? (t_) : MROWS - 1)
#define SL_IDS(t_, A_, B_) do { A_ = IDX[(size_t)(t_) * 128 + lane] & idmask; B_ = IDX[(size_t)(t_) * 128 + 64 + lane] & idmask; } while (0)
#define SL_ROWS(buf, A_, B_) do { _Pragma("unroll") for (int i_ = 0; i_ < 16; ++i_) { const int id_ = __builtin_amdgcn_ds_bpermute(bp + 32 * (i_ & 7), (i_ < 8) ? (A_) : (B_)); \
        buf[i_] = __builtin_amdgcn_raw_buffer_load_b128(rs, id_ * 128 + coloff, 0, 0); } } while (0)
#if PEER_MFMA
typedef int i32x8 __attribute__((ext_vector_type(8)));
__device__ __forceinline__ void peer_u_phase(const Frame& F0, const unsigned* XQ, const float* XS, const int* IDX, const unsigned char* U, float* PART, bool lat_only, int idmask = 0x7fffffff) {
    const Frame F = phase_frame(F0);
    const int lane = F.lane, g = lane >> 3, j = lane & 7, bp = 4 * g, n = lane & 15, kb = lane >> 4;
    const int wps = F.G >> 3, x = F.vcu / wps, wi = (F.vcu - x * wps) * NWAVES + F.wave, stride = wps * NWAVES;
    const __amdgpu_buffer_rsrc_t rs = __builtin_amdgcn_make_buffer_rsrc((void*)(U + (size_t)x * (NEXP * 128)), 0, NEXP * 128, 0x00020000);
    const int coloff = 16 * j;
    LAS unsigned char* const lbase = F.lds + F.wave * 16384;
    LAS unsigned char* const wr_even = lbase + g * 128 + ((j ^ (g >> 1)) << 4);
    LAS unsigned char* const wr_odd = lbase + g * 128 + ((j ^ (g >> 1) ^ 4) << 4);
    LAS unsigned char* const rd0 = lbase + n * 128 + ((kb ^ (n >> 1)) << 4);
    LAS unsigned char* const rd1 = lbase + n * 128 + (((4 + kb) ^ (n >> 1)) << 4);
    int t = wi - stride; t = sl_next_tok(t, stride, lat_only);
    int t1 = sl_next_tok(t, stride, lat_only), t2 = sl_next_tok(t1, stride, lat_only);
    int idA1 = 0, idB1 = 0, idA2 = 0, idB2 = 0, idA3 = 0, idB3 = 0; u32x4 xs[4], xs1[4], xs2[4], w[16], wn[16];
#define SL_XS(dst, t_) do { const u32x4* xp_ = (const u32x4*)((const unsigned char*)XQ + (size_t)(t_) * DM + 256 * x + 16 * kb); dst[0] = xp_[0]; dst[1] = xp_[4]; dst[2] = xp_[8]; dst[3] = xp_[12]; } while (0)
    { int idA0, idB0; const int c0_ = SL_CL(t), c1_ = SL_CL(t1), c2_ = SL_CL(t2); SL_IDS(c0_, idA0, idB0); SL_XS(xs1, c0_); SL_ROWS(w, idA0, idB0); SL_IDS(c1_, idA2, idB2); SL_XS(xs2, c1_); SL_IDS(c2_, idA3, idB3); }
#define SL_UBODY(CUR, NXT) do { \
        const int t3 = sl_next_tok(t2, stride, lat_only); \
_Pragma("unroll") \
        for (int q = 0; q < 4; ++q) { xs[q] = xs1[q]; xs1[q] = xs2[q]; } \
        idA1 = idA2; idB1 = idB2; idA2 = idA3; idB2 = idB3; \
        SL_ROWS(NXT, idA1, idB1); \
        { const int c2_ = SL_CL(t2), c3_ = SL_CL(t3); SL_XS(xs2, c2_); SL_IDS(c3_, idA3, idB3); } \
_Pragma("unroll") \
        for (int i = 0; i < 16; ++i) *(LAS u32x4*)(((i & 1) ? wr_odd : wr_even) + i * 1024) = CUR[i]; \
        const i32x8 a0 = {(int)xs[0].x, (int)xs[0].y, (int)xs[0].z, (int)xs[0].w, (int)xs[1].x, (int)xs[1].y, (int)xs[1].z, (int)xs[1].w}; \
        const i32x8 a1 = {(int)xs[2].x, (int)xs[2].y, (int)xs[2].z, (int)xs[2].w, (int)xs[3].x, (int)xs[3].y, (int)xs[3].z, (int)xs[3].w}; \
        float res_lo = 0.f, res_hi = 0.f; \
_Pragma("unroll") \
        for (int h = 0; h < 8; ++h) { \
            const u32x4 r0_ = *(LAS u32x4*)(rd0 + h * 2048), r1_ = *(LAS u32x4*)(rd1 + h * 2048); \
            const i32x8 b0 = {(int)r0_.x, (int)r0_.y, (int)r0_.z, (int)r0_.w, 0, 0, 0, 0}; \
            const i32x8 b1 = {(int)r1_.x, (int)r1_.y, (int)r1_.z, (int)r1_.w, 0, 0, 0, 0}; \
            f32x4 d = {0.f, 0.f, 0.f, 0.f}; \
            d = __builtin_amdgcn_mfma_scale_f32_16x16x128_f8f6f4(a0, b0, d, 0, 4, 0, 0, 0, 0); \
            d = __builtin_amdgcn_mfma_scale_f32_16x16x128_f8f6f4(a1, b1, d, 0, 4, 0, 0, 0, 0); \
            if (h < 4) res_lo = (kb == h) ? d[0] : res_lo; else res_hi = (kb == h - 4) ? d[0] : res_hi; \
        } \
        float* pp = PART + ((size_t)t * 8 + x) * 128 + lane; \
        pp[0] = res_lo; pp[64] = res_hi; \
        t = t1; t1 = t2; t2 = t3; \
    } while (0)
    while (t < MROWS) { SL_UBODY(w, wn); if (!(t < MROWS)) break; SL_UBODY(wn, w); }
#undef SL_UBODY
#undef SL_XS
}
#else
__device__ __forceinline__ void peer_u_phase(const Frame& F0, const unsigned* XQ, const float* XS, const int* IDX, const unsigned char* U, float* PART, bool lat_only, int idmask = 0x7fffffff) {
    const Frame F = phase_frame(F0);
    const int lane = F.lane, g = lane >> 3, j = lane & 7, bp = 4 * g;
    const int wps = F.G >> 3, x = F.vcu / wps, wi = (F.vcu - x * wps) * NWAVES + F.wave, stride = wps * NWAVES;
    const __amdgpu_buffer_rsrc_t rs = __builtin_amdgcn_make_buffer_rsrc((void*)(U + (size_t)x * (NEXP * 128)), 0, NEXP * 128, 0x00020000);
    const int coloff = 16 * j;
    int t = wi - stride; t = sl_next_tok(t, stride, lat_only);
    int t1 = sl_next_tok(t, stride, lat_only), t2 = sl_next_tok(t1, stride, lat_only);
    int idA1 = 0, idB1 = 0, idA2 = 0, idB2 = 0, idA3 = 0, idB3 = 0; u32x4 xs[3], xs1[3], xs2[3], w[16], wn[16];
#define SL_XS(dst, t_) do { const u32x4* xp_ = (const u32x4*)(XQ + ((size_t)(t_) * 64 + 8 * x + j) * 8); dst[0] = xp_[0]; dst[1] = xp_[1]; const f32x2 s2_ = *(const f32x2*)(XS + ((size_t)(t_) * 64 + 8 * x + j) * 2); dst[2] = (u32x4){__float_as_uint(s2_.x), __float_as_uint(s2_.y), 0u, 0u}; } while (0)
    { int idA0, idB0; const int c0_ = SL_CL(t), c1_ = SL_CL(t1), c2_ = SL_CL(t2); SL_IDS(c0_, idA0, idB0); SL_XS(xs1, c0_); SL_ROWS(w, idA0, idB0); SL_IDS(c1_, idA2, idB2); SL_XS(xs2, c1_); SL_IDS(c2_, idA3, idB3); }
#define SL_UBODY(CUR, NXT) do { \
        const int t3 = sl_next_tok(t2, stride, lat_only); \
_Pragma("unroll") \
        for (int q = 0; q < 3; ++q) { xs[q] = xs1[q]; xs1[q] = xs2[q]; } \
        idA1 = idA2; idB1 = idB2; idA2 = idA3; idB2 = idB3; \
        SL_ROWS(NXT, idA1, idB1); \
        { const int c2_ = SL_CL(t2), c3_ = SL_CL(t3); SL_XS(xs2, c2_); SL_IDS(c3_, idA3, idB3); } \
        const int xh[4] = {(int)xs[0].x, (int)xs[0].y, (int)xs[0].z, (int)xs[0].w}, xl[4] = {(int)xs[1].x, (int)xs[1].y, (int)xs[1].z, (int)xs[1].w}; \
        const float dq = __uint_as_float(xs[2].x), off = __uint_as_float(xs[2].y); \
        float res_lo = 0.f, res_hi = 0.f; \
_Pragma("unroll") \
        for (int i = 0; i < 16; ++i) { \
            const int wd_[4] = {(int)CUR[i].x, (int)CUR[i].y, (int)CUR[i].z, (int)CUR[i].w}; int ah_ = 0, al_ = 0; \
_Pragma("unroll") \
            for (int d = 0; d < 4; ++d) { ah_ = __builtin_amdgcn_sdot8(wd_[d], xh[d], ah_, false); al_ = __builtin_amdgcn_sdot8(wd_[d], xl[d], al_, false); } \
            const float a_ = oct_sum(((float)(16 * ah_ + al_) + off) * dq); \
            if (i < 8) res_lo = (j == i) ? a_ : res_lo; else res_hi = (j == i - 8) ? a_ : res_hi; \
        } \
        float* pp = PART + ((size_t)t * 8 + x) * 128 + 8 * j + g; \
        pp[0] = res_lo; pp[64] = res_hi; \
        t = t1; t1 = t2; t2 = t3; \
    } while (0)
    while (t < MROWS) { SL_UBODY(w, wn); if (!(t < MROWS)) break; SL_UBODY(wn, w); }
#undef SL_UBODY
#undef SL_XS
}
#endif
#if PEER_VMFMA
typedef int i32x8v __attribute__((ext_vector_type(8)));
typedef int i32x2v __attribute__((ext_vector_type(2)));
constexpr int WQ_U = 3;
__device__ __forceinline__ void peer_wq_phase(const Frame& F0, const float* PART, const int* IDX, const float* GATE, const float* USC, const float* VSC, bool lat_only, unsigned char* WQ8, float* WSC, const float* XS = nullptr) {
    const Frame F = phase_frame(F0);
    const int lane = F.lane;
    for (int t0 = F.gw; t0 < MROWS; t0 += WQ_U * F.NGW) {
        float s[WQ_U][2]; int id[WQ_U][2]; float gt[WQ_U][2]; bool ok[WQ_U];
#pragma unroll
        for (int u = 0; u < WQ_U; ++u) { const int t = t0 + u * F.NGW; ok[u] = t < MROWS && !(lat_only && row_cls(t) == 2);
            s[u][0] = s[u][1] = 0.f; id[u][0] = id[u][1] = 0; gt[u][0] = gt[u][1] = 0.f;
            if (ok[u]) { const float* pp = PART + (size_t)t * 1024 + lane;
#pragma unroll
                for (int xx = 0; xx < 8; ++xx) { s[u][0] += pp[xx * 128]; s[u][1] += pp[xx * 128 + 64]; }
                id[u][0] = IDX[(size_t)t * 128 + lane]; id[u][1] = IDX[(size_t)t * 128 + 64 + lane]; gt[u][0] = GATE[(size_t)t * 128 + lane]; gt[u][1] = GATE[(size_t)t * 128 + 64 + lane]; } }
        float us[WQ_U][2], vs[WQ_U][2];
#pragma unroll
        for (int u = 0; u < WQ_U; ++u)
#pragma unroll
            for (int q = 0; q < 2; ++q) { us[u][q] = ok[u] ? USC[id[u][q]] : 0.f; vs[u][q] = ok[u] ? VSC[id[u][q]] : 0.f; }
#pragma unroll
        for (int u = 0; u < WQ_U; ++u) if (ok[u]) { const int t = t0 + u * F.NGW;
#if PEER_MFMA
            { const float xsc = XS[t]; us[u][0] *= xsc; us[u][1] *= xsc; }
#endif
            const float w0 = gt[u][0] * gelu_erf(s[u][0] * us[u][0]) * vs[u][0], w1 = gt[u][1] * gelu_erf(s[u][1] * us[u][1]) * vs[u][1];
            const float am = fmaxf(wave_max_dpp(fmaxf(fabsf(w0), fabsf(w1))), 1e-30f), qs = 440.0f / am;
            const int pk = __builtin_amdgcn_cvt_pk_fp8_f32(w0 * qs, w1 * qs, 0, false);
            WQ8[(size_t)t * 128 + lane] = (unsigned char)(pk & 0xff); WQ8[(size_t)t * 128 + 64 + lane] = (unsigned char)((pk >> 8) & 0xff);
            if (lane == 0) WSC[t] = am * (1.0f / 440.0f); }
    }
}
__device__ __forceinline__ void peer_v_phase(const Frame& F0, const int* IDX, const unsigned char* WQ8, const float* WSC, const unsigned char* VT, const float* g2  , bf16_t* XW, float* OUT, bool lat_only) {
    const int idmask = 0x7fffffff;
    const Frame F = phase_frame(F0);
    const int lane = F.lane, g = lane >> 3, j = lane & 7, bp = 4 * g, n = lane & 15, kb = lane >> 4;
    const int wps = F.G >> 3, x = F.vcu / wps, wi = (F.vcu - x * wps) * NWAVES + F.wave, stride = wps * NWAVES;
    const __amdgpu_buffer_rsrc_t rs = __builtin_amdgcn_make_buffer_rsrc((void*)(VT + (size_t)x * (NEXP * 128)), 0, NEXP * 128, 0x00020000);
    const int coloff = 16 * j;
    LAS unsigned char* const lbase = F.lds + F.wave * 16384;
    LAS unsigned char* const wr_even = lbase + g * 128 + ((j ^ (g >> 1)) << 4);
    LAS unsigned char* const wr_odd = lbase + g * 128 + ((j ^ (g >> 1) ^ 4) << 4);
    LAS unsigned char* const rd_row = lbase + (32 * kb + n) * 128;
    const int rsw = (n >> 1) << 4;
    const int col0 = 256 * x + lane;
    int t = wi - stride; t = sl_next_tok(t, stride, lat_only);
    int t1 = sl_next_tok(t, stride, lat_only), t2 = sl_next_tok(t1, stride, lat_only);
    int idA1 = 0, idB1 = 0, idA2 = 0, idB2 = 0, idA3 = 0, idB3 = 0; u32x4 w[16], wn[16];
    u32x4 wa[2], wa1[2], wa2[2]; float sc = 0.f, sc1 = 0.f, sc2 = 0.f;
    float xo[4], gv[4], xo1[4], gv1[4], xo2[4], gv2[4];
#pragma unroll
    for (int q = 0; q < 4; ++q) { xo[q] = gv[q] = xo1[q] = gv1[q] = xo2[q] = gv2[q] = 0.f; }
    wa[0] = wa[1] = wa1[0] = wa1[1] = wa2[0] = wa2[1] = (u32x4){0u, 0u, 0u, 0u};
#define SL_WA(dst, S_, t_) do { const u32x4* wp_ = (const u32x4*)(WQ8 + (size_t)(t_) * 128 + 16 * kb); dst[0] = wp_[0]; dst[1] = wp_[4]; S_ = WSC[t_]; } while (0)
#define SL_XG(t_, X_, G_) do { const bf16_t* xp_ = XW + (size_t)(t_) * DM + col0; const float* gp_ = g2 + (size_t)row_cls(t_) * NMOD + col0; _Pragma("unroll") for (int q_ = 0; q_ < 4; ++q_) { X_[q_] = bf2f(xp_[64 * q_]); G_[q_] = gp_[64 * q_]; } } while (0)
    { int idA0, idB0; const int c0_ = SL_CL(t), c1_ = SL_CL(t1), c2_ = SL_CL(t2); SL_IDS(c0_, idA0, idB0); SL_WA(wa1, sc1, c0_); SL_XG(c0_, xo1, gv1); SL_ROWS(w, idA0, idB0);
      SL_IDS(c1_, idA2, idB2); SL_WA(wa2, sc2, c1_); SL_XG(c1_, xo2, gv2); SL_IDS(c2_, idA3, idB3); }
#define SL_VBODY(CUR, NXT) do { \
        const int t3 = sl_next_tok(t2, stride, lat_only); \
        wa[0] = wa1[0]; wa[1] = wa1[1]; wa1[0] = wa2[0]; wa1[1] = wa2[1]; sc = sc1; sc1 = sc2; \
_Pragma("unroll") \
        for (int q = 0; q < 4; ++q) { xo[q] = xo1[q]; gv[q] = gv1[q]; xo1[q] = xo2[q]; gv1[q] = gv2[q]; } \
        idA1 = idA2; idB1 = idB2; idA2 = idA3; idB2 = idB3; \
        SL_ROWS(NXT, idA1, idB1); \
        { const int c2_ = SL_CL(t2), c3_ = SL_CL(t3); SL_WA(wa2, sc2, c2_); SL_XG(c2_, xo2, gv2); SL_IDS(c3_, idA3, idB3); } \
_Pragma("unroll") \
        for (int i = 0; i < 16; ++i) *(LAS u32x4*)(((i & 1) ? wr_odd : wr_even) + i * 1024) = CUR[i]; \
        const i32x8v a = {(int)wa[0].x, (int)wa[0].y, (int)wa[0].z, (int)wa[0].w, (int)wa[1].x, (int)wa[1].y, (int)wa[1].z, (int)wa[1].w}; \
        float vs[4] = {0.f, 0.f, 0.f, 0.f}; \
_Pragma("unroll") \
        for (int cb = 0; cb < 16; ++cb) { \
            LAS unsigned char* ra_ = rd_row + ((((cb >> 1) << 4) ^ rsw) + ((cb & 1) << 3)); \
            const i32x2v lo_ = __builtin_amdgcn_ds_read_tr4_b64_v2i32((LAS i32x2v*)ra_), hi_ = __builtin_amdgcn_ds_read_tr4_b64_v2i32((LAS i32x2v*)(ra_ + 2048)); \
            const i32x8v b_ = {lo_.x, lo_.y, hi_.x, hi_.y, 0, 0, 0, 0}; \
            const f32x4 z_ = {0.f, 0.f, 0.f, 0.f}; \
            const f32x4 d_ = __builtin_amdgcn_mfma_scale_f32_16x16x128_f8f6f4(a, b_, z_, 0, 4, 0, 0, 0, 0); \
            vs[cb >> 2] = (kb == (cb & 3)) ? d_[0] : vs[cb >> 2]; \
        } \
        { const int b = t / RB, i = t - b * RB; \
_Pragma("unroll") \
          for (int q = 0; q < 4; ++q) { const float xn = xo[q] + gv[q] * (sc * vs[q]); XW[(size_t)t * DM + col0 + 64 * q] = (bf16_t)f2bf(xn); \
              if (OUT) { if (i >= CTX) OUT[((size_t)b * SEQ + (i - CTX)) * DM + col0 + 64 * q] = xn; } } } \
        t = t1; t1 = t2; t2 = t3; \
    } while (0)
    while (t < MROWS) { SL_VBODY(w, wn); if (!(t < MROWS)) break; SL_VBODY(wn, w); }
#undef SL_VBODY
#undef SL_WA
#undef SL_XG
}
#else
__device__ __forceinline__ void peer_w_phase(const Frame& F0, const float* PART, const int* IDX, float* GATE, const float* USC, const float* VSC, bool lat_only, const float* XS = nullptr) {
    const Frame F = phase_frame(F0);
    const int gt = F.vcu * NTHREADS + F.tid, GT = F.G * NTHREADS;
    for (int e0 = gt; e0 < MROWS * 128; e0 += 4 * GT) {
        float s[4]; int id[4]; float gte[4], us[4], vs[4]; bool ok[4];
#pragma unroll
        for (int u = 0; u < 4; ++u) { const int e = e0 + u * GT; ok[u] = e < MROWS * 128 && !(lat_only && row_cls(e >> 7) == 2); s[u] = 0.f; id[u] = 0; gte[u] = 0.f;
            if (ok[u]) { const float* pp = PART + (size_t)(e >> 7) * 1024 + (e & 127);
#pragma unroll
                for (int xx = 0; xx < 8; ++xx) s[u] += pp[xx * 128];
                id[u] = IDX[e]; gte[u] = GATE[e]; } }
#pragma unroll
        for (int u = 0; u < 4; ++u) { us[u] = ok[u] ? USC[id[u]] : 0.f; vs[u] = ok[u] ? VSC[id[u]] : 0.f;
#if PEER_MFMA
            if (ok[u]) us[u] *= XS[(e0 + u * GT) >> 7];
#endif
        }
#pragma unroll
        for (int u = 0; u < 4; ++u) if (ok[u]) GATE[e0 + u * GT] = gte[u] * gelu_erf(s[u] * us[u]) * vs[u];
    }
}
#ifdef SELFTEST
#define SELFTEST_LEAK * (1.0f + sqrtf(*(const volatile float*)((const unsigned char*)XW - WS_XW + WS_CTL + 32768)))
#define SELFTEST_SPIKE do { if (b == 0 && i == CTX && mycol == 0) xo_.x += *(const volatile float*)((const unsigned char*)XW - WS_XW + WS_CTL + 32772); } while (0)
#else
#define SELFTEST_LEAK
#define SELFTEST_SPIKE do {} while (0)
#endif
__device__ __forceinline__ void peer_v_phase(const Frame& F0, const int* IDX, const float* WK, const unsigned char* VT, const float* g2  , float* XW, float* OUT, bool lat_only) {
    const int idmask = 0x7fffffff;
    const Frame F = phase_frame(F0);
    const int lane = F.lane, g = lane >> 3, j = lane & 7, bp = 4 * g;
    const int wps = F.G >> 3, x = F.vcu / wps, wi = (F.vcu - x * wps) * NWAVES + F.wave, stride = wps * NWAVES;
    const __amdgpu_buffer_rsrc_t rs = __builtin_amdgcn_make_buffer_rsrc((void*)(VT + (size_t)x * (NEXP * 128)), 0, NEXP * 128, 0x00020000);
    const int coloff = 16 * j;
    const int mycol = 256 * x + 32 * j + 4 * g;
    int t = wi - stride; t = sl_next_tok(t, stride, lat_only);
    int t1 = sl_next_tok(t, stride, lat_only), t2 = sl_next_tok(t1, stride, lat_only);
    int idA1 = 0, idB1 = 0, idA2 = 0, idB2 = 0, idA3 = 0, idB3 = 0; float wA = 0.f, wB = 0.f, wA1 = 0.f, wB1 = 0.f, wA2 = 0.f, wB2 = 0.f; u32x4 w[16], wn[16];
    f32x4 x_old = {0.f, 0.f, 0.f, 0.f}, g_vec = x_old, xo1 = x_old, gv1 = x_old, xo2 = x_old, gv2 = x_old;
#define SL_WK(t_, A_, B_) do { A_ = WK[(size_t)(t_) * 128 + lane]; B_ = WK[(size_t)(t_) * 128 + 64 + lane]; } while (0)
#define SL_XG(t_, X_, G_) do { X_ = *(const f32x4*)(XW + (size_t)(t_) * DM + mycol); G_ = *(const f32x4*)(g2 + (size_t)row_cls(t_) * NMOD + mycol); } while (0)
    if (t < MROWS) { int idA0, idB0; SL_IDS(t, idA0, idB0); SL_WK(t, wA1, wB1); SL_XG(t, xo1, gv1); SL_ROWS(w, idA0, idB0); }
    if (t1 < MROWS) { SL_IDS(t1, idA2, idB2); SL_WK(t1, wA2, wB2); SL_XG(t1, xo2, gv2); }
    if (t2 < MROWS) SL_IDS(t2, idA3, idB3);
#define SL_V1(d_, b_) { const h2_t r2_ = __builtin_amdgcn_cvt_scalef32_pk_f16_fp4(wd_[d_], 1.0f, b_); acc[4 * (d_) + (b_)] = __builtin_elementwise_fma(r2_, wg2_, acc[4 * (d_) + (b_)]); }
#define SL_VBODY(CUR, NXT) do { \
        const int t3 = sl_next_tok(t2, stride, lat_only); \
        wA = wA1; wB = wB1; wA1 = wA2; wB1 = wB2; x_old = xo1; g_vec = gv1; xo1 = xo2; gv1 = gv2; \
        idA1 = idA2; idB1 = idB2; idA2 = idA3; idB2 = idB3; \
        if (t1 < MROWS) SL_ROWS(NXT, idA1, idB1); \
        if (t2 < MROWS) { SL_WK(t2, wA2, wB2); SL_XG(t2, xo2, gv2); } \
        if (t3 < MROWS) SL_IDS(t3, idA3, idB3); \
        h2_t acc[16]; \
_Pragma("unroll") \
        for (int p = 0; p < 16; ++p) acc[p] = (h2_t){(_Float16)0.f, (_Float16)0.f}; \
_Pragma("unroll") \
        for (int i = 0; i < 16; ++i) { \
            const unsigned wd_[4] = {CUR[i].x, CUR[i].y, CUR[i].z, CUR[i].w}; \
            const float wgf_ = __int_as_float(__builtin_amdgcn_ds_bpermute(bp + 32 * (i & 7), __float_as_int((i < 8) ? wA : wB))); \
            const _Float16 wgh_ = (_Float16)wgf_; const h2_t wg2_ = {wgh_, wgh_}; \
            SL_V1(0, 0) SL_V1(0, 1) SL_V1(0, 2) SL_V1(0, 3) SL_V1(1, 0) SL_V1(1, 1) SL_V1(1, 2) SL_V1(1, 3) SL_V1(2, 0) SL_V1(2, 1) SL_V1(2, 2) SL_V1(2, 3) SL_V1(3, 0) SL_V1(3, 1) SL_V1(3, 2) SL_V1(3, 3) \
        } \
        unsigned m0 = 0u, m1 = 0u; \
_Pragma("unroll") \
        for (int p = 0; p < 16; ++p) { \
            h2_t v = acc[p]; \
            v = v + __builtin_bit_cast(h2_t, __builtin_amdgcn_update_dpp(0, __builtin_bit_cast(int, v), 0x128, 0xf, 0xf, true)); \
            { auto r = __builtin_amdgcn_permlane16_swap(__builtin_bit_cast(unsigned, v), __builtin_bit_cast(unsigned, v), false, false); v = __builtin_bit_cast(h2_t, (unsigned)r[0]) + __builtin_bit_cast(h2_t, (unsigned)r[1]); } \
            { auto r = __builtin_amdgcn_permlane32_swap(__builtin_bit_cast(unsigned, v), __builtin_bit_cast(unsigned, v), false, false); v = __builtin_bit_cast(h2_t, (unsigned)r[0]) + __builtin_bit_cast(h2_t, (unsigned)r[1]); } \
            if (g == (p >> 1)) { if (p & 1) m1 = __builtin_bit_cast(unsigned, v); else m0 = __builtin_bit_cast(unsigned, v); } \
        } \
        const h2_t q0 = __builtin_bit_cast(h2_t, m0), q1 = __builtin_bit_cast(h2_t, m1); \
        const f32x4 mine = {(float)q0.x, (float)q0.y, (float)q1.x, (float)q1.y}; \
        const f32x4 xn = x_old + g_vec * mine; \
        *(f32x4*)(XW + (size_t)t * DM + mycol) = xn; \
        if (OUT) { const int b = t / RB, i = t - b * RB; if (i >= CTX) { f32x4 xo_ = xn SELFTEST_LEAK; SELFTEST_SPIKE; *(f32x4*)(OUT + ((size_t)b * SEQ + (i - CTX)) * DM + mycol) = xo_; } } \
        t = t1; t1 = t2; t2 = t3; \
    } while (0)
    while (t < MROWS) { SL_VBODY(w, wn); if (!(t < MROWS)) break; SL_VBODY(wn, w); }
#undef SL_VBODY
#undef SL_V1
#undef SL_WK
#undef SL_XG
}
#endif
#undef SL_IDS
#undef SL_ROWS
#undef SL_CL
#endif
#ifndef N_LAUNCHES
#define N_LAUNCHES 1
#endif
struct Args { const float* in[26]; float* out; unsigned char* ws; int ph_lo, ph_hi; };
constexpr int NPHASES = 39;
__global__ void __launch_bounds__(NTHREADS, 2) fwd_kernel(Args args) {
    extern __shared__ __attribute__((aligned(16))) unsigned char lds_raw[];
    Frame F_;
    F_.lds = (LAS unsigned char*)lds_raw;
    F_.tid = threadIdx.x; F_.lane = F_.tid & 63; F_.wave = __builtin_amdgcn_readfirstlane(F_.tid >> 6);
    F_.G = gridDim.x; { const int bx = blockIdx.x; F_.vcu = (F_.G % 8 == 0) ? (bx % 8) * (F_.G / 8) + bx / 8 : bx; }
    F_.gw = F_.vcu * NWAVES + F_.wave; F_.NGW = F_.G * NWAVES;
    F_.ws = args.ws;
    volatile LAS unsigned* MISC = (volatile LAS unsigned*)(F_.lds + LDS_MISC);
    if (F_.tid < 32) MISC[F_.tid] = 0u;
    __syncthreads();
    const int lo = args.ph_lo, hi = args.ph_hi;
    XcdBarrier bar; bar.bar = (unsigned*)(args.ws + WS_CTL) + CW_BAR; bar.x = 0; bar.st = nullptr;
    if (N_LAUNCHES == 1 || hi - lo > 1) bar = xcd_barrier_post((unsigned*)(args.ws + WS_CTL) + CW_BAR, MISC + 8);
#if N_LAUNCHES == 1
#define IN(k) true
#define SEAM(k) xcd_barrier(bar)
#else
#define IN(k) (lo <= (k) && (k) < hi)
#define SEAM(k) do { if (IN(k) && IN((k) + 1)) xcd_barrier(bar); } while (0)
#endif
    PG8_LAS unsigned char* glds = (PG8_LAS unsigned char*)lds_raw;

    if (IN(0)) { p0_prologue(F_, args.in); } SEAM(0);

#pragma unroll 1
    for (int lp = 0; lp < 2; ++lp) {
        const int pb = 1 + lp * 19;
        unsigned char* ws = args.ws; asm volatile("" : "+s"(ws));
        Frame F = F_; { int w_ = F_.wave, v_ = F_.vcu, g_ = F_.G; asm volatile("" : "+s"(w_), "+s"(v_), "+s"(g_)); F.wave = w_; F.vcu = v_; F.G = g_; F.gw = v_ * NWAVES + w_; F.NGW = g_ * NWAVES; F.ws = ws; }
        float* mod = (float*)(ws + WS_MOD); bf16_t* XW = (bf16_t*)(ws + WS_XW);
        bf16_t* H = (bf16_t*)(ws + WS_H); bf16_t* P = (bf16_t*)(ws + WS_P); bf16_t* QRAW = (bf16_t*)(ws + WS_QRAW); bf16_t* KVRAW = (bf16_t*)(ws + WS_KVRAW);
        bf16_t* Q = (bf16_t*)(ws + WS_Q); bf16_t* KB = (bf16_t*)(ws + WS_K); bf16_t* VB = (bf16_t*)(ws + WS_V); bf16_t* CAT = (bf16_t*)(ws + WS_CAT); bf16_t* PQ = (bf16_t*)(ws + WS_PQ);
        int* IDX = (int*)(ws + WS_IDX); float* GATE = (float*)(ws + WS_GATE);
        const float* rope_c = (const float*)(ws + WS_ROPE); const float* rope_a = rope_c + 64 * 32 * 2;
        const float* SMv = (const float*)(ws + WS_SMALL);
        {
            const int l = 2 * lp, i = lp;
            const float* modl = mod + (size_t)l * 3 * NMOD;
            if (lp == 0) { if (IN(pb + 0)) { norm_phase(F, XW, SMv + SM_N1G + l * DM, modl, 0, 2048, H, false); } SEAM(pb + 0); }
            if (IN(pb + 1)) {
                pg8::Gemm g{H, (const bf16_t*)(ws + WS_WIN) + (size_t)i * 4096 * DM, MROWS, 4096, DM, DM, DM}; pg8::StaticOrder S; S.init(MROWS, 4096, F.G, (int)blockIdx.x, true);
                pg8::EpiBf16 E{P, 4096};
                ctx_gemm_phase<false>(F, H, DM, (const bf16_t*)(ws + WS_WIN) + (size_t)i * 4096 * DM, DM, 4096, DM, P, nullptr, 4096, nullptr);
                pg8::gemm_phase<pg8::EpiBf16, pg8::StaticOrder, true, true>(glds, g, S, E, phase_tid(F.wave));
            } SEAM(pb + 1);
            if (IN(pb + 2)) {
                { pg8::Gemm g{P, (const bf16_t*)(ws + WS_WUQ) + (size_t)i * 1536 * 512, MROWS, 1536, 512, 4096, 512}; pg8::StaticOrder S; S.init(MROWS, 1536, F.G, (int)blockIdx.x);
                  pg8::EpiBf16 E{QRAW, 1536};
                  pg8::gemm_phase<pg8::EpiBf16, pg8::StaticOrder, true, true>(glds, g, S, E, phase_tid(F.wave)); }
                __syncthreads();
                { pg8::Gemm g{P + 512, (const bf16_t*)(ws + WS_WUKV) + (size_t)i * 2048 * 256, MROWS, 2048, 256, 4096, 256}; pg8::StaticOrder S; S.init(MROWS, 2048, F.G, (F.G == 256) ? (((int)blockIdx.x + 48) & 255) : (int)blockIdx.x);
                  pg8::EpiBf16 E{KVRAW, 2048};
                  pg8::gemm_phase<pg8::EpiBf16, pg8::StaticOrder, true, true>(glds, g, S, E, phase_tid(F.wave)); }
                __syncthreads();
                conv_phase(F, P, SMv + SM_CW + i * 3072, SMv + SM_CB + i * 1024, CAT);
            } SEAM(pb + 2);
            if (IN(pb + 3)) { prep_even_phase(F, P, QRAW, KVRAW, SMv + SM_AQG + i * 192, SMv + SM_AKG + i * 192, rope_a, Q, KB, VB); } SEAM(pb + 3);
            if (IN(pb + 4)) { attn_even_phase(F, Q, KB, VB, CAT, l); } SEAM(pb + 4);
            if (IN(pb + 5)) {
                pg8::Gemm g{CAT, (const bf16_t*)(ws + WS_WEO) + (size_t)i * DM * DM, MROWS, DM, DM, DM, DM}; pg8::StaticOrder S; S.init(MROWS, DM, F.G, (int)blockIdx.x, true);
                pg8::EpiResid E{XW, DM, modl + 4096};
                ctx_gemm_phase<true>(F, CAT, DM, (const bf16_t*)(ws + WS_WEO) + (size_t)i * DM * DM, DM, DM, DM, nullptr, XW, DM, modl + 4096);
                pg8::gemm_phase<pg8::EpiResid, pg8::StaticOrder, true, true>(glds, g, S, E, phase_tid(F.wave));
            } SEAM(pb + 5);
            if (IN(pb + 6)) { norm_phase(F, XW, SMv + SM_N2G + l * DM, modl, 6144, 8192, H, l == 3, (unsigned*)(ws + WS_XQ), (float*)(ws + WS_XS)); } SEAM(pb + 6);
            if (IN(pb + 7)) {
                pg8::Gemm g{H, (const bf16_t*)(ws + WS_WPQ) + (size_t)l * DM * DM, MROWS, DM, DM, DM, DM}; pg8::StaticOrder S; S.init(MROWS, DM, F.G, (int)blockIdx.x, true);
                pg8::EpiBf16 E{PQ, DM};
                ctx_gemm_phase<false>(F, H, DM, (const bf16_t*)(ws + WS_WPQ) + (size_t)l * DM * DM, DM, DM, DM, PQ, nullptr, DM, nullptr);
                pg8::gemm_phase<pg8::EpiBf16, pg8::StaticOrder, true, true>(glds, g, S, E, phase_tid(F.wave));
            } SEAM(pb + 7);
            if (IN(pb + 8)) { peer_topk_phase(F, PQ, (const bf16_t*)(ws + WS_SUBK) + (size_t)l * 16 * 128 * 128, IDX, GATE, l == 3); } SEAM(pb + 8);
            {
                const unsigned char* Ut = ws + WS_U + (size_t)l * NEXP * ROWB; const unsigned char* Vt = ws + WS_VT + (size_t)l * NEXP * ROWB;
                peer_u_phase(F, (const unsigned*)(ws + WS_XQ), (const float*)(ws + WS_XS), IDX, Ut, (float*)(ws + WS_PART), false); SEAM(0);
                peer_wq_phase(F, (const float*)(ws + WS_PART), IDX, GATE, (const float*)(ws + WS_USC) + l * NEXP, (const float*)(ws + WS_VSC) + l * NEXP, false, ws + WS_WQ8, (float*)(ws + WS_WSC), (const float*)(ws + WS_XS)); SEAM(0);
                peer_v_phase(F, IDX, ws + WS_WQ8, (const float*)(ws + WS_WSC), Vt, modl + 10240, XW, nullptr, false); SEAM(0);
                norm_phase(F, XW, SMv + SM_N1G + (l + 1) * DM, mod + (size_t)(l + 1) * 3 * NMOD, 0, 2048, H, false); SEAM(0);
            }
        }
        {
            const int l = 2 * lp + 1, i = lp, qb = pb + 10;
            const float* modl = mod + (size_t)l * 3 * NMOD;
            if (IN(qb + 1)) {
                pg8::Gemm g{H, (const bf16_t*)(ws + WS_WQKV) + (size_t)i * 3072 * DM, MROWS, 3072, DM, DM, DM}; pg8::StaticOrder S; S.init(MROWS, 3072, F.G, (int)blockIdx.x);
                pg8::EpiBf16 E{P, 3072};
                pg8::gemm_phase<pg8::EpiBf16, pg8::StaticOrder, true, true>(glds, g, S, E, phase_tid(F.wave));
                if (F.G == 256 && (int)blockIdx.x >= 152) tab_deferred_rows(F, l, ((int)blockIdx.x - 152) * NWAVES + F.wave);
            } SEAM(qb + 1);
            if (IN(qb + 2)) { prep_odd_phase(F, P, SMv + SM_CQG + i * 128, SMv + SM_CKG + i * 128, rope_c, Q, KB); } SEAM(qb + 2);
            if (IN(qb + 3)) { attn_odd_phase(F, Q, KB, P, CAT, l == 3, l); } SEAM(qb + 3);
            if (IN(qb + 4)) {
                pg8::Gemm g{CAT, (const bf16_t*)(ws + WS_WCO) + (size_t)i * DM * DM, MROWS, DM, DM, DM, DM}; pg8::StaticOrder S; S.init(MROWS, DM, F.G, (int)blockIdx.x, true);
                pg8::EpiResid E{XW, DM, modl + 4096};
                if (l != 3) ctx_gemm_phase<true>(F, CAT, DM, (const bf16_t*)(ws + WS_WCO) + (size_t)i * DM * DM, DM, DM, DM, nullptr, XW, DM, modl + 4096);
                pg8::gemm_phase<pg8::EpiResid, pg8::StaticOrder, true, true>(glds, g, S, E, phase_tid(F.wave));
            } SEAM(qb + 4);
            if (IN(qb + 5)) { norm_phase(F, XW, SMv + SM_N2G + l * DM, modl, 6144, 8192, H, l == 3, (unsigned*)(ws + WS_XQ), (float*)(ws + WS_XS)); } SEAM(qb + 5);
            if (IN(qb + 6)) {
                pg8::Gemm g{H, (const bf16_t*)(ws + WS_WPQ) + (size_t)l * DM * DM, MROWS, DM, DM, DM, DM}; pg8::StaticOrder S; S.init(MROWS, DM, F.G, (int)blockIdx.x, true);
                pg8::EpiBf16 E{PQ, DM};
                if (l != 3) ctx_gemm_phase<false>(F, H, DM, (const bf16_t*)(ws + WS_WPQ) + (size_t)l * DM * DM, DM, DM, DM, PQ, nullptr, DM, nullptr);
                pg8::gemm_phase<pg8::EpiBf16, pg8::StaticOrder, true, true>(glds, g, S, E, phase_tid(F.wave));
            } SEAM(qb + 6);
            if (IN(qb + 7)) { peer_topk_phase(F, PQ, (const bf16_t*)(ws + WS_SUBK) + (size_t)l * 16 * 128 * 128, IDX, GATE, l == 3); } SEAM(qb + 7);
            {
                const unsigned char* Ut = ws + WS_U + (size_t)l * NEXP * ROWB; const unsigned char* Vt = ws + WS_VT + (size_t)l * NEXP * ROWB;
                peer_u_phase(F, (const unsigned*)(ws + WS_XQ), (const float*)(ws + WS_XS), IDX, Ut, (float*)(ws + WS_PART), l == 3); SEAM(0);
                peer_wq_phase(F, (const float*)(ws + WS_PART), IDX, GATE, (const float*)(ws + WS_USC) + l * NEXP, (const float*)(ws + WS_VSC) + l * NEXP, l == 3, ws + WS_WQ8, (float*)(ws + WS_WSC), (const float*)(ws + WS_XS)); SEAM(0);
                peer_v_phase(F, IDX, ws + WS_WQ8, (const float*)(ws + WS_WSC), Vt, modl + 10240, XW, (l == 3) ? args.out : nullptr, l == 3);
                if (lp == 0) { SEAM(0); norm_phase(F, XW, SMv + SM_N1G + (l + 1) * DM, mod + (size_t)(l + 1) * 3 * NMOD, 0, 2048, H, false); SEAM(0); }
            }
        }
    }
#undef IN
#undef SEAM
}

extern "C" void kernel_launch(void* const* d_in, const int* in_sizes, int n_in, void* d_out, int out_size, void* d_ws, size_t ws_size, hipStream_t stream) {
    static int grid = 0;
    if (grid == 0) {
        if (n_in != 26 || out_size != NBATCH * SEQ * DM || ws_size < WS_END) { fprintf(stderr, "kernel_launch: unexpected shapes: n_in %d out %d ws %zu (need %zu)\n", n_in, out_size, ws_size, (size_t)WS_END); grid = -1; return; }
        int dev = 0, cus = 0, per_cu = 0;
        if (hipGetDevice(&dev) != hipSuccess || hipDeviceGetAttribute(&cus, hipDeviceAttributeMultiprocessorCount, dev) != hipSuccess) { fprintf(stderr, "kernel_launch: device query failed\n"); grid = -1; return; }
        if (hipFuncSetAttribute((const void*)fwd_kernel, hipFuncAttributeMaxDynamicSharedMemorySize, LDS_BYTES) != hipSuccess) { fprintf(stderr, "kernel_launch: hipFuncSetAttribute failed\n"); grid = -1; return; }
        if (hipOccupancyMaxActiveBlocksPerMultiprocessor(&per_cu, (const void*)fwd_kernel, NTHREADS, LDS_BYTES) != hipSuccess || per_cu < 1) { fprintf(stderr, "kernel_launch: occupancy query says %d blocks per CU\n", per_cu); (void)hipGetLastError(); grid = -1; return; }
        if (cus % 8 != 0) { fprintf(stderr, "kernel_launch: %d CUs: the phase decompositions assume a multiple of 8 workgroups\n", cus); grid = -1; return; }
        grid = cus;
    }
    if (grid < 0) return;
    (void)hipMemsetAsync((char*)d_ws + WS_CTL, 0, CTL_ZERO_BYTES, stream);
    Args a{};
    for (int i = 0; i < 26; ++i) a.in[i] = (const float*)d_in[i];
    a.out = (float*)d_out; a.ws = (unsigned char*)d_ws;
    for (int li = 0; li < N_LAUNCHES; ++li) {
        a.ph_lo = (N_LAUNCHES == 1) ? 0 : li; a.ph_hi = (N_LAUNCHES == 1) ? NPHASES : li + 1;
        hipLaunchKernelGGL(fwd_kernel, dim3(grid), dim3(NTHREADS), LDS_BYTES, stream, a);
        const hipError_t le = hipPeekAtLastError();
        if (le != hipSuccess) { fprintf(stderr, "kernel_launch: launch %d failed: %s\n", li, hipGetErrorName(le)); break; }
    }
}
```

```cpp
#include <hip/hip_runtime.h>
#include <cstdio>
#include <cstdint>
namespace pg8 {
#define PG8_LAS __attribute__((address_space(3)))
typedef unsigned short bf16_t;
typedef short bf16x8 __attribute__((ext_vector_type(8)));
typedef float f32x4 __attribute__((ext_vector_type(4)));
typedef unsigned u32x4 __attribute__((ext_vector_type(4)));
constexpr int BM = 256, BK = 64, HALF = 128, HTB = HALF * BK * 2  , STAGE_BYTES = 8 * HTB, NXCD = 8, WGM = 8;

__host__ __device__ __forceinline__ int lds_byte(int r, int c) { const int st = (r >> 4) * 2 + (c >> 5), rr = r & 15, cc = c & 31, ob = rr * 64 + cc * 2; return st * 1024 + (ob ^ (((ob >> 9) & 1) << 5)); }
__host__ __device__ __forceinline__ void stage_rc(int b, int& R, int& C) { const int st = b / 1024, sb = b % 1024, swz = sb ^ (((sb >> 9) & 1) << 5); R = (st >> 1) * 16 + swz / 64; C = (st & 1) * 32 + (swz % 64) / 2; }
__host__ __device__ __forceinline__ int perm32(int rho) { const int n = rho >> 4, i = rho & 15; return 8 * (i >> 2) + 4 * n + (i & 3); }

struct Unit { int pm, pn; };
struct Gemm { const bf16_t* A; const bf16_t* Bt; int M, N, K, lda, ldb; };

struct StaticOrder {
    int nM, nN, nwg, G, c; bool lat_only;
    __host__ __device__ void init(int M, int N, int G_, int c_, bool lat_only_ = false) { lat_only = lat_only_; nM = lat_only_ ? 32 : M / BM; nN = N / BM; nwg = nM * nN; G = G_; c = c_; }
    __host__ __device__ bool next(int i, Unit& u) const {
        const long L = (long)i * G + c; if (L >= nwg) return false;
        int wgid = (int)L; { const int q = nwg / NXCD, r = nwg % NXCD, xcd = wgid % NXCD, off = wgid / NXCD; wgid = (xcd < r ? xcd * (q + 1) : r * (q + 1) + (xcd - r) * q) + off; }
        const int nig = WGM * nN, gid = wgid / nig, fm = gid * WGM, gsz = (nM - fm) < WGM ? (nM - fm) : WGM;
        u.pm = fm + ((wgid % nig) % gsz); u.pn = (wgid % nig) / gsz; if (lat_only) u.pm += 1 + (u.pm >= 16 ? 1 : 0); return true;
    }
    __device__ __forceinline__ void a_ready(const Unit&) const {}
    __device__ __forceinline__ void done(const Unit&) const {}
};
__device__ __forceinline__ unsigned cvt_pk_bf16(float lo, float hi) { unsigned r; asm volatile("v_cvt_pk_bf16_f32 %0, %1, %2" : "=v"(r) : "v"(lo), "v"(hi)); return r; }
typedef float f32x2 __attribute__((ext_vector_type(2)));
struct EpiBf16 {
    static constexpr bool PERM = true, AFTER_DRAIN = false;
    bf16_t* O; int ldc;
    __device__ __forceinline__ void operator()(const f32x4 (&acc)[2][2][4][2], const Unit& u, int wr, int wc, int fr, int fq) const {
        const int row0 = u.pm * BM + wr * 64 + fr, col0 = u.pn * BM + wc * 32 + 8 * fq;
#pragma unroll
        for (int ai = 0; ai < 2; ++ai)
#pragma unroll
            for (int m = 0; m < 4; ++m) { bf16_t* rowp = O + (size_t)(row0 + ai * HALF + m * 16) * ldc + col0;
#pragma unroll
                for (int bj = 0; bj < 2; ++bj) { const f32x4 v0 = acc[ai][bj][m][0], v1 = acc[ai][bj][m][1];
                    u32x4 w; w.x = cvt_pk_bf16(v0[0], v0[1]); w.y = cvt_pk_bf16(v0[2], v0[3]); w.z = cvt_pk_bf16(v1[0], v1[1]); w.w = cvt_pk_bf16(v1[2], v1[3]);
                    *(u32x4*)(rowp + bj * HALF) = w; } }
    }
};
struct EpiResid {
    static constexpr bool PERM = false, AFTER_DRAIN = false;
    bf16_t* X; int ldc; const float* gate;
    __device__ __forceinline__ void operator()(const f32x4 (&acc)[2][2][4][2], const Unit& u, int wr, int wc, int fr, int fq) const {
        const int row0 = u.pm * BM + wr * 64 + fr, col0 = u.pn * BM + wc * 32 + 4 * fq;
        const int cls = (u.pm % 17 == 0) ? 2 : (u.pm / 17);
        const float* gp = gate + (size_t)cls * 12288 + col0;
        f32x4 gv[2][2];
#pragma unroll
        for (int bj = 0; bj < 2; ++bj)
#pragma unroll
            for (int n = 0; n < 2; ++n) gv[bj][n] = *(const f32x4*)(gp + bj * HALF + n * 16);
#pragma unroll
        for (int ai = 0; ai < 2; ++ai)
#pragma unroll
            for (int m = 0; m < 4; ++m) { bf16_t* rowp = X + (size_t)(row0 + ai * HALF + m * 16) * ldc + col0;
#pragma unroll
                for (int bj = 0; bj < 2; ++bj)
#pragma unroll
                    for (int n = 0; n < 2; ++n) { typedef unsigned u32x2_ __attribute__((ext_vector_type(2))); u32x2_* p = (u32x2_*)(rowp + bj * HALF + n * 16); const u32x2_ w_ = *p;
                        const f32x4 xo_ = {__builtin_bit_cast(float, w_.x << 16), __builtin_bit_cast(float, w_.x & 0xffff0000u), __builtin_bit_cast(float, w_.y << 16), __builtin_bit_cast(float, w_.y & 0xffff0000u)};
                        const f32x4 xn_ = xo_ + gv[bj][n] * acc[ai][bj][m][n]; u32x2_ o_; o_.x = cvt_pk_bf16(xn_[0], xn_[1]); o_.y = cvt_pk_bf16(xn_[2], xn_[3]); *p = o_; } }
    }
};
template <class Epi, class Sched, bool ALIGN_EPI = false, bool SP2 = false>
__device__ __forceinline__ void gemm_phase(PG8_LAS unsigned char* lds, const Gemm g, const Sched& S, const Epi& E, int tid_in) {
    int tid_ = tid_in; asm volatile("" : "+v"(tid_));
    const int tid = tid_, wid = __builtin_amdgcn_readfirstlane(tid >> 6), lane = tid & 63, wr = wid >> 2, wc = wid & 3, fr = lane & 15, fq = lane >> 4;
    const int K = g.K, nt = K / BK;
    unsigned voffA[2], voffB[2];
#pragma unroll
    for (int i = 0; i < 2; ++i) { int R, C; stage_rc(tid * 16 + i * 8192, R, C); const int Rb = Epi::PERM ? ((R & ~31) + perm32(R & 31)) : R;
        voffA[i] = (unsigned)(R * g.lda + C) * 2u; voffB[i] = (unsigned)(Rb * g.ldb + C) * 2u; }
    const size_t kstep = (size_t)(BK * 2);
    const size_t hstepA = (size_t)HALF * g.lda * 2, hstepB = (size_t)HALF * g.ldb * 2;
    const size_t tstepA = 2 * hstepA, tstepB = 2 * hstepB;
    const unsigned ldsw = (unsigned)wid * 1024u;
    const int aoff = lds_byte(wr * 64 + fr, fq * 8), boff = lds_byte(wc * 32 + fr, fq * 8);
#define PG8_SA(b, h) (((b) * 2 + (h)) * HTB)
#define PG8_SB(b, h) ((4 + (b) * 2 + (h)) * HTB)
#define PG8_STAGE(bufoff, gbase, voff) do { _Pragma("unroll") for (int _i = 0; _i < 2; ++_i) \
        __builtin_amdgcn_global_load_lds((const unsigned*)((const char*)(gbase) + (voff)[_i]), (PG8_LAS unsigned*)(lds + (bufoff) + ldsw + _i * 8192), 16, 0, 0); } while (0)
#define PG8_LDA(dst, b, h) do { _Pragma("unroll") for (int m = 0; m < 4; ++m) _Pragma("unroll") for (int k = 0; k < 2; ++k) dst[m][k] = *(const PG8_LAS bf16x8*)(lds + PG8_SA(b, h) + aoff + m * 2048 + k * 1024); } while (0)
#define PG8_LDB(dst, b, h) do { _Pragma("unroll") for (int n = 0; n < 2; ++n) _Pragma("unroll") for (int k = 0; k < 2; ++k) dst[n][k] = *(const PG8_LAS bf16x8*)(lds + PG8_SB(b, h) + boff + n * 2048 + k * 1024); } while (0)
#define PG8_MMA(ai, bj, At, Bt) do { __builtin_amdgcn_s_setprio(1); _Pragma("unroll") for (int m = 0; m < 4; ++m) _Pragma("unroll") for (int n = 0; n < 2; ++n) _Pragma("unroll") for (int k = 0; k < 2; ++k) \
        acc[ai][bj][m][n] = __builtin_amdgcn_mfma_f32_16x16x32_bf16(Bt[n][k], At[m][k], acc[ai][bj][m][n], 0, 0, 0); __builtin_amdgcn_s_setprio(0); } while (0)
#define PG8_WAIT_V(n) asm volatile("s_waitcnt vmcnt(" #n ")" ::: "memory")
#define PG8_WAIT_L(n) asm volatile("s_waitcnt lgkmcnt(" #n ")" ::: "memory")
#define PG8_BAR __builtin_amdgcn_s_barrier()
#define PG8_SCHED __builtin_amdgcn_sched_barrier(0)
    Unit cur, nxt; int ui = 0;
    if (!S.next(0, cur)) return;
    f32x4 acc[2][2][4][2];
#pragma unroll
    for (int a = 0; a < 2; ++a)
#pragma unroll
        for (int b = 0; b < 2; ++b)
#pragma unroll
            for (int m = 0; m < 4; ++m)
#pragma unroll
                for (int n = 0; n < 2; ++n) acc[a][b][m][n] = (f32x4){0.f, 0.f, 0.f, 0.f};
    bf16x8 At[4][2], B0[2][2], B1[2][2];
    const char* cA = (const char*)g.A + (size_t)cur.pm * tstepA; const char* cB = (const char*)g.Bt + (size_t)cur.pn * tstepB;
    S.a_ready(cur);
    if constexpr (SP2) {
        PG8_STAGE(PG8_SB(0, 0), cB, voffB); PG8_STAGE(PG8_SB(0, 1), cB + hstepB, voffB); PG8_STAGE(PG8_SA(0, 0), cA, voffA); PG8_STAGE(PG8_SA(0, 1), cA + hstepA, voffA);
        if (wr == 1) PG8_BAR;
        PG8_WAIT_V(2); PG8_BAR;
        PG8_STAGE(PG8_SB(1, 0), cB + kstep, voffB); PG8_STAGE(PG8_SA(1, 0), cA + kstep, voffA); PG8_STAGE(PG8_SB(1, 1), cB + hstepB + kstep, voffB);
        PG8_WAIT_V(6); PG8_BAR;
    } else {
        PG8_STAGE(PG8_SB(0, 0), cB, voffB); PG8_STAGE(PG8_SA(0, 0), cA, voffA); PG8_STAGE(PG8_SB(0, 1), cB + hstepB, voffB); PG8_STAGE(PG8_SA(0, 1), cA + hstepA, voffA);
        if (wr == 1) PG8_BAR;
        PG8_WAIT_V(4); PG8_BAR;
        PG8_STAGE(PG8_SB(1, 0), cB + kstep, voffB); PG8_STAGE(PG8_SA(1, 0), cA + kstep, voffA); PG8_STAGE(PG8_SB(1, 1), cB + hstepB + kstep, voffB);
        PG8_WAIT_V(6); PG8_BAR;
    }
    for (;;) {
        const bool has_next = S.next(ui + 1, nxt);
        const char* nA = has_next ? (const char*)g.A + (size_t)nxt.pm * tstepA : cA; const char* nB = has_next ? (const char*)g.Bt + (size_t)nxt.pn * tstepB : cB;
        for (int t = 0; t < nt; t += 2) {
            const bool last = (t == nt - 2);
            const char* a1 = cA + (size_t)(t + 1) * kstep;
            const char* a2 = last ? nA : cA + (size_t)(t + 2) * kstep; const char* b2 = last ? nB : cB + (size_t)(t + 2) * kstep;
            const char* a3 = a2 + kstep; const char* b3 = b2 + kstep;
            if (last && has_next) S.a_ready(nxt);
            if constexpr (SP2) {
            PG8_LDB(B0, 0, 0); PG8_LDB(B1, 0, 1); PG8_SCHED; PG8_LDA(At, 0, 0); PG8_STAGE(PG8_SA(1, 1), a1 + hstepA, voffA);
            PG8_WAIT_V(8); PG8_WAIT_L(0); PG8_BAR; PG8_MMA(0, 0, At, B0); PG8_MMA(0, 1, At, B1); PG8_BAR; PG8_SCHED;
            PG8_LDA(At, 0, 1); PG8_STAGE(PG8_SB(0, 0), b2, voffB); PG8_STAGE(PG8_SB(0, 1), b2 + hstepB, voffB); PG8_STAGE(PG8_SA(0, 0), a2, voffA);
            PG8_WAIT_V(8); PG8_WAIT_L(0); PG8_BAR; PG8_MMA(1, 0, At, B0); PG8_MMA(1, 1, At, B1); PG8_BAR; PG8_SCHED;
            PG8_LDB(B0, 1, 0); PG8_LDB(B1, 1, 1); PG8_SCHED; PG8_LDA(At, 1, 0); PG8_STAGE(PG8_SA(0, 1), a2 + hstepA, voffA);
            PG8_WAIT_V(8); PG8_WAIT_L(0); PG8_BAR; PG8_MMA(0, 0, At, B0); PG8_MMA(0, 1, At, B1); PG8_BAR; PG8_SCHED;
            PG8_LDA(At, 1, 1); PG8_STAGE(PG8_SB(1, 0), b3, voffB); PG8_STAGE(PG8_SB(1, 1), b3 + hstepB, voffB); PG8_STAGE(PG8_SA(1, 0), a3, voffA);
            PG8_WAIT_V(8); PG8_WAIT_L(0); PG8_BAR; PG8_MMA(1, 0, At, B0); PG8_MMA(1, 1, At, B1); PG8_BAR; PG8_SCHED;
            } else {
            PG8_LDB(B0, 0, 0); PG8_SCHED; PG8_LDA(At, 0, 0); PG8_STAGE(PG8_SA(1, 1), a1 + hstepA, voffA);
            PG8_WAIT_L(8); PG8_BAR; PG8_WAIT_L(0); PG8_MMA(0, 0, At, B0); PG8_BAR; PG8_SCHED;
            PG8_LDB(B1, 0, 1); PG8_STAGE(PG8_SB(0, 0), b2, voffB);
            PG8_BAR; PG8_WAIT_L(0); PG8_MMA(0, 1, At, B1); PG8_BAR;
            PG8_LDA(At, 0, 1); PG8_STAGE(PG8_SA(0, 0), a2, voffA);
            PG8_BAR; PG8_WAIT_L(0); PG8_MMA(1, 0, At, B0); PG8_BAR; PG8_SCHED;
            PG8_STAGE(PG8_SB(0, 1), b2 + hstepB, voffB);
            PG8_WAIT_V(6); PG8_BAR; PG8_MMA(1, 1, At, B1); PG8_BAR;
            PG8_LDB(B0, 1, 0); PG8_SCHED; PG8_LDA(At, 1, 0); PG8_STAGE(PG8_SA(0, 1), a2 + hstepA, voffA);
            PG8_WAIT_L(8); PG8_BAR; PG8_WAIT_L(0); PG8_MMA(0, 0, At, B0); PG8_BAR; PG8_SCHED;
            PG8_LDB(B1, 1, 1); PG8_STAGE(PG8_SB(1, 0), b3, voffB);
            PG8_BAR; PG8_WAIT_L(0); PG8_MMA(0, 1, At, B1); PG8_BAR;
            PG8_LDA(At, 1, 1); PG8_STAGE(PG8_SA(1, 0), a3, voffA);
            PG8_BAR; PG8_WAIT_L(0); PG8_MMA(1, 0, At, B0); PG8_BAR; PG8_SCHED;
            PG8_STAGE(PG8_SB(1, 1), b3 + hstepB, voffB);
            PG8_WAIT_V(6); PG8_BAR; PG8_MMA(1, 1, At, B1); PG8_BAR;
            }
        }
        if constexpr (ALIGN_EPI) { if (wr == 0) PG8_BAR; }
        if constexpr (!Epi::AFTER_DRAIN) { E(acc, cur, wr, wc, fr, fq); S.done(cur); }
        if (!has_next) break;
#pragma unroll
        for (int a = 0; a < 2; ++a)
#pragma unroll
            for (int b = 0; b < 2; ++b)
#pragma unroll
                for (int m = 0; m < 4; ++m)
#pragma unroll
                    for (int n = 0; n < 2; ++n) acc[a][b][m][n] = (f32x4){0.f, 0.f, 0.f, 0.f};
        cur = nxt; cA = nA; cB = nB; ++ui;
        if constexpr (ALIGN_EPI) { if (wr == 1) PG8_BAR; }
    }
    PG8_WAIT_V(0);
    if constexpr (!ALIGN_EPI) { if (wr == 0) PG8_BAR; }
    PG8_BAR;
    if constexpr (Epi::AFTER_DRAIN) { E.fused(acc, cur, wr, wc, fr, fq, lds, wid, lane); S.done(cur); }
#undef PG8_SA
#undef PG8_SB
#undef PG8_STAGE
#undef PG8_LDA
#undef PG8_LDB
#undef PG8_MMA
#undef PG8_WAIT_V
#undef PG8_WAIT_L
#undef PG8_BAR
#undef PG8_SCHED
}
}
namespace att {
typedef unsigned short bf16_t;
using bf16x8 = __attribute__((ext_vector_type(8))) short;
using s16x4  = __attribute__((ext_vector_type(4))) short;
using f32x16 = __attribute__((ext_vector_type(16))) float;
using u32x4  = __attribute__((ext_vector_type(4))) unsigned;
constexpr int DV = 128, NW = 8, QBLK = 32, KVBLK = 64;
constexpr float THR = 8.f;
constexpr int SHM_V = KVBLK * DV * 2;
template <int DQK> struct Cfg {
    static constexpr int SHM_K = KVBLK * DQK * 2, KROWB = DQK * 2, NCK = DQK / 64, C8 = DQK / 8, ND0 = DQK / 16;
    static constexpr float SCALE = (DQK == 128) ? 0.088388347648318440f : 0.072168783648703220f;
    static constexpr int LDS_BYTES = 2 * SHM_V + 2 * SHM_K + NW * 64 * 4;
};
#define ATT_SBAR() __builtin_amdgcn_sched_barrier(0)
__device__ __forceinline__ int crow(int r, int hi) { return (r & 3) + 8 * (r >> 2) + 4 * hi; }
__device__ __forceinline__ unsigned cvtpk(float lo, float hi) { unsigned r; asm volatile("v_cvt_pk_bf16_f32 %0, %1, %2" : "=v"(r) : "v"(lo), "v"(hi)); return r; }
template <int DQK> __device__ __forceinline__ int kswz(int row, int colB) {
    const int key = (DQK == 128) ? (row & 7) : ((row >> 1) & 7);
    return row * (DQK * 2) + (colB ^ (key << 4));
}
template <int DQK> __device__ __forceinline__ void partialSM(f32x16& p0, f32x16& p1, float& m_reg, float& mn, float& alpha) {
    constexpr float SCALE = Cfg<DQK>::SCALE, C = SCALE * 1.4426950408889634f;
    float pmax = p0[0];
#pragma unroll
    for (int r = 1; r < 16; ++r) pmax = fmaxf(pmax, p0[r]);
#pragma unroll
    for (int r = 0; r < 16; ++r) pmax = fmaxf(pmax, p1[r]);
    { auto rr = __builtin_amdgcn_permlane32_swap(__float_as_uint(pmax), __float_as_uint(pmax), false, false);
      pmax = fmaxf(__uint_as_float(rr[0]), __uint_as_float(rr[1])); }
    if (__builtin_expect(__all(pmax - m_reg <= THR / SCALE), 1)) { mn = m_reg; alpha = 1.f; }
    else { mn = fmaxf(m_reg, pmax); alpha = __builtin_amdgcn_exp2f((m_reg - mn) * C); m_reg = mn; }
    const float mnC = -mn * C;
#pragma unroll
    for (int r = 0; r < 16; ++r) p0[r] = fmaf(p0[r], C, mnC);
#pragma unroll
    for (int r = 0; r < 16; ++r) p1[r] = fmaf(p1[r], C, mnC);
#pragma unroll
    for (int r = 0; r < 16; ++r) p0[r] = __builtin_amdgcn_exp2f(p0[r]);
}
__device__ __forceinline__ void finishSM(f32x16& p0, f32x16& p1, float alpha, float& l_reg, bf16x8& pa0, bf16x8& pa1, bf16x8& pa2, bf16x8& pa3) {
#pragma unroll
    for (int r = 0; r < 16; ++r) p1[r] = __builtin_amdgcn_exp2f(p1[r]);
    float ps = 0;
#pragma unroll
    for (int r = 0; r < 16; ++r) ps += p0[r];
#pragma unroll
    for (int r = 0; r < 16; ++r) ps += p1[r];
    { auto rr = __builtin_amdgcn_permlane32_swap(__float_as_uint(ps), __float_as_uint(ps), false, false);
      ps = __uint_as_float(rr[0]) + __uint_as_float(rr[1]); }
    l_reg = l_reg * alpha + ps;
#define ATT_PK4(P, BASE, OUT) do { unsigned a0 = cvtpk(P[BASE + 0], P[BASE + 1]), a1 = cvtpk(P[BASE + 2], P[BASE + 3]);   \
    unsigned b0 = cvtpk(P[BASE + 4], P[BASE + 5]), b1 = cvtpk(P[BASE + 6], P[BASE + 7]);                              \
    auto r0 = __builtin_amdgcn_permlane32_swap(a0, b0, false, false); auto r1 = __builtin_amdgcn_permlane32_swap(a1, b1, false, false); \
    u32x4 w = {r0[0], r1[0], r0[1], r1[1]}; OUT = *reinterpret_cast<bf16x8*>(&w); } while (0)
    ATT_PK4(p0, 0, pa0); ATT_PK4(p0, 8, pa1); ATT_PK4(p1, 0, pa2); ATT_PK4(p1, 8, pa3);
#undef ATT_PK4
}
template <int DQK> __device__ __forceinline__ void qkt(f32x16& p0, f32x16& p1, const char* Ks, const bf16x8* qr, int r32, int hi) {
    p0 = f32x16{}; p1 = f32x16{};
#pragma unroll
    for (int d0 = 0; d0 < Cfg<DQK>::ND0; ++d0) { const int cb = (d0 * 16 + hi * 8) * 2;
        bf16x8 b0 = *reinterpret_cast<const bf16x8*>(Ks + kswz<DQK>(r32, cb));
        bf16x8 b1 = *reinterpret_cast<const bf16x8*>(Ks + kswz<DQK>(32 + r32, cb));
        p0 = __builtin_amdgcn_mfma_f32_32x32x16_bf16(b0, qr[d0], p0, 0, 0, 0);
        p1 = __builtin_amdgcn_mfma_f32_32x32x16_bf16(b1, qr[d0], p1, 0, 0, 0); }
}
__device__ __forceinline__ int v_st(int k, int c) { const int kk = (k & ~0xC) | ((k & 4) << 1) | ((k & 8) >> 1); return ((kk >> 3) * 4 + (c >> 5)) * 512 + ((kk & 7) * 32 + (c & 31)) * 2; }
__device__ __forceinline__ int v_rd_base(int lane) { return ((lane & 3) << 3) | (((lane >> 2) & 3) << 6) | (((lane >> 4) & 1) << 5) | (((lane >> 5) & 1) << 8); }
constexpr int v_rd_off(int d0, int ks, int half) { return d0 * 512 + ks * 4096 + half * 2048; }
template <int OFF> __device__ __forceinline__ s16x4 tr_read(int vb) {
    s16x4 r; asm volatile("ds_read_b64_tr_b16 %0, %1 offset:%2" : "=&v"(r) : "v"(vb), "i"(OFF) : "memory"); return r;
}
template <int D0> __device__ __forceinline__ void pv_one(f32x16& od, int vb, bf16x8 pa0, bf16x8 pa1, bf16x8 pa2, bf16x8 pa3) {
    const s16x4 l0 = tr_read<v_rd_off(D0, 0, 0)>(vb), h0 = tr_read<v_rd_off(D0, 0, 1)>(vb), l1 = tr_read<v_rd_off(D0, 1, 0)>(vb), h1 = tr_read<v_rd_off(D0, 1, 1)>(vb);
    const s16x4 l2 = tr_read<v_rd_off(D0, 2, 0)>(vb), h2 = tr_read<v_rd_off(D0, 2, 1)>(vb), l3 = tr_read<v_rd_off(D0, 3, 0)>(vb), h3 = tr_read<v_rd_off(D0, 3, 1)>(vb);
    asm volatile("s_waitcnt lgkmcnt(0)" ::: "memory"); ATT_SBAR();
#define ATT_PK(L, H) (bf16x8){L[0], L[1], L[2], L[3], H[0], H[1], H[2], H[3]}
    od = __builtin_amdgcn_mfma_f32_32x32x16_bf16(pa0, ATT_PK(l0, h0), od, 0, 0, 0);
    od = __builtin_amdgcn_mfma_f32_32x32x16_bf16(pa1, ATT_PK(l1, h1), od, 0, 0, 0);
    od = __builtin_amdgcn_mfma_f32_32x32x16_bf16(pa2, ATT_PK(l2, h2), od, 0, 0, 0);
    od = __builtin_amdgcn_mfma_f32_32x32x16_bf16(pa3, ATT_PK(l3, h3), od, 0, 0, 0);
#undef ATT_PK
}
__device__ __forceinline__ void pv_d0(f32x16* o, int vb, bf16x8 pa0, bf16x8 pa1, bf16x8 pa2, bf16x8 pa3) {
    pv_one<0>(o[0], vb, pa0, pa1, pa2, pa3); pv_one<1>(o[1], vb, pa0, pa1, pa2, pa3); pv_one<2>(o[2], vb, pa0, pa1, pa2, pa3); pv_one<3>(o[3], vb, pa0, pa1, pa2, pa3);
}
template <int DQK, int LDQ, int LDK, int LDV, int LDO, int SDEPTH>
__device__ __forceinline__ void attn_body(const bf16_t* __restrict__ Qb, const bf16_t* __restrict__ Kh, const bf16_t* __restrict__ Vh, bf16_t* __restrict__ Ob, int seq, char* lds, int tid_in) {
    using C_ = Cfg<DQK>;
    constexpr int SHM_K = C_::SHM_K, NCK = C_::NCK, C8 = C_::C8, ND0 = C_::ND0;
    int tid_ = tid_in; asm volatile("" : "+v"(tid_));
    const int tid = tid_, wid = tid >> 6, lane = tid & 63, r32 = lane & 31, hi = lane >> 5;
    char* V_lds = lds; char* K_lds = lds + 2 * SHM_V;
    float* ws = (float*)(lds + 2 * SHM_V + 2 * SHM_K) + wid * 64; float* li_l = ws; float* al_l = ws + 32;
    float m_reg = -1e30f, l_reg = 0; f32x16 o[4] = {}; bf16x8 qr[ND0];
    const bf16_t* Qw = Qb + (long)(wid * QBLK + r32) * LDQ + hi * 8;
#pragma unroll
    for (int d0 = 0; d0 < ND0; ++d0) qr[d0] = *reinterpret_cast<const bf16x8*>(Qw + d0 * 16);
    const int sr = tid >> 4, sc = (tid & 15) * 8, vst0 = v_st(sr, sc), vst1 = v_st(32 + sr, sc);
    int krow[NCK], kcol[NCK];
#pragma unroll
    for (int i = 0; i < NCK; ++i) { const int ci = tid + 512 * i; krow[i] = ci / C8; kcol[i] = (ci % C8) * 8; }
    const int vb0 = (int)(uintptr_t)V_lds + v_rd_base(lane);
    struct { bf16x8 vs0, vs1, ks[NCK]; } sr_[SDEPTH];
#define ATT_SLOAD(i, k0) do { sr_[i].vs0 = *reinterpret_cast<const bf16x8*>(&Vh[(long)((k0) + sr) * LDV + sc]); sr_[i].vs1 = *reinterpret_cast<const bf16x8*>(&Vh[(long)((k0) + 32 + sr) * LDV + sc]); \
    _Pragma("unroll") for (int c_ = 0; c_ < NCK; ++c_) sr_[i].ks[c_] = *reinterpret_cast<const bf16x8*>(&Kh[(long)((k0) + krow[c_]) * LDK + kcol[c_]]); } while (0)
#define ATT_SWRITE(b, i) do { *(bf16x8*)(V_lds + (b) * SHM_V + vst0) = sr_[i].vs0; *(bf16x8*)(V_lds + (b) * SHM_V + vst1) = sr_[i].vs1; \
    _Pragma("unroll") for (int c_ = 0; c_ < NCK; ++c_) *(bf16x8*)(K_lds + (b) * SHM_K + kswz<DQK>(krow[c_], kcol[c_] * 2)) = sr_[i].ks[c_]; } while (0)
#define ATT_SWAIT() do { if constexpr (SDEPTH == 2) { if constexpr (NCK == 2) asm volatile("s_waitcnt vmcnt(4)" ::: "memory"); else asm volatile("s_waitcnt vmcnt(5)" ::: "memory"); } else asm volatile("s_waitcnt vmcnt(0)" ::: "memory"); } while (0)
#define ATT_RESC(a) do { if (__any((a) < 1.f)) { if (hi == 0) al_l[r32] = (a); asm volatile("s_waitcnt lgkmcnt(0)" ::: "memory"); \
    _Pragma("unroll") for (int d = 0; d < 4; ++d) _Pragma("unroll") for (int r = 0; r < 16; ++r) o[d][r] *= al_l[crow(r, hi)]; } } while (0)
    f32x16 pA0, pA1, pB0, pB1; float mnA, mnB, alA, alB; bf16x8 pa0, pa1, pa2, pa3; const int NT = seq / KVBLK;
    constexpr int SE = 0, SO = SDEPTH - 1;
    ATT_SLOAD(SE, 0); asm volatile("s_waitcnt vmcnt(0)" ::: "memory"); ATT_SWRITE(0, SE); __syncthreads();
    qkt<DQK>(pA0, pA1, K_lds, qr, r32, hi); partialSM<DQK>(pA0, pA1, m_reg, mnA, alA);
    ATT_SLOAD(SO, KVBLK); if constexpr (SDEPTH == 2) { if (2 < NT) ATT_SLOAD(SE, 2 * KVBLK); }
    ATT_SWAIT(); ATT_SWRITE(1, SO); __syncthreads();
    for (int j = 1; j + 1 < NT; j += 2) {
        ATT_SBAR(); qkt<DQK>(pB0, pB1, K_lds + SHM_K, qr, r32, hi);
        finishSM(pA0, pA1, alA, l_reg, pa0, pa1, pa2, pa3); ATT_SBAR();
        ATT_SLOAD(SO, (j + SDEPTH) * KVBLK); ATT_SBAR();
        pv_d0(o, vb0, pa0, pa1, pa2, pa3); partialSM<DQK>(pB0, pB1, m_reg, mnB, alB);
        __syncthreads(); ATT_SWAIT(); ATT_SWRITE(0, SE);
        ATT_RESC(alB); __syncthreads();
        ATT_SBAR(); qkt<DQK>(pA0, pA1, K_lds, qr, r32, hi);
        finishSM(pB0, pB1, alB, l_reg, pa0, pa1, pa2, pa3); ATT_SBAR();
        if (SDEPTH == 1 || j + 3 < NT) ATT_SLOAD(SE, (j + 1 + SDEPTH) * KVBLK); ATT_SBAR();
        pv_d0(o, vb0 + (int)SHM_V, pa0, pa1, pa2, pa3); partialSM<DQK>(pA0, pA1, m_reg, mnA, alA);
        __syncthreads(); ATT_SWAIT(); ATT_SWRITE(1, SO);
        ATT_RESC(alA); __syncthreads();
    }
    ATT_SBAR(); qkt<DQK>(pB0, pB1, K_lds + SHM_K, qr, r32, hi);
    finishSM(pA0, pA1, alA, l_reg, pa0, pa1, pa2, pa3); ATT_SBAR();
    pv_d0(o, vb0, pa0, pa1, pa2, pa3); partialSM<DQK>(pB0, pB1, m_reg, mnB, alB);
    __syncthreads(); ATT_RESC(alB);
    finishSM(pB0, pB1, alB, l_reg, pa0, pa1, pa2, pa3); ATT_SBAR();
    pv_d0(o, vb0 + (int)SHM_V, pa0, pa1, pa2, pa3);
    if (hi == 0) li_l[r32] = l_reg;
    asm volatile("s_waitcnt lgkmcnt(0)" ::: "memory");
    __syncthreads();
    float rli[16];
#pragma unroll
    for (int r = 0; r < 16; ++r) rli[r] = __builtin_amdgcn_rcpf(li_l[crow(r, hi)]);
    unsigned short* stg = (unsigned short*)(lds + wid * 8192);
#pragma unroll
    for (int r = 0; r < 16; ++r) { const int orow = crow(r, hi);
#pragma unroll
        for (int d0 = 0; d0 < 4; ++d0) { const unsigned w = cvtpk(o[d0][r] * rli[r], 0.f); stg[orow * 128 + d0 * 32 + r32] = (unsigned short)(w & 0xffffu); } }
    asm volatile("s_waitcnt lgkmcnt(0)" ::: "memory");
    bf16_t* Ow = Ob + (long)(wid * QBLK) * LDO;
#pragma unroll
    for (int i = 0; i < 8; ++i) { const int id = lane + 64 * i, row = id >> 4, c16 = id & 15;
        const u32x4 v = *(const u32x4*)((const char*)stg + row * 256 + c16 * 16);
        *(u32x4*)(Ow + (long)row * LDO + c16 * 8) = v; }
    asm volatile("s_waitcnt lgkmcnt(0)" ::: "memory");
    __syncthreads();
#undef ATT_SLOAD
#undef ATT_SWRITE
#undef ATT_SWAIT
#undef ATT_RESC
}

template <int DQK, int LDQ, int LDK, int LDV, int LDO>
__device__ __forceinline__ void attn_body1(const bf16_t* __restrict__ Qb, const bf16_t* __restrict__ Kh, const bf16_t* __restrict__ Vh, bf16_t* __restrict__ Ob, int seq, char* lds, int tid_in) {
    using C_ = Cfg<DQK>;
    constexpr int SHM_K = C_::SHM_K, NCK = C_::NCK, C8 = C_::C8, ND0 = C_::ND0;
    int tid_ = tid_in; asm volatile("" : "+v"(tid_));
    const int tid = tid_, wid = tid >> 6, lane = tid & 63, r32 = lane & 31, hi = lane >> 5;
    char* V_lds = lds; char* K_lds = lds + 2 * SHM_V;
    float* ws = (float*)(lds + 2 * SHM_V + 2 * SHM_K) + wid * 64; float* li_l = ws; float* al_l = ws + 32;
    float m_reg = -1e30f, l_reg = 0; f32x16 o[4] = {}; bf16x8 qr[ND0];
    const bf16_t* Qw = Qb + (long)(wid * QBLK + r32) * LDQ + hi * 8;
#pragma unroll
    for (int d0 = 0; d0 < ND0; ++d0) qr[d0] = *reinterpret_cast<const bf16x8*>(Qw + d0 * 16);
    const int sr = tid >> 4, sc = (tid & 15) * 8, vst0 = v_st(sr, sc), vst1 = v_st(32 + sr, sc);
    int krow[NCK], kcol[NCK];
#pragma unroll
    for (int i = 0; i < NCK; ++i) { const int ci = tid + 512 * i; krow[i] = ci / C8; kcol[i] = (ci % C8) * 8; }
    const int vb0 = (int)(uintptr_t)V_lds + v_rd_base(lane);
    bf16x8 vs0, vs1, ks[NCK];
#define ATT1_SLOAD(k0) do { vs0 = *reinterpret_cast<const bf16x8*>(&Vh[(long)((k0) + sr) * LDV + sc]); vs1 = *reinterpret_cast<const bf16x8*>(&Vh[(long)((k0) + 32 + sr) * LDV + sc]); \
    _Pragma("unroll") for (int c_ = 0; c_ < NCK; ++c_) ks[c_] = *reinterpret_cast<const bf16x8*>(&Kh[(long)((k0) + krow[c_]) * LDK + kcol[c_]]); } while (0)
#define ATT1_SWRITE(b) do { *(bf16x8*)(V_lds + (b) * SHM_V + vst0) = vs0; *(bf16x8*)(V_lds + (b) * SHM_V + vst1) = vs1; \
    _Pragma("unroll") for (int c_ = 0; c_ < NCK; ++c_) *(bf16x8*)(K_lds + (b) * SHM_K + kswz<DQK>(krow[c_], kcol[c_] * 2)) = ks[c_]; } while (0)
    const int NT = seq / KVBLK;
    ATT1_SLOAD(0); asm volatile("s_waitcnt vmcnt(0)" ::: "memory"); ATT1_SWRITE(0); __syncthreads();
    for (int j = 0; j < NT; ++j) {
        const int b = j & 1;
        if (j + 1 < NT) ATT1_SLOAD((j + 1) * KVBLK);
        ATT_SBAR();
        f32x16 p0, p1; float mn, alpha; bf16x8 pa0, pa1, pa2, pa3;
        qkt<DQK>(p0, p1, K_lds + b * SHM_K, qr, r32, hi);
        partialSM<DQK>(p0, p1, m_reg, mn, alpha);
        if (__any(alpha < 1.f)) { if (hi == 0) al_l[r32] = alpha; asm volatile("s_waitcnt lgkmcnt(0)" ::: "memory");
#pragma unroll
            for (int d = 0; d < 4; ++d)
#pragma unroll
                for (int r = 0; r < 16; ++r) o[d][r] *= al_l[crow(r, hi)]; }
        finishSM(p0, p1, alpha, l_reg, pa0, pa1, pa2, pa3); ATT_SBAR();
        pv_d0(o, vb0 + b * (int)SHM_V, pa0, pa1, pa2, pa3);
        if (j + 1 < NT) { ATT1_SWRITE(b ^ 1); }
        __syncthreads();
    }
    if (hi == 0) li_l[r32] = l_reg;
    asm volatile("s_waitcnt lgkmcnt(0)" ::: "memory");
    __syncthreads();
    float rli[16];
#pragma unroll
    for (int r = 0; r < 16; ++r) rli[r] = __builtin_amdgcn_rcpf(li_l[crow(r, hi)]);
    unsigned short* stg = (unsigned short*)(lds + wid * 8192);
#pragma unroll
    for (int r = 0; r < 16; ++r) { const int orow = crow(r, hi);
#pragma unroll
        for (int d0 = 0; d0 < 4; ++d0) { const unsigned w = cvtpk(o[d0][r] * rli[r], 0.f); stg[orow * 128 + d0 * 32 + r32] = (unsigned short)(w & 0xffffu); } }
    asm volatile("s_waitcnt lgkmcnt(0)" ::: "memory");
    bf16_t* Ow = Ob + (long)(wid * QBLK) * LDO;
#pragma unroll
    for (int i = 0; i < 8; ++i) { const int id = lane + 64 * i, row = id >> 4, c16 = id & 15;
        const u32x4 v = *(const u32x4*)((const char*)stg + row * 256 + c16 * 16);
        *(u32x4*)(Ow + (long)row * LDO + c16 * 8) = v; }
    asm volatile("s_waitcnt lgkmcnt(0)" ::: "memory");
    __syncthreads();
#undef ATT1_SLOAD
#undef ATT1_SWRITE
}
template <int DQK, int LDQ, int LDK, int LDV, int LDO>
__device__ __forceinline__ void attn_body1g(const bf16_t* __restrict__ Qb, const bf16_t* __restrict__ Kh, const bf16_t* __restrict__ Vh, bf16_t* __restrict__ Ob, int seq, char* lds, int tid_in) {
    using C_ = Cfg<DQK>;
    constexpr int SHM_K = C_::SHM_K, NCK = C_::NCK, ND0 = C_::ND0, KROWB = C_::KROWB;
    typedef __attribute__((address_space(3))) unsigned l3u;
    int tid_ = tid_in; asm volatile("" : "+v"(tid_));
    const int tid = tid_, wid = tid >> 6, lane = tid & 63, r32 = lane & 31, hi = lane >> 5;
    const int widu = __builtin_amdgcn_readfirstlane(wid);
    char* V_lds = lds; char* K_lds = lds + 3 * SHM_V;
    __attribute__((address_space(3))) char* l3 = (__attribute__((address_space(3))) char*)lds;
    float* ws = (float*)(lds + 3 * SHM_V + 3 * SHM_K) + wid * 64; float* li_l = ws; float* al_l = ws + 32;
    float m_reg = -1e30f, l_reg = 0; f32x16 o[4] = {}; bf16x8 qr[ND0];
    const bf16_t* Qw = Qb + (long)(wid * QBLK + r32) * LDQ + hi * 8;
#pragma unroll
    for (int d0 = 0; d0 < ND0; ++d0) qr[d0] = *reinterpret_cast<const bf16x8*>(Qw + d0 * 16);
    int koff[NCK], voff[2];
#pragma unroll
    for (int i = 0; i < NCK; ++i) { const int ob = (wid + 8 * i) * 1024 + 16 * lane, row = ob / KROWB, pos = (ob - row * KROWB) >> 4;
        const int key = (DQK == 128) ? (row & 7) : ((row >> 1) & 7); koff[i] = row * LDK + ((pos ^ key) << 3); }
#pragma unroll
    for (int i = 0; i < 2; ++i) { const int ob = (wid + 8 * i) * 1024 + 16 * lane, st = ob >> 9, r = ob & 511, kk = (st >> 2) * 8 + (r >> 6), c = (st & 3) * 32 + ((r & 63) >> 1);
        const int k = (kk & ~0xC) | ((kk & 4) << 1) | ((kk & 8) >> 1); voff[i] = k * LDV + c; }
    const int vb0 = (int)(uintptr_t)V_lds + v_rd_base(lane);
    const int NT = seq / KVBLK;
#define ATT1G_ISSUE(jt, b) do { const int jc_ = (jt) < NT ? (jt) : NT - 1; const bf16_t* kp_ = Kh + (long)jc_ * KVBLK * LDK; const bf16_t* vp_ = Vh + (long)jc_ * KVBLK * LDV; \
    _Pragma("unroll") for (int i_ = 0; i_ < NCK; ++i_) __builtin_amdgcn_global_load_lds((const unsigned*)(kp_ + koff[i_]), (l3u*)(l3 + 3 * SHM_V + (b) * SHM_K + (widu + 8 * i_) * 1024), 16, 0, 0); \
    _Pragma("unroll") for (int i_ = 0; i_ < 2; ++i_) __builtin_amdgcn_global_load_lds((const unsigned*)(vp_ + voff[i_]), (l3u*)(l3 + (b) * SHM_V + (widu + 8 * i_) * 1024), 16, 0, 0); } while (0)
    ATT1G_ISSUE(0, 0); ATT1G_ISSUE(1, 1);
    asm volatile("s_waitcnt vmcnt(%0)" :: "n"(NCK + 2) : "memory");
    __builtin_amdgcn_s_barrier(); ATT_SBAR();
    int b = 0, b2 = 2;
    for (int j = 0; j < NT; ++j) {
        ATT1G_ISSUE(j + 2, b2);
        ATT_SBAR();
        f32x16 p0, p1; float mn, alpha; bf16x8 pa0, pa1, pa2, pa3;
        qkt<DQK>(p0, p1, K_lds + b * SHM_K, qr, r32, hi);
        partialSM<DQK>(p0, p1, m_reg, mn, alpha);
        if (__any(alpha < 1.f)) { if (hi == 0) al_l[r32] = alpha; asm volatile("s_waitcnt lgkmcnt(0)" ::: "memory");
#pragma unroll
            for (int d = 0; d < 4; ++d)
#pragma unroll
                for (int r = 0; r < 16; ++r) o[d][r] *= al_l[crow(r, hi)]; }
        finishSM(p0, p1, alpha, l_reg, pa0, pa1, pa2, pa3); ATT_SBAR();
        pv_d0(o, vb0 + b * (int)SHM_V, pa0, pa1, pa2, pa3);
        asm volatile("s_waitcnt vmcnt(%0) lgkmcnt(0)" :: "n"(NCK + 2) : "memory");
        __builtin_amdgcn_s_barrier(); ATT_SBAR();
        b = (b == 2) ? 0 : b + 1; b2 = (b2 == 2) ? 0 : b2 + 1;
    }
    asm volatile("s_waitcnt vmcnt(0)" ::: "memory");
    if (hi == 0) li_l[r32] = l_reg;
    asm volatile("s_waitcnt lgkmcnt(0)" ::: "memory");
    __syncthreads();
    float rli[16];
#pragma unroll
    for (int r = 0; r < 16; ++r) rli[r] = __builtin_amdgcn_rcpf(li_l[crow(r, hi)]);
    unsigned short* stg = (unsigned short*)(lds + wid * 8192);
#pragma unroll
    for (int r = 0; r < 16; ++r) { const int orow = crow(r, hi);
#pragma unroll
        for (int d0 = 0; d0 < 4; ++d0) { const unsigned w = cvtpk(o[d0][r] * rli[r], 0.f); stg[orow * 128 + d0 * 32 + r32] = (unsigned short)(w & 0xffffu); } }
    asm volatile("s_waitcnt lgkmcnt(0)" ::: "memory");
    bf16_t* Ow = Ob + (long)(wid * QBLK) * LDO;
#pragma unroll
    for (int i = 0; i < 8; ++i) { const int id = lane + 64 * i, row = id >> 4, c16 = id & 15;
        const u32x4 v = *(const u32x4*)((const char*)stg + row * 256 + c16 * 16);
        *(u32x4*)(Ow + (long)row * LDO + c16 * 8) = v; }
    asm volatile("s_waitcnt lgkmcnt(0)" ::: "memory");
    __syncthreads();
#undef ATT1G_ISSUE
}
template <int DQK, int LDQ, int LDK, int LDV, int LDO>
__device__ __forceinline__ void attn_body2g(const bf16_t* __restrict__ Qb, const bf16_t* __restrict__ Kh, const bf16_t* __restrict__ Vh, bf16_t* __restrict__ Ob, int seq, char* lds, int tid_in) {
    using C_ = Cfg<DQK>;
    constexpr int SHM_K = C_::SHM_K, NCK = C_::NCK, ND0 = C_::ND0, KROWB = C_::KROWB;
    typedef __attribute__((address_space(3))) unsigned l3u;
    int tid_ = tid_in; asm volatile("" : "+v"(tid_));
    const int tid = tid_, wid = tid >> 6, lane = tid & 63, r32 = lane & 31, hi = lane >> 5;
    const int widu = __builtin_amdgcn_readfirstlane(wid);
    char* V_lds = lds; char* K_lds = lds + 3 * SHM_V;
    __attribute__((address_space(3))) char* l3 = (__attribute__((address_space(3))) char*)lds;
    float* ws = (float*)(lds + 3 * SHM_V + 3 * SHM_K) + wid * 64; float* li_l = ws; float* al_l = ws + 32;
    float m_reg = -1e30f, l_reg = 0; f32x16 o[4] = {}; bf16x8 qr[ND0];
    const bf16_t* Qw = Qb + (long)(wid * QBLK + r32) * LDQ + hi * 8;
#pragma unroll
    for (int d0 = 0; d0 < ND0; ++d0) qr[d0] = *reinterpret_cast<const bf16x8*>(Qw + d0 * 16);
    int koff[NCK], voff[2];
#pragma unroll
    for (int i = 0; i < NCK; ++i) { const int ob = (wid + 8 * i) * 1024 + 16 * lane, row = ob / KROWB, pos = (ob - row * KROWB) >> 4;
        const int key = (DQK == 128) ? (row & 7) : ((row >> 1) & 7); koff[i] = row * LDK + ((pos ^ key) << 3); }
#pragma unroll
    for (int i = 0; i < 2; ++i) { const int ob = (wid + 8 * i) * 1024 + 16 * lane, st = ob >> 9, r = ob & 511, kk = (st >> 2) * 8 + (r >> 6), c = (st & 3) * 32 + ((r & 63) >> 1);
        const int k = (kk & ~0xC) | ((kk & 4) << 1) | ((kk & 8) >> 1); voff[i] = k * LDV + c; }
    const int vb0 = (int)(uintptr_t)V_lds + v_rd_base(lane);
    const int NT = seq / KVBLK;
#define ATT2G_K(jt, b) do { const int jc_ = (jt) < NT ? (jt) : NT - 1; const bf16_t* kp_ = Kh + (long)jc_ * KVBLK * LDK; \
    _Pragma("unroll") for (int i_ = 0; i_ < NCK; ++i_) __builtin_amdgcn_global_load_lds((const unsigned*)(kp_ + koff[i_]), (l3u*)(l3 + 3 * SHM_V + (b) * SHM_K + (widu + 8 * i_) * 1024), 16, 0, 0); } while (0)
#define ATT2G_V(jt, b) do { const int jc_ = (jt) < NT ? (jt) : NT - 1; const bf16_t* vp_ = Vh + (long)jc_ * KVBLK * LDV; \
    _Pragma("unroll") for (int i_ = 0; i_ < 2; ++i_) __builtin_amdgcn_global_load_lds((const unsigned*)(vp_ + voff[i_]), (l3u*)(l3 + (b) * SHM_V + (widu + 8 * i_) * 1024), 16, 0, 0); } while (0)
#define ATT2G_RESC(a) do { if (__any((a) < 1.f)) { if (hi == 0) al_l[r32] = (a); asm volatile("s_waitcnt lgkmcnt(0)" ::: "memory"); \
    _Pragma("unroll") for (int d = 0; d < 4; ++d) _Pragma("unroll") for (int r = 0; r < 16; ++r) o[d][r] *= al_l[crow(r, hi)]; } } while (0)
#define ATT2G_SYNC() do { asm volatile("s_waitcnt vmcnt(%0) lgkmcnt(0)" :: "n"(NCK + 2) : "memory"); __builtin_amdgcn_s_barrier(); ATT_SBAR(); } while (0)
#define ATT2G_STEP(PC0, PC1, PP0, PP1, ALP, ALC, MNC) do { \
        ATT2G_K(j + 2, k2); ATT2G_V(j + 1, v1); ATT_SBAR(); \
        qkt<DQK>(PC0, PC1, K_lds + kc * SHM_K, qr, r32, hi); \
        finishSM(PP0, PP1, ALP, l_reg, pa0, pa1, pa2, pa3); ATT_SBAR(); \
        pv_d0(o, vb0 + vp * (int)SHM_V, pa0, pa1, pa2, pa3); partialSM<DQK>(PC0, PC1, m_reg, MNC, ALC); \
        ATT2G_SYNC(); ATT2G_RESC(ALC); \
        kc = (kc == 2) ? 0 : kc + 1; k2 = (k2 == 2) ? 0 : k2 + 1; vp = (vp == 2) ? 0 : vp + 1; v1 = (v1 == 2) ? 0 : v1 + 1; ++j; } while (0)
    f32x16 pA0, pA1, pB0, pB1; float mnA, mnB, alA, alB; bf16x8 pa0, pa1, pa2, pa3;
    ATT2G_K(0, 0); ATT2G_V(0, 0); ATT2G_K(1, 1);
    ATT2G_K(2, 2); ATT2G_V(1, 1);
    ATT2G_SYNC();
    qkt<DQK>(pA0, pA1, K_lds, qr, r32, hi); partialSM<DQK>(pA0, pA1, m_reg, mnA, alA);
    asm volatile("s_waitcnt lgkmcnt(0)" ::: "memory"); __builtin_amdgcn_s_barrier(); ATT_SBAR();
    int j = 1, kc = 1, k2 = 0, vp = 0, v1 = 2;
    while (j + 1 < NT) {
        ATT2G_STEP(pB0, pB1, pA0, pA1, alA, alB, mnB);
        ATT2G_STEP(pA0, pA1, pB0, pB1, alB, alA, mnA);
    }
    ATT2G_STEP(pB0, pB1, pA0, pA1, alA, alB, mnB);
    finishSM(pB0, pB1, alB, l_reg, pa0, pa1, pa2, pa3); ATT_SBAR();
    pv_d0(o, vb0 + vp * (int)SHM_V, pa0, pa1, pa2, pa3);
    asm volatile("s_waitcnt vmcnt(0)" ::: "memory");
    if (hi == 0) li_l[r32] = l_reg;
    asm volatile("s_waitcnt lgkmcnt(0)" ::: "memory");
    __syncthreads();
    float rli[16];
#pragma unroll
    for (int r = 0; r < 16; ++r) rli[r] = __builtin_amdgcn_rcpf(li_l[crow(r, hi)]);
    unsigned short* stg = (unsigned short*)(lds + wid * 8192);
#pragma unroll
    for (int r = 0; r < 16; ++r) { const int orow = crow(r, hi);
#pragma unroll
        for (int d0 = 0; d0 < 4; ++d0) { const unsigned w = cvtpk(o[d0][r] * rli[r], 0.f); stg[orow * 128 + d0 * 32 + r32] = (unsigned short)(w & 0xffffu); } }
    asm volatile("s_waitcnt lgkmcnt(0)" ::: "memory");
    bf16_t* Ow = Ob + (long)(wid * QBLK) * LDO;
#pragma unroll
    for (int i = 0; i < 8; ++i) { const int id = lane + 64 * i, row = id >> 4, c16 = id & 15;
        const u32x4 v = *(const u32x4*)((const char*)stg + row * 256 + c16 * 16);
        *(u32x4*)(Ow + (long)row * LDO + c16 * 8) = v; }
    asm volatile("s_waitcnt lgkmcnt(0)" ::: "memory");
    __syncthreads();
#undef ATT2G_STEP
#undef ATT2G_SYNC
#undef ATT2G_RESC
#undef ATT2G_V
#undef ATT2G_K
}
template <int DQK, int LDQ, int LDK, int LDV, int LDO>
__device__ __forceinline__ void attn_body1s(const bf16_t* __restrict__ Qb, const bf16_t* __restrict__ Kh, const bf16_t* __restrict__ Vh, bf16_t* __restrict__ Ob, int seq, char* lds, int tid_in) {
    using C_ = Cfg<DQK>;
    constexpr int SHM_K = C_::SHM_K, NCK = C_::NCK, C8 = C_::C8, ND0 = C_::ND0;
    int tid_ = tid_in; asm volatile("" : "+v"(tid_));
    const bool grpB = __builtin_amdgcn_readfirstlane(tid_ >> 16) != 0;
    const int tid = tid_ & 0xffff, wid = tid >> 6, lane = tid & 63, r32 = lane & 31, hi = lane >> 5;
    char* V_lds = lds; char* K_lds = lds + 2 * SHM_V;
    float* ws = (float*)(lds + 2 * SHM_V + 2 * SHM_K) + wid * 64; float* li_l = ws; float* al_l = ws + 32;
    float m_reg = -1e30f, l_reg = 0; f32x16 o[4] = {}; bf16x8 qr[ND0];
    const bf16_t* Qw = Qb + (long)(wid * QBLK + r32) * LDQ + hi * 8;
#pragma unroll
    for (int d0 = 0; d0 < ND0; ++d0) qr[d0] = *reinterpret_cast<const bf16x8*>(Qw + d0 * 16);
    const int sr = tid >> 4, sc = (tid & 15) * 8, vst0 = v_st(sr, sc), vst1 = v_st(32 + sr, sc);
    int krow[NCK], kcol[NCK];
#pragma unroll
    for (int i = 0; i < NCK; ++i) { const int ci = tid + 512 * i; krow[i] = ci / C8; kcol[i] = (ci % C8) * 8; }
    const int vb0 = (int)(uintptr_t)V_lds + v_rd_base(lane);
    bf16x8 vs0, vs1, ks[NCK];
#define ATT1_SLOAD(k0) do { vs0 = *reinterpret_cast<const bf16x8*>(&Vh[(long)((k0) + sr) * LDV + sc]); vs1 = *reinterpret_cast<const bf16x8*>(&Vh[(long)((k0) + 32 + sr) * LDV + sc]); \
    _Pragma("unroll") for (int c_ = 0; c_ < NCK; ++c_) ks[c_] = *reinterpret_cast<const bf16x8*>(&Kh[(long)((k0) + krow[c_]) * LDK + kcol[c_]]); } while (0)
#define ATT1_SWRITE(b) do { *(bf16x8*)(V_lds + (b) * SHM_V + vst0) = vs0; *(bf16x8*)(V_lds + (b) * SHM_V + vst1) = vs1; \
    _Pragma("unroll") for (int c_ = 0; c_ < NCK; ++c_) *(bf16x8*)(K_lds + (b) * SHM_K + kswz<DQK>(krow[c_], kcol[c_] * 2)) = ks[c_]; } while (0)
    const int NT = seq / KVBLK;
    ATT1_SLOAD(0); asm volatile("s_waitcnt vmcnt(0)" ::: "memory"); ATT1_SWRITE(0); __syncthreads();
#define ATT1_SM(P0, P1, PA0, PA1, PA2, PA3) do { float mn, alpha; partialSM<DQK>(P0, P1, m_reg, mn, alpha); \
        if (__any(alpha < 1.f)) { if (hi == 0) al_l[r32] = alpha; asm volatile("s_waitcnt lgkmcnt(0)" ::: "memory"); \
            _Pragma("unroll") for (int d = 0; d < 4; ++d) _Pragma("unroll") for (int r = 0; r < 16; ++r) o[d][r] *= al_l[crow(r, hi)]; } \
        finishSM(P0, P1, alpha, l_reg, PA0, PA1, PA2, PA3); ATT_SBAR(); } while (0)
    if (!grpB) {
        for (int j = 0; j < NT; ++j) {
            const int b = j & 1;
            if (j + 1 < NT) ATT1_SLOAD((j + 1) * KVBLK);
            ATT_SBAR();
            f32x16 p0, p1; bf16x8 pa0, pa1, pa2, pa3;
            qkt<DQK>(p0, p1, K_lds + b * SHM_K, qr, r32, hi);
            __syncthreads();
            ATT1_SM(p0, p1, pa0, pa1, pa2, pa3);
            pv_d0(o, vb0 + b * (int)SHM_V, pa0, pa1, pa2, pa3);
            if (j + 1 < NT) { ATT1_SWRITE(b ^ 1); }
            __syncthreads();
        }
    } else {
        bf16x8 pa0, pa1, pa2, pa3;
        {
            if (1 < NT) ATT1_SLOAD(KVBLK);
            ATT_SBAR();
            __syncthreads();
            f32x16 p0, p1;
            qkt<DQK>(p0, p1, K_lds, qr, r32, hi);
            ATT1_SM(p0, p1, pa0, pa1, pa2, pa3);
            if (1 < NT) { ATT1_SWRITE(1); }
            __syncthreads();
        }
        for (int j = 1; j < NT; ++j) {
            const int b = j & 1;
            if (j + 1 < NT) ATT1_SLOAD((j + 1) * KVBLK);
            ATT_SBAR();
            pv_d0(o, vb0 + (b ^ 1) * (int)SHM_V, pa0, pa1, pa2, pa3);
            __syncthreads();
            f32x16 p0, p1;
            qkt<DQK>(p0, p1, K_lds + b * SHM_K, qr, r32, hi);
            ATT1_SM(p0, p1, pa0, pa1, pa2, pa3);
            if (j + 1 < NT) { ATT1_SWRITE(b ^ 1); }
            __syncthreads();
        }
        pv_d0(o, vb0 + ((NT - 1) & 1) * (int)SHM_V, pa0, pa1, pa2, pa3);
    }
#undef ATT1_SM
    if (hi == 0) li_l[r32] = l_reg;
    asm volatile("s_waitcnt lgkmcnt(0)" ::: "memory");
    __syncthreads();
    float rli[16];
#pragma unroll
    for (int r = 0; r < 16; ++r) rli[r] = __builtin_amdgcn_rcpf(li_l[crow(r, hi)]);
    unsigned short* stg = (unsigned short*)(lds + wid * 8192);
#pragma unroll
    for (int r = 0; r < 16; ++r) { const int orow = crow(r, hi);
#pragma unroll
        for (int d0 = 0; d0 < 4; ++d0) { const unsigned w = cvtpk(o[d0][r] * rli[r], 0.f); stg[orow * 128 + d0 * 32 + r32] = (unsigned short)(w & 0xffffu); } }
    asm volatile("s_waitcnt lgkmcnt(0)" ::: "memory");
    bf16_t* Ow = Ob + (long)(wid * QBLK) * LDO;
#pragma unroll
    for (int i = 0; i < 8; ++i) { const int id = lane + 64 * i, row = id >> 4, c16 = id & 15;
        const u32x4 v = *(const u32x4*)((const char*)stg + row * 256 + c16 * 16);
        *(u32x4*)(Ow + (long)row * LDO + c16 * 8) = v; }
    asm volatile("s_waitcnt lgkmcnt(0)" ::: "memory");
    __syncthreads();
#undef ATT1_SLOAD
#undef ATT1_SWRITE
}
}
constexpr int DM = 2048, NBATCH = 2, SEQ = 4096, CTX = 256, RB = SEQ + CTX  , MROWS = NBATCH * RB  ;
constexpr int NMOD = 6 * DM, NEXP = 16384;
constexpr float EPS = 1e-6f;
constexpr int NWAVES = 8, NTHREADS = 512;
constexpr size_t MiB = 1u << 20;
constexpr size_t WS_CTL = 0, CTL_ZERO_BYTES = 64 * 1024;
constexpr size_t WS_MOD = 1 * MiB;
constexpr size_t WS_ROPE = 2 * MiB;
constexpr size_t WS_SMALL = 3 * MiB;
constexpr int SM_N1G = 0, SM_N2G = 8192, SM_AQG = 16384, SM_AKG = 16384 + 384, SM_CW = 16384 + 768, SM_CB = SM_CW + 6144, SM_CQG = SM_CB + 2048, SM_CKG = SM_CQG + 256, SM_END = SM_CKG + 256;
constexpr size_t WS_PTRS = 3 * MiB + 512 * 1024;
constexpr size_t WS_XW = 4 * MiB;
constexpr size_t WS_H = 72 * MiB;
constexpr size_t WS_P = 106 * MiB;
constexpr size_t WS_QRAW = 174 * MiB;
constexpr size_t WS_KVRAW = 200 * MiB;
constexpr size_t WS_Q = 234 * MiB;
constexpr size_t WS_K = 268 * MiB;
constexpr size_t WS_V = 294 * MiB;
constexpr size_t WS_CAT = 311 * MiB;
constexpr size_t WS_PQ = 345 * MiB;
constexpr size_t WS_IDX = 379 * MiB;
constexpr size_t WS_GATE = 384 * MiB;
constexpr size_t WS_WIN = 389 * MiB;
constexpr size_t WS_WUQ = 421 * MiB;
constexpr size_t WS_WUKV = 424 * MiB;
constexpr size_t WS_WEO = 426 * MiB;
constexpr size_t WS_WQKV = 442 * MiB;
constexpr size_t WS_WCO = 466 * MiB;
constexpr size_t WS_WPQ = 482 * MiB;
constexpr size_t WS_SUBK = 514 * MiB;
#ifndef TAB_FP4
#define TAB_FP4 1
#endif
#if TAB_FP4
constexpr int ROWB = 1024;
#else
constexpr int ROWB = 1536;
#endif
constexpr size_t WS_U = 516 * MiB;
constexpr size_t WS_VT = 644 * MiB;
constexpr size_t WS_USC = 772 * MiB;
constexpr size_t WS_VSC = 773 * MiB;
constexpr size_t WS_XQ = 810 * MiB;
constexpr size_t WS_XS = 828 * MiB;
constexpr size_t WS_WQ8 = 834 * MiB;
constexpr size_t WS_WSC = 836 * MiB;
constexpr size_t WS_PART = 774 * MiB;
constexpr size_t WS_END = 837 * MiB;
#ifndef EXP_SLICED
#define EXP_SLICED 1
#endif
#ifndef PEER_MFMA
#define PEER_MFMA 1
#endif
#ifndef PEER_VMFMA
#define PEER_VMFMA 1
#endif
constexpr int CW_BAR = 4096;
constexpr int LDS_MISC = 131072 + 8192;
constexpr int LDS_BYTES = 147456;

#define LAS __attribute__((address_space(3)))
typedef unsigned short bf16_t;
typedef float f32x4 __attribute__((ext_vector_type(4)));
typedef unsigned u32x4 __attribute__((ext_vector_type(4)));
typedef unsigned u32x2 __attribute__((ext_vector_type(2)));
typedef short bf16x8 __attribute__((ext_vector_type(8)));
typedef float f32x16 __attribute__((ext_vector_type(16)));
typedef __bf16 bf16x2_t __attribute__((ext_vector_type(2)));
typedef float f32x2 __attribute__((ext_vector_type(2)));
typedef _Float16 h2_t __attribute__((ext_vector_type(2)));
typedef float f32x32 __attribute__((ext_vector_type(32)));
typedef unsigned u32x6 __attribute__((ext_vector_type(6)));

__device__ __forceinline__ unsigned f2bf(float f) { unsigned u = __builtin_bit_cast(unsigned, f); return (u + 0x7fffu + ((u >> 16) & 1u)) >> 16; }
__device__ __forceinline__ unsigned pk2(float lo, float hi) { return f2bf(lo) | (f2bf(hi) << 16); }
__device__ __forceinline__ float bf_lo(unsigned w) { return __builtin_bit_cast(float, w << 16); }
__device__ __forceinline__ float bf_hi(unsigned w) { return __builtin_bit_cast(float, w & 0xffff0000u); }
__device__ __forceinline__ float bf2f(bf16_t h) { return __builtin_bit_cast(float, (unsigned)h << 16); }
__device__ __forceinline__ float wave_sum(float v) {
#pragma unroll
    for (int o = 1; o < 64; o <<= 1) v += __shfl_xor(v, o);
    return v;
}
#define DPP_ADD(v, ctrl) ((v) + __builtin_bit_cast(float, __builtin_amdgcn_update_dpp(0, __builtin_bit_cast(int, (v)), (ctrl), 0xf, 0xf, true)))
__device__ __forceinline__ float wave_sum_dpp(float v) {
    v = DPP_ADD(v, 0xB1);
    v = DPP_ADD(v, 0x4E);
    v = DPP_ADD(v, 0x141);
    v = DPP_ADD(v, 0x140);
    const int vi = __builtin_bit_cast(int, v);
    const float s0 = __builtin_bit_cast(float, __builtin_amdgcn_readlane(vi, 0)), s1 = __builtin_bit_cast(float, __builtin_amdgcn_readlane(vi, 16));
    const float s2 = __builtin_bit_cast(float, __builtin_amdgcn_readlane(vi, 32)), s3 = __builtin_bit_cast(float, __builtin_amdgcn_readlane(vi, 48));
    return (s0 + s1) + (s2 + s3);
}
#define DPP_MOV(v, ctrl) __builtin_bit_cast(float, __builtin_amdgcn_update_dpp(0, __builtin_bit_cast(int, (v)), (ctrl), 0xf, 0xf, true))
__device__ __forceinline__ float wave_max_dpp(float v) {
    v = fmaxf(v, DPP_MOV(v, 0xB1)); v = fmaxf(v, DPP_MOV(v, 0x4E)); v = fmaxf(v, DPP_MOV(v, 0x141)); v = fmaxf(v, DPP_MOV(v, 0x140));
    const int vi = __builtin_bit_cast(int, v);
    return fmaxf(fmaxf(__builtin_bit_cast(float, __builtin_amdgcn_readlane(vi, 0)), __builtin_bit_cast(float, __builtin_amdgcn_readlane(vi, 16))),
                 fmaxf(__builtin_bit_cast(float, __builtin_amdgcn_readlane(vi, 32)), __builtin_bit_cast(float, __builtin_amdgcn_readlane(vi, 48))));
}
__device__ __forceinline__ float dot2_bf16(unsigned w, unsigned x, float acc) { return __builtin_amdgcn_fdot2_f32_bf16(__builtin_bit_cast(bf16x2_t, w), __builtin_bit_cast(bf16x2_t, x), acc, false); }
__device__ __forceinline__ float gelu_erf(float v) {
    const float av = fabsf(v), t = __builtin_amdgcn_rcpf(av * 0.2316418882f + 1.0f);
    float q = t * 0.5307027145f + (-0.7265760135f); q = q * t + 0.7107068705f; q = q * t + (-0.142248368f); q = q * t + 0.127414796f; q = q * t;
    const float e = __builtin_amdgcn_exp2f((v * v) * (-0.72134752044f));
    const float m = v * (q * e);
    return v < 0.f ? m : v - m;
}
#ifndef BW_ROWS
#define BW_ROWS 1
#endif
constexpr int TAB_DEFER_PER_WAVE = 12, TAB_DEFER = 104 * NWAVES * TAB_DEFER_PER_WAVE;
constexpr int TAB_DEFA_EVEN = 6, TAB_DEFA_ODD = 4;
__device__ __forceinline__ int tab_defer_u(int ll) { return (ll == 0 || ll == 2) ? 240 * NWAVES * TAB_DEFA_EVEN : (ll == 1 ? 224 * NWAVES * TAB_DEFA_ODD : 0); }
constexpr int TAB_DEFT = 4;
__device__ __forceinline__ int tab_defer_t(int ll) { return 0; }
__device__ __forceinline__ void tab_row_convert(const float* src_row, unsigned char* ws, int tab, int rr  , int lane) {
    const float* src = src_row + lane * 4;
    f32x4 v[8];
#pragma unroll
    for (int q = 0; q < 8; ++q) v[q] = *(const f32x4*)(src + q * 256);
    float am = 0.f, ssq = 0.f;
#pragma unroll
    for (int q = 0; q < 8; ++q) { am = fmaxf(fmaxf(am, fmaxf(fabsf(v[q].x), fabsf(v[q].y))), fmaxf(fabsf(v[q].z), fabsf(v[q].w))); ssq += (v[q].x * v[q].x + v[q].y * v[q].y) + (v[q].z * v[q].z + v[q].w * v[q].w); }
    am = fmaxf(wave_max_dpp(am), 1e-30f); ssq = wave_sum_dpp(ssq);
    const float sig = fmaxf(sqrtf(ssq * (1.f / DM)), am * (1.f / 64.f)), sc = 2.0f / sig;
    const int ll = rr / NEXP, ee = rr - ll * NEXP;
    unsigned char* dst = ws + (tab ? WS_VT : WS_U) + (size_t)ll * NEXP * ROWB + (size_t)ee * 128 + lane * 2;
#define P0_C6(x) fminf(fmaxf((x), -6.f), 6.f)
#pragma unroll
    for (int q = 0; q < 8; ++q) { const f32x4 x = v[q] * sc; unsigned t = 0u;
        t = __builtin_amdgcn_cvt_scalef32_pk_fp4_f32(t, P0_C6(x.x), P0_C6(x.y), 1.0f, 0); t = __builtin_amdgcn_cvt_scalef32_pk_fp4_f32(t, P0_C6(x.z), P0_C6(x.w), 1.0f, 1);
        *(unsigned short*)(dst + (size_t)q * (NEXP * 128)) = (unsigned short)t; }
#undef P0_C6
    if (lane == 0) ((float*)(ws + (tab ? WS_VSC : WS_USC)))[rr] = sig * 0.5f;
}
constexpr int BW_L1U = NEXP - 224 * NWAVES * TAB_DEFA_ODD, BW_L1V = NEXP - TAB_DEFER, BW_N0 = NEXP - 240 * NWAVES * TAB_DEFA_EVEN, BW_N1 = NEXP, BW_N2 = NEXP, BW_N3 = NEXP - TAB_DEFER;
constexpr int BW_L0U = NEXP - 240 * NWAVES * TAB_DEFA_EVEN;
#ifndef BW_WAVES
#define BW_WAVES 7
#endif
#ifndef BW_L0V
#define BW_L0V 13056
#endif
constexpr int BW_QN = BW_L0U + BW_L0V + BW_L1U + BW_L1V + BW_N0 + BW_N1 + BW_N2 + BW_N3, BW_W = BW_WAVES, BW_PER = BW_W * 256;
__device__ __forceinline__ void bw_row(unsigned char* ws, unsigned ord, int lane, volatile LAS unsigned* st_) {
    int wave = __builtin_amdgcn_readfirstlane((int)(threadIdx.x >> 6)), bx_ = (int)blockIdx.x;
    asm volatile("" : "+s"(wave), "+s"(bx_), "+s"(ws), "+v"(lane));
    if (wave == 0 || wave > BW_W) return;
    const int q = (int)ord * BW_PER + BW_W * bx_ + wave - 1;
    if (q >= BW_QN) return;
    int tab, rr, q2 = q;
    if (q2 < BW_L0U) { tab = 0; rr = q2; }
    else if ((q2 -= BW_L0U) < BW_L0V) { tab = 1; rr = q2; }
    else if ((q2 -= BW_L0V) < BW_L1U) { tab = 0; rr = NEXP + q2; }
    else if ((q2 -= BW_L1U) < BW_L1V) { tab = 1; rr = NEXP + q2; }
    else if ((q2 -= BW_L1V) < BW_N0) { tab = 0; rr = 2 * NEXP + q2; }
    else if ((q2 -= BW_N0) < BW_N1) { tab = 1; rr = 2 * NEXP + q2; }
    else if ((q2 -= BW_N1) < BW_N2) { tab = 0; rr = 3 * NEXP + q2; }
    else { q2 -= BW_N2; tab = 1; rr = 3 * NEXP + q2; }
    const unsigned long long sp_ = (unsigned long long)st_[4 + 2 * tab] | ((unsigned long long)st_[5 + 2 * tab] << 32);
    const float* src = (const float*)sp_;
    tab_row_convert(src + (size_t)rr * DM, ws, tab, rr, lane);
}
#define XB_TMO      128
#define XB_XCNT(j)  (256  + 64 * (j))
#define XB_XSUB(j)  (1280 + 64 * (j))
#define XB_XGEN(j)  (2304 + 64 * (j))
#define XB_TOP      3328
#define XB_TOPGEN   3392
#define XCD_BAR_WORDS 3456
#define XB_SPIN_CAP (1u << 18)

__device__ __forceinline__ unsigned xb_ld(unsigned* p)              { return __hip_atomic_load(p, __ATOMIC_RELAXED, __HIP_MEMORY_SCOPE_AGENT); }
__device__ __forceinline__ unsigned xb_add(unsigned* p, unsigned v) { return __hip_atomic_fetch_add(p, v, __ATOMIC_RELAXED, __HIP_MEMORY_SCOPE_AGENT); }
__device__ __forceinline__ unsigned xb_xcc_id() { return (unsigned)__builtin_amdgcn_s_getreg((3 << 11) | 20) & 0xFu; }
#define XB_SPIN(cond, bar) do { unsigned _sp = 0; while (cond) { __builtin_amdgcn_s_sleep(1); \
    if ((++_sp & 255u) == 0u) { if (xb_ld(&(bar)[XB_TMO])) break; if (_sp > XB_SPIN_CAP) { atomicAdd(&(bar)[XB_TMO], 1u); break; } } } } while (0)

struct XcdBarrier {
    unsigned* bar; unsigned x;
    volatile LAS unsigned* st;
};

__device__ __forceinline__ XcdBarrier xcd_barrier_post(unsigned* bar, volatile LAS unsigned* st) {
    XcdBarrier b; b.bar = bar; b.x = xb_xcc_id(); b.st = st;
    if (threadIdx.x == 0) (void)xb_add(&bar[XB_XCNT(b.x)], 1u);
    return b;
}
__device__ __forceinline__ void xcd_barrier_complete(unsigned* bar, unsigned x, unsigned& nloc, unsigned& nx) {
    const unsigned G = gridDim.x * gridDim.y * gridDim.z;
    unsigned sum, cnt, mine, sp = 0u;
    for (;;) {
        sum = 0u; cnt = 0u; mine = 0u;
#pragma unroll
        for (unsigned j = 0; j < 16; ++j) { const unsigned c = xb_ld(&bar[XB_XCNT(j)]); sum += c; cnt += (c > 0u) ? 1u : 0u; mine = (j == x) ? c : mine; }
        if (sum == G) break;
        __builtin_amdgcn_s_sleep(1);
        if ((++sp & 255u) == 0u) { if (xb_ld(&bar[XB_TMO])) break; if (sp > XB_SPIN_CAP) { atomicAdd(&bar[XB_TMO], 1u); break; } }
    }
    nloc = mine > 0u ? mine : 1u; nx = cnt > 0u ? cnt : 1u;
}

__device__ __forceinline__ void xcd_barrier(const XcdBarrier& b) {
    asm volatile("s_waitcnt vmcnt(0)" ::: "memory");
    __syncthreads();
#if BW_ROWS
    const unsigned ord_ = b.st[2];
    if (gridDim.x == 256) bw_row((unsigned char*)(b.bar - CW_BAR) - WS_CTL, ord_, (int)(threadIdx.x & 63), b.st);
#endif
    if (threadIdx.x == 0) {
        unsigned* bar = b.bar; unsigned bx = b.x;
        asm volatile("" : "+s"(bar), "+s"(bx));
        __builtin_amdgcn_s_waitcnt(0);
        unsigned nloc = b.st[0], nx = b.st[1];
        if (nloc == 0u) { xcd_barrier_complete(bar, bx, nloc, nx); b.st[0] = nloc; b.st[1] = nx; }
        const unsigned old = xb_add(&bar[XB_XSUB(bx)], 1u);
        const unsigned gen = old / nloc;
        if (old + 1u == (gen + 1u) * nloc) {
            __builtin_amdgcn_fence(__ATOMIC_RELEASE, "agent");
            asm volatile("s_waitcnt vmcnt(0)" ::: "memory");
            const unsigned og = xb_add(&bar[XB_TOP], 1u);
            const unsigned tg = og / nx;
            if (og + 1u == (tg + 1u) * nx) xb_add(&bar[XB_TOPGEN], 1u);
            else XB_SPIN(xb_ld(&bar[XB_TOPGEN]) == tg, bar);
            __builtin_amdgcn_fence(__ATOMIC_ACQUIRE, "agent");
            xb_add(&bar[XB_XGEN(bx)], 1u);
            asm volatile("s_waitcnt vmcnt(0)" ::: "memory");
        } else {
            __builtin_amdgcn_fence(__ATOMIC_ACQUIRE, "agent");
            XB_SPIN(xb_ld(&bar[XB_XGEN(bx)]) == gen, bar);
            asm volatile("s_waitcnt vmcnt(0)" ::: "memory");
        }
    }
    __syncthreads();
#if BW_ROWS
    if (threadIdx.x == 0) b.st[2] = ord_ + 1u;
#endif
}
struct Frame {
    LAS unsigned char* lds;
    int tid, lane, wave, vcu, G, gw, NGW;
    unsigned char* ws;
};
__device__ __forceinline__ int opaque_v(int v) { asm volatile("" : "+v"(v)); return v; }
__device__ __forceinline__ int phase_tid(int wave) { int lane; asm volatile("v_mbcnt_lo_u32_b32 %0, -1, 0\n\tv_mbcnt_hi_u32_b32 %0, -1, %0" : "=v"(lane)); return wave * 64 + lane; }
__device__ __forceinline__ Frame phase_frame(const Frame& F0) { Frame F = F0; F.tid = phase_tid(F0.wave); F.lane = F.tid & 63; return F; }
__device__ __forceinline__ float swap32(float v, int lane) { auto rr = __builtin_amdgcn_permlane32_swap(__float_as_uint(v), __float_as_uint(v), false, false); return __uint_as_float(lane < 32 ? rr[1] : rr[0]); }
__device__ __forceinline__ int row_cls(int row) { const int b = row / RB, i = row - b * RB; return i < CTX ? 2 : b; }

__device__ __forceinline__ void p0_transpose_item(const float* W, int K, int N, bf16_t* WT, const float* gain, LAS float* scr, int item, int lane, bool perm_q = false) {
    const int nblk = N / 32, kb = item / nblk, nb = item % nblk, k0 = 64 * kb, n0 = 32 * nb;
    {
        const int rgp = lane >> 3, c4 = (lane & 7) * 4; f32x4 tv[8];
#pragma unroll
        for (int i = 0; i < 8; ++i) tv[i] = *(const f32x4*)(W + (size_t)(k0 + 8 * i + rgp) * N + n0 + c4);
#pragma unroll
        for (int i = 0; i < 8; ++i) { const int kk = 8 * i + rgp; f32x4 v = tv[i]; if (gain) v = v * gain[k0 + kk];
            LAS float* d = scr + kk * 33 + c4; d[0] = v.x; d[1] = v.y; d[2] = v.z; d[3] = v.w; }
    }
    asm volatile("s_waitcnt lgkmcnt(0)" ::: "memory");
    const int c = lane & 7;
#pragma unroll
    for (int j = 0; j < 4; ++j) { const int n = (lane >> 3) + 8 * j; const LAS float* s = scr + (8 * c) * 33 + n;
        u32x4 o; o.x = pk2(s[0 * 33], s[1 * 33]); o.y = pk2(s[2 * 33], s[3 * 33]); o.z = pk2(s[4 * 33], s[5 * 33]); o.w = pk2(s[6 * 33], s[7 * 33]);
        int nn = n0 + n; if (perm_q) { const int hh = nn / 192, e = nn - hh * 192; nn = (e < 128) ? hh * 128 + e : 1024 + hh * 64 + (e - 128); }
        *(u32x4*)(WT + (size_t)nn * K + k0 + 8 * c) = o; }
    asm volatile("s_waitcnt lgkmcnt(0)" ::: "memory");
}
struct TrDesc { const float* W; const float* gain; bf16_t* WT; int K, N, items; };

__device__ __forceinline__ void p0_gemv_task(Frame& F, int task, const float* ada_w, const float* ada_b, float* mod) {
    LAS float* sv = (LAS float*)F.lds; LAS float* part = (LAS float*)(F.lds + 32768);
    const int l = task / 192, n0 = (task % 192) * 64, rg = F.lane >> 4, c4 = (F.lane & 15) * 4;
    const float* Wp = ada_w + (size_t)l * DM * NMOD + n0 + c4 + (size_t)(F.wave * 256 + rg) * NMOD;
    f32x4 a0 = {0, 0, 0, 0}, a1 = a0, a2 = a0;
    for (int k = 0; k < 256; k += 32) {
        f32x4 w[8];
#pragma unroll
        for (int u = 0; u < 8; ++u) w[u] = *(const f32x4*)(Wp + (size_t)(k + 4 * u) * NMOD);
#pragma unroll
        for (int u = 0; u < 8; ++u) { const int kk = F.wave * 256 + k + 4 * u + rg; const float s0 = sv[kk], s1 = sv[2048 + kk], s2 = sv[4096 + kk];
            a0 += w[u] * s0; a1 += w[u] * s1; a2 += w[u] * s2; }
    }
    LAS float* pp = part + ((F.wave * 4 + rg) * 3) * 64 + c4;
    *(LAS f32x4*)(pp) = a0; *(LAS f32x4*)(pp + 64) = a1; *(LAS f32x4*)(pp + 128) = a2;
    __syncthreads();
    if (F.tid < 192) { const int r = F.tid >> 6, c = F.tid & 63; float s = 0.f;
#pragma unroll
        for (int q = 0; q < 32; ++q) s += part[(q * 3 + r) * 64 + c];
        mod[(size_t)(l * 3 + r) * NMOD + n0 + c] = s + ada_b[(size_t)l * NMOD + n0 + c]; }
    __syncthreads();
}

__device__ __forceinline__ void tab_deferred_u_rows(const Frame& F0, int l, int wslot, int per, int extra_off = 0) {
    const Frame F = phase_frame(F0);
    unsigned char* ws = F.ws;
    const float* in_u = ((const float* const*)(ws + WS_PTRS))[0];
#pragma unroll 1
    for (int i = 0; i < per; ++i) { const int rr = l * NEXP + NEXP - tab_defer_u(l) - extra_off + wslot * per + i; tab_row_convert(in_u + (size_t)rr * DM, ws, 0, rr, F.lane); }
}
__device__ __forceinline__ void tab_row_convert2(const float* src_a, const float* src_b, unsigned char* ws, int tab, int rra, int rrb, int lane) {
    f32x4 va[8], vb[8];
#pragma unroll
    for (int q = 0; q < 8; ++q) va[q] = *(const f32x4*)(src_a + lane * 4 + q * 256);
#pragma unroll
    for (int q = 0; q < 8; ++q) vb[q] = *(const f32x4*)(src_b + lane * 4 + q * 256);
#define P0_C6(x) fminf(fmaxf((x), -6.f), 6.f)
#define TAB_ONE(V, RR) do { float am = 0.f, ssq = 0.f; \
    _Pragma("unroll") for (int q = 0; q < 8; ++q) { am = fmaxf(fmaxf(am, fmaxf(fabsf(V[q].x), fabsf(V[q].y))), fmaxf(fabsf(V[q].z), fabsf(V[q].w))); ssq += (V[q].x * V[q].x + V[q].y * V[q].y) + (V[q].z * V[q].z + V[q].w * V[q].w); } \
    am = fmaxf(wave_max_dpp(am), 1e-30f); ssq = wave_sum_dpp(ssq); \
    const float sig = fmaxf(sqrtf(ssq * (1.f / DM)), am * (1.f / 64.f)), sc = 2.0f / sig; \
    const int ll = (RR) / NEXP, ee = (RR) - ll * NEXP; \
    unsigned char* dst = ws + (tab ? WS_VT : WS_U) + (size_t)ll * NEXP * ROWB + (size_t)ee * 128 + lane * 2; \
    _Pragma("unroll") for (int q = 0; q < 8; ++q) { const f32x4 x = V[q] * sc; unsigned t = 0u; \
        t = __builtin_amdgcn_cvt_scalef32_pk_fp4_f32(t, P0_C6(x.x), P0_C6(x.y), 1.0f, 0); t = __builtin_amdgcn_cvt_scalef32_pk_fp4_f32(t, P0_C6(x.z), P0_C6(x.w), 1.0f, 1); \
        *(unsigned short*)(dst + (size_t)q * (NEXP * 128)) = (unsigned short)t; } \
    if (lane == 0) ((float*)(ws + (tab ? WS_VSC : WS_USC)))[RR] = sig * 0.5f; } while (0)
    TAB_ONE(va, rra); TAB_ONE(vb, rrb);
#undef TAB_ONE
#undef P0_C6
}
__device__ __forceinline__ void tab_deferred_rows(const Frame& F0, int l, int wslot) {
    const Frame F = phase_frame(F0);
    unsigned char* ws = F.ws;
    const float* in_v = ((const float* const*)(ws + WS_PTRS))[1];
#pragma unroll 1
    for (int i = 0; i < TAB_DEFER_PER_WAVE; ++i) { const int rr = l * NEXP + NEXP - TAB_DEFER + wslot * TAB_DEFER_PER_WAVE + i; tab_row_convert(in_v + (size_t)rr * DM, ws, 1, rr, F.lane); }
}
__device__ __forceinline__ void p0_prologue(Frame& F, const float* const* in, const int parts = 15) {
    unsigned char* ws = F.ws;
    if (parts & 1) {
        LAS float* sv = (LAS float*)F.lds;
        for (int i = F.tid; i < 3 * DM; i += NTHREADS) { const int r = i / DM, k = i - r * DM; const float x = (r < 2) ? in[1][r * DM + k] : in[3][k]; sv[i] = x / (1.f + __expf(-x)); }
        __syncthreads();
        for (int task = F.vcu; task < 768; task += F.G) p0_gemv_task(F, task, in[4], in[5], (float*)(ws + WS_MOD));
        __syncthreads();
    }
    if (parts & 2) {
        bf16_t* xw = (bf16_t*)(ws + WS_XW);
        for (int row = F.gw; row < MROWS; row += F.NGW) { const int b = row / RB, i = row - b * RB;
            const float* src = (i < CTX) ? in[2] + (size_t)(b * CTX + i) * DM : in[0] + (size_t)(b * SEQ + i - CTX) * DM;
            const f32x4* s4 = (const f32x4*)src + F.lane; u32x2* d4 = (u32x2*)(xw + (size_t)row * DM) + F.lane;
#pragma unroll
            for (int j = 0; j < 8; ++j) { const f32x4 v = s4[64 * j]; u32x2 o; o.x = pk2(v.x, v.y); o.y = pk2(v.z, v.w); d4[64 * j] = o; } }
    }
    if (parts & 2) {
        float* sm = (float*)(ws + WS_SMALL); const int g = F.vcu * NTHREADS + F.tid;
        if (g < 8192) { sm[SM_N1G + g] = in[6][g]; sm[SM_N2G + g] = in[7][g]; }
        if (g < 384) { sm[SM_AQG + g] = in[13][g]; sm[SM_AKG + g] = in[14][g]; }
        if (g < 6144) sm[SM_CW + g] = in[15][g];
        if (g < 2048) sm[SM_CB + g] = in[16][g];
        if (g < 256) { sm[SM_CQG + g] = in[19][g]; sm[SM_CKG + g] = in[20][g]; }
    }
    if (parts & 2) {
        float* rc = (float*)(ws + WS_ROPE); float* ra = rc + 64 * 32 * 2;
        const int g = F.vcu * NTHREADS + F.tid;
        if (g < 64 * 32) { const int pos = g >> 5, f = g & 31; const float fr = exp2f(-(float)f * (13.287712379549449f / 32.f)); const float ang = (float)pos * fr;
            rc[2 * g] = cosf(ang); rc[2 * g + 1] = sinf(ang); }
        else if (g < 64 * 32 + 64 * 16) { const int e = g - 64 * 32, pos = e >> 4, f = e & 15; const float fr = exp2f(-(float)f * (13.287712379549449f / 16.f)); const float ang = (float)pos * fr;
            ra[2 * e] = cosf(ang); ra[2 * e + 1] = sinf(ang); }
    }
    if (parts & 4) {
        LAS float* scr = (LAS float*)(F.lds + F.wave * 16384);
        TrDesc d[16]; int nd = 0;
#pragma unroll
        for (int i = 0; i < 2; ++i) {
            d[nd++] = TrDesc{in[8] + (size_t)i * DM * 3904, nullptr, (bf16_t*)(ws + WS_WIN) + (size_t)i * 4096 * DM, DM, 3904, 32 * 122};
            d[nd++] = TrDesc{in[11] + (size_t)i * 512 * 1536, in[9] + i * 512, (bf16_t*)(ws + WS_WUQ) + (size_t)i * 1536 * 512, 512, 1536, 8 * 48};
            d[nd++] = TrDesc{in[12] + (size_t)i * 256 * 2048, in[10] + i * 256, (bf16_t*)(ws + WS_WUKV) + (size_t)i * 2048 * 256, 256, 2048, 4 * 64};
            d[nd++] = TrDesc{in[17] + (size_t)i * DM * DM, nullptr, (bf16_t*)(ws + WS_WEO) + (size_t)i * DM * DM, DM, DM, 32 * 64};
            d[nd++] = TrDesc{in[18] + (size_t)i * DM * 3072, nullptr, (bf16_t*)(ws + WS_WQKV) + (size_t)i * 3072 * DM, DM, 3072, 32 * 96};
            d[nd++] = TrDesc{in[21] + (size_t)i * DM * DM, nullptr, (bf16_t*)(ws + WS_WCO) + (size_t)i * DM * DM, DM, DM, 32 * 64};
        }
#pragma unroll
        for (int l = 0; l < 4; ++l) d[nd++] = TrDesc{in[22] + (size_t)l * DM * DM, nullptr, (bf16_t*)(ws + WS_WPQ) + (size_t)l * DM * DM, DM, DM, 32 * 64};
#pragma unroll
        for (int m = 0; m < 16; ++m) {
            for (int it = F.gw; it < d[m].items; it += F.NGW) p0_transpose_item(d[m].W, d[m].K, d[m].N, d[m].WT, d[m].gain, scr, it, F.lane, d[m].K == 512);
        }
        for (int i = F.gw * 64 + F.lane; i < 2 * 192 * DM / 8; i += F.NGW * 64) { const int li = i / (192 * DM / 8), r = i % (192 * DM / 8);
            *(u32x4*)((bf16_t*)(ws + WS_WIN) + (size_t)li * 4096 * DM + (size_t)3904 * DM + (size_t)r * 8) = (u32x4){0u, 0u, 0u, 0u}; }
    }
    if (parts & 2) {
        const size_t n_sk = (size_t)4 * 16 * 128 * 128 / 8;
        const size_t gt = (size_t)F.vcu * NTHREADS + F.tid, GT = (size_t)F.G * NTHREADS;
        for (size_t j = gt; j < n_sk; j += GT) {
            const f32x4 a = *(const f32x4*)(in[23] + j * 8), b = *(const f32x4*)(in[23] + j * 8 + 4);
            u32x4 o; o.x = pk2(a.x, a.y); o.y = pk2(a.z, a.w); o.z = pk2(b.x, b.y); o.w = pk2(b.z, b.w);
            *(u32x4*)((bf16_t*)(ws + WS_SUBK) + j * 8) = o;
        }
    }
#if TAB_FP4 && EXP_SLICED && PEER_MFMA && !defined(P0_NOCOAL)
    if (parts & 8) {
        if (F.vcu == 0 && F.tid == 0) { const float** pp = (const float**)(ws + WS_PTRS); pp[0] = in[24]; pp[1] = in[25]; }
        for (int r = F.gw; r < 2 * 4 * NEXP; r += F.NGW) { const int tab = r >= 4 * NEXP, rr = r - tab * (4 * NEXP);
            if (BW_ROWS && F.G == 256 && (rr >= NEXP || tab == 0 || rr < BW_L0V)) continue;
            if (F.G == 256) { const int ll = rr / NEXP, ee = rr - ll * NEXP; if (tab == 1 ? ((ll & 1) && ee >= NEXP - TAB_DEFER) : (ee >= NEXP - tab_defer_u(ll) - tab_defer_t(ll))) continue; }
            tab_row_convert((tab ? in[25] : in[24]) + (size_t)rr * DM, ws, tab, rr, F.lane); }
    }
#elif TAB_FP4 && EXP_SLICED && PEER_MFMA && defined(P0_PIPE)
    {
        const int NR = 2 * 4 * NEXP;
#define P0_LOAD(V, r_) do { const int rc_ = (r_) < NR ? (r_) : NR - 1; const float* s_ = ((rc_ >= 4 * NEXP) ? in[25] + (size_t)(rc_ - 4 * NEXP) * DM : in[24] + (size_t)rc_ * DM) + F.lane * 32; \
        _Pragma("unroll") for (int q = 0; q < 8; ++q) V[q] = *(const f32x4*)(s_ + q * 4); } while (0)
#define P0_C6(x) fminf(fmaxf((x), -6.f), 6.f)
#define P0_ROW(V, VN) do { \
        const int rn = r + F.NGW; P0_LOAD(VN, rn); \
        const int tab = r >= 4 * NEXP, rr = r - tab * (4 * NEXP); \
        float am = 0.f, ssq = 0.f; \
        _Pragma("unroll") for (int q = 0; q < 8; ++q) { am = fmaxf(fmaxf(am, fmaxf(fabsf(V[q].x), fabsf(V[q].y))), fmaxf(fabsf(V[q].z), fabsf(V[q].w))); ssq += (V[q].x * V[q].x + V[q].y * V[q].y) + (V[q].z * V[q].z + V[q].w * V[q].w); } \
        am = fmaxf(wave_max_dpp(am), 1e-30f); ssq = wave_sum_dpp(ssq); \
        const float sig = fmaxf(sqrtf(ssq * (1.f / DM)), am * (1.f / 64.f)), sc = 2.0f / sig; \
        unsigned w4[4]; \
        _Pragma("unroll") for (int q = 0; q < 4; ++q) { unsigned t = 0u; const f32x4 xa = V[2 * q] * sc, xb = V[2 * q + 1] * sc; \
            t = __builtin_amdgcn_cvt_scalef32_pk_fp4_f32(t, P0_C6(xa.x), P0_C6(xa.y), 1.0f, 0); t = __builtin_amdgcn_cvt_scalef32_pk_fp4_f32(t, P0_C6(xa.z), P0_C6(xa.w), 1.0f, 1); \
            t = __builtin_amdgcn_cvt_scalef32_pk_fp4_f32(t, P0_C6(xb.x), P0_C6(xb.y), 1.0f, 2); t = __builtin_amdgcn_cvt_scalef32_pk_fp4_f32(t, P0_C6(xb.z), P0_C6(xb.w), 1.0f, 3); w4[q] = t; } \
        { const int ll = rr / NEXP, ee = rr - ll * NEXP; \
          *(u32x4*)(ws + (tab ? WS_VT : WS_U) + (size_t)ll * NEXP * ROWB + (size_t)(F.lane >> 3) * (NEXP * 128) + (size_t)ee * 128 + (F.lane & 7) * 16) = (u32x4){w4[0], w4[1], w4[2], w4[3]}; } \
        if (F.lane == 0) ((float*)(ws + (tab ? WS_VSC : WS_USC)))[rr] = sig * 0.5f; \
        r = rn; } while (0)
        int r = F.gw; f32x4 va[8], vb[8]; P0_LOAD(va, r);
        while (r < NR) { P0_ROW(va, vb); if (!(r < NR)) break; P0_ROW(vb, va); }
#undef P0_ROW
#undef P0_C6
#undef P0_LOAD
    }
#else
    {
        for (int r = F.gw; r < 2 * 4 * NEXP; r += F.NGW) {
            const int tab = r / (4 * NEXP), rr = r - tab * (4 * NEXP);
#if EXP_SLICED
            const float* src = (tab ? in[25] : in[24]) + (size_t)rr * DM + F.lane * 32;
            f32x4 v[8];
#pragma unroll
            for (int q = 0; q < 8; ++q) v[q] = *(const f32x4*)(src + q * 4);
#else
            const float* src = (tab ? in[25] : in[24]) + (size_t)rr * DM + F.lane * 16;
            f32x4 v[8];
#pragma unroll
            for (int j = 0; j < 2; ++j)
#pragma unroll
                for (int q = 0; q < 4; ++q) v[j * 4 + q] = *(const f32x4*)(src + j * 1024 + q * 4);
#endif
            float am = 0.f;
#pragma unroll
            for (int q = 0; q < 8; ++q) am = fmaxf(fmaxf(am, fmaxf(fabsf(v[q].x), fabsf(v[q].y))), fmaxf(fabsf(v[q].z), fabsf(v[q].w)));
#pragma unroll
            for (int o = 1; o < 64; o <<= 1) am = fmaxf(am, __shfl_xor(am, o));
            am = fmaxf(am, 1e-30f);
#if TAB_FP4
            float ssq = 0.f;
#pragma unroll
            for (int q = 0; q < 8; ++q) ssq += (v[q].x * v[q].x + v[q].y * v[q].y) + (v[q].z * v[q].z + v[q].w * v[q].w);
#pragma unroll
            for (int o = 1; o < 64; o <<= 1) ssq += __shfl_xor(ssq, o);
            const float sig = fmaxf(sqrtf(ssq * (1.f / DM)), am * (1.f / 64.f));
            unsigned w4[4];
#if EXP_SLICED
            if (tab == 0 && !PEER_MFMA) {
                const float delta = 0.3352f * sig, isc = 1.0f / delta;
#pragma unroll
                for (int q = 0; q < 4; ++q) { unsigned t = 0u;
#pragma unroll
                    for (int hh = 0; hh < 2; ++hh) { const f32x4 x = v[2 * q + hh] * isc;
                        const int n0 = min(max((int)floorf(x.x), -8), 7) & 15, n1 = min(max((int)floorf(x.y), -8), 7) & 15, n2 = min(max((int)floorf(x.z), -8), 7) & 15, n3 = min(max((int)floorf(x.w), -8), 7) & 15;
                        t |= ((unsigned)n0 | ((unsigned)n1 << 4) | ((unsigned)n2 << 8) | ((unsigned)n3 << 12)) << (16 * hh); }
                    w4[q] = t; }
                { const int ll = rr / NEXP, ee = rr - ll * NEXP;
                  *(u32x4*)(ws + WS_U + (size_t)ll * NEXP * ROWB + (size_t)(F.lane >> 3) * (NEXP * 128) + (size_t)ee * 128 + (F.lane & 7) * 16) = (u32x4){w4[0], w4[1], w4[2], w4[3]}; }
                if (F.lane == 0) ((float*)(ws + WS_USC))[rr] = delta;
                continue;
            }
#endif
            const float sc = 2.0f / sig;
#pragma unroll
            for (int q = 0; q < 4; ++q) { unsigned t = 0u;
                const f32x4 xa = v[2 * q] * sc, xb = v[2 * q + 1] * sc;
#define P0_C6(x) fminf(fmaxf((x), -6.f), 6.f)
                t = __builtin_amdgcn_cvt_scalef32_pk_fp4_f32(t, P0_C6(xa.x), P0_C6(xa.y), 1.0f, 0);
                t = __builtin_amdgcn_cvt_scalef32_pk_fp4_f32(t, P0_C6(xa.z), P0_C6(xa.w), 1.0f, 1);
                t = __builtin_amdgcn_cvt_scalef32_pk_fp4_f32(t, P0_C6(xb.x), P0_C6(xb.y), 1.0f, 2);
                t = __builtin_amdgcn_cvt_scalef32_pk_fp4_f32(t, P0_C6(xb.z), P0_C6(xb.w), 1.0f, 3);
#undef P0_C6
                w4[q] = t; }
#if EXP_SLICED
            { const int ll = rr / NEXP, ee = rr - ll * NEXP;
              *(u32x4*)(ws + (tab ? WS_VT : WS_U) + (size_t)ll * NEXP * ROWB + (size_t)(F.lane >> 3) * (NEXP * 128) + (size_t)ee * 128 + (F.lane & 7) * 16) = (u32x4){w4[0], w4[1], w4[2], w4[3]}; }
#else
            *(u32x4*)(ws + (tab ? WS_VT : WS_U) + (size_t)rr * ROWB + F.lane * 16) = (u32x4){w4[0], w4[1], w4[2], w4[3]};
#endif
            if (F.lane == 0) ((float*)(ws + (tab ? WS_VSC : WS_USC)))[rr] = sig * 0.5f;
#else
            const float sc = 7.5f / am;
            f32x16 a, b;
#pragma unroll
            for (int q = 0; q < 8; ++q) { const f32x4 x = v[q] * sc; a[2 * q] = x.x; b[2 * q] = x.y; a[2 * q + 1] = x.z; b[2 * q + 1] = x.w; }
            const u32x6 w = __builtin_amdgcn_cvt_scalef32_2xpk16_fp6_f32(a, b, 1.0f);
            unsigned char* dst = ws + (tab ? WS_VT : WS_U) + (size_t)rr * ROWB;
            *(u32x4*)(dst + F.lane * 16) = (u32x4){w[0], w[1], w[2], w[3]};
            *(u32x2*)(dst + 1024 + F.lane * 8) = (u32x2){w[4], w[5]};
            if (F.lane == 0) ((float*)(ws + (tab ? WS_VSC : WS_USC)))[rr] = am * (1.0f / 7.5f);
#endif
        }
    }
#endif
}

template <bool RESID>
__device__ __forceinline__ void ctx_gemm_phase(const Frame& F0, const bf16_t* A, int lda, const bf16_t* Bt, int ldb, int N, int K, bf16_t* O, bf16_t* X, int ldc, const float* gate) {
    const Frame F = phase_frame(F0);
    const int lane = F.lane, li = lane & 15, lq = lane >> 4, wave = F.wave;
    LAS float* red = (LAS float*)F.lds;
    LAS unsigned char* priv = F.lds + wave * 12288;
    const int lr = lane >> 3, lc = lane & 7;
    const int wr_even = lr * 128 + ((lc ^ (lr >> 1)) << 4), wr_odd = lr * 128 + ((lc ^ (4 + (lr >> 1))) << 4);
    const int rd_row = li * 128;
    const int ntask = 8 * (N / 32), k0 = wave * (K / 8);
#define CG_PTRS(t_, XG, WG) do { const int tc_ = (t_) < ntask ? (t_) : ntask - 1; const int rb_ = tc_ & 7, cb_ = tc_ >> 3; const int r0_ = (rb_ < 4) ? rb_ * 64 : RB + (rb_ - 4) * 64; \
        XG = A + (size_t)(r0_ + lr) * lda + k0 + 8 * lc; WG = Bt + (size_t)(cb_ * 32 + lr) * ldb + k0 + 8 * lc; } while (0)
#define CG_LOAD(XQ, WQ, XG, WG, q_) do { _Pragma("unroll") for (int i = 0; i < 8; ++i) XQ[i] = *(const u32x4*)(XG + (size_t)(8 * i) * lda + 64 * (q_)); \
        _Pragma("unroll") for (int i = 0; i < 4; ++i) WQ[i] = *(const u32x4*)(WG + (size_t)(8 * i) * ldb + 64 * (q_)); } while (0)
#define CG_QUARTER(XQ, WQ, XGN, WGN, qn_) do { \
        _Pragma("unroll") for (int i = 0; i < 8; ++i) *(LAS u32x4*)(priv + ((i & 1) ? wr_odd : wr_even) + i * 1024) = XQ[i]; \
        _Pragma("unroll") for (int i = 0; i < 4; ++i) *(LAS u32x4*)(priv + 8192 + ((i & 1) ? wr_odd : wr_even) + i * 1024) = WQ[i]; \
        __builtin_amdgcn_sched_barrier(0); \
        CG_LOAD(XQ, WQ, XGN, WGN, qn_); \
        __builtin_amdgcn_sched_barrier(0); \
        _Pragma("unroll") for (int s = 0; s < 2; ++s) { \
            const int ro = rd_row + (((4 * s + lq) ^ (li >> 1)) << 4); \
            bf16x8 xa[4], wb[2]; \
            _Pragma("unroll") for (int m = 0; m < 4; ++m) xa[m] = *(const LAS bf16x8*)(priv + ro + m * 2048); \
            _Pragma("unroll") for (int n = 0; n < 2; ++n) wb[n] = *(const LAS bf16x8*)(priv + 8192 + ro + n * 2048); \
            _Pragma("unroll") for (int m = 0; m < 4; ++m) _Pragma("unroll") for (int n = 0; n < 2; ++n) acc[m][n] = __builtin_amdgcn_mfma_f32_16x16x32_bf16(wb[n], xa[m], acc[m][n], 0, 0, 0); } \
    } while (0)
    u32x4 xa_[8], wa_[4], xb_[8], wb_[4];
    const bf16_t *xg, *wg, *xgn, *wgn;
    CG_PTRS(F.vcu, xg, wg);
    __builtin_amdgcn_s_waitcnt(0x0f70);
    __builtin_amdgcn_sched_barrier(0); CG_LOAD(xa_, wa_, xg, wg, 0); __builtin_amdgcn_sched_barrier(0); CG_LOAD(xb_, wb_, xg, wg, 1); __builtin_amdgcn_sched_barrier(0);
    for (int task = F.vcu; task < ntask; task += F.G) {
        const int rb = task & 7, cb = task >> 3;
        const int row0 = (rb < 4) ? rb * 64 : RB + (rb - 4) * 64, col0 = cb * 32;
        CG_PTRS(task + F.G, xgn, wgn);
        const int row = row0 + 16 * (wave >> 1) + li, col = col0 + 16 * (wave & 1) + 4 * lq;
        f32x4 xold = {0.f, 0.f, 0.f, 0.f}, gv = xold;
        if (RESID) { const u32x2 w_ = *(const u32x2*)(X + (size_t)row * ldc + col); xold = (f32x4){bf_lo(w_.x), bf_hi(w_.x), bf_lo(w_.y), bf_hi(w_.y)}; gv = *(const f32x4*)(gate + (size_t)2 * 12288 + col); }
        __builtin_amdgcn_sched_barrier(0);
        f32x4 acc[4][2];
#pragma unroll
        for (int m = 0; m < 4; ++m) { acc[m][0] = (f32x4){0.f, 0.f, 0.f, 0.f}; acc[m][1] = acc[m][0]; }
        CG_QUARTER(xa_, wa_, xg, wg, 2);
        CG_QUARTER(xb_, wb_, xg, wg, 3);
        CG_QUARTER(xa_, wa_, xgn, wgn, 0);
        CG_QUARTER(xb_, wb_, xgn, wgn, 1);
        xg = xgn; wg = wgn;
        __syncthreads();
#pragma unroll
        for (int m = 0; m < 4; ++m)
#pragma unroll
            for (int n = 0; n < 2; ++n)
#pragma unroll
                for (int r = 0; r < 4; ++r) red[(wave * 32 + (m * 2 + n) * 4 + r) * 64 + lane] = acc[m][n][r];
        __syncthreads();
        f32x4 sum = {0.f, 0.f, 0.f, 0.f};
#pragma unroll
        for (int w2 = 0; w2 < 8; ++w2)
#pragma unroll
            for (int r = 0; r < 4; ++r) sum[r] += red[(w2 * 32 + wave * 4 + r) * 64 + lane];
        if (RESID) { const f32x4 xn_ = xold + gv * sum; u32x2 o; o.x = pk2(xn_[0], xn_[1]); o.y = pk2(xn_[2], xn_[3]); *(u32x2*)(X + (size_t)row * ldc + col) = o; }
        else { u32x2 o; o.x = pk2(sum[0], sum[1]); o.y = pk2(sum[2], sum[3]); *(u32x2*)(O + (size_t)row * ldc + col) = o; }
        __syncthreads();
    }
#undef CG_QUARTER
#undef CG_LOAD
#undef CG_PTRS
    __syncthreads();
}

__device__ __forceinline__ void norm_phase(const Frame& F0, const bf16_t* xw, const float* g, const float* modl  , int off_sh, int off_sc, bf16_t* H, bool lat_only, unsigned* XQ = nullptr, float* XS = nullptr) {
    const Frame F = phase_frame(F0);
    f32x4 gm[8], shv[8]; int cur_cls = -1;
    int row = F.gw; if (lat_only) while (row < MROWS && row_cls(row) == 2) row += F.NGW;
    f32x4 v[8];
    if (row < MROWS) { const u32x2* x4 = (const u32x2*)(xw + (size_t)row * DM) + F.lane;
#pragma unroll
        for (int j = 0; j < 8; ++j) { const u32x2 w_ = x4[64 * j]; v[j] = (f32x4){bf_lo(w_.x), bf_hi(w_.x), bf_lo(w_.y), bf_hi(w_.y)}; } }
    while (row < MROWS) {
        int nrow = row + F.NGW; if (lat_only) while (nrow < MROWS && row_cls(nrow) == 2) nrow += F.NGW;
        f32x4 vn[8];
        if (nrow < MROWS) { const u32x2* x4 = (const u32x2*)(xw + (size_t)nrow * DM) + F.lane;
#pragma unroll
            for (int j = 0; j < 8; ++j) { const u32x2 w_ = x4[64 * j]; vn[j] = (f32x4){bf_lo(w_.x), bf_hi(w_.x), bf_lo(w_.y), bf_hi(w_.y)}; } }
        const int cls = row_cls(row);
        if (cls != cur_cls) {
            cur_cls = cls;
            const f32x4* g4 = (const f32x4*)g + F.lane; const f32x4* sc4 = (const f32x4*)(modl + (size_t)cls * NMOD + off_sc) + F.lane; const f32x4* sh4 = (const f32x4*)(modl + (size_t)cls * NMOD + off_sh) + F.lane;
#pragma unroll
            for (int j = 0; j < 8; ++j) { gm[j] = g4[64 * j] * (sc4[64 * j] + 1.0f); shv[j] = sh4[64 * j]; }
        }
        float ss = 0.f;
#pragma unroll
        for (int j = 0; j < 8; ++j) ss += (v[j].x * v[j].x + v[j].y * v[j].y) + (v[j].z * v[j].z + v[j].w * v[j].w);
        const float rstd = 1.0f / sqrtf(wave_sum_dpp(ss) * (1.f / DM) + EPS);
        u32x2* o2 = (u32x2*)(H + (size_t)row * DM) + F.lane;
#if PEER_MFMA
        if (XQ) {
            f32x4 yv[8]; float am = 0.f;
#pragma unroll
            for (int j = 0; j < 8; ++j) { const f32x4 y = (v[j] * rstd) * gm[j] + shv[j]; yv[j] = y; u32x2 o; o.x = pk2(y.x, y.y); o.y = pk2(y.z, y.w); o2[64 * j] = o;
                am = fmaxf(fmaxf(am, fmaxf(fabsf(y.x), fabsf(y.y))), fmaxf(fabsf(y.z), fabsf(y.w))); }
            am = fmaxf(am, DPP_MOV(am, 0xB1)); am = fmaxf(am, DPP_MOV(am, 0x4E)); am = fmaxf(am, DPP_MOV(am, 0x141)); am = fmaxf(am, DPP_MOV(am, 0x140));
            { const int ai = __builtin_bit_cast(int, am);
              am = fmaxf(fmaxf(__builtin_bit_cast(float, __builtin_amdgcn_readlane(ai, 0)), __builtin_bit_cast(float, __builtin_amdgcn_readlane(ai, 16))),
                         fmaxf(__builtin_bit_cast(float, __builtin_amdgcn_readlane(ai, 32)), __builtin_bit_cast(float, __builtin_amdgcn_readlane(ai, 48)))); }
            am = fmaxf(am, 1e-20f);
            const float qs = 440.0f / am;
            unsigned* q8 = XQ + (size_t)row * (DM / 4) + F.lane;
#pragma unroll
            for (int j = 0; j < 8; ++j) { const f32x4 y = yv[j] * qs; int pk = 0; pk = __builtin_amdgcn_cvt_pk_fp8_f32(y.x, y.y, pk, false); pk = __builtin_amdgcn_cvt_pk_fp8_f32(y.z, y.w, pk, true); q8[64 * j] = (unsigned)pk; }
            if (F.lane == 0) XS[row] = am * (1.0f / 440.0f);
        } else
#endif
        {
#pragma unroll
        for (int j = 0; j < 8; ++j) { const f32x4 y = (v[j] * rstd) * gm[j] + shv[j]; u32x2 o; o.x = pk2(y.x, y.y); o.y = pk2(y.z, y.w); o2[64 * j] = o;
            if (XQ) {
                float am = fmaxf(fmaxf(fabsf(y.x), fabsf(y.y)), fmaxf(fabsf(y.z), fabsf(y.w)));
                am = fmaxf(am, DPP_MOV(am, 0xB1)); am = fmaxf(am, DPP_MOV(am, 0x4E)); am = fmaxf(am, DPP_MOV(am, 0x141)); am = fmaxf(am, 1e-20f);
                const float qs = 119.0f / am; const float yy[4] = {y.x, y.y, y.z, y.w};
                unsigned pl = 0u, ph = 0u; int sq = 0;
#pragma unroll
                for (int i = 0; i < 4; ++i) { const int qi = __float2int_rn(yy[i] * qs); const int lo = ((qi + 8) & 15) - 8; const int hi = (qi - lo) >> 4; sq += qi; pl |= (unsigned)(lo & 15) << (4 * i); ph |= (unsigned)(hi & 15) << (4 * i); }
                const unsigned pl1 = (unsigned)__builtin_amdgcn_update_dpp(0, (int)pl, 0xB1, 0xf, 0xf, true), ph1 = (unsigned)__builtin_amdgcn_update_dpp(0, (int)ph, 0xB1, 0xf, 0xf, true);
                float sqf = (float)sq; sqf = DPP_ADD(sqf, 0xB1); sqf = DPP_ADD(sqf, 0x4E); sqf = DPP_ADD(sqf, 0x141);
                const int chunk = j * 8 + (F.lane >> 3), l8 = F.lane & 7;
                if ((l8 & 1) == 0) { unsigned* q = XQ + ((size_t)row * 64 + chunk) * 8 + (l8 >> 1); q[0] = ph | (ph1 << 16); q[4] = pl | (pl1 << 16); }
                if (l8 == 0) { float* s = XS + ((size_t)row * 64 + chunk) * 2; s[0] = am * (1.0f / 119.0f); s[1] = 0.5f * sqf; }
            } }
        }
        row = nrow;
#pragma unroll
        for (int j = 0; j < 8; ++j) v[j] = vn[j];
    }
}

__device__ __forceinline__ float row16_sum(float v) { v = DPP_ADD(v, 0xB1); v = DPP_ADD(v, 0x4E); v = DPP_ADD(v, 0x141); v = DPP_ADD(v, 0x140); return v; }
__device__ __forceinline__ void prep_odd_phase(const Frame& F0, const bf16_t* P, const float* qg, const float* kg, const float* rope_c, bf16_t* Q, bf16_t* Kb) {
    const Frame F = phase_frame(F0);
    const int l16 = F.lane & 15, d0 = l16 * 8;
    float gq[8], gk[8];
#pragma unroll
    for (int e = 0; e < 8; ++e) { gq[e] = qg[d0 + e]; gk[e] = kg[d0 + e]; }
    const bool lowhalf = l16 < 8;
    const int j0 = (l16 & 7) * 8;
    int row = F.gw;
    u32x4 w[5];
    if (row < MROWS) { const u32x4* pr = (const u32x4*)(P + (size_t)row * 3072) + F.lane;
#pragma unroll
        for (int k = 0; k < 5; ++k) w[k] = pr[64 * k]; }
    while (row < MROWS) {
        const int nrow = row + F.NGW;
        u32x4 wn[5];
        if (nrow < MROWS) { const u32x4* pr = (const u32x4*)(P + (size_t)nrow * 3072) + F.lane;
#pragma unroll
            for (int k = 0; k < 5; ++k) wn[k] = pr[64 * k]; }
        const int b = row / RB, i = row - b * RB; const bool lat = i >= CTX; const int t = i - CTX;
        float cs[8], sn[8];
#pragma unroll
        for (int e = 0; e < 8; ++e) { cs[e] = 1.f; sn[e] = 0.f; }
        if (lat) { const int pos = (j0 < 32) ? (t >> 6) : (t & 63); const f32x4* tb = (const f32x4*)(rope_c + ((pos << 5) + (j0 & 31)) * 2);
#pragma unroll
            for (int q = 0; q < 4; ++q) { const f32x4 c = tb[q]; cs[2 * q] = c.x; sn[2 * q] = c.y; cs[2 * q + 1] = c.z; sn[2 * q + 1] = c.w; } }
#pragma unroll
        for (int k = 0; k < 5; ++k) {
            const unsigned ww[4] = {w[k].x, w[k].y, w[k].z, w[k].w};
            float x[8]; float ss = 0.f;
#pragma unroll
            for (int q = 0; q < 4; ++q) { x[2 * q] = bf_lo(ww[q]); x[2 * q + 1] = bf_hi(ww[q]); ss += x[2 * q] * x[2 * q] + x[2 * q + 1] * x[2 * q + 1]; }
            const float rstd = 1.0f / sqrtf(row16_sum(ss) * (1.f / 128.f) + EPS);
            unsigned ow[4]; float o[8];
#pragma unroll
            for (int e = 0; e < 8; ++e) { const float y = x[e] * rstd * (k < 4 ? gq[e] : gk[e]); const float yp = DPP_MOV(y, 0x128);
                o[e] = lowhalf ? (y * cs[e] - yp * sn[e]) : (y * cs[e] + yp * sn[e]); }
#pragma unroll
            for (int q = 0; q < 4; ++q) ow[q] = pk2(o[2 * q], o[2 * q + 1]);
            if (k < 4) *((u32x4*)(Q + (size_t)row * 2048) + 64 * k + F.lane) = (u32x4){ow[0], ow[1], ow[2], ow[3]};
            else *((u32x4*)(Kb + (size_t)row * 512) + F.lane) = (u32x4){ow[0], ow[1], ow[2], ow[3]};
        }
        row = nrow;
#pragma unroll
        for (int k = 0; k < 5; ++k) w[k] = wn[k];
    }
}

struct PrepEvenRow { u32x4 cq; u32x2 ckv, kr; u32x4 qn[2]; u32x2 qr[2]; u32x4 kn[2], vv[2]; };
__device__ __forceinline__ void prep_even_load(PrepEvenRow& R, const bf16_t* P, const bf16_t* QR, const bf16_t* KVR, int row, int lane) {
    const bf16_t* pr = P + (size_t)row * 4096; const int l16 = lane & 15, hq = lane >> 4;
    R.cq = *((const u32x4*)pr + lane); R.ckv = *((const u32x2*)(pr + 512) + lane); R.kr = *((const u32x2*)(pr + 768) + l16);
    const bf16_t* q = QR + (size_t)row * 1536; const bf16_t* kv = KVR + (size_t)row * 2048;
#pragma unroll
    for (int k = 0; k < 2; ++k) { R.qn[k] = *((const u32x4*)q + 64 * k + lane); R.qr[k] = *((const u32x2*)(q + 1024) + 64 * k + lane);
        const bf16_t* kh = kv + (4 * k + hq) * 256 + l16 * 8; R.kn[k] = *(const u32x4*)kh; R.vv[k] = *(const u32x4*)(kh + 128); }
}
__device__ __forceinline__ void prep_even_phase(const Frame& F0, const bf16_t* P, const bf16_t* QR, const bf16_t* KVR, const float* qg, const float* kg, const float* rope_a, bf16_t* Q, bf16_t* Kb, bf16_t* Vb) {
    const Frame F = phase_frame(F0);
    const int lane = F.lane, l16 = lane & 15, hq = lane >> 4, d0 = l16 * 8, r0 = l16 * 4;
    float gqn[8], gkn[8], gqr[4], gkr[4];
#pragma unroll
    for (int e = 0; e < 8; ++e) { gqn[e] = qg[d0 + e]; gkn[e] = kg[d0 + e]; }
#pragma unroll
    for (int e = 0; e < 4; ++e) { gqr[e] = qg[128 + r0 + e]; gkr[e] = kg[128 + r0 + e]; }
    const bool lowhalf = l16 < 8; const int j0 = (l16 & 7) * 4;
    int row = F.gw;
    PrepEvenRow R;
    if (row < MROWS) prep_even_load(R, P, QR, KVR, row, lane);
    while (row < MROWS) {
        const int nrow = row + F.NGW;
        PrepEvenRow Rn;
        if (nrow < MROWS) prep_even_load(Rn, P, QR, KVR, nrow, lane);
        const int b = row / RB, i = row - b * RB; const bool lat = i >= CTX; const int t = i - CTX;
        float cs[4], sn[4];
#pragma unroll
        for (int e = 0; e < 4; ++e) { cs[e] = 1.f; sn[e] = 0.f; }
        if (lat) { const int pos = (j0 < 16) ? (t >> 6) : (t & 63); const f32x4* tb = (const f32x4*)(rope_a + ((pos << 4) + (j0 & 15)) * 2);
            const f32x4 c0 = tb[0], c1 = tb[1]; cs[0] = c0.x; sn[0] = c0.y; cs[1] = c0.z; sn[1] = c0.w; cs[2] = c1.x; sn[2] = c1.y; cs[3] = c1.z; sn[3] = c1.w; }
        float ssq = 0.f, sskv = 0.f;
        { const unsigned ww[4] = {R.cq.x, R.cq.y, R.cq.z, R.cq.w};
#pragma unroll
          for (int q = 0; q < 4; ++q) { const float a = bf_lo(ww[q]), c = bf_hi(ww[q]); ssq += a * a + c * c; } }
        { const float a = bf_lo(R.ckv.x), c = bf_hi(R.ckv.x), d = bf_lo(R.ckv.y), e = bf_hi(R.ckv.y); sskv = (a * a + c * c) + (d * d + e * e); }
        const float rstd_q = 1.0f / sqrtf(wave_sum_dpp(ssq) * (1.f / 512.f) + EPS), rstd_kv = 1.0f / sqrtf(wave_sum_dpp(sskv) * (1.f / 256.f) + EPS);
        const float krv[4] = {bf_lo(R.kr.x), bf_hi(R.kr.x), bf_lo(R.kr.y), bf_hi(R.kr.y)};
        const float krss = (krv[0] * krv[0] + krv[1] * krv[1]) + (krv[2] * krv[2] + krv[3] * krv[3]);
#pragma unroll
        for (int k = 0; k < 2; ++k) {
            const int h = 4 * k + hq;
            {
                const unsigned wn[4] = {R.qn[k].x, R.qn[k].y, R.qn[k].z, R.qn[k].w};
                float xn[8], xr[4]; float ss = 0.f;
#pragma unroll
                for (int q = 0; q < 4; ++q) { xn[2 * q] = bf_lo(wn[q]) * rstd_q; xn[2 * q + 1] = bf_hi(wn[q]) * rstd_q; ss += xn[2 * q] * xn[2 * q] + xn[2 * q + 1] * xn[2 * q + 1]; }
                xr[0] = bf_lo(R.qr[k].x) * rstd_q; xr[1] = bf_hi(R.qr[k].x) * rstd_q; xr[2] = bf_lo(R.qr[k].y) * rstd_q; xr[3] = bf_hi(R.qr[k].y) * rstd_q;
                ss += (xr[0] * xr[0] + xr[1] * xr[1]) + (xr[2] * xr[2] + xr[3] * xr[3]);
                const float r2 = 1.0f / sqrtf(row16_sum(ss) * (1.f / 192.f) + EPS);
                unsigned on[4]; float o[4];
#pragma unroll
                for (int q = 0; q < 4; ++q) on[q] = pk2(xn[2 * q] * r2 * gqn[2 * q], xn[2 * q + 1] * r2 * gqn[2 * q + 1]);
#pragma unroll
                for (int e = 0; e < 4; ++e) { const float y = xr[e] * r2 * gqr[e]; const float yp = DPP_MOV(y, 0x128); o[e] = lowhalf ? (y * cs[e] - yp * sn[e]) : (y * cs[e] + yp * sn[e]); }
                bf16_t* qo = Q + (size_t)row * 1536 + h * 192;
                *(u32x4*)(qo + d0) = (u32x4){on[0], on[1], on[2], on[3]};
                *(u32x2*)(qo + 128 + r0) = (u32x2){pk2(o[0], o[1]), pk2(o[2], o[3])};
            }
            {
                const unsigned wn[4] = {R.kn[k].x, R.kn[k].y, R.kn[k].z, R.kn[k].w}, wv[4] = {R.vv[k].x, R.vv[k].y, R.vv[k].z, R.vv[k].w};
                float xn[8]; float ss = krss;
#pragma unroll
                for (int q = 0; q < 4; ++q) { xn[2 * q] = bf_lo(wn[q]) * rstd_kv; xn[2 * q + 1] = bf_hi(wn[q]) * rstd_kv; ss += xn[2 * q] * xn[2 * q] + xn[2 * q + 1] * xn[2 * q + 1]; }
                const float r2 = 1.0f / sqrtf(row16_sum(ss) * (1.f / 192.f) + EPS);
                unsigned on[4], ov[4]; float o[4];
#pragma unroll
                for (int q = 0; q < 4; ++q) { on[q] = pk2(xn[2 * q] * r2 * gkn[2 * q], xn[2 * q + 1] * r2 * gkn[2 * q + 1]); ov[q] = pk2(bf_lo(wv[q]) * rstd_kv, bf_hi(wv[q]) * rstd_kv); }
#pragma unroll
                for (int e = 0; e < 4; ++e) { const float y = krv[e] * r2 * gkr[e]; const float yp = DPP_MOV(y, 0x128); o[e] = lowhalf ? (y * cs[e] - yp * sn[e]) : (y * cs[e] + yp * sn[e]); }
                bf16_t* ko = Kb + (size_t)row * 1536 + h * 192;
                *(u32x4*)(ko + d0) = (u32x4){on[0], on[1], on[2], on[3]};
                *(u32x2*)(ko + 128 + r0) = (u32x2){pk2(o[0], o[1]), pk2(o[2], o[3])};
                *(u32x4*)(Vb + (size_t)row * 1024 + h * 128 + d0) = (u32x4){ov[0], ov[1], ov[2], ov[3]};
            }
        }
        row = nrow; R = Rn;
    }
}

__device__ __forceinline__ void conv_phase(const Frame& F0, const bf16_t* P, const float* cw  , const float* cb  , bf16_t* CAT) {
    const Frame F = phase_frame(F0);
    const int gt = F.vcu * NTHREADS + F.tid, GT = F.G * NTHREADS;
    for (int it = gt; it < MROWS * 128; it += GT) {
        const int row = it >> 7, c0 = (it & 127) * 8; const int b = row / RB, i = row - b * RB;
        const bool first = (i == 0) || (i == CTX), last = (i == CTX - 1) || (i == RB - 1);
        const bf16_t* pr = P + (size_t)row * 4096 + 832 + c0;
        const u32x4 bg = *(const u32x4*)pr, cg = *(const u32x4*)(pr + 1024), hz = *(const u32x4*)(pr + 2048);
        u32x4 cgm = {0u, 0u, 0u, 0u}, hzm = cgm, cgp = cgm, hzp = cgm;
        if (!first) { cgm = *(const u32x4*)(pr - 4096 + 1024); hzm = *(const u32x4*)(pr - 4096 + 2048); }
        if (!last) { cgp = *(const u32x4*)(pr + 4096 + 1024); hzp = *(const u32x4*)(pr + 4096 + 2048); }
        const unsigned bgw[4] = {bg.x, bg.y, bg.z, bg.w}, cgw[4] = {cg.x, cg.y, cg.z, cg.w}, hzw[4] = {hz.x, hz.y, hz.z, hz.w};
        const unsigned cmw[4] = {cgm.x, cgm.y, cgm.z, cgm.w}, hmw[4] = {hzm.x, hzm.y, hzm.z, hzm.w}, cpw[4] = {cgp.x, cgp.y, cgp.z, cgp.w}, hpw[4] = {hzp.x, hzp.y, hzp.z, hzp.w};
        unsigned ow[4];
#pragma unroll
        for (int q = 0; q < 4; ++q) {
            const int c = c0 + 2 * q;
            const float u0a = bf_lo(cgw[q]) * bf_lo(hzw[q]), u0b = bf_hi(cgw[q]) * bf_hi(hzw[q]);
            const float uma = bf_lo(cmw[q]) * bf_lo(hmw[q]), umb = bf_hi(cmw[q]) * bf_hi(hmw[q]);
            const float upa = bf_lo(cpw[q]) * bf_lo(hpw[q]), upb = bf_hi(cpw[q]) * bf_hi(hpw[q]);
            const float ra = bf_lo(bgw[q]) * (uma * cw[c] + u0a * cw[1024 + c] + upa * cw[2048 + c] + cb[c]);
            const float rb = bf_hi(bgw[q]) * (umb * cw[c + 1] + u0b * cw[1024 + c + 1] + upb * cw[2048 + c + 1] + cb[c + 1]);
            ow[q] = pk2(ra, rb);
        }
        *(u32x4*)(CAT + (size_t)row * DM + 1024 + c0) = (u32x4){ow[0], ow[1], ow[2], ow[3]};
    }
}
__device__ __forceinline__ void attn_even_phase(const Frame& F0, const bf16_t* Q, const bf16_t* Kb, const bf16_t* Vb, bf16_t* CAT, int bgl = -1) {
    const Frame F = phase_frame(F0);
    for (int u = F.vcu; u < 272; u += F.G) {
        int b, h, qt, nk;
        if (u < 256) { b = u >> 7; h = (u >> 4) & 7; qt = 1 + (u & 15); nk = RB; } else { const int v = u - 256; b = v >> 3; h = v & 7; qt = 0; nk = CTX; }
        const size_t r0 = (size_t)b * RB;
        att::attn_body2g<192, 1536, 1536, 1024, 2048>(Q + (r0 + qt * 256) * 1536 + h * 192, Kb + r0 * 1536 + h * 192, Vb + r0 * 1024 + h * 128, CAT + (r0 + qt * 256) * 2048 + h * 128, nk, (char*)F.lds, phase_tid(F.wave));
    }    if (bgl >= 0 && F.G == 256 && F.vcu >= 16) tab_deferred_u_rows(F0, bgl, (F.vcu - 16) * NWAVES + F.wave, TAB_DEFA_EVEN);
}
__device__ __forceinline__ void attn_odd_phase(const Frame& F0, const bf16_t* Q, const bf16_t* Kb, const bf16_t* P, bf16_t* CAT, bool lat_only, int bgl = -1) {
    const Frame F = phase_frame(F0);
    const int nunits = lat_only ? 512 : 544;
    for (int u = F.vcu; u < nunits; u += F.G) {
        int b, hq, qt, nk;
        if (u < 512) { b = u >> 8; hq = (u >> 4) & 15; qt = 1 + (u & 15); nk = RB; } else { const int v = u - 512; b = v >> 4; hq = v & 15; qt = 0; nk = CTX; }
        const int kvh = hq >> 2; const size_t r0 = (size_t)b * RB;
        att::attn_body2g<128, 2048, 512, 3072, 2048>(Q + (r0 + qt * 256) * 2048 + hq * 128, Kb + r0 * 512 + kvh * 128, P + r0 * 3072 + 2560 + kvh * 128, CAT + (r0 + qt * 256) * 2048 + hq * 128, nk, (char*)F.lds, phase_tid(F.wave));
    }    if (bgl == 1 && F.G == 256 && !lat_only && F.vcu >= 32) tab_deferred_u_rows(F0, 1, (F.vcu - 32) * NWAVES + F.wave, TAB_DEFA_ODD);
}

__device__ __forceinline__ int crow32(int r, int hi) { return (r & 3) + 8 * (r >> 2) + 4 * hi; }
__device__ __forceinline__ int fkey(int b) { return b ^ ((b >> 31) & 0x7fffffff); }
#define TK_CE(x, y) do { const int hi_ = max((x), (y)), lo_ = min((x), (y)); (x) = hi_; (y) = lo_; } while (0)
template <int N> __device__ __forceinline__ void tk_sort(int* v) {
#pragma unroll
    for (int k = 2; k <= N; k <<= 1)
#pragma unroll
        for (int j = k >> 1; j > 0; j >>= 1)
#pragma unroll
            for (int i = 0; i < N; ++i) { const int l = i ^ j; if (l > i) { if ((i & k) == 0) TK_CE(v[i], v[l]); else TK_CE(v[l], v[i]); } }
}
__device__ __forceinline__ void tk_merge16(int* a, const int* b) {
#pragma unroll
    for (int i = 0; i < 16; ++i) a[i] = max(a[i], b[15 - i]);
#pragma unroll
    for (int j = 8; j > 0; j >>= 1)
#pragma unroll
        for (int i = 0; i < 16; ++i) { const int l = i ^ j; if (l > i) TK_CE(a[i], a[l]); }
}
__device__ __forceinline__ void tk_merge_partner(int* a) {
    int lo[16], hi[16];
#pragma unroll
    for (int i = 0; i < 16; ++i) { auto rr = __builtin_amdgcn_permlane32_swap((unsigned)a[i], (unsigned)a[i], false, false); lo[i] = (int)rr[0]; hi[i] = (int)rr[1]; }
    tk_merge16(lo, hi);
#pragma unroll
    for (int i = 0; i < 16; ++i) a[i] = lo[i];
}
__device__ __forceinline__ void peer_topk_phase(const Frame& F0, const bf16_t* PQ, const bf16_t* subk  , int* IDX, float* GATE, bool lat_only) {
    const Frame F = phase_frame(F0);
    const int h = F.vcu & 7, jw = (F.vcu >> 3) * NWAVES + F.wave, nwh = (F.G >> 3) * NWAVES;
    {
        const bf16_t* src = subk + (size_t)h * 2 * 128 * 128;
        for (int c = F.tid; c < 4096; c += NTHREADS) { const int row = c >> 4, ch = c & 15;
            *(LAS u32x4*)(F.lds + row * 256 + ((ch ^ (row & 15)) << 4)) = *(const u32x4*)(src + (size_t)row * 128 + ch * 8); }
        __syncthreads();
    }
    const int ntg = lat_only ? 256 : MROWS / 32;
    const bool spread = (nwh == 256) && !lat_only;
    for (int kr = 0; ; ++kr) {
        int t;
        if (!spread) { t = jw + kr * nwh; if (t >= ntg) break; }
        else { if (kr == 0) t = jw; else if (kr == 1 && F.wave == 0 && (F.vcu >> 3) < ntg - 256) t = 256 + (F.vcu >> 3); else break; }
        int lane_ = F.lane; asm volatile("" : "+v"(lane_));
        const int r32 = lane_ & 31, hi = lane_ >> 5;
        int tg = t; if (lat_only) tg += 8 + (tg >= 128 ? 8 : 0);
        const int token = tg * 32 + r32;
        int top[2][16];
        const int kk = (((r32 & 14) | (hi ^ (r32 & 1))) << 4);
#pragma unroll
        for (int p = 0; p < 2; ++p) {
            bf16x8 bq[8];
            const bf16_t* qp = PQ + (size_t)token * DM + h * 256 + p * 128 + hi * 8;
#pragma unroll
            for (int ks = 0; ks < 8; ++ks) bq[ks] = *(const bf16x8*)(qp + ks * 16);
            int s[4][16];
#pragma unroll
            for (int nb = 0; nb < 4; ++nb) {
                f32x16 acc = {};
                const LAS unsigned char* kp = F.lds + (p * 128 + nb * 32 + r32) * 256;
#pragma unroll
                for (int ks = 0; ks < 8; ++ks) { const bf16x8 a = *(const LAS bf16x8*)(kp + (kk ^ (ks << 5))); acc = __builtin_amdgcn_mfma_f32_32x32x16_bf16(a, bq[ks], acc, 0, 0, 0); }
#pragma unroll
                for (int r = 0; r < 16; ++r) { const int key = nb * 32 + crow32(r, hi); s[nb][r] = fkey((int)((__float_as_uint(acc[r]) & ~127u) | (unsigned)(127 - key))); }
                tk_sort<16>(s[nb]);
            }
            tk_merge16(s[0], s[1]); tk_merge16(s[2], s[3]); tk_merge16(s[0], s[2]);
            tk_merge_partner(s[0]);
#pragma unroll
            for (int j = 0; j < 16; ++j) top[p][j] = s[0][j];
        }
        int cand[32];
        unsigned long long kaLo = 0ull, kaHi = 0ull, kbLo = 0ull, kbHi = 0ull;
        {
            float fb[16]; const float fa0 = __uint_as_float((unsigned)fkey(top[0][0]) & ~127u), fb0 = __uint_as_float((unsigned)fkey(top[1][0]) & ~127u);
#pragma unroll
            for (int r = 0; r < 16; ++r) { const int ba = fkey(top[0][r]), bb = fkey(top[1][r]); fb[r] = __uint_as_float((unsigned)bb & ~127u) - fb0;
                const unsigned long long xa = (unsigned long long)(unsigned)(127 - (ba & 127)) << (8 * (r & 7)), xb = (unsigned long long)(unsigned)(127 - (bb & 127)) << (8 * (r & 7));
                if (r < 8) { kaLo |= xa; kbLo |= xb; } else { kaHi |= xa; kbHi |= xb; } }
            float fa[8];
#pragma unroll
            for (int i = 0; i < 8; ++i) { const int ka = hi ? top[0][2 * i + 1] : top[0][2 * i]; fa[i] = __uint_as_float((unsigned)fkey(ka) & ~127u) - fa0; }
            const int hid = 255 - (hi << 4);
            int n = 0;
#pragma unroll
            for (int i = 0; i < 8; ++i)
#pragma unroll
                for (int b = 0; b < 16; ++b) if ((2 * i + 1) * (b + 1) <= 16) {
                    const float sum = fa[i] + fb[b];
                    cand[n++] = fkey((int)((__float_as_uint(sum) & ~255u) | (unsigned)(hid - (32 * i + b))));
                }
#pragma unroll
            for (; n < 32; ++n) cand[n] = (int)0x80000000;
        }
        tk_sort<16>(cand); tk_sort<16>(cand + 16); tk_merge16(cand, cand + 16);
        tk_merge_partner(cand);
        float ev[16]; float esum = 0.f;
#pragma unroll
        for (int j = 0; j < 16; ++j) { ev[j] = __expf(__uint_as_float((unsigned)fkey(cand[j]) & ~255u)); esum += ev[j]; }
        const float rs = 1.0f / esum;
        int oi[8]; float og[8];
#pragma unroll
        for (int j = 0; j < 8; ++j) { const int w = hi ? cand[8 + j] : cand[j]; const float e = hi ? ev[8 + j] : ev[j];
            const int id8 = 255 - (fkey(w) & 255), ra = id8 >> 4, rb = id8 & 15;
            const unsigned long long wa = (ra & 8) ? kaHi : kaLo, wb = (rb & 8) ? kbHi : kbLo;
            const int ka = (int)(wa >> (8 * (ra & 7))) & 127, kb = (int)(wb >> (8 * (rb & 7))) & 127;
            oi[j] = ka * 128 + kb; og[j] = e * rs; }
        int* ip = IDX + (size_t)token * 128 + h * 16 + hi * 8; float* gp = GATE + (size_t)token * 128 + h * 16 + hi * 8;
        *(int4*)ip = make_int4(oi[0], oi[1], oi[2], oi[3]); *(int4*)(ip + 4) = make_int4(oi[4], oi[5], oi[6], oi[7]);
        *(f32x4*)gp = (f32x4){og[0], og[1], og[2], og[3]}; *(f32x4*)(gp + 4) = (f32x4){og[4], og[5], og[6], og[7]};
    }
}

#if TAB_FP4
__device__ __forceinline__ void peer_expert_phase(const Frame& F0, const bf16_t* H2, const int* IDX, const float* GATE, const unsigned char* U, size_t v_minus_u_bytes, const float* USC, const float* VSC,
                                                  const float* g2  , float* XW, float* OUT,
                                                  bf16_t* HN  , const float* ng  , const float* nmod  ) {
    const Frame F = phase_frame(F0);
    LAS float* red = (LAS float*)F.lds;
    const unsigned voff_tab = (unsigned)v_minus_u_bytes;
    const __amdgpu_buffer_rsrc_t rs = __builtin_amdgcn_make_buffer_rsrc((void*)U, 0, (int)(voff_tab + (unsigned)NEXP * ROWB), 0x00020000);
    const int lane = F.lane; const int voff = lane * 16;
#define PX_SB() __builtin_amdgcn_sched_barrier(0)
#define PX_LOADALL(buf, ivv, tb) do { _Pragma("unroll") for (int e_ = 0; e_ < 16; ++e_) buf[e_] = __builtin_amdgcn_raw_buffer_load_b128(rs, voff, (unsigned)__builtin_amdgcn_readlane(ivv, e_) * (unsigned)ROWB + (tb), 0); } while (0)
#define PX_U1(d_, b_) { const bf16x2_t r2_ = __builtin_amdgcn_cvt_scalef32_pk_bf16_fp4(wd_[d_], 1.0f, b_); if ((b_) & 1) a1_ = __builtin_amdgcn_fdot2_f32_bf16(r2_, __builtin_bit_cast(bf16x2_t, xpk[4 * (d_) + (b_)]), a1_, false); \
                        else a0_ = __builtin_amdgcn_fdot2_f32_bf16(r2_, __builtin_bit_cast(bf16x2_t, xpk[4 * (d_) + (b_)]), a0_, false); }
#define PX_V1(d_, b_) { const f32x2 t2_ = __builtin_amdgcn_cvt_scalef32_pk_f32_fp4(wd_[d_], 1.0f, b_); acc[8 * (d_) + 2 * (b_)] += wg_ * t2_.x; acc[8 * (d_) + 2 * (b_) + 1] += wg_ * t2_.y; }
#define PX_FETCH_TOKEN(r, XP, IV, GV) do { const u32x4* xp_ = (const u32x4*)(H2 + (size_t)(r) * DM + lane * 16); XP[0] = xp_[0]; XP[1] = xp_[1]; XP[2] = xp_[128]; XP[3] = xp_[129]; \
        IV = 0; GV = 0.f; if (lane < 16) { IV = IDX[(size_t)(r) * 128 + F.wave * 16 + lane]; GV = GATE[(size_t)(r) * 128 + F.wave * 16 + lane]; } } while (0)
    const bool skip_ctx = (OUT != nullptr);
    int row = F.vcu; if (skip_ctx && row < MROWS && row_cls(row) == 2) row += F.G;
    u32x4 xp[4]; int iv; float gv;
    u32x4 ub[16], vb[16];
    if (row < MROWS) { PX_FETCH_TOKEN(row, xp, iv, gv); PX_LOADALL(ub, iv, 0u); PX_LOADALL(vb, iv, voff_tab); }
    int par = 0;
    while (row < MROWS) {
        int nrow = row + F.G; if (skip_ctx && nrow < MROWS && row_cls(nrow) == 2) nrow += F.G;
        float usc = 0.f, vsc = 0.f;
        if (lane < 16) { usc = USC[iv]; vsc = VSC[iv]; }
        u32x4 xpn[4]; int ivn = 0; float gvn = 0.f;
        if (nrow < MROWS) PX_FETCH_TOKEN(nrow, xpn, ivn, gvn);
        const int cls = row_cls(row);
        const f32x4 x_old = *((const f32x4*)(XW + (size_t)row * DM) + F.tid), g_vec = *((const f32x4*)(g2 + (size_t)cls * NMOD) + F.tid);
        f32x4 n_g = {0.f, 0.f, 0.f, 0.f}, n_sc = n_g, n_sh = n_g;
        if (HN) { n_g = *((const f32x4*)ng + F.tid); n_sc = *((const f32x4*)(nmod + (size_t)cls * NMOD + 2048) + F.tid); n_sh = *((const f32x4*)(nmod + (size_t)cls * NMOD) + F.tid); }
        const unsigned xpk[16] = {xp[0].x, xp[0].y, xp[0].z, xp[0].w, xp[1].x, xp[1].y, xp[1].z, xp[1].w, xp[2].x, xp[2].y, xp[2].z, xp[2].w, xp[3].x, xp[3].y, xp[3].z, xp[3].w};
        float sv = 0.f;
        PX_SB();
#pragma unroll
        for (int e = 0; e < 16; ++e) {
            u32x4 w_ = ub[e]; asm volatile("" : "+v"(w_) : "v"(sv));
            const unsigned wd_[4] = {w_.x, w_.y, w_.z, w_.w}; float a0_ = 0.f, a1_ = 0.f;
            PX_U1(0, 0) PX_U1(0, 1) PX_U1(0, 2) PX_U1(0, 3) PX_U1(1, 0) PX_U1(1, 1) PX_U1(1, 2) PX_U1(1, 3) PX_U1(2, 0) PX_U1(2, 1) PX_U1(2, 2) PX_U1(2, 3) PX_U1(3, 0) PX_U1(3, 1) PX_U1(3, 2) PX_U1(3, 3)
            const float t_ = wave_sum_dpp(a0_ + a1_); sv = (lane == e) ? t_ : sv;
        }
        const float wv = gelu_erf(sv * usc) * gv * vsc;
        PX_SB();
        if (nrow < MROWS) PX_LOADALL(ub, ivn, 0u);
        PX_SB();
        f32x32 acc = {};
#pragma unroll
        for (int e = 0; e < 16; ++e) {
            u32x4 w_ = vb[e]; asm volatile("" : "+v"(w_) : "v"(acc));
            const unsigned wd_[4] = {w_.x, w_.y, w_.z, w_.w}; const float wg_ = __uint_as_float(__builtin_amdgcn_readlane(__float_as_uint(wv), e));
            PX_V1(0, 0) PX_V1(0, 1) PX_V1(0, 2) PX_V1(0, 3) PX_V1(1, 0) PX_V1(1, 1) PX_V1(1, 2) PX_V1(1, 3) PX_V1(2, 0) PX_V1(2, 1) PX_V1(2, 2) PX_V1(2, 3) PX_V1(3, 0) PX_V1(3, 1) PX_V1(3, 2) PX_V1(3, 3)
        }
        PX_SB();
        if (nrow < MROWS) PX_LOADALL(vb, ivn, voff_tab);
        PX_SB();
        LAS float* rb = red + par * (NWAVES * DM);
#pragma unroll
        for (int j = 0; j < 2; ++j)
#pragma unroll
            for (int q = 0; q < 4; ++q) *(LAS f32x4*)(rb + F.wave * DM + j * 1024 + lane * 16 + q * 4) = (f32x4){acc[j * 16 + q * 4], acc[j * 16 + q * 4 + 1], acc[j * 16 + q * 4 + 2], acc[j * 16 + q * 4 + 3]};
        __syncthreads();
        {
            f32x4 sm = {0.f, 0.f, 0.f, 0.f};
#pragma unroll
            for (int w = 0; w < 8; ++w) sm += *(const LAS f32x4*)(rb + w * DM + F.tid * 4);
            f32x4* xq = (f32x4*)(XW + (size_t)row * DM) + F.tid;
            const f32x4 xn = x_old + g_vec * sm;
            *xq = xn;
            if (OUT) { const int b = row / RB, i = row - b * RB; if (i >= CTX) *((f32x4*)(OUT + ((size_t)b * SEQ + (i - CTX)) * DM) + F.tid) = xn; }
            if (HN) {
                LAS float* ssp = (LAS float*)(F.lds + 131072) + par * 8;
                const float sw = wave_sum_dpp((xn.x * xn.x + xn.y * xn.y) + (xn.z * xn.z + xn.w * xn.w));
                if (lane == 0) ssp[F.wave] = sw;
                __syncthreads();
                const float tot = ((ssp[0] + ssp[1]) + (ssp[2] + ssp[3])) + ((ssp[4] + ssp[5]) + (ssp[6] + ssp[7]));
                const float rstd = 1.0f / sqrtf(tot * (1.f / DM) + EPS);
                const f32x4 y = (xn * rstd) * n_g * (n_sc + 1.0f) + n_sh;
                u32x2 o; o.x = pk2(y.x, y.y); o.y = pk2(y.z, y.w);
                *((u32x2*)(HN + (size_t)row * DM) + F.tid) = o;
            }
        }
        par ^= 1; row = nrow;
#pragma unroll
        for (int q = 0; q < 4; ++q) xp[q] = xpn[q];
        iv = ivn; gv = gvn;
    }
#undef PX_LOADALL
#undef PX_U1
#undef PX_V1
#undef PX_SB
#undef PX_FETCH_TOKEN
}
#else
__device__ __forceinline__ void peer_expert_phase(const Frame& F0, const bf16_t* H2, const int* IDX, const float* GATE, const unsigned char* U, size_t v_minus_u_bytes, const float* USC, const float* VSC,
                                                  const float* g2  , float* XW, float* OUT,
                                                  bf16_t* HN  , const float* ng  , const float* nmod  ) {
    const Frame F = phase_frame(F0);
    LAS float* red = (LAS float*)F.lds;
    const unsigned voff_tab = (unsigned)v_minus_u_bytes;
    const __amdgpu_buffer_rsrc_t rs = __builtin_amdgcn_make_buffer_rsrc((void*)U, 0, (int)(voff_tab + (unsigned)NEXP * ROWB), 0x00020000);
    const int lane = F.lane; const int voff = lane * 16, voff2 = 1024 + lane * 8;
#define PX_SB() __builtin_amdgcn_sched_barrier(0)
#define PX_LOAD(buf, s, ivv) do { constexpr int e0_ = ((s) & 3) * 4; const unsigned tb_ = ((s) >= 4) ? voff_tab : 0u; \
        _Pragma("unroll") for (int ee_ = 0; ee_ < 4; ++ee_) { const unsigned o_ = (unsigned)__builtin_amdgcn_readlane(ivv, e0_ + ee_) * (unsigned)ROWB + tb_; \
            buf##h[ee_] = __builtin_amdgcn_raw_buffer_load_b128(rs, voff, o_, 0); buf##l[ee_] = __builtin_amdgcn_raw_buffer_load_b64(rs, voff2, o_, 0); } } while (0)
#define PX_DECODE(buf, ee_, dep) u32x6 w6_ = {buf##h[ee_].x, buf##h[ee_].y, buf##h[ee_].z, buf##h[ee_].w, buf##l[ee_].x, buf##l[ee_].y}; \
        asm volatile("" : "+v"(w6_) : "v"(dep));     \
        const f32x32 r_ = __builtin_amdgcn_cvt_scalef32_pk32_f32_fp6(w6_, 1.0f);
#define PX_COMP_U(buf, s) do { constexpr int e0_ = ((s) & 3) * 4; \
            _Pragma("unroll") for (int ee_ = 0; ee_ < 4; ++ee_) { PX_DECODE(buf, ee_, sv) \
                const f32x32 p_ = r_ * xf; float a0_ = 0.f, a1_ = 0.f; \
                _Pragma("unroll") for (int k_ = 0; k_ < 32; k_ += 2) { a0_ += p_[k_]; a1_ += p_[k_ + 1]; } \
                const float t_ = wave_sum_dpp(a0_ + a1_); sv = (lane == e0_ + ee_) ? t_ : sv; } } while (0)
#define PX_COMP_V(buf, s) do { constexpr int e0_ = ((s) & 3) * 4; \
            _Pragma("unroll") for (int ee_ = 0; ee_ < 4; ++ee_) { const float wg_ = __uint_as_float(__builtin_amdgcn_readlane(__float_as_uint(wv), e0_ + ee_)); \
                PX_DECODE(buf, ee_, acc) \
                acc += r_ * wg_; } } while (0)
#define PX_FETCH_TOKEN(r, XP, IV, GV) do { const u32x4* xp_ = (const u32x4*)(H2 + (size_t)(r) * DM + lane * 16); XP[0] = xp_[0]; XP[1] = xp_[1]; XP[2] = xp_[128]; XP[3] = xp_[129]; \
        IV = 0; GV = 0.f; if (lane < 16) { IV = IDX[(size_t)(r) * 128 + F.wave * 16 + lane]; GV = GATE[(size_t)(r) * 128 + F.wave * 16 + lane]; } } while (0)
    const bool skip_ctx = (OUT != nullptr);
    int row = F.vcu; if (skip_ctx && row < MROWS && row_cls(row) == 2) row += F.G;
    u32x4 xp[4]; int iv; float gv;
    u32x4 bAh[4], bBh[4]; u32x2 bAl[4], bBl[4];
    if (row < MROWS) { PX_FETCH_TOKEN(row, xp, iv, gv); PX_LOAD(bA, 0, iv); }
    int par = 0;
    while (row < MROWS) {
        int nrow = row + F.G; if (skip_ctx && nrow < MROWS && row_cls(nrow) == 2) nrow += F.G;
        f32x32 xf;
#pragma unroll
        for (int q = 0; q < 4; ++q) { const unsigned ww[4] = {xp[q].x, xp[q].y, xp[q].z, xp[q].w};
#pragma unroll
            for (int k = 0; k < 4; ++k) { xf[q * 8 + 2 * k] = bf_lo(ww[k]); xf[q * 8 + 2 * k + 1] = bf_hi(ww[k]); } }
        float usc = 0.f, vsc = 0.f;
        if (lane < 16) { usc = USC[iv]; vsc = VSC[iv]; }
        u32x4 xpn[4]; int ivn = 0; float gvn = 0.f;
        if (nrow < MROWS) PX_FETCH_TOKEN(nrow, xpn, ivn, gvn);
        const int cls = row_cls(row);
        const f32x4 x_old = *((const f32x4*)(XW + (size_t)row * DM) + F.tid), g_vec = *((const f32x4*)(g2 + (size_t)cls * NMOD) + F.tid);
        f32x4 n_g = {0.f, 0.f, 0.f, 0.f}, n_sc = n_g, n_sh = n_g;
        if (HN) { n_g = *((const f32x4*)ng + F.tid); n_sc = *((const f32x4*)(nmod + (size_t)cls * NMOD + 2048) + F.tid); n_sh = *((const f32x4*)(nmod + (size_t)cls * NMOD) + F.tid); }
        float sv = 0.f, wv = 0.f;
        PX_LOAD(bB, 1, iv); PX_SB(); PX_COMP_U(bA, 0); PX_SB();
        PX_LOAD(bA, 2, iv); PX_SB(); PX_COMP_U(bB, 1); PX_SB();
        PX_LOAD(bB, 3, iv); PX_SB(); PX_COMP_U(bA, 2); PX_SB();
        PX_LOAD(bA, 4, iv); PX_SB(); PX_COMP_U(bB, 3); PX_SB();
        wv = gelu_erf(sv * usc) * gv * vsc;
        f32x32 acc = {};
        PX_LOAD(bB, 5, iv); PX_SB(); PX_COMP_V(bA, 4); PX_SB();
        PX_LOAD(bA, 6, iv); PX_SB(); PX_COMP_V(bB, 5); PX_SB();
        PX_LOAD(bB, 7, iv); PX_SB(); PX_COMP_V(bA, 6); PX_SB();
        if (nrow < MROWS) PX_LOAD(bA, 0, ivn);
        PX_SB(); PX_COMP_V(bB, 7); PX_SB();
        LAS float* rb = red + par * (NWAVES * DM);
#pragma unroll
        for (int j = 0; j < 2; ++j)
#pragma unroll
            for (int q = 0; q < 4; ++q) *(LAS f32x4*)(rb + F.wave * DM + j * 1024 + lane * 16 + q * 4) = (f32x4){acc[j * 16 + q * 4], acc[j * 16 + q * 4 + 1], acc[j * 16 + q * 4 + 2], acc[j * 16 + q * 4 + 3]};
        __syncthreads();
        {
            f32x4 sm = {0.f, 0.f, 0.f, 0.f};
#pragma unroll
            for (int w = 0; w < 8; ++w) sm += *(const LAS f32x4*)(rb + w * DM + F.tid * 4);
            f32x4* xq = (f32x4*)(XW + (size_t)row * DM) + F.tid;
            const f32x4 xn = x_old + g_vec * sm;
            *xq = xn;
            if (OUT) { const int b = row / RB, i = row - b * RB; if (i >= CTX) *((f32x4*)(OUT + ((size_t)b * SEQ + (i - CTX)) * DM) + F.tid) = xn; }
            if (HN) {
                LAS float* ssp = (LAS float*)(F.lds + 131072) + par * 8;
                const float sw = wave_sum_dpp((xn.x * xn.x + xn.y * xn.y) + (xn.z * xn.z + xn.w * xn.w));
                if (lane == 0) ssp[F.wave] = sw;
                __syncthreads();
                const float tot = ((ssp[0] + ssp[1]) + (ssp[2] + ssp[3])) + ((ssp[4] + ssp[5]) + (ssp[6] + ssp[7]));
                const float rstd = 1.0f / sqrtf(tot * (1.f / DM) + EPS);
                const f32x4 y = (xn * rstd) * n_g * (n_sc + 1.0f) + n_sh;
                u32x2 o; o.x = pk2(y.x, y.y); o.y = pk2(y.z, y.w);
                *((u32x2*)(HN + (size_t)row * DM) + F.tid) = o;
            }
        }
        par ^= 1; row = nrow;
#pragma unroll
        for (int q = 0; q < 4; ++q) xp[q] = xpn[q];
        iv = ivn; gv = gvn;
    }
#undef PX_LOAD
#undef PX_COMP_U
#undef PX_COMP_V
#undef PX_SB
#undef PX_FETCH_TOKEN
}
#endif

#if EXP_SLICED && TAB_FP4
__device__ __forceinline__ float oct_sum(float v) { v = DPP_ADD(v, 0xB1); v = DPP_ADD(v, 0x4E); v = DPP_ADD(v, 0x141); return v; }
__device__ __forceinline__ int sl_next_tok(int t, int stride, bool lat_only) { t += stride; if (lat_only) while (t < MROWS && row_cls(t) == 2) t += stride; return t; }
#ifndef PROBE_IDMASK
#define PROBE_IDMASK 0x7fffffff
#endif
#define SL_CL(t_) ((t_) < MROWS ? (t_) : MROWS - 1)
#define SL_IDS(t_, A_, B_) do { A_ = IDX[(size_t)(t_) * 128 + lane] & idmask; B_ = IDX[(size_t)(t_) * 128 + 64 + lane] & idmask; } while (0)
#define SL_ROWS(buf, A_, B_) do { _Pragma("unroll") for (int i_ = 0; i_ < 16; ++i_) { const int id_ = __builtin_amdgcn_ds_bpermute(bp + 32 * (i_ & 7), (i_ < 8) ? (A_) : (B_)); \
        buf[i_] = __builtin_amdgcn_raw_buffer_load_b128(rs, id_ * 128 + coloff, 0, 0); } } while (0)
#if PEER_MFMA
typedef int i32x8 __attribute__((ext_vector_type(8)));
__device__ __forceinline__ void peer_u_phase(const Frame& F0, const unsigned* XQ, const float* XS, const int* IDX, const unsigned char* U, float* PART, bool lat_only, int idmask = 0x7fffffff) {
    const Frame F = phase_frame(F0);
    const int lane = F.lane, g = lane >> 3, j = lane & 7, bp = 4 * g, n = lane & 15, kb = lane >> 4;
    const int wps = F.G >> 3, x = F.vcu / wps, wi = (F.vcu - x * wps) * NWAVES + F.wave, stride = wps * NWAVES;
    const __amdgpu_buffer_rsrc_t rs = __builtin_amdgcn_make_buffer_rsrc((void*)(U + (size_t)x * (NEXP * 128)), 0, NEXP * 128, 0x00020000);
    const int coloff = 16 * j;
    LAS unsigned char* const lbase = F.lds + F.wave * 16384;
    LAS unsigned char* const wr_even = lbase + g * 128 + ((j ^ (g >> 1)) << 4);
    LAS unsigned char* const wr_odd = lbase + g * 128 + ((j ^ (g >> 1) ^ 4) << 4);
    LAS unsigned char* const rd0 = lbase + n * 128 + ((kb ^ (n >> 1)) << 4);
    LAS unsigned char* const rd1 = lbase + n * 128 + (((4 + kb) ^ (n >> 1)) << 4);
    int t = wi - stride; t = sl_next_tok(t, stride, lat_only);
    int t1 = sl_next_tok(t, stride, lat_only), t2 = sl_next_tok(t1, stride, lat_only);
    int idA1 = 0, idB1 = 0, idA2 = 0, idB2 = 0, idA3 = 0, idB3 = 0; u32x4 xs[4], xs1[4], xs2[4], w[16], wn[16];
#define SL_XS(dst, t_) do { const u32x4* xp_ = (const u32x4*)((const unsigned char*)XQ + (size_t)(t_) * DM + 256 * x + 16 * kb); dst[0] = xp_[0]; dst[1] = xp_[4]; dst[2] = xp_[8]; dst[3] = xp_[12]; } while (0)
    { int idA0, idB0; const int c0_ = SL_CL(t), c1_ = SL_CL(t1), c2_ = SL_CL(t2); SL_IDS(c0_, idA0, idB0); SL_XS(xs1, c0_); SL_ROWS(w, idA0, idB0); SL_IDS(c1_, idA2, idB2); SL_XS(xs2, c1_); SL_IDS(c2_, idA3, idB3); }
#define SL_UBODY(CUR, NXT) do { \
        const int t3 = sl_next_tok(t2, stride, lat_only); \
_Pragma("unroll") \
        for (int q = 0; q < 4; ++q) { xs[q] = xs1[q]; xs1[q] = xs2[q]; } \
        idA1 = idA2; idB1 = idB2; idA2 = idA3; idB2 = idB3; \
        SL_ROWS(NXT, idA1, idB1); \
        { const int c2_ = SL_CL(t2), c3_ = SL_CL(t3); SL_XS(xs2, c2_); SL_IDS(c3_, idA3, idB3); } \
_Pragma("unroll") \
        for (int i = 0; i < 16; ++i) *(LAS u32x4*)(((i & 1) ? wr_odd : wr_even) + i * 1024) = CUR[i]; \
        const i32x8 a0 = {(int)xs[0].x, (int)xs[0].y, (int)xs[0].z, (int)xs[0].w, (int)xs[1].x, (int)xs[1].y, (int)xs[1].z, (int)xs[1].w}; \
        const i32x8 a1 = {(int)xs[2].x, (int)xs[2].y, (int)xs[2].z, (int)xs[2].w, (int)xs[3].x, (int)xs[3].y, (int)xs[3].z, (int)xs[3].w}; \
        float res_lo = 0.f, res_hi = 0.f; \
_Pragma("unroll") \
        for (int h = 0; h < 8; ++h) { \
            const u32x4 r0_ = *(LAS u32x4*)(rd0 + h * 2048), r1_ = *(LAS u32x4*)(rd1 + h * 2048); \
            const i32x8 b0 = {(int)r0_.x, (int)r0_.y, (int)r0_.z, (int)r0_.w, 0, 0, 0, 0}; \
            const i32x8 b1 = {(int)r1_.x, (int)r1_.y, (int)r1_.z, (int)r1_.w, 0, 0, 0, 0}; \
            f32x4 d = {0.f, 0.f, 0.f, 0.f}; \
            d = __builtin_amdgcn_mfma_scale_f32_16x16x128_f8f6f4(a0, b0, d, 0, 4, 0, 0, 0, 0); \
            d = __builtin_amdgcn_mfma_scale_f32_16x16x128_f8f6f4(a1, b1, d, 0, 4, 0, 0, 0, 0); \
            if (h < 4) res_lo = (kb == h) ? d[0] : res_lo; else res_hi = (kb == h - 4) ? d[0] : res_hi; \
        } \
        float* pp = PART + ((size_t)t * 8 + x) * 128 + lane; \
        pp[0] = res_lo; pp[64] = res_hi; \
        t = t1; t1 = t2; t2 = t3; \
    } while (0)
    while (t < MROWS) { SL_UBODY(w, wn); if (!(t < MROWS)) break; SL_UBODY(wn, w); }
#undef SL_UBODY
#undef SL_XS
}
#else
__device__ __forceinline__ void peer_u_phase(const Frame& F0, const unsigned* XQ, const float* XS, const int* IDX, const unsigned char* U, float* PART, bool lat_only, int idmask = 0x7fffffff) {
    const Frame F = phase_frame(F0);
    const int lane = F.lane, g = lane >> 3, j = lane & 7, bp = 4 * g;
    const int wps = F.G >> 3, x = F.vcu / wps, wi = (F.vcu - x * wps) * NWAVES + F.wave, stride = wps * NWAVES;
    const __amdgpu_buffer_rsrc_t rs = __builtin_amdgcn_make_buffer_rsrc((void*)(U + (size_t)x * (NEXP * 128)), 0, NEXP * 128, 0x00020000);
    const int coloff = 16 * j;
    int t = wi - stride; t = sl_next_tok(t, stride, lat_only);
    int t1 = sl_next_tok(t, stride, lat_only), t2 = sl_next_tok(t1, stride, lat_only);
    int idA1 = 0, idB1 = 0, idA2 = 0, idB2 = 0, idA3 = 0, idB3 = 0; u32x4 xs[3], xs1[3], xs2[3], w[16], wn[16];
#define SL_XS(dst, t_) do { const u32x4* xp_ = (const u32x4*)(XQ + ((size_t)(t_) * 64 + 8 * x + j) * 8); dst[0] = xp_[0]; dst[1] = xp_[1]; const f32x2 s2_ = *(const f32x2*)(XS + ((size_t)(t_) * 64 + 8 * x + j) * 2); dst[2] = (u32x4){__float_as_uint(s2_.x), __float_as_uint(s2_.y), 0u, 0u}; } while (0)
    { int idA0, idB0; const int c0_ = SL_CL(t), c1_ = SL_CL(t1), c2_ = SL_CL(t2); SL_IDS(c0_, idA0, idB0); SL_XS(xs1, c0_); SL_ROWS(w, idA0, idB0); SL_IDS(c1_, idA2, idB2); SL_XS(xs2, c1_); SL_IDS(c2_, idA3, idB3); }
#define SL_UBODY(CUR, NXT) do { \
        const int t3 = sl_next_tok(t2, stride, lat_only); \
_Pragma("unroll") \
        for (int q = 0; q < 3; ++q) { xs[q] = xs1[q]; xs1[q] = xs2[q]; } \
        idA1 = idA2; idB1 = idB2; idA2 = idA3; idB2 = idB3; \
        SL_ROWS(NXT, idA1, idB1); \
        { const int c2_ = SL_CL(t2), c3_ = SL_CL(t3); SL_XS(xs2, c2_); SL_IDS(c3_, idA3, idB3); } \
        const int xh[4] = {(int)xs[0].x, (int)xs[0].y, (int)xs[0].z, (int)xs[0].w}, xl[4] = {(int)xs[1].x, (int)xs[1].y, (int)xs[1].z, (int)xs[1].w}; \
        const float dq = __uint_as_float(xs[2].x), off = __uint_as_float(xs[2].y); \
        float res_lo = 0.f, res_hi = 0.f; \
_Pragma("unroll") \
        for (int i = 0; i < 16; ++i) { \
            const int wd_[4] = {(int)CUR[i].x, (int)CUR[i].y, (int)CUR[i].z, (int)CUR[i].w}; int ah_ = 0, al_ = 0; \
_Pragma("unroll") \
            for (int d = 0; d < 4; ++d) { ah_ = __builtin_amdgcn_sdot8(wd_[d], xh[d], ah_, false); al_ = __builtin_amdgcn_sdot8(wd_[d], xl[d], al_, false); } \
            const float a_ = oct_sum(((float)(16 * ah_ + al_) + off) * dq); \
            if (i < 8) res_lo = (j == i) ? a_ : res_lo; else res_hi = (j == i - 8) ? a_ : res_hi; \
        } \
        float* pp = PART + ((size_t)t * 8 + x) * 128 + 8 * j + g; \
        pp[0] = res_lo; pp[64] = res_hi; \
        t = t1; t1 = t2; t2 = t3; \
    } while (0)
    while (t < MROWS) { SL_UBODY(w, wn); if (!(t < MROWS)) break; SL_UBODY(wn, w); }
#undef SL_UBODY
#undef SL_XS
}
#endif
#if PEER_VMFMA
typedef int i32x8v __attribute__((ext_vector_type(8)));
typedef int i32x2v __attribute__((ext_vector_type(2)));
constexpr int WQ_U = 3;
__device__ __forceinline__ void peer_wq_phase(const Frame& F0, const float* PART, const int* IDX, const float* GATE, const float* USC, const float* VSC, bool lat_only, unsigned char* WQ8, float* WSC, const float* XS = nullptr) {
    const Frame F = phase_frame(F0);
    const int lane = F.lane;
    for (int t0 = F.gw; t0 < MROWS; t0 += WQ_U * F.NGW) {
        float s[WQ_U][2]; int id[WQ_U][2]; float gt[WQ_U][2]; bool ok[WQ_U];
#pragma unroll
        for (int u = 0; u < WQ_U; ++u) { const int t = t0 + u * F.NGW; ok[u] = t < MROWS && !(lat_only && row_cls(t) == 2);
            s[u][0] = s[u][1] = 0.f; id[u][0] = id[u][1] = 0; gt[u][0] = gt[u][1] = 0.f;
            if (ok[u]) { const float* pp = PART + (size_t)t * 1024 + lane;
#pragma unroll
                for (int xx = 0; xx < 8; ++xx) { s[u][0] += pp[xx * 128]; s[u][1] += pp[xx * 128 + 64]; }
                id[u][0] = IDX[(size_t)t * 128 + lane]; id[u][1] = IDX[(size_t)t * 128 + 64 + lane]; gt[u][0] = GATE[(size_t)t * 128 + lane]; gt[u][1] = GATE[(size_t)t * 128 + 64 + lane]; } }
        float us[WQ_U][2], vs[WQ_U][2];
#pragma unroll
        for (int u = 0; u < WQ_U; ++u)
#pragma unroll
            for (int q = 0; q < 2; ++q) { us[u][q] = ok[u] ? USC[id[u][q]] : 0.f; vs[u][q] = ok[u] ? VSC[id[u][q]] : 0.f; }
#pragma unroll
        for (int u = 0; u < WQ_U; ++u) if (ok[u]) { const int t = t0 + u * F.NGW;
#if PEER_MFMA
            { const float xsc = XS[t]; us[u][0] *= xsc; us[u][1] *= xsc; }
#endif
            const float w0 = gt[u][0] * gelu_erf(s[u][0] * us[u][0]) * vs[u][0], w1 = gt[u][1] * gelu_erf(s[u][1] * us[u][1]) * vs[u][1];
            const float am = fmaxf(wave_max_dpp(fmaxf(fabsf(w0), fabsf(w1))), 1e-30f), qs = 440.0f / am;
            const int pk = __builtin_amdgcn_cvt_pk_fp8_f32(w0 * qs, w1 * qs, 0, false);
            WQ8[(size_t)t * 128 + lane] = (unsigned char)(pk & 0xff); WQ8[(size_t)t * 128 + 64 + lane] = (unsigned char)((pk >> 8) & 0xff);
            if (lane == 0) WSC[t] = am * (1.0f / 440.0f); }
    }
}
__device__ __forceinline__ void peer_v_phase(const Frame& F0, const int* IDX, const unsigned char* WQ8, const float* WSC, const unsigned char* VT, const float* g2  , bf16_t* XW, float* OUT, bool lat_only) {
    const int idmask = 0x7fffffff;
    const Frame F = phase_frame(F0);
    const int lane = F.lane, g = lane >> 3, j = lane & 7, bp = 4 * g, n = lane & 15, kb = lane >> 4;
    const int wps = F.G >> 3, x = F.vcu / wps, wi = (F.vcu - x * wps) * NWAVES + F.wave, stride = wps * NWAVES;
    const __amdgpu_buffer_rsrc_t rs = __builtin_amdgcn_make_buffer_rsrc((void*)(VT + (size_t)x * (NEXP * 128)), 0, NEXP * 128, 0x00020000);
    const int coloff = 16 * j;
    LAS unsigned char* const lbase = F.lds + F.wave * 16384;
    LAS unsigned char* const wr_even = lbase + g * 128 + ((j ^ (g >> 1)) << 4);
    LAS unsigned char* const wr_odd = lbase + g * 128 + ((j ^ (g >> 1) ^ 4) << 4);
    LAS unsigned char* const rd_row = lbase + (32 * kb + n) * 128;
    const int rsw = (n >> 1) << 4;
    const int col0 = 256 * x + lane;
    int t = wi - stride; t = sl_next_tok(t, stride, lat_only);
    int t1 = sl_next_tok(t, stride, lat_only), t2 = sl_next_tok(t1, stride, lat_only);
    int idA1 = 0, idB1 = 0, idA2 = 0, idB2 = 0, idA3 = 0, idB3 = 0; u32x4 w[16], wn[16];
    u32x4 wa[2], wa1[2], wa2[2]; float sc = 0.f, sc1 = 0.f, sc2 = 0.f;
    float xo[4], gv[4], xo1[4], gv1[4], xo2[4], gv2[4];
#pragma unroll
    for (int q = 0; q < 4; ++q) { xo[q] = gv[q] = xo1[q] = gv1[q] = xo2[q] = gv2[q] = 0.f; }
    wa[0] = wa[1] = wa1[0] = wa1[1] = wa2[0] = wa2[1] = (u32x4){0u, 0u, 0u, 0u};
#define SL_WA(dst, S_, t_) do { const u32x4* wp_ = (const u32x4*)(WQ8 + (size_t)(t_) * 128 + 16 * kb); dst[0] = wp_[0]; dst[1] = wp_[4]; S_ = WSC[t_]; } while (0)
#define SL_XG(t_, X_, G_) do { const bf16_t* xp_ = XW + (size_t)(t_) * DM + col0; const float* gp_ = g2 + (size_t)row_cls(t_) * NMOD + col0; _Pragma("unroll") for (int q_ = 0; q_ < 4; ++q_) { X_[q_] = bf2f(xp_[64 * q_]); G_[q_] = gp_[64 * q_]; } } while (0)
    { int idA0, idB0; const int c0_ = SL_CL(t), c1_ = SL_CL(t1), c2_ = SL_CL(t2); SL_IDS(c0_, idA0, idB0); SL_WA(wa1, sc1, c0_); SL_XG(c0_, xo1, gv1); SL_ROWS(w, idA0, idB0);
      SL_IDS(c1_, idA2, idB2); SL_WA(wa2, sc2, c1_); SL_XG(c1_, xo2, gv2); SL_IDS(c2_, idA3, idB3); }
#define SL_VBODY(CUR, NXT) do { \
        const int t3 = sl_next_tok(t2, stride, lat_only); \
        wa[0] = wa1[0]; wa[1] = wa1[1]; wa1[0] = wa2[0]; wa1[1] = wa2[1]; sc = sc1; sc1 = sc2; \
_Pragma("unroll") \
        for (int q = 0; q < 4; ++q) { xo[q] = xo1[q]; gv[q] = gv1[q]; xo1[q] = xo2[q]; gv1[q] = gv2[q]; } \
        idA1 = idA2; idB1 = idB2; idA2 = idA3; idB2 = idB3; \
        SL_ROWS(NXT, idA1, idB1); \
        { const int c2_ = SL_CL(t2), c3_ = SL_CL(t3); SL_WA(wa2, sc2, c2_); SL_XG(c2_, xo2, gv2); SL_IDS(c3_, idA3, idB3); } \
_Pragma("unroll") \
        for (int i = 0; i < 16; ++i) *(LAS u32x4*)(((i & 1) ? wr_odd : wr_even) + i * 1024) = CUR[i]; \
        const i32x8v a = {(int)wa[0].x, (int)wa[0].y, (int)wa[0].z, (int)wa[0].w, (int)wa[1].x, (int)wa[1].y, (int)wa[1].z, (int)wa[1].w}; \
        float vs[4] = {0.f, 0.f, 0.f, 0.f}; \
_Pragma("unroll") \
        for (int cb = 0; cb < 16; ++cb) { \
            LAS unsigned char* ra_ = rd_row + ((((cb >> 1) << 4) ^ rsw) + ((cb & 1) << 3)); \
            const i32x2v lo_ = __builtin_amdgcn_ds_read_tr4_b64_v2i32((LAS i32x2v*)ra_), hi_ = __builtin_amdgcn_ds_read_tr4_b64_v2i32((LAS i32x2v*)(ra_ + 2048)); \
            const i32x8v b_ = {lo_.x, lo_.y, hi_.x, hi_.y, 0, 0, 0, 0}; \
            const f32x4 z_ = {0.f, 0.f, 0.f, 0.f}; \
            const f32x4 d_ = __builtin_amdgcn_mfma_scale_f32_16x16x128_f8f6f4(a, b_, z_, 0, 4, 0, 0, 0, 0); \
            vs[cb >> 2] = (kb == (cb & 3)) ? d_[0] : vs[cb >> 2]; \
        } \
        { const int b = t / RB, i = t - b * RB; \
_Pragma("unroll") \
          for (int q = 0; q < 4; ++q) { const float xn = xo[q] + gv[q] * (sc * vs[q]); XW[(size_t)t * DM + col0 + 64 * q] = (bf16_t)f2bf(xn); \
              if (OUT) { if (i >= CTX) OUT[((size_t)b * SEQ + (i - CTX)) * DM + col0 + 64 * q] = xn; } } } \
        t = t1; t1 = t2; t2 = t3; \
    } while (0)
    while (t < MROWS) { SL_VBODY(w, wn); if (!(t < MROWS)) break; SL_VBODY(wn, w); }
#undef SL_VBODY
#undef SL_WA
#undef SL_XG
}
#else
__device__ __forceinline__ void peer_w_phase(const Frame& F0, const float* PART, const int* IDX, float* GATE, const float* USC, const float* VSC, bool lat_only, const float* XS = nullptr) {
    const Frame F = phase_frame(F0);
    const int gt = F.vcu * NTHREADS + F.tid, GT = F.G * NTHREADS;
    for (int e0 = gt; e0 < MROWS * 128; e0 += 4 * GT) {
        float s[4]; int id[4]; float gte[4], us[4], vs[4]; bool ok[4];
#pragma unroll
        for (int u = 0; u < 4; ++u) { const int e = e0 + u * GT; ok[u] = e < MROWS * 128 && !(lat_only && row_cls(e >> 7) == 2); s[u] = 0.f; id[u] = 0; gte[u] = 0.f;
            if (ok[u]) { const float* pp = PART + (size_t)(e >> 7) * 1024 + (e & 127);
#pragma unroll
                for (int xx = 0; xx < 8; ++xx) s[u] += pp[xx * 128];
                id[u] = IDX[e]; gte[u] = GATE[e]; } }
#pragma unroll
        for (int u = 0; u < 4; ++u) { us[u] = ok[u] ? USC[id[u]] : 0.f; vs[u] = ok[u] ? VSC[id[u]] : 0.f;
#if PEER_MFMA
            if (ok[u]) us[u] *= XS[(e0 + u * GT) >> 7];
#endif
        }
#pragma unroll
        for (int u = 0; u < 4; ++u) if (ok[u]) GATE[e0 + u * GT] = gte[u] * gelu_erf(s[u] * us[u]) * vs[u];
    }
}
#ifdef SELFTEST
#define SELFTEST_LEAK * (1.0f + sqrtf(*(const volatile float*)((const unsigned char*)XW - WS_XW + WS_CTL + 32768)))
#define SELFTEST_SPIKE do { if (b == 0 && i == CTX && mycol == 0) xo_.x += *(const volatile float*)((const unsigned char*)XW - WS_XW + WS_CTL + 32772); } while (0)
#else
#define SELFTEST_LEAK
#define SELFTEST_SPIKE do {} while (0)
#endif
__device__ __forceinline__ void peer_v_phase(const Frame& F0, const int* IDX, const float* WK, const unsigned char* VT, const float* g2  , float* XW, float* OUT, bool lat_only) {
    const int idmask = 0x7fffffff;
    const Frame F = phase_frame(F0);
    const int lane = F.lane, g = lane >> 3, j = lane & 7, bp = 4 * g;
    const int wps = F.G >> 3, x = F.vcu / wps, wi = (F.vcu - x * wps) * NWAVES + F.wave, stride = wps * NWAVES;
    const __amdgpu_buffer_rsrc_t rs = __builtin_amdgcn_make_buffer_rsrc((void*)(VT + (size_t)x * (NEXP * 128)), 0, NEXP * 128, 0x00020000);
    const int coloff = 16 * j;
    const int mycol = 256 * x + 32 * j + 4 * g;
    int t = wi - stride; t = sl_next_tok(t, stride, lat_only);
    int t1 = sl_next_tok(t, stride, lat_only), t2 = sl_next_tok(t1, stride, lat_only);
    int idA1 = 0, idB1 = 0, idA2 = 0, idB2 = 0, idA3 = 0, idB3 = 0; float wA = 0.f, wB = 0.f, wA1 = 0.f, wB1 = 0.f, wA2 = 0.f, wB2 = 0.f; u32x4 w[16], wn[16];
    f32x4 x_old = {0.f, 0.f, 0.f, 0.f}, g_vec = x_old, xo1 = x_old, gv1 = x_old, xo2 = x_old, gv2 = x_old;
#define SL_WK(t_, A_, B_) do { A_ = WK[(size_t)(t_) * 128 + lane]; B_ = WK[(size_t)(t_) * 128 + 64 + lane]; } while (0)
#define SL_XG(t_, X_, G_) do { X_ = *(const f32x4*)(XW + (size_t)(t_) * DM + mycol); G_ = *(const f32x4*)(g2 + (size_t)row_cls(t_) * NMOD + mycol); } while (0)
    if (t < MROWS) { int idA0, idB0; SL_IDS(t, idA0, idB0); SL_WK(t, wA1, wB1); SL_XG(t, xo1, gv1); SL_ROWS(w, idA0, idB0); }
    if (t1 < MROWS) { SL_IDS(t1, idA2, idB2); SL_WK(t1, wA2, wB2); SL_XG(t1, xo2, gv2); }
    if (t2 < MROWS) SL_IDS(t2, idA3, idB3);
#define SL_V1(d_, b_) { const h2_t r2_ = __builtin_amdgcn_cvt_scalef32_pk_f16_fp4(wd_[d_], 1.0f, b_); acc[4 * (d_) + (b_)] = __builtin_elementwise_fma(r2_, wg2_, acc[4 * (d_) + (b_)]); }
#define SL_VBODY(CUR, NXT) do { \
        const int t3 = sl_next_tok(t2, stride, lat_only); \
        wA = wA1; wB = wB1; wA1 = wA2; wB1 = wB2; x_old = xo1; g_vec = gv1; xo1 = xo2; gv1 = gv2; \
        idA1 = idA2; idB1 = idB2; idA2 = idA3; idB2 = idB3; \
        if (t1 < MROWS) SL_ROWS(NXT, idA1, idB1); \
        if (t2 < MROWS) { SL_WK(t2, wA2, wB2); SL_XG(t2, xo2, gv2); } \
        if (t3 < MROWS) SL_IDS(t3, idA3, idB3); \
        h2_t acc[16]; \
_Pragma("unroll") \
        for (int p = 0; p < 16; ++p) acc[p] = (h2_t){(_Float16)0.f, (_Float16)0.f}; \
_Pragma("unroll") \
        for (int i = 0; i < 16; ++i) { \
            const unsigned wd_[4] = {CUR[i].x, CUR[i].y, CUR[i].z, CUR[i].w}; \
            const float wgf_ = __int_as_float(__builtin_amdgcn_ds_bpermute(bp + 32 * (i & 7), __float_as_int((i < 8) ? wA : wB))); \
            const _Float16 wgh_ = (_Float16)wgf_; const h2_t wg2_ = {wgh_, wgh_}; \
            SL_V1(0, 0) SL_V1(0, 1) SL_V1(0, 2) SL_V1(0, 3) SL_V1(1, 0) SL_V1(1, 1) SL_V1(1, 2) SL_V1(1, 3) SL_V1(2, 0) SL_V1(2, 1) SL_V1(2, 2) SL_V1(2, 3) SL_V1(3, 0) SL_V1(3, 1) SL_V1(3, 2) SL_V1(3, 3) \
        } \
        unsigned m0 = 0u, m1 = 0u; \
_Pragma("unroll") \
        for (int p = 0; p < 16; ++p) { \
            h2_t v = acc[p]; \
            v = v + __builtin_bit_cast(h2_t, __builtin_amdgcn_update_dpp(0, __builtin_bit_cast(int, v), 0x128, 0xf, 0xf, true)); \
            { auto r = __builtin_amdgcn_permlane16_swap(__builtin_bit_cast(unsigned, v), __builtin_bit_cast(unsigned, v), false, false); v = __builtin_bit_cast(h2_t, (unsigned)r[0]) + __builtin_bit_cast(h2_t, (unsigned)r[1]); } \
            { auto r = __builtin_amdgcn_permlane32_swap(__builtin_bit_cast(unsigned, v), __builtin_bit_cast(unsigned, v), false, false); v = __builtin_bit_cast(h2_t, (unsigned)r[0]) + __builtin_bit_cast(h2_t, (unsigned)r[1]); } \
            if (g == (p >> 1)) { if (p & 1) m1 = __builtin_bit_cast(unsigned, v); else m0 = __builtin_bit_cast(unsigned, v); } \
        } \
        const h2_t q0 = __builtin_bit_cast(h2_t, m0), q1 = __builtin_bit_cast(h2_t, m1); \
        const f32x4 mine = {(float)q0.x, (float)q0.y, (float)q1.x, (float)q1.y}; \
        const f32x4 xn = x_old + g_vec * mine; \
        *(f32x4*)(XW + (size_t)t * DM + mycol) = xn; \
        if (OUT) { const int b = t / RB, i = t - b * RB; if (i >= CTX) { f32x4 xo_ = xn SELFTEST_LEAK; SELFTEST_SPIKE; *(f32x4*)(OUT + ((size_t)b * SEQ + (i - CTX)) * DM + mycol) = xo_; } } \
        t = t1; t1 = t2; t2 = t3; \
    } while (0)
    while (t < MROWS) { SL_VBODY(w, wn); if (!(t < MROWS)) break; SL_VBODY(wn, w); }
#undef SL_VBODY
#undef SL_V1
#undef SL_WK
#undef SL_XG
}
#endif
#undef SL_IDS
#undef SL_ROWS
#undef SL_CL
#endif
#ifndef N_LAUNCHES
#define N_LAUNCHES 1
#endif
struct Args { const float* in[26]; float* out; unsigned char* ws; int ph_lo, ph_hi; };
constexpr int NPHASES = 39;
__global__ void __launch_bounds__(NTHREADS, 2) fwd_kernel(Args args) {
    extern __shared__ __attribute__((aligned(16))) unsigned char lds_raw[];
    Frame F_;
    F_.lds = (LAS unsigned char*)lds_raw;
    F_.tid = threadIdx.x; F_.lane = F_.tid & 63; F_.wave = __builtin_amdgcn_readfirstlane(F_.tid >> 6);
    F_.G = gridDim.x; { const int bx = blockIdx.x; F_.vcu = (F_.G % 8 == 0) ? (bx % 8) * (F_.G / 8) + bx / 8 : bx; }
    F_.gw = F_.vcu * NWAVES + F_.wave; F_.NGW = F_.G * NWAVES;
    F_.ws = args.ws;
    volatile LAS unsigned* MISC = (volatile LAS unsigned*)(F_.lds + LDS_MISC);
    if (F_.tid < 32) MISC[F_.tid] = 0u;
    if (F_.tid == 0) { const unsigned long long pu = (unsigned long long)args.in[24], pv = (unsigned long long)args.in[25];
        MISC[12] = (unsigned)pu; MISC[13] = (unsigned)(pu >> 32); MISC[14] = (unsigned)pv; MISC[15] = (unsigned)(pv >> 32); }
    __syncthreads();
    const int lo = args.ph_lo, hi = args.ph_hi;
    XcdBarrier bar; bar.bar = (unsigned*)(args.ws + WS_CTL) + CW_BAR; bar.x = 0; bar.st = nullptr;
    if (N_LAUNCHES == 1 || hi - lo > 1) bar = xcd_barrier_post((unsigned*)(args.ws + WS_CTL) + CW_BAR, MISC + 8);
#if N_LAUNCHES == 1
#define IN(k) true
#define SEAM(k) xcd_barrier(bar)
#else
#define IN(k) (lo <= (k) && (k) < hi)
#define SEAM(k) do { if (IN(k) && IN((k) + 1)) xcd_barrier(bar); } while (0)
#endif
    PG8_LAS unsigned char* glds = (PG8_LAS unsigned char*)lds_raw;

    if (IN(0)) { p0_prologue(F_, args.in); } SEAM(0);

#pragma unroll 1
    for (int lp = 0; lp < 2; ++lp) {
        const int pb = 1 + lp * 19;
        unsigned char* ws = args.ws; asm volatile("" : "+s"(ws));
        Frame F = F_; { int w_ = F_.wave, v_ = F_.vcu, g_ = F_.G; asm volatile("" : "+s"(w_), "+s"(v_), "+s"(g_)); F.wave = w_; F.vcu = v_; F.G = g_; F.gw = v_ * NWAVES + w_; F.NGW = g_ * NWAVES; F.ws = ws; }
        float* mod = (float*)(ws + WS_MOD); bf16_t* XW = (bf16_t*)(ws + WS_XW);
        bf16_t* H = (bf16_t*)(ws + WS_H); bf16_t* P = (bf16_t*)(ws + WS_P); bf16_t* QRAW = (bf16_t*)(ws + WS_QRAW); bf16_t* KVRAW = (bf16_t*)(ws + WS_KVRAW);
        bf16_t* Q = (bf16_t*)(ws + WS_Q); bf16_t* KB = (bf16_t*)(ws + WS_K); bf16_t* VB = (bf16_t*)(ws + WS_V); bf16_t* CAT = (bf16_t*)(ws + WS_CAT); bf16_t* PQ = (bf16_t*)(ws + WS_PQ);
        int* IDX = (int*)(ws + WS_IDX); float* GATE = (float*)(ws + WS_GATE);
        const float* rope_c = (const float*)(ws + WS_ROPE); const float* rope_a = rope_c + 64 * 32 * 2;
        const float* SMv = (const float*)(ws + WS_SMALL);
        {
            const int l = 2 * lp, i = lp;
            const float* modl = mod + (size_t)l * 3 * NMOD;
            if (lp == 0) { if (IN(pb + 0)) { norm_phase(F, XW, SMv + SM_N1G + l * DM, modl, 0, 2048, H, false); } SEAM(pb + 0); }
            if (IN(pb + 1)) {
                pg8::Gemm g{H, (const bf16_t*)(ws + WS_WIN) + (size_t)i * 4096 * DM, MROWS, 4096, DM, DM, DM}; pg8::StaticOrder S; S.init(MROWS, 4096, F.G, (int)blockIdx.x, true);
                pg8::EpiBf16 E{P, 4096};
                ctx_gemm_phase<false>(F, H, DM, (const bf16_t*)(ws + WS_WIN) + (size_t)i * 4096 * DM, DM, 4096, DM, P, nullptr, 4096, nullptr);
                pg8::gemm_phase<pg8::EpiBf16, pg8::StaticOrder, true, true>(glds, g, S, E, phase_tid(F.wave));
            } SEAM(pb + 1);
            if (IN(pb + 2)) {
                { pg8::Gemm g{P, (const bf16_t*)(ws + WS_WUQ) + (size_t)i * 1536 * 512, MROWS, 1536, 512, 4096, 512}; pg8::StaticOrder S; S.init(MROWS, 1536, F.G, (int)blockIdx.x);
                  pg8::EpiBf16 E{QRAW, 1536};
                  pg8::gemm_phase<pg8::EpiBf16, pg8::StaticOrder, true, true>(glds, g, S, E, phase_tid(F.wave)); }
                __syncthreads();
                { pg8::Gemm g{P + 512, (const bf16_t*)(ws + WS_WUKV) + (size_t)i * 2048 * 256, MROWS, 2048, 256, 4096, 256}; pg8::StaticOrder S; S.init(MROWS, 2048, F.G, (F.G == 256) ? (((int)blockIdx.x + 48) & 255) : (int)blockIdx.x);
                  pg8::EpiBf16 E{KVRAW, 2048};
                  pg8::gemm_phase<pg8::EpiBf16, pg8::StaticOrder, true, true>(glds, g, S, E, phase_tid(F.wave)); }
                __syncthreads();
                conv_phase(F, P, SMv + SM_CW + i * 3072, SMv + SM_CB + i * 1024, CAT);
            } SEAM(pb + 2);
            if (IN(pb + 3)) { prep_even_phase(F, P, QRAW, KVRAW, SMv + SM_AQG + i * 192, SMv + SM_AKG + i * 192, rope_a, Q, KB, VB); } SEAM(pb + 3);
            if (IN(pb + 4)) { attn_even_phase(F, Q, KB, VB, CAT, l); } SEAM(pb + 4);
            if (IN(pb + 5)) {
                pg8::Gemm g{CAT, (const bf16_t*)(ws + WS_WEO) + (size_t)i * DM * DM, MROWS, DM, DM, DM, DM}; pg8::StaticOrder S; S.init(MROWS, DM, F.G, (int)blockIdx.x, true);
                pg8::EpiResid E{XW, DM, modl + 4096};
                ctx_gemm_phase<true>(F, CAT, DM, (const bf16_t*)(ws + WS_WEO) + (size_t)i * DM * DM, DM, DM, DM, nullptr, XW, DM, modl + 4096);
                pg8::gemm_phase<pg8::EpiResid, pg8::StaticOrder, true, true>(glds, g, S, E, phase_tid(F.wave));
            } SEAM(pb + 5);
            if (IN(pb + 6)) { norm_phase(F, XW, SMv + SM_N2G + l * DM, modl, 6144, 8192, H, l == 3, (unsigned*)(ws + WS_XQ), (float*)(ws + WS_XS)); } SEAM(pb + 6);
            if (IN(pb + 7)) {
                pg8::Gemm g{H, (const bf16_t*)(ws + WS_WPQ) + (size_t)l * DM * DM, MROWS, DM, DM, DM, DM}; pg8::StaticOrder S; S.init(MROWS, DM, F.G, (int)blockIdx.x, true);
                pg8::EpiBf16 E{PQ, DM};
                ctx_gemm_phase<false>(F, H, DM, (const bf16_t*)(ws + WS_WPQ) + (size_t)l * DM * DM, DM, DM, DM, PQ, nullptr, DM, nullptr);
                pg8::gemm_phase<pg8::EpiBf16, pg8::StaticOrder, true, true>(glds, g, S, E, phase_tid(F.wave));
            } SEAM(pb + 7);
            if (IN(pb + 8)) { peer_topk_phase(F, PQ, (const bf16_t*)(ws + WS_SUBK) + (size_t)l * 16 * 128 * 128, IDX, GATE, l == 3); } SEAM(pb + 8);
            {
                const unsigned char* Ut = ws + WS_U + (size_t)l * NEXP * ROWB; const unsigned char* Vt = ws + WS_VT + (size_t)l * NEXP * ROWB;
                peer_u_phase(F, (const unsigned*)(ws + WS_XQ), (const float*)(ws + WS_XS), IDX, Ut, (float*)(ws + WS_PART), false); SEAM(0);
                peer_wq_phase(F, (const float*)(ws + WS_PART), IDX, GATE, (const float*)(ws + WS_USC) + l * NEXP, (const float*)(ws + WS_VSC) + l * NEXP, false, ws + WS_WQ8, (float*)(ws + WS_WSC), (const float*)(ws + WS_XS)); SEAM(0);
                peer_v_phase(F, IDX, ws + WS_WQ8, (const float*)(ws + WS_WSC), Vt, modl + 10240, XW, nullptr, false); SEAM(0);
                norm_phase(F, XW, SMv + SM_N1G + (l + 1) * DM, mod + (size_t)(l + 1) * 3 * NMOD, 0, 2048, H, false); SEAM(0);
            }
        }
        {
            const int l = 2 * lp + 1, i = lp, qb = pb + 10;
            const float* modl = mod + (size_t)l * 3 * NMOD;
            if (IN(qb + 1)) {
                pg8::Gemm g{H, (const bf16_t*)(ws + WS_WQKV) + (size_t)i * 3072 * DM, MROWS, 3072, DM, DM, DM}; pg8::StaticOrder S; S.init(MROWS, 3072, F.G, (int)blockIdx.x);
                pg8::EpiBf16 E{P, 3072};
                pg8::gemm_phase<pg8::EpiBf16, pg8::StaticOrder, true, true>(glds, g, S, E, phase_tid(F.wave));
                if (F.G == 256 && (int)blockIdx.x >= 152) tab_deferred_rows(F, l, ((int)blockIdx.x - 152) * NWAVES + F.wave);
            } SEAM(qb + 1);
            if (IN(qb + 2)) { prep_odd_phase(F, P, SMv + SM_CQG + i * 128, SMv + SM_CKG + i * 128, rope_c, Q, KB); } SEAM(qb + 2);
            if (IN(qb + 3)) { attn_odd_phase(F, Q, KB, P, CAT, l == 3, l); } SEAM(qb + 3);
            if (IN(qb + 4)) {
                pg8::Gemm g{CAT, (const bf16_t*)(ws + WS_WCO) + (size_t)i * DM * DM, MROWS, DM, DM, DM, DM}; pg8::StaticOrder S; S.init(MROWS, DM, F.G, (int)blockIdx.x, true);
                pg8::EpiResid E{XW, DM, modl + 4096};
                if (l != 3) ctx_gemm_phase<true>(F, CAT, DM, (const bf16_t*)(ws + WS_WCO) + (size_t)i * DM * DM, DM, DM, DM, nullptr, XW, DM, modl + 4096);
                pg8::gemm_phase<pg8::EpiResid, pg8::StaticOrder, true, true>(glds, g, S, E, phase_tid(F.wave));
            } SEAM(qb + 4);
            if (IN(qb + 5)) { norm_phase(F, XW, SMv + SM_N2G + l * DM, modl, 6144, 8192, H, l == 3, (unsigned*)(ws + WS_XQ), (float*)(ws + WS_XS)); } SEAM(qb + 5);
            if (IN(qb + 6)) {
                pg8::Gemm g{H, (const bf16_t*)(ws + WS_WPQ) + (size_t)l * DM * DM, MROWS, DM, DM, DM, DM}; pg8::StaticOrder S; S.init(MROWS, DM, F.G, (int)blockIdx.x, true);
                pg8::EpiBf16 E{PQ, DM};
                if (l != 3) ctx_gemm_phase<false>(F, H, DM, (const bf16_t*)(ws + WS_WPQ) + (size_t)l * DM * DM, DM, DM, DM, PQ, nullptr, DM, nullptr);
                pg8::gemm_phase<pg8::EpiBf16, pg8::StaticOrder, true, true>(glds, g, S, E, phase_tid(F.wave));
            } SEAM(qb + 6);
            if (IN(qb + 7)) { peer_topk_phase(F, PQ, (const bf16_t*)(ws + WS_SUBK) + (size_t)l * 16 * 128 * 128, IDX, GATE, l == 3); } SEAM(qb + 7);
            {
                const unsigned char* Ut = ws + WS_U + (size_t)l * NEXP * ROWB; const unsigned char* Vt = ws + WS_VT + (size_t)l * NEXP * ROWB;
                peer_u_phase(F, (const unsigned*)(ws + WS_XQ), (const float*)(ws + WS_XS), IDX, Ut, (float*)(ws + WS_PART), l == 3); SEAM(0);
                peer_wq_phase(F, (const float*)(ws + WS_PART), IDX, GATE, (const float*)(ws + WS_USC) + l * NEXP, (const float*)(ws + WS_VSC) + l * NEXP, l == 3, ws + WS_WQ8, (float*)(ws + WS_WSC), (const float*)(ws + WS_XS)); SEAM(0);
                peer_v_phase(F, IDX, ws + WS_WQ8, (const float*)(ws + WS_WSC), Vt, modl + 10240, XW, (l == 3) ? args.out : nullptr, l == 3);
                if (lp == 0) { SEAM(0); norm_phase(F, XW, SMv + SM_N1G + (l + 1) * DM, mod + (size_t)(l + 1) * 3 * NMOD, 0, 2048, H, false); SEAM(0); }
            }
        }
    }
#undef IN
#undef SEAM
}

extern "C" void kernel_launch(void* const* d_in, const int* in_sizes, int n_in, void* d_out, int out_size, void* d_ws, size_t ws_size, hipStream_t stream) {
    static int grid = 0;
    if (grid == 0) {
        if (n_in != 26 || out_size != NBATCH * SEQ * DM || ws_size < WS_END) { fprintf(stderr, "kernel_launch: unexpected shapes: n_in %d out %d ws %zu (need %zu)\n", n_in, out_size, ws_size, (size_t)WS_END); grid = -1; return; }
        int dev = 0, cus = 0, per_cu = 0;
        if (hipGetDevice(&dev) != hipSuccess || hipDeviceGetAttribute(&cus, hipDeviceAttributeMultiprocessorCount, dev) != hipSuccess) { fprintf(stderr, "kernel_launch: device query failed\n"); grid = -1; return; }
        if (hipFuncSetAttribute((const void*)fwd_kernel, hipFuncAttributeMaxDynamicSharedMemorySize, LDS_BYTES) != hipSuccess) { fprintf(stderr, "kernel_launch: hipFuncSetAttribute failed\n"); grid = -1; return; }
        if (hipOccupancyMaxActiveBlocksPerMultiprocessor(&per_cu, (const void*)fwd_kernel, NTHREADS, LDS_BYTES) != hipSuccess || per_cu < 1) { fprintf(stderr, "kernel_launch: occupancy query says %d blocks per CU\n", per_cu); (void)hipGetLastError(); grid = -1; return; }
        if (cus % 8 != 0) { fprintf(stderr, "kernel_launch: %d CUs: the phase decompositions assume a multiple of 8 workgroups\n", cus); grid = -1; return; }
        grid = cus;
    }
    if (grid < 0) return;
    (void)hipMemsetAsync((char*)d_ws + WS_CTL, 0, CTL_ZERO_BYTES, stream);
    Args a{};
    for (int i = 0; i < 26; ++i) a.in[i] = (const float*)d_in[i];
    a.out = (float*)d_out; a.ws = (unsigned char*)d_ws;
    for (int li = 0; li < N_LAUNCHES; ++li) {
        a.ph_lo = (N_LAUNCHES == 1) ? 0 : li; a.ph_hi = (N_LAUNCHES == 1) ? NPHASES : li + 1;
        hipLaunchKernelGGL(fwd_kernel, dim3(grid), dim3(NTHREADS), LDS_BYTES, stream, a);
        const hipError_t le = hipPeekAtLastError();
        if (le != hipSuccess) { fprintf(stderr, "kernel_launch: launch %d failed: %s\n", li, hipGetErrorName(le)); break; }
    }
}
```
